# Optimizing an MI355X kernel written in HIP

```python
import math
import jax, jax.numpy as jnp
from jax import lax
import numpy as np


D_MODEL = 1024
BATCH = 8
SEQ = 4096
DEPTH = 1

HEAD_DIM = 64
MIX_WIDTH = D_MODEL
RWKV_WIDTH = MIX_WIDTH // 2
RWKV_HEADS = RWKV_WIDTH // HEAD_DIM
DIFF_WIDTH = MIX_WIDTH - RWKV_WIDTH
DIFF_QK = HEAD_DIM
DIFF_VD = 2 * HEAD_DIM
DIFF_HEADS = DIFF_WIDTH // DIFF_VD
DECAY_LORA = 32
AAA_LORA = 32
GATE_LORA = 96
N_RWKV_COLS = 3 * RWKV_WIDTH + DECAY_LORA + AAA_LORA + GATE_LORA
N_DIFF_COLS = 3 * DIFF_WIDTH
N_IN = N_RWKV_COLS + N_DIFF_COLS
NUM_BUCKETS = 32
MAX_DISTANCE = 128
Q_BLOCK = 128
N_EXPERTS = 32
TOP_K = 4
D_EXPERT = D_MODEL
SWIGLU_LIMIT = 7.0
SWIGLU_ALPHA = 1.702
ROW_BLOCK = 128
NORM_EPS = 1e-5
LNX_EPS = 64e-5

kernel_name = 'hymba_rwkv7_diffattn_moe_block'


def rms_norm(t, g, eps=NORM_EPS):
    t32 = t.astype(jnp.float32)
    y = t32 * lax.rsqrt(jnp.mean(t32 * t32, axis=-1, keepdims=True) + eps)
    return (y * g.astype(jnp.float32)).astype(t.dtype)


def t5_causal_bucket(dist):
    n = jnp.maximum(dist, 0)
    max_exact = NUM_BUCKETS // 2
    nf = jnp.maximum(n, 1).astype(jnp.float32)
    large = max_exact + (jnp.log(nf / max_exact) / math.log(MAX_DISTANCE / max_exact)
                         * (NUM_BUCKETS - max_exact)).astype(jnp.int32)
    large = jnp.minimum(large, NUM_BUCKETS - 1)
    return jnp.where(n < max_exact, n, large)


def rwkv7_time_mix(p, mu, w0, w2, a0, a2, g2, k_k, k_a, r_k, lnx_g, lnx_b):
    B, S, _ = p.shape
    H, N, C = RWKV_HEADS, HEAD_DIM, RWKV_WIDTH
    prev = jnp.pad(p, ((0, 0), (1, 0), (0, 0)))[:, :-1]
    p = (p + (prev - p) * mu).astype(jnp.float32)
    r, k, v, xw, xa, xg = jnp.split(
        p, [C, 2 * C, 3 * C, 3 * C + DECAY_LORA, 3 * C + DECAY_LORA + AAA_LORA], axis=-1)
    w = -jax.nn.softplus(-(w0 + jnp.tanh(xw) @ w2)) - 0.5
    decay = jnp.exp(-jnp.exp(w))
    a = jax.nn.sigmoid(a0 + xa @ a2)
    g = jax.nn.sigmoid(xg) @ g2
    heads = lambda t: t.reshape(B, S, H, N)
    kk = heads(k * k_k)
    kk = kk * lax.rsqrt(jnp.maximum(jnp.sum(kk * kk, -1, keepdims=True), 1e-24))
    k = k * (1.0 + (a - 1.0) * k_a)
    r_h, k_h, v_h, a_h, d_h = heads(r), heads(k), heads(v), heads(a), heads(decay)
    tm = lambda t: jnp.moveaxis(t, 1, 0)
    xs = (tm(r_h), tm(d_h), tm(k_h), tm(v_h), tm(-kk), tm(kk * a_h))

    def step(state, inp):
        r_t, w_t, k_t, v_t, a_t, b_t = inp
        sa = jnp.einsum('bhij,bhj->bhi', state, a_t)
        state = (state * w_t[:, :, None, :] + sa[..., None] * b_t[:, :, None, :]
                 + v_t[..., None] * k_t[:, :, None, :])
        return state, jnp.einsum('bhij,bhj->bhi', state, r_t)

    state0 = jnp.zeros((B, H, N, N), jnp.float32)
    _, y = lax.scan(step, state0, xs)
    y = jnp.moveaxis(y, 0, 1)
    mean = jnp.mean(y, -1, keepdims=True)
    var = jnp.mean(jnp.square(y - mean), -1, keepdims=True)
    y = ((y - mean) * lax.rsqrt(var + LNX_EPS)).reshape(B, S, C) * lnx_g + lnx_b
    bonus = jnp.sum(r_h * k_h * r_k, -1, keepdims=True) * v_h
    return (y + bonus.reshape(B, S, C)) * g


def diff_attention(p, qn_g, kn_g, lq1, lk1, lq2, lk2, subln_g, rel_bias, lam_init):
    B, S, _ = p.shape
    H = DIFF_HEADS
    q, k, v = jnp.split(p, [DIFF_WIDTH, 2 * DIFF_WIDTH], axis=-1)
    q = q.reshape(B, S, H, 2, DIFF_QK).transpose(0, 2, 3, 1, 4)
    k = k.reshape(B, S, H, 2, DIFF_QK).transpose(0, 2, 3, 1, 4)
    v = v.reshape(B, S, H, DIFF_VD).transpose(0, 2, 1, 3)
    q = rms_norm(q, qn_g) * (DIFF_QK ** -0.5)
    k = rms_norm(k, kn_g)
    lam = (jnp.exp(jnp.sum(lq1 * lk1).astype(jnp.float32))
           - jnp.exp(jnp.sum(lq2 * lk2).astype(jnp.float32)) + lam_init)
    k_pos = jnp.arange(S)

    def block(i):
        q_blk = lax.dynamic_slice_in_dim(q, i * Q_BLOCK, Q_BLOCK, axis=3)
        q_pos = i * Q_BLOCK + jnp.arange(Q_BLOCK)
        dist = q_pos[:, None] - k_pos[None, :]
        bias = rel_bias[t5_causal_bucket(dist)].transpose(2, 0, 1)
        s = jnp.einsum('bhcqd,bhckd->bhcqk', q_blk, k).astype(jnp.float32)
        s = s + bias[None, :, None].astype(jnp.float32)
        s = jnp.where(dist >= 0, s, -jnp.inf)
        pr = jax.nn.softmax(s, axis=-1)
        a_diff = pr[:, :, 0] - lam * pr[:, :, 1]
        return jnp.einsum('bhqk,bhkd->bhqd', a_diff.astype(v.dtype), v)

    o = lax.map(block, jnp.arange(S // Q_BLOCK))
    o = o.transpose(1, 2, 0, 3, 4).reshape(B, H, S, DIFF_VD)
    o = rms_norm(o, subln_g) * (1.0 - lam_init)
    return o.transpose(0, 2, 1, 3).reshape(B, S, H * DIFF_VD)


def clamped_swiglu(hid):
    x_glu, x_lin = jnp.split(hid, 2, axis=-1)
    x_glu = jnp.minimum(x_glu, SWIGLU_LIMIT)
    x_lin = jnp.clip(x_lin, -SWIGLU_LIMIT, SWIGLU_LIMIT)
    return x_glu * jax.nn.sigmoid(SWIGLU_ALPHA * x_glu) * (x_lin + 1.0)


def moe_ffn(h, router_w, router_b, w1, b1, w2, b2):
    T = h.shape[0]
    logits = (h @ router_w + router_b).astype(jnp.float32)
    top_vals, top_idx = lax.top_k(logits, TOP_K)
    gates = jax.nn.softmax(top_vals, axis=-1)
    flat_e = top_idx.reshape(-1)
    flat_tok = jnp.repeat(jnp.arange(T, dtype=jnp.int32), TOP_K)
    flat_g = gates.reshape(-1)
    order = jnp.argsort(flat_e, stable=True)
    e_sorted, tok_sorted, g_sorted = flat_e[order], flat_tok[order], flat_g[order]
    counts = jnp.bincount(flat_e, length=N_EXPERTS)
    starts = jnp.cumsum(counts) - counts
    padded = (counts + ROW_BLOCK - 1) // ROW_BLOCK * ROW_BLOCK
    pad_ends = jnp.cumsum(padded)
    pad_starts = pad_ends - padded
    dest = pad_starts[e_sorted] + (jnp.arange(T * TOP_K) - starts[e_sorted])
    n_rows = T * TOP_K + N_EXPERTS * ROW_BLOCK
    n_blocks = n_rows // ROW_BLOCK
    row_tok = jnp.zeros((n_rows,), jnp.int32).at[dest].set(tok_sorted)
    row_gate = jnp.zeros((n_rows,), h.dtype).at[dest].set(g_sorted.astype(h.dtype))
    blk_expert = jnp.minimum(
        jnp.searchsorted(pad_ends, jnp.arange(n_blocks) * ROW_BLOCK, side='right'), N_EXPERTS - 1)

    def run_block(args):
        tok, e = args
        xb = h[tok]
        hid = clamped_swiglu(xb @ w1[e] + b1[e])
        return hid @ w2[e] + b2[e]

    ys = lax.map(run_block, (row_tok.reshape(n_blocks, ROW_BLOCK), blk_expert))
    ys = ys.reshape(n_rows, -1) * row_gate[:, None]
    return jax.ops.segment_sum(ys, row_tok, num_segments=T)


def setup_inputs(seed: int = 0) -> dict:
    key = jax.random.key(seed)
    ks = jax.random.split(key, 32)
    L = DEPTH
    nrm = lambda i, shape, s: jax.random.normal(ks[i], shape, jnp.float32) * s
    gain = lambda i, shape: 1.0 + nrm(i, shape, 0.02)
    return {
        'x': nrm(0, (BATCH, SEQ, D_MODEL), 1.0),
        'norm1_g': gain(1, (L, D_MODEL)),
        'w_in': nrm(2, (L, D_MODEL, N_IN), D_MODEL ** -0.5),
        'mu_shift': jax.random.uniform(ks[3], (L, N_RWKV_COLS), jnp.float32),
        'w0': jax.random.uniform(ks[4], (L, RWKV_WIDTH), jnp.float32, -4.0, 0.0),
        'w2': nrm(5, (L, DECAY_LORA, RWKV_WIDTH), 0.1),
        'a0': nrm(6, (L, RWKV_WIDTH), 0.1),
        'a2': nrm(7, (L, AAA_LORA, RWKV_WIDTH), AAA_LORA ** -0.5),
        'g2': nrm(8, (L, GATE_LORA, RWKV_WIDTH), GATE_LORA ** -0.5),
        'k_k': 0.85 + nrm(9, (L, RWKV_WIDTH), 0.05),
        'k_a': 1.0 + nrm(10, (L, RWKV_WIDTH), 0.05),
        'r_k': nrm(11, (L, RWKV_HEADS, HEAD_DIM), 0.1),
        'lnx_g': gain(12, (L, RWKV_WIDTH)),
        'lnx_b': nrm(13, (L, RWKV_WIDTH), 0.01),
        'qn_g': gain(14, (L, DIFF_QK)),
        'kn_g': gain(15, (L, DIFF_QK)),
        'lam_q1': nrm(16, (L, DIFF_QK), 0.1),
        'lam_k1': nrm(17, (L, DIFF_QK), 0.1),
        'lam_q2': nrm(18, (L, DIFF_QK), 0.1),
        'lam_k2': nrm(19, (L, DIFF_QK), 0.1),
        'subln_g': gain(20, (L, DIFF_VD)),
        'rel_bias': nrm(21, (NUM_BUCKETS, DIFF_HEADS), 0.1),
        'w_out': nrm(22, (L, MIX_WIDTH, D_MODEL), MIX_WIDTH ** -0.5),
        'norm2_g': gain(23, (L, D_MODEL)),
        'router_w': nrm(24, (L, D_MODEL, N_EXPERTS), D_MODEL ** -0.5),
        'router_b': nrm(25, (L, N_EXPERTS), 0.01),
        'exp_w1': nrm(26, (L, N_EXPERTS, D_MODEL, 2 * D_EXPERT), D_MODEL ** -0.5),
        'exp_b1': nrm(27, (L, N_EXPERTS, 2 * D_EXPERT), 0.01),
        'exp_w2': nrm(28, (L, N_EXPERTS, D_EXPERT, D_MODEL), D_EXPERT ** -0.5),
        'exp_b2': nrm(29, (L, N_EXPERTS, D_MODEL), 0.01),
    }


def reference(x, norm1_g, w_in, mu_shift, w0, w2, a0, a2, g2, k_k, k_a, r_k, lnx_g, lnx_b,
              qn_g, kn_g, lam_q1, lam_k1, lam_q2, lam_k2, subln_g, rel_bias, w_out,
              norm2_g, router_w, router_b, exp_w1, exp_b1, exp_w2, exp_b2):
    B, S, D = x.shape
    for layer in range(DEPTH):
        h = rms_norm(x, norm1_g[layer])
        p = h @ w_in[layer]
        p_rwkv, p_diff = p[..., :N_RWKV_COLS], p[..., N_RWKV_COLS:]
        y_a = rwkv7_time_mix(p_rwkv, mu_shift[layer], w0[layer], w2[layer], a0[layer],
                             a2[layer], g2[layer], k_k[layer], k_a[layer], r_k[layer],
                             lnx_g[layer], lnx_b[layer]).astype(x.dtype)
        lam_init = 0.8 - 0.6 * math.exp(-0.3 * layer)
        y_b = diff_attention(p_diff, qn_g[layer], kn_g[layer], lam_q1[layer], lam_k1[layer],
                             lam_q2[layer], lam_k2[layer], subln_g[layer], rel_bias,
                             lam_init).astype(x.dtype)
        x = x + jnp.concatenate([y_a, y_b], axis=-1) @ w_out[layer]
        h2 = rms_norm(x, norm2_g[layer]).reshape(B * S, D)
        x = x + moe_ffn(h2, router_w[layer], router_b[layer], exp_w1[layer], exp_b1[layer],
                        exp_w2[layer], exp_b2[layer]).reshape(B, S, D).astype(x.dtype)
    return x
```

```cpp
#include <hip/hip_runtime.h>
#include <hip/hip_cooperative_groups.h>
#include <cstdio>
#include <cstdint>
#include <type_traits>
namespace cg = cooperative_groups;

#ifndef REP_PHASE
#define REP_PHASE -1
#endif
#ifndef MK_N_LAUNCHES
#define MK_N_LAUNCHES 1
#endif

#define LAS __attribute__((address_space(3)))
#define GAS __attribute__((address_space(1)))
typedef unsigned short bf16_t;
typedef short bf16x8 __attribute__((ext_vector_type(8)));
typedef short s16x4 __attribute__((ext_vector_type(4)));
typedef float f32x2 __attribute__((ext_vector_type(2)));
typedef float f32x4 __attribute__((ext_vector_type(4)));
typedef float f32x16 __attribute__((ext_vector_type(16)));
typedef unsigned u32x2 __attribute__((ext_vector_type(2)));
typedef unsigned u32x4 __attribute__((ext_vector_type(4)));
typedef int v8i32 __attribute__((ext_vector_type(8)));

constexpr int NB = 8, SEQ = 4096, T = NB * SEQ, D = 1024;
constexpr int CW = 512;
constexpr int NRW = 1696, NIN = 3232, NINP = 3328;
constexpr int DQ0 = 1696, DK0 = 2208, DV0 = 2720;
constexpr int NE = 32, TOPK = 4, DE = 1024;
constexpr int MAXROWS = T * TOPK + NE * 256;
constexpr int MAXTILES = MAXROWS / 256;
constexpr float LOG2E = 1.4426950408889634f;
constexpr float F8_W_MUL = 32.f, F8_X_MUL = 8.f, F8_H_MUL = 4.f; constexpr int F8_W_SC = 0x7A7A7A7A, F8_X_SC = 0x7C7C7C7C, F8_H_SC = 0x7D7D7D7D;

constexpr size_t MiB = 1u << 20;
constexpr size_t WS_CTL = 0, CTL_ZERO_BYTES = 64 * 1024;
constexpr size_t WS_TILEE = 512 * 1024;
constexpr size_t WS_WINT = 1 * MiB;
constexpr size_t WS_WOUT = 8 * MiB;
constexpr size_t WS_W1T = 10 * MiB;
constexpr size_t WS_W2T = 138 * MiB;
constexpr size_t WS_EIDX = 202 * MiB;
constexpr size_t WS_GATE = WS_EIDX + 512 * 1024;
constexpr size_t WS_POS = WS_GATE + 512 * 1024;
constexpr size_t WS_DEST = WS_POS + 512 * 1024;
constexpr size_t WS_ROWGATE = 204 * MiB;
constexpr size_t WS_XN = 206 * MiB;
constexpr size_t WS_P = 270 * MiB;
constexpr size_t WS_SR = 478 * MiB, WS_SK = 510 * MiB, WS_SV = 542 * MiB, WS_SA = 574 * MiB, WS_SB = 606 * MiB;
constexpr size_t WS_SW = 638 * MiB;
constexpr size_t WS_SG = 702 * MiB;
constexpr size_t WS_QN = 734 * MiB, WS_KN = 766 * MiB;
constexpr size_t WS_YMIX = 798 * MiB;
constexpr size_t WS_H2 = 206 * MiB;
constexpr size_t WS_XS = 270 * MiB;
constexpr size_t WS_HID = 406 * MiB;
constexpr size_t WS_YS = 542 * MiB;
constexpr size_t WS_YRAW = 862 * MiB;
constexpr size_t WS_END = 926 * MiB;
constexpr int CW_CNT = 64;
constexpr int CW_ATTQ = 128;
constexpr int CW_BAR = 4096;

constexpr int RING_BYTES = 131072, MISC_OFF = RING_BYTES, LDS_BYTES = 147456;

__device__ __forceinline__ unsigned f2bf(float f) { unsigned u = __builtin_bit_cast(unsigned, f); return (u + 0x7fffu + ((u >> 16) & 1u)) >> 16; }
typedef __bf16 hwbf16x2 __attribute__((ext_vector_type(2)));
__device__ __forceinline__ unsigned pk2(float lo, float hi) { const f32x2 v = {lo, hi}; return __builtin_bit_cast(unsigned, __builtin_convertvector(v, hwbf16x2)); }
__device__ __forceinline__ unsigned pk4_fp8(float a, float b, float c, float d) {
    a = fminf(fmaxf(a, -448.f), 448.f); b = fminf(fmaxf(b, -448.f), 448.f); c = fminf(fmaxf(c, -448.f), 448.f); d = fminf(fmaxf(d, -448.f), 448.f);
    int r = __builtin_amdgcn_cvt_pk_fp8_f32(a, b, 0, false); r = __builtin_amdgcn_cvt_pk_fp8_f32(c, d, r, true); return (unsigned)r; }
__device__ __forceinline__ float bf2f(unsigned short b) { return __builtin_bit_cast(float, (unsigned)b << 16); }
__device__ __forceinline__ float bflo(unsigned w) { return __builtin_bit_cast(float, w << 16); }
__device__ __forceinline__ float bfhi(unsigned w) { return __builtin_bit_cast(float, w & 0xffff0000u); }
__device__ __forceinline__ float wave_sum(float v) {
#pragma unroll
    for (int o = 1; o < 64; o <<= 1) v += __shfl_xor(v, o);
    return v;
}
__device__ __forceinline__ float sigmoidf_(float x) { return 1.0f / (1.0f + __expf(-x)); }
template <int CTRL> __device__ __forceinline__ float dpp_f(float v) { return __builtin_bit_cast(float, __builtin_amdgcn_update_dpp(0, __builtin_bit_cast(int, v), CTRL, 0xF, 0xF, true)); }
__device__ __forceinline__ float red8(float v) {
    v += dpp_f<0xB1>(v);
    v += dpp_f<0x4E>(v);
    v += dpp_f<0x141>(v);
    return v;
}
__device__ __forceinline__ float red4(float v) { v += dpp_f<0xB1>(v); v += dpp_f<0x4E>(v); return v; }


#define XB_TMO      128
#define XB_XCNT(j)  (256  + 64 * (j))
#define XB_XSUB(j)  (1280 + 64 * (j))
#define XB_XGEN(j)  (2304 + 64 * (j))
#define XB_TOP      3328
#define XB_TOPGEN   3392
#define XCD_BAR_WORDS 3456
#define XB_SPIN_CAP (1u << 18)
__device__ __forceinline__ unsigned xb_ld(unsigned* p)              { return __hip_atomic_load(p, __ATOMIC_RELAXED, __HIP_MEMORY_SCOPE_AGENT); }
__device__ __forceinline__ unsigned xb_add(unsigned* p, unsigned v) { return __hip_atomic_fetch_add(p, v, __ATOMIC_RELAXED, __HIP_MEMORY_SCOPE_AGENT); }
__device__ __forceinline__ unsigned xb_xcc_id() { return (unsigned)__builtin_amdgcn_s_getreg((3 << 11) | 20) & 0xFu; }
#define XB_SPIN(cond, bar) do { unsigned _sp = 0; while (cond) { __builtin_amdgcn_s_sleep(1); \
    if ((++_sp & 255u) == 0u) { if (xb_ld(&(bar)[XB_TMO])) break; if (_sp > XB_SPIN_CAP) { atomicAdd(&(bar)[XB_TMO], 1u); break; } } } } while (0)
struct XcdBarrier { unsigned* bar; unsigned x; volatile LAS unsigned* st; };
__device__ __forceinline__ XcdBarrier xcd_barrier_post(unsigned* bar, volatile LAS unsigned* st) {
    XcdBarrier b; b.bar = bar; b.x = xb_xcc_id(); b.st = st;
    if (threadIdx.x == 0) (void)xb_add(&bar[XB_XCNT(b.x)], 1u);
    return b;
}
__device__ __forceinline__ void xcd_barrier_complete(unsigned* bar, unsigned x, unsigned& nloc, unsigned& nx) {
    const unsigned G = gridDim.x * gridDim.y * gridDim.z;
    unsigned sum, cnt, mine, sp = 0u;
    for (;;) {
        sum = 0u; cnt = 0u; mine = 0u;
#pragma unroll
        for (unsigned j = 0; j < 16; ++j) { const unsigned c = xb_ld(&bar[XB_XCNT(j)]); sum += c; cnt += (c > 0u) ? 1u : 0u; mine = (j == x) ? c : mine; }
        if (sum == G) break;
        __builtin_amdgcn_s_sleep(1);
        if ((++sp & 255u) == 0u) { if (xb_ld(&bar[XB_TMO])) break; if (sp > XB_SPIN_CAP) { atomicAdd(&bar[XB_TMO], 1u); break; } }
    }
    nloc = mine > 0u ? mine : 1u; nx = cnt > 0u ? cnt : 1u;
}
__device__ __forceinline__ void xcd_barrier(const XcdBarrier& b) {
    asm volatile("s_waitcnt vmcnt(0)" ::: "memory");
    __syncthreads();
    if (threadIdx.x == 0) {
        unsigned* bar = b.bar;
        __builtin_amdgcn_s_waitcnt(0);
        unsigned nloc = b.st[0], nx = b.st[1];
        if (nloc == 0u) { xcd_barrier_complete(bar, b.x, nloc, nx); b.st[0] = nloc; b.st[1] = nx; }
        const unsigned old = xb_add(&bar[XB_XSUB(b.x)], 1u);
        const unsigned gen = old / nloc;
        if (old + 1u == (gen + 1u) * nloc) {
            __builtin_amdgcn_fence(__ATOMIC_RELEASE, "agent");
            asm volatile("s_waitcnt vmcnt(0)" ::: "memory");
            const unsigned og = xb_add(&bar[XB_TOP], 1u);
            const unsigned tg = og / nx;
            if (og + 1u == (tg + 1u) * nx) xb_add(&bar[XB_TOPGEN], 1u);
            else XB_SPIN(xb_ld(&bar[XB_TOPGEN]) == tg, bar);
            __builtin_amdgcn_fence(__ATOMIC_ACQUIRE, "agent");
            xb_add(&bar[XB_XGEN(b.x)], 1u);
            asm volatile("s_waitcnt vmcnt(0)" ::: "memory");
        } else {
            XB_SPIN(xb_ld(&bar[XB_XGEN(b.x)]) == gen, bar);
            __builtin_amdgcn_fence(__ATOMIC_ACQUIRE, "agent");
            asm volatile("s_waitcnt vmcnt(0)" ::: "memory");
        }
    }
    __syncthreads();
}

namespace pg8 {
constexpr int BM = 256, BK = 64, HALF = 128, HTB = HALF * BK * 2, STAGE_BYTES = 8 * HTB, NXCD = 8, WGM = 8;
__host__ __device__ __forceinline__ int lds_byte(int r, int c) { const int st = (r >> 4) * 2 + (c >> 5), rr = r & 15, cc = c & 31, ob = rr * 64 + cc * 2; return st * 1024 + (ob ^ (((ob >> 9) & 1) << 5)); }
__host__ __device__ __forceinline__ void stage_rc(int b, int& R, int& C) { const int st = b / 1024, sb = b % 1024, swz = sb ^ (((sb >> 9) & 1) << 5); R = (st >> 1) * 16 + swz / 64; C = (st & 1) * 32 + (swz % 64) / 2; }
__host__ __device__ __forceinline__ int perm32(int rho) { const int n = rho >> 4, i = rho & 15; return 8 * (i >> 2) + 4 * n + (i & 3); }

struct Unit { int pm, pn, pb; };
struct Gemm { const void* A; const void* Bt; int K; int scW, scA; };

struct TileOrder {
    int nM, nN, nwg, G, c; const int* tile_e; int nb_per_e;
    __device__ void init(int nM_, int nN_, int G_, int c_, const int* te, int nbe) { nM = nM_; nN = nN_; nwg = nM * nN; G = G_; c = c_; tile_e = te; nb_per_e = nbe; }
    __device__ bool next(int i, Unit& u) const {
        const long L = (long)i * G + c; if (L >= nwg) return false;
        int wgid = (int)L; { const int q = nwg / NXCD, r = nwg % NXCD, xcd = wgid % NXCD, off = wgid / NXCD; wgid = (xcd < r ? xcd * (q + 1) : r * (q + 1) + (xcd - r) * q) + off; }
        const int nig = WGM * nN, gid = wgid / nig, fm = gid * WGM, gsz = (nM - fm) < WGM ? (nM - fm) : WGM;
        u.pm = fm + ((wgid % nig) % gsz); u.pn = (wgid % nig) / gsz;
        u.pb = tile_e ? tile_e[u.pm] * nb_per_e + u.pn : u.pn;
        return true;
    }
};

struct EpiBf16 {
    static constexpr bool PERM = true;
    bf16_t* O; int ldc;
    __device__ __forceinline__ void operator()(const f32x4 (&acc)[2][2][4][2], const Unit& u, int wr, int wc, int fr, int fq) const {
        const int row0 = u.pm * BM + wr * 64 + fr; const int col0 = u.pn * BM + wc * 32 + 8 * fq;
#pragma unroll
        for (int ai = 0; ai < 2; ++ai)
#pragma unroll
            for (int m = 0; m < 4; ++m) { bf16_t* rowp = O + (size_t)(row0 + ai * HALF + m * 16) * ldc + col0;
#pragma unroll
                for (int bj = 0; bj < 2; ++bj) { const f32x4 v0 = acc[ai][bj][m][0], v1 = acc[ai][bj][m][1];
                    u32x4 w; w.x = pk2(v0[0], v0[1]); w.y = pk2(v0[2], v0[3]); w.z = pk2(v1[0], v1[1]); w.w = pk2(v1[2], v1[3]);
                    *(u32x4*)(rowp + bj * HALF) = w; } }
    }
};
struct EpiResF32 {
    static constexpr bool PERM = false;
    const float* base; float* out; int ldc;
    __device__ __forceinline__ void operator()(const f32x4 (&acc)[2][2][4][2], const Unit& u, int wr, int wc, int fr, int fq) const {
        const int col0 = u.pn * BM + wc * 32 + 4 * fq;
#pragma unroll
        for (int ai = 0; ai < 2; ++ai)
#pragma unroll
            for (int m = 0; m < 4; ++m) { const size_t off = (size_t)(u.pm * BM + ai * HALF + wr * 64 + m * 16 + fr) * ldc + col0;
#pragma unroll
                for (int bj = 0; bj < 2; ++bj)
#pragma unroll
                    for (int n = 0; n < 2; ++n) { const f32x4 bs = *(const f32x4*)(base + off + bj * HALF + n * 16); *(f32x4*)(out + off + bj * HALF + n * 16) = bs + acc[ai][bj][m][n]; } }
    }
};
struct EpiSwiglu {
    static constexpr bool PERM = true;
    unsigned char* O; const float* b1; const int* tile_e;
    __device__ __forceinline__ void operator()(const f32x4 (&acc)[2][2][4][2], const Unit& u, int wr, int wc, int fr, int fq) const {
        const int e = tile_e[u.pm]; const int row0 = u.pm * BM + wr * 64 + fr; const int hc0 = u.pn * 128 + wc * 32 + 8 * fq;
        const float* bg = b1 + (size_t)e * 2048 + hc0; const float* bl = bg + 1024;
        const f32x4 g0 = *(const f32x4*)bg, g1 = *(const f32x4*)(bg + 4), l0 = *(const f32x4*)bl, l1 = *(const f32x4*)(bl + 4);
#pragma unroll
        for (int ai = 0; ai < 2; ++ai)
#pragma unroll
            for (int m = 0; m < 4; ++m) { unsigned char* rowp = O + (size_t)(row0 + ai * HALF + m * 16) * 1024 + hc0;
                float o[8];
#pragma unroll
                for (int n = 0; n < 2; ++n) { const f32x4 gv = acc[ai][0][m][n] + (n ? g1 : g0), lv = acc[ai][1][m][n] + (n ? l1 : l0);
#pragma unroll
                    for (int i = 0; i < 4; ++i) { const float g = fminf(gv[i], 7.0f), l = fminf(fmaxf(lv[i], -7.0f), 7.0f);
                        const float sg = __builtin_amdgcn_rcpf(1.0f + __builtin_amdgcn_exp2f(-1.702f * LOG2E * g)); o[n * 4 + i] = g * sg * (l + 1.0f); } }
                u32x2 w; w.x = pk4_fp8(o[0] * F8_H_MUL, o[1] * F8_H_MUL, o[2] * F8_H_MUL, o[3] * F8_H_MUL); w.y = pk4_fp8(o[4] * F8_H_MUL, o[5] * F8_H_MUL, o[6] * F8_H_MUL, o[7] * F8_H_MUL);
                *(u32x2*)rowp = w; }
    }
};
struct EpiGateBf16 {
    static constexpr bool PERM = true;
    bf16_t* O; const float* b2; const float* rowgate; const int* tile_e;
    __device__ __forceinline__ void operator()(const f32x4 (&acc)[2][2][4][2], const Unit& u, int wr, int wc, int fr, int fq) const {
        const int e = tile_e[u.pm]; const int row0 = u.pm * BM + wr * 64 + fr; const int col0 = u.pn * BM + wc * 32 + 8 * fq;
        f32x4 bv[2][2];
#pragma unroll
        for (int bj = 0; bj < 2; ++bj)
#pragma unroll
            for (int n = 0; n < 2; ++n) bv[bj][n] = *(const f32x4*)(b2 + (size_t)e * 1024 + col0 + bj * HALF + 4 * n);
#pragma unroll
        for (int ai = 0; ai < 2; ++ai)
#pragma unroll
            for (int m = 0; m < 4; ++m) { const int row = row0 + ai * HALF + m * 16; const float gt = rowgate[row]; bf16_t* rowp = O + (size_t)row * 1024 + col0;
#pragma unroll
                for (int bj = 0; bj < 2; ++bj) { const f32x4 v0 = (acc[ai][bj][m][0] + bv[bj][0]) * gt, v1 = (acc[ai][bj][m][1] + bv[bj][1]) * gt;
                    u32x4 w; w.x = pk2(v0[0], v0[1]); w.y = pk2(v0[2], v0[3]); w.z = pk2(v1[0], v1[1]); w.w = pk2(v1[2], v1[3]);
                    *(u32x4*)(rowp + bj * HALF) = w; } }
    }
};

template <bool F8, class Epi, class Sched>
__device__ __forceinline__ void gemm_phase(LAS unsigned char* lds, const Gemm g, const Sched& S, const Epi& E) {
    const int tid = threadIdx.x, wid = __builtin_amdgcn_readfirstlane(tid >> 6), lane = tid & 63, wr = wid >> 2, wc = wid & 3, fr = lane & 15, fq = lane >> 4;
    const int RB = F8 ? g.K : g.K * 2, nt = RB / 128;
    unsigned voffA[2], voffB[2];
#pragma unroll
    for (int i = 0; i < 2; ++i) { int R, C; stage_rc(tid * 16 + i * 8192, R, C); const int Rb = Epi::PERM ? ((R & ~31) + perm32(R & 31)) : R;
        voffA[i] = (unsigned)(R * RB + C * 2); voffB[i] = (unsigned)(Rb * RB + C * 2); }
    const size_t kstep = (size_t)(BK * 2);
    const size_t hstep = (size_t)HALF * RB;
    const size_t tstep = 2 * hstep;
    const unsigned ldsw = (unsigned)wid * 1024u;
    const int aoff = F8 ? lds_byte(wr * 64 + fr, (fq & 1) * 16) + (fq >> 1) * 1024 : lds_byte(wr * 64 + fr, fq * 8);
    const int boff = F8 ? lds_byte(wc * 32 + fr, (fq & 1) * 16) + (fq >> 1) * 1024 : lds_byte(wc * 32 + fr, fq * 8);
    const int scW = g.scW, scA = g.scA;
#define PG8_SA(b, h) (((b) * 2 + (h)) * HTB)
#define PG8_SB(b, h) ((4 + (b) * 2 + (h)) * HTB)
#define PG8_STAGE(bufoff, gbase, voff) do { _Pragma("unroll") for (int _i = 0; _i < 2; ++_i) \
        __builtin_amdgcn_global_load_lds((const unsigned*)((const char*)(gbase) + (voff)[_i]), (LAS unsigned*)(lds + (bufoff) + ldsw + _i * 8192), 16, 0, 0); } while (0)
typedef int v8i32a __attribute__((ext_vector_type(8), aligned(16)));
#define PG8_LD32(p) (*(const LAS v8i32a*)(p))
#define PG8_LDA(dst, b, h) do { _Pragma("unroll") for (int m = 0; m < 4; ++m) { if constexpr (F8) { dst[m].f8 = __builtin_bit_cast(v8i32, PG8_LD32(lds + PG8_SA(b, h) + aoff + m * 2048)); } \
        else { _Pragma("unroll") for (int k = 0; k < 2; ++k) dst[m].hv[k] = *(const LAS bf16x8*)(lds + PG8_SA(b, h) + aoff + m * 2048 + k * 1024); } } } while (0)
#define PG8_LDB(dst, b, h) do { _Pragma("unroll") for (int n = 0; n < 2; ++n) { if constexpr (F8) { dst[n].f8 = __builtin_bit_cast(v8i32, PG8_LD32(lds + PG8_SB(b, h) + boff + n * 2048)); } \
        else { _Pragma("unroll") for (int k = 0; k < 2; ++k) dst[n].hv[k] = *(const LAS bf16x8*)(lds + PG8_SB(b, h) + boff + n * 2048 + k * 1024); } } } while (0)
#define PG8_MMA(ai, bj, At, Bt) do { __builtin_amdgcn_s_setprio(1); _Pragma("unroll") for (int m = 0; m < 4; ++m) _Pragma("unroll") for (int n = 0; n < 2; ++n) { \
        if constexpr (F8) { asm volatile("v_mfma_scale_f32_16x16x128_f8f6f4 %0, %1, %2, %0, %3, %4 op_sel_hi:[0,0,0]" : "+v"(acc[ai][bj][m][n]) : "v"(Bt[n].f8), "v"(At[m].f8), "v"(scW), "v"(scA)); } \
        else { _Pragma("unroll") for (int k = 0; k < 2; ++k) acc[ai][bj][m][n] = __builtin_amdgcn_mfma_f32_16x16x32_bf16(Bt[n].hv[k], At[m].hv[k], acc[ai][bj][m][n], 0, 0, 0); } } \
        __builtin_amdgcn_s_setprio(0); } while (0)
#define PG8_WAIT_V(n) asm volatile("s_waitcnt vmcnt(" #n ")" ::: "memory")
#define PG8_WAIT_L(n) asm volatile("s_waitcnt lgkmcnt(" #n ")" ::: "memory")
#define PG8_BAR __builtin_amdgcn_s_barrier()
#define PG8_SCHED __builtin_amdgcn_sched_barrier(0)
    Unit cur, nxt; int ui = 0;
    if (!S.next(0, cur)) return;
    f32x4 acc[2][2][4][2];
#pragma unroll
    for (int a = 0; a < 2; ++a)
#pragma unroll
        for (int b = 0; b < 2; ++b)
#pragma unroll
            for (int m = 0; m < 4; ++m)
#pragma unroll
                for (int n = 0; n < 2; ++n) acc[a][b][m][n] = (f32x4){0.f, 0.f, 0.f, 0.f};
    struct FragH { bf16x8 hv[2]; }; struct Frag8 { v8i32 f8; };
    typename std::conditional<F8, Frag8, FragH>::type At[4], B0[2], B1[2];
    const char* cA = (const char*)g.A + (size_t)cur.pm * tstep; const char* cB = (const char*)g.Bt + (size_t)cur.pb * tstep;
    PG8_STAGE(PG8_SB(0, 0), cB, voffB); PG8_STAGE(PG8_SB(0, 1), cB + hstep, voffB); PG8_STAGE(PG8_SA(0, 0), cA, voffA); PG8_STAGE(PG8_SA(0, 1), cA + hstep, voffA);
    if (wr == 1) PG8_BAR;
    PG8_WAIT_V(2); PG8_BAR;
    PG8_STAGE(PG8_SB(1, 0), cB + kstep, voffB); PG8_STAGE(PG8_SA(1, 0), cA + kstep, voffA); PG8_STAGE(PG8_SB(1, 1), cB + hstep + kstep, voffB);
    PG8_WAIT_V(6); PG8_BAR;
    for (;;) {
        const bool has_next = S.next(ui + 1, nxt);
        const char* nA = has_next ? (const char*)g.A + (size_t)nxt.pm * tstep : cA; const char* nB = has_next ? (const char*)g.Bt + (size_t)nxt.pb * tstep : cB;
#pragma clang loop unroll(disable)
        for (int t = 0; t < nt; t += 2) {
            const bool last = (t == nt - 2);
            const char* a1 = cA + (size_t)(t + 1) * kstep;
            const char* a2 = last ? nA : cA + (size_t)(t + 2) * kstep; const char* b2 = last ? nB : cB + (size_t)(t + 2) * kstep;
            const char* a3 = a2 + kstep; const char* b3 = b2 + kstep;
            PG8_LDB(B0, 0, 0); PG8_LDB(B1, 0, 1); PG8_SCHED; PG8_LDA(At, 0, 0); PG8_STAGE(PG8_SA(1, 1), a1 + hstep, voffA);
            PG8_WAIT_V(8); PG8_WAIT_L(0); PG8_BAR; PG8_MMA(0, 0, At, B0); PG8_MMA(0, 1, At, B1); PG8_BAR; PG8_SCHED;
            PG8_LDA(At, 0, 1); PG8_STAGE(PG8_SB(0, 0), b2, voffB); PG8_STAGE(PG8_SB(0, 1), b2 + hstep, voffB); PG8_STAGE(PG8_SA(0, 0), a2, voffA);
            PG8_WAIT_V(8); PG8_WAIT_L(0); PG8_BAR; PG8_MMA(1, 0, At, B0); PG8_MMA(1, 1, At, B1); PG8_BAR; PG8_SCHED;
            PG8_LDB(B0, 1, 0); PG8_LDB(B1, 1, 1); PG8_SCHED; PG8_LDA(At, 1, 0); PG8_STAGE(PG8_SA(0, 1), a2 + hstep, voffA);
            PG8_WAIT_V(8); PG8_WAIT_L(0); PG8_BAR; PG8_MMA(0, 0, At, B0); PG8_MMA(0, 1, At, B1); PG8_BAR; PG8_SCHED;
            PG8_LDA(At, 1, 1); PG8_STAGE(PG8_SB(1, 0), b3, voffB); PG8_STAGE(PG8_SB(1, 1), b3 + hstep, voffB); PG8_STAGE(PG8_SA(1, 0), a3, voffA);
            PG8_WAIT_V(8); PG8_WAIT_L(0); PG8_BAR; PG8_MMA(1, 0, At, B0); PG8_MMA(1, 1, At, B1); PG8_BAR; PG8_SCHED;
        }
        if (wr == 0) PG8_BAR;
        if constexpr (F8) asm volatile("s_nop 15\n\ts_nop 15" ::: "memory");
        E(acc, cur, wr, wc, fr, fq);
        if (!has_next) break;
#pragma unroll
        for (int a = 0; a < 2; ++a)
#pragma unroll
            for (int b = 0; b < 2; ++b)
#pragma unroll
                for (int m = 0; m < 4; ++m)
#pragma unroll
                    for (int n = 0; n < 2; ++n) acc[a][b][m][n] = (f32x4){0.f, 0.f, 0.f, 0.f};
        cur = nxt; cA = nA; cB = nB; ++ui;
        if (wr == 1) PG8_BAR;
    }
    PG8_WAIT_V(0);
    PG8_BAR;
#undef PG8_SA
#undef PG8_SB
#undef PG8_STAGE
#undef PG8_LDA
#undef PG8_LDB
#undef PG8_MMA
#undef PG8_LD32
#undef PG8_WAIT_V
#undef PG8_WAIT_L
#undef PG8_BAR
#undef PG8_SCHED
}
}

struct Args { const float* in[30]; float* out; unsigned char* ws; int ph_lo, ph_hi; };

__device__ __forceinline__ void p0_transpose_item(const float* W, int K, int N, bf16_t* WT, int k0, int n0, int drow0, LAS float* scr, int lane) {
#pragma unroll 8
    for (int i = 0; i < 32; ++i) { const int kk = 2 * i + (lane >> 5); scr[kk * 33 + (lane & 31)] = W[(size_t)(k0 + kk) * N + n0 + (lane & 31)]; }
    asm volatile("s_waitcnt lgkmcnt(0)" ::: "memory");
    const int c = lane & 7;
#pragma unroll
    for (int j = 0; j < 4; ++j) { const int n = (lane >> 3) + 8 * j; const LAS float* s = scr + (8 * c) * 33 + n;
        u32x4 o; o.x = pk2(s[0 * 33], s[1 * 33]); o.y = pk2(s[2 * 33], s[3 * 33]); o.z = pk2(s[4 * 33], s[5 * 33]); o.w = pk2(s[6 * 33], s[7 * 33]);
        *(u32x4*)(WT + (size_t)(drow0 + n) * K + k0 + 8 * c) = o; }
    asm volatile("s_waitcnt lgkmcnt(0)" ::: "memory");
}
__device__ __forceinline__ void p0_transpose_item_f8(const float* W, int K, int N, unsigned char* WT, int k0, int n0, int drow0, LAS float* scr, int lane) {
#pragma unroll 8
    for (int i = 0; i < 32; ++i) { const int kk = 2 * i + (lane >> 5); scr[kk * 33 + (lane & 31)] = W[(size_t)(k0 + kk) * N + n0 + (lane & 31)]; }
    asm volatile("s_waitcnt lgkmcnt(0)" ::: "memory");
    const int c = lane & 3;
#pragma unroll
    for (int j = 0; j < 2; ++j) { const int n = (lane >> 2) + 16 * j; const LAS float* s = scr + (16 * c) * 33 + n;
        u32x4 o;
        o.x = pk4_fp8(s[0 * 33] * F8_W_MUL, s[1 * 33] * F8_W_MUL, s[2 * 33] * F8_W_MUL, s[3 * 33] * F8_W_MUL);
        o.y = pk4_fp8(s[4 * 33] * F8_W_MUL, s[5 * 33] * F8_W_MUL, s[6 * 33] * F8_W_MUL, s[7 * 33] * F8_W_MUL);
        o.z = pk4_fp8(s[8 * 33] * F8_W_MUL, s[9 * 33] * F8_W_MUL, s[10 * 33] * F8_W_MUL, s[11 * 33] * F8_W_MUL);
        o.w = pk4_fp8(s[12 * 33] * F8_W_MUL, s[13 * 33] * F8_W_MUL, s[14 * 33] * F8_W_MUL, s[15 * 33] * F8_W_MUL);
        *(u32x4*)(WT + (size_t)(drow0 + n) * K + k0 + 16 * c) = o; }
    asm volatile("s_waitcnt lgkmcnt(0)" ::: "memory");
}
__device__ __forceinline__ void p0_prologue(LAS unsigned char* lds, const Args& a, int G) {
    const int tid = threadIdx.x, lane = tid & 63, wave = __builtin_amdgcn_readfirstlane(tid >> 6);
    LAS float* scr = (LAS float*)(lds + wave * 16384);
    const int gw = blockIdx.x * 8 + wave, NGW = G * 8;
    unsigned char* ws = a.ws;
    bf16_t* Wint = (bf16_t*)(ws + WS_WINT); bf16_t* Woutt = (bf16_t*)(ws + WS_WOUT); unsigned char* W1t = ws + WS_W1T; unsigned char* W2t = ws + WS_W2T;
    constexpr int I_IN = 16 * (NIN / 32);
    constexpr int I_OUT = 16 * 32;
    constexpr int I_W1 = 16 * 64;
    constexpr int I_W2 = 16 * 32;
    constexpr int NITEMS = I_IN + I_OUT + NE * I_W1 + NE * I_W2;
    for (int it = gw; it < NITEMS; it += NGW) {
        int r = it;
        if (r < I_IN) { const int nblk = NIN / 32, kb = r / nblk, nb = r % nblk; p0_transpose_item(a.in[2], 1024, NIN, Wint, 64 * kb, 32 * nb, 32 * nb, scr, lane); continue; } r -= I_IN;
        if (r < I_OUT) { const int kb = r / 32, nb = r % 32; p0_transpose_item(a.in[22], 1024, 1024, Woutt, 64 * kb, 32 * nb, 32 * nb, scr, lane); continue; } r -= I_OUT;
        if (r < NE * I_W1) { const int e = r / I_W1, q = r % I_W1, kb = q / 64, nb = q % 64; const int n0 = 32 * nb;
            const int drow = (n0 < 1024) ? ((n0 >> 7) * 256 + (n0 & 127)) : (((n0 - 1024) >> 7) * 256 + 128 + ((n0 - 1024) & 127));
            p0_transpose_item_f8(a.in[26] + (size_t)e * 1024 * 2048, 1024, 2048, W1t + (size_t)e * 2048 * 1024, 64 * kb, n0, drow, scr, lane); continue; } r -= NE * I_W1;
        { const int e = r / I_W2, q = r % I_W2, kb = q / 32, nb = q % 32;
            p0_transpose_item_f8(a.in[28] + (size_t)e * 1024 * 1024, 1024, 1024, W2t + (size_t)e * 1024 * 1024, 64 * kb, 32 * nb, 32 * nb, scr, lane); }
    }
    const float* x = a.in[0]; const float* g1 = a.in[1]; bf16_t* XN = (bf16_t*)(ws + WS_XN);
    f32x4 gv[4];
#pragma unroll
    for (int j = 0; j < 4; ++j) gv[j] = *((const f32x4*)g1 + lane + 64 * j);
    for (int m = gw; m < T; m += NGW) {
        const f32x4* xr = (const f32x4*)(x + (size_t)m * D) + lane;
        f32x4 v[4]; float s = 0.f;
#pragma unroll
        for (int j = 0; j < 4; ++j) { v[j] = xr[64 * j]; s += (v[j].x * v[j].x + v[j].y * v[j].y) + (v[j].z * v[j].z + v[j].w * v[j].w); }
        const float rstd = 1.0f / sqrtf(wave_sum(s) * (1.0f / D) + 1e-5f);
        u32x2* o8 = (u32x2*)(XN + (size_t)m * D) + lane;
#pragma unroll
        for (int j = 0; j < 4; ++j) { u32x2 w; w.x = pk2(v[j].x * rstd * gv[j].x, v[j].y * rstd * gv[j].y); w.y = pk2(v[j].z * rstd * gv[j].z, v[j].w * rstd * gv[j].w); o8[64 * j] = w; }
    }
}

__device__ __forceinline__ f32x4 cvlo(const u32x4 u) { return (f32x4){bflo(u.x), bfhi(u.x), bflo(u.y), bfhi(u.y)}; }
__device__ __forceinline__ f32x4 cvhi(const u32x4 u) { return (f32x4){bflo(u.z), bfhi(u.z), bflo(u.w), bfhi(u.w)}; }
__device__ __forceinline__ u32x4 pk8(const f32x4 lo, const f32x4 hi) { u32x4 w; w.x = pk2(lo.x, lo.y); w.y = pk2(lo.z, lo.w); w.z = pk2(hi.x, hi.y); w.w = pk2(hi.z, hi.w); return w; }
__device__ __forceinline__ void p2_prep(LAS unsigned char* lds, const Args& a) {
    const int tid = threadIdx.x, lane = tid & 63, wave = __builtin_amdgcn_readfirstlane(tid >> 6);
    unsigned char* ws = a.ws;
    const bf16_t* P = (const bf16_t*)(ws + WS_P);
    bf16_t* SR = (bf16_t*)(ws + WS_SR); bf16_t* SK = (bf16_t*)(ws + WS_SK); bf16_t* SV = (bf16_t*)(ws + WS_SV); bf16_t* SA = (bf16_t*)(ws + WS_SA); bf16_t* SB = (bf16_t*)(ws + WS_SB);
    float* SW = (float*)(ws + WS_SW); bf16_t* SG = (bf16_t*)(ws + WS_SG); bf16_t* QN = (bf16_t*)(ws + WS_QN); bf16_t* KN = (bf16_t*)(ws + WS_KN);
    const float* mu = a.in[3]; const float* w0 = a.in[4]; const float* w2 = a.in[5]; const float* a0 = a.in[6]; const float* a2 = a.in[7]; const float* g2 = a.in[8];
    const float* k_k = a.in[9]; const float* k_a = a.in[10]; const float* qn_g = a.in[14]; const float* kn_g = a.in[15];
    LAS unsigned char* ACT = lds;
    LAS float* DEC = (LAS float*)(lds + 8192); LAS float* ALR = (LAS float*)(lds + 40960); LAS float* GG = (LAS float*)(lds + 73728);
    bf16x8 bw[4][5];
    const int fcol = lane & 15, fk = (lane >> 4) * 8;
#pragma unroll
    for (int cb = 0; cb < 4; ++cb) {
        const int col = wave * 64 + cb * 16 + fcol;
#pragma unroll
        for (int kb = 0; kb < 5; ++kb) {
            const float* src = (kb == 0) ? (w2 + (size_t)fk * CW + col) : (kb == 1) ? (a2 + (size_t)fk * CW + col) : (g2 + (size_t)((kb - 2) * 32 + fk) * CW + col);
            u32x4 w; w.x = pk2(src[0], src[CW]); w.y = pk2(src[2 * CW], src[3 * CW]); w.z = pk2(src[4 * CW], src[5 * CW]); w.w = pk2(src[6 * CW], src[7 * CW]);
            bw[cb][kb] = __builtin_bit_cast(bf16x8, w);
        }
    }
    float w0c[4], a0c[4];
#pragma unroll
    for (int cb = 0; cb < 4; ++cb) { w0c[cb] = w0[wave * 64 + cb * 16 + fcol]; a0c[cb] = a0[wave * 64 + cb * 16 + fcol]; }
    const int c8 = lane * 8;
    const int TPB = T / (int)gridDim.x;
    const int tb0 = blockIdx.x * TPB;
    for (int t0 = tb0; t0 < tb0 + TPB; t0 += 16) {
        if (tid < 320) {
            const int tok = tid / 20, ch = tid - tok * 20, t = t0 + tok, col = 1536 + ch * 8;
            const u32x4 cu = *(const u32x4*)(P + (size_t)t * NINP + col);
            u32x4 pu = (u32x4){0u, 0u, 0u, 0u};
            if (t & (SEQ - 1)) pu = *(const u32x4*)(P + (size_t)(t - 1) * NINP + col);
            const f32x4 m0 = *(const f32x4*)(mu + col), m1 = *(const f32x4*)(mu + col + 4);
            const f32x4 c0 = cvlo(cu), c1 = cvhi(cu), p0 = cvlo(pu), p1 = cvhi(pu);
            f32x4 s0 = c0 + (p0 - c0) * m0, s1 = c1 + (p1 - c1) * m1;
            if (ch < 4) {
#pragma unroll
                for (int i = 0; i < 4; ++i) { const float e0 = __expf(-2.0f * fabsf(s0[i])), e1 = __expf(-2.0f * fabsf(s1[i])); const float th0 = (1.0f - e0) / (1.0f + e0), th1 = (1.0f - e1) / (1.0f + e1);
                    s0[i] = s0[i] < 0.f ? -th0 : th0; s1[i] = s1[i] < 0.f ? -th1 : th1; }
            } else if (ch >= 8) {
#pragma unroll
                for (int i = 0; i < 4; ++i) { s0[i] = sigmoidf_(s0[i]); s1[i] = sigmoidf_(s1[i]); }
            }
            *(LAS u32x4*)(ACT + tok * 320 + ch * 16) = pk8(s0, s1);
        }
        __syncthreads();
        {
            bf16x8 af[5];
#pragma unroll
            for (int kb = 0; kb < 5; ++kb) af[kb] = *(const LAS bf16x8*)(ACT + fcol * 320 + kb * 64 + (lane >> 4) * 16);
#pragma unroll
            for (int cb = 0; cb < 4; ++cb) {
                const f32x4 z = {0.f, 0.f, 0.f, 0.f};
                const f32x4 aw = __builtin_amdgcn_mfma_f32_16x16x32_bf16(af[0], bw[cb][0], z, 0, 0, 0);
                const f32x4 aa = __builtin_amdgcn_mfma_f32_16x16x32_bf16(af[1], bw[cb][1], z, 0, 0, 0);
                f32x4 ag = __builtin_amdgcn_mfma_f32_16x16x32_bf16(af[2], bw[cb][2], z, 0, 0, 0);
                ag = __builtin_amdgcn_mfma_f32_16x16x32_bf16(af[3], bw[cb][3], ag, 0, 0, 0);
                ag = __builtin_amdgcn_mfma_f32_16x16x32_bf16(af[4], bw[cb][4], ag, 0, 0, 0);
                const int col = wave * 64 + cb * 16 + fcol;
#pragma unroll
                for (int i = 0; i < 4; ++i) { const int row = (lane >> 4) * 4 + i;
                    DEC[row * 512 + col] = __expf(-0.6065306597126334f * sigmoidf_(aw[i] + w0c[cb]));
                    ALR[row * 512 + col] = sigmoidf_(aa[i] + a0c[cb]);
                    GG[row * 512 + col] = ag[i]; }
            }
        }
        __syncthreads();
#pragma unroll 1
        for (int q = 0; q < 2; ++q) {
            const int tok = 2 * wave + q, t = t0 + tok; const size_t o = (size_t)t * CW + c8;
            const bf16_t* pr = P + (size_t)t * NINP + c8;
            const bool first = (t & (SEQ - 1)) == 0;
            const u32x4 zz = (u32x4){0u, 0u, 0u, 0u};
            { const u32x4 cu = *(const u32x4*)(pr), pu = first ? zz : *(const u32x4*)(pr - NINP);
              const f32x4 m0 = *(const f32x4*)(mu + c8), m1 = *(const f32x4*)(mu + c8 + 4);
              const f32x4 c0 = cvlo(cu), c1 = cvhi(cu), p0 = cvlo(pu), p1 = cvhi(pu);
              *(u32x4*)(SR + o) = pk8(c0 + (p0 - c0) * m0, c1 + (p1 - c1) * m1); }
            { const u32x4 cu = *(const u32x4*)(pr + 1024), pu = first ? zz : *(const u32x4*)(pr - NINP + 1024);
              const f32x4 m0 = *(const f32x4*)(mu + 1024 + c8), m1 = *(const f32x4*)(mu + 1024 + c8 + 4);
              const f32x4 c0 = cvlo(cu), c1 = cvhi(cu), p0 = cvlo(pu), p1 = cvhi(pu);
              *(u32x4*)(SV + o) = pk8(c0 + (p0 - c0) * m0, c1 + (p1 - c1) * m1); }
            { const u32x4 cu = *(const u32x4*)(pr + 512), pu = first ? zz : *(const u32x4*)(pr - NINP + 512);
              const f32x4 m0 = *(const f32x4*)(mu + 512 + c8), m1 = *(const f32x4*)(mu + 512 + c8 + 4);
              const f32x4 c0 = cvlo(cu), c1 = cvhi(cu), p0 = cvlo(pu), p1 = cvhi(pu);
              const f32x4 k0 = c0 + (p0 - c0) * m0, k1 = c1 + (p1 - c1) * m1;
              const f32x4 kk0 = k0 * *(const f32x4*)(k_k + c8), kk1 = k1 * *(const f32x4*)(k_k + c8 + 4);
              float ss = (kk0.x * kk0.x + kk0.y * kk0.y) + (kk0.z * kk0.z + kk0.w * kk0.w) + (kk1.x * kk1.x + kk1.y * kk1.y) + (kk1.z * kk1.z + kk1.w * kk1.w);
              ss = red8(ss);
              const float inv = 1.0f / sqrtf(fmaxf(ss, 1e-24f));
              const f32x4 kn0 = kk0 * inv, kn1 = kk1 * inv;
              const f32x4 al0 = *(const LAS f32x4*)(ALR + tok * 512 + c8), al1 = *(const LAS f32x4*)(ALR + tok * 512 + c8 + 4);
              const f32x4 k20 = k0 * (1.0f + (al0 - 1.0f) * *(const f32x4*)(k_a + c8)), k21 = k1 * (1.0f + (al1 - 1.0f) * *(const f32x4*)(k_a + c8 + 4));
              *(u32x4*)(SK + o) = pk8(k20, k21); *(u32x4*)(SA + o) = pk8(-kn0, -kn1); *(u32x4*)(SB + o) = pk8(kn0 * al0, kn1 * al1); }
            { const f32x4 de0 = *(const LAS f32x4*)(DEC + tok * 512 + c8), de1 = *(const LAS f32x4*)(DEC + tok * 512 + c8 + 4);
              const f32x4 gg0 = *(const LAS f32x4*)(GG + tok * 512 + c8), gg1 = *(const LAS f32x4*)(GG + tok * 512 + c8 + 4);
              *(u32x4*)(SG + o) = pk8(gg0, gg1); *(f32x4*)(SW + o) = de0; *(f32x4*)(SW + o + 4) = de1; }
            { const u32x4 uq = *(const u32x4*)(pr + DQ0), ukd = *(const u32x4*)(pr + DK0);
              const f32x4 q0 = cvlo(uq), q1 = cvhi(uq), d0 = cvlo(ukd), d1 = cvhi(ukd);
              float qs = (q0.x * q0.x + q0.y * q0.y) + (q0.z * q0.z + q0.w * q0.w) + (q1.x * q1.x + q1.y * q1.y) + (q1.z * q1.z + q1.w * q1.w);
              float ks = (d0.x * d0.x + d0.y * d0.y) + (d0.z * d0.z + d0.w * d0.w) + (d1.x * d1.x + d1.y * d1.y) + (d1.z * d1.z + d1.w * d1.w);
              qs = red8(qs); ks = red8(ks);
              const float qi = (1.0f / sqrtf(qs * (1.0f / 64.0f) + 1e-5f)) * (0.125f * LOG2E), ki = 1.0f / sqrtf(ks * (1.0f / 64.0f) + 1e-5f);
              const f32x4 g0 = *(const f32x4*)(qn_g + (c8 & 63)), g1 = *(const f32x4*)(qn_g + (c8 & 63) + 4), h0 = *(const f32x4*)(kn_g + (c8 & 63)), h1 = *(const f32x4*)(kn_g + (c8 & 63) + 4);
              *(u32x4*)(QN + o) = pk8(q0 * qi * g0, q1 * qi * g1);
              *(u32x4*)(KN + o) = pk8(d0 * ki * h0, d1 * ki * h1); }
        }
        __syncthreads();
    }
}

__device__ __forceinline__ float red16(float v) {
    v += dpp_f<0xB1>(v); v += dpp_f<0x4E>(v); v += dpp_f<0x141>(v); v += dpp_f<0x140>(v);
    return v;
}
__device__ __forceinline__ void p3_scan(LAS unsigned char* lds, const Args& a) {
    const int tid = threadIdx.x, lane = tid & 63, wave = __builtin_amdgcn_readfirstlane(tid >> 6);
    unsigned char* ws = a.ws;
    const bf16_t* SR = (const bf16_t*)(ws + WS_SR); const bf16_t* SK = (const bf16_t*)(ws + WS_SK); const bf16_t* SV = (const bf16_t*)(ws + WS_SV);
    const bf16_t* SA = (const bf16_t*)(ws + WS_SA); const bf16_t* SB = (const bf16_t*)(ws + WS_SB); const float* SW = (const float*)(ws + WS_SW);
    float* YRAW = (float*)(ws + WS_YRAW);
    const int bh = blockIdx.x >> 1, half = blockIdx.x & 1;
    const int b = bh >> 3, h = bh & 7, tok0 = b * SEQ, col0 = h * 64, row0 = half * 32;
    constexpr int BUFB = 45056;
    LAS float* buf0 = (LAS float*)lds; LAS float* buf1 = (LAS float*)(lds + BUFB);
    LAS float* Y0 = (LAS float*)(lds + 2 * BUFB); LAS float* Y1 = Y0 + 1024;
    constexpr int NCH = SEQ / 32;
    if (wave >= 4) {
        const int lw = wave - 4, sl = lw * 8 + (lane >> 3), cg = lane & 7, c8 = cg * 8;
        f32x4 w0_, w1_; u32x4 uk, ua, ub, ur; u32x2 uv;
#define SC_ISSUE(ch) do { const size_t o_ = (size_t)(tok0 + (ch) * 32 + sl) * CW + col0; \
            w0_ = *(const f32x4*)(SW + o_ + c8); w1_ = *(const f32x4*)(SW + o_ + c8 + 4); uk = *(const u32x4*)(SK + o_ + c8); ua = *(const u32x4*)(SA + o_ + c8); ub = *(const u32x4*)(SB + o_ + c8); ur = *(const u32x4*)(SR + o_ + c8); \
            uv = *(const u32x2*)(SV + o_ + row0 + 4 * cg); } while (0)
#define SC_STORE(bufp) do { LAS float* d_ = (bufp) + sl * 64 + c8; *(LAS f32x4*)(d_) = w0_; *(LAS f32x4*)(d_ + 4) = w1_; \
            *(LAS f32x4*)(d_ + 2048) = cvlo(uk); *(LAS f32x4*)(d_ + 2052) = cvhi(uk); *(LAS f32x4*)(d_ + 4096) = cvlo(ua); *(LAS f32x4*)(d_ + 4100) = cvhi(ua); \
            *(LAS f32x4*)(d_ + 6144) = cvlo(ub); *(LAS f32x4*)(d_ + 6148) = cvhi(ub); *(LAS f32x4*)(d_ + 8192) = cvlo(ur); *(LAS f32x4*)(d_ + 8196) = cvhi(ur); \
            *(LAS f32x4*)((bufp) + 10240 + sl * 32 + 4 * cg) = (f32x4){bflo(uv.x), bfhi(uv.x), bflo(uv.y), bfhi(uv.y)}; } while (0)
#define SC_YOUT(ch, yp) do { *(f32x4*)(YRAW + (size_t)(tok0 + (ch) * 32 + sl) * CW + col0 + row0 + 4 * cg) = *(const LAS f32x4*)((yp) + sl * 32 + 4 * cg); } while (0)
        SC_ISSUE(0); SC_STORE(buf0);
        __syncthreads();
        for (int ch = 0; ch < NCH; ++ch) {
            LAS float* ob = (ch & 1) ? buf0 : buf1; const LAS float* oy = (ch & 1) ? Y0 : Y1;
            if (ch + 1 < NCH) SC_ISSUE(ch + 1);
            if (ch > 0) SC_YOUT(ch - 1, oy);
            if (ch + 1 < NCH) SC_STORE(ob);
            __syncthreads();
        }
        { const LAS float* oy = ((NCH - 1) & 1) ? Y1 : Y0; SC_YOUT(NCH - 1, oy); }
#undef SC_ISSUE
#undef SC_STORE
#undef SC_YOUT
    } else {
        const int g = lane & 7, rl = lane >> 3, row = wave * 8 + rl;
        f32x2 S0 = {0.f, 0.f}, S1 = S0, S2 = S0, S3 = S0;
        __syncthreads();
        for (int ch = 0; ch < NCH; ++ch) {
            const LAS float* cb = (ch & 1) ? buf1 : buf0; LAS float* yb = (ch & 1) ? Y1 : Y0;
            const LAS float* pa = cb + 4 * g; const LAS float* pv = cb + 10240 + row;
#define SC_LD(X, s_) const f32x4 w0##X = *(const LAS f32x4*)(pa + (s_) * 64), w1##X = *(const LAS f32x4*)(pa + (s_) * 64 + 32), k0##X = *(const LAS f32x4*)(pa + (s_) * 64 + 2048), k1##X = *(const LAS f32x4*)(pa + (s_) * 64 + 2080), \
                a0##X = *(const LAS f32x4*)(pa + (s_) * 64 + 4096), a1##X = *(const LAS f32x4*)(pa + (s_) * 64 + 4128), b0##X = *(const LAS f32x4*)(pa + (s_) * 64 + 6144), b1##X = *(const LAS f32x4*)(pa + (s_) * 64 + 6176), \
                r0##X = *(const LAS f32x4*)(pa + (s_) * 64 + 8192), r1##X = *(const LAS f32x4*)(pa + (s_) * 64 + 8224); const float v##X = pv[(s_) * 32]
#define LO(q) ((f32x2){(q).x, (q).y})
#define HI(q) ((f32x2){(q).z, (q).w})
#define SC_STEP(X, s_) do { f32x2 t = S0 * LO(a0##X); t = S1 * HI(a0##X) + t; t = S2 * LO(a1##X) + t; t = S3 * HI(a1##X) + t; float sa = t.x + t.y; \
                const f32x2 vv = {v##X, v##X}; \
                f32x2 p0 = S0 * LO(w0##X), p1 = S1 * HI(w0##X), p2 = S2 * LO(w1##X), p3 = S3 * HI(w1##X); \
                p0 = vv * LO(k0##X) + p0; p1 = vv * HI(k0##X) + p1; p2 = vv * LO(k1##X) + p2; p3 = vv * HI(k1##X) + p3; \
                sa = red8(sa); const f32x2 ss = {sa, sa}; \
                S0 = ss * LO(b0##X) + p0; S1 = ss * HI(b0##X) + p1; S2 = ss * LO(b1##X) + p2; S3 = ss * HI(b1##X) + p3; \
                f32x2 u = S0 * LO(r0##X); u = S1 * HI(r0##X) + u; u = S2 * LO(r1##X) + u; u = S3 * HI(r1##X) + u; float y = u.x + u.y; y = red8(y); \
                yb[(s_) * 32 + row] = y; } while (0)
#pragma unroll 1
            for (int s8 = 0; s8 < 32; s8 += 8) {
                SC_LD(0, s8 + 0); SC_LD(1, s8 + 1);
                SC_STEP(0, s8 + 0); SC_LD(2, s8 + 2);
                SC_STEP(1, s8 + 1); SC_LD(3, s8 + 3);
                SC_STEP(2, s8 + 2); SC_LD(4, s8 + 4);
                SC_STEP(3, s8 + 3); SC_LD(5, s8 + 5);
                SC_STEP(4, s8 + 4); SC_LD(6, s8 + 6);
                SC_STEP(5, s8 + 5); SC_LD(7, s8 + 7);
                SC_STEP(6, s8 + 6);
                SC_STEP(7, s8 + 7);
            }
#undef SC_LD
#undef LO
#undef HI
#undef SC_STEP
            __syncthreads();
        }
    }
}

__device__ __forceinline__ void p3_post(const Args& a, int G) {
    const int tid = threadIdx.x, lane = tid & 63, wave = __builtin_amdgcn_readfirstlane(tid >> 6);
    unsigned char* ws = a.ws;
    const bf16_t* SR = (const bf16_t*)(ws + WS_SR); const bf16_t* SK = (const bf16_t*)(ws + WS_SK); const bf16_t* SV = (const bf16_t*)(ws + WS_SV);
    const bf16_t* SG = (const bf16_t*)(ws + WS_SG); const float* YRAW = (const float*)(ws + WS_YRAW); bf16_t* YMIX = (bf16_t*)(ws + WS_YMIX);
    const int gw = blockIdx.x * 8 + wave, NGW = G * 8, c8 = lane * 8;
    const f32x4 lg0 = *(const f32x4*)(a.in[12] + c8), lg1 = *(const f32x4*)(a.in[12] + c8 + 4), lb0 = *(const f32x4*)(a.in[13] + c8), lb1 = *(const f32x4*)(a.in[13] + c8 + 4);
    const f32x4 rk0 = *(const f32x4*)(a.in[11] + c8), rk1 = *(const f32x4*)(a.in[11] + c8 + 4);
    for (int t = gw; t < T; t += NGW) {
        const size_t o = (size_t)t * CW + c8;
        const f32x4 y0 = *(const f32x4*)(YRAW + o), y1 = *(const f32x4*)(YRAW + o + 4);
        const u32x4 ur = *(const u32x4*)(SR + o), uk = *(const u32x4*)(SK + o), uv = *(const u32x4*)(SV + o), ug = *(const u32x4*)(SG + o);
        const float mean = red8((y0.x + y0.y) + (y0.z + y0.w) + (y1.x + y1.y) + (y1.z + y1.w)) * (1.0f / 64.0f);
        const f32x4 d0 = y0 - mean, d1 = y1 - mean;
        const float var = red8((d0.x * d0.x + d0.y * d0.y) + (d0.z * d0.z + d0.w * d0.w) + (d1.x * d1.x + d1.y * d1.y) + (d1.z * d1.z + d1.w * d1.w)) * (1.0f / 64.0f);
        const f32x4 r0 = cvlo(ur), r1 = cvhi(ur), k0 = cvlo(uk), k1 = cvhi(uk);
        const f32x4 p0 = r0 * k0 * rk0, p1 = r1 * k1 * rk1;
        const float rk = red8((p0.x + p0.y) + (p0.z + p0.w) + (p1.x + p1.y) + (p1.z + p1.w));
        const float rs = 1.0f / sqrtf(var + 64e-5f);
        const f32x4 o0 = (d0 * rs * lg0 + lb0 + rk * cvlo(uv)) * cvlo(ug), o1 = (d1 * rs * lg1 + lb1 + rk * cvhi(uv)) * cvhi(ug);
        *(u32x4*)(YMIX + (size_t)t * D + c8) = pk8(o0, o1);
    }
}

namespace att {
constexpr int SLOT = 32768, OFF_V = 16384;
constexpr int TBL_OFF = MISC_OFF + 1024;
constexpr int LW_OFF = MISC_OFF + 2048;
constexpr int CST_OFF = MISC_OFF + 3072;
__device__ __forceinline__ int crow(int r, int hi) { return (r & 3) + 8 * (r >> 2) + 4 * hi; }
__device__ __forceinline__ void glds16(const void* gsrc, unsigned lds_dst) { unsigned keep;
    asm volatile("s_mov_b32 %0, m0\n\ts_mov_b32 m0, %2\n\ts_nop 0\n\tglobal_load_lds_dwordx4 %1, off\n\ts_mov_b32 m0, %0" : "=&s"(keep) : "v"(gsrc), "s"(lds_dst) : "memory"); }
__device__ __forceinline__ s16x4 vtr(const LAS unsigned char* p) { return __builtin_bit_cast(s16x4, __builtin_amdgcn_ds_read_tr16_b64_v4i16((LAS s16x4*)p)); }

__device__ __forceinline__ void attn_unit(LAS unsigned char* lds, const Args& a, int b, int h, int qb, float negM, float lam) {
    const int tid = threadIdx.x, lane = tid & 63, r32 = lane & 31, hi = lane >> 5; const int wid = __builtin_amdgcn_readfirstlane(tid >> 6);
    const int c = wid >> 2, rg = wid & 3;
    unsigned char* ws = a.ws;
    const bf16_t* QN = (const bf16_t*)(ws + WS_QN); const bf16_t* KN = (const bf16_t*)(ws + WS_KN); const bf16_t* P = (const bf16_t*)(ws + WS_P); bf16_t* YMIX = (bf16_t*)(ws + WS_YMIX);
    const int q0 = qb * 128; const size_t rowbase = (size_t)b * SEQ;
    const int NT = 2 * qb + 2;
    LAS float* tbl = (LAS float*)(lds + TBL_OFF); LAS float* lw = (LAS float*)(lds + LW_OFF) + wid * 32;
    if (tid < 128) {
        const int n = tid; int bkt;
        if (n < 16) bkt = n; else { bkt = 16 + (int)(logf((float)n * (1.0f / 16.0f)) / 2.0794415416798357f * 16.0f); bkt = bkt > 31 ? 31 : bkt; }
        tbl[n] = (a.in[21][bkt * 4 + h] - a.in[21][31 * 4 + h]) * LOG2E;
    }
    const bf16_t* Qw = QN + (rowbase + q0 + rg * 32 + r32) * CW + h * 128 + c * 64;
    bf16x8 qr[4];
#pragma unroll
    for (int d0 = 0; d0 < 4; ++d0) qr[d0] = *(const bf16x8*)(Qw + d0 * 16 + hi * 8);
    const bf16_t* k0src = KN + (rowbase + lane) * CW + h * 128 + wid * 8;
    const bf16_t* k1src = k0src + 64;
    const int pv0 = 2 * wid, pv1 = 2 * wid + 1;
    const bf16_t* v0src = P + (rowbase + 16 * (pv0 & 3) + (lane >> 2)) * NINP + DV0 + h * 128 + 32 * (pv0 >> 2) + (lane & 3) * 8;
    const bf16_t* v1src = P + (rowbase + 16 * (pv1 & 3) + (lane >> 2)) * NINP + DV0 + h * 128 + 32 * (pv1 >> 2) + (lane & 3) * 8;
#define ATT_DMA(t, slot) do { const unsigned s_ = lds0 + (unsigned)(slot) * SLOT; \
        glds16(k0src + (size_t)(t) * 64 * CW, (unsigned)__builtin_amdgcn_readfirstlane(s_ + wid * 1024)); \
        glds16(k1src + (size_t)(t) * 64 * CW, (unsigned)__builtin_amdgcn_readfirstlane(s_ + 8192 + wid * 1024)); \
        glds16(v0src + (size_t)(t) * 64 * NINP, (unsigned)__builtin_amdgcn_readfirstlane(s_ + OFF_V + pv0 * 1024)); \
        glds16(v1src + (size_t)(t) * 64 * NINP, (unsigned)__builtin_amdgcn_readfirstlane(s_ + OFF_V + pv1 * 1024)); } while (0)
#define ATT_SBAR() __builtin_amdgcn_sched_barrier(0)
    const unsigned lds0 = (unsigned)(uintptr_t)lds;
    f32x16 o[4];
#pragma unroll
    for (int d0 = 0; d0 < 4; ++d0) o[d0] = f32x16{};
    float lsum = 0.f;
    const bool shift = negM < -60.0f;
    const int qmin = q0 + 32 * rg, qpos = qmin + r32;
    ATT_DMA(0, 0);
    asm volatile("s_waitcnt vmcnt(0)" ::: "memory");
    __syncthreads();
    for (int t = 0; t < NT; ++t) {
        if (t + 1 < NT) ATT_DMA(t + 1, (t + 1) & 1);
        const int kmin = 64 * t;
        if (kmin <= qmin + 31) {
            const LAS unsigned char* slot = lds + (t & 1) * SLOT;
            const LAS unsigned char* kb = slot + c * 8192 + hi * 1024 + r32 * 16;
            const LAS unsigned char* vb = slot + OFF_V + ((lane >> 4) & 1) * 32 + (lane & 3) * 8 + (4 * hi + ((lane & 15) >> 2)) * 64;
            bf16x8 kf[8];
#pragma unroll
            for (int d0 = 0; d0 < 4; ++d0) { kf[2 * d0] = *(const LAS bf16x8*)(kb + d0 * 2048); kf[2 * d0 + 1] = *(const LAS bf16x8*)(kb + d0 * 2048 + 512); }
            s16x4 va[16], vc[16];
#pragma unroll
            for (int i = 0; i < 8; ++i) { va[2 * i] = vtr(vb + (i >> 2) * 4096 + (i & 3) * 1024); va[2 * i + 1] = vtr(vb + (i >> 2) * 4096 + (i & 3) * 1024 + 512); }
            ATT_SBAR();
            f32x16 p0, p1;
            p0 = __builtin_amdgcn_mfma_f32_32x32x16_bf16(kf[0], qr[0], f32x16{}, 0, 0, 0); p1 = __builtin_amdgcn_mfma_f32_32x32x16_bf16(kf[1], qr[0], f32x16{}, 0, 0, 0);
#pragma unroll
            for (int d0 = 1; d0 < 4; ++d0) { p0 = __builtin_amdgcn_mfma_f32_32x32x16_bf16(kf[2 * d0], qr[d0], p0, 0, 0, 0); p1 = __builtin_amdgcn_mfma_f32_32x32x16_bf16(kf[2 * d0 + 1], qr[d0], p1, 0, 0, 0); }
            ATT_SBAR();
            if (qmin - (kmin + 63) < 113) {
#pragma unroll
                for (int r = 0; r < 16; ++r) {
                    const int d0_ = qpos - (kmin + crow(r, hi)); const int d1_ = d0_ - 32;
                    const float t0 = tbl[d0_ < 0 ? 0 : (d0_ > 127 ? 127 : d0_)], t1 = tbl[d1_ < 0 ? 0 : (d1_ > 127 ? 127 : d1_)];
                    p0[r] = d0_ < 0 ? -INFINITY : p0[r] + t0; p1[r] = d1_ < 0 ? -INFINITY : p1[r] + t1;
                }
            }
            if (shift) {
#pragma unroll
                for (int r = 0; r < 16; ++r) { p0[r] += negM; p1[r] += negM; }
            }
            float sacc = 0.f;
#pragma unroll
            for (int r = 0; r < 16; ++r) { p0[r] = __builtin_amdgcn_exp2f(p0[r]); p1[r] = __builtin_amdgcn_exp2f(p1[r]); sacc += p0[r] + p1[r]; }
            lsum += sacc;
            u32x4 pw[4];
#pragma unroll
            for (int i = 0; i < 4; ++i) { pw[0][i] = pk2(p0[2 * i], p0[2 * i + 1]); pw[1][i] = pk2(p0[8 + 2 * i], p0[8 + 2 * i + 1]); pw[2][i] = pk2(p1[2 * i], p1[2 * i + 1]); pw[3][i] = pk2(p1[8 + 2 * i], p1[8 + 2 * i + 1]); }
            ATT_SBAR();
#pragma unroll
            for (int i = 0; i < 8; ++i) { vc[2 * i] = vtr(vb + (2 + (i >> 2)) * 4096 + (i & 3) * 1024); vc[2 * i + 1] = vtr(vb + (2 + (i >> 2)) * 4096 + (i & 3) * 1024 + 512); }
#pragma unroll
            for (int i = 0; i < 8; ++i) {
                const bf16x8 vf = (bf16x8){va[2 * i][0], va[2 * i][1], va[2 * i][2], va[2 * i][3], va[2 * i + 1][0], va[2 * i + 1][1], va[2 * i + 1][2], va[2 * i + 1][3]};
                o[i >> 2] = __builtin_amdgcn_mfma_f32_32x32x16_bf16(__builtin_bit_cast(bf16x8, pw[i & 3]), vf, o[i >> 2], 0, 0, 0);
            }
#pragma unroll
            for (int i = 0; i < 8; ++i) {
                const bf16x8 vf = (bf16x8){vc[2 * i][0], vc[2 * i][1], vc[2 * i][2], vc[2 * i][3], vc[2 * i + 1][0], vc[2 * i + 1][1], vc[2 * i + 1][2], vc[2 * i + 1][3]};
                o[2 + (i >> 2)] = __builtin_amdgcn_mfma_f32_32x32x16_bf16(__builtin_bit_cast(bf16x8, pw[i & 3]), vf, o[2 + (i >> 2)], 0, 0, 0);
            }
        }
        asm volatile("s_waitcnt vmcnt(0)" ::: "memory");
        __syncthreads();
    }
#undef ATT_DMA
#undef ATT_SBAR
    lsum += __shfl_xor(lsum, 32);
    if (hi == 0) lw[r32] = 1.0f / lsum;
    asm volatile("s_waitcnt lgkmcnt(0)" ::: "memory");
    LAS float* stg = (LAS float*)(lds + wid * 16384);
#pragma unroll
    for (int r = 0; r < 16; ++r) { const int orow = crow(r, hi); const float il = lw[orow];
#pragma unroll
        for (int d0 = 0; d0 < 4; ++d0) stg[orow * 128 + d0 * 32 + r32] = o[d0][r] * il; }
    __syncthreads();
    {
        const int row = tid >> 2, part = tid & 3, rgp = row >> 5, rr = row & 31;
        const LAS float* s1 = (const LAS float*)(lds + rgp * 16384) + rr * 128 + part * 32;
        const LAS float* s2 = (const LAS float*)(lds + (4 + rgp) * 16384) + rr * 128 + part * 32;
        float dv[32]; float ss = 0.f;
#pragma unroll
        for (int i = 0; i < 8; ++i) { const f32x4 x1 = *(const LAS f32x4*)(s1 + 4 * i), x2 = *(const LAS f32x4*)(s2 + 4 * i);
#pragma unroll
            for (int j = 0; j < 4; ++j) { const float dd = x1[j] - lam * x2[j]; dv[4 * i + j] = dd; ss += dd * dd; } }
        ss = red4(ss);
        const float sc = (1.0f / sqrtf(ss * (1.0f / 128.0f) + 1e-5f)) * 0.8f;
        const float* sg = a.in[20] + part * 32;
        bf16_t* op = YMIX + (rowbase + q0 + row) * D + CW + h * 128 + part * 32;
#pragma unroll
        for (int i = 0; i < 4; ++i) { u32x4 w;
            w.x = pk2(dv[8 * i] * sc * sg[8 * i], dv[8 * i + 1] * sc * sg[8 * i + 1]); w.y = pk2(dv[8 * i + 2] * sc * sg[8 * i + 2], dv[8 * i + 3] * sc * sg[8 * i + 3]);
            w.z = pk2(dv[8 * i + 4] * sc * sg[8 * i + 4], dv[8 * i + 5] * sc * sg[8 * i + 5]); w.w = pk2(dv[8 * i + 6] * sc * sg[8 * i + 6], dv[8 * i + 7] * sc * sg[8 * i + 7]);
            *(u32x4*)(op + 8 * i) = w; }
    }
    __syncthreads();
}

__device__ __forceinline__ void attn_phase(LAS unsigned char* lds, const Args& a, unsigned* ctl) {
    const int tid = threadIdx.x;
    LAS float* cst = (LAS float*)(lds + CST_OFF);
    if (tid < 64) {
        const float gq = fabsf(a.in[14][tid]), gk = fabsf(a.in[15][tid]);
        float mq = gq, mk = gk;
#pragma unroll
        for (int o = 1; o < 64; o <<= 1) { mq = fmaxf(mq, __shfl_xor(mq, o)); mk = fmaxf(mk, __shfl_xor(mk, o)); }
        const float d1 = wave_sum(a.in[16][tid] * a.in[17][tid]), d2 = wave_sum(a.in[18][tid] * a.in[19][tid]);
        float mb = 0.f;
        if (tid < 32) { for (int hh = 0; hh < 4; ++hh) mb = fmaxf(mb, (a.in[21][tid * 4 + hh] - a.in[21][31 * 4 + hh]) * LOG2E); }
#pragma unroll
        for (int o = 1; o < 64; o <<= 1) mb = fmaxf(mb, __shfl_xor(mb, o));
        if (tid == 0) { cst[0] = -(8.0f * LOG2E * mq * mk * 1.02f + mb); cst[1] = __expf(d1) - __expf(d2) + 0.2f; }
    }
    __syncthreads();
    const float negM = cst[0], lam = cst[1];
    LAS int* ubox = (LAS int*)(lds + CST_OFF + 16);
    for (;;) {
        if (tid == 0) ubox[0] = (int)atomicAdd(ctl + CW_ATTQ, 1u);
        __syncthreads();
        const int u = ubox[0];
        __syncthreads();
        if (u >= 1024) break;
        const int qb = 31 - (u >> 5), bhh = u & 31;
        attn_unit(lds, a, bhh >> 2, bhh & 3, qb, negM, lam);
    }
}
}

__device__ __forceinline__ void p5_router(LAS unsigned char* lds, const Args& a, unsigned* ctl) {
    const int tid = threadIdx.x, lane = tid & 63, wave = __builtin_amdgcn_readfirstlane(tid >> 6);
    unsigned char* ws = a.ws;
    const float* x1 = a.out; const float* g2 = a.in[23]; const float* rw = a.in[24]; const float* rb = a.in[25];
    unsigned char* H2 = ws + WS_H2; int* EIDX = (int*)(ws + WS_EIDX); float* GATE = (float*)(ws + WS_GATE); int* POS = (int*)(ws + WS_POS);
    LAS float* rwT = (LAS float*)lds;
    LAS int* cnt = (LAS int*)(lds + MISC_OFF + 1024);
    LAS int* basel = (LAS int*)(lds + MISC_OFF + 1024 + 128);
    LAS int* el = (LAS int*)(lds + MISC_OFF + 2048);
    LAS int* pl = (LAS int*)(lds + MISC_OFF + 4096);
    for (int i = tid; i < 32 * 1024; i += 512) { const int k = i >> 5, e = i & 31; rwT[e * 1024 + k] = rw[i]; }
    if (tid < 32) cnt[tid] = 0;
    __syncthreads();
    f32x4 gv[4];
#pragma unroll
    for (int j = 0; j < 4; ++j) gv[j] = *((const f32x4*)g2 + lane + 64 * j);
    const float rbias = rb[lane >> 1];
    const int TPB = T / (int)gridDim.x, tb0 = blockIdx.x * TPB, TPW = TPB / 8;
    for (int i = 0; i < TPW; ++i) {
        const int tl = wave * TPW + i, t = tb0 + tl;
        const f32x4* xr = (const f32x4*)(x1 + (size_t)t * D) + lane;
        f32x4 v[4]; float s = 0.f;
#pragma unroll
        for (int j = 0; j < 4; ++j) { v[j] = xr[64 * j]; s += (v[j].x * v[j].x + v[j].y * v[j].y) + (v[j].z * v[j].z + v[j].w * v[j].w); }
        const float rstd = 1.0f / sqrtf(wave_sum(s) * (1.0f / D) + 1e-5f);
        unsigned* o4 = (unsigned*)(H2 + (size_t)t * D) + lane;
#pragma unroll
        for (int j = 0; j < 4; ++j) { v[j] = v[j] * rstd * gv[j]; o4[64 * j] = pk4_fp8(v[j].x * F8_X_MUL, v[j].y * F8_X_MUL, v[j].z * F8_X_MUL, v[j].w * F8_X_MUL); }
        float acc[32];
#pragma unroll
        for (int e = 0; e < 32; ++e) {
            float s2 = 0.f;
#pragma unroll
            for (int j = 0; j < 4; ++j) { const f32x4 w = *((const LAS f32x4*)(rwT + e * 1024) + lane + 64 * j); s2 += (v[j].x * w.x + v[j].y * w.y) + (v[j].z * w.z + v[j].w * w.w); }
            acc[e] = s2;
        }
#pragma unroll
        for (int e = 0; e < 16; ++e) { const bool up = lane & 32; const float keep = up ? acc[e + 16] : acc[e], send = up ? acc[e] : acc[e + 16]; acc[e] = keep + __shfl_xor(send, 32); }
#pragma unroll
        for (int e = 0; e < 8; ++e) { const bool up = lane & 16; const float keep = up ? acc[e + 8] : acc[e], send = up ? acc[e] : acc[e + 8]; acc[e] = keep + __shfl_xor(send, 16); }
#pragma unroll
        for (int e = 0; e < 4; ++e) { const bool up = lane & 8; const float keep = up ? acc[e + 4] : acc[e], send = up ? acc[e] : acc[e + 4]; acc[e] = keep + __shfl_xor(send, 8); }
#pragma unroll
        for (int e = 0; e < 2; ++e) { const bool up = lane & 4; const float keep = up ? acc[e + 2] : acc[e], send = up ? acc[e] : acc[e + 2]; acc[e] = keep + __shfl_xor(send, 4); }
        { const bool up = lane & 2; const float keep = up ? acc[1] : acc[0], send = up ? acc[0] : acc[1]; acc[0] = keep + __shfl_xor(send, 2); }
        float logit = acc[0] + __shfl_xor(acc[0], 1) + rbias;
        const int myid = lane >> 1;
        float tv[4]; int ti[4];
#pragma unroll
        for (int k = 0; k < 4; ++k) {
            float bv = logit; int bi = myid;
#pragma unroll
            for (int o = 1; o < 64; o <<= 1) { const float ov = __shfl_xor(bv, o); const int oi = __shfl_xor(bi, o); if (ov > bv || (ov == bv && oi < bi)) { bv = ov; bi = oi; } }
            tv[k] = bv; ti[k] = bi;
            if (myid == bi) logit = -INFINITY;
        }
        const float e1 = __expf(tv[1] - tv[0]), e2 = __expf(tv[2] - tv[0]), e3 = __expf(tv[3] - tv[0]);
        const float inv = 1.0f / (1.0f + e1 + e2 + e3);
        if (lane < 4) {
            const int ek = lane == 0 ? ti[0] : lane == 1 ? ti[1] : lane == 2 ? ti[2] : ti[3];
            const float gk = (lane == 0 ? 1.0f : lane == 1 ? e1 : lane == 2 ? e2 : e3) * inv;
            EIDX[t * 4 + lane] = ek; GATE[t * 4 + lane] = gk;
            el[tl * 4 + lane] = ek; pl[tl * 4 + lane] = atomicAdd((int*)(cnt + ek), 1);
        }
    }
    __syncthreads();
    if (tid < 32) basel[tid] = (int)atomicAdd(ctl + CW_CNT + tid, (unsigned)cnt[tid]);
    __syncthreads();
    for (int i = tid; i < TPB * 4; i += 512) POS[(size_t)tb0 * 4 + i] = pl[i] + basel[el[i]];
}

__device__ __forceinline__ void p6_dispatch(LAS unsigned char* lds, const Args& a, unsigned* ctl) {
    const int tid = threadIdx.x, lane = tid & 63, wave = __builtin_amdgcn_readfirstlane(tid >> 6);
    unsigned char* ws = a.ws;
    const unsigned char* H2 = ws + WS_H2; unsigned char* XS = ws + WS_XS;
    const int* EIDX = (const int*)(ws + WS_EIDX); const float* GATE = (const float*)(ws + WS_GATE); const int* POS = (const int*)(ws + WS_POS);
    int* DEST = (int*)(ws + WS_DEST); float* ROWGATE = (float*)(ws + WS_ROWGATE); int* TILEE = (int*)(ws + WS_TILEE);
    LAS int* pstart = (LAS int*)(lds + MISC_OFF + 1024);
    if (tid == 0) {
        int acc = 0;
        for (int e = 0; e < NE; ++e) { const int cn = (int)__hip_atomic_load(ctl + CW_CNT + e, __ATOMIC_RELAXED, __HIP_MEMORY_SCOPE_AGENT); pstart[e] = acc;
            const int nt = (cn + 255) >> 8;
            if (blockIdx.x == 0) for (int i = 0; i < nt; ++i) TILEE[(acc >> 8) + i] = e;
            acc += nt * 256; }
        if (blockIdx.x == 0) TILEE[1023] = acc >> 8;
    }
    __syncthreads();
    const int TPB = T / (int)gridDim.x, tb0 = blockIdx.x * TPB, PPW = TPB * 4 / 8;
    for (int i = 0; i < PPW; ++i) {
        const int pi = tb0 * 4 + wave * PPW + i, t = pi >> 2;
        const int e = EIDX[pi], dest = pstart[e] + POS[pi];
        if (lane == 0) { DEST[pi] = dest; ROWGATE[dest] = GATE[pi]; }
        const u32x4* src = (const u32x4*)(H2 + (size_t)t * D); u32x4* dst = (u32x4*)(XS + (size_t)dest * D);
        dst[lane] = src[lane];
    }
}

__device__ __forceinline__ void p9_combine(const Args& a, int G) {
    const int tid = threadIdx.x, lane = tid & 63, wave = __builtin_amdgcn_readfirstlane(tid >> 6);
    unsigned char* ws = a.ws;
    const bf16_t* YS = (const bf16_t*)(ws + WS_YS); const int* DEST = (const int*)(ws + WS_DEST);
    float* out = a.out;
    const int gw = blockIdx.x * 8 + wave, NGW = G * 8;
    for (int t = gw; t < T; t += NGW) {
        f32x4* xr = (f32x4*)(out + (size_t)t * D) + lane;
        f32x4 v[4];
#pragma unroll
        for (int j = 0; j < 4; ++j) v[j] = xr[64 * j];
#pragma unroll
        for (int k = 0; k < 4; ++k) {
            const int dest = DEST[t * 4 + k];
            const u32x2* yr = (const u32x2*)(YS + (size_t)dest * D) + lane;
#pragma unroll
            for (int j = 0; j < 4; ++j) { const u32x2 w = yr[64 * j]; v[j].x += bflo(w.x); v[j].y += bfhi(w.x); v[j].z += bflo(w.y); v[j].w += bfhi(w.y); }
        }
#pragma unroll
        for (int j = 0; j < 4; ++j) xr[64 * j] = v[j];
    }
}

constexpr int NPHASE = 10;
__global__ void __launch_bounds__(512, 2) hymba_fwd(Args args) {
    extern __shared__ __attribute__((aligned(16))) unsigned char lds_raw[];
    LAS unsigned char* lds = (LAS unsigned char*)lds_raw;
    cg::grid_group grid = cg::this_grid();
    const int G = gridDim.x;
    unsigned char* ws = args.ws;
    unsigned* ctl = (unsigned*)(ws + WS_CTL);
    const int lo = args.ph_lo, hi = args.ph_hi;
#define IN(k) (lo <= (k) && (k) < hi)
#define NREP(k) ((REP_PHASE) == (k) ? 2 : 1)
#define SEAM(k) do { if (IN(k) && IN((k) + 1)) { if ((k) == 0) grid.sync(); else xcd_barrier(xbar); } } while (0)
    const int* TILEE = (const int*)(ws + WS_TILEE);
    { volatile LAS unsigned* st = (volatile LAS unsigned*)(lds + MISC_OFF); if (threadIdx.x < 2) st[threadIdx.x] = 0u; }
    __syncthreads();
    const XcdBarrier xbar = xcd_barrier_post(ctl + CW_BAR, (volatile LAS unsigned*)(lds + MISC_OFF));

    if (IN(0)) { for (int rep = 0; rep < NREP(0); ++rep) p0_prologue(lds, args, G); } SEAM(0);
    if (IN(1)) {
        pg8::Gemm g{ws + WS_XN, ws + WS_WINT, 1024, 0, 0};
        pg8::TileOrder S; S.init(T / 256, NINP / 256, G, (int)blockIdx.x, nullptr, 0);
        pg8::EpiBf16 E{(bf16_t*)(ws + WS_P), NINP};
        for (int rep = 0; rep < NREP(1); ++rep) pg8::gemm_phase<false>(lds, g, S, E);
    } SEAM(1);
    if (IN(2)) { _Pragma("clang loop unroll(disable)") for (int rep = 0; rep < NREP(2); ++rep) { p2_prep(lds, args); __syncthreads(); } } SEAM(2);
    if (IN(3)) {
        for (int rep = 0; rep < NREP(30); ++rep) { if (blockIdx.x < 128) p3_scan(lds, args); __syncthreads(); }
        for (int rep = 0; rep < NREP(31); ++rep) att::attn_phase(lds, args, ctl + 64 * rep);
        xcd_barrier(xbar);
        for (int rep = 0; rep < NREP(32); ++rep) p3_post(args, G);
    } SEAM(3);
    if (IN(4)) {
        pg8::Gemm g{ws + WS_YMIX, ws + WS_WOUT, 1024, 0, 0};
        pg8::TileOrder S; S.init(T / 256, D / 256, G, (int)blockIdx.x, nullptr, 0);
        pg8::EpiResF32 E{args.in[0], args.out, D};
        for (int rep = 0; rep < NREP(4); ++rep) pg8::gemm_phase<false>(lds, g, S, E);
    } SEAM(4);
    if (IN(5)) { _Pragma("clang loop unroll(disable)") for (int rep = 0; rep < NREP(5); ++rep) { p5_router(lds, args, ctl + 256 * (NREP(5) - 1 - rep)); __syncthreads(); } } SEAM(5);
    if (IN(6)) { for (int rep = 0; rep < NREP(6); ++rep) { p6_dispatch(lds, args, ctl); __syncthreads(); } } SEAM(6);
    if (IN(7)) {
        const int ntile = TILEE[1023];
        pg8::Gemm g{ws + WS_XS, ws + WS_W1T, 1024, F8_W_SC, F8_X_SC};
        pg8::TileOrder S; S.init(ntile, 8, G, (int)blockIdx.x, TILEE, 8);
        pg8::EpiSwiglu E{ws + WS_HID, args.in[27], TILEE};
        for (int rep = 0; rep < NREP(7); ++rep) pg8::gemm_phase<true>(lds, g, S, E);
    } SEAM(7);
    if (IN(8)) {
        const int ntile = TILEE[1023];
        pg8::Gemm g{ws + WS_HID, ws + WS_W2T, 1024, F8_W_SC, F8_H_SC};
        pg8::TileOrder S; S.init(ntile, 4, G, (int)blockIdx.x, TILEE, 4);
        pg8::EpiGateBf16 E{(bf16_t*)(ws + WS_YS), args.in[29], (const float*)(ws + WS_ROWGATE), TILEE};
        for (int rep = 0; rep < NREP(8); ++rep) pg8::gemm_phase<true>(lds, g, S, E);
    } SEAM(8);
    if (IN(9)) { p9_combine(args, G); }
#undef IN
#undef SEAM
}

extern "C" void kernel_launch(void* const* d_in, const int* in_sizes, int n_in, void* d_out, int out_size, void* d_ws, size_t ws_size, hipStream_t stream) {
    static int grid = 0;
    if (grid == 0) {
        if (n_in != 30 || in_sizes[0] != T * D || out_size != T * D || ws_size < WS_END) { fprintf(stderr, "kernel_launch: unexpected shapes (n_in %d, in0 %d, out %d, ws %zu); nothing launched\n", n_in, n_in > 0 ? in_sizes[0] : -1, out_size, ws_size); grid = -1; return; }
        int dev = 0, cus = 0, per_cu = 0;
        if (hipGetDevice(&dev) != hipSuccess || hipDeviceGetAttribute(&cus, hipDeviceAttributeMultiprocessorCount, dev) != hipSuccess) { grid = -1; return; }
        if (hipFuncSetAttribute((const void*)hymba_fwd, hipFuncAttributeMaxDynamicSharedMemorySize, LDS_BYTES) != hipSuccess) { fprintf(stderr, "kernel_launch: hipFuncSetAttribute failed\n"); grid = -1; return; }
        if (hipOccupancyMaxActiveBlocksPerMultiprocessor(&per_cu, (const void*)hymba_fwd, 512, LDS_BYTES) != hipSuccess || per_cu < 1) { fprintf(stderr, "kernel_launch: occupancy query says %d\n", per_cu); per_cu = 1; }
        (void)hipGetLastError();
        grid = cus;
        if (grid > 256) grid = 256;
        if (grid != 256 || T % grid != 0 || (T / grid) % 16 != 0) { fprintf(stderr, "kernel_launch: grid %d does not divide the token count evenly\n", grid); grid = -1; return; }
    }
    if (grid < 0) return;
    (void)hipMemsetAsync((char*)d_ws + WS_CTL, 0, CTL_ZERO_BYTES, stream);
    Args a{};
    for (int i = 0; i < 30; ++i) a.in[i] = (const float*)d_in[i];
    a.out = (float*)d_out; a.ws = (unsigned char*)d_ws;
    constexpr int NL = MK_N_LAUNCHES;
    for (int li = 0; li < NL; ++li) {
        a.ph_lo = (NL == 1) ? 0 : li; a.ph_hi = (NL == 1) ? NPHASE : li + 1;
        void* kargs[] = {&a};
        hipError_t e = hipLaunchCooperativeKernel((const void*)hymba_fwd, dim3(grid), dim3(512), kargs, LDS_BYTES, stream);
        if (e != hipSuccess) { fprintf(stderr, "kernel_launch: cooperative launch %d failed: %s (grid %d)\n", li, hipGetErrorString(e), grid); break; }
    }
}
```

```cpp
#include <hip/hip_runtime.h>
#include <hip/hip_cooperative_groups.h>
#include <cstdio>
#include <cstdint>
#include <type_traits>
namespace cg = cooperative_groups;

#ifndef REP_PHASE
#define REP_PHASE -1
#endif
#ifndef MK_N_LAUNCHES
#define MK_N_LAUNCHES 1
#endif

#define LAS __attribute__((address_space(3)))
#define GAS __attribute__((address_space(1)))
typedef unsigned short bf16_t;
typedef short bf16x8 __attribute__((ext_vector_type(8)));
typedef short s16x4 __attribute__((ext_vector_type(4)));
typedef float f32x2 __attribute__((ext_vector_type(2)));
typedef float f32x4 __attribute__((ext_vector_type(4)));
typedef float f32x16 __attribute__((ext_vector_type(16)));
typedef unsigned u32x2 __attribute__((ext_vector_type(2)));
typedef unsigned u32x4 __attribute__((ext_vector_type(4)));
typedef int v8i32 __attribute__((ext_vector_type(8)));

constexpr int NB = 8, SEQ = 4096, T = NB * SEQ, D = 1024;
constexpr int CW = 512;
constexpr int NRW = 1696, NIN = 3232, NINP = 3328;
constexpr int DQ0 = 1696, DK0 = 2208, DV0 = 2720;
constexpr int NE = 32, TOPK = 4, DE = 1024;
constexpr int MAXROWS = T * TOPK + NE * 256;
constexpr int MAXTILES = MAXROWS / 256;
constexpr float LOG2E = 1.4426950408889634f;
constexpr float F8_W_MUL = 32.f, F8_X_MUL = 8.f, F8_H_MUL = 4.f; constexpr int F8_W_SC = 0x7A7A7A7A, F8_X_SC = 0x7C7C7C7C, F8_H_SC = 0x7D7D7D7D;

constexpr size_t MiB = 1u << 20;
constexpr size_t WS_CTL = 0, CTL_ZERO_BYTES = 64 * 1024;
constexpr size_t WS_TILEE = 512 * 1024;
constexpr size_t WS_WINT = 1 * MiB;
constexpr size_t WS_WOUT = 8 * MiB;
constexpr size_t WS_W1T = 10 * MiB;
constexpr size_t WS_W2T = 138 * MiB;
constexpr size_t WS_EIDX = 202 * MiB;
constexpr size_t WS_GATE = WS_EIDX + 512 * 1024;
constexpr size_t WS_POS = WS_GATE + 512 * 1024;
constexpr size_t WS_DEST = WS_POS + 512 * 1024;
constexpr size_t WS_ROWGATE = 204 * MiB;
constexpr size_t WS_XN = 206 * MiB;
constexpr size_t WS_P = 270 * MiB;
constexpr size_t WS_SR = 478 * MiB, WS_SK = 510 * MiB, WS_SV = 542 * MiB, WS_SA = 574 * MiB, WS_SB = 606 * MiB;
constexpr size_t WS_SW = 638 * MiB;
constexpr size_t WS_SG = 702 * MiB;
constexpr size_t WS_QN = 734 * MiB, WS_KN = 766 * MiB;
constexpr size_t WS_YMIX = 798 * MiB;
constexpr size_t WS_H2 = 206 * MiB;
constexpr size_t WS_XS = 270 * MiB;
constexpr size_t WS_HID = 406 * MiB;
constexpr size_t WS_YS = 542 * MiB;
constexpr size_t WS_YRAW = 862 * MiB;
constexpr size_t WS_END = 926 * MiB;
constexpr int CW_CNT = 64;
constexpr int CW_ATTQ = 128;
constexpr int CW_BAR = 4096;

constexpr int RING_BYTES = 131072, MISC_OFF = RING_BYTES, LDS_BYTES = 147456;

__device__ __forceinline__ unsigned f2bf(float f) { unsigned u = __builtin_bit_cast(unsigned, f); return (u + 0x7fffu + ((u >> 16) & 1u)) >> 16; }
typedef __bf16 hwbf16x2 __attribute__((ext_vector_type(2)));
__device__ __forceinline__ unsigned pk2(float lo, float hi) { const f32x2 v = {lo, hi}; return __builtin_bit_cast(unsigned, __builtin_convertvector(v, hwbf16x2)); }
__device__ __forceinline__ unsigned pk4_fp8(float a, float b, float c, float d) {
    a = fminf(fmaxf(a, -448.f), 448.f); b = fminf(fmaxf(b, -448.f), 448.f); c = fminf(fmaxf(c, -448.f), 448.f); d = fminf(fmaxf(d, -448.f), 448.f);
    int r = __builtin_amdgcn_cvt_pk_fp8_f32(a, b, 0, false); r = __builtin_amdgcn_cvt_pk_fp8_f32(c, d, r, true); return (unsigned)r; }
__device__ __forceinline__ float bf2f(unsigned short b) { return __builtin_bit_cast(float, (unsigned)b << 16); }
__device__ __forceinline__ float bflo(unsigned w) { return __builtin_bit_cast(float, w << 16); }
__device__ __forceinline__ float bfhi(unsigned w) { return __builtin_bit_cast(float, w & 0xffff0000u); }
__device__ __forceinline__ float wave_sum(float v) {
#pragma unroll
    for (int o = 1; o < 64; o <<= 1) v += __shfl_xor(v, o);
    return v;
}
__device__ __forceinline__ float sigmoidf_(float x) { return 1.0f / (1.0f + __expf(-x)); }
template <int CTRL> __device__ __forceinline__ float dpp_f(float v) { return __builtin_bit_cast(float, __builtin_amdgcn_update_dpp(0, __builtin_bit_cast(int, v), CTRL, 0xF, 0xF, true)); }
__device__ __forceinline__ float red8(float v) {
    v += dpp_f<0xB1>(v);
    v += dpp_f<0x4E>(v);
    v += dpp_f<0x141>(v);
    return v;
}
__device__ __forceinline__ float red4(float v) { v += dpp_f<0xB1>(v); v += dpp_f<0x4E>(v); return v; }


#define XB_TMO      128
#define XB_XCNT(j)  (256  + 64 * (j))
#define XB_XSUB(j)  (1280 + 64 * (j))
#define XB_XGEN(j)  (2304 + 64 * (j))
#define XB_TOP      3328
#define XB_TOPGEN   3392
#define XCD_BAR_WORDS 3456
#define XB_SPIN_CAP (1u << 18)
__device__ __forceinline__ unsigned xb_ld(unsigned* p)              { return __hip_atomic_load(p, __ATOMIC_RELAXED, __HIP_MEMORY_SCOPE_AGENT); }
__device__ __forceinline__ unsigned xb_add(unsigned* p, unsigned v) { return __hip_atomic_fetch_add(p, v, __ATOMIC_RELAXED, __HIP_MEMORY_SCOPE_AGENT); }
__device__ __forceinline__ unsigned xb_xcc_id() { return (unsigned)__builtin_amdgcn_s_getreg((3 << 11) | 20) & 0xFu; }
#define XB_SPIN(cond, bar) do { unsigned _sp = 0; while (cond) { __builtin_amdgcn_s_sleep(1); \
    if ((++_sp & 255u) == 0u) { if (xb_ld(&(bar)[XB_TMO])) break; if (_sp > XB_SPIN_CAP) { atomicAdd(&(bar)[XB_TMO], 1u); break; } } } } while (0)
struct XcdBarrier { unsigned* bar; unsigned x; volatile LAS unsigned* st; };
__device__ __forceinline__ XcdBarrier xcd_barrier_post(unsigned* bar, volatile LAS unsigned* st) {
    XcdBarrier b; b.bar = bar; b.x = xb_xcc_id(); b.st = st;
    if (threadIdx.x == 0) (void)xb_add(&bar[XB_XCNT(b.x)], 1u);
    return b;
}
__device__ __forceinline__ void xcd_barrier_complete(unsigned* bar, unsigned x, unsigned& nloc, unsigned& nx) {
    const unsigned G = gridDim.x * gridDim.y * gridDim.z;
    unsigned sum, cnt, mine, sp = 0u;
    for (;;) {
        sum = 0u; cnt = 0u; mine = 0u;
#pragma unroll
        for (unsigned j = 0; j < 16; ++j) { const unsigned c = xb_ld(&bar[XB_XCNT(j)]); sum += c; cnt += (c > 0u) ? 1u : 0u; mine = (j == x) ? c : mine; }
        if (sum == G) break;
        __builtin_amdgcn_s_sleep(1);
        if ((++sp & 255u) == 0u) { if (xb_ld(&bar[XB_TMO])) break; if (sp > XB_SPIN_CAP) { atomicAdd(&bar[XB_TMO], 1u); break; } }
    }
    nloc = mine > 0u ? mine : 1u; nx = cnt > 0u ? cnt : 1u;
}
__device__ __forceinline__ void xcd_barrier(const XcdBarrier& b) {
    asm volatile("s_waitcnt vmcnt(0)" ::: "memory");
    __syncthreads();
    if (threadIdx.x == 0) {
        unsigned* bar = b.bar;
        __builtin_amdgcn_s_waitcnt(0);
        unsigned nloc = b.st[0], nx = b.st[1];
        if (nloc == 0u) { xcd_barrier_complete(bar, b.x, nloc, nx); b.st[0] = nloc; b.st[1] = nx; }
        const unsigned old = xb_add(&bar[XB_XSUB(b.x)], 1u);
        const unsigned gen = old / nloc;
        if (old + 1u == (gen + 1u) * nloc) {
            __builtin_amdgcn_fence(__ATOMIC_RELEASE, "agent");
            asm volatile("s_waitcnt vmcnt(0)" ::: "memory");
            const unsigned og = xb_add(&bar[XB_TOP], 1u);
            const unsigned tg = og / nx;
            if (og + 1u == (tg + 1u) * nx) xb_add(&bar[XB_TOPGEN], 1u);
            else XB_SPIN(xb_ld(&bar[XB_TOPGEN]) == tg, bar);
            __builtin_amdgcn_fence(__ATOMIC_ACQUIRE, "agent");
            xb_add(&bar[XB_XGEN(b.x)], 1u);
            asm volatile("s_waitcnt vmcnt(0)" ::: "memory");
        } else {
            XB_SPIN(xb_ld(&bar[XB_XGEN(b.x)]) == gen, bar);
            __builtin_amdgcn_fence(__ATOMIC_ACQUIRE, "agent");
            asm volatile("s_waitcnt vmcnt(0)" ::: "memory");
        }
    }
    __syncthreads();
}

namespace pg8 {
constexpr int BM = 256, BK = 64, HALF = 128, HTB = HALF * BK * 2, STAGE_BYTES = 8 * HTB, NXCD = 8, WGM = 8;
__host__ __device__ __forceinline__ int lds_byte(int r, int c) { const int st = (r >> 4) * 2 + (c >> 5), rr = r & 15, cc = c & 31, ob = rr * 64 + cc * 2; return st * 1024 + (ob ^ (((ob >> 9) & 1) << 5)); }
__host__ __device__ __forceinline__ void stage_rc(int b, int& R, int& C) { const int st = b / 1024, sb = b % 1024, swz = sb ^ (((sb >> 9) & 1) << 5); R = (st >> 1) * 16 + swz / 64; C = (st & 1) * 32 + (swz % 64) / 2; }
__host__ __device__ __forceinline__ int perm32(int rho) { const int n = rho >> 4, i = rho & 15; return 8 * (i >> 2) + 4 * n + (i & 3); }

struct Unit { int pm, pn, pb; };
struct Gemm { const void* A; const void* Bt; int K; int scW, scA; };

struct TileOrder {
    int nM, nN, nwg, G, c; const int* tile_e; int nb_per_e;
    __device__ void init(int nM_, int nN_, int G_, int c_, const int* te, int nbe) { nM = nM_; nN = nN_; nwg = nM * nN; G = G_; c = c_; tile_e = te; nb_per_e = nbe; }
    __device__ bool next(int i, Unit& u) const {
        const long L = (long)i * G + c; if (L >= nwg) return false;
        int wgid = (int)L; { const int q = nwg / NXCD, r = nwg % NXCD, xcd = wgid % NXCD, off = wgid / NXCD; wgid = (xcd < r ? xcd * (q + 1) : r * (q + 1) + (xcd - r) * q) + off; }
        const int nig = WGM * nN, gid = wgid / nig, fm = gid * WGM, gsz = (nM - fm) < WGM ? (nM - fm) : WGM;
        u.pm = fm + ((wgid % nig) % gsz); u.pn = (wgid % nig) / gsz;
        u.pb = tile_e ? tile_e[u.pm] * nb_per_e + u.pn : u.pn;
        return true;
    }
};

struct EpiBf16 {
    static constexpr bool PERM = true;
    bf16_t* O; int ldc;
    __device__ __forceinline__ void operator()(const f32x4 (&acc)[2][2][4][2], const Unit& u, int wr, int wc, int fr, int fq) const {
        const int row0 = u.pm * BM + wr * 64 + fr; const int col0 = u.pn * BM + wc * 32 + 8 * fq;
#pragma unroll
        for (int ai = 0; ai < 2; ++ai)
#pragma unroll
            for (int m = 0; m < 4; ++m) { bf16_t* rowp = O + (size_t)(row0 + ai * HALF + m * 16) * ldc + col0;
#pragma unroll
                for (int bj = 0; bj < 2; ++bj) { const f32x4 v0 = acc[ai][bj][m][0], v1 = acc[ai][bj][m][1];
                    u32x4 w; w.x = pk2(v0[0], v0[1]); w.y = pk2(v0[2], v0[3]); w.z = pk2(v1[0], v1[1]); w.w = pk2(v1[2], v1[3]);
                    *(u32x4*)(rowp + bj * HALF) = w; } }
    }
};
struct EpiResF32 {
    static constexpr bool PERM = false;
    const float* base; float* out; int ldc;
    __device__ __forceinline__ void operator()(const f32x4 (&acc)[2][2][4][2], const Unit& u, int wr, int wc, int fr, int fq) const {
        const int col0 = u.pn * BM + wc * 32 + 4 * fq;
#pragma unroll
        for (int ai = 0; ai < 2; ++ai)
#pragma unroll
            for (int m = 0; m < 4; ++m) { const size_t off = (size_t)(u.pm * BM + ai * HALF + wr * 64 + m * 16 + fr) * ldc + col0;
#pragma unroll
                for (int bj = 0; bj < 2; ++bj)
#pragma unroll
                    for (int n = 0; n < 2; ++n) { const f32x4 bs = *(const f32x4*)(base + off + bj * HALF + n * 16); *(f32x4*)(out + off + bj * HALF + n * 16) = bs + acc[ai][bj][m][n]; } }
    }
};
struct EpiSwiglu {
    static constexpr bool PERM = true;
    unsigned char* O; const float* b1; const int* tile_e;
    __device__ __forceinline__ void operator()(const f32x4 (&acc)[2][2][4][2], const Unit& u, int wr, int wc, int fr, int fq) const {
        const int e = tile_e[u.pm]; const int row0 = u.pm * BM + wr * 64 + fr; const int hc0 = u.pn * 128 + wc * 32 + 8 * fq;
        const float* bg = b1 + (size_t)e * 2048 + hc0; const float* bl = bg + 1024;
        const f32x4 g0 = *(const f32x4*)bg, g1 = *(const f32x4*)(bg + 4), l0 = *(const f32x4*)bl, l1 = *(const f32x4*)(bl + 4);
#pragma unroll
        for (int ai = 0; ai < 2; ++ai)
#pragma unroll
            for (int m = 0; m < 4; ++m) { unsigned char* rowp = O + (size_t)(row0 + ai * HALF + m * 16) * 1024 + hc0;
                float o[8];
#pragma unroll
                for (int n = 0; n < 2; ++n) { const f32x4 gv = acc[ai][0][m][n] + (n ? g1 : g0), lv = acc[ai][1][m][n] + (n ? l1 : l0);
#pragma unroll
                    for (int i = 0; i < 4; ++i) { const float g = fminf(gv[i], 7.0f), l = fminf(fmaxf(lv[i], -7.0f), 7.0f);
                        const float sg = __builtin_amdgcn_rcpf(1.0f + __builtin_amdgcn_exp2f(-1.702f * LOG2E * g)); o[n * 4 + i] = g * sg * (l + 1.0f); } }
                u32x2 w; w.x = pk4_fp8(o[0] * F8_H_MUL, o[1] * F8_H_MUL, o[2] * F8_H_MUL, o[3] * F8_H_MUL); w.y = pk4_fp8(o[4] * F8_H_MUL, o[5] * F8_H_MUL, o[6] * F8_H_MUL, o[7] * F8_H_MUL);
                *(u32x2*)rowp = w; }
    }
};
struct EpiGateBf16 {
    static constexpr bool PERM = true;
    bf16_t* O; const float* b2; const float* rowgate; const int* tile_e;
    __device__ __forceinline__ void operator()(const f32x4 (&acc)[2][2][4][2], const Unit& u, int wr, int wc, int fr, int fq) const {
        const int e = tile_e[u.pm]; const int row0 = u.pm * BM + wr * 64 + fr; const int col0 = u.pn * BM + wc * 32 + 8 * fq;
        f32x4 bv[2][2];
#pragma unroll
        for (int bj = 0; bj < 2; ++bj)
#pragma unroll
            for (int n = 0; n < 2; ++n) bv[bj][n] = *(const f32x4*)(b2 + (size_t)e * 1024 + col0 + bj * HALF + 4 * n);
#pragma unroll
        for (int ai = 0; ai < 2; ++ai)
#pragma unroll
            for (int m = 0; m < 4; ++m) { const int row = row0 + ai * HALF + m * 16; const float gt = rowgate[row]; bf16_t* rowp = O + (size_t)row * 1024 + col0;
#pragma unroll
                for (int bj = 0; bj < 2; ++bj) { const f32x4 v0 = (acc[ai][bj][m][0] + bv[bj][0]) * gt, v1 = (acc[ai][bj][m][1] + bv[bj][1]) * gt;
                    u32x4 w; w.x = pk2(v0[0], v0[1]); w.y = pk2(v0[2], v0[3]); w.z = pk2(v1[0], v1[1]); w.w = pk2(v1[2], v1[3]);
                    *(u32x4*)(rowp + bj * HALF) = w; } }
    }
};

template <bool F8, class Epi, class Sched>
__device__ __forceinline__ void gemm_phase(LAS unsigned char* lds, const Gemm g, const Sched& S, const Epi& E) {
    const int tid = threadIdx.x, wid = __builtin_amdgcn_readfirstlane(tid >> 6), lane = tid & 63, wr = wid >> 2, wc = wid & 3, fr = lane & 15, fq = lane >> 4;
    const int RB = F8 ? g.K : g.K * 2, nt = RB / 128;
    unsigned voffA[2], voffB[2];
#pragma unroll
    for (int i = 0; i < 2; ++i) { int R, C; stage_rc(tid * 16 + i * 8192, R, C); const int Rb = Epi::PERM ? ((R & ~31) + perm32(R & 31)) : R;
        voffA[i] = (unsigned)(R * RB + C * 2); voffB[i] = (unsigned)(Rb * RB + C * 2); }
    const size_t kstep = (size_t)(BK * 2);
    const size_t hstep = (size_t)HALF * RB;
    const size_t tstep = 2 * hstep;
    const unsigned ldsw = (unsigned)wid * 1024u;
    const int aoff = F8 ? lds_byte(wr * 64 + fr, (fq & 1) * 16) + (fq >> 1) * 1024 : lds_byte(wr * 64 + fr, fq * 8);
    const int boff = F8 ? lds_byte(wc * 32 + fr, (fq & 1) * 16) + (fq >> 1) * 1024 : lds_byte(wc * 32 + fr, fq * 8);
    const int scW = g.scW, scA = g.scA;
#define PG8_SA(b, h) (((b) * 2 + (h)) * HTB)
#define PG8_SB(b, h) ((4 + (b) * 2 + (h)) * HTB)
#define PG8_STAGE(bufoff, gbase, voff) do { _Pragma("unroll") for (int _i = 0; _i < 2; ++_i) \
        __builtin_amdgcn_global_load_lds((const unsigned*)((const char*)(gbase) + (voff)[_i]), (LAS unsigned*)(lds + (bufoff) + ldsw + _i * 8192), 16, 0, 0); } while (0)
typedef int v8i32a __attribute__((ext_vector_type(8), aligned(16)));
#define PG8_LD32(p) (*(const LAS v8i32a*)(p))
#define PG8_LDA(dst, b, h) do { _Pragma("unroll") for (int m = 0; m < 4; ++m) { if constexpr (F8) { dst[m].f8 = __builtin_bit_cast(v8i32, PG8_LD32(lds + PG8_SA(b, h) + aoff + m * 2048)); } \
        else { _Pragma("unroll") for (int k = 0; k < 2; ++k) dst[m].hv[k] = *(const LAS bf16x8*)(lds + PG8_SA(b, h) + aoff + m * 2048 + k * 1024); } } } while (0)
#define PG8_LDB(dst, b, h) do { _Pragma("unroll") for (int n = 0; n < 2; ++n) { if constexpr (F8) { dst[n].f8 = __builtin_bit_cast(v8i32, PG8_LD32(lds + PG8_SB(b, h) + boff + n * 2048)); } \
        else { _Pragma("unroll") for (int k = 0; k < 2; ++k) dst[n].hv[k] = *(const LAS bf16x8*)(lds + PG8_SB(b, h) + boff + n * 2048 + k * 1024); } } } while (0)
#define PG8_MMA(ai, bj, At, Bt) do { __builtin_amdgcn_s_setprio(1); _Pragma("unroll") for (int m = 0; m < 4; ++m) _Pragma("unroll") for (int n = 0; n < 2; ++n) { \
        if constexpr (F8) { asm volatile("v_mfma_scale_f32_16x16x128_f8f6f4 %0, %1, %2, %0, %3, %4 op_sel_hi:[0,0,0]" : "+v"(acc[ai][bj][m][n]) : "v"(Bt[n].f8), "v"(At[m].f8), "v"(scW), "v"(scA)); } \
        else { _Pragma("unroll") for (int k = 0; k < 2; ++k) acc[ai][bj][m][n] = __builtin_amdgcn_mfma_f32_16x16x32_bf16(Bt[n].hv[k], At[m].hv[k], acc[ai][bj][m][n], 0, 0, 0); } } \
        __builtin_amdgcn_s_setprio(0); } while (0)
#define PG8_WAIT_V(n) asm volatile("s_waitcnt vmcnt(" #n ")" ::: "memory")
#define PG8_WAIT_L(n) asm volatile("s_waitcnt lgkmcnt(" #n ")" ::: "memory")
#define PG8_BAR __builtin_amdgcn_s_barrier()
#define PG8_SCHED __builtin_amdgcn_sched_barrier(0)
    Unit cur, nxt; int ui = 0;
    if (!S.next(0, cur)) return;
    f32x4 acc[2][2][4][2];
#pragma unroll
    for (int a = 0; a < 2; ++a)
#pragma unroll
        for (int b = 0; b < 2; ++b)
#pragma unroll
            for (int m = 0; m < 4; ++m)
#pragma unroll
                for (int n = 0; n < 2; ++n) acc[a][b][m][n] = (f32x4){0.f, 0.f, 0.f, 0.f};
    struct FragH { bf16x8 hv[2]; }; struct Frag8 { v8i32 f8; };
    typename std::conditional<F8, Frag8, FragH>::type At[4], B0[2], B1[2];
    const char* cA = (const char*)g.A + (size_t)cur.pm * tstep; const char* cB = (const char*)g.Bt + (size_t)cur.pb * tstep;
    PG8_STAGE(PG8_SB(0, 0), cB, voffB); PG8_STAGE(PG8_SB(0, 1), cB + hstep, voffB); PG8_STAGE(PG8_SA(0, 0), cA, voffA); PG8_STAGE(PG8_SA(0, 1), cA + hstep, voffA);
    if (wr == 1) PG8_BAR;
    PG8_WAIT_V(2); PG8_BAR;
    PG8_STAGE(PG8_SB(1, 0), cB + kstep, voffB); PG8_STAGE(PG8_SA(1, 0), cA + kstep, voffA); PG8_STAGE(PG8_SB(1, 1), cB + hstep + kstep, voffB);
    PG8_WAIT_V(6); PG8_BAR;
    for (;;) {
        const bool has_next = S.next(ui + 1, nxt);
        const char* nA = has_next ? (const char*)g.A + (size_t)nxt.pm * tstep : cA; const char* nB = has_next ? (const char*)g.Bt + (size_t)nxt.pb * tstep : cB;
#pragma clang loop unroll(disable)
        for (int t = 0; t < nt; t += 2) {
            const bool last = (t == nt - 2);
            const char* a1 = cA + (size_t)(t + 1) * kstep;
            const char* a2 = last ? nA : cA + (size_t)(t + 2) * kstep; const char* b2 = last ? nB : cB + (size_t)(t + 2) * kstep;
            const char* a3 = a2 + kstep; const char* b3 = b2 + kstep;
            PG8_LDB(B0, 0, 0); PG8_LDB(B1, 0, 1); PG8_SCHED; PG8_LDA(At, 0, 0); PG8_STAGE(PG8_SA(1, 1), a1 + hstep, voffA);
            PG8_WAIT_V(8); PG8_WAIT_L(0); PG8_BAR; PG8_MMA(0, 0, At, B0); PG8_MMA(0, 1, At, B1); PG8_BAR; PG8_SCHED;
            PG8_LDA(At, 0, 1); PG8_STAGE(PG8_SB(0, 0), b2, voffB); PG8_STAGE(PG8_SB(0, 1), b2 + hstep, voffB); PG8_STAGE(PG8_SA(0, 0), a2, voffA);
            PG8_WAIT_V(8); PG8_WAIT_L(0); PG8_BAR; PG8_MMA(1, 0, At, B0); PG8_MMA(1, 1, At, B1); PG8_BAR; PG8_SCHED;
            PG8_LDB(B0, 1, 0); PG8_LDB(B1, 1, 1); PG8_SCHED; PG8_LDA(At, 1, 0); PG8_STAGE(PG8_SA(0, 1), a2 + hstep, voffA);
            PG8_WAIT_V(8); PG8_WAIT_L(0); PG8_BAR; PG8_MMA(0, 0, At, B0); PG8_MMA(0, 1, At, B1); PG8_BAR; PG8_SCHED;
            PG8_LDA(At, 1, 1); PG8_STAGE(PG8_SB(1, 0), b3, voffB); PG8_STAGE(PG8_SB(1, 1), b3 + hstep, voffB); PG8_STAGE(PG8_SA(1, 0), a3, voffA);
            PG8_WAIT_V(8); PG8_WAIT_L(0); PG8_BAR; PG8_MMA(1, 0, At, B0); PG8_MMA(1, 1, At, B1); PG8_BAR; PG8_SCHED;
        }
        if (wr == 0) PG8_BAR;
        if constexpr (F8) asm volatile("s_nop 15\n\ts_nop 15" ::: "memory");
        E(acc, cur, wr, wc, fr, fq);
        if (!has_next) break;
#pragma unroll
        for (int a = 0; a < 2; ++a)
#pragma unroll
            for (int b = 0; b < 2; ++b)
#pragma unroll
                for (int m = 0; m < 4; ++m)
#pragma unroll
                    for (int n = 0; n < 2; ++n) acc[a][b][m][n] = (f32x4){0.f, 0.f, 0.f, 0.f};
        cur = nxt; cA = nA; cB = nB; ++ui;
        if (wr == 1) PG8_BAR;
    }
    PG8_WAIT_V(0);
    PG8_BAR;
#undef PG8_SA
#undef PG8_SB
#undef PG8_STAGE
#undef PG8_LDA
#undef PG8_LDB
#undef PG8_MMA
#undef PG8_LD32
#undef PG8_WAIT_V
#undef PG8_WAIT_L
#undef PG8_BAR
#undef PG8_SCHED
}
}

struct Args { const float* in[30]; float* out; unsigned char* ws; int ph_lo, ph_hi; };

__device__ __forceinline__ void p0_transpose_item(const float* W, int K, int N, bf16_t* WT, int k0, int n0, int drow0, LAS float* scr, int lane) {
#pragma unroll 8
    for (int i = 0; i < 32; ++i) { const int kk = 2 * i + (lane >> 5); scr[kk * 33 + (lane & 31)] = W[(size_t)(k0 + kk) * N + n0 + (lane & 31)]; }
    asm volatile("s_waitcnt lgkmcnt(0)" ::: "memory");
    const int c = lane & 7;
#pragma unroll
    for (int j = 0; j < 4; ++j) { const int n = (lane >> 3) + 8 * j; const LAS float* s = scr + (8 * c) * 33 + n;
        u32x4 o; o.x = pk2(s[0 * 33], s[1 * 33]); o.y = pk2(s[2 * 33], s[3 * 33]); o.z = pk2(s[4 * 33], s[5 * 33]); o.w = pk2(s[6 * 33], s[7 * 33]);
        *(u32x4*)(WT + (size_t)(drow0 + n) * K + k0 + 8 * c) = o; }
    asm volatile("s_waitcnt lgkmcnt(0)" ::: "memory");
}
__device__ __forceinline__ void p0_transpose_item_f8(const float* W, int K, int N, unsigned char* WT, int k0, int n0, int drow0, LAS float* scr, int lane) {
#pragma unroll 8
    for (int i = 0; i < 32; ++i) { const int kk = 2 * i + (lane >> 5); scr[kk * 33 + (lane & 31)] = W[(size_t)(k0 + kk) * N + n0 + (lane & 31)]; }
    asm volatile("s_waitcnt lgkmcnt(0)" ::: "memory");
    const int c = lane & 3;
#pragma unroll
    for (int j = 0; j < 2; ++j) { const int n = (lane >> 2) + 16 * j; const LAS float* s = scr + (16 * c) * 33 + n;
        u32x4 o;
        o.x = pk4_fp8(s[0 * 33] * F8_W_MUL, s[1 * 33] * F8_W_MUL, s[2 * 33] * F8_W_MUL, s[3 * 33] * F8_W_MUL);
        o.y = pk4_fp8(s[4 * 33] * F8_W_MUL, s[5 * 33] * F8_W_MUL, s[6 * 33] * F8_W_MUL, s[7 * 33] * F8_W_MUL);
        o.z = pk4_fp8(s[8 * 33] * F8_W_MUL, s[9 * 33] * F8_W_MUL, s[10 * 33] * F8_W_MUL, s[11 * 33] * F8_W_MUL);
        o.w = pk4_fp8(s[12 * 33] * F8_W_MUL, s[13 * 33] * F8_W_MUL, s[14 * 33] * F8_W_MUL, s[15 * 33] * F8_W_MUL);
        *(u32x4*)(WT + (size_t)(drow0 + n) * K + k0 + 16 * c) = o; }
    asm volatile("s_waitcnt lgkmcnt(0)" ::: "memory");
}
__device__ __forceinline__ void p0_prologue(LAS unsigned char* lds, const Args& a, int G) {
    const int tid = threadIdx.x, lane = tid & 63, wave = __builtin_amdgcn_readfirstlane(tid >> 6);
    LAS float* scr = (LAS float*)(lds + wave * 16384);
    const int gw = blockIdx.x * 8 + wave, NGW = G * 8;
    unsigned char* ws = a.ws;
    bf16_t* Wint = (bf16_t*)(ws + WS_WINT); bf16_t* Woutt = (bf16_t*)(ws + WS_WOUT); unsigned char* W1t = ws + WS_W1T; unsigned char* W2t = ws + WS_W2T;
    constexpr int I_IN = 16 * (NIN / 32);
    constexpr int I_OUT = 16 * 32;
    constexpr int I_W1 = 16 * 64;
    constexpr int I_W2 = 16 * 32;
    constexpr int NITEMS = I_IN + I_OUT + NE * I_W1 + NE * I_W2;
    for (int it = gw; it < NITEMS; it += NGW) {
        int r = it;
        if (r < I_IN) { const int nblk = NIN / 32, kb = r / nblk, nb = r % nblk; p0_transpose_item(a.in[2], 1024, NIN, Wint, 64 * kb, 32 * nb, 32 * nb, scr, lane); continue; } r -= I_IN;
        if (r < I_OUT) { const int kb = r / 32, nb = r % 32; p0_transpose_item(a.in[22], 1024, 1024, Woutt, 64 * kb, 32 * nb, 32 * nb, scr, lane); continue; } r -= I_OUT;
        if (r < NE * I_W1) { const int e = r / I_W1, q = r % I_W1, kb = q / 64, nb = q % 64; const int n0 = 32 * nb;
            const int drow = (n0 < 1024) ? ((n0 >> 7) * 256 + (n0 & 127)) : (((n0 - 1024) >> 7) * 256 + 128 + ((n0 - 1024) & 127));
            p0_transpose_item_f8(a.in[26] + (size_t)e * 1024 * 2048, 1024, 2048, W1t + (size_t)e * 2048 * 1024, 64 * kb, n0, drow, scr, lane); continue; } r -= NE * I_W1;
        { const int e = r / I_W2, q = r % I_W2, kb = q / 32, nb = q % 32;
            p0_transpose_item_f8(a.in[28] + (size_t)e * 1024 * 1024, 1024, 1024, W2t + (size_t)e * 1024 * 1024, 64 * kb, 32 * nb, 32 * nb, scr, lane); }
    }
    const float* x = a.in[0]; const float* g1 = a.in[1]; bf16_t* XN = (bf16_t*)(ws + WS_XN);
    f32x4 gv[4];
#pragma unroll
    for (int j = 0; j < 4; ++j) gv[j] = *((const f32x4*)g1 + lane + 64 * j);
    for (int m = gw; m < T; m += NGW) {
        const f32x4* xr = (const f32x4*)(x + (size_t)m * D) + lane;
        f32x4 v[4]; float s = 0.f;
#pragma unroll
        for (int j = 0; j < 4; ++j) { v[j] = xr[64 * j]; s += (v[j].x * v[j].x + v[j].y * v[j].y) + (v[j].z * v[j].z + v[j].w * v[j].w); }
        const float rstd = 1.0f / sqrtf(wave_sum(s) * (1.0f / D) + 1e-5f);
        u32x2* o8 = (u32x2*)(XN + (size_t)m * D) + lane;
#pragma unroll
        for (int j = 0; j < 4; ++j) { u32x2 w; w.x = pk2(v[j].x * rstd * gv[j].x, v[j].y * rstd * gv[j].y); w.y = pk2(v[j].z * rstd * gv[j].z, v[j].w * rstd * gv[j].w); o8[64 * j] = w; }
    }
}

__device__ __forceinline__ f32x4 cvlo(const u32x4 u) { return (f32x4){bflo(u.x), bfhi(u.x), bflo(u.y), bfhi(u.y)}; }
__device__ __forceinline__ f32x4 cvhi(const u32x4 u) { return (f32x4){bflo(u.z), bfhi(u.z), bflo(u.w), bfhi(u.w)}; }
__device__ __forceinline__ u32x4 pk8(const f32x4 lo, const f32x4 hi) { u32x4 w; w.x = pk2(lo.x, lo.y); w.y = pk2(lo.z, lo.w); w.z = pk2(hi.x, hi.y); w.w = pk2(hi.z, hi.w); return w; }
__device__ __forceinline__ void p2_prep(LAS unsigned char* lds, const Args& a) {
    const int tid = threadIdx.x, lane = tid & 63, wave = __builtin_amdgcn_readfirstlane(tid >> 6);
    unsigned char* ws = a.ws;
    const bf16_t* P = (const bf16_t*)(ws + WS_P);
    bf16_t* SR = (bf16_t*)(ws + WS_SR); bf16_t* SK = (bf16_t*)(ws + WS_SK); bf16_t* SV = (bf16_t*)(ws + WS_SV); bf16_t* SA = (bf16_t*)(ws + WS_SA); bf16_t* SB = (bf16_t*)(ws + WS_SB);
    float* SW = (float*)(ws + WS_SW); bf16_t* SG = (bf16_t*)(ws + WS_SG); bf16_t* QN = (bf16_t*)(ws + WS_QN); bf16_t* KN = (bf16_t*)(ws + WS_KN);
    const float* mu = a.in[3]; const float* w0 = a.in[4]; const float* w2 = a.in[5]; const float* a0 = a.in[6]; const float* a2 = a.in[7]; const float* g2 = a.in[8];
    const float* k_k = a.in[9]; const float* k_a = a.in[10]; const float* qn_g = a.in[14]; const float* kn_g = a.in[15];
    LAS unsigned char* ACT = lds;
    LAS float* DEC = (LAS float*)(lds + 8192); LAS float* ALR = (LAS float*)(lds + 40960); LAS float* GG = (LAS float*)(lds + 73728);
    bf16x8 bw[4][5];
    const int fcol = lane & 15, fk = (lane >> 4) * 8;
#pragma unroll
    for (int cb = 0; cb < 4; ++cb) {
        const int col = wave * 64 + cb * 16 + fcol;
#pragma unroll
        for (int kb = 0; kb < 5; ++kb) {
            const float* src = (kb == 0) ? (w2 + (size_t)fk * CW + col) : (kb == 1) ? (a2 + (size_t)fk * CW + col) : (g2 + (size_t)((kb - 2) * 32 + fk) * CW + col);
            u32x4 w; w.x = pk2(src[0], src[CW]); w.y = pk2(src[2 * CW], src[3 * CW]); w.z = pk2(src[4 * CW], src[5 * CW]); w.w = pk2(src[6 * CW], src[7 * CW]);
            bw[cb][kb] = __builtin_bit_cast(bf16x8, w);
        }
    }
    float w0c[4], a0c[4];
#pragma unroll
    for (int cb = 0; cb < 4; ++cb) { w0c[cb] = w0[wave * 64 + cb * 16 + fcol]; a0c[cb] = a0[wave * 64 + cb * 16 + fcol]; }
    const int c8 = lane * 8;
    const int TPB = T / (int)gridDim.x;
    const int tb0 = blockIdx.x * TPB;
    for (int t0 = tb0; t0 < tb0 + TPB; t0 += 16) {
        if (tid < 320) {
            const int tok = tid / 20, ch = tid - tok * 20, t = t0 + tok, col = 1536 + ch * 8;
            const u32x4 cu = *(const u32x4*)(P + (size_t)t * NINP + col);
            u32x4 pu = (u32x4){0u, 0u, 0u, 0u};
            if (t & (SEQ - 1)) pu = *(const u32x4*)(P + (size_t)(t - 1) * NINP + col);
            const f32x4 m0 = *(const f32x4*)(mu + col), m1 = *(const f32x4*)(mu + col + 4);
            const f32x4 c0 = cvlo(cu), c1 = cvhi(cu), p0 = cvlo(pu), p1 = cvhi(pu);
            f32x4 s0 = c0 + (p0 - c0) * m0, s1 = c1 + (p1 - c1) * m1;
            if (ch < 4) {
#pragma unroll
                for (int i = 0; i < 4; ++i) { const float e0 = __expf(-2.0f * fabsf(s0[i])), e1 = __expf(-2.0f * fabsf(s1[i])); const float th0 = (1.0f - e0) / (1.0f + e0), th1 = (1.0f - e1) / (1.0f + e1);
                    s0[i] = s0[i] < 0.f ? -th0 : th0; s1[i] = s1[i] < 0.f ? -th1 : th1; }
            } else if (ch >= 8) {
#pragma unroll
                for (int i = 0; i < 4; ++i) { s0[i] = sigmoidf_(s0[i]); s1[i] = sigmoidf_(s1[i]); }
            }
            *(LAS u32x4*)(ACT + tok * 320 + ch * 16) = pk8(s0, s1);
        }
        __syncthreads();
        {
            bf16x8 af[5];
#pragma unroll
            for (int kb = 0; kb < 5; ++kb) af[kb] = *(const LAS bf16x8*)(ACT + fcol * 320 + kb * 64 + (lane >> 4) * 16);
#pragma unroll
            for (int cb = 0; cb < 4; ++cb) {
                const f32x4 z = {0.f, 0.f, 0.f, 0.f};
                const f32x4 aw = __builtin_amdgcn_mfma_f32_16x16x32_bf16(af[0], bw[cb][0], z, 0, 0, 0);
                const f32x4 aa = __builtin_amdgcn_mfma_f32_16x16x32_bf16(af[1], bw[cb][1], z, 0, 0, 0);
                f32x4 ag = __builtin_amdgcn_mfma_f32_16x16x32_bf16(af[2], bw[cb][2], z, 0, 0, 0);
                ag = __builtin_amdgcn_mfma_f32_16x16x32_bf16(af[3], bw[cb][3], ag, 0, 0, 0);
                ag = __builtin_amdgcn_mfma_f32_16x16x32_bf16(af[4], bw[cb][4], ag, 0, 0, 0);
                const int col = wave * 64 + cb * 16 + fcol;
#pragma unroll
                for (int i = 0; i < 4; ++i) { const int row = (lane >> 4) * 4 + i;
                    DEC[row * 512 + col] = __expf(-0.6065306597126334f * sigmoidf_(aw[i] + w0c[cb]));
                    ALR[row * 512 + col] = sigmoidf_(aa[i] + a0c[cb]);
                    GG[row * 512 + col] = ag[i]; }
            }
        }
        __syncthreads();
#pragma unroll 1
        for (int q = 0; q < 2; ++q) {
            const int tok = 2 * wave + q, t = t0 + tok; const size_t o = (size_t)t * CW + c8;
            const bf16_t* pr = P + (size_t)t * NINP + c8;
            const bool first = (t & (SEQ - 1)) == 0;
            const u32x4 zz = (u32x4){0u, 0u, 0u, 0u};
            { const u32x4 cu = *(const u32x4*)(pr), pu = first ? zz : *(const u32x4*)(pr - NINP);
              const f32x4 m0 = *(const f32x4*)(mu + c8), m1 = *(const f32x4*)(mu + c8 + 4);
              const f32x4 c0 = cvlo(cu), c1 = cvhi(cu), p0 = cvlo(pu), p1 = cvhi(pu);
              *(u32x4*)(SR + o) = pk8(c0 + (p0 - c0) * m0, c1 + (p1 - c1) * m1); }
            { const u32x4 cu = *(const u32x4*)(pr + 1024), pu = first ? zz : *(const u32x4*)(pr - NINP + 1024);
              const f32x4 m0 = *(const f32x4*)(mu + 1024 + c8), m1 = *(const f32x4*)(mu + 1024 + c8 + 4);
              const f32x4 c0 = cvlo(cu), c1 = cvhi(cu), p0 = cvlo(pu), p1 = cvhi(pu);
              *(u32x4*)(SV + o) = pk8(c0 + (p0 - c0) * m0, c1 + (p1 - c1) * m1); }
            { const u32x4 cu = *(const u32x4*)(pr + 512), pu = first ? zz : *(const u32x4*)(pr - NINP + 512);
              const f32x4 m0 = *(const f32x4*)(mu + 512 + c8), m1 = *(const f32x4*)(mu + 512 + c8 + 4);
              const f32x4 c0 = cvlo(cu), c1 = cvhi(cu), p0 = cvlo(pu), p1 = cvhi(pu);
              const f32x4 k0 = c0 + (p0 - c0) * m0, k1 = c1 + (p1 - c1) * m1;
              const f32x4 kk0 = k0 * *(const f32x4*)(k_k + c8), kk1 = k1 * *(const f32x4*)(k_k + c8 + 4);
              float ss = (kk0.x * kk0.x + kk0.y * kk0.y) + (kk0.z * kk0.z + kk0.w * kk0.w) + (kk1.x * kk1.x + kk1.y * kk1.y) + (kk1.z * kk1.z + kk1.w * kk1.w);
              ss = red8(ss);
              const float inv = 1.0f / sqrtf(fmaxf(ss, 1e-24f));
              const f32x4 kn0 = kk0 * inv, kn1 = kk1 * inv;
              const f32x4 al0 = *(const LAS f32x4*)(ALR + tok * 512 + c8), al1 = *(const LAS f32x4*)(ALR + tok * 512 + c8 + 4);
              const f32x4 k20 = k0 * (1.0f + (al0 - 1.0f) * *(const f32x4*)(k_a + c8)), k21 = k1 * (1.0f + (al1 - 1.0f) * *(const f32x4*)(k_a + c8 + 4));
              *(u32x4*)(SK + o) = pk8(k20, k21); *(u32x4*)(SA + o) = pk8(-kn0, -kn1); *(u32x4*)(SB + o) = pk8(kn0 * al0, kn1 * al1); }
            { const f32x4 de0 = *(const LAS f32x4*)(DEC + tok * 512 + c8), de1 = *(const LAS f32x4*)(DEC + tok * 512 + c8 + 4);
              const f32x4 gg0 = *(const LAS f32x4*)(GG + tok * 512 + c8), gg1 = *(const LAS f32x4*)(GG + tok * 512 + c8 + 4);
              *(u32x4*)(SG + o) = pk8(gg0, gg1); *(f32x4*)(SW + o) = de0; *(f32x4*)(SW + o + 4) = de1; }
            { const u32x4 uq = *(const u32x4*)(pr + DQ0), ukd = *(const u32x4*)(pr + DK0);
              const f32x4 q0 = cvlo(uq), q1 = cvhi(uq), d0 = cvlo(ukd), d1 = cvhi(ukd);
              float qs = (q0.x * q0.x + q0.y * q0.y) + (q0.z * q0.z + q0.w * q0.w) + (q1.x * q1.x + q1.y * q1.y) + (q1.z * q1.z + q1.w * q1.w);
              float ks = (d0.x * d0.x + d0.y * d0.y) + (d0.z * d0.z + d0.w * d0.w) + (d1.x * d1.x + d1.y * d1.y) + (d1.z * d1.z + d1.w * d1.w);
              qs = red8(qs); ks = red8(ks);
              const float qi = (1.0f / sqrtf(qs * (1.0f / 64.0f) + 1e-5f)) * (0.125f * LOG2E), ki = 1.0f / sqrtf(ks * (1.0f / 64.0f) + 1e-5f);
              const f32x4 g0 = *(const f32x4*)(qn_g + (c8 & 63)), g1 = *(const f32x4*)(qn_g + (c8 & 63) + 4), h0 = *(const f32x4*)(kn_g + (c8 & 63)), h1 = *(const f32x4*)(kn_g + (c8 & 63) + 4);
              *(u32x4*)(QN + o) = pk8(q0 * qi * g0, q1 * qi * g1);
              *(u32x4*)(KN + o) = pk8(d0 * ki * h0, d1 * ki * h1); }
        }
        __syncthreads();
    }
}

__device__ __forceinline__ float red16(float v) {
    v += dpp_f<0xB1>(v); v += dpp_f<0x4E>(v); v += dpp_f<0x141>(v); v += dpp_f<0x140>(v);
    return v;
}
__device__ __forceinline__ void p3_scan(LAS unsigned char* lds, const Args& a) {
    const int tid = threadIdx.x, lane = tid & 63, wave = __builtin_amdgcn_readfirstlane(tid >> 6);
    unsigned char* ws = a.ws;
    const bf16_t* SR = (const bf16_t*)(ws + WS_SR); const bf16_t* SK = (const bf16_t*)(ws + WS_SK); const bf16_t* SV = (const bf16_t*)(ws + WS_SV);
    const bf16_t* SA = (const bf16_t*)(ws + WS_SA); const bf16_t* SB = (const bf16_t*)(ws + WS_SB); const float* SW = (const float*)(ws + WS_SW);
    float* YRAW = (float*)(ws + WS_YRAW);
    const int bh = blockIdx.x >> 1, half = blockIdx.x & 1;
    const int b = bh >> 3, h = bh & 7, tok0 = b * SEQ, col0 = h * 64, row0 = half * 32;
    constexpr int BUFB = 45056;
    LAS float* buf0 = (LAS float*)lds; LAS float* buf1 = (LAS float*)(lds + BUFB);
    LAS float* Y0 = (LAS float*)(lds + 2 * BUFB); LAS float* Y1 = Y0 + 1024;
    constexpr int NCH = SEQ / 32;
    if (wave >= 4) {
        const int lw = wave - 4, sl = lw * 8 + (lane >> 3), cg = lane & 7, c8 = cg * 8;
        f32x4 w0_, w1_; u32x4 uk, ua, ub, ur; u32x2 uv;
#define SC_ISSUE(ch) do { const size_t o_ = (size_t)(tok0 + (ch) * 32 + sl) * CW + col0; \
            w0_ = *(const f32x4*)(SW + o_ + c8); w1_ = *(const f32x4*)(SW + o_ + c8 + 4); uk = *(const u32x4*)(SK + o_ + c8); ua = *(const u32x4*)(SA + o_ + c8); ub = *(const u32x4*)(SB + o_ + c8); ur = *(const u32x4*)(SR + o_ + c8); \
            uv = *(const u32x2*)(SV + o_ + row0 + 4 * cg); } while (0)
#define SC_STORE(bufp) do { LAS float* d_ = (bufp) + sl * 64 + c8; *(LAS f32x4*)(d_) = w0_; *(LAS f32x4*)(d_ + 4) = w1_; \
            *(LAS f32x4*)(d_ + 2048) = cvlo(uk); *(LAS f32x4*)(d_ + 2052) = cvhi(uk); *(LAS f32x4*)(d_ + 4096) = cvlo(ua); *(LAS f32x4*)(d_ + 4100) = cvhi(ua); \
            *(LAS f32x4*)(d_ + 6144) = cvlo(ub); *(LAS f32x4*)(d_ + 6148) = cvhi(ub); *(LAS f32x4*)(d_ + 8192) = cvlo(ur); *(LAS f32x4*)(d_ + 8196) = cvhi(ur); \
            *(LAS f32x4*)((bufp) + 10240 + sl * 32 + 4 * cg) = (f32x4){bflo(uv.x), bfhi(uv.x), bflo(uv.y), bfhi(uv.y)}; } while (0)
#define SC_YOUT(ch, yp) do { *(f32x4*)(YRAW + (size_t)(tok0 + (ch) * 32 + sl) * CW + col0 + row0 + 4 * cg) = *(const LAS f32x4*)((yp) + sl * 32 + 4 * cg); } while (0)
        SC_ISSUE(0); SC_STORE(buf0);
        __syncthreads();
        for (int ch = 0; ch < NCH; ++ch) {
            LAS float* ob = (ch & 1) ? buf0 : buf1; const LAS float* oy = (ch & 1) ? Y0 : Y1;
            if (ch + 1 < NCH) SC_ISSUE(ch + 1);
            if (ch > 0) SC_YOUT(ch - 1, oy);
            if (ch + 1 < NCH) SC_STORE(ob);
            __syncthreads();
        }
        { const LAS float* oy = ((NCH - 1) & 1) ? Y1 : Y0; SC_YOUT(NCH - 1, oy); }
#undef SC_ISSUE
#undef SC_STORE
#undef SC_YOUT
    } else {
        const int g = lane & 7, rl = lane >> 3, row = wave * 8 + rl;
        f32x2 S0 = {0.f, 0.f}, S1 = S0, S2 = S0, S3 = S0;
        __syncthreads();
        for (int ch = 0; ch < NCH; ++ch) {
            const LAS float* cb = (ch & 1) ? buf1 : buf0; LAS float* yb = (ch & 1) ? Y1 : Y0;
            const LAS float* pa = cb + 4 * g; const LAS float* pv = cb + 10240 + row;
#define SC_LD(X, s_) const f32x4 w0##X = *(const LAS f32x4*)(pa + (s_) * 64), w1##X = *(const LAS f32x4*)(pa + (s_) * 64 + 32), k0##X = *(const LAS f32x4*)(pa + (s_) * 64 + 2048), k1##X = *(const LAS f32x4*)(pa + (s_) * 64 + 2080), \
                a0##X = *(const LAS f32x4*)(pa + (s_) * 64 + 4096), a1##X = *(const LAS f32x4*)(pa + (s_) * 64 + 4128), b0##X = *(const LAS f32x4*)(pa + (s_) * 64 + 6144), b1##X = *(const LAS f32x4*)(pa + (s_) * 64 + 6176), \
                r0##X = *(const LAS f32x4*)(pa + (s_) * 64 + 8192), r1##X = *(const LAS f32x4*)(pa + (s_) * 64 + 8224); const float v##X = pv[(s_) * 32]
#define LO(q) ((f32x2){(q).x, (q).y})
#define HI(q) ((f32x2){(q).z, (q).w})
#define SC_STEP(X, s_) do { f32x2 t = S0 * LO(a0##X); t = S1 * HI(a0##X) + t; t = S2 * LO(a1##X) + t; t = S3 * HI(a1##X) + t; float sa = t.x + t.y; \
                const f32x2 vv = {v##X, v##X}; \
                f32x2 p0 = S0 * LO(w0##X), p1 = S1 * HI(w0##X), p2 = S2 * LO(w1##X), p3 = S3 * HI(w1##X); \
                p0 = vv * LO(k0##X) + p0; p1 = vv * HI(k0##X) + p1; p2 = vv * LO(k1##X) + p2; p3 = vv * HI(k1##X) + p3; \
                sa = red8(sa); const f32x2 ss = {sa, sa}; \
                S0 = ss * LO(b0##X) + p0; S1 = ss * HI(b0##X) + p1; S2 = ss * LO(b1##X) + p2; S3 = ss * HI(b1##X) + p3; \
                f32x2 u = S0 * LO(r0##X); u = S1 * HI(r0##X) + u; u = S2 * LO(r1##X) + u; u = S3 * HI(r1##X) + u; float y = u.x + u.y; y = red8(y); \
                yb[(s_) * 32 + row] = y; } while (0)
#pragma unroll 1
            for (int s8 = 0; s8 < 32; s8 += 8) {
                SC_LD(0, s8 + 0); SC_LD(1, s8 + 1);
                SC_STEP(0, s8 + 0); SC_LD(2, s8 + 2);
                SC_STEP(1, s8 + 1); SC_LD(3, s8 + 3);
                SC_STEP(2, s8 + 2); SC_LD(4, s8 + 4);
                SC_STEP(3, s8 + 3); SC_LD(5, s8 + 5);
                SC_STEP(4, s8 + 4); SC_LD(6, s8 + 6);
                SC_STEP(5, s8 + 5); SC_LD(7, s8 + 7);
                SC_STEP(6, s8 + 6);
                SC_STEP(7, s8 + 7);
            }
#undef SC_LD
#undef LO
#undef HI
#undef SC_STEP
            __syncthreads();
        }
    }
}

__device__ __forceinline__ void p3_post(const Args& a, int G) {
    const int tid = threadIdx.x, lane = tid & 63, wave = __builtin_amdgcn_readfirstlane(tid >> 6);
    unsigned char* ws = a.ws;
    const bf16_t* SR = (const bf16_t*)(ws + WS_SR); const bf16_t* SK = (const bf16_t*)(ws + WS_SK); const bf16_t* SV = (const bf16_t*)(ws + WS_SV);
    const bf16_t* SG = (const bf16_t*)(ws + WS_SG); const float* YRAW = (const float*)(ws + WS_YRAW); bf16_t* YMIX = (bf16_t*)(ws + WS_YMIX);
    const int gw = blockIdx.x * 8 + wave, NGW = G * 8, c8 = lane * 8;
    const f32x4 lg0 = *(const f32x4*)(a.in[12] + c8), lg1 = *(const f32x4*)(a.in[12] + c8 + 4), lb0 = *(const f32x4*)(a.in[13] + c8), lb1 = *(const f32x4*)(a.in[13] + c8 + 4);
    const f32x4 rk0 = *(const f32x4*)(a.in[11] + c8), rk1 = *(const f32x4*)(a.in[11] + c8 + 4);
    for (int t = gw; t < T; t += NGW) {
        const size_t o = (size_t)t * CW + c8;
        const f32x4 y0 = *(const f32x4*)(YRAW + o), y1 = *(const f32x4*)(YRAW + o + 4);
        const u32x4 ur = *(const u32x4*)(SR + o), uk = *(const u32x4*)(SK + o), uv = *(const u32x4*)(SV + o), ug = *(const u32x4*)(SG + o);
        const float mean = red8((y0.x + y0.y) + (y0.z + y0.w) + (y1.x + y1.y) + (y1.z + y1.w)) * (1.0f / 64.0f);
        const f32x4 d0 = y0 - mean, d1 = y1 - mean;
        const float var = red8((d0.x * d0.x + d0.y * d0.y) + (d0.z * d0.z + d0.w * d0.w) + (d1.x * d1.x + d1.y * d1.y) + (d1.z * d1.z + d1.w * d1.w)) * (1.0f / 64.0f);
        const f32x4 r0 = cvlo(ur), r1 = cvhi(ur), k0 = cvlo(uk), k1 = cvhi(uk);
        const f32x4 p0 = r0 * k0 * rk0, p1 = r1 * k1 * rk1;
        const float rk = red8((p0.x + p0.y) + (p0.z + p0.w) + (p1.x + p1.y) + (p1.z + p1.w));
        const float rs = 1.0f / sqrtf(var + 64e-5f);
        const f32x4 o0 = (d0 * rs * lg0 + lb0 + rk * cvlo(uv)) * cvlo(ug), o1 = (d1 * rs * lg1 + lb1 + rk * cvhi(uv)) * cvhi(ug);
        *(u32x4*)(YMIX + (size_t)t * D + c8) = pk8(o0, o1);
    }
}

namespace att {
constexpr int SLOT = 32768, OFF_V = 16384;
constexpr int TBL_OFF = MISC_OFF + 1024;
constexpr int LW_OFF = MISC_OFF + 2048;
constexpr int CST_OFF = MISC_OFF + 3072;
__device__ __forceinline__ int crow(int r, int hi) { return (r & 3) + 8 * (r >> 2) + 4 * hi; }
__device__ __forceinline__ void glds16(const void* gsrc, unsigned lds_dst) { unsigned keep;
    asm volatile("s_mov_b32 %0, m0\n\ts_mov_b32 m0, %2\n\ts_nop 0\n\tglobal_load_lds_dwordx4 %1, off\n\ts_mov_b32 m0, %0" : "=&s"(keep) : "v"(gsrc), "s"(lds_dst) : "memory"); }
__device__ __forceinline__ s16x4 vtr(const LAS unsigned char* p) { return __builtin_bit_cast(s16x4, __builtin_amdgcn_ds_read_tr16_b64_v4i16((LAS s16x4*)p)); }

__device__ __forceinline__ void attn_unit(LAS unsigned char* lds, const Args& a, int b, int h, int qb, float negM, float lam) {
    const int tid = threadIdx.x, lane = tid & 63, r32 = lane & 31, hi = lane >> 5; const int wid = __builtin_amdgcn_readfirstlane(tid >> 6);
    const int c = wid >> 2, rg = wid & 3;
    unsigned char* ws = a.ws;
    const bf16_t* QN = (const bf16_t*)(ws + WS_QN); const bf16_t* KN = (const bf16_t*)(ws + WS_KN); const bf16_t* P = (const bf16_t*)(ws + WS_P); bf16_t* YMIX = (bf16_t*)(ws + WS_YMIX);
    const int q0 = qb * 128; const size_t rowbase = (size_t)b * SEQ;
    const int NT = 2 * qb + 2;
    LAS float* tbl = (LAS float*)(lds + TBL_OFF); LAS float* lw = (LAS float*)(lds + LW_OFF) + wid * 32;
    if (tid < 128) {
        const int n = tid; int bkt;
        if (n < 16) bkt = n; else { bkt = 16 + (int)(logf((float)n * (1.0f / 16.0f)) / 2.0794415416798357f * 16.0f); bkt = bkt > 31 ? 31 : bkt; }
        tbl[n] = (a.in[21][bkt * 4 + h] - a.in[21][31 * 4 + h]) * LOG2E;
    }
    const bf16_t* Qw = QN + (rowbase + q0 + rg * 32 + r32) * CW + h * 128 + c * 64;
    bf16x8 qr[4];
#pragma unroll
    for (int d0 = 0; d0 < 4; ++d0) qr[d0] = *(const bf16x8*)(Qw + d0 * 16 + hi * 8);
    const bf16_t* k0src = KN + (rowbase + lane) * CW + h * 128 + wid * 8;
    const bf16_t* k1src = k0src + 64;
    const int pv0 = 2 * wid, pv1 = 2 * wid + 1;
    const bf16_t* v0src = P + (rowbase + 16 * (pv0 & 3) + (lane >> 2)) * NINP + DV0 + h * 128 + 32 * (pv0 >> 2) + (lane & 3) * 8;
    const bf16_t* v1src = P + (rowbase + 16 * (pv1 & 3) + (lane >> 2)) * NINP + DV0 + h * 128 + 32 * (pv1 >> 2) + (lane & 3) * 8;
#define ATT_DMA(t, slot) do { const unsigned s_ = lds0 + (unsigned)(slot) * SLOT; \
        glds16(k0src + (size_t)(t) * 64 * CW, (unsigned)__builtin_amdgcn_readfirstlane(s_ + wid * 1024)); \
        glds16(k1src + (size_t)(t) * 64 * CW, (unsigned)__builtin_amdgcn_readfirstlane(s_ + 8192 + wid * 1024)); \
        glds16(v0src + (size_t)(t) * 64 * NINP, (unsigned)__builtin_amdgcn_readfirstlane(s_ + OFF_V + pv0 * 1024)); \
        glds16(v1src + (size_t)(t) * 64 * NINP, (unsigned)__builtin_amdgcn_readfirstlane(s_ + OFF_V + pv1 * 1024)); } while (0)
#define ATT_SBAR() __builtin_amdgcn_sched_barrier(0)
    const unsigned lds0 = (unsigned)(uintptr_t)lds;
    f32x16 o[4];
#pragma unroll
    for (int d0 = 0; d0 < 4; ++d0) o[d0] = f32x16{};
    float lsum = 0.f;
    const bool shift = negM < -60.0f;
    const int qmin = q0 + 32 * rg, qpos = qmin + r32;
    ATT_DMA(0, 0);
    asm volatile("s_waitcnt vmcnt(0)" ::: "memory");
    __syncthreads();
    for (int t = 0; t < NT; ++t) {
        if (t + 1 < NT) ATT_DMA(t + 1, (t + 1) & 1);
        const int kmin = 64 * t;
        if (kmin <= qmin + 31) {
            const LAS unsigned char* slot = lds + (t & 1) * SLOT;
            const LAS unsigned char* kb = slot + c * 8192 + hi * 1024 + r32 * 16;
            const LAS unsigned char* vb = slot + OFF_V + ((lane >> 4) & 1) * 32 + (lane & 3) * 8 + (4 * hi + ((lane & 15) >> 2)) * 64;
            bf16x8 kf[8];
#pragma unroll
            for (int d0 = 0; d0 < 4; ++d0) { kf[2 * d0] = *(const LAS bf16x8*)(kb + d0 * 2048); kf[2 * d0 + 1] = *(const LAS bf16x8*)(kb + d0 * 2048 + 512); }
            s16x4 va[16], vc[16];
#pragma unroll
            for (int i = 0; i < 8; ++i) { va[2 * i] = vtr(vb + (i >> 2) * 4096 + (i & 3) * 1024); va[2 * i + 1] = vtr(vb + (i >> 2) * 4096 + (i & 3) * 1024 + 512); }
            ATT_SBAR();
            f32x16 p0, p1;
            p0 = __builtin_amdgcn_mfma_f32_32x32x16_bf16(kf[0], qr[0], f32x16{}, 0, 0, 0); p1 = __builtin_amdgcn_mfma_f32_32x32x16_bf16(kf[1], qr[0], f32x16{}, 0, 0, 0);
#pragma unroll
            for (int d0 = 1; d0 < 4; ++d0) { p0 = __builtin_amdgcn_mfma_f32_32x32x16_bf16(kf[2 * d0], qr[d0], p0, 0, 0, 0); p1 = __builtin_amdgcn_mfma_f32_32x32x16_bf16(kf[2 * d0 + 1], qr[d0], p1, 0, 0, 0); }
            ATT_SBAR();
            if (qmin - (kmin + 63) < 113) {
#pragma unroll
                for (int r = 0; r < 16; ++r) {
                    const int d0_ = qpos - (kmin + crow(r, hi)); const int d1_ = d0_ - 32;
                    const float t0 = tbl[d0_ < 0 ? 0 : (d0_ > 127 ? 127 : d0_)], t1 = tbl[d1_ < 0 ? 0 : (d1_ > 127 ? 127 : d1_)];
                    p0[r] = d0_ < 0 ? -INFINITY : p0[r] + t0; p1[r] = d1_ < 0 ? -INFINITY : p1[r] + t1;
                }
            }
            if (shift) {
#pragma unroll
                for (int r = 0; r < 16; ++r) { p0[r] += negM; p1[r] += negM; }
            }
            float sacc = 0.f;
#pragma unroll
            for (int r = 0; r < 16; ++r) { p0[r] = __builtin_amdgcn_exp2f(p0[r]); p1[r] = __builtin_amdgcn_exp2f(p1[r]); sacc += p0[r] + p1[r]; }
            lsum += sacc;
            u32x4 pw[4];
#pragma unroll
            for (int i = 0; i < 4; ++i) { pw[0][i] = pk2(p0[2 * i], p0[2 * i + 1]); pw[1][i] = pk2(p0[8 + 2 * i], p0[8 + 2 * i + 1]); pw[2][i] = pk2(p1[2 * i], p1[2 * i + 1]); pw[3][i] = pk2(p1[8 + 2 * i], p1[8 + 2 * i + 1]); }
            ATT_SBAR();
#pragma unroll
            for (int i = 0; i < 8; ++i) { vc[2 * i] = vtr(vb + (2 + (i >> 2)) * 4096 + (i & 3) * 1024); vc[2 * i + 1] = vtr(vb + (2 + (i >> 2)) * 4096 + (i & 3) * 1024 + 512); }
#pragma unroll
            for (int i = 0; i < 8; ++i) {
                const bf16x8 vf = (bf16x8){va[2 * i][0], va[2 * i][1], va[2 * i][2], va[2 * i][3], va[2 * i + 1][0], va[2 * i + 1][1], va[2 * i + 1][2], va[2 * i + 1][3]};
                o[i >> 2] = __builtin_amdgcn_mfma_f32_32x32x16_bf16(__builtin_bit_cast(bf16x8, pw[i & 3]), vf, o[i >> 2], 0, 0, 0);
            }
#pragma unroll
            for (int i = 0; i < 8; ++i) {
                const bf16x8 vf = (bf16x8){vc[2 * i][0], vc[2 * i][1], vc[2 * i][2], vc[2 * i][3], vc[2 * i + 1][0], vc[2 * i + 1][1], vc[2 * i + 1][2], vc[2 * i + 1][3]};
                o[2 + (i >> 2)] = __builtin_amdgcn_mfma_f32_32x32x16_bf16(__builtin_bit_cast(bf16x8, pw[i & 3]), vf, o[2 + (i >> 2)], 0, 0, 0);
            }
        }
        asm volatile("s_waitcnt vmcnt(0)" ::: "memory");
        __syncthreads();
    }
#undef ATT_DMA
#undef ATT_SBAR
    lsum += __shfl_xor(lsum, 32);
    if (hi == 0) lw[r32] = 1.0f / lsum;
    asm volatile("s_waitcnt lgkmcnt(0)" ::: "memory");
    LAS float* stg = (LAS float*)(lds + wid * 16384);
#pragma unroll
    for (int r = 0; r < 16; ++r) { const int orow = crow(r, hi); const float il = lw[orow];
#pragma unroll
        for (int d0 = 0; d0 < 4; ++d0) stg[orow * 128 + d0 * 32 + r32] = o[d0][r] * il; }
    __syncthreads();
    {
        const int row = tid >> 2, part = tid & 3, rgp = row >> 5, rr = row & 31;
        const LAS float* s1 = (const LAS float*)(lds + rgp * 16384) + rr * 128 + part * 32;
        const LAS float* s2 = (const LAS float*)(lds + (4 + rgp) * 16384) + rr * 128 + part * 32;
        float dv[32]; float ss = 0.f;
#pragma unroll
        for (int i = 0; i < 8; ++i) { const f32x4 x1 = *(const LAS f32x4*)(s1 + 4 * i), x2 = *(const LAS f32x4*)(s2 + 4 * i);
#pragma unroll
            for (int j = 0; j < 4; ++j) { const float dd = x1[j] - lam * x2[j]; dv[4 * i + j] = dd; ss += dd * dd; } }
        ss = red4(ss);
        const float sc = (1.0f / sqrtf(ss * (1.0f / 128.0f) + 1e-5f)) * 0.8f;
        const float* sg = a.in[20] + part * 32;
        bf16_t* op = YMIX + (rowbase + q0 + row) * D + CW + h * 128 + part * 32;
#pragma unroll
        for (int i = 0; i < 4; ++i) { u32x4 w;
            w.x = pk2(dv[8 * i] * sc * sg[8 * i], dv[8 * i + 1] * sc * sg[8 * i + 1]); w.y = pk2(dv[8 * i + 2] * sc * sg[8 * i + 2], dv[8 * i + 3] * sc * sg[8 * i + 3]);
            w.z = pk2(dv[8 * i + 4] * sc * sg[8 * i + 4], dv[8 * i + 5] * sc * sg[8 * i + 5]); w.w = pk2(dv[8 * i + 6] * sc * sg[8 * i + 6], dv[8 * i + 7] * sc * sg[8 * i + 7]);
            *(u32x4*)(op + 8 * i) = w; }
    }
    __syncthreads();
}

__device__ __forceinline__ void attn_phase(LAS unsigned char* lds, const Args& a, unsigned* ctl) {
    const int tid = threadIdx.x;
    LAS float* cst = (LAS float*)(lds + CST_OFF);
    if (tid < 64) {
        const float gq = fabsf(a.in[14][tid]), gk = fabsf(a.in[15][tid]);
        float mq = gq, mk = gk;
#pragma unroll
        for (int o = 1; o < 64; o <<= 1) { mq = fmaxf(mq, __shfl_xor(mq, o)); mk = fmaxf(mk, __shfl_xor(mk, o)); }
        const float d1 = wave_sum(a.in[16][tid] * a.in[17][tid]), d2 = wave_sum(a.in[18][tid] * a.in[19][tid]);
        float mb = 0.f;
        if (tid < 32) { for (int hh = 0; hh < 4; ++hh) mb = fmaxf(mb, (a.in[21][tid * 4 + hh] - a.in[21][31 * 4 + hh]) * LOG2E); }
#pragma unroll
        for (int o = 1; o < 64; o <<= 1) mb = fmaxf(mb, __shfl_xor(mb, o));
        if (tid == 0) { cst[0] = -(8.0f * LOG2E * mq * mk * 1.02f + mb); cst[1] = __expf(d1) - __expf(d2) + 0.2f; }
    }
    __syncthreads();
    const float negM = cst[0], lam = cst[1];
    LAS int* ubox = (LAS int*)(lds + CST_OFF + 16);
    for (;;) {
        if (tid == 0) ubox[0] = (int)atomicAdd(ctl + CW_ATTQ, 1u);
        __syncthreads();
        const int u = ubox[0];
        __syncthreads();
        if (u >= 1024) break;
        const int qb = 31 - (u >> 5), bhh = u & 31;
        attn_unit(lds, a, bhh >> 2, bhh & 3, qb, negM, lam);
    }
}
}

__device__ __forceinline__ void p5_router(LAS unsigned char* lds, const Args& a, unsigned* ctl) {
    const int tid = threadIdx.x, lane = tid & 63, wave = __builtin_amdgcn_readfirstlane(tid >> 6);
    unsigned char* ws = a.ws;
    const float* x1 = a.out; const float* g2 = a.in[23]; const float* rw = a.in[24]; const float* rb = a.in[25];
    unsigned char* H2 = ws + WS_H2; int* EIDX = (int*)(ws + WS_EIDX); float* GATE = (float*)(ws + WS_GATE); int* POS = (int*)(ws + WS_POS);
    LAS float* rwT = (LAS float*)lds;
    LAS int* cnt = (LAS int*)(lds + MISC_OFF + 1024);
    LAS int* basel = (LAS int*)(lds + MISC_OFF + 1024 + 128);
    LAS int* el = (LAS int*)(lds + MISC_OFF + 2048);
    LAS int* pl = (LAS int*)(lds + MISC_OFF + 4096);
    for (int i = tid; i < 32 * 1024; i += 512) { const int k = i >> 5, e = i & 31; rwT[e * 1024 + k] = rw[i]; }
    if (tid < 32) cnt[tid] = 0;
    __syncthreads();
    f32x4 gv[4];
#pragma unroll
    for (int j = 0; j < 4; ++j) gv[j] = *((const f32x4*)g2 + lane + 64 * j);
    const float rbias = rb[lane >> 1];
    const int TPB = T / (int)gridDim.x, tb0 = blockIdx.x * TPB, TPW = TPB / 8;
    for (int i = 0; i < TPW; ++i) {
        const int tl = wave * TPW + i, t = tb0 + tl;
        const f32x4* xr = (const f32x4*)(x1 + (size_t)t * D) + lane;
        f32x4 v[4]; float s = 0.f;
#pragma unroll
        for (int j = 0; j < 4; ++j) { v[j] = xr[64 * j]; s += (v[j].x * v[j].x + v[j].y * v[j].y) + (v[j].z * v[j].z + v[j].w * v[j].w); }
        const float rstd = 1.0f / sqrtf(wave_sum(s) * (1.0f / D) + 1e-5f);
        unsigned* o4 = (unsigned*)(H2 + (size_t)t * D) + lane;
#pragma unroll
        for (int j = 0; j < 4; ++j) { v[j] = v[j] * rstd * gv[j]; o4[64 * j] = pk4_fp8(v[j].x * F8_X_MUL, v[j].y * F8_X_MUL, v[j].z * F8_X_MUL, v[j].w * F8_X_MUL); }
        float acc[32];
#pragma unroll
        for (int e = 0; e < 32; ++e) {
            float s2 = 0.f;
#pragma unroll
            for (int j = 0; j < 4; ++j) { const f32x4 w = *((const LAS f32x4*)(rwT + e * 1024) + lane + 64 * j); s2 += (v[j].x * w.x + v[j].y * w.y) + (v[j].z * w.z + v[j].w * w.w); }
            acc[e] = s2;
        }
#pragma unroll
        for (int e = 0; e < 16; ++e) { const bool up = lane & 32; const float keep = up ? acc[e + 16] : acc[e], send = up ? acc[e] : acc[e + 16]; acc[e] = keep + __shfl_xor(send, 32); }
#pragma unroll
        for (int e = 0; e < 8; ++e) { const bool up = lane & 16; const float keep = up ? acc[e + 8] : acc[e], send = up ? acc[e] : acc[e + 8]; acc[e] = keep + __shfl_xor(send, 16); }
#pragma unroll
        for (int e = 0; e < 4; ++e) { const bool up = lane & 8; const float keep = up ? acc[e + 4] : acc[e], send = up ? acc[e] : acc[e + 4]; acc[e] = keep + __shfl_xor(send, 8); }
#pragma unroll
        for (int e = 0; e < 2; ++e) { const bool up = lane & 4; const float keep = up ? acc[e + 2] : acc[e], send = up ? acc[e] : acc[e + 2]; acc[e] = keep + __shfl_xor(send, 4); }
        { const bool up = lane & 2; const float keep = up ? acc[1] : acc[0], send = up ? acc[0] : acc[1]; acc[0] = keep + __shfl_xor(send, 2); }
        float logit = acc[0] + __shfl_xor(acc[0], 1) + rbias;
        const int myid = lane >> 1;
        float tv[4]; int ti[4];
#pragma unroll
        for (int k = 0; k < 4; ++k) {
            float bv = logit; int bi = myid;
#pragma unroll
            for (int o = 1; o < 64; o <<= 1) { const float ov = __shfl_xor(bv, o); const int oi = __shfl_xor(bi, o); if (ov > bv || (ov == bv && oi < bi)) { bv = ov; bi = oi; } }
            tv[k] = bv; ti[k] = bi;
            if (myid == bi) logit = -INFINITY;
        }
        const float e1 = __expf(tv[1] - tv[0]), e2 = __expf(tv[2] - tv[0]), e3 = __expf(tv[3] - tv[0]);
        const float inv = 1.0f / (1.0f + e1 + e2 + e3);
        if (lane < 4) {
            const int ek = lane == 0 ? ti[0] : lane == 1 ? ti[1] : lane == 2 ? ti[2] : ti[3];
            const float gk = (lane == 0 ? 1.0f : lane == 1 ? e1 : lane == 2 ? e2 : e3) * inv;
            EIDX[t * 4 + lane] = ek; GATE[t * 4 + lane] = gk;
            el[tl * 4 + lane] = ek; pl[tl * 4 + lane] = atomicAdd((int*)(cnt + ek), 1);
        }
    }
    __syncthreads();
    if (tid < 32) basel[tid] = (int)atomicAdd(ctl + CW_CNT + tid, (unsigned)cnt[tid]);
    __syncthreads();
    for (int i = tid; i < TPB * 4; i += 512) POS[(size_t)tb0 * 4 + i] = pl[i] + basel[el[i]];
}

__device__ __forceinline__ void p6_dispatch(LAS unsigned char* lds, const Args& a, unsigned* ctl) {
    const int tid = threadIdx.x, lane = tid & 63, wave = __builtin_amdgcn_readfirstlane(tid >> 6);
    unsigned char* ws = a.ws;
    const unsigned char* H2 = ws + WS_H2; unsigned char* XS = ws + WS_XS;
    const int* EIDX = (const int*)(ws + WS_EIDX); const float* GATE = (const float*)(ws + WS_GATE); const int* POS = (const int*)(ws + WS_POS);
    int* DEST = (int*)(ws + WS_DEST); float* ROWGATE = (float*)(ws + WS_ROWGATE); int* TILEE = (int*)(ws + WS_TILEE);
    LAS int* pstart = (LAS int*)(lds + MISC_OFF + 1024);
    if (tid == 0) {
        int acc = 0;
        for (int e = 0; e < NE; ++e) { const int cn = (int)__hip_atomic_load(ctl + CW_CNT + e, __ATOMIC_RELAXED, __HIP_MEMORY_SCOPE_AGENT); pstart[e] = acc;
            const int nt = (cn + 255) >> 8;
            if (blockIdx.x == 0) for (int i = 0; i < nt; ++i) TILEE[(acc >> 8) + i] = e;
            acc += nt * 256; }
        if (blockIdx.x == 0) TILEE[1023] = acc >> 8;
    }
    __syncthreads();
    const int TPB = T / (int)gridDim.x, tb0 = blockIdx.x * TPB, PPW = TPB * 4 / 8;
    for (int i = 0; i < PPW; ++i) {
        const int pi = tb0 * 4 + wave * PPW + i, t = pi >> 2;
        const int e = EIDX[pi], dest = pstart[e] + POS[pi];
        if (lane == 0) { DEST[pi] = dest; ROWGATE[dest] = GATE[pi]; }
        const u32x4* src = (const u32x4*)(H2 + (size_t)t * D); u32x4* dst = (u32x4*)(XS + (size_t)dest * D);
        dst[lane] = src[lane];
    }
}

__device__ __forceinline__ void p9_combine(const Args& a, int G) {
    const int tid = threadIdx.x, lane = tid & 63, wave = __builtin_amdgcn_readfirstlane(tid >> 6);
    unsigned char* ws = a.ws;
    const bf16_t* YS = (const bf16_t*)(ws + WS_YS); const int* DEST = (const int*)(ws + WS_DEST);
    float* out = a.out;
    const int gw = blockIdx.x * 8 + wave, NGW = G * 8;
    for (int t = gw; t < T; t += NGW) {
        f32x4* xr = (f32x4*)(out + (size_t)t * D) + lane;
        f32x4 v[4];
#pragma unroll
        for (int j = 0; j < 4; ++j) v[j] = xr[64 * j];
#pragma unroll
        for (int k = 0; k < 4; ++k) {
            const int dest = DEST[t * 4 + k];
            const u32x2* yr = (const u32x2*)(YS + (size_t)dest * D) + lane;
#pragma unroll
            for (int j = 0; j < 4; ++j) { const u32x2 w = yr[64 * j]; v[j].x += bflo(w.x); v[j].y += bfhi(w.x); v[j].z += bflo(w.y); v[j].w += bfhi(w.y); }
        }
#pragma unroll
        for (int j = 0; j < 4; ++j) xr[64 * j] = v[j];
    }
}

constexpr int NPHASE = 10;
__global__ void __launch_bounds__(512, 2) hymba_fwd(Args args) {
    extern __shared__ __attribute__((aligned(16))) unsigned char lds_raw[];
    LAS unsigned char* lds = (LAS unsigned char*)lds_raw;
    cg::grid_group grid = cg::this_grid();
    const int G = gridDim.x;
    unsigned char* ws = args.ws;
    unsigned* ctl = (unsigned*)(ws + WS_CTL);
    const int lo = args.ph_lo, hi = args.ph_hi;
#define IN(k) (lo <= (k) && (k) < hi)
#define NREP(k) ((REP_PHASE) == (k) ? 2 : 1)
#define SEAM(k) do { if (IN(k) && IN((k) + 1)) { if (args.ph_lo < 0) grid.sync(); xcd_barrier(xbar); } } while (0)
    const int* TILEE = (const int*)(ws + WS_TILEE);
    { volatile LAS unsigned* st = (volatile LAS unsigned*)(lds + MISC_OFF); if (threadIdx.x < 2) st[threadIdx.x] = 0u; }
    __syncthreads();
    const XcdBarrier xbar = xcd_barrier_post(ctl + CW_BAR, (volatile LAS unsigned*)(lds + MISC_OFF));

    if (IN(0)) { for (int rep = 0; rep < NREP(0); ++rep) p0_prologue(lds, args, G); } SEAM(0);
    if (IN(1)) {
        pg8::Gemm g{ws + WS_XN, ws + WS_WINT, 1024, 0, 0};
        pg8::TileOrder S; S.init(T / 256, NINP / 256, G, (int)blockIdx.x, nullptr, 0);
        pg8::EpiBf16 E{(bf16_t*)(ws + WS_P), NINP};
        for (int rep = 0; rep < NREP(1); ++rep) pg8::gemm_phase<false>(lds, g, S, E);
    } SEAM(1);
    if (IN(2)) { _Pragma("clang loop unroll(disable)") for (int rep = 0; rep < NREP(2); ++rep) { p2_prep(lds, args); __syncthreads(); } } SEAM(2);
    if (IN(3)) {
        for (int rep = 0; rep < NREP(30); ++rep) { if (blockIdx.x < 128) p3_scan(lds, args); __syncthreads(); }
        for (int rep = 0; rep < NREP(31); ++rep) att::attn_phase(lds, args, ctl + 64 * rep);
        xcd_barrier(xbar);
        for (int rep = 0; rep < NREP(32); ++rep) p3_post(args, G);
    } SEAM(3);
    if (IN(4)) {
        pg8::Gemm g{ws + WS_YMIX, ws + WS_WOUT, 1024, 0, 0};
        pg8::TileOrder S; S.init(T / 256, D / 256, G, (int)blockIdx.x, nullptr, 0);
        pg8::EpiResF32 E{args.in[0], args.out, D};
        for (int rep = 0; rep < NREP(4); ++rep) pg8::gemm_phase<false>(lds, g, S, E);
    } SEAM(4);
    if (IN(5)) { _Pragma("clang loop unroll(disable)") for (int rep = 0; rep < NREP(5); ++rep) { p5_router(lds, args, ctl + 256 * (NREP(5) - 1 - rep)); __syncthreads(); } } SEAM(5);
    if (IN(6)) { for (int rep = 0; rep < NREP(6); ++rep) { p6_dispatch(lds, args, ctl); __syncthreads(); } } SEAM(6);
    if (IN(7)) {
        const int ntile = TILEE[1023];
        pg8::Gemm g{ws + WS_XS, ws + WS_W1T, 1024, F8_W_SC, F8_X_SC};
        pg8::TileOrder S; S.init(ntile, 8, G, (int)blockIdx.x, TILEE, 8);
        pg8::EpiSwiglu E{ws + WS_HID, args.in[27], TILEE};
        for (int rep = 0; rep < NREP(7); ++rep) pg8::gemm_phase<true>(lds, g, S, E);
    } SEAM(7);
    if (IN(8)) {
        const int ntile = TILEE[1023];
        pg8::Gemm g{ws + WS_HID, ws + WS_W2T, 1024, F8_W_SC, F8_H_SC};
        pg8::TileOrder S; S.init(ntile, 4, G, (int)blockIdx.x, TILEE, 4);
        pg8::EpiGateBf16 E{(bf16_t*)(ws + WS_YS), args.in[29], (const float*)(ws + WS_ROWGATE), TILEE};
        for (int rep = 0; rep < NREP(8); ++rep) pg8::gemm_phase<true>(lds, g, S, E);
    } SEAM(8);
    if (IN(9)) { p9_combine(args, G); }
#undef IN
#undef SEAM
}

extern "C" void kernel_launch(void* const* d_in, const int* in_sizes, int n_in, void* d_out, int out_size, void* d_ws, size_t ws_size, hipStream_t stream) {
    static int grid = 0;
    if (grid == 0) {
        if (n_in != 30 || in_sizes[0] != T * D || out_size != T * D || ws_size < WS_END) { fprintf(stderr, "kernel_launch: unexpected shapes (n_in %d, in0 %d, out %d, ws %zu); nothing launched\n", n_in, n_in > 0 ? in_sizes[0] : -1, out_size, ws_size); grid = -1; return; }
        int dev = 0, cus = 0, per_cu = 0;
        if (hipGetDevice(&dev) != hipSuccess || hipDeviceGetAttribute(&cus, hipDeviceAttributeMultiprocessorCount, dev) != hipSuccess) { grid = -1; return; }
        if (hipFuncSetAttribute((const void*)hymba_fwd, hipFuncAttributeMaxDynamicSharedMemorySize, LDS_BYTES) != hipSuccess) { fprintf(stderr, "kernel_launch: hipFuncSetAttribute failed\n"); grid = -1; return; }
        if (hipOccupancyMaxActiveBlocksPerMultiprocessor(&per_cu, (const void*)hymba_fwd, 512, LDS_BYTES) != hipSuccess || per_cu < 1) { fprintf(stderr, "kernel_launch: occupancy query says %d\n", per_cu); per_cu = 1; }
        (void)hipGetLastError();
        grid = cus;
        if (grid > 256) grid = 256;
        if (grid != 256 || T % grid != 0 || (T / grid) % 16 != 0) { fprintf(stderr, "kernel_launch: grid %d does not divide the token count evenly\n", grid); grid = -1; return; }
    }
    if (grid < 0) return;
    (void)hipMemsetAsync((char*)d_ws + WS_CTL, 0, CTL_ZERO_BYTES, stream);
    Args a{};
    for (int i = 0; i < 30; ++i) a.in[i] = (const float*)d_in[i];
    a.out = (float*)d_out; a.ws = (unsigned char*)d_ws;
    constexpr int NL = MK_N_LAUNCHES;
    for (int li = 0; li < NL; ++li) {
        a.ph_lo = (NL == 1) ? 0 : li; a.ph_hi = (NL == 1) ? NPHASE : li + 1;
        void* kargs[] = {&a};
        hipError_t e = hipLaunchCooperativeKernel((const void*)hymba_fwd, dim3(grid), dim3(512), kargs, LDS_BYTES, stream);
        if (e != hipSuccess) { fprintf(stderr, "kernel_launch: cooperative launch %d failed: %s (grid %d)\n", li, hipGetErrorString(e), grid); break; }
    }
}
```

```cpp
#include <hip/hip_runtime.h>
#include <hip/hip_cooperative_groups.h>
#include <cstdio>
#include <cstdint>
#include <type_traits>
namespace cg = cooperative_groups;

#ifndef REP_PHASE
#define REP_PHASE -1
#endif
#ifndef MK_N_LAUNCHES
#define MK_N_LAUNCHES 1
#endif

#define LAS __attribute__((address_space(3)))
#define GAS __attribute__((address_space(1)))
typedef unsigned short bf16_t;
typedef short bf16x8 __attribute__((ext_vector_type(8)));
typedef short s16x4 __attribute__((ext_vector_type(4)));
typedef float f32x2 __attribute__((ext_vector_type(2)));
typedef float f32x4 __attribute__((ext_vector_type(4)));
typedef float f32x16 __attribute__((ext_vector_type(16)));
typedef unsigned u32x2 __attribute__((ext_vector_type(2)));
typedef unsigned u32x4 __attribute__((ext_vector_type(4)));
typedef int v8i32 __attribute__((ext_vector_type(8)));

constexpr int NB = 8, SEQ = 4096, T = NB * SEQ, D = 1024;
constexpr int CW = 512;
constexpr int NRW = 1696, NIN = 3232, NINP = 3328;
constexpr int DQ0 = 1696, DK0 = 2208, DV0 = 2720;
constexpr int NE = 32, TOPK = 4, DE = 1024;
constexpr int MAXROWS = T * TOPK + NE * 256;
constexpr int MAXTILES = MAXROWS / 256;
constexpr float LOG2E = 1.4426950408889634f;
constexpr float F8_W_MUL = 32.f, F8_X_MUL = 8.f, F8_H_MUL = 4.f; constexpr int F8_W_SC = 0x7A7A7A7A, F8_X_SC = 0x7C7C7C7C, F8_H_SC = 0x7D7D7D7D;

constexpr size_t MiB = 1u << 20;
constexpr size_t WS_CTL = 0, CTL_ZERO_BYTES = 64 * 1024;
constexpr size_t WS_TILEE = 512 * 1024;
constexpr size_t WS_WINT = 1 * MiB;
constexpr size_t WS_WOUT = 8 * MiB;
constexpr size_t WS_W1T = 10 * MiB;
constexpr size_t WS_W2T = 138 * MiB;
constexpr size_t WS_EIDX = 202 * MiB;
constexpr size_t WS_GATE = WS_EIDX + 512 * 1024;
constexpr size_t WS_POS = WS_GATE + 512 * 1024;
constexpr size_t WS_DEST = WS_POS + 512 * 1024;
constexpr size_t WS_ROWGATE = 204 * MiB;
constexpr size_t WS_XN = 206 * MiB;
constexpr size_t WS_P = 270 * MiB;
constexpr size_t WS_SR = 478 * MiB, WS_SK = 510 * MiB, WS_SV = 542 * MiB, WS_SA = 574 * MiB, WS_SB = 606 * MiB;
constexpr size_t WS_SW = 638 * MiB;
constexpr size_t WS_SG = 702 * MiB;
constexpr size_t WS_QN = 734 * MiB, WS_KN = 766 * MiB;
constexpr size_t WS_YMIX = 798 * MiB;
constexpr size_t WS_H2 = 206 * MiB;
constexpr size_t WS_XS = 270 * MiB;
constexpr size_t WS_HID = 406 * MiB;
constexpr size_t WS_YS = 542 * MiB;
constexpr size_t WS_YRAW = 862 * MiB;
constexpr size_t WS_CG = 862 * MiB;
constexpr size_t WS_CH = 894 * MiB;
constexpr size_t WS_CR2 = 926 * MiB;
constexpr size_t WS_CY0 = 958 * MiB;
constexpr size_t WS_RK = 990 * MiB;
constexpr size_t WS_END = 992 * MiB;
constexpr int CW_CNT = 64;
constexpr int CW_ATTQ = 128;
constexpr int CW_BAR = 4096;

constexpr int RING_BYTES = 131072, MISC_OFF = RING_BYTES, LDS_BYTES = 147456;

__device__ __forceinline__ unsigned f2bf(float f) { unsigned u = __builtin_bit_cast(unsigned, f); return (u + 0x7fffu + ((u >> 16) & 1u)) >> 16; }
typedef __bf16 hwbf16x2 __attribute__((ext_vector_type(2)));
__device__ __forceinline__ unsigned pk2(float lo, float hi) { const f32x2 v = {lo, hi}; return __builtin_bit_cast(unsigned, __builtin_convertvector(v, hwbf16x2)); }
__device__ __forceinline__ unsigned pk4_fp8(float a, float b, float c, float d) {
    a = fminf(fmaxf(a, -448.f), 448.f); b = fminf(fmaxf(b, -448.f), 448.f); c = fminf(fmaxf(c, -448.f), 448.f); d = fminf(fmaxf(d, -448.f), 448.f);
    int r = __builtin_amdgcn_cvt_pk_fp8_f32(a, b, 0, false); r = __builtin_amdgcn_cvt_pk_fp8_f32(c, d, r, true); return (unsigned)r; }
__device__ __forceinline__ float bf2f(unsigned short b) { return __builtin_bit_cast(float, (unsigned)b << 16); }
__device__ __forceinline__ float bflo(unsigned w) { return __builtin_bit_cast(float, w << 16); }
__device__ __forceinline__ float bfhi(unsigned w) { return __builtin_bit_cast(float, w & 0xffff0000u); }
__device__ __forceinline__ float wave_sum(float v) {
#pragma unroll
    for (int o = 1; o < 64; o <<= 1) v += __shfl_xor(v, o);
    return v;
}
__device__ __forceinline__ float sigmoidf_(float x) { return 1.0f / (1.0f + __expf(-x)); }
template <int CTRL> __device__ __forceinline__ float dpp_f(float v) { return __builtin_bit_cast(float, __builtin_amdgcn_update_dpp(0, __builtin_bit_cast(int, v), CTRL, 0xF, 0xF, true)); }
__device__ __forceinline__ float red8(float v) {
    v += dpp_f<0xB1>(v);
    v += dpp_f<0x4E>(v);
    v += dpp_f<0x141>(v);
    return v;
}
__device__ __forceinline__ float red4(float v) { v += dpp_f<0xB1>(v); v += dpp_f<0x4E>(v); return v; }


#define XB_TMO      128
#define XB_XCNT(j)  (256  + 64 * (j))
#define XB_XSUB(j)  (1280 + 64 * (j))
#define XB_XGEN(j)  (2304 + 64 * (j))
#define XB_TOP      3328
#define XB_TOPGEN   3392
#define XCD_BAR_WORDS 3456
#define XB_SPIN_CAP (1u << 18)
__device__ __forceinline__ unsigned xb_ld(unsigned* p)              { return __hip_atomic_load(p, __ATOMIC_RELAXED, __HIP_MEMORY_SCOPE_AGENT); }
__device__ __forceinline__ unsigned xb_add(unsigned* p, unsigned v) { return __hip_atomic_fetch_add(p, v, __ATOMIC_RELAXED, __HIP_MEMORY_SCOPE_AGENT); }
__device__ __forceinline__ unsigned xb_xcc_id() { return (unsigned)__builtin_amdgcn_s_getreg((3 << 11) | 20) & 0xFu; }
#define XB_SPIN(cond, bar) do { unsigned _sp = 0; while (cond) { __builtin_amdgcn_s_sleep(1); \
    if ((++_sp & 255u) == 0u) { if (xb_ld(&(bar)[XB_TMO])) break; if (_sp > XB_SPIN_CAP) { atomicAdd(&(bar)[XB_TMO], 1u); break; } } } } while (0)
struct XcdBarrier { unsigned* bar; unsigned x; volatile LAS unsigned* st; };
__device__ __forceinline__ XcdBarrier xcd_barrier_post(unsigned* bar, volatile LAS unsigned* st) {
    XcdBarrier b; b.bar = bar; b.x = xb_xcc_id(); b.st = st;
    if (threadIdx.x == 0) (void)xb_add(&bar[XB_XCNT(b.x)], 1u);
    return b;
}
__device__ __forceinline__ void xcd_barrier_complete(unsigned* bar, unsigned x, unsigned& nloc, unsigned& nx) {
    const unsigned G = gridDim.x * gridDim.y * gridDim.z;
    unsigned sum, cnt, mine, sp = 0u;
    for (;;) {
        sum = 0u; cnt = 0u; mine = 0u;
#pragma unroll
        for (unsigned j = 0; j < 16; ++j) { const unsigned c = xb_ld(&bar[XB_XCNT(j)]); sum += c; cnt += (c > 0u) ? 1u : 0u; mine = (j == x) ? c : mine; }
        if (sum == G) break;
        __builtin_amdgcn_s_sleep(1);
        if ((++sp & 255u) == 0u) { if (xb_ld(&bar[XB_TMO])) break; if (sp > XB_SPIN_CAP) { atomicAdd(&bar[XB_TMO], 1u); break; } }
    }
    nloc = mine > 0u ? mine : 1u; nx = cnt > 0u ? cnt : 1u;
}
__device__ __forceinline__ void xcd_barrier(const XcdBarrier& b) {
    asm volatile("s_waitcnt vmcnt(0)" ::: "memory");
    __syncthreads();
    if (threadIdx.x == 0) {
        unsigned* bar = b.bar;
        __builtin_amdgcn_s_waitcnt(0);
        unsigned nloc = b.st[0], nx = b.st[1];
        if (nloc == 0u) { xcd_barrier_complete(bar, b.x, nloc, nx); b.st[0] = nloc; b.st[1] = nx; }
        const unsigned old = xb_add(&bar[XB_XSUB(b.x)], 1u);
        const unsigned gen = old / nloc;
        if (old + 1u == (gen + 1u) * nloc) {
            __builtin_amdgcn_fence(__ATOMIC_RELEASE, "agent");
            asm volatile("s_waitcnt vmcnt(0)" ::: "memory");
            const unsigned og = xb_add(&bar[XB_TOP], 1u);
            const unsigned tg = og / nx;
            if (og + 1u == (tg + 1u) * nx) xb_add(&bar[XB_TOPGEN], 1u);
            else XB_SPIN(xb_ld(&bar[XB_TOPGEN]) == tg, bar);
            __builtin_amdgcn_fence(__ATOMIC_ACQUIRE, "agent");
            xb_add(&bar[XB_XGEN(b.x)], 1u);
            asm volatile("s_waitcnt vmcnt(0)" ::: "memory");
        } else {
            XB_SPIN(xb_ld(&bar[XB_XGEN(b.x)]) == gen, bar);
            __builtin_amdgcn_fence(__ATOMIC_ACQUIRE, "agent");
            asm volatile("s_waitcnt vmcnt(0)" ::: "memory");
        }
    }
    __syncthreads();
}

namespace pg8 {
constexpr int BM = 256, BK = 64, HALF = 128, HTB = HALF * BK * 2, STAGE_BYTES = 8 * HTB, NXCD = 8, WGM = 8;
__host__ __device__ __forceinline__ int lds_byte(int r, int c) { const int st = (r >> 4) * 2 + (c >> 5), rr = r & 15, cc = c & 31, ob = rr * 64 + cc * 2; return st * 1024 + (ob ^ (((ob >> 9) & 1) << 5)); }
__host__ __device__ __forceinline__ void stage_rc(int b, int& R, int& C) { const int st = b / 1024, sb = b % 1024, swz = sb ^ (((sb >> 9) & 1) << 5); R = (st >> 1) * 16 + swz / 64; C = (st & 1) * 32 + (swz % 64) / 2; }
__host__ __device__ __forceinline__ int perm32(int rho) { const int n = rho >> 4, i = rho & 15; return 8 * (i >> 2) + 4 * n + (i & 3); }

struct Unit { int pm, pn, pb; };
struct Gemm { const void* A; const void* Bt; int K; int scW, scA; };

struct TileOrder {
    int nM, nN, nwg, G, c; const int* tile_e; int nb_per_e;
    __device__ void init(int nM_, int nN_, int G_, int c_, const int* te, int nbe) { nM = nM_; nN = nN_; nwg = nM * nN; G = G_; c = c_; tile_e = te; nb_per_e = nbe; }
    __device__ bool next(int i, Unit& u) const {
        const long L = (long)i * G + c; if (L >= nwg) return false;
        int wgid = (int)L; { const int q = nwg / NXCD, r = nwg % NXCD, xcd = wgid % NXCD, off = wgid / NXCD; wgid = (xcd < r ? xcd * (q + 1) : r * (q + 1) + (xcd - r) * q) + off; }
        const int nig = WGM * nN, gid = wgid / nig, fm = gid * WGM, gsz = (nM - fm) < WGM ? (nM - fm) : WGM;
        u.pm = fm + ((wgid % nig) % gsz); u.pn = (wgid % nig) / gsz;
        u.pb = tile_e ? tile_e[u.pm] * nb_per_e + u.pn : u.pn;
        return true;
    }
};

struct EpiBf16 {
    static constexpr bool PERM = true;
    bf16_t* O; int ldc;
    __device__ __forceinline__ void operator()(const f32x4 (&acc)[2][2][4][2], const Unit& u, int wr, int wc, int fr, int fq) const {
        const int row0 = u.pm * BM + wr * 64 + fr; const int col0 = u.pn * BM + wc * 32 + 8 * fq;
#pragma unroll
        for (int ai = 0; ai < 2; ++ai)
#pragma unroll
            for (int m = 0; m < 4; ++m) { bf16_t* rowp = O + (size_t)(row0 + ai * HALF + m * 16) * ldc + col0;
#pragma unroll
                for (int bj = 0; bj < 2; ++bj) { const f32x4 v0 = acc[ai][bj][m][0], v1 = acc[ai][bj][m][1];
                    u32x4 w; w.x = pk2(v0[0], v0[1]); w.y = pk2(v0[2], v0[3]); w.z = pk2(v1[0], v1[1]); w.w = pk2(v1[2], v1[3]);
                    *(u32x4*)(rowp + bj * HALF) = w; } }
    }
};
struct EpiResF32 {
    static constexpr bool PERM = false;
    const float* base; float* out; int ldc;
    __device__ __forceinline__ void operator()(const f32x4 (&acc)[2][2][4][2], const Unit& u, int wr, int wc, int fr, int fq) const {
        const int col0 = u.pn * BM + wc * 32 + 4 * fq;
#pragma unroll
        for (int ai = 0; ai < 2; ++ai)
#pragma unroll
            for (int m = 0; m < 4; ++m) { const size_t off = (size_t)(u.pm * BM + ai * HALF + wr * 64 + m * 16 + fr) * ldc + col0;
#pragma unroll
                for (int bj = 0; bj < 2; ++bj)
#pragma unroll
                    for (int n = 0; n < 2; ++n) { const f32x4 bs = *(const f32x4*)(base + off + bj * HALF + n * 16); *(f32x4*)(out + off + bj * HALF + n * 16) = bs + acc[ai][bj][m][n]; } }
    }
};
struct EpiSwiglu {
    static constexpr bool PERM = true;
    unsigned char* O; const float* b1; const int* tile_e;
    __device__ __forceinline__ void operator()(const f32x4 (&acc)[2][2][4][2], const Unit& u, int wr, int wc, int fr, int fq) const {
        const int e = tile_e[u.pm]; const int row0 = u.pm * BM + wr * 64 + fr; const int hc0 = u.pn * 128 + wc * 32 + 8 * fq;
        const float* bg = b1 + (size_t)e * 2048 + hc0; const float* bl = bg + 1024;
        const f32x4 g0 = *(const f32x4*)bg, g1 = *(const f32x4*)(bg + 4), l0 = *(const f32x4*)bl, l1 = *(const f32x4*)(bl + 4);
#pragma unroll
        for (int ai = 0; ai < 2; ++ai)
#pragma unroll
            for (int m = 0; m < 4; ++m) { unsigned char* rowp = O + (size_t)(row0 + ai * HALF + m * 16) * 1024 + hc0;
                float o[8];
#pragma unroll
                for (int n = 0; n < 2; ++n) { const f32x4 gv = acc[ai][0][m][n] + (n ? g1 : g0), lv = acc[ai][1][m][n] + (n ? l1 : l0);
#pragma unroll
                    for (int i = 0; i < 4; ++i) { const float g = fminf(gv[i], 7.0f), l = fminf(fmaxf(lv[i], -7.0f), 7.0f);
                        const float sg = __builtin_amdgcn_rcpf(1.0f + __builtin_amdgcn_exp2f(-1.702f * LOG2E * g)); o[n * 4 + i] = g * sg * (l + 1.0f); } }
                u32x2 w; w.x = pk4_fp8(o[0] * F8_H_MUL, o[1] * F8_H_MUL, o[2] * F8_H_MUL, o[3] * F8_H_MUL); w.y = pk4_fp8(o[4] * F8_H_MUL, o[5] * F8_H_MUL, o[6] * F8_H_MUL, o[7] * F8_H_MUL);
                *(u32x2*)rowp = w; }
    }
};
struct EpiGateBf16 {
    static constexpr bool PERM = true;
    bf16_t* O; const float* b2; const float* rowgate; const int* tile_e;
    __device__ __forceinline__ void operator()(const f32x4 (&acc)[2][2][4][2], const Unit& u, int wr, int wc, int fr, int fq) const {
        const int e = tile_e[u.pm]; const int row0 = u.pm * BM + wr * 64 + fr; const int col0 = u.pn * BM + wc * 32 + 8 * fq;
        f32x4 bv[2][2];
#pragma unroll
        for (int bj = 0; bj < 2; ++bj)
#pragma unroll
            for (int n = 0; n < 2; ++n) bv[bj][n] = *(const f32x4*)(b2 + (size_t)e * 1024 + col0 + bj * HALF + 4 * n);
#pragma unroll
        for (int ai = 0; ai < 2; ++ai)
#pragma unroll
            for (int m = 0; m < 4; ++m) { const int row = row0 + ai * HALF + m * 16; const float gt = rowgate[row]; bf16_t* rowp = O + (size_t)row * 1024 + col0;
#pragma unroll
                for (int bj = 0; bj < 2; ++bj) { const f32x4 v0 = (acc[ai][bj][m][0] + bv[bj][0]) * gt, v1 = (acc[ai][bj][m][1] + bv[bj][1]) * gt;
                    u32x4 w; w.x = pk2(v0[0], v0[1]); w.y = pk2(v0[2], v0[3]); w.z = pk2(v1[0], v1[1]); w.w = pk2(v1[2], v1[3]);
                    *(u32x4*)(rowp + bj * HALF) = w; } }
    }
};

template <bool F8, class Epi, class Sched>
__device__ __forceinline__ void gemm_phase(LAS unsigned char* lds, const Gemm g, const Sched& S, const Epi& E) {
    const int tid = threadIdx.x, wid = __builtin_amdgcn_readfirstlane(tid >> 6), lane = tid & 63, wr = wid >> 2, wc = wid & 3, fr = lane & 15, fq = lane >> 4;
    const int RB = F8 ? g.K : g.K * 2, nt = RB / 128;
    unsigned voffA[2], voffB[2];
#pragma unroll
    for (int i = 0; i < 2; ++i) { int R, C; stage_rc(tid * 16 + i * 8192, R, C); const int Rb = Epi::PERM ? ((R & ~31) + perm32(R & 31)) : R;
        voffA[i] = (unsigned)(R * RB + C * 2); voffB[i] = (unsigned)(Rb * RB + C * 2); }
    const size_t kstep = (size_t)(BK * 2);
    const size_t hstep = (size_t)HALF * RB;
    const size_t tstep = 2 * hstep;
    const unsigned ldsw = (unsigned)wid * 1024u;
    const int aoff = F8 ? lds_byte(wr * 64 + fr, (fq & 1) * 16) + (fq >> 1) * 1024 : lds_byte(wr * 64 + fr, fq * 8);
    const int boff = F8 ? lds_byte(wc * 32 + fr, (fq & 1) * 16) + (fq >> 1) * 1024 : lds_byte(wc * 32 + fr, fq * 8);
    const int scW = g.scW, scA = g.scA;
#define PG8_SA(b, h) (((b) * 2 + (h)) * HTB)
#define PG8_SB(b, h) ((4 + (b) * 2 + (h)) * HTB)
#define PG8_STAGE(bufoff, gbase, voff) do { _Pragma("unroll") for (int _i = 0; _i < 2; ++_i) \
        __builtin_amdgcn_global_load_lds((const unsigned*)((const char*)(gbase) + (voff)[_i]), (LAS unsigned*)(lds + (bufoff) + ldsw + _i * 8192), 16, 0, 0); } while (0)
typedef int v8i32a __attribute__((ext_vector_type(8), aligned(16)));
#define PG8_LD32(p) (*(const LAS v8i32a*)(p))
#define PG8_LDA(dst, b, h) do { _Pragma("unroll") for (int m = 0; m < 4; ++m) { if constexpr (F8) { dst[m].f8 = __builtin_bit_cast(v8i32, PG8_LD32(lds + PG8_SA(b, h) + aoff + m * 2048)); } \
        else { _Pragma("unroll") for (int k = 0; k < 2; ++k) dst[m].hv[k] = *(const LAS bf16x8*)(lds + PG8_SA(b, h) + aoff + m * 2048 + k * 1024); } } } while (0)
#define PG8_LDB(dst, b, h) do { _Pragma("unroll") for (int n = 0; n < 2; ++n) { if constexpr (F8) { dst[n].f8 = __builtin_bit_cast(v8i32, PG8_LD32(lds + PG8_SB(b, h) + boff + n * 2048)); } \
        else { _Pragma("unroll") for (int k = 0; k < 2; ++k) dst[n].hv[k] = *(const LAS bf16x8*)(lds + PG8_SB(b, h) + boff + n * 2048 + k * 1024); } } } while (0)
#define PG8_MMA(ai, bj, At, Bt) do { __builtin_amdgcn_s_setprio(1); _Pragma("unroll") for (int m = 0; m < 4; ++m) _Pragma("unroll") for (int n = 0; n < 2; ++n) { \
        if constexpr (F8) { asm volatile("v_mfma_scale_f32_16x16x128_f8f6f4 %0, %1, %2, %0, %3, %4 op_sel_hi:[0,0,0]" : "+v"(acc[ai][bj][m][n]) : "v"(Bt[n].f8), "v"(At[m].f8), "v"(scW), "v"(scA)); } \
        else { _Pragma("unroll") for (int k = 0; k < 2; ++k) acc[ai][bj][m][n] = __builtin_amdgcn_mfma_f32_16x16x32_bf16(Bt[n].hv[k], At[m].hv[k], acc[ai][bj][m][n], 0, 0, 0); } } \
        __builtin_amdgcn_s_setprio(0); } while (0)
#define PG8_WAIT_V(n) asm volatile("s_waitcnt vmcnt(" #n ")" ::: "memory")
#define PG8_WAIT_L(n) asm volatile("s_waitcnt lgkmcnt(" #n ")" ::: "memory")
#define PG8_BAR __builtin_amdgcn_s_barrier()
#define PG8_SCHED __builtin_amdgcn_sched_barrier(0)
    Unit cur, nxt; int ui = 0;
    if (!S.next(0, cur)) return;
    f32x4 acc[2][2][4][2];
#pragma unroll
    for (int a = 0; a < 2; ++a)
#pragma unroll
        for (int b = 0; b < 2; ++b)
#pragma unroll
            for (int m = 0; m < 4; ++m)
#pragma unroll
                for (int n = 0; n < 2; ++n) acc[a][b][m][n] = (f32x4){0.f, 0.f, 0.f, 0.f};
    struct FragH { bf16x8 hv[2]; }; struct Frag8 { v8i32 f8; };
    typename std::conditional<F8, Frag8, FragH>::type At[4], B0[2], B1[2];
    const char* cA = (const char*)g.A + (size_t)cur.pm * tstep; const char* cB = (const char*)g.Bt + (size_t)cur.pb * tstep;
    PG8_STAGE(PG8_SB(0, 0), cB, voffB); PG8_STAGE(PG8_SB(0, 1), cB + hstep, voffB); PG8_STAGE(PG8_SA(0, 0), cA, voffA); PG8_STAGE(PG8_SA(0, 1), cA + hstep, voffA);
    if (wr == 1) PG8_BAR;
    PG8_WAIT_V(2); PG8_BAR;
    PG8_STAGE(PG8_SB(1, 0), cB + kstep, voffB); PG8_STAGE(PG8_SA(1, 0), cA + kstep, voffA); PG8_STAGE(PG8_SB(1, 1), cB + hstep + kstep, voffB);
    PG8_WAIT_V(6); PG8_BAR;
    for (;;) {
        const bool has_next = S.next(ui + 1, nxt);
        const char* nA = has_next ? (const char*)g.A + (size_t)nxt.pm * tstep : cA; const char* nB = has_next ? (const char*)g.Bt + (size_t)nxt.pb * tstep : cB;
#pragma clang loop unroll(disable)
        for (int t = 0; t < nt; t += 2) {
            const bool last = (t == nt - 2);
            const char* a1 = cA + (size_t)(t + 1) * kstep;
            const char* a2 = last ? nA : cA + (size_t)(t + 2) * kstep; const char* b2 = last ? nB : cB + (size_t)(t + 2) * kstep;
            const char* a3 = a2 + kstep; const char* b3 = b2 + kstep;
            PG8_LDB(B0, 0, 0); PG8_LDB(B1, 0, 1); PG8_SCHED; PG8_LDA(At, 0, 0); PG8_STAGE(PG8_SA(1, 1), a1 + hstep, voffA);
            PG8_WAIT_V(8); PG8_WAIT_L(0); PG8_BAR; PG8_MMA(0, 0, At, B0); PG8_MMA(0, 1, At, B1); PG8_BAR; PG8_SCHED;
            PG8_LDA(At, 0, 1); PG8_STAGE(PG8_SB(0, 0), b2, voffB); PG8_STAGE(PG8_SB(0, 1), b2 + hstep, voffB); PG8_STAGE(PG8_SA(0, 0), a2, voffA);
            PG8_WAIT_V(8); PG8_WAIT_L(0); PG8_BAR; PG8_MMA(1, 0, At, B0); PG8_MMA(1, 1, At, B1); PG8_BAR; PG8_SCHED;
            PG8_LDB(B0, 1, 0); PG8_LDB(B1, 1, 1); PG8_SCHED; PG8_LDA(At, 1, 0); PG8_STAGE(PG8_SA(0, 1), a2 + hstep, voffA);
            PG8_WAIT_V(8); PG8_WAIT_L(0); PG8_BAR; PG8_MMA(0, 0, At, B0); PG8_MMA(0, 1, At, B1); PG8_BAR; PG8_SCHED;
            PG8_LDA(At, 1, 1); PG8_STAGE(PG8_SB(1, 0), b3, voffB); PG8_STAGE(PG8_SB(1, 1), b3 + hstep, voffB); PG8_STAGE(PG8_SA(1, 0), a3, voffA);
            PG8_WAIT_V(8); PG8_WAIT_L(0); PG8_BAR; PG8_MMA(1, 0, At, B0); PG8_MMA(1, 1, At, B1); PG8_BAR; PG8_SCHED;
        }
        if (wr == 0) PG8_BAR;
        if constexpr (F8) asm volatile("s_nop 15\n\ts_nop 15" ::: "memory");
        E(acc, cur, wr, wc, fr, fq);
        if (!has_next) break;
#pragma unroll
        for (int a = 0; a < 2; ++a)
#pragma unroll
            for (int b = 0; b < 2; ++b)
#pragma unroll
                for (int m = 0; m < 4; ++m)
#pragma unroll
                    for (int n = 0; n < 2; ++n) acc[a][b][m][n] = (f32x4){0.f, 0.f, 0.f, 0.f};
        cur = nxt; cA = nA; cB = nB; ++ui;
        if (wr == 1) PG8_BAR;
    }
    PG8_WAIT_V(0);
    PG8_BAR;
#undef PG8_SA
#undef PG8_SB
#undef PG8_STAGE
#undef PG8_LDA
#undef PG8_LDB
#undef PG8_MMA
#undef PG8_LD32
#undef PG8_WAIT_V
#undef PG8_WAIT_L
#undef PG8_BAR
#undef PG8_SCHED
}
}

struct Args { const float* in[30]; float* out; unsigned char* ws; int ph_lo, ph_hi; };

__device__ __forceinline__ void p0_transpose_item(const float* W, int K, int N, bf16_t* WT, int k0, int n0, int drow0, LAS float* scr, int lane) {
#pragma unroll 8
    for (int i = 0; i < 32; ++i) { const int kk = 2 * i + (lane >> 5); scr[kk * 33 + (lane & 31)] = W[(size_t)(k0 + kk) * N + n0 + (lane & 31)]; }
    asm volatile("s_waitcnt lgkmcnt(0)" ::: "memory");
    const int c = lane & 7;
#pragma unroll
    for (int j = 0; j < 4; ++j) { const int n = (lane >> 3) + 8 * j; const LAS float* s = scr + (8 * c) * 33 + n;
        u32x4 o; o.x = pk2(s[0 * 33], s[1 * 33]); o.y = pk2(s[2 * 33], s[3 * 33]); o.z = pk2(s[4 * 33], s[5 * 33]); o.w = pk2(s[6 * 33], s[7 * 33]);
        *(u32x4*)(WT + (size_t)(drow0 + n) * K + k0 + 8 * c) = o; }
    asm volatile("s_waitcnt lgkmcnt(0)" ::: "memory");
}
__device__ __forceinline__ void p0_transpose_item_f8(const float* W, int K, int N, unsigned char* WT, int k0, int n0, int drow0, LAS float* scr, int lane) {
#pragma unroll 8
    for (int i = 0; i < 32; ++i) { const int kk = 2 * i + (lane >> 5); scr[kk * 33 + (lane & 31)] = W[(size_t)(k0 + kk) * N + n0 + (lane & 31)]; }
    asm volatile("s_waitcnt lgkmcnt(0)" ::: "memory");
    const int c = lane & 3;
#pragma unroll
    for (int j = 0; j < 2; ++j) { const int n = (lane >> 2) + 16 * j; const LAS float* s = scr + (16 * c) * 33 + n;
        u32x4 o;
        o.x = pk4_fp8(s[0 * 33] * F8_W_MUL, s[1 * 33] * F8_W_MUL, s[2 * 33] * F8_W_MUL, s[3 * 33] * F8_W_MUL);
        o.y = pk4_fp8(s[4 * 33] * F8_W_MUL, s[5 * 33] * F8_W_MUL, s[6 * 33] * F8_W_MUL, s[7 * 33] * F8_W_MUL);
        o.z = pk4_fp8(s[8 * 33] * F8_W_MUL, s[9 * 33] * F8_W_MUL, s[10 * 33] * F8_W_MUL, s[11 * 33] * F8_W_MUL);
        o.w = pk4_fp8(s[12 * 33] * F8_W_MUL, s[13 * 33] * F8_W_MUL, s[14 * 33] * F8_W_MUL, s[15 * 33] * F8_W_MUL);
        *(u32x4*)(WT + (size_t)(drow0 + n) * K + k0 + 16 * c) = o; }
    asm volatile("s_waitcnt lgkmcnt(0)" ::: "memory");
}
__device__ __forceinline__ void p0_prologue(LAS unsigned char* lds, const Args& a, int G) {
    const int tid = threadIdx.x, lane = tid & 63, wave = __builtin_amdgcn_readfirstlane(tid >> 6);
    LAS float* scr = (LAS float*)(lds + wave * 16384);
    const int gw = blockIdx.x * 8 + wave, NGW = G * 8;
    unsigned char* ws = a.ws;
    bf16_t* Wint = (bf16_t*)(ws + WS_WINT); bf16_t* Woutt = (bf16_t*)(ws + WS_WOUT); unsigned char* W1t = ws + WS_W1T; unsigned char* W2t = ws + WS_W2T;
    constexpr int I_IN = 16 * (NIN / 32);
    constexpr int I_OUT = 16 * 32;
    constexpr int I_W1 = 16 * 64;
    constexpr int I_W2 = 16 * 32;
    constexpr int NITEMS = I_IN + I_OUT + NE * I_W1 + NE * I_W2;
    for (int it = gw; it < NITEMS; it += NGW) {
        int r = it;
        if (r < I_IN) { const int nblk = NIN / 32, kb = r / nblk, nb = r % nblk; p0_transpose_item(a.in[2], 1024, NIN, Wint, 64 * kb, 32 * nb, 32 * nb, scr, lane); continue; } r -= I_IN;
        if (r < I_OUT) { const int kb = r / 32, nb = r % 32; p0_transpose_item(a.in[22], 1024, 1024, Woutt, 64 * kb, 32 * nb, 32 * nb, scr, lane); continue; } r -= I_OUT;
        if (r < NE * I_W1) { const int e = r / I_W1, q = r % I_W1, kb = q / 64, nb = q % 64; const int n0 = 32 * nb;
            const int drow = (n0 < 1024) ? ((n0 >> 7) * 256 + (n0 & 127)) : (((n0 - 1024) >> 7) * 256 + 128 + ((n0 - 1024) & 127));
            p0_transpose_item_f8(a.in[26] + (size_t)e * 1024 * 2048, 1024, 2048, W1t + (size_t)e * 2048 * 1024, 64 * kb, n0, drow, scr, lane); continue; } r -= NE * I_W1;
        { const int e = r / I_W2, q = r % I_W2, kb = q / 32, nb = q % 32;
            p0_transpose_item_f8(a.in[28] + (size_t)e * 1024 * 1024, 1024, 1024, W2t + (size_t)e * 1024 * 1024, 64 * kb, 32 * nb, 32 * nb, scr, lane); }
    }
    const float* x = a.in[0]; const float* g1 = a.in[1]; bf16_t* XN = (bf16_t*)(ws + WS_XN);
    f32x4 gv[4];
#pragma unroll
    for (int j = 0; j < 4; ++j) gv[j] = *((const f32x4*)g1 + lane + 64 * j);
    for (int m = gw; m < T; m += NGW) {
        const f32x4* xr = (const f32x4*)(x + (size_t)m * D) + lane;
        f32x4 v[4]; float s = 0.f;
#pragma unroll
        for (int j = 0; j < 4; ++j) { v[j] = xr[64 * j]; s += (v[j].x * v[j].x + v[j].y * v[j].y) + (v[j].z * v[j].z + v[j].w * v[j].w); }
        const float rstd = 1.0f / sqrtf(wave_sum(s) * (1.0f / D) + 1e-5f);
        u32x2* o8 = (u32x2*)(XN + (size_t)m * D) + lane;
#pragma unroll
        for (int j = 0; j < 4; ++j) { u32x2 w; w.x = pk2(v[j].x * rstd * gv[j].x, v[j].y * rstd * gv[j].y); w.y = pk2(v[j].z * rstd * gv[j].z, v[j].w * rstd * gv[j].w); o8[64 * j] = w; }
    }
}

__device__ __forceinline__ f32x4 cvlo(const u32x4 u) { return (f32x4){bflo(u.x), bfhi(u.x), bflo(u.y), bfhi(u.y)}; }
__device__ __forceinline__ f32x4 cvhi(const u32x4 u) { return (f32x4){bflo(u.z), bfhi(u.z), bflo(u.w), bfhi(u.w)}; }
__device__ __forceinline__ u32x4 pk8(const f32x4 lo, const f32x4 hi) { u32x4 w; w.x = pk2(lo.x, lo.y); w.y = pk2(lo.z, lo.w); w.z = pk2(hi.x, hi.y); w.w = pk2(hi.z, hi.w); return w; }
__device__ __forceinline__ void p2_prep(LAS unsigned char* lds, const Args& a) {
    const int tid = threadIdx.x, lane = tid & 63, wave = __builtin_amdgcn_readfirstlane(tid >> 6);
    unsigned char* ws = a.ws;
    const bf16_t* P = (const bf16_t*)(ws + WS_P);
    bf16_t* SR = (bf16_t*)(ws + WS_SR); bf16_t* SK = (bf16_t*)(ws + WS_SK); bf16_t* SV = (bf16_t*)(ws + WS_SV); bf16_t* SA = (bf16_t*)(ws + WS_SA); bf16_t* SB = (bf16_t*)(ws + WS_SB);
    float* SW = (float*)(ws + WS_SW); bf16_t* SG = (bf16_t*)(ws + WS_SG); bf16_t* QN = (bf16_t*)(ws + WS_QN); bf16_t* KN = (bf16_t*)(ws + WS_KN);
    const float* mu = a.in[3]; const float* w0 = a.in[4]; const float* w2 = a.in[5]; const float* a0 = a.in[6]; const float* a2 = a.in[7]; const float* g2 = a.in[8];
    const float* k_k = a.in[9]; const float* k_a = a.in[10]; const float* qn_g = a.in[14]; const float* kn_g = a.in[15];
    LAS unsigned char* ACT = lds;
    LAS float* DEC = (LAS float*)(lds + 8192); LAS float* ALR = (LAS float*)(lds + 40960); LAS float* GG = (LAS float*)(lds + 73728);
    bf16x8 bw[4][5];
    const int fcol = lane & 15, fk = (lane >> 4) * 8;
#pragma unroll
    for (int cb = 0; cb < 4; ++cb) {
        const int col = wave * 64 + cb * 16 + fcol;
#pragma unroll
        for (int kb = 0; kb < 5; ++kb) {
            const float* src = (kb == 0) ? (w2 + (size_t)fk * CW + col) : (kb == 1) ? (a2 + (size_t)fk * CW + col) : (g2 + (size_t)((kb - 2) * 32 + fk) * CW + col);
            u32x4 w; w.x = pk2(src[0], src[CW]); w.y = pk2(src[2 * CW], src[3 * CW]); w.z = pk2(src[4 * CW], src[5 * CW]); w.w = pk2(src[6 * CW], src[7 * CW]);
            bw[cb][kb] = __builtin_bit_cast(bf16x8, w);
        }
    }
    float w0c[4], a0c[4];
#pragma unroll
    for (int cb = 0; cb < 4; ++cb) { w0c[cb] = w0[wave * 64 + cb * 16 + fcol]; a0c[cb] = a0[wave * 64 + cb * 16 + fcol]; }
    const int c8 = lane * 8;
    const int TPB = T / (int)gridDim.x;
    const int tb0 = blockIdx.x * TPB;
    for (int t0 = tb0; t0 < tb0 + TPB; t0 += 16) {
        if (tid < 320) {
            const int tok = tid / 20, ch = tid - tok * 20, t = t0 + tok, col = 1536 + ch * 8;
            const u32x4 cu = *(const u32x4*)(P + (size_t)t * NINP + col);
            u32x4 pu = (u32x4){0u, 0u, 0u, 0u};
            if (t & (SEQ - 1)) pu = *(const u32x4*)(P + (size_t)(t - 1) * NINP + col);
            const f32x4 m0 = *(const f32x4*)(mu + col), m1 = *(const f32x4*)(mu + col + 4);
            const f32x4 c0 = cvlo(cu), c1 = cvhi(cu), p0 = cvlo(pu), p1 = cvhi(pu);
            f32x4 s0 = c0 + (p0 - c0) * m0, s1 = c1 + (p1 - c1) * m1;
            if (ch < 4) {
#pragma unroll
                for (int i = 0; i < 4; ++i) { const float e0 = __expf(-2.0f * fabsf(s0[i])), e1 = __expf(-2.0f * fabsf(s1[i])); const float th0 = (1.0f - e0) / (1.0f + e0), th1 = (1.0f - e1) / (1.0f + e1);
                    s0[i] = s0[i] < 0.f ? -th0 : th0; s1[i] = s1[i] < 0.f ? -th1 : th1; }
            } else if (ch >= 8) {
#pragma unroll
                for (int i = 0; i < 4; ++i) { s0[i] = sigmoidf_(s0[i]); s1[i] = sigmoidf_(s1[i]); }
            }
            *(LAS u32x4*)(ACT + tok * 320 + ch * 16) = pk8(s0, s1);
        }
        __syncthreads();
        {
            bf16x8 af[5];
#pragma unroll
            for (int kb = 0; kb < 5; ++kb) af[kb] = *(const LAS bf16x8*)(ACT + fcol * 320 + kb * 64 + (lane >> 4) * 16);
#pragma unroll
            for (int cb = 0; cb < 4; ++cb) {
                const f32x4 z = {0.f, 0.f, 0.f, 0.f};
                const f32x4 aw = __builtin_amdgcn_mfma_f32_16x16x32_bf16(af[0], bw[cb][0], z, 0, 0, 0);
                const f32x4 aa = __builtin_amdgcn_mfma_f32_16x16x32_bf16(af[1], bw[cb][1], z, 0, 0, 0);
                f32x4 ag = __builtin_amdgcn_mfma_f32_16x16x32_bf16(af[2], bw[cb][2], z, 0, 0, 0);
                ag = __builtin_amdgcn_mfma_f32_16x16x32_bf16(af[3], bw[cb][3], ag, 0, 0, 0);
                ag = __builtin_amdgcn_mfma_f32_16x16x32_bf16(af[4], bw[cb][4], ag, 0, 0, 0);
                const int col = wave * 64 + cb * 16 + fcol;
#pragma unroll
                for (int i = 0; i < 4; ++i) { const int row = (lane >> 4) * 4 + i;
                    DEC[row * 512 + col] = __expf(-0.6065306597126334f * sigmoidf_(aw[i] + w0c[cb]));
                    ALR[row * 512 + col] = sigmoidf_(aa[i] + a0c[cb]);
                    GG[row * 512 + col] = ag[i]; }
            }
        }
        __syncthreads();
#pragma unroll 1
        for (int q = 0; q < 2; ++q) {
            const int tok = 2 * wave + q, t = t0 + tok; const size_t o = (size_t)t * CW + c8;
            const bf16_t* pr = P + (size_t)t * NINP + c8;
            const bool first = (t & (SEQ - 1)) == 0;
            const u32x4 zz = (u32x4){0u, 0u, 0u, 0u};
            f32x4 rr0, rr1;
            { const u32x4 cu = *(const u32x4*)(pr), pu = first ? zz : *(const u32x4*)(pr - NINP);
              const f32x4 m0 = *(const f32x4*)(mu + c8), m1 = *(const f32x4*)(mu + c8 + 4);
              const f32x4 c0 = cvlo(cu), c1 = cvhi(cu), p0 = cvlo(pu), p1 = cvhi(pu);
              rr0 = c0 + (p0 - c0) * m0; rr1 = c1 + (p1 - c1) * m1; *(u32x4*)(SR + o) = pk8(rr0, rr1); }
            { const u32x4 cu = *(const u32x4*)(pr + 1024), pu = first ? zz : *(const u32x4*)(pr - NINP + 1024);
              const f32x4 m0 = *(const f32x4*)(mu + 1024 + c8), m1 = *(const f32x4*)(mu + 1024 + c8 + 4);
              const f32x4 c0 = cvlo(cu), c1 = cvhi(cu), p0 = cvlo(pu), p1 = cvhi(pu);
              *(u32x4*)(SV + o) = pk8(c0 + (p0 - c0) * m0, c1 + (p1 - c1) * m1); }
            { const u32x4 cu = *(const u32x4*)(pr + 512), pu = first ? zz : *(const u32x4*)(pr - NINP + 512);
              const f32x4 m0 = *(const f32x4*)(mu + 512 + c8), m1 = *(const f32x4*)(mu + 512 + c8 + 4);
              const f32x4 c0 = cvlo(cu), c1 = cvhi(cu), p0 = cvlo(pu), p1 = cvhi(pu);
              const f32x4 k0 = c0 + (p0 - c0) * m0, k1 = c1 + (p1 - c1) * m1;
              const f32x4 kk0 = k0 * *(const f32x4*)(k_k + c8), kk1 = k1 * *(const f32x4*)(k_k + c8 + 4);
              float ss = (kk0.x * kk0.x + kk0.y * kk0.y) + (kk0.z * kk0.z + kk0.w * kk0.w) + (kk1.x * kk1.x + kk1.y * kk1.y) + (kk1.z * kk1.z + kk1.w * kk1.w);
              ss = red8(ss);
              const float inv = 1.0f / sqrtf(fmaxf(ss, 1e-24f));
              const f32x4 kn0 = kk0 * inv, kn1 = kk1 * inv;
              const f32x4 al0 = *(const LAS f32x4*)(ALR + tok * 512 + c8), al1 = *(const LAS f32x4*)(ALR + tok * 512 + c8 + 4);
              const f32x4 k20 = k0 * (1.0f + (al0 - 1.0f) * *(const f32x4*)(k_a + c8)), k21 = k1 * (1.0f + (al1 - 1.0f) * *(const f32x4*)(k_a + c8 + 4));
              *(u32x4*)(SK + o) = pk8(k20, k21); *(u32x4*)(SA + o) = pk8(-kn0, -kn1); *(u32x4*)(SB + o) = pk8(kn0 * al0, kn1 * al1);
              const f32x4 q0 = rr0 * k20 * *(const f32x4*)(a.in[11] + c8), q1 = rr1 * k21 * *(const f32x4*)(a.in[11] + c8 + 4);
              const float rk = red8((q0.x + q0.y) + (q0.z + q0.w) + (q1.x + q1.y) + (q1.z + q1.w));
              if ((lane & 7) == 0) ((float*)(ws + WS_RK))[(size_t)t * 8 + (lane >> 3)] = rk; }
            { const f32x4 de0 = *(const LAS f32x4*)(DEC + tok * 512 + c8), de1 = *(const LAS f32x4*)(DEC + tok * 512 + c8 + 4);
              const f32x4 gg0 = *(const LAS f32x4*)(GG + tok * 512 + c8), gg1 = *(const LAS f32x4*)(GG + tok * 512 + c8 + 4);
              *(u32x4*)(SG + o) = pk8(gg0, gg1); *(f32x4*)(SW + o) = de0; *(f32x4*)(SW + o + 4) = de1; }
            { const u32x4 uq = *(const u32x4*)(pr + DQ0), ukd = *(const u32x4*)(pr + DK0);
              const f32x4 q0 = cvlo(uq), q1 = cvhi(uq), d0 = cvlo(ukd), d1 = cvhi(ukd);
              float qs = (q0.x * q0.x + q0.y * q0.y) + (q0.z * q0.z + q0.w * q0.w) + (q1.x * q1.x + q1.y * q1.y) + (q1.z * q1.z + q1.w * q1.w);
              float ks = (d0.x * d0.x + d0.y * d0.y) + (d0.z * d0.z + d0.w * d0.w) + (d1.x * d1.x + d1.y * d1.y) + (d1.z * d1.z + d1.w * d1.w);
              qs = red8(qs); ks = red8(ks);
              const float qi = (1.0f / sqrtf(qs * (1.0f / 64.0f) + 1e-5f)) * (0.125f * LOG2E), ki = 1.0f / sqrtf(ks * (1.0f / 64.0f) + 1e-5f);
              const f32x4 g0 = *(const f32x4*)(qn_g + (c8 & 63)), g1 = *(const f32x4*)(qn_g + (c8 & 63) + 4), h0 = *(const f32x4*)(kn_g + (c8 & 63)), h1 = *(const f32x4*)(kn_g + (c8 & 63) + 4);
              *(u32x4*)(QN + o) = pk8(q0 * qi * g0, q1 * qi * g1);
              *(u32x4*)(KN + o) = pk8(d0 * ki * h0, d1 * ki * h1); }
        }
        __syncthreads();
    }
}

namespace ck {
constexpr int PS = 136;
constexpr int O_BT = 0, O_KT = 8704, O_AP = 17408, O_RT = 26112;
constexpr int O_AT = 34816, O_BH = 43008, O_KH = 51200, O_VV = 59392, O_TN = 67584, O_A2 = 75776, O_V2 = 83968;
constexpr int O_L = 92160, LSTR = 68;
constexpr int O_TOT = 109568, O_GC = 111616;
__device__ __forceinline__ int crow(int r, int hi) { return (r & 3) + 8 * (r >> 2) + 4 * hi; }
__device__ __forceinline__ int voff(int row, int col) { return ((col >> 5) * 4 + (row >> 4)) * 1024 + (row & 15) * 64 + (col & 31) * 2; }
__device__ __forceinline__ s16x4 vtr(const LAS unsigned char* p) { return __builtin_bit_cast(s16x4, __builtin_amdgcn_ds_read_tr16_b64_v4i16((LAS s16x4*)p)); }
__device__ __forceinline__ bf16x8 fragP(const LAS unsigned char* M, int row, int k0, int hi) {
    const LAS unsigned char* p = M + row * PS + (k0 + 4 * hi) * 2; const s16x4 lo = *(const LAS s16x4*)p, h = *(const LAS s16x4*)(p + 16);
    return (bf16x8){lo[0], lo[1], lo[2], lo[3], h[0], h[1], h[2], h[3]}; }
__device__ __forceinline__ bf16x8 fragT(const LAS unsigned char* M, int k0, int colblk, int lane, int hi) {
    const LAS unsigned char* p = M + (colblk * 4 + (k0 >> 4)) * 1024 + ((lane >> 4) & 1) * 32 + (lane & 3) * 8 + (4 * hi + ((lane & 15) >> 2)) * 64;
    const s16x4 lo = vtr(p), h = vtr(p + 512); return (bf16x8){lo[0], lo[1], lo[2], lo[3], h[0], h[1], h[2], h[3]}; }
__device__ __forceinline__ bf16x8 packR(const f32x16& x, int s) {
    u32x4 w; w.x = pk2(x[8 * s], x[8 * s + 1]); w.y = pk2(x[8 * s + 2], x[8 * s + 3]); w.z = pk2(x[8 * s + 4], x[8 * s + 5]); w.w = pk2(x[8 * s + 6], x[8 * s + 7]); return __builtin_bit_cast(bf16x8, w); }
#define CK_MFMA(a, b, c) __builtin_amdgcn_mfma_f32_32x32x16_bf16(a, b, c, 0, 0, 0)
__device__ __forceinline__ f32x16 score(const LAS unsigned char* Am, const LAS unsigned char* Bm, int sblk, int tblk, int mode, int r32, int hi) {
    f32x16 x = f32x16{};
#pragma unroll
    for (int ks = 0; ks < 4; ++ks) x = CK_MFMA(fragP(Am, sblk * 32 + r32, 16 * ks, hi), fragP(Bm, tblk * 32 + r32, 16 * ks, hi), x);
    if (mode) {
        const int t = tblk * 32 + r32;
#pragma unroll
        for (int r = 0; r < 16; ++r) { const int s = sblk * 32 + crow(r, hi); if (mode == 1 ? !(s < t) : !(s <= t)) x[r] = 0.f; }
    }
    return x;
}
__device__ __forceinline__ void storeT_V(LAS unsigned char* M, const f32x16& x, int rb, int c, int hi) {
#pragma unroll
    for (int q = 0; q < 4; ++q) { u32x2 w; w.x = pk2(x[4 * q], x[4 * q + 1]); w.y = pk2(x[4 * q + 2], x[4 * q + 3]); *(LAS u32x2*)(M + voff(c, rb * 32 + 8 * q + 4 * hi)) = w; }
}
__device__ __forceinline__ void storeT_S(LAS unsigned char* M, const f32x16& x, int rb, int c, int hi) {
#pragma unroll
    for (int q = 0; q < 4; ++q) { u32x2 w; w.x = pk2(x[4 * q], x[4 * q + 1]); w.y = pk2(x[4 * q + 2], x[4 * q + 3]); *(LAS u32x2*)(M + c * PS + (rb * 32 + 8 * q + 4 * hi) * 2) = w; }
}

__device__ __forceinline__ void chunk_item(LAS unsigned char* lds, const Args& a, int item) {
    const int tid = threadIdx.x; int lane = tid & 63; const int wave = __builtin_amdgcn_readfirstlane(tid >> 6);
#define CK_FRESH() asm volatile("" : "+v"(lane)); r32 = lane & 31; hi = lane >> 5
    int r32, hi; CK_FRESH();
    unsigned char* ws = a.ws;
    const bf16_t* SR = (const bf16_t*)(ws + WS_SR); const bf16_t* SK = (const bf16_t*)(ws + WS_SK); const bf16_t* SV = (const bf16_t*)(ws + WS_SV);
    const bf16_t* SA = (const bf16_t*)(ws + WS_SA); const bf16_t* SB = (const bf16_t*)(ws + WS_SB); const float* SW = (const float*)(ws + WS_SW);
    bf16_t* CG = (bf16_t*)(ws + WS_CG) + (size_t)item * 4096; bf16_t* CH = (bf16_t*)(ws + WS_CH) + (size_t)item * 4096;
    bf16_t* CR2 = (bf16_t*)(ws + WS_CR2) + (size_t)item * 4096; bf16_t* CY0 = (bf16_t*)(ws + WS_CY0) + (size_t)item * 4096;
    const int bh = item >> 6, c = item & 63, b = bh >> 3, h = bh & 7, tokc = b * SEQ + c * 64, col0 = h * 64;
    LAS unsigned char* BT = lds + O_BT; LAS unsigned char* KT = lds + O_KT; LAS unsigned char* AP = lds + O_AP; LAS unsigned char* RT = lds + O_RT;
    LAS unsigned char* AT = lds + O_AT; LAS unsigned char* BH = lds + O_BH; LAS unsigned char* KH = lds + O_KH; LAS unsigned char* VV = lds + O_VV;
    LAS unsigned char* TN = lds + O_TN; LAS unsigned char* A2M = lds + O_A2; LAS unsigned char* V2M = lds + O_V2;
    LAS float* L = (LAS float*)(lds + O_L); LAS float* TOT = (LAS float*)(lds + O_TOT); LAS float* GC = (LAS float*)(lds + O_GC);
    {
        float loc[8];
#pragma unroll
        for (int i = 0; i < 8; ++i) { const float wv = SW[(size_t)(tokc + 8 * wave + i) * CW + col0 + lane]; loc[i] = i ? loc[i - 1] * wv : wv; }
        TOT[wave * 64 + lane] = loc[7];
        __syncthreads();
        float pre = 1.f, gC = 1.f;
#pragma unroll
        for (int w2 = 0; w2 < 8; ++w2) { const float tv = TOT[w2 * 64 + lane]; if (w2 < wave) pre *= tv; gC *= tv; }
        if (wave == 0) GC[lane] = gC;
#pragma unroll
        for (int i = 0; i < 8; ++i) {
            const int tl = 8 * wave + i; const size_t o = (size_t)(tokc + tl) * CW + col0 + lane;
            const float g = pre * loc[i], gp = i ? pre * loc[i - 1] : pre, ig = 1.0f / g;
            const float av = bf2f(SA[o]), bv = bf2f(SB[o]), kv = bf2f(SK[o]), rv = bf2f(SR[o]), vv = bf2f(SV[o]);
            const unsigned short at = (unsigned short)f2bf(av * gp);
            *(LAS unsigned short*)(AP + tl * PS + lane * 2) = at; *(LAS unsigned short*)(AT + voff(tl, lane)) = at;
            *(LAS unsigned short*)(RT + tl * PS + lane * 2) = (unsigned short)f2bf(rv * g);
            *(LAS unsigned short*)(BT + tl * PS + lane * 2) = (unsigned short)f2bf(bv * ig);
            *(LAS unsigned short*)(KT + tl * PS + lane * 2) = (unsigned short)f2bf(kv * ig);
            *(LAS unsigned short*)(BH + voff(tl, lane)) = (unsigned short)f2bf(bv * ig * gC);
            *(LAS unsigned short*)(KH + voff(tl, lane)) = (unsigned short)f2bf(kv * ig * gC);
            *(LAS unsigned short*)(VV + voff(tl, lane)) = (unsigned short)f2bf(vv);
        }
    }
    __syncthreads();
    CK_FRESH();
    f32x16 pa = f32x16{}, pb = f32x16{}, pc = f32x16{}, pd = f32x16{};
#define w1a pa
#define w1b pb
#define xb0 pa
#define xb1 pb
#define y0a pc
#define y0b pd
    if (wave < 2) {
        for (int k = 0; k < (wave == 0 ? 2 : 1); ++k) {
            const int sblk = wave == 0 ? k : 0, tblk = wave == 0 ? k : 1;
            const f32x16 x = score(BT, AP, sblk, tblk, wave == 0 ? 1 : 0, r32, hi);
            const int t = tblk * 32 + r32;
#pragma unroll
            for (int q = 0; q < 4; ++q) *(LAS f32x4*)(L + t * LSTR + sblk * 32 + 8 * q + 4 * hi) = (f32x4){x[4 * q], x[4 * q + 1], x[4 * q + 2], x[4 * q + 3]};
        }
    }
    __syncthreads();
    CK_FRESH();
    if (wave == 6) {
        float x[32];
        const LAS float* Lr = L + (32 * hi) * LSTR + 32 * hi;
#pragma unroll
        for (int t = 0; t < 32; ++t) {
            float acc = (r32 == t) ? 1.f : 0.f;
#pragma unroll
            for (int s4 = 0; s4 * 4 < t; ++s4) {
                const f32x4 l = *(const LAS f32x4*)(Lr + t * LSTR + 4 * s4);
                if (4 * s4 + 0 < t) acc += l.x * x[4 * s4 + 0];
                if (4 * s4 + 1 < t) acc += l.y * x[4 * s4 + 1];
                if (4 * s4 + 2 < t) acc += l.z * x[4 * s4 + 2];
                if (4 * s4 + 3 < t) acc += l.w * x[4 * s4 + 3];
            }
            x[t] = acc;
            __builtin_amdgcn_sched_barrier(0);
        }
        const int cc = 32 * hi + r32;
#pragma unroll
        for (int t0 = 0; t0 < 32; t0 += 8) { u32x4 w; w.x = pk2(x[t0], x[t0 + 1]); w.y = pk2(x[t0 + 2], x[t0 + 3]); w.z = pk2(x[t0 + 4], x[t0 + 5]); w.w = pk2(x[t0 + 6], x[t0 + 7]);
            *(LAS u32x4*)(TN + voff(cc, 32 * hi + t0)) = w; }
        f32x16 m = f32x16{};
#pragma unroll
        for (int s = 0; s < 2; ++s) {
            const LAS float* lp = L + (32 + r32) * LSTR + 16 * s + 4 * hi;
            const f32x4 l0 = *(const LAS f32x4*)lp, l1 = *(const LAS f32x4*)(lp + 8);
            u32x4 aw; aw.x = pk2(l0.x, l0.y); aw.y = pk2(l0.z, l0.w); aw.z = pk2(l1.x, l1.y); aw.w = pk2(l1.z, l1.w);
            const s16x4 b0 = *(const LAS s16x4*)(TN + voff(r32, 16 * s + 4 * hi)), b1 = *(const LAS s16x4*)(TN + voff(r32, 16 * s + 8 + 4 * hi));
            m = CK_MFMA(__builtin_bit_cast(bf16x8, aw), ((bf16x8){b0[0], b0[1], b0[2], b0[3], b1[0], b1[1], b1[2], b1[3]}), m);
        }
        f32x16 t21 = f32x16{};
#pragma unroll
        for (int s = 0; s < 2; ++s) t21 = CK_MFMA(fragT(TN, 32 + 16 * s, 1, lane, hi), packR(m, s), t21);
        storeT_V(TN, t21, 1, r32, hi);
    } else if (wave < 4) {
        const int dvb = wave - 2;
        const f32x16 x00 = score(KT, AP, 0, 0, 1, r32, hi), x01 = score(KT, AP, 0, 1, 0, r32, hi), x11 = score(KT, AP, 1, 1, 1, r32, hi);
#pragma unroll
        for (int s = 0; s < 2; ++s) {
            const bf16x8 v0 = fragT(VV, 16 * s, dvb, lane, hi), v1 = fragT(VV, 32 + 16 * s, dvb, lane, hi);
            w1a = CK_MFMA(packR(x00, s), v0, w1a);
            w1b = CK_MFMA(packR(x01, s), v0, w1b);
            w1b = CK_MFMA(packR(x11, s), v1, w1b);
        }
    } else if (wave < 6) {
        const int tb = wave - 4;
        f32x16 xk0, xk1 = f32x16{};
        if (tb == 0) { xk0 = score(KT, RT, 0, 0, 2, r32, hi); xb0 = score(BT, RT, 0, 0, 2, r32, hi); }
        else { xk0 = score(KT, RT, 0, 1, 0, r32, hi); xk1 = score(KT, RT, 1, 1, 2, r32, hi); xb0 = score(BT, RT, 0, 1, 0, r32, hi); xb1 = score(BT, RT, 1, 1, 2, r32, hi); }
#pragma unroll
        for (int s = 0; s < 2; ++s) {
            y0a = CK_MFMA(fragT(VV, 16 * s, 0, lane, hi), packR(xk0, s), y0a);
            y0b = CK_MFMA(fragT(VV, 16 * s, 1, lane, hi), packR(xk0, s), y0b);
            if (tb == 1) { y0a = CK_MFMA(fragT(VV, 32 + 16 * s, 0, lane, hi), packR(xk1, s), y0a); y0b = CK_MFMA(fragT(VV, 32 + 16 * s, 1, lane, hi), packR(xk1, s), y0b); }
        }
    }
    __syncthreads();
    CK_FRESH();
    if (wave < 2) {
        const int cb = wave; f32x16 a0 = f32x16{}, a1 = f32x16{};
#pragma unroll
        for (int ks = 0; ks < 4; ++ks) {
            const bf16x8 af = fragT(AT, 16 * ks, cb, lane, hi);
            if (ks < 2) a0 = CK_MFMA(af, fragT(TN, 16 * ks, 0, lane, hi), a0);
            a1 = CK_MFMA(af, fragT(TN, 16 * ks, 1, lane, hi), a1);
        }
        storeT_V(A2M, a0, cb, r32, hi); storeT_V(A2M, a1, cb, 32 + r32, hi);
    } else if (wave < 4) {
        const int dvb = wave - 2; f32x16 v0 = f32x16{}, v1 = f32x16{};
#pragma unroll
        for (int s = 0; s < 2; ++s) {
            v0 = CK_MFMA(packR(w1a, s), fragT(TN, 16 * s, 0, lane, hi), v0);
            v1 = CK_MFMA(packR(w1a, s), fragT(TN, 16 * s, 1, lane, hi), v1);
            v1 = CK_MFMA(packR(w1b, s), fragT(TN, 32 + 16 * s, 1, lane, hi), v1);
        }
        storeT_V(V2M, v0, dvb, r32, hi); storeT_V(V2M, v1, dvb, 32 + r32, hi);
    }
    __syncthreads();
    CK_FRESH();
    if (wave >= 4 && wave < 6) {
        const int tb = wave - 4, t = tb * 32 + r32;
        f32x16 r0 = f32x16{}, r1 = f32x16{};
#pragma unroll
        for (int s = 0; s < 2; ++s) {
            const bf16x8 p0 = packR(xb0, s);
            r0 = CK_MFMA(fragT(A2M, 16 * s, 0, lane, hi), p0, r0); r1 = CK_MFMA(fragT(A2M, 16 * s, 1, lane, hi), p0, r1);
            y0a = CK_MFMA(fragT(V2M, 16 * s, 0, lane, hi), p0, y0a); y0b = CK_MFMA(fragT(V2M, 16 * s, 1, lane, hi), p0, y0b);
            if (tb == 1) { const bf16x8 p1 = packR(xb1, s);
                r0 = CK_MFMA(fragT(A2M, 32 + 16 * s, 0, lane, hi), p1, r0); r1 = CK_MFMA(fragT(A2M, 32 + 16 * s, 1, lane, hi), p1, r1);
                y0a = CK_MFMA(fragT(V2M, 32 + 16 * s, 0, lane, hi), p1, y0a); y0b = CK_MFMA(fragT(V2M, 32 + 16 * s, 1, lane, hi), p1, y0b); }
        }
#pragma unroll
        for (int q = 0; q < 4; ++q) {
            const u32x2 u0 = *(const LAS u32x2*)(RT + t * PS + (8 * q + 4 * hi) * 2), u1 = *(const LAS u32x2*)(RT + t * PS + (32 + 8 * q + 4 * hi) * 2);
            r0[4 * q] += bflo(u0.x); r0[4 * q + 1] += bfhi(u0.x); r0[4 * q + 2] += bflo(u0.y); r0[4 * q + 3] += bfhi(u0.y);
            r1[4 * q] += bflo(u1.x); r1[4 * q + 1] += bfhi(u1.x); r1[4 * q + 2] += bflo(u1.y); r1[4 * q + 3] += bfhi(u1.y);
        }
        storeT_S(BT, r0, 0, t, hi); storeT_S(BT, r1, 1, t, hi);
        storeT_S(KT, y0a, 0, t, hi); storeT_S(KT, y0b, 1, t, hi);
    } else if (wave < 2) {
        const int ib = wave, i = ib * 32 + r32; const float gci = GC[i];
        f32x16 g0 = f32x16{}, g1 = f32x16{};
#pragma unroll
        for (int ks = 0; ks < 4; ++ks) { const bf16x8 bf_ = fragT(BH, 16 * ks, ib, lane, hi);
            g0 = CK_MFMA(fragT(A2M, 16 * ks, 0, lane, hi), bf_, g0); g1 = CK_MFMA(fragT(A2M, 16 * ks, 1, lane, hi), bf_, g1); }
#pragma unroll
        for (int r = 0; r < 16; ++r) { if (crow(r, hi) == i) g0[r] += gci; if (32 + crow(r, hi) == i) g1[r] += gci; }
        storeT_S(AP, g0, 0, i, hi); storeT_S(AP, g1, 1, i, hi);
    } else {
        const int id = wave < 4 ? wave - 2 : wave - 4, ib = id >> 1, dvb = id & 1;
        f32x16 hh = f32x16{};
#pragma unroll
        for (int ks = 0; ks < 4; ++ks) {
            hh = CK_MFMA(fragT(BH, 16 * ks, ib, lane, hi), fragT(V2M, 16 * ks, dvb, lane, hi), hh);
            hh = CK_MFMA(fragT(KH, 16 * ks, ib, lane, hi), fragT(VV, 16 * ks, dvb, lane, hi), hh);
        }
        storeT_S((LAS unsigned char*)L, hh, ib, dvb * 32 + r32, hi);
    }
    __syncthreads();
    {
        const int row = tid >> 3, ch = tid & 7;
        const LAS unsigned char* s0 = BT + row * PS + ch * 16; const LAS unsigned char* s1 = KT + row * PS + ch * 16; const LAS unsigned char* s2 = AP + row * PS + ch * 16; const LAS unsigned char* s3 = (const LAS unsigned char*)L + row * PS + ch * 16;
        const u32x2 a0 = *(const LAS u32x2*)s0, a1 = *(const LAS u32x2*)(s0 + 8), b0 = *(const LAS u32x2*)s1, b1 = *(const LAS u32x2*)(s1 + 8);
        const u32x2 c0 = *(const LAS u32x2*)s2, c1 = *(const LAS u32x2*)(s2 + 8), d0 = *(const LAS u32x2*)s3, d1 = *(const LAS u32x2*)(s3 + 8);
        *(u32x4*)(CR2 + row * 64 + ch * 8) = (u32x4){a0.x, a0.y, a1.x, a1.y}; *(u32x4*)(CY0 + row * 64 + ch * 8) = (u32x4){b0.x, b0.y, b1.x, b1.y};
        *(u32x4*)(CG + row * 64 + ch * 8) = (u32x4){c0.x, c0.y, c1.x, c1.y}; *(u32x4*)(CH + row * 64 + ch * 8) = (u32x4){d0.x, d0.y, d1.x, d1.y};
    }
    __syncthreads();
#undef CK_FRESH
#undef w1a
#undef w1b
#undef xb0
#undef xb1
#undef y0a
#undef y0b
}
__device__ __forceinline__ void p2b_chunks(LAS unsigned char* lds, const Args& a) {
#pragma unroll 1
    for (int item = blockIdx.x; item < 4096; item += gridDim.x) chunk_item(lds, a, item);
}
}

namespace ck {
constexpr int SQ_MAT = 8704, SQ_BUF = 6 * SQ_MAT;
constexpr int SQ_OUT = 2 * SQ_BUF;
__device__ __forceinline__ bf16x8 lfrag(const LAS unsigned char* M, int row, int k0, int hi) { return fragP(M, row, k0, hi); }
__device__ __forceinline__ void linit(f32x16& x, const LAS unsigned char* M, int row, int cblk, int hi) {
#pragma unroll
    for (int q = 0; q < 4; ++q) { const u32x2 u = *(const LAS u32x2*)(M + row * PS + (cblk * 32 + 8 * q + 4 * hi) * 2); x[4 * q] = bflo(u.x); x[4 * q + 1] = bfhi(u.x); x[4 * q + 2] = bflo(u.y); x[4 * q + 3] = bfhi(u.y); }
}
__device__ __forceinline__ void seq_head(LAS unsigned char* lds, const Args& a, int bh) {
    const int tid = threadIdx.x, lane = tid & 63, r32 = lane & 31, hi = lane >> 5; const int wave = __builtin_amdgcn_readfirstlane(tid >> 6);
    unsigned char* ws = a.ws;
    const bf16_t* SV = (const bf16_t*)(ws + WS_SV); const bf16_t* SG = (const bf16_t*)(ws + WS_SG); const float* RK = (const float*)(ws + WS_RK); bf16_t* YMIX = (bf16_t*)(ws + WS_YMIX);
    const int b = bh >> 3, h = bh & 7, col0 = h * 64;
    const float* lng = a.in[12] + col0; const float* lnb = a.in[13] + col0;
#define SQ_LOAD(ch) do { const size_t item_ = (size_t)bh * 64 + (ch); LAS unsigned char* bb_ = lds + ((ch) & 1) * SQ_BUF; const size_t t0_ = (size_t)b * SEQ + (ch) * 64; \
        for (int p_ = tid - 128; p_ < 3072; p_ += 384) { const int m_ = p_ >> 9, q_ = p_ & 511, row_ = q_ >> 3, c8_ = (q_ & 7) * 8; u32x4 v_; \
            if (m_ == 0) v_ = *(const u32x4*)((const bf16_t*)(ws + WS_CG) + item_ * 4096 + row_ * 64 + c8_); \
            else if (m_ == 1) v_ = *(const u32x4*)((const bf16_t*)(ws + WS_CH) + item_ * 4096 + row_ * 64 + c8_); \
            else if (m_ == 2) v_ = *(const u32x4*)((const bf16_t*)(ws + WS_CR2) + item_ * 4096 + row_ * 64 + c8_); \
            else if (m_ == 3) v_ = *(const u32x4*)((const bf16_t*)(ws + WS_CY0) + item_ * 4096 + row_ * 64 + c8_); \
            else if (m_ == 4) v_ = *(const u32x4*)(SV + (t0_ + row_) * CW + col0 + c8_); \
            else v_ = *(const u32x4*)(SG + (t0_ + row_) * CW + col0 + c8_); \
            LAS unsigned char* d_ = bb_ + m_ * SQ_MAT + row_ * PS + c8_ * 2; *(LAS u32x2*)d_ = (u32x2){v_.x, v_.y}; *(LAS u32x2*)(d_ + 8) = (u32x2){v_.z, v_.w}; } } while (0)
#define SQ_STORE(ch) do { const LAS unsigned char* ob_ = lds + SQ_OUT + ((ch) & 1) * SQ_MAT; const size_t t0_ = (size_t)b * SEQ + (ch) * 64; \
        for (int p_ = tid - 128; p_ < 512; p_ += 384) { const int row_ = p_ >> 3, c8_ = (p_ & 7) * 8; const LAS unsigned char* s_ = ob_ + row_ * PS + c8_ * 2; \
            const u32x2 lo_ = *(const LAS u32x2*)s_, hi_ = *(const LAS u32x2*)(s_ + 8); *(u32x4*)(YMIX + (t0_ + row_) * D + col0 + c8_) = (u32x4){lo_.x, lo_.y, hi_.x, hi_.y}; } } while (0)
    if (wave >= 2) SQ_LOAD(0);
    __syncthreads();
    f32x16 X00 = f32x16{}, X01 = f32x16{}, X10 = f32x16{}, X11 = f32x16{};
#pragma unroll 1
    for (int c = 0; c < 64; ++c) {
        if (wave >= 2) {
            if (c + 1 < 64) SQ_LOAD(c + 1);
            if (c > 0) SQ_STORE(c - 1);
        } else {
            const int tb = wave;
            const LAS unsigned char* bb = lds + (c & 1) * SQ_BUF;
            const LAS unsigned char* MG = bb; const LAS unsigned char* MH = bb + SQ_MAT; const LAS unsigned char* MR = bb + 2 * SQ_MAT; const LAS unsigned char* MY = bb + 3 * SQ_MAT;
            const LAS unsigned char* MV = bb + 4 * SQ_MAT; const LAS unsigned char* MGT = bb + 5 * SQ_MAT;
            LAS unsigned char* OB = lds + SQ_OUT + (c & 1) * SQ_MAT;
            const int tl = tb * 32 + r32; const size_t t = (size_t)b * SEQ + c * 64 + tl;
            const float rk = RK[t * 8 + h];
            f32x16 y0, y1; linit(y0, MY, tl, 0, hi); linit(y1, MY, tl, 1, hi);
#pragma unroll
            for (int s = 0; s < 2; ++s) {
                const bf16x8 rf0 = lfrag(MR, tl, 16 * s, hi), rf1 = lfrag(MR, tl, 32 + 16 * s, hi);
                y0 = CK_MFMA(packR(X00, s), rf0, y0); y0 = CK_MFMA(packR(X10, s), rf1, y0);
                y1 = CK_MFMA(packR(X01, s), rf0, y1); y1 = CK_MFMA(packR(X11, s), rf1, y1);
            }
#pragma unroll
            for (int db = 0; db < 2; ++db) {
                f32x16 Na, Nb; linit(Na, MH, db * 32 + r32, 0, hi); linit(Nb, MH, db * 32 + r32, 1, hi);
#pragma unroll
                for (int s = 0; s < 2; ++s) {
                    const bf16x8 g00 = lfrag(MG, r32, 16 * s, hi), g01 = lfrag(MG, r32, 32 + 16 * s, hi), g10 = lfrag(MG, 32 + r32, 16 * s, hi), g11 = lfrag(MG, 32 + r32, 32 + 16 * s, hi);
                    const bf16x8 p0 = packR(db ? X01 : X00, s), p1 = packR(db ? X11 : X10, s);
                    Na = CK_MFMA(g00, p0, Na); Na = CK_MFMA(g01, p1, Na);
                    Nb = CK_MFMA(g10, p0, Nb); Nb = CK_MFMA(g11, p1, Nb);
                }
                if (db == 0) { X00 = Na; X10 = Nb; } else { X01 = Na; X11 = Nb; }
            }
            float sm = 0.f;
#pragma unroll
            for (int r = 0; r < 16; ++r) sm += y0[r] + y1[r];
            sm += __shfl_xor(sm, 32);
            const float mean = sm * (1.0f / 64.0f);
            float sq = 0.f;
#pragma unroll
            for (int r = 0; r < 16; ++r) { const float d0 = y0[r] - mean, d1 = y1[r] - mean; sq += d0 * d0 + d1 * d1; }
            sq += __shfl_xor(sq, 32);
            const float rs = 1.0f / sqrtf(sq * (1.0f / 64.0f) + 64e-5f);
#pragma unroll
            for (int db = 0; db < 2; ++db)
#pragma unroll
                for (int q = 0; q < 4; ++q) {
                    const int dv = db * 32 + 8 * q + 4 * hi;
                    const f32x4 lg = *(const f32x4*)(lng + dv), lb = *(const f32x4*)(lnb + dv);
                    const u32x2 uv = *(const LAS u32x2*)(MV + tl * PS + dv * 2), ug = *(const LAS u32x2*)(MGT + tl * PS + dv * 2);
                    const f32x4 vv = {bflo(uv.x), bfhi(uv.x), bflo(uv.y), bfhi(uv.y)}, gg = {bflo(ug.x), bfhi(ug.x), bflo(ug.y), bfhi(ug.y)};
                    f32x4 yy; if (db == 0) yy = (f32x4){y0[4 * q], y0[4 * q + 1], y0[4 * q + 2], y0[4 * q + 3]}; else yy = (f32x4){y1[4 * q], y1[4 * q + 1], y1[4 * q + 2], y1[4 * q + 3]};
                    const f32x4 o = ((yy - mean) * rs * lg + lb + rk * vv) * gg;
                    u32x2 w; w.x = pk2(o.x, o.y); w.y = pk2(o.z, o.w);
                    *(LAS u32x2*)(OB + tl * PS + dv * 2) = w;
                }
        }
        __syncthreads();
    }
    if (wave >= 2) SQ_STORE(63);
#undef SQ_LOAD
#undef SQ_STORE
}
}

__device__ __forceinline__ float red16(float v) {
    v += dpp_f<0xB1>(v); v += dpp_f<0x4E>(v); v += dpp_f<0x141>(v); v += dpp_f<0x140>(v);
    return v;
}
__device__ __forceinline__ void p3_scan(LAS unsigned char* lds, const Args& a) {
    const int tid = threadIdx.x, lane = tid & 63, wave = __builtin_amdgcn_readfirstlane(tid >> 6);
    unsigned char* ws = a.ws;
    const bf16_t* SR = (const bf16_t*)(ws + WS_SR); const bf16_t* SK = (const bf16_t*)(ws + WS_SK); const bf16_t* SV = (const bf16_t*)(ws + WS_SV);
    const bf16_t* SA = (const bf16_t*)(ws + WS_SA); const bf16_t* SB = (const bf16_t*)(ws + WS_SB); const float* SW = (const float*)(ws + WS_SW);
    float* YRAW = (float*)(ws + WS_YRAW);
    const int bh = blockIdx.x >> 1, half = blockIdx.x & 1;
    const int b = bh >> 3, h = bh & 7, tok0 = b * SEQ, col0 = h * 64, row0 = half * 32;
    constexpr int BUFB = 45056;
    LAS float* buf0 = (LAS float*)lds; LAS float* buf1 = (LAS float*)(lds + BUFB);
    LAS float* Y0 = (LAS float*)(lds + 2 * BUFB); LAS float* Y1 = Y0 + 1024;
    constexpr int NCH = SEQ / 32;
    if (wave >= 4) {
        const int lw = wave - 4, sl = lw * 8 + (lane >> 3), cg = lane & 7, c8 = cg * 8;
        f32x4 w0_, w1_; u32x4 uk, ua, ub, ur; u32x2 uv;
#define SC_ISSUE(ch) do { const size_t o_ = (size_t)(tok0 + (ch) * 32 + sl) * CW + col0; \
            w0_ = *(const f32x4*)(SW + o_ + c8); w1_ = *(const f32x4*)(SW + o_ + c8 + 4); uk = *(const u32x4*)(SK + o_ + c8); ua = *(const u32x4*)(SA + o_ + c8); ub = *(const u32x4*)(SB + o_ + c8); ur = *(const u32x4*)(SR + o_ + c8); \
            uv = *(const u32x2*)(SV + o_ + row0 + 4 * cg); } while (0)
#define SC_STORE(bufp) do { LAS float* d_ = (bufp) + sl * 64 + c8; *(LAS f32x4*)(d_) = w0_; *(LAS f32x4*)(d_ + 4) = w1_; \
            *(LAS f32x4*)(d_ + 2048) = cvlo(uk); *(LAS f32x4*)(d_ + 2052) = cvhi(uk); *(LAS f32x4*)(d_ + 4096) = cvlo(ua); *(LAS f32x4*)(d_ + 4100) = cvhi(ua); \
            *(LAS f32x4*)(d_ + 6144) = cvlo(ub); *(LAS f32x4*)(d_ + 6148) = cvhi(ub); *(LAS f32x4*)(d_ + 8192) = cvlo(ur); *(LAS f32x4*)(d_ + 8196) = cvhi(ur); \
            *(LAS f32x4*)((bufp) + 10240 + sl * 32 + 4 * cg) = (f32x4){bflo(uv.x), bfhi(uv.x), bflo(uv.y), bfhi(uv.y)}; } while (0)
#define SC_YOUT(ch, yp) do { *(f32x4*)(YRAW + (size_t)(tok0 + (ch) * 32 + sl) * CW + col0 + row0 + 4 * cg) = *(const LAS f32x4*)((yp) + sl * 32 + 4 * cg); } while (0)
        SC_ISSUE(0); SC_STORE(buf0);
        __syncthreads();
        for (int ch = 0; ch < NCH; ++ch) {
            LAS float* ob = (ch & 1) ? buf0 : buf1; const LAS float* oy = (ch & 1) ? Y0 : Y1;
            if (ch + 1 < NCH) SC_ISSUE(ch + 1);
            if (ch > 0) SC_YOUT(ch - 1, oy);
            if (ch + 1 < NCH) SC_STORE(ob);
            __syncthreads();
        }
        { const LAS float* oy = ((NCH - 1) & 1) ? Y1 : Y0; SC_YOUT(NCH - 1, oy); }
#undef SC_ISSUE
#undef SC_STORE
#undef SC_YOUT
    } else {
        const int g = lane & 7, rl = lane >> 3, row = wave * 8 + rl;
        f32x2 S0 = {0.f, 0.f}, S1 = S0, S2 = S0, S3 = S0;
        __syncthreads();
        for (int ch = 0; ch < NCH; ++ch) {
            const LAS float* cb = (ch & 1) ? buf1 : buf0; LAS float* yb = (ch & 1) ? Y1 : Y0;
            const LAS float* pa = cb + 4 * g; const LAS float* pv = cb + 10240 + row;
#define SC_LD(X, s_) const f32x4 w0##X = *(const LAS f32x4*)(pa + (s_) * 64), w1##X = *(const LAS f32x4*)(pa + (s_) * 64 + 32), k0##X = *(const LAS f32x4*)(pa + (s_) * 64 + 2048), k1##X = *(const LAS f32x4*)(pa + (s_) * 64 + 2080), \
                a0##X = *(const LAS f32x4*)(pa + (s_) * 64 + 4096), a1##X = *(const LAS f32x4*)(pa + (s_) * 64 + 4128), b0##X = *(const LAS f32x4*)(pa + (s_) * 64 + 6144), b1##X = *(const LAS f32x4*)(pa + (s_) * 64 + 6176), \
                r0##X = *(const LAS f32x4*)(pa + (s_) * 64 + 8192), r1##X = *(const LAS f32x4*)(pa + (s_) * 64 + 8224); const float v##X = pv[(s_) * 32]
#define LO(q) ((f32x2){(q).x, (q).y})
#define HI(q) ((f32x2){(q).z, (q).w})
#define SC_STEP(X, s_) do { f32x2 t = S0 * LO(a0##X); t = S1 * HI(a0##X) + t; t = S2 * LO(a1##X) + t; t = S3 * HI(a1##X) + t; float sa = t.x + t.y; \
                const f32x2 vv = {v##X, v##X}; \
                f32x2 p0 = S0 * LO(w0##X), p1 = S1 * HI(w0##X), p2 = S2 * LO(w1##X), p3 = S3 * HI(w1##X); \
                p0 = vv * LO(k0##X) + p0; p1 = vv * HI(k0##X) + p1; p2 = vv * LO(k1##X) + p2; p3 = vv * HI(k1##X) + p3; \
                sa = red8(sa); const f32x2 ss = {sa, sa}; \
                S0 = ss * LO(b0##X) + p0; S1 = ss * HI(b0##X) + p1; S2 = ss * LO(b1##X) + p2; S3 = ss * HI(b1##X) + p3; \
                f32x2 u = S0 * LO(r0##X); u = S1 * HI(r0##X) + u; u = S2 * LO(r1##X) + u; u = S3 * HI(r1##X) + u; float y = u.x + u.y; y = red8(y); \
                yb[(s_) * 32 + row] = y; } while (0)
#pragma unroll 1
            for (int s8 = 0; s8 < 32; s8 += 8) {
                SC_LD(0, s8 + 0); SC_LD(1, s8 + 1);
                SC_STEP(0, s8 + 0); SC_LD(2, s8 + 2);
                SC_STEP(1, s8 + 1); SC_LD(3, s8 + 3);
                SC_STEP(2, s8 + 2); SC_LD(4, s8 + 4);
                SC_STEP(3, s8 + 3); SC_LD(5, s8 + 5);
                SC_STEP(4, s8 + 4); SC_LD(6, s8 + 6);
                SC_STEP(5, s8 + 5); SC_LD(7, s8 + 7);
                SC_STEP(6, s8 + 6);
                SC_STEP(7, s8 + 7);
            }
#undef SC_LD
#undef LO
#undef HI
#undef SC_STEP
            __syncthreads();
        }
    }
}

__device__ __forceinline__ void p3_post(const Args& a, int G) {
    const int tid = threadIdx.x, lane = tid & 63, wave = __builtin_amdgcn_readfirstlane(tid >> 6);
    unsigned char* ws = a.ws;
    const bf16_t* SR = (const bf16_t*)(ws + WS_SR); const bf16_t* SK = (const bf16_t*)(ws + WS_SK); const bf16_t* SV = (const bf16_t*)(ws + WS_SV);
    const bf16_t* SG = (const bf16_t*)(ws + WS_SG); const float* YRAW = (const float*)(ws + WS_YRAW); bf16_t* YMIX = (bf16_t*)(ws + WS_YMIX);
    const int gw = blockIdx.x * 8 + wave, NGW = G * 8, c8 = lane * 8;
    const f32x4 lg0 = *(const f32x4*)(a.in[12] + c8), lg1 = *(const f32x4*)(a.in[12] + c8 + 4), lb0 = *(const f32x4*)(a.in[13] + c8), lb1 = *(const f32x4*)(a.in[13] + c8 + 4);
    const f32x4 rk0 = *(const f32x4*)(a.in[11] + c8), rk1 = *(const f32x4*)(a.in[11] + c8 + 4);
    for (int t = gw; t < T; t += NGW) {
        const size_t o = (size_t)t * CW + c8;
        const f32x4 y0 = *(const f32x4*)(YRAW + o), y1 = *(const f32x4*)(YRAW + o + 4);
        const u32x4 ur = *(const u32x4*)(SR + o), uk = *(const u32x4*)(SK + o), uv = *(const u32x4*)(SV + o), ug = *(const u32x4*)(SG + o);
        const float mean = red8((y0.x + y0.y) + (y0.z + y0.w) + (y1.x + y1.y) + (y1.z + y1.w)) * (1.0f / 64.0f);
        const f32x4 d0 = y0 - mean, d1 = y1 - mean;
        const float var = red8((d0.x * d0.x + d0.y * d0.y) + (d0.z * d0.z + d0.w * d0.w) + (d1.x * d1.x + d1.y * d1.y) + (d1.z * d1.z + d1.w * d1.w)) * (1.0f / 64.0f);
        const f32x4 r0 = cvlo(ur), r1 = cvhi(ur), k0 = cvlo(uk), k1 = cvhi(uk);
        const f32x4 p0 = r0 * k0 * rk0, p1 = r1 * k1 * rk1;
        const float rk = red8((p0.x + p0.y) + (p0.z + p0.w) + (p1.x + p1.y) + (p1.z + p1.w));
        const float rs = 1.0f / sqrtf(var + 64e-5f);
        const f32x4 o0 = (d0 * rs * lg0 + lb0 + rk * cvlo(uv)) * cvlo(ug), o1 = (d1 * rs * lg1 + lb1 + rk * cvhi(uv)) * cvhi(ug);
        *(u32x4*)(YMIX + (size_t)t * D + c8) = pk8(o0, o1);
    }
}

namespace att {
constexpr int SLOT = 32768, OFF_V = 16384;
constexpr int TBL_OFF = MISC_OFF + 1024;
constexpr int LW_OFF = MISC_OFF + 2048;
constexpr int CST_OFF = MISC_OFF + 3072;
__device__ __forceinline__ int crow(int r, int hi) { return (r & 3) + 8 * (r >> 2) + 4 * hi; }
__device__ __forceinline__ void glds16(const void* gsrc, unsigned lds_dst) { unsigned keep;
    asm volatile("s_mov_b32 %0, m0\n\ts_mov_b32 m0, %2\n\ts_nop 0\n\tglobal_load_lds_dwordx4 %1, off\n\ts_mov_b32 m0, %0" : "=&s"(keep) : "v"(gsrc), "s"(lds_dst) : "memory"); }
__device__ __forceinline__ s16x4 vtr(const LAS unsigned char* p) { return __builtin_bit_cast(s16x4, __builtin_amdgcn_ds_read_tr16_b64_v4i16((LAS s16x4*)p)); }

__device__ __forceinline__ void attn_unit(LAS unsigned char* lds, const Args& a, int b, int h, int qb, float negM, float lam) {
    const int tid = threadIdx.x, lane = tid & 63, r32 = lane & 31, hi = lane >> 5; const int wid = __builtin_amdgcn_readfirstlane(tid >> 6);
    const int c = wid >> 2, rg = wid & 3;
    unsigned char* ws = a.ws;
    const bf16_t* QN = (const bf16_t*)(ws + WS_QN); const bf16_t* KN = (const bf16_t*)(ws + WS_KN); const bf16_t* P = (const bf16_t*)(ws + WS_P); bf16_t* YMIX = (bf16_t*)(ws + WS_YMIX);
    const int q0 = qb * 128; const size_t rowbase = (size_t)b * SEQ;
    const int NT = 2 * qb + 2;
    LAS float* tbl = (LAS float*)(lds + TBL_OFF); LAS float* lw = (LAS float*)(lds + LW_OFF) + wid * 32;
    if (tid < 128) {
        const int n = tid; int bkt;
        if (n < 16) bkt = n; else { bkt = 16 + (int)(logf((float)n * (1.0f / 16.0f)) / 2.0794415416798357f * 16.0f); bkt = bkt > 31 ? 31 : bkt; }
        tbl[n] = (a.in[21][bkt * 4 + h] - a.in[21][31 * 4 + h]) * LOG2E;
    }
    const bf16_t* Qw = QN + (rowbase + q0 + rg * 32 + r32) * CW + h * 128 + c * 64;
    bf16x8 qr[4];
#pragma unroll
    for (int d0 = 0; d0 < 4; ++d0) qr[d0] = *(const bf16x8*)(Qw + d0 * 16 + hi * 8);
    const bf16_t* k0src = KN + (rowbase + lane) * CW + h * 128 + wid * 8;
    const bf16_t* k1src = k0src + 64;
    const int pv0 = 2 * wid, pv1 = 2 * wid + 1;
    const bf16_t* v0src = P + (rowbase + 16 * (pv0 & 3) + (lane >> 2)) * NINP + DV0 + h * 128 + 32 * (pv0 >> 2) + (lane & 3) * 8;
    const bf16_t* v1src = P + (rowbase + 16 * (pv1 & 3) + (lane >> 2)) * NINP + DV0 + h * 128 + 32 * (pv1 >> 2) + (lane & 3) * 8;
#define ATT_DMA(t, slot) do { const unsigned s_ = lds0 + (unsigned)(slot) * SLOT; \
        glds16(k0src + (size_t)(t) * 64 * CW, (unsigned)__builtin_amdgcn_readfirstlane(s_ + wid * 1024)); \
        glds16(k1src + (size_t)(t) * 64 * CW, (unsigned)__builtin_amdgcn_readfirstlane(s_ + 8192 + wid * 1024)); \
        glds16(v0src + (size_t)(t) * 64 * NINP, (unsigned)__builtin_amdgcn_readfirstlane(s_ + OFF_V + pv0 * 1024)); \
        glds16(v1src + (size_t)(t) * 64 * NINP, (unsigned)__builtin_amdgcn_readfirstlane(s_ + OFF_V + pv1 * 1024)); } while (0)
#define ATT_SBAR() __builtin_amdgcn_sched_barrier(0)
    const unsigned lds0 = (unsigned)(uintptr_t)lds;
    f32x16 o[4];
#pragma unroll
    for (int d0 = 0; d0 < 4; ++d0) o[d0] = f32x16{};
    float lsum = 0.f;
    const bool shift = negM < -60.0f;
    const int qmin = q0 + 32 * rg, qpos = qmin + r32;
    ATT_DMA(0, 0);
    asm volatile("s_waitcnt vmcnt(0)" ::: "memory");
    __syncthreads();
    for (int t = 0; t < NT; ++t) {
        if (t + 1 < NT) ATT_DMA(t + 1, (t + 1) & 1);
        const int kmin = 64 * t;
        if (kmin <= qmin + 31) {
            const LAS unsigned char* slot = lds + (t & 1) * SLOT;
            const LAS unsigned char* kb = slot + c * 8192 + hi * 1024 + r32 * 16;
            const LAS unsigned char* vb = slot + OFF_V + ((lane >> 4) & 1) * 32 + (lane & 3) * 8 + (4 * hi + ((lane & 15) >> 2)) * 64;
            bf16x8 kf[8];
#pragma unroll
            for (int d0 = 0; d0 < 4; ++d0) { kf[2 * d0] = *(const LAS bf16x8*)(kb + d0 * 2048); kf[2 * d0 + 1] = *(const LAS bf16x8*)(kb + d0 * 2048 + 512); }
            s16x4 va[16], vc[16];
#pragma unroll
            for (int i = 0; i < 8; ++i) { va[2 * i] = vtr(vb + (i >> 2) * 4096 + (i & 3) * 1024); va[2 * i + 1] = vtr(vb + (i >> 2) * 4096 + (i & 3) * 1024 + 512); }
            ATT_SBAR();
            f32x16 p0, p1;
            p0 = __builtin_amdgcn_mfma_f32_32x32x16_bf16(kf[0], qr[0], f32x16{}, 0, 0, 0); p1 = __builtin_amdgcn_mfma_f32_32x32x16_bf16(kf[1], qr[0], f32x16{}, 0, 0, 0);
#pragma unroll
            for (int d0 = 1; d0 < 4; ++d0) { p0 = __builtin_amdgcn_mfma_f32_32x32x16_bf16(kf[2 * d0], qr[d0], p0, 0, 0, 0); p1 = __builtin_amdgcn_mfma_f32_32x32x16_bf16(kf[2 * d0 + 1], qr[d0], p1, 0, 0, 0); }
            ATT_SBAR();
            if (qmin - (kmin + 63) < 113) {
#pragma unroll
                for (int r = 0; r < 16; ++r) {
                    const int d0_ = qpos - (kmin + crow(r, hi)); const int d1_ = d0_ - 32;
                    const float t0 = tbl[d0_ < 0 ? 0 : (d0_ > 127 ? 127 : d0_)], t1 = tbl[d1_ < 0 ? 0 : (d1_ > 127 ? 127 : d1_)];
                    p0[r] = d0_ < 0 ? -INFINITY : p0[r] + t0; p1[r] = d1_ < 0 ? -INFINITY : p1[r] + t1;
                }
            }
            if (shift) {
#pragma unroll
                for (int r = 0; r < 16; ++r) { p0[r] += negM; p1[r] += negM; }
            }
            float sacc = 0.f;
#pragma unroll
            for (int r = 0; r < 16; ++r) { p0[r] = __builtin_amdgcn_exp2f(p0[r]); p1[r] = __builtin_amdgcn_exp2f(p1[r]); sacc += p0[r] + p1[r]; }
            lsum += sacc;
            u32x4 pw[4];
#pragma unroll
            for (int i = 0; i < 4; ++i) { pw[0][i] = pk2(p0[2 * i], p0[2 * i + 1]); pw[1][i] = pk2(p0[8 + 2 * i], p0[8 + 2 * i + 1]); pw[2][i] = pk2(p1[2 * i], p1[2 * i + 1]); pw[3][i] = pk2(p1[8 + 2 * i], p1[8 + 2 * i + 1]); }
            ATT_SBAR();
#pragma unroll
            for (int i = 0; i < 8; ++i) { vc[2 * i] = vtr(vb + (2 + (i >> 2)) * 4096 + (i & 3) * 1024); vc[2 * i + 1] = vtr(vb + (2 + (i >> 2)) * 4096 + (i & 3) * 1024 + 512); }
#pragma unroll
            for (int i = 0; i < 8; ++i) {
                const bf16x8 vf = (bf16x8){va[2 * i][0], va[2 * i][1], va[2 * i][2], va[2 * i][3], va[2 * i + 1][0], va[2 * i + 1][1], va[2 * i + 1][2], va[2 * i + 1][3]};
                o[i >> 2] = __builtin_amdgcn_mfma_f32_32x32x16_bf16(__builtin_bit_cast(bf16x8, pw[i & 3]), vf, o[i >> 2], 0, 0, 0);
            }
#pragma unroll
            for (int i = 0; i < 8; ++i) {
                const bf16x8 vf = (bf16x8){vc[2 * i][0], vc[2 * i][1], vc[2 * i][2], vc[2 * i][3], vc[2 * i + 1][0], vc[2 * i + 1][1], vc[2 * i + 1][2], vc[2 * i + 1][3]};
                o[2 + (i >> 2)] = __builtin_amdgcn_mfma_f32_32x32x16_bf16(__builtin_bit_cast(bf16x8, pw[i & 3]), vf, o[2 + (i >> 2)], 0, 0, 0);
            }
        }
        asm volatile("s_waitcnt vmcnt(0)" ::: "memory");
        __syncthreads();
    }
#undef ATT_DMA
#undef ATT_SBAR
    lsum += __shfl_xor(lsum, 32);
    if (hi == 0) lw[r32] = 1.0f / lsum;
    asm volatile("s_waitcnt lgkmcnt(0)" ::: "memory");
    LAS float* stg = (LAS float*)(lds + wid * 16384);
#pragma unroll
    for (int r = 0; r < 16; ++r) { const int orow = crow(r, hi); const float il = lw[orow];
#pragma unroll
        for (int d0 = 0; d0 < 4; ++d0) stg[orow * 128 + d0 * 32 + r32] = o[d0][r] * il; }
    __syncthreads();
    {
        const int row = tid >> 2, part = tid & 3, rgp = row >> 5, rr = row & 31;
        const LAS float* s1 = (const LAS float*)(lds + rgp * 16384) + rr * 128 + part * 32;
        const LAS float* s2 = (const LAS float*)(lds + (4 + rgp) * 16384) + rr * 128 + part * 32;
        float dv[32]; float ss = 0.f;
#pragma unroll
        for (int i = 0; i < 8; ++i) { const f32x4 x1 = *(const LAS f32x4*)(s1 + 4 * i), x2 = *(const LAS f32x4*)(s2 + 4 * i);
#pragma unroll
            for (int j = 0; j < 4; ++j) { const float dd = x1[j] - lam * x2[j]; dv[4 * i + j] = dd; ss += dd * dd; } }
        ss = red4(ss);
        const float sc = (1.0f / sqrtf(ss * (1.0f / 128.0f) + 1e-5f)) * 0.8f;
        const float* sg = a.in[20] + part * 32;
        bf16_t* op = YMIX + (rowbase + q0 + row) * D + CW + h * 128 + part * 32;
#pragma unroll
        for (int i = 0; i < 4; ++i) { u32x4 w;
            w.x = pk2(dv[8 * i] * sc * sg[8 * i], dv[8 * i + 1] * sc * sg[8 * i + 1]); w.y = pk2(dv[8 * i + 2] * sc * sg[8 * i + 2], dv[8 * i + 3] * sc * sg[8 * i + 3]);
            w.z = pk2(dv[8 * i + 4] * sc * sg[8 * i + 4], dv[8 * i + 5] * sc * sg[8 * i + 5]); w.w = pk2(dv[8 * i + 6] * sc * sg[8 * i + 6], dv[8 * i + 7] * sc * sg[8 * i + 7]);
            *(u32x4*)(op + 8 * i) = w; }
    }
    __syncthreads();
}

__device__ __forceinline__ void attn_phase(LAS unsigned char* lds, const Args& a, unsigned* ctl) {
    const int tid = threadIdx.x;
    LAS float* cst = (LAS float*)(lds + CST_OFF);
    if (tid < 64) {
        const float gq = fabsf(a.in[14][tid]), gk = fabsf(a.in[15][tid]);
        float mq = gq, mk = gk;
#pragma unroll
        for (int o = 1; o < 64; o <<= 1) { mq = fmaxf(mq, __shfl_xor(mq, o)); mk = fmaxf(mk, __shfl_xor(mk, o)); }
        const float d1 = wave_sum(a.in[16][tid] * a.in[17][tid]), d2 = wave_sum(a.in[18][tid] * a.in[19][tid]);
        float mb = 0.f;
        if (tid < 32) { for (int hh = 0; hh < 4; ++hh) mb = fmaxf(mb, (a.in[21][tid * 4 + hh] - a.in[21][31 * 4 + hh]) * LOG2E); }
#pragma unroll
        for (int o = 1; o < 64; o <<= 1) mb = fmaxf(mb, __shfl_xor(mb, o));
        if (tid == 0) { cst[0] = -(8.0f * LOG2E * mq * mk * 1.02f + mb); cst[1] = __expf(d1) - __expf(d2) + 0.2f; }
    }
    __syncthreads();
    const float negM = cst[0], lam = cst[1];
    LAS int* ubox = (LAS int*)(lds + CST_OFF + 16);
    for (;;) {
        if (tid == 0) ubox[0] = (int)atomicAdd(ctl + CW_ATTQ, 1u);
        __syncthreads();
        const int u = ubox[0];
        __syncthreads();
        if (u >= 1024) break;
        const int qb = 31 - (u >> 5), bhh = u & 31;
        attn_unit(lds, a, bhh >> 2, bhh & 3, qb, negM, lam);
    }
}
}

__device__ __forceinline__ void p5_router(LAS unsigned char* lds, const Args& a, unsigned* ctl) {
    const int tid = threadIdx.x, lane = tid & 63, wave = __builtin_amdgcn_readfirstlane(tid >> 6);
    unsigned char* ws = a.ws;
    const float* x1 = a.out; const float* g2 = a.in[23]; const float* rw = a.in[24]; const float* rb = a.in[25];
    unsigned char* H2 = ws + WS_H2; int* EIDX = (int*)(ws + WS_EIDX); float* GATE = (float*)(ws + WS_GATE); int* POS = (int*)(ws + WS_POS);
    LAS float* rwT = (LAS float*)lds;
    LAS int* cnt = (LAS int*)(lds + MISC_OFF + 1024);
    LAS int* basel = (LAS int*)(lds + MISC_OFF + 1024 + 128);
    LAS int* el = (LAS int*)(lds + MISC_OFF + 2048);
    LAS int* pl = (LAS int*)(lds + MISC_OFF + 4096);
    for (int i = tid; i < 32 * 1024; i += 512) { const int k = i >> 5, e = i & 31; rwT[e * 1024 + k] = rw[i]; }
    if (tid < 32) cnt[tid] = 0;
    __syncthreads();
    f32x4 gv[4];
#pragma unroll
    for (int j = 0; j < 4; ++j) gv[j] = *((const f32x4*)g2 + lane + 64 * j);
    const float rbias = rb[lane >> 1];
    const int TPB = T / (int)gridDim.x, tb0 = blockIdx.x * TPB, TPW = TPB / 8;
    for (int i = 0; i < TPW; ++i) {
        const int tl = wave * TPW + i, t = tb0 + tl;
        const f32x4* xr = (const f32x4*)(x1 + (size_t)t * D) + lane;
        f32x4 v[4]; float s = 0.f;
#pragma unroll
        for (int j = 0; j < 4; ++j) { v[j] = xr[64 * j]; s += (v[j].x * v[j].x + v[j].y * v[j].y) + (v[j].z * v[j].z + v[j].w * v[j].w); }
        const float rstd = 1.0f / sqrtf(wave_sum(s) * (1.0f / D) + 1e-5f);
        unsigned* o4 = (unsigned*)(H2 + (size_t)t * D) + lane;
#pragma unroll
        for (int j = 0; j < 4; ++j) { v[j] = v[j] * rstd * gv[j]; o4[64 * j] = pk4_fp8(v[j].x * F8_X_MUL, v[j].y * F8_X_MUL, v[j].z * F8_X_MUL, v[j].w * F8_X_MUL); }
        float acc[32];
#pragma unroll
        for (int e = 0; e < 32; ++e) {
            float s2 = 0.f;
#pragma unroll
            for (int j = 0; j < 4; ++j) { const f32x4 w = *((const LAS f32x4*)(rwT + e * 1024) + lane + 64 * j); s2 += (v[j].x * w.x + v[j].y * w.y) + (v[j].z * w.z + v[j].w * w.w); }
            acc[e] = s2;
        }
#pragma unroll
        for (int e = 0; e < 16; ++e) { const bool up = lane & 32; const float keep = up ? acc[e + 16] : acc[e], send = up ? acc[e] : acc[e + 16]; acc[e] = keep + __shfl_xor(send, 32); }
#pragma unroll
        for (int e = 0; e < 8; ++e) { const bool up = lane & 16; const float keep = up ? acc[e + 8] : acc[e], send = up ? acc[e] : acc[e + 8]; acc[e] = keep + __shfl_xor(send, 16); }
#pragma unroll
        for (int e = 0; e < 4; ++e) { const bool up = lane & 8; const float keep = up ? acc[e + 4] : acc[e], send = up ? acc[e] : acc[e + 4]; acc[e] = keep + __shfl_xor(send, 8); }
#pragma unroll
        for (int e = 0; e < 2; ++e) { const bool up = lane & 4; const float keep = up ? acc[e + 2] : acc[e], send = up ? acc[e] : acc[e + 2]; acc[e] = keep + __shfl_xor(send, 4); }
        { const bool up = lane & 2; const float keep = up ? acc[1] : acc[0], send = up ? acc[0] : acc[1]; acc[0] = keep + __shfl_xor(send, 2); }
        float logit = acc[0] + __shfl_xor(acc[0], 1) + rbias;
        const int myid = lane >> 1;
        float tv[4]; int ti[4];
#pragma unroll
        for (int k = 0; k < 4; ++k) {
            float bv = logit; int bi = myid;
#pragma unroll
            for (int o = 1; o < 64; o <<= 1) { const float ov = __shfl_xor(bv, o); const int oi = __shfl_xor(bi, o); if (ov > bv || (ov == bv && oi < bi)) { bv = ov; bi = oi; } }
            tv[k] = bv; ti[k] = bi;
            if (myid == bi) logit = -INFINITY;
        }
        const float e1 = __expf(tv[1] - tv[0]), e2 = __expf(tv[2] - tv[0]), e3 = __expf(tv[3] - tv[0]);
        const float inv = 1.0f / (1.0f + e1 + e2 + e3);
        if (lane < 4) {
            const int ek = lane == 0 ? ti[0] : lane == 1 ? ti[1] : lane == 2 ? ti[2] : ti[3];
            const float gk = (lane == 0 ? 1.0f : lane == 1 ? e1 : lane == 2 ? e2 : e3) * inv;
            EIDX[t * 4 + lane] = ek; GATE[t * 4 + lane] = gk;
            el[tl * 4 + lane] = ek; pl[tl * 4 + lane] = atomicAdd((int*)(cnt + ek), 1);
        }
    }
    __syncthreads();
    if (tid < 32) basel[tid] = (int)atomicAdd(ctl + CW_CNT + tid, (unsigned)cnt[tid]);
    __syncthreads();
    for (int i = tid; i < TPB * 4; i += 512) POS[(size_t)tb0 * 4 + i] = pl[i] + basel[el[i]];
}

__device__ __forceinline__ void p6_dispatch(LAS unsigned char* lds, const Args& a, unsigned* ctl) {
    const int tid = threadIdx.x, lane = tid & 63, wave = __builtin_amdgcn_readfirstlane(tid >> 6);
    unsigned char* ws = a.ws;
    const unsigned char* H2 = ws + WS_H2; unsigned char* XS = ws + WS_XS;
    const int* EIDX = (const int*)(ws + WS_EIDX); const float* GATE = (const float*)(ws + WS_GATE); const int* POS = (const int*)(ws + WS_POS);
    int* DEST = (int*)(ws + WS_DEST); float* ROWGATE = (float*)(ws + WS_ROWGATE); int* TILEE = (int*)(ws + WS_TILEE);
    LAS int* pstart = (LAS int*)(lds + MISC_OFF + 1024);
    if (tid == 0) {
        int acc = 0;
        for (int e = 0; e < NE; ++e) { const int cn = (int)__hip_atomic_load(ctl + CW_CNT + e, __ATOMIC_RELAXED, __HIP_MEMORY_SCOPE_AGENT); pstart[e] = acc;
            const int nt = (cn + 255) >> 8;
            if (blockIdx.x == 0) for (int i = 0; i < nt; ++i) TILEE[(acc >> 8) + i] = e;
            acc += nt * 256; }
        if (blockIdx.x == 0) TILEE[1023] = acc >> 8;
    }
    __syncthreads();
    const int TPB = T / (int)gridDim.x, tb0 = blockIdx.x * TPB, PPW = TPB * 4 / 8;
    for (int i = 0; i < PPW; ++i) {
        const int pi = tb0 * 4 + wave * PPW + i, t = pi >> 2;
        const int e = EIDX[pi], dest = pstart[e] + POS[pi];
        if (lane == 0) { DEST[pi] = dest; ROWGATE[dest] = GATE[pi]; }
        const u32x4* src = (const u32x4*)(H2 + (size_t)t * D); u32x4* dst = (u32x4*)(XS + (size_t)dest * D);
        dst[lane] = src[lane];
    }
}

__device__ __forceinline__ void p9_combine(const Args& a, int G) {
    const int tid = threadIdx.x, lane = tid & 63, wave = __builtin_amdgcn_readfirstlane(tid >> 6);
    unsigned char* ws = a.ws;
    const bf16_t* YS = (const bf16_t*)(ws + WS_YS); const int* DEST = (const int*)(ws + WS_DEST);
    float* out = a.out;
    const int gw = blockIdx.x * 8 + wave, NGW = G * 8;
    for (int t = gw; t < T; t += NGW) {
        f32x4* xr = (f32x4*)(out + (size_t)t * D) + lane;
        f32x4 v[4];
#pragma unroll
        for (int j = 0; j < 4; ++j) v[j] = xr[64 * j];
#pragma unroll
        for (int k = 0; k < 4; ++k) {
            const int dest = DEST[t * 4 + k];
            const u32x2* yr = (const u32x2*)(YS + (size_t)dest * D) + lane;
#pragma unroll
            for (int j = 0; j < 4; ++j) { const u32x2 w = yr[64 * j]; v[j].x += bflo(w.x); v[j].y += bfhi(w.x); v[j].z += bflo(w.y); v[j].w += bfhi(w.y); }
        }
#pragma unroll
        for (int j = 0; j < 4; ++j) xr[64 * j] = v[j];
    }
}

constexpr int NPHASE = 10;
__global__ void __launch_bounds__(512, 2) hymba_fwd(Args args) {
    extern __shared__ __attribute__((aligned(16))) unsigned char lds_raw[];
    LAS unsigned char* lds = (LAS unsigned char*)lds_raw;
    cg::grid_group grid = cg::this_grid();
    const int G = gridDim.x;
    unsigned char* ws = args.ws;
    unsigned* ctl = (unsigned*)(ws + WS_CTL);
    const int lo = args.ph_lo, hi = args.ph_hi;
#define IN(k) (lo <= (k) && (k) < hi)
#define NREP(k) ((REP_PHASE) == (k) ? 2 : 1)
#define SEAM(k) do { if (IN(k) && IN((k) + 1)) { if (args.ph_lo < 0) grid.sync(); xcd_barrier(xbar); } } while (0)
    const int* TILEE = (const int*)(ws + WS_TILEE);
    { volatile LAS unsigned* st = (volatile LAS unsigned*)(lds + MISC_OFF); if (threadIdx.x < 2) st[threadIdx.x] = 0u; }
    __syncthreads();
    const XcdBarrier xbar = xcd_barrier_post(ctl + CW_BAR, (volatile LAS unsigned*)(lds + MISC_OFF));

    if (IN(0)) { for (int rep = 0; rep < NREP(0); ++rep) p0_prologue(lds, args, G); } SEAM(0);
    if (IN(1)) {
        pg8::Gemm g{ws + WS_XN, ws + WS_WINT, 1024, 0, 0};
        pg8::TileOrder S; S.init(T / 256, NINP / 256, G, (int)blockIdx.x, nullptr, 0);
        pg8::EpiBf16 E{(bf16_t*)(ws + WS_P), NINP};
        for (int rep = 0; rep < NREP(1); ++rep) pg8::gemm_phase<false>(lds, g, S, E);
    } SEAM(1);
    if (IN(2)) { _Pragma("clang loop unroll(disable)") for (int rep = 0; rep < NREP(2); ++rep) { p2_prep(lds, args); __syncthreads(); }
        xcd_barrier(xbar);
        for (int rep = 0; rep < NREP(20); ++rep) ck::p2b_chunks(lds, args); } SEAM(2);
    if (IN(3)) {
        for (int rep = 0; rep < NREP(30); ++rep) { if (blockIdx.x < 64) ck::seq_head(lds, args, (int)blockIdx.x); __syncthreads(); }
        for (int rep = 0; rep < NREP(31); ++rep) att::attn_phase(lds, args, ctl + 64 * rep);
    } SEAM(3);
    if (IN(4)) {
        pg8::Gemm g{ws + WS_YMIX, ws + WS_WOUT, 1024, 0, 0};
        pg8::TileOrder S; S.init(T / 256, D / 256, G, (int)blockIdx.x, nullptr, 0);
        pg8::EpiResF32 E{args.in[0], args.out, D};
        for (int rep = 0; rep < NREP(4); ++rep) pg8::gemm_phase<false>(lds, g, S, E);
    } SEAM(4);
    if (IN(5)) { _Pragma("clang loop unroll(disable)") for (int rep = 0; rep < NREP(5); ++rep) { p5_router(lds, args, ctl + 256 * (NREP(5) - 1 - rep)); __syncthreads(); } } SEAM(5);
    if (IN(6)) { for (int rep = 0; rep < NREP(6); ++rep) { p6_dispatch(lds, args, ctl); __syncthreads(); } } SEAM(6);
    if (IN(7)) {
        const int ntile = TILEE[1023];
        pg8::Gemm g{ws + WS_XS, ws + WS_W1T, 1024, F8_W_SC, F8_X_SC};
        pg8::TileOrder S; S.init(ntile, 8, G, (int)blockIdx.x, TILEE, 8);
        pg8::EpiSwiglu E{ws + WS_HID, args.in[27], TILEE};
        for (int rep = 0; rep < NREP(7); ++rep) pg8::gemm_phase<true>(lds, g, S, E);
    } SEAM(7);
    if (IN(8)) {
        const int ntile = TILEE[1023];
        pg8::Gemm g{ws + WS_HID, ws + WS_W2T, 1024, F8_W_SC, F8_H_SC};
        pg8::TileOrder S; S.init(ntile, 4, G, (int)blockIdx.x, TILEE, 4);
        pg8::EpiGateBf16 E{(bf16_t*)(ws + WS_YS), args.in[29], (const float*)(ws + WS_ROWGATE), TILEE};
        for (int rep = 0; rep < NREP(8); ++rep) pg8::gemm_phase<true>(lds, g, S, E);
    } SEAM(8);
    if (IN(9)) { p9_combine(args, G); }
#undef IN
#undef SEAM
}

extern "C" void kernel_launch(void* const* d_in, const int* in_sizes, int n_in, void* d_out, int out_size, void* d_ws, size_t ws_size, hipStream_t stream) {
    static int grid = 0;
    if (grid == 0) {
        if (n_in != 30 || in_sizes[0] != T * D || out_size != T * D || ws_size < WS_END) { fprintf(stderr, "kernel_launch: unexpected shapes (n_in %d, in0 %d, out %d, ws %zu); nothing launched\n", n_in, n_in > 0 ? in_sizes[0] : -1, out_size, ws_size); grid = -1; return; }
        int dev = 0, cus = 0, per_cu = 0;
        if (hipGetDevice(&dev) != hipSuccess || hipDeviceGetAttribute(&cus, hipDeviceAttributeMultiprocessorCount, dev) != hipSuccess) { grid = -1; return; }
        if (hipFuncSetAttribute((const void*)hymba_fwd, hipFuncAttributeMaxDynamicSharedMemorySize, LDS_BYTES) != hipSuccess) { fprintf(stderr, "kernel_launch: hipFuncSetAttribute failed\n"); grid = -1; return; }
        if (hipOccupancyMaxActiveBlocksPerMultiprocessor(&per_cu, (const void*)hymba_fwd, 512, LDS_BYTES) != hipSuccess || per_cu < 1) { fprintf(stderr, "kernel_launch: occupancy query says %d\n", per_cu); per_cu = 1; }
        (void)hipGetLastError();
        grid = cus;
        if (grid > 256) grid = 256;
        if (grid != 256 || T % grid != 0 || (T / grid) % 16 != 0) { fprintf(stderr, "kernel_launch: grid %d does not divide the token count evenly\n", grid); grid = -1; return; }
    }
    if (grid < 0) return;
    (void)hipMemsetAsync((char*)d_ws + WS_CTL, 0, CTL_ZERO_BYTES, stream);
    Args a{};
    for (int i = 0; i < 30; ++i) a.in[i] = (const float*)d_in[i];
    a.out = (float*)d_out; a.ws = (unsigned char*)d_ws;
    constexpr int NL = MK_N_LAUNCHES;
    for (int li = 0; li < NL; ++li) {
        a.ph_lo = (NL == 1) ? 0 : li; a.ph_hi = (NL == 1) ? NPHASE : li + 1;
        void* kargs[] = {&a};
        hipError_t e = hipLaunchCooperativeKernel((const void*)hymba_fwd, dim3(grid), dim3(512), kargs, LDS_BYTES, stream);
        if (e != hipSuccess) { fprintf(stderr, "kernel_launch: cooperative launch %d failed: %s (grid %d)\n", li, hipGetErrorString(e), grid); break; }
    }
}
```

```cpp
#include <hip/hip_runtime.h>
#include <hip/hip_cooperative_groups.h>
#include <cstdio>
#include <cstdint>
#include <type_traits>
namespace cg = cooperative_groups;

#ifndef REP_PHASE
#define REP_PHASE -1
#endif
#ifndef TIME_REGION
#define TIME_REGION -1
#endif
#ifndef MK_N_LAUNCHES
#define MK_N_LAUNCHES 1
#endif

#define LAS __attribute__((address_space(3)))
#define GAS __attribute__((address_space(1)))
typedef unsigned short bf16_t;
typedef short bf16x8 __attribute__((ext_vector_type(8)));
typedef short s16x4 __attribute__((ext_vector_type(4)));
typedef float f32x2 __attribute__((ext_vector_type(2)));
typedef float f32x4 __attribute__((ext_vector_type(4)));
typedef float f32x16 __attribute__((ext_vector_type(16)));
typedef unsigned u32x2 __attribute__((ext_vector_type(2)));
typedef unsigned u32x4 __attribute__((ext_vector_type(4)));
typedef int v8i32 __attribute__((ext_vector_type(8)));

constexpr int NB = 8, SEQ = 4096, T = NB * SEQ, D = 1024;
constexpr int CW = 512;
constexpr int NRW = 1696, NIN = 3232, NINP = 3328;
constexpr int DQ0 = 1696, DK0 = 2208, DV0 = 2720;
constexpr int NE = 32, TOPK = 4, DE = 1024;
constexpr int MAXROWS = T * TOPK + NE * 256;
constexpr int MAXTILES = MAXROWS / 256;
constexpr float LOG2E = 1.4426950408889634f;
constexpr float F8_W_MUL = 32.f, F8_X_MUL = 8.f, F8_H_MUL = 4.f; constexpr int F8_W_SC = 0x7A7A7A7A, F8_X_SC = 0x7C7C7C7C, F8_H_SC = 0x7D7D7D7D;

constexpr size_t MiB = 1u << 20;
constexpr size_t WS_CTL = 0, CTL_ZERO_BYTES = 64 * 1024;
constexpr size_t WS_TILEE = 512 * 1024;
constexpr size_t WS_WINT = 1 * MiB;
constexpr size_t WS_WOUT = 8 * MiB;
constexpr size_t WS_W1T = 10 * MiB;
constexpr size_t WS_W2T = 138 * MiB;
constexpr size_t WS_EIDX = 202 * MiB;
constexpr size_t WS_GATE = WS_EIDX + 512 * 1024;
constexpr size_t WS_POS = WS_GATE + 512 * 1024;
constexpr size_t WS_DEST = WS_POS + 512 * 1024;
constexpr size_t WS_ROWGATE = 204 * MiB;
constexpr size_t WS_XN = 206 * MiB;
constexpr size_t WS_P = 270 * MiB;
constexpr size_t WS_SR = 478 * MiB, WS_SK = 510 * MiB, WS_SV = 542 * MiB, WS_SA = 574 * MiB, WS_SB = 606 * MiB;
constexpr size_t WS_SW = 638 * MiB;
constexpr size_t WS_SG = 702 * MiB;
constexpr size_t WS_QN = 734 * MiB, WS_KN = 766 * MiB;
constexpr size_t WS_YMIX = 798 * MiB;
constexpr size_t WS_H2 = 206 * MiB;
constexpr size_t WS_XS = 270 * MiB;
constexpr size_t WS_HID = 406 * MiB;
constexpr size_t WS_YS = 542 * MiB;
constexpr size_t WS_YRAW = 862 * MiB;
constexpr size_t WS_CG = 862 * MiB;
constexpr size_t WS_CH = 894 * MiB;
constexpr size_t WS_CR2 = 926 * MiB;
constexpr size_t WS_CY0 = 958 * MiB;
constexpr size_t WS_RK = 990 * MiB;
constexpr size_t WS_END = 992 * MiB;
constexpr int CW_CNT = 64;
constexpr int CW_ATTQ = 128;
constexpr int CW_BAR = 4096;

constexpr int RING_BYTES = 131072, MISC_OFF = RING_BYTES, LDS_BYTES = 147456;

__device__ __forceinline__ unsigned f2bf(float f) { unsigned u = __builtin_bit_cast(unsigned, f); return (u + 0x7fffu + ((u >> 16) & 1u)) >> 16; }
typedef __bf16 hwbf16x2 __attribute__((ext_vector_type(2)));
__device__ __forceinline__ unsigned pk2(float lo, float hi) { const f32x2 v = {lo, hi}; return __builtin_bit_cast(unsigned, __builtin_convertvector(v, hwbf16x2)); }
__device__ __forceinline__ unsigned pk4_fp8(float a, float b, float c, float d) {
    a = fminf(fmaxf(a, -448.f), 448.f); b = fminf(fmaxf(b, -448.f), 448.f); c = fminf(fmaxf(c, -448.f), 448.f); d = fminf(fmaxf(d, -448.f), 448.f);
    int r = __builtin_amdgcn_cvt_pk_fp8_f32(a, b, 0, false); r = __builtin_amdgcn_cvt_pk_fp8_f32(c, d, r, true); return (unsigned)r; }
__device__ __forceinline__ float bf2f(unsigned short b) { return __builtin_bit_cast(float, (unsigned)b << 16); }
__device__ __forceinline__ float bflo(unsigned w) { return __builtin_bit_cast(float, w << 16); }
__device__ __forceinline__ float bfhi(unsigned w) { return __builtin_bit_cast(float, w & 0xffff0000u); }
__device__ __forceinline__ float wave_sum(float v) {
#pragma unroll
    for (int o = 1; o < 64; o <<= 1) v += __shfl_xor(v, o);
    return v;
}
__device__ __forceinline__ float sigmoidf_(float x) { return 1.0f / (1.0f + __expf(-x)); }
template <int CTRL> __device__ __forceinline__ float dpp_f(float v) { return __builtin_bit_cast(float, __builtin_amdgcn_update_dpp(0, __builtin_bit_cast(int, v), CTRL, 0xF, 0xF, true)); }
__device__ __forceinline__ float red8(float v) {
    v += dpp_f<0xB1>(v);
    v += dpp_f<0x4E>(v);
    v += dpp_f<0x141>(v);
    return v;
}
__device__ __forceinline__ float red4(float v) { v += dpp_f<0xB1>(v); v += dpp_f<0x4E>(v); return v; }


#define XB_TMO      128
#define XB_XCNT(j)  (256  + 64 * (j))
#define XB_XSUB(j)  (1280 + 64 * (j))
#define XB_XGEN(j)  (2304 + 64 * (j))
#define XB_TOP      3328
#define XB_TOPGEN   3392
#define XCD_BAR_WORDS 3456
#define XB_SPIN_CAP (1u << 18)
__device__ __forceinline__ unsigned xb_ld(unsigned* p)              { return __hip_atomic_load(p, __ATOMIC_RELAXED, __HIP_MEMORY_SCOPE_AGENT); }
__device__ __forceinline__ unsigned xb_add(unsigned* p, unsigned v) { return __hip_atomic_fetch_add(p, v, __ATOMIC_RELAXED, __HIP_MEMORY_SCOPE_AGENT); }
__device__ __forceinline__ unsigned xb_xcc_id() { return (unsigned)__builtin_amdgcn_s_getreg((3 << 11) | 20) & 0xFu; }
#define XB_SPIN(cond, bar) do { unsigned _sp = 0; while (cond) { __builtin_amdgcn_s_sleep(1); \
    if ((++_sp & 255u) == 0u) { if (xb_ld(&(bar)[XB_TMO])) break; if (_sp > XB_SPIN_CAP) { atomicAdd(&(bar)[XB_TMO], 1u); break; } } } } while (0)
struct XcdBarrier { unsigned* bar; unsigned x; volatile LAS unsigned* st; };
__device__ __forceinline__ XcdBarrier xcd_barrier_post(unsigned* bar, volatile LAS unsigned* st) {
    XcdBarrier b; b.bar = bar; b.x = xb_xcc_id(); b.st = st;
    if (threadIdx.x == 0) (void)xb_add(&bar[XB_XCNT(b.x)], 1u);
    return b;
}
__device__ __forceinline__ void xcd_barrier_complete(unsigned* bar, unsigned x, unsigned& nloc, unsigned& nx) {
    const unsigned G = gridDim.x * gridDim.y * gridDim.z;
    unsigned sum, cnt, mine, sp = 0u;
    for (;;) {
        sum = 0u; cnt = 0u; mine = 0u;
#pragma unroll
        for (unsigned j = 0; j < 16; ++j) { const unsigned c = xb_ld(&bar[XB_XCNT(j)]); sum += c; cnt += (c > 0u) ? 1u : 0u; mine = (j == x) ? c : mine; }
        if (sum == G) break;
        __builtin_amdgcn_s_sleep(1);
        if ((++sp & 255u) == 0u) { if (xb_ld(&bar[XB_TMO])) break; if (sp > XB_SPIN_CAP) { atomicAdd(&bar[XB_TMO], 1u); break; } }
    }
    nloc = mine > 0u ? mine : 1u; nx = cnt > 0u ? cnt : 1u;
}
__device__ __forceinline__ void xcd_barrier(const XcdBarrier& b) {
    asm volatile("s_waitcnt vmcnt(0)" ::: "memory");
    __syncthreads();
    if (threadIdx.x == 0) {
        unsigned* bar = b.bar;
        __builtin_amdgcn_s_waitcnt(0);
        unsigned nloc = b.st[0], nx = b.st[1];
        if (nloc == 0u) { xcd_barrier_complete(bar, b.x, nloc, nx); b.st[0] = nloc; b.st[1] = nx; }
        const unsigned old = xb_add(&bar[XB_XSUB(b.x)], 1u);
        const unsigned gen = old / nloc;
        if (old + 1u == (gen + 1u) * nloc) {
            __builtin_amdgcn_fence(__ATOMIC_RELEASE, "agent");
            asm volatile("s_waitcnt vmcnt(0)" ::: "memory");
            const unsigned og = xb_add(&bar[XB_TOP], 1u);
            const unsigned tg = og / nx;
            if (og + 1u == (tg + 1u) * nx) xb_add(&bar[XB_TOPGEN], 1u);
            else XB_SPIN(xb_ld(&bar[XB_TOPGEN]) == tg, bar);
            __builtin_amdgcn_fence(__ATOMIC_ACQUIRE, "agent");
            xb_add(&bar[XB_XGEN(b.x)], 1u);
            asm volatile("s_waitcnt vmcnt(0)" ::: "memory");
        } else {
            XB_SPIN(xb_ld(&bar[XB_XGEN(b.x)]) == gen, bar);
            __builtin_amdgcn_fence(__ATOMIC_ACQUIRE, "agent");
            asm volatile("s_waitcnt vmcnt(0)" ::: "memory");
        }
    }
    __syncthreads();
}

namespace pg8 {
constexpr int BM = 256, BK = 64, HALF = 128, HTB = HALF * BK * 2, STAGE_BYTES = 8 * HTB, NXCD = 8, WGM = 8;
__host__ __device__ __forceinline__ int lds_byte(int r, int c) { const int st = (r >> 4) * 2 + (c >> 5), rr = r & 15, cc = c & 31, ob = rr * 64 + cc * 2; return st * 1024 + (ob ^ (((ob >> 9) & 1) << 5)); }
__host__ __device__ __forceinline__ void stage_rc(int b, int& R, int& C) { const int st = b / 1024, sb = b % 1024, swz = sb ^ (((sb >> 9) & 1) << 5); R = (st >> 1) * 16 + swz / 64; C = (st & 1) * 32 + (swz % 64) / 2; }
__host__ __device__ __forceinline__ int perm32(int rho) { const int n = rho >> 4, i = rho & 15; return 8 * (i >> 2) + 4 * n + (i & 3); }

struct Unit { int pm, pn, pb; };
struct Gemm { const void* A; const void* Bt; int K; int scW, scA; };

struct TileOrder {
    int nM, nN, nwg, G, c; const int* tile_e; int nb_per_e;
    __device__ void init(int nM_, int nN_, int G_, int c_, const int* te, int nbe) { nM = nM_; nN = nN_; nwg = nM * nN; G = G_; c = c_; tile_e = te; nb_per_e = nbe; }
    __device__ bool next(int i, Unit& u) const {
        const long L = (long)i * G + c; if (L >= nwg) return false;
        int wgid = (int)L; { const int q = nwg / NXCD, r = nwg % NXCD, xcd = wgid % NXCD, off = wgid / NXCD; wgid = (xcd < r ? xcd * (q + 1) : r * (q + 1) + (xcd - r) * q) + off; }
        const int nig = WGM * nN, gid = wgid / nig, fm = gid * WGM, gsz = (nM - fm) < WGM ? (nM - fm) : WGM;
        u.pm = fm + ((wgid % nig) % gsz); u.pn = (wgid % nig) / gsz;
        u.pb = tile_e ? tile_e[u.pm] * nb_per_e + u.pn : u.pn;
        return true;
    }
};

struct EpiBf16 {
    static constexpr bool PERM = true;
    bf16_t* O; int ldc;
    __device__ __forceinline__ void operator()(const f32x4 (&acc)[2][2][4][2], const Unit& u, int wr, int wc, int fr, int fq) const {
        const int row0 = u.pm * BM + wr * 64 + fr; const int col0 = u.pn * BM + wc * 32 + 8 * fq;
#pragma unroll
        for (int ai = 0; ai < 2; ++ai)
#pragma unroll
            for (int m = 0; m < 4; ++m) { bf16_t* rowp = O + (size_t)(row0 + ai * HALF + m * 16) * ldc + col0;
#pragma unroll
                for (int bj = 0; bj < 2; ++bj) { const f32x4 v0 = acc[ai][bj][m][0], v1 = acc[ai][bj][m][1];
                    u32x4 w; w.x = pk2(v0[0], v0[1]); w.y = pk2(v0[2], v0[3]); w.z = pk2(v1[0], v1[1]); w.w = pk2(v1[2], v1[3]);
                    *(u32x4*)(rowp + bj * HALF) = w; } }
    }
};
struct EpiResF32 {
    static constexpr bool PERM = false;
    const float* base; float* out; int ldc;
    __device__ __forceinline__ void operator()(const f32x4 (&acc)[2][2][4][2], const Unit& u, int wr, int wc, int fr, int fq) const {
        const int col0 = u.pn * BM + wc * 32 + 4 * fq;
#pragma unroll
        for (int ai = 0; ai < 2; ++ai)
#pragma unroll
            for (int m = 0; m < 4; ++m) { const size_t off = (size_t)(u.pm * BM + ai * HALF + wr * 64 + m * 16 + fr) * ldc + col0;
#pragma unroll
                for (int bj = 0; bj < 2; ++bj)
#pragma unroll
                    for (int n = 0; n < 2; ++n) { const f32x4 bs = *(const f32x4*)(base + off + bj * HALF + n * 16); *(f32x4*)(out + off + bj * HALF + n * 16) = bs + acc[ai][bj][m][n]; } }
    }
};
struct EpiSwiglu {
    static constexpr bool PERM = true;
    unsigned char* O; const float* b1; const int* tile_e;
    __device__ __forceinline__ void operator()(const f32x4 (&acc)[2][2][4][2], const Unit& u, int wr, int wc, int fr, int fq) const {
        const int e = tile_e[u.pm]; const int row0 = u.pm * BM + wr * 64 + fr; const int hc0 = u.pn * 128 + wc * 32 + 8 * fq;
        const float* bg = b1 + (size_t)e * 2048 + hc0; const float* bl = bg + 1024;
        const f32x4 g0 = *(const f32x4*)bg, g1 = *(const f32x4*)(bg + 4), l0 = *(const f32x4*)bl, l1 = *(const f32x4*)(bl + 4);
#pragma unroll
        for (int ai = 0; ai < 2; ++ai)
#pragma unroll
            for (int m = 0; m < 4; ++m) { unsigned char* rowp = O + (size_t)(row0 + ai * HALF + m * 16) * 1024 + hc0;
                float o[8];
#pragma unroll
                for (int n = 0; n < 2; ++n) { const f32x4 gv = acc[ai][0][m][n] + (n ? g1 : g0), lv = acc[ai][1][m][n] + (n ? l1 : l0);
#pragma unroll
                    for (int i = 0; i < 4; ++i) { const float g = fminf(gv[i], 7.0f), l = fminf(fmaxf(lv[i], -7.0f), 7.0f);
                        const float sg = __builtin_amdgcn_rcpf(1.0f + __builtin_amdgcn_exp2f(-1.702f * LOG2E * g)); o[n * 4 + i] = g * sg * (l + 1.0f); } }
                u32x2 w; w.x = pk4_fp8(o[0] * F8_H_MUL, o[1] * F8_H_MUL, o[2] * F8_H_MUL, o[3] * F8_H_MUL); w.y = pk4_fp8(o[4] * F8_H_MUL, o[5] * F8_H_MUL, o[6] * F8_H_MUL, o[7] * F8_H_MUL);
                *(u32x2*)rowp = w; }
    }
};
struct EpiGateBf16 {
    static constexpr bool PERM = true;
    bf16_t* O; const float* b2; const float* rowgate; const int* tile_e;
    __device__ __forceinline__ void operator()(const f32x4 (&acc)[2][2][4][2], const Unit& u, int wr, int wc, int fr, int fq) const {
        const int e = tile_e[u.pm]; const int row0 = u.pm * BM + wr * 64 + fr; const int col0 = u.pn * BM + wc * 32 + 8 * fq;
        f32x4 bv[2][2];
#pragma unroll
        for (int bj = 0; bj < 2; ++bj)
#pragma unroll
            for (int n = 0; n < 2; ++n) bv[bj][n] = *(const f32x4*)(b2 + (size_t)e * 1024 + col0 + bj * HALF + 4 * n);
#pragma unroll
        for (int ai = 0; ai < 2; ++ai)
#pragma unroll
            for (int m = 0; m < 4; ++m) { const int row = row0 + ai * HALF + m * 16; const float gt = rowgate[row]; bf16_t* rowp = O + (size_t)row * 1024 + col0;
#pragma unroll
                for (int bj = 0; bj < 2; ++bj) { const f32x4 v0 = (acc[ai][bj][m][0] + bv[bj][0]) * gt, v1 = (acc[ai][bj][m][1] + bv[bj][1]) * gt;
                    u32x4 w; w.x = pk2(v0[0], v0[1]); w.y = pk2(v0[2], v0[3]); w.z = pk2(v1[0], v1[1]); w.w = pk2(v1[2], v1[3]);
                    *(u32x4*)(rowp + bj * HALF) = w; } }
    }
};

template <bool F8, class Epi, class Sched>
__device__ __forceinline__ void gemm_phase(LAS unsigned char* lds, const Gemm g, const Sched& S, const Epi& E) {
    const int tid = threadIdx.x, wid = __builtin_amdgcn_readfirstlane(tid >> 6), lane = tid & 63, wr = wid >> 2, wc = wid & 3, fr = lane & 15, fq = lane >> 4;
    const int RB = F8 ? g.K : g.K * 2, nt = RB / 128;
    unsigned voffA[2], voffB[2];
#pragma unroll
    for (int i = 0; i < 2; ++i) { int R, C; stage_rc(tid * 16 + i * 8192, R, C); const int Rb = Epi::PERM ? ((R & ~31) + perm32(R & 31)) : R;
        voffA[i] = (unsigned)(R * RB + C * 2); voffB[i] = (unsigned)(Rb * RB + C * 2); }
    const size_t kstep = (size_t)(BK * 2);
    const size_t hstep = (size_t)HALF * RB;
    const size_t tstep = 2 * hstep;
    const unsigned ldsw = (unsigned)wid * 1024u;
    const int aoff = F8 ? lds_byte(wr * 64 + fr, (fq & 1) * 16) + (fq >> 1) * 1024 : lds_byte(wr * 64 + fr, fq * 8);
    const int boff = F8 ? lds_byte(wc * 32 + fr, (fq & 1) * 16) + (fq >> 1) * 1024 : lds_byte(wc * 32 + fr, fq * 8);
    const int scW = g.scW, scA = g.scA;
#define PG8_SA(b, h) (((b) * 2 + (h)) * HTB)
#define PG8_SB(b, h) ((4 + (b) * 2 + (h)) * HTB)
#define PG8_STAGE(bufoff, gbase, voff) do { _Pragma("unroll") for (int _i = 0; _i < 2; ++_i) \
        __builtin_amdgcn_global_load_lds((const unsigned*)((const char*)(gbase) + (voff)[_i]), (LAS unsigned*)(lds + (bufoff) + ldsw + _i * 8192), 16, 0, 0); } while (0)
typedef int v8i32a __attribute__((ext_vector_type(8), aligned(16)));
#define PG8_LD32(p) (*(const LAS v8i32a*)(p))
#define PG8_LDA(dst, b, h) do { _Pragma("unroll") for (int m = 0; m < 4; ++m) { if constexpr (F8) { dst[m].f8 = __builtin_bit_cast(v8i32, PG8_LD32(lds + PG8_SA(b, h) + aoff + m * 2048)); } \
        else { _Pragma("unroll") for (int k = 0; k < 2; ++k) dst[m].hv[k] = *(const LAS bf16x8*)(lds + PG8_SA(b, h) + aoff + m * 2048 + k * 1024); } } } while (0)
#define PG8_LDB(dst, b, h) do { _Pragma("unroll") for (int n = 0; n < 2; ++n) { if constexpr (F8) { dst[n].f8 = __builtin_bit_cast(v8i32, PG8_LD32(lds + PG8_SB(b, h) + boff + n * 2048)); } \
        else { _Pragma("unroll") for (int k = 0; k < 2; ++k) dst[n].hv[k] = *(const LAS bf16x8*)(lds + PG8_SB(b, h) + boff + n * 2048 + k * 1024); } } } while (0)
#define PG8_MMA(ai, bj, At, Bt) do { __builtin_amdgcn_s_setprio(1); _Pragma("unroll") for (int m = 0; m < 4; ++m) _Pragma("unroll") for (int n = 0; n < 2; ++n) { \
        if constexpr (F8) { asm volatile("v_mfma_scale_f32_16x16x128_f8f6f4 %0, %1, %2, %0, %3, %4 op_sel_hi:[0,0,0]" : "+v"(acc[ai][bj][m][n]) : "v"(Bt[n].f8), "v"(At[m].f8), "v"(scW), "v"(scA)); } \
        else { _Pragma("unroll") for (int k = 0; k < 2; ++k) acc[ai][bj][m][n] = __builtin_amdgcn_mfma_f32_16x16x32_bf16(Bt[n].hv[k], At[m].hv[k], acc[ai][bj][m][n], 0, 0, 0); } } \
        __builtin_amdgcn_s_setprio(0); } while (0)
#define PG8_WAIT_V(n) asm volatile("s_waitcnt vmcnt(" #n ")" ::: "memory")
#define PG8_WAIT_L(n) asm volatile("s_waitcnt lgkmcnt(" #n ")" ::: "memory")
#define PG8_BAR __builtin_amdgcn_s_barrier()
#define PG8_SCHED __builtin_amdgcn_sched_barrier(0)
    Unit cur, nxt; int ui = 0;
    if (!S.next(0, cur)) return;
    f32x4 acc[2][2][4][2];
#pragma unroll
    for (int a = 0; a < 2; ++a)
#pragma unroll
        for (int b = 0; b < 2; ++b)
#pragma unroll
            for (int m = 0; m < 4; ++m)
#pragma unroll
                for (int n = 0; n < 2; ++n) acc[a][b][m][n] = (f32x4){0.f, 0.f, 0.f, 0.f};
    struct FragH { bf16x8 hv[2]; }; struct Frag8 { v8i32 f8; };
    typename std::conditional<F8, Frag8, FragH>::type At[4], B0[2], B1[2];
    const char* cA = (const char*)g.A + (size_t)cur.pm * tstep; const char* cB = (const char*)g.Bt + (size_t)cur.pb * tstep;
    PG8_STAGE(PG8_SB(0, 0), cB, voffB); PG8_STAGE(PG8_SB(0, 1), cB + hstep, voffB); PG8_STAGE(PG8_SA(0, 0), cA, voffA); PG8_STAGE(PG8_SA(0, 1), cA + hstep, voffA);
    if (wr == 1) PG8_BAR;
    PG8_WAIT_V(2); PG8_BAR;
    PG8_STAGE(PG8_SB(1, 0), cB + kstep, voffB); PG8_STAGE(PG8_SA(1, 0), cA + kstep, voffA); PG8_STAGE(PG8_SB(1, 1), cB + hstep + kstep, voffB);
    PG8_WAIT_V(6); PG8_BAR;
    for (;;) {
        const bool has_next = S.next(ui + 1, nxt);
        const char* nA = has_next ? (const char*)g.A + (size_t)nxt.pm * tstep : cA; const char* nB = has_next ? (const char*)g.Bt + (size_t)nxt.pb * tstep : cB;
#pragma clang loop unroll(disable)
        for (int t = 0; t < nt; t += 2) {
            const bool last = (t == nt - 2);
            const char* a1 = cA + (size_t)(t + 1) * kstep;
            const char* a2 = last ? nA : cA + (size_t)(t + 2) * kstep; const char* b2 = last ? nB : cB + (size_t)(t + 2) * kstep;
            const char* a3 = a2 + kstep; const char* b3 = b2 + kstep;
            PG8_LDB(B0, 0, 0); PG8_LDB(B1, 0, 1); PG8_SCHED; PG8_LDA(At, 0, 0); PG8_STAGE(PG8_SA(1, 1), a1 + hstep, voffA);
            PG8_WAIT_V(8); PG8_WAIT_L(0); PG8_BAR; PG8_MMA(0, 0, At, B0); PG8_MMA(0, 1, At, B1); PG8_BAR; PG8_SCHED;
            PG8_LDA(At, 0, 1); PG8_STAGE(PG8_SB(0, 0), b2, voffB); PG8_STAGE(PG8_SB(0, 1), b2 + hstep, voffB); PG8_STAGE(PG8_SA(0, 0), a2, voffA);
            PG8_WAIT_V(8); PG8_WAIT_L(0); PG8_BAR; PG8_MMA(1, 0, At, B0); PG8_MMA(1, 1, At, B1); PG8_BAR; PG8_SCHED;
            PG8_LDB(B0, 1, 0); PG8_LDB(B1, 1, 1); PG8_SCHED; PG8_LDA(At, 1, 0); PG8_STAGE(PG8_SA(0, 1), a2 + hstep, voffA);
            PG8_WAIT_V(8); PG8_WAIT_L(0); PG8_BAR; PG8_MMA(0, 0, At, B0); PG8_MMA(0, 1, At, B1); PG8_BAR; PG8_SCHED;
            PG8_LDA(At, 1, 1); PG8_STAGE(PG8_SB(1, 0), b3, voffB); PG8_STAGE(PG8_SB(1, 1), b3 + hstep, voffB); PG8_STAGE(PG8_SA(1, 0), a3, voffA);
            PG8_WAIT_V(8); PG8_WAIT_L(0); PG8_BAR; PG8_MMA(1, 0, At, B0); PG8_MMA(1, 1, At, B1); PG8_BAR; PG8_SCHED;
        }
        if (wr == 0) PG8_BAR;
        if constexpr (F8) asm volatile("s_nop 15\n\ts_nop 15" ::: "memory");
        E(acc, cur, wr, wc, fr, fq);
        if (!has_next) break;
#pragma unroll
        for (int a = 0; a < 2; ++a)
#pragma unroll
            for (int b = 0; b < 2; ++b)
#pragma unroll
                for (int m = 0; m < 4; ++m)
#pragma unroll
                    for (int n = 0; n < 2; ++n) acc[a][b][m][n] = (f32x4){0.f, 0.f, 0.f, 0.f};
        cur = nxt; cA = nA; cB = nB; ++ui;
        if (wr == 1) PG8_BAR;
    }
    PG8_WAIT_V(0);
    PG8_BAR;
#undef PG8_SA
#undef PG8_SB
#undef PG8_STAGE
#undef PG8_LDA
#undef PG8_LDB
#undef PG8_MMA
#undef PG8_LD32
#undef PG8_WAIT_V
#undef PG8_WAIT_L
#undef PG8_BAR
#undef PG8_SCHED
}
}

struct Args { const float* in[30]; float* out; unsigned char* ws; int ph_lo, ph_hi; };

__device__ __forceinline__ void p0_transpose_item(const float* W, int K, int N, bf16_t* WT, int k0, int n0, int drow0, LAS float* scr, int lane) {
#pragma unroll 8
    for (int i = 0; i < 32; ++i) { const int kk = 2 * i + (lane >> 5); scr[kk * 33 + (lane & 31)] = W[(size_t)(k0 + kk) * N + n0 + (lane & 31)]; }
    asm volatile("s_waitcnt lgkmcnt(0)" ::: "memory");
    const int c = lane & 7;
#pragma unroll
    for (int j = 0; j < 4; ++j) { const int n = (lane >> 3) + 8 * j; const LAS float* s = scr + (8 * c) * 33 + n;
        u32x4 o; o.x = pk2(s[0 * 33], s[1 * 33]); o.y = pk2(s[2 * 33], s[3 * 33]); o.z = pk2(s[4 * 33], s[5 * 33]); o.w = pk2(s[6 * 33], s[7 * 33]);
        *(u32x4*)(WT + (size_t)(drow0 + n) * K + k0 + 8 * c) = o; }
    asm volatile("s_waitcnt lgkmcnt(0)" ::: "memory");
}
__device__ __forceinline__ void p0_transpose_item_f8(const float* W, int K, int N, unsigned char* WT, int k0, int n0, int drow0, LAS float* scr, int lane) {
#pragma unroll 8
    for (int i = 0; i < 32; ++i) { const int kk = 2 * i + (lane >> 5); scr[kk * 33 + (lane & 31)] = W[(size_t)(k0 + kk) * N + n0 + (lane & 31)]; }
    asm volatile("s_waitcnt lgkmcnt(0)" ::: "memory");
    const int c = lane & 3;
#pragma unroll
    for (int j = 0; j < 2; ++j) { const int n = (lane >> 2) + 16 * j; const LAS float* s = scr + (16 * c) * 33 + n;
        u32x4 o;
        o.x = pk4_fp8(s[0 * 33] * F8_W_MUL, s[1 * 33] * F8_W_MUL, s[2 * 33] * F8_W_MUL, s[3 * 33] * F8_W_MUL);
        o.y = pk4_fp8(s[4 * 33] * F8_W_MUL, s[5 * 33] * F8_W_MUL, s[6 * 33] * F8_W_MUL, s[7 * 33] * F8_W_MUL);
        o.z = pk4_fp8(s[8 * 33] * F8_W_MUL, s[9 * 33] * F8_W_MUL, s[10 * 33] * F8_W_MUL, s[11 * 33] * F8_W_MUL);
        o.w = pk4_fp8(s[12 * 33] * F8_W_MUL, s[13 * 33] * F8_W_MUL, s[14 * 33] * F8_W_MUL, s[15 * 33] * F8_W_MUL);
        *(u32x4*)(WT + (size_t)(drow0 + n) * K + k0 + 16 * c) = o; }
    asm volatile("s_waitcnt lgkmcnt(0)" ::: "memory");
}
__device__ __forceinline__ void p0_prologue(LAS unsigned char* lds, const Args& a, int G) {
    const int tid = threadIdx.x, lane = tid & 63, wave = __builtin_amdgcn_readfirstlane(tid >> 6);
    LAS float* scr = (LAS float*)(lds + wave * 16384);
    const int gw = blockIdx.x * 8 + wave, NGW = G * 8;
    unsigned char* ws = a.ws;
    bf16_t* Wint = (bf16_t*)(ws + WS_WINT); bf16_t* Woutt = (bf16_t*)(ws + WS_WOUT); unsigned char* W1t = ws + WS_W1T; unsigned char* W2t = ws + WS_W2T;
    constexpr int I_IN = 16 * (NIN / 32);
    constexpr int I_OUT = 16 * 32;
    constexpr int I_W1 = 16 * 64;
    constexpr int I_W2 = 16 * 32;
    constexpr int NITEMS = I_IN + I_OUT + NE * I_W1 + NE * I_W2;
    for (int it = gw; it < NITEMS; it += NGW) {
        int r = it;
        if (r < I_IN) { const int nblk = NIN / 32, kb = r / nblk, nb = r % nblk; p0_transpose_item(a.in[2], 1024, NIN, Wint, 64 * kb, 32 * nb, 32 * nb, scr, lane); continue; } r -= I_IN;
        if (r < I_OUT) { const int kb = r / 32, nb = r % 32; p0_transpose_item(a.in[22], 1024, 1024, Woutt, 64 * kb, 32 * nb, 32 * nb, scr, lane); continue; } r -= I_OUT;
        if (r < NE * I_W1) { const int e = r / I_W1, q = r % I_W1, kb = q / 64, nb = q % 64; const int n0 = 32 * nb;
            const int drow = (n0 < 1024) ? ((n0 >> 7) * 256 + (n0 & 127)) : (((n0 - 1024) >> 7) * 256 + 128 + ((n0 - 1024) & 127));
            p0_transpose_item_f8(a.in[26] + (size_t)e * 1024 * 2048, 1024, 2048, W1t + (size_t)e * 2048 * 1024, 64 * kb, n0, drow, scr, lane); continue; } r -= NE * I_W1;
        { const int e = r / I_W2, q = r % I_W2, kb = q / 32, nb = q % 32;
            p0_transpose_item_f8(a.in[28] + (size_t)e * 1024 * 1024, 1024, 1024, W2t + (size_t)e * 1024 * 1024, 64 * kb, 32 * nb, 32 * nb, scr, lane); }
    }
    const float* x = a.in[0]; const float* g1 = a.in[1]; bf16_t* XN = (bf16_t*)(ws + WS_XN);
    f32x4 gv[4];
#pragma unroll
    for (int j = 0; j < 4; ++j) gv[j] = *((const f32x4*)g1 + lane + 64 * j);
    for (int m = gw; m < T; m += NGW) {
        const f32x4* xr = (const f32x4*)(x + (size_t)m * D) + lane;
        f32x4 v[4]; float s = 0.f;
#pragma unroll
        for (int j = 0; j < 4; ++j) { v[j] = xr[64 * j]; s += (v[j].x * v[j].x + v[j].y * v[j].y) + (v[j].z * v[j].z + v[j].w * v[j].w); }
        const float rstd = 1.0f / sqrtf(wave_sum(s) * (1.0f / D) + 1e-5f);
        u32x2* o8 = (u32x2*)(XN + (size_t)m * D) + lane;
#pragma unroll
        for (int j = 0; j < 4; ++j) { u32x2 w; w.x = pk2(v[j].x * rstd * gv[j].x, v[j].y * rstd * gv[j].y); w.y = pk2(v[j].z * rstd * gv[j].z, v[j].w * rstd * gv[j].w); o8[64 * j] = w; }
    }
}

__device__ __forceinline__ f32x4 cvlo(const u32x4 u) { return (f32x4){bflo(u.x), bfhi(u.x), bflo(u.y), bfhi(u.y)}; }
__device__ __forceinline__ f32x4 cvhi(const u32x4 u) { return (f32x4){bflo(u.z), bfhi(u.z), bflo(u.w), bfhi(u.w)}; }
__device__ __forceinline__ u32x4 pk8(const f32x4 lo, const f32x4 hi) { u32x4 w; w.x = pk2(lo.x, lo.y); w.y = pk2(lo.z, lo.w); w.z = pk2(hi.x, hi.y); w.w = pk2(hi.z, hi.w); return w; }
__device__ __forceinline__ void p2_prep(LAS unsigned char* lds, const Args& a) {
    const int tid = threadIdx.x, lane = tid & 63, wave = __builtin_amdgcn_readfirstlane(tid >> 6);
    unsigned char* ws = a.ws;
    const bf16_t* P = (const bf16_t*)(ws + WS_P);
    bf16_t* SR = (bf16_t*)(ws + WS_SR); bf16_t* SK = (bf16_t*)(ws + WS_SK); bf16_t* SV = (bf16_t*)(ws + WS_SV); bf16_t* SA = (bf16_t*)(ws + WS_SA); bf16_t* SB = (bf16_t*)(ws + WS_SB);
    float* SW = (float*)(ws + WS_SW); bf16_t* SG = (bf16_t*)(ws + WS_SG); bf16_t* QN = (bf16_t*)(ws + WS_QN); bf16_t* KN = (bf16_t*)(ws + WS_KN);
    const float* mu = a.in[3]; const float* w0 = a.in[4]; const float* w2 = a.in[5]; const float* a0 = a.in[6]; const float* a2 = a.in[7]; const float* g2 = a.in[8];
    const float* k_k = a.in[9]; const float* k_a = a.in[10]; const float* qn_g = a.in[14]; const float* kn_g = a.in[15];
    LAS unsigned char* ACT = lds;
    LAS float* DEC = (LAS float*)(lds + 8192); LAS float* ALR = (LAS float*)(lds + 40960); LAS float* GG = (LAS float*)(lds + 73728);
    bf16x8 bw[4][5];
    const int fcol = lane & 15, fk = (lane >> 4) * 8;
#pragma unroll
    for (int cb = 0; cb < 4; ++cb) {
        const int col = wave * 64 + cb * 16 + fcol;
#pragma unroll
        for (int kb = 0; kb < 5; ++kb) {
            const float* src = (kb == 0) ? (w2 + (size_t)fk * CW + col) : (kb == 1) ? (a2 + (size_t)fk * CW + col) : (g2 + (size_t)((kb - 2) * 32 + fk) * CW + col);
            u32x4 w; w.x = pk2(src[0], src[CW]); w.y = pk2(src[2 * CW], src[3 * CW]); w.z = pk2(src[4 * CW], src[5 * CW]); w.w = pk2(src[6 * CW], src[7 * CW]);
            bw[cb][kb] = __builtin_bit_cast(bf16x8, w);
        }
    }
    float w0c[4], a0c[4];
#pragma unroll
    for (int cb = 0; cb < 4; ++cb) { w0c[cb] = w0[wave * 64 + cb * 16 + fcol]; a0c[cb] = a0[wave * 64 + cb * 16 + fcol]; }
    const int c8 = lane * 8;
    const int TPB = T / (int)gridDim.x;
    const int tb0 = blockIdx.x * TPB;
    for (int t0 = tb0; t0 < tb0 + TPB; t0 += 16) {
        if (tid < 320) {
            const int tok = tid / 20, ch = tid - tok * 20, t = t0 + tok, col = 1536 + ch * 8;
            const u32x4 cu = *(const u32x4*)(P + (size_t)t * NINP + col);
            u32x4 pu = (u32x4){0u, 0u, 0u, 0u};
            if (t & (SEQ - 1)) pu = *(const u32x4*)(P + (size_t)(t - 1) * NINP + col);
            const f32x4 m0 = *(const f32x4*)(mu + col), m1 = *(const f32x4*)(mu + col + 4);
            const f32x4 c0 = cvlo(cu), c1 = cvhi(cu), p0 = cvlo(pu), p1 = cvhi(pu);
            f32x4 s0 = c0 + (p0 - c0) * m0, s1 = c1 + (p1 - c1) * m1;
            if (ch < 4) {
#pragma unroll
                for (int i = 0; i < 4; ++i) { const float e0 = __expf(-2.0f * fabsf(s0[i])), e1 = __expf(-2.0f * fabsf(s1[i])); const float th0 = (1.0f - e0) / (1.0f + e0), th1 = (1.0f - e1) / (1.0f + e1);
                    s0[i] = s0[i] < 0.f ? -th0 : th0; s1[i] = s1[i] < 0.f ? -th1 : th1; }
            } else if (ch >= 8) {
#pragma unroll
                for (int i = 0; i < 4; ++i) { s0[i] = sigmoidf_(s0[i]); s1[i] = sigmoidf_(s1[i]); }
            }
            *(LAS u32x4*)(ACT + tok * 320 + ch * 16) = pk8(s0, s1);
        }
        __syncthreads();
        {
            bf16x8 af[5];
#pragma unroll
            for (int kb = 0; kb < 5; ++kb) af[kb] = *(const LAS bf16x8*)(ACT + fcol * 320 + kb * 64 + (lane >> 4) * 16);
#pragma unroll
            for (int cb = 0; cb < 4; ++cb) {
                const f32x4 z = {0.f, 0.f, 0.f, 0.f};
                const f32x4 aw = __builtin_amdgcn_mfma_f32_16x16x32_bf16(af[0], bw[cb][0], z, 0, 0, 0);
                const f32x4 aa = __builtin_amdgcn_mfma_f32_16x16x32_bf16(af[1], bw[cb][1], z, 0, 0, 0);
                f32x4 ag = __builtin_amdgcn_mfma_f32_16x16x32_bf16(af[2], bw[cb][2], z, 0, 0, 0);
                ag = __builtin_amdgcn_mfma_f32_16x16x32_bf16(af[3], bw[cb][3], ag, 0, 0, 0);
                ag = __builtin_amdgcn_mfma_f32_16x16x32_bf16(af[4], bw[cb][4], ag, 0, 0, 0);
                const int col = wave * 64 + cb * 16 + fcol;
#pragma unroll
                for (int i = 0; i < 4; ++i) { const int row = (lane >> 4) * 4 + i;
                    DEC[row * 512 + col] = __expf(-0.6065306597126334f * sigmoidf_(aw[i] + w0c[cb]));
                    ALR[row * 512 + col] = sigmoidf_(aa[i] + a0c[cb]);
                    GG[row * 512 + col] = ag[i]; }
            }
        }
        __syncthreads();
#pragma unroll 1
        for (int q = 0; q < 2; ++q) {
            const int tok = 2 * wave + q, t = t0 + tok; const size_t o = (size_t)t * CW + c8;
            const bf16_t* pr = P + (size_t)t * NINP + c8;
            const bool first = (t & (SEQ - 1)) == 0;
            const u32x4 zz = (u32x4){0u, 0u, 0u, 0u};
            f32x4 rr0, rr1;
            { const u32x4 cu = *(const u32x4*)(pr), pu = first ? zz : *(const u32x4*)(pr - NINP);
              const f32x4 m0 = *(const f32x4*)(mu + c8), m1 = *(const f32x4*)(mu + c8 + 4);
              const f32x4 c0 = cvlo(cu), c1 = cvhi(cu), p0 = cvlo(pu), p1 = cvhi(pu);
              rr0 = c0 + (p0 - c0) * m0; rr1 = c1 + (p1 - c1) * m1; *(u32x4*)(SR + o) = pk8(rr0, rr1); }
            { const u32x4 cu = *(const u32x4*)(pr + 1024), pu = first ? zz : *(const u32x4*)(pr - NINP + 1024);
              const f32x4 m0 = *(const f32x4*)(mu + 1024 + c8), m1 = *(const f32x4*)(mu + 1024 + c8 + 4);
              const f32x4 c0 = cvlo(cu), c1 = cvhi(cu), p0 = cvlo(pu), p1 = cvhi(pu);
              *(u32x4*)(SV + o) = pk8(c0 + (p0 - c0) * m0, c1 + (p1 - c1) * m1); }
            { const u32x4 cu = *(const u32x4*)(pr + 512), pu = first ? zz : *(const u32x4*)(pr - NINP + 512);
              const f32x4 m0 = *(const f32x4*)(mu + 512 + c8), m1 = *(const f32x4*)(mu + 512 + c8 + 4);
              const f32x4 c0 = cvlo(cu), c1 = cvhi(cu), p0 = cvlo(pu), p1 = cvhi(pu);
              const f32x4 k0 = c0 + (p0 - c0) * m0, k1 = c1 + (p1 - c1) * m1;
              const f32x4 kk0 = k0 * *(const f32x4*)(k_k + c8), kk1 = k1 * *(const f32x4*)(k_k + c8 + 4);
              float ss = (kk0.x * kk0.x + kk0.y * kk0.y) + (kk0.z * kk0.z + kk0.w * kk0.w) + (kk1.x * kk1.x + kk1.y * kk1.y) + (kk1.z * kk1.z + kk1.w * kk1.w);
              ss = red8(ss);
              const float inv = 1.0f / sqrtf(fmaxf(ss, 1e-24f));
              const f32x4 kn0 = kk0 * inv, kn1 = kk1 * inv;
              const f32x4 al0 = *(const LAS f32x4*)(ALR + tok * 512 + c8), al1 = *(const LAS f32x4*)(ALR + tok * 512 + c8 + 4);
              const f32x4 k20 = k0 * (1.0f + (al0 - 1.0f) * *(const f32x4*)(k_a + c8)), k21 = k1 * (1.0f + (al1 - 1.0f) * *(const f32x4*)(k_a + c8 + 4));
              *(u32x4*)(SK + o) = pk8(k20, k21); *(u32x4*)(SA + o) = pk8(-kn0, -kn1); *(u32x4*)(SB + o) = pk8(kn0 * al0, kn1 * al1);
              const f32x4 q0 = rr0 * k20 * *(const f32x4*)(a.in[11] + c8), q1 = rr1 * k21 * *(const f32x4*)(a.in[11] + c8 + 4);
              const float rk = red8((q0.x + q0.y) + (q0.z + q0.w) + (q1.x + q1.y) + (q1.z + q1.w));
              if ((lane & 7) == 0) ((float*)(ws + WS_RK))[(size_t)t * 8 + (lane >> 3)] = rk; }
            { const f32x4 de0 = *(const LAS f32x4*)(DEC + tok * 512 + c8), de1 = *(const LAS f32x4*)(DEC + tok * 512 + c8 + 4);
              const f32x4 gg0 = *(const LAS f32x4*)(GG + tok * 512 + c8), gg1 = *(const LAS f32x4*)(GG + tok * 512 + c8 + 4);
              *(u32x4*)(SG + o) = pk8(gg0, gg1); *(f32x4*)(SW + o) = de0; *(f32x4*)(SW + o + 4) = de1; }
            { const u32x4 uq = *(const u32x4*)(pr + DQ0), ukd = *(const u32x4*)(pr + DK0);
              const f32x4 q0 = cvlo(uq), q1 = cvhi(uq), d0 = cvlo(ukd), d1 = cvhi(ukd);
              float qs = (q0.x * q0.x + q0.y * q0.y) + (q0.z * q0.z + q0.w * q0.w) + (q1.x * q1.x + q1.y * q1.y) + (q1.z * q1.z + q1.w * q1.w);
              float ks = (d0.x * d0.x + d0.y * d0.y) + (d0.z * d0.z + d0.w * d0.w) + (d1.x * d1.x + d1.y * d1.y) + (d1.z * d1.z + d1.w * d1.w);
              qs = red8(qs); ks = red8(ks);
              const float qi = (1.0f / sqrtf(qs * (1.0f / 64.0f) + 1e-5f)) * (0.125f * LOG2E), ki = 1.0f / sqrtf(ks * (1.0f / 64.0f) + 1e-5f);
              const f32x4 g0 = *(const f32x4*)(qn_g + (c8 & 63)), g1 = *(const f32x4*)(qn_g + (c8 & 63) + 4), h0 = *(const f32x4*)(kn_g + (c8 & 63)), h1 = *(const f32x4*)(kn_g + (c8 & 63) + 4);
              *(u32x4*)(QN + o) = pk8(q0 * qi * g0, q1 * qi * g1);
              *(u32x4*)(KN + o) = pk8(d0 * ki * h0, d1 * ki * h1); }
        }
        __syncthreads();
    }
}

namespace ck {
constexpr int PS = 136;
constexpr int O_BT = 0, O_KT = 8704, O_AP = 17408, O_RT = 26112;
constexpr int O_AT = 34816, O_BH = 43008, O_KH = 51200, O_VV = 59392, O_TN = 67584, O_A2 = 75776, O_V2 = 83968;
constexpr int O_L = 92160, LSTR = 68;
constexpr int O_TOT = 109568, O_GC = 111616;
__device__ __forceinline__ int crow(int r, int hi) { return (r & 3) + 8 * (r >> 2) + 4 * hi; }
__device__ __forceinline__ int voff(int row, int col) { return ((col >> 5) * 4 + (row >> 4)) * 1024 + (row & 15) * 64 + (col & 31) * 2; }
__device__ __forceinline__ s16x4 vtr(const LAS unsigned char* p) { return __builtin_bit_cast(s16x4, __builtin_amdgcn_ds_read_tr16_b64_v4i16((LAS s16x4*)p)); }
__device__ __forceinline__ bf16x8 fragP(const LAS unsigned char* M, int row, int k0, int hi) {
    const LAS unsigned char* p = M + row * PS + (k0 + 4 * hi) * 2; const s16x4 lo = *(const LAS s16x4*)p, h = *(const LAS s16x4*)(p + 16);
    return (bf16x8){lo[0], lo[1], lo[2], lo[3], h[0], h[1], h[2], h[3]}; }
__device__ __forceinline__ bf16x8 fragT(const LAS unsigned char* M, int k0, int colblk, int lane, int hi) {
    const LAS unsigned char* p = M + (colblk * 4 + (k0 >> 4)) * 1024 + ((lane >> 4) & 1) * 32 + (lane & 3) * 8 + (4 * hi + ((lane & 15) >> 2)) * 64;
    const s16x4 lo = vtr(p), h = vtr(p + 512); return (bf16x8){lo[0], lo[1], lo[2], lo[3], h[0], h[1], h[2], h[3]}; }
__device__ __forceinline__ bf16x8 packR(const f32x16& x, int s) {
    u32x4 w; w.x = pk2(x[8 * s], x[8 * s + 1]); w.y = pk2(x[8 * s + 2], x[8 * s + 3]); w.z = pk2(x[8 * s + 4], x[8 * s + 5]); w.w = pk2(x[8 * s + 6], x[8 * s + 7]); return __builtin_bit_cast(bf16x8, w); }
#define CK_MFMA(a, b, c) __builtin_amdgcn_mfma_f32_32x32x16_bf16(a, b, c, 0, 0, 0)
__device__ __forceinline__ f32x16 score(const LAS unsigned char* Am, const LAS unsigned char* Bm, int sblk, int tblk, int mode, int r32, int hi) {
    f32x16 x = f32x16{};
#pragma unroll
    for (int ks = 0; ks < 4; ++ks) x = CK_MFMA(fragP(Am, sblk * 32 + r32, 16 * ks, hi), fragP(Bm, tblk * 32 + r32, 16 * ks, hi), x);
    if (mode) {
        const int t = tblk * 32 + r32;
#pragma unroll
        for (int r = 0; r < 16; ++r) { const int s = sblk * 32 + crow(r, hi); if (mode == 1 ? !(s < t) : !(s <= t)) x[r] = 0.f; }
    }
    return x;
}
__device__ __forceinline__ void storeT_V(LAS unsigned char* M, const f32x16& x, int rb, int c, int hi) {
#pragma unroll
    for (int q = 0; q < 4; ++q) { u32x2 w; w.x = pk2(x[4 * q], x[4 * q + 1]); w.y = pk2(x[4 * q + 2], x[4 * q + 3]); *(LAS u32x2*)(M + voff(c, rb * 32 + 8 * q + 4 * hi)) = w; }
}
__device__ __forceinline__ void storeT_S(LAS unsigned char* M, const f32x16& x, int rb, int c, int hi) {
#pragma unroll
    for (int q = 0; q < 4; ++q) { u32x2 w; w.x = pk2(x[4 * q], x[4 * q + 1]); w.y = pk2(x[4 * q + 2], x[4 * q + 3]); *(LAS u32x2*)(M + c * PS + (rb * 32 + 8 * q + 4 * hi) * 2) = w; }
}

__device__ __forceinline__ void chunk_item(LAS unsigned char* lds, const Args& a, int item) {
    const int tid = threadIdx.x; int lane = tid & 63; const int wave = __builtin_amdgcn_readfirstlane(tid >> 6);
#define CK_FRESH() asm volatile("" : "+v"(lane)); r32 = lane & 31; hi = lane >> 5
    int r32, hi; CK_FRESH();
    unsigned char* ws = a.ws;
    const bf16_t* SR = (const bf16_t*)(ws + WS_SR); const bf16_t* SK = (const bf16_t*)(ws + WS_SK); const bf16_t* SV = (const bf16_t*)(ws + WS_SV);
    const bf16_t* SA = (const bf16_t*)(ws + WS_SA); const bf16_t* SB = (const bf16_t*)(ws + WS_SB); const float* SW = (const float*)(ws + WS_SW);
    bf16_t* CG = (bf16_t*)(ws + WS_CG) + (size_t)item * 4096; bf16_t* CH = (bf16_t*)(ws + WS_CH) + (size_t)item * 4096;
    bf16_t* CR2 = (bf16_t*)(ws + WS_CR2) + (size_t)item * 4096; bf16_t* CY0 = (bf16_t*)(ws + WS_CY0) + (size_t)item * 4096;
    const int bh = item >> 6, c = item & 63, b = bh >> 3, h = bh & 7, tokc = b * SEQ + c * 64, col0 = h * 64;
    LAS unsigned char* BT = lds + O_BT; LAS unsigned char* KT = lds + O_KT; LAS unsigned char* AP = lds + O_AP; LAS unsigned char* RT = lds + O_RT;
    LAS unsigned char* AT = lds + O_AT; LAS unsigned char* BH = lds + O_BH; LAS unsigned char* KH = lds + O_KH; LAS unsigned char* VV = lds + O_VV;
    LAS unsigned char* TN = lds + O_TN; LAS unsigned char* A2M = lds + O_A2; LAS unsigned char* V2M = lds + O_V2;
    LAS float* L = (LAS float*)(lds + O_L); LAS float* TOT = (LAS float*)(lds + O_TOT); LAS float* GC = (LAS float*)(lds + O_GC);
    {
        float loc[8];
#pragma unroll
        for (int i = 0; i < 8; ++i) { const float wv = SW[(size_t)(tokc + 8 * wave + i) * CW + col0 + lane]; loc[i] = i ? loc[i - 1] * wv : wv; }
        TOT[wave * 64 + lane] = loc[7];
        __syncthreads();
        float pre = 1.f, gC = 1.f;
#pragma unroll
        for (int w2 = 0; w2 < 8; ++w2) { const float tv = TOT[w2 * 64 + lane]; if (w2 < wave) pre *= tv; gC *= tv; }
        if (wave == 0) GC[lane] = gC;
#pragma unroll
        for (int i = 0; i < 8; ++i) {
            const int tl = 8 * wave + i; const size_t o = (size_t)(tokc + tl) * CW + col0 + lane;
            const float g = pre * loc[i], gp = i ? pre * loc[i - 1] : pre, ig = __builtin_amdgcn_rcpf(g);
            const float av = bf2f(SA[o]), bv = bf2f(SB[o]), kv = bf2f(SK[o]), rv = bf2f(SR[o]), vv = bf2f(SV[o]);
            const unsigned short at = (unsigned short)f2bf(av * gp);
            *(LAS unsigned short*)(AP + tl * PS + lane * 2) = at; *(LAS unsigned short*)(AT + voff(tl, lane)) = at;
            *(LAS unsigned short*)(RT + tl * PS + lane * 2) = (unsigned short)f2bf(rv * g);
            *(LAS unsigned short*)(BT + tl * PS + lane * 2) = (unsigned short)f2bf(bv * ig);
            *(LAS unsigned short*)(KT + tl * PS + lane * 2) = (unsigned short)f2bf(kv * ig);
            *(LAS unsigned short*)(BH + voff(tl, lane)) = (unsigned short)f2bf(bv * ig * gC);
            *(LAS unsigned short*)(KH + voff(tl, lane)) = (unsigned short)f2bf(kv * ig * gC);
            *(LAS unsigned short*)(VV + voff(tl, lane)) = (unsigned short)f2bf(vv);
        }
    }
    __syncthreads();
    CK_FRESH();
    f32x16 pa = f32x16{}, pb = f32x16{}, pc = f32x16{}, pd = f32x16{};
#define w1a pa
#define w1b pb
#define xb0 pa
#define xb1 pb
#define y0a pc
#define y0b pd
    if (wave < 2) {
        for (int k = 0; k < (wave == 0 ? 2 : 1); ++k) {
            const int sblk = wave == 0 ? k : 0, tblk = wave == 0 ? k : 1;
            const f32x16 x = score(BT, AP, sblk, tblk, wave == 0 ? 1 : 0, r32, hi);
            const int t = tblk * 32 + r32;
#pragma unroll
            for (int q = 0; q < 4; ++q) *(LAS f32x4*)(L + t * LSTR + sblk * 32 + 8 * q + 4 * hi) = (f32x4){x[4 * q], x[4 * q + 1], x[4 * q + 2], x[4 * q + 3]};
        }
    }
    __syncthreads();
    CK_FRESH();
    if (wave == 6) {
        float x[32];
        const LAS float* Lr = L + (32 * hi) * LSTR + 32 * hi;
#pragma unroll
        for (int t = 0; t < 32; ++t) {
            float acc = (r32 == t) ? 1.f : 0.f;
#pragma unroll
            for (int s4 = 0; s4 * 4 < t; ++s4) {
                const f32x4 l = *(const LAS f32x4*)(Lr + t * LSTR + 4 * s4);
                if (4 * s4 + 0 < t) acc += l.x * x[4 * s4 + 0];
                if (4 * s4 + 1 < t) acc += l.y * x[4 * s4 + 1];
                if (4 * s4 + 2 < t) acc += l.z * x[4 * s4 + 2];
                if (4 * s4 + 3 < t) acc += l.w * x[4 * s4 + 3];
            }
            x[t] = acc;
            __builtin_amdgcn_sched_barrier(0);
        }
        const int cc = 32 * hi + r32;
#pragma unroll
        for (int t0 = 0; t0 < 32; t0 += 8) { u32x4 w; w.x = pk2(x[t0], x[t0 + 1]); w.y = pk2(x[t0 + 2], x[t0 + 3]); w.z = pk2(x[t0 + 4], x[t0 + 5]); w.w = pk2(x[t0 + 6], x[t0 + 7]);
            *(LAS u32x4*)(TN + voff(cc, 32 * hi + t0)) = w; }
        f32x16 m = f32x16{};
#pragma unroll
        for (int s = 0; s < 2; ++s) {
            const LAS float* lp = L + (32 + r32) * LSTR + 16 * s + 4 * hi;
            const f32x4 l0 = *(const LAS f32x4*)lp, l1 = *(const LAS f32x4*)(lp + 8);
            u32x4 aw; aw.x = pk2(l0.x, l0.y); aw.y = pk2(l0.z, l0.w); aw.z = pk2(l1.x, l1.y); aw.w = pk2(l1.z, l1.w);
            const s16x4 b0 = *(const LAS s16x4*)(TN + voff(r32, 16 * s + 4 * hi)), b1 = *(const LAS s16x4*)(TN + voff(r32, 16 * s + 8 + 4 * hi));
            m = CK_MFMA(__builtin_bit_cast(bf16x8, aw), ((bf16x8){b0[0], b0[1], b0[2], b0[3], b1[0], b1[1], b1[2], b1[3]}), m);
        }
        f32x16 t21 = f32x16{};
#pragma unroll
        for (int s = 0; s < 2; ++s) t21 = CK_MFMA(fragT(TN, 32 + 16 * s, 1, lane, hi), packR(m, s), t21);
        storeT_V(TN, t21, 1, r32, hi);
    } else if (wave < 4) {
        const int dvb = wave - 2;
        const f32x16 x00 = score(KT, AP, 0, 0, 1, r32, hi), x01 = score(KT, AP, 0, 1, 0, r32, hi), x11 = score(KT, AP, 1, 1, 1, r32, hi);
#pragma unroll
        for (int s = 0; s < 2; ++s) {
            const bf16x8 v0 = fragT(VV, 16 * s, dvb, lane, hi), v1 = fragT(VV, 32 + 16 * s, dvb, lane, hi);
            w1a = CK_MFMA(packR(x00, s), v0, w1a);
            w1b = CK_MFMA(packR(x01, s), v0, w1b);
            w1b = CK_MFMA(packR(x11, s), v1, w1b);
        }
    } else if (wave < 6) {
        const int tb = wave - 4;
        f32x16 xk0, xk1 = f32x16{};
        if (tb == 0) { xk0 = score(KT, RT, 0, 0, 2, r32, hi); xb0 = score(BT, RT, 0, 0, 2, r32, hi); }
        else { xk0 = score(KT, RT, 0, 1, 0, r32, hi); xk1 = score(KT, RT, 1, 1, 2, r32, hi); xb0 = score(BT, RT, 0, 1, 0, r32, hi); xb1 = score(BT, RT, 1, 1, 2, r32, hi); }
#pragma unroll
        for (int s = 0; s < 2; ++s) {
            y0a = CK_MFMA(fragT(VV, 16 * s, 0, lane, hi), packR(xk0, s), y0a);
            y0b = CK_MFMA(fragT(VV, 16 * s, 1, lane, hi), packR(xk0, s), y0b);
            if (tb == 1) { y0a = CK_MFMA(fragT(VV, 32 + 16 * s, 0, lane, hi), packR(xk1, s), y0a); y0b = CK_MFMA(fragT(VV, 32 + 16 * s, 1, lane, hi), packR(xk1, s), y0b); }
        }
    }
    __syncthreads();
    CK_FRESH();
    if (wave < 2) {
        const int cb = wave; f32x16 a0 = f32x16{}, a1 = f32x16{};
#pragma unroll
        for (int ks = 0; ks < 4; ++ks) {
            const bf16x8 af = fragT(AT, 16 * ks, cb, lane, hi);
            if (ks < 2) a0 = CK_MFMA(af, fragT(TN, 16 * ks, 0, lane, hi), a0);
            a1 = CK_MFMA(af, fragT(TN, 16 * ks, 1, lane, hi), a1);
        }
        storeT_V(A2M, a0, cb, r32, hi); storeT_V(A2M, a1, cb, 32 + r32, hi);
    } else if (wave < 4) {
        const int dvb = wave - 2; f32x16 v0 = f32x16{}, v1 = f32x16{};
#pragma unroll
        for (int s = 0; s < 2; ++s) {
            v0 = CK_MFMA(packR(w1a, s), fragT(TN, 16 * s, 0, lane, hi), v0);
            v1 = CK_MFMA(packR(w1a, s), fragT(TN, 16 * s, 1, lane, hi), v1);
            v1 = CK_MFMA(packR(w1b, s), fragT(TN, 32 + 16 * s, 1, lane, hi), v1);
        }
        storeT_V(V2M, v0, dvb, r32, hi); storeT_V(V2M, v1, dvb, 32 + r32, hi);
    }
    __syncthreads();
    CK_FRESH();
    if (wave >= 4 && wave < 6) {
        const int tb = wave - 4, t = tb * 32 + r32;
        f32x16 r0 = f32x16{}, r1 = f32x16{};
#pragma unroll
        for (int s = 0; s < 2; ++s) {
            const bf16x8 p0 = packR(xb0, s);
            r0 = CK_MFMA(fragT(A2M, 16 * s, 0, lane, hi), p0, r0); r1 = CK_MFMA(fragT(A2M, 16 * s, 1, lane, hi), p0, r1);
            y0a = CK_MFMA(fragT(V2M, 16 * s, 0, lane, hi), p0, y0a); y0b = CK_MFMA(fragT(V2M, 16 * s, 1, lane, hi), p0, y0b);
            if (tb == 1) { const bf16x8 p1 = packR(xb1, s);
                r0 = CK_MFMA(fragT(A2M, 32 + 16 * s, 0, lane, hi), p1, r0); r1 = CK_MFMA(fragT(A2M, 32 + 16 * s, 1, lane, hi), p1, r1);
                y0a = CK_MFMA(fragT(V2M, 32 + 16 * s, 0, lane, hi), p1, y0a); y0b = CK_MFMA(fragT(V2M, 32 + 16 * s, 1, lane, hi), p1, y0b); }
        }
#pragma unroll
        for (int q = 0; q < 4; ++q) {
            const u32x2 u0 = *(const LAS u32x2*)(RT + t * PS + (8 * q + 4 * hi) * 2), u1 = *(const LAS u32x2*)(RT + t * PS + (32 + 8 * q + 4 * hi) * 2);
            r0[4 * q] += bflo(u0.x); r0[4 * q + 1] += bfhi(u0.x); r0[4 * q + 2] += bflo(u0.y); r0[4 * q + 3] += bfhi(u0.y);
            r1[4 * q] += bflo(u1.x); r1[4 * q + 1] += bfhi(u1.x); r1[4 * q + 2] += bflo(u1.y); r1[4 * q + 3] += bfhi(u1.y);
        }
        storeT_S(BT, r0, 0, t, hi); storeT_S(BT, r1, 1, t, hi);
        storeT_S(KT, y0a, 0, t, hi); storeT_S(KT, y0b, 1, t, hi);
    } else if (wave < 2) {
        const int ib = wave, i = ib * 32 + r32; const float gci = GC[i];
        f32x16 g0 = f32x16{}, g1 = f32x16{};
#pragma unroll
        for (int ks = 0; ks < 4; ++ks) { const bf16x8 bf_ = fragT(BH, 16 * ks, ib, lane, hi);
            g0 = CK_MFMA(fragT(A2M, 16 * ks, 0, lane, hi), bf_, g0); g1 = CK_MFMA(fragT(A2M, 16 * ks, 1, lane, hi), bf_, g1); }
#pragma unroll
        for (int r = 0; r < 16; ++r) { if (crow(r, hi) == i) g0[r] += gci; if (32 + crow(r, hi) == i) g1[r] += gci; }
        storeT_S(AP, g0, 0, i, hi); storeT_S(AP, g1, 1, i, hi);
    } else {
        const int id = wave < 4 ? wave - 2 : wave - 4, ib = id >> 1, dvb = id & 1;
        f32x16 hh = f32x16{};
#pragma unroll
        for (int ks = 0; ks < 4; ++ks) {
            hh = CK_MFMA(fragT(BH, 16 * ks, ib, lane, hi), fragT(V2M, 16 * ks, dvb, lane, hi), hh);
            hh = CK_MFMA(fragT(KH, 16 * ks, ib, lane, hi), fragT(VV, 16 * ks, dvb, lane, hi), hh);
        }
        storeT_S((LAS unsigned char*)L, hh, ib, dvb * 32 + r32, hi);
    }
    __syncthreads();
    {
        const int row = tid >> 3, ch = tid & 7;
        const LAS unsigned char* s0 = BT + row * PS + ch * 16; const LAS unsigned char* s1 = KT + row * PS + ch * 16; const LAS unsigned char* s2 = AP + row * PS + ch * 16; const LAS unsigned char* s3 = (const LAS unsigned char*)L + row * PS + ch * 16;
        const u32x2 a0 = *(const LAS u32x2*)s0, a1 = *(const LAS u32x2*)(s0 + 8), b0 = *(const LAS u32x2*)s1, b1 = *(const LAS u32x2*)(s1 + 8);
        const u32x2 c0 = *(const LAS u32x2*)s2, c1 = *(const LAS u32x2*)(s2 + 8), d0 = *(const LAS u32x2*)s3, d1 = *(const LAS u32x2*)(s3 + 8);
        *(u32x4*)(CR2 + row * 64 + ch * 8) = (u32x4){a0.x, a0.y, a1.x, a1.y}; *(u32x4*)(CY0 + row * 64 + ch * 8) = (u32x4){b0.x, b0.y, b1.x, b1.y};
        *(u32x4*)(CG + row * 64 + ch * 8) = (u32x4){c0.x, c0.y, c1.x, c1.y}; *(u32x4*)(CH + row * 64 + ch * 8) = (u32x4){d0.x, d0.y, d1.x, d1.y};
    }
    __syncthreads();
#undef CK_FRESH
#undef w1a
#undef w1b
#undef xb0
#undef xb1
#undef y0a
#undef y0b
}
__device__ __forceinline__ void p2b_chunks(LAS unsigned char* lds, const Args& a) {
#pragma unroll 1
    for (int item = blockIdx.x; item < 4096; item += gridDim.x) chunk_item(lds, a, item);
}
}

namespace ck {
constexpr int SQ_MAT = 8704, SQ_BUF = 6 * SQ_MAT;
constexpr int SQ_OUT = 2 * SQ_BUF;
__device__ __forceinline__ bf16x8 lfrag(const LAS unsigned char* M, int row, int k0, int hi) { return fragP(M, row, k0, hi); }
__device__ __forceinline__ void linit(f32x16& x, const LAS unsigned char* M, int row, int cblk, int hi) {
#pragma unroll
    for (int q = 0; q < 4; ++q) { const u32x2 u = *(const LAS u32x2*)(M + row * PS + (cblk * 32 + 8 * q + 4 * hi) * 2); x[4 * q] = bflo(u.x); x[4 * q + 1] = bfhi(u.x); x[4 * q + 2] = bflo(u.y); x[4 * q + 3] = bfhi(u.y); }
}
__device__ __forceinline__ void seq_head(LAS unsigned char* lds, const Args& a, int bh) {
    const int tid = threadIdx.x, lane = tid & 63, r32 = lane & 31, hi = lane >> 5; const int wave = __builtin_amdgcn_readfirstlane(tid >> 6);
    unsigned char* ws = a.ws;
    const bf16_t* SV = (const bf16_t*)(ws + WS_SV); const bf16_t* SG = (const bf16_t*)(ws + WS_SG); const float* RK = (const float*)(ws + WS_RK); bf16_t* YMIX = (bf16_t*)(ws + WS_YMIX);
    const int b = bh >> 3, h = bh & 7, col0 = h * 64;
    const float* lng = a.in[12] + col0; const float* lnb = a.in[13] + col0;
#define SQ_LOAD(ch) do { const size_t item_ = (size_t)bh * 64 + (ch); LAS unsigned char* bb_ = lds + ((ch) & 1) * SQ_BUF; const size_t t0_ = (size_t)b * SEQ + (ch) * 64; \
        for (int p_ = tid - 128; p_ < 3072; p_ += 384) { const int m_ = p_ >> 9, q_ = p_ & 511, row_ = q_ >> 3, c8_ = (q_ & 7) * 8; u32x4 v_; \
            if (m_ == 0) v_ = *(const u32x4*)((const bf16_t*)(ws + WS_CG) + item_ * 4096 + row_ * 64 + c8_); \
            else if (m_ == 1) v_ = *(const u32x4*)((const bf16_t*)(ws + WS_CH) + item_ * 4096 + row_ * 64 + c8_); \
            else if (m_ == 2) v_ = *(const u32x4*)((const bf16_t*)(ws + WS_CR2) + item_ * 4096 + row_ * 64 + c8_); \
            else if (m_ == 3) v_ = *(const u32x4*)((const bf16_t*)(ws + WS_CY0) + item_ * 4096 + row_ * 64 + c8_); \
            else if (m_ == 4) v_ = *(const u32x4*)(SV + (t0_ + row_) * CW + col0 + c8_); \
            else v_ = *(const u32x4*)(SG + (t0_ + row_) * CW + col0 + c8_); \
            LAS unsigned char* d_ = bb_ + m_ * SQ_MAT + row_ * PS + c8_ * 2; *(LAS u32x2*)d_ = (u32x2){v_.x, v_.y}; *(LAS u32x2*)(d_ + 8) = (u32x2){v_.z, v_.w}; } } while (0)
#define SQ_STORE(ch) do { const LAS unsigned char* ob_ = lds + SQ_OUT + ((ch) & 1) * SQ_MAT; const size_t t0_ = (size_t)b * SEQ + (ch) * 64; \
        for (int p_ = tid - 128; p_ < 512; p_ += 384) { const int row_ = p_ >> 3, c8_ = (p_ & 7) * 8; const LAS unsigned char* s_ = ob_ + row_ * PS + c8_ * 2; \
            const u32x2 lo_ = *(const LAS u32x2*)s_, hi_ = *(const LAS u32x2*)(s_ + 8); *(u32x4*)(YMIX + (t0_ + row_) * D + col0 + c8_) = (u32x4){lo_.x, lo_.y, hi_.x, hi_.y}; } } while (0)
    if (wave >= 2) SQ_LOAD(0);
    __syncthreads();
    f32x16 X00 = f32x16{}, X01 = f32x16{}, X10 = f32x16{}, X11 = f32x16{};
#pragma unroll 1
    for (int c = 0; c < 64; ++c) {
        if (wave >= 2) {
            if (c + 1 < 64) SQ_LOAD(c + 1);
            if (c > 0) SQ_STORE(c - 1);
        } else {
            const int tb = wave;
            const LAS unsigned char* bb = lds + (c & 1) * SQ_BUF;
            const LAS unsigned char* MG = bb; const LAS unsigned char* MH = bb + SQ_MAT; const LAS unsigned char* MR = bb + 2 * SQ_MAT; const LAS unsigned char* MY = bb + 3 * SQ_MAT;
            const LAS unsigned char* MV = bb + 4 * SQ_MAT; const LAS unsigned char* MGT = bb + 5 * SQ_MAT;
            LAS unsigned char* OB = lds + SQ_OUT + (c & 1) * SQ_MAT;
            const int tl = tb * 32 + r32; const size_t t = (size_t)b * SEQ + c * 64 + tl;
            const float rk = RK[t * 8 + h];
            f32x16 y0, y1; linit(y0, MY, tl, 0, hi); linit(y1, MY, tl, 1, hi);
#pragma unroll
            for (int s = 0; s < 2; ++s) {
                const bf16x8 rf0 = lfrag(MR, tl, 16 * s, hi), rf1 = lfrag(MR, tl, 32 + 16 * s, hi);
                y0 = CK_MFMA(packR(X00, s), rf0, y0); y0 = CK_MFMA(packR(X10, s), rf1, y0);
                y1 = CK_MFMA(packR(X01, s), rf0, y1); y1 = CK_MFMA(packR(X11, s), rf1, y1);
            }
#pragma unroll
            for (int db = 0; db < 2; ++db) {
                f32x16 Na, Nb; linit(Na, MH, db * 32 + r32, 0, hi); linit(Nb, MH, db * 32 + r32, 1, hi);
#pragma unroll
                for (int s = 0; s < 2; ++s) {
                    const bf16x8 g00 = lfrag(MG, r32, 16 * s, hi), g01 = lfrag(MG, r32, 32 + 16 * s, hi), g10 = lfrag(MG, 32 + r32, 16 * s, hi), g11 = lfrag(MG, 32 + r32, 32 + 16 * s, hi);
                    const bf16x8 p0 = packR(db ? X01 : X00, s), p1 = packR(db ? X11 : X10, s);
                    Na = CK_MFMA(g00, p0, Na); Na = CK_MFMA(g01, p1, Na);
                    Nb = CK_MFMA(g10, p0, Nb); Nb = CK_MFMA(g11, p1, Nb);
                }
                if (db == 0) { X00 = Na; X10 = Nb; } else { X01 = Na; X11 = Nb; }
            }
            float sm = 0.f;
#pragma unroll
            for (int r = 0; r < 16; ++r) sm += y0[r] + y1[r];
            sm += __shfl_xor(sm, 32);
            const float mean = sm * (1.0f / 64.0f);
            float sq = 0.f;
#pragma unroll
            for (int r = 0; r < 16; ++r) { const float d0 = y0[r] - mean, d1 = y1[r] - mean; sq += d0 * d0 + d1 * d1; }
            sq += __shfl_xor(sq, 32);
            const float rs = 1.0f / sqrtf(sq * (1.0f / 64.0f) + 64e-5f);
#pragma unroll
            for (int db = 0; db < 2; ++db)
#pragma unroll
                for (int q = 0; q < 4; ++q) {
                    const int dv = db * 32 + 8 * q + 4 * hi;
                    const f32x4 lg = *(const f32x4*)(lng + dv), lb = *(const f32x4*)(lnb + dv);
                    const u32x2 uv = *(const LAS u32x2*)(MV + tl * PS + dv * 2), ug = *(const LAS u32x2*)(MGT + tl * PS + dv * 2);
                    const f32x4 vv = {bflo(uv.x), bfhi(uv.x), bflo(uv.y), bfhi(uv.y)}, gg = {bflo(ug.x), bfhi(ug.x), bflo(ug.y), bfhi(ug.y)};
                    f32x4 yy; if (db == 0) yy = (f32x4){y0[4 * q], y0[4 * q + 1], y0[4 * q + 2], y0[4 * q + 3]}; else yy = (f32x4){y1[4 * q], y1[4 * q + 1], y1[4 * q + 2], y1[4 * q + 3]};
                    const f32x4 o = ((yy - mean) * rs * lg + lb + rk * vv) * gg;
                    u32x2 w; w.x = pk2(o.x, o.y); w.y = pk2(o.z, o.w);
                    *(LAS u32x2*)(OB + tl * PS + dv * 2) = w;
                }
        }
        __syncthreads();
    }
    if (wave >= 2) SQ_STORE(63);
#undef SQ_LOAD
#undef SQ_STORE
}
}

__device__ __forceinline__ float red16(float v) {
    v += dpp_f<0xB1>(v); v += dpp_f<0x4E>(v); v += dpp_f<0x141>(v); v += dpp_f<0x140>(v);
    return v;
}
__device__ __forceinline__ void p3_scan(LAS unsigned char* lds, const Args& a) {
    const int tid = threadIdx.x, lane = tid & 63, wave = __builtin_amdgcn_readfirstlane(tid >> 6);
    unsigned char* ws = a.ws;
    const bf16_t* SR = (const bf16_t*)(ws + WS_SR); const bf16_t* SK = (const bf16_t*)(ws + WS_SK); const bf16_t* SV = (const bf16_t*)(ws + WS_SV);
    const bf16_t* SA = (const bf16_t*)(ws + WS_SA); const bf16_t* SB = (const bf16_t*)(ws + WS_SB); const float* SW = (const float*)(ws + WS_SW);
    float* YRAW = (float*)(ws + WS_YRAW);
    const int bh = blockIdx.x >> 1, half = blockIdx.x & 1;
    const int b = bh >> 3, h = bh & 7, tok0 = b * SEQ, col0 = h * 64, row0 = half * 32;
    constexpr int BUFB = 45056;
    LAS float* buf0 = (LAS float*)lds; LAS float* buf1 = (LAS float*)(lds + BUFB);
    LAS float* Y0 = (LAS float*)(lds + 2 * BUFB); LAS float* Y1 = Y0 + 1024;
    constexpr int NCH = SEQ / 32;
    if (wave >= 4) {
        const int lw = wave - 4, sl = lw * 8 + (lane >> 3), cg = lane & 7, c8 = cg * 8;
        f32x4 w0_, w1_; u32x4 uk, ua, ub, ur; u32x2 uv;
#define SC_ISSUE(ch) do { const size_t o_ = (size_t)(tok0 + (ch) * 32 + sl) * CW + col0; \
            w0_ = *(const f32x4*)(SW + o_ + c8); w1_ = *(const f32x4*)(SW + o_ + c8 + 4); uk = *(const u32x4*)(SK + o_ + c8); ua = *(const u32x4*)(SA + o_ + c8); ub = *(const u32x4*)(SB + o_ + c8); ur = *(const u32x4*)(SR + o_ + c8); \
            uv = *(const u32x2*)(SV + o_ + row0 + 4 * cg); } while (0)
#define SC_STORE(bufp) do { LAS float* d_ = (bufp) + sl * 64 + c8; *(LAS f32x4*)(d_) = w0_; *(LAS f32x4*)(d_ + 4) = w1_; \
            *(LAS f32x4*)(d_ + 2048) = cvlo(uk); *(LAS f32x4*)(d_ + 2052) = cvhi(uk); *(LAS f32x4*)(d_ + 4096) = cvlo(ua); *(LAS f32x4*)(d_ + 4100) = cvhi(ua); \
            *(LAS f32x4*)(d_ + 6144) = cvlo(ub); *(LAS f32x4*)(d_ + 6148) = cvhi(ub); *(LAS f32x4*)(d_ + 8192) = cvlo(ur); *(LAS f32x4*)(d_ + 8196) = cvhi(ur); \
            *(LAS f32x4*)((bufp) + 10240 + sl * 32 + 4 * cg) = (f32x4){bflo(uv.x), bfhi(uv.x), bflo(uv.y), bfhi(uv.y)}; } while (0)
#define SC_YOUT(ch, yp) do { *(f32x4*)(YRAW + (size_t)(tok0 + (ch) * 32 + sl) * CW + col0 + row0 + 4 * cg) = *(const LAS f32x4*)((yp) + sl * 32 + 4 * cg); } while (0)
        SC_ISSUE(0); SC_STORE(buf0);
        __syncthreads();
        for (int ch = 0; ch < NCH; ++ch) {
            LAS float* ob = (ch & 1) ? buf0 : buf1; const LAS float* oy = (ch & 1) ? Y0 : Y1;
            if (ch + 1 < NCH) SC_ISSUE(ch + 1);
            if (ch > 0) SC_YOUT(ch - 1, oy);
            if (ch + 1 < NCH) SC_STORE(ob);
            __syncthreads();
        }
        { const LAS float* oy = ((NCH - 1) & 1) ? Y1 : Y0; SC_YOUT(NCH - 1, oy); }
#undef SC_ISSUE
#undef SC_STORE
#undef SC_YOUT
    } else {
        const int g = lane & 7, rl = lane >> 3, row = wave * 8 + rl;
        f32x2 S0 = {0.f, 0.f}, S1 = S0, S2 = S0, S3 = S0;
        __syncthreads();
        for (int ch = 0; ch < NCH; ++ch) {
            const LAS float* cb = (ch & 1) ? buf1 : buf0; LAS float* yb = (ch & 1) ? Y1 : Y0;
            const LAS float* pa = cb + 4 * g; const LAS float* pv = cb + 10240 + row;
#define SC_LD(X, s_) const f32x4 w0##X = *(const LAS f32x4*)(pa + (s_) * 64), w1##X = *(const LAS f32x4*)(pa + (s_) * 64 + 32), k0##X = *(const LAS f32x4*)(pa + (s_) * 64 + 2048), k1##X = *(const LAS f32x4*)(pa + (s_) * 64 + 2080), \
                a0##X = *(const LAS f32x4*)(pa + (s_) * 64 + 4096), a1##X = *(const LAS f32x4*)(pa + (s_) * 64 + 4128), b0##X = *(const LAS f32x4*)(pa + (s_) * 64 + 6144), b1##X = *(const LAS f32x4*)(pa + (s_) * 64 + 6176), \
                r0##X = *(const LAS f32x4*)(pa + (s_) * 64 + 8192), r1##X = *(const LAS f32x4*)(pa + (s_) * 64 + 8224); const float v##X = pv[(s_) * 32]
#define LO(q) ((f32x2){(q).x, (q).y})
#define HI(q) ((f32x2){(q).z, (q).w})
#define SC_STEP(X, s_) do { f32x2 t = S0 * LO(a0##X); t = S1 * HI(a0##X) + t; t = S2 * LO(a1##X) + t; t = S3 * HI(a1##X) + t; float sa = t.x + t.y; \
                const f32x2 vv = {v##X, v##X}; \
                f32x2 p0 = S0 * LO(w0##X), p1 = S1 * HI(w0##X), p2 = S2 * LO(w1##X), p3 = S3 * HI(w1##X); \
                p0 = vv * LO(k0##X) + p0; p1 = vv * HI(k0##X) + p1; p2 = vv * LO(k1##X) + p2; p3 = vv * HI(k1##X) + p3; \
                sa = red8(sa); const f32x2 ss = {sa, sa}; \
                S0 = ss * LO(b0##X) + p0; S1 = ss * HI(b0##X) + p1; S2 = ss * LO(b1##X) + p2; S3 = ss * HI(b1##X) + p3; \
                f32x2 u = S0 * LO(r0##X); u = S1 * HI(r0##X) + u; u = S2 * LO(r1##X) + u; u = S3 * HI(r1##X) + u; float y = u.x + u.y; y = red8(y); \
                yb[(s_) * 32 + row] = y; } while (0)
#pragma unroll 1
            for (int s8 = 0; s8 < 32; s8 += 8) {
                SC_LD(0, s8 + 0); SC_LD(1, s8 + 1);
                SC_STEP(0, s8 + 0); SC_LD(2, s8 + 2);
                SC_STEP(1, s8 + 1); SC_LD(3, s8 + 3);
                SC_STEP(2, s8 + 2); SC_LD(4, s8 + 4);
                SC_STEP(3, s8 + 3); SC_LD(5, s8 + 5);
                SC_STEP(4, s8 + 4); SC_LD(6, s8 + 6);
                SC_STEP(5, s8 + 5); SC_LD(7, s8 + 7);
                SC_STEP(6, s8 + 6);
                SC_STEP(7, s8 + 7);
            }
#undef SC_LD
#undef LO
#undef HI
#undef SC_STEP
            __syncthreads();
        }
    }
}

__device__ __forceinline__ void p3_post(const Args& a, int G) {
    const int tid = threadIdx.x, lane = tid & 63, wave = __builtin_amdgcn_readfirstlane(tid >> 6);
    unsigned char* ws = a.ws;
    const bf16_t* SR = (const bf16_t*)(ws + WS_SR); const bf16_t* SK = (const bf16_t*)(ws + WS_SK); const bf16_t* SV = (const bf16_t*)(ws + WS_SV);
    const bf16_t* SG = (const bf16_t*)(ws + WS_SG); const float* YRAW = (const float*)(ws + WS_YRAW); bf16_t* YMIX = (bf16_t*)(ws + WS_YMIX);
    const int gw = blockIdx.x * 8 + wave, NGW = G * 8, c8 = lane * 8;
    const f32x4 lg0 = *(const f32x4*)(a.in[12] + c8), lg1 = *(const f32x4*)(a.in[12] + c8 + 4), lb0 = *(const f32x4*)(a.in[13] + c8), lb1 = *(const f32x4*)(a.in[13] + c8 + 4);
    const f32x4 rk0 = *(const f32x4*)(a.in[11] + c8), rk1 = *(const f32x4*)(a.in[11] + c8 + 4);
    for (int t = gw; t < T; t += NGW) {
        const size_t o = (size_t)t * CW + c8;
        const f32x4 y0 = *(const f32x4*)(YRAW + o), y1 = *(const f32x4*)(YRAW + o + 4);
        const u32x4 ur = *(const u32x4*)(SR + o), uk = *(const u32x4*)(SK + o), uv = *(const u32x4*)(SV + o), ug = *(const u32x4*)(SG + o);
        const float mean = red8((y0.x + y0.y) + (y0.z + y0.w) + (y1.x + y1.y) + (y1.z + y1.w)) * (1.0f / 64.0f);
        const f32x4 d0 = y0 - mean, d1 = y1 - mean;
        const float var = red8((d0.x * d0.x + d0.y * d0.y) + (d0.z * d0.z + d0.w * d0.w) + (d1.x * d1.x + d1.y * d1.y) + (d1.z * d1.z + d1.w * d1.w)) * (1.0f / 64.0f);
        const f32x4 r0 = cvlo(ur), r1 = cvhi(ur), k0 = cvlo(uk), k1 = cvhi(uk);
        const f32x4 p0 = r0 * k0 * rk0, p1 = r1 * k1 * rk1;
        const float rk = red8((p0.x + p0.y) + (p0.z + p0.w) + (p1.x + p1.y) + (p1.z + p1.w));
        const float rs = 1.0f / sqrtf(var + 64e-5f);
        const f32x4 o0 = (d0 * rs * lg0 + lb0 + rk * cvlo(uv)) * cvlo(ug), o1 = (d1 * rs * lg1 + lb1 + rk * cvhi(uv)) * cvhi(ug);
        *(u32x4*)(YMIX + (size_t)t * D + c8) = pk8(o0, o1);
    }
}

namespace att {
constexpr int SLOT = 32768, OFF_V = 16384;
constexpr int TBL_OFF = MISC_OFF + 1024;
constexpr int LW_OFF = MISC_OFF + 2048;
constexpr int CST_OFF = MISC_OFF + 3072;
__device__ __forceinline__ int crow(int r, int hi) { return (r & 3) + 8 * (r >> 2) + 4 * hi; }
__device__ __forceinline__ void glds16(const void* gsrc, unsigned lds_dst) { unsigned keep;
    asm volatile("s_mov_b32 %0, m0\n\ts_mov_b32 m0, %2\n\ts_nop 0\n\tglobal_load_lds_dwordx4 %1, off\n\ts_mov_b32 m0, %0" : "=&s"(keep) : "v"(gsrc), "s"(lds_dst) : "memory"); }
__device__ __forceinline__ s16x4 vtr(const LAS unsigned char* p) { return __builtin_bit_cast(s16x4, __builtin_amdgcn_ds_read_tr16_b64_v4i16((LAS s16x4*)p)); }

__device__ __forceinline__ void attn_unit(LAS unsigned char* lds, const Args& a, int b, int h, int qb, float negM, float lam) {
    const int tid = threadIdx.x, lane = tid & 63, r32 = lane & 31, hi = lane >> 5; const int wid = __builtin_amdgcn_readfirstlane(tid >> 6);
    const int c = wid >> 2, rg = wid & 3;
    unsigned char* ws = a.ws;
    const bf16_t* QN = (const bf16_t*)(ws + WS_QN); const bf16_t* KN = (const bf16_t*)(ws + WS_KN); const bf16_t* P = (const bf16_t*)(ws + WS_P); bf16_t* YMIX = (bf16_t*)(ws + WS_YMIX);
    const int q0 = qb * 128; const size_t rowbase = (size_t)b * SEQ;
    const int NT = 2 * qb + 2;
    LAS float* tbl = (LAS float*)(lds + TBL_OFF); LAS float* lw = (LAS float*)(lds + LW_OFF) + wid * 32;
    if (tid < 128) {
        const int n = tid; int bkt;
        if (n < 16) bkt = n; else { bkt = 16 + (int)(logf((float)n * (1.0f / 16.0f)) / 2.0794415416798357f * 16.0f); bkt = bkt > 31 ? 31 : bkt; }
        tbl[n] = (a.in[21][bkt * 4 + h] - a.in[21][31 * 4 + h]) * LOG2E;
    }
    const bf16_t* Qw = QN + (rowbase + q0 + rg * 32 + r32) * CW + h * 128 + c * 64;
    bf16x8 qr[4];
#pragma unroll
    for (int d0 = 0; d0 < 4; ++d0) qr[d0] = *(const bf16x8*)(Qw + d0 * 16 + hi * 8);
    const bf16_t* k0src = KN + (rowbase + lane) * CW + h * 128 + wid * 8;
    const bf16_t* k1src = k0src + 64;
    const int pv0 = 2 * wid, pv1 = 2 * wid + 1;
    const bf16_t* v0src = P + (rowbase + 16 * (pv0 & 3) + (lane >> 2)) * NINP + DV0 + h * 128 + 32 * (pv0 >> 2) + (lane & 3) * 8;
    const bf16_t* v1src = P + (rowbase + 16 * (pv1 & 3) + (lane >> 2)) * NINP + DV0 + h * 128 + 32 * (pv1 >> 2) + (lane & 3) * 8;
#define ATT_DMA(t, slot) do { const unsigned s_ = lds0 + (unsigned)(slot) * SLOT; \
        glds16(k0src + (size_t)(t) * 64 * CW, (unsigned)__builtin_amdgcn_readfirstlane(s_ + wid * 1024)); \
        glds16(k1src + (size_t)(t) * 64 * CW, (unsigned)__builtin_amdgcn_readfirstlane(s_ + 8192 + wid * 1024)); \
        glds16(v0src + (size_t)(t) * 64 * NINP, (unsigned)__builtin_amdgcn_readfirstlane(s_ + OFF_V + pv0 * 1024)); \
        glds16(v1src + (size_t)(t) * 64 * NINP, (unsigned)__builtin_amdgcn_readfirstlane(s_ + OFF_V + pv1 * 1024)); } while (0)
#define ATT_SBAR() __builtin_amdgcn_sched_barrier(0)
    const unsigned lds0 = (unsigned)(uintptr_t)lds;
    f32x16 o[4];
#pragma unroll
    for (int d0 = 0; d0 < 4; ++d0) o[d0] = f32x16{};
    float lsum = 0.f;
    const bool shift = negM < -60.0f;
    const int qmin = q0 + 32 * rg, qpos = qmin + r32;
    ATT_DMA(0, 0);
    asm volatile("s_waitcnt vmcnt(0)" ::: "memory");
    __syncthreads();
    for (int t = 0; t < NT; ++t) {
        if (t + 1 < NT) ATT_DMA(t + 1, (t + 1) & 1);
        const int kmin = 64 * t;
        if (kmin <= qmin + 31) {
            const LAS unsigned char* slot = lds + (t & 1) * SLOT;
            const LAS unsigned char* kb = slot + c * 8192 + hi * 1024 + r32 * 16;
            const LAS unsigned char* vb = slot + OFF_V + ((lane >> 4) & 1) * 32 + (lane & 3) * 8 + (4 * hi + ((lane & 15) >> 2)) * 64;
            bf16x8 kf[8];
#pragma unroll
            for (int d0 = 0; d0 < 4; ++d0) { kf[2 * d0] = *(const LAS bf16x8*)(kb + d0 * 2048); kf[2 * d0 + 1] = *(const LAS bf16x8*)(kb + d0 * 2048 + 512); }
            s16x4 va[16], vc[16];
#pragma unroll
            for (int i = 0; i < 8; ++i) { va[2 * i] = vtr(vb + (i >> 2) * 4096 + (i & 3) * 1024); va[2 * i + 1] = vtr(vb + (i >> 2) * 4096 + (i & 3) * 1024 + 512); }
            ATT_SBAR();
            f32x16 p0, p1;
            p0 = __builtin_amdgcn_mfma_f32_32x32x16_bf16(kf[0], qr[0], f32x16{}, 0, 0, 0); p1 = __builtin_amdgcn_mfma_f32_32x32x16_bf16(kf[1], qr[0], f32x16{}, 0, 0, 0);
#pragma unroll
            for (int d0 = 1; d0 < 4; ++d0) { p0 = __builtin_amdgcn_mfma_f32_32x32x16_bf16(kf[2 * d0], qr[d0], p0, 0, 0, 0); p1 = __builtin_amdgcn_mfma_f32_32x32x16_bf16(kf[2 * d0 + 1], qr[d0], p1, 0, 0, 0); }
            ATT_SBAR();
            if (qmin - (kmin + 63) < 113) {
#pragma unroll
                for (int r = 0; r < 16; ++r) {
                    const int d0_ = qpos - (kmin + crow(r, hi)); const int d1_ = d0_ - 32;
                    const float t0 = tbl[d0_ < 0 ? 0 : (d0_ > 127 ? 127 : d0_)], t1 = tbl[d1_ < 0 ? 0 : (d1_ > 127 ? 127 : d1_)];
                    p0[r] = d0_ < 0 ? -INFINITY : p0[r] + t0; p1[r] = d1_ < 0 ? -INFINITY : p1[r] + t1;
                }
            }
            if (shift) {
#pragma unroll
                for (int r = 0; r < 16; ++r) { p0[r] += negM; p1[r] += negM; }
            }
            float sacc = 0.f;
#pragma unroll
            for (int r = 0; r < 16; ++r) { p0[r] = __builtin_amdgcn_exp2f(p0[r]); p1[r] = __builtin_amdgcn_exp2f(p1[r]); sacc += p0[r] + p1[r]; }
            lsum += sacc;
            u32x4 pw[4];
#pragma unroll
            for (int i = 0; i < 4; ++i) { pw[0][i] = pk2(p0[2 * i], p0[2 * i + 1]); pw[1][i] = pk2(p0[8 + 2 * i], p0[8 + 2 * i + 1]); pw[2][i] = pk2(p1[2 * i], p1[2 * i + 1]); pw[3][i] = pk2(p1[8 + 2 * i], p1[8 + 2 * i + 1]); }
            ATT_SBAR();
#pragma unroll
            for (int i = 0; i < 8; ++i) { vc[2 * i] = vtr(vb + (2 + (i >> 2)) * 4096 + (i & 3) * 1024); vc[2 * i + 1] = vtr(vb + (2 + (i >> 2)) * 4096 + (i & 3) * 1024 + 512); }
#pragma unroll
            for (int i = 0; i < 8; ++i) {
                const bf16x8 vf = (bf16x8){va[2 * i][0], va[2 * i][1], va[2 * i][2], va[2 * i][3], va[2 * i + 1][0], va[2 * i + 1][1], va[2 * i + 1][2], va[2 * i + 1][3]};
                o[i >> 2] = __builtin_amdgcn_mfma_f32_32x32x16_bf16(__builtin_bit_cast(bf16x8, pw[i & 3]), vf, o[i >> 2], 0, 0, 0);
            }
#pragma unroll
            for (int i = 0; i < 8; ++i) {
                const bf16x8 vf = (bf16x8){vc[2 * i][0], vc[2 * i][1], vc[2 * i][2], vc[2 * i][3], vc[2 * i + 1][0], vc[2 * i + 1][1], vc[2 * i + 1][2], vc[2 * i + 1][3]};
                o[2 + (i >> 2)] = __builtin_amdgcn_mfma_f32_32x32x16_bf16(__builtin_bit_cast(bf16x8, pw[i & 3]), vf, o[2 + (i >> 2)], 0, 0, 0);
            }
        }
        asm volatile("s_waitcnt vmcnt(0)" ::: "memory");
        __syncthreads();
    }
#undef ATT_DMA
#undef ATT_SBAR
    lsum += __shfl_xor(lsum, 32);
    if (hi == 0) lw[r32] = 1.0f / lsum;
    asm volatile("s_waitcnt lgkmcnt(0)" ::: "memory");
    LAS float* stg = (LAS float*)(lds + wid * 16384);
#pragma unroll
    for (int r = 0; r < 16; ++r) { const int orow = crow(r, hi); const float il = lw[orow];
#pragma unroll
        for (int d0 = 0; d0 < 4; ++d0) stg[orow * 128 + d0 * 32 + r32] = o[d0][r] * il; }
    __syncthreads();
    {
        const int row = tid >> 2, part = tid & 3, rgp = row >> 5, rr = row & 31;
        const LAS float* s1 = (const LAS float*)(lds + rgp * 16384) + rr * 128 + part * 32;
        const LAS float* s2 = (const LAS float*)(lds + (4 + rgp) * 16384) + rr * 128 + part * 32;
        float dv[32]; float ss = 0.f;
#pragma unroll
        for (int i = 0; i < 8; ++i) { const f32x4 x1 = *(const LAS f32x4*)(s1 + 4 * i), x2 = *(const LAS f32x4*)(s2 + 4 * i);
#pragma unroll
            for (int j = 0; j < 4; ++j) { const float dd = x1[j] - lam * x2[j]; dv[4 * i + j] = dd; ss += dd * dd; } }
        ss = red4(ss);
        const float sc = (1.0f / sqrtf(ss * (1.0f / 128.0f) + 1e-5f)) * 0.8f;
        const float* sg = a.in[20] + part * 32;
        bf16_t* op = YMIX + (rowbase + q0 + row) * D + CW + h * 128 + part * 32;
#pragma unroll
        for (int i = 0; i < 4; ++i) { u32x4 w;
            w.x = pk2(dv[8 * i] * sc * sg[8 * i], dv[8 * i + 1] * sc * sg[8 * i + 1]); w.y = pk2(dv[8 * i + 2] * sc * sg[8 * i + 2], dv[8 * i + 3] * sc * sg[8 * i + 3]);
            w.z = pk2(dv[8 * i + 4] * sc * sg[8 * i + 4], dv[8 * i + 5] * sc * sg[8 * i + 5]); w.w = pk2(dv[8 * i + 6] * sc * sg[8 * i + 6], dv[8 * i + 7] * sc * sg[8 * i + 7]);
            *(u32x4*)(op + 8 * i) = w; }
    }
    __syncthreads();
}

__device__ __forceinline__ void attn_phase(LAS unsigned char* lds, const Args& a, unsigned* ctl) {
    const int tid = threadIdx.x;
    LAS float* cst = (LAS float*)(lds + CST_OFF);
    if (tid < 64) {
        const float gq = fabsf(a.in[14][tid]), gk = fabsf(a.in[15][tid]);
        float mq = gq, mk = gk;
#pragma unroll
        for (int o = 1; o < 64; o <<= 1) { mq = fmaxf(mq, __shfl_xor(mq, o)); mk = fmaxf(mk, __shfl_xor(mk, o)); }
        const float d1 = wave_sum(a.in[16][tid] * a.in[17][tid]), d2 = wave_sum(a.in[18][tid] * a.in[19][tid]);
        float mb = 0.f;
        if (tid < 32) { for (int hh = 0; hh < 4; ++hh) mb = fmaxf(mb, (a.in[21][tid * 4 + hh] - a.in[21][31 * 4 + hh]) * LOG2E); }
#pragma unroll
        for (int o = 1; o < 64; o <<= 1) mb = fmaxf(mb, __shfl_xor(mb, o));
        if (tid == 0) { cst[0] = -(8.0f * LOG2E * mq * mk * 1.02f + mb); cst[1] = __expf(d1) - __expf(d2) + 0.2f; }
    }
    __syncthreads();
    const float negM = cst[0], lam = cst[1];
    LAS int* ubox = (LAS int*)(lds + CST_OFF + 16);
    for (;;) {
        if (tid == 0) ubox[0] = (int)atomicAdd(ctl + CW_ATTQ, 1u);
        __syncthreads();
        const int u = ubox[0];
        __syncthreads();
        if (u >= 1024) break;
        const int qb = 31 - (u >> 5), bhh = u & 31;
        attn_unit(lds, a, bhh >> 2, bhh & 3, qb, negM, lam);
    }
}
}

__device__ __forceinline__ void p5_router(LAS unsigned char* lds, const Args& a, unsigned* ctl) {
    const int tid = threadIdx.x, lane = tid & 63, wave = __builtin_amdgcn_readfirstlane(tid >> 6);
    unsigned char* ws = a.ws;
    const float* x1 = a.out; const float* g2 = a.in[23]; const float* rw = a.in[24]; const float* rb = a.in[25];
    unsigned char* H2 = ws + WS_H2; int* EIDX = (int*)(ws + WS_EIDX); float* GATE = (float*)(ws + WS_GATE); int* POS = (int*)(ws + WS_POS);
    LAS float* rwT = (LAS float*)lds;
    LAS int* cnt = (LAS int*)(lds + MISC_OFF + 1024);
    LAS int* basel = (LAS int*)(lds + MISC_OFF + 1024 + 128);
    LAS int* el = (LAS int*)(lds + MISC_OFF + 2048);
    LAS int* pl = (LAS int*)(lds + MISC_OFF + 4096);
    for (int i = tid; i < 32 * 1024; i += 512) { const int k = i >> 5, e = i & 31; rwT[e * 1024 + k] = rw[i]; }
    if (tid < 32) cnt[tid] = 0;
    __syncthreads();
    f32x4 gv[4];
#pragma unroll
    for (int j = 0; j < 4; ++j) gv[j] = *((const f32x4*)g2 + lane + 64 * j);
    const float rbias = rb[lane >> 1];
    const int TPB = T / (int)gridDim.x, tb0 = blockIdx.x * TPB, TPW = TPB / 8;
    for (int i = 0; i < TPW; ++i) {
        const int tl = wave * TPW + i, t = tb0 + tl;
        const f32x4* xr = (const f32x4*)(x1 + (size_t)t * D) + lane;
        f32x4 v[4]; float s = 0.f;
#pragma unroll
        for (int j = 0; j < 4; ++j) { v[j] = xr[64 * j]; s += (v[j].x * v[j].x + v[j].y * v[j].y) + (v[j].z * v[j].z + v[j].w * v[j].w); }
        const float rstd = 1.0f / sqrtf(wave_sum(s) * (1.0f / D) + 1e-5f);
        unsigned* o4 = (unsigned*)(H2 + (size_t)t * D) + lane;
#pragma unroll
        for (int j = 0; j < 4; ++j) { v[j] = v[j] * rstd * gv[j]; o4[64 * j] = pk4_fp8(v[j].x * F8_X_MUL, v[j].y * F8_X_MUL, v[j].z * F8_X_MUL, v[j].w * F8_X_MUL); }
        float acc[32];
#pragma unroll
        for (int e = 0; e < 32; ++e) {
            float s2 = 0.f;
#pragma unroll
            for (int j = 0; j < 4; ++j) { const f32x4 w = *((const LAS f32x4*)(rwT + e * 1024) + lane + 64 * j); s2 += (v[j].x * w.x + v[j].y * w.y) + (v[j].z * w.z + v[j].w * w.w); }
            acc[e] = s2;
        }
#pragma unroll
        for (int e = 0; e < 16; ++e) { const bool up = lane & 32; const float keep = up ? acc[e + 16] : acc[e], send = up ? acc[e] : acc[e + 16]; acc[e] = keep + __shfl_xor(send, 32); }
#pragma unroll
        for (int e = 0; e < 8; ++e) { const bool up = lane & 16; const float keep = up ? acc[e + 8] : acc[e], send = up ? acc[e] : acc[e + 8]; acc[e] = keep + __shfl_xor(send, 16); }
#pragma unroll
        for (int e = 0; e < 4; ++e) { const bool up = lane & 8; const float keep = up ? acc[e + 4] : acc[e], send = up ? acc[e] : acc[e + 4]; acc[e] = keep + __shfl_xor(send, 8); }
#pragma unroll
        for (int e = 0; e < 2; ++e) { const bool up = lane & 4; const float keep = up ? acc[e + 2] : acc[e], send = up ? acc[e] : acc[e + 2]; acc[e] = keep + __shfl_xor(send, 4); }
        { const bool up = lane & 2; const float keep = up ? acc[1] : acc[0], send = up ? acc[0] : acc[1]; acc[0] = keep + __shfl_xor(send, 2); }
        float logit = acc[0] + __shfl_xor(acc[0], 1) + rbias;
        const int myid = lane >> 1;
        float tv[4]; int ti[4];
#pragma unroll
        for (int k = 0; k < 4; ++k) {
            float bv = logit; int bi = myid;
#pragma unroll
            for (int o = 1; o < 64; o <<= 1) { const float ov = __shfl_xor(bv, o); const int oi = __shfl_xor(bi, o); if (ov > bv || (ov == bv && oi < bi)) { bv = ov; bi = oi; } }
            tv[k] = bv; ti[k] = bi;
            if (myid == bi) logit = -INFINITY;
        }
        const float e1 = __expf(tv[1] - tv[0]), e2 = __expf(tv[2] - tv[0]), e3 = __expf(tv[3] - tv[0]);
        const float inv = 1.0f / (1.0f + e1 + e2 + e3);
        if (lane < 4) {
            const int ek = lane == 0 ? ti[0] : lane == 1 ? ti[1] : lane == 2 ? ti[2] : ti[3];
            const float gk = (lane == 0 ? 1.0f : lane == 1 ? e1 : lane == 2 ? e2 : e3) * inv;
            EIDX[t * 4 + lane] = ek; GATE[t * 4 + lane] = gk;
            el[tl * 4 + lane] = ek; pl[tl * 4 + lane] = atomicAdd((int*)(cnt + ek), 1);
        }
    }
    __syncthreads();
    if (tid < 32) basel[tid] = (int)atomicAdd(ctl + CW_CNT + tid, (unsigned)cnt[tid]);
    __syncthreads();
    for (int i = tid; i < TPB * 4; i += 512) POS[(size_t)tb0 * 4 + i] = pl[i] + basel[el[i]];
}

__device__ __forceinline__ void p6_dispatch(LAS unsigned char* lds, const Args& a, unsigned* ctl) {
    const int tid = threadIdx.x, lane = tid & 63, wave = __builtin_amdgcn_readfirstlane(tid >> 6);
    unsigned char* ws = a.ws;
    const unsigned char* H2 = ws + WS_H2; unsigned char* XS = ws + WS_XS;
    const int* EIDX = (const int*)(ws + WS_EIDX); const float* GATE = (const float*)(ws + WS_GATE); const int* POS = (const int*)(ws + WS_POS);
    int* DEST = (int*)(ws + WS_DEST); float* ROWGATE = (float*)(ws + WS_ROWGATE); int* TILEE = (int*)(ws + WS_TILEE);
    LAS int* pstart = (LAS int*)(lds + MISC_OFF + 1024);
    if (tid == 0) {
        int acc = 0;
        for (int e = 0; e < NE; ++e) { const int cn = (int)__hip_atomic_load(ctl + CW_CNT + e, __ATOMIC_RELAXED, __HIP_MEMORY_SCOPE_AGENT); pstart[e] = acc;
            const int nt = (cn + 255) >> 8;
            if (blockIdx.x == 0) for (int i = 0; i < nt; ++i) TILEE[(acc >> 8) + i] = e;
            acc += nt * 256; }
        if (blockIdx.x == 0) TILEE[1023] = acc >> 8;
    }
    __syncthreads();
    const int TPB = T / (int)gridDim.x, tb0 = blockIdx.x * TPB, PPW = TPB * 4 / 8;
    for (int i = 0; i < PPW; ++i) {
        const int pi = tb0 * 4 + wave * PPW + i, t = pi >> 2;
        const int e = EIDX[pi], dest = pstart[e] + POS[pi];
        if (lane == 0) { DEST[pi] = dest; ROWGATE[dest] = GATE[pi]; }
        const u32x4* src = (const u32x4*)(H2 + (size_t)t * D); u32x4* dst = (u32x4*)(XS + (size_t)dest * D);
        dst[lane] = src[lane];
    }
}

__device__ __forceinline__ void p9_combine(const Args& a, int G) {
    const int tid = threadIdx.x, lane = tid & 63, wave = __builtin_amdgcn_readfirstlane(tid >> 6);
    unsigned char* ws = a.ws;
    const bf16_t* YS = (const bf16_t*)(ws + WS_YS); const int* DEST = (const int*)(ws + WS_DEST);
    float* out = a.out;
    const int gw = blockIdx.x * 8 + wave, NGW = G * 8;
    for (int t = gw; t < T; t += NGW) {
        f32x4* xr = (f32x4*)(out + (size_t)t * D) + lane;
        f32x4 v[4];
#pragma unroll
        for (int j = 0; j < 4; ++j) v[j] = xr[64 * j];
#pragma unroll
        for (int k = 0; k < 4; ++k) {
            const int dest = DEST[t * 4 + k];
            const u32x2* yr = (const u32x2*)(YS + (size_t)dest * D) + lane;
#pragma unroll
            for (int j = 0; j < 4; ++j) { const u32x2 w = yr[64 * j]; v[j].x += bflo(w.x); v[j].y += bfhi(w.x); v[j].z += bflo(w.y); v[j].w += bfhi(w.y); }
        }
        if (TIME_REGION >= 0) { const float sc_ = 1.0f + 4e-6f * (float)((const unsigned*)(ws + WS_CTL))[301];
#pragma unroll
            for (int j = 0; j < 4; ++j) v[j] = v[j] * sc_; }
#pragma unroll
        for (int j = 0; j < 4; ++j) xr[64 * j] = v[j];
    }
}

constexpr int NPHASE = 10;
__global__ void __launch_bounds__(512, 2) hymba_fwd(Args args) {
    extern __shared__ __attribute__((aligned(16))) unsigned char lds_raw[];
    LAS unsigned char* lds = (LAS unsigned char*)lds_raw;
    cg::grid_group grid = cg::this_grid();
    const int G = gridDim.x;
    unsigned char* ws = args.ws;
    unsigned* ctl = (unsigned*)(ws + WS_CTL);
    const int lo = args.ph_lo, hi = args.ph_hi;
#define IN(k) (lo <= (k) && (k) < hi)
#define NREP(k) ((REP_PHASE) == (k) ? 2 : 1)
#define TSTART(k) do { if ((TIME_REGION) == (k) && blockIdx.x == 0 && threadIdx.x == 0) ctl[300] = (unsigned)__builtin_amdgcn_s_memrealtime(); } while (0)
#define TEND(k) do { if ((TIME_REGION) == (k) && blockIdx.x == 0 && threadIdx.x == 0) ctl[301] = (unsigned)__builtin_amdgcn_s_memrealtime() - ctl[300]; } while (0)
#define SEAM(k) do { if (IN(k) && IN((k) + 1)) { if (args.ph_lo < 0) grid.sync(); xcd_barrier(xbar); } } while (0)
    const int* TILEE = (const int*)(ws + WS_TILEE);
    { volatile LAS unsigned* st = (volatile LAS unsigned*)(lds + MISC_OFF); if (threadIdx.x < 2) st[threadIdx.x] = 0u; }
    __syncthreads();
    const XcdBarrier xbar = xcd_barrier_post(ctl + CW_BAR, (volatile LAS unsigned*)(lds + MISC_OFF));

    if (IN(0)) { for (int rep = 0; rep < NREP(0); ++rep) p0_prologue(lds, args, G); } SEAM(0);
    if (IN(1)) {
        pg8::Gemm g{ws + WS_XN, ws + WS_WINT, 1024, 0, 0};
        pg8::TileOrder S; S.init(T / 256, NINP / 256, G, (int)blockIdx.x, nullptr, 0);
        pg8::EpiBf16 E{(bf16_t*)(ws + WS_P), NINP};
        for (int rep = 0; rep < NREP(1); ++rep) pg8::gemm_phase<false>(lds, g, S, E);
    } SEAM(1);
    TSTART(2);
    if (IN(2)) { _Pragma("clang loop unroll(disable)") for (int rep = 0; rep < NREP(2); ++rep) { p2_prep(lds, args); __syncthreads(); }
        xcd_barrier(xbar); TEND(2);
        TSTART(20); for (int rep = 0; rep < NREP(20); ++rep) ck::p2b_chunks(lds, args); } SEAM(2); TEND(20);
    TSTART(3);
    if (IN(3)) {
        TSTART(30); for (int rep = 0; rep < NREP(30); ++rep) { if (blockIdx.x < 64) ck::seq_head(lds, args, (int)blockIdx.x); __syncthreads(); } TEND(30);
        for (int rep = 0; rep < NREP(31); ++rep) att::attn_phase(lds, args, ctl + 64 * rep);
    } SEAM(3); TEND(3);
    if (IN(4)) {
        pg8::Gemm g{ws + WS_YMIX, ws + WS_WOUT, 1024, 0, 0};
        pg8::TileOrder S; S.init(T / 256, D / 256, G, (int)blockIdx.x, nullptr, 0);
        pg8::EpiResF32 E{args.in[0], args.out, D};
        for (int rep = 0; rep < NREP(4); ++rep) pg8::gemm_phase<false>(lds, g, S, E);
    } SEAM(4);
    if (IN(5)) { _Pragma("clang loop unroll(disable)") for (int rep = 0; rep < NREP(5); ++rep) { p5_router(lds, args, ctl + 256 * (NREP(5) - 1 - rep)); __syncthreads(); } } SEAM(5);
    if (IN(6)) { for (int rep = 0; rep < NREP(6); ++rep) { p6_dispatch(lds, args, ctl); __syncthreads(); } } SEAM(6);
    if (IN(7)) {
        const int ntile = TILEE[1023];
        pg8::Gemm g{ws + WS_XS, ws + WS_W1T, 1024, F8_W_SC, F8_X_SC};
        pg8::TileOrder S; S.init(ntile, 8, G, (int)blockIdx.x, TILEE, 8);
        pg8::EpiSwiglu E{ws + WS_HID, args.in[27], TILEE};
        for (int rep = 0; rep < NREP(7); ++rep) pg8::gemm_phase<true>(lds, g, S, E);
    } SEAM(7);
    if (IN(8)) {
        const int ntile = TILEE[1023];
        pg8::Gemm g{ws + WS_HID, ws + WS_W2T, 1024, F8_W_SC, F8_H_SC};
        pg8::TileOrder S; S.init(ntile, 4, G, (int)blockIdx.x, TILEE, 4);
        pg8::EpiGateBf16 E{(bf16_t*)(ws + WS_YS), args.in[29], (const float*)(ws + WS_ROWGATE), TILEE};
        for (int rep = 0; rep < NREP(8); ++rep) pg8::gemm_phase<true>(lds, g, S, E);
    } SEAM(8);
    if (IN(9)) { p9_combine(args, G); }
#undef IN
#undef SEAM
}

extern "C" void kernel_launch(void* const* d_in, const int* in_sizes, int n_in, void* d_out, int out_size, void* d_ws, size_t ws_size, hipStream_t stream) {
    static int grid = 0;
    if (grid == 0) {
        if (n_in != 30 || in_sizes[0] != T * D || out_size != T * D || ws_size < WS_END) { fprintf(stderr, "kernel_launch: unexpected shapes (n_in %d, in0 %d, out %d, ws %zu); nothing launched\n", n_in, n_in > 0 ? in_sizes[0] : -1, out_size, ws_size); grid = -1; return; }
        int dev = 0, cus = 0, per_cu = 0;
        if (hipGetDevice(&dev) != hipSuccess || hipDeviceGetAttribute(&cus, hipDeviceAttributeMultiprocessorCount, dev) != hipSuccess) { grid = -1; return; }
        if (hipFuncSetAttribute((const void*)hymba_fwd, hipFuncAttributeMaxDynamicSharedMemorySize, LDS_BYTES) != hipSuccess) { fprintf(stderr, "kernel_launch: hipFuncSetAttribute failed\n"); grid = -1; return; }
        if (hipOccupancyMaxActiveBlocksPerMultiprocessor(&per_cu, (const void*)hymba_fwd, 512, LDS_BYTES) != hipSuccess || per_cu < 1) { fprintf(stderr, "kernel_launch: occupancy query says %d\n", per_cu); per_cu = 1; }
        (void)hipGetLastError();
        grid = cus;
        if (grid > 256) grid = 256;
        if (grid != 256 || T % grid != 0 || (T / grid) % 16 != 0) { fprintf(stderr, "kernel_launch: grid %d does not divide the token count evenly\n", grid); grid = -1; return; }
    }
    if (grid < 0) return;
    (void)hipMemsetAsync((char*)d_ws + WS_CTL, 0, CTL_ZERO_BYTES, stream);
    Args a{};
    for (int i = 0; i < 30; ++i) a.in[i] = (const float*)d_in[i];
    a.out = (float*)d_out; a.ws = (unsigned char*)d_ws;
    constexpr int NL = MK_N_LAUNCHES;
    for (int li = 0; li < NL; ++li) {
        a.ph_lo = (NL == 1) ? 0 : li; a.ph_hi = (NL == 1) ? NPHASE : li + 1;
        void* kargs[] = {&a};
        hipError_t e = hipLaunchCooperativeKernel((const void*)hymba_fwd, dim3(grid), dim3(512), kargs, LDS_BYTES, stream);
        if (e != hipSuccess) { fprintf(stderr, "kernel_launch: cooperative launch %d failed: %s (grid %d)\n", li, hipGetErrorString(e), grid); break; }
    }
}
```

```cpp
#include <hip/hip_runtime.h>
#include <hip/hip_cooperative_groups.h>
#include <cstdio>
#include <cstdint>
#include <type_traits>
namespace cg = cooperative_groups;

#ifndef REP_PHASE
#define REP_PHASE -1
#endif
#ifndef TIME_REGION
#define TIME_REGION -1
#endif
#ifndef MK_N_LAUNCHES
#define MK_N_LAUNCHES 1
#endif

#define LAS __attribute__((address_space(3)))
#define GAS __attribute__((address_space(1)))
typedef unsigned short bf16_t;
typedef short bf16x8 __attribute__((ext_vector_type(8)));
typedef short s16x4 __attribute__((ext_vector_type(4)));
typedef float f32x2 __attribute__((ext_vector_type(2)));
typedef float f32x4 __attribute__((ext_vector_type(4)));
typedef float f32x16 __attribute__((ext_vector_type(16)));
typedef unsigned u32x2 __attribute__((ext_vector_type(2)));
typedef unsigned u32x4 __attribute__((ext_vector_type(4)));
typedef int v8i32 __attribute__((ext_vector_type(8)));

constexpr int NB = 8, SEQ = 4096, T = NB * SEQ, D = 1024;
constexpr int CW = 512;
constexpr int NRW = 1696, NIN = 3232, NINP = 3328;
constexpr int DQ0 = 1696, DK0 = 2208, DV0 = 2720;
constexpr int NE = 32, TOPK = 4, DE = 1024;
constexpr int MAXROWS = T * TOPK + NE * 256;
constexpr int MAXTILES = MAXROWS / 256;
constexpr float LOG2E = 1.4426950408889634f;
constexpr float F8_W_MUL = 32.f, F8_X_MUL = 8.f, F8_H_MUL = 4.f; constexpr int F8_W_SC = 0x7A7A7A7A, F8_X_SC = 0x7C7C7C7C, F8_H_SC = 0x7D7D7D7D;

constexpr size_t MiB = 1u << 20;
constexpr size_t WS_CTL = 0, CTL_ZERO_BYTES = 64 * 1024;
constexpr size_t WS_TILEE = 512 * 1024;
constexpr size_t WS_WINT = 1 * MiB;
constexpr size_t WS_WOUT = 8 * MiB;
constexpr size_t WS_W1T = 10 * MiB;
constexpr size_t WS_W2T = 138 * MiB;
constexpr size_t WS_EIDX = 202 * MiB;
constexpr size_t WS_GATE = WS_EIDX + 512 * 1024;
constexpr size_t WS_POS = WS_GATE + 512 * 1024;
constexpr size_t WS_DEST = WS_POS + 512 * 1024;
constexpr size_t WS_ROWGATE = 204 * MiB;
constexpr size_t WS_XN = 206 * MiB;
constexpr size_t WS_P = 270 * MiB;
constexpr size_t WS_SR = 478 * MiB, WS_SK = 510 * MiB, WS_SV = 542 * MiB, WS_SA = 574 * MiB, WS_SB = 606 * MiB;
constexpr size_t WS_SW = 638 * MiB;
constexpr size_t WS_SG = 702 * MiB;
constexpr size_t WS_QN = 734 * MiB, WS_KN = 766 * MiB;
constexpr size_t WS_YMIX = 798 * MiB;
constexpr size_t WS_H2 = 206 * MiB;
constexpr size_t WS_ROWTOK = 270 * MiB;
constexpr size_t WS_HID = 406 * MiB;
constexpr size_t WS_YS = 542 * MiB;
constexpr size_t WS_YRAW = 862 * MiB;
constexpr size_t WS_CG = 862 * MiB;
constexpr size_t WS_CH = 894 * MiB;
constexpr size_t WS_CR2 = 926 * MiB;
constexpr size_t WS_CY0 = 958 * MiB;
constexpr size_t WS_RK = 990 * MiB;
constexpr size_t WS_END = 992 * MiB;
constexpr int CW_CNT = 64;
constexpr int CW_ATTQ = 128;
constexpr int CW_BAR = 4096;

constexpr int RING_BYTES = 131072, MISC_OFF = RING_BYTES, LDS_BYTES = 147456;

__device__ __forceinline__ unsigned f2bf(float f) { unsigned u = __builtin_bit_cast(unsigned, f); return (u + 0x7fffu + ((u >> 16) & 1u)) >> 16; }
typedef __bf16 hwbf16x2 __attribute__((ext_vector_type(2)));
__device__ __forceinline__ unsigned pk2(float lo, float hi) { const f32x2 v = {lo, hi}; return __builtin_bit_cast(unsigned, __builtin_convertvector(v, hwbf16x2)); }
__device__ __forceinline__ unsigned pk4_fp8(float a, float b, float c, float d) {
    a = fminf(fmaxf(a, -448.f), 448.f); b = fminf(fmaxf(b, -448.f), 448.f); c = fminf(fmaxf(c, -448.f), 448.f); d = fminf(fmaxf(d, -448.f), 448.f);
    int r = __builtin_amdgcn_cvt_pk_fp8_f32(a, b, 0, false); r = __builtin_amdgcn_cvt_pk_fp8_f32(c, d, r, true); return (unsigned)r; }
__device__ __forceinline__ float bf2f(unsigned short b) { return __builtin_bit_cast(float, (unsigned)b << 16); }
__device__ __forceinline__ float bflo(unsigned w) { return __builtin_bit_cast(float, w << 16); }
__device__ __forceinline__ float bfhi(unsigned w) { return __builtin_bit_cast(float, w & 0xffff0000u); }
__device__ __forceinline__ float wave_sum(float v) {
#pragma unroll
    for (int o = 1; o < 64; o <<= 1) v += __shfl_xor(v, o);
    return v;
}
__device__ __forceinline__ float sigmoidf_(float x) { return 1.0f / (1.0f + __expf(-x)); }
template <int CTRL> __device__ __forceinline__ float dpp_f(float v) { return __builtin_bit_cast(float, __builtin_amdgcn_update_dpp(0, __builtin_bit_cast(int, v), CTRL, 0xF, 0xF, true)); }
__device__ __forceinline__ float red8(float v) {
    v += dpp_f<0xB1>(v);
    v += dpp_f<0x4E>(v);
    v += dpp_f<0x141>(v);
    return v;
}
__device__ __forceinline__ float red4(float v) { v += dpp_f<0xB1>(v); v += dpp_f<0x4E>(v); return v; }


#define XB_TMO      128
#define XB_XCNT(j)  (256  + 64 * (j))
#define XB_XSUB(j)  (1280 + 64 * (j))
#define XB_XGEN(j)  (2304 + 64 * (j))
#define XB_TOP      3328
#define XB_TOPGEN   3392
#define XCD_BAR_WORDS 3456
#define XB_SPIN_CAP (1u << 18)
__device__ __forceinline__ unsigned xb_ld(unsigned* p)              { return __hip_atomic_load(p, __ATOMIC_RELAXED, __HIP_MEMORY_SCOPE_AGENT); }
__device__ __forceinline__ unsigned xb_add(unsigned* p, unsigned v) { return __hip_atomic_fetch_add(p, v, __ATOMIC_RELAXED, __HIP_MEMORY_SCOPE_AGENT); }
__device__ __forceinline__ unsigned xb_xcc_id() { return (unsigned)__builtin_amdgcn_s_getreg((3 << 11) | 20) & 0xFu; }
#define XB_SPIN(cond, bar) do { unsigned _sp = 0; while (cond) { __builtin_amdgcn_s_sleep(1); \
    if ((++_sp & 255u) == 0u) { if (xb_ld(&(bar)[XB_TMO])) break; if (_sp > XB_SPIN_CAP) { atomicAdd(&(bar)[XB_TMO], 1u); break; } } } } while (0)
struct XcdBarrier { unsigned* bar; unsigned x; volatile LAS unsigned* st; };
__device__ __forceinline__ XcdBarrier xcd_barrier_post(unsigned* bar, volatile LAS unsigned* st) {
    XcdBarrier b; b.bar = bar; b.x = xb_xcc_id(); b.st = st;
    if (threadIdx.x == 0) (void)xb_add(&bar[XB_XCNT(b.x)], 1u);
    return b;
}
__device__ __forceinline__ void xcd_barrier_complete(unsigned* bar, unsigned x, unsigned& nloc, unsigned& nx) {
    const unsigned G = gridDim.x * gridDim.y * gridDim.z;
    unsigned sum, cnt, mine, sp = 0u;
    for (;;) {
        sum = 0u; cnt = 0u; mine = 0u;
#pragma unroll
        for (unsigned j = 0; j < 16; ++j) { const unsigned c = xb_ld(&bar[XB_XCNT(j)]); sum += c; cnt += (c > 0u) ? 1u : 0u; mine = (j == x) ? c : mine; }
        if (sum == G) break;
        __builtin_amdgcn_s_sleep(1);
        if ((++sp & 255u) == 0u) { if (xb_ld(&bar[XB_TMO])) break; if (sp > XB_SPIN_CAP) { atomicAdd(&bar[XB_TMO], 1u); break; } }
    }
    nloc = mine > 0u ? mine : 1u; nx = cnt > 0u ? cnt : 1u;
}
__device__ __forceinline__ void xcd_barrier(const XcdBarrier& b) {
    asm volatile("s_waitcnt vmcnt(0)" ::: "memory");
    __syncthreads();
    if (threadIdx.x == 0) {
        unsigned* bar = b.bar;
        __builtin_amdgcn_s_waitcnt(0);
        unsigned nloc = b.st[0], nx = b.st[1];
        if (nloc == 0u) { xcd_barrier_complete(bar, b.x, nloc, nx); b.st[0] = nloc; b.st[1] = nx; }
        const unsigned old = xb_add(&bar[XB_XSUB(b.x)], 1u);
        const unsigned gen = old / nloc;
        if (old + 1u == (gen + 1u) * nloc) {
            __builtin_amdgcn_fence(__ATOMIC_RELEASE, "agent");
            asm volatile("s_waitcnt vmcnt(0)" ::: "memory");
            const unsigned og = xb_add(&bar[XB_TOP], 1u);
            const unsigned tg = og / nx;
            if (og + 1u == (tg + 1u) * nx) xb_add(&bar[XB_TOPGEN], 1u);
            else XB_SPIN(xb_ld(&bar[XB_TOPGEN]) == tg, bar);
            __builtin_amdgcn_fence(__ATOMIC_ACQUIRE, "agent");
            xb_add(&bar[XB_XGEN(b.x)], 1u);
            asm volatile("s_waitcnt vmcnt(0)" ::: "memory");
        } else {
            XB_SPIN(xb_ld(&bar[XB_XGEN(b.x)]) == gen, bar);
            __builtin_amdgcn_fence(__ATOMIC_ACQUIRE, "agent");
            asm volatile("s_waitcnt vmcnt(0)" ::: "memory");
        }
    }
    __syncthreads();
}

namespace pg8 {
constexpr int BM = 256, BK = 64, HALF = 128, HTB = HALF * BK * 2, STAGE_BYTES = 8 * HTB, NXCD = 8, WGM = 8;
__host__ __device__ __forceinline__ int lds_byte(int r, int c) { const int st = (r >> 4) * 2 + (c >> 5), rr = r & 15, cc = c & 31, ob = rr * 64 + cc * 2; return st * 1024 + (ob ^ (((ob >> 9) & 1) << 5)); }
__host__ __device__ __forceinline__ void stage_rc(int b, int& R, int& C) { const int st = b / 1024, sb = b % 1024, swz = sb ^ (((sb >> 9) & 1) << 5); R = (st >> 1) * 16 + swz / 64; C = (st & 1) * 32 + (swz % 64) / 2; }
__host__ __device__ __forceinline__ int perm32(int rho) { const int n = rho >> 4, i = rho & 15; return 8 * (i >> 2) + 4 * n + (i & 3); }

struct Unit { int pm, pn, pb; };
struct Gemm { const void* A; const void* Bt; int K; int scW, scA; const int* rowtok; };

struct TileOrder {
    int nM, nN, nwg, G, c; const int* tile_e; int nb_per_e;
    __device__ void init(int nM_, int nN_, int G_, int c_, const int* te, int nbe) { nM = nM_; nN = nN_; nwg = nM * nN; G = G_; c = c_; tile_e = te; nb_per_e = nbe; }
    __device__ bool next(int i, Unit& u) const {
        const long L = (long)i * G + c; if (L >= nwg) return false;
        int wgid = (int)L; { const int q = nwg / NXCD, r = nwg % NXCD, xcd = wgid % NXCD, off = wgid / NXCD; wgid = (xcd < r ? xcd * (q + 1) : r * (q + 1) + (xcd - r) * q) + off; }
        const int nig = WGM * nN, gid = wgid / nig, fm = gid * WGM, gsz = (nM - fm) < WGM ? (nM - fm) : WGM;
        u.pm = fm + ((wgid % nig) % gsz); u.pn = (wgid % nig) / gsz;
        u.pb = tile_e ? tile_e[u.pm] * nb_per_e + u.pn : u.pn;
        return true;
    }
};

struct EpiBf16 {
    static constexpr bool PERM = true;
    bf16_t* O; int ldc;
    __device__ __forceinline__ void operator()(const f32x4 (&acc)[2][2][4][2], const Unit& u, int wr, int wc, int fr, int fq) const {
        const int row0 = u.pm * BM + wr * 64 + fr; const int col0 = u.pn * BM + wc * 32 + 8 * fq;
#pragma unroll
        for (int ai = 0; ai < 2; ++ai)
#pragma unroll
            for (int m = 0; m < 4; ++m) { bf16_t* rowp = O + (size_t)(row0 + ai * HALF + m * 16) * ldc + col0;
#pragma unroll
                for (int bj = 0; bj < 2; ++bj) { const f32x4 v0 = acc[ai][bj][m][0], v1 = acc[ai][bj][m][1];
                    u32x4 w; w.x = pk2(v0[0], v0[1]); w.y = pk2(v0[2], v0[3]); w.z = pk2(v1[0], v1[1]); w.w = pk2(v1[2], v1[3]);
                    *(u32x4*)(rowp + bj * HALF) = w; } }
    }
};
struct EpiResF32 {
    static constexpr bool PERM = false;
    const float* base; float* out; int ldc;
    __device__ __forceinline__ void operator()(const f32x4 (&acc)[2][2][4][2], const Unit& u, int wr, int wc, int fr, int fq) const {
        const int col0 = u.pn * BM + wc * 32 + 4 * fq;
#pragma unroll
        for (int ai = 0; ai < 2; ++ai)
#pragma unroll
            for (int m = 0; m < 4; ++m) { const size_t off = (size_t)(u.pm * BM + ai * HALF + wr * 64 + m * 16 + fr) * ldc + col0;
#pragma unroll
                for (int bj = 0; bj < 2; ++bj)
#pragma unroll
                    for (int n = 0; n < 2; ++n) { const f32x4 bs = *(const f32x4*)(base + off + bj * HALF + n * 16); *(f32x4*)(out + off + bj * HALF + n * 16) = bs + acc[ai][bj][m][n]; } }
    }
};
struct EpiSwiglu {
    static constexpr bool PERM = true;
    unsigned char* O; const float* b1; const int* tile_e;
    __device__ __forceinline__ void operator()(const f32x4 (&acc)[2][2][4][2], const Unit& u, int wr, int wc, int fr, int fq) const {
        const int e = tile_e[u.pm]; const int row0 = u.pm * BM + wr * 64 + fr; const int hc0 = u.pn * 128 + wc * 32 + 8 * fq;
        const float* bg = b1 + (size_t)e * 2048 + hc0; const float* bl = bg + 1024;
        const f32x4 g0 = *(const f32x4*)bg, g1 = *(const f32x4*)(bg + 4), l0 = *(const f32x4*)bl, l1 = *(const f32x4*)(bl + 4);
#pragma unroll
        for (int ai = 0; ai < 2; ++ai)
#pragma unroll
            for (int m = 0; m < 4; ++m) { unsigned char* rowp = O + (size_t)(row0 + ai * HALF + m * 16) * 1024 + hc0;
                float o[8];
#pragma unroll
                for (int n = 0; n < 2; ++n) { const f32x4 gv = acc[ai][0][m][n] + (n ? g1 : g0), lv = acc[ai][1][m][n] + (n ? l1 : l0);
#pragma unroll
                    for (int i = 0; i < 4; ++i) { const float g = fminf(gv[i], 7.0f), l = fminf(fmaxf(lv[i], -7.0f), 7.0f);
                        const float sg = __builtin_amdgcn_rcpf(1.0f + __builtin_amdgcn_exp2f(-1.702f * LOG2E * g)); o[n * 4 + i] = g * sg * (l + 1.0f); } }
                u32x2 w; w.x = pk4_fp8(o[0] * F8_H_MUL, o[1] * F8_H_MUL, o[2] * F8_H_MUL, o[3] * F8_H_MUL); w.y = pk4_fp8(o[4] * F8_H_MUL, o[5] * F8_H_MUL, o[6] * F8_H_MUL, o[7] * F8_H_MUL);
                *(u32x2*)rowp = w; }
    }
};
struct EpiGateBf16 {
    static constexpr bool PERM = true;
    bf16_t* O; const float* b2; const float* rowgate; const int* tile_e;
    __device__ __forceinline__ void operator()(const f32x4 (&acc)[2][2][4][2], const Unit& u, int wr, int wc, int fr, int fq) const {
        const int e = tile_e[u.pm]; const int row0 = u.pm * BM + wr * 64 + fr; const int col0 = u.pn * BM + wc * 32 + 8 * fq;
        f32x4 bv[2][2];
#pragma unroll
        for (int bj = 0; bj < 2; ++bj)
#pragma unroll
            for (int n = 0; n < 2; ++n) bv[bj][n] = *(const f32x4*)(b2 + (size_t)e * 1024 + col0 + bj * HALF + 4 * n);
#pragma unroll
        for (int ai = 0; ai < 2; ++ai)
#pragma unroll
            for (int m = 0; m < 4; ++m) { const int row = row0 + ai * HALF + m * 16; const float gt = rowgate[row]; bf16_t* rowp = O + (size_t)row * 1024 + col0;
#pragma unroll
                for (int bj = 0; bj < 2; ++bj) { const f32x4 v0 = (acc[ai][bj][m][0] + bv[bj][0]) * gt, v1 = (acc[ai][bj][m][1] + bv[bj][1]) * gt;
                    u32x4 w; w.x = pk2(v0[0], v0[1]); w.y = pk2(v0[2], v0[3]); w.z = pk2(v1[0], v1[1]); w.w = pk2(v1[2], v1[3]);
                    *(u32x4*)(rowp + bj * HALF) = w; } }
    }
};

template <bool F8, bool GATHER, class Epi, class Sched>
__device__ __forceinline__ void gemm_phase(LAS unsigned char* lds, const Gemm g, const Sched& S, const Epi& E) {
    const int tid = threadIdx.x, wid = __builtin_amdgcn_readfirstlane(tid >> 6), lane = tid & 63, wr = wid >> 2, wc = wid & 3, fr = lane & 15, fq = lane >> 4;
    const int RB = F8 ? g.K : g.K * 2, nt = RB / 128;
    unsigned voffB[2];
#pragma unroll
    for (int i = 0; i < 2; ++i) { int R, C; stage_rc(tid * 16 + i * 8192, R, C); const int Rb = Epi::PERM ? ((R & ~31) + perm32(R & 31)) : R;
        voffB[i] = (unsigned)(Rb * RB + C * 2); }
#define PG8_AOFFS(dst, pm_) do { _Pragma("unroll") for (int h_ = 0; h_ < 2; ++h_) _Pragma("unroll") for (int i_ = 0; i_ < 2; ++i_) { int R_, C_; stage_rc(tid * 16 + i_ * 8192, R_, C_); \
        const int row_ = (pm_) * BM + h_ * HALF + R_; const unsigned grow_ = GATHER ? (unsigned)g.rowtok[row_] : (unsigned)row_; dst[h_][i_] = grow_ * (unsigned)RB + (unsigned)(C_ * 2); } } while (0)
    unsigned cvA[2][2], nvA[2][2];
    const size_t kstep = (size_t)(BK * 2);
    const size_t hstep = (size_t)HALF * RB;
    const size_t tstep = 2 * hstep;
    const unsigned ldsw = (unsigned)wid * 1024u;
    const int aoff = F8 ? lds_byte(wr * 64 + fr, (fq & 1) * 16) + (fq >> 1) * 1024 : lds_byte(wr * 64 + fr, fq * 8);
    const int boff = F8 ? lds_byte(wc * 32 + fr, (fq & 1) * 16) + (fq >> 1) * 1024 : lds_byte(wc * 32 + fr, fq * 8);
    const int scW = g.scW, scA = g.scA;
#define PG8_SA(b, h) (((b) * 2 + (h)) * HTB)
#define PG8_SB(b, h) ((4 + (b) * 2 + (h)) * HTB)
#define PG8_STAGE(bufoff, gbase, voff) do { _Pragma("unroll") for (int _i = 0; _i < 2; ++_i) \
        __builtin_amdgcn_global_load_lds((const unsigned*)((const char*)(gbase) + (voff)[_i]), (LAS unsigned*)(lds + (bufoff) + ldsw + _i * 8192), 16, 0, 0); } while (0)
typedef int v8i32a __attribute__((ext_vector_type(8), aligned(16)));
#define PG8_LD32(p) (*(const LAS v8i32a*)(p))
#define PG8_STAGE_A(bufoff, kptr, offs) do { _Pragma("unroll") for (int _i = 0; _i < 2; ++_i) \
        __builtin_amdgcn_global_load_lds((const unsigned*)((const char*)(kptr) + (offs)[_i]), (LAS unsigned*)(lds + (bufoff) + ldsw + _i * 8192), 16, 0, 0); } while (0)
#define PG8_LDA(dst, b, h) do { _Pragma("unroll") for (int m = 0; m < 4; ++m) { if constexpr (F8) { dst[m].f8 = __builtin_bit_cast(v8i32, PG8_LD32(lds + PG8_SA(b, h) + aoff + m * 2048)); } \
        else { _Pragma("unroll") for (int k = 0; k < 2; ++k) dst[m].hv[k] = *(const LAS bf16x8*)(lds + PG8_SA(b, h) + aoff + m * 2048 + k * 1024); } } } while (0)
#define PG8_LDB(dst, b, h) do { _Pragma("unroll") for (int n = 0; n < 2; ++n) { if constexpr (F8) { dst[n].f8 = __builtin_bit_cast(v8i32, PG8_LD32(lds + PG8_SB(b, h) + boff + n * 2048)); } \
        else { _Pragma("unroll") for (int k = 0; k < 2; ++k) dst[n].hv[k] = *(const LAS bf16x8*)(lds + PG8_SB(b, h) + boff + n * 2048 + k * 1024); } } } while (0)
#define PG8_MMA(ai, bj, At, Bt) do { __builtin_amdgcn_s_setprio(1); _Pragma("unroll") for (int m = 0; m < 4; ++m) _Pragma("unroll") for (int n = 0; n < 2; ++n) { \
        if constexpr (F8) { asm volatile("v_mfma_scale_f32_16x16x128_f8f6f4 %0, %1, %2, %0, %3, %4 op_sel_hi:[0,0,0]" : "+v"(acc[ai][bj][m][n]) : "v"(Bt[n].f8), "v"(At[m].f8), "v"(scW), "v"(scA)); } \
        else { _Pragma("unroll") for (int k = 0; k < 2; ++k) acc[ai][bj][m][n] = __builtin_amdgcn_mfma_f32_16x16x32_bf16(Bt[n].hv[k], At[m].hv[k], acc[ai][bj][m][n], 0, 0, 0); } } \
        __builtin_amdgcn_s_setprio(0); } while (0)
#define PG8_WAIT_V(n) asm volatile("s_waitcnt vmcnt(" #n ")" ::: "memory")
#define PG8_WAIT_L(n) asm volatile("s_waitcnt lgkmcnt(" #n ")" ::: "memory")
#define PG8_BAR __builtin_amdgcn_s_barrier()
#define PG8_SCHED __builtin_amdgcn_sched_barrier(0)
    Unit cur, nxt; int ui = 0;
    if (!S.next(0, cur)) return;
    f32x4 acc[2][2][4][2];
#pragma unroll
    for (int a = 0; a < 2; ++a)
#pragma unroll
        for (int b = 0; b < 2; ++b)
#pragma unroll
            for (int m = 0; m < 4; ++m)
#pragma unroll
                for (int n = 0; n < 2; ++n) acc[a][b][m][n] = (f32x4){0.f, 0.f, 0.f, 0.f};
    struct FragH { bf16x8 hv[2]; }; struct Frag8 { v8i32 f8; };
    typename std::conditional<F8, Frag8, FragH>::type At[4], B0[2], B1[2];
    const char* const kA = (const char*)g.A; const char* cB = (const char*)g.Bt + (size_t)cur.pb * tstep;
    PG8_AOFFS(cvA, cur.pm);
    PG8_STAGE(PG8_SB(0, 0), cB, voffB); PG8_STAGE(PG8_SB(0, 1), cB + hstep, voffB); PG8_STAGE_A(PG8_SA(0, 0), kA, cvA[0]); PG8_STAGE_A(PG8_SA(0, 1), kA, cvA[1]);
    if (wr == 1) PG8_BAR;
    PG8_WAIT_V(2); PG8_BAR;
    PG8_STAGE(PG8_SB(1, 0), cB + kstep, voffB); PG8_STAGE_A(PG8_SA(1, 0), kA + kstep, cvA[0]); PG8_STAGE(PG8_SB(1, 1), cB + hstep + kstep, voffB);
    PG8_WAIT_V(6); PG8_BAR;
    for (;;) {
        const bool has_next = S.next(ui + 1, nxt);
        const char* nB = has_next ? (const char*)g.Bt + (size_t)nxt.pb * tstep : cB;
        if (has_next) { PG8_AOFFS(nvA, nxt.pm); } else { _Pragma("unroll") for (int h_ = 0; h_ < 2; ++h_) _Pragma("unroll") for (int i_ = 0; i_ < 2; ++i_) nvA[h_][i_] = cvA[h_][i_]; }
#pragma clang loop unroll(disable)
        for (int t = 0; t < nt; t += 2) {
            const bool last = (t == nt - 2);
            const char* a1 = kA + (size_t)(t + 1) * kstep;
            const char* a2 = last ? kA : kA + (size_t)(t + 2) * kstep; const char* b2 = last ? nB : cB + (size_t)(t + 2) * kstep;
            const char* a3 = a2 + kstep; const char* b3 = b2 + kstep;
            unsigned v2A[2][2];
#pragma unroll
            for (int h_ = 0; h_ < 2; ++h_)
#pragma unroll
                for (int i_ = 0; i_ < 2; ++i_) v2A[h_][i_] = last ? nvA[h_][i_] : cvA[h_][i_];
            PG8_LDB(B0, 0, 0); PG8_LDB(B1, 0, 1); PG8_SCHED; PG8_LDA(At, 0, 0); PG8_STAGE_A(PG8_SA(1, 1), a1, cvA[1]);
            PG8_WAIT_V(8); PG8_WAIT_L(0); PG8_BAR; PG8_MMA(0, 0, At, B0); PG8_MMA(0, 1, At, B1); PG8_BAR; PG8_SCHED;
            PG8_LDA(At, 0, 1); PG8_STAGE(PG8_SB(0, 0), b2, voffB); PG8_STAGE(PG8_SB(0, 1), b2 + hstep, voffB); PG8_STAGE_A(PG8_SA(0, 0), a2, v2A[0]);
            PG8_WAIT_V(8); PG8_WAIT_L(0); PG8_BAR; PG8_MMA(1, 0, At, B0); PG8_MMA(1, 1, At, B1); PG8_BAR; PG8_SCHED;
            PG8_LDB(B0, 1, 0); PG8_LDB(B1, 1, 1); PG8_SCHED; PG8_LDA(At, 1, 0); PG8_STAGE_A(PG8_SA(0, 1), a2, v2A[1]);
            PG8_WAIT_V(8); PG8_WAIT_L(0); PG8_BAR; PG8_MMA(0, 0, At, B0); PG8_MMA(0, 1, At, B1); PG8_BAR; PG8_SCHED;
            PG8_LDA(At, 1, 1); PG8_STAGE(PG8_SB(1, 0), b3, voffB); PG8_STAGE(PG8_SB(1, 1), b3 + hstep, voffB); PG8_STAGE_A(PG8_SA(1, 0), a3, v2A[0]);
            PG8_WAIT_V(8); PG8_WAIT_L(0); PG8_BAR; PG8_MMA(1, 0, At, B0); PG8_MMA(1, 1, At, B1); PG8_BAR; PG8_SCHED;
        }
        if (wr == 0) PG8_BAR;
        if constexpr (F8) asm volatile("s_nop 15\n\ts_nop 15" ::: "memory");
        E(acc, cur, wr, wc, fr, fq);
        if (!has_next) break;
#pragma unroll
        for (int a = 0; a < 2; ++a)
#pragma unroll
            for (int b = 0; b < 2; ++b)
#pragma unroll
                for (int m = 0; m < 4; ++m)
#pragma unroll
                    for (int n = 0; n < 2; ++n) acc[a][b][m][n] = (f32x4){0.f, 0.f, 0.f, 0.f};
        cur = nxt; cB = nB; ++ui;
#pragma unroll
        for (int h_ = 0; h_ < 2; ++h_)
#pragma unroll
            for (int i_ = 0; i_ < 2; ++i_) cvA[h_][i_] = nvA[h_][i_];
        if (wr == 1) PG8_BAR;
    }
    PG8_WAIT_V(0);
    PG8_BAR;
#undef PG8_SA
#undef PG8_SB
#undef PG8_STAGE
#undef PG8_STAGE_A
#undef PG8_AOFFS
#undef PG8_LDA
#undef PG8_LDB
#undef PG8_MMA
#undef PG8_LD32
#undef PG8_WAIT_V
#undef PG8_WAIT_L
#undef PG8_BAR
#undef PG8_SCHED
}
}

struct Args { const float* in[30]; float* out; unsigned char* ws; int ph_lo, ph_hi; };

__device__ __forceinline__ void p0_transpose_item(const float* W, int K, int N, bf16_t* WT, int k0, int n0, int drow0, LAS float* scr, int lane) {
#pragma unroll 8
    for (int i = 0; i < 32; ++i) { const int kk = 2 * i + (lane >> 5); scr[kk * 33 + (lane & 31)] = W[(size_t)(k0 + kk) * N + n0 + (lane & 31)]; }
    asm volatile("s_waitcnt lgkmcnt(0)" ::: "memory");
    const int c = lane & 7;
#pragma unroll
    for (int j = 0; j < 4; ++j) { const int n = (lane >> 3) + 8 * j; const LAS float* s = scr + (8 * c) * 33 + n;
        u32x4 o; o.x = pk2(s[0 * 33], s[1 * 33]); o.y = pk2(s[2 * 33], s[3 * 33]); o.z = pk2(s[4 * 33], s[5 * 33]); o.w = pk2(s[6 * 33], s[7 * 33]);
        *(u32x4*)(WT + (size_t)(drow0 + n) * K + k0 + 8 * c) = o; }
    asm volatile("s_waitcnt lgkmcnt(0)" ::: "memory");
}
__device__ __forceinline__ void p0_transpose_item_f8(const float* W, int K, int N, unsigned char* WT, int k0, int n0, int drow0, LAS float* scr, int lane) {
#pragma unroll 8
    for (int i = 0; i < 32; ++i) { const int kk = 2 * i + (lane >> 5); scr[kk * 33 + (lane & 31)] = W[(size_t)(k0 + kk) * N + n0 + (lane & 31)]; }
    asm volatile("s_waitcnt lgkmcnt(0)" ::: "memory");
    const int c = lane & 3;
#pragma unroll
    for (int j = 0; j < 2; ++j) { const int n = (lane >> 2) + 16 * j; const LAS float* s = scr + (16 * c) * 33 + n;
        u32x4 o;
        o.x = pk4_fp8(s[0 * 33] * F8_W_MUL, s[1 * 33] * F8_W_MUL, s[2 * 33] * F8_W_MUL, s[3 * 33] * F8_W_MUL);
        o.y = pk4_fp8(s[4 * 33] * F8_W_MUL, s[5 * 33] * F8_W_MUL, s[6 * 33] * F8_W_MUL, s[7 * 33] * F8_W_MUL);
        o.z = pk4_fp8(s[8 * 33] * F8_W_MUL, s[9 * 33] * F8_W_MUL, s[10 * 33] * F8_W_MUL, s[11 * 33] * F8_W_MUL);
        o.w = pk4_fp8(s[12 * 33] * F8_W_MUL, s[13 * 33] * F8_W_MUL, s[14 * 33] * F8_W_MUL, s[15 * 33] * F8_W_MUL);
        *(u32x4*)(WT + (size_t)(drow0 + n) * K + k0 + 16 * c) = o; }
    asm volatile("s_waitcnt lgkmcnt(0)" ::: "memory");
}
__device__ __forceinline__ void p0_prologue(LAS unsigned char* lds, const Args& a, int G) {
    const int tid = threadIdx.x, lane = tid & 63, wave = __builtin_amdgcn_readfirstlane(tid >> 6);
    LAS float* scr = (LAS float*)(lds + wave * 16384);
    const int gw = blockIdx.x * 8 + wave, NGW = G * 8;
    unsigned char* ws = a.ws;
    bf16_t* Wint = (bf16_t*)(ws + WS_WINT); bf16_t* Woutt = (bf16_t*)(ws + WS_WOUT); unsigned char* W1t = ws + WS_W1T; unsigned char* W2t = ws + WS_W2T;
    constexpr int I_IN = 16 * (NIN / 32);
    constexpr int I_OUT = 16 * 32;
    constexpr int I_W1 = 16 * 64;
    constexpr int I_W2 = 16 * 32;
    constexpr int NITEMS = I_IN + I_OUT + NE * I_W1 + NE * I_W2;
    for (int it = gw; it < NITEMS; it += NGW) {
        int r = it;
        if (r < I_IN) { const int nblk = NIN / 32, kb = r / nblk, nb = r % nblk; p0_transpose_item(a.in[2], 1024, NIN, Wint, 64 * kb, 32 * nb, 32 * nb, scr, lane); continue; } r -= I_IN;
        if (r < I_OUT) { const int kb = r / 32, nb = r % 32; p0_transpose_item(a.in[22], 1024, 1024, Woutt, 64 * kb, 32 * nb, 32 * nb, scr, lane); continue; } r -= I_OUT;
        if (r < NE * I_W1) { const int e = r / I_W1, q = r % I_W1, kb = q / 64, nb = q % 64; const int n0 = 32 * nb;
            const int drow = (n0 < 1024) ? ((n0 >> 7) * 256 + (n0 & 127)) : (((n0 - 1024) >> 7) * 256 + 128 + ((n0 - 1024) & 127));
            p0_transpose_item_f8(a.in[26] + (size_t)e * 1024 * 2048, 1024, 2048, W1t + (size_t)e * 2048 * 1024, 64 * kb, n0, drow, scr, lane); continue; } r -= NE * I_W1;
        { const int e = r / I_W2, q = r % I_W2, kb = q / 32, nb = q % 32;
            p0_transpose_item_f8(a.in[28] + (size_t)e * 1024 * 1024, 1024, 1024, W2t + (size_t)e * 1024 * 1024, 64 * kb, 32 * nb, 32 * nb, scr, lane); }
    }
    const float* x = a.in[0]; const float* g1 = a.in[1]; bf16_t* XN = (bf16_t*)(ws + WS_XN);
    f32x4 gv[4];
#pragma unroll
    for (int j = 0; j < 4; ++j) gv[j] = *((const f32x4*)g1 + lane + 64 * j);
    for (int m = gw; m < T; m += NGW) {
        const f32x4* xr = (const f32x4*)(x + (size_t)m * D) + lane;
        f32x4 v[4]; float s = 0.f;
#pragma unroll
        for (int j = 0; j < 4; ++j) { v[j] = xr[64 * j]; s += (v[j].x * v[j].x + v[j].y * v[j].y) + (v[j].z * v[j].z + v[j].w * v[j].w); }
        const float rstd = 1.0f / sqrtf(wave_sum(s) * (1.0f / D) + 1e-5f);
        u32x2* o8 = (u32x2*)(XN + (size_t)m * D) + lane;
#pragma unroll
        for (int j = 0; j < 4; ++j) { u32x2 w; w.x = pk2(v[j].x * rstd * gv[j].x, v[j].y * rstd * gv[j].y); w.y = pk2(v[j].z * rstd * gv[j].z, v[j].w * rstd * gv[j].w); o8[64 * j] = w; }
    }
}

__device__ __forceinline__ f32x4 cvlo(const u32x4 u) { return (f32x4){bflo(u.x), bfhi(u.x), bflo(u.y), bfhi(u.y)}; }
__device__ __forceinline__ f32x4 cvhi(const u32x4 u) { return (f32x4){bflo(u.z), bfhi(u.z), bflo(u.w), bfhi(u.w)}; }
__device__ __forceinline__ u32x4 pk8(const f32x4 lo, const f32x4 hi) { u32x4 w; w.x = pk2(lo.x, lo.y); w.y = pk2(lo.z, lo.w); w.z = pk2(hi.x, hi.y); w.w = pk2(hi.z, hi.w); return w; }
__device__ __forceinline__ void p2_prep(LAS unsigned char* lds, const Args& a) {
    const int tid = threadIdx.x, lane = tid & 63, wave = __builtin_amdgcn_readfirstlane(tid >> 6);
    unsigned char* ws = a.ws;
    const bf16_t* P = (const bf16_t*)(ws + WS_P);
    bf16_t* SR = (bf16_t*)(ws + WS_SR); bf16_t* SK = (bf16_t*)(ws + WS_SK); bf16_t* SV = (bf16_t*)(ws + WS_SV); bf16_t* SA = (bf16_t*)(ws + WS_SA); bf16_t* SB = (bf16_t*)(ws + WS_SB);
    float* SW = (float*)(ws + WS_SW); bf16_t* SG = (bf16_t*)(ws + WS_SG); bf16_t* QN = (bf16_t*)(ws + WS_QN); bf16_t* KN = (bf16_t*)(ws + WS_KN);
    const float* mu = a.in[3]; const float* w0 = a.in[4]; const float* w2 = a.in[5]; const float* a0 = a.in[6]; const float* a2 = a.in[7]; const float* g2 = a.in[8];
    const float* k_k = a.in[9]; const float* k_a = a.in[10]; const float* qn_g = a.in[14]; const float* kn_g = a.in[15];
    LAS unsigned char* ACT = lds;
    LAS float* DEC = (LAS float*)(lds + 8192); LAS float* ALR = (LAS float*)(lds + 40960); LAS float* GG = (LAS float*)(lds + 73728);
    bf16x8 bw[4][5];
    const int fcol = lane & 15, fk = (lane >> 4) * 8;
#pragma unroll
    for (int cb = 0; cb < 4; ++cb) {
        const int col = wave * 64 + cb * 16 + fcol;
#pragma unroll
        for (int kb = 0; kb < 5; ++kb) {
            const float* src = (kb == 0) ? (w2 + (size_t)fk * CW + col) : (kb == 1) ? (a2 + (size_t)fk * CW + col) : (g2 + (size_t)((kb - 2) * 32 + fk) * CW + col);
            u32x4 w; w.x = pk2(src[0], src[CW]); w.y = pk2(src[2 * CW], src[3 * CW]); w.z = pk2(src[4 * CW], src[5 * CW]); w.w = pk2(src[6 * CW], src[7 * CW]);
            bw[cb][kb] = __builtin_bit_cast(bf16x8, w);
        }
    }
    float w0c[4], a0c[4];
#pragma unroll
    for (int cb = 0; cb < 4; ++cb) { w0c[cb] = w0[wave * 64 + cb * 16 + fcol]; a0c[cb] = a0[wave * 64 + cb * 16 + fcol]; }
    const int c8 = lane * 8;
    const int TPB = T / (int)gridDim.x;
    const int tb0 = blockIdx.x * TPB;
    for (int t0 = tb0; t0 < tb0 + TPB; t0 += 16) {
        if (tid < 320) {
            const int tok = tid / 20, ch = tid - tok * 20, t = t0 + tok, col = 1536 + ch * 8;
            const u32x4 cu = *(const u32x4*)(P + (size_t)t * NINP + col);
            u32x4 pu = (u32x4){0u, 0u, 0u, 0u};
            if (t & (SEQ - 1)) pu = *(const u32x4*)(P + (size_t)(t - 1) * NINP + col);
            const f32x4 m0 = *(const f32x4*)(mu + col), m1 = *(const f32x4*)(mu + col + 4);
            const f32x4 c0 = cvlo(cu), c1 = cvhi(cu), p0 = cvlo(pu), p1 = cvhi(pu);
            f32x4 s0 = c0 + (p0 - c0) * m0, s1 = c1 + (p1 - c1) * m1;
            if (ch < 4) {
#pragma unroll
                for (int i = 0; i < 4; ++i) { const float e0 = __expf(-2.0f * fabsf(s0[i])), e1 = __expf(-2.0f * fabsf(s1[i])); const float th0 = (1.0f - e0) / (1.0f + e0), th1 = (1.0f - e1) / (1.0f + e1);
                    s0[i] = s0[i] < 0.f ? -th0 : th0; s1[i] = s1[i] < 0.f ? -th1 : th1; }
            } else if (ch >= 8) {
#pragma unroll
                for (int i = 0; i < 4; ++i) { s0[i] = sigmoidf_(s0[i]); s1[i] = sigmoidf_(s1[i]); }
            }
            *(LAS u32x4*)(ACT + tok * 320 + ch * 16) = pk8(s0, s1);
        }
        __syncthreads();
        {
            bf16x8 af[5];
#pragma unroll
            for (int kb = 0; kb < 5; ++kb) af[kb] = *(const LAS bf16x8*)(ACT + fcol * 320 + kb * 64 + (lane >> 4) * 16);
#pragma unroll
            for (int cb = 0; cb < 4; ++cb) {
                const f32x4 z = {0.f, 0.f, 0.f, 0.f};
                const f32x4 aw = __builtin_amdgcn_mfma_f32_16x16x32_bf16(af[0], bw[cb][0], z, 0, 0, 0);
                const f32x4 aa = __builtin_amdgcn_mfma_f32_16x16x32_bf16(af[1], bw[cb][1], z, 0, 0, 0);
                f32x4 ag = __builtin_amdgcn_mfma_f32_16x16x32_bf16(af[2], bw[cb][2], z, 0, 0, 0);
                ag = __builtin_amdgcn_mfma_f32_16x16x32_bf16(af[3], bw[cb][3], ag, 0, 0, 0);
                ag = __builtin_amdgcn_mfma_f32_16x16x32_bf16(af[4], bw[cb][4], ag, 0, 0, 0);
                const int col = wave * 64 + cb * 16 + fcol;
#pragma unroll
                for (int i = 0; i < 4; ++i) { const int row = (lane >> 4) * 4 + i;
                    DEC[row * 512 + col] = __expf(-0.6065306597126334f * sigmoidf_(aw[i] + w0c[cb]));
                    ALR[row * 512 + col] = sigmoidf_(aa[i] + a0c[cb]);
                    GG[row * 512 + col] = ag[i]; }
            }
        }
        __syncthreads();
#pragma unroll 1
        for (int q = 0; q < 2; ++q) {
            const int tok = 2 * wave + q, t = t0 + tok; const size_t o = (size_t)t * CW + c8;
            const bf16_t* pr = P + (size_t)t * NINP + c8;
            const bool first = (t & (SEQ - 1)) == 0;
            const u32x4 zz = (u32x4){0u, 0u, 0u, 0u};
            f32x4 rr0, rr1;
            { const u32x4 cu = *(const u32x4*)(pr), pu = first ? zz : *(const u32x4*)(pr - NINP);
              const f32x4 m0 = *(const f32x4*)(mu + c8), m1 = *(const f32x4*)(mu + c8 + 4);
              const f32x4 c0 = cvlo(cu), c1 = cvhi(cu), p0 = cvlo(pu), p1 = cvhi(pu);
              rr0 = c0 + (p0 - c0) * m0; rr1 = c1 + (p1 - c1) * m1; *(u32x4*)(SR + o) = pk8(rr0, rr1); }
            { const u32x4 cu = *(const u32x4*)(pr + 1024), pu = first ? zz : *(const u32x4*)(pr - NINP + 1024);
              const f32x4 m0 = *(const f32x4*)(mu + 1024 + c8), m1 = *(const f32x4*)(mu + 1024 + c8 + 4);
              const f32x4 c0 = cvlo(cu), c1 = cvhi(cu), p0 = cvlo(pu), p1 = cvhi(pu);
              *(u32x4*)(SV + o) = pk8(c0 + (p0 - c0) * m0, c1 + (p1 - c1) * m1); }
            { const u32x4 cu = *(const u32x4*)(pr + 512), pu = first ? zz : *(const u32x4*)(pr - NINP + 512);
              const f32x4 m0 = *(const f32x4*)(mu + 512 + c8), m1 = *(const f32x4*)(mu + 512 + c8 + 4);
              const f32x4 c0 = cvlo(cu), c1 = cvhi(cu), p0 = cvlo(pu), p1 = cvhi(pu);
              const f32x4 k0 = c0 + (p0 - c0) * m0, k1 = c1 + (p1 - c1) * m1;
              const f32x4 kk0 = k0 * *(const f32x4*)(k_k + c8), kk1 = k1 * *(const f32x4*)(k_k + c8 + 4);
              float ss = (kk0.x * kk0.x + kk0.y * kk0.y) + (kk0.z * kk0.z + kk0.w * kk0.w) + (kk1.x * kk1.x + kk1.y * kk1.y) + (kk1.z * kk1.z + kk1.w * kk1.w);
              ss = red8(ss);
              const float inv = 1.0f / sqrtf(fmaxf(ss, 1e-24f));
              const f32x4 kn0 = kk0 * inv, kn1 = kk1 * inv;
              const f32x4 al0 = *(const LAS f32x4*)(ALR + tok * 512 + c8), al1 = *(const LAS f32x4*)(ALR + tok * 512 + c8 + 4);
              const f32x4 k20 = k0 * (1.0f + (al0 - 1.0f) * *(const f32x4*)(k_a + c8)), k21 = k1 * (1.0f + (al1 - 1.0f) * *(const f32x4*)(k_a + c8 + 4));
              *(u32x4*)(SK + o) = pk8(k20, k21); *(u32x4*)(SA + o) = pk8(-kn0, -kn1); *(u32x4*)(SB + o) = pk8(kn0 * al0, kn1 * al1);
              const f32x4 q0 = rr0 * k20 * *(const f32x4*)(a.in[11] + c8), q1 = rr1 * k21 * *(const f32x4*)(a.in[11] + c8 + 4);
              const float rk = red8((q0.x + q0.y) + (q0.z + q0.w) + (q1.x + q1.y) + (q1.z + q1.w));
              if ((lane & 7) == 0) ((float*)(ws + WS_RK))[(size_t)t * 8 + (lane >> 3)] = rk; }
            { const f32x4 de0 = *(const LAS f32x4*)(DEC + tok * 512 + c8), de1 = *(const LAS f32x4*)(DEC + tok * 512 + c8 + 4);
              const f32x4 gg0 = *(const LAS f32x4*)(GG + tok * 512 + c8), gg1 = *(const LAS f32x4*)(GG + tok * 512 + c8 + 4);
              *(u32x4*)(SG + o) = pk8(gg0, gg1); *(f32x4*)(SW + o) = de0; *(f32x4*)(SW + o + 4) = de1; }
            { const u32x4 uq = *(const u32x4*)(pr + DQ0), ukd = *(const u32x4*)(pr + DK0);
              const f32x4 q0 = cvlo(uq), q1 = cvhi(uq), d0 = cvlo(ukd), d1 = cvhi(ukd);
              float qs = (q0.x * q0.x + q0.y * q0.y) + (q0.z * q0.z + q0.w * q0.w) + (q1.x * q1.x + q1.y * q1.y) + (q1.z * q1.z + q1.w * q1.w);
              float ks = (d0.x * d0.x + d0.y * d0.y) + (d0.z * d0.z + d0.w * d0.w) + (d1.x * d1.x + d1.y * d1.y) + (d1.z * d1.z + d1.w * d1.w);
              qs = red8(qs); ks = red8(ks);
              const float qi = (1.0f / sqrtf(qs * (1.0f / 64.0f) + 1e-5f)) * (0.125f * LOG2E), ki = 1.0f / sqrtf(ks * (1.0f / 64.0f) + 1e-5f);
              const f32x4 g0 = *(const f32x4*)(qn_g + (c8 & 63)), g1 = *(const f32x4*)(qn_g + (c8 & 63) + 4), h0 = *(const f32x4*)(kn_g + (c8 & 63)), h1 = *(const f32x4*)(kn_g + (c8 & 63) + 4);
              *(u32x4*)(QN + o) = pk8(q0 * qi * g0, q1 * qi * g1);
              *(u32x4*)(KN + o) = pk8(d0 * ki * h0, d1 * ki * h1); }
        }
        __syncthreads();
    }
}

namespace ck {
constexpr int PS = 136;
constexpr int O_BT = 0, O_KT = 8704, O_AP = 17408, O_RT = 26112;
constexpr int O_AT = 34816, O_BH = 43008, O_KH = 51200, O_VV = 59392, O_TN = 67584, O_A2 = 75776, O_V2 = 83968;
constexpr int O_L = 92160, LSTR = 68;
constexpr int O_TOT = 109568, O_GC = 111616;
__device__ __forceinline__ int crow(int r, int hi) { return (r & 3) + 8 * (r >> 2) + 4 * hi; }
__device__ __forceinline__ int voff(int row, int col) { return ((col >> 5) * 4 + (row >> 4)) * 1024 + (row & 15) * 64 + (col & 31) * 2; }
__device__ __forceinline__ s16x4 vtr(const LAS unsigned char* p) { return __builtin_bit_cast(s16x4, __builtin_amdgcn_ds_read_tr16_b64_v4i16((LAS s16x4*)p)); }
__device__ __forceinline__ bf16x8 fragP(const LAS unsigned char* M, int row, int k0, int hi) {
    const LAS unsigned char* p = M + row * PS + (k0 + 4 * hi) * 2; const s16x4 lo = *(const LAS s16x4*)p, h = *(const LAS s16x4*)(p + 16);
    return (bf16x8){lo[0], lo[1], lo[2], lo[3], h[0], h[1], h[2], h[3]}; }
__device__ __forceinline__ bf16x8 fragT(const LAS unsigned char* M, int k0, int colblk, int lane, int hi) {
    const LAS unsigned char* p = M + (colblk * 4 + (k0 >> 4)) * 1024 + ((lane >> 4) & 1) * 32 + (lane & 3) * 8 + (4 * hi + ((lane & 15) >> 2)) * 64;
    const s16x4 lo = vtr(p), h = vtr(p + 512); return (bf16x8){lo[0], lo[1], lo[2], lo[3], h[0], h[1], h[2], h[3]}; }
__device__ __forceinline__ bf16x8 packR(const f32x16& x, int s) {
    u32x4 w; w.x = pk2(x[8 * s], x[8 * s + 1]); w.y = pk2(x[8 * s + 2], x[8 * s + 3]); w.z = pk2(x[8 * s + 4], x[8 * s + 5]); w.w = pk2(x[8 * s + 6], x[8 * s + 7]); return __builtin_bit_cast(bf16x8, w); }
#define CK_MFMA(a, b, c) __builtin_amdgcn_mfma_f32_32x32x16_bf16(a, b, c, 0, 0, 0)
__device__ __forceinline__ f32x16 score(const LAS unsigned char* Am, const LAS unsigned char* Bm, int sblk, int tblk, int mode, int r32, int hi) {
    f32x16 x = f32x16{};
#pragma unroll
    for (int ks = 0; ks < 4; ++ks) x = CK_MFMA(fragP(Am, sblk * 32 + r32, 16 * ks, hi), fragP(Bm, tblk * 32 + r32, 16 * ks, hi), x);
    if (mode) {
        const int t = tblk * 32 + r32;
#pragma unroll
        for (int r = 0; r < 16; ++r) { const int s = sblk * 32 + crow(r, hi); if (mode == 1 ? !(s < t) : !(s <= t)) x[r] = 0.f; }
    }
    return x;
}
__device__ __forceinline__ void storeT_V(LAS unsigned char* M, const f32x16& x, int rb, int c, int hi) {
#pragma unroll
    for (int q = 0; q < 4; ++q) { u32x2 w; w.x = pk2(x[4 * q], x[4 * q + 1]); w.y = pk2(x[4 * q + 2], x[4 * q + 3]); *(LAS u32x2*)(M + voff(c, rb * 32 + 8 * q + 4 * hi)) = w; }
}
__device__ __forceinline__ void storeT_S(LAS unsigned char* M, const f32x16& x, int rb, int c, int hi) {
#pragma unroll
    for (int q = 0; q < 4; ++q) { u32x2 w; w.x = pk2(x[4 * q], x[4 * q + 1]); w.y = pk2(x[4 * q + 2], x[4 * q + 3]); *(LAS u32x2*)(M + c * PS + (rb * 32 + 8 * q + 4 * hi) * 2) = w; }
}

__device__ __forceinline__ void chunk_item(LAS unsigned char* lds, const Args& a, int item) {
    const int tid = threadIdx.x; int lane = tid & 63; const int wave = __builtin_amdgcn_readfirstlane(tid >> 6);
#define CK_FRESH() asm volatile("" : "+v"(lane)); r32 = lane & 31; hi = lane >> 5
    int r32, hi; CK_FRESH();
    unsigned char* ws = a.ws;
    const bf16_t* SR = (const bf16_t*)(ws + WS_SR); const bf16_t* SK = (const bf16_t*)(ws + WS_SK); const bf16_t* SV = (const bf16_t*)(ws + WS_SV);
    const bf16_t* SA = (const bf16_t*)(ws + WS_SA); const bf16_t* SB = (const bf16_t*)(ws + WS_SB); const float* SW = (const float*)(ws + WS_SW);
    bf16_t* CG = (bf16_t*)(ws + WS_CG) + (size_t)item * 4096; bf16_t* CH = (bf16_t*)(ws + WS_CH) + (size_t)item * 4096;
    bf16_t* CR2 = (bf16_t*)(ws + WS_CR2) + (size_t)item * 4096; bf16_t* CY0 = (bf16_t*)(ws + WS_CY0) + (size_t)item * 4096;
    const int bh = item >> 6, c = item & 63, b = bh >> 3, h = bh & 7, tokc = b * SEQ + c * 64, col0 = h * 64;
    LAS unsigned char* BT = lds + O_BT; LAS unsigned char* KT = lds + O_KT; LAS unsigned char* AP = lds + O_AP; LAS unsigned char* RT = lds + O_RT;
    LAS unsigned char* AT = lds + O_AT; LAS unsigned char* BH = lds + O_BH; LAS unsigned char* KH = lds + O_KH; LAS unsigned char* VV = lds + O_VV;
    LAS unsigned char* TN = lds + O_TN; LAS unsigned char* A2M = lds + O_A2; LAS unsigned char* V2M = lds + O_V2;
    LAS float* L = (LAS float*)(lds + O_L); LAS float* TOT = (LAS float*)(lds + O_TOT); LAS float* GC = (LAS float*)(lds + O_GC);
    {
        const int tl = tid >> 3, c8 = (tid & 7) * 8; const size_t o = (size_t)(tokc + tl) * CW + col0 + c8;
        const f32x4 w0 = *(const f32x4*)(SW + o), w1 = *(const f32x4*)(SW + o + 4);
        const u32x4 ua = *(const u32x4*)(SA + o), ub = *(const u32x4*)(SB + o), uk = *(const u32x4*)(SK + o), ur = *(const u32x4*)(SR + o), uv = *(const u32x4*)(SV + o);
        float p[8] = {w0.x, w0.y, w0.z, w0.w, w1.x, w1.y, w1.z, w1.w}, wv[8];
#pragma unroll
        for (int j = 0; j < 8; ++j) wv[j] = p[j];
#pragma unroll
        for (int d = 8; d < 64; d <<= 1) {
#pragma unroll
            for (int j = 0; j < 8; ++j) { const float q = __shfl_up(p[j], d); if (lane >= d) p[j] *= q; }
        }
        if ((lane >> 3) == 7) { *(LAS f32x4*)(TOT + wave * 64 + c8) = (f32x4){p[0], p[1], p[2], p[3]}; *(LAS f32x4*)(TOT + wave * 64 + c8 + 4) = (f32x4){p[4], p[5], p[6], p[7]}; }
        __syncthreads();
        float pre[8], gC[8];
#pragma unroll
        for (int j = 0; j < 8; ++j) { pre[j] = 1.f; gC[j] = 1.f; }
#pragma unroll
        for (int w2 = 0; w2 < 8; ++w2) { const f32x4 t0 = *(const LAS f32x4*)(TOT + w2 * 64 + c8), t1 = *(const LAS f32x4*)(TOT + w2 * 64 + c8 + 4);
            const float tv[8] = {t0.x, t0.y, t0.z, t0.w, t1.x, t1.y, t1.z, t1.w};
#pragma unroll
            for (int j = 0; j < 8; ++j) { if (w2 < wave) pre[j] *= tv[j]; gC[j] *= tv[j]; } }
        if (tid < 8) { *(LAS f32x4*)(GC + c8) = (f32x4){gC[0], gC[1], gC[2], gC[3]}; *(LAS f32x4*)(GC + c8 + 4) = (f32x4){gC[4], gC[5], gC[6], gC[7]}; }
        const f32x4 a0 = cvlo(ua), a1 = cvhi(ua), b0 = cvlo(ub), b1 = cvhi(ub), k0 = cvlo(uk), k1 = cvhi(uk), r0 = cvlo(ur), r1 = cvhi(ur);
        const float av[8] = {a0.x, a0.y, a0.z, a0.w, a1.x, a1.y, a1.z, a1.w}, bv[8] = {b0.x, b0.y, b0.z, b0.w, b1.x, b1.y, b1.z, b1.w};
        const float kv[8] = {k0.x, k0.y, k0.z, k0.w, k1.x, k1.y, k1.z, k1.w}, rv[8] = {r0.x, r0.y, r0.z, r0.w, r1.x, r1.y, r1.z, r1.w};
        float at[8], rt[8], bt[8], kt[8], bh[8], kh[8];
#pragma unroll
        for (int j = 0; j < 8; ++j) { const float g = pre[j] * p[j], ig = __builtin_amdgcn_rcpf(g), gp = g * __builtin_amdgcn_rcpf(wv[j]);
            at[j] = av[j] * gp; rt[j] = rv[j] * g; bt[j] = bv[j] * ig; kt[j] = kv[j] * ig; bh[j] = bt[j] * gC[j]; kh[j] = kt[j] * gC[j]; }
#define CK_PK8(v) ((u32x4){pk2(v[0], v[1]), pk2(v[2], v[3]), pk2(v[4], v[5]), pk2(v[6], v[7])})
#define CK_ST_P(M, val_) do { LAS unsigned char* d_ = (M) + tl * PS + c8 * 2; const u32x4 q_ = (val_); *(LAS u32x2*)d_ = (u32x2){q_[0], q_[1]}; *(LAS u32x2*)(d_ + 8) = (u32x2){q_[2], q_[3]}; } while (0)
        const u32x4 wa = CK_PK8(at), wr = CK_PK8(rt), wb = CK_PK8(bt), wk = CK_PK8(kt), wbh = CK_PK8(bh), wkh = CK_PK8(kh);
        CK_ST_P(AP, wa); CK_ST_P(RT, wr); CK_ST_P(BT, wb); CK_ST_P(KT, wk);
        *(LAS u32x4*)(AT + voff(tl, c8)) = wa; *(LAS u32x4*)(BH + voff(tl, c8)) = wbh; *(LAS u32x4*)(KH + voff(tl, c8)) = wkh; *(LAS u32x4*)(VV + voff(tl, c8)) = uv;
#undef CK_PK8
#undef CK_ST_P
    }
    __syncthreads();
    CK_FRESH();
    f32x16 pa = f32x16{}, pb = f32x16{}, pc = f32x16{}, pd = f32x16{};
#define w1a pa
#define w1b pb
#define xb0 pa
#define xb1 pb
#define y0a pc
#define y0b pd
    if (wave < 2) {
        for (int k = 0; k < (wave == 0 ? 2 : 1); ++k) {
            const int sblk = wave == 0 ? k : 0, tblk = wave == 0 ? k : 1;
            const f32x16 x = score(BT, AP, sblk, tblk, wave == 0 ? 1 : 0, r32, hi);
            const int t = tblk * 32 + r32;
#pragma unroll
            for (int r = 0; r < 16; ++r) L[(sblk * 32 + crow(r, hi)) * LSTR + t] = x[r];
        }
    }
    __syncthreads();
    CK_FRESH();
    if (wave == 6) {
        float x[32];
#pragma unroll
        for (int t = 0; t < 32; ++t) x[t] = (r32 == t) ? 1.f : 0.f;
        const LAS float* Nr = L + (32 * hi) * LSTR + 32 * hi;
#pragma unroll
        for (int sidx = 0; sidx < 31; ++sidx) {
#pragma unroll
            for (int g4 = (sidx + 1) / 4; g4 < 8; ++g4) {
                const f32x4 nv = *(const LAS f32x4*)(Nr + sidx * LSTR + 4 * g4);
                if (4 * g4 + 0 > sidx) x[4 * g4 + 0] += nv.x * x[sidx];
                if (4 * g4 + 1 > sidx) x[4 * g4 + 1] += nv.y * x[sidx];
                if (4 * g4 + 2 > sidx) x[4 * g4 + 2] += nv.z * x[sidx];
                if (4 * g4 + 3 > sidx) x[4 * g4 + 3] += nv.w * x[sidx];
            }
            if ((sidx & 3) == 3) __builtin_amdgcn_sched_barrier(0);
        }
        const int cc = 32 * hi + r32;
#pragma unroll
        for (int t0 = 0; t0 < 32; t0 += 8) { u32x4 w; w.x = pk2(x[t0], x[t0 + 1]); w.y = pk2(x[t0 + 2], x[t0 + 3]); w.z = pk2(x[t0 + 4], x[t0 + 5]); w.w = pk2(x[t0 + 6], x[t0 + 7]);
            *(LAS u32x4*)(TN + voff(cc, 32 * hi + t0)) = w; }
        f32x16 m = f32x16{};
#pragma unroll
        for (int s = 0; s < 2; ++s) {
            const LAS float* lp = L + (16 * s + 4 * hi) * LSTR + 32 + r32;
            u32x4 aw; aw.x = pk2(lp[0], lp[LSTR]); aw.y = pk2(lp[2 * LSTR], lp[3 * LSTR]); aw.z = pk2(lp[8 * LSTR], lp[9 * LSTR]); aw.w = pk2(lp[10 * LSTR], lp[11 * LSTR]);
            const s16x4 b0 = *(const LAS s16x4*)(TN + voff(r32, 16 * s + 4 * hi)), b1 = *(const LAS s16x4*)(TN + voff(r32, 16 * s + 8 + 4 * hi));
            m = CK_MFMA(__builtin_bit_cast(bf16x8, aw), ((bf16x8){b0[0], b0[1], b0[2], b0[3], b1[0], b1[1], b1[2], b1[3]}), m);
        }
        f32x16 t21 = f32x16{};
#pragma unroll
        for (int s = 0; s < 2; ++s) t21 = CK_MFMA(fragT(TN, 32 + 16 * s, 1, lane, hi), packR(m, s), t21);
        storeT_V(TN, t21, 1, r32, hi);
    } else if (wave < 4) {
        const int dvb = wave - 2;
        const f32x16 x00 = score(KT, AP, 0, 0, 1, r32, hi), x01 = score(KT, AP, 0, 1, 0, r32, hi), x11 = score(KT, AP, 1, 1, 1, r32, hi);
#pragma unroll
        for (int s = 0; s < 2; ++s) {
            const bf16x8 v0 = fragT(VV, 16 * s, dvb, lane, hi), v1 = fragT(VV, 32 + 16 * s, dvb, lane, hi);
            w1a = CK_MFMA(packR(x00, s), v0, w1a);
            w1b = CK_MFMA(packR(x01, s), v0, w1b);
            w1b = CK_MFMA(packR(x11, s), v1, w1b);
        }
    } else if (wave < 6) {
        const int tb = wave - 4;
        f32x16 xk0, xk1 = f32x16{};
        if (tb == 0) { xk0 = score(KT, RT, 0, 0, 2, r32, hi); xb0 = score(BT, RT, 0, 0, 2, r32, hi); }
        else { xk0 = score(KT, RT, 0, 1, 0, r32, hi); xk1 = score(KT, RT, 1, 1, 2, r32, hi); xb0 = score(BT, RT, 0, 1, 0, r32, hi); xb1 = score(BT, RT, 1, 1, 2, r32, hi); }
#pragma unroll
        for (int s = 0; s < 2; ++s) {
            y0a = CK_MFMA(fragT(VV, 16 * s, 0, lane, hi), packR(xk0, s), y0a);
            y0b = CK_MFMA(fragT(VV, 16 * s, 1, lane, hi), packR(xk0, s), y0b);
            if (tb == 1) { y0a = CK_MFMA(fragT(VV, 32 + 16 * s, 0, lane, hi), packR(xk1, s), y0a); y0b = CK_MFMA(fragT(VV, 32 + 16 * s, 1, lane, hi), packR(xk1, s), y0b); }
        }
    }
    __syncthreads();
    CK_FRESH();
    if (wave < 2) {
        const int cb = wave; f32x16 a0 = f32x16{}, a1 = f32x16{};
#pragma unroll
        for (int ks = 0; ks < 4; ++ks) {
            const bf16x8 af = fragT(AT, 16 * ks, cb, lane, hi);
            if (ks < 2) a0 = CK_MFMA(af, fragT(TN, 16 * ks, 0, lane, hi), a0);
            a1 = CK_MFMA(af, fragT(TN, 16 * ks, 1, lane, hi), a1);
        }
        storeT_V(A2M, a0, cb, r32, hi); storeT_V(A2M, a1, cb, 32 + r32, hi);
    } else if (wave < 4) {
        const int dvb = wave - 2; f32x16 v0 = f32x16{}, v1 = f32x16{};
#pragma unroll
        for (int s = 0; s < 2; ++s) {
            v0 = CK_MFMA(packR(w1a, s), fragT(TN, 16 * s, 0, lane, hi), v0);
            v1 = CK_MFMA(packR(w1a, s), fragT(TN, 16 * s, 1, lane, hi), v1);
            v1 = CK_MFMA(packR(w1b, s), fragT(TN, 32 + 16 * s, 1, lane, hi), v1);
        }
        storeT_V(V2M, v0, dvb, r32, hi); storeT_V(V2M, v1, dvb, 32 + r32, hi);
    }
    __syncthreads();
    CK_FRESH();
    if (wave >= 4 && wave < 6) {
        const int tb = wave - 4, t = tb * 32 + r32;
        f32x16 r0 = f32x16{}, r1 = f32x16{};
#pragma unroll
        for (int s = 0; s < 2; ++s) {
            const bf16x8 p0 = packR(xb0, s);
            r0 = CK_MFMA(fragT(A2M, 16 * s, 0, lane, hi), p0, r0); r1 = CK_MFMA(fragT(A2M, 16 * s, 1, lane, hi), p0, r1);
            y0a = CK_MFMA(fragT(V2M, 16 * s, 0, lane, hi), p0, y0a); y0b = CK_MFMA(fragT(V2M, 16 * s, 1, lane, hi), p0, y0b);
            if (tb == 1) { const bf16x8 p1 = packR(xb1, s);
                r0 = CK_MFMA(fragT(A2M, 32 + 16 * s, 0, lane, hi), p1, r0); r1 = CK_MFMA(fragT(A2M, 32 + 16 * s, 1, lane, hi), p1, r1);
                y0a = CK_MFMA(fragT(V2M, 32 + 16 * s, 0, lane, hi), p1, y0a); y0b = CK_MFMA(fragT(V2M, 32 + 16 * s, 1, lane, hi), p1, y0b); }
        }
#pragma unroll
        for (int q = 0; q < 4; ++q) {
            const u32x2 u0 = *(const LAS u32x2*)(RT + t * PS + (8 * q + 4 * hi) * 2), u1 = *(const LAS u32x2*)(RT + t * PS + (32 + 8 * q + 4 * hi) * 2);
            r0[4 * q] += bflo(u0.x); r0[4 * q + 1] += bfhi(u0.x); r0[4 * q + 2] += bflo(u0.y); r0[4 * q + 3] += bfhi(u0.y);
            r1[4 * q] += bflo(u1.x); r1[4 * q + 1] += bfhi(u1.x); r1[4 * q + 2] += bflo(u1.y); r1[4 * q + 3] += bfhi(u1.y);
        }
        storeT_S(BT, r0, 0, t, hi); storeT_S(BT, r1, 1, t, hi);
        storeT_S(KT, y0a, 0, t, hi); storeT_S(KT, y0b, 1, t, hi);
    } else if (wave < 2) {
        const int ib = wave, i = ib * 32 + r32; const float gci = GC[i];
        f32x16 g0 = f32x16{}, g1 = f32x16{};
#pragma unroll
        for (int ks = 0; ks < 4; ++ks) { const bf16x8 bf_ = fragT(BH, 16 * ks, ib, lane, hi);
            g0 = CK_MFMA(fragT(A2M, 16 * ks, 0, lane, hi), bf_, g0); g1 = CK_MFMA(fragT(A2M, 16 * ks, 1, lane, hi), bf_, g1); }
#pragma unroll
        for (int r = 0; r < 16; ++r) { if (crow(r, hi) == i) g0[r] += gci; if (32 + crow(r, hi) == i) g1[r] += gci; }
        storeT_S(AP, g0, 0, i, hi); storeT_S(AP, g1, 1, i, hi);
    } else {
        const int id = wave < 4 ? wave - 2 : wave - 4, ib = id >> 1, dvb = id & 1;
        f32x16 hh = f32x16{};
#pragma unroll
        for (int ks = 0; ks < 4; ++ks) {
            hh = CK_MFMA(fragT(BH, 16 * ks, ib, lane, hi), fragT(V2M, 16 * ks, dvb, lane, hi), hh);
            hh = CK_MFMA(fragT(KH, 16 * ks, ib, lane, hi), fragT(VV, 16 * ks, dvb, lane, hi), hh);
        }
        storeT_S((LAS unsigned char*)L, hh, ib, dvb * 32 + r32, hi);
    }
    __syncthreads();
    {
        const int row = tid >> 3, ch = tid & 7;
        const LAS unsigned char* s0 = BT + row * PS + ch * 16; const LAS unsigned char* s1 = KT + row * PS + ch * 16; const LAS unsigned char* s2 = AP + row * PS + ch * 16; const LAS unsigned char* s3 = (const LAS unsigned char*)L + row * PS + ch * 16;
        const u32x2 a0 = *(const LAS u32x2*)s0, a1 = *(const LAS u32x2*)(s0 + 8), b0 = *(const LAS u32x2*)s1, b1 = *(const LAS u32x2*)(s1 + 8);
        const u32x2 c0 = *(const LAS u32x2*)s2, c1 = *(const LAS u32x2*)(s2 + 8), d0 = *(const LAS u32x2*)s3, d1 = *(const LAS u32x2*)(s3 + 8);
        *(u32x4*)(CR2 + row * 64 + ch * 8) = (u32x4){a0.x, a0.y, a1.x, a1.y}; *(u32x4*)(CY0 + row * 64 + ch * 8) = (u32x4){b0.x, b0.y, b1.x, b1.y};
        *(u32x4*)(CG + row * 64 + ch * 8) = (u32x4){c0.x, c0.y, c1.x, c1.y}; *(u32x4*)(CH + row * 64 + ch * 8) = (u32x4){d0.x, d0.y, d1.x, d1.y};
    }
    asm volatile("s_waitcnt lgkmcnt(0)" ::: "memory"); __builtin_amdgcn_s_barrier();
#undef CK_FRESH
#undef w1a
#undef w1b
#undef xb0
#undef xb1
#undef y0a
#undef y0b
}
__device__ __forceinline__ void p2b_chunks(LAS unsigned char* lds, const Args& a) {
#pragma unroll 1
    for (int item = blockIdx.x; item < 4096; item += gridDim.x) chunk_item(lds, a, item);
}
}

namespace ck {
constexpr int SQ_MAT = 8704, SQ_BUF = 6 * SQ_MAT;
constexpr int SQ_OUT = 2 * SQ_BUF;
__device__ __forceinline__ bf16x8 lfrag(const LAS unsigned char* M, int row, int k0, int hi) { return fragP(M, row, k0, hi); }
__device__ __forceinline__ void linit(f32x16& x, const LAS unsigned char* M, int row, int cblk, int hi) {
#pragma unroll
    for (int q = 0; q < 4; ++q) { const u32x2 u = *(const LAS u32x2*)(M + row * PS + (cblk * 32 + 8 * q + 4 * hi) * 2); x[4 * q] = bflo(u.x); x[4 * q + 1] = bfhi(u.x); x[4 * q + 2] = bflo(u.y); x[4 * q + 3] = bfhi(u.y); }
}
__device__ __forceinline__ void seq_head(LAS unsigned char* lds, const Args& a, int bh) {
    const int tid = threadIdx.x, lane = tid & 63, r32 = lane & 31, hi = lane >> 5; const int wave = __builtin_amdgcn_readfirstlane(tid >> 6);
    unsigned char* ws = a.ws;
    const bf16_t* SV = (const bf16_t*)(ws + WS_SV); const bf16_t* SG = (const bf16_t*)(ws + WS_SG); const float* RK = (const float*)(ws + WS_RK); bf16_t* YMIX = (bf16_t*)(ws + WS_YMIX);
    const int b = bh >> 3, h = bh & 7, col0 = h * 64;
    const float* lng = a.in[12] + col0; const float* lnb = a.in[13] + col0;
#define SQ_LOAD(ch) do { const size_t item_ = (size_t)bh * 64 + (ch); LAS unsigned char* bb_ = lds + ((ch) & 1) * SQ_BUF; const size_t t0_ = (size_t)b * SEQ + (ch) * 64; \
        for (int p_ = tid - 128; p_ < 3072; p_ += 384) { const int m_ = p_ >> 9, q_ = p_ & 511, row_ = q_ >> 3, c8_ = (q_ & 7) * 8; u32x4 v_; \
            if (m_ == 0) v_ = *(const u32x4*)((const bf16_t*)(ws + WS_CG) + item_ * 4096 + row_ * 64 + c8_); \
            else if (m_ == 1) v_ = *(const u32x4*)((const bf16_t*)(ws + WS_CH) + item_ * 4096 + row_ * 64 + c8_); \
            else if (m_ == 2) v_ = *(const u32x4*)((const bf16_t*)(ws + WS_CR2) + item_ * 4096 + row_ * 64 + c8_); \
            else if (m_ == 3) v_ = *(const u32x4*)((const bf16_t*)(ws + WS_CY0) + item_ * 4096 + row_ * 64 + c8_); \
            else if (m_ == 4) v_ = *(const u32x4*)(SV + (t0_ + row_) * CW + col0 + c8_); \
            else v_ = *(const u32x4*)(SG + (t0_ + row_) * CW + col0 + c8_); \
            LAS unsigned char* d_ = bb_ + m_ * SQ_MAT + row_ * PS + c8_ * 2; *(LAS u32x2*)d_ = (u32x2){v_.x, v_.y}; *(LAS u32x2*)(d_ + 8) = (u32x2){v_.z, v_.w}; } } while (0)
#define SQ_STORE(ch) do { const LAS unsigned char* ob_ = lds + SQ_OUT + ((ch) & 1) * SQ_MAT; const size_t t0_ = (size_t)b * SEQ + (ch) * 64; \
        for (int p_ = tid - 128; p_ < 512; p_ += 384) { const int row_ = p_ >> 3, c8_ = (p_ & 7) * 8; const LAS unsigned char* s_ = ob_ + row_ * PS + c8_ * 2; \
            const u32x2 lo_ = *(const LAS u32x2*)s_, hi_ = *(const LAS u32x2*)(s_ + 8); *(u32x4*)(YMIX + (t0_ + row_) * D + col0 + c8_) = (u32x4){lo_.x, lo_.y, hi_.x, hi_.y}; } } while (0)
    if (wave >= 2) SQ_LOAD(0);
    __syncthreads();
    f32x16 X00 = f32x16{}, X01 = f32x16{}, X10 = f32x16{}, X11 = f32x16{};
#pragma unroll 1
    for (int c = 0; c < 64; ++c) {
        if (wave >= 2) {
            if (c + 1 < 64) SQ_LOAD(c + 1);
            if (c > 0) SQ_STORE(c - 1);
        } else {
            const int tb = wave;
            const LAS unsigned char* bb = lds + (c & 1) * SQ_BUF;
            const LAS unsigned char* MG = bb; const LAS unsigned char* MH = bb + SQ_MAT; const LAS unsigned char* MR = bb + 2 * SQ_MAT; const LAS unsigned char* MY = bb + 3 * SQ_MAT;
            const LAS unsigned char* MV = bb + 4 * SQ_MAT; const LAS unsigned char* MGT = bb + 5 * SQ_MAT;
            LAS unsigned char* OB = lds + SQ_OUT + (c & 1) * SQ_MAT;
            const int tl = tb * 32 + r32; const size_t t = (size_t)b * SEQ + c * 64 + tl;
            const float rk = RK[t * 8 + h];
            f32x16 y0, y1; linit(y0, MY, tl, 0, hi); linit(y1, MY, tl, 1, hi);
#pragma unroll
            for (int s = 0; s < 2; ++s) {
                const bf16x8 rf0 = lfrag(MR, tl, 16 * s, hi), rf1 = lfrag(MR, tl, 32 + 16 * s, hi);
                y0 = CK_MFMA(packR(X00, s), rf0, y0); y0 = CK_MFMA(packR(X10, s), rf1, y0);
                y1 = CK_MFMA(packR(X01, s), rf0, y1); y1 = CK_MFMA(packR(X11, s), rf1, y1);
            }
#pragma unroll
            for (int db = 0; db < 2; ++db) {
                f32x16 Na, Nb; linit(Na, MH, db * 32 + r32, 0, hi); linit(Nb, MH, db * 32 + r32, 1, hi);
#pragma unroll
                for (int s = 0; s < 2; ++s) {
                    const bf16x8 g00 = lfrag(MG, r32, 16 * s, hi), g01 = lfrag(MG, r32, 32 + 16 * s, hi), g10 = lfrag(MG, 32 + r32, 16 * s, hi), g11 = lfrag(MG, 32 + r32, 32 + 16 * s, hi);
                    const bf16x8 p0 = packR(db ? X01 : X00, s), p1 = packR(db ? X11 : X10, s);
                    Na = CK_MFMA(g00, p0, Na); Na = CK_MFMA(g01, p1, Na);
                    Nb = CK_MFMA(g10, p0, Nb); Nb = CK_MFMA(g11, p1, Nb);
                }
                if (db == 0) { X00 = Na; X10 = Nb; } else { X01 = Na; X11 = Nb; }
            }
            float sm = 0.f;
#pragma unroll
            for (int r = 0; r < 16; ++r) sm += y0[r] + y1[r];
            sm += __shfl_xor(sm, 32);
            const float mean = sm * (1.0f / 64.0f);
            float sq = 0.f;
#pragma unroll
            for (int r = 0; r < 16; ++r) { const float d0 = y0[r] - mean, d1 = y1[r] - mean; sq += d0 * d0 + d1 * d1; }
            sq += __shfl_xor(sq, 32);
            const float rs = 1.0f / sqrtf(sq * (1.0f / 64.0f) + 64e-5f);
#pragma unroll
            for (int db = 0; db < 2; ++db)
#pragma unroll
                for (int q = 0; q < 4; ++q) {
                    const int dv = db * 32 + 8 * q + 4 * hi;
                    const f32x4 lg = *(const f32x4*)(lng + dv), lb = *(const f32x4*)(lnb + dv);
                    const u32x2 uv = *(const LAS u32x2*)(MV + tl * PS + dv * 2), ug = *(const LAS u32x2*)(MGT + tl * PS + dv * 2);
                    const f32x4 vv = {bflo(uv.x), bfhi(uv.x), bflo(uv.y), bfhi(uv.y)}, gg = {bflo(ug.x), bfhi(ug.x), bflo(ug.y), bfhi(ug.y)};
                    f32x4 yy; if (db == 0) yy = (f32x4){y0[4 * q], y0[4 * q + 1], y0[4 * q + 2], y0[4 * q + 3]}; else yy = (f32x4){y1[4 * q], y1[4 * q + 1], y1[4 * q + 2], y1[4 * q + 3]};
                    const f32x4 o = ((yy - mean) * rs * lg + lb + rk * vv) * gg;
                    u32x2 w; w.x = pk2(o.x, o.y); w.y = pk2(o.z, o.w);
                    *(LAS u32x2*)(OB + tl * PS + dv * 2) = w;
                }
        }
        __syncthreads();
    }
    if (wave >= 2) SQ_STORE(63);
#undef SQ_LOAD
#undef SQ_STORE
}
}

__device__ __forceinline__ float red16(float v) {
    v += dpp_f<0xB1>(v); v += dpp_f<0x4E>(v); v += dpp_f<0x141>(v); v += dpp_f<0x140>(v);
    return v;
}
__device__ __forceinline__ void p3_scan(LAS unsigned char* lds, const Args& a) {
    const int tid = threadIdx.x, lane = tid & 63, wave = __builtin_amdgcn_readfirstlane(tid >> 6);
    unsigned char* ws = a.ws;
    const bf16_t* SR = (const bf16_t*)(ws + WS_SR); const bf16_t* SK = (const bf16_t*)(ws + WS_SK); const bf16_t* SV = (const bf16_t*)(ws + WS_SV);
    const bf16_t* SA = (const bf16_t*)(ws + WS_SA); const bf16_t* SB = (const bf16_t*)(ws + WS_SB); const float* SW = (const float*)(ws + WS_SW);
    float* YRAW = (float*)(ws + WS_YRAW);
    const int bh = blockIdx.x >> 1, half = blockIdx.x & 1;
    const int b = bh >> 3, h = bh & 7, tok0 = b * SEQ, col0 = h * 64, row0 = half * 32;
    constexpr int BUFB = 45056;
    LAS float* buf0 = (LAS float*)lds; LAS float* buf1 = (LAS float*)(lds + BUFB);
    LAS float* Y0 = (LAS float*)(lds + 2 * BUFB); LAS float* Y1 = Y0 + 1024;
    constexpr int NCH = SEQ / 32;
    if (wave >= 4) {
        const int lw = wave - 4, sl = lw * 8 + (lane >> 3), cg = lane & 7, c8 = cg * 8;
        f32x4 w0_, w1_; u32x4 uk, ua, ub, ur; u32x2 uv;
#define SC_ISSUE(ch) do { const size_t o_ = (size_t)(tok0 + (ch) * 32 + sl) * CW + col0; \
            w0_ = *(const f32x4*)(SW + o_ + c8); w1_ = *(const f32x4*)(SW + o_ + c8 + 4); uk = *(const u32x4*)(SK + o_ + c8); ua = *(const u32x4*)(SA + o_ + c8); ub = *(const u32x4*)(SB + o_ + c8); ur = *(const u32x4*)(SR + o_ + c8); \
            uv = *(const u32x2*)(SV + o_ + row0 + 4 * cg); } while (0)
#define SC_STORE(bufp) do { LAS float* d_ = (bufp) + sl * 64 + c8; *(LAS f32x4*)(d_) = w0_; *(LAS f32x4*)(d_ + 4) = w1_; \
            *(LAS f32x4*)(d_ + 2048) = cvlo(uk); *(LAS f32x4*)(d_ + 2052) = cvhi(uk); *(LAS f32x4*)(d_ + 4096) = cvlo(ua); *(LAS f32x4*)(d_ + 4100) = cvhi(ua); \
            *(LAS f32x4*)(d_ + 6144) = cvlo(ub); *(LAS f32x4*)(d_ + 6148) = cvhi(ub); *(LAS f32x4*)(d_ + 8192) = cvlo(ur); *(LAS f32x4*)(d_ + 8196) = cvhi(ur); \
            *(LAS f32x4*)((bufp) + 10240 + sl * 32 + 4 * cg) = (f32x4){bflo(uv.x), bfhi(uv.x), bflo(uv.y), bfhi(uv.y)}; } while (0)
#define SC_YOUT(ch, yp) do { *(f32x4*)(YRAW + (size_t)(tok0 + (ch) * 32 + sl) * CW + col0 + row0 + 4 * cg) = *(const LAS f32x4*)((yp) + sl * 32 + 4 * cg); } while (0)
        SC_ISSUE(0); SC_STORE(buf0);
        __syncthreads();
        for (int ch = 0; ch < NCH; ++ch) {
            LAS float* ob = (ch & 1) ? buf0 : buf1; const LAS float* oy = (ch & 1) ? Y0 : Y1;
            if (ch + 1 < NCH) SC_ISSUE(ch + 1);
            if (ch > 0) SC_YOUT(ch - 1, oy);
            if (ch + 1 < NCH) SC_STORE(ob);
            __syncthreads();
        }
        { const LAS float* oy = ((NCH - 1) & 1) ? Y1 : Y0; SC_YOUT(NCH - 1, oy); }
#undef SC_ISSUE
#undef SC_STORE
#undef SC_YOUT
    } else {
        const int g = lane & 7, rl = lane >> 3, row = wave * 8 + rl;
        f32x2 S0 = {0.f, 0.f}, S1 = S0, S2 = S0, S3 = S0;
        __syncthreads();
        for (int ch = 0; ch < NCH; ++ch) {
            const LAS float* cb = (ch & 1) ? buf1 : buf0; LAS float* yb = (ch & 1) ? Y1 : Y0;
            const LAS float* pa = cb + 4 * g; const LAS float* pv = cb + 10240 + row;
#define SC_LD(X, s_) const f32x4 w0##X = *(const LAS f32x4*)(pa + (s_) * 64), w1##X = *(const LAS f32x4*)(pa + (s_) * 64 + 32), k0##X = *(const LAS f32x4*)(pa + (s_) * 64 + 2048), k1##X = *(const LAS f32x4*)(pa + (s_) * 64 + 2080), \
                a0##X = *(const LAS f32x4*)(pa + (s_) * 64 + 4096), a1##X = *(const LAS f32x4*)(pa + (s_) * 64 + 4128), b0##X = *(const LAS f32x4*)(pa + (s_) * 64 + 6144), b1##X = *(const LAS f32x4*)(pa + (s_) * 64 + 6176), \
                r0##X = *(const LAS f32x4*)(pa + (s_) * 64 + 8192), r1##X = *(const LAS f32x4*)(pa + (s_) * 64 + 8224); const float v##X = pv[(s_) * 32]
#define LO(q) ((f32x2){(q).x, (q).y})
#define HI(q) ((f32x2){(q).z, (q).w})
#define SC_STEP(X, s_) do { f32x2 t = S0 * LO(a0##X); t = S1 * HI(a0##X) + t; t = S2 * LO(a1##X) + t; t = S3 * HI(a1##X) + t; float sa = t.x + t.y; \
                const f32x2 vv = {v##X, v##X}; \
                f32x2 p0 = S0 * LO(w0##X), p1 = S1 * HI(w0##X), p2 = S2 * LO(w1##X), p3 = S3 * HI(w1##X); \
                p0 = vv * LO(k0##X) + p0; p1 = vv * HI(k0##X) + p1; p2 = vv * LO(k1##X) + p2; p3 = vv * HI(k1##X) + p3; \
                sa = red8(sa); const f32x2 ss = {sa, sa}; \
                S0 = ss * LO(b0##X) + p0; S1 = ss * HI(b0##X) + p1; S2 = ss * LO(b1##X) + p2; S3 = ss * HI(b1##X) + p3; \
                f32x2 u = S0 * LO(r0##X); u = S1 * HI(r0##X) + u; u = S2 * LO(r1##X) + u; u = S3 * HI(r1##X) + u; float y = u.x + u.y; y = red8(y); \
                yb[(s_) * 32 + row] = y; } while (0)
#pragma unroll 1
            for (int s8 = 0; s8 < 32; s8 += 8) {
                SC_LD(0, s8 + 0); SC_LD(1, s8 + 1);
                SC_STEP(0, s8 + 0); SC_LD(2, s8 + 2);
                SC_STEP(1, s8 + 1); SC_LD(3, s8 + 3);
                SC_STEP(2, s8 + 2); SC_LD(4, s8 + 4);
                SC_STEP(3, s8 + 3); SC_LD(5, s8 + 5);
                SC_STEP(4, s8 + 4); SC_LD(6, s8 + 6);
                SC_STEP(5, s8 + 5); SC_LD(7, s8 + 7);
                SC_STEP(6, s8 + 6);
                SC_STEP(7, s8 + 7);
            }
#undef SC_LD
#undef LO
#undef HI
#undef SC_STEP
            __syncthreads();
        }
    }
}

__device__ __forceinline__ void p3_post(const Args& a, int G) {
    const int tid = threadIdx.x, lane = tid & 63, wave = __builtin_amdgcn_readfirstlane(tid >> 6);
    unsigned char* ws = a.ws;
    const bf16_t* SR = (const bf16_t*)(ws + WS_SR); const bf16_t* SK = (const bf16_t*)(ws + WS_SK); const bf16_t* SV = (const bf16_t*)(ws + WS_SV);
    const bf16_t* SG = (const bf16_t*)(ws + WS_SG); const float* YRAW = (const float*)(ws + WS_YRAW); bf16_t* YMIX = (bf16_t*)(ws + WS_YMIX);
    const int gw = blockIdx.x * 8 + wave, NGW = G * 8, c8 = lane * 8;
    const f32x4 lg0 = *(const f32x4*)(a.in[12] + c8), lg1 = *(const f32x4*)(a.in[12] + c8 + 4), lb0 = *(const f32x4*)(a.in[13] + c8), lb1 = *(const f32x4*)(a.in[13] + c8 + 4);
    const f32x4 rk0 = *(const f32x4*)(a.in[11] + c8), rk1 = *(const f32x4*)(a.in[11] + c8 + 4);
    for (int t = gw; t < T; t += NGW) {
        const size_t o = (size_t)t * CW + c8;
        const f32x4 y0 = *(const f32x4*)(YRAW + o), y1 = *(const f32x4*)(YRAW + o + 4);
        const u32x4 ur = *(const u32x4*)(SR + o), uk = *(const u32x4*)(SK + o), uv = *(const u32x4*)(SV + o), ug = *(const u32x4*)(SG + o);
        const float mean = red8((y0.x + y0.y) + (y0.z + y0.w) + (y1.x + y1.y) + (y1.z + y1.w)) * (1.0f / 64.0f);
        const f32x4 d0 = y0 - mean, d1 = y1 - mean;
        const float var = red8((d0.x * d0.x + d0.y * d0.y) + (d0.z * d0.z + d0.w * d0.w) + (d1.x * d1.x + d1.y * d1.y) + (d1.z * d1.z + d1.w * d1.w)) * (1.0f / 64.0f);
        const f32x4 r0 = cvlo(ur), r1 = cvhi(ur), k0 = cvlo(uk), k1 = cvhi(uk);
        const f32x4 p0 = r0 * k0 * rk0, p1 = r1 * k1 * rk1;
        const float rk = red8((p0.x + p0.y) + (p0.z + p0.w) + (p1.x + p1.y) + (p1.z + p1.w));
        const float rs = 1.0f / sqrtf(var + 64e-5f);
        const f32x4 o0 = (d0 * rs * lg0 + lb0 + rk * cvlo(uv)) * cvlo(ug), o1 = (d1 * rs * lg1 + lb1 + rk * cvhi(uv)) * cvhi(ug);
        *(u32x4*)(YMIX + (size_t)t * D + c8) = pk8(o0, o1);
    }
}

namespace att {
constexpr int SLOT = 32768, OFF_V = 16384;
constexpr int TBL_OFF = MISC_OFF + 1024;
constexpr int LW_OFF = MISC_OFF + 2048;
constexpr int CST_OFF = MISC_OFF + 3072;
__device__ __forceinline__ int crow(int r, int hi) { return (r & 3) + 8 * (r >> 2) + 4 * hi; }
__device__ __forceinline__ void glds16(const void* gsrc, unsigned lds_dst) { unsigned keep;
    asm volatile("s_mov_b32 %0, m0\n\ts_mov_b32 m0, %2\n\ts_nop 0\n\tglobal_load_lds_dwordx4 %1, off\n\ts_mov_b32 m0, %0" : "=&s"(keep) : "v"(gsrc), "s"(lds_dst) : "memory"); }
__device__ __forceinline__ s16x4 vtr(const LAS unsigned char* p) { return __builtin_bit_cast(s16x4, __builtin_amdgcn_ds_read_tr16_b64_v4i16((LAS s16x4*)p)); }

__device__ __forceinline__ void attn_unit(LAS unsigned char* lds, const Args& a, int b, int h, int qb, float negM, float lam) {
    const int tid = threadIdx.x, lane = tid & 63, r32 = lane & 31, hi = lane >> 5; const int wid = __builtin_amdgcn_readfirstlane(tid >> 6);
    const int c = wid >> 2, rg = wid & 3;
    unsigned char* ws = a.ws;
    const bf16_t* QN = (const bf16_t*)(ws + WS_QN); const bf16_t* KN = (const bf16_t*)(ws + WS_KN); const bf16_t* P = (const bf16_t*)(ws + WS_P); bf16_t* YMIX = (bf16_t*)(ws + WS_YMIX);
    const int q0 = qb * 128; const size_t rowbase = (size_t)b * SEQ;
    const int NT = 2 * qb + 2;
    LAS float* tbl = (LAS float*)(lds + TBL_OFF); LAS float* lw = (LAS float*)(lds + LW_OFF) + wid * 32;
    if (tid < 128) {
        const int n = tid; int bkt;
        if (n < 16) bkt = n; else { bkt = 16 + (int)(logf((float)n * (1.0f / 16.0f)) / 2.0794415416798357f * 16.0f); bkt = bkt > 31 ? 31 : bkt; }
        tbl[n] = (a.in[21][bkt * 4 + h] - a.in[21][31 * 4 + h]) * LOG2E;
    }
    const bf16_t* Qw = QN + (rowbase + q0 + rg * 32 + r32) * CW + h * 128 + c * 64;
    bf16x8 qr[4];
#pragma unroll
    for (int d0 = 0; d0 < 4; ++d0) qr[d0] = *(const bf16x8*)(Qw + d0 * 16 + hi * 8);
    const bf16_t* k0src = KN + (rowbase + lane) * CW + h * 128 + wid * 8;
    const bf16_t* k1src = k0src + 64;
    const int pv0 = 2 * wid, pv1 = 2 * wid + 1;
    const bf16_t* v0src = P + (rowbase + 16 * (pv0 & 3) + (lane >> 2)) * NINP + DV0 + h * 128 + 32 * (pv0 >> 2) + (lane & 3) * 8;
    const bf16_t* v1src = P + (rowbase + 16 * (pv1 & 3) + (lane >> 2)) * NINP + DV0 + h * 128 + 32 * (pv1 >> 2) + (lane & 3) * 8;
#define ATT_DMA(t, slot) do { const unsigned s_ = lds0 + (unsigned)(slot) * SLOT; \
        glds16(k0src + (size_t)(t) * 64 * CW, (unsigned)__builtin_amdgcn_readfirstlane(s_ + wid * 1024)); \
        glds16(k1src + (size_t)(t) * 64 * CW, (unsigned)__builtin_amdgcn_readfirstlane(s_ + 8192 + wid * 1024)); \
        glds16(v0src + (size_t)(t) * 64 * NINP, (unsigned)__builtin_amdgcn_readfirstlane(s_ + OFF_V + pv0 * 1024)); \
        glds16(v1src + (size_t)(t) * 64 * NINP, (unsigned)__builtin_amdgcn_readfirstlane(s_ + OFF_V + pv1 * 1024)); } while (0)
#define ATT_SBAR() __builtin_amdgcn_sched_barrier(0)
    const unsigned lds0 = (unsigned)(uintptr_t)lds;
    f32x16 o[4];
#pragma unroll
    for (int d0 = 0; d0 < 4; ++d0) o[d0] = f32x16{};
    float lsum = 0.f;
    const bool shift = negM < -60.0f;
    const int qmin = q0 + 32 * rg, qpos = qmin + r32;
    ATT_DMA(0, 0);
    asm volatile("s_waitcnt vmcnt(0)" ::: "memory");
    __syncthreads();
    for (int t = 0; t < NT; ++t) {
        if (t + 1 < NT) ATT_DMA(t + 1, (t + 1) & 1);
        const int kmin = 64 * t;
        if (kmin <= qmin + 31) {
            const LAS unsigned char* slot = lds + (t & 1) * SLOT;
            const LAS unsigned char* kb = slot + c * 8192 + hi * 1024 + r32 * 16;
            const LAS unsigned char* vb = slot + OFF_V + ((lane >> 4) & 1) * 32 + (lane & 3) * 8 + (4 * hi + ((lane & 15) >> 2)) * 64;
            bf16x8 kf[8];
#pragma unroll
            for (int d0 = 0; d0 < 4; ++d0) { kf[2 * d0] = *(const LAS bf16x8*)(kb + d0 * 2048); kf[2 * d0 + 1] = *(const LAS bf16x8*)(kb + d0 * 2048 + 512); }
            s16x4 va[16], vc[16];
#pragma unroll
            for (int i = 0; i < 8; ++i) { va[2 * i] = vtr(vb + (i >> 2) * 4096 + (i & 3) * 1024); va[2 * i + 1] = vtr(vb + (i >> 2) * 4096 + (i & 3) * 1024 + 512); }
            ATT_SBAR();
            f32x16 p0, p1;
            p0 = __builtin_amdgcn_mfma_f32_32x32x16_bf16(kf[0], qr[0], f32x16{}, 0, 0, 0); p1 = __builtin_amdgcn_mfma_f32_32x32x16_bf16(kf[1], qr[0], f32x16{}, 0, 0, 0);
#pragma unroll
            for (int d0 = 1; d0 < 4; ++d0) { p0 = __builtin_amdgcn_mfma_f32_32x32x16_bf16(kf[2 * d0], qr[d0], p0, 0, 0, 0); p1 = __builtin_amdgcn_mfma_f32_32x32x16_bf16(kf[2 * d0 + 1], qr[d0], p1, 0, 0, 0); }
            ATT_SBAR();
            if (qmin - (kmin + 63) < 113) {
#pragma unroll
                for (int r = 0; r < 16; ++r) {
                    const int d0_ = qpos - (kmin + crow(r, hi)); const int d1_ = d0_ - 32;
                    const float t0 = tbl[d0_ < 0 ? 0 : (d0_ > 127 ? 127 : d0_)], t1 = tbl[d1_ < 0 ? 0 : (d1_ > 127 ? 127 : d1_)];
                    p0[r] = d0_ < 0 ? -INFINITY : p0[r] + t0; p1[r] = d1_ < 0 ? -INFINITY : p1[r] + t1;
                }
            }
            if (shift) {
#pragma unroll
                for (int r = 0; r < 16; ++r) { p0[r] += negM; p1[r] += negM; }
            }
            float sacc = 0.f;
#pragma unroll
            for (int r = 0; r < 16; ++r) { p0[r] = __builtin_amdgcn_exp2f(p0[r]); p1[r] = __builtin_amdgcn_exp2f(p1[r]); sacc += p0[r] + p1[r]; }
            lsum += sacc;
            u32x4 pw[4];
#pragma unroll
            for (int i = 0; i < 4; ++i) { pw[0][i] = pk2(p0[2 * i], p0[2 * i + 1]); pw[1][i] = pk2(p0[8 + 2 * i], p0[8 + 2 * i + 1]); pw[2][i] = pk2(p1[2 * i], p1[2 * i + 1]); pw[3][i] = pk2(p1[8 + 2 * i], p1[8 + 2 * i + 1]); }
            ATT_SBAR();
#pragma unroll
            for (int i = 0; i < 8; ++i) { vc[2 * i] = vtr(vb + (2 + (i >> 2)) * 4096 + (i & 3) * 1024); vc[2 * i + 1] = vtr(vb + (2 + (i >> 2)) * 4096 + (i & 3) * 1024 + 512); }
#pragma unroll
            for (int i = 0; i < 8; ++i) {
                const bf16x8 vf = (bf16x8){va[2 * i][0], va[2 * i][1], va[2 * i][2], va[2 * i][3], va[2 * i + 1][0], va[2 * i + 1][1], va[2 * i + 1][2], va[2 * i + 1][3]};
                o[i >> 2] = __builtin_amdgcn_mfma_f32_32x32x16_bf16(__builtin_bit_cast(bf16x8, pw[i & 3]), vf, o[i >> 2], 0, 0, 0);
            }
#pragma unroll
            for (int i = 0; i < 8; ++i) {
                const bf16x8 vf = (bf16x8){vc[2 * i][0], vc[2 * i][1], vc[2 * i][2], vc[2 * i][3], vc[2 * i + 1][0], vc[2 * i + 1][1], vc[2 * i + 1][2], vc[2 * i + 1][3]};
                o[2 + (i >> 2)] = __builtin_amdgcn_mfma_f32_32x32x16_bf16(__builtin_bit_cast(bf16x8, pw[i & 3]), vf, o[2 + (i >> 2)], 0, 0, 0);
            }
        }
        asm volatile("s_waitcnt vmcnt(0)" ::: "memory");
        __syncthreads();
    }
#undef ATT_DMA
#undef ATT_SBAR
    lsum += __shfl_xor(lsum, 32);
    if (hi == 0) lw[r32] = 1.0f / lsum;
    asm volatile("s_waitcnt lgkmcnt(0)" ::: "memory");
    LAS float* stg = (LAS float*)(lds + wid * 16384);
#pragma unroll
    for (int r = 0; r < 16; ++r) { const int orow = crow(r, hi); const float il = lw[orow];
#pragma unroll
        for (int d0 = 0; d0 < 4; ++d0) stg[orow * 128 + d0 * 32 + r32] = o[d0][r] * il; }
    __syncthreads();
    {
        const int row = tid >> 2, part = tid & 3, rgp = row >> 5, rr = row & 31;
        const LAS float* s1 = (const LAS float*)(lds + rgp * 16384) + rr * 128 + part * 32;
        const LAS float* s2 = (const LAS float*)(lds + (4 + rgp) * 16384) + rr * 128 + part * 32;
        float dv[32]; float ss = 0.f;
#pragma unroll
        for (int i = 0; i < 8; ++i) { const f32x4 x1 = *(const LAS f32x4*)(s1 + 4 * i), x2 = *(const LAS f32x4*)(s2 + 4 * i);
#pragma unroll
            for (int j = 0; j < 4; ++j) { const float dd = x1[j] - lam * x2[j]; dv[4 * i + j] = dd; ss += dd * dd; } }
        ss = red4(ss);
        const float sc = (1.0f / sqrtf(ss * (1.0f / 128.0f) + 1e-5f)) * 0.8f;
        const float* sg = a.in[20] + part * 32;
        bf16_t* op = YMIX + (rowbase + q0 + row) * D + CW + h * 128 + part * 32;
#pragma unroll
        for (int i = 0; i < 4; ++i) { u32x4 w;
            w.x = pk2(dv[8 * i] * sc * sg[8 * i], dv[8 * i + 1] * sc * sg[8 * i + 1]); w.y = pk2(dv[8 * i + 2] * sc * sg[8 * i + 2], dv[8 * i + 3] * sc * sg[8 * i + 3]);
            w.z = pk2(dv[8 * i + 4] * sc * sg[8 * i + 4], dv[8 * i + 5] * sc * sg[8 * i + 5]); w.w = pk2(dv[8 * i + 6] * sc * sg[8 * i + 6], dv[8 * i + 7] * sc * sg[8 * i + 7]);
            *(u32x4*)(op + 8 * i) = w; }
    }
    __syncthreads();
}

__device__ __forceinline__ void attn_phase(LAS unsigned char* lds, const Args& a, unsigned* ctl) {
    const int tid = threadIdx.x;
    LAS float* cst = (LAS float*)(lds + CST_OFF);
    if (tid < 64) {
        const float gq = fabsf(a.in[14][tid]), gk = fabsf(a.in[15][tid]);
        float mq = gq, mk = gk;
#pragma unroll
        for (int o = 1; o < 64; o <<= 1) { mq = fmaxf(mq, __shfl_xor(mq, o)); mk = fmaxf(mk, __shfl_xor(mk, o)); }
        const float d1 = wave_sum(a.in[16][tid] * a.in[17][tid]), d2 = wave_sum(a.in[18][tid] * a.in[19][tid]);
        float mb = 0.f;
        if (tid < 32) { for (int hh = 0; hh < 4; ++hh) mb = fmaxf(mb, (a.in[21][tid * 4 + hh] - a.in[21][31 * 4 + hh]) * LOG2E); }
#pragma unroll
        for (int o = 1; o < 64; o <<= 1) mb = fmaxf(mb, __shfl_xor(mb, o));
        if (tid == 0) { cst[0] = -(8.0f * LOG2E * mq * mk * 1.02f + mb); cst[1] = __expf(d1) - __expf(d2) + 0.2f; }
    }
    __syncthreads();
    const float negM = cst[0], lam = cst[1];
    LAS int* ubox = (LAS int*)(lds + CST_OFF + 16);
    for (;;) {
        if (tid == 0) ubox[0] = (int)atomicAdd(ctl + CW_ATTQ, 1u);
        __syncthreads();
        const int u = ubox[0];
        __syncthreads();
        if (u >= 1024) break;
        const int qb = 31 - (u >> 5), bhh = u & 31;
        attn_unit(lds, a, bhh >> 2, bhh & 3, qb, negM, lam);
    }
}
}

__device__ __forceinline__ void p5_router(LAS unsigned char* lds, const Args& a, unsigned* ctl) {
    const int tid = threadIdx.x, lane = tid & 63, wave = __builtin_amdgcn_readfirstlane(tid >> 6);
    unsigned char* ws = a.ws;
    const float* x1 = a.out; const float* g2 = a.in[23]; const float* rw = a.in[24]; const float* rb = a.in[25];
    unsigned char* H2 = ws + WS_H2; int* EIDX = (int*)(ws + WS_EIDX); float* GATE = (float*)(ws + WS_GATE); int* POS = (int*)(ws + WS_POS);
    LAS float* rwT = (LAS float*)lds;
    LAS int* cnt = (LAS int*)(lds + MISC_OFF + 1024);
    LAS int* basel = (LAS int*)(lds + MISC_OFF + 1024 + 128);
    LAS int* el = (LAS int*)(lds + MISC_OFF + 2048);
    LAS int* pl = (LAS int*)(lds + MISC_OFF + 4096);
    for (int i = tid; i < 32 * 1024; i += 512) { const int k = i >> 5, e = i & 31; rwT[e * 1024 + k] = rw[i]; }
    if (tid < 32) cnt[tid] = 0;
    __syncthreads();
    f32x4 gv[4];
#pragma unroll
    for (int j = 0; j < 4; ++j) gv[j] = *((const f32x4*)g2 + lane + 64 * j);
    const float rbias = rb[lane >> 1];
    const int TPB = T / (int)gridDim.x, tb0 = blockIdx.x * TPB, TPW = TPB / 8;
    for (int i = 0; i < TPW; ++i) {
        const int tl = wave * TPW + i, t = tb0 + tl;
        const f32x4* xr = (const f32x4*)(x1 + (size_t)t * D) + lane;
        f32x4 v[4]; float s = 0.f;
#pragma unroll
        for (int j = 0; j < 4; ++j) { v[j] = xr[64 * j]; s += (v[j].x * v[j].x + v[j].y * v[j].y) + (v[j].z * v[j].z + v[j].w * v[j].w); }
        const float rstd = 1.0f / sqrtf(wave_sum(s) * (1.0f / D) + 1e-5f);
        unsigned* o4 = (unsigned*)(H2 + (size_t)t * D) + lane;
#pragma unroll
        for (int j = 0; j < 4; ++j) { v[j] = v[j] * rstd * gv[j]; o4[64 * j] = pk4_fp8(v[j].x * F8_X_MUL, v[j].y * F8_X_MUL, v[j].z * F8_X_MUL, v[j].w * F8_X_MUL); }
        float acc[32];
#pragma unroll
        for (int e = 0; e < 32; ++e) {
            float s2 = 0.f;
#pragma unroll
            for (int j = 0; j < 4; ++j) { const f32x4 w = *((const LAS f32x4*)(rwT + e * 1024) + lane + 64 * j); s2 += (v[j].x * w.x + v[j].y * w.y) + (v[j].z * w.z + v[j].w * w.w); }
            acc[e] = s2;
        }
#pragma unroll
        for (int e = 0; e < 16; ++e) { const bool up = lane & 32; const float keep = up ? acc[e + 16] : acc[e], send = up ? acc[e] : acc[e + 16]; acc[e] = keep + __shfl_xor(send, 32); }
#pragma unroll
        for (int e = 0; e < 8; ++e) { const bool up = lane & 16; const float keep = up ? acc[e + 8] : acc[e], send = up ? acc[e] : acc[e + 8]; acc[e] = keep + __shfl_xor(send, 16); }
#pragma unroll
        for (int e = 0; e < 4; ++e) { const bool up = lane & 8; const float keep = up ? acc[e + 4] : acc[e], send = up ? acc[e] : acc[e + 4]; acc[e] = keep + __shfl_xor(send, 8); }
#pragma unroll
        for (int e = 0; e < 2; ++e) { const bool up = lane & 4; const float keep = up ? acc[e + 2] : acc[e], send = up ? acc[e] : acc[e + 2]; acc[e] = keep + __shfl_xor(send, 4); }
        { const bool up = lane & 2; const float keep = up ? acc[1] : acc[0], send = up ? acc[0] : acc[1]; acc[0] = keep + __shfl_xor(send, 2); }
        float logit = acc[0] + __shfl_xor(acc[0], 1) + rbias;
        const int myid = lane >> 1;
        float tv[4]; int ti[4];
#pragma unroll
        for (int k = 0; k < 4; ++k) {
            float bv = logit; int bi = myid;
#pragma unroll
            for (int o = 1; o < 64; o <<= 1) { const float ov = __shfl_xor(bv, o); const int oi = __shfl_xor(bi, o); if (ov > bv || (ov == bv && oi < bi)) { bv = ov; bi = oi; } }
            tv[k] = bv; ti[k] = bi;
            if (myid == bi) logit = -INFINITY;
        }
        const float e1 = __expf(tv[1] - tv[0]), e2 = __expf(tv[2] - tv[0]), e3 = __expf(tv[3] - tv[0]);
        const float inv = 1.0f / (1.0f + e1 + e2 + e3);
        if (lane < 4) {
            const int ek = lane == 0 ? ti[0] : lane == 1 ? ti[1] : lane == 2 ? ti[2] : ti[3];
            const float gk = (lane == 0 ? 1.0f : lane == 1 ? e1 : lane == 2 ? e2 : e3) * inv;
            EIDX[t * 4 + lane] = ek; GATE[t * 4 + lane] = gk;
            el[tl * 4 + lane] = ek; pl[tl * 4 + lane] = atomicAdd((int*)(cnt + ek), 1);
        }
    }
    __syncthreads();
    if (tid < 32) basel[tid] = (int)atomicAdd(ctl + CW_CNT + tid, (unsigned)cnt[tid]);
    __syncthreads();
    for (int i = tid; i < TPB * 4; i += 512) POS[(size_t)tb0 * 4 + i] = pl[i] + basel[el[i]];
}

__device__ __forceinline__ void p6_dispatch(LAS unsigned char* lds, const Args& a, unsigned* ctl) {
    const int tid = threadIdx.x, lane = tid & 63, wave = __builtin_amdgcn_readfirstlane(tid >> 6);
    unsigned char* ws = a.ws;
    const int* EIDX = (const int*)(ws + WS_EIDX); const float* GATE = (const float*)(ws + WS_GATE); const int* POS = (const int*)(ws + WS_POS);
    int* DEST = (int*)(ws + WS_DEST); float* ROWGATE = (float*)(ws + WS_ROWGATE); int* TILEE = (int*)(ws + WS_TILEE); int* ROWTOK = (int*)(ws + WS_ROWTOK);
    LAS int* pstart = (LAS int*)(lds + MISC_OFF + 1024); LAS int* pcnt = pstart + 32;
    if (tid == 0) {
        int acc = 0;
        for (int e = 0; e < NE; ++e) { const int cn = (int)__hip_atomic_load(ctl + CW_CNT + e, __ATOMIC_RELAXED, __HIP_MEMORY_SCOPE_AGENT); pstart[e] = acc; pcnt[e] = cn;
            const int nt = (cn + 255) >> 8;
            if (blockIdx.x == 0) for (int i = 0; i < nt; ++i) TILEE[(acc >> 8) + i] = e;
            acc += nt * 256; }
        if (blockIdx.x == 0) TILEE[1023] = acc >> 8;
    }
    __syncthreads();
    if (blockIdx.x < NE) {
        const int e = blockIdx.x, cn = pcnt[e], pe = ((cn + 255) >> 8) * 256;
        for (int i = cn + tid; i < pe; i += 512) ROWTOK[pstart[e] + i] = 0;
    }
    const int TPB = T / (int)gridDim.x, tb0 = blockIdx.x * TPB;
    for (int pi = tb0 * 4 + tid; pi < (tb0 + TPB) * 4; pi += 512) {
        const int e = EIDX[pi], dest = pstart[e] + POS[pi];
        DEST[pi] = dest; ROWGATE[dest] = GATE[pi]; ROWTOK[dest] = pi >> 2;
    }
}

__device__ __forceinline__ void p9_combine(const Args& a, int G) {
    const int tid = threadIdx.x, lane = tid & 63, wave = __builtin_amdgcn_readfirstlane(tid >> 6);
    unsigned char* ws = a.ws;
    const bf16_t* YS = (const bf16_t*)(ws + WS_YS); const int* DEST = (const int*)(ws + WS_DEST);
    float* out = a.out;
    const int gw = blockIdx.x * 8 + wave, NGW = G * 8;
    for (int t = gw; t < T; t += NGW) {
        f32x4* xr = (f32x4*)(out + (size_t)t * D) + lane;
        f32x4 v[4];
#pragma unroll
        for (int j = 0; j < 4; ++j) v[j] = xr[64 * j];
#pragma unroll
        for (int k = 0; k < 4; ++k) {
            const int dest = DEST[t * 4 + k];
            const u32x2* yr = (const u32x2*)(YS + (size_t)dest * D) + lane;
#pragma unroll
            for (int j = 0; j < 4; ++j) { const u32x2 w = yr[64 * j]; v[j].x += bflo(w.x); v[j].y += bfhi(w.x); v[j].z += bflo(w.y); v[j].w += bfhi(w.y); }
        }
        if (TIME_REGION >= 0) { const float sc_ = 1.0f + 4e-6f * (float)((const unsigned*)(ws + WS_CTL))[301];
#pragma unroll
            for (int j = 0; j < 4; ++j) v[j] = v[j] * sc_; }
#pragma unroll
        for (int j = 0; j < 4; ++j) xr[64 * j] = v[j];
    }
}

constexpr int NPHASE = 10;
__global__ void __launch_bounds__(512, 2) hymba_fwd(Args args) {
    extern __shared__ __attribute__((aligned(16))) unsigned char lds_raw[];
    LAS unsigned char* lds = (LAS unsigned char*)lds_raw;
    cg::grid_group grid = cg::this_grid();
    const int G = gridDim.x;
    unsigned char* ws = args.ws;
    unsigned* ctl = (unsigned*)(ws + WS_CTL);
    const int lo = args.ph_lo, hi = args.ph_hi;
#define IN(k) (lo <= (k) && (k) < hi)
#define NREP(k) ((REP_PHASE) == (k) ? 2 : 1)
#define TSTART(k) do { if ((TIME_REGION) == (k) && blockIdx.x == 0 && threadIdx.x == 0) ctl[300] = (unsigned)__builtin_amdgcn_s_memrealtime(); } while (0)
#define TEND(k) do { if ((TIME_REGION) == (k) && blockIdx.x == 0 && threadIdx.x == 0) ctl[301] = (unsigned)__builtin_amdgcn_s_memrealtime() - ctl[300]; } while (0)
#define SEAM(k) do { if (IN(k) && IN((k) + 1)) { if (args.ph_lo < 0) grid.sync(); xcd_barrier(xbar); } } while (0)
    const int* TILEE = (const int*)(ws + WS_TILEE);
    { volatile LAS unsigned* st = (volatile LAS unsigned*)(lds + MISC_OFF); if (threadIdx.x < 2) st[threadIdx.x] = 0u; }
    __syncthreads();
    const XcdBarrier xbar = xcd_barrier_post(ctl + CW_BAR, (volatile LAS unsigned*)(lds + MISC_OFF));

    if (IN(0)) { for (int rep = 0; rep < NREP(0); ++rep) p0_prologue(lds, args, G); } SEAM(0);
    if (IN(1)) {
        pg8::Gemm g{ws + WS_XN, ws + WS_WINT, 1024, 0, 0, nullptr};
        pg8::TileOrder S; S.init(T / 256, NINP / 256, G, (int)blockIdx.x, nullptr, 0);
        pg8::EpiBf16 E{(bf16_t*)(ws + WS_P), NINP};
        for (int rep = 0; rep < NREP(1); ++rep) pg8::gemm_phase<false, false>(lds, g, S, E);
    } SEAM(1);
    TSTART(2);
    if (IN(2)) { _Pragma("clang loop unroll(disable)") for (int rep = 0; rep < NREP(2); ++rep) { p2_prep(lds, args); __syncthreads(); }
        xcd_barrier(xbar); TEND(2);
        TSTART(20); for (int rep = 0; rep < NREP(20); ++rep) ck::p2b_chunks(lds, args); } SEAM(2); TEND(20);
    TSTART(3);
    if (IN(3)) {
        TSTART(30); for (int rep = 0; rep < NREP(30); ++rep) { if (blockIdx.x < 64) ck::seq_head(lds, args, (int)blockIdx.x); __syncthreads(); } TEND(30);
        for (int rep = 0; rep < NREP(31); ++rep) att::attn_phase(lds, args, ctl + 64 * rep);
    } SEAM(3); TEND(3);
    if (IN(4)) {
        pg8::Gemm g{ws + WS_YMIX, ws + WS_WOUT, 1024, 0, 0, nullptr};
        pg8::TileOrder S; S.init(T / 256, D / 256, G, (int)blockIdx.x, nullptr, 0);
        pg8::EpiResF32 E{args.in[0], args.out, D};
        for (int rep = 0; rep < NREP(4); ++rep) pg8::gemm_phase<false, false>(lds, g, S, E);
    } SEAM(4);
    if (IN(5)) { _Pragma("clang loop unroll(disable)") for (int rep = 0; rep < NREP(5); ++rep) { p5_router(lds, args, ctl + 256 * (NREP(5) - 1 - rep)); __syncthreads(); } } SEAM(5);
    if (IN(6)) { for (int rep = 0; rep < NREP(6); ++rep) { p6_dispatch(lds, args, ctl); __syncthreads(); } } SEAM(6);
    if (IN(7)) {
        const int ntile = TILEE[1023];
        pg8::Gemm g{ws + WS_H2, ws + WS_W1T, 1024, F8_W_SC, F8_X_SC, (const int*)(ws + WS_ROWTOK)};
        pg8::TileOrder S; S.init(ntile, 8, G, (int)blockIdx.x, TILEE, 8);
        pg8::EpiSwiglu E{ws + WS_HID, args.in[27], TILEE};
        for (int rep = 0; rep < NREP(7); ++rep) pg8::gemm_phase<true, true>(lds, g, S, E);
    } SEAM(7);
    if (IN(8)) {
        const int ntile = TILEE[1023];
        pg8::Gemm g{ws + WS_HID, ws + WS_W2T, 1024, F8_W_SC, F8_H_SC, nullptr};
        pg8::TileOrder S; S.init(ntile, 4, G, (int)blockIdx.x, TILEE, 4);
        pg8::EpiGateBf16 E{(bf16_t*)(ws + WS_YS), args.in[29], (const float*)(ws + WS_ROWGATE), TILEE};
        for (int rep = 0; rep < NREP(8); ++rep) pg8::gemm_phase<true, false>(lds, g, S, E);
    } SEAM(8);
    if (IN(9)) { p9_combine(args, G); }
#undef IN
#undef SEAM
}

extern "C" void kernel_launch(void* const* d_in, const int* in_sizes, int n_in, void* d_out, int out_size, void* d_ws, size_t ws_size, hipStream_t stream) {
    static int grid = 0;
    if (grid == 0) {
        if (n_in != 30 || in_sizes[0] != T * D || out_size != T * D || ws_size < WS_END) { fprintf(stderr, "kernel_launch: unexpected shapes (n_in %d, in0 %d, out %d, ws %zu); nothing launched\n", n_in, n_in > 0 ? in_sizes[0] : -1, out_size, ws_size); grid = -1; return; }
        int dev = 0, cus = 0, per_cu = 0;
        if (hipGetDevice(&dev) != hipSuccess || hipDeviceGetAttribute(&cus, hipDeviceAttributeMultiprocessorCount, dev) != hipSuccess) { grid = -1; return; }
        if (hipFuncSetAttribute((const void*)hymba_fwd, hipFuncAttributeMaxDynamicSharedMemorySize, LDS_BYTES) != hipSuccess) { fprintf(stderr, "kernel_launch: hipFuncSetAttribute failed\n"); grid = -1; return; }
        if (hipOccupancyMaxActiveBlocksPerMultiprocessor(&per_cu, (const void*)hymba_fwd, 512, LDS_BYTES) != hipSuccess || per_cu < 1) { fprintf(stderr, "kernel_launch: occupancy query says %d\n", per_cu); per_cu = 1; }
        (void)hipGetLastError();
        grid = cus;
        if (grid > 256) grid = 256;
        if (grid != 256 || T % grid != 0 || (T / grid) % 16 != 0) { fprintf(stderr, "kernel_launch: grid %d does not divide the token count evenly\n", grid); grid = -1; return; }
    }
    if (grid < 0) return;
    (void)hipMemsetAsync((char*)d_ws + WS_CTL, 0, CTL_ZERO_BYTES, stream);
    Args a{};
    for (int i = 0; i < 30; ++i) a.in[i] = (const float*)d_in[i];
    a.out = (float*)d_out; a.ws = (unsigned char*)d_ws;
    constexpr int NL = MK_N_LAUNCHES;
    for (int li = 0; li < NL; ++li) {
        a.ph_lo = (NL == 1) ? 0 : li; a.ph_hi = (NL == 1) ? NPHASE : li + 1;
        void* kargs[] = {&a};
        hipError_t e = hipLaunchCooperativeKernel((const void*)hymba_fwd, dim3(grid), dim3(512), kargs, LDS_BYTES, stream);
        if (e != hipSuccess) { fprintf(stderr, "kernel_launch: cooperative launch %d failed: %s (grid %d)\n", li, hipGetErrorString(e), grid); break; }
    }
}
```

```cpp
#include <hip/hip_runtime.h>
#include <hip/hip_cooperative_groups.h>
#include <cstdio>
#include <cstdint>
#include <type_traits>
namespace cg = cooperative_groups;

#ifndef REP_PHASE
#define REP_PHASE -1
#endif
#ifndef TIME_REGION
#define TIME_REGION -1
#endif
#ifndef MK_N_LAUNCHES
#define MK_N_LAUNCHES 1
#endif

#define LAS __attribute__((address_space(3)))
#define GAS __attribute__((address_space(1)))
typedef unsigned short bf16_t;
typedef short bf16x8 __attribute__((ext_vector_type(8)));
typedef short s16x4 __attribute__((ext_vector_type(4)));
typedef float f32x2 __attribute__((ext_vector_type(2)));
typedef float f32x4 __attribute__((ext_vector_type(4)));
typedef float f32x16 __attribute__((ext_vector_type(16)));
typedef unsigned u32x2 __attribute__((ext_vector_type(2)));
typedef unsigned u32x4 __attribute__((ext_vector_type(4)));
typedef int v8i32 __attribute__((ext_vector_type(8)));

constexpr int NB = 8, SEQ = 4096, T = NB * SEQ, D = 1024;
constexpr int CW = 512;
constexpr int NRW = 1696, NIN = 3232, NINP = 3328;
constexpr int DQ0 = 1696, DK0 = 2208, DV0 = 2720;
constexpr int NE = 32, TOPK = 4, DE = 1024;
constexpr int MAXROWS = T * TOPK + NE * 256;
constexpr int MAXTILES = MAXROWS / 256;
constexpr float LOG2E = 1.4426950408889634f;
constexpr float F8_W_MUL = 32.f, F8_X_MUL = 8.f, F8_H_MUL = 4.f, F8_Y_MUL = 16.f; constexpr int F8_W_SC = 0x7A7A7A7A, F8_X_SC = 0x7C7C7C7C, F8_H_SC = 0x7D7D7D7D;

constexpr size_t MiB = 1u << 20;
constexpr size_t WS_CTL = 0, CTL_ZERO_BYTES = 64 * 1024;
constexpr size_t WS_TILEE = 512 * 1024;
constexpr size_t WS_WINT = 1 * MiB;
constexpr size_t WS_WOUT = 8 * MiB;
constexpr size_t WS_W1T = 10 * MiB;
constexpr size_t WS_W2T = 138 * MiB;
constexpr size_t WS_EIDX = 202 * MiB;
constexpr size_t WS_GATE = WS_EIDX + 512 * 1024;
constexpr size_t WS_POS = WS_GATE + 512 * 1024;
constexpr size_t WS_DEST = WS_POS + 512 * 1024;
constexpr size_t WS_ROWGATE = 204 * MiB;
constexpr size_t WS_XN = 206 * MiB;
constexpr size_t WS_P = 270 * MiB;
constexpr size_t WS_SR = 478 * MiB, WS_SK = 510 * MiB, WS_SV = 542 * MiB, WS_SA = 574 * MiB, WS_SB = 606 * MiB;
constexpr size_t WS_SW = 638 * MiB;
constexpr size_t WS_SG = 702 * MiB;
constexpr size_t WS_QN = 734 * MiB, WS_KN = 766 * MiB;
constexpr size_t WS_YMIX = 798 * MiB;
constexpr size_t WS_H2 = 206 * MiB;
constexpr size_t WS_ROWTOK = 270 * MiB;
constexpr size_t WS_HID = 406 * MiB;
constexpr size_t WS_YS = 542 * MiB;
constexpr size_t WS_YRAW = 862 * MiB;
constexpr size_t WS_X1B = 862 * MiB;
constexpr size_t WS_CG = 862 * MiB;
constexpr size_t WS_CH = 894 * MiB;
constexpr size_t WS_CR2 = 926 * MiB;
constexpr size_t WS_CY0 = 958 * MiB;
constexpr size_t WS_RK = 990 * MiB;
constexpr size_t WS_END = 992 * MiB;
constexpr int CW_CNT = 64;
constexpr int CW_ATTQ = 128;
constexpr int CW_BAR = 4096;

constexpr int RING_BYTES = 131072, MISC_OFF = RING_BYTES, LDS_BYTES = 147456;

__device__ __forceinline__ unsigned f2bf(float f) { unsigned u = __builtin_bit_cast(unsigned, f); return (u + 0x7fffu + ((u >> 16) & 1u)) >> 16; }
typedef __bf16 hwbf16x2 __attribute__((ext_vector_type(2)));
__device__ __forceinline__ unsigned pk2(float lo, float hi) { const f32x2 v = {lo, hi}; return __builtin_bit_cast(unsigned, __builtin_convertvector(v, hwbf16x2)); }
__device__ __forceinline__ unsigned pk4_fp8(float a, float b, float c, float d) {
    a = fminf(fmaxf(a, -448.f), 448.f); b = fminf(fmaxf(b, -448.f), 448.f); c = fminf(fmaxf(c, -448.f), 448.f); d = fminf(fmaxf(d, -448.f), 448.f);
    int r = __builtin_amdgcn_cvt_pk_fp8_f32(a, b, 0, false); r = __builtin_amdgcn_cvt_pk_fp8_f32(c, d, r, true); return (unsigned)r; }
__device__ __forceinline__ float bf2f(unsigned short b) { return __builtin_bit_cast(float, (unsigned)b << 16); }
__device__ __forceinline__ float bflo(unsigned w) { return __builtin_bit_cast(float, w << 16); }
__device__ __forceinline__ float bfhi(unsigned w) { return __builtin_bit_cast(float, w & 0xffff0000u); }
__device__ __forceinline__ float wave_sum(float v) {
#pragma unroll
    for (int o = 1; o < 64; o <<= 1) v += __shfl_xor(v, o);
    return v;
}
__device__ __forceinline__ float sigmoidf_(float x) { return 1.0f / (1.0f + __expf(-x)); }
template <int CTRL> __device__ __forceinline__ float dpp_f(float v) { return __builtin_bit_cast(float, __builtin_amdgcn_update_dpp(0, __builtin_bit_cast(int, v), CTRL, 0xF, 0xF, true)); }
__device__ __forceinline__ float red8(float v) {
    v += dpp_f<0xB1>(v);
    v += dpp_f<0x4E>(v);
    v += dpp_f<0x141>(v);
    return v;
}
__device__ __forceinline__ float red4(float v) { v += dpp_f<0xB1>(v); v += dpp_f<0x4E>(v); return v; }


#define XB_TMO      128
#define XB_XCNT(j)  (256  + 64 * (j))
#define XB_XSUB(j)  (1280 + 64 * (j))
#define XB_XGEN(j)  (2304 + 64 * (j))
#define XB_TOP      3328
#define XB_TOPGEN   3392
#define XCD_BAR_WORDS 3456
#define XB_SPIN_CAP (1u << 18)
__device__ __forceinline__ unsigned xb_ld(unsigned* p)              { return __hip_atomic_load(p, __ATOMIC_RELAXED, __HIP_MEMORY_SCOPE_AGENT); }
__device__ __forceinline__ unsigned xb_add(unsigned* p, unsigned v) { return __hip_atomic_fetch_add(p, v, __ATOMIC_RELAXED, __HIP_MEMORY_SCOPE_AGENT); }
__device__ __forceinline__ unsigned xb_xcc_id() { return (unsigned)__builtin_amdgcn_s_getreg((3 << 11) | 20) & 0xFu; }
#define XB_SPIN(cond, bar) do { unsigned _sp = 0; while (cond) { __builtin_amdgcn_s_sleep(1); \
    if ((++_sp & 255u) == 0u) { if (xb_ld(&(bar)[XB_TMO])) break; if (_sp > XB_SPIN_CAP) { atomicAdd(&(bar)[XB_TMO], 1u); break; } } } } while (0)
struct XcdBarrier { unsigned* bar; unsigned x; volatile LAS unsigned* st; };
__device__ __forceinline__ XcdBarrier xcd_barrier_post(unsigned* bar, volatile LAS unsigned* st) {
    XcdBarrier b; b.bar = bar; b.x = xb_xcc_id(); b.st = st;
    if (threadIdx.x == 0) (void)xb_add(&bar[XB_XCNT(b.x)], 1u);
    return b;
}
__device__ __forceinline__ void xcd_barrier_complete(unsigned* bar, unsigned x, unsigned& nloc, unsigned& nx) {
    const unsigned G = gridDim.x * gridDim.y * gridDim.z;
    unsigned sum, cnt, mine, sp = 0u;
    for (;;) {
        sum = 0u; cnt = 0u; mine = 0u;
#pragma unroll
        for (unsigned j = 0; j < 16; ++j) { const unsigned c = xb_ld(&bar[XB_XCNT(j)]); sum += c; cnt += (c > 0u) ? 1u : 0u; mine = (j == x) ? c : mine; }
        if (sum == G) break;
        __builtin_amdgcn_s_sleep(1);
        if ((++sp & 255u) == 0u) { if (xb_ld(&bar[XB_TMO])) break; if (sp > XB_SPIN_CAP) { atomicAdd(&bar[XB_TMO], 1u); break; } }
    }
    nloc = mine > 0u ? mine : 1u; nx = cnt > 0u ? cnt : 1u;
}
__device__ __forceinline__ void xcd_barrier(const XcdBarrier& b) {
    asm volatile("s_waitcnt vmcnt(0)" ::: "memory");
    __syncthreads();
    if (threadIdx.x == 0) {
        unsigned* bar = b.bar;
        __builtin_amdgcn_s_waitcnt(0);
        unsigned nloc = b.st[0], nx = b.st[1];
        if (nloc == 0u) { xcd_barrier_complete(bar, b.x, nloc, nx); b.st[0] = nloc; b.st[1] = nx; }
        const unsigned old = xb_add(&bar[XB_XSUB(b.x)], 1u);
        const unsigned gen = old / nloc;
        if (old + 1u == (gen + 1u) * nloc) {
            __builtin_amdgcn_fence(__ATOMIC_RELEASE, "agent");
            asm volatile("s_waitcnt vmcnt(0)" ::: "memory");
            const unsigned og = xb_add(&bar[XB_TOP], 1u);
            const unsigned tg = og / nx;
            if (og + 1u == (tg + 1u) * nx) xb_add(&bar[XB_TOPGEN], 1u);
            else XB_SPIN(xb_ld(&bar[XB_TOPGEN]) == tg, bar);
            __builtin_amdgcn_fence(__ATOMIC_ACQUIRE, "agent");
            xb_add(&bar[XB_XGEN(b.x)], 1u);
            asm volatile("s_waitcnt vmcnt(0)" ::: "memory");
        } else {
            XB_SPIN(xb_ld(&bar[XB_XGEN(b.x)]) == gen, bar);
            __builtin_amdgcn_fence(__ATOMIC_ACQUIRE, "agent");
            asm volatile("s_waitcnt vmcnt(0)" ::: "memory");
        }
    }
    __syncthreads();
}

namespace pg8 {
constexpr int BM = 256, BK = 64, HALF = 128, HTB = HALF * BK * 2, STAGE_BYTES = 8 * HTB, NXCD = 8, WGM = 8;
__host__ __device__ __forceinline__ int lds_byte(int r, int c) { const int st = (r >> 4) * 2 + (c >> 5), rr = r & 15, cc = c & 31, ob = rr * 64 + cc * 2; return st * 1024 + (ob ^ (((ob >> 9) & 1) << 5)); }
__host__ __device__ __forceinline__ void stage_rc(int b, int& R, int& C) { const int st = b / 1024, sb = b % 1024, swz = sb ^ (((sb >> 9) & 1) << 5); R = (st >> 1) * 16 + swz / 64; C = (st & 1) * 32 + (swz % 64) / 2; }
__host__ __device__ __forceinline__ int perm32(int rho) { const int n = rho >> 4, i = rho & 15; return 8 * (i >> 2) + 4 * n + (i & 3); }

struct Unit { int pm, pn, pb; };
struct Gemm { const void* A; const void* Bt; int K; int scW, scA; const int* rowtok; };

struct TileOrder {
    int nM, nN, nwg, G, c; const int* tile_e; int nb_per_e;
    __device__ void init(int nM_, int nN_, int G_, int c_, const int* te, int nbe) { nM = nM_; nN = nN_; nwg = nM * nN; G = G_; c = c_; tile_e = te; nb_per_e = nbe; }
    __device__ bool next(int i, Unit& u) const {
        const long L = (long)i * G + c; if (L >= nwg) return false;
        int wgid = (int)L; { const int q = nwg / NXCD, r = nwg % NXCD, xcd = wgid % NXCD, off = wgid / NXCD; wgid = (xcd < r ? xcd * (q + 1) : r * (q + 1) + (xcd - r) * q) + off; }
        const int nig = WGM * nN, gid = wgid / nig, fm = gid * WGM, gsz = (nM - fm) < WGM ? (nM - fm) : WGM;
        u.pm = fm + ((wgid % nig) % gsz); u.pn = (wgid % nig) / gsz;
        u.pb = tile_e ? tile_e[u.pm] * nb_per_e + u.pn : u.pn;
        return true;
    }
};

struct EpiBf16 {
    static constexpr bool PERM = true;
    bf16_t* O; int ldc;
    __device__ __forceinline__ void operator()(const f32x4 (&acc)[2][2][4][2], const Unit& u, int wr, int wc, int fr, int fq) const {
        const int row0 = u.pm * BM + wr * 64 + fr; const int col0 = u.pn * BM + wc * 32 + 8 * fq;
#pragma unroll
        for (int ai = 0; ai < 2; ++ai)
#pragma unroll
            for (int m = 0; m < 4; ++m) { bf16_t* rowp = O + (size_t)(row0 + ai * HALF + m * 16) * ldc + col0;
#pragma unroll
                for (int bj = 0; bj < 2; ++bj) { const f32x4 v0 = acc[ai][bj][m][0], v1 = acc[ai][bj][m][1];
                    u32x4 w; w.x = pk2(v0[0], v0[1]); w.y = pk2(v0[2], v0[3]); w.z = pk2(v1[0], v1[1]); w.w = pk2(v1[2], v1[3]);
                    *(u32x4*)(rowp + bj * HALF) = w; } }
    }
};
struct EpiResBf16 {
    static constexpr bool PERM = true;
    const float* base; bf16_t* out; int ldc;
    __device__ __forceinline__ void operator()(const f32x4 (&acc)[2][2][4][2], const Unit& u, int wr, int wc, int fr, int fq) const {
        const int col0 = u.pn * BM + wc * 32 + 8 * fq;
#pragma unroll
        for (int ai = 0; ai < 2; ++ai)
#pragma unroll
            for (int m = 0; m < 4; ++m) { const size_t off = (size_t)(u.pm * BM + ai * HALF + wr * 64 + m * 16 + fr) * ldc + col0;
#pragma unroll
                for (int bj = 0; bj < 2; ++bj) { const f32x4 b0 = *(const f32x4*)(base + off + bj * HALF), b1 = *(const f32x4*)(base + off + bj * HALF + 4);
                    const f32x4 v0 = b0 + acc[ai][bj][m][0], v1 = b1 + acc[ai][bj][m][1];
                    u32x4 w; w.x = pk2(v0[0], v0[1]); w.y = pk2(v0[2], v0[3]); w.z = pk2(v1[0], v1[1]); w.w = pk2(v1[2], v1[3]);
                    *(u32x4*)(out + off + bj * HALF) = w; } }
    }
};
struct EpiSwiglu {
    static constexpr bool PERM = true;
    unsigned char* O; const float* b1; const int* tile_e;
    __device__ __forceinline__ void operator()(const f32x4 (&acc)[2][2][4][2], const Unit& u, int wr, int wc, int fr, int fq) const {
        const int e = tile_e[u.pm]; const int row0 = u.pm * BM + wr * 64 + fr; const int hc0 = u.pn * 128 + wc * 32 + 8 * fq;
        const float* bg = b1 + (size_t)e * 2048 + hc0; const float* bl = bg + 1024;
        const f32x4 g0 = *(const f32x4*)bg, g1 = *(const f32x4*)(bg + 4), l0 = *(const f32x4*)bl, l1 = *(const f32x4*)(bl + 4);
#pragma unroll
        for (int ai = 0; ai < 2; ++ai)
#pragma unroll
            for (int m = 0; m < 4; ++m) { unsigned char* rowp = O + (size_t)(row0 + ai * HALF + m * 16) * 1024 + hc0;
                float o[8];
#pragma unroll
                for (int n = 0; n < 2; ++n) { const f32x4 gv = acc[ai][0][m][n] + (n ? g1 : g0), lv = acc[ai][1][m][n] + (n ? l1 : l0);
#pragma unroll
                    for (int i = 0; i < 4; ++i) { const float g = fminf(gv[i], 7.0f), l = fminf(fmaxf(lv[i], -7.0f), 7.0f);
                        const float sg = __builtin_amdgcn_rcpf(1.0f + __builtin_amdgcn_exp2f(-1.702f * LOG2E * g)); o[n * 4 + i] = g * sg * (l + 1.0f); } }
                u32x2 w; w.x = pk4_fp8(o[0] * F8_H_MUL, o[1] * F8_H_MUL, o[2] * F8_H_MUL, o[3] * F8_H_MUL); w.y = pk4_fp8(o[4] * F8_H_MUL, o[5] * F8_H_MUL, o[6] * F8_H_MUL, o[7] * F8_H_MUL);
                *(u32x2*)rowp = w; }
    }
};
struct EpiGateF8 {
    static constexpr bool PERM = true;
    unsigned char* O; const float* b2; const float* rowgate; const int* tile_e;
    __device__ __forceinline__ void operator()(const f32x4 (&acc)[2][2][4][2], const Unit& u, int wr, int wc, int fr, int fq) const {
        const int e = tile_e[u.pm]; const int row0 = u.pm * BM + wr * 64 + fr; const int col0 = u.pn * BM + wc * 32 + 8 * fq;
        f32x4 bv[2][2];
#pragma unroll
        for (int bj = 0; bj < 2; ++bj)
#pragma unroll
            for (int n = 0; n < 2; ++n) bv[bj][n] = *(const f32x4*)(b2 + (size_t)e * 1024 + col0 + bj * HALF + 4 * n);
#pragma unroll
        for (int ai = 0; ai < 2; ++ai)
#pragma unroll
            for (int m = 0; m < 4; ++m) { const int row = row0 + ai * HALF + m * 16; const float gt = rowgate[row] * F8_Y_MUL; unsigned char* rowp = O + (size_t)row * 1024 + col0;
#pragma unroll
                for (int bj = 0; bj < 2; ++bj) { const f32x4 v0 = (acc[ai][bj][m][0] + bv[bj][0]) * gt, v1 = (acc[ai][bj][m][1] + bv[bj][1]) * gt;
                    u32x2 w; w.x = pk4_fp8(v0[0], v0[1], v0[2], v0[3]); w.y = pk4_fp8(v1[0], v1[1], v1[2], v1[3]);
                    *(u32x2*)(rowp + bj * HALF) = w; } }
    }
};

template <bool F8, bool GATHER, class Epi, class Sched>
__device__ __forceinline__ void gemm_phase(LAS unsigned char* lds, const Gemm g, const Sched& S, const Epi& E) {
    const int tid = threadIdx.x, wid = __builtin_amdgcn_readfirstlane(tid >> 6), lane = tid & 63, wr = wid >> 2, wc = wid & 3, fr = lane & 15, fq = lane >> 4;
    const int RB = F8 ? g.K : g.K * 2, nt = RB / 128;
    unsigned voffB[2];
#pragma unroll
    for (int i = 0; i < 2; ++i) { int R, C; stage_rc(tid * 16 + i * 8192, R, C); const int Rb = Epi::PERM ? ((R & ~31) + perm32(R & 31)) : R;
        voffB[i] = (unsigned)(Rb * RB + C * 2); }
#define PG8_AOFFS(dst, pm_) do { _Pragma("unroll") for (int h_ = 0; h_ < 2; ++h_) _Pragma("unroll") for (int i_ = 0; i_ < 2; ++i_) { int R_, C_; stage_rc(tid * 16 + i_ * 8192, R_, C_); \
        const int row_ = (pm_) * BM + h_ * HALF + R_; const unsigned grow_ = GATHER ? (unsigned)g.rowtok[row_] : (unsigned)row_; dst[h_][i_] = grow_ * (unsigned)RB + (unsigned)(C_ * 2); } } while (0)
    unsigned cvA[2][2], nvA[2][2];
    const size_t kstep = (size_t)(BK * 2);
    const size_t hstep = (size_t)HALF * RB;
    const size_t tstep = 2 * hstep;
    const unsigned ldsw = (unsigned)wid * 1024u;
    const int aoff = F8 ? lds_byte(wr * 64 + fr, (fq & 1) * 16) + (fq >> 1) * 1024 : lds_byte(wr * 64 + fr, fq * 8);
    const int boff = F8 ? lds_byte(wc * 32 + fr, (fq & 1) * 16) + (fq >> 1) * 1024 : lds_byte(wc * 32 + fr, fq * 8);
    const int scW = g.scW, scA = g.scA;
#define PG8_SA(b, h) (((b) * 2 + (h)) * HTB)
#define PG8_SB(b, h) ((4 + (b) * 2 + (h)) * HTB)
#define PG8_STAGE(bufoff, gbase, voff) do { _Pragma("unroll") for (int _i = 0; _i < 2; ++_i) \
        __builtin_amdgcn_global_load_lds((const unsigned*)((const char*)(gbase) + (voff)[_i]), (LAS unsigned*)(lds + (bufoff) + ldsw + _i * 8192), 16, 0, 0); } while (0)
typedef int v8i32a __attribute__((ext_vector_type(8), aligned(16)));
#define PG8_LD32(p) (*(const LAS v8i32a*)(p))
#define PG8_STAGE_A(bufoff, kptr, offs) do { _Pragma("unroll") for (int _i = 0; _i < 2; ++_i) \
        __builtin_amdgcn_global_load_lds((const unsigned*)((const char*)(kptr) + (offs)[_i]), (LAS unsigned*)(lds + (bufoff) + ldsw + _i * 8192), 16, 0, 0); } while (0)
#define PG8_LDA(dst, b, h) do { _Pragma("unroll") for (int m = 0; m < 4; ++m) { if constexpr (F8) { dst[m].f8 = __builtin_bit_cast(v8i32, PG8_LD32(lds + PG8_SA(b, h) + aoff + m * 2048)); } \
        else { _Pragma("unroll") for (int k = 0; k < 2; ++k) dst[m].hv[k] = *(const LAS bf16x8*)(lds + PG8_SA(b, h) + aoff + m * 2048 + k * 1024); } } } while (0)
#define PG8_LDB(dst, b, h) do { _Pragma("unroll") for (int n = 0; n < 2; ++n) { if constexpr (F8) { dst[n].f8 = __builtin_bit_cast(v8i32, PG8_LD32(lds + PG8_SB(b, h) + boff + n * 2048)); } \
        else { _Pragma("unroll") for (int k = 0; k < 2; ++k) dst[n].hv[k] = *(const LAS bf16x8*)(lds + PG8_SB(b, h) + boff + n * 2048 + k * 1024); } } } while (0)
#define PG8_MMA(ai, bj, At, Bt) do { __builtin_amdgcn_s_setprio(1); _Pragma("unroll") for (int m = 0; m < 4; ++m) _Pragma("unroll") for (int n = 0; n < 2; ++n) { \
        if constexpr (F8) { asm volatile("v_mfma_scale_f32_16x16x128_f8f6f4 %0, %1, %2, %0, %3, %4 op_sel_hi:[0,0,0]" : "+v"(acc[ai][bj][m][n]) : "v"(Bt[n].f8), "v"(At[m].f8), "v"(scW), "v"(scA)); } \
        else { _Pragma("unroll") for (int k = 0; k < 2; ++k) acc[ai][bj][m][n] = __builtin_amdgcn_mfma_f32_16x16x32_bf16(Bt[n].hv[k], At[m].hv[k], acc[ai][bj][m][n], 0, 0, 0); } } \
        __builtin_amdgcn_s_setprio(0); } while (0)
#define PG8_WAIT_V(n) asm volatile("s_waitcnt vmcnt(" #n ")" ::: "memory")
#define PG8_WAIT_L(n) asm volatile("s_waitcnt lgkmcnt(" #n ")" ::: "memory")
#define PG8_BAR __builtin_amdgcn_s_barrier()
#define PG8_SCHED __builtin_amdgcn_sched_barrier(0)
    Unit cur, nxt; int ui = 0;
    if (!S.next(0, cur)) return;
    f32x4 acc[2][2][4][2];
#pragma unroll
    for (int a = 0; a < 2; ++a)
#pragma unroll
        for (int b = 0; b < 2; ++b)
#pragma unroll
            for (int m = 0; m < 4; ++m)
#pragma unroll
                for (int n = 0; n < 2; ++n) acc[a][b][m][n] = (f32x4){0.f, 0.f, 0.f, 0.f};
    struct FragH { bf16x8 hv[2]; }; struct Frag8 { v8i32 f8; };
    typename std::conditional<F8, Frag8, FragH>::type At[4], B0[2], B1[2];
    const char* const kA = (const char*)g.A; const char* cB = (const char*)g.Bt + (size_t)cur.pb * tstep;
    PG8_AOFFS(cvA, cur.pm);
    PG8_STAGE(PG8_SB(0, 0), cB, voffB); PG8_STAGE(PG8_SB(0, 1), cB + hstep, voffB); PG8_STAGE_A(PG8_SA(0, 0), kA, cvA[0]); PG8_STAGE_A(PG8_SA(0, 1), kA, cvA[1]);
    if (wr == 1) PG8_BAR;
    PG8_WAIT_V(2); PG8_BAR;
    PG8_STAGE(PG8_SB(1, 0), cB + kstep, voffB); PG8_STAGE_A(PG8_SA(1, 0), kA + kstep, cvA[0]); PG8_STAGE(PG8_SB(1, 1), cB + hstep + kstep, voffB);
    PG8_WAIT_V(6); PG8_BAR;
    for (;;) {
        const bool has_next = S.next(ui + 1, nxt);
        const char* nB = has_next ? (const char*)g.Bt + (size_t)nxt.pb * tstep : cB;
        if (has_next) { PG8_AOFFS(nvA, nxt.pm); } else { _Pragma("unroll") for (int h_ = 0; h_ < 2; ++h_) _Pragma("unroll") for (int i_ = 0; i_ < 2; ++i_) nvA[h_][i_] = cvA[h_][i_]; }
#pragma clang loop unroll(disable)
        for (int t = 0; t < nt; t += 2) {
            const bool last = (t == nt - 2);
            const char* a1 = kA + (size_t)(t + 1) * kstep;
            const char* a2 = last ? kA : kA + (size_t)(t + 2) * kstep; const char* b2 = last ? nB : cB + (size_t)(t + 2) * kstep;
            const char* a3 = a2 + kstep; const char* b3 = b2 + kstep;
            unsigned v2A[2][2];
#pragma unroll
            for (int h_ = 0; h_ < 2; ++h_)
#pragma unroll
                for (int i_ = 0; i_ < 2; ++i_) v2A[h_][i_] = last ? nvA[h_][i_] : cvA[h_][i_];
            PG8_LDB(B0, 0, 0); PG8_LDB(B1, 0, 1); PG8_SCHED; PG8_LDA(At, 0, 0); PG8_STAGE_A(PG8_SA(1, 1), a1, cvA[1]);
            PG8_WAIT_V(8); PG8_WAIT_L(0); PG8_BAR; PG8_MMA(0, 0, At, B0); PG8_MMA(0, 1, At, B1); PG8_BAR; PG8_SCHED;
            PG8_LDA(At, 0, 1); PG8_STAGE(PG8_SB(0, 0), b2, voffB); PG8_STAGE(PG8_SB(0, 1), b2 + hstep, voffB); PG8_STAGE_A(PG8_SA(0, 0), a2, v2A[0]);
            PG8_WAIT_V(8); PG8_WAIT_L(0); PG8_BAR; PG8_MMA(1, 0, At, B0); PG8_MMA(1, 1, At, B1); PG8_BAR; PG8_SCHED;
            PG8_LDB(B0, 1, 0); PG8_LDB(B1, 1, 1); PG8_SCHED; PG8_LDA(At, 1, 0); PG8_STAGE_A(PG8_SA(0, 1), a2, v2A[1]);
            PG8_WAIT_V(8); PG8_WAIT_L(0); PG8_BAR; PG8_MMA(0, 0, At, B0); PG8_MMA(0, 1, At, B1); PG8_BAR; PG8_SCHED;
            PG8_LDA(At, 1, 1); PG8_STAGE(PG8_SB(1, 0), b3, voffB); PG8_STAGE(PG8_SB(1, 1), b3 + hstep, voffB); PG8_STAGE_A(PG8_SA(1, 0), a3, v2A[0]);
            PG8_WAIT_V(8); PG8_WAIT_L(0); PG8_BAR; PG8_MMA(1, 0, At, B0); PG8_MMA(1, 1, At, B1); PG8_BAR; PG8_SCHED;
        }
        if (wr == 0) PG8_BAR;
        if constexpr (F8) asm volatile("s_nop 15\n\ts_nop 15" ::: "memory");
        E(acc, cur, wr, wc, fr, fq);
        if (!has_next) break;
#pragma unroll
        for (int a = 0; a < 2; ++a)
#pragma unroll
            for (int b = 0; b < 2; ++b)
#pragma unroll
                for (int m = 0; m < 4; ++m)
#pragma unroll
                    for (int n = 0; n < 2; ++n) acc[a][b][m][n] = (f32x4){0.f, 0.f, 0.f, 0.f};
        cur = nxt; cB = nB; ++ui;
#pragma unroll
        for (int h_ = 0; h_ < 2; ++h_)
#pragma unroll
            for (int i_ = 0; i_ < 2; ++i_) cvA[h_][i_] = nvA[h_][i_];
        if (wr == 1) PG8_BAR;
    }
    PG8_WAIT_V(0);
    PG8_BAR;
#undef PG8_SA
#undef PG8_SB
#undef PG8_STAGE
#undef PG8_STAGE_A
#undef PG8_AOFFS
#undef PG8_LDA
#undef PG8_LDB
#undef PG8_MMA
#undef PG8_LD32
#undef PG8_WAIT_V
#undef PG8_WAIT_L
#undef PG8_BAR
#undef PG8_SCHED
}
}

struct Args { const float* in[30]; float* out; unsigned char* ws; int ph_lo, ph_hi; };

__device__ __forceinline__ void p0_transpose_item(const float* W, int K, int N, bf16_t* WT, int k0, int n0, int drow0, LAS float* scr, int lane) {
#pragma unroll 8
    for (int i = 0; i < 32; ++i) { const int kk = 2 * i + (lane >> 5); scr[kk * 33 + (lane & 31)] = W[(size_t)(k0 + kk) * N + n0 + (lane & 31)]; }
    asm volatile("s_waitcnt lgkmcnt(0)" ::: "memory");
    const int c = lane & 7;
#pragma unroll
    for (int j = 0; j < 4; ++j) { const int n = (lane >> 3) + 8 * j; const LAS float* s = scr + (8 * c) * 33 + n;
        u32x4 o; o.x = pk2(s[0 * 33], s[1 * 33]); o.y = pk2(s[2 * 33], s[3 * 33]); o.z = pk2(s[4 * 33], s[5 * 33]); o.w = pk2(s[6 * 33], s[7 * 33]);
        *(u32x4*)(WT + (size_t)(drow0 + n) * K + k0 + 8 * c) = o; }
    asm volatile("s_waitcnt lgkmcnt(0)" ::: "memory");
}
__device__ __forceinline__ void p0_transpose_item_f8(const float* W, int K, int N, unsigned char* WT, int k0, int n0, int drow0, LAS float* scr, int lane) {
#pragma unroll 8
    for (int i = 0; i < 32; ++i) { const int kk = 2 * i + (lane >> 5); scr[kk * 33 + (lane & 31)] = W[(size_t)(k0 + kk) * N + n0 + (lane & 31)]; }
    asm volatile("s_waitcnt lgkmcnt(0)" ::: "memory");
    const int c = lane & 3;
#pragma unroll
    for (int j = 0; j < 2; ++j) { const int n = (lane >> 2) + 16 * j; const LAS float* s = scr + (16 * c) * 33 + n;
        u32x4 o;
        o.x = pk4_fp8(s[0 * 33] * F8_W_MUL, s[1 * 33] * F8_W_MUL, s[2 * 33] * F8_W_MUL, s[3 * 33] * F8_W_MUL);
        o.y = pk4_fp8(s[4 * 33] * F8_W_MUL, s[5 * 33] * F8_W_MUL, s[6 * 33] * F8_W_MUL, s[7 * 33] * F8_W_MUL);
        o.z = pk4_fp8(s[8 * 33] * F8_W_MUL, s[9 * 33] * F8_W_MUL, s[10 * 33] * F8_W_MUL, s[11 * 33] * F8_W_MUL);
        o.w = pk4_fp8(s[12 * 33] * F8_W_MUL, s[13 * 33] * F8_W_MUL, s[14 * 33] * F8_W_MUL, s[15 * 33] * F8_W_MUL);
        *(u32x4*)(WT + (size_t)(drow0 + n) * K + k0 + 16 * c) = o; }
    asm volatile("s_waitcnt lgkmcnt(0)" ::: "memory");
}
__device__ __forceinline__ void p0_prologue(LAS unsigned char* lds, const Args& a, int G) {
    const int tid = threadIdx.x, lane = tid & 63, wave = __builtin_amdgcn_readfirstlane(tid >> 6);
    LAS float* scr = (LAS float*)(lds + wave * 16384);
    const int gw = blockIdx.x * 8 + wave, NGW = G * 8;
    unsigned char* ws = a.ws;
    bf16_t* Wint = (bf16_t*)(ws + WS_WINT); bf16_t* Woutt = (bf16_t*)(ws + WS_WOUT); unsigned char* W1t = ws + WS_W1T; unsigned char* W2t = ws + WS_W2T;
    constexpr int I_IN = 16 * (NIN / 32);
    constexpr int I_OUT = 16 * 32;
    constexpr int I_W1 = 16 * 64;
    constexpr int I_W2 = 16 * 32;
    constexpr int NITEMS = I_IN + I_OUT + NE * I_W1 + NE * I_W2;
    for (int it = gw; it < NITEMS; it += NGW) {
        int r = it;
        if (r < I_IN) { const int nblk = NIN / 32, kb = r / nblk, nb = r % nblk; p0_transpose_item(a.in[2], 1024, NIN, Wint, 64 * kb, 32 * nb, 32 * nb, scr, lane); continue; } r -= I_IN;
        if (r < I_OUT) { const int kb = r / 32, nb = r % 32; p0_transpose_item(a.in[22], 1024, 1024, Woutt, 64 * kb, 32 * nb, 32 * nb, scr, lane); continue; } r -= I_OUT;
        if (r < NE * I_W1) { const int e = r / I_W1, q = r % I_W1, kb = q / 64, nb = q % 64; const int n0 = 32 * nb;
            const int drow = (n0 < 1024) ? ((n0 >> 7) * 256 + (n0 & 127)) : (((n0 - 1024) >> 7) * 256 + 128 + ((n0 - 1024) & 127));
            p0_transpose_item_f8(a.in[26] + (size_t)e * 1024 * 2048, 1024, 2048, W1t + (size_t)e * 2048 * 1024, 64 * kb, n0, drow, scr, lane); continue; } r -= NE * I_W1;
        { const int e = r / I_W2, q = r % I_W2, kb = q / 32, nb = q % 32;
            p0_transpose_item_f8(a.in[28] + (size_t)e * 1024 * 1024, 1024, 1024, W2t + (size_t)e * 1024 * 1024, 64 * kb, 32 * nb, 32 * nb, scr, lane); }
    }
    const float* x = a.in[0]; const float* g1 = a.in[1]; bf16_t* XN = (bf16_t*)(ws + WS_XN);
    f32x4 gv[4];
#pragma unroll
    for (int j = 0; j < 4; ++j) gv[j] = *((const f32x4*)g1 + lane + 64 * j);
    for (int m = gw; m < T; m += NGW) {
        const f32x4* xr = (const f32x4*)(x + (size_t)m * D) + lane;
        f32x4 v[4]; float s = 0.f;
#pragma unroll
        for (int j = 0; j < 4; ++j) { v[j] = xr[64 * j]; s += (v[j].x * v[j].x + v[j].y * v[j].y) + (v[j].z * v[j].z + v[j].w * v[j].w); }
        const float rstd = 1.0f / sqrtf(wave_sum(s) * (1.0f / D) + 1e-5f);
        u32x2* o8 = (u32x2*)(XN + (size_t)m * D) + lane;
#pragma unroll
        for (int j = 0; j < 4; ++j) { u32x2 w; w.x = pk2(v[j].x * rstd * gv[j].x, v[j].y * rstd * gv[j].y); w.y = pk2(v[j].z * rstd * gv[j].z, v[j].w * rstd * gv[j].w); o8[64 * j] = w; }
    }
}

__device__ __forceinline__ f32x4 cvlo(const u32x4 u) { return (f32x4){bflo(u.x), bfhi(u.x), bflo(u.y), bfhi(u.y)}; }
__device__ __forceinline__ f32x4 cvhi(const u32x4 u) { return (f32x4){bflo(u.z), bfhi(u.z), bflo(u.w), bfhi(u.w)}; }
__device__ __forceinline__ u32x4 pk8(const f32x4 lo, const f32x4 hi) { u32x4 w; w.x = pk2(lo.x, lo.y); w.y = pk2(lo.z, lo.w); w.z = pk2(hi.x, hi.y); w.w = pk2(hi.z, hi.w); return w; }
__device__ __forceinline__ void p2_prep(LAS unsigned char* lds, const Args& a) {
    const int tid = threadIdx.x, lane = tid & 63, wave = __builtin_amdgcn_readfirstlane(tid >> 6);
    unsigned char* ws = a.ws;
    const bf16_t* P = (const bf16_t*)(ws + WS_P);
    bf16_t* SR = (bf16_t*)(ws + WS_SR); bf16_t* SK = (bf16_t*)(ws + WS_SK); bf16_t* SV = (bf16_t*)(ws + WS_SV); bf16_t* SA = (bf16_t*)(ws + WS_SA); bf16_t* SB = (bf16_t*)(ws + WS_SB);
    float* SW = (float*)(ws + WS_SW); bf16_t* SG = (bf16_t*)(ws + WS_SG); bf16_t* QN = (bf16_t*)(ws + WS_QN); bf16_t* KN = (bf16_t*)(ws + WS_KN);
    const float* mu = a.in[3]; const float* w0 = a.in[4]; const float* w2 = a.in[5]; const float* a0 = a.in[6]; const float* a2 = a.in[7]; const float* g2 = a.in[8];
    const float* k_k = a.in[9]; const float* k_a = a.in[10]; const float* qn_g = a.in[14]; const float* kn_g = a.in[15];
    LAS unsigned char* ACT = lds;
    LAS float* DEC = (LAS float*)(lds + 8192); LAS float* ALR = (LAS float*)(lds + 40960); LAS float* GG = (LAS float*)(lds + 73728);
    bf16x8 bw[4][5];
    const int fcol = lane & 15, fk = (lane >> 4) * 8;
#pragma unroll
    for (int cb = 0; cb < 4; ++cb) {
        const int col = wave * 64 + cb * 16 + fcol;
#pragma unroll
        for (int kb = 0; kb < 5; ++kb) {
            const float* src = (kb == 0) ? (w2 + (size_t)fk * CW + col) : (kb == 1) ? (a2 + (size_t)fk * CW + col) : (g2 + (size_t)((kb - 2) * 32 + fk) * CW + col);
            u32x4 w; w.x = pk2(src[0], src[CW]); w.y = pk2(src[2 * CW], src[3 * CW]); w.z = pk2(src[4 * CW], src[5 * CW]); w.w = pk2(src[6 * CW], src[7 * CW]);
            bw[cb][kb] = __builtin_bit_cast(bf16x8, w);
        }
    }
    float w0c[4], a0c[4];
#pragma unroll
    for (int cb = 0; cb < 4; ++cb) { w0c[cb] = w0[wave * 64 + cb * 16 + fcol]; a0c[cb] = a0[wave * 64 + cb * 16 + fcol]; }
    const int c8 = lane * 8;
    const int TPB = T / (int)gridDim.x;
    const int tb0 = blockIdx.x * TPB;
    for (int t0 = tb0; t0 < tb0 + TPB; t0 += 16) {
        if (tid < 320) {
            const int tok = tid / 20, ch = tid - tok * 20, t = t0 + tok, col = 1536 + ch * 8;
            const u32x4 cu = *(const u32x4*)(P + (size_t)t * NINP + col);
            u32x4 pu = (u32x4){0u, 0u, 0u, 0u};
            if (t & (SEQ - 1)) pu = *(const u32x4*)(P + (size_t)(t - 1) * NINP + col);
            const f32x4 m0 = *(const f32x4*)(mu + col), m1 = *(const f32x4*)(mu + col + 4);
            const f32x4 c0 = cvlo(cu), c1 = cvhi(cu), p0 = cvlo(pu), p1 = cvhi(pu);
            f32x4 s0 = c0 + (p0 - c0) * m0, s1 = c1 + (p1 - c1) * m1;
            if (ch < 4) {
#pragma unroll
                for (int i = 0; i < 4; ++i) { const float e0 = __expf(-2.0f * fabsf(s0[i])), e1 = __expf(-2.0f * fabsf(s1[i])); const float th0 = (1.0f - e0) / (1.0f + e0), th1 = (1.0f - e1) / (1.0f + e1);
                    s0[i] = s0[i] < 0.f ? -th0 : th0; s1[i] = s1[i] < 0.f ? -th1 : th1; }
            } else if (ch >= 8) {
#pragma unroll
                for (int i = 0; i < 4; ++i) { s0[i] = sigmoidf_(s0[i]); s1[i] = sigmoidf_(s1[i]); }
            }
            *(LAS u32x4*)(ACT + tok * 320 + ch * 16) = pk8(s0, s1);
        }
        __syncthreads();
        {
            bf16x8 af[5];
#pragma unroll
            for (int kb = 0; kb < 5; ++kb) af[kb] = *(const LAS bf16x8*)(ACT + fcol * 320 + kb * 64 + (lane >> 4) * 16);
#pragma unroll
            for (int cb = 0; cb < 4; ++cb) {
                const f32x4 z = {0.f, 0.f, 0.f, 0.f};
                const f32x4 aw = __builtin_amdgcn_mfma_f32_16x16x32_bf16(af[0], bw[cb][0], z, 0, 0, 0);
                const f32x4 aa = __builtin_amdgcn_mfma_f32_16x16x32_bf16(af[1], bw[cb][1], z, 0, 0, 0);
                f32x4 ag = __builtin_amdgcn_mfma_f32_16x16x32_bf16(af[2], bw[cb][2], z, 0, 0, 0);
                ag = __builtin_amdgcn_mfma_f32_16x16x32_bf16(af[3], bw[cb][3], ag, 0, 0, 0);
                ag = __builtin_amdgcn_mfma_f32_16x16x32_bf16(af[4], bw[cb][4], ag, 0, 0, 0);
                const int col = wave * 64 + cb * 16 + fcol;
#pragma unroll
                for (int i = 0; i < 4; ++i) { const int row = (lane >> 4) * 4 + i;
                    DEC[row * 512 + col] = __expf(-0.6065306597126334f * sigmoidf_(aw[i] + w0c[cb]));
                    ALR[row * 512 + col] = sigmoidf_(aa[i] + a0c[cb]);
                    GG[row * 512 + col] = ag[i]; }
            }
        }
        __syncthreads();
#pragma unroll 1
        for (int q = 0; q < 2; ++q) {
            const int tok = 2 * wave + q, t = t0 + tok; const size_t o = (size_t)t * CW + c8;
            const bf16_t* pr = P + (size_t)t * NINP + c8;
            const bool first = (t & (SEQ - 1)) == 0;
            const u32x4 zz = (u32x4){0u, 0u, 0u, 0u};
            f32x4 rr0, rr1;
            { const u32x4 cu = *(const u32x4*)(pr), pu = first ? zz : *(const u32x4*)(pr - NINP);
              const f32x4 m0 = *(const f32x4*)(mu + c8), m1 = *(const f32x4*)(mu + c8 + 4);
              const f32x4 c0 = cvlo(cu), c1 = cvhi(cu), p0 = cvlo(pu), p1 = cvhi(pu);
              rr0 = c0 + (p0 - c0) * m0; rr1 = c1 + (p1 - c1) * m1; *(u32x4*)(SR + o) = pk8(rr0, rr1); }
            { const u32x4 cu = *(const u32x4*)(pr + 1024), pu = first ? zz : *(const u32x4*)(pr - NINP + 1024);
              const f32x4 m0 = *(const f32x4*)(mu + 1024 + c8), m1 = *(const f32x4*)(mu + 1024 + c8 + 4);
              const f32x4 c0 = cvlo(cu), c1 = cvhi(cu), p0 = cvlo(pu), p1 = cvhi(pu);
              *(u32x4*)(SV + o) = pk8(c0 + (p0 - c0) * m0, c1 + (p1 - c1) * m1); }
            { const u32x4 cu = *(const u32x4*)(pr + 512), pu = first ? zz : *(const u32x4*)(pr - NINP + 512);
              const f32x4 m0 = *(const f32x4*)(mu + 512 + c8), m1 = *(const f32x4*)(mu + 512 + c8 + 4);
              const f32x4 c0 = cvlo(cu), c1 = cvhi(cu), p0 = cvlo(pu), p1 = cvhi(pu);
              const f32x4 k0 = c0 + (p0 - c0) * m0, k1 = c1 + (p1 - c1) * m1;
              const f32x4 kk0 = k0 * *(const f32x4*)(k_k + c8), kk1 = k1 * *(const f32x4*)(k_k + c8 + 4);
              float ss = (kk0.x * kk0.x + kk0.y * kk0.y) + (kk0.z * kk0.z + kk0.w * kk0.w) + (kk1.x * kk1.x + kk1.y * kk1.y) + (kk1.z * kk1.z + kk1.w * kk1.w);
              ss = red8(ss);
              const float inv = 1.0f / sqrtf(fmaxf(ss, 1e-24f));
              const f32x4 kn0 = kk0 * inv, kn1 = kk1 * inv;
              const f32x4 al0 = *(const LAS f32x4*)(ALR + tok * 512 + c8), al1 = *(const LAS f32x4*)(ALR + tok * 512 + c8 + 4);
              const f32x4 k20 = k0 * (1.0f + (al0 - 1.0f) * *(const f32x4*)(k_a + c8)), k21 = k1 * (1.0f + (al1 - 1.0f) * *(const f32x4*)(k_a + c8 + 4));
              *(u32x4*)(SK + o) = pk8(k20, k21); *(u32x4*)(SA + o) = pk8(-kn0, -kn1); *(u32x4*)(SB + o) = pk8(kn0 * al0, kn1 * al1);
              const f32x4 q0 = rr0 * k20 * *(const f32x4*)(a.in[11] + c8), q1 = rr1 * k21 * *(const f32x4*)(a.in[11] + c8 + 4);
              const float rk = red8((q0.x + q0.y) + (q0.z + q0.w) + (q1.x + q1.y) + (q1.z + q1.w));
              if ((lane & 7) == 0) ((float*)(ws + WS_RK))[(size_t)t * 8 + (lane >> 3)] = rk; }
            { const f32x4 de0 = *(const LAS f32x4*)(DEC + tok * 512 + c8), de1 = *(const LAS f32x4*)(DEC + tok * 512 + c8 + 4);
              const f32x4 gg0 = *(const LAS f32x4*)(GG + tok * 512 + c8), gg1 = *(const LAS f32x4*)(GG + tok * 512 + c8 + 4);
              *(u32x4*)(SG + o) = pk8(gg0, gg1); *(f32x4*)(SW + o) = de0; *(f32x4*)(SW + o + 4) = de1; }
            { const u32x4 uq = *(const u32x4*)(pr + DQ0), ukd = *(const u32x4*)(pr + DK0);
              const f32x4 q0 = cvlo(uq), q1 = cvhi(uq), d0 = cvlo(ukd), d1 = cvhi(ukd);
              float qs = (q0.x * q0.x + q0.y * q0.y) + (q0.z * q0.z + q0.w * q0.w) + (q1.x * q1.x + q1.y * q1.y) + (q1.z * q1.z + q1.w * q1.w);
              float ks = (d0.x * d0.x + d0.y * d0.y) + (d0.z * d0.z + d0.w * d0.w) + (d1.x * d1.x + d1.y * d1.y) + (d1.z * d1.z + d1.w * d1.w);
              qs = red8(qs); ks = red8(ks);
              const float qi = (1.0f / sqrtf(qs * (1.0f / 64.0f) + 1e-5f)) * (0.125f * LOG2E), ki = 1.0f / sqrtf(ks * (1.0f / 64.0f) + 1e-5f);
              const f32x4 g0 = *(const f32x4*)(qn_g + (c8 & 63)), g1 = *(const f32x4*)(qn_g + (c8 & 63) + 4), h0 = *(const f32x4*)(kn_g + (c8 & 63)), h1 = *(const f32x4*)(kn_g + (c8 & 63) + 4);
              *(u32x4*)(QN + o) = pk8(q0 * qi * g0, q1 * qi * g1);
              *(u32x4*)(KN + o) = pk8(d0 * ki * h0, d1 * ki * h1); }
        }
        __syncthreads();
    }
}

namespace ck {
constexpr int PS = 136;
constexpr int O_BT = 0, O_KT = 8704, O_AP = 17408, O_RT = 26112;
constexpr int O_AT = 34816, O_BH = 43008, O_KH = 51200, O_VV = 59392, O_TN = 67584, O_A2 = 75776, O_V2 = 83968;
constexpr int O_L = 92160, LSTR = 68;
constexpr int O_TOT = 109568, O_GC = 111616;
__device__ __forceinline__ int crow(int r, int hi) { return (r & 3) + 8 * (r >> 2) + 4 * hi; }
__device__ __forceinline__ int voff(int row, int col) { return ((col >> 5) * 4 + (row >> 4)) * 1024 + (row & 15) * 64 + (col & 31) * 2; }
__device__ __forceinline__ s16x4 vtr(const LAS unsigned char* p) { return __builtin_bit_cast(s16x4, __builtin_amdgcn_ds_read_tr16_b64_v4i16((LAS s16x4*)p)); }
__device__ __forceinline__ bf16x8 fragP(const LAS unsigned char* M, int row, int k0, int hi) {
    const LAS unsigned char* p = M + row * PS + (k0 + 4 * hi) * 2; const s16x4 lo = *(const LAS s16x4*)p, h = *(const LAS s16x4*)(p + 16);
    return (bf16x8){lo[0], lo[1], lo[2], lo[3], h[0], h[1], h[2], h[3]}; }
__device__ __forceinline__ bf16x8 fragT(const LAS unsigned char* M, int k0, int colblk, int lane, int hi) {
    const LAS unsigned char* p = M + (colblk * 4 + (k0 >> 4)) * 1024 + ((lane >> 4) & 1) * 32 + (lane & 3) * 8 + (4 * hi + ((lane & 15) >> 2)) * 64;
    const s16x4 lo = vtr(p), h = vtr(p + 512); return (bf16x8){lo[0], lo[1], lo[2], lo[3], h[0], h[1], h[2], h[3]}; }
__device__ __forceinline__ bf16x8 packR(const f32x16& x, int s) {
    u32x4 w; w.x = pk2(x[8 * s], x[8 * s + 1]); w.y = pk2(x[8 * s + 2], x[8 * s + 3]); w.z = pk2(x[8 * s + 4], x[8 * s + 5]); w.w = pk2(x[8 * s + 6], x[8 * s + 7]); return __builtin_bit_cast(bf16x8, w); }
#define CK_MFMA(a, b, c) __builtin_amdgcn_mfma_f32_32x32x16_bf16(a, b, c, 0, 0, 0)
__device__ __forceinline__ f32x16 score(const LAS unsigned char* Am, const LAS unsigned char* Bm, int sblk, int tblk, int mode, int r32, int hi) {
    f32x16 x = f32x16{};
#pragma unroll
    for (int ks = 0; ks < 4; ++ks) x = CK_MFMA(fragP(Am, sblk * 32 + r32, 16 * ks, hi), fragP(Bm, tblk * 32 + r32, 16 * ks, hi), x);
    if (mode) {
        const int t = tblk * 32 + r32;
#pragma unroll
        for (int r = 0; r < 16; ++r) { const int s = sblk * 32 + crow(r, hi); if (mode == 1 ? !(s < t) : !(s <= t)) x[r] = 0.f; }
    }
    return x;
}
__device__ __forceinline__ void storeT_V(LAS unsigned char* M, const f32x16& x, int rb, int c, int hi) {
#pragma unroll
    for (int q = 0; q < 4; ++q) { u32x2 w; w.x = pk2(x[4 * q], x[4 * q + 1]); w.y = pk2(x[4 * q + 2], x[4 * q + 3]); *(LAS u32x2*)(M + voff(c, rb * 32 + 8 * q + 4 * hi)) = w; }
}
__device__ __forceinline__ void storeT_S(LAS unsigned char* M, const f32x16& x, int rb, int c, int hi) {
#pragma unroll
    for (int q = 0; q < 4; ++q) { u32x2 w; w.x = pk2(x[4 * q], x[4 * q + 1]); w.y = pk2(x[4 * q + 2], x[4 * q + 3]); *(LAS u32x2*)(M + c * PS + (rb * 32 + 8 * q + 4 * hi) * 2) = w; }
}

__device__ __forceinline__ void chunk_item(LAS unsigned char* lds, const Args& a, int item) {
    const int tid = threadIdx.x; int lane = tid & 63; const int wave = __builtin_amdgcn_readfirstlane(tid >> 6);
#define CK_FRESH() asm volatile("" : "+v"(lane)); r32 = lane & 31; hi = lane >> 5
    int r32, hi; CK_FRESH();
    unsigned char* ws = a.ws;
    const bf16_t* SR = (const bf16_t*)(ws + WS_SR); const bf16_t* SK = (const bf16_t*)(ws + WS_SK); const bf16_t* SV = (const bf16_t*)(ws + WS_SV);
    const bf16_t* SA = (const bf16_t*)(ws + WS_SA); const bf16_t* SB = (const bf16_t*)(ws + WS_SB); const float* SW = (const float*)(ws + WS_SW);
    bf16_t* CG = (bf16_t*)(ws + WS_CG) + (size_t)item * 4096; bf16_t* CH = (bf16_t*)(ws + WS_CH) + (size_t)item * 4096;
    bf16_t* CR2 = (bf16_t*)(ws + WS_CR2) + (size_t)item * 4096; bf16_t* CY0 = (bf16_t*)(ws + WS_CY0) + (size_t)item * 4096;
    const int bh = item >> 6, c = item & 63, b = bh >> 3, h = bh & 7, tokc = b * SEQ + c * 64, col0 = h * 64;
    LAS unsigned char* BT = lds + O_BT; LAS unsigned char* KT = lds + O_KT; LAS unsigned char* AP = lds + O_AP; LAS unsigned char* RT = lds + O_RT;
    LAS unsigned char* AT = lds + O_AT; LAS unsigned char* BH = lds + O_BH; LAS unsigned char* KH = lds + O_KH; LAS unsigned char* VV = lds + O_VV;
    LAS unsigned char* TN = lds + O_TN; LAS unsigned char* A2M = lds + O_A2; LAS unsigned char* V2M = lds + O_V2;
    LAS float* L = (LAS float*)(lds + O_L); LAS float* TOT = (LAS float*)(lds + O_TOT); LAS float* GC = (LAS float*)(lds + O_GC);
    {
        const int tl = tid >> 3, c8 = (tid & 7) * 8; const size_t o = (size_t)(tokc + tl) * CW + col0 + c8;
        const f32x4 w0 = *(const f32x4*)(SW + o), w1 = *(const f32x4*)(SW + o + 4);
        const u32x4 ua = *(const u32x4*)(SA + o), ub = *(const u32x4*)(SB + o), uk = *(const u32x4*)(SK + o), ur = *(const u32x4*)(SR + o), uv = *(const u32x4*)(SV + o);
        float p[8] = {w0.x, w0.y, w0.z, w0.w, w1.x, w1.y, w1.z, w1.w}, wv[8];
#pragma unroll
        for (int j = 0; j < 8; ++j) wv[j] = p[j];
#pragma unroll
        for (int d = 8; d < 64; d <<= 1) {
#pragma unroll
            for (int j = 0; j < 8; ++j) { const float q = __shfl_up(p[j], d); if (lane >= d) p[j] *= q; }
        }
        if ((lane >> 3) == 7) { *(LAS f32x4*)(TOT + wave * 64 + c8) = (f32x4){p[0], p[1], p[2], p[3]}; *(LAS f32x4*)(TOT + wave * 64 + c8 + 4) = (f32x4){p[4], p[5], p[6], p[7]}; }
        __syncthreads();
        float pre[8], gC[8];
#pragma unroll
        for (int j = 0; j < 8; ++j) { pre[j] = 1.f; gC[j] = 1.f; }
#pragma unroll
        for (int w2 = 0; w2 < 8; ++w2) { const f32x4 t0 = *(const LAS f32x4*)(TOT + w2 * 64 + c8), t1 = *(const LAS f32x4*)(TOT + w2 * 64 + c8 + 4);
            const float tv[8] = {t0.x, t0.y, t0.z, t0.w, t1.x, t1.y, t1.z, t1.w};
#pragma unroll
            for (int j = 0; j < 8; ++j) { if (w2 < wave) pre[j] *= tv[j]; gC[j] *= tv[j]; } }
        if (tid < 8) { *(LAS f32x4*)(GC + c8) = (f32x4){gC[0], gC[1], gC[2], gC[3]}; *(LAS f32x4*)(GC + c8 + 4) = (f32x4){gC[4], gC[5], gC[6], gC[7]}; }
        const f32x4 a0 = cvlo(ua), a1 = cvhi(ua), b0 = cvlo(ub), b1 = cvhi(ub), k0 = cvlo(uk), k1 = cvhi(uk), r0 = cvlo(ur), r1 = cvhi(ur);
        const float av[8] = {a0.x, a0.y, a0.z, a0.w, a1.x, a1.y, a1.z, a1.w}, bv[8] = {b0.x, b0.y, b0.z, b0.w, b1.x, b1.y, b1.z, b1.w};
        const float kv[8] = {k0.x, k0.y, k0.z, k0.w, k1.x, k1.y, k1.z, k1.w}, rv[8] = {r0.x, r0.y, r0.z, r0.w, r1.x, r1.y, r1.z, r1.w};
        float at[8], rt[8], bt[8], kt[8], bh[8], kh[8];
#pragma unroll
        for (int j = 0; j < 8; ++j) { const float g = pre[j] * p[j], ig = __builtin_amdgcn_rcpf(g), gp = g * __builtin_amdgcn_rcpf(wv[j]);
            at[j] = av[j] * gp; rt[j] = rv[j] * g; bt[j] = bv[j] * ig; kt[j] = kv[j] * ig; bh[j] = bt[j] * gC[j]; kh[j] = kt[j] * gC[j]; }
#define CK_PK8(v) ((u32x4){pk2(v[0], v[1]), pk2(v[2], v[3]), pk2(v[4], v[5]), pk2(v[6], v[7])})
#define CK_ST_P(M, val_) do { LAS unsigned char* d_ = (M) + tl * PS + c8 * 2; const u32x4 q_ = (val_); *(LAS u32x2*)d_ = (u32x2){q_[0], q_[1]}; *(LAS u32x2*)(d_ + 8) = (u32x2){q_[2], q_[3]}; } while (0)
        const u32x4 wa = CK_PK8(at), wr = CK_PK8(rt), wb = CK_PK8(bt), wk = CK_PK8(kt), wbh = CK_PK8(bh), wkh = CK_PK8(kh);
        CK_ST_P(AP, wa); CK_ST_P(RT, wr); CK_ST_P(BT, wb); CK_ST_P(KT, wk);
        *(LAS u32x4*)(AT + voff(tl, c8)) = wa; *(LAS u32x4*)(BH + voff(tl, c8)) = wbh; *(LAS u32x4*)(KH + voff(tl, c8)) = wkh; *(LAS u32x4*)(VV + voff(tl, c8)) = uv;
#undef CK_PK8
#undef CK_ST_P
    }
    __syncthreads();
    CK_FRESH();
    f32x16 pa = f32x16{}, pb = f32x16{}, pc = f32x16{}, pd = f32x16{};
#define w1a pa
#define w1b pb
#define xb0 pa
#define xb1 pb
#define y0a pc
#define y0b pd
    if (wave < 2) {
        for (int k = 0; k < (wave == 0 ? 2 : 1); ++k) {
            const int sblk = wave == 0 ? k : 0, tblk = wave == 0 ? k : 1;
            const f32x16 x = score(BT, AP, sblk, tblk, wave == 0 ? 1 : 0, r32, hi);
            const int t = tblk * 32 + r32;
#pragma unroll
            for (int r = 0; r < 16; ++r) L[(sblk * 32 + crow(r, hi)) * LSTR + t] = x[r];
        }
    }
    __syncthreads();
    CK_FRESH();
    if (wave == 6) {
        float x[32];
#pragma unroll
        for (int t = 0; t < 32; ++t) x[t] = (r32 == t) ? 1.f : 0.f;
        const LAS float* Nr = L + (32 * hi) * LSTR + 32 * hi;
#pragma unroll
        for (int sidx = 0; sidx < 31; ++sidx) {
#pragma unroll
            for (int g4 = (sidx + 1) / 4; g4 < 8; ++g4) {
                const f32x4 nv = *(const LAS f32x4*)(Nr + sidx * LSTR + 4 * g4);
                if (4 * g4 + 0 > sidx) x[4 * g4 + 0] += nv.x * x[sidx];
                if (4 * g4 + 1 > sidx) x[4 * g4 + 1] += nv.y * x[sidx];
                if (4 * g4 + 2 > sidx) x[4 * g4 + 2] += nv.z * x[sidx];
                if (4 * g4 + 3 > sidx) x[4 * g4 + 3] += nv.w * x[sidx];
            }
            if ((sidx & 3) == 3) __builtin_amdgcn_sched_barrier(0);
        }
        const int cc = 32 * hi + r32;
#pragma unroll
        for (int t0 = 0; t0 < 32; t0 += 8) { u32x4 w; w.x = pk2(x[t0], x[t0 + 1]); w.y = pk2(x[t0 + 2], x[t0 + 3]); w.z = pk2(x[t0 + 4], x[t0 + 5]); w.w = pk2(x[t0 + 6], x[t0 + 7]);
            *(LAS u32x4*)(TN + voff(cc, 32 * hi + t0)) = w; }
        f32x16 m = f32x16{};
#pragma unroll
        for (int s = 0; s < 2; ++s) {
            const LAS float* lp = L + (16 * s + 4 * hi) * LSTR + 32 + r32;
            u32x4 aw; aw.x = pk2(lp[0], lp[LSTR]); aw.y = pk2(lp[2 * LSTR], lp[3 * LSTR]); aw.z = pk2(lp[8 * LSTR], lp[9 * LSTR]); aw.w = pk2(lp[10 * LSTR], lp[11 * LSTR]);
            const s16x4 b0 = *(const LAS s16x4*)(TN + voff(r32, 16 * s + 4 * hi)), b1 = *(const LAS s16x4*)(TN + voff(r32, 16 * s + 8 + 4 * hi));
            m = CK_MFMA(__builtin_bit_cast(bf16x8, aw), ((bf16x8){b0[0], b0[1], b0[2], b0[3], b1[0], b1[1], b1[2], b1[3]}), m);
        }
        f32x16 t21 = f32x16{};
#pragma unroll
        for (int s = 0; s < 2; ++s) t21 = CK_MFMA(fragT(TN, 32 + 16 * s, 1, lane, hi), packR(m, s), t21);
        storeT_V(TN, t21, 1, r32, hi);
    } else if (wave < 4) {
        const int dvb = wave - 2;
        const f32x16 x00 = score(KT, AP, 0, 0, 1, r32, hi), x01 = score(KT, AP, 0, 1, 0, r32, hi), x11 = score(KT, AP, 1, 1, 1, r32, hi);
#pragma unroll
        for (int s = 0; s < 2; ++s) {
            const bf16x8 v0 = fragT(VV, 16 * s, dvb, lane, hi), v1 = fragT(VV, 32 + 16 * s, dvb, lane, hi);
            w1a = CK_MFMA(packR(x00, s), v0, w1a);
            w1b = CK_MFMA(packR(x01, s), v0, w1b);
            w1b = CK_MFMA(packR(x11, s), v1, w1b);
        }
    } else if (wave < 6) {
        const int tb = wave - 4;
        f32x16 xk0, xk1 = f32x16{};
        if (tb == 0) { xk0 = score(KT, RT, 0, 0, 2, r32, hi); xb0 = score(BT, RT, 0, 0, 2, r32, hi); }
        else { xk0 = score(KT, RT, 0, 1, 0, r32, hi); xk1 = score(KT, RT, 1, 1, 2, r32, hi); xb0 = score(BT, RT, 0, 1, 0, r32, hi); xb1 = score(BT, RT, 1, 1, 2, r32, hi); }
#pragma unroll
        for (int s = 0; s < 2; ++s) {
            y0a = CK_MFMA(fragT(VV, 16 * s, 0, lane, hi), packR(xk0, s), y0a);
            y0b = CK_MFMA(fragT(VV, 16 * s, 1, lane, hi), packR(xk0, s), y0b);
            if (tb == 1) { y0a = CK_MFMA(fragT(VV, 32 + 16 * s, 0, lane, hi), packR(xk1, s), y0a); y0b = CK_MFMA(fragT(VV, 32 + 16 * s, 1, lane, hi), packR(xk1, s), y0b); }
        }
    }
    __syncthreads();
    CK_FRESH();
    if (wave < 2) {
        const int cb = wave; f32x16 a0 = f32x16{}, a1 = f32x16{};
#pragma unroll
        for (int ks = 0; ks < 4; ++ks) {
            const bf16x8 af = fragT(AT, 16 * ks, cb, lane, hi);
            if (ks < 2) a0 = CK_MFMA(af, fragT(TN, 16 * ks, 0, lane, hi), a0);
            a1 = CK_MFMA(af, fragT(TN, 16 * ks, 1, lane, hi), a1);
        }
        storeT_V(A2M, a0, cb, r32, hi); storeT_V(A2M, a1, cb, 32 + r32, hi);
    } else if (wave < 4) {
        const int dvb = wave - 2; f32x16 v0 = f32x16{}, v1 = f32x16{};
#pragma unroll
        for (int s = 0; s < 2; ++s) {
            v0 = CK_MFMA(packR(w1a, s), fragT(TN, 16 * s, 0, lane, hi), v0);
            v1 = CK_MFMA(packR(w1a, s), fragT(TN, 16 * s, 1, lane, hi), v1);
            v1 = CK_MFMA(packR(w1b, s), fragT(TN, 32 + 16 * s, 1, lane, hi), v1);
        }
        storeT_V(V2M, v0, dvb, r32, hi); storeT_V(V2M, v1, dvb, 32 + r32, hi);
    }
    __syncthreads();
    CK_FRESH();
    if (wave >= 4 && wave < 6) {
        const int tb = wave - 4, t = tb * 32 + r32;
        f32x16 r0 = f32x16{}, r1 = f32x16{};
#pragma unroll
        for (int s = 0; s < 2; ++s) {
            const bf16x8 p0 = packR(xb0, s);
            r0 = CK_MFMA(fragT(A2M, 16 * s, 0, lane, hi), p0, r0); r1 = CK_MFMA(fragT(A2M, 16 * s, 1, lane, hi), p0, r1);
            y0a = CK_MFMA(fragT(V2M, 16 * s, 0, lane, hi), p0, y0a); y0b = CK_MFMA(fragT(V2M, 16 * s, 1, lane, hi), p0, y0b);
            if (tb == 1) { const bf16x8 p1 = packR(xb1, s);
                r0 = CK_MFMA(fragT(A2M, 32 + 16 * s, 0, lane, hi), p1, r0); r1 = CK_MFMA(fragT(A2M, 32 + 16 * s, 1, lane, hi), p1, r1);
                y0a = CK_MFMA(fragT(V2M, 32 + 16 * s, 0, lane, hi), p1, y0a); y0b = CK_MFMA(fragT(V2M, 32 + 16 * s, 1, lane, hi), p1, y0b); }
        }
#pragma unroll
        for (int q = 0; q < 4; ++q) {
            const u32x2 u0 = *(const LAS u32x2*)(RT + t * PS + (8 * q + 4 * hi) * 2), u1 = *(const LAS u32x2*)(RT + t * PS + (32 + 8 * q + 4 * hi) * 2);
            r0[4 * q] += bflo(u0.x); r0[4 * q + 1] += bfhi(u0.x); r0[4 * q + 2] += bflo(u0.y); r0[4 * q + 3] += bfhi(u0.y);
            r1[4 * q] += bflo(u1.x); r1[4 * q + 1] += bfhi(u1.x); r1[4 * q + 2] += bflo(u1.y); r1[4 * q + 3] += bfhi(u1.y);
        }
        storeT_S(BT, r0, 0, t, hi); storeT_S(BT, r1, 1, t, hi);
        storeT_S(KT, y0a, 0, t, hi); storeT_S(KT, y0b, 1, t, hi);
    } else if (wave < 2) {
        const int ib = wave, i = ib * 32 + r32; const float gci = GC[i];
        f32x16 g0 = f32x16{}, g1 = f32x16{};
#pragma unroll
        for (int ks = 0; ks < 4; ++ks) { const bf16x8 bf_ = fragT(BH, 16 * ks, ib, lane, hi);
            g0 = CK_MFMA(fragT(A2M, 16 * ks, 0, lane, hi), bf_, g0); g1 = CK_MFMA(fragT(A2M, 16 * ks, 1, lane, hi), bf_, g1); }
#pragma unroll
        for (int r = 0; r < 16; ++r) { if (crow(r, hi) == i) g0[r] += gci; if (32 + crow(r, hi) == i) g1[r] += gci; }
        storeT_S(AP, g0, 0, i, hi); storeT_S(AP, g1, 1, i, hi);
    } else {
        const int id = wave < 4 ? wave - 2 : wave - 4, ib = id >> 1, dvb = id & 1;
        f32x16 hh = f32x16{};
#pragma unroll
        for (int ks = 0; ks < 4; ++ks) {
            hh = CK_MFMA(fragT(BH, 16 * ks, ib, lane, hi), fragT(V2M, 16 * ks, dvb, lane, hi), hh);
            hh = CK_MFMA(fragT(KH, 16 * ks, ib, lane, hi), fragT(VV, 16 * ks, dvb, lane, hi), hh);
        }
        storeT_S((LAS unsigned char*)L, hh, ib, dvb * 32 + r32, hi);
    }
    __syncthreads();
    {
        const int row = tid >> 3, ch = tid & 7;
        const LAS unsigned char* s0 = BT + row * PS + ch * 16; const LAS unsigned char* s1 = KT + row * PS + ch * 16; const LAS unsigned char* s2 = AP + row * PS + ch * 16; const LAS unsigned char* s3 = (const LAS unsigned char*)L + row * PS + ch * 16;
        const u32x2 a0 = *(const LAS u32x2*)s0, a1 = *(const LAS u32x2*)(s0 + 8), b0 = *(const LAS u32x2*)s1, b1 = *(const LAS u32x2*)(s1 + 8);
        const u32x2 c0 = *(const LAS u32x2*)s2, c1 = *(const LAS u32x2*)(s2 + 8), d0 = *(const LAS u32x2*)s3, d1 = *(const LAS u32x2*)(s3 + 8);
        *(u32x4*)(CR2 + row * 64 + ch * 8) = (u32x4){a0.x, a0.y, a1.x, a1.y}; *(u32x4*)(CY0 + row * 64 + ch * 8) = (u32x4){b0.x, b0.y, b1.x, b1.y};
        *(u32x4*)(CG + row * 64 + ch * 8) = (u32x4){c0.x, c0.y, c1.x, c1.y}; *(u32x4*)(CH + row * 64 + ch * 8) = (u32x4){d0.x, d0.y, d1.x, d1.y};
    }
    asm volatile("s_waitcnt lgkmcnt(0)" ::: "memory"); __builtin_amdgcn_s_barrier();
#undef CK_FRESH
#undef w1a
#undef w1b
#undef xb0
#undef xb1
#undef y0a
#undef y0b
}
__device__ __forceinline__ void p2b_chunks(LAS unsigned char* lds, const Args& a) {
#pragma unroll 1
    for (int item = blockIdx.x; item < 4096; item += gridDim.x) chunk_item(lds, a, item);
}
}

namespace ck {
constexpr int SQ_MAT = 8704, SQ_BUF = 6 * SQ_MAT;
constexpr int SQ_OUT = 2 * SQ_BUF;
__device__ __forceinline__ bf16x8 lfrag(const LAS unsigned char* M, int row, int k0, int hi) { return fragP(M, row, k0, hi); }
__device__ __forceinline__ void linit(f32x16& x, const LAS unsigned char* M, int row, int cblk, int hi) {
#pragma unroll
    for (int q = 0; q < 4; ++q) { const u32x2 u = *(const LAS u32x2*)(M + row * PS + (cblk * 32 + 8 * q + 4 * hi) * 2); x[4 * q] = bflo(u.x); x[4 * q + 1] = bfhi(u.x); x[4 * q + 2] = bflo(u.y); x[4 * q + 3] = bfhi(u.y); }
}
__device__ __forceinline__ void seq_head(LAS unsigned char* lds, const Args& a, int bh) {
    const int tid = threadIdx.x, lane = tid & 63, r32 = lane & 31, hi = lane >> 5; const int wave = __builtin_amdgcn_readfirstlane(tid >> 6);
    unsigned char* ws = a.ws;
    const bf16_t* SV = (const bf16_t*)(ws + WS_SV); const bf16_t* SG = (const bf16_t*)(ws + WS_SG); const float* RK = (const float*)(ws + WS_RK); bf16_t* YMIX = (bf16_t*)(ws + WS_YMIX);
    const int b = bh >> 3, h = bh & 7, col0 = h * 64;
    const float* lng = a.in[12] + col0; const float* lnb = a.in[13] + col0;
#define SQ_LOAD(ch) do { const size_t item_ = (size_t)bh * 64 + (ch); LAS unsigned char* bb_ = lds + ((ch) & 1) * SQ_BUF; const size_t t0_ = (size_t)b * SEQ + (ch) * 64; \
        for (int p_ = tid - 128; p_ < 3072; p_ += 384) { const int m_ = p_ >> 9, q_ = p_ & 511, row_ = q_ >> 3, c8_ = (q_ & 7) * 8; u32x4 v_; \
            if (m_ == 0) v_ = *(const u32x4*)((const bf16_t*)(ws + WS_CG) + item_ * 4096 + row_ * 64 + c8_); \
            else if (m_ == 1) v_ = *(const u32x4*)((const bf16_t*)(ws + WS_CH) + item_ * 4096 + row_ * 64 + c8_); \
            else if (m_ == 2) v_ = *(const u32x4*)((const bf16_t*)(ws + WS_CR2) + item_ * 4096 + row_ * 64 + c8_); \
            else if (m_ == 3) v_ = *(const u32x4*)((const bf16_t*)(ws + WS_CY0) + item_ * 4096 + row_ * 64 + c8_); \
            else if (m_ == 4) v_ = *(const u32x4*)(SV + (t0_ + row_) * CW + col0 + c8_); \
            else v_ = *(const u32x4*)(SG + (t0_ + row_) * CW + col0 + c8_); \
            LAS unsigned char* d_ = bb_ + m_ * SQ_MAT + row_ * PS + c8_ * 2; *(LAS u32x2*)d_ = (u32x2){v_.x, v_.y}; *(LAS u32x2*)(d_ + 8) = (u32x2){v_.z, v_.w}; } } while (0)
#define SQ_STORE(ch) do { const LAS unsigned char* ob_ = lds + SQ_OUT + ((ch) & 1) * SQ_MAT; const size_t t0_ = (size_t)b * SEQ + (ch) * 64; \
        for (int p_ = tid - 128; p_ < 512; p_ += 384) { const int row_ = p_ >> 3, c8_ = (p_ & 7) * 8; const LAS unsigned char* s_ = ob_ + row_ * PS + c8_ * 2; \
            const u32x2 lo_ = *(const LAS u32x2*)s_, hi_ = *(const LAS u32x2*)(s_ + 8); *(u32x4*)(YMIX + (t0_ + row_) * D + col0 + c8_) = (u32x4){lo_.x, lo_.y, hi_.x, hi_.y}; } } while (0)
    if (wave >= 2) SQ_LOAD(0);
    __syncthreads();
    f32x16 X00 = f32x16{}, X01 = f32x16{}, X10 = f32x16{}, X11 = f32x16{};
#pragma unroll 1
    for (int c = 0; c < 64; ++c) {
        if (wave >= 2) {
            if (c + 1 < 64) SQ_LOAD(c + 1);
            if (c > 0) SQ_STORE(c - 1);
        } else {
            const int tb = wave;
            const LAS unsigned char* bb = lds + (c & 1) * SQ_BUF;
            const LAS unsigned char* MG = bb; const LAS unsigned char* MH = bb + SQ_MAT; const LAS unsigned char* MR = bb + 2 * SQ_MAT; const LAS unsigned char* MY = bb + 3 * SQ_MAT;
            const LAS unsigned char* MV = bb + 4 * SQ_MAT; const LAS unsigned char* MGT = bb + 5 * SQ_MAT;
            LAS unsigned char* OB = lds + SQ_OUT + (c & 1) * SQ_MAT;
            const int tl = tb * 32 + r32; const size_t t = (size_t)b * SEQ + c * 64 + tl;
            const float rk = RK[t * 8 + h];
            f32x16 y0, y1; linit(y0, MY, tl, 0, hi); linit(y1, MY, tl, 1, hi);
#pragma unroll
            for (int s = 0; s < 2; ++s) {
                const bf16x8 rf0 = lfrag(MR, tl, 16 * s, hi), rf1 = lfrag(MR, tl, 32 + 16 * s, hi);
                y0 = CK_MFMA(packR(X00, s), rf0, y0); y0 = CK_MFMA(packR(X10, s), rf1, y0);
                y1 = CK_MFMA(packR(X01, s), rf0, y1); y1 = CK_MFMA(packR(X11, s), rf1, y1);
            }
#pragma unroll
            for (int db = 0; db < 2; ++db) {
                f32x16 Na, Nb; linit(Na, MH, db * 32 + r32, 0, hi); linit(Nb, MH, db * 32 + r32, 1, hi);
#pragma unroll
                for (int s = 0; s < 2; ++s) {
                    const bf16x8 g00 = lfrag(MG, r32, 16 * s, hi), g01 = lfrag(MG, r32, 32 + 16 * s, hi), g10 = lfrag(MG, 32 + r32, 16 * s, hi), g11 = lfrag(MG, 32 + r32, 32 + 16 * s, hi);
                    const bf16x8 p0 = packR(db ? X01 : X00, s), p1 = packR(db ? X11 : X10, s);
                    Na = CK_MFMA(g00, p0, Na); Na = CK_MFMA(g01, p1, Na);
                    Nb = CK_MFMA(g10, p0, Nb); Nb = CK_MFMA(g11, p1, Nb);
                }
                if (db == 0) { X00 = Na; X10 = Nb; } else { X01 = Na; X11 = Nb; }
            }
            float sm = 0.f;
#pragma unroll
            for (int r = 0; r < 16; ++r) sm += y0[r] + y1[r];
            sm += __shfl_xor(sm, 32);
            const float mean = sm * (1.0f / 64.0f);
            float sq = 0.f;
#pragma unroll
            for (int r = 0; r < 16; ++r) { const float d0 = y0[r] - mean, d1 = y1[r] - mean; sq += d0 * d0 + d1 * d1; }
            sq += __shfl_xor(sq, 32);
            const float rs = 1.0f / sqrtf(sq * (1.0f / 64.0f) + 64e-5f);
#pragma unroll
            for (int db = 0; db < 2; ++db)
#pragma unroll
                for (int q = 0; q < 4; ++q) {
                    const int dv = db * 32 + 8 * q + 4 * hi;
                    const f32x4 lg = *(const f32x4*)(lng + dv), lb = *(const f32x4*)(lnb + dv);
                    const u32x2 uv = *(const LAS u32x2*)(MV + tl * PS + dv * 2), ug = *(const LAS u32x2*)(MGT + tl * PS + dv * 2);
                    const f32x4 vv = {bflo(uv.x), bfhi(uv.x), bflo(uv.y), bfhi(uv.y)}, gg = {bflo(ug.x), bfhi(ug.x), bflo(ug.y), bfhi(ug.y)};
                    f32x4 yy; if (db == 0) yy = (f32x4){y0[4 * q], y0[4 * q + 1], y0[4 * q + 2], y0[4 * q + 3]}; else yy = (f32x4){y1[4 * q], y1[4 * q + 1], y1[4 * q + 2], y1[4 * q + 3]};
                    const f32x4 o = ((yy - mean) * rs * lg + lb + rk * vv) * gg;
                    u32x2 w; w.x = pk2(o.x, o.y); w.y = pk2(o.z, o.w);
                    *(LAS u32x2*)(OB + tl * PS + dv * 2) = w;
                }
        }
        __syncthreads();
    }
    if (wave >= 2) SQ_STORE(63);
#undef SQ_LOAD
#undef SQ_STORE
}
}

__device__ __forceinline__ float red16(float v) {
    v += dpp_f<0xB1>(v); v += dpp_f<0x4E>(v); v += dpp_f<0x141>(v); v += dpp_f<0x140>(v);
    return v;
}
__device__ __forceinline__ void p3_scan(LAS unsigned char* lds, const Args& a) {
    const int tid = threadIdx.x, lane = tid & 63, wave = __builtin_amdgcn_readfirstlane(tid >> 6);
    unsigned char* ws = a.ws;
    const bf16_t* SR = (const bf16_t*)(ws + WS_SR); const bf16_t* SK = (const bf16_t*)(ws + WS_SK); const bf16_t* SV = (const bf16_t*)(ws + WS_SV);
    const bf16_t* SA = (const bf16_t*)(ws + WS_SA); const bf16_t* SB = (const bf16_t*)(ws + WS_SB); const float* SW = (const float*)(ws + WS_SW);
    float* YRAW = (float*)(ws + WS_YRAW);
    const int bh = blockIdx.x >> 1, half = blockIdx.x & 1;
    const int b = bh >> 3, h = bh & 7, tok0 = b * SEQ, col0 = h * 64, row0 = half * 32;
    constexpr int BUFB = 45056;
    LAS float* buf0 = (LAS float*)lds; LAS float* buf1 = (LAS float*)(lds + BUFB);
    LAS float* Y0 = (LAS float*)(lds + 2 * BUFB); LAS float* Y1 = Y0 + 1024;
    constexpr int NCH = SEQ / 32;
    if (wave >= 4) {
        const int lw = wave - 4, sl = lw * 8 + (lane >> 3), cg = lane & 7, c8 = cg * 8;
        f32x4 w0_, w1_; u32x4 uk, ua, ub, ur; u32x2 uv;
#define SC_ISSUE(ch) do { const size_t o_ = (size_t)(tok0 + (ch) * 32 + sl) * CW + col0; \
            w0_ = *(const f32x4*)(SW + o_ + c8); w1_ = *(const f32x4*)(SW + o_ + c8 + 4); uk = *(const u32x4*)(SK + o_ + c8); ua = *(const u32x4*)(SA + o_ + c8); ub = *(const u32x4*)(SB + o_ + c8); ur = *(const u32x4*)(SR + o_ + c8); \
            uv = *(const u32x2*)(SV + o_ + row0 + 4 * cg); } while (0)
#define SC_STORE(bufp) do { LAS float* d_ = (bufp) + sl * 64 + c8; *(LAS f32x4*)(d_) = w0_; *(LAS f32x4*)(d_ + 4) = w1_; \
            *(LAS f32x4*)(d_ + 2048) = cvlo(uk); *(LAS f32x4*)(d_ + 2052) = cvhi(uk); *(LAS f32x4*)(d_ + 4096) = cvlo(ua); *(LAS f32x4*)(d_ + 4100) = cvhi(ua); \
            *(LAS f32x4*)(d_ + 6144) = cvlo(ub); *(LAS f32x4*)(d_ + 6148) = cvhi(ub); *(LAS f32x4*)(d_ + 8192) = cvlo(ur); *(LAS f32x4*)(d_ + 8196) = cvhi(ur); \
            *(LAS f32x4*)((bufp) + 10240 + sl * 32 + 4 * cg) = (f32x4){bflo(uv.x), bfhi(uv.x), bflo(uv.y), bfhi(uv.y)}; } while (0)
#define SC_YOUT(ch, yp) do { *(f32x4*)(YRAW + (size_t)(tok0 + (ch) * 32 + sl) * CW + col0 + row0 + 4 * cg) = *(const LAS f32x4*)((yp) + sl * 32 + 4 * cg); } while (0)
        SC_ISSUE(0); SC_STORE(buf0);
        __syncthreads();
        for (int ch = 0; ch < NCH; ++ch) {
            LAS float* ob = (ch & 1) ? buf0 : buf1; const LAS float* oy = (ch & 1) ? Y0 : Y1;
            if (ch + 1 < NCH) SC_ISSUE(ch + 1);
            if (ch > 0) SC_YOUT(ch - 1, oy);
            if (ch + 1 < NCH) SC_STORE(ob);
            __syncthreads();
        }
        { const LAS float* oy = ((NCH - 1) & 1) ? Y1 : Y0; SC_YOUT(NCH - 1, oy); }
#undef SC_ISSUE
#undef SC_STORE
#undef SC_YOUT
    } else {
        const int g = lane & 7, rl = lane >> 3, row = wave * 8 + rl;
        f32x2 S0 = {0.f, 0.f}, S1 = S0, S2 = S0, S3 = S0;
        __syncthreads();
        for (int ch = 0; ch < NCH; ++ch) {
            const LAS float* cb = (ch & 1) ? buf1 : buf0; LAS float* yb = (ch & 1) ? Y1 : Y0;
            const LAS float* pa = cb + 4 * g; const LAS float* pv = cb + 10240 + row;
#define SC_LD(X, s_) const f32x4 w0##X = *(const LAS f32x4*)(pa + (s_) * 64), w1##X = *(const LAS f32x4*)(pa + (s_) * 64 + 32), k0##X = *(const LAS f32x4*)(pa + (s_) * 64 + 2048), k1##X = *(const LAS f32x4*)(pa + (s_) * 64 + 2080), \
                a0##X = *(const LAS f32x4*)(pa + (s_) * 64 + 4096), a1##X = *(const LAS f32x4*)(pa + (s_) * 64 + 4128), b0##X = *(const LAS f32x4*)(pa + (s_) * 64 + 6144), b1##X = *(const LAS f32x4*)(pa + (s_) * 64 + 6176), \
                r0##X = *(const LAS f32x4*)(pa + (s_) * 64 + 8192), r1##X = *(const LAS f32x4*)(pa + (s_) * 64 + 8224); const float v##X = pv[(s_) * 32]
#define LO(q) ((f32x2){(q).x, (q).y})
#define HI(q) ((f32x2){(q).z, (q).w})
#define SC_STEP(X, s_) do { f32x2 t = S0 * LO(a0##X); t = S1 * HI(a0##X) + t; t = S2 * LO(a1##X) + t; t = S3 * HI(a1##X) + t; float sa = t.x + t.y; \
                const f32x2 vv = {v##X, v##X}; \
                f32x2 p0 = S0 * LO(w0##X), p1 = S1 * HI(w0##X), p2 = S2 * LO(w1##X), p3 = S3 * HI(w1##X); \
                p0 = vv * LO(k0##X) + p0; p1 = vv * HI(k0##X) + p1; p2 = vv * LO(k1##X) + p2; p3 = vv * HI(k1##X) + p3; \
                sa = red8(sa); const f32x2 ss = {sa, sa}; \
                S0 = ss * LO(b0##X) + p0; S1 = ss * HI(b0##X) + p1; S2 = ss * LO(b1##X) + p2; S3 = ss * HI(b1##X) + p3; \
                f32x2 u = S0 * LO(r0##X); u = S1 * HI(r0##X) + u; u = S2 * LO(r1##X) + u; u = S3 * HI(r1##X) + u; float y = u.x + u.y; y = red8(y); \
                yb[(s_) * 32 + row] = y; } while (0)
#pragma unroll 1
            for (int s8 = 0; s8 < 32; s8 += 8) {
                SC_LD(0, s8 + 0); SC_LD(1, s8 + 1);
                SC_STEP(0, s8 + 0); SC_LD(2, s8 + 2);
                SC_STEP(1, s8 + 1); SC_LD(3, s8 + 3);
                SC_STEP(2, s8 + 2); SC_LD(4, s8 + 4);
                SC_STEP(3, s8 + 3); SC_LD(5, s8 + 5);
                SC_STEP(4, s8 + 4); SC_LD(6, s8 + 6);
                SC_STEP(5, s8 + 5); SC_LD(7, s8 + 7);
                SC_STEP(6, s8 + 6);
                SC_STEP(7, s8 + 7);
            }
#undef SC_LD
#undef LO
#undef HI
#undef SC_STEP
            __syncthreads();
        }
    }
}

__device__ __forceinline__ void p3_post(const Args& a, int G) {
    const int tid = threadIdx.x, lane = tid & 63, wave = __builtin_amdgcn_readfirstlane(tid >> 6);
    unsigned char* ws = a.ws;
    const bf16_t* SR = (const bf16_t*)(ws + WS_SR); const bf16_t* SK = (const bf16_t*)(ws + WS_SK); const bf16_t* SV = (const bf16_t*)(ws + WS_SV);
    const bf16_t* SG = (const bf16_t*)(ws + WS_SG); const float* YRAW = (const float*)(ws + WS_YRAW); bf16_t* YMIX = (bf16_t*)(ws + WS_YMIX);
    const int gw = blockIdx.x * 8 + wave, NGW = G * 8, c8 = lane * 8;
    const f32x4 lg0 = *(const f32x4*)(a.in[12] + c8), lg1 = *(const f32x4*)(a.in[12] + c8 + 4), lb0 = *(const f32x4*)(a.in[13] + c8), lb1 = *(const f32x4*)(a.in[13] + c8 + 4);
    const f32x4 rk0 = *(const f32x4*)(a.in[11] + c8), rk1 = *(const f32x4*)(a.in[11] + c8 + 4);
    for (int t = gw; t < T; t += NGW) {
        const size_t o = (size_t)t * CW + c8;
        const f32x4 y0 = *(const f32x4*)(YRAW + o), y1 = *(const f32x4*)(YRAW + o + 4);
        const u32x4 ur = *(const u32x4*)(SR + o), uk = *(const u32x4*)(SK + o), uv = *(const u32x4*)(SV + o), ug = *(const u32x4*)(SG + o);
        const float mean = red8((y0.x + y0.y) + (y0.z + y0.w) + (y1.x + y1.y) + (y1.z + y1.w)) * (1.0f / 64.0f);
        const f32x4 d0 = y0 - mean, d1 = y1 - mean;
        const float var = red8((d0.x * d0.x + d0.y * d0.y) + (d0.z * d0.z + d0.w * d0.w) + (d1.x * d1.x + d1.y * d1.y) + (d1.z * d1.z + d1.w * d1.w)) * (1.0f / 64.0f);
        const f32x4 r0 = cvlo(ur), r1 = cvhi(ur), k0 = cvlo(uk), k1 = cvhi(uk);
        const f32x4 p0 = r0 * k0 * rk0, p1 = r1 * k1 * rk1;
        const float rk = red8((p0.x + p0.y) + (p0.z + p0.w) + (p1.x + p1.y) + (p1.z + p1.w));
        const float rs = 1.0f / sqrtf(var + 64e-5f);
        const f32x4 o0 = (d0 * rs * lg0 + lb0 + rk * cvlo(uv)) * cvlo(ug), o1 = (d1 * rs * lg1 + lb1 + rk * cvhi(uv)) * cvhi(ug);
        *(u32x4*)(YMIX + (size_t)t * D + c8) = pk8(o0, o1);
    }
}

namespace att {
constexpr int SLOT = 32768, OFF_V = 16384;
constexpr int TBL_OFF = MISC_OFF + 1024;
constexpr int LW_OFF = MISC_OFF + 2048;
constexpr int CST_OFF = MISC_OFF + 3072;
__device__ __forceinline__ int crow(int r, int hi) { return (r & 3) + 8 * (r >> 2) + 4 * hi; }
__device__ __forceinline__ void glds16(const void* gsrc, unsigned lds_dst) { unsigned keep;
    asm volatile("s_mov_b32 %0, m0\n\ts_mov_b32 m0, %2\n\ts_nop 0\n\tglobal_load_lds_dwordx4 %1, off\n\ts_mov_b32 m0, %0" : "=&s"(keep) : "v"(gsrc), "s"(lds_dst) : "memory"); }
__device__ __forceinline__ s16x4 vtr(const LAS unsigned char* p) { return __builtin_bit_cast(s16x4, __builtin_amdgcn_ds_read_tr16_b64_v4i16((LAS s16x4*)p)); }

__device__ __forceinline__ void attn_unit(LAS unsigned char* lds, const Args& a, int b, int h, int qb, float negM, float lam) {
    const int tid = threadIdx.x, lane = tid & 63, r32 = lane & 31, hi = lane >> 5; const int wid = __builtin_amdgcn_readfirstlane(tid >> 6);
    const int c = wid >> 2, rg = wid & 3;
    unsigned char* ws = a.ws;
    const bf16_t* QN = (const bf16_t*)(ws + WS_QN); const bf16_t* KN = (const bf16_t*)(ws + WS_KN); const bf16_t* P = (const bf16_t*)(ws + WS_P); bf16_t* YMIX = (bf16_t*)(ws + WS_YMIX);
    const int q0 = qb * 128; const size_t rowbase = (size_t)b * SEQ;
    const int NT = 2 * qb + 2;
    LAS float* tbl = (LAS float*)(lds + TBL_OFF); LAS float* lw = (LAS float*)(lds + LW_OFF) + wid * 32;
    if (tid < 128) {
        const int n = tid; int bkt;
        if (n < 16) bkt = n; else { bkt = 16 + (int)(logf((float)n * (1.0f / 16.0f)) / 2.0794415416798357f * 16.0f); bkt = bkt > 31 ? 31 : bkt; }
        tbl[n] = (a.in[21][bkt * 4 + h] - a.in[21][31 * 4 + h]) * LOG2E;
    }
    const bf16_t* Qw = QN + (rowbase + q0 + rg * 32 + r32) * CW + h * 128 + c * 64;
    bf16x8 qr[4];
#pragma unroll
    for (int d0 = 0; d0 < 4; ++d0) qr[d0] = *(const bf16x8*)(Qw + d0 * 16 + hi * 8);
    const bf16_t* k0src = KN + (rowbase + lane) * CW + h * 128 + wid * 8;
    const bf16_t* k1src = k0src + 64;
    const int pv0 = 2 * wid, pv1 = 2 * wid + 1;
    const bf16_t* v0src = P + (rowbase + 16 * (pv0 & 3) + (lane >> 2)) * NINP + DV0 + h * 128 + 32 * (pv0 >> 2) + (lane & 3) * 8;
    const bf16_t* v1src = P + (rowbase + 16 * (pv1 & 3) + (lane >> 2)) * NINP + DV0 + h * 128 + 32 * (pv1 >> 2) + (lane & 3) * 8;
#define ATT_DMA(t, slot) do { const unsigned s_ = lds0 + (unsigned)(slot) * SLOT; \
        glds16(k0src + (size_t)(t) * 64 * CW, (unsigned)__builtin_amdgcn_readfirstlane(s_ + wid * 1024)); \
        glds16(k1src + (size_t)(t) * 64 * CW, (unsigned)__builtin_amdgcn_readfirstlane(s_ + 8192 + wid * 1024)); \
        glds16(v0src + (size_t)(t) * 64 * NINP, (unsigned)__builtin_amdgcn_readfirstlane(s_ + OFF_V + pv0 * 1024)); \
        glds16(v1src + (size_t)(t) * 64 * NINP, (unsigned)__builtin_amdgcn_readfirstlane(s_ + OFF_V + pv1 * 1024)); } while (0)
#define ATT_SBAR() __builtin_amdgcn_sched_barrier(0)
    const unsigned lds0 = (unsigned)(uintptr_t)lds;
    f32x16 o[4];
#pragma unroll
    for (int d0 = 0; d0 < 4; ++d0) o[d0] = f32x16{};
    float lsum = 0.f;
    const bool shift = negM < -60.0f;
    const int qmin = q0 + 32 * rg, qpos = qmin + r32;
    ATT_DMA(0, 0);
    asm volatile("s_waitcnt vmcnt(0)" ::: "memory");
    __syncthreads();
    for (int t = 0; t < NT; ++t) {
        if (t + 1 < NT) ATT_DMA(t + 1, (t + 1) & 1);
        const int kmin = 64 * t;
        if (kmin <= qmin + 31) {
            const LAS unsigned char* slot = lds + (t & 1) * SLOT;
            const LAS unsigned char* kb = slot + c * 8192 + hi * 1024 + r32 * 16;
            const LAS unsigned char* vb = slot + OFF_V + ((lane >> 4) & 1) * 32 + (lane & 3) * 8 + (4 * hi + ((lane & 15) >> 2)) * 64;
            bf16x8 kf[8];
#pragma unroll
            for (int d0 = 0; d0 < 4; ++d0) { kf[2 * d0] = *(const LAS bf16x8*)(kb + d0 * 2048); kf[2 * d0 + 1] = *(const LAS bf16x8*)(kb + d0 * 2048 + 512); }
            s16x4 va[16], vc[16];
#pragma unroll
            for (int i = 0; i < 8; ++i) { va[2 * i] = vtr(vb + (i >> 2) * 4096 + (i & 3) * 1024); va[2 * i + 1] = vtr(vb + (i >> 2) * 4096 + (i & 3) * 1024 + 512); }
            ATT_SBAR();
            f32x16 p0, p1;
            p0 = __builtin_amdgcn_mfma_f32_32x32x16_bf16(kf[0], qr[0], f32x16{}, 0, 0, 0); p1 = __builtin_amdgcn_mfma_f32_32x32x16_bf16(kf[1], qr[0], f32x16{}, 0, 0, 0);
#pragma unroll
            for (int d0 = 1; d0 < 4; ++d0) { p0 = __builtin_amdgcn_mfma_f32_32x32x16_bf16(kf[2 * d0], qr[d0], p0, 0, 0, 0); p1 = __builtin_amdgcn_mfma_f32_32x32x16_bf16(kf[2 * d0 + 1], qr[d0], p1, 0, 0, 0); }
            ATT_SBAR();
            if (qmin - (kmin + 63) < 113) {
#pragma unroll
                for (int r = 0; r < 16; ++r) {
                    const int d0_ = qpos - (kmin + crow(r, hi)); const int d1_ = d0_ - 32;
                    const float t0 = tbl[d0_ < 0 ? 0 : (d0_ > 127 ? 127 : d0_)], t1 = tbl[d1_ < 0 ? 0 : (d1_ > 127 ? 127 : d1_)];
                    p0[r] = d0_ < 0 ? -INFINITY : p0[r] + t0; p1[r] = d1_ < 0 ? -INFINITY : p1[r] + t1;
                }
            }
            if (shift) {
#pragma unroll
                for (int r = 0; r < 16; ++r) { p0[r] += negM; p1[r] += negM; }
            }
            float sacc = 0.f;
#pragma unroll
            for (int r = 0; r < 16; ++r) { p0[r] = __builtin_amdgcn_exp2f(p0[r]); p1[r] = __builtin_amdgcn_exp2f(p1[r]); sacc += p0[r] + p1[r]; }
            lsum += sacc;
            u32x4 pw[4];
#pragma unroll
            for (int i = 0; i < 4; ++i) { pw[0][i] = pk2(p0[2 * i], p0[2 * i + 1]); pw[1][i] = pk2(p0[8 + 2 * i], p0[8 + 2 * i + 1]); pw[2][i] = pk2(p1[2 * i], p1[2 * i + 1]); pw[3][i] = pk2(p1[8 + 2 * i], p1[8 + 2 * i + 1]); }
            ATT_SBAR();
#pragma unroll
            for (int i = 0; i < 8; ++i) { vc[2 * i] = vtr(vb + (2 + (i >> 2)) * 4096 + (i & 3) * 1024); vc[2 * i + 1] = vtr(vb + (2 + (i >> 2)) * 4096 + (i & 3) * 1024 + 512); }
#pragma unroll
            for (int i = 0; i < 8; ++i) {
                const bf16x8 vf = (bf16x8){va[2 * i][0], va[2 * i][1], va[2 * i][2], va[2 * i][3], va[2 * i + 1][0], va[2 * i + 1][1], va[2 * i + 1][2], va[2 * i + 1][3]};
                o[i >> 2] = __builtin_amdgcn_mfma_f32_32x32x16_bf16(__builtin_bit_cast(bf16x8, pw[i & 3]), vf, o[i >> 2], 0, 0, 0);
            }
#pragma unroll
            for (int i = 0; i < 8; ++i) {
                const bf16x8 vf = (bf16x8){vc[2 * i][0], vc[2 * i][1], vc[2 * i][2], vc[2 * i][3], vc[2 * i + 1][0], vc[2 * i + 1][1], vc[2 * i + 1][2], vc[2 * i + 1][3]};
                o[2 + (i >> 2)] = __builtin_amdgcn_mfma_f32_32x32x16_bf16(__builtin_bit_cast(bf16x8, pw[i & 3]), vf, o[2 + (i >> 2)], 0, 0, 0);
            }
        }
        asm volatile("s_waitcnt vmcnt(0)" ::: "memory");
        __syncthreads();
    }
#undef ATT_DMA
#undef ATT_SBAR
    lsum += __shfl_xor(lsum, 32);
    if (hi == 0) lw[r32] = 1.0f / lsum;
    asm volatile("s_waitcnt lgkmcnt(0)" ::: "memory");
    LAS float* stg = (LAS float*)(lds + wid * 16384);
#pragma unroll
    for (int r = 0; r < 16; ++r) { const int orow = crow(r, hi); const float il = lw[orow];
#pragma unroll
        for (int d0 = 0; d0 < 4; ++d0) stg[orow * 128 + d0 * 32 + r32] = o[d0][r] * il; }
    __syncthreads();
    {
        const int row = tid >> 2, part = tid & 3, rgp = row >> 5, rr = row & 31;
        const LAS float* s1 = (const LAS float*)(lds + rgp * 16384) + rr * 128 + part * 32;
        const LAS float* s2 = (const LAS float*)(lds + (4 + rgp) * 16384) + rr * 128 + part * 32;
        float dv[32]; float ss = 0.f;
#pragma unroll
        for (int i = 0; i < 8; ++i) { const f32x4 x1 = *(const LAS f32x4*)(s1 + 4 * i), x2 = *(const LAS f32x4*)(s2 + 4 * i);
#pragma unroll
            for (int j = 0; j < 4; ++j) { const float dd = x1[j] - lam * x2[j]; dv[4 * i + j] = dd; ss += dd * dd; } }
        ss = red4(ss);
        const float sc = (1.0f / sqrtf(ss * (1.0f / 128.0f) + 1e-5f)) * 0.8f;
        const float* sg = a.in[20] + part * 32;
        bf16_t* op = YMIX + (rowbase + q0 + row) * D + CW + h * 128 + part * 32;
#pragma unroll
        for (int i = 0; i < 4; ++i) { u32x4 w;
            w.x = pk2(dv[8 * i] * sc * sg[8 * i], dv[8 * i + 1] * sc * sg[8 * i + 1]); w.y = pk2(dv[8 * i + 2] * sc * sg[8 * i + 2], dv[8 * i + 3] * sc * sg[8 * i + 3]);
            w.z = pk2(dv[8 * i + 4] * sc * sg[8 * i + 4], dv[8 * i + 5] * sc * sg[8 * i + 5]); w.w = pk2(dv[8 * i + 6] * sc * sg[8 * i + 6], dv[8 * i + 7] * sc * sg[8 * i + 7]);
            *(u32x4*)(op + 8 * i) = w; }
    }
    __syncthreads();
}

__device__ __forceinline__ void attn_phase(LAS unsigned char* lds, const Args& a, unsigned* ctl) {
    const int tid = threadIdx.x;
    LAS float* cst = (LAS float*)(lds + CST_OFF);
    if (tid < 64) {
        const float gq = fabsf(a.in[14][tid]), gk = fabsf(a.in[15][tid]);
        float mq = gq, mk = gk;
#pragma unroll
        for (int o = 1; o < 64; o <<= 1) { mq = fmaxf(mq, __shfl_xor(mq, o)); mk = fmaxf(mk, __shfl_xor(mk, o)); }
        const float d1 = wave_sum(a.in[16][tid] * a.in[17][tid]), d2 = wave_sum(a.in[18][tid] * a.in[19][tid]);
        float mb = 0.f;
        if (tid < 32) { for (int hh = 0; hh < 4; ++hh) mb = fmaxf(mb, (a.in[21][tid * 4 + hh] - a.in[21][31 * 4 + hh]) * LOG2E); }
#pragma unroll
        for (int o = 1; o < 64; o <<= 1) mb = fmaxf(mb, __shfl_xor(mb, o));
        if (tid == 0) { cst[0] = -(8.0f * LOG2E * mq * mk * 1.02f + mb); cst[1] = __expf(d1) - __expf(d2) + 0.2f; }
    }
    __syncthreads();
    const float negM = cst[0], lam = cst[1];
    LAS int* ubox = (LAS int*)(lds + CST_OFF + 16);
    for (;;) {
        if (tid == 0) ubox[0] = (int)atomicAdd(ctl + CW_ATTQ, 1u);
        __syncthreads();
        const int u = ubox[0];
        __syncthreads();
        if (u >= 1024) break;
        const int qb = 31 - (u >> 5), bhh = u & 31;
        attn_unit(lds, a, bhh >> 2, bhh & 3, qb, negM, lam);
    }
}
}

__device__ __forceinline__ void p5_router(LAS unsigned char* lds, const Args& a, unsigned* ctl) {
    const int tid = threadIdx.x, lane = tid & 63, wave = __builtin_amdgcn_readfirstlane(tid >> 6);
    unsigned char* ws = a.ws;
    const bf16_t* x1 = (const bf16_t*)(ws + WS_X1B); const float* g2 = a.in[23]; const float* rw = a.in[24]; const float* rb = a.in[25];
    unsigned char* H2 = ws + WS_H2; int* EIDX = (int*)(ws + WS_EIDX); float* GATE = (float*)(ws + WS_GATE); int* POS = (int*)(ws + WS_POS);
    LAS float* rwT = (LAS float*)lds;
    LAS int* cnt = (LAS int*)(lds + MISC_OFF + 1024);
    LAS int* basel = (LAS int*)(lds + MISC_OFF + 1024 + 128);
    LAS int* el = (LAS int*)(lds + MISC_OFF + 2048);
    LAS int* pl = (LAS int*)(lds + MISC_OFF + 4096);
    for (int i = tid; i < 32 * 1024; i += 512) { const int k = i >> 5, e = i & 31; rwT[e * 1024 + k] = rw[i]; }
    if (tid < 32) cnt[tid] = 0;
    __syncthreads();
    f32x4 gv[4];
#pragma unroll
    for (int j = 0; j < 4; ++j) gv[j] = *((const f32x4*)g2 + lane + 64 * j);
    const float rbias = rb[lane >> 1];
    const int TPB = T / (int)gridDim.x, tb0 = blockIdx.x * TPB, TPW = TPB / 8;
    for (int i = 0; i < TPW; ++i) {
        const int tl = wave * TPW + i, t = tb0 + tl;
        const u32x2* xr = (const u32x2*)(x1 + (size_t)t * D) + lane;
        f32x4 v[4]; float s = 0.f;
#pragma unroll
        for (int j = 0; j < 4; ++j) { const u32x2 xw = xr[64 * j]; v[j] = (f32x4){bflo(xw.x), bfhi(xw.x), bflo(xw.y), bfhi(xw.y)}; s += (v[j].x * v[j].x + v[j].y * v[j].y) + (v[j].z * v[j].z + v[j].w * v[j].w); }
        const float rstd = 1.0f / sqrtf(wave_sum(s) * (1.0f / D) + 1e-5f);
        unsigned* o4 = (unsigned*)(H2 + (size_t)t * D) + lane;
#pragma unroll
        for (int j = 0; j < 4; ++j) { v[j] = v[j] * rstd * gv[j]; o4[64 * j] = pk4_fp8(v[j].x * F8_X_MUL, v[j].y * F8_X_MUL, v[j].z * F8_X_MUL, v[j].w * F8_X_MUL); }
        float acc[32];
#pragma unroll
        for (int e = 0; e < 32; ++e) {
            float s2 = 0.f;
#pragma unroll
            for (int j = 0; j < 4; ++j) { const f32x4 w = *((const LAS f32x4*)(rwT + e * 1024) + lane + 64 * j); s2 += (v[j].x * w.x + v[j].y * w.y) + (v[j].z * w.z + v[j].w * w.w); }
            acc[e] = s2;
        }
#pragma unroll
        for (int e = 0; e < 16; ++e) { const bool up = lane & 32; const float keep = up ? acc[e + 16] : acc[e], send = up ? acc[e] : acc[e + 16]; acc[e] = keep + __shfl_xor(send, 32); }
#pragma unroll
        for (int e = 0; e < 8; ++e) { const bool up = lane & 16; const float keep = up ? acc[e + 8] : acc[e], send = up ? acc[e] : acc[e + 8]; acc[e] = keep + __shfl_xor(send, 16); }
#pragma unroll
        for (int e = 0; e < 4; ++e) { const bool up = lane & 8; const float keep = up ? acc[e + 4] : acc[e], send = up ? acc[e] : acc[e + 4]; acc[e] = keep + __shfl_xor(send, 8); }
#pragma unroll
        for (int e = 0; e < 2; ++e) { const bool up = lane & 4; const float keep = up ? acc[e + 2] : acc[e], send = up ? acc[e] : acc[e + 2]; acc[e] = keep + __shfl_xor(send, 4); }
        { const bool up = lane & 2; const float keep = up ? acc[1] : acc[0], send = up ? acc[0] : acc[1]; acc[0] = keep + __shfl_xor(send, 2); }
        float logit = acc[0] + __shfl_xor(acc[0], 1) + rbias;
        const int myid = lane >> 1;
        float tv[4]; int ti[4];
#pragma unroll
        for (int k = 0; k < 4; ++k) {
            float bv = logit; int bi = myid;
#pragma unroll
            for (int o = 1; o < 64; o <<= 1) { const float ov = __shfl_xor(bv, o); const int oi = __shfl_xor(bi, o); if (ov > bv || (ov == bv && oi < bi)) { bv = ov; bi = oi; } }
            tv[k] = bv; ti[k] = bi;
            if (myid == bi) logit = -INFINITY;
        }
        const float e1 = __expf(tv[1] - tv[0]), e2 = __expf(tv[2] - tv[0]), e3 = __expf(tv[3] - tv[0]);
        const float inv = 1.0f / (1.0f + e1 + e2 + e3);
        if (lane < 4) {
            const int ek = lane == 0 ? ti[0] : lane == 1 ? ti[1] : lane == 2 ? ti[2] : ti[3];
            const float gk = (lane == 0 ? 1.0f : lane == 1 ? e1 : lane == 2 ? e2 : e3) * inv;
            EIDX[t * 4 + lane] = ek; GATE[t * 4 + lane] = gk;
            el[tl * 4 + lane] = ek; pl[tl * 4 + lane] = atomicAdd((int*)(cnt + ek), 1);
        }
    }
    __syncthreads();
    if (tid < 32) basel[tid] = (int)atomicAdd(ctl + CW_CNT + tid, (unsigned)cnt[tid]);
    __syncthreads();
    for (int i = tid; i < TPB * 4; i += 512) POS[(size_t)tb0 * 4 + i] = pl[i] + basel[el[i]];
}

__device__ __forceinline__ void p6_dispatch(LAS unsigned char* lds, const Args& a, unsigned* ctl) {
    const int tid = threadIdx.x, lane = tid & 63, wave = __builtin_amdgcn_readfirstlane(tid >> 6);
    unsigned char* ws = a.ws;
    const int* EIDX = (const int*)(ws + WS_EIDX); const float* GATE = (const float*)(ws + WS_GATE); const int* POS = (const int*)(ws + WS_POS);
    int* DEST = (int*)(ws + WS_DEST); float* ROWGATE = (float*)(ws + WS_ROWGATE); int* TILEE = (int*)(ws + WS_TILEE); int* ROWTOK = (int*)(ws + WS_ROWTOK);
    LAS int* pstart = (LAS int*)(lds + MISC_OFF + 1024); LAS int* pcnt = pstart + 32;
    if (tid == 0) {
        int acc = 0;
        for (int e = 0; e < NE; ++e) { const int cn = (int)__hip_atomic_load(ctl + CW_CNT + e, __ATOMIC_RELAXED, __HIP_MEMORY_SCOPE_AGENT); pstart[e] = acc; pcnt[e] = cn;
            const int nt = (cn + 255) >> 8;
            if (blockIdx.x == 0) for (int i = 0; i < nt; ++i) TILEE[(acc >> 8) + i] = e;
            acc += nt * 256; }
        if (blockIdx.x == 0) TILEE[1023] = acc >> 8;
    }
    __syncthreads();
    if (blockIdx.x < NE) {
        const int e = blockIdx.x, cn = pcnt[e], pe = ((cn + 255) >> 8) * 256;
        for (int i = cn + tid; i < pe; i += 512) ROWTOK[pstart[e] + i] = 0;
    }
    const int TPB = T / (int)gridDim.x, tb0 = blockIdx.x * TPB;
    for (int pi = tb0 * 4 + tid; pi < (tb0 + TPB) * 4; pi += 512) {
        const int e = EIDX[pi], dest = pstart[e] + POS[pi];
        DEST[pi] = dest; ROWGATE[dest] = GATE[pi]; ROWTOK[dest] = pi >> 2;
    }
}

__device__ __forceinline__ void p9_combine(const Args& a, int G) {
    const int tid = threadIdx.x, lane = tid & 63, wave = __builtin_amdgcn_readfirstlane(tid >> 6);
    unsigned char* ws = a.ws;
    const unsigned char* YS = ws + WS_YS; const int* DEST = (const int*)(ws + WS_DEST);
    float* out = a.out;
    const int gw = blockIdx.x * 8 + wave, NGW = G * 8;
    for (int t = gw; t < T; t += NGW) {
        f32x4* xr = (f32x4*)(out + (size_t)t * D) + lane; const u32x2* xi = (const u32x2*)((const bf16_t*)(ws + WS_X1B) + (size_t)t * D) + lane;
        f32x4 v[4];
#pragma unroll
        for (int j = 0; j < 4; ++j) { const u32x2 xw = xi[64 * j]; v[j] = (f32x4){bflo(xw.x), bfhi(xw.x), bflo(xw.y), bfhi(xw.y)}; }
#pragma unroll
        for (int k = 0; k < 4; ++k) {
            const int dest = DEST[t * 4 + k];
            const unsigned* yr = (const unsigned*)(YS + (size_t)dest * D) + lane;
#pragma unroll
            for (int j = 0; j < 4; ++j) { const unsigned w = yr[64 * j];
                const f32x2 lo = __builtin_amdgcn_cvt_pk_f32_fp8((int)w, false), hi2 = __builtin_amdgcn_cvt_pk_f32_fp8((int)w, true);
                v[j].x += lo.x * (1.0f / F8_Y_MUL); v[j].y += lo.y * (1.0f / F8_Y_MUL); v[j].z += hi2.x * (1.0f / F8_Y_MUL); v[j].w += hi2.y * (1.0f / F8_Y_MUL); }
        }
        if (TIME_REGION >= 0) { const float sc_ = 1.0f + 4e-6f * (float)((const unsigned*)(ws + WS_CTL))[301];
#pragma unroll
            for (int j = 0; j < 4; ++j) v[j] = v[j] * sc_; }
#pragma unroll
        for (int j = 0; j < 4; ++j) xr[64 * j] = v[j];
    }
}

constexpr int NPHASE = 10;
__global__ void __launch_bounds__(512, 2) hymba_fwd(Args args) {
    extern __shared__ __attribute__((aligned(16))) unsigned char lds_raw[];
    LAS unsigned char* lds = (LAS unsigned char*)lds_raw;
    cg::grid_group grid = cg::this_grid();
    const int G = gridDim.x;
    unsigned char* ws = args.ws;
    unsigned* ctl = (unsigned*)(ws + WS_CTL);
    const int lo = args.ph_lo, hi = args.ph_hi;
#define IN(k) (lo <= (k) && (k) < hi)
#define NREP(k) ((REP_PHASE) == (k) ? 2 : 1)
#define TSTART(k) do { if ((TIME_REGION) == (k) && blockIdx.x == 0 && threadIdx.x == 0) ctl[300] = (unsigned)__builtin_amdgcn_s_memrealtime(); } while (0)
#define TEND(k) do { if ((TIME_REGION) == (k) && blockIdx.x == 0 && threadIdx.x == 0) ctl[301] = (unsigned)__builtin_amdgcn_s_memrealtime() - ctl[300]; } while (0)
#define SEAM(k) do { if (IN(k) && IN((k) + 1)) { if (args.ph_lo < 0) grid.sync(); xcd_barrier(xbar); } } while (0)
    const int* TILEE = (const int*)(ws + WS_TILEE);
    { volatile LAS unsigned* st = (volatile LAS unsigned*)(lds + MISC_OFF); if (threadIdx.x < 2) st[threadIdx.x] = 0u; }
    __syncthreads();
    const XcdBarrier xbar = xcd_barrier_post(ctl + CW_BAR, (volatile LAS unsigned*)(lds + MISC_OFF));

    if (IN(0)) { for (int rep = 0; rep < NREP(0); ++rep) p0_prologue(lds, args, G); } SEAM(0);
    if (IN(1)) {
        pg8::Gemm g{ws + WS_XN, ws + WS_WINT, 1024, 0, 0, nullptr};
        pg8::TileOrder S; S.init(T / 256, NINP / 256, G, (int)blockIdx.x, nullptr, 0);
        pg8::EpiBf16 E{(bf16_t*)(ws + WS_P), NINP};
        for (int rep = 0; rep < NREP(1); ++rep) pg8::gemm_phase<false, false>(lds, g, S, E);
    } SEAM(1);
    TSTART(2);
    if (IN(2)) {
        p2_prep(lds, args);
        asm volatile("s_waitcnt vmcnt(0)" ::: "memory");
        __syncthreads();
        { const int bb = (int)blockIdx.x >> 5, cp = ((int)blockIdx.x & 31) * 2;
          _Pragma("clang loop unroll(disable)") for (int i = 0; i < 16; ++i) ck::chunk_item(lds, args, ((bb * 8 + (i & 7)) << 6) + cp + (i >> 3)); }
    } SEAM(2);
    TSTART(3);
    if (IN(3)) {
        TSTART(30); for (int rep = 0; rep < NREP(30); ++rep) { if (blockIdx.x < 64) ck::seq_head(lds, args, (int)blockIdx.x); __syncthreads(); } TEND(30);
        for (int rep = 0; rep < NREP(31); ++rep) att::attn_phase(lds, args, ctl + 64 * rep);
    } SEAM(3); TEND(3);
    if (IN(4)) {
        pg8::Gemm g{ws + WS_YMIX, ws + WS_WOUT, 1024, 0, 0, nullptr};
        pg8::TileOrder S; S.init(T / 256, D / 256, G, (int)blockIdx.x, nullptr, 0);
        pg8::EpiResBf16 E{args.in[0], (bf16_t*)(ws + WS_X1B), D};
        for (int rep = 0; rep < NREP(4); ++rep) pg8::gemm_phase<false, false>(lds, g, S, E);
    } SEAM(4);
    if (IN(5)) { _Pragma("clang loop unroll(disable)") for (int rep = 0; rep < NREP(5); ++rep) { p5_router(lds, args, ctl + 256 * (NREP(5) - 1 - rep)); __syncthreads(); } } SEAM(5);
    if (IN(6)) { for (int rep = 0; rep < NREP(6); ++rep) { p6_dispatch(lds, args, ctl); __syncthreads(); } } SEAM(6);
    if (IN(7)) {
        const int ntile = TILEE[1023];
        pg8::Gemm g{ws + WS_H2, ws + WS_W1T, 1024, F8_W_SC, F8_X_SC, (const int*)(ws + WS_ROWTOK)};
        pg8::TileOrder S; S.init(ntile, 8, G, (int)blockIdx.x, TILEE, 8);
        pg8::EpiSwiglu E{ws + WS_HID, args.in[27], TILEE};
        for (int rep = 0; rep < NREP(7); ++rep) pg8::gemm_phase<true, true>(lds, g, S, E);
    } SEAM(7);
    if (IN(8)) {
        const int ntile = TILEE[1023];
        pg8::Gemm g{ws + WS_HID, ws + WS_W2T, 1024, F8_W_SC, F8_H_SC, nullptr};
        pg8::TileOrder S; S.init(ntile, 4, G, (int)blockIdx.x, TILEE, 4);
        pg8::EpiGateF8 E{ws + WS_YS, args.in[29], (const float*)(ws + WS_ROWGATE), TILEE};
        for (int rep = 0; rep < NREP(8); ++rep) pg8::gemm_phase<true, false>(lds, g, S, E);
    } SEAM(8);
    if (IN(9)) { p9_combine(args, G); }
#undef IN
#undef SEAM
}

extern "C" void kernel_launch(void* const* d_in, const int* in_sizes, int n_in, void* d_out, int out_size, void* d_ws, size_t ws_size, hipStream_t stream) {
    static int grid = 0;
    if (grid == 0) {
        if (n_in != 30 || in_sizes[0] != T * D || out_size != T * D || ws_size < WS_END) { fprintf(stderr, "kernel_launch: unexpected shapes (n_in %d, in0 %d, out %d, ws %zu); nothing launched\n", n_in, n_in > 0 ? in_sizes[0] : -1, out_size, ws_size); grid = -1; return; }
        int dev = 0, cus = 0, per_cu = 0;
        if (hipGetDevice(&dev) != hipSuccess || hipDeviceGetAttribute(&cus, hipDeviceAttributeMultiprocessorCount, dev) != hipSuccess) { grid = -1; return; }
        if (hipFuncSetAttribute((const void*)hymba_fwd, hipFuncAttributeMaxDynamicSharedMemorySize, LDS_BYTES) != hipSuccess) { fprintf(stderr, "kernel_launch: hipFuncSetAttribute failed\n"); grid = -1; return; }
        if (hipOccupancyMaxActiveBlocksPerMultiprocessor(&per_cu, (const void*)hymba_fwd, 512, LDS_BYTES) != hipSuccess || per_cu < 1) { fprintf(stderr, "kernel_launch: occupancy query says %d\n", per_cu); per_cu = 1; }
        (void)hipGetLastError();
        grid = cus;
        if (grid > 256) grid = 256;
        if (grid != 256 || T % grid != 0 || (T / grid) % 16 != 0) { fprintf(stderr, "kernel_launch: grid %d does not divide the token count evenly\n", grid); grid = -1; return; }
    }
    if (grid < 0) return;
    (void)hipMemsetAsync((char*)d_ws + WS_CTL, 0, CTL_ZERO_BYTES, stream);
    Args a{};
    for (int i = 0; i < 30; ++i) a.in[i] = (const float*)d_in[i];
    a.out = (float*)d_out; a.ws = (unsigned char*)d_ws;
    constexpr int NL = MK_N_LAUNCHES;
    for (int li = 0; li < NL; ++li) {
        a.ph_lo = (NL == 1) ? 0 : li; a.ph_hi = (NL == 1) ? NPHASE : li + 1;
        void* kargs[] = {&a};
        hipError_t e = hipLaunchCooperativeKernel((const void*)hymba_fwd, dim3(grid), dim3(512), kargs, LDS_BYTES, stream);
        if (e != hipSuccess) { fprintf(stderr, "kernel_launch: cooperative launch %d failed: %s (grid %d)\n", li, hipGetErrorString(e), grid); break; }
    }
}
```

```cpp
#include <hip/hip_runtime.h>
#include <hip/hip_cooperative_groups.h>
#include <cstdio>
#include <cstdint>
#include <type_traits>
namespace cg = cooperative_groups;

#ifndef REP_PHASE
#define REP_PHASE -1
#endif
#ifndef TIME_REGION
#define TIME_REGION -1
#endif
#ifndef MK_N_LAUNCHES
#define MK_N_LAUNCHES 1
#endif

#define LAS __attribute__((address_space(3)))
#define GAS __attribute__((address_space(1)))
typedef unsigned short bf16_t;
typedef short bf16x8 __attribute__((ext_vector_type(8)));
typedef short s16x4 __attribute__((ext_vector_type(4)));
typedef float f32x2 __attribute__((ext_vector_type(2)));
typedef float f32x4 __attribute__((ext_vector_type(4)));
typedef float f32x16 __attribute__((ext_vector_type(16)));
typedef unsigned u32x2 __attribute__((ext_vector_type(2)));
typedef unsigned u32x4 __attribute__((ext_vector_type(4)));
typedef int v8i32 __attribute__((ext_vector_type(8)));

constexpr int NB = 8, SEQ = 4096, T = NB * SEQ, D = 1024;
constexpr int CW = 512;
constexpr int NRW = 1696, NIN = 3232, NINP = 3328;
constexpr int DQ0 = 1696, DK0 = 2208, DV0 = 2720;
constexpr int NE = 32, TOPK = 4, DE = 1024;
constexpr int MAXROWS = T * TOPK + NE * 256;
constexpr int MAXTILES = MAXROWS / 256;
constexpr float LOG2E = 1.4426950408889634f;
constexpr float F8_W_MUL = 32.f, F8_X_MUL = 8.f, F8_H_MUL = 4.f, F8_Y_MUL = 16.f; constexpr int F8_W_SC = 0x7A7A7A7A, F8_X_SC = 0x7C7C7C7C, F8_H_SC = 0x7D7D7D7D;

constexpr size_t MiB = 1u << 20;
constexpr size_t WS_CTL = 0, CTL_ZERO_BYTES = 64 * 1024;
constexpr size_t WS_TILEE = 512 * 1024;
constexpr size_t WS_WINT = 1 * MiB;
constexpr size_t WS_WOUT = 8 * MiB;
constexpr size_t WS_W1T = 10 * MiB;
constexpr size_t WS_W2T = 138 * MiB;
constexpr size_t WS_EIDX = 202 * MiB;
constexpr size_t WS_GATE = WS_EIDX + 512 * 1024;
constexpr size_t WS_POS = WS_GATE + 512 * 1024;
constexpr size_t WS_DEST = WS_POS + 512 * 1024;
constexpr size_t WS_ROWGATE = 204 * MiB;
constexpr size_t WS_XN = 206 * MiB;
constexpr size_t WS_P = 270 * MiB;
constexpr size_t WS_SR = 478 * MiB, WS_SK = 510 * MiB, WS_SV = 542 * MiB, WS_SA = 574 * MiB, WS_SB = 606 * MiB;
constexpr size_t WS_SW = 638 * MiB;
constexpr size_t WS_SG = 702 * MiB;
constexpr size_t WS_QN = 734 * MiB, WS_KN = 766 * MiB;
constexpr size_t WS_YMIX = 798 * MiB;
constexpr size_t WS_H2 = 206 * MiB;
constexpr size_t WS_ROWTOK = 270 * MiB;
constexpr size_t WS_HID = 406 * MiB;
constexpr size_t WS_YS = 542 * MiB;
constexpr size_t WS_YRAW = 862 * MiB;
constexpr size_t WS_X1B = 862 * MiB;
constexpr size_t WS_CG = 862 * MiB;
constexpr size_t WS_CH = 894 * MiB;
constexpr size_t WS_CR2 = 926 * MiB;
constexpr size_t WS_CY0 = 958 * MiB;
constexpr size_t WS_RK = 990 * MiB;
constexpr size_t WS_END = 992 * MiB;
constexpr int CW_CNT = 64;
constexpr int CW_ATTQ = 128;
constexpr int CW_BAR = 4096;

constexpr int RING_BYTES = 131072, MISC_OFF = RING_BYTES, LDS_BYTES = 147456;

__device__ __forceinline__ unsigned f2bf(float f) { unsigned u = __builtin_bit_cast(unsigned, f); return (u + 0x7fffu + ((u >> 16) & 1u)) >> 16; }
typedef __bf16 hwbf16x2 __attribute__((ext_vector_type(2)));
__device__ __forceinline__ unsigned pk2(float lo, float hi) { const f32x2 v = {lo, hi}; return __builtin_bit_cast(unsigned, __builtin_convertvector(v, hwbf16x2)); }
__device__ __forceinline__ unsigned pk4_fp8(float a, float b, float c, float d) {
    a = fminf(fmaxf(a, -448.f), 448.f); b = fminf(fmaxf(b, -448.f), 448.f); c = fminf(fmaxf(c, -448.f), 448.f); d = fminf(fmaxf(d, -448.f), 448.f);
    int r = __builtin_amdgcn_cvt_pk_fp8_f32(a, b, 0, false); r = __builtin_amdgcn_cvt_pk_fp8_f32(c, d, r, true); return (unsigned)r; }
__device__ __forceinline__ float bf2f(unsigned short b) { return __builtin_bit_cast(float, (unsigned)b << 16); }
__device__ __forceinline__ float bflo(unsigned w) { return __builtin_bit_cast(float, w << 16); }
__device__ __forceinline__ float bfhi(unsigned w) { return __builtin_bit_cast(float, w & 0xffff0000u); }
__device__ __forceinline__ float wave_sum(float v) {
#pragma unroll
    for (int o = 1; o < 64; o <<= 1) v += __shfl_xor(v, o);
    return v;
}
__device__ __forceinline__ float sigmoidf_(float x) { return 1.0f / (1.0f + __expf(-x)); }
template <int CTRL> __device__ __forceinline__ float dpp_f(float v) { return __builtin_bit_cast(float, __builtin_amdgcn_update_dpp(0, __builtin_bit_cast(int, v), CTRL, 0xF, 0xF, true)); }
__device__ __forceinline__ float red8(float v) {
    v += dpp_f<0xB1>(v);
    v += dpp_f<0x4E>(v);
    v += dpp_f<0x141>(v);
    return v;
}
__device__ __forceinline__ float red4(float v) { v += dpp_f<0xB1>(v); v += dpp_f<0x4E>(v); return v; }


#define XB_TMO      128
#define XB_XCNT(j)  (256  + 64 * (j))
#define XB_XSUB(j)  (1280 + 64 * (j))
#define XB_XGEN(j)  (2304 + 64 * (j))
#define XB_TOP      3328
#define XB_TOPGEN   3392
#define XCD_BAR_WORDS 3456
#define XB_SPIN_CAP (1u << 18)
__device__ __forceinline__ unsigned xb_ld(unsigned* p)              { return __hip_atomic_load(p, __ATOMIC_RELAXED, __HIP_MEMORY_SCOPE_AGENT); }
__device__ __forceinline__ unsigned xb_add(unsigned* p, unsigned v) { return __hip_atomic_fetch_add(p, v, __ATOMIC_RELAXED, __HIP_MEMORY_SCOPE_AGENT); }
__device__ __forceinline__ unsigned xb_xcc_id() { return (unsigned)__builtin_amdgcn_s_getreg((3 << 11) | 20) & 0xFu; }
#define XB_SPIN(cond, bar) do { unsigned _sp = 0; while (cond) { __builtin_amdgcn_s_sleep(1); \
    if ((++_sp & 255u) == 0u) { if (xb_ld(&(bar)[XB_TMO])) break; if (_sp > XB_SPIN_CAP) { atomicAdd(&(bar)[XB_TMO], 1u); break; } } } } while (0)
struct XcdBarrier { unsigned* bar; unsigned x; volatile LAS unsigned* st; };
__device__ __forceinline__ XcdBarrier xcd_barrier_post(unsigned* bar, volatile LAS unsigned* st) {
    XcdBarrier b; b.bar = bar; b.x = xb_xcc_id(); b.st = st;
    if (threadIdx.x == 0) (void)xb_add(&bar[XB_XCNT(b.x)], 1u);
    return b;
}
__device__ __forceinline__ void xcd_barrier_complete(unsigned* bar, unsigned x, unsigned& nloc, unsigned& nx) {
    const unsigned G = gridDim.x * gridDim.y * gridDim.z;
    unsigned sum, cnt, mine, sp = 0u;
    for (;;) {
        sum = 0u; cnt = 0u; mine = 0u;
#pragma unroll
        for (unsigned j = 0; j < 16; ++j) { const unsigned c = xb_ld(&bar[XB_XCNT(j)]); sum += c; cnt += (c > 0u) ? 1u : 0u; mine = (j == x) ? c : mine; }
        if (sum == G) break;
        __builtin_amdgcn_s_sleep(1);
        if ((++sp & 255u) == 0u) { if (xb_ld(&bar[XB_TMO])) break; if (sp > XB_SPIN_CAP) { atomicAdd(&bar[XB_TMO], 1u); break; } }
    }
    nloc = mine > 0u ? mine : 1u; nx = cnt > 0u ? cnt : 1u;
}
__device__ __forceinline__ void xcd_barrier(const XcdBarrier& b) {
    asm volatile("s_waitcnt vmcnt(0)" ::: "memory");
    __syncthreads();
    if (threadIdx.x == 0) {
        unsigned* bar = b.bar;
        __builtin_amdgcn_s_waitcnt(0);
        unsigned nloc = b.st[0], nx = b.st[1];
        if (nloc == 0u) { xcd_barrier_complete(bar, b.x, nloc, nx); b.st[0] = nloc; b.st[1] = nx; }
        const unsigned old = xb_add(&bar[XB_XSUB(b.x)], 1u);
        const unsigned gen = old / nloc;
        if (old + 1u == (gen + 1u) * nloc) {
            __builtin_amdgcn_fence(__ATOMIC_RELEASE, "agent");
            asm volatile("s_waitcnt vmcnt(0)" ::: "memory");
            const unsigned og = xb_add(&bar[XB_TOP], 1u);
            const unsigned tg = og / nx;
            if (og + 1u == (tg + 1u) * nx) xb_add(&bar[XB_TOPGEN], 1u);
            else XB_SPIN(xb_ld(&bar[XB_TOPGEN]) == tg, bar);
            __builtin_amdgcn_fence(__ATOMIC_ACQUIRE, "agent");
            xb_add(&bar[XB_XGEN(b.x)], 1u);
            asm volatile("s_waitcnt vmcnt(0)" ::: "memory");
        } else {
            XB_SPIN(xb_ld(&bar[XB_XGEN(b.x)]) == gen, bar);
            __builtin_amdgcn_fence(__ATOMIC_ACQUIRE, "agent");
            asm volatile("s_waitcnt vmcnt(0)" ::: "memory");
        }
    }
    __syncthreads();
}

namespace pg8 {
constexpr int BM = 256, BK = 64, HALF = 128, HTB = HALF * BK * 2, STAGE_BYTES = 8 * HTB, NXCD = 8, WGM = 8;
__host__ __device__ __forceinline__ int lds_byte(int r, int c) { const int st = (r >> 4) * 2 + (c >> 5), rr = r & 15, cc = c & 31, ob = rr * 64 + cc * 2; return st * 1024 + (ob ^ (((ob >> 9) & 1) << 5)); }
__host__ __device__ __forceinline__ void stage_rc(int b, int& R, int& C) { const int st = b / 1024, sb = b % 1024, swz = sb ^ (((sb >> 9) & 1) << 5); R = (st >> 1) * 16 + swz / 64; C = (st & 1) * 32 + (swz % 64) / 2; }
__host__ __device__ __forceinline__ int perm32(int rho) { const int n = rho >> 4, i = rho & 15; return 8 * (i >> 2) + 4 * n + (i & 3); }

struct Unit { int pm, pn, pb; };
struct Gemm { const void* A; const void* Bt; int K; int scW, scA; const int* rowtok; };

struct TileOrder {
    int nM, nN, nwg, G, c; const int* tile_e; int nb_per_e;
    __device__ void init(int nM_, int nN_, int G_, int c_, const int* te, int nbe) { nM = nM_; nN = nN_; nwg = nM * nN; G = G_; c = c_; tile_e = te; nb_per_e = nbe; }
    __device__ bool next(int i, Unit& u) const {
        const long L = (long)i * G + c; if (L >= nwg) return false;
        int wgid = (int)L; { const int q = nwg / NXCD, r = nwg % NXCD, xcd = wgid % NXCD, off = wgid / NXCD; wgid = (xcd < r ? xcd * (q + 1) : r * (q + 1) + (xcd - r) * q) + off; }
        const int nig = WGM * nN, gid = wgid / nig, fm = gid * WGM, gsz = (nM - fm) < WGM ? (nM - fm) : WGM;
        u.pm = fm + ((wgid % nig) % gsz); u.pn = (wgid % nig) / gsz;
        u.pb = tile_e ? tile_e[u.pm] * nb_per_e + u.pn : u.pn;
        return true;
    }
};

struct EpiBf16 {
    static constexpr bool PERM = true;
    bf16_t* O; int ldc;
    __device__ __forceinline__ void operator()(const f32x4 (&acc)[2][2][4][2], const Unit& u, int wr, int wc, int fr, int fq) const {
        const int row0 = u.pm * BM + wr * 64 + fr; const int col0 = u.pn * BM + wc * 32 + 8 * fq;
#pragma unroll
        for (int ai = 0; ai < 2; ++ai)
#pragma unroll
            for (int m = 0; m < 4; ++m) { bf16_t* rowp = O + (size_t)(row0 + ai * HALF + m * 16) * ldc + col0;
#pragma unroll
                for (int bj = 0; bj < 2; ++bj) { const f32x4 v0 = acc[ai][bj][m][0], v1 = acc[ai][bj][m][1];
                    u32x4 w; w.x = pk2(v0[0], v0[1]); w.y = pk2(v0[2], v0[3]); w.z = pk2(v1[0], v1[1]); w.w = pk2(v1[2], v1[3]);
                    *(u32x4*)(rowp + bj * HALF) = w; } }
    }
};
struct EpiResBf16 {
    static constexpr bool PERM = true;
    const float* base; bf16_t* out; int ldc;
    __device__ __forceinline__ void operator()(const f32x4 (&acc)[2][2][4][2], const Unit& u, int wr, int wc, int fr, int fq) const {
        const int col0 = u.pn * BM + wc * 32 + 8 * fq;
#pragma unroll
        for (int ai = 0; ai < 2; ++ai)
#pragma unroll
            for (int m = 0; m < 4; ++m) { const size_t off = (size_t)(u.pm * BM + ai * HALF + wr * 64 + m * 16 + fr) * ldc + col0;
#pragma unroll
                for (int bj = 0; bj < 2; ++bj) { const f32x4 b0 = *(const f32x4*)(base + off + bj * HALF), b1 = *(const f32x4*)(base + off + bj * HALF + 4);
                    const f32x4 v0 = b0 + acc[ai][bj][m][0], v1 = b1 + acc[ai][bj][m][1];
                    u32x4 w; w.x = pk2(v0[0], v0[1]); w.y = pk2(v0[2], v0[3]); w.z = pk2(v1[0], v1[1]); w.w = pk2(v1[2], v1[3]);
                    *(u32x4*)(out + off + bj * HALF) = w; } }
    }
};
struct EpiSwiglu {
    static constexpr bool PERM = true;
    unsigned char* O; const float* b1; const int* tile_e;
    __device__ __forceinline__ void operator()(const f32x4 (&acc)[2][2][4][2], const Unit& u, int wr, int wc, int fr, int fq) const {
        const int e = tile_e[u.pm]; const int row0 = u.pm * BM + wr * 64 + fr; const int hc0 = u.pn * 128 + wc * 32 + 8 * fq;
        const float* bg = b1 + (size_t)e * 2048 + hc0; const float* bl = bg + 1024;
        const f32x4 g0 = *(const f32x4*)bg, g1 = *(const f32x4*)(bg + 4), l0 = *(const f32x4*)bl, l1 = *(const f32x4*)(bl + 4);
#pragma unroll
        for (int ai = 0; ai < 2; ++ai)
#pragma unroll
            for (int m = 0; m < 4; ++m) { unsigned char* rowp = O + (size_t)(row0 + ai * HALF + m * 16) * 1024 + hc0;
                float o[8];
#pragma unroll
                for (int n = 0; n < 2; ++n) { const f32x4 gv = acc[ai][0][m][n] + (n ? g1 : g0), lv = acc[ai][1][m][n] + (n ? l1 : l0);
#pragma unroll
                    for (int i = 0; i < 4; ++i) { const float g = fminf(gv[i], 7.0f), l = fminf(fmaxf(lv[i], -7.0f), 7.0f);
                        const float sg = __builtin_amdgcn_rcpf(1.0f + __builtin_amdgcn_exp2f(-1.702f * LOG2E * g)); o[n * 4 + i] = g * sg * (l + 1.0f); } }
                u32x2 w; w.x = pk4_fp8(o[0] * F8_H_MUL, o[1] * F8_H_MUL, o[2] * F8_H_MUL, o[3] * F8_H_MUL); w.y = pk4_fp8(o[4] * F8_H_MUL, o[5] * F8_H_MUL, o[6] * F8_H_MUL, o[7] * F8_H_MUL);
                *(u32x2*)rowp = w; }
    }
};
struct EpiGateF8 {
    static constexpr bool PERM = true;
    unsigned char* O; const float* b2; const float* rowgate; const int* tile_e;
    __device__ __forceinline__ void operator()(const f32x4 (&acc)[2][2][4][2], const Unit& u, int wr, int wc, int fr, int fq) const {
        const int e = tile_e[u.pm]; const int row0 = u.pm * BM + wr * 64 + fr; const int col0 = u.pn * BM + wc * 32 + 8 * fq;
        f32x4 bv[2][2];
#pragma unroll
        for (int bj = 0; bj < 2; ++bj)
#pragma unroll
            for (int n = 0; n < 2; ++n) bv[bj][n] = *(const f32x4*)(b2 + (size_t)e * 1024 + col0 + bj * HALF + 4 * n);
#pragma unroll
        for (int ai = 0; ai < 2; ++ai)
#pragma unroll
            for (int m = 0; m < 4; ++m) { const int row = row0 + ai * HALF + m * 16; const float gt = rowgate[row] * F8_Y_MUL; unsigned char* rowp = O + (size_t)row * 1024 + col0;
#pragma unroll
                for (int bj = 0; bj < 2; ++bj) { const f32x4 v0 = (acc[ai][bj][m][0] + bv[bj][0]) * gt, v1 = (acc[ai][bj][m][1] + bv[bj][1]) * gt;
                    u32x2 w; w.x = pk4_fp8(v0[0], v0[1], v0[2], v0[3]); w.y = pk4_fp8(v1[0], v1[1], v1[2], v1[3]);
                    *(u32x2*)(rowp + bj * HALF) = w; } }
    }
};

template <bool F8, bool GATHER, class Epi, class Sched>
__device__ __forceinline__ void gemm_phase(LAS unsigned char* lds, const Gemm g, const Sched& S, const Epi& E) {
    const int tid = threadIdx.x, wid = __builtin_amdgcn_readfirstlane(tid >> 6), lane = tid & 63, wr = wid >> 2, wc = wid & 3, fr = lane & 15, fq = lane >> 4;
    const int RB = F8 ? g.K : g.K * 2, nt = RB / 128;
    unsigned voffB[2];
#pragma unroll
    for (int i = 0; i < 2; ++i) { int R, C; stage_rc(tid * 16 + i * 8192, R, C); const int Rb = Epi::PERM ? ((R & ~31) + perm32(R & 31)) : R;
        voffB[i] = (unsigned)(Rb * RB + C * 2); }
#define PG8_AOFFS(dst, pm_) do { _Pragma("unroll") for (int h_ = 0; h_ < 2; ++h_) _Pragma("unroll") for (int i_ = 0; i_ < 2; ++i_) { int R_, C_; stage_rc(tid * 16 + i_ * 8192, R_, C_); \
        const int row_ = (pm_) * BM + h_ * HALF + R_; const unsigned grow_ = GATHER ? (unsigned)g.rowtok[row_] : (unsigned)row_; dst[h_][i_] = grow_ * (unsigned)RB + (unsigned)(C_ * 2); } } while (0)
    unsigned cvA[2][2], nvA[2][2];
    const size_t kstep = (size_t)(BK * 2);
    const size_t hstep = (size_t)HALF * RB;
    const size_t tstep = 2 * hstep;
    const unsigned ldsw = (unsigned)wid * 1024u;
    const int aoff = F8 ? lds_byte(wr * 64 + fr, (fq & 1) * 16) + (fq >> 1) * 1024 : lds_byte(wr * 64 + fr, fq * 8);
    const int boff = F8 ? lds_byte(wc * 32 + fr, (fq & 1) * 16) + (fq >> 1) * 1024 : lds_byte(wc * 32 + fr, fq * 8);
    const int scW = g.scW, scA = g.scA;
#define PG8_SA(b, h) (((b) * 2 + (h)) * HTB)
#define PG8_SB(b, h) ((4 + (b) * 2 + (h)) * HTB)
#define PG8_STAGE(bufoff, gbase, voff) do { _Pragma("unroll") for (int _i = 0; _i < 2; ++_i) \
        __builtin_amdgcn_global_load_lds((const unsigned*)((const char*)(gbase) + (voff)[_i]), (LAS unsigned*)(lds + (bufoff) + ldsw + _i * 8192), 16, 0, 0); } while (0)
typedef int v8i32a __attribute__((ext_vector_type(8), aligned(16)));
#define PG8_LD32(p) (*(const LAS v8i32a*)(p))
#define PG8_STAGE_A(bufoff, kptr, offs) do { _Pragma("unroll") for (int _i = 0; _i < 2; ++_i) \
        __builtin_amdgcn_global_load_lds((const unsigned*)((const char*)(kptr) + (offs)[_i]), (LAS unsigned*)(lds + (bufoff) + ldsw + _i * 8192), 16, 0, 0); } while (0)
#define PG8_LDA(dst, b, h) do { _Pragma("unroll") for (int m = 0; m < 4; ++m) { if constexpr (F8) { dst[m].f8 = __builtin_bit_cast(v8i32, PG8_LD32(lds + PG8_SA(b, h) + aoff + m * 2048)); } \
        else { _Pragma("unroll") for (int k = 0; k < 2; ++k) dst[m].hv[k] = *(const LAS bf16x8*)(lds + PG8_SA(b, h) + aoff + m * 2048 + k * 1024); } } } while (0)
#define PG8_LDB(dst, b, h) do { _Pragma("unroll") for (int n = 0; n < 2; ++n) { if constexpr (F8) { dst[n].f8 = __builtin_bit_cast(v8i32, PG8_LD32(lds + PG8_SB(b, h) + boff + n * 2048)); } \
        else { _Pragma("unroll") for (int k = 0; k < 2; ++k) dst[n].hv[k] = *(const LAS bf16x8*)(lds + PG8_SB(b, h) + boff + n * 2048 + k * 1024); } } } while (0)
#define PG8_MMA(ai, bj, At, Bt) do { __builtin_amdgcn_s_setprio(1); _Pragma("unroll") for (int m = 0; m < 4; ++m) _Pragma("unroll") for (int n = 0; n < 2; ++n) { \
        if constexpr (F8) { asm volatile("v_mfma_scale_f32_16x16x128_f8f6f4 %0, %1, %2, %0, %3, %4 op_sel_hi:[0,0,0]" : "+v"(acc[ai][bj][m][n]) : "v"(Bt[n].f8), "v"(At[m].f8), "v"(scW), "v"(scA)); } \
        else { _Pragma("unroll") for (int k = 0; k < 2; ++k) acc[ai][bj][m][n] = __builtin_amdgcn_mfma_f32_16x16x32_bf16(Bt[n].hv[k], At[m].hv[k], acc[ai][bj][m][n], 0, 0, 0); } } \
        __builtin_amdgcn_s_setprio(0); } while (0)
#define PG8_WAIT_V(n) asm volatile("s_waitcnt vmcnt(" #n ")" ::: "memory")
#define PG8_WAIT_L(n) asm volatile("s_waitcnt lgkmcnt(" #n ")" ::: "memory")
#define PG8_BAR __builtin_amdgcn_s_barrier()
#define PG8_SCHED __builtin_amdgcn_sched_barrier(0)
    Unit cur, nxt; int ui = 0;
    if (!S.next(0, cur)) return;
    f32x4 acc[2][2][4][2];
#pragma unroll
    for (int a = 0; a < 2; ++a)
#pragma unroll
        for (int b = 0; b < 2; ++b)
#pragma unroll
            for (int m = 0; m < 4; ++m)
#pragma unroll
                for (int n = 0; n < 2; ++n) acc[a][b][m][n] = (f32x4){0.f, 0.f, 0.f, 0.f};
    struct FragH { bf16x8 hv[2]; }; struct Frag8 { v8i32 f8; };
    typename std::conditional<F8, Frag8, FragH>::type At[4], B0[2], B1[2];
    const char* const kA = (const char*)g.A; const char* cB = (const char*)g.Bt + (size_t)cur.pb * tstep;
    PG8_AOFFS(cvA, cur.pm);
    PG8_STAGE(PG8_SB(0, 0), cB, voffB); PG8_STAGE(PG8_SB(0, 1), cB + hstep, voffB); PG8_STAGE_A(PG8_SA(0, 0), kA, cvA[0]); PG8_STAGE_A(PG8_SA(0, 1), kA, cvA[1]);
    if (wr == 1) PG8_BAR;
    PG8_WAIT_V(2); PG8_BAR;
    PG8_STAGE(PG8_SB(1, 0), cB + kstep, voffB); PG8_STAGE_A(PG8_SA(1, 0), kA + kstep, cvA[0]); PG8_STAGE(PG8_SB(1, 1), cB + hstep + kstep, voffB);
    PG8_WAIT_V(6); PG8_BAR;
    for (;;) {
        const bool has_next = S.next(ui + 1, nxt);
        const char* nB = has_next ? (const char*)g.Bt + (size_t)nxt.pb * tstep : cB;
        if (has_next) { PG8_AOFFS(nvA, nxt.pm); } else { _Pragma("unroll") for (int h_ = 0; h_ < 2; ++h_) _Pragma("unroll") for (int i_ = 0; i_ < 2; ++i_) nvA[h_][i_] = cvA[h_][i_]; }
#pragma clang loop unroll(disable)
        for (int t = 0; t < nt; t += 2) {
            const bool last = (t == nt - 2);
            const char* a1 = kA + (size_t)(t + 1) * kstep;
            const char* a2 = last ? kA : kA + (size_t)(t + 2) * kstep; const char* b2 = last ? nB : cB + (size_t)(t + 2) * kstep;
            const char* a3 = a2 + kstep; const char* b3 = b2 + kstep;
            unsigned v2A[2][2];
#pragma unroll
            for (int h_ = 0; h_ < 2; ++h_)
#pragma unroll
                for (int i_ = 0; i_ < 2; ++i_) v2A[h_][i_] = last ? nvA[h_][i_] : cvA[h_][i_];
            PG8_LDB(B0, 0, 0); PG8_LDB(B1, 0, 1); PG8_SCHED; PG8_LDA(At, 0, 0); PG8_STAGE_A(PG8_SA(1, 1), a1, cvA[1]);
            PG8_WAIT_V(8); PG8_WAIT_L(0); PG8_BAR; PG8_MMA(0, 0, At, B0); PG8_MMA(0, 1, At, B1); PG8_BAR; PG8_SCHED;
            PG8_LDA(At, 0, 1); PG8_STAGE(PG8_SB(0, 0), b2, voffB); PG8_STAGE(PG8_SB(0, 1), b2 + hstep, voffB); PG8_STAGE_A(PG8_SA(0, 0), a2, v2A[0]);
            PG8_WAIT_V(8); PG8_WAIT_L(0); PG8_BAR; PG8_MMA(1, 0, At, B0); PG8_MMA(1, 1, At, B1); PG8_BAR; PG8_SCHED;
            PG8_LDB(B0, 1, 0); PG8_LDB(B1, 1, 1); PG8_SCHED; PG8_LDA(At, 1, 0); PG8_STAGE_A(PG8_SA(0, 1), a2, v2A[1]);
            PG8_WAIT_V(8); PG8_WAIT_L(0); PG8_BAR; PG8_MMA(0, 0, At, B0); PG8_MMA(0, 1, At, B1); PG8_BAR; PG8_SCHED;
            PG8_LDA(At, 1, 1); PG8_STAGE(PG8_SB(1, 0), b3, voffB); PG8_STAGE(PG8_SB(1, 1), b3 + hstep, voffB); PG8_STAGE_A(PG8_SA(1, 0), a3, v2A[0]);
            PG8_WAIT_V(8); PG8_WAIT_L(0); PG8_BAR; PG8_MMA(1, 0, At, B0); PG8_MMA(1, 1, At, B1); PG8_BAR; PG8_SCHED;
        }
        if (wr == 0) PG8_BAR;
        if constexpr (F8) asm volatile("s_nop 15\n\ts_nop 15" ::: "memory");
        E(acc, cur, wr, wc, fr, fq);
        if (!has_next) break;
#pragma unroll
        for (int a = 0; a < 2; ++a)
#pragma unroll
            for (int b = 0; b < 2; ++b)
#pragma unroll
                for (int m = 0; m < 4; ++m)
#pragma unroll
                    for (int n = 0; n < 2; ++n) acc[a][b][m][n] = (f32x4){0.f, 0.f, 0.f, 0.f};
        cur = nxt; cB = nB; ++ui;
#pragma unroll
        for (int h_ = 0; h_ < 2; ++h_)
#pragma unroll
            for (int i_ = 0; i_ < 2; ++i_) cvA[h_][i_] = nvA[h_][i_];
        if (wr == 1) PG8_BAR;
    }
    PG8_WAIT_V(0);
    PG8_BAR;
#undef PG8_SA
#undef PG8_SB
#undef PG8_STAGE
#undef PG8_STAGE_A
#undef PG8_AOFFS
#undef PG8_LDA
#undef PG8_LDB
#undef PG8_MMA
#undef PG8_LD32
#undef PG8_WAIT_V
#undef PG8_WAIT_L
#undef PG8_BAR
#undef PG8_SCHED
}
}

struct Args { const float* in[30]; float* out; unsigned char* ws; int ph_lo, ph_hi; };

__device__ __forceinline__ void p0_transpose_item(const float* W, int K, int N, bf16_t* WT, int k0, int n0, int drow0, LAS float* scr, int lane) {
#pragma unroll 8
    for (int i = 0; i < 32; ++i) { const int kk = 2 * i + (lane >> 5); scr[kk * 33 + (lane & 31)] = W[(size_t)(k0 + kk) * N + n0 + (lane & 31)]; }
    asm volatile("s_waitcnt lgkmcnt(0)" ::: "memory");
    const int c = lane & 7;
#pragma unroll
    for (int j = 0; j < 4; ++j) { const int n = (lane >> 3) + 8 * j; const LAS float* s = scr + (8 * c) * 33 + n;
        u32x4 o; o.x = pk2(s[0 * 33], s[1 * 33]); o.y = pk2(s[2 * 33], s[3 * 33]); o.z = pk2(s[4 * 33], s[5 * 33]); o.w = pk2(s[6 * 33], s[7 * 33]);
        *(u32x4*)(WT + (size_t)(drow0 + n) * K + k0 + 8 * c) = o; }
    asm volatile("s_waitcnt lgkmcnt(0)" ::: "memory");
}
__device__ __forceinline__ void p0_transpose_item_f8(const float* W, int K, int N, unsigned char* WT, int k0, int n0, int drow0, LAS float* scr, int lane) {
#pragma unroll 8
    for (int i = 0; i < 32; ++i) { const int kk = 2 * i + (lane >> 5); scr[kk * 33 + (lane & 31)] = W[(size_t)(k0 + kk) * N + n0 + (lane & 31)]; }
    asm volatile("s_waitcnt lgkmcnt(0)" ::: "memory");
    const int c = lane & 3;
#pragma unroll
    for (int j = 0; j < 2; ++j) { const int n = (lane >> 2) + 16 * j; const LAS float* s = scr + (16 * c) * 33 + n;
        u32x4 o;
        o.x = pk4_fp8(s[0 * 33] * F8_W_MUL, s[1 * 33] * F8_W_MUL, s[2 * 33] * F8_W_MUL, s[3 * 33] * F8_W_MUL);
        o.y = pk4_fp8(s[4 * 33] * F8_W_MUL, s[5 * 33] * F8_W_MUL, s[6 * 33] * F8_W_MUL, s[7 * 33] * F8_W_MUL);
        o.z = pk4_fp8(s[8 * 33] * F8_W_MUL, s[9 * 33] * F8_W_MUL, s[10 * 33] * F8_W_MUL, s[11 * 33] * F8_W_MUL);
        o.w = pk4_fp8(s[12 * 33] * F8_W_MUL, s[13 * 33] * F8_W_MUL, s[14 * 33] * F8_W_MUL, s[15 * 33] * F8_W_MUL);
        *(u32x4*)(WT + (size_t)(drow0 + n) * K + k0 + 16 * c) = o; }
    asm volatile("s_waitcnt lgkmcnt(0)" ::: "memory");
}
__device__ __forceinline__ void p0_prologue(LAS unsigned char* lds, const Args& a, int G) {
    const int tid = threadIdx.x, lane = tid & 63, wave = __builtin_amdgcn_readfirstlane(tid >> 6);
    LAS float* scr = (LAS float*)(lds + wave * 16384);
    const int gw = blockIdx.x * 8 + wave, NGW = G * 8;
    unsigned char* ws = a.ws;
    bf16_t* Wint = (bf16_t*)(ws + WS_WINT); bf16_t* Woutt = (bf16_t*)(ws + WS_WOUT); unsigned char* W1t = ws + WS_W1T; unsigned char* W2t = ws + WS_W2T;
    constexpr int I_IN = 16 * (NIN / 32);
    constexpr int I_OUT = 16 * 32;
    constexpr int I_W1 = 16 * 64;
    constexpr int I_W2 = 16 * 32;
    constexpr int NITEMS = I_IN + I_OUT + NE * I_W1 + NE * I_W2;
    for (int it = gw; it < NITEMS; it += NGW) {
        int r = it;
        if (r < I_IN) { const int nblk = NIN / 32, kb = r / nblk, nb = r % nblk; p0_transpose_item(a.in[2], 1024, NIN, Wint, 64 * kb, 32 * nb, 32 * nb, scr, lane); continue; } r -= I_IN;
        if (r < I_OUT) { const int kb = r / 32, nb = r % 32; p0_transpose_item(a.in[22], 1024, 1024, Woutt, 64 * kb, 32 * nb, 32 * nb, scr, lane); continue; } r -= I_OUT;
        if (r < NE * I_W1) { const int e = r / I_W1, q = r % I_W1, kb = q / 64, nb = q % 64; const int n0 = 32 * nb;
            const int drow = (n0 < 1024) ? ((n0 >> 7) * 256 + (n0 & 127)) : (((n0 - 1024) >> 7) * 256 + 128 + ((n0 - 1024) & 127));
            p0_transpose_item_f8(a.in[26] + (size_t)e * 1024 * 2048, 1024, 2048, W1t + (size_t)e * 2048 * 1024, 64 * kb, n0, drow, scr, lane); continue; } r -= NE * I_W1;
        { const int e = r / I_W2, q = r % I_W2, kb = q / 32, nb = q % 32;
            p0_transpose_item_f8(a.in[28] + (size_t)e * 1024 * 1024, 1024, 1024, W2t + (size_t)e * 1024 * 1024, 64 * kb, 32 * nb, 32 * nb, scr, lane); }
    }
    const float* x = a.in[0]; const float* g1 = a.in[1]; bf16_t* XN = (bf16_t*)(ws + WS_XN);
    f32x4 gv[4];
#pragma unroll
    for (int j = 0; j < 4; ++j) gv[j] = *((const f32x4*)g1 + lane + 64 * j);
    for (int m = gw; m < T; m += NGW) {
        const f32x4* xr = (const f32x4*)(x + (size_t)m * D) + lane;
        f32x4 v[4]; float s = 0.f;
#pragma unroll
        for (int j = 0; j < 4; ++j) { v[j] = xr[64 * j]; s += (v[j].x * v[j].x + v[j].y * v[j].y) + (v[j].z * v[j].z + v[j].w * v[j].w); }
        const float rstd = 1.0f / sqrtf(wave_sum(s) * (1.0f / D) + 1e-5f);
        u32x2* o8 = (u32x2*)(XN + (size_t)m * D) + lane;
#pragma unroll
        for (int j = 0; j < 4; ++j) { u32x2 w; w.x = pk2(v[j].x * rstd * gv[j].x, v[j].y * rstd * gv[j].y); w.y = pk2(v[j].z * rstd * gv[j].z, v[j].w * rstd * gv[j].w); o8[64 * j] = w; }
    }
}

__device__ __forceinline__ f32x4 cvlo(const u32x4 u) { return (f32x4){bflo(u.x), bfhi(u.x), bflo(u.y), bfhi(u.y)}; }
__device__ __forceinline__ f32x4 cvhi(const u32x4 u) { return (f32x4){bflo(u.z), bfhi(u.z), bflo(u.w), bfhi(u.w)}; }
__device__ __forceinline__ u32x4 pk8(const f32x4 lo, const f32x4 hi) { u32x4 w; w.x = pk2(lo.x, lo.y); w.y = pk2(lo.z, lo.w); w.z = pk2(hi.x, hi.y); w.w = pk2(hi.z, hi.w); return w; }
__device__ __forceinline__ void p2_prep(LAS unsigned char* lds, const Args& a) {
    const int tid = threadIdx.x, lane = tid & 63, wave = __builtin_amdgcn_readfirstlane(tid >> 6);
    unsigned char* ws = a.ws;
    const bf16_t* P = (const bf16_t*)(ws + WS_P);
    bf16_t* SR = (bf16_t*)(ws + WS_SR); bf16_t* SK = (bf16_t*)(ws + WS_SK); bf16_t* SV = (bf16_t*)(ws + WS_SV); bf16_t* SA = (bf16_t*)(ws + WS_SA); bf16_t* SB = (bf16_t*)(ws + WS_SB);
    float* SW = (float*)(ws + WS_SW); bf16_t* SG = (bf16_t*)(ws + WS_SG); bf16_t* QN = (bf16_t*)(ws + WS_QN); bf16_t* KN = (bf16_t*)(ws + WS_KN);
    const float* mu = a.in[3]; const float* w0 = a.in[4]; const float* w2 = a.in[5]; const float* a0 = a.in[6]; const float* a2 = a.in[7]; const float* g2 = a.in[8];
    const float* k_k = a.in[9]; const float* k_a = a.in[10]; const float* qn_g = a.in[14]; const float* kn_g = a.in[15];
    LAS unsigned char* ACT = lds;
    LAS float* DEC = (LAS float*)(lds + 8192); LAS float* ALR = (LAS float*)(lds + 40960); LAS float* GG = (LAS float*)(lds + 73728);
    bf16x8 bw[4][5];
    const int fcol = lane & 15, fk = (lane >> 4) * 8;
#pragma unroll
    for (int cb = 0; cb < 4; ++cb) {
        const int col = wave * 64 + cb * 16 + fcol;
#pragma unroll
        for (int kb = 0; kb < 5; ++kb) {
            const float* src = (kb == 0) ? (w2 + (size_t)fk * CW + col) : (kb == 1) ? (a2 + (size_t)fk * CW + col) : (g2 + (size_t)((kb - 2) * 32 + fk) * CW + col);
            u32x4 w; w.x = pk2(src[0], src[CW]); w.y = pk2(src[2 * CW], src[3 * CW]); w.z = pk2(src[4 * CW], src[5 * CW]); w.w = pk2(src[6 * CW], src[7 * CW]);
            bw[cb][kb] = __builtin_bit_cast(bf16x8, w);
        }
    }
    float w0c[4], a0c[4];
#pragma unroll
    for (int cb = 0; cb < 4; ++cb) { w0c[cb] = w0[wave * 64 + cb * 16 + fcol]; a0c[cb] = a0[wave * 64 + cb * 16 + fcol]; }
    const int c8 = lane * 8;
    const int TPB = T / (int)gridDim.x;
    const int tb0 = blockIdx.x * TPB;
    for (int t0 = tb0; t0 < tb0 + TPB; t0 += 16) {
        if (tid < 320) {
            const int tok = tid / 20, ch = tid - tok * 20, t = t0 + tok, col = 1536 + ch * 8;
            const u32x4 cu = *(const u32x4*)(P + (size_t)t * NINP + col);
            u32x4 pu = (u32x4){0u, 0u, 0u, 0u};
            if (t & (SEQ - 1)) pu = *(const u32x4*)(P + (size_t)(t - 1) * NINP + col);
            const f32x4 m0 = *(const f32x4*)(mu + col), m1 = *(const f32x4*)(mu + col + 4);
            const f32x4 c0 = cvlo(cu), c1 = cvhi(cu), p0 = cvlo(pu), p1 = cvhi(pu);
            f32x4 s0 = c0 + (p0 - c0) * m0, s1 = c1 + (p1 - c1) * m1;
            if (ch < 4) {
#pragma unroll
                for (int i = 0; i < 4; ++i) { const float e0 = __expf(-2.0f * fabsf(s0[i])), e1 = __expf(-2.0f * fabsf(s1[i])); const float th0 = (1.0f - e0) / (1.0f + e0), th1 = (1.0f - e1) / (1.0f + e1);
                    s0[i] = s0[i] < 0.f ? -th0 : th0; s1[i] = s1[i] < 0.f ? -th1 : th1; }
            } else if (ch >= 8) {
#pragma unroll
                for (int i = 0; i < 4; ++i) { s0[i] = sigmoidf_(s0[i]); s1[i] = sigmoidf_(s1[i]); }
            }
            *(LAS u32x4*)(ACT + tok * 320 + ch * 16) = pk8(s0, s1);
        }
        __syncthreads();
        {
            bf16x8 af[5];
#pragma unroll
            for (int kb = 0; kb < 5; ++kb) af[kb] = *(const LAS bf16x8*)(ACT + fcol * 320 + kb * 64 + (lane >> 4) * 16);
#pragma unroll
            for (int cb = 0; cb < 4; ++cb) {
                const f32x4 z = {0.f, 0.f, 0.f, 0.f};
                const f32x4 aw = __builtin_amdgcn_mfma_f32_16x16x32_bf16(af[0], bw[cb][0], z, 0, 0, 0);
                const f32x4 aa = __builtin_amdgcn_mfma_f32_16x16x32_bf16(af[1], bw[cb][1], z, 0, 0, 0);
                f32x4 ag = __builtin_amdgcn_mfma_f32_16x16x32_bf16(af[2], bw[cb][2], z, 0, 0, 0);
                ag = __builtin_amdgcn_mfma_f32_16x16x32_bf16(af[3], bw[cb][3], ag, 0, 0, 0);
                ag = __builtin_amdgcn_mfma_f32_16x16x32_bf16(af[4], bw[cb][4], ag, 0, 0, 0);
                const int col = wave * 64 + cb * 16 + fcol;
#pragma unroll
                for (int i = 0; i < 4; ++i) { const int row = (lane >> 4) * 4 + i;
                    DEC[row * 512 + col] = __expf(-0.6065306597126334f * sigmoidf_(aw[i] + w0c[cb]));
                    ALR[row * 512 + col] = sigmoidf_(aa[i] + a0c[cb]);
                    GG[row * 512 + col] = ag[i]; }
            }
        }
        __syncthreads();
#pragma unroll 1
        for (int q = 0; q < 2; ++q) {
            const int tok = 2 * wave + q, t = t0 + tok; const size_t o = (size_t)t * CW + c8;
            const bf16_t* pr = P + (size_t)t * NINP + c8;
            const bool first = (t & (SEQ - 1)) == 0;
            const u32x4 zz = (u32x4){0u, 0u, 0u, 0u};
            f32x4 rr0, rr1;
            { const u32x4 cu = *(const u32x4*)(pr), pu = first ? zz : *(const u32x4*)(pr - NINP);
              const f32x4 m0 = *(const f32x4*)(mu + c8), m1 = *(const f32x4*)(mu + c8 + 4);
              const f32x4 c0 = cvlo(cu), c1 = cvhi(cu), p0 = cvlo(pu), p1 = cvhi(pu);
              rr0 = c0 + (p0 - c0) * m0; rr1 = c1 + (p1 - c1) * m1; *(u32x4*)(SR + o) = pk8(rr0, rr1); }
            { const u32x4 cu = *(const u32x4*)(pr + 1024), pu = first ? zz : *(const u32x4*)(pr - NINP + 1024);
              const f32x4 m0 = *(const f32x4*)(mu + 1024 + c8), m1 = *(const f32x4*)(mu + 1024 + c8 + 4);
              const f32x4 c0 = cvlo(cu), c1 = cvhi(cu), p0 = cvlo(pu), p1 = cvhi(pu);
              *(u32x4*)(SV + o) = pk8(c0 + (p0 - c0) * m0, c1 + (p1 - c1) * m1); }
            { const u32x4 cu = *(const u32x4*)(pr + 512), pu = first ? zz : *(const u32x4*)(pr - NINP + 512);
              const f32x4 m0 = *(const f32x4*)(mu + 512 + c8), m1 = *(const f32x4*)(mu + 512 + c8 + 4);
              const f32x4 c0 = cvlo(cu), c1 = cvhi(cu), p0 = cvlo(pu), p1 = cvhi(pu);
              const f32x4 k0 = c0 + (p0 - c0) * m0, k1 = c1 + (p1 - c1) * m1;
              const f32x4 kk0 = k0 * *(const f32x4*)(k_k + c8), kk1 = k1 * *(const f32x4*)(k_k + c8 + 4);
              float ss = (kk0.x * kk0.x + kk0.y * kk0.y) + (kk0.z * kk0.z + kk0.w * kk0.w) + (kk1.x * kk1.x + kk1.y * kk1.y) + (kk1.z * kk1.z + kk1.w * kk1.w);
              ss = red8(ss);
              const float inv = 1.0f / sqrtf(fmaxf(ss, 1e-24f));
              const f32x4 kn0 = kk0 * inv, kn1 = kk1 * inv;
              const f32x4 al0 = *(const LAS f32x4*)(ALR + tok * 512 + c8), al1 = *(const LAS f32x4*)(ALR + tok * 512 + c8 + 4);
              const f32x4 k20 = k0 * (1.0f + (al0 - 1.0f) * *(const f32x4*)(k_a + c8)), k21 = k1 * (1.0f + (al1 - 1.0f) * *(const f32x4*)(k_a + c8 + 4));
              *(u32x4*)(SK + o) = pk8(k20, k21); *(u32x4*)(SA + o) = pk8(-kn0, -kn1); *(u32x4*)(SB + o) = pk8(kn0 * al0, kn1 * al1);
              const f32x4 q0 = rr0 * k20 * *(const f32x4*)(a.in[11] + c8), q1 = rr1 * k21 * *(const f32x4*)(a.in[11] + c8 + 4);
              const float rk = red8((q0.x + q0.y) + (q0.z + q0.w) + (q1.x + q1.y) + (q1.z + q1.w));
              if ((lane & 7) == 0) ((float*)(ws + WS_RK))[(size_t)t * 8 + (lane >> 3)] = rk; }
            { const f32x4 de0 = *(const LAS f32x4*)(DEC + tok * 512 + c8), de1 = *(const LAS f32x4*)(DEC + tok * 512 + c8 + 4);
              const f32x4 gg0 = *(const LAS f32x4*)(GG + tok * 512 + c8), gg1 = *(const LAS f32x4*)(GG + tok * 512 + c8 + 4);
              *(u32x4*)(SG + o) = pk8(gg0, gg1); *(f32x4*)(SW + o) = de0; *(f32x4*)(SW + o + 4) = de1; }
            { const u32x4 uq = *(const u32x4*)(pr + DQ0), ukd = *(const u32x4*)(pr + DK0);
              const f32x4 q0 = cvlo(uq), q1 = cvhi(uq), d0 = cvlo(ukd), d1 = cvhi(ukd);
              float qs = (q0.x * q0.x + q0.y * q0.y) + (q0.z * q0.z + q0.w * q0.w) + (q1.x * q1.x + q1.y * q1.y) + (q1.z * q1.z + q1.w * q1.w);
              float ks = (d0.x * d0.x + d0.y * d0.y) + (d0.z * d0.z + d0.w * d0.w) + (d1.x * d1.x + d1.y * d1.y) + (d1.z * d1.z + d1.w * d1.w);
              qs = red8(qs); ks = red8(ks);
              const float qi = (1.0f / sqrtf(qs * (1.0f / 64.0f) + 1e-5f)) * (0.125f * LOG2E), ki = 1.0f / sqrtf(ks * (1.0f / 64.0f) + 1e-5f);
              const f32x4 g0 = *(const f32x4*)(qn_g + (c8 & 63)), g1 = *(const f32x4*)(qn_g + (c8 & 63) + 4), h0 = *(const f32x4*)(kn_g + (c8 & 63)), h1 = *(const f32x4*)(kn_g + (c8 & 63) + 4);
              *(u32x4*)(QN + o) = pk8(q0 * qi * g0, q1 * qi * g1);
              *(u32x4*)(KN + o) = pk8(d0 * ki * h0, d1 * ki * h1); }
        }
        __syncthreads();
    }
}

namespace ck {
constexpr int PS = 136;
constexpr int O_BT = 0, O_KT = 8704, O_AP = 17408, O_RT = 26112;
constexpr int O_AT = 34816, O_BH = 43008, O_KH = 51200, O_VV = 59392, O_TN = 67584, O_A2 = 75776, O_V2 = 83968;
constexpr int O_L = 92160, LSTR = 68;
constexpr int O_TOT = 109568, O_GC = 111616;
__device__ __forceinline__ int crow(int r, int hi) { return (r & 3) + 8 * (r >> 2) + 4 * hi; }
__device__ __forceinline__ int voff(int row, int col) { return ((col >> 5) * 4 + (row >> 4)) * 1024 + (row & 15) * 64 + (col & 31) * 2; }
__device__ __forceinline__ s16x4 vtr(const LAS unsigned char* p) { return __builtin_bit_cast(s16x4, __builtin_amdgcn_ds_read_tr16_b64_v4i16((LAS s16x4*)p)); }
__device__ __forceinline__ bf16x8 fragP(const LAS unsigned char* M, int row, int k0, int hi) {
    const LAS unsigned char* p = M + row * PS + (k0 + 4 * hi) * 2; const s16x4 lo = *(const LAS s16x4*)p, h = *(const LAS s16x4*)(p + 16);
    return (bf16x8){lo[0], lo[1], lo[2], lo[3], h[0], h[1], h[2], h[3]}; }
__device__ __forceinline__ bf16x8 fragT(const LAS unsigned char* M, int k0, int colblk, int lane, int hi) {
    const LAS unsigned char* p = M + (colblk * 4 + (k0 >> 4)) * 1024 + ((lane >> 4) & 1) * 32 + (lane & 3) * 8 + (4 * hi + ((lane & 15) >> 2)) * 64;
    const s16x4 lo = vtr(p), h = vtr(p + 512); return (bf16x8){lo[0], lo[1], lo[2], lo[3], h[0], h[1], h[2], h[3]}; }
__device__ __forceinline__ bf16x8 packR(const f32x16& x, int s) {
    u32x4 w; w.x = pk2(x[8 * s], x[8 * s + 1]); w.y = pk2(x[8 * s + 2], x[8 * s + 3]); w.z = pk2(x[8 * s + 4], x[8 * s + 5]); w.w = pk2(x[8 * s + 6], x[8 * s + 7]); return __builtin_bit_cast(bf16x8, w); }
#define CK_MFMA(a, b, c) __builtin_amdgcn_mfma_f32_32x32x16_bf16(a, b, c, 0, 0, 0)
__device__ __forceinline__ f32x16 score(const LAS unsigned char* Am, const LAS unsigned char* Bm, int sblk, int tblk, int mode, int r32, int hi) {
    f32x16 x = f32x16{};
#pragma unroll
    for (int ks = 0; ks < 4; ++ks) x = CK_MFMA(fragP(Am, sblk * 32 + r32, 16 * ks, hi), fragP(Bm, tblk * 32 + r32, 16 * ks, hi), x);
    if (mode) {
        const int t = tblk * 32 + r32;
#pragma unroll
        for (int r = 0; r < 16; ++r) { const int s = sblk * 32 + crow(r, hi); if (mode == 1 ? !(s < t) : !(s <= t)) x[r] = 0.f; }
    }
    return x;
}
__device__ __forceinline__ void storeT_V(LAS unsigned char* M, const f32x16& x, int rb, int c, int hi) {
#pragma unroll
    for (int q = 0; q < 4; ++q) { u32x2 w; w.x = pk2(x[4 * q], x[4 * q + 1]); w.y = pk2(x[4 * q + 2], x[4 * q + 3]); *(LAS u32x2*)(M + voff(c, rb * 32 + 8 * q + 4 * hi)) = w; }
}
__device__ __forceinline__ void storeT_S(LAS unsigned char* M, const f32x16& x, int rb, int c, int hi) {
#pragma unroll
    for (int q = 0; q < 4; ++q) { u32x2 w; w.x = pk2(x[4 * q], x[4 * q + 1]); w.y = pk2(x[4 * q + 2], x[4 * q + 3]); *(LAS u32x2*)(M + c * PS + (rb * 32 + 8 * q + 4 * hi) * 2) = w; }
}

__device__ __forceinline__ void chunk_item(LAS unsigned char* lds, const Args& a, int item) {
    const int tid = threadIdx.x; int lane = tid & 63; const int wave = __builtin_amdgcn_readfirstlane(tid >> 6);
#define CK_FRESH() asm volatile("" : "+v"(lane)); r32 = lane & 31; hi = lane >> 5
    int r32, hi; CK_FRESH();
    unsigned char* ws = a.ws;
    const bf16_t* SR = (const bf16_t*)(ws + WS_SR); const bf16_t* SK = (const bf16_t*)(ws + WS_SK); const bf16_t* SV = (const bf16_t*)(ws + WS_SV);
    const bf16_t* SA = (const bf16_t*)(ws + WS_SA); const bf16_t* SB = (const bf16_t*)(ws + WS_SB); const float* SW = (const float*)(ws + WS_SW);
    bf16_t* CG = (bf16_t*)(ws + WS_CG) + (size_t)item * 4096; bf16_t* CH = (bf16_t*)(ws + WS_CH) + (size_t)item * 4096;
    bf16_t* CR2 = (bf16_t*)(ws + WS_CR2) + (size_t)item * 4096; bf16_t* CY0 = (bf16_t*)(ws + WS_CY0) + (size_t)item * 4096;
    const int bh = item >> 6, c = item & 63, b = bh >> 3, h = bh & 7, tokc = b * SEQ + c * 64, col0 = h * 64;
    LAS unsigned char* BT = lds + O_BT; LAS unsigned char* KT = lds + O_KT; LAS unsigned char* AP = lds + O_AP; LAS unsigned char* RT = lds + O_RT;
    LAS unsigned char* AT = lds + O_AT; LAS unsigned char* BH = lds + O_BH; LAS unsigned char* KH = lds + O_KH; LAS unsigned char* VV = lds + O_VV;
    LAS unsigned char* TN = lds + O_TN; LAS unsigned char* A2M = lds + O_A2; LAS unsigned char* V2M = lds + O_V2;
    LAS float* L = (LAS float*)(lds + O_L); LAS float* TOT = (LAS float*)(lds + O_TOT); LAS float* GC = (LAS float*)(lds + O_GC);
    {
        const int tl = tid >> 3, c8 = (tid & 7) * 8; const size_t o = (size_t)(tokc + tl) * CW + col0 + c8;
        const f32x4 w0 = *(const f32x4*)(SW + o), w1 = *(const f32x4*)(SW + o + 4);
        const u32x4 ua = *(const u32x4*)(SA + o), ub = *(const u32x4*)(SB + o), uk = *(const u32x4*)(SK + o), ur = *(const u32x4*)(SR + o), uv = *(const u32x4*)(SV + o);
        float p[8] = {w0.x, w0.y, w0.z, w0.w, w1.x, w1.y, w1.z, w1.w}, wv[8];
#pragma unroll
        for (int j = 0; j < 8; ++j) wv[j] = p[j];
#pragma unroll
        for (int d = 8; d < 64; d <<= 1) {
#pragma unroll
            for (int j = 0; j < 8; ++j) { const float q = __shfl_up(p[j], d); if (lane >= d) p[j] *= q; }
        }
        if ((lane >> 3) == 7) { *(LAS f32x4*)(TOT + wave * 64 + c8) = (f32x4){p[0], p[1], p[2], p[3]}; *(LAS f32x4*)(TOT + wave * 64 + c8 + 4) = (f32x4){p[4], p[5], p[6], p[7]}; }
        __syncthreads();
        float pre[8], gC[8];
#pragma unroll
        for (int j = 0; j < 8; ++j) { pre[j] = 1.f; gC[j] = 1.f; }
#pragma unroll
        for (int w2 = 0; w2 < 8; ++w2) { const f32x4 t0 = *(const LAS f32x4*)(TOT + w2 * 64 + c8), t1 = *(const LAS f32x4*)(TOT + w2 * 64 + c8 + 4);
            const float tv[8] = {t0.x, t0.y, t0.z, t0.w, t1.x, t1.y, t1.z, t1.w};
#pragma unroll
            for (int j = 0; j < 8; ++j) { if (w2 < wave) pre[j] *= tv[j]; gC[j] *= tv[j]; } }
        if (tid < 8) { *(LAS f32x4*)(GC + c8) = (f32x4){gC[0], gC[1], gC[2], gC[3]}; *(LAS f32x4*)(GC + c8 + 4) = (f32x4){gC[4], gC[5], gC[6], gC[7]}; }
        const f32x4 a0 = cvlo(ua), a1 = cvhi(ua), b0 = cvlo(ub), b1 = cvhi(ub), k0 = cvlo(uk), k1 = cvhi(uk), r0 = cvlo(ur), r1 = cvhi(ur);
        const float av[8] = {a0.x, a0.y, a0.z, a0.w, a1.x, a1.y, a1.z, a1.w}, bv[8] = {b0.x, b0.y, b0.z, b0.w, b1.x, b1.y, b1.z, b1.w};
        const float kv[8] = {k0.x, k0.y, k0.z, k0.w, k1.x, k1.y, k1.z, k1.w}, rv[8] = {r0.x, r0.y, r0.z, r0.w, r1.x, r1.y, r1.z, r1.w};
        float at[8], rt[8], bt[8], kt[8], bh[8], kh[8];
#pragma unroll
        for (int j = 0; j < 8; ++j) { const float g = pre[j] * p[j], ig = __builtin_amdgcn_rcpf(g), gp = g * __builtin_amdgcn_rcpf(wv[j]);
            at[j] = av[j] * gp; rt[j] = rv[j] * g; bt[j] = bv[j] * ig; kt[j] = kv[j] * ig; bh[j] = bt[j] * gC[j]; kh[j] = kt[j] * gC[j]; }
#define CK_PK8(v) ((u32x4){pk2(v[0], v[1]), pk2(v[2], v[3]), pk2(v[4], v[5]), pk2(v[6], v[7])})
#define CK_ST_P(M, val_) do { LAS unsigned char* d_ = (M) + tl * PS + c8 * 2; const u32x4 q_ = (val_); *(LAS u32x2*)d_ = (u32x2){q_[0], q_[1]}; *(LAS u32x2*)(d_ + 8) = (u32x2){q_[2], q_[3]}; } while (0)
        const u32x4 wa = CK_PK8(at), wr = CK_PK8(rt), wb = CK_PK8(bt), wk = CK_PK8(kt), wbh = CK_PK8(bh), wkh = CK_PK8(kh);
        CK_ST_P(AP, wa); CK_ST_P(RT, wr); CK_ST_P(BT, wb); CK_ST_P(KT, wk);
        *(LAS u32x4*)(AT + voff(tl, c8)) = wa; *(LAS u32x4*)(BH + voff(tl, c8)) = wbh; *(LAS u32x4*)(KH + voff(tl, c8)) = wkh; *(LAS u32x4*)(VV + voff(tl, c8)) = uv;
#undef CK_PK8
#undef CK_ST_P
    }
    __syncthreads();
    CK_FRESH();
    f32x16 pa = f32x16{}, pb = f32x16{}, pc = f32x16{}, pd = f32x16{};
#define w1a pa
#define w1b pb
#define xb0 pa
#define xb1 pb
#define y0a pc
#define y0b pd
    if (wave < 2) {
        for (int k = 0; k < (wave == 0 ? 2 : 1); ++k) {
            const int sblk = wave == 0 ? k : 0, tblk = wave == 0 ? k : 1;
            const f32x16 x = score(BT, AP, sblk, tblk, wave == 0 ? 1 : 0, r32, hi);
            const int t = tblk * 32 + r32;
#pragma unroll
            for (int r = 0; r < 16; ++r) L[(sblk * 32 + crow(r, hi)) * LSTR + t] = x[r];
        }
    }
    __syncthreads();
    CK_FRESH();
    if (wave == 6) {
        float x[32];
#pragma unroll
        for (int t = 0; t < 32; ++t) x[t] = (r32 == t) ? 1.f : 0.f;
        const LAS float* Nr = L + (32 * hi) * LSTR + 32 * hi;
#pragma unroll
        for (int sidx = 0; sidx < 31; ++sidx) {
#pragma unroll
            for (int g4 = (sidx + 1) / 4; g4 < 8; ++g4) {
                const f32x4 nv = *(const LAS f32x4*)(Nr + sidx * LSTR + 4 * g4);
                if (4 * g4 + 0 > sidx) x[4 * g4 + 0] += nv.x * x[sidx];
                if (4 * g4 + 1 > sidx) x[4 * g4 + 1] += nv.y * x[sidx];
                if (4 * g4 + 2 > sidx) x[4 * g4 + 2] += nv.z * x[sidx];
                if (4 * g4 + 3 > sidx) x[4 * g4 + 3] += nv.w * x[sidx];
            }
            if ((sidx & 3) == 3) __builtin_amdgcn_sched_barrier(0);
        }
        const int cc = 32 * hi + r32;
#pragma unroll
        for (int t0 = 0; t0 < 32; t0 += 8) { u32x4 w; w.x = pk2(x[t0], x[t0 + 1]); w.y = pk2(x[t0 + 2], x[t0 + 3]); w.z = pk2(x[t0 + 4], x[t0 + 5]); w.w = pk2(x[t0 + 6], x[t0 + 7]);
            *(LAS u32x4*)(TN + voff(cc, 32 * hi + t0)) = w; }
        f32x16 m = f32x16{};
#pragma unroll
        for (int s = 0; s < 2; ++s) {
            const LAS float* lp = L + (16 * s + 4 * hi) * LSTR + 32 + r32;
            u32x4 aw; aw.x = pk2(lp[0], lp[LSTR]); aw.y = pk2(lp[2 * LSTR], lp[3 * LSTR]); aw.z = pk2(lp[8 * LSTR], lp[9 * LSTR]); aw.w = pk2(lp[10 * LSTR], lp[11 * LSTR]);
            const s16x4 b0 = *(const LAS s16x4*)(TN + voff(r32, 16 * s + 4 * hi)), b1 = *(const LAS s16x4*)(TN + voff(r32, 16 * s + 8 + 4 * hi));
            m = CK_MFMA(__builtin_bit_cast(bf16x8, aw), ((bf16x8){b0[0], b0[1], b0[2], b0[3], b1[0], b1[1], b1[2], b1[3]}), m);
        }
        f32x16 t21 = f32x16{};
#pragma unroll
        for (int s = 0; s < 2; ++s) t21 = CK_MFMA(fragT(TN, 32 + 16 * s, 1, lane, hi), packR(m, s), t21);
        storeT_V(TN, t21, 1, r32, hi);
    } else if (wave < 4) {
        const int dvb = wave - 2;
        const f32x16 x00 = score(KT, AP, 0, 0, 1, r32, hi), x01 = score(KT, AP, 0, 1, 0, r32, hi), x11 = score(KT, AP, 1, 1, 1, r32, hi);
#pragma unroll
        for (int s = 0; s < 2; ++s) {
            const bf16x8 v0 = fragT(VV, 16 * s, dvb, lane, hi), v1 = fragT(VV, 32 + 16 * s, dvb, lane, hi);
            w1a = CK_MFMA(packR(x00, s), v0, w1a);
            w1b = CK_MFMA(packR(x01, s), v0, w1b);
            w1b = CK_MFMA(packR(x11, s), v1, w1b);
        }
    } else if (wave < 6) {
        const int tb = wave - 4;
        f32x16 xk0, xk1 = f32x16{};
        if (tb == 0) { xk0 = score(KT, RT, 0, 0, 2, r32, hi); xb0 = score(BT, RT, 0, 0, 2, r32, hi); }
        else { xk0 = score(KT, RT, 0, 1, 0, r32, hi); xk1 = score(KT, RT, 1, 1, 2, r32, hi); xb0 = score(BT, RT, 0, 1, 0, r32, hi); xb1 = score(BT, RT, 1, 1, 2, r32, hi); }
#pragma unroll
        for (int s = 0; s < 2; ++s) {
            y0a = CK_MFMA(fragT(VV, 16 * s, 0, lane, hi), packR(xk0, s), y0a);
            y0b = CK_MFMA(fragT(VV, 16 * s, 1, lane, hi), packR(xk0, s), y0b);
            if (tb == 1) { y0a = CK_MFMA(fragT(VV, 32 + 16 * s, 0, lane, hi), packR(xk1, s), y0a); y0b = CK_MFMA(fragT(VV, 32 + 16 * s, 1, lane, hi), packR(xk1, s), y0b); }
        }
    }
    __syncthreads();
    CK_FRESH();
    if (wave < 2) {
        const int cb = wave; f32x16 a0 = f32x16{}, a1 = f32x16{};
#pragma unroll
        for (int ks = 0; ks < 4; ++ks) {
            const bf16x8 af = fragT(AT, 16 * ks, cb, lane, hi);
            if (ks < 2) a0 = CK_MFMA(af, fragT(TN, 16 * ks, 0, lane, hi), a0);
            a1 = CK_MFMA(af, fragT(TN, 16 * ks, 1, lane, hi), a1);
        }
        storeT_V(A2M, a0, cb, r32, hi); storeT_V(A2M, a1, cb, 32 + r32, hi);
    } else if (wave < 4) {
        const int dvb = wave - 2; f32x16 v0 = f32x16{}, v1 = f32x16{};
#pragma unroll
        for (int s = 0; s < 2; ++s) {
            v0 = CK_MFMA(packR(w1a, s), fragT(TN, 16 * s, 0, lane, hi), v0);
            v1 = CK_MFMA(packR(w1a, s), fragT(TN, 16 * s, 1, lane, hi), v1);
            v1 = CK_MFMA(packR(w1b, s), fragT(TN, 32 + 16 * s, 1, lane, hi), v1);
        }
        storeT_V(V2M, v0, dvb, r32, hi); storeT_V(V2M, v1, dvb, 32 + r32, hi);
    }
    __syncthreads();
    CK_FRESH();
    if (wave >= 4 && wave < 6) {
        const int tb = wave - 4, t = tb * 32 + r32;
        f32x16 r0 = f32x16{}, r1 = f32x16{};
#pragma unroll
        for (int s = 0; s < 2; ++s) {
            const bf16x8 p0 = packR(xb0, s);
            r0 = CK_MFMA(fragT(A2M, 16 * s, 0, lane, hi), p0, r0); r1 = CK_MFMA(fragT(A2M, 16 * s, 1, lane, hi), p0, r1);
            y0a = CK_MFMA(fragT(V2M, 16 * s, 0, lane, hi), p0, y0a); y0b = CK_MFMA(fragT(V2M, 16 * s, 1, lane, hi), p0, y0b);
            if (tb == 1) { const bf16x8 p1 = packR(xb1, s);
                r0 = CK_MFMA(fragT(A2M, 32 + 16 * s, 0, lane, hi), p1, r0); r1 = CK_MFMA(fragT(A2M, 32 + 16 * s, 1, lane, hi), p1, r1);
                y0a = CK_MFMA(fragT(V2M, 32 + 16 * s, 0, lane, hi), p1, y0a); y0b = CK_MFMA(fragT(V2M, 32 + 16 * s, 1, lane, hi), p1, y0b); }
        }
#pragma unroll
        for (int q = 0; q < 4; ++q) {
            const u32x2 u0 = *(const LAS u32x2*)(RT + t * PS + (8 * q + 4 * hi) * 2), u1 = *(const LAS u32x2*)(RT + t * PS + (32 + 8 * q + 4 * hi) * 2);
            r0[4 * q] += bflo(u0.x); r0[4 * q + 1] += bfhi(u0.x); r0[4 * q + 2] += bflo(u0.y); r0[4 * q + 3] += bfhi(u0.y);
            r1[4 * q] += bflo(u1.x); r1[4 * q + 1] += bfhi(u1.x); r1[4 * q + 2] += bflo(u1.y); r1[4 * q + 3] += bfhi(u1.y);
        }
        storeT_S(BT, r0, 0, t, hi); storeT_S(BT, r1, 1, t, hi);
        storeT_S(KT, y0a, 0, t, hi); storeT_S(KT, y0b, 1, t, hi);
    } else if (wave < 2) {
        const int ib = wave, i = ib * 32 + r32; const float gci = GC[i];
        f32x16 g0 = f32x16{}, g1 = f32x16{};
#pragma unroll
        for (int ks = 0; ks < 4; ++ks) { const bf16x8 bf_ = fragT(BH, 16 * ks, ib, lane, hi);
            g0 = CK_MFMA(fragT(A2M, 16 * ks, 0, lane, hi), bf_, g0); g1 = CK_MFMA(fragT(A2M, 16 * ks, 1, lane, hi), bf_, g1); }
#pragma unroll
        for (int r = 0; r < 16; ++r) { if (crow(r, hi) == i) g0[r] += gci; if (32 + crow(r, hi) == i) g1[r] += gci; }
        storeT_S(AP, g0, 0, i, hi); storeT_S(AP, g1, 1, i, hi);
    } else {
        const int id = wave < 4 ? wave - 2 : wave - 4, ib = id >> 1, dvb = id & 1;
        f32x16 hh = f32x16{};
#pragma unroll
        for (int ks = 0; ks < 4; ++ks) {
            hh = CK_MFMA(fragT(BH, 16 * ks, ib, lane, hi), fragT(V2M, 16 * ks, dvb, lane, hi), hh);
            hh = CK_MFMA(fragT(KH, 16 * ks, ib, lane, hi), fragT(VV, 16 * ks, dvb, lane, hi), hh);
        }
        storeT_S((LAS unsigned char*)L, hh, ib, dvb * 32 + r32, hi);
    }
    __syncthreads();
    {
        const int row = tid >> 3, ch = tid & 7;
        const LAS unsigned char* s0 = BT + row * PS + ch * 16; const LAS unsigned char* s1 = KT + row * PS + ch * 16; const LAS unsigned char* s2 = AP + row * PS + ch * 16; const LAS unsigned char* s3 = (const LAS unsigned char*)L + row * PS + ch * 16;
        const u32x2 a0 = *(const LAS u32x2*)s0, a1 = *(const LAS u32x2*)(s0 + 8), b0 = *(const LAS u32x2*)s1, b1 = *(const LAS u32x2*)(s1 + 8);
        const u32x2 c0 = *(const LAS u32x2*)s2, c1 = *(const LAS u32x2*)(s2 + 8), d0 = *(const LAS u32x2*)s3, d1 = *(const LAS u32x2*)(s3 + 8);
        *(u32x4*)(CR2 + row * 64 + ch * 8) = (u32x4){a0.x, a0.y, a1.x, a1.y}; *(u32x4*)(CY0 + row * 64 + ch * 8) = (u32x4){b0.x, b0.y, b1.x, b1.y};
        *(u32x4*)(CG + row * 64 + ch * 8) = (u32x4){c0.x, c0.y, c1.x, c1.y}; *(u32x4*)(CH + row * 64 + ch * 8) = (u32x4){d0.x, d0.y, d1.x, d1.y};
    }
    asm volatile("s_waitcnt lgkmcnt(0)" ::: "memory"); __builtin_amdgcn_s_barrier();
#undef CK_FRESH
#undef w1a
#undef w1b
#undef xb0
#undef xb1
#undef y0a
#undef y0b
}
__device__ __forceinline__ void p2b_chunks(LAS unsigned char* lds, const Args& a) {
#pragma unroll 1
    for (int item = blockIdx.x; item < 4096; item += gridDim.x) chunk_item(lds, a, item);
}
}

namespace ck {
constexpr int SQ_MAT = 8704, SQ_BUF = 6 * SQ_MAT;
constexpr int SQ_OUT = 2 * SQ_BUF;
__device__ __forceinline__ bf16x8 lfrag(const LAS unsigned char* M, int row, int k0, int hi) { return fragP(M, row, k0, hi); }
__device__ __forceinline__ void linit(f32x16& x, const LAS unsigned char* M, int row, int cblk, int hi) {
#pragma unroll
    for (int q = 0; q < 4; ++q) { const u32x2 u = *(const LAS u32x2*)(M + row * PS + (cblk * 32 + 8 * q + 4 * hi) * 2); x[4 * q] = bflo(u.x); x[4 * q + 1] = bfhi(u.x); x[4 * q + 2] = bflo(u.y); x[4 * q + 3] = bfhi(u.y); }
}
__device__ __forceinline__ void seq_head(LAS unsigned char* lds, const Args& a, int bh) {
    const int tid = threadIdx.x, lane = tid & 63, r32 = lane & 31, hi = lane >> 5; const int wave = __builtin_amdgcn_readfirstlane(tid >> 6);
    unsigned char* ws = a.ws;
    const bf16_t* SV = (const bf16_t*)(ws + WS_SV); const bf16_t* SG = (const bf16_t*)(ws + WS_SG); const float* RK = (const float*)(ws + WS_RK); bf16_t* YMIX = (bf16_t*)(ws + WS_YMIX);
    const int b = bh >> 3, h = bh & 7, col0 = h * 64;
    const float* lng = a.in[12] + col0; const float* lnb = a.in[13] + col0;
#define SQ_LOAD(ch) do { const size_t item_ = (size_t)bh * 64 + (ch); LAS unsigned char* bb_ = lds + ((ch) & 1) * SQ_BUF; const size_t t0_ = (size_t)b * SEQ + (ch) * 64; \
        for (int p_ = tid - 128; p_ < 3072; p_ += 384) { const int m_ = p_ >> 9, q_ = p_ & 511, row_ = q_ >> 3, c8_ = (q_ & 7) * 8; u32x4 v_; \
            if (m_ == 0) v_ = *(const u32x4*)((const bf16_t*)(ws + WS_CG) + item_ * 4096 + row_ * 64 + c8_); \
            else if (m_ == 1) v_ = *(const u32x4*)((const bf16_t*)(ws + WS_CH) + item_ * 4096 + row_ * 64 + c8_); \
            else if (m_ == 2) v_ = *(const u32x4*)((const bf16_t*)(ws + WS_CR2) + item_ * 4096 + row_ * 64 + c8_); \
            else if (m_ == 3) v_ = *(const u32x4*)((const bf16_t*)(ws + WS_CY0) + item_ * 4096 + row_ * 64 + c8_); \
            else if (m_ == 4) v_ = *(const u32x4*)(SV + (t0_ + row_) * CW + col0 + c8_); \
            else v_ = *(const u32x4*)(SG + (t0_ + row_) * CW + col0 + c8_); \
            LAS unsigned char* d_ = bb_ + m_ * SQ_MAT + row_ * PS + c8_ * 2; *(LAS u32x2*)d_ = (u32x2){v_.x, v_.y}; *(LAS u32x2*)(d_ + 8) = (u32x2){v_.z, v_.w}; } } while (0)
#define SQ_STORE(ch) do { const LAS unsigned char* ob_ = lds + SQ_OUT + ((ch) & 1) * SQ_MAT; const size_t t0_ = (size_t)b * SEQ + (ch) * 64; \
        for (int p_ = tid - 128; p_ < 512; p_ += 384) { const int row_ = p_ >> 3, c8_ = (p_ & 7) * 8; const LAS unsigned char* s_ = ob_ + row_ * PS + c8_ * 2; \
            const u32x2 lo_ = *(const LAS u32x2*)s_, hi_ = *(const LAS u32x2*)(s_ + 8); *(u32x4*)(YMIX + (t0_ + row_) * D + col0 + c8_) = (u32x4){lo_.x, lo_.y, hi_.x, hi_.y}; } } while (0)
    if (wave >= 2) SQ_LOAD(0);
    __syncthreads();
    f32x16 X00 = f32x16{}, X01 = f32x16{}, X10 = f32x16{}, X11 = f32x16{};
#pragma unroll 1
    for (int c = 0; c < 64; ++c) {
        if (wave >= 2) {
            if (c + 1 < 64) SQ_LOAD(c + 1);
            if (c > 0) SQ_STORE(c - 1);
        } else {
            const int tb = wave;
            const LAS unsigned char* bb = lds + (c & 1) * SQ_BUF;
            const LAS unsigned char* MG = bb; const LAS unsigned char* MH = bb + SQ_MAT; const LAS unsigned char* MR = bb + 2 * SQ_MAT; const LAS unsigned char* MY = bb + 3 * SQ_MAT;
            const LAS unsigned char* MV = bb + 4 * SQ_MAT; const LAS unsigned char* MGT = bb + 5 * SQ_MAT;
            LAS unsigned char* OB = lds + SQ_OUT + (c & 1) * SQ_MAT;
            const int tl = tb * 32 + r32; const size_t t = (size_t)b * SEQ + c * 64 + tl;
            const float rk = RK[t * 8 + h];
            f32x16 y0, y1; linit(y0, MY, tl, 0, hi); linit(y1, MY, tl, 1, hi);
#pragma unroll
            for (int s = 0; s < 2; ++s) {
                const bf16x8 rf0 = lfrag(MR, tl, 16 * s, hi), rf1 = lfrag(MR, tl, 32 + 16 * s, hi);
                y0 = CK_MFMA(packR(X00, s), rf0, y0); y0 = CK_MFMA(packR(X10, s), rf1, y0);
                y1 = CK_MFMA(packR(X01, s), rf0, y1); y1 = CK_MFMA(packR(X11, s), rf1, y1);
            }
#pragma unroll
            for (int db = 0; db < 2; ++db) {
                f32x16 Na, Nb; linit(Na, MH, db * 32 + r32, 0, hi); linit(Nb, MH, db * 32 + r32, 1, hi);
#pragma unroll
                for (int s = 0; s < 2; ++s) {
                    const bf16x8 g00 = lfrag(MG, r32, 16 * s, hi), g01 = lfrag(MG, r32, 32 + 16 * s, hi), g10 = lfrag(MG, 32 + r32, 16 * s, hi), g11 = lfrag(MG, 32 + r32, 32 + 16 * s, hi);
                    const bf16x8 p0 = packR(db ? X01 : X00, s), p1 = packR(db ? X11 : X10, s);
                    Na = CK_MFMA(g00, p0, Na); Na = CK_MFMA(g01, p1, Na);
                    Nb = CK_MFMA(g10, p0, Nb); Nb = CK_MFMA(g11, p1, Nb);
                }
                if (db == 0) { X00 = Na; X10 = Nb; } else { X01 = Na; X11 = Nb; }
            }
            float sm = 0.f;
#pragma unroll
            for (int r = 0; r < 16; ++r) sm += y0[r] + y1[r];
            sm += __shfl_xor(sm, 32);
            const float mean = sm * (1.0f / 64.0f);
            float sq = 0.f;
#pragma unroll
            for (int r = 0; r < 16; ++r) { const float d0 = y0[r] - mean, d1 = y1[r] - mean; sq += d0 * d0 + d1 * d1; }
            sq += __shfl_xor(sq, 32);
            const float rs = 1.0f / sqrtf(sq * (1.0f / 64.0f) + 64e-5f);
#pragma unroll
            for (int db = 0; db < 2; ++db)
#pragma unroll
                for (int q = 0; q < 4; ++q) {
                    const int dv = db * 32 + 8 * q + 4 * hi;
                    const f32x4 lg = *(const f32x4*)(lng + dv), lb = *(const f32x4*)(lnb + dv);
                    const u32x2 uv = *(const LAS u32x2*)(MV + tl * PS + dv * 2), ug = *(const LAS u32x2*)(MGT + tl * PS + dv * 2);
                    const f32x4 vv = {bflo(uv.x), bfhi(uv.x), bflo(uv.y), bfhi(uv.y)}, gg = {bflo(ug.x), bfhi(ug.x), bflo(ug.y), bfhi(ug.y)};
                    f32x4 yy; if (db == 0) yy = (f32x4){y0[4 * q], y0[4 * q + 1], y0[4 * q + 2], y0[4 * q + 3]}; else yy = (f32x4){y1[4 * q], y1[4 * q + 1], y1[4 * q + 2], y1[4 * q + 3]};
                    const f32x4 o = ((yy - mean) * rs * lg + lb + rk * vv) * gg;
                    u32x2 w; w.x = pk2(o.x, o.y); w.y = pk2(o.z, o.w);
                    *(LAS u32x2*)(OB + tl * PS + dv * 2) = w;
                }
        }
        __syncthreads();
    }
    if (wave >= 2) SQ_STORE(63);
#undef SQ_LOAD
#undef SQ_STORE
}
}

__device__ __forceinline__ float red16(float v) {
    v += dpp_f<0xB1>(v); v += dpp_f<0x4E>(v); v += dpp_f<0x141>(v); v += dpp_f<0x140>(v);
    return v;
}
__device__ __forceinline__ void p3_scan(LAS unsigned char* lds, const Args& a) {
    const int tid = threadIdx.x, lane = tid & 63, wave = __builtin_amdgcn_readfirstlane(tid >> 6);
    unsigned char* ws = a.ws;
    const bf16_t* SR = (const bf16_t*)(ws + WS_SR); const bf16_t* SK = (const bf16_t*)(ws + WS_SK); const bf16_t* SV = (const bf16_t*)(ws + WS_SV);
    const bf16_t* SA = (const bf16_t*)(ws + WS_SA); const bf16_t* SB = (const bf16_t*)(ws + WS_SB); const float* SW = (const float*)(ws + WS_SW);
    float* YRAW = (float*)(ws + WS_YRAW);
    const int bh = blockIdx.x >> 1, half = blockIdx.x & 1;
    const int b = bh >> 3, h = bh & 7, tok0 = b * SEQ, col0 = h * 64, row0 = half * 32;
    constexpr int BUFB = 45056;
    LAS float* buf0 = (LAS float*)lds; LAS float* buf1 = (LAS float*)(lds + BUFB);
    LAS float* Y0 = (LAS float*)(lds + 2 * BUFB); LAS float* Y1 = Y0 + 1024;
    constexpr int NCH = SEQ / 32;
    if (wave >= 4) {
        const int lw = wave - 4, sl = lw * 8 + (lane >> 3), cg = lane & 7, c8 = cg * 8;
        f32x4 w0_, w1_; u32x4 uk, ua, ub, ur; u32x2 uv;
#define SC_ISSUE(ch) do { const size_t o_ = (size_t)(tok0 + (ch) * 32 + sl) * CW + col0; \
            w0_ = *(const f32x4*)(SW + o_ + c8); w1_ = *(const f32x4*)(SW + o_ + c8 + 4); uk = *(const u32x4*)(SK + o_ + c8); ua = *(const u32x4*)(SA + o_ + c8); ub = *(const u32x4*)(SB + o_ + c8); ur = *(const u32x4*)(SR + o_ + c8); \
            uv = *(const u32x2*)(SV + o_ + row0 + 4 * cg); } while (0)
#define SC_STORE(bufp) do { LAS float* d_ = (bufp) + sl * 64 + c8; *(LAS f32x4*)(d_) = w0_; *(LAS f32x4*)(d_ + 4) = w1_; \
            *(LAS f32x4*)(d_ + 2048) = cvlo(uk); *(LAS f32x4*)(d_ + 2052) = cvhi(uk); *(LAS f32x4*)(d_ + 4096) = cvlo(ua); *(LAS f32x4*)(d_ + 4100) = cvhi(ua); \
            *(LAS f32x4*)(d_ + 6144) = cvlo(ub); *(LAS f32x4*)(d_ + 6148) = cvhi(ub); *(LAS f32x4*)(d_ + 8192) = cvlo(ur); *(LAS f32x4*)(d_ + 8196) = cvhi(ur); \
            *(LAS f32x4*)((bufp) + 10240 + sl * 32 + 4 * cg) = (f32x4){bflo(uv.x), bfhi(uv.x), bflo(uv.y), bfhi(uv.y)}; } while (0)
#define SC_YOUT(ch, yp) do { *(f32x4*)(YRAW + (size_t)(tok0 + (ch) * 32 + sl) * CW + col0 + row0 + 4 * cg) = *(const LAS f32x4*)((yp) + sl * 32 + 4 * cg); } while (0)
        SC_ISSUE(0); SC_STORE(buf0);
        __syncthreads();
        for (int ch = 0; ch < NCH; ++ch) {
            LAS float* ob = (ch & 1) ? buf0 : buf1; const LAS float* oy = (ch & 1) ? Y0 : Y1;
            if (ch + 1 < NCH) SC_ISSUE(ch + 1);
            if (ch > 0) SC_YOUT(ch - 1, oy);
            if (ch + 1 < NCH) SC_STORE(ob);
            __syncthreads();
        }
        { const LAS float* oy = ((NCH - 1) & 1) ? Y1 : Y0; SC_YOUT(NCH - 1, oy); }
#undef SC_ISSUE
#undef SC_STORE
#undef SC_YOUT
    } else {
        const int g = lane & 7, rl = lane >> 3, row = wave * 8 + rl;
        f32x2 S0 = {0.f, 0.f}, S1 = S0, S2 = S0, S3 = S0;
        __syncthreads();
        for (int ch = 0; ch < NCH; ++ch) {
            const LAS float* cb = (ch & 1) ? buf1 : buf0; LAS float* yb = (ch & 1) ? Y1 : Y0;
            const LAS float* pa = cb + 4 * g; const LAS float* pv = cb + 10240 + row;
#define SC_LD(X, s_) const f32x4 w0##X = *(const LAS f32x4*)(pa + (s_) * 64), w1##X = *(const LAS f32x4*)(pa + (s_) * 64 + 32), k0##X = *(const LAS f32x4*)(pa + (s_) * 64 + 2048), k1##X = *(const LAS f32x4*)(pa + (s_) * 64 + 2080), \
                a0##X = *(const LAS f32x4*)(pa + (s_) * 64 + 4096), a1##X = *(const LAS f32x4*)(pa + (s_) * 64 + 4128), b0##X = *(const LAS f32x4*)(pa + (s_) * 64 + 6144), b1##X = *(const LAS f32x4*)(pa + (s_) * 64 + 6176), \
                r0##X = *(const LAS f32x4*)(pa + (s_) * 64 + 8192), r1##X = *(const LAS f32x4*)(pa + (s_) * 64 + 8224); const float v##X = pv[(s_) * 32]
#define LO(q) ((f32x2){(q).x, (q).y})
#define HI(q) ((f32x2){(q).z, (q).w})
#define SC_STEP(X, s_) do { f32x2 t = S0 * LO(a0##X); t = S1 * HI(a0##X) + t; t = S2 * LO(a1##X) + t; t = S3 * HI(a1##X) + t; float sa = t.x + t.y; \
                const f32x2 vv = {v##X, v##X}; \
                f32x2 p0 = S0 * LO(w0##X), p1 = S1 * HI(w0##X), p2 = S2 * LO(w1##X), p3 = S3 * HI(w1##X); \
                p0 = vv * LO(k0##X) + p0; p1 = vv * HI(k0##X) + p1; p2 = vv * LO(k1##X) + p2; p3 = vv * HI(k1##X) + p3; \
                sa = red8(sa); const f32x2 ss = {sa, sa}; \
                S0 = ss * LO(b0##X) + p0; S1 = ss * HI(b0##X) + p1; S2 = ss * LO(b1##X) + p2; S3 = ss * HI(b1##X) + p3; \
                f32x2 u = S0 * LO(r0##X); u = S1 * HI(r0##X) + u; u = S2 * LO(r1##X) + u; u = S3 * HI(r1##X) + u; float y = u.x + u.y; y = red8(y); \
                yb[(s_) * 32 + row] = y; } while (0)
#pragma unroll 1
            for (int s8 = 0; s8 < 32; s8 += 8) {
                SC_LD(0, s8 + 0); SC_LD(1, s8 + 1);
                SC_STEP(0, s8 + 0); SC_LD(2, s8 + 2);
                SC_STEP(1, s8 + 1); SC_LD(3, s8 + 3);
                SC_STEP(2, s8 + 2); SC_LD(4, s8 + 4);
                SC_STEP(3, s8 + 3); SC_LD(5, s8 + 5);
                SC_STEP(4, s8 + 4); SC_LD(6, s8 + 6);
                SC_STEP(5, s8 + 5); SC_LD(7, s8 + 7);
                SC_STEP(6, s8 + 6);
                SC_STEP(7, s8 + 7);
            }
#undef SC_LD
#undef LO
#undef HI
#undef SC_STEP
            __syncthreads();
        }
    }
}

__device__ __forceinline__ void p3_post(const Args& a, int G) {
    const int tid = threadIdx.x, lane = tid & 63, wave = __builtin_amdgcn_readfirstlane(tid >> 6);
    unsigned char* ws = a.ws;
    const bf16_t* SR = (const bf16_t*)(ws + WS_SR); const bf16_t* SK = (const bf16_t*)(ws + WS_SK); const bf16_t* SV = (const bf16_t*)(ws + WS_SV);
    const bf16_t* SG = (const bf16_t*)(ws + WS_SG); const float* YRAW = (const float*)(ws + WS_YRAW); bf16_t* YMIX = (bf16_t*)(ws + WS_YMIX);
    const int gw = blockIdx.x * 8 + wave, NGW = G * 8, c8 = lane * 8;
    const f32x4 lg0 = *(const f32x4*)(a.in[12] + c8), lg1 = *(const f32x4*)(a.in[12] + c8 + 4), lb0 = *(const f32x4*)(a.in[13] + c8), lb1 = *(const f32x4*)(a.in[13] + c8 + 4);
    const f32x4 rk0 = *(const f32x4*)(a.in[11] + c8), rk1 = *(const f32x4*)(a.in[11] + c8 + 4);
    for (int t = gw; t < T; t += NGW) {
        const size_t o = (size_t)t * CW + c8;
        const f32x4 y0 = *(const f32x4*)(YRAW + o), y1 = *(const f32x4*)(YRAW + o + 4);
        const u32x4 ur = *(const u32x4*)(SR + o), uk = *(const u32x4*)(SK + o), uv = *(const u32x4*)(SV + o), ug = *(const u32x4*)(SG + o);
        const float mean = red8((y0.x + y0.y) + (y0.z + y0.w) + (y1.x + y1.y) + (y1.z + y1.w)) * (1.0f / 64.0f);
        const f32x4 d0 = y0 - mean, d1 = y1 - mean;
        const float var = red8((d0.x * d0.x + d0.y * d0.y) + (d0.z * d0.z + d0.w * d0.w) + (d1.x * d1.x + d1.y * d1.y) + (d1.z * d1.z + d1.w * d1.w)) * (1.0f / 64.0f);
        const f32x4 r0 = cvlo(ur), r1 = cvhi(ur), k0 = cvlo(uk), k1 = cvhi(uk);
        const f32x4 p0 = r0 * k0 * rk0, p1 = r1 * k1 * rk1;
        const float rk = red8((p0.x + p0.y) + (p0.z + p0.w) + (p1.x + p1.y) + (p1.z + p1.w));
        const float rs = 1.0f / sqrtf(var + 64e-5f);
        const f32x4 o0 = (d0 * rs * lg0 + lb0 + rk * cvlo(uv)) * cvlo(ug), o1 = (d1 * rs * lg1 + lb1 + rk * cvhi(uv)) * cvhi(ug);
        *(u32x4*)(YMIX + (size_t)t * D + c8) = pk8(o0, o1);
    }
}

namespace att {
constexpr int SLOT = 32768, OFF_V = 16384;
constexpr int TBL_OFF = MISC_OFF + 1024;
constexpr int LW_OFF = MISC_OFF + 2048;
constexpr int CST_OFF = MISC_OFF + 3072;
__device__ __forceinline__ int crow(int r, int hi) { return (r & 3) + 8 * (r >> 2) + 4 * hi; }
__device__ __forceinline__ void glds16(const void* gsrc, unsigned lds_dst) { unsigned keep;
    asm volatile("s_mov_b32 %0, m0\n\ts_mov_b32 m0, %2\n\ts_nop 0\n\tglobal_load_lds_dwordx4 %1, off\n\ts_mov_b32 m0, %0" : "=&s"(keep) : "v"(gsrc), "s"(lds_dst) : "memory"); }
__device__ __forceinline__ s16x4 vtr(const LAS unsigned char* p) { return __builtin_bit_cast(s16x4, __builtin_amdgcn_ds_read_tr16_b64_v4i16((LAS s16x4*)p)); }

__device__ __forceinline__ void attn_unit(LAS unsigned char* lds, const Args& a, int b, int h, int qb, float negM, float lam) {
    const int tid = threadIdx.x, lane = tid & 63, r32 = lane & 31, hi = lane >> 5; const int wid = __builtin_amdgcn_readfirstlane(tid >> 6);
    const int c = wid >> 2, rg = wid & 3;
    unsigned char* ws = a.ws;
    const bf16_t* QN = (const bf16_t*)(ws + WS_QN); const bf16_t* KN = (const bf16_t*)(ws + WS_KN); const bf16_t* P = (const bf16_t*)(ws + WS_P); bf16_t* YMIX = (bf16_t*)(ws + WS_YMIX);
    const int q0 = qb * 128; const size_t rowbase = (size_t)b * SEQ;
    const int NT = 2 * qb + 2;
    LAS float* tbl = (LAS float*)(lds + TBL_OFF); LAS float* lw = (LAS float*)(lds + LW_OFF) + wid * 32;
    if (tid < 128) {
        const int n = tid; int bkt;
        if (n < 16) bkt = n; else { bkt = 16 + (int)(logf((float)n * (1.0f / 16.0f)) / 2.0794415416798357f * 16.0f); bkt = bkt > 31 ? 31 : bkt; }
        tbl[n] = (a.in[21][bkt * 4 + h] - a.in[21][31 * 4 + h]) * LOG2E;
    }
    const bf16_t* Qw = QN + (rowbase + q0 + rg * 32 + r32) * CW + h * 128 + c * 64;
    bf16x8 qr[4];
#pragma unroll
    for (int d0 = 0; d0 < 4; ++d0) qr[d0] = *(const bf16x8*)(Qw + d0 * 16 + hi * 8);
    const bf16_t* k0src = KN + (rowbase + lane) * CW + h * 128 + wid * 8;
    const bf16_t* k1src = k0src + 64;
    const int pv0 = 2 * wid, pv1 = 2 * wid + 1;
    const bf16_t* v0src = P + (rowbase + 16 * (pv0 & 3) + (lane >> 2)) * NINP + DV0 + h * 128 + 32 * (pv0 >> 2) + (lane & 3) * 8;
    const bf16_t* v1src = P + (rowbase + 16 * (pv1 & 3) + (lane >> 2)) * NINP + DV0 + h * 128 + 32 * (pv1 >> 2) + (lane & 3) * 8;
#define ATT_DMA(t, slot) do { const unsigned s_ = lds0 + (unsigned)(slot) * SLOT; \
        glds16(k0src + (size_t)(t) * 64 * CW, (unsigned)__builtin_amdgcn_readfirstlane(s_ + wid * 1024)); \
        glds16(k1src + (size_t)(t) * 64 * CW, (unsigned)__builtin_amdgcn_readfirstlane(s_ + 8192 + wid * 1024)); \
        glds16(v0src + (size_t)(t) * 64 * NINP, (unsigned)__builtin_amdgcn_readfirstlane(s_ + OFF_V + pv0 * 1024)); \
        glds16(v1src + (size_t)(t) * 64 * NINP, (unsigned)__builtin_amdgcn_readfirstlane(s_ + OFF_V + pv1 * 1024)); } while (0)
#define ATT_SBAR() __builtin_amdgcn_sched_barrier(0)
    const unsigned lds0 = (unsigned)(uintptr_t)lds;
    f32x16 o[4];
#pragma unroll
    for (int d0 = 0; d0 < 4; ++d0) o[d0] = f32x16{};
    float lsum = 0.f;
    const bool shift = negM < -60.0f;
    const int qmin = q0 + 32 * rg, qpos = qmin + r32;
    ATT_DMA(0, 0);
    asm volatile("s_waitcnt vmcnt(0)" ::: "memory");
    __syncthreads();
    for (int t = 0; t < NT; ++t) {
        if (t + 1 < NT) ATT_DMA(t + 1, (t + 1) & 1);
        const int kmin = 64 * t;
        if (kmin <= qmin + 31) {
            const LAS unsigned char* slot = lds + (t & 1) * SLOT;
            const LAS unsigned char* kb = slot + c * 8192 + hi * 1024 + r32 * 16;
            const LAS unsigned char* vb = slot + OFF_V + ((lane >> 4) & 1) * 32 + (lane & 3) * 8 + (4 * hi + ((lane & 15) >> 2)) * 64;
            bf16x8 kf[8];
#pragma unroll
            for (int d0 = 0; d0 < 4; ++d0) { kf[2 * d0] = *(const LAS bf16x8*)(kb + d0 * 2048); kf[2 * d0 + 1] = *(const LAS bf16x8*)(kb + d0 * 2048 + 512); }
            s16x4 va[16], vc[16];
#pragma unroll
            for (int i = 0; i < 8; ++i) { va[2 * i] = vtr(vb + (i >> 2) * 4096 + (i & 3) * 1024); va[2 * i + 1] = vtr(vb + (i >> 2) * 4096 + (i & 3) * 1024 + 512); }
            ATT_SBAR();
            f32x16 p0, p1;
            p0 = __builtin_amdgcn_mfma_f32_32x32x16_bf16(kf[0], qr[0], f32x16{}, 0, 0, 0); p1 = __builtin_amdgcn_mfma_f32_32x32x16_bf16(kf[1], qr[0], f32x16{}, 0, 0, 0);
#pragma unroll
            for (int d0 = 1; d0 < 4; ++d0) { p0 = __builtin_amdgcn_mfma_f32_32x32x16_bf16(kf[2 * d0], qr[d0], p0, 0, 0, 0); p1 = __builtin_amdgcn_mfma_f32_32x32x16_bf16(kf[2 * d0 + 1], qr[d0], p1, 0, 0, 0); }
            ATT_SBAR();
            if (qmin - (kmin + 63) < 113) {
#pragma unroll
                for (int r = 0; r < 16; ++r) {
                    const int d0_ = qpos - (kmin + crow(r, hi)); const int d1_ = d0_ - 32;
                    const float t0 = tbl[d0_ < 0 ? 0 : (d0_ > 127 ? 127 : d0_)], t1 = tbl[d1_ < 0 ? 0 : (d1_ > 127 ? 127 : d1_)];
                    p0[r] = d0_ < 0 ? -INFINITY : p0[r] + t0; p1[r] = d1_ < 0 ? -INFINITY : p1[r] + t1;
                }
            }
            if (shift) {
#pragma unroll
                for (int r = 0; r < 16; ++r) { p0[r] += negM; p1[r] += negM; }
            }
            float sacc = 0.f;
#pragma unroll
            for (int r = 0; r < 16; ++r) { p0[r] = __builtin_amdgcn_exp2f(p0[r]); p1[r] = __builtin_amdgcn_exp2f(p1[r]); sacc += p0[r] + p1[r]; }
            lsum += sacc;
            u32x4 pw[4];
#pragma unroll
            for (int i = 0; i < 4; ++i) { pw[0][i] = pk2(p0[2 * i], p0[2 * i + 1]); pw[1][i] = pk2(p0[8 + 2 * i], p0[8 + 2 * i + 1]); pw[2][i] = pk2(p1[2 * i], p1[2 * i + 1]); pw[3][i] = pk2(p1[8 + 2 * i], p1[8 + 2 * i + 1]); }
            ATT_SBAR();
#pragma unroll
            for (int i = 0; i < 8; ++i) { vc[2 * i] = vtr(vb + (2 + (i >> 2)) * 4096 + (i & 3) * 1024); vc[2 * i + 1] = vtr(vb + (2 + (i >> 2)) * 4096 + (i & 3) * 1024 + 512); }
#pragma unroll
            for (int i = 0; i < 8; ++i) {
                const bf16x8 vf = (bf16x8){va[2 * i][0], va[2 * i][1], va[2 * i][2], va[2 * i][3], va[2 * i + 1][0], va[2 * i + 1][1], va[2 * i + 1][2], va[2 * i + 1][3]};
                o[i >> 2] = __builtin_amdgcn_mfma_f32_32x32x16_bf16(__builtin_bit_cast(bf16x8, pw[i & 3]), vf, o[i >> 2], 0, 0, 0);
            }
#pragma unroll
            for (int i = 0; i < 8; ++i) {
                const bf16x8 vf = (bf16x8){vc[2 * i][0], vc[2 * i][1], vc[2 * i][2], vc[2 * i][3], vc[2 * i + 1][0], vc[2 * i + 1][1], vc[2 * i + 1][2], vc[2 * i + 1][3]};
                o[2 + (i >> 2)] = __builtin_amdgcn_mfma_f32_32x32x16_bf16(__builtin_bit_cast(bf16x8, pw[i & 3]), vf, o[2 + (i >> 2)], 0, 0, 0);
            }
        }
        asm volatile("s_waitcnt vmcnt(0)" ::: "memory");
        __syncthreads();
    }
#undef ATT_DMA
#undef ATT_SBAR
    lsum += __shfl_xor(lsum, 32);
    if (hi == 0) lw[r32] = 1.0f / lsum;
    asm volatile("s_waitcnt lgkmcnt(0)" ::: "memory");
    LAS float* stg = (LAS float*)(lds + wid * 16384);
#pragma unroll
    for (int r = 0; r < 16; ++r) { const int orow = crow(r, hi); const float il = lw[orow];
#pragma unroll
        for (int d0 = 0; d0 < 4; ++d0) stg[orow * 128 + d0 * 32 + r32] = o[d0][r] * il; }
    __syncthreads();
    {
        const int row = tid >> 2, part = tid & 3, rgp = row >> 5, rr = row & 31;
        const LAS float* s1 = (const LAS float*)(lds + rgp * 16384) + rr * 128 + part * 32;
        const LAS float* s2 = (const LAS float*)(lds + (4 + rgp) * 16384) + rr * 128 + part * 32;
        float dv[32]; float ss = 0.f;
#pragma unroll
        for (int i = 0; i < 8; ++i) { const f32x4 x1 = *(const LAS f32x4*)(s1 + 4 * i), x2 = *(const LAS f32x4*)(s2 + 4 * i);
#pragma unroll
            for (int j = 0; j < 4; ++j) { const float dd = x1[j] - lam * x2[j]; dv[4 * i + j] = dd; ss += dd * dd; } }
        ss = red4(ss);
        const float sc = (1.0f / sqrtf(ss * (1.0f / 128.0f) + 1e-5f)) * 0.8f;
        const float* sg = a.in[20] + part * 32;
        bf16_t* op = YMIX + (rowbase + q0 + row) * D + CW + h * 128 + part * 32;
#pragma unroll
        for (int i = 0; i < 4; ++i) { u32x4 w;
            w.x = pk2(dv[8 * i] * sc * sg[8 * i], dv[8 * i + 1] * sc * sg[8 * i + 1]); w.y = pk2(dv[8 * i + 2] * sc * sg[8 * i + 2], dv[8 * i + 3] * sc * sg[8 * i + 3]);
            w.z = pk2(dv[8 * i + 4] * sc * sg[8 * i + 4], dv[8 * i + 5] * sc * sg[8 * i + 5]); w.w = pk2(dv[8 * i + 6] * sc * sg[8 * i + 6], dv[8 * i + 7] * sc * sg[8 * i + 7]);
            *(u32x4*)(op + 8 * i) = w; }
    }
    __syncthreads();
}

__device__ __forceinline__ void attn_phase(LAS unsigned char* lds, const Args& a, unsigned* ctl) {
    const int tid = threadIdx.x;
    LAS float* cst = (LAS float*)(lds + CST_OFF);
    if (tid < 64) {
        const float gq = fabsf(a.in[14][tid]), gk = fabsf(a.in[15][tid]);
        float mq = gq, mk = gk;
#pragma unroll
        for (int o = 1; o < 64; o <<= 1) { mq = fmaxf(mq, __shfl_xor(mq, o)); mk = fmaxf(mk, __shfl_xor(mk, o)); }
        const float d1 = wave_sum(a.in[16][tid] * a.in[17][tid]), d2 = wave_sum(a.in[18][tid] * a.in[19][tid]);
        float mb = 0.f;
        if (tid < 32) { for (int hh = 0; hh < 4; ++hh) mb = fmaxf(mb, (a.in[21][tid * 4 + hh] - a.in[21][31 * 4 + hh]) * LOG2E); }
#pragma unroll
        for (int o = 1; o < 64; o <<= 1) mb = fmaxf(mb, __shfl_xor(mb, o));
        if (tid == 0) { cst[0] = -(8.0f * LOG2E * mq * mk * 1.02f + mb); cst[1] = __expf(d1) - __expf(d2) + 0.2f; }
    }
    __syncthreads();
    const float negM = cst[0], lam = cst[1];
    LAS int* ubox = (LAS int*)(lds + CST_OFF + 16);
    for (;;) {
        if (tid == 0) ubox[0] = (int)atomicAdd(ctl + CW_ATTQ, 1u);
        __syncthreads();
        const int u = ubox[0];
        __syncthreads();
        if (u >= 1024) break;
        const int qb = 31 - (u >> 5), bhh = u & 31;
        attn_unit(lds, a, bhh >> 2, bhh & 3, qb, negM, lam);
    }
}
}

__device__ __forceinline__ void p5_router(LAS unsigned char* lds, const Args& a, unsigned* ctl) {
    const int tid = threadIdx.x, lane = tid & 63, r32 = lane & 31, hi = lane >> 5; const int wave = __builtin_amdgcn_readfirstlane(tid >> 6);
    unsigned char* ws = a.ws;
    const bf16_t* x1 = (const bf16_t*)(ws + WS_X1B); const float* g2 = a.in[23]; const float* rw = a.in[24]; const float* rb = a.in[25];
    unsigned char* H2 = ws + WS_H2; int* EIDX = (int*)(ws + WS_EIDX); float* GATE = (float*)(ws + WS_GATE); int* POS = (int*)(ws + WS_POS);
    LAS unsigned char* WH = lds; LAS unsigned char* WL = lds + 65536;
    LAS int* cnt = (LAS int*)(lds + MISC_OFF + 1024);
    LAS int* basel = (LAS int*)(lds + MISC_OFF + 1024 + 128);
    LAS int* el = (LAS int*)(lds + MISC_OFF + 2048);
    LAS int* pl = (LAS int*)(lds + MISC_OFF + 4096);
    {
        const int e = tid & 31;
        for (int k = tid >> 5; k < 1024; k += 16) {
            const float v = rw[k * 32 + e] * g2[k]; const unsigned h = f2bf(v); const float vh = __builtin_bit_cast(float, h << 16); const unsigned l = f2bf(v - vh);
            const int off = e * 2048 + (((k >> 3) ^ (e & 15)) << 4) + (k & 7) * 2;
            *(LAS unsigned short*)(WH + off) = (unsigned short)h; *(LAS unsigned short*)(WL + off) = (unsigned short)l;
        }
    }
    if (tid < 32) cnt[tid] = 0;
    __syncthreads();
    const int TPB = T / (int)gridDim.x, tb0 = blockIdx.x * TPB;
    if (wave < 4) {
        const int tl = wave * 32 + r32, t = tb0 + tl;
        const bf16_t* xrow = x1 + (size_t)t * D + 8 * hi;
        const LAS unsigned char* wh = WH + r32 * 2048; const LAS unsigned char* wl = WL + r32 * 2048; const int sw = r32 & 15;
        f32x16 d = f32x16{}; float ssq = 0.f;
#pragma unroll 8
        for (int s = 0; s < 64; ++s) {
            const u32x4 xb = *(const u32x4*)(xrow + 16 * s);
            const int co = ((2 * s + hi) ^ sw) << 4;
            const bf16x8 ah = *(const LAS bf16x8*)(wh + co), al = *(const LAS bf16x8*)(wl + co);
            const bf16x8 bx = __builtin_bit_cast(bf16x8, xb);
            d = __builtin_amdgcn_mfma_f32_32x32x16_bf16(ah, bx, d, 0, 0, 0);
            d = __builtin_amdgcn_mfma_f32_32x32x16_bf16(al, bx, d, 0, 0, 0);
            const f32x4 x0 = cvlo(xb), x1v = cvhi(xb);
            ssq += (x0.x * x0.x + x0.y * x0.y) + (x0.z * x0.z + x0.w * x0.w) + (x1v.x * x1v.x + x1v.y * x1v.y) + (x1v.z * x1v.z + x1v.w * x1v.w);
        }
        ssq += __shfl_xor(ssq, 32);
        const float rstd = 1.0f / sqrtf(ssq * (1.0f / D) + 1e-5f);
        float lg[16];
#pragma unroll
        for (int r = 0; r < 16; ++r) lg[r] = d[r] * rstd + rb[8 * (r >> 2) + 4 * hi + (r & 3)];
        float tv[4]; int ti[4];
#pragma unroll
        for (int k = 0; k < 4; ++k) {
            float bv = -INFINITY; int bi = 0;
#pragma unroll
            for (int r = 0; r < 16; ++r) { const int e = 8 * (r >> 2) + 4 * hi + (r & 3); if (lg[r] > bv) { bv = lg[r]; bi = e; } }
            tv[k] = bv; ti[k] = bi;
#pragma unroll
            for (int r = 0; r < 16; ++r) { const int e = 8 * (r >> 2) + 4 * hi + (r & 3); if (e == bi) lg[r] = -INFINITY; }
        }
        float ov[4]; int oi[4];
#pragma unroll
        for (int k = 0; k < 4; ++k) { ov[k] = __shfl_xor(tv[k], 32); oi[k] = __shfl_xor(ti[k], 32); }
        float mv[4]; int mi[4];
        {
            int pa = 0, pb = 0;
#pragma unroll
            for (int k = 0; k < 4; ++k) {
                float ca = -INFINITY, cb = -INFINITY; int ia = 0, ib = 0;
#pragma unroll
                for (int q = 0; q < 4; ++q) { if (q == pa) { ca = tv[q]; ia = ti[q]; } if (q == pb) { cb = ov[q]; ib = oi[q]; } }
                const bool takeA = (ca > cb) || (ca == cb && ia < ib);
                mv[k] = takeA ? ca : cb; mi[k] = takeA ? ia : ib; pa += takeA ? 1 : 0; pb += takeA ? 0 : 1;
            }
        }
        const float e1 = __expf(mv[1] - mv[0]), e2 = __expf(mv[2] - mv[0]), e3 = __expf(mv[3] - mv[0]);
        const float inv = 1.0f / (1.0f + e1 + e2 + e3);
        if (hi == 0) {
            *(int4*)(EIDX + (size_t)t * 4) = make_int4(mi[0], mi[1], mi[2], mi[3]);
            *(float4*)(GATE + (size_t)t * 4) = make_float4(inv, e1 * inv, e2 * inv, e3 * inv);
#pragma unroll
            for (int k = 0; k < 4; ++k) { el[tl * 4 + k] = mi[k]; pl[tl * 4 + k] = atomicAdd((int*)(cnt + mi[k]), 1); }
        }
    } else {
        f32x4 gv[4];
#pragma unroll
        for (int j = 0; j < 4; ++j) gv[j] = *((const f32x4*)g2 + lane + 64 * j);
        for (int i = 0; i < 32; ++i) {
            const int t = tb0 + (wave - 4) * 32 + i;
            const u32x2* xr = (const u32x2*)(x1 + (size_t)t * D) + lane;
            f32x4 v[4]; float s = 0.f;
#pragma unroll
            for (int j = 0; j < 4; ++j) { const u32x2 xw = xr[64 * j]; v[j] = (f32x4){bflo(xw.x), bfhi(xw.x), bflo(xw.y), bfhi(xw.y)}; s += (v[j].x * v[j].x + v[j].y * v[j].y) + (v[j].z * v[j].z + v[j].w * v[j].w); }
            const float rstd = (1.0f / sqrtf(wave_sum(s) * (1.0f / D) + 1e-5f)) * F8_X_MUL;
            unsigned* o4 = (unsigned*)(H2 + (size_t)t * D) + lane;
#pragma unroll
            for (int j = 0; j < 4; ++j) { v[j] = v[j] * rstd * gv[j]; o4[64 * j] = pk4_fp8(v[j].x, v[j].y, v[j].z, v[j].w); }
        }
    }
    __syncthreads();
    if (tid < 32) basel[tid] = (int)atomicAdd(ctl + CW_CNT + tid, (unsigned)cnt[tid]);
    __syncthreads();
    for (int i = tid; i < TPB * 4; i += 512) POS[(size_t)tb0 * 4 + i] = pl[i] + basel[el[i]];
}

__device__ __forceinline__ void p6_dispatch(LAS unsigned char* lds, const Args& a, unsigned* ctl) {
    const int tid = threadIdx.x, lane = tid & 63, wave = __builtin_amdgcn_readfirstlane(tid >> 6);
    unsigned char* ws = a.ws;
    const int* EIDX = (const int*)(ws + WS_EIDX); const float* GATE = (const float*)(ws + WS_GATE); const int* POS = (const int*)(ws + WS_POS);
    int* DEST = (int*)(ws + WS_DEST); float* ROWGATE = (float*)(ws + WS_ROWGATE); int* TILEE = (int*)(ws + WS_TILEE); int* ROWTOK = (int*)(ws + WS_ROWTOK);
    LAS int* pstart = (LAS int*)(lds + MISC_OFF + 1024); LAS int* pcnt = pstart + 32;
    if (tid == 0) {
        int acc = 0;
        for (int e = 0; e < NE; ++e) { const int cn = (int)__hip_atomic_load(ctl + CW_CNT + e, __ATOMIC_RELAXED, __HIP_MEMORY_SCOPE_AGENT); pstart[e] = acc; pcnt[e] = cn;
            const int nt = (cn + 255) >> 8;
            if (blockIdx.x == 0) for (int i = 0; i < nt; ++i) TILEE[(acc >> 8) + i] = e;
            acc += nt * 256; }
        if (blockIdx.x == 0) TILEE[1023] = acc >> 8;
    }
    __syncthreads();
    if (blockIdx.x < NE) {
        const int e = blockIdx.x, cn = pcnt[e], pe = ((cn + 255) >> 8) * 256;
        for (int i = cn + tid; i < pe; i += 512) ROWTOK[pstart[e] + i] = 0;
    }
    const int TPB = T / (int)gridDim.x, tb0 = blockIdx.x * TPB;
    for (int pi = tb0 * 4 + tid; pi < (tb0 + TPB) * 4; pi += 512) {
        const int e = EIDX[pi], dest = pstart[e] + POS[pi];
        DEST[pi] = dest; ROWGATE[dest] = GATE[pi]; ROWTOK[dest] = pi >> 2;
    }
}

__device__ __forceinline__ void p9_combine(const Args& a, int G) {
    const int tid = threadIdx.x, lane = tid & 63, wave = __builtin_amdgcn_readfirstlane(tid >> 6);
    unsigned char* ws = a.ws;
    const unsigned char* YS = ws + WS_YS; const int* DEST = (const int*)(ws + WS_DEST);
    float* out = a.out;
    const int gw = blockIdx.x * 8 + wave, NGW = G * 8;
    for (int t = gw; t < T; t += NGW) {
        f32x4* xr = (f32x4*)(out + (size_t)t * D) + lane; const u32x2* xi = (const u32x2*)((const bf16_t*)(ws + WS_X1B) + (size_t)t * D) + lane;
        f32x4 v[4];
#pragma unroll
        for (int j = 0; j < 4; ++j) { const u32x2 xw = xi[64 * j]; v[j] = (f32x4){bflo(xw.x), bfhi(xw.x), bflo(xw.y), bfhi(xw.y)}; }
#pragma unroll
        for (int k = 0; k < 4; ++k) {
            const int dest = DEST[t * 4 + k];
            const unsigned* yr = (const unsigned*)(YS + (size_t)dest * D) + lane;
#pragma unroll
            for (int j = 0; j < 4; ++j) { const unsigned w = yr[64 * j];
                const f32x2 lo = __builtin_amdgcn_cvt_pk_f32_fp8((int)w, false), hi2 = __builtin_amdgcn_cvt_pk_f32_fp8((int)w, true);
                v[j].x += lo.x * (1.0f / F8_Y_MUL); v[j].y += lo.y * (1.0f / F8_Y_MUL); v[j].z += hi2.x * (1.0f / F8_Y_MUL); v[j].w += hi2.y * (1.0f / F8_Y_MUL); }
        }
        if (TIME_REGION >= 0) { const float sc_ = 1.0f + 4e-6f * (float)((const unsigned*)(ws + WS_CTL))[301];
#pragma unroll
            for (int j = 0; j < 4; ++j) v[j] = v[j] * sc_; }
#pragma unroll
        for (int j = 0; j < 4; ++j) xr[64 * j] = v[j];
    }
}

constexpr int NPHASE = 10;
__global__ void __launch_bounds__(512, 2) hymba_fwd(Args args) {
    extern __shared__ __attribute__((aligned(16))) unsigned char lds_raw[];
    LAS unsigned char* lds = (LAS unsigned char*)lds_raw;
    cg::grid_group grid = cg::this_grid();
    const int G = gridDim.x;
    unsigned char* ws = args.ws;
    unsigned* ctl = (unsigned*)(ws + WS_CTL);
    const int lo = args.ph_lo, hi = args.ph_hi;
#define IN(k) (lo <= (k) && (k) < hi)
#define NREP(k) ((REP_PHASE) == (k) ? 2 : 1)
#define TSTART(k) do { if ((TIME_REGION) == (k) && blockIdx.x == 0 && threadIdx.x == 0) ctl[300] = (unsigned)__builtin_amdgcn_s_memrealtime(); } while (0)
#define TEND(k) do { if ((TIME_REGION) == (k) && blockIdx.x == 0 && threadIdx.x == 0) ctl[301] = (unsigned)__builtin_amdgcn_s_memrealtime() - ctl[300]; } while (0)
#define SEAM(k) do { if (IN(k) && IN((k) + 1)) { if (args.ph_lo < 0) grid.sync(); xcd_barrier(xbar); } } while (0)
    const int* TILEE = (const int*)(ws + WS_TILEE);
    { volatile LAS unsigned* st = (volatile LAS unsigned*)(lds + MISC_OFF); if (threadIdx.x < 2) st[threadIdx.x] = 0u; }
    __syncthreads();
    const XcdBarrier xbar = xcd_barrier_post(ctl + CW_BAR, (volatile LAS unsigned*)(lds + MISC_OFF));

    if (IN(0)) { for (int rep = 0; rep < NREP(0); ++rep) p0_prologue(lds, args, G); } SEAM(0);
    if (IN(1)) {
        pg8::Gemm g{ws + WS_XN, ws + WS_WINT, 1024, 0, 0, nullptr};
        pg8::TileOrder S; S.init(T / 256, NINP / 256, G, (int)blockIdx.x, nullptr, 0);
        pg8::EpiBf16 E{(bf16_t*)(ws + WS_P), NINP};
        for (int rep = 0; rep < NREP(1); ++rep) pg8::gemm_phase<false, false>(lds, g, S, E);
    } SEAM(1);
    TSTART(2);
    if (IN(2)) {
        p2_prep(lds, args);
        asm volatile("s_waitcnt vmcnt(0)" ::: "memory");
        __syncthreads();
        { const int bb = (int)blockIdx.x >> 5, cp = ((int)blockIdx.x & 31) * 2;
          _Pragma("clang loop unroll(disable)") for (int i = 0; i < 16; ++i) ck::chunk_item(lds, args, ((bb * 8 + (i & 7)) << 6) + cp + (i >> 3)); }
    } SEAM(2);
    TSTART(3);
    if (IN(3)) {
        TSTART(30); for (int rep = 0; rep < NREP(30); ++rep) { if (blockIdx.x < 64) ck::seq_head(lds, args, (int)blockIdx.x); __syncthreads(); } TEND(30);
        for (int rep = 0; rep < NREP(31); ++rep) att::attn_phase(lds, args, ctl + 64 * rep);
    } SEAM(3); TEND(3);
    if (IN(4)) {
        pg8::Gemm g{ws + WS_YMIX, ws + WS_WOUT, 1024, 0, 0, nullptr};
        pg8::TileOrder S; S.init(T / 256, D / 256, G, (int)blockIdx.x, nullptr, 0);
        pg8::EpiResBf16 E{args.in[0], (bf16_t*)(ws + WS_X1B), D};
        for (int rep = 0; rep < NREP(4); ++rep) pg8::gemm_phase<false, false>(lds, g, S, E);
    } SEAM(4);
    if (IN(5)) { _Pragma("clang loop unroll(disable)") for (int rep = 0; rep < NREP(5); ++rep) { p5_router(lds, args, ctl + 256 * (NREP(5) - 1 - rep)); __syncthreads(); } } SEAM(5);
    if (IN(6)) { for (int rep = 0; rep < NREP(6); ++rep) { p6_dispatch(lds, args, ctl); __syncthreads(); } } SEAM(6);
    if (IN(7)) {
        const int ntile = TILEE[1023];
        pg8::Gemm g{ws + WS_H2, ws + WS_W1T, 1024, F8_W_SC, F8_X_SC, (const int*)(ws + WS_ROWTOK)};
        pg8::TileOrder S; S.init(ntile, 8, G, (int)blockIdx.x, TILEE, 8);
        pg8::EpiSwiglu E{ws + WS_HID, args.in[27], TILEE};
        for (int rep = 0; rep < NREP(7); ++rep) pg8::gemm_phase<true, true>(lds, g, S, E);
    } SEAM(7);
    if (IN(8)) {
        const int ntile = TILEE[1023];
        pg8::Gemm g{ws + WS_HID, ws + WS_W2T, 1024, F8_W_SC, F8_H_SC, nullptr};
        pg8::TileOrder S; S.init(ntile, 4, G, (int)blockIdx.x, TILEE, 4);
        pg8::EpiGateF8 E{ws + WS_YS, args.in[29], (const float*)(ws + WS_ROWGATE), TILEE};
        for (int rep = 0; rep < NREP(8); ++rep) pg8::gemm_phase<true, false>(lds, g, S, E);
    } SEAM(8);
    if (IN(9)) { p9_combine(args, G); }
#undef IN
#undef SEAM
}

extern "C" void kernel_launch(void* const* d_in, const int* in_sizes, int n_in, void* d_out, int out_size, void* d_ws, size_t ws_size, hipStream_t stream) {
    static int grid = 0;
    if (grid == 0) {
        if (n_in != 30 || in_sizes[0] != T * D || out_size != T * D || ws_size < WS_END) { fprintf(stderr, "kernel_launch: unexpected shapes (n_in %d, in0 %d, out %d, ws %zu); nothing launched\n", n_in, n_in > 0 ? in_sizes[0] : -1, out_size, ws_size); grid = -1; return; }
        int dev = 0, cus = 0, per_cu = 0;
        if (hipGetDevice(&dev) != hipSuccess || hipDeviceGetAttribute(&cus, hipDeviceAttributeMultiprocessorCount, dev) != hipSuccess) { grid = -1; return; }
        if (hipFuncSetAttribute((const void*)hymba_fwd, hipFuncAttributeMaxDynamicSharedMemorySize, LDS_BYTES) != hipSuccess) { fprintf(stderr, "kernel_launch: hipFuncSetAttribute failed\n"); grid = -1; return; }
        if (hipOccupancyMaxActiveBlocksPerMultiprocessor(&per_cu, (const void*)hymba_fwd, 512, LDS_BYTES) != hipSuccess || per_cu < 1) { fprintf(stderr, "kernel_launch: occupancy query says %d\n", per_cu); per_cu = 1; }
        (void)hipGetLastError();
        grid = cus;
        if (grid > 256) grid = 256;
        if (grid != 256 || T % grid != 0 || (T / grid) % 16 != 0) { fprintf(stderr, "kernel_launch: grid %d does not divide the token count evenly\n", grid); grid = -1; return; }
    }
    if (grid < 0) return;
    (void)hipMemsetAsync((char*)d_ws + WS_CTL, 0, CTL_ZERO_BYTES, stream);
    Args a{};
    for (int i = 0; i < 30; ++i) a.in[i] = (const float*)d_in[i];
    a.out = (float*)d_out; a.ws = (unsigned char*)d_ws;
    constexpr int NL = MK_N_LAUNCHES;
    for (int li = 0; li < NL; ++li) {
        a.ph_lo = (NL == 1) ? 0 : li; a.ph_hi = (NL == 1) ? NPHASE : li + 1;
        void* kargs[] = {&a};
        hipError_t e = hipLaunchCooperativeKernel((const void*)hymba_fwd, dim3(grid), dim3(512), kargs, LDS_BYTES, stream);
        if (e != hipSuccess) { fprintf(stderr, "kernel_launch: cooperative launch %d failed: %s (grid %d)\n", li, hipGetErrorString(e), grid); break; }
    }
}
```

```cpp
#include <hip/hip_runtime.h>
#include <hip/hip_cooperative_groups.h>
#include <cstdio>
#include <cstdint>
#include <type_traits>
namespace cg = cooperative_groups;

#ifndef REP_PHASE
#define REP_PHASE -1
#endif
#ifndef TIME_REGION
#define TIME_REGION -1
#endif
#ifndef WGM_P1
#define WGM_P1 2
#endif
#ifndef WGM_P4
#define WGM_P4 2
#endif
#ifndef WGM_P7
#define WGM_P7 2
#endif
#ifndef WGM_P8
#define WGM_P8 2
#endif
#ifndef MK_N_LAUNCHES
#define MK_N_LAUNCHES 1
#endif

#define LAS __attribute__((address_space(3)))
#define GAS __attribute__((address_space(1)))
typedef unsigned short bf16_t;
typedef short bf16x8 __attribute__((ext_vector_type(8)));
typedef short s16x4 __attribute__((ext_vector_type(4)));
typedef float f32x2 __attribute__((ext_vector_type(2)));
typedef float f32x4 __attribute__((ext_vector_type(4)));
typedef float f32x16 __attribute__((ext_vector_type(16)));
typedef unsigned u32x2 __attribute__((ext_vector_type(2)));
typedef unsigned u32x4 __attribute__((ext_vector_type(4)));
typedef int v8i32 __attribute__((ext_vector_type(8)));

constexpr int NB = 8, SEQ = 4096, T = NB * SEQ, D = 1024;
constexpr int CW = 512;
constexpr int NRW = 1696, NIN = 3232, NINP = 3328;
constexpr int DQ0 = 1696, DK0 = 2208, DV0 = 2720;
constexpr int NE = 32, TOPK = 4, DE = 1024;
constexpr int MAXROWS = T * TOPK + NE * 256;
constexpr int MAXTILES = MAXROWS / 256;
constexpr float LOG2E = 1.4426950408889634f;
constexpr float F8_W_MUL = 32.f, F8_X_MUL = 8.f, F8_H_MUL = 4.f, F8_Y_MUL = 16.f; constexpr int F8_W_SC = 0x7A7A7A7A, F8_X_SC = 0x7C7C7C7C, F8_H_SC = 0x7D7D7D7D;

constexpr size_t MiB = 1u << 20;
constexpr size_t WS_CTL = 0, CTL_ZERO_BYTES = 64 * 1024;
constexpr size_t WS_TILEE = 512 * 1024;
constexpr size_t WS_WINT = 1 * MiB;
constexpr size_t WS_WOUT = 8 * MiB;
constexpr size_t WS_W1T = 10 * MiB;
constexpr size_t WS_W2T = 138 * MiB;
constexpr size_t WS_EIDX = 202 * MiB;
constexpr size_t WS_GATE = WS_EIDX + 512 * 1024;
constexpr size_t WS_POS = WS_GATE + 512 * 1024;
constexpr size_t WS_DEST = WS_POS + 512 * 1024;
constexpr size_t WS_ROWGATE = 204 * MiB;
constexpr size_t WS_XN = 206 * MiB;
constexpr size_t WS_P = 270 * MiB;
constexpr size_t WS_SR = 478 * MiB, WS_SK = 510 * MiB, WS_SV = 542 * MiB, WS_SA = 574 * MiB, WS_SB = 606 * MiB;
constexpr size_t WS_SW = 638 * MiB;
constexpr size_t WS_SG = 702 * MiB;
constexpr size_t WS_QN = 734 * MiB, WS_KN = 766 * MiB;
constexpr size_t WS_YMIX = 798 * MiB;
constexpr size_t WS_H2 = 206 * MiB;
constexpr size_t WS_ROWTOK = 270 * MiB;
constexpr size_t WS_HID = 406 * MiB;
constexpr size_t WS_YS = 542 * MiB;
constexpr size_t WS_YRAW = 862 * MiB;
constexpr size_t WS_X1B = 862 * MiB;
constexpr size_t WS_CG = 862 * MiB;
constexpr size_t WS_CH = 894 * MiB;
constexpr size_t WS_CR2 = 926 * MiB;
constexpr size_t WS_CY0 = 958 * MiB;
constexpr size_t WS_RK = 990 * MiB;
constexpr size_t WS_END = 992 * MiB;
constexpr int CW_CNT = 64;
constexpr int CW_ATTQ = 128;
constexpr int CW_BAR = 4096;

constexpr int RING_BYTES = 131072, MISC_OFF = RING_BYTES, LDS_BYTES = 147456;

__device__ __forceinline__ unsigned f2bf(float f) { unsigned u = __builtin_bit_cast(unsigned, f); return (u + 0x7fffu + ((u >> 16) & 1u)) >> 16; }
typedef __bf16 hwbf16x2 __attribute__((ext_vector_type(2)));
__device__ __forceinline__ unsigned pk2(float lo, float hi) { const f32x2 v = {lo, hi}; return __builtin_bit_cast(unsigned, __builtin_convertvector(v, hwbf16x2)); }
__device__ __forceinline__ unsigned pk4_fp8(float a, float b, float c, float d) {
    a = fminf(fmaxf(a, -448.f), 448.f); b = fminf(fmaxf(b, -448.f), 448.f); c = fminf(fmaxf(c, -448.f), 448.f); d = fminf(fmaxf(d, -448.f), 448.f);
    int r = __builtin_amdgcn_cvt_pk_fp8_f32(a, b, 0, false); r = __builtin_amdgcn_cvt_pk_fp8_f32(c, d, r, true); return (unsigned)r; }
__device__ __forceinline__ float bf2f(unsigned short b) { return __builtin_bit_cast(float, (unsigned)b << 16); }
__device__ __forceinline__ float bflo(unsigned w) { return __builtin_bit_cast(float, w << 16); }
__device__ __forceinline__ float bfhi(unsigned w) { return __builtin_bit_cast(float, w & 0xffff0000u); }
__device__ __forceinline__ float wave_sum(float v) {
#pragma unroll
    for (int o = 1; o < 64; o <<= 1) v += __shfl_xor(v, o);
    return v;
}
__device__ __forceinline__ float sigmoidf_(float x) { return 1.0f / (1.0f + __expf(-x)); }
template <int CTRL> __device__ __forceinline__ float dpp_f(float v) { return __builtin_bit_cast(float, __builtin_amdgcn_update_dpp(0, __builtin_bit_cast(int, v), CTRL, 0xF, 0xF, true)); }
__device__ __forceinline__ float red8(float v) {
    v += dpp_f<0xB1>(v);
    v += dpp_f<0x4E>(v);
    v += dpp_f<0x141>(v);
    return v;
}
__device__ __forceinline__ float red4(float v) { v += dpp_f<0xB1>(v); v += dpp_f<0x4E>(v); return v; }


#define XB_TMO      128
#define XB_XCNT(j)  (256  + 64 * (j))
#define XB_XSUB(j)  (1280 + 64 * (j))
#define XB_XGEN(j)  (2304 + 64 * (j))
#define XB_TOP      3328
#define XB_TOPGEN   3392
#define XCD_BAR_WORDS 3456
#define XB_SPIN_CAP (1u << 18)
__device__ __forceinline__ unsigned xb_ld(unsigned* p)              { return __hip_atomic_load(p, __ATOMIC_RELAXED, __HIP_MEMORY_SCOPE_AGENT); }
__device__ __forceinline__ unsigned xb_add(unsigned* p, unsigned v) { return __hip_atomic_fetch_add(p, v, __ATOMIC_RELAXED, __HIP_MEMORY_SCOPE_AGENT); }
__device__ __forceinline__ unsigned xb_xcc_id() { return (unsigned)__builtin_amdgcn_s_getreg((3 << 11) | 20) & 0xFu; }
#define XB_SPIN(cond, bar) do { unsigned _sp = 0; while (cond) { __builtin_amdgcn_s_sleep(1); \
    if ((++_sp & 255u) == 0u) { if (xb_ld(&(bar)[XB_TMO])) break; if (_sp > XB_SPIN_CAP) { atomicAdd(&(bar)[XB_TMO], 1u); break; } } } } while (0)
struct XcdBarrier { unsigned* bar; unsigned x; volatile LAS unsigned* st; };
__device__ __forceinline__ XcdBarrier xcd_barrier_post(unsigned* bar, volatile LAS unsigned* st) {
    XcdBarrier b; b.bar = bar; b.x = xb_xcc_id(); b.st = st;
    if (threadIdx.x == 0) (void)xb_add(&bar[XB_XCNT(b.x)], 1u);
    return b;
}
__device__ __forceinline__ void xcd_barrier_complete(unsigned* bar, unsigned x, unsigned& nloc, unsigned& nx) {
    const unsigned G = gridDim.x * gridDim.y * gridDim.z;
    unsigned sum, cnt, mine, sp = 0u;
    for (;;) {
        sum = 0u; cnt = 0u; mine = 0u;
#pragma unroll
        for (unsigned j = 0; j < 16; ++j) { const unsigned c = xb_ld(&bar[XB_XCNT(j)]); sum += c; cnt += (c > 0u) ? 1u : 0u; mine = (j == x) ? c : mine; }
        if (sum == G) break;
        __builtin_amdgcn_s_sleep(1);
        if ((++sp & 255u) == 0u) { if (xb_ld(&bar[XB_TMO])) break; if (sp > XB_SPIN_CAP) { atomicAdd(&bar[XB_TMO], 1u); break; } }
    }
    nloc = mine > 0u ? mine : 1u; nx = cnt > 0u ? cnt : 1u;
}
__device__ __forceinline__ void xcd_barrier(const XcdBarrier& b) {
    asm volatile("s_waitcnt vmcnt(0)" ::: "memory");
    __syncthreads();
    if (threadIdx.x == 0) {
        unsigned* bar = b.bar;
        __builtin_amdgcn_s_waitcnt(0);
        unsigned nloc = b.st[0], nx = b.st[1];
        if (nloc == 0u) { xcd_barrier_complete(bar, b.x, nloc, nx); b.st[0] = nloc; b.st[1] = nx; }
        const unsigned old = xb_add(&bar[XB_XSUB(b.x)], 1u);
        const unsigned gen = old / nloc;
        if (old + 1u == (gen + 1u) * nloc) {
            __builtin_amdgcn_fence(__ATOMIC_RELEASE, "agent");
            asm volatile("s_waitcnt vmcnt(0)" ::: "memory");
            const unsigned og = xb_add(&bar[XB_TOP], 1u);
            const unsigned tg = og / nx;
            if (og + 1u == (tg + 1u) * nx) xb_add(&bar[XB_TOPGEN], 1u);
            else XB_SPIN(xb_ld(&bar[XB_TOPGEN]) == tg, bar);
            __builtin_amdgcn_fence(__ATOMIC_ACQUIRE, "agent");
            xb_add(&bar[XB_XGEN(b.x)], 1u);
            asm volatile("s_waitcnt vmcnt(0)" ::: "memory");
        } else {
            XB_SPIN(xb_ld(&bar[XB_XGEN(b.x)]) == gen, bar);
            __builtin_amdgcn_fence(__ATOMIC_ACQUIRE, "agent");
            asm volatile("s_waitcnt vmcnt(0)" ::: "memory");
        }
    }
    __syncthreads();
}

namespace pg8 {
constexpr int BM = 256, BK = 64, HALF = 128, HTB = HALF * BK * 2, STAGE_BYTES = 8 * HTB, NXCD = 8;
__host__ __device__ __forceinline__ int lds_byte(int r, int c) { const int st = (r >> 4) * 2 + (c >> 5), rr = r & 15, cc = c & 31, ob = rr * 64 + cc * 2; return st * 1024 + (ob ^ (((ob >> 9) & 1) << 5)); }
__host__ __device__ __forceinline__ void stage_rc(int b, int& R, int& C) { const int st = b / 1024, sb = b % 1024, swz = sb ^ (((sb >> 9) & 1) << 5); R = (st >> 1) * 16 + swz / 64; C = (st & 1) * 32 + (swz % 64) / 2; }
__host__ __device__ __forceinline__ int perm32(int rho) { const int n = rho >> 4, i = rho & 15; return 8 * (i >> 2) + 4 * n + (i & 3); }

struct Unit { int pm, pn, pb; };
struct Gemm { const void* A; const void* Bt; int K; int scW, scA; const int* rowtok; };

struct TileOrder {
    int nM, nN, nwg, G, c, WGM; const int* tile_e; int nb_per_e;
    __device__ void init(int nM_, int nN_, int G_, int c_, const int* te, int nbe, int wgm) { nM = nM_; nN = nN_; nwg = nM * nN; G = G_; c = c_; tile_e = te; nb_per_e = nbe; WGM = wgm; }
    __device__ bool next(int i, Unit& u) const {
        const long L = (long)i * G + c; if (L >= nwg) return false;
        int wgid = (int)L; { const int q = nwg / NXCD, r = nwg % NXCD, xcd = wgid % NXCD, off = wgid / NXCD; wgid = (xcd < r ? xcd * (q + 1) : r * (q + 1) + (xcd - r) * q) + off; }
        const int nig = WGM * nN, gid = wgid / nig, fm = gid * WGM, gsz = (nM - fm) < WGM ? (nM - fm) : WGM;
        u.pm = fm + ((wgid % nig) % gsz); u.pn = (wgid % nig) / gsz;
        u.pb = tile_e ? tile_e[u.pm] * nb_per_e + u.pn : u.pn;
        return true;
    }
};

struct EpiBf16 {
    static constexpr bool PERM = true;
    bf16_t* O; int ldc;
    __device__ __forceinline__ void operator()(const f32x4 (&acc)[2][2][4][2], const Unit& u, int wr, int wc, int fr, int fq) const {
        const int row0 = u.pm * BM + wr * 64 + fr; const int col0 = u.pn * BM + wc * 32 + 8 * fq;
#pragma unroll
        for (int ai = 0; ai < 2; ++ai)
#pragma unroll
            for (int m = 0; m < 4; ++m) { bf16_t* rowp = O + (size_t)(row0 + ai * HALF + m * 16) * ldc + col0;
#pragma unroll
                for (int bj = 0; bj < 2; ++bj) { const f32x4 v0 = acc[ai][bj][m][0], v1 = acc[ai][bj][m][1];
                    u32x4 w; w.x = pk2(v0[0], v0[1]); w.y = pk2(v0[2], v0[3]); w.z = pk2(v1[0], v1[1]); w.w = pk2(v1[2], v1[3]);
                    *(u32x4*)(rowp + bj * HALF) = w; } }
    }
};
struct EpiResBf16 {
    static constexpr bool PERM = true;
    const float* base; bf16_t* out; int ldc;
    __device__ __forceinline__ void operator()(const f32x4 (&acc)[2][2][4][2], const Unit& u, int wr, int wc, int fr, int fq) const {
        const int col0 = u.pn * BM + wc * 32 + 8 * fq;
#pragma unroll
        for (int ai = 0; ai < 2; ++ai)
#pragma unroll
            for (int m = 0; m < 4; ++m) { const size_t off = (size_t)(u.pm * BM + ai * HALF + wr * 64 + m * 16 + fr) * ldc + col0;
#pragma unroll
                for (int bj = 0; bj < 2; ++bj) { const f32x4 b0 = *(const f32x4*)(base + off + bj * HALF), b1 = *(const f32x4*)(base + off + bj * HALF + 4);
                    const f32x4 v0 = b0 + acc[ai][bj][m][0], v1 = b1 + acc[ai][bj][m][1];
                    u32x4 w; w.x = pk2(v0[0], v0[1]); w.y = pk2(v0[2], v0[3]); w.z = pk2(v1[0], v1[1]); w.w = pk2(v1[2], v1[3]);
                    *(u32x4*)(out + off + bj * HALF) = w; } }
    }
};
struct EpiSwiglu {
    static constexpr bool PERM = true;
    unsigned char* O; const float* b1; const int* tile_e;
    __device__ __forceinline__ void operator()(const f32x4 (&acc)[2][2][4][2], const Unit& u, int wr, int wc, int fr, int fq) const {
        const int e = tile_e[u.pm]; const int row0 = u.pm * BM + wr * 64 + fr; const int hc0 = u.pn * 128 + wc * 32 + 8 * fq;
        const float* bg = b1 + (size_t)e * 2048 + hc0; const float* bl = bg + 1024;
        const f32x4 g0 = *(const f32x4*)bg, g1 = *(const f32x4*)(bg + 4), l0 = *(const f32x4*)bl, l1 = *(const f32x4*)(bl + 4);
#pragma unroll
        for (int ai = 0; ai < 2; ++ai)
#pragma unroll
            for (int m = 0; m < 4; ++m) { unsigned char* rowp = O + (size_t)(row0 + ai * HALF + m * 16) * 1024 + hc0;
                float o[8];
#pragma unroll
                for (int n = 0; n < 2; ++n) { const f32x4 gv = acc[ai][0][m][n] + (n ? g1 : g0), lv = acc[ai][1][m][n] + (n ? l1 : l0);
#pragma unroll
                    for (int i = 0; i < 4; ++i) { const float g = fminf(gv[i], 7.0f), l = fminf(fmaxf(lv[i], -7.0f), 7.0f);
                        const float sg = __builtin_amdgcn_rcpf(1.0f + __builtin_amdgcn_exp2f(-1.702f * LOG2E * g)); o[n * 4 + i] = g * sg * (l + 1.0f); } }
                u32x2 w; w.x = pk4_fp8(o[0] * F8_H_MUL, o[1] * F8_H_MUL, o[2] * F8_H_MUL, o[3] * F8_H_MUL); w.y = pk4_fp8(o[4] * F8_H_MUL, o[5] * F8_H_MUL, o[6] * F8_H_MUL, o[7] * F8_H_MUL);
                *(u32x2*)rowp = w; }
    }
};
struct EpiGateF8 {
    static constexpr bool PERM = true;
    unsigned char* O; const float* b2; const float* rowgate; const int* tile_e;
    __device__ __forceinline__ void operator()(const f32x4 (&acc)[2][2][4][2], const Unit& u, int wr, int wc, int fr, int fq) const {
        const int e = tile_e[u.pm]; const int row0 = u.pm * BM + wr * 64 + fr; const int col0 = u.pn * BM + wc * 32 + 8 * fq;
        f32x4 bv[2][2];
#pragma unroll
        for (int bj = 0; bj < 2; ++bj)
#pragma unroll
            for (int n = 0; n < 2; ++n) bv[bj][n] = *(const f32x4*)(b2 + (size_t)e * 1024 + col0 + bj * HALF + 4 * n);
#pragma unroll
        for (int ai = 0; ai < 2; ++ai)
#pragma unroll
            for (int m = 0; m < 4; ++m) { const int row = row0 + ai * HALF + m * 16; const float gt = rowgate[row] * F8_Y_MUL; unsigned char* rowp = O + (size_t)row * 1024 + col0;
#pragma unroll
                for (int bj = 0; bj < 2; ++bj) { const f32x4 v0 = (acc[ai][bj][m][0] + bv[bj][0]) * gt, v1 = (acc[ai][bj][m][1] + bv[bj][1]) * gt;
                    u32x2 w; w.x = pk4_fp8(v0[0], v0[1], v0[2], v0[3]); w.y = pk4_fp8(v1[0], v1[1], v1[2], v1[3]);
                    *(u32x2*)(rowp + bj * HALF) = w; } }
    }
};

template <bool F8, bool GATHER, class Epi, class Sched>
__device__ __forceinline__ void gemm_phase(LAS unsigned char* lds, const Gemm g, const Sched& S, const Epi& E) {
    const int tid = threadIdx.x, wid = __builtin_amdgcn_readfirstlane(tid >> 6), lane = tid & 63, wr = wid >> 2, wc = wid & 3, fr = lane & 15, fq = lane >> 4;
    const int RB = F8 ? g.K : g.K * 2, nt = RB / 128;
    unsigned voffB[2];
#pragma unroll
    for (int i = 0; i < 2; ++i) { int R, C; stage_rc(tid * 16 + i * 8192, R, C); const int Rb = Epi::PERM ? ((R & ~31) + perm32(R & 31)) : R;
        voffB[i] = (unsigned)(Rb * RB + C * 2); }
#define PG8_AOFFS(dst, pm_) do { _Pragma("unroll") for (int h_ = 0; h_ < 2; ++h_) _Pragma("unroll") for (int i_ = 0; i_ < 2; ++i_) { int R_, C_; stage_rc(tid * 16 + i_ * 8192, R_, C_); \
        const int row_ = (pm_) * BM + h_ * HALF + R_; const unsigned grow_ = GATHER ? (unsigned)g.rowtok[row_] : (unsigned)row_; dst[h_][i_] = grow_ * (unsigned)RB + (unsigned)(C_ * 2); } } while (0)
    unsigned cvA[2][2], nvA[2][2];
    const size_t kstep = (size_t)(BK * 2);
    const size_t hstep = (size_t)HALF * RB;
    const size_t tstep = 2 * hstep;
    const unsigned ldsw = (unsigned)wid * 1024u;
    const int aoff = F8 ? lds_byte(wr * 64 + fr, (fq & 1) * 16) + (fq >> 1) * 1024 : lds_byte(wr * 64 + fr, fq * 8);
    const int boff = F8 ? lds_byte(wc * 32 + fr, (fq & 1) * 16) + (fq >> 1) * 1024 : lds_byte(wc * 32 + fr, fq * 8);
    const int scW = g.scW, scA = g.scA;
#define PG8_SA(b, h) (((b) * 2 + (h)) * HTB)
#define PG8_SB(b, h) ((4 + (b) * 2 + (h)) * HTB)
#define PG8_STAGE(bufoff, gbase, voff) do { _Pragma("unroll") for (int _i = 0; _i < 2; ++_i) \
        __builtin_amdgcn_global_load_lds((const unsigned*)((const char*)(gbase) + (voff)[_i]), (LAS unsigned*)(lds + (bufoff) + ldsw + _i * 8192), 16, 0, 0); } while (0)
typedef int v8i32a __attribute__((ext_vector_type(8), aligned(16)));
#define PG8_LD32(p) (*(const LAS v8i32a*)(p))
#define PG8_STAGE_A(bufoff, kptr, offs) do { _Pragma("unroll") for (int _i = 0; _i < 2; ++_i) \
        __builtin_amdgcn_global_load_lds((const unsigned*)((const char*)(kptr) + (offs)[_i]), (LAS unsigned*)(lds + (bufoff) + ldsw + _i * 8192), 16, 0, 0); } while (0)
#define PG8_LDA(dst, b, h) do { _Pragma("unroll") for (int m = 0; m < 4; ++m) { if constexpr (F8) { dst[m].f8 = __builtin_bit_cast(v8i32, PG8_LD32(lds + PG8_SA(b, h) + aoff + m * 2048)); } \
        else { _Pragma("unroll") for (int k = 0; k < 2; ++k) dst[m].hv[k] = *(const LAS bf16x8*)(lds + PG8_SA(b, h) + aoff + m * 2048 + k * 1024); } } } while (0)
#define PG8_LDB(dst, b, h) do { _Pragma("unroll") for (int n = 0; n < 2; ++n) { if constexpr (F8) { dst[n].f8 = __builtin_bit_cast(v8i32, PG8_LD32(lds + PG8_SB(b, h) + boff + n * 2048)); } \
        else { _Pragma("unroll") for (int k = 0; k < 2; ++k) dst[n].hv[k] = *(const LAS bf16x8*)(lds + PG8_SB(b, h) + boff + n * 2048 + k * 1024); } } } while (0)
#define PG8_MMA(ai, bj, At, Bt) do { __builtin_amdgcn_s_setprio(1); _Pragma("unroll") for (int m = 0; m < 4; ++m) _Pragma("unroll") for (int n = 0; n < 2; ++n) { \
        if constexpr (F8) { asm volatile("v_mfma_scale_f32_16x16x128_f8f6f4 %0, %1, %2, %0, %3, %4 op_sel_hi:[0,0,0]" : "+v"(acc[ai][bj][m][n]) : "v"(Bt[n].f8), "v"(At[m].f8), "v"(scW), "v"(scA)); } \
        else { _Pragma("unroll") for (int k = 0; k < 2; ++k) acc[ai][bj][m][n] = __builtin_amdgcn_mfma_f32_16x16x32_bf16(Bt[n].hv[k], At[m].hv[k], acc[ai][bj][m][n], 0, 0, 0); } } \
        __builtin_amdgcn_s_setprio(0); } while (0)
#define PG8_WAIT_V(n) asm volatile("s_waitcnt vmcnt(" #n ")" ::: "memory")
#define PG8_WAIT_L(n) asm volatile("s_waitcnt lgkmcnt(" #n ")" ::: "memory")
#define PG8_BAR __builtin_amdgcn_s_barrier()
#define PG8_SCHED __builtin_amdgcn_sched_barrier(0)
    Unit cur, nxt; int ui = 0;
    if (!S.next(0, cur)) return;
    f32x4 acc[2][2][4][2];
#pragma unroll
    for (int a = 0; a < 2; ++a)
#pragma unroll
        for (int b = 0; b < 2; ++b)
#pragma unroll
            for (int m = 0; m < 4; ++m)
#pragma unroll
                for (int n = 0; n < 2; ++n) acc[a][b][m][n] = (f32x4){0.f, 0.f, 0.f, 0.f};
    struct FragH { bf16x8 hv[2]; }; struct Frag8 { v8i32 f8; };
    typename std::conditional<F8, Frag8, FragH>::type At[4], B0[2], B1[2];
    const char* const kA = (const char*)g.A; const char* cB = (const char*)g.Bt + (size_t)cur.pb * tstep;
    PG8_AOFFS(cvA, cur.pm);
    PG8_STAGE(PG8_SB(0, 0), cB, voffB); PG8_STAGE(PG8_SB(0, 1), cB + hstep, voffB); PG8_STAGE_A(PG8_SA(0, 0), kA, cvA[0]); PG8_STAGE_A(PG8_SA(0, 1), kA, cvA[1]);
    if (wr == 1) PG8_BAR;
    PG8_WAIT_V(2); PG8_BAR;
    PG8_STAGE(PG8_SB(1, 0), cB + kstep, voffB); PG8_STAGE_A(PG8_SA(1, 0), kA + kstep, cvA[0]); PG8_STAGE(PG8_SB(1, 1), cB + hstep + kstep, voffB);
    PG8_WAIT_V(6); PG8_BAR;
    for (;;) {
        const bool has_next = S.next(ui + 1, nxt);
        const char* nB = has_next ? (const char*)g.Bt + (size_t)nxt.pb * tstep : cB;
        if (has_next) { PG8_AOFFS(nvA, nxt.pm); } else { _Pragma("unroll") for (int h_ = 0; h_ < 2; ++h_) _Pragma("unroll") for (int i_ = 0; i_ < 2; ++i_) nvA[h_][i_] = cvA[h_][i_]; }
#pragma clang loop unroll(disable)
        for (int t = 0; t < nt; t += 2) {
            const bool last = (t == nt - 2);
            const char* a1 = kA + (size_t)(t + 1) * kstep;
            const char* a2 = last ? kA : kA + (size_t)(t + 2) * kstep; const char* b2 = last ? nB : cB + (size_t)(t + 2) * kstep;
            const char* a3 = a2 + kstep; const char* b3 = b2 + kstep;
            unsigned v2A[2][2];
#pragma unroll
            for (int h_ = 0; h_ < 2; ++h_)
#pragma unroll
                for (int i_ = 0; i_ < 2; ++i_) v2A[h_][i_] = last ? nvA[h_][i_] : cvA[h_][i_];
            PG8_LDB(B0, 0, 0); PG8_LDB(B1, 0, 1); PG8_SCHED; PG8_LDA(At, 0, 0); PG8_STAGE_A(PG8_SA(1, 1), a1, cvA[1]);
            PG8_WAIT_V(8); PG8_WAIT_L(0); PG8_BAR; PG8_MMA(0, 0, At, B0); PG8_MMA(0, 1, At, B1); PG8_BAR; PG8_SCHED;
            PG8_LDA(At, 0, 1); PG8_STAGE(PG8_SB(0, 0), b2, voffB); PG8_STAGE(PG8_SB(0, 1), b2 + hstep, voffB); PG8_STAGE_A(PG8_SA(0, 0), a2, v2A[0]);
            PG8_WAIT_V(8); PG8_WAIT_L(0); PG8_BAR; PG8_MMA(1, 0, At, B0); PG8_MMA(1, 1, At, B1); PG8_BAR; PG8_SCHED;
            PG8_LDB(B0, 1, 0); PG8_LDB(B1, 1, 1); PG8_SCHED; PG8_LDA(At, 1, 0); PG8_STAGE_A(PG8_SA(0, 1), a2, v2A[1]);
            PG8_WAIT_V(8); PG8_WAIT_L(0); PG8_BAR; PG8_MMA(0, 0, At, B0); PG8_MMA(0, 1, At, B1); PG8_BAR; PG8_SCHED;
            PG8_LDA(At, 1, 1); PG8_STAGE(PG8_SB(1, 0), b3, voffB); PG8_STAGE(PG8_SB(1, 1), b3 + hstep, voffB); PG8_STAGE_A(PG8_SA(1, 0), a3, v2A[0]);
            PG8_WAIT_V(8); PG8_WAIT_L(0); PG8_BAR; PG8_MMA(1, 0, At, B0); PG8_MMA(1, 1, At, B1); PG8_BAR; PG8_SCHED;
        }
        if (wr == 0) PG8_BAR;
        if constexpr (F8) asm volatile("s_nop 15\n\ts_nop 15" ::: "memory");
        E(acc, cur, wr, wc, fr, fq);
        if (!has_next) break;
#pragma unroll
        for (int a = 0; a < 2; ++a)
#pragma unroll
            for (int b = 0; b < 2; ++b)
#pragma unroll
                for (int m = 0; m < 4; ++m)
#pragma unroll
                    for (int n = 0; n < 2; ++n) acc[a][b][m][n] = (f32x4){0.f, 0.f, 0.f, 0.f};
        cur = nxt; cB = nB; ++ui;
#pragma unroll
        for (int h_ = 0; h_ < 2; ++h_)
#pragma unroll
            for (int i_ = 0; i_ < 2; ++i_) cvA[h_][i_] = nvA[h_][i_];
        if (wr == 1) PG8_BAR;
    }
    PG8_WAIT_V(0);
    PG8_BAR;
#undef PG8_SA
#undef PG8_SB
#undef PG8_STAGE
#undef PG8_STAGE_A
#undef PG8_AOFFS
#undef PG8_LDA
#undef PG8_LDB
#undef PG8_MMA
#undef PG8_LD32
#undef PG8_WAIT_V
#undef PG8_WAIT_L
#undef PG8_BAR
#undef PG8_SCHED
}
}

struct Args { const float* in[30]; float* out; unsigned char* ws; int ph_lo, ph_hi; };

__device__ __forceinline__ void p0_transpose_item(const float* W, int K, int N, bf16_t* WT, int k0, int n0, int drow0, LAS float* scr, int lane) {
#pragma unroll 8
    for (int i = 0; i < 32; ++i) { const int kk = 2 * i + (lane >> 5); scr[kk * 33 + (lane & 31)] = W[(size_t)(k0 + kk) * N + n0 + (lane & 31)]; }
    asm volatile("s_waitcnt lgkmcnt(0)" ::: "memory");
    const int c = lane & 7;
#pragma unroll
    for (int j = 0; j < 4; ++j) { const int n = (lane >> 3) + 8 * j; const LAS float* s = scr + (8 * c) * 33 + n;
        u32x4 o; o.x = pk2(s[0 * 33], s[1 * 33]); o.y = pk2(s[2 * 33], s[3 * 33]); o.z = pk2(s[4 * 33], s[5 * 33]); o.w = pk2(s[6 * 33], s[7 * 33]);
        *(u32x4*)(WT + (size_t)(drow0 + n) * K + k0 + 8 * c) = o; }
    asm volatile("s_waitcnt lgkmcnt(0)" ::: "memory");
}
__device__ __forceinline__ void p0_transpose_item_f8(const float* W, int K, int N, unsigned char* WT, int k0, int n0, int drow0, LAS float* scr, int lane) {
#pragma unroll 8
    for (int i = 0; i < 32; ++i) { const int kk = 2 * i + (lane >> 5); scr[kk * 33 + (lane & 31)] = W[(size_t)(k0 + kk) * N + n0 + (lane & 31)]; }
    asm volatile("s_waitcnt lgkmcnt(0)" ::: "memory");
    const int c = lane & 3;
#pragma unroll
    for (int j = 0; j < 2; ++j) { const int n = (lane >> 2) + 16 * j; const LAS float* s = scr + (16 * c) * 33 + n;
        u32x4 o;
        o.x = pk4_fp8(s[0 * 33] * F8_W_MUL, s[1 * 33] * F8_W_MUL, s[2 * 33] * F8_W_MUL, s[3 * 33] * F8_W_MUL);
        o.y = pk4_fp8(s[4 * 33] * F8_W_MUL, s[5 * 33] * F8_W_MUL, s[6 * 33] * F8_W_MUL, s[7 * 33] * F8_W_MUL);
        o.z = pk4_fp8(s[8 * 33] * F8_W_MUL, s[9 * 33] * F8_W_MUL, s[10 * 33] * F8_W_MUL, s[11 * 33] * F8_W_MUL);
        o.w = pk4_fp8(s[12 * 33] * F8_W_MUL, s[13 * 33] * F8_W_MUL, s[14 * 33] * F8_W_MUL, s[15 * 33] * F8_W_MUL);
        *(u32x4*)(WT + (size_t)(drow0 + n) * K + k0 + 16 * c) = o; }
    asm volatile("s_waitcnt lgkmcnt(0)" ::: "memory");
}
__device__ __forceinline__ void p0_prologue(LAS unsigned char* lds, const Args& a, int G) {
    const int tid = threadIdx.x, lane = tid & 63, wave = __builtin_amdgcn_readfirstlane(tid >> 6);
    LAS float* scr = (LAS float*)(lds + wave * 16384);
    const int gw = blockIdx.x * 8 + wave, NGW = G * 8;
    unsigned char* ws = a.ws;
    bf16_t* Wint = (bf16_t*)(ws + WS_WINT); bf16_t* Woutt = (bf16_t*)(ws + WS_WOUT); unsigned char* W1t = ws + WS_W1T; unsigned char* W2t = ws + WS_W2T;
    constexpr int I_IN = 16 * (NIN / 32);
    constexpr int I_OUT = 16 * 32;
    constexpr int I_W1 = 16 * 64;
    constexpr int I_W2 = 16 * 32;
    constexpr int NITEMS = I_IN + I_OUT + NE * I_W1 + NE * I_W2;
    for (int it = gw; it < NITEMS; it += NGW) {
        int r = it;
        if (r < I_IN) { const int nblk = NIN / 32, kb = r / nblk, nb = r % nblk; p0_transpose_item(a.in[2], 1024, NIN, Wint, 64 * kb, 32 * nb, 32 * nb, scr, lane); continue; } r -= I_IN;
        if (r < I_OUT) { const int kb = r / 32, nb = r % 32; p0_transpose_item(a.in[22], 1024, 1024, Woutt, 64 * kb, 32 * nb, 32 * nb, scr, lane); continue; } r -= I_OUT;
        if (r < NE * I_W1) { const int e = r / I_W1, q = r % I_W1, kb = q / 64, nb = q % 64; const int n0 = 32 * nb;
            const int drow = (n0 < 1024) ? ((n0 >> 7) * 256 + (n0 & 127)) : (((n0 - 1024) >> 7) * 256 + 128 + ((n0 - 1024) & 127));
            p0_transpose_item_f8(a.in[26] + (size_t)e * 1024 * 2048, 1024, 2048, W1t + (size_t)e * 2048 * 1024, 64 * kb, n0, drow, scr, lane); continue; } r -= NE * I_W1;
        { const int e = r / I_W2, q = r % I_W2, kb = q / 32, nb = q % 32;
            p0_transpose_item_f8(a.in[28] + (size_t)e * 1024 * 1024, 1024, 1024, W2t + (size_t)e * 1024 * 1024, 64 * kb, 32 * nb, 32 * nb, scr, lane); }
    }
    const float* x = a.in[0]; const float* g1 = a.in[1]; bf16_t* XN = (bf16_t*)(ws + WS_XN);
    f32x4 gv[4];
#pragma unroll
    for (int j = 0; j < 4; ++j) gv[j] = *((const f32x4*)g1 + lane + 64 * j);
    for (int m = gw; m < T; m += NGW) {
        const f32x4* xr = (const f32x4*)(x + (size_t)m * D) + lane;
        f32x4 v[4]; float s = 0.f;
#pragma unroll
        for (int j = 0; j < 4; ++j) { v[j] = xr[64 * j]; s += (v[j].x * v[j].x + v[j].y * v[j].y) + (v[j].z * v[j].z + v[j].w * v[j].w); }
        const float rstd = 1.0f / sqrtf(wave_sum(s) * (1.0f / D) + 1e-5f);
        u32x2* o8 = (u32x2*)(XN + (size_t)m * D) + lane;
#pragma unroll
        for (int j = 0; j < 4; ++j) { u32x2 w; w.x = pk2(v[j].x * rstd * gv[j].x, v[j].y * rstd * gv[j].y); w.y = pk2(v[j].z * rstd * gv[j].z, v[j].w * rstd * gv[j].w); o8[64 * j] = w; }
    }
}

__device__ __forceinline__ f32x4 cvlo(const u32x4 u) { return (f32x4){bflo(u.x), bfhi(u.x), bflo(u.y), bfhi(u.y)}; }
__device__ __forceinline__ f32x4 cvhi(const u32x4 u) { return (f32x4){bflo(u.z), bfhi(u.z), bflo(u.w), bfhi(u.w)}; }
__device__ __forceinline__ u32x4 pk8(const f32x4 lo, const f32x4 hi) { u32x4 w; w.x = pk2(lo.x, lo.y); w.y = pk2(lo.z, lo.w); w.z = pk2(hi.x, hi.y); w.w = pk2(hi.z, hi.w); return w; }
__device__ __forceinline__ void p2_prep(LAS unsigned char* lds, const Args& a) {
    const int tid = threadIdx.x, lane = tid & 63, wave = __builtin_amdgcn_readfirstlane(tid >> 6);
    unsigned char* ws = a.ws;
    const bf16_t* P = (const bf16_t*)(ws + WS_P);
    bf16_t* SR = (bf16_t*)(ws + WS_SR); bf16_t* SK = (bf16_t*)(ws + WS_SK); bf16_t* SV = (bf16_t*)(ws + WS_SV); bf16_t* SA = (bf16_t*)(ws + WS_SA); bf16_t* SB = (bf16_t*)(ws + WS_SB);
    float* SW = (float*)(ws + WS_SW); bf16_t* SG = (bf16_t*)(ws + WS_SG); bf16_t* QN = (bf16_t*)(ws + WS_QN); bf16_t* KN = (bf16_t*)(ws + WS_KN);
    const float* mu = a.in[3]; const float* w0 = a.in[4]; const float* w2 = a.in[5]; const float* a0 = a.in[6]; const float* a2 = a.in[7]; const float* g2 = a.in[8];
    const float* k_k = a.in[9]; const float* k_a = a.in[10]; const float* qn_g = a.in[14]; const float* kn_g = a.in[15];
    LAS unsigned char* ACT = lds;
    LAS float* DEC = (LAS float*)(lds + 8192); LAS float* ALR = (LAS float*)(lds + 40960); LAS float* GG = (LAS float*)(lds + 73728);
    bf16x8 bw[4][5];
    const int fcol = lane & 15, fk = (lane >> 4) * 8;
#pragma unroll
    for (int cb = 0; cb < 4; ++cb) {
        const int col = wave * 64 + cb * 16 + fcol;
#pragma unroll
        for (int kb = 0; kb < 5; ++kb) {
            const float* src = (kb == 0) ? (w2 + (size_t)fk * CW + col) : (kb == 1) ? (a2 + (size_t)fk * CW + col) : (g2 + (size_t)((kb - 2) * 32 + fk) * CW + col);
            u32x4 w; w.x = pk2(src[0], src[CW]); w.y = pk2(src[2 * CW], src[3 * CW]); w.z = pk2(src[4 * CW], src[5 * CW]); w.w = pk2(src[6 * CW], src[7 * CW]);
            bw[cb][kb] = __builtin_bit_cast(bf16x8, w);
        }
    }
    float w0c[4], a0c[4];
#pragma unroll
    for (int cb = 0; cb < 4; ++cb) { w0c[cb] = w0[wave * 64 + cb * 16 + fcol]; a0c[cb] = a0[wave * 64 + cb * 16 + fcol]; }
    const int c8 = lane * 8;
    const int TPB = T / (int)gridDim.x;
    const int tb0 = blockIdx.x * TPB;
    for (int t0 = tb0; t0 < tb0 + TPB; t0 += 16) {
        if (tid < 320) {
            const int tok = tid / 20, ch = tid - tok * 20, t = t0 + tok, col = 1536 + ch * 8;
            const u32x4 cu = *(const u32x4*)(P + (size_t)t * NINP + col);
            u32x4 pu = (u32x4){0u, 0u, 0u, 0u};
            if (t & (SEQ - 1)) pu = *(const u32x4*)(P + (size_t)(t - 1) * NINP + col);
            const f32x4 m0 = *(const f32x4*)(mu + col), m1 = *(const f32x4*)(mu + col + 4);
            const f32x4 c0 = cvlo(cu), c1 = cvhi(cu), p0 = cvlo(pu), p1 = cvhi(pu);
            f32x4 s0 = c0 + (p0 - c0) * m0, s1 = c1 + (p1 - c1) * m1;
            if (ch < 4) {
#pragma unroll
                for (int i = 0; i < 4; ++i) { const float e0 = __expf(-2.0f * fabsf(s0[i])), e1 = __expf(-2.0f * fabsf(s1[i])); const float th0 = (1.0f - e0) / (1.0f + e0), th1 = (1.0f - e1) / (1.0f + e1);
                    s0[i] = s0[i] < 0.f ? -th0 : th0; s1[i] = s1[i] < 0.f ? -th1 : th1; }
            } else if (ch >= 8) {
#pragma unroll
                for (int i = 0; i < 4; ++i) { s0[i] = sigmoidf_(s0[i]); s1[i] = sigmoidf_(s1[i]); }
            }
            *(LAS u32x4*)(ACT + tok * 320 + ch * 16) = pk8(s0, s1);
        }
        __syncthreads();
        {
            bf16x8 af[5];
#pragma unroll
            for (int kb = 0; kb < 5; ++kb) af[kb] = *(const LAS bf16x8*)(ACT + fcol * 320 + kb * 64 + (lane >> 4) * 16);
#pragma unroll
            for (int cb = 0; cb < 4; ++cb) {
                const f32x4 z = {0.f, 0.f, 0.f, 0.f};
                const f32x4 aw = __builtin_amdgcn_mfma_f32_16x16x32_bf16(af[0], bw[cb][0], z, 0, 0, 0);
                const f32x4 aa = __builtin_amdgcn_mfma_f32_16x16x32_bf16(af[1], bw[cb][1], z, 0, 0, 0);
                f32x4 ag = __builtin_amdgcn_mfma_f32_16x16x32_bf16(af[2], bw[cb][2], z, 0, 0, 0);
                ag = __builtin_amdgcn_mfma_f32_16x16x32_bf16(af[3], bw[cb][3], ag, 0, 0, 0);
                ag = __builtin_amdgcn_mfma_f32_16x16x32_bf16(af[4], bw[cb][4], ag, 0, 0, 0);
                const int col = wave * 64 + cb * 16 + fcol;
#pragma unroll
                for (int i = 0; i < 4; ++i) { const int row = (lane >> 4) * 4 + i;
                    DEC[row * 512 + col] = __expf(-0.6065306597126334f * sigmoidf_(aw[i] + w0c[cb]));
                    ALR[row * 512 + col] = sigmoidf_(aa[i] + a0c[cb]);
                    GG[row * 512 + col] = ag[i]; }
            }
        }
        __syncthreads();
#pragma unroll 1
        for (int q = 0; q < 2; ++q) {
            const int tok = 2 * wave + q, t = t0 + tok; const size_t o = (size_t)t * CW + c8;
            const bf16_t* pr = P + (size_t)t * NINP + c8;
            const bool first = (t & (SEQ - 1)) == 0;
            const u32x4 zz = (u32x4){0u, 0u, 0u, 0u};
            f32x4 rr0, rr1;
            { const u32x4 cu = *(const u32x4*)(pr), pu = first ? zz : *(const u32x4*)(pr - NINP);
              const f32x4 m0 = *(const f32x4*)(mu + c8), m1 = *(const f32x4*)(mu + c8 + 4);
              const f32x4 c0 = cvlo(cu), c1 = cvhi(cu), p0 = cvlo(pu), p1 = cvhi(pu);
              rr0 = c0 + (p0 - c0) * m0; rr1 = c1 + (p1 - c1) * m1; *(u32x4*)(SR + o) = pk8(rr0, rr1); }
            { const u32x4 cu = *(const u32x4*)(pr + 1024), pu = first ? zz : *(const u32x4*)(pr - NINP + 1024);
              const f32x4 m0 = *(const f32x4*)(mu + 1024 + c8), m1 = *(const f32x4*)(mu + 1024 + c8 + 4);
              const f32x4 c0 = cvlo(cu), c1 = cvhi(cu), p0 = cvlo(pu), p1 = cvhi(pu);
              *(u32x4*)(SV + o) = pk8(c0 + (p0 - c0) * m0, c1 + (p1 - c1) * m1); }
            { const u32x4 cu = *(const u32x4*)(pr + 512), pu = first ? zz : *(const u32x4*)(pr - NINP + 512);
              const f32x4 m0 = *(const f32x4*)(mu + 512 + c8), m1 = *(const f32x4*)(mu + 512 + c8 + 4);
              const f32x4 c0 = cvlo(cu), c1 = cvhi(cu), p0 = cvlo(pu), p1 = cvhi(pu);
              const f32x4 k0 = c0 + (p0 - c0) * m0, k1 = c1 + (p1 - c1) * m1;
              const f32x4 kk0 = k0 * *(const f32x4*)(k_k + c8), kk1 = k1 * *(const f32x4*)(k_k + c8 + 4);
              float ss = (kk0.x * kk0.x + kk0.y * kk0.y) + (kk0.z * kk0.z + kk0.w * kk0.w) + (kk1.x * kk1.x + kk1.y * kk1.y) + (kk1.z * kk1.z + kk1.w * kk1.w);
              ss = red8(ss);
              const float inv = 1.0f / sqrtf(fmaxf(ss, 1e-24f));
              const f32x4 kn0 = kk0 * inv, kn1 = kk1 * inv;
              const f32x4 al0 = *(const LAS f32x4*)(ALR + tok * 512 + c8), al1 = *(const LAS f32x4*)(ALR + tok * 512 + c8 + 4);
              const f32x4 k20 = k0 * (1.0f + (al0 - 1.0f) * *(const f32x4*)(k_a + c8)), k21 = k1 * (1.0f + (al1 - 1.0f) * *(const f32x4*)(k_a + c8 + 4));
              *(u32x4*)(SK + o) = pk8(k20, k21); *(u32x4*)(SA + o) = pk8(-kn0, -kn1); *(u32x4*)(SB + o) = pk8(kn0 * al0, kn1 * al1);
              const f32x4 q0 = rr0 * k20 * *(const f32x4*)(a.in[11] + c8), q1 = rr1 * k21 * *(const f32x4*)(a.in[11] + c8 + 4);
              const float rk = red8((q0.x + q0.y) + (q0.z + q0.w) + (q1.x + q1.y) + (q1.z + q1.w));
              if ((lane & 7) == 0) ((float*)(ws + WS_RK))[(size_t)t * 8 + (lane >> 3)] = rk; }
            { const f32x4 de0 = *(const LAS f32x4*)(DEC + tok * 512 + c8), de1 = *(const LAS f32x4*)(DEC + tok * 512 + c8 + 4);
              const f32x4 gg0 = *(const LAS f32x4*)(GG + tok * 512 + c8), gg1 = *(const LAS f32x4*)(GG + tok * 512 + c8 + 4);
              *(u32x4*)(SG + o) = pk8(gg0, gg1); *(f32x4*)(SW + o) = de0; *(f32x4*)(SW + o + 4) = de1; }
            { const u32x4 uq = *(const u32x4*)(pr + DQ0), ukd = *(const u32x4*)(pr + DK0);
              const f32x4 q0 = cvlo(uq), q1 = cvhi(uq), d0 = cvlo(ukd), d1 = cvhi(ukd);
              float qs = (q0.x * q0.x + q0.y * q0.y) + (q0.z * q0.z + q0.w * q0.w) + (q1.x * q1.x + q1.y * q1.y) + (q1.z * q1.z + q1.w * q1.w);
              float ks = (d0.x * d0.x + d0.y * d0.y) + (d0.z * d0.z + d0.w * d0.w) + (d1.x * d1.x + d1.y * d1.y) + (d1.z * d1.z + d1.w * d1.w);
              qs = red8(qs); ks = red8(ks);
              const float qi = (1.0f / sqrtf(qs * (1.0f / 64.0f) + 1e-5f)) * (0.125f * LOG2E), ki = 1.0f / sqrtf(ks * (1.0f / 64.0f) + 1e-5f);
              const f32x4 g0 = *(const f32x4*)(qn_g + (c8 & 63)), g1 = *(const f32x4*)(qn_g + (c8 & 63) + 4), h0 = *(const f32x4*)(kn_g + (c8 & 63)), h1 = *(const f32x4*)(kn_g + (c8 & 63) + 4);
              *(u32x4*)(QN + o) = pk8(q0 * qi * g0, q1 * qi * g1);
              *(u32x4*)(KN + o) = pk8(d0 * ki * h0, d1 * ki * h1); }
        }
        __syncthreads();
    }
}

namespace ck {
constexpr int PS = 136;
constexpr int O_BT = 0, O_KT = 8704, O_AP = 17408, O_RT = 26112;
constexpr int O_AT = 34816, O_BH = 43008, O_KH = 51200, O_VV = 59392, O_TN = 67584, O_A2 = 75776, O_V2 = 83968;
constexpr int O_L = 92160, LSTR = 68;
constexpr int O_TOT = 109568, O_GC = 111616;
__device__ __forceinline__ int crow(int r, int hi) { return (r & 3) + 8 * (r >> 2) + 4 * hi; }
__device__ __forceinline__ int voff(int row, int col) { return ((col >> 5) * 4 + (row >> 4)) * 1024 + (row & 15) * 64 + (col & 31) * 2; }
__device__ __forceinline__ s16x4 vtr(const LAS unsigned char* p) { return __builtin_bit_cast(s16x4, __builtin_amdgcn_ds_read_tr16_b64_v4i16((LAS s16x4*)p)); }
__device__ __forceinline__ bf16x8 fragP(const LAS unsigned char* M, int row, int k0, int hi) {
    const LAS unsigned char* p = M + row * PS + (k0 + 4 * hi) * 2; const s16x4 lo = *(const LAS s16x4*)p, h = *(const LAS s16x4*)(p + 16);
    return (bf16x8){lo[0], lo[1], lo[2], lo[3], h[0], h[1], h[2], h[3]}; }
__device__ __forceinline__ bf16x8 fragT(const LAS unsigned char* M, int k0, int colblk, int lane, int hi) {
    const LAS unsigned char* p = M + (colblk * 4 + (k0 >> 4)) * 1024 + ((lane >> 4) & 1) * 32 + (lane & 3) * 8 + (4 * hi + ((lane & 15) >> 2)) * 64;
    const s16x4 lo = vtr(p), h = vtr(p + 512); return (bf16x8){lo[0], lo[1], lo[2], lo[3], h[0], h[1], h[2], h[3]}; }
__device__ __forceinline__ bf16x8 packR(const f32x16& x, int s) {
    u32x4 w; w.x = pk2(x[8 * s], x[8 * s + 1]); w.y = pk2(x[8 * s + 2], x[8 * s + 3]); w.z = pk2(x[8 * s + 4], x[8 * s + 5]); w.w = pk2(x[8 * s + 6], x[8 * s + 7]); return __builtin_bit_cast(bf16x8, w); }
#define CK_MFMA(a, b, c) __builtin_amdgcn_mfma_f32_32x32x16_bf16(a, b, c, 0, 0, 0)
__device__ __forceinline__ f32x16 score(const LAS unsigned char* Am, const LAS unsigned char* Bm, int sblk, int tblk, int mode, int r32, int hi) {
    f32x16 x = f32x16{};
#pragma unroll
    for (int ks = 0; ks < 4; ++ks) x = CK_MFMA(fragP(Am, sblk * 32 + r32, 16 * ks, hi), fragP(Bm, tblk * 32 + r32, 16 * ks, hi), x);
    if (mode) {
        const int t = tblk * 32 + r32;
#pragma unroll
        for (int r = 0; r < 16; ++r) { const int s = sblk * 32 + crow(r, hi); if (mode == 1 ? !(s < t) : !(s <= t)) x[r] = 0.f; }
    }
    return x;
}
__device__ __forceinline__ void storeT_V(LAS unsigned char* M, const f32x16& x, int rb, int c, int hi) {
#pragma unroll
    for (int q = 0; q < 4; ++q) { u32x2 w; w.x = pk2(x[4 * q], x[4 * q + 1]); w.y = pk2(x[4 * q + 2], x[4 * q + 3]); *(LAS u32x2*)(M + voff(c, rb * 32 + 8 * q + 4 * hi)) = w; }
}
__device__ __forceinline__ void storeT_S(LAS unsigned char* M, const f32x16& x, int rb, int c, int hi) {
#pragma unroll
    for (int q = 0; q < 4; ++q) { u32x2 w; w.x = pk2(x[4 * q], x[4 * q + 1]); w.y = pk2(x[4 * q + 2], x[4 * q + 3]); *(LAS u32x2*)(M + c * PS + (rb * 32 + 8 * q + 4 * hi) * 2) = w; }
}

__device__ __forceinline__ void chunk_item(LAS unsigned char* lds, const Args& a, int item) {
    const int tid = threadIdx.x; int lane = tid & 63; const int wave = __builtin_amdgcn_readfirstlane(tid >> 6);
#define CK_FRESH() asm volatile("" : "+v"(lane)); r32 = lane & 31; hi = lane >> 5
    int r32, hi; CK_FRESH();
    unsigned char* ws = a.ws;
    const bf16_t* SR = (const bf16_t*)(ws + WS_SR); const bf16_t* SK = (const bf16_t*)(ws + WS_SK); const bf16_t* SV = (const bf16_t*)(ws + WS_SV);
    const bf16_t* SA = (const bf16_t*)(ws + WS_SA); const bf16_t* SB = (const bf16_t*)(ws + WS_SB); const float* SW = (const float*)(ws + WS_SW);
    bf16_t* CG = (bf16_t*)(ws + WS_CG) + (size_t)item * 4096; bf16_t* CH = (bf16_t*)(ws + WS_CH) + (size_t)item * 4096;
    bf16_t* CR2 = (bf16_t*)(ws + WS_CR2) + (size_t)item * 4096; bf16_t* CY0 = (bf16_t*)(ws + WS_CY0) + (size_t)item * 4096;
    const int bh = item >> 6, c = item & 63, b = bh >> 3, h = bh & 7, tokc = b * SEQ + c * 64, col0 = h * 64;
    LAS unsigned char* BT = lds + O_BT; LAS unsigned char* KT = lds + O_KT; LAS unsigned char* AP = lds + O_AP; LAS unsigned char* RT = lds + O_RT;
    LAS unsigned char* AT = lds + O_AT; LAS unsigned char* BH = lds + O_BH; LAS unsigned char* KH = lds + O_KH; LAS unsigned char* VV = lds + O_VV;
    LAS unsigned char* TN = lds + O_TN; LAS unsigned char* A2M = lds + O_A2; LAS unsigned char* V2M = lds + O_V2;
    LAS float* L = (LAS float*)(lds + O_L); LAS float* TOT = (LAS float*)(lds + O_TOT); LAS float* GC = (LAS float*)(lds + O_GC);
    {
        const int tl = tid >> 3, c8 = (tid & 7) * 8; const size_t o = (size_t)(tokc + tl) * CW + col0 + c8;
        const f32x4 w0 = *(const f32x4*)(SW + o), w1 = *(const f32x4*)(SW + o + 4);
        const u32x4 ua = *(const u32x4*)(SA + o), ub = *(const u32x4*)(SB + o), uk = *(const u32x4*)(SK + o), ur = *(const u32x4*)(SR + o), uv = *(const u32x4*)(SV + o);
        float p[8] = {w0.x, w0.y, w0.z, w0.w, w1.x, w1.y, w1.z, w1.w}, wv[8];
#pragma unroll
        for (int j = 0; j < 8; ++j) wv[j] = p[j];
#pragma unroll
        for (int d = 8; d < 64; d <<= 1) {
#pragma unroll
            for (int j = 0; j < 8; ++j) { const float q = __shfl_up(p[j], d); if (lane >= d) p[j] *= q; }
        }
        if ((lane >> 3) == 7) { *(LAS f32x4*)(TOT + wave * 64 + c8) = (f32x4){p[0], p[1], p[2], p[3]}; *(LAS f32x4*)(TOT + wave * 64 + c8 + 4) = (f32x4){p[4], p[5], p[6], p[7]}; }
        __syncthreads();
        float pre[8], gC[8];
#pragma unroll
        for (int j = 0; j < 8; ++j) { pre[j] = 1.f; gC[j] = 1.f; }
#pragma unroll
        for (int w2 = 0; w2 < 8; ++w2) { const f32x4 t0 = *(const LAS f32x4*)(TOT + w2 * 64 + c8), t1 = *(const LAS f32x4*)(TOT + w2 * 64 + c8 + 4);
            const float tv[8] = {t0.x, t0.y, t0.z, t0.w, t1.x, t1.y, t1.z, t1.w};
#pragma unroll
            for (int j = 0; j < 8; ++j) { if (w2 < wave) pre[j] *= tv[j]; gC[j] *= tv[j]; } }
        if (tid < 8) { *(LAS f32x4*)(GC + c8) = (f32x4){gC[0], gC[1], gC[2], gC[3]}; *(LAS f32x4*)(GC + c8 + 4) = (f32x4){gC[4], gC[5], gC[6], gC[7]}; }
        const f32x4 a0 = cvlo(ua), a1 = cvhi(ua), b0 = cvlo(ub), b1 = cvhi(ub), k0 = cvlo(uk), k1 = cvhi(uk), r0 = cvlo(ur), r1 = cvhi(ur);
        const float av[8] = {a0.x, a0.y, a0.z, a0.w, a1.x, a1.y, a1.z, a1.w}, bv[8] = {b0.x, b0.y, b0.z, b0.w, b1.x, b1.y, b1.z, b1.w};
        const float kv[8] = {k0.x, k0.y, k0.z, k0.w, k1.x, k1.y, k1.z, k1.w}, rv[8] = {r0.x, r0.y, r0.z, r0.w, r1.x, r1.y, r1.z, r1.w};
        float at[8], rt[8], bt[8], kt[8], bh[8], kh[8];
#pragma unroll
        for (int j = 0; j < 8; ++j) { const float g = pre[j] * p[j], ig = __builtin_amdgcn_rcpf(g), gp = g * __builtin_amdgcn_rcpf(wv[j]);
            at[j] = av[j] * gp; rt[j] = rv[j] * g; bt[j] = bv[j] * ig; kt[j] = kv[j] * ig; bh[j] = bt[j] * gC[j]; kh[j] = kt[j] * gC[j]; }
#define CK_PK8(v) ((u32x4){pk2(v[0], v[1]), pk2(v[2], v[3]), pk2(v[4], v[5]), pk2(v[6], v[7])})
#define CK_ST_P(M, val_) do { LAS unsigned char* d_ = (M) + tl * PS + c8 * 2; const u32x4 q_ = (val_); *(LAS u32x2*)d_ = (u32x2){q_[0], q_[1]}; *(LAS u32x2*)(d_ + 8) = (u32x2){q_[2], q_[3]}; } while (0)
        const u32x4 wa = CK_PK8(at), wr = CK_PK8(rt), wb = CK_PK8(bt), wk = CK_PK8(kt), wbh = CK_PK8(bh), wkh = CK_PK8(kh);
        CK_ST_P(AP, wa); CK_ST_P(RT, wr); CK_ST_P(BT, wb); CK_ST_P(KT, wk);
        *(LAS u32x4*)(AT + voff(tl, c8)) = wa; *(LAS u32x4*)(BH + voff(tl, c8)) = wbh; *(LAS u32x4*)(KH + voff(tl, c8)) = wkh; *(LAS u32x4*)(VV + voff(tl, c8)) = uv;
#undef CK_PK8
#undef CK_ST_P
    }
    __syncthreads();
    CK_FRESH();
    f32x16 pa = f32x16{}, pb = f32x16{}, pc = f32x16{}, pd = f32x16{};
#define w1a pa
#define w1b pb
#define xb0 pa
#define xb1 pb
#define y0a pc
#define y0b pd
    if (wave < 2) {
        for (int k = 0; k < (wave == 0 ? 2 : 1); ++k) {
            const int sblk = wave == 0 ? k : 0, tblk = wave == 0 ? k : 1;
            const f32x16 x = score(BT, AP, sblk, tblk, wave == 0 ? 1 : 0, r32, hi);
            const int t = tblk * 32 + r32;
#pragma unroll
            for (int r = 0; r < 16; ++r) L[(sblk * 32 + crow(r, hi)) * LSTR + t] = x[r];
        }
    }
    __syncthreads();
    CK_FRESH();
    if (wave == 6) {
        float x[32];
#pragma unroll
        for (int t = 0; t < 32; ++t) x[t] = (r32 == t) ? 1.f : 0.f;
        const LAS float* Nr = L + (32 * hi) * LSTR + 32 * hi;
#pragma unroll
        for (int sidx = 0; sidx < 31; ++sidx) {
#pragma unroll
            for (int g4 = (sidx + 1) / 4; g4 < 8; ++g4) {
                const f32x4 nv = *(const LAS f32x4*)(Nr + sidx * LSTR + 4 * g4);
                if (4 * g4 + 0 > sidx) x[4 * g4 + 0] += nv.x * x[sidx];
                if (4 * g4 + 1 > sidx) x[4 * g4 + 1] += nv.y * x[sidx];
                if (4 * g4 + 2 > sidx) x[4 * g4 + 2] += nv.z * x[sidx];
                if (4 * g4 + 3 > sidx) x[4 * g4 + 3] += nv.w * x[sidx];
            }
            if ((sidx & 3) == 3) __builtin_amdgcn_sched_barrier(0);
        }
        const int cc = 32 * hi + r32;
#pragma unroll
        for (int t0 = 0; t0 < 32; t0 += 8) { u32x4 w; w.x = pk2(x[t0], x[t0 + 1]); w.y = pk2(x[t0 + 2], x[t0 + 3]); w.z = pk2(x[t0 + 4], x[t0 + 5]); w.w = pk2(x[t0 + 6], x[t0 + 7]);
            *(LAS u32x4*)(TN + voff(cc, 32 * hi + t0)) = w; }
        f32x16 m = f32x16{};
#pragma unroll
        for (int s = 0; s < 2; ++s) {
            const LAS float* lp = L + (16 * s + 4 * hi) * LSTR + 32 + r32;
            u32x4 aw; aw.x = pk2(lp[0], lp[LSTR]); aw.y = pk2(lp[2 * LSTR], lp[3 * LSTR]); aw.z = pk2(lp[8 * LSTR], lp[9 * LSTR]); aw.w = pk2(lp[10 * LSTR], lp[11 * LSTR]);
            const s16x4 b0 = *(const LAS s16x4*)(TN + voff(r32, 16 * s + 4 * hi)), b1 = *(const LAS s16x4*)(TN + voff(r32, 16 * s + 8 + 4 * hi));
            m = CK_MFMA(__builtin_bit_cast(bf16x8, aw), ((bf16x8){b0[0], b0[1], b0[2], b0[3], b1[0], b1[1], b1[2], b1[3]}), m);
        }
        f32x16 t21 = f32x16{};
#pragma unroll
        for (int s = 0; s < 2; ++s) t21 = CK_MFMA(fragT(TN, 32 + 16 * s, 1, lane, hi), packR(m, s), t21);
        storeT_V(TN, t21, 1, r32, hi);
    } else if (wave < 4) {
        const int dvb = wave - 2;
        const f32x16 x00 = score(KT, AP, 0, 0, 1, r32, hi), x01 = score(KT, AP, 0, 1, 0, r32, hi), x11 = score(KT, AP, 1, 1, 1, r32, hi);
#pragma unroll
        for (int s = 0; s < 2; ++s) {
            const bf16x8 v0 = fragT(VV, 16 * s, dvb, lane, hi), v1 = fragT(VV, 32 + 16 * s, dvb, lane, hi);
            w1a = CK_MFMA(packR(x00, s), v0, w1a);
            w1b = CK_MFMA(packR(x01, s), v0, w1b);
            w1b = CK_MFMA(packR(x11, s), v1, w1b);
        }
    } else if (wave < 6) {
        const int tb = wave - 4;
        f32x16 xk0, xk1 = f32x16{};
        if (tb == 0) { xk0 = score(KT, RT, 0, 0, 2, r32, hi); xb0 = score(BT, RT, 0, 0, 2, r32, hi); }
        else { xk0 = score(KT, RT, 0, 1, 0, r32, hi); xk1 = score(KT, RT, 1, 1, 2, r32, hi); xb0 = score(BT, RT, 0, 1, 0, r32, hi); xb1 = score(BT, RT, 1, 1, 2, r32, hi); }
#pragma unroll
        for (int s = 0; s < 2; ++s) {
            y0a = CK_MFMA(fragT(VV, 16 * s, 0, lane, hi), packR(xk0, s), y0a);
            y0b = CK_MFMA(fragT(VV, 16 * s, 1, lane, hi), packR(xk0, s), y0b);
            if (tb == 1) { y0a = CK_MFMA(fragT(VV, 32 + 16 * s, 0, lane, hi), packR(xk1, s), y0a); y0b = CK_MFMA(fragT(VV, 32 + 16 * s, 1, lane, hi), packR(xk1, s), y0b); }
        }
    }
    __syncthreads();
    CK_FRESH();
    if (wave < 2) {
        const int cb = wave; f32x16 a0 = f32x16{}, a1 = f32x16{};
#pragma unroll
        for (int ks = 0; ks < 4; ++ks) {
            const bf16x8 af = fragT(AT, 16 * ks, cb, lane, hi);
            if (ks < 2) a0 = CK_MFMA(af, fragT(TN, 16 * ks, 0, lane, hi), a0);
            a1 = CK_MFMA(af, fragT(TN, 16 * ks, 1, lane, hi), a1);
        }
        storeT_V(A2M, a0, cb, r32, hi); storeT_V(A2M, a1, cb, 32 + r32, hi);
    } else if (wave < 4) {
        const int dvb = wave - 2; f32x16 v0 = f32x16{}, v1 = f32x16{};
#pragma unroll
        for (int s = 0; s < 2; ++s) {
            v0 = CK_MFMA(packR(w1a, s), fragT(TN, 16 * s, 0, lane, hi), v0);
            v1 = CK_MFMA(packR(w1a, s), fragT(TN, 16 * s, 1, lane, hi), v1);
            v1 = CK_MFMA(packR(w1b, s), fragT(TN, 32 + 16 * s, 1, lane, hi), v1);
        }
        storeT_V(V2M, v0, dvb, r32, hi); storeT_V(V2M, v1, dvb, 32 + r32, hi);
    }
    __syncthreads();
    CK_FRESH();
    if (wave >= 4 && wave < 6) {
        const int tb = wave - 4, t = tb * 32 + r32;
        f32x16 r0 = f32x16{}, r1 = f32x16{};
#pragma unroll
        for (int s = 0; s < 2; ++s) {
            const bf16x8 p0 = packR(xb0, s);
            r0 = CK_MFMA(fragT(A2M, 16 * s, 0, lane, hi), p0, r0); r1 = CK_MFMA(fragT(A2M, 16 * s, 1, lane, hi), p0, r1);
            y0a = CK_MFMA(fragT(V2M, 16 * s, 0, lane, hi), p0, y0a); y0b = CK_MFMA(fragT(V2M, 16 * s, 1, lane, hi), p0, y0b);
            if (tb == 1) { const bf16x8 p1 = packR(xb1, s);
                r0 = CK_MFMA(fragT(A2M, 32 + 16 * s, 0, lane, hi), p1, r0); r1 = CK_MFMA(fragT(A2M, 32 + 16 * s, 1, lane, hi), p1, r1);
                y0a = CK_MFMA(fragT(V2M, 32 + 16 * s, 0, lane, hi), p1, y0a); y0b = CK_MFMA(fragT(V2M, 32 + 16 * s, 1, lane, hi), p1, y0b); }
        }
#pragma unroll
        for (int q = 0; q < 4; ++q) {
            const u32x2 u0 = *(const LAS u32x2*)(RT + t * PS + (8 * q + 4 * hi) * 2), u1 = *(const LAS u32x2*)(RT + t * PS + (32 + 8 * q + 4 * hi) * 2);
            r0[4 * q] += bflo(u0.x); r0[4 * q + 1] += bfhi(u0.x); r0[4 * q + 2] += bflo(u0.y); r0[4 * q + 3] += bfhi(u0.y);
            r1[4 * q] += bflo(u1.x); r1[4 * q + 1] += bfhi(u1.x); r1[4 * q + 2] += bflo(u1.y); r1[4 * q + 3] += bfhi(u1.y);
        }
        storeT_S(BT, r0, 0, t, hi); storeT_S(BT, r1, 1, t, hi);
        storeT_S(KT, y0a, 0, t, hi); storeT_S(KT, y0b, 1, t, hi);
    } else if (wave < 2) {
        const int ib = wave, i = ib * 32 + r32; const float gci = GC[i];
        f32x16 g0 = f32x16{}, g1 = f32x16{};
#pragma unroll
        for (int ks = 0; ks < 4; ++ks) { const bf16x8 bf_ = fragT(BH, 16 * ks, ib, lane, hi);
            g0 = CK_MFMA(fragT(A2M, 16 * ks, 0, lane, hi), bf_, g0); g1 = CK_MFMA(fragT(A2M, 16 * ks, 1, lane, hi), bf_, g1); }
#pragma unroll
        for (int r = 0; r < 16; ++r) { if (crow(r, hi) == i) g0[r] += gci; if (32 + crow(r, hi) == i) g1[r] += gci; }
        storeT_S(AP, g0, 0, i, hi); storeT_S(AP, g1, 1, i, hi);
    } else {
        const int id = wave < 4 ? wave - 2 : wave - 4, ib = id >> 1, dvb = id & 1;
        f32x16 hh = f32x16{};
#pragma unroll
        for (int ks = 0; ks < 4; ++ks) {
            hh = CK_MFMA(fragT(BH, 16 * ks, ib, lane, hi), fragT(V2M, 16 * ks, dvb, lane, hi), hh);
            hh = CK_MFMA(fragT(KH, 16 * ks, ib, lane, hi), fragT(VV, 16 * ks, dvb, lane, hi), hh);
        }
        storeT_S((LAS unsigned char*)L, hh, ib, dvb * 32 + r32, hi);
    }
    __syncthreads();
    {
        const int row = tid >> 3, ch = tid & 7;
        const LAS unsigned char* s0 = BT + row * PS + ch * 16; const LAS unsigned char* s1 = KT + row * PS + ch * 16; const LAS unsigned char* s2 = AP + row * PS + ch * 16; const LAS unsigned char* s3 = (const LAS unsigned char*)L + row * PS + ch * 16;
        const u32x2 a0 = *(const LAS u32x2*)s0, a1 = *(const LAS u32x2*)(s0 + 8), b0 = *(const LAS u32x2*)s1, b1 = *(const LAS u32x2*)(s1 + 8);
        const u32x2 c0 = *(const LAS u32x2*)s2, c1 = *(const LAS u32x2*)(s2 + 8), d0 = *(const LAS u32x2*)s3, d1 = *(const LAS u32x2*)(s3 + 8);
        *(u32x4*)(CR2 + row * 64 + ch * 8) = (u32x4){a0.x, a0.y, a1.x, a1.y}; *(u32x4*)(CY0 + row * 64 + ch * 8) = (u32x4){b0.x, b0.y, b1.x, b1.y};
        *(u32x4*)(CG + row * 64 + ch * 8) = (u32x4){c0.x, c0.y, c1.x, c1.y}; *(u32x4*)(CH + row * 64 + ch * 8) = (u32x4){d0.x, d0.y, d1.x, d1.y};
    }
    asm volatile("s_waitcnt lgkmcnt(0)" ::: "memory"); __builtin_amdgcn_s_barrier();
#undef CK_FRESH
#undef w1a
#undef w1b
#undef xb0
#undef xb1
#undef y0a
#undef y0b
}
__device__ __forceinline__ void p2b_chunks(LAS unsigned char* lds, const Args& a) {
#pragma unroll 1
    for (int item = blockIdx.x; item < 4096; item += gridDim.x) chunk_item(lds, a, item);
}
}

namespace ck {
constexpr int SQ_MAT = 8704, SQ_BUF = 6 * SQ_MAT;
constexpr int SQ_OUT = 2 * SQ_BUF;
__device__ __forceinline__ bf16x8 lfrag(const LAS unsigned char* M, int row, int k0, int hi) { return fragP(M, row, k0, hi); }
__device__ __forceinline__ void linit(f32x16& x, const LAS unsigned char* M, int row, int cblk, int hi) {
#pragma unroll
    for (int q = 0; q < 4; ++q) { const u32x2 u = *(const LAS u32x2*)(M + row * PS + (cblk * 32 + 8 * q + 4 * hi) * 2); x[4 * q] = bflo(u.x); x[4 * q + 1] = bfhi(u.x); x[4 * q + 2] = bflo(u.y); x[4 * q + 3] = bfhi(u.y); }
}
__device__ __forceinline__ void seq_head(LAS unsigned char* lds, const Args& a, int bh) {
    const int tid = threadIdx.x, lane = tid & 63, r32 = lane & 31, hi = lane >> 5; const int wave = __builtin_amdgcn_readfirstlane(tid >> 6);
    unsigned char* ws = a.ws;
    const bf16_t* SV = (const bf16_t*)(ws + WS_SV); const bf16_t* SG = (const bf16_t*)(ws + WS_SG); const float* RK = (const float*)(ws + WS_RK); bf16_t* YMIX = (bf16_t*)(ws + WS_YMIX);
    const int b = bh >> 3, h = bh & 7, col0 = h * 64;
    const float* lng = a.in[12] + col0; const float* lnb = a.in[13] + col0;
#define SQ_LOAD(ch) do { const size_t item_ = (size_t)bh * 64 + (ch); LAS unsigned char* bb_ = lds + ((ch) & 1) * SQ_BUF; const size_t t0_ = (size_t)b * SEQ + (ch) * 64; \
        for (int p_ = tid - 128; p_ < 3072; p_ += 384) { const int m_ = p_ >> 9, q_ = p_ & 511, row_ = q_ >> 3, c8_ = (q_ & 7) * 8; u32x4 v_; \
            if (m_ == 0) v_ = *(const u32x4*)((const bf16_t*)(ws + WS_CG) + item_ * 4096 + row_ * 64 + c8_); \
            else if (m_ == 1) v_ = *(const u32x4*)((const bf16_t*)(ws + WS_CH) + item_ * 4096 + row_ * 64 + c8_); \
            else if (m_ == 2) v_ = *(const u32x4*)((const bf16_t*)(ws + WS_CR2) + item_ * 4096 + row_ * 64 + c8_); \
            else if (m_ == 3) v_ = *(const u32x4*)((const bf16_t*)(ws + WS_CY0) + item_ * 4096 + row_ * 64 + c8_); \
            else if (m_ == 4) v_ = *(const u32x4*)(SV + (t0_ + row_) * CW + col0 + c8_); \
            else v_ = *(const u32x4*)(SG + (t0_ + row_) * CW + col0 + c8_); \
            LAS unsigned char* d_ = bb_ + m_ * SQ_MAT + row_ * PS + c8_ * 2; *(LAS u32x2*)d_ = (u32x2){v_.x, v_.y}; *(LAS u32x2*)(d_ + 8) = (u32x2){v_.z, v_.w}; } } while (0)
#define SQ_STORE(ch) do { const LAS unsigned char* ob_ = lds + SQ_OUT + ((ch) & 1) * SQ_MAT; const size_t t0_ = (size_t)b * SEQ + (ch) * 64; \
        for (int p_ = tid - 128; p_ < 512; p_ += 384) { const int row_ = p_ >> 3, c8_ = (p_ & 7) * 8; const LAS unsigned char* s_ = ob_ + row_ * PS + c8_ * 2; \
            const u32x2 lo_ = *(const LAS u32x2*)s_, hi_ = *(const LAS u32x2*)(s_ + 8); *(u32x4*)(YMIX + (t0_ + row_) * D + col0 + c8_) = (u32x4){lo_.x, lo_.y, hi_.x, hi_.y}; } } while (0)
    if (wave >= 2) SQ_LOAD(0);
    __syncthreads();
    f32x16 X00 = f32x16{}, X01 = f32x16{}, X10 = f32x16{}, X11 = f32x16{};
#pragma unroll 1
    for (int c = 0; c < 64; ++c) {
        if (wave >= 2) {
            if (c + 1 < 64) SQ_LOAD(c + 1);
            if (c > 0) SQ_STORE(c - 1);
        } else {
            const int tb = wave;
            const LAS unsigned char* bb = lds + (c & 1) * SQ_BUF;
            const LAS unsigned char* MG = bb; const LAS unsigned char* MH = bb + SQ_MAT; const LAS unsigned char* MR = bb + 2 * SQ_MAT; const LAS unsigned char* MY = bb + 3 * SQ_MAT;
            const LAS unsigned char* MV = bb + 4 * SQ_MAT; const LAS unsigned char* MGT = bb + 5 * SQ_MAT;
            LAS unsigned char* OB = lds + SQ_OUT + (c & 1) * SQ_MAT;
            const int tl = tb * 32 + r32; const size_t t = (size_t)b * SEQ + c * 64 + tl;
            const float rk = RK[t * 8 + h];
            f32x16 y0, y1; linit(y0, MY, tl, 0, hi); linit(y1, MY, tl, 1, hi);
#pragma unroll
            for (int s = 0; s < 2; ++s) {
                const bf16x8 rf0 = lfrag(MR, tl, 16 * s, hi), rf1 = lfrag(MR, tl, 32 + 16 * s, hi);
                y0 = CK_MFMA(packR(X00, s), rf0, y0); y0 = CK_MFMA(packR(X10, s), rf1, y0);
                y1 = CK_MFMA(packR(X01, s), rf0, y1); y1 = CK_MFMA(packR(X11, s), rf1, y1);
            }
#pragma unroll
            for (int db = 0; db < 2; ++db) {
                f32x16 Na, Nb; linit(Na, MH, db * 32 + r32, 0, hi); linit(Nb, MH, db * 32 + r32, 1, hi);
#pragma unroll
                for (int s = 0; s < 2; ++s) {
                    const bf16x8 g00 = lfrag(MG, r32, 16 * s, hi), g01 = lfrag(MG, r32, 32 + 16 * s, hi), g10 = lfrag(MG, 32 + r32, 16 * s, hi), g11 = lfrag(MG, 32 + r32, 32 + 16 * s, hi);
                    const bf16x8 p0 = packR(db ? X01 : X00, s), p1 = packR(db ? X11 : X10, s);
                    Na = CK_MFMA(g00, p0, Na); Na = CK_MFMA(g01, p1, Na);
                    Nb = CK_MFMA(g10, p0, Nb); Nb = CK_MFMA(g11, p1, Nb);
                }
                if (db == 0) { X00 = Na; X10 = Nb; } else { X01 = Na; X11 = Nb; }
            }
            float sm = 0.f;
#pragma unroll
            for (int r = 0; r < 16; ++r) sm += y0[r] + y1[r];
            sm += __shfl_xor(sm, 32);
            const float mean = sm * (1.0f / 64.0f);
            float sq = 0.f;
#pragma unroll
            for (int r = 0; r < 16; ++r) { const float d0 = y0[r] - mean, d1 = y1[r] - mean; sq += d0 * d0 + d1 * d1; }
            sq += __shfl_xor(sq, 32);
            const float rs = 1.0f / sqrtf(sq * (1.0f / 64.0f) + 64e-5f);
#pragma unroll
            for (int db = 0; db < 2; ++db)
#pragma unroll
                for (int q = 0; q < 4; ++q) {
                    const int dv = db * 32 + 8 * q + 4 * hi;
                    const f32x4 lg = *(const f32x4*)(lng + dv), lb = *(const f32x4*)(lnb + dv);
                    const u32x2 uv = *(const LAS u32x2*)(MV + tl * PS + dv * 2), ug = *(const LAS u32x2*)(MGT + tl * PS + dv * 2);
                    const f32x4 vv = {bflo(uv.x), bfhi(uv.x), bflo(uv.y), bfhi(uv.y)}, gg = {bflo(ug.x), bfhi(ug.x), bflo(ug.y), bfhi(ug.y)};
                    f32x4 yy; if (db == 0) yy = (f32x4){y0[4 * q], y0[4 * q + 1], y0[4 * q + 2], y0[4 * q + 3]}; else yy = (f32x4){y1[4 * q], y1[4 * q + 1], y1[4 * q + 2], y1[4 * q + 3]};
                    const f32x4 o = ((yy - mean) * rs * lg + lb + rk * vv) * gg;
                    u32x2 w; w.x = pk2(o.x, o.y); w.y = pk2(o.z, o.w);
                    *(LAS u32x2*)(OB + tl * PS + dv * 2) = w;
                }
        }
        __syncthreads();
    }
    if (wave >= 2) SQ_STORE(63);
#undef SQ_LOAD
#undef SQ_STORE
}
}

__device__ __forceinline__ float red16(float v) {
    v += dpp_f<0xB1>(v); v += dpp_f<0x4E>(v); v += dpp_f<0x141>(v); v += dpp_f<0x140>(v);
    return v;
}
__device__ __forceinline__ void p3_scan(LAS unsigned char* lds, const Args& a) {
    const int tid = threadIdx.x, lane = tid & 63, wave = __builtin_amdgcn_readfirstlane(tid >> 6);
    unsigned char* ws = a.ws;
    const bf16_t* SR = (const bf16_t*)(ws + WS_SR); const bf16_t* SK = (const bf16_t*)(ws + WS_SK); const bf16_t* SV = (const bf16_t*)(ws + WS_SV);
    const bf16_t* SA = (const bf16_t*)(ws + WS_SA); const bf16_t* SB = (const bf16_t*)(ws + WS_SB); const float* SW = (const float*)(ws + WS_SW);
    float* YRAW = (float*)(ws + WS_YRAW);
    const int bh = blockIdx.x >> 1, half = blockIdx.x & 1;
    const int b = bh >> 3, h = bh & 7, tok0 = b * SEQ, col0 = h * 64, row0 = half * 32;
    constexpr int BUFB = 45056;
    LAS float* buf0 = (LAS float*)lds; LAS float* buf1 = (LAS float*)(lds + BUFB);
    LAS float* Y0 = (LAS float*)(lds + 2 * BUFB); LAS float* Y1 = Y0 + 1024;
    constexpr int NCH = SEQ / 32;
    if (wave >= 4) {
        const int lw = wave - 4, sl = lw * 8 + (lane >> 3), cg = lane & 7, c8 = cg * 8;
        f32x4 w0_, w1_; u32x4 uk, ua, ub, ur; u32x2 uv;
#define SC_ISSUE(ch) do { const size_t o_ = (size_t)(tok0 + (ch) * 32 + sl) * CW + col0; \
            w0_ = *(const f32x4*)(SW + o_ + c8); w1_ = *(const f32x4*)(SW + o_ + c8 + 4); uk = *(const u32x4*)(SK + o_ + c8); ua = *(const u32x4*)(SA + o_ + c8); ub = *(const u32x4*)(SB + o_ + c8); ur = *(const u32x4*)(SR + o_ + c8); \
            uv = *(const u32x2*)(SV + o_ + row0 + 4 * cg); } while (0)
#define SC_STORE(bufp) do { LAS float* d_ = (bufp) + sl * 64 + c8; *(LAS f32x4*)(d_) = w0_; *(LAS f32x4*)(d_ + 4) = w1_; \
            *(LAS f32x4*)(d_ + 2048) = cvlo(uk); *(LAS f32x4*)(d_ + 2052) = cvhi(uk); *(LAS f32x4*)(d_ + 4096) = cvlo(ua); *(LAS f32x4*)(d_ + 4100) = cvhi(ua); \
            *(LAS f32x4*)(d_ + 6144) = cvlo(ub); *(LAS f32x4*)(d_ + 6148) = cvhi(ub); *(LAS f32x4*)(d_ + 8192) = cvlo(ur); *(LAS f32x4*)(d_ + 8196) = cvhi(ur); \
            *(LAS f32x4*)((bufp) + 10240 + sl * 32 + 4 * cg) = (f32x4){bflo(uv.x), bfhi(uv.x), bflo(uv.y), bfhi(uv.y)}; } while (0)
#define SC_YOUT(ch, yp) do { *(f32x4*)(YRAW + (size_t)(tok0 + (ch) * 32 + sl) * CW + col0 + row0 + 4 * cg) = *(const LAS f32x4*)((yp) + sl * 32 + 4 * cg); } while (0)
        SC_ISSUE(0); SC_STORE(buf0);
        __syncthreads();
        for (int ch = 0; ch < NCH; ++ch) {
            LAS float* ob = (ch & 1) ? buf0 : buf1; const LAS float* oy = (ch & 1) ? Y0 : Y1;
            if (ch + 1 < NCH) SC_ISSUE(ch + 1);
            if (ch > 0) SC_YOUT(ch - 1, oy);
            if (ch + 1 < NCH) SC_STORE(ob);
            __syncthreads();
        }
        { const LAS float* oy = ((NCH - 1) & 1) ? Y1 : Y0; SC_YOUT(NCH - 1, oy); }
#undef SC_ISSUE
#undef SC_STORE
#undef SC_YOUT
    } else {
        const int g = lane & 7, rl = lane >> 3, row = wave * 8 + rl;
        f32x2 S0 = {0.f, 0.f}, S1 = S0, S2 = S0, S3 = S0;
        __syncthreads();
        for (int ch = 0; ch < NCH; ++ch) {
            const LAS float* cb = (ch & 1) ? buf1 : buf0; LAS float* yb = (ch & 1) ? Y1 : Y0;
            const LAS float* pa = cb + 4 * g; const LAS float* pv = cb + 10240 + row;
#define SC_LD(X, s_) const f32x4 w0##X = *(const LAS f32x4*)(pa + (s_) * 64), w1##X = *(const LAS f32x4*)(pa + (s_) * 64 + 32), k0##X = *(const LAS f32x4*)(pa + (s_) * 64 + 2048), k1##X = *(const LAS f32x4*)(pa + (s_) * 64 + 2080), \
                a0##X = *(const LAS f32x4*)(pa + (s_) * 64 + 4096), a1##X = *(const LAS f32x4*)(pa + (s_) * 64 + 4128), b0##X = *(const LAS f32x4*)(pa + (s_) * 64 + 6144), b1##X = *(const LAS f32x4*)(pa + (s_) * 64 + 6176), \
                r0##X = *(const LAS f32x4*)(pa + (s_) * 64 + 8192), r1##X = *(const LAS f32x4*)(pa + (s_) * 64 + 8224); const float v##X = pv[(s_) * 32]
#define LO(q) ((f32x2){(q).x, (q).y})
#define HI(q) ((f32x2){(q).z, (q).w})
#define SC_STEP(X, s_) do { f32x2 t = S0 * LO(a0##X); t = S1 * HI(a0##X) + t; t = S2 * LO(a1##X) + t; t = S3 * HI(a1##X) + t; float sa = t.x + t.y; \
                const f32x2 vv = {v##X, v##X}; \
                f32x2 p0 = S0 * LO(w0##X), p1 = S1 * HI(w0##X), p2 = S2 * LO(w1##X), p3 = S3 * HI(w1##X); \
                p0 = vv * LO(k0##X) + p0; p1 = vv * HI(k0##X) + p1; p2 = vv * LO(k1##X) + p2; p3 = vv * HI(k1##X) + p3; \
                sa = red8(sa); const f32x2 ss = {sa, sa}; \
                S0 = ss * LO(b0##X) + p0; S1 = ss * HI(b0##X) + p1; S2 = ss * LO(b1##X) + p2; S3 = ss * HI(b1##X) + p3; \
                f32x2 u = S0 * LO(r0##X); u = S1 * HI(r0##X) + u; u = S2 * LO(r1##X) + u; u = S3 * HI(r1##X) + u; float y = u.x + u.y; y = red8(y); \
                yb[(s_) * 32 + row] = y; } while (0)
#pragma unroll 1
            for (int s8 = 0; s8 < 32; s8 += 8) {
                SC_LD(0, s8 + 0); SC_LD(1, s8 + 1);
                SC_STEP(0, s8 + 0); SC_LD(2, s8 + 2);
                SC_STEP(1, s8 + 1); SC_LD(3, s8 + 3);
                SC_STEP(2, s8 + 2); SC_LD(4, s8 + 4);
                SC_STEP(3, s8 + 3); SC_LD(5, s8 + 5);
                SC_STEP(4, s8 + 4); SC_LD(6, s8 + 6);
                SC_STEP(5, s8 + 5); SC_LD(7, s8 + 7);
                SC_STEP(6, s8 + 6);
                SC_STEP(7, s8 + 7);
            }
#undef SC_LD
#undef LO
#undef HI
#undef SC_STEP
            __syncthreads();
        }
    }
}

__device__ __forceinline__ void p3_post(const Args& a, int G) {
    const int tid = threadIdx.x, lane = tid & 63, wave = __builtin_amdgcn_readfirstlane(tid >> 6);
    unsigned char* ws = a.ws;
    const bf16_t* SR = (const bf16_t*)(ws + WS_SR); const bf16_t* SK = (const bf16_t*)(ws + WS_SK); const bf16_t* SV = (const bf16_t*)(ws + WS_SV);
    const bf16_t* SG = (const bf16_t*)(ws + WS_SG); const float* YRAW = (const float*)(ws + WS_YRAW); bf16_t* YMIX = (bf16_t*)(ws + WS_YMIX);
    const int gw = blockIdx.x * 8 + wave, NGW = G * 8, c8 = lane * 8;
    const f32x4 lg0 = *(const f32x4*)(a.in[12] + c8), lg1 = *(const f32x4*)(a.in[12] + c8 + 4), lb0 = *(const f32x4*)(a.in[13] + c8), lb1 = *(const f32x4*)(a.in[13] + c8 + 4);
    const f32x4 rk0 = *(const f32x4*)(a.in[11] + c8), rk1 = *(const f32x4*)(a.in[11] + c8 + 4);
    for (int t = gw; t < T; t += NGW) {
        const size_t o = (size_t)t * CW + c8;
        const f32x4 y0 = *(const f32x4*)(YRAW + o), y1 = *(const f32x4*)(YRAW + o + 4);
        const u32x4 ur = *(const u32x4*)(SR + o), uk = *(const u32x4*)(SK + o), uv = *(const u32x4*)(SV + o), ug = *(const u32x4*)(SG + o);
        const float mean = red8((y0.x + y0.y) + (y0.z + y0.w) + (y1.x + y1.y) + (y1.z + y1.w)) * (1.0f / 64.0f);
        const f32x4 d0 = y0 - mean, d1 = y1 - mean;
        const float var = red8((d0.x * d0.x + d0.y * d0.y) + (d0.z * d0.z + d0.w * d0.w) + (d1.x * d1.x + d1.y * d1.y) + (d1.z * d1.z + d1.w * d1.w)) * (1.0f / 64.0f);
        const f32x4 r0 = cvlo(ur), r1 = cvhi(ur), k0 = cvlo(uk), k1 = cvhi(uk);
        const f32x4 p0 = r0 * k0 * rk0, p1 = r1 * k1 * rk1;
        const float rk = red8((p0.x + p0.y) + (p0.z + p0.w) + (p1.x + p1.y) + (p1.z + p1.w));
        const float rs = 1.0f / sqrtf(var + 64e-5f);
        const f32x4 o0 = (d0 * rs * lg0 + lb0 + rk * cvlo(uv)) * cvlo(ug), o1 = (d1 * rs * lg1 + lb1 + rk * cvhi(uv)) * cvhi(ug);
        *(u32x4*)(YMIX + (size_t)t * D + c8) = pk8(o0, o1);
    }
}

namespace att {
constexpr int SLOT = 32768, OFF_V = 16384;
constexpr int TBL_OFF = MISC_OFF + 1024;
constexpr int LW_OFF = MISC_OFF + 2048;
constexpr int CST_OFF = MISC_OFF + 3072;
__device__ __forceinline__ int crow(int r, int hi) { return (r & 3) + 8 * (r >> 2) + 4 * hi; }
__device__ __forceinline__ void glds16(const void* gsrc, unsigned lds_dst) { unsigned keep;
    asm volatile("s_mov_b32 %0, m0\n\ts_mov_b32 m0, %2\n\ts_nop 0\n\tglobal_load_lds_dwordx4 %1, off\n\ts_mov_b32 m0, %0" : "=&s"(keep) : "v"(gsrc), "s"(lds_dst) : "memory"); }
__device__ __forceinline__ s16x4 vtr(const LAS unsigned char* p) { return __builtin_bit_cast(s16x4, __builtin_amdgcn_ds_read_tr16_b64_v4i16((LAS s16x4*)p)); }

__device__ __forceinline__ void attn_unit(LAS unsigned char* lds, const Args& a, int b, int h, int qb, float negM, float lam) {
    const int tid = threadIdx.x, lane = tid & 63, r32 = lane & 31, hi = lane >> 5; const int wid = __builtin_amdgcn_readfirstlane(tid >> 6);
    const int c = wid >> 2, rg = wid & 3;
    unsigned char* ws = a.ws;
    const bf16_t* QN = (const bf16_t*)(ws + WS_QN); const bf16_t* KN = (const bf16_t*)(ws + WS_KN); const bf16_t* P = (const bf16_t*)(ws + WS_P); bf16_t* YMIX = (bf16_t*)(ws + WS_YMIX);
    const int q0 = qb * 128; const size_t rowbase = (size_t)b * SEQ;
    const int NT = 2 * qb + 2;
    LAS float* tbl = (LAS float*)(lds + TBL_OFF); LAS float* lw = (LAS float*)(lds + LW_OFF) + wid * 32;
    if (tid < 128) {
        const int n = tid; int bkt;
        if (n < 16) bkt = n; else { bkt = 16 + (int)(logf((float)n * (1.0f / 16.0f)) / 2.0794415416798357f * 16.0f); bkt = bkt > 31 ? 31 : bkt; }
        tbl[n] = (a.in[21][bkt * 4 + h] - a.in[21][31 * 4 + h]) * LOG2E;
    }
    const bf16_t* Qw = QN + (rowbase + q0 + rg * 32 + r32) * CW + h * 128 + c * 64;
    bf16x8 qr[4];
#pragma unroll
    for (int d0 = 0; d0 < 4; ++d0) qr[d0] = *(const bf16x8*)(Qw + d0 * 16 + hi * 8);
    const bf16_t* k0src = KN + (rowbase + lane) * CW + h * 128 + wid * 8;
    const bf16_t* k1src = k0src + 64;
    const int pv0 = 2 * wid, pv1 = 2 * wid + 1;
    const bf16_t* v0src = P + (rowbase + 16 * (pv0 & 3) + (lane >> 2)) * NINP + DV0 + h * 128 + 32 * (pv0 >> 2) + (lane & 3) * 8;
    const bf16_t* v1src = P + (rowbase + 16 * (pv1 & 3) + (lane >> 2)) * NINP + DV0 + h * 128 + 32 * (pv1 >> 2) + (lane & 3) * 8;
#define ATT_DMA(t, slot) do { const unsigned s_ = lds0 + (unsigned)(slot) * SLOT; \
        glds16(k0src + (size_t)(t) * 64 * CW, (unsigned)__builtin_amdgcn_readfirstlane(s_ + wid * 1024)); \
        glds16(k1src + (size_t)(t) * 64 * CW, (unsigned)__builtin_amdgcn_readfirstlane(s_ + 8192 + wid * 1024)); \
        glds16(v0src + (size_t)(t) * 64 * NINP, (unsigned)__builtin_amdgcn_readfirstlane(s_ + OFF_V + pv0 * 1024)); \
        glds16(v1src + (size_t)(t) * 64 * NINP, (unsigned)__builtin_amdgcn_readfirstlane(s_ + OFF_V + pv1 * 1024)); } while (0)
#define ATT_SBAR() __builtin_amdgcn_sched_barrier(0)
    const unsigned lds0 = (unsigned)(uintptr_t)lds;
    f32x16 o[4];
#pragma unroll
    for (int d0 = 0; d0 < 4; ++d0) o[d0] = f32x16{};
    float lsum = 0.f;
    const bool shift = negM < -60.0f;
    const int qmin = q0 + 32 * rg, qpos = qmin + r32;
    ATT_DMA(0, 0);
    asm volatile("s_waitcnt vmcnt(0)" ::: "memory");
    __syncthreads();
    for (int t = 0; t < NT; ++t) {
        if (t + 1 < NT) ATT_DMA(t + 1, (t + 1) & 1);
        const int kmin = 64 * t;
        if (kmin <= qmin + 31) {
            const LAS unsigned char* slot = lds + (t & 1) * SLOT;
            const LAS unsigned char* kb = slot + c * 8192 + hi * 1024 + r32 * 16;
            const LAS unsigned char* vb = slot + OFF_V + ((lane >> 4) & 1) * 32 + (lane & 3) * 8 + (4 * hi + ((lane & 15) >> 2)) * 64;
            bf16x8 kf[8];
#pragma unroll
            for (int d0 = 0; d0 < 4; ++d0) { kf[2 * d0] = *(const LAS bf16x8*)(kb + d0 * 2048); kf[2 * d0 + 1] = *(const LAS bf16x8*)(kb + d0 * 2048 + 512); }
            s16x4 va[16], vc[16];
#pragma unroll
            for (int i = 0; i < 8; ++i) { va[2 * i] = vtr(vb + (i >> 2) * 4096 + (i & 3) * 1024); va[2 * i + 1] = vtr(vb + (i >> 2) * 4096 + (i & 3) * 1024 + 512); }
            ATT_SBAR();
            f32x16 p0, p1;
            p0 = __builtin_amdgcn_mfma_f32_32x32x16_bf16(kf[0], qr[0], f32x16{}, 0, 0, 0); p1 = __builtin_amdgcn_mfma_f32_32x32x16_bf16(kf[1], qr[0], f32x16{}, 0, 0, 0);
#pragma unroll
            for (int d0 = 1; d0 < 4; ++d0) { p0 = __builtin_amdgcn_mfma_f32_32x32x16_bf16(kf[2 * d0], qr[d0], p0, 0, 0, 0); p1 = __builtin_amdgcn_mfma_f32_32x32x16_bf16(kf[2 * d0 + 1], qr[d0], p1, 0, 0, 0); }
            ATT_SBAR();
            if (qmin - (kmin + 63) < 113) {
#pragma unroll
                for (int r = 0; r < 16; ++r) {
                    const int d0_ = qpos - (kmin + crow(r, hi)); const int d1_ = d0_ - 32;
                    const float t0 = tbl[d0_ < 0 ? 0 : (d0_ > 127 ? 127 : d0_)], t1 = tbl[d1_ < 0 ? 0 : (d1_ > 127 ? 127 : d1_)];
                    p0[r] = d0_ < 0 ? -INFINITY : p0[r] + t0; p1[r] = d1_ < 0 ? -INFINITY : p1[r] + t1;
                }
            }
            if (shift) {
#pragma unroll
                for (int r = 0; r < 16; ++r) { p0[r] += negM; p1[r] += negM; }
            }
            float sacc = 0.f;
#pragma unroll
            for (int r = 0; r < 16; ++r) { p0[r] = __builtin_amdgcn_exp2f(p0[r]); p1[r] = __builtin_amdgcn_exp2f(p1[r]); sacc += p0[r] + p1[r]; }
            lsum += sacc;
            u32x4 pw[4];
#pragma unroll
            for (int i = 0; i < 4; ++i) { pw[0][i] = pk2(p0[2 * i], p0[2 * i + 1]); pw[1][i] = pk2(p0[8 + 2 * i], p0[8 + 2 * i + 1]); pw[2][i] = pk2(p1[2 * i], p1[2 * i + 1]); pw[3][i] = pk2(p1[8 + 2 * i], p1[8 + 2 * i + 1]); }
            ATT_SBAR();
#pragma unroll
            for (int i = 0; i < 8; ++i) { vc[2 * i] = vtr(vb + (2 + (i >> 2)) * 4096 + (i & 3) * 1024); vc[2 * i + 1] = vtr(vb + (2 + (i >> 2)) * 4096 + (i & 3) * 1024 + 512); }
#pragma unroll
            for (int i = 0; i < 8; ++i) {
                const bf16x8 vf = (bf16x8){va[2 * i][0], va[2 * i][1], va[2 * i][2], va[2 * i][3], va[2 * i + 1][0], va[2 * i + 1][1], va[2 * i + 1][2], va[2 * i + 1][3]};
                o[i >> 2] = __builtin_amdgcn_mfma_f32_32x32x16_bf16(__builtin_bit_cast(bf16x8, pw[i & 3]), vf, o[i >> 2], 0, 0, 0);
            }
#pragma unroll
            for (int i = 0; i < 8; ++i) {
                const bf16x8 vf = (bf16x8){vc[2 * i][0], vc[2 * i][1], vc[2 * i][2], vc[2 * i][3], vc[2 * i + 1][0], vc[2 * i + 1][1], vc[2 * i + 1][2], vc[2 * i + 1][3]};
                o[2 + (i >> 2)] = __builtin_amdgcn_mfma_f32_32x32x16_bf16(__builtin_bit_cast(bf16x8, pw[i & 3]), vf, o[2 + (i >> 2)], 0, 0, 0);
            }
        }
        asm volatile("s_waitcnt vmcnt(0)" ::: "memory");
        __syncthreads();
    }
#undef ATT_DMA
#undef ATT_SBAR
    lsum += __shfl_xor(lsum, 32);
    if (hi == 0) lw[r32] = 1.0f / lsum;
    asm volatile("s_waitcnt lgkmcnt(0)" ::: "memory");
    LAS float* stg = (LAS float*)(lds + wid * 16384);
#pragma unroll
    for (int r = 0; r < 16; ++r) { const int orow = crow(r, hi); const float il = lw[orow];
#pragma unroll
        for (int d0 = 0; d0 < 4; ++d0) stg[orow * 128 + d0 * 32 + r32] = o[d0][r] * il; }
    __syncthreads();
    {
        const int row = tid >> 2, part = tid & 3, rgp = row >> 5, rr = row & 31;
        const LAS float* s1 = (const LAS float*)(lds + rgp * 16384) + rr * 128 + part * 32;
        const LAS float* s2 = (const LAS float*)(lds + (4 + rgp) * 16384) + rr * 128 + part * 32;
        float dv[32]; float ss = 0.f;
#pragma unroll
        for (int i = 0; i < 8; ++i) { const f32x4 x1 = *(const LAS f32x4*)(s1 + 4 * i), x2 = *(const LAS f32x4*)(s2 + 4 * i);
#pragma unroll
            for (int j = 0; j < 4; ++j) { const float dd = x1[j] - lam * x2[j]; dv[4 * i + j] = dd; ss += dd * dd; } }
        ss = red4(ss);
        const float sc = (1.0f / sqrtf(ss * (1.0f / 128.0f) + 1e-5f)) * 0.8f;
        const float* sg = a.in[20] + part * 32;
        bf16_t* op = YMIX + (rowbase + q0 + row) * D + CW + h * 128 + part * 32;
#pragma unroll
        for (int i = 0; i < 4; ++i) { u32x4 w;
            w.x = pk2(dv[8 * i] * sc * sg[8 * i], dv[8 * i + 1] * sc * sg[8 * i + 1]); w.y = pk2(dv[8 * i + 2] * sc * sg[8 * i + 2], dv[8 * i + 3] * sc * sg[8 * i + 3]);
            w.z = pk2(dv[8 * i + 4] * sc * sg[8 * i + 4], dv[8 * i + 5] * sc * sg[8 * i + 5]); w.w = pk2(dv[8 * i + 6] * sc * sg[8 * i + 6], dv[8 * i + 7] * sc * sg[8 * i + 7]);
            *(u32x4*)(op + 8 * i) = w; }
    }
    __syncthreads();
}

__device__ __forceinline__ void attn_phase(LAS unsigned char* lds, const Args& a, unsigned* ctl) {
    const int tid = threadIdx.x;
    LAS float* cst = (LAS float*)(lds + CST_OFF);
    if (tid < 64) {
        const float gq = fabsf(a.in[14][tid]), gk = fabsf(a.in[15][tid]);
        float mq = gq, mk = gk;
#pragma unroll
        for (int o = 1; o < 64; o <<= 1) { mq = fmaxf(mq, __shfl_xor(mq, o)); mk = fmaxf(mk, __shfl_xor(mk, o)); }
        const float d1 = wave_sum(a.in[16][tid] * a.in[17][tid]), d2 = wave_sum(a.in[18][tid] * a.in[19][tid]);
        float mb = 0.f;
        if (tid < 32) { for (int hh = 0; hh < 4; ++hh) mb = fmaxf(mb, (a.in[21][tid * 4 + hh] - a.in[21][31 * 4 + hh]) * LOG2E); }
#pragma unroll
        for (int o = 1; o < 64; o <<= 1) mb = fmaxf(mb, __shfl_xor(mb, o));
        if (tid == 0) { cst[0] = -(8.0f * LOG2E * mq * mk * 1.02f + mb); cst[1] = __expf(d1) - __expf(d2) + 0.2f; }
    }
    __syncthreads();
    const float negM = cst[0], lam = cst[1];
    LAS int* ubox = (LAS int*)(lds + CST_OFF + 16);
    for (;;) {
        if (tid == 0) ubox[0] = (int)atomicAdd(ctl + CW_ATTQ, 1u);
        __syncthreads();
        const int u = ubox[0];
        __syncthreads();
        if (u >= 1024) break;
        const int qb = 31 - (u >> 5), bhh = u & 31;
        attn_unit(lds, a, bhh >> 2, bhh & 3, qb, negM, lam);
    }
}
}

__device__ __forceinline__ void p5_router(LAS unsigned char* lds, const Args& a, unsigned* ctl) {
    const int tid = threadIdx.x, lane = tid & 63, r32 = lane & 31, hi = lane >> 5; const int wave = __builtin_amdgcn_readfirstlane(tid >> 6);
    unsigned char* ws = a.ws;
    const bf16_t* x1 = (const bf16_t*)(ws + WS_X1B); const float* g2 = a.in[23]; const float* rw = a.in[24]; const float* rb = a.in[25];
    unsigned char* H2 = ws + WS_H2; int* EIDX = (int*)(ws + WS_EIDX); float* GATE = (float*)(ws + WS_GATE); int* POS = (int*)(ws + WS_POS);
    LAS unsigned char* WH = lds; LAS unsigned char* WL = lds + 65536;
    LAS int* cnt = (LAS int*)(lds + MISC_OFF + 1024);
    LAS int* basel = (LAS int*)(lds + MISC_OFF + 1024 + 128);
    LAS int* el = (LAS int*)(lds + MISC_OFF + 2048);
    LAS int* pl = (LAS int*)(lds + MISC_OFF + 4096);
    {
        const int e = tid & 31;
        for (int k = tid >> 5; k < 1024; k += 16) {
            const float v = rw[k * 32 + e] * g2[k]; const unsigned h = f2bf(v); const float vh = __builtin_bit_cast(float, h << 16); const unsigned l = f2bf(v - vh);
            const int off = e * 2048 + (((k >> 3) ^ (e & 15)) << 4) + (k & 7) * 2;
            *(LAS unsigned short*)(WH + off) = (unsigned short)h; *(LAS unsigned short*)(WL + off) = (unsigned short)l;
        }
    }
    if (tid < 32) cnt[tid] = 0;
    __syncthreads();
    const int TPB = T / (int)gridDim.x, tb0 = blockIdx.x * TPB;
    if (wave < 4) {
        const int tl = wave * 32 + r32, t = tb0 + tl;
        const bf16_t* xrow = x1 + (size_t)t * D + 8 * hi;
        const LAS unsigned char* wh = WH + r32 * 2048; const LAS unsigned char* wl = WL + r32 * 2048; const int sw = r32 & 15;
        f32x16 d = f32x16{}; float ssq = 0.f;
#pragma unroll 8
        for (int s = 0; s < 64; ++s) {
            const u32x4 xb = *(const u32x4*)(xrow + 16 * s);
            const int co = ((2 * s + hi) ^ sw) << 4;
            const bf16x8 ah = *(const LAS bf16x8*)(wh + co), al = *(const LAS bf16x8*)(wl + co);
            const bf16x8 bx = __builtin_bit_cast(bf16x8, xb);
            d = __builtin_amdgcn_mfma_f32_32x32x16_bf16(ah, bx, d, 0, 0, 0);
            d = __builtin_amdgcn_mfma_f32_32x32x16_bf16(al, bx, d, 0, 0, 0);
            const f32x4 x0 = cvlo(xb), x1v = cvhi(xb);
            ssq += (x0.x * x0.x + x0.y * x0.y) + (x0.z * x0.z + x0.w * x0.w) + (x1v.x * x1v.x + x1v.y * x1v.y) + (x1v.z * x1v.z + x1v.w * x1v.w);
        }
        ssq += __shfl_xor(ssq, 32);
        const float rstd = 1.0f / sqrtf(ssq * (1.0f / D) + 1e-5f);
        float lg[16];
#pragma unroll
        for (int r = 0; r < 16; ++r) lg[r] = d[r] * rstd + rb[8 * (r >> 2) + 4 * hi + (r & 3)];
        float tv[4]; int ti[4];
#pragma unroll
        for (int k = 0; k < 4; ++k) {
            float bv = -INFINITY; int bi = 0;
#pragma unroll
            for (int r = 0; r < 16; ++r) { const int e = 8 * (r >> 2) + 4 * hi + (r & 3); if (lg[r] > bv) { bv = lg[r]; bi = e; } }
            tv[k] = bv; ti[k] = bi;
#pragma unroll
            for (int r = 0; r < 16; ++r) { const int e = 8 * (r >> 2) + 4 * hi + (r & 3); if (e == bi) lg[r] = -INFINITY; }
        }
        float ov[4]; int oi[4];
#pragma unroll
        for (int k = 0; k < 4; ++k) { ov[k] = __shfl_xor(tv[k], 32); oi[k] = __shfl_xor(ti[k], 32); }
        float mv[4]; int mi[4];
        {
            int pa = 0, pb = 0;
#pragma unroll
            for (int k = 0; k < 4; ++k) {
                float ca = -INFINITY, cb = -INFINITY; int ia = 0, ib = 0;
#pragma unroll
                for (int q = 0; q < 4; ++q) { if (q == pa) { ca = tv[q]; ia = ti[q]; } if (q == pb) { cb = ov[q]; ib = oi[q]; } }
                const bool takeA = (ca > cb) || (ca == cb && ia < ib);
                mv[k] = takeA ? ca : cb; mi[k] = takeA ? ia : ib; pa += takeA ? 1 : 0; pb += takeA ? 0 : 1;
            }
        }
        const float e1 = __expf(mv[1] - mv[0]), e2 = __expf(mv[2] - mv[0]), e3 = __expf(mv[3] - mv[0]);
        const float inv = 1.0f / (1.0f + e1 + e2 + e3);
        if (hi == 0) {
            *(int4*)(EIDX + (size_t)t * 4) = make_int4(mi[0], mi[1], mi[2], mi[3]);
            *(float4*)(GATE + (size_t)t * 4) = make_float4(inv, e1 * inv, e2 * inv, e3 * inv);
#pragma unroll
            for (int k = 0; k < 4; ++k) { el[tl * 4 + k] = mi[k]; pl[tl * 4 + k] = atomicAdd((int*)(cnt + mi[k]), 1); }
        }
    } else {
        f32x4 gv[4];
#pragma unroll
        for (int j = 0; j < 4; ++j) gv[j] = *((const f32x4*)g2 + lane + 64 * j);
        for (int i = 0; i < 32; ++i) {
            const int t = tb0 + (wave - 4) * 32 + i;
            const u32x2* xr = (const u32x2*)(x1 + (size_t)t * D) + lane;
            f32x4 v[4]; float s = 0.f;
#pragma unroll
            for (int j = 0; j < 4; ++j) { const u32x2 xw = xr[64 * j]; v[j] = (f32x4){bflo(xw.x), bfhi(xw.x), bflo(xw.y), bfhi(xw.y)}; s += (v[j].x * v[j].x + v[j].y * v[j].y) + (v[j].z * v[j].z + v[j].w * v[j].w); }
            const float rstd = (1.0f / sqrtf(wave_sum(s) * (1.0f / D) + 1e-5f)) * F8_X_MUL;
            unsigned* o4 = (unsigned*)(H2 + (size_t)t * D) + lane;
#pragma unroll
            for (int j = 0; j < 4; ++j) { v[j] = v[j] * rstd * gv[j]; o4[64 * j] = pk4_fp8(v[j].x, v[j].y, v[j].z, v[j].w); }
        }
    }
    __syncthreads();
    if (tid < 32) basel[tid] = (int)atomicAdd(ctl + CW_CNT + tid, (unsigned)cnt[tid]);
    __syncthreads();
    for (int i = tid; i < TPB * 4; i += 512) POS[(size_t)tb0 * 4 + i] = pl[i] + basel[el[i]];
}

__device__ __forceinline__ void p6_dispatch(LAS unsigned char* lds, const Args& a, unsigned* ctl) {
    const int tid = threadIdx.x, lane = tid & 63, wave = __builtin_amdgcn_readfirstlane(tid >> 6);
    unsigned char* ws = a.ws;
    const int* EIDX = (const int*)(ws + WS_EIDX); const float* GATE = (const float*)(ws + WS_GATE); const int* POS = (const int*)(ws + WS_POS);
    int* DEST = (int*)(ws + WS_DEST); float* ROWGATE = (float*)(ws + WS_ROWGATE); int* TILEE = (int*)(ws + WS_TILEE); int* ROWTOK = (int*)(ws + WS_ROWTOK);
    LAS int* pstart = (LAS int*)(lds + MISC_OFF + 1024); LAS int* pcnt = pstart + 32;
    if (tid == 0) {
        int acc = 0;
        for (int e = 0; e < NE; ++e) { const int cn = (int)__hip_atomic_load(ctl + CW_CNT + e, __ATOMIC_RELAXED, __HIP_MEMORY_SCOPE_AGENT); pstart[e] = acc; pcnt[e] = cn;
            const int nt = (cn + 255) >> 8;
            if (blockIdx.x == 0) for (int i = 0; i < nt; ++i) TILEE[(acc >> 8) + i] = e;
            acc += nt * 256; }
        if (blockIdx.x == 0) TILEE[1023] = acc >> 8;
    }
    __syncthreads();
    if (blockIdx.x < NE) {
        const int e = blockIdx.x, cn = pcnt[e], pe = ((cn + 255) >> 8) * 256;
        for (int i = cn + tid; i < pe; i += 512) ROWTOK[pstart[e] + i] = 0;
    }
    const int TPB = T / (int)gridDim.x, tb0 = blockIdx.x * TPB;
    for (int pi = tb0 * 4 + tid; pi < (tb0 + TPB) * 4; pi += 512) {
        const int e = EIDX[pi], dest = pstart[e] + POS[pi];
        DEST[pi] = dest; ROWGATE[dest] = GATE[pi]; ROWTOK[dest] = pi >> 2;
    }
}

__device__ __forceinline__ void p9_combine(const Args& a, int G) {
    const int tid = threadIdx.x, lane = tid & 63, wave = __builtin_amdgcn_readfirstlane(tid >> 6);
    unsigned char* ws = a.ws;
    const unsigned char* YS = ws + WS_YS; const int* DEST = (const int*)(ws + WS_DEST);
    float* out = a.out;
    const int gw = blockIdx.x * 8 + wave, NGW = G * 8;
    for (int t = gw; t < T; t += NGW) {
        f32x4* xr = (f32x4*)(out + (size_t)t * D) + lane; const u32x2* xi = (const u32x2*)((const bf16_t*)(ws + WS_X1B) + (size_t)t * D) + lane;
        f32x4 v[4];
#pragma unroll
        for (int j = 0; j < 4; ++j) { const u32x2 xw = xi[64 * j]; v[j] = (f32x4){bflo(xw.x), bfhi(xw.x), bflo(xw.y), bfhi(xw.y)}; }
#pragma unroll
        for (int k = 0; k < 4; ++k) {
            const int dest = DEST[t * 4 + k];
            const unsigned* yr = (const unsigned*)(YS + (size_t)dest * D) + lane;
#pragma unroll
            for (int j = 0; j < 4; ++j) { const unsigned w = yr[64 * j];
                const f32x2 lo = __builtin_amdgcn_cvt_pk_f32_fp8((int)w, false), hi2 = __builtin_amdgcn_cvt_pk_f32_fp8((int)w, true);
                v[j].x += lo.x * (1.0f / F8_Y_MUL); v[j].y += lo.y * (1.0f / F8_Y_MUL); v[j].z += hi2.x * (1.0f / F8_Y_MUL); v[j].w += hi2.y * (1.0f / F8_Y_MUL); }
        }
        if (TIME_REGION >= 0) { const float sc_ = 1.0f + 4e-6f * (float)((const unsigned*)(ws + WS_CTL))[301];
#pragma unroll
            for (int j = 0; j < 4; ++j) v[j] = v[j] * sc_; }
#pragma unroll
        for (int j = 0; j < 4; ++j) xr[64 * j] = v[j];
    }
}

constexpr int NPHASE = 10;
__global__ void __launch_bounds__(512, 2) hymba_fwd(Args args) {
    extern __shared__ __attribute__((aligned(16))) unsigned char lds_raw[];
    LAS unsigned char* lds = (LAS unsigned char*)lds_raw;
    cg::grid_group grid = cg::this_grid();
    const int G = gridDim.x;
    unsigned char* ws = args.ws;
    unsigned* ctl = (unsigned*)(ws + WS_CTL);
    const int lo = args.ph_lo, hi = args.ph_hi;
#define IN(k) (lo <= (k) && (k) < hi)
#define NREP(k) ((REP_PHASE) == (k) ? 2 : 1)
#define TSTART(k) do { if ((TIME_REGION) == (k) && blockIdx.x == 0 && threadIdx.x == 0) ctl[300] = (unsigned)__builtin_amdgcn_s_memrealtime(); } while (0)
#define TEND(k) do { if ((TIME_REGION) == (k) && blockIdx.x == 0 && threadIdx.x == 0) ctl[301] = (unsigned)__builtin_amdgcn_s_memrealtime() - ctl[300]; } while (0)
#define SEAM(k) do { if (IN(k) && IN((k) + 1)) { if (args.ph_lo < 0) grid.sync(); xcd_barrier(xbar); } } while (0)
    const int* TILEE = (const int*)(ws + WS_TILEE);
    { volatile LAS unsigned* st = (volatile LAS unsigned*)(lds + MISC_OFF); if (threadIdx.x < 2) st[threadIdx.x] = 0u; }
    __syncthreads();
    const XcdBarrier xbar = xcd_barrier_post(ctl + CW_BAR, (volatile LAS unsigned*)(lds + MISC_OFF));

    if (IN(0)) { for (int rep = 0; rep < NREP(0); ++rep) p0_prologue(lds, args, G); } SEAM(0);
    if (IN(1)) {
        pg8::Gemm g{ws + WS_XN, ws + WS_WINT, 1024, 0, 0, nullptr};
        pg8::TileOrder S; S.init(T / 256, NINP / 256, G, (int)blockIdx.x, nullptr, 0, WGM_P1);
        pg8::EpiBf16 E{(bf16_t*)(ws + WS_P), NINP};
        for (int rep = 0; rep < NREP(1); ++rep) pg8::gemm_phase<false, false>(lds, g, S, E);
    } SEAM(1);
    TSTART(2);
    if (IN(2)) {
        p2_prep(lds, args);
        asm volatile("s_waitcnt vmcnt(0)" ::: "memory");
        __syncthreads();
        { const int bb = (int)blockIdx.x >> 5, cp = ((int)blockIdx.x & 31) * 2;
          _Pragma("clang loop unroll(disable)") for (int i = 0; i < 16; ++i) ck::chunk_item(lds, args, ((bb * 8 + (i & 7)) << 6) + cp + (i >> 3)); }
    } SEAM(2);
    TSTART(3);
    if (IN(3)) {
        TSTART(30); for (int rep = 0; rep < NREP(30); ++rep) { if (blockIdx.x < 64) ck::seq_head(lds, args, (int)blockIdx.x); __syncthreads(); } TEND(30);
        for (int rep = 0; rep < NREP(31); ++rep) att::attn_phase(lds, args, ctl + 64 * rep);
    } SEAM(3); TEND(3);
    if (IN(4)) {
        pg8::Gemm g{ws + WS_YMIX, ws + WS_WOUT, 1024, 0, 0, nullptr};
        pg8::TileOrder S; S.init(T / 256, D / 256, G, (int)blockIdx.x, nullptr, 0, WGM_P4);
        pg8::EpiResBf16 E{args.in[0], (bf16_t*)(ws + WS_X1B), D};
        for (int rep = 0; rep < NREP(4); ++rep) pg8::gemm_phase<false, false>(lds, g, S, E);
    } SEAM(4);
    if (IN(5)) { _Pragma("clang loop unroll(disable)") for (int rep = 0; rep < NREP(5); ++rep) { p5_router(lds, args, ctl + 256 * (NREP(5) - 1 - rep)); __syncthreads(); } } SEAM(5);
    if (IN(6)) { for (int rep = 0; rep < NREP(6); ++rep) { p6_dispatch(lds, args, ctl); __syncthreads(); } } SEAM(6);
    if (IN(7)) {
        const int ntile = TILEE[1023];
        pg8::Gemm g{ws + WS_H2, ws + WS_W1T, 1024, F8_W_SC, F8_X_SC, (const int*)(ws + WS_ROWTOK)};
        pg8::TileOrder S; S.init(ntile, 8, G, (int)blockIdx.x, TILEE, 8, WGM_P7);
        pg8::EpiSwiglu E{ws + WS_HID, args.in[27], TILEE};
        for (int rep = 0; rep < NREP(7); ++rep) pg8::gemm_phase<true, true>(lds, g, S, E);
    } SEAM(7);
    if (IN(8)) {
        const int ntile = TILEE[1023];
        pg8::Gemm g{ws + WS_HID, ws + WS_W2T, 1024, F8_W_SC, F8_H_SC, nullptr};
        pg8::TileOrder S; S.init(ntile, 4, G, (int)blockIdx.x, TILEE, 4, WGM_P8);
        pg8::EpiGateF8 E{ws + WS_YS, args.in[29], (const float*)(ws + WS_ROWGATE), TILEE};
        for (int rep = 0; rep < NREP(8); ++rep) pg8::gemm_phase<true, false>(lds, g, S, E);
    } SEAM(8);
    if (IN(9)) { p9_combine(args, G); }
#undef IN
#undef SEAM
}

extern "C" void kernel_launch(void* const* d_in, const int* in_sizes, int n_in, void* d_out, int out_size, void* d_ws, size_t ws_size, hipStream_t stream) {
    static int grid = 0;
    if (grid == 0) {
        if (n_in != 30 || in_sizes[0] != T * D || out_size != T * D || ws_size < WS_END) { fprintf(stderr, "kernel_launch: unexpected shapes (n_in %d, in0 %d, out %d, ws %zu); nothing launched\n", n_in, n_in > 0 ? in_sizes[0] : -1, out_size, ws_size); grid = -1; return; }
        int dev = 0, cus = 0, per_cu = 0;
        if (hipGetDevice(&dev) != hipSuccess || hipDeviceGetAttribute(&cus, hipDeviceAttributeMultiprocessorCount, dev) != hipSuccess) { grid = -1; return; }
        if (hipFuncSetAttribute((const void*)hymba_fwd, hipFuncAttributeMaxDynamicSharedMemorySize, LDS_BYTES) != hipSuccess) { fprintf(stderr, "kernel_launch: hipFuncSetAttribute failed\n"); grid = -1; return; }
        if (hipOccupancyMaxActiveBlocksPerMultiprocessor(&per_cu, (const void*)hymba_fwd, 512, LDS_BYTES) != hipSuccess || per_cu < 1) { fprintf(stderr, "kernel_launch: occupancy query says %d\n", per_cu); per_cu = 1; }
        (void)hipGetLastError();
        grid = cus;
        if (grid > 256) grid = 256;
        if (grid != 256 || T % grid != 0 || (T / grid) % 16 != 0) { fprintf(stderr, "kernel_launch: grid %d does not divide the token count evenly\n", grid); grid = -1; return; }
    }
    if (grid < 0) return;
    (void)hipMemsetAsync((char*)d_ws + WS_CTL, 0, CTL_ZERO_BYTES, stream);
    Args a{};
    for (int i = 0; i < 30; ++i) a.in[i] = (const float*)d_in[i];
    a.out = (float*)d_out; a.ws = (unsigned char*)d_ws;
    constexpr int NL = MK_N_LAUNCHES;
    for (int li = 0; li < NL; ++li) {
        a.ph_lo = (NL == 1) ? 0 : li; a.ph_hi = (NL == 1) ? NPHASE : li + 1;
        void* kargs[] = {&a};
        hipError_t e = hipLaunchCooperativeKernel((const void*)hymba_fwd, dim3(grid), dim3(512), kargs, LDS_BYTES, stream);
        if (e != hipSuccess) { fprintf(stderr, "kernel_launch: cooperative launch %d failed: %s (grid %d)\n", li, hipGetErrorString(e), grid); break; }
    }
}
```

```cpp
#include <hip/hip_runtime.h>
#include <hip/hip_cooperative_groups.h>
#include <cstdio>
#include <cstdint>
#include <type_traits>
namespace cg = cooperative_groups;

#ifndef REP_PHASE
#define REP_PHASE -1
#endif
#ifndef TIME_REGION
#define TIME_REGION -1
#endif
#ifndef WGM_P1
#define WGM_P1 2
#endif
#ifndef WGM_P4
#define WGM_P4 2
#endif
#ifndef WGM_P7
#define WGM_P7 2
#endif
#ifndef WGM_P8
#define WGM_P8 2
#endif
#ifndef MK_N_LAUNCHES
#define MK_N_LAUNCHES 1
#endif

#define LAS __attribute__((address_space(3)))
#define GAS __attribute__((address_space(1)))
typedef unsigned short bf16_t;
typedef short bf16x8 __attribute__((ext_vector_type(8)));
typedef short s16x4 __attribute__((ext_vector_type(4)));
typedef float f32x2 __attribute__((ext_vector_type(2)));
typedef float f32x4 __attribute__((ext_vector_type(4)));
typedef float f32x16 __attribute__((ext_vector_type(16)));
typedef unsigned u32x2 __attribute__((ext_vector_type(2)));
typedef unsigned u32x4 __attribute__((ext_vector_type(4)));
typedef int v8i32 __attribute__((ext_vector_type(8)));

constexpr int NB = 8, SEQ = 4096, T = NB * SEQ, D = 1024;
constexpr int CW = 512;
constexpr int NRW = 1696, NIN = 3232, NINP = 3328;
constexpr int DQ0 = 1696, DK0 = 2208, DV0 = 2720;
constexpr int NE = 32, TOPK = 4, DE = 1024;
constexpr int MAXROWS = T * TOPK + NE * 256;
constexpr int MAXTILES = MAXROWS / 256;
constexpr float LOG2E = 1.4426950408889634f;
constexpr float F8_W_MUL = 32.f, F8_X_MUL = 8.f, F8_H_MUL = 4.f, F8_Y_MUL = 16.f; constexpr int F8_W_SC = 0x7A7A7A7A, F8_X_SC = 0x7C7C7C7C, F8_H_SC = 0x7D7D7D7D;

constexpr size_t MiB = 1u << 20;
constexpr size_t WS_CTL = 0, CTL_ZERO_BYTES = 64 * 1024;
constexpr size_t WS_TILEE = 512 * 1024;
constexpr size_t WS_WINT = 1 * MiB;
constexpr size_t WS_WOUT = 8 * MiB;
constexpr size_t WS_W1T = 10 * MiB;
constexpr size_t WS_W2T = 138 * MiB;
constexpr size_t WS_EIDX = 202 * MiB;
constexpr size_t WS_GATE = WS_EIDX + 512 * 1024;
constexpr size_t WS_POS = WS_GATE + 512 * 1024;
constexpr size_t WS_DEST = WS_POS + 512 * 1024;
constexpr size_t WS_ROWGATE = 204 * MiB;
constexpr size_t WS_XN = 206 * MiB;
constexpr size_t WS_P = 270 * MiB;
constexpr size_t WS_SR = 478 * MiB, WS_SK = 510 * MiB, WS_SV = 542 * MiB, WS_SA = 574 * MiB, WS_SB = 606 * MiB;
constexpr size_t WS_SW = 638 * MiB;
constexpr size_t WS_SG = 702 * MiB;
constexpr size_t WS_QN = 734 * MiB, WS_KN = 766 * MiB;
constexpr size_t WS_YMIX = 798 * MiB;
constexpr size_t WS_H2 = 206 * MiB;
constexpr size_t WS_ROWTOK = 270 * MiB;
constexpr size_t WS_HID = 406 * MiB;
constexpr size_t WS_YS = 542 * MiB;
constexpr size_t WS_YRAW = 862 * MiB;
constexpr size_t WS_X1B = 862 * MiB;
constexpr size_t WS_CG = 862 * MiB;
constexpr size_t WS_CH = 894 * MiB;
constexpr size_t WS_CR2 = 926 * MiB;
constexpr size_t WS_CY0 = 958 * MiB;
constexpr size_t WS_RK = 990 * MiB;
constexpr size_t WS_VT = 992 * MiB;
constexpr size_t WS_END = 1024 * MiB;
constexpr int CW_CNT = 64;
constexpr int CW_ATTQ = 128;
constexpr int CW_BAR = 4096;

constexpr int RING_BYTES = 131072, MISC_OFF = RING_BYTES, LDS_BYTES = 147456;

__device__ __forceinline__ unsigned f2bf(float f) { unsigned u = __builtin_bit_cast(unsigned, f); return (u + 0x7fffu + ((u >> 16) & 1u)) >> 16; }
typedef __bf16 hwbf16x2 __attribute__((ext_vector_type(2)));
__device__ __forceinline__ unsigned pk2(float lo, float hi) { const f32x2 v = {lo, hi}; return __builtin_bit_cast(unsigned, __builtin_convertvector(v, hwbf16x2)); }
__device__ __forceinline__ unsigned pk4_fp8(float a, float b, float c, float d) {
    a = fminf(fmaxf(a, -448.f), 448.f); b = fminf(fmaxf(b, -448.f), 448.f); c = fminf(fmaxf(c, -448.f), 448.f); d = fminf(fmaxf(d, -448.f), 448.f);
    int r = __builtin_amdgcn_cvt_pk_fp8_f32(a, b, 0, false); r = __builtin_amdgcn_cvt_pk_fp8_f32(c, d, r, true); return (unsigned)r; }
__device__ __forceinline__ float bf2f(unsigned short b) { return __builtin_bit_cast(float, (unsigned)b << 16); }
__device__ __forceinline__ float bflo(unsigned w) { return __builtin_bit_cast(float, w << 16); }
__device__ __forceinline__ float bfhi(unsigned w) { return __builtin_bit_cast(float, w & 0xffff0000u); }
__device__ __forceinline__ float wave_sum(float v) {
#pragma unroll
    for (int o = 1; o < 64; o <<= 1) v += __shfl_xor(v, o);
    return v;
}
__device__ __forceinline__ float sigmoidf_(float x) { return 1.0f / (1.0f + __expf(-x)); }
template <int CTRL> __device__ __forceinline__ float dpp_f(float v) { return __builtin_bit_cast(float, __builtin_amdgcn_update_dpp(0, __builtin_bit_cast(int, v), CTRL, 0xF, 0xF, true)); }
__device__ __forceinline__ float red8(float v) {
    v += dpp_f<0xB1>(v);
    v += dpp_f<0x4E>(v);
    v += dpp_f<0x141>(v);
    return v;
}
__device__ __forceinline__ float red4(float v) { v += dpp_f<0xB1>(v); v += dpp_f<0x4E>(v); return v; }


#define XB_TMO      128
#define XB_XCNT(j)  (256  + 64 * (j))
#define XB_XSUB(j)  (1280 + 64 * (j))
#define XB_XGEN(j)  (2304 + 64 * (j))
#define XB_TOP      3328
#define XB_TOPGEN   3392
#define XCD_BAR_WORDS 3456
#define XB_SPIN_CAP (1u << 18)
__device__ __forceinline__ unsigned xb_ld(unsigned* p)              { return __hip_atomic_load(p, __ATOMIC_RELAXED, __HIP_MEMORY_SCOPE_AGENT); }
__device__ __forceinline__ unsigned xb_add(unsigned* p, unsigned v) { return __hip_atomic_fetch_add(p, v, __ATOMIC_RELAXED, __HIP_MEMORY_SCOPE_AGENT); }
__device__ __forceinline__ unsigned xb_xcc_id() { return (unsigned)__builtin_amdgcn_s_getreg((3 << 11) | 20) & 0xFu; }
#define XB_SPIN(cond, bar) do { unsigned _sp = 0; while (cond) { __builtin_amdgcn_s_sleep(1); \
    if ((++_sp & 255u) == 0u) { if (xb_ld(&(bar)[XB_TMO])) break; if (_sp > XB_SPIN_CAP) { atomicAdd(&(bar)[XB_TMO], 1u); break; } } } } while (0)
struct XcdBarrier { unsigned* bar; unsigned x; volatile LAS unsigned* st; };
__device__ __forceinline__ XcdBarrier xcd_barrier_post(unsigned* bar, volatile LAS unsigned* st) {
    XcdBarrier b; b.bar = bar; b.x = xb_xcc_id(); b.st = st;
    if (threadIdx.x == 0) (void)xb_add(&bar[XB_XCNT(b.x)], 1u);
    return b;
}
__device__ __forceinline__ void xcd_barrier_complete(unsigned* bar, unsigned x, unsigned& nloc, unsigned& nx) {
    const unsigned G = gridDim.x * gridDim.y * gridDim.z;
    unsigned sum, cnt, mine, sp = 0u;
    for (;;) {
        sum = 0u; cnt = 0u; mine = 0u;
#pragma unroll
        for (unsigned j = 0; j < 16; ++j) { const unsigned c = xb_ld(&bar[XB_XCNT(j)]); sum += c; cnt += (c > 0u) ? 1u : 0u; mine = (j == x) ? c : mine; }
        if (sum == G) break;
        __builtin_amdgcn_s_sleep(1);
        if ((++sp & 255u) == 0u) { if (xb_ld(&bar[XB_TMO])) break; if (sp > XB_SPIN_CAP) { atomicAdd(&bar[XB_TMO], 1u); break; } }
    }
    nloc = mine > 0u ? mine : 1u; nx = cnt > 0u ? cnt : 1u;
}
__device__ __forceinline__ void xcd_barrier(const XcdBarrier& b) {
    asm volatile("s_waitcnt vmcnt(0)" ::: "memory");
    __syncthreads();
    if (threadIdx.x == 0) {
        unsigned* bar = b.bar;
        __builtin_amdgcn_s_waitcnt(0);
        unsigned nloc = b.st[0], nx = b.st[1];
        if (nloc == 0u) { xcd_barrier_complete(bar, b.x, nloc, nx); b.st[0] = nloc; b.st[1] = nx; }
        const unsigned old = xb_add(&bar[XB_XSUB(b.x)], 1u);
        const unsigned gen = old / nloc;
        if (old + 1u == (gen + 1u) * nloc) {
            __builtin_amdgcn_fence(__ATOMIC_RELEASE, "agent");
            asm volatile("s_waitcnt vmcnt(0)" ::: "memory");
            const unsigned og = xb_add(&bar[XB_TOP], 1u);
            const unsigned tg = og / nx;
            if (og + 1u == (tg + 1u) * nx) xb_add(&bar[XB_TOPGEN], 1u);
            else XB_SPIN(xb_ld(&bar[XB_TOPGEN]) == tg, bar);
            __builtin_amdgcn_fence(__ATOMIC_ACQUIRE, "agent");
            xb_add(&bar[XB_XGEN(b.x)], 1u);
            asm volatile("s_waitcnt vmcnt(0)" ::: "memory");
        } else {
            XB_SPIN(xb_ld(&bar[XB_XGEN(b.x)]) == gen, bar);
            __builtin_amdgcn_fence(__ATOMIC_ACQUIRE, "agent");
            asm volatile("s_waitcnt vmcnt(0)" ::: "memory");
        }
    }
    __syncthreads();
}

namespace pg8 {
constexpr int BM = 256, BK = 64, HALF = 128, HTB = HALF * BK * 2, STAGE_BYTES = 8 * HTB, NXCD = 8;
__host__ __device__ __forceinline__ int lds_byte(int r, int c) { const int st = (r >> 4) * 2 + (c >> 5), rr = r & 15, cc = c & 31, ob = rr * 64 + cc * 2; return st * 1024 + (ob ^ (((ob >> 9) & 1) << 5)); }
__host__ __device__ __forceinline__ void stage_rc(int b, int& R, int& C) { const int st = b / 1024, sb = b % 1024, swz = sb ^ (((sb >> 9) & 1) << 5); R = (st >> 1) * 16 + swz / 64; C = (st & 1) * 32 + (swz % 64) / 2; }
__host__ __device__ __forceinline__ int perm32(int rho) { const int n = rho >> 4, i = rho & 15; return 8 * (i >> 2) + 4 * n + (i & 3); }

struct Unit { int pm, pn, pb; };
struct Gemm { const void* A; const void* Bt; int K; int scW, scA; const int* rowtok; };

struct TileOrder {
    int nM, nN, nwg, G, c, WGM; const int* tile_e; int nb_per_e;
    __device__ void init(int nM_, int nN_, int G_, int c_, const int* te, int nbe, int wgm) { nM = nM_; nN = nN_; nwg = nM * nN; G = G_; c = c_; tile_e = te; nb_per_e = nbe; WGM = wgm; }
    __device__ bool next(int i, Unit& u) const {
        const long L = (long)i * G + c; if (L >= nwg) return false;
        int wgid = (int)L; { const int q = nwg / NXCD, r = nwg % NXCD, xcd = wgid % NXCD, off = wgid / NXCD; wgid = (xcd < r ? xcd * (q + 1) : r * (q + 1) + (xcd - r) * q) + off; }
        const int nig = WGM * nN, gid = wgid / nig, fm = gid * WGM, gsz = (nM - fm) < WGM ? (nM - fm) : WGM;
        u.pm = fm + ((wgid % nig) % gsz); u.pn = (wgid % nig) / gsz;
        u.pb = tile_e ? tile_e[u.pm] * nb_per_e + u.pn : u.pn;
        return true;
    }
};

struct EpiBf16 {
    static constexpr bool PERM = true;
    bf16_t* O; int ldc; bf16_t* VT;
    __device__ __forceinline__ void operator()(const f32x4 (&acc)[2][2][4][2], const Unit& u, int wr, int wc, int fr, int fq) const {
        const int row0 = u.pm * BM + wr * 64 + fr; const int col0 = u.pn * BM + wc * 32 + 8 * fq;
#pragma unroll
        for (int ai = 0; ai < 2; ++ai)
#pragma unroll
            for (int m = 0; m < 4; ++m) { const int t = row0 + ai * HALF + m * 16; bf16_t* rowp = O + (size_t)t * ldc + col0;
#pragma unroll
                for (int bj = 0; bj < 2; ++bj) { const f32x4 v0 = acc[ai][bj][m][0], v1 = acc[ai][bj][m][1];
                    u32x4 w; w.x = pk2(v0[0], v0[1]); w.y = pk2(v0[2], v0[3]); w.z = pk2(v1[0], v1[1]); w.w = pk2(v1[2], v1[3]);
                    const int col = col0 + bj * HALF;
                    if (col >= DV0) { const int dvf = col - DV0, hh = dvf >> 7, dv = dvf & 127, tp = t & (SEQ - 1), key = tp & 63;
                        bf16_t* vp = VT + (((((size_t)((t >> 12) * 4 + hh) * 64 + (tp >> 6)) * 4 + (dv >> 5)) * 4 + (key >> 4)) * 16 + (key & 15)) * 32 + (dv & 31);
                        if (col < NIN) *(u32x4*)vp = w; }
                    else *(u32x4*)(rowp + bj * HALF) = w; } }
    }
};
struct EpiResBf16 {
    static constexpr bool PERM = true;
    const float* base; bf16_t* out; int ldc;
    __device__ __forceinline__ void operator()(const f32x4 (&acc)[2][2][4][2], const Unit& u, int wr, int wc, int fr, int fq) const {
        const int col0 = u.pn * BM + wc * 32 + 8 * fq;
#pragma unroll
        for (int ai = 0; ai < 2; ++ai)
#pragma unroll
            for (int m = 0; m < 4; ++m) { const size_t off = (size_t)(u.pm * BM + ai * HALF + wr * 64 + m * 16 + fr) * ldc + col0;
#pragma unroll
                for (int bj = 0; bj < 2; ++bj) { const f32x4 b0 = *(const f32x4*)(base + off + bj * HALF), b1 = *(const f32x4*)(base + off + bj * HALF + 4);
                    const f32x4 v0 = b0 + acc[ai][bj][m][0], v1 = b1 + acc[ai][bj][m][1];
                    u32x4 w; w.x = pk2(v0[0], v0[1]); w.y = pk2(v0[2], v0[3]); w.z = pk2(v1[0], v1[1]); w.w = pk2(v1[2], v1[3]);
                    *(u32x4*)(out + off + bj * HALF) = w; } }
    }
};
struct EpiSwiglu {
    static constexpr bool PERM = true;
    unsigned char* O; const float* b1; const int* tile_e;
    __device__ __forceinline__ void operator()(const f32x4 (&acc)[2][2][4][2], const Unit& u, int wr, int wc, int fr, int fq) const {
        const int e = tile_e[u.pm]; const int row0 = u.pm * BM + wr * 64 + fr; const int hc0 = u.pn * 128 + wc * 32 + 8 * fq;
        const float* bg = b1 + (size_t)e * 2048 + hc0; const float* bl = bg + 1024;
        const f32x4 g0 = *(const f32x4*)bg, g1 = *(const f32x4*)(bg + 4), l0 = *(const f32x4*)bl, l1 = *(const f32x4*)(bl + 4);
#pragma unroll
        for (int ai = 0; ai < 2; ++ai)
#pragma unroll
            for (int m = 0; m < 4; ++m) { unsigned char* rowp = O + (size_t)(row0 + ai * HALF + m * 16) * 1024 + hc0;
                float o[8];
#pragma unroll
                for (int n = 0; n < 2; ++n) { const f32x4 gv = acc[ai][0][m][n] + (n ? g1 : g0), lv = acc[ai][1][m][n] + (n ? l1 : l0);
#pragma unroll
                    for (int i = 0; i < 4; ++i) { const float g = fminf(gv[i], 7.0f), l = fminf(fmaxf(lv[i], -7.0f), 7.0f);
                        const float sg = __builtin_amdgcn_rcpf(1.0f + __builtin_amdgcn_exp2f(-1.702f * LOG2E * g)); o[n * 4 + i] = g * sg * (l + 1.0f); } }
                u32x2 w; w.x = pk4_fp8(o[0] * F8_H_MUL, o[1] * F8_H_MUL, o[2] * F8_H_MUL, o[3] * F8_H_MUL); w.y = pk4_fp8(o[4] * F8_H_MUL, o[5] * F8_H_MUL, o[6] * F8_H_MUL, o[7] * F8_H_MUL);
                *(u32x2*)rowp = w; }
    }
};
struct EpiGateF8 {
    static constexpr bool PERM = true;
    unsigned char* O; const float* b2; const float* rowgate; const int* tile_e;
    __device__ __forceinline__ void operator()(const f32x4 (&acc)[2][2][4][2], const Unit& u, int wr, int wc, int fr, int fq) const {
        const int e = tile_e[u.pm]; const int row0 = u.pm * BM + wr * 64 + fr; const int col0 = u.pn * BM + wc * 32 + 8 * fq;
        f32x4 bv[2][2];
#pragma unroll
        for (int bj = 0; bj < 2; ++bj)
#pragma unroll
            for (int n = 0; n < 2; ++n) bv[bj][n] = *(const f32x4*)(b2 + (size_t)e * 1024 + col0 + bj * HALF + 4 * n);
#pragma unroll
        for (int ai = 0; ai < 2; ++ai)
#pragma unroll
            for (int m = 0; m < 4; ++m) { const int row = row0 + ai * HALF + m * 16; const float gt = rowgate[row] * F8_Y_MUL; unsigned char* rowp = O + (size_t)row * 1024 + col0;
#pragma unroll
                for (int bj = 0; bj < 2; ++bj) { const f32x4 v0 = (acc[ai][bj][m][0] + bv[bj][0]) * gt, v1 = (acc[ai][bj][m][1] + bv[bj][1]) * gt;
                    u32x2 w; w.x = pk4_fp8(v0[0], v0[1], v0[2], v0[3]); w.y = pk4_fp8(v1[0], v1[1], v1[2], v1[3]);
                    *(u32x2*)(rowp + bj * HALF) = w; } }
    }
};

template <bool F8, bool GATHER, class Epi, class Sched>
__device__ __forceinline__ void gemm_phase(LAS unsigned char* lds, const Gemm g, const Sched& S, const Epi& E) {
    const int tid = threadIdx.x, wid = __builtin_amdgcn_readfirstlane(tid >> 6), lane = tid & 63, wr = wid >> 2, wc = wid & 3, fr = lane & 15, fq = lane >> 4;
    const int RB = F8 ? g.K : g.K * 2, nt = RB / 128;
    unsigned voffB[2];
#pragma unroll
    for (int i = 0; i < 2; ++i) { int R, C; stage_rc(tid * 16 + i * 8192, R, C); const int Rb = Epi::PERM ? ((R & ~31) + perm32(R & 31)) : R;
        voffB[i] = (unsigned)(Rb * RB + C * 2); }
#define PG8_AOFFS(dst, pm_) do { _Pragma("unroll") for (int h_ = 0; h_ < 2; ++h_) _Pragma("unroll") for (int i_ = 0; i_ < 2; ++i_) { int R_, C_; stage_rc(tid * 16 + i_ * 8192, R_, C_); \
        const int row_ = (pm_) * BM + h_ * HALF + R_; const unsigned grow_ = GATHER ? (unsigned)g.rowtok[row_] : (unsigned)row_; dst[h_][i_] = grow_ * (unsigned)RB + (unsigned)(C_ * 2); } } while (0)
    unsigned cvA[2][2], nvA[2][2];
    const size_t kstep = (size_t)(BK * 2);
    const size_t hstep = (size_t)HALF * RB;
    const size_t tstep = 2 * hstep;
    const unsigned ldsw = (unsigned)wid * 1024u;
    const int aoff = F8 ? lds_byte(wr * 64 + fr, (fq & 1) * 16) + (fq >> 1) * 1024 : lds_byte(wr * 64 + fr, fq * 8);
    const int boff = F8 ? lds_byte(wc * 32 + fr, (fq & 1) * 16) + (fq >> 1) * 1024 : lds_byte(wc * 32 + fr, fq * 8);
    const int scW = g.scW, scA = g.scA;
#define PG8_SA(b, h) (((b) * 2 + (h)) * HTB)
#define PG8_SB(b, h) ((4 + (b) * 2 + (h)) * HTB)
#define PG8_STAGE(bufoff, gbase, voff) do { _Pragma("unroll") for (int _i = 0; _i < 2; ++_i) \
        __builtin_amdgcn_global_load_lds((const unsigned*)((const char*)(gbase) + (voff)[_i]), (LAS unsigned*)(lds + (bufoff) + ldsw + _i * 8192), 16, 0, 0); } while (0)
typedef int v8i32a __attribute__((ext_vector_type(8), aligned(16)));
#define PG8_LD32(p) (*(const LAS v8i32a*)(p))
#define PG8_STAGE_A(bufoff, kptr, offs) do { _Pragma("unroll") for (int _i = 0; _i < 2; ++_i) \
        __builtin_amdgcn_global_load_lds((const unsigned*)((const char*)(kptr) + (offs)[_i]), (LAS unsigned*)(lds + (bufoff) + ldsw + _i * 8192), 16, 0, 0); } while (0)
#define PG8_LDA(dst, b, h) do { _Pragma("unroll") for (int m = 0; m < 4; ++m) { if constexpr (F8) { dst[m].f8 = __builtin_bit_cast(v8i32, PG8_LD32(lds + PG8_SA(b, h) + aoff + m * 2048)); } \
        else { _Pragma("unroll") for (int k = 0; k < 2; ++k) dst[m].hv[k] = *(const LAS bf16x8*)(lds + PG8_SA(b, h) + aoff + m * 2048 + k * 1024); } } } while (0)
#define PG8_LDB(dst, b, h) do { _Pragma("unroll") for (int n = 0; n < 2; ++n) { if constexpr (F8) { dst[n].f8 = __builtin_bit_cast(v8i32, PG8_LD32(lds + PG8_SB(b, h) + boff + n * 2048)); } \
        else { _Pragma("unroll") for (int k = 0; k < 2; ++k) dst[n].hv[k] = *(const LAS bf16x8*)(lds + PG8_SB(b, h) + boff + n * 2048 + k * 1024); } } } while (0)
#define PG8_MMA(ai, bj, At, Bt) do { __builtin_amdgcn_s_setprio(1); _Pragma("unroll") for (int m = 0; m < 4; ++m) _Pragma("unroll") for (int n = 0; n < 2; ++n) { \
        if constexpr (F8) { asm volatile("v_mfma_scale_f32_16x16x128_f8f6f4 %0, %1, %2, %0, %3, %4 op_sel_hi:[0,0,0]" : "+v"(acc[ai][bj][m][n]) : "v"(Bt[n].f8), "v"(At[m].f8), "v"(scW), "v"(scA)); } \
        else { _Pragma("unroll") for (int k = 0; k < 2; ++k) acc[ai][bj][m][n] = __builtin_amdgcn_mfma_f32_16x16x32_bf16(Bt[n].hv[k], At[m].hv[k], acc[ai][bj][m][n], 0, 0, 0); } } \
        __builtin_amdgcn_s_setprio(0); } while (0)
#define PG8_WAIT_V(n) asm volatile("s_waitcnt vmcnt(" #n ")" ::: "memory")
#define PG8_WAIT_L(n) asm volatile("s_waitcnt lgkmcnt(" #n ")" ::: "memory")
#define PG8_BAR __builtin_amdgcn_s_barrier()
#define PG8_SCHED __builtin_amdgcn_sched_barrier(0)
    Unit cur, nxt; int ui = 0;
    if (!S.next(0, cur)) return;
    f32x4 acc[2][2][4][2];
#pragma unroll
    for (int a = 0; a < 2; ++a)
#pragma unroll
        for (int b = 0; b < 2; ++b)
#pragma unroll
            for (int m = 0; m < 4; ++m)
#pragma unroll
                for (int n = 0; n < 2; ++n) acc[a][b][m][n] = (f32x4){0.f, 0.f, 0.f, 0.f};
    struct FragH { bf16x8 hv[2]; }; struct Frag8 { v8i32 f8; };
    typename std::conditional<F8, Frag8, FragH>::type At[4], B0[2], B1[2];
    const char* const kA = (const char*)g.A; const char* cB = (const char*)g.Bt + (size_t)cur.pb * tstep;
    PG8_AOFFS(cvA, cur.pm);
    PG8_STAGE(PG8_SB(0, 0), cB, voffB); PG8_STAGE(PG8_SB(0, 1), cB + hstep, voffB); PG8_STAGE_A(PG8_SA(0, 0), kA, cvA[0]); PG8_STAGE_A(PG8_SA(0, 1), kA, cvA[1]);
    if (wr == 1) PG8_BAR;
    PG8_WAIT_V(2); PG8_BAR;
    PG8_STAGE(PG8_SB(1, 0), cB + kstep, voffB); PG8_STAGE_A(PG8_SA(1, 0), kA + kstep, cvA[0]); PG8_STAGE(PG8_SB(1, 1), cB + hstep + kstep, voffB);
    PG8_WAIT_V(6); PG8_BAR;
    for (;;) {
        const bool has_next = S.next(ui + 1, nxt);
        const char* nB = has_next ? (const char*)g.Bt + (size_t)nxt.pb * tstep : cB;
        if (has_next) { PG8_AOFFS(nvA, nxt.pm); } else { _Pragma("unroll") for (int h_ = 0; h_ < 2; ++h_) _Pragma("unroll") for (int i_ = 0; i_ < 2; ++i_) nvA[h_][i_] = cvA[h_][i_]; }
#pragma clang loop unroll(disable)
        for (int t = 0; t < nt; t += 2) {
            const bool last = (t == nt - 2);
            const char* a1 = kA + (size_t)(t + 1) * kstep;
            const char* a2 = last ? kA : kA + (size_t)(t + 2) * kstep; const char* b2 = last ? nB : cB + (size_t)(t + 2) * kstep;
            const char* a3 = a2 + kstep; const char* b3 = b2 + kstep;
            unsigned v2A[2][2];
#pragma unroll
            for (int h_ = 0; h_ < 2; ++h_)
#pragma unroll
                for (int i_ = 0; i_ < 2; ++i_) v2A[h_][i_] = last ? nvA[h_][i_] : cvA[h_][i_];
            PG8_LDB(B0, 0, 0); PG8_LDB(B1, 0, 1); PG8_SCHED; PG8_LDA(At, 0, 0); PG8_STAGE_A(PG8_SA(1, 1), a1, cvA[1]);
            PG8_WAIT_V(8); PG8_WAIT_L(0); PG8_BAR; PG8_MMA(0, 0, At, B0); PG8_MMA(0, 1, At, B1); PG8_BAR; PG8_SCHED;
            PG8_LDA(At, 0, 1); PG8_STAGE(PG8_SB(0, 0), b2, voffB); PG8_STAGE(PG8_SB(0, 1), b2 + hstep, voffB); PG8_STAGE_A(PG8_SA(0, 0), a2, v2A[0]);
            PG8_WAIT_V(8); PG8_WAIT_L(0); PG8_BAR; PG8_MMA(1, 0, At, B0); PG8_MMA(1, 1, At, B1); PG8_BAR; PG8_SCHED;
            PG8_LDB(B0, 1, 0); PG8_LDB(B1, 1, 1); PG8_SCHED; PG8_LDA(At, 1, 0); PG8_STAGE_A(PG8_SA(0, 1), a2, v2A[1]);
            PG8_WAIT_V(8); PG8_WAIT_L(0); PG8_BAR; PG8_MMA(0, 0, At, B0); PG8_MMA(0, 1, At, B1); PG8_BAR; PG8_SCHED;
            PG8_LDA(At, 1, 1); PG8_STAGE(PG8_SB(1, 0), b3, voffB); PG8_STAGE(PG8_SB(1, 1), b3 + hstep, voffB); PG8_STAGE_A(PG8_SA(1, 0), a3, v2A[0]);
            PG8_WAIT_V(8); PG8_WAIT_L(0); PG8_BAR; PG8_MMA(1, 0, At, B0); PG8_MMA(1, 1, At, B1); PG8_BAR; PG8_SCHED;
        }
        if (wr == 0) PG8_BAR;
        if constexpr (F8) asm volatile("s_nop 15\n\ts_nop 15" ::: "memory");
        E(acc, cur, wr, wc, fr, fq);
        if (!has_next) break;
#pragma unroll
        for (int a = 0; a < 2; ++a)
#pragma unroll
            for (int b = 0; b < 2; ++b)
#pragma unroll
                for (int m = 0; m < 4; ++m)
#pragma unroll
                    for (int n = 0; n < 2; ++n) acc[a][b][m][n] = (f32x4){0.f, 0.f, 0.f, 0.f};
        cur = nxt; cB = nB; ++ui;
#pragma unroll
        for (int h_ = 0; h_ < 2; ++h_)
#pragma unroll
            for (int i_ = 0; i_ < 2; ++i_) cvA[h_][i_] = nvA[h_][i_];
        if (wr == 1) PG8_BAR;
    }
    PG8_WAIT_V(0);
    PG8_BAR;
#undef PG8_SA
#undef PG8_SB
#undef PG8_STAGE
#undef PG8_STAGE_A
#undef PG8_AOFFS
#undef PG8_LDA
#undef PG8_LDB
#undef PG8_MMA
#undef PG8_LD32
#undef PG8_WAIT_V
#undef PG8_WAIT_L
#undef PG8_BAR
#undef PG8_SCHED
}
}

struct Args { const float* in[30]; float* out; unsigned char* ws; int ph_lo, ph_hi; };

__device__ __forceinline__ void p0_transpose_item(const float* W, int K, int N, bf16_t* WT, int k0, int n0, int drow0, LAS float* scr, int lane) {
#pragma unroll 8
    for (int i = 0; i < 32; ++i) { const int kk = 2 * i + (lane >> 5); scr[kk * 33 + (lane & 31)] = W[(size_t)(k0 + kk) * N + n0 + (lane & 31)]; }
    asm volatile("s_waitcnt lgkmcnt(0)" ::: "memory");
    const int c = lane & 7;
#pragma unroll
    for (int j = 0; j < 4; ++j) { const int n = (lane >> 3) + 8 * j; const LAS float* s = scr + (8 * c) * 33 + n;
        u32x4 o; o.x = pk2(s[0 * 33], s[1 * 33]); o.y = pk2(s[2 * 33], s[3 * 33]); o.z = pk2(s[4 * 33], s[5 * 33]); o.w = pk2(s[6 * 33], s[7 * 33]);
        *(u32x4*)(WT + (size_t)(drow0 + n) * K + k0 + 8 * c) = o; }
    asm volatile("s_waitcnt lgkmcnt(0)" ::: "memory");
}
__device__ __forceinline__ void p0_transpose_item_f8(const float* W, int K, int N, unsigned char* WT, int k0, int n0, int drow0, LAS float* scr, int lane) {
#pragma unroll 8
    for (int i = 0; i < 32; ++i) { const int kk = 2 * i + (lane >> 5); scr[kk * 33 + (lane & 31)] = W[(size_t)(k0 + kk) * N + n0 + (lane & 31)]; }
    asm volatile("s_waitcnt lgkmcnt(0)" ::: "memory");
    const int c = lane & 3;
#pragma unroll
    for (int j = 0; j < 2; ++j) { const int n = (lane >> 2) + 16 * j; const LAS float* s = scr + (16 * c) * 33 + n;
        u32x4 o;
        o.x = pk4_fp8(s[0 * 33] * F8_W_MUL, s[1 * 33] * F8_W_MUL, s[2 * 33] * F8_W_MUL, s[3 * 33] * F8_W_MUL);
        o.y = pk4_fp8(s[4 * 33] * F8_W_MUL, s[5 * 33] * F8_W_MUL, s[6 * 33] * F8_W_MUL, s[7 * 33] * F8_W_MUL);
        o.z = pk4_fp8(s[8 * 33] * F8_W_MUL, s[9 * 33] * F8_W_MUL, s[10 * 33] * F8_W_MUL, s[11 * 33] * F8_W_MUL);
        o.w = pk4_fp8(s[12 * 33] * F8_W_MUL, s[13 * 33] * F8_W_MUL, s[14 * 33] * F8_W_MUL, s[15 * 33] * F8_W_MUL);
        *(u32x4*)(WT + (size_t)(drow0 + n) * K + k0 + 16 * c) = o; }
    asm volatile("s_waitcnt lgkmcnt(0)" ::: "memory");
}
__device__ __forceinline__ void p0_prologue(LAS unsigned char* lds, const Args& a, int G) {
    const int tid = threadIdx.x, lane = tid & 63, wave = __builtin_amdgcn_readfirstlane(tid >> 6);
    LAS float* scr = (LAS float*)(lds + wave * 16384);
    const int gw = blockIdx.x * 8 + wave, NGW = G * 8;
    unsigned char* ws = a.ws;
    bf16_t* Wint = (bf16_t*)(ws + WS_WINT); bf16_t* Woutt = (bf16_t*)(ws + WS_WOUT); unsigned char* W1t = ws + WS_W1T; unsigned char* W2t = ws + WS_W2T;
    constexpr int I_IN = 16 * (NIN / 32);
    constexpr int I_OUT = 16 * 32;
    constexpr int I_W1 = 16 * 64;
    constexpr int I_W2 = 16 * 32;
    constexpr int NITEMS = I_IN + I_OUT + NE * I_W1 + NE * I_W2;
    for (int it = gw; it < NITEMS; it += NGW) {
        int r = it;
        if (r < I_IN) { const int nblk = NIN / 32, kb = r / nblk, nb = r % nblk; p0_transpose_item(a.in[2], 1024, NIN, Wint, 64 * kb, 32 * nb, 32 * nb, scr, lane); continue; } r -= I_IN;
        if (r < I_OUT) { const int kb = r / 32, nb = r % 32; p0_transpose_item(a.in[22], 1024, 1024, Woutt, 64 * kb, 32 * nb, 32 * nb, scr, lane); continue; } r -= I_OUT;
        if (r < NE * I_W1) { const int e = r / I_W1, q = r % I_W1, kb = q / 64, nb = q % 64; const int n0 = 32 * nb;
            const int drow = (n0 < 1024) ? ((n0 >> 7) * 256 + (n0 & 127)) : (((n0 - 1024) >> 7) * 256 + 128 + ((n0 - 1024) & 127));
            p0_transpose_item_f8(a.in[26] + (size_t)e * 1024 * 2048, 1024, 2048, W1t + (size_t)e * 2048 * 1024, 64 * kb, n0, drow, scr, lane); continue; } r -= NE * I_W1;
        { const int e = r / I_W2, q = r % I_W2, kb = q / 32, nb = q % 32;
            p0_transpose_item_f8(a.in[28] + (size_t)e * 1024 * 1024, 1024, 1024, W2t + (size_t)e * 1024 * 1024, 64 * kb, 32 * nb, 32 * nb, scr, lane); }
    }
    const float* x = a.in[0]; const float* g1 = a.in[1]; bf16_t* XN = (bf16_t*)(ws + WS_XN);
    f32x4 gv[4];
#pragma unroll
    for (int j = 0; j < 4; ++j) gv[j] = *((const f32x4*)g1 + lane + 64 * j);
    for (int m = gw; m < T; m += NGW) {
        const f32x4* xr = (const f32x4*)(x + (size_t)m * D) + lane;
        f32x4 v[4]; float s = 0.f;
#pragma unroll
        for (int j = 0; j < 4; ++j) { v[j] = xr[64 * j]; s += (v[j].x * v[j].x + v[j].y * v[j].y) + (v[j].z * v[j].z + v[j].w * v[j].w); }
        const float rstd = 1.0f / sqrtf(wave_sum(s) * (1.0f / D) + 1e-5f);
        u32x2* o8 = (u32x2*)(XN + (size_t)m * D) + lane;
#pragma unroll
        for (int j = 0; j < 4; ++j) { u32x2 w; w.x = pk2(v[j].x * rstd * gv[j].x, v[j].y * rstd * gv[j].y); w.y = pk2(v[j].z * rstd * gv[j].z, v[j].w * rstd * gv[j].w); o8[64 * j] = w; }
    }
}

__device__ __forceinline__ f32x4 cvlo(const u32x4 u) { return (f32x4){bflo(u.x), bfhi(u.x), bflo(u.y), bfhi(u.y)}; }
__device__ __forceinline__ f32x4 cvhi(const u32x4 u) { return (f32x4){bflo(u.z), bfhi(u.z), bflo(u.w), bfhi(u.w)}; }
__device__ __forceinline__ u32x4 pk8(const f32x4 lo, const f32x4 hi) { u32x4 w; w.x = pk2(lo.x, lo.y); w.y = pk2(lo.z, lo.w); w.z = pk2(hi.x, hi.y); w.w = pk2(hi.z, hi.w); return w; }
__device__ __forceinline__ void p2_prep(LAS unsigned char* lds, const Args& a) {
    const int tid = threadIdx.x, lane = tid & 63, wave = __builtin_amdgcn_readfirstlane(tid >> 6);
    unsigned char* ws = a.ws;
    const bf16_t* P = (const bf16_t*)(ws + WS_P);
    bf16_t* SR = (bf16_t*)(ws + WS_SR); bf16_t* SK = (bf16_t*)(ws + WS_SK); bf16_t* SV = (bf16_t*)(ws + WS_SV); bf16_t* SA = (bf16_t*)(ws + WS_SA); bf16_t* SB = (bf16_t*)(ws + WS_SB);
    float* SW = (float*)(ws + WS_SW); bf16_t* SG = (bf16_t*)(ws + WS_SG); bf16_t* QN = (bf16_t*)(ws + WS_QN); bf16_t* KN = (bf16_t*)(ws + WS_KN);
    const float* mu = a.in[3]; const float* w0 = a.in[4]; const float* w2 = a.in[5]; const float* a0 = a.in[6]; const float* a2 = a.in[7]; const float* g2 = a.in[8];
    const float* k_k = a.in[9]; const float* k_a = a.in[10]; const float* qn_g = a.in[14]; const float* kn_g = a.in[15];
    LAS unsigned char* ACT = lds;
    LAS float* DEC = (LAS float*)(lds + 8192); LAS float* ALR = (LAS float*)(lds + 40960); LAS float* GG = (LAS float*)(lds + 73728);
    bf16x8 bw[4][5];
    const int fcol = lane & 15, fk = (lane >> 4) * 8;
#pragma unroll
    for (int cb = 0; cb < 4; ++cb) {
        const int col = wave * 64 + cb * 16 + fcol;
#pragma unroll
        for (int kb = 0; kb < 5; ++kb) {
            const float* src = (kb == 0) ? (w2 + (size_t)fk * CW + col) : (kb == 1) ? (a2 + (size_t)fk * CW + col) : (g2 + (size_t)((kb - 2) * 32 + fk) * CW + col);
            u32x4 w; w.x = pk2(src[0], src[CW]); w.y = pk2(src[2 * CW], src[3 * CW]); w.z = pk2(src[4 * CW], src[5 * CW]); w.w = pk2(src[6 * CW], src[7 * CW]);
            bw[cb][kb] = __builtin_bit_cast(bf16x8, w);
        }
    }
    float w0c[4], a0c[4];
#pragma unroll
    for (int cb = 0; cb < 4; ++cb) { w0c[cb] = w0[wave * 64 + cb * 16 + fcol]; a0c[cb] = a0[wave * 64 + cb * 16 + fcol]; }
    const int c8 = lane * 8;
    const int TPB = T / (int)gridDim.x;
    const int tb0 = blockIdx.x * TPB;
    for (int t0 = tb0; t0 < tb0 + TPB; t0 += 16) {
        if (tid < 320) {
            const int tok = tid / 20, ch = tid - tok * 20, t = t0 + tok, col = 1536 + ch * 8;
            const u32x4 cu = *(const u32x4*)(P + (size_t)t * NINP + col);
            u32x4 pu = (u32x4){0u, 0u, 0u, 0u};
            if (t & (SEQ - 1)) pu = *(const u32x4*)(P + (size_t)(t - 1) * NINP + col);
            const f32x4 m0 = *(const f32x4*)(mu + col), m1 = *(const f32x4*)(mu + col + 4);
            const f32x4 c0 = cvlo(cu), c1 = cvhi(cu), p0 = cvlo(pu), p1 = cvhi(pu);
            f32x4 s0 = c0 + (p0 - c0) * m0, s1 = c1 + (p1 - c1) * m1;
            if (ch < 4) {
#pragma unroll
                for (int i = 0; i < 4; ++i) { const float e0 = __expf(-2.0f * fabsf(s0[i])), e1 = __expf(-2.0f * fabsf(s1[i])); const float th0 = (1.0f - e0) / (1.0f + e0), th1 = (1.0f - e1) / (1.0f + e1);
                    s0[i] = s0[i] < 0.f ? -th0 : th0; s1[i] = s1[i] < 0.f ? -th1 : th1; }
            } else if (ch >= 8) {
#pragma unroll
                for (int i = 0; i < 4; ++i) { s0[i] = sigmoidf_(s0[i]); s1[i] = sigmoidf_(s1[i]); }
            }
            *(LAS u32x4*)(ACT + tok * 320 + ch * 16) = pk8(s0, s1);
        }
        __syncthreads();
        {
            bf16x8 af[5];
#pragma unroll
            for (int kb = 0; kb < 5; ++kb) af[kb] = *(const LAS bf16x8*)(ACT + fcol * 320 + kb * 64 + (lane >> 4) * 16);
#pragma unroll
            for (int cb = 0; cb < 4; ++cb) {
                const f32x4 z = {0.f, 0.f, 0.f, 0.f};
                const f32x4 aw = __builtin_amdgcn_mfma_f32_16x16x32_bf16(af[0], bw[cb][0], z, 0, 0, 0);
                const f32x4 aa = __builtin_amdgcn_mfma_f32_16x16x32_bf16(af[1], bw[cb][1], z, 0, 0, 0);
                f32x4 ag = __builtin_amdgcn_mfma_f32_16x16x32_bf16(af[2], bw[cb][2], z, 0, 0, 0);
                ag = __builtin_amdgcn_mfma_f32_16x16x32_bf16(af[3], bw[cb][3], ag, 0, 0, 0);
                ag = __builtin_amdgcn_mfma_f32_16x16x32_bf16(af[4], bw[cb][4], ag, 0, 0, 0);
                const int col = wave * 64 + cb * 16 + fcol;
#pragma unroll
                for (int i = 0; i < 4; ++i) { const int row = (lane >> 4) * 4 + i;
                    DEC[row * 512 + col] = __expf(-0.6065306597126334f * sigmoidf_(aw[i] + w0c[cb]));
                    ALR[row * 512 + col] = sigmoidf_(aa[i] + a0c[cb]);
                    GG[row * 512 + col] = ag[i]; }
            }
        }
        __syncthreads();
#pragma unroll 1
        for (int q = 0; q < 2; ++q) {
            const int tok = 2 * wave + q, t = t0 + tok; const size_t o = (size_t)t * CW + c8;
            const bf16_t* pr = P + (size_t)t * NINP + c8;
            const bool first = (t & (SEQ - 1)) == 0;
            const u32x4 zz = (u32x4){0u, 0u, 0u, 0u};
            f32x4 rr0, rr1;
            { const u32x4 cu = *(const u32x4*)(pr), pu = first ? zz : *(const u32x4*)(pr - NINP);
              const f32x4 m0 = *(const f32x4*)(mu + c8), m1 = *(const f32x4*)(mu + c8 + 4);
              const f32x4 c0 = cvlo(cu), c1 = cvhi(cu), p0 = cvlo(pu), p1 = cvhi(pu);
              rr0 = c0 + (p0 - c0) * m0; rr1 = c1 + (p1 - c1) * m1; *(u32x4*)(SR + o) = pk8(rr0, rr1); }
            { const u32x4 cu = *(const u32x4*)(pr + 1024), pu = first ? zz : *(const u32x4*)(pr - NINP + 1024);
              const f32x4 m0 = *(const f32x4*)(mu + 1024 + c8), m1 = *(const f32x4*)(mu + 1024 + c8 + 4);
              const f32x4 c0 = cvlo(cu), c1 = cvhi(cu), p0 = cvlo(pu), p1 = cvhi(pu);
              *(u32x4*)(SV + o) = pk8(c0 + (p0 - c0) * m0, c1 + (p1 - c1) * m1); }
            { const u32x4 cu = *(const u32x4*)(pr + 512), pu = first ? zz : *(const u32x4*)(pr - NINP + 512);
              const f32x4 m0 = *(const f32x4*)(mu + 512 + c8), m1 = *(const f32x4*)(mu + 512 + c8 + 4);
              const f32x4 c0 = cvlo(cu), c1 = cvhi(cu), p0 = cvlo(pu), p1 = cvhi(pu);
              const f32x4 k0 = c0 + (p0 - c0) * m0, k1 = c1 + (p1 - c1) * m1;
              const f32x4 kk0 = k0 * *(const f32x4*)(k_k + c8), kk1 = k1 * *(const f32x4*)(k_k + c8 + 4);
              float ss = (kk0.x * kk0.x + kk0.y * kk0.y) + (kk0.z * kk0.z + kk0.w * kk0.w) + (kk1.x * kk1.x + kk1.y * kk1.y) + (kk1.z * kk1.z + kk1.w * kk1.w);
              ss = red8(ss);
              const float inv = 1.0f / sqrtf(fmaxf(ss, 1e-24f));
              const f32x4 kn0 = kk0 * inv, kn1 = kk1 * inv;
              const f32x4 al0 = *(const LAS f32x4*)(ALR + tok * 512 + c8), al1 = *(const LAS f32x4*)(ALR + tok * 512 + c8 + 4);
              const f32x4 k20 = k0 * (1.0f + (al0 - 1.0f) * *(const f32x4*)(k_a + c8)), k21 = k1 * (1.0f + (al1 - 1.0f) * *(const f32x4*)(k_a + c8 + 4));
              *(u32x4*)(SK + o) = pk8(k20, k21); *(u32x4*)(SA + o) = pk8(-kn0, -kn1); *(u32x4*)(SB + o) = pk8(kn0 * al0, kn1 * al1);
              const f32x4 q0 = rr0 * k20 * *(const f32x4*)(a.in[11] + c8), q1 = rr1 * k21 * *(const f32x4*)(a.in[11] + c8 + 4);
              const float rk = red8((q0.x + q0.y) + (q0.z + q0.w) + (q1.x + q1.y) + (q1.z + q1.w));
              if ((lane & 7) == 0) ((float*)(ws + WS_RK))[(size_t)t * 8 + (lane >> 3)] = rk; }
            { const f32x4 de0 = *(const LAS f32x4*)(DEC + tok * 512 + c8), de1 = *(const LAS f32x4*)(DEC + tok * 512 + c8 + 4);
              const f32x4 gg0 = *(const LAS f32x4*)(GG + tok * 512 + c8), gg1 = *(const LAS f32x4*)(GG + tok * 512 + c8 + 4);
              *(u32x4*)(SG + o) = pk8(gg0, gg1); *(f32x4*)(SW + o) = de0; *(f32x4*)(SW + o + 4) = de1; }
            { const u32x4 uq = *(const u32x4*)(pr + DQ0), ukd = *(const u32x4*)(pr + DK0);
              const f32x4 q0 = cvlo(uq), q1 = cvhi(uq), d0 = cvlo(ukd), d1 = cvhi(ukd);
              float qs = (q0.x * q0.x + q0.y * q0.y) + (q0.z * q0.z + q0.w * q0.w) + (q1.x * q1.x + q1.y * q1.y) + (q1.z * q1.z + q1.w * q1.w);
              float ks = (d0.x * d0.x + d0.y * d0.y) + (d0.z * d0.z + d0.w * d0.w) + (d1.x * d1.x + d1.y * d1.y) + (d1.z * d1.z + d1.w * d1.w);
              qs = red8(qs); ks = red8(ks);
              const float qi = (1.0f / sqrtf(qs * (1.0f / 64.0f) + 1e-5f)) * (0.125f * LOG2E), ki = 1.0f / sqrtf(ks * (1.0f / 64.0f) + 1e-5f);
              const f32x4 g0 = *(const f32x4*)(qn_g + (c8 & 63)), g1 = *(const f32x4*)(qn_g + (c8 & 63) + 4), h0 = *(const f32x4*)(kn_g + (c8 & 63)), h1 = *(const f32x4*)(kn_g + (c8 & 63) + 4);
              *(u32x4*)(QN + o) = pk8(q0 * qi * g0, q1 * qi * g1);
              const size_t ko = ((((size_t)((t >> 12) * 8 + (c8 >> 6)) * 64 + ((t & (SEQ - 1)) >> 6)) * 8 + ((c8 & 63) >> 3)) * 64 + (t & 63)) * 8;
              *(u32x4*)(KN + ko) = pk8(d0 * ki * h0, d1 * ki * h1); }
        }
        __syncthreads();
    }
}

namespace ck {
constexpr int PS = 136;
constexpr int O_BT = 0, O_KT = 8704, O_AP = 17408, O_RT = 26112;
constexpr int O_AT = 34816, O_BH = 43008, O_KH = 51200, O_VV = 59392, O_TN = 67584, O_A2 = 75776, O_V2 = 83968;
constexpr int O_L = 92160, LSTR = 68;
constexpr int O_TOT = 109568, O_GC = 111616;
__device__ __forceinline__ int crow(int r, int hi) { return (r & 3) + 8 * (r >> 2) + 4 * hi; }
__device__ __forceinline__ int voff(int row, int col) { return ((col >> 5) * 4 + (row >> 4)) * 1024 + (row & 15) * 64 + (col & 31) * 2; }
__device__ __forceinline__ s16x4 vtr(const LAS unsigned char* p) { return __builtin_bit_cast(s16x4, __builtin_amdgcn_ds_read_tr16_b64_v4i16((LAS s16x4*)p)); }
__device__ __forceinline__ bf16x8 fragP(const LAS unsigned char* M, int row, int k0, int hi) {
    const LAS unsigned char* p = M + row * PS + (k0 + 4 * hi) * 2; const s16x4 lo = *(const LAS s16x4*)p, h = *(const LAS s16x4*)(p + 16);
    return (bf16x8){lo[0], lo[1], lo[2], lo[3], h[0], h[1], h[2], h[3]}; }
__device__ __forceinline__ bf16x8 fragT(const LAS unsigned char* M, int k0, int colblk, int lane, int hi) {
    const LAS unsigned char* p = M + (colblk * 4 + (k0 >> 4)) * 1024 + ((lane >> 4) & 1) * 32 + (lane & 3) * 8 + (4 * hi + ((lane & 15) >> 2)) * 64;
    const s16x4 lo = vtr(p), h = vtr(p + 512); return (bf16x8){lo[0], lo[1], lo[2], lo[3], h[0], h[1], h[2], h[3]}; }
__device__ __forceinline__ bf16x8 packR(const f32x16& x, int s) {
    u32x4 w; w.x = pk2(x[8 * s], x[8 * s + 1]); w.y = pk2(x[8 * s + 2], x[8 * s + 3]); w.z = pk2(x[8 * s + 4], x[8 * s + 5]); w.w = pk2(x[8 * s + 6], x[8 * s + 7]); return __builtin_bit_cast(bf16x8, w); }
#define CK_MFMA(a, b, c) __builtin_amdgcn_mfma_f32_32x32x16_bf16(a, b, c, 0, 0, 0)
__device__ __forceinline__ f32x16 score(const LAS unsigned char* Am, const LAS unsigned char* Bm, int sblk, int tblk, int mode, int r32, int hi) {
    f32x16 x = f32x16{};
#pragma unroll
    for (int ks = 0; ks < 4; ++ks) x = CK_MFMA(fragP(Am, sblk * 32 + r32, 16 * ks, hi), fragP(Bm, tblk * 32 + r32, 16 * ks, hi), x);
    if (mode) {
        const int t = tblk * 32 + r32;
#pragma unroll
        for (int r = 0; r < 16; ++r) { const int s = sblk * 32 + crow(r, hi); if (mode == 1 ? !(s < t) : !(s <= t)) x[r] = 0.f; }
    }
    return x;
}
__device__ __forceinline__ void storeT_V(LAS unsigned char* M, const f32x16& x, int rb, int c, int hi) {
#pragma unroll
    for (int q = 0; q < 4; ++q) { u32x2 w; w.x = pk2(x[4 * q], x[4 * q + 1]); w.y = pk2(x[4 * q + 2], x[4 * q + 3]); *(LAS u32x2*)(M + voff(c, rb * 32 + 8 * q + 4 * hi)) = w; }
}
__device__ __forceinline__ void storeT_S(LAS unsigned char* M, const f32x16& x, int rb, int c, int hi) {
#pragma unroll
    for (int q = 0; q < 4; ++q) { u32x2 w; w.x = pk2(x[4 * q], x[4 * q + 1]); w.y = pk2(x[4 * q + 2], x[4 * q + 3]); *(LAS u32x2*)(M + c * PS + (rb * 32 + 8 * q + 4 * hi) * 2) = w; }
}

__device__ __forceinline__ void chunk_item(LAS unsigned char* lds, const Args& a, int item) {
    const int tid = threadIdx.x; int lane = tid & 63; const int wave = __builtin_amdgcn_readfirstlane(tid >> 6);
#define CK_FRESH() asm volatile("" : "+v"(lane)); r32 = lane & 31; hi = lane >> 5
    int r32, hi; CK_FRESH();
    unsigned char* ws = a.ws;
    const bf16_t* SR = (const bf16_t*)(ws + WS_SR); const bf16_t* SK = (const bf16_t*)(ws + WS_SK); const bf16_t* SV = (const bf16_t*)(ws + WS_SV);
    const bf16_t* SA = (const bf16_t*)(ws + WS_SA); const bf16_t* SB = (const bf16_t*)(ws + WS_SB); const float* SW = (const float*)(ws + WS_SW);
    bf16_t* CG = (bf16_t*)(ws + WS_CG) + (size_t)item * 4096; bf16_t* CH = (bf16_t*)(ws + WS_CH) + (size_t)item * 4096;
    bf16_t* CR2 = (bf16_t*)(ws + WS_CR2) + (size_t)item * 4096; bf16_t* CY0 = (bf16_t*)(ws + WS_CY0) + (size_t)item * 4096;
    const int bh = item >> 6, c = item & 63, b = bh >> 3, h = bh & 7, tokc = b * SEQ + c * 64, col0 = h * 64;
    LAS unsigned char* BT = lds + O_BT; LAS unsigned char* KT = lds + O_KT; LAS unsigned char* AP = lds + O_AP; LAS unsigned char* RT = lds + O_RT;
    LAS unsigned char* AT = lds + O_AT; LAS unsigned char* BH = lds + O_BH; LAS unsigned char* KH = lds + O_KH; LAS unsigned char* VV = lds + O_VV;
    LAS unsigned char* TN = lds + O_TN; LAS unsigned char* A2M = lds + O_A2; LAS unsigned char* V2M = lds + O_V2;
    LAS float* L = (LAS float*)(lds + O_L); LAS float* TOT = (LAS float*)(lds + O_TOT); LAS float* GC = (LAS float*)(lds + O_GC);
    {
        const int tl = tid >> 3, c8 = (tid & 7) * 8; const size_t o = (size_t)(tokc + tl) * CW + col0 + c8;
        const f32x4 w0 = *(const f32x4*)(SW + o), w1 = *(const f32x4*)(SW + o + 4);
        const u32x4 ua = *(const u32x4*)(SA + o), ub = *(const u32x4*)(SB + o), uk = *(const u32x4*)(SK + o), ur = *(const u32x4*)(SR + o), uv = *(const u32x4*)(SV + o);
        float p[8] = {w0.x, w0.y, w0.z, w0.w, w1.x, w1.y, w1.z, w1.w}, wv[8];
#pragma unroll
        for (int j = 0; j < 8; ++j) wv[j] = p[j];
#pragma unroll
        for (int d = 8; d < 64; d <<= 1) {
#pragma unroll
            for (int j = 0; j < 8; ++j) { const float q = __shfl_up(p[j], d); if (lane >= d) p[j] *= q; }
        }
        if ((lane >> 3) == 7) { *(LAS f32x4*)(TOT + wave * 64 + c8) = (f32x4){p[0], p[1], p[2], p[3]}; *(LAS f32x4*)(TOT + wave * 64 + c8 + 4) = (f32x4){p[4], p[5], p[6], p[7]}; }
        __syncthreads();
        float pre[8], gC[8];
#pragma unroll
        for (int j = 0; j < 8; ++j) { pre[j] = 1.f; gC[j] = 1.f; }
#pragma unroll
        for (int w2 = 0; w2 < 8; ++w2) { const f32x4 t0 = *(const LAS f32x4*)(TOT + w2 * 64 + c8), t1 = *(const LAS f32x4*)(TOT + w2 * 64 + c8 + 4);
            const float tv[8] = {t0.x, t0.y, t0.z, t0.w, t1.x, t1.y, t1.z, t1.w};
#pragma unroll
            for (int j = 0; j < 8; ++j) { if (w2 < wave) pre[j] *= tv[j]; gC[j] *= tv[j]; } }
        if (tid < 8) { *(LAS f32x4*)(GC + c8) = (f32x4){gC[0], gC[1], gC[2], gC[3]}; *(LAS f32x4*)(GC + c8 + 4) = (f32x4){gC[4], gC[5], gC[6], gC[7]}; }
        const f32x4 a0 = cvlo(ua), a1 = cvhi(ua), b0 = cvlo(ub), b1 = cvhi(ub), k0 = cvlo(uk), k1 = cvhi(uk), r0 = cvlo(ur), r1 = cvhi(ur);
        const float av[8] = {a0.x, a0.y, a0.z, a0.w, a1.x, a1.y, a1.z, a1.w}, bv[8] = {b0.x, b0.y, b0.z, b0.w, b1.x, b1.y, b1.z, b1.w};
        const float kv[8] = {k0.x, k0.y, k0.z, k0.w, k1.x, k1.y, k1.z, k1.w}, rv[8] = {r0.x, r0.y, r0.z, r0.w, r1.x, r1.y, r1.z, r1.w};
        float at[8], rt[8], bt[8], kt[8], bh[8], kh[8];
#pragma unroll
        for (int j = 0; j < 8; ++j) { const float g = pre[j] * p[j], ig = __builtin_amdgcn_rcpf(g), gp = g * __builtin_amdgcn_rcpf(wv[j]);
            at[j] = av[j] * gp; rt[j] = rv[j] * g; bt[j] = bv[j] * ig; kt[j] = kv[j] * ig; bh[j] = bt[j] * gC[j]; kh[j] = kt[j] * gC[j]; }
#define CK_PK8(v) ((u32x4){pk2(v[0], v[1]), pk2(v[2], v[3]), pk2(v[4], v[5]), pk2(v[6], v[7])})
#define CK_ST_P(M, val_) do { LAS unsigned char* d_ = (M) + tl * PS + c8 * 2; const u32x4 q_ = (val_); *(LAS u32x2*)d_ = (u32x2){q_[0], q_[1]}; *(LAS u32x2*)(d_ + 8) = (u32x2){q_[2], q_[3]}; } while (0)
        const u32x4 wa = CK_PK8(at), wr = CK_PK8(rt), wb = CK_PK8(bt), wk = CK_PK8(kt), wbh = CK_PK8(bh), wkh = CK_PK8(kh);
        CK_ST_P(AP, wa); CK_ST_P(RT, wr); CK_ST_P(BT, wb); CK_ST_P(KT, wk);
        *(LAS u32x4*)(AT + voff(tl, c8)) = wa; *(LAS u32x4*)(BH + voff(tl, c8)) = wbh; *(LAS u32x4*)(KH + voff(tl, c8)) = wkh; *(LAS u32x4*)(VV + voff(tl, c8)) = uv;
#undef CK_PK8
#undef CK_ST_P
    }
    __syncthreads();
    CK_FRESH();
    f32x16 pa = f32x16{}, pb = f32x16{}, pc = f32x16{}, pd = f32x16{};
#define w1a pa
#define w1b pb
#define xb0 pa
#define xb1 pb
#define y0a pc
#define y0b pd
    if (wave < 2) {
        for (int k = 0; k < (wave == 0 ? 2 : 1); ++k) {
            const int sblk = wave == 0 ? k : 0, tblk = wave == 0 ? k : 1;
            const f32x16 x = score(BT, AP, sblk, tblk, wave == 0 ? 1 : 0, r32, hi);
            const int t = tblk * 32 + r32;
#pragma unroll
            for (int r = 0; r < 16; ++r) L[(sblk * 32 + crow(r, hi)) * LSTR + t] = x[r];
        }
    }
    __syncthreads();
    CK_FRESH();
    if (wave == 6) {
        float x[32];
#pragma unroll
        for (int t = 0; t < 32; ++t) x[t] = (r32 == t) ? 1.f : 0.f;
        const LAS float* Nr = L + (32 * hi) * LSTR + 32 * hi;
#pragma unroll
        for (int sidx = 0; sidx < 31; ++sidx) {
#pragma unroll
            for (int g4 = (sidx + 1) / 4; g4 < 8; ++g4) {
                const f32x4 nv = *(const LAS f32x4*)(Nr + sidx * LSTR + 4 * g4);
                if (4 * g4 + 0 > sidx) x[4 * g4 + 0] += nv.x * x[sidx];
                if (4 * g4 + 1 > sidx) x[4 * g4 + 1] += nv.y * x[sidx];
                if (4 * g4 + 2 > sidx) x[4 * g4 + 2] += nv.z * x[sidx];
                if (4 * g4 + 3 > sidx) x[4 * g4 + 3] += nv.w * x[sidx];
            }
            if ((sidx & 3) == 3) __builtin_amdgcn_sched_barrier(0);
        }
        const int cc = 32 * hi + r32;
#pragma unroll
        for (int t0 = 0; t0 < 32; t0 += 8) { u32x4 w; w.x = pk2(x[t0], x[t0 + 1]); w.y = pk2(x[t0 + 2], x[t0 + 3]); w.z = pk2(x[t0 + 4], x[t0 + 5]); w.w = pk2(x[t0 + 6], x[t0 + 7]);
            *(LAS u32x4*)(TN + voff(cc, 32 * hi + t0)) = w; }
        f32x16 m = f32x16{};
#pragma unroll
        for (int s = 0; s < 2; ++s) {
            const LAS float* lp = L + (16 * s + 4 * hi) * LSTR + 32 + r32;
            u32x4 aw; aw.x = pk2(lp[0], lp[LSTR]); aw.y = pk2(lp[2 * LSTR], lp[3 * LSTR]); aw.z = pk2(lp[8 * LSTR], lp[9 * LSTR]); aw.w = pk2(lp[10 * LSTR], lp[11 * LSTR]);
            const s16x4 b0 = *(const LAS s16x4*)(TN + voff(r32, 16 * s + 4 * hi)), b1 = *(const LAS s16x4*)(TN + voff(r32, 16 * s + 8 + 4 * hi));
            m = CK_MFMA(__builtin_bit_cast(bf16x8, aw), ((bf16x8){b0[0], b0[1], b0[2], b0[3], b1[0], b1[1], b1[2], b1[3]}), m);
        }
        f32x16 t21 = f32x16{};
#pragma unroll
        for (int s = 0; s < 2; ++s) t21 = CK_MFMA(fragT(TN, 32 + 16 * s, 1, lane, hi), packR(m, s), t21);
        storeT_V(TN, t21, 1, r32, hi);
    } else if (wave < 4) {
        const int dvb = wave - 2;
        const f32x16 x00 = score(KT, AP, 0, 0, 1, r32, hi), x01 = score(KT, AP, 0, 1, 0, r32, hi), x11 = score(KT, AP, 1, 1, 1, r32, hi);
#pragma unroll
        for (int s = 0; s < 2; ++s) {
            const bf16x8 v0 = fragT(VV, 16 * s, dvb, lane, hi), v1 = fragT(VV, 32 + 16 * s, dvb, lane, hi);
            w1a = CK_MFMA(packR(x00, s), v0, w1a);
            w1b = CK_MFMA(packR(x01, s), v0, w1b);
            w1b = CK_MFMA(packR(x11, s), v1, w1b);
        }
    } else if (wave < 6) {
        const int tb = wave - 4;
        f32x16 xk0, xk1 = f32x16{};
        if (tb == 0) { xk0 = score(KT, RT, 0, 0, 2, r32, hi); xb0 = score(BT, RT, 0, 0, 2, r32, hi); }
        else { xk0 = score(KT, RT, 0, 1, 0, r32, hi); xk1 = score(KT, RT, 1, 1, 2, r32, hi); xb0 = score(BT, RT, 0, 1, 0, r32, hi); xb1 = score(BT, RT, 1, 1, 2, r32, hi); }
#pragma unroll
        for (int s = 0; s < 2; ++s) {
            y0a = CK_MFMA(fragT(VV, 16 * s, 0, lane, hi), packR(xk0, s), y0a);
            y0b = CK_MFMA(fragT(VV, 16 * s, 1, lane, hi), packR(xk0, s), y0b);
            if (tb == 1) { y0a = CK_MFMA(fragT(VV, 32 + 16 * s, 0, lane, hi), packR(xk1, s), y0a); y0b = CK_MFMA(fragT(VV, 32 + 16 * s, 1, lane, hi), packR(xk1, s), y0b); }
        }
    }
    __syncthreads();
    CK_FRESH();
    if (wave < 2) {
        const int cb = wave; f32x16 a0 = f32x16{}, a1 = f32x16{};
#pragma unroll
        for (int ks = 0; ks < 4; ++ks) {
            const bf16x8 af = fragT(AT, 16 * ks, cb, lane, hi);
            if (ks < 2) a0 = CK_MFMA(af, fragT(TN, 16 * ks, 0, lane, hi), a0);
            a1 = CK_MFMA(af, fragT(TN, 16 * ks, 1, lane, hi), a1);
        }
        storeT_V(A2M, a0, cb, r32, hi); storeT_V(A2M, a1, cb, 32 + r32, hi);
    } else if (wave < 4) {
        const int dvb = wave - 2; f32x16 v0 = f32x16{}, v1 = f32x16{};
#pragma unroll
        for (int s = 0; s < 2; ++s) {
            v0 = CK_MFMA(packR(w1a, s), fragT(TN, 16 * s, 0, lane, hi), v0);
            v1 = CK_MFMA(packR(w1a, s), fragT(TN, 16 * s, 1, lane, hi), v1);
            v1 = CK_MFMA(packR(w1b, s), fragT(TN, 32 + 16 * s, 1, lane, hi), v1);
        }
        storeT_V(V2M, v0, dvb, r32, hi); storeT_V(V2M, v1, dvb, 32 + r32, hi);
    }
    __syncthreads();
    CK_FRESH();
    if (wave >= 4 && wave < 6) {
        const int tb = wave - 4, t = tb * 32 + r32;
        f32x16 r0 = f32x16{}, r1 = f32x16{};
#pragma unroll
        for (int s = 0; s < 2; ++s) {
            const bf16x8 p0 = packR(xb0, s);
            r0 = CK_MFMA(fragT(A2M, 16 * s, 0, lane, hi), p0, r0); r1 = CK_MFMA(fragT(A2M, 16 * s, 1, lane, hi), p0, r1);
            y0a = CK_MFMA(fragT(V2M, 16 * s, 0, lane, hi), p0, y0a); y0b = CK_MFMA(fragT(V2M, 16 * s, 1, lane, hi), p0, y0b);
            if (tb == 1) { const bf16x8 p1 = packR(xb1, s);
                r0 = CK_MFMA(fragT(A2M, 32 + 16 * s, 0, lane, hi), p1, r0); r1 = CK_MFMA(fragT(A2M, 32 + 16 * s, 1, lane, hi), p1, r1);
                y0a = CK_MFMA(fragT(V2M, 32 + 16 * s, 0, lane, hi), p1, y0a); y0b = CK_MFMA(fragT(V2M, 32 + 16 * s, 1, lane, hi), p1, y0b); }
        }
#pragma unroll
        for (int q = 0; q < 4; ++q) {
            const u32x2 u0 = *(const LAS u32x2*)(RT + t * PS + (8 * q + 4 * hi) * 2), u1 = *(const LAS u32x2*)(RT + t * PS + (32 + 8 * q + 4 * hi) * 2);
            r0[4 * q] += bflo(u0.x); r0[4 * q + 1] += bfhi(u0.x); r0[4 * q + 2] += bflo(u0.y); r0[4 * q + 3] += bfhi(u0.y);
            r1[4 * q] += bflo(u1.x); r1[4 * q + 1] += bfhi(u1.x); r1[4 * q + 2] += bflo(u1.y); r1[4 * q + 3] += bfhi(u1.y);
        }
        storeT_S(BT, r0, 0, t, hi); storeT_S(BT, r1, 1, t, hi);
        storeT_S(KT, y0a, 0, t, hi); storeT_S(KT, y0b, 1, t, hi);
    } else if (wave < 2) {
        const int ib = wave, i = ib * 32 + r32; const float gci = GC[i];
        f32x16 g0 = f32x16{}, g1 = f32x16{};
#pragma unroll
        for (int ks = 0; ks < 4; ++ks) { const bf16x8 bf_ = fragT(BH, 16 * ks, ib, lane, hi);
            g0 = CK_MFMA(fragT(A2M, 16 * ks, 0, lane, hi), bf_, g0); g1 = CK_MFMA(fragT(A2M, 16 * ks, 1, lane, hi), bf_, g1); }
#pragma unroll
        for (int r = 0; r < 16; ++r) { if (crow(r, hi) == i) g0[r] += gci; if (32 + crow(r, hi) == i) g1[r] += gci; }
        storeT_S(AP, g0, 0, i, hi); storeT_S(AP, g1, 1, i, hi);
    } else {
        const int id = wave < 4 ? wave - 2 : wave - 4, ib = id >> 1, dvb = id & 1;
        f32x16 hh = f32x16{};
#pragma unroll
        for (int ks = 0; ks < 4; ++ks) {
            hh = CK_MFMA(fragT(BH, 16 * ks, ib, lane, hi), fragT(V2M, 16 * ks, dvb, lane, hi), hh);
            hh = CK_MFMA(fragT(KH, 16 * ks, ib, lane, hi), fragT(VV, 16 * ks, dvb, lane, hi), hh);
        }
        storeT_S((LAS unsigned char*)L, hh, ib, dvb * 32 + r32, hi);
    }
    __syncthreads();
    {
        const int row = tid >> 3, ch = tid & 7;
        const LAS unsigned char* s0 = BT + row * PS + ch * 16; const LAS unsigned char* s1 = KT + row * PS + ch * 16; const LAS unsigned char* s2 = AP + row * PS + ch * 16; const LAS unsigned char* s3 = (const LAS unsigned char*)L + row * PS + ch * 16;
        const u32x2 a0 = *(const LAS u32x2*)s0, a1 = *(const LAS u32x2*)(s0 + 8), b0 = *(const LAS u32x2*)s1, b1 = *(const LAS u32x2*)(s1 + 8);
        const u32x2 c0 = *(const LAS u32x2*)s2, c1 = *(const LAS u32x2*)(s2 + 8), d0 = *(const LAS u32x2*)s3, d1 = *(const LAS u32x2*)(s3 + 8);
        *(u32x4*)(CR2 + row * 64 + ch * 8) = (u32x4){a0.x, a0.y, a1.x, a1.y}; *(u32x4*)(CY0 + row * 64 + ch * 8) = (u32x4){b0.x, b0.y, b1.x, b1.y};
        *(u32x4*)(CG + row * 64 + ch * 8) = (u32x4){c0.x, c0.y, c1.x, c1.y}; *(u32x4*)(CH + row * 64 + ch * 8) = (u32x4){d0.x, d0.y, d1.x, d1.y};
    }
    asm volatile("s_waitcnt lgkmcnt(0)" ::: "memory"); __builtin_amdgcn_s_barrier();
#undef CK_FRESH
#undef w1a
#undef w1b
#undef xb0
#undef xb1
#undef y0a
#undef y0b
}
__device__ __forceinline__ void p2b_chunks(LAS unsigned char* lds, const Args& a) {
#pragma unroll 1
    for (int item = blockIdx.x; item < 4096; item += gridDim.x) chunk_item(lds, a, item);
}
}

namespace ck {
constexpr int SQ_MAT = 8704, SQ_BUF = 6 * SQ_MAT;
constexpr int SQ_OUT = 2 * SQ_BUF;
__device__ __forceinline__ bf16x8 lfrag(const LAS unsigned char* M, int row, int k0, int hi) { return fragP(M, row, k0, hi); }
__device__ __forceinline__ void linit(f32x16& x, const LAS unsigned char* M, int row, int cblk, int hi) {
#pragma unroll
    for (int q = 0; q < 4; ++q) { const u32x2 u = *(const LAS u32x2*)(M + row * PS + (cblk * 32 + 8 * q + 4 * hi) * 2); x[4 * q] = bflo(u.x); x[4 * q + 1] = bfhi(u.x); x[4 * q + 2] = bflo(u.y); x[4 * q + 3] = bfhi(u.y); }
}
__device__ __forceinline__ void seq_head(LAS unsigned char* lds, const Args& a, int bh) {
    const int tid = threadIdx.x, lane = tid & 63, r32 = lane & 31, hi = lane >> 5; const int wave = __builtin_amdgcn_readfirstlane(tid >> 6);
    unsigned char* ws = a.ws;
    const bf16_t* SV = (const bf16_t*)(ws + WS_SV); const bf16_t* SG = (const bf16_t*)(ws + WS_SG); const float* RK = (const float*)(ws + WS_RK); bf16_t* YMIX = (bf16_t*)(ws + WS_YMIX);
    const int b = bh >> 3, h = bh & 7, col0 = h * 64;
    const float* lng = a.in[12] + col0; const float* lnb = a.in[13] + col0;
#define SQ_LOAD(ch) do { const size_t item_ = (size_t)bh * 64 + (ch); LAS unsigned char* bb_ = lds + ((ch) & 1) * SQ_BUF; const size_t t0_ = (size_t)b * SEQ + (ch) * 64; \
        for (int p_ = tid - 128; p_ < 3072; p_ += 384) { const int m_ = p_ >> 9, q_ = p_ & 511, row_ = q_ >> 3, c8_ = (q_ & 7) * 8; u32x4 v_; \
            if (m_ == 0) v_ = *(const u32x4*)((const bf16_t*)(ws + WS_CG) + item_ * 4096 + row_ * 64 + c8_); \
            else if (m_ == 1) v_ = *(const u32x4*)((const bf16_t*)(ws + WS_CH) + item_ * 4096 + row_ * 64 + c8_); \
            else if (m_ == 2) v_ = *(const u32x4*)((const bf16_t*)(ws + WS_CR2) + item_ * 4096 + row_ * 64 + c8_); \
            else if (m_ == 3) v_ = *(const u32x4*)((const bf16_t*)(ws + WS_CY0) + item_ * 4096 + row_ * 64 + c8_); \
            else if (m_ == 4) v_ = *(const u32x4*)(SV + (t0_ + row_) * CW + col0 + c8_); \
            else v_ = *(const u32x4*)(SG + (t0_ + row_) * CW + col0 + c8_); \
            LAS unsigned char* d_ = bb_ + m_ * SQ_MAT + row_ * PS + c8_ * 2; *(LAS u32x2*)d_ = (u32x2){v_.x, v_.y}; *(LAS u32x2*)(d_ + 8) = (u32x2){v_.z, v_.w}; } } while (0)
#define SQ_STORE(ch) do { const LAS unsigned char* ob_ = lds + SQ_OUT + ((ch) & 1) * SQ_MAT; const size_t t0_ = (size_t)b * SEQ + (ch) * 64; \
        for (int p_ = tid - 128; p_ < 512; p_ += 384) { const int row_ = p_ >> 3, c8_ = (p_ & 7) * 8; const LAS unsigned char* s_ = ob_ + row_ * PS + c8_ * 2; \
            const u32x2 lo_ = *(const LAS u32x2*)s_, hi_ = *(const LAS u32x2*)(s_ + 8); *(u32x4*)(YMIX + (t0_ + row_) * D + col0 + c8_) = (u32x4){lo_.x, lo_.y, hi_.x, hi_.y}; } } while (0)
    if (wave >= 2) SQ_LOAD(0);
    __syncthreads();
    f32x16 X00 = f32x16{}, X01 = f32x16{}, X10 = f32x16{}, X11 = f32x16{};
#pragma unroll 1
    for (int c = 0; c < 64; ++c) {
        if (wave >= 2) {
            if (c + 1 < 64) SQ_LOAD(c + 1);
            if (c > 0) SQ_STORE(c - 1);
        } else {
            const int tb = wave;
            const LAS unsigned char* bb = lds + (c & 1) * SQ_BUF;
            const LAS unsigned char* MG = bb; const LAS unsigned char* MH = bb + SQ_MAT; const LAS unsigned char* MR = bb + 2 * SQ_MAT; const LAS unsigned char* MY = bb + 3 * SQ_MAT;
            const LAS unsigned char* MV = bb + 4 * SQ_MAT; const LAS unsigned char* MGT = bb + 5 * SQ_MAT;
            LAS unsigned char* OB = lds + SQ_OUT + (c & 1) * SQ_MAT;
            const int tl = tb * 32 + r32; const size_t t = (size_t)b * SEQ + c * 64 + tl;
            const float rk = RK[t * 8 + h];
            f32x16 y0, y1; linit(y0, MY, tl, 0, hi); linit(y1, MY, tl, 1, hi);
#pragma unroll
            for (int s = 0; s < 2; ++s) {
                const bf16x8 rf0 = lfrag(MR, tl, 16 * s, hi), rf1 = lfrag(MR, tl, 32 + 16 * s, hi);
                y0 = CK_MFMA(packR(X00, s), rf0, y0); y0 = CK_MFMA(packR(X10, s), rf1, y0);
                y1 = CK_MFMA(packR(X01, s), rf0, y1); y1 = CK_MFMA(packR(X11, s), rf1, y1);
            }
#pragma unroll
            for (int db = 0; db < 2; ++db) {
                f32x16 Na, Nb; linit(Na, MH, db * 32 + r32, 0, hi); linit(Nb, MH, db * 32 + r32, 1, hi);
#pragma unroll
                for (int s = 0; s < 2; ++s) {
                    const bf16x8 g00 = lfrag(MG, r32, 16 * s, hi), g01 = lfrag(MG, r32, 32 + 16 * s, hi), g10 = lfrag(MG, 32 + r32, 16 * s, hi), g11 = lfrag(MG, 32 + r32, 32 + 16 * s, hi);
                    const bf16x8 p0 = packR(db ? X01 : X00, s), p1 = packR(db ? X11 : X10, s);
                    Na = CK_MFMA(g00, p0, Na); Na = CK_MFMA(g01, p1, Na);
                    Nb = CK_MFMA(g10, p0, Nb); Nb = CK_MFMA(g11, p1, Nb);
                }
                if (db == 0) { X00 = Na; X10 = Nb; } else { X01 = Na; X11 = Nb; }
            }
            float sm = 0.f;
#pragma unroll
            for (int r = 0; r < 16; ++r) sm += y0[r] + y1[r];
            sm += __shfl_xor(sm, 32);
            const float mean = sm * (1.0f / 64.0f);
            float sq = 0.f;
#pragma unroll
            for (int r = 0; r < 16; ++r) { const float d0 = y0[r] - mean, d1 = y1[r] - mean; sq += d0 * d0 + d1 * d1; }
            sq += __shfl_xor(sq, 32);
            const float rs = 1.0f / sqrtf(sq * (1.0f / 64.0f) + 64e-5f);
#pragma unroll
            for (int db = 0; db < 2; ++db)
#pragma unroll
                for (int q = 0; q < 4; ++q) {
                    const int dv = db * 32 + 8 * q + 4 * hi;
                    const f32x4 lg = *(const f32x4*)(lng + dv), lb = *(const f32x4*)(lnb + dv);
                    const u32x2 uv = *(const LAS u32x2*)(MV + tl * PS + dv * 2), ug = *(const LAS u32x2*)(MGT + tl * PS + dv * 2);
                    const f32x4 vv = {bflo(uv.x), bfhi(uv.x), bflo(uv.y), bfhi(uv.y)}, gg = {bflo(ug.x), bfhi(ug.x), bflo(ug.y), bfhi(ug.y)};
                    f32x4 yy; if (db == 0) yy = (f32x4){y0[4 * q], y0[4 * q + 1], y0[4 * q + 2], y0[4 * q + 3]}; else yy = (f32x4){y1[4 * q], y1[4 * q + 1], y1[4 * q + 2], y1[4 * q + 3]};
                    const f32x4 o = ((yy - mean) * rs * lg + lb + rk * vv) * gg;
                    u32x2 w; w.x = pk2(o.x, o.y); w.y = pk2(o.z, o.w);
                    *(LAS u32x2*)(OB + tl * PS + dv * 2) = w;
                }
        }
        __syncthreads();
    }
    if (wave >= 2) SQ_STORE(63);
#undef SQ_LOAD
#undef SQ_STORE
}
}

__device__ __forceinline__ float red16(float v) {
    v += dpp_f<0xB1>(v); v += dpp_f<0x4E>(v); v += dpp_f<0x141>(v); v += dpp_f<0x140>(v);
    return v;
}
__device__ __forceinline__ void p3_scan(LAS unsigned char* lds, const Args& a) {
    const int tid = threadIdx.x, lane = tid & 63, wave = __builtin_amdgcn_readfirstlane(tid >> 6);
    unsigned char* ws = a.ws;
    const bf16_t* SR = (const bf16_t*)(ws + WS_SR); const bf16_t* SK = (const bf16_t*)(ws + WS_SK); const bf16_t* SV = (const bf16_t*)(ws + WS_SV);
    const bf16_t* SA = (const bf16_t*)(ws + WS_SA); const bf16_t* SB = (const bf16_t*)(ws + WS_SB); const float* SW = (const float*)(ws + WS_SW);
    float* YRAW = (float*)(ws + WS_YRAW);
    const int bh = blockIdx.x >> 1, half = blockIdx.x & 1;
    const int b = bh >> 3, h = bh & 7, tok0 = b * SEQ, col0 = h * 64, row0 = half * 32;
    constexpr int BUFB = 45056;
    LAS float* buf0 = (LAS float*)lds; LAS float* buf1 = (LAS float*)(lds + BUFB);
    LAS float* Y0 = (LAS float*)(lds + 2 * BUFB); LAS float* Y1 = Y0 + 1024;
    constexpr int NCH = SEQ / 32;
    if (wave >= 4) {
        const int lw = wave - 4, sl = lw * 8 + (lane >> 3), cg = lane & 7, c8 = cg * 8;
        f32x4 w0_, w1_; u32x4 uk, ua, ub, ur; u32x2 uv;
#define SC_ISSUE(ch) do { const size_t o_ = (size_t)(tok0 + (ch) * 32 + sl) * CW + col0; \
            w0_ = *(const f32x4*)(SW + o_ + c8); w1_ = *(const f32x4*)(SW + o_ + c8 + 4); uk = *(const u32x4*)(SK + o_ + c8); ua = *(const u32x4*)(SA + o_ + c8); ub = *(const u32x4*)(SB + o_ + c8); ur = *(const u32x4*)(SR + o_ + c8); \
            uv = *(const u32x2*)(SV + o_ + row0 + 4 * cg); } while (0)
#define SC_STORE(bufp) do { LAS float* d_ = (bufp) + sl * 64 + c8; *(LAS f32x4*)(d_) = w0_; *(LAS f32x4*)(d_ + 4) = w1_; \
            *(LAS f32x4*)(d_ + 2048) = cvlo(uk); *(LAS f32x4*)(d_ + 2052) = cvhi(uk); *(LAS f32x4*)(d_ + 4096) = cvlo(ua); *(LAS f32x4*)(d_ + 4100) = cvhi(ua); \
            *(LAS f32x4*)(d_ + 6144) = cvlo(ub); *(LAS f32x4*)(d_ + 6148) = cvhi(ub); *(LAS f32x4*)(d_ + 8192) = cvlo(ur); *(LAS f32x4*)(d_ + 8196) = cvhi(ur); \
            *(LAS f32x4*)((bufp) + 10240 + sl * 32 + 4 * cg) = (f32x4){bflo(uv.x), bfhi(uv.x), bflo(uv.y), bfhi(uv.y)}; } while (0)
#define SC_YOUT(ch, yp) do { *(f32x4*)(YRAW + (size_t)(tok0 + (ch) * 32 + sl) * CW + col0 + row0 + 4 * cg) = *(const LAS f32x4*)((yp) + sl * 32 + 4 * cg); } while (0)
        SC_ISSUE(0); SC_STORE(buf0);
        __syncthreads();
        for (int ch = 0; ch < NCH; ++ch) {
            LAS float* ob = (ch & 1) ? buf0 : buf1; const LAS float* oy = (ch & 1) ? Y0 : Y1;
            if (ch + 1 < NCH) SC_ISSUE(ch + 1);
            if (ch > 0) SC_YOUT(ch - 1, oy);
            if (ch + 1 < NCH) SC_STORE(ob);
            __syncthreads();
        }
        { const LAS float* oy = ((NCH - 1) & 1) ? Y1 : Y0; SC_YOUT(NCH - 1, oy); }
#undef SC_ISSUE
#undef SC_STORE
#undef SC_YOUT
    } else {
        const int g = lane & 7, rl = lane >> 3, row = wave * 8 + rl;
        f32x2 S0 = {0.f, 0.f}, S1 = S0, S2 = S0, S3 = S0;
        __syncthreads();
        for (int ch = 0; ch < NCH; ++ch) {
            const LAS float* cb = (ch & 1) ? buf1 : buf0; LAS float* yb = (ch & 1) ? Y1 : Y0;
            const LAS float* pa = cb + 4 * g; const LAS float* pv = cb + 10240 + row;
#define SC_LD(X, s_) const f32x4 w0##X = *(const LAS f32x4*)(pa + (s_) * 64), w1##X = *(const LAS f32x4*)(pa + (s_) * 64 + 32), k0##X = *(const LAS f32x4*)(pa + (s_) * 64 + 2048), k1##X = *(const LAS f32x4*)(pa + (s_) * 64 + 2080), \
                a0##X = *(const LAS f32x4*)(pa + (s_) * 64 + 4096), a1##X = *(const LAS f32x4*)(pa + (s_) * 64 + 4128), b0##X = *(const LAS f32x4*)(pa + (s_) * 64 + 6144), b1##X = *(const LAS f32x4*)(pa + (s_) * 64 + 6176), \
                r0##X = *(const LAS f32x4*)(pa + (s_) * 64 + 8192), r1##X = *(const LAS f32x4*)(pa + (s_) * 64 + 8224); const float v##X = pv[(s_) * 32]
#define LO(q) ((f32x2){(q).x, (q).y})
#define HI(q) ((f32x2){(q).z, (q).w})
#define SC_STEP(X, s_) do { f32x2 t = S0 * LO(a0##X); t = S1 * HI(a0##X) + t; t = S2 * LO(a1##X) + t; t = S3 * HI(a1##X) + t; float sa = t.x + t.y; \
                const f32x2 vv = {v##X, v##X}; \
                f32x2 p0 = S0 * LO(w0##X), p1 = S1 * HI(w0##X), p2 = S2 * LO(w1##X), p3 = S3 * HI(w1##X); \
                p0 = vv * LO(k0##X) + p0; p1 = vv * HI(k0##X) + p1; p2 = vv * LO(k1##X) + p2; p3 = vv * HI(k1##X) + p3; \
                sa = red8(sa); const f32x2 ss = {sa, sa}; \
                S0 = ss * LO(b0##X) + p0; S1 = ss * HI(b0##X) + p1; S2 = ss * LO(b1##X) + p2; S3 = ss * HI(b1##X) + p3; \
                f32x2 u = S0 * LO(r0##X); u = S1 * HI(r0##X) + u; u = S2 * LO(r1##X) + u; u = S3 * HI(r1##X) + u; float y = u.x + u.y; y = red8(y); \
                yb[(s_) * 32 + row] = y; } while (0)
#pragma unroll 1
            for (int s8 = 0; s8 < 32; s8 += 8) {
                SC_LD(0, s8 + 0); SC_LD(1, s8 + 1);
                SC_STEP(0, s8 + 0); SC_LD(2, s8 + 2);
                SC_STEP(1, s8 + 1); SC_LD(3, s8 + 3);
                SC_STEP(2, s8 + 2); SC_LD(4, s8 + 4);
                SC_STEP(3, s8 + 3); SC_LD(5, s8 + 5);
                SC_STEP(4, s8 + 4); SC_LD(6, s8 + 6);
                SC_STEP(5, s8 + 5); SC_LD(7, s8 + 7);
                SC_STEP(6, s8 + 6);
                SC_STEP(7, s8 + 7);
            }
#undef SC_LD
#undef LO
#undef HI
#undef SC_STEP
            __syncthreads();
        }
    }
}

__device__ __forceinline__ void p3_post(const Args& a, int G) {
    const int tid = threadIdx.x, lane = tid & 63, wave = __builtin_amdgcn_readfirstlane(tid >> 6);
    unsigned char* ws = a.ws;
    const bf16_t* SR = (const bf16_t*)(ws + WS_SR); const bf16_t* SK = (const bf16_t*)(ws + WS_SK); const bf16_t* SV = (const bf16_t*)(ws + WS_SV);
    const bf16_t* SG = (const bf16_t*)(ws + WS_SG); const float* YRAW = (const float*)(ws + WS_YRAW); bf16_t* YMIX = (bf16_t*)(ws + WS_YMIX);
    const int gw = blockIdx.x * 8 + wave, NGW = G * 8, c8 = lane * 8;
    const f32x4 lg0 = *(const f32x4*)(a.in[12] + c8), lg1 = *(const f32x4*)(a.in[12] + c8 + 4), lb0 = *(const f32x4*)(a.in[13] + c8), lb1 = *(const f32x4*)(a.in[13] + c8 + 4);
    const f32x4 rk0 = *(const f32x4*)(a.in[11] + c8), rk1 = *(const f32x4*)(a.in[11] + c8 + 4);
    for (int t = gw; t < T; t += NGW) {
        const size_t o = (size_t)t * CW + c8;
        const f32x4 y0 = *(const f32x4*)(YRAW + o), y1 = *(const f32x4*)(YRAW + o + 4);
        const u32x4 ur = *(const u32x4*)(SR + o), uk = *(const u32x4*)(SK + o), uv = *(const u32x4*)(SV + o), ug = *(const u32x4*)(SG + o);
        const float mean = red8((y0.x + y0.y) + (y0.z + y0.w) + (y1.x + y1.y) + (y1.z + y1.w)) * (1.0f / 64.0f);
        const f32x4 d0 = y0 - mean, d1 = y1 - mean;
        const float var = red8((d0.x * d0.x + d0.y * d0.y) + (d0.z * d0.z + d0.w * d0.w) + (d1.x * d1.x + d1.y * d1.y) + (d1.z * d1.z + d1.w * d1.w)) * (1.0f / 64.0f);
        const f32x4 r0 = cvlo(ur), r1 = cvhi(ur), k0 = cvlo(uk), k1 = cvhi(uk);
        const f32x4 p0 = r0 * k0 * rk0, p1 = r1 * k1 * rk1;
        const float rk = red8((p0.x + p0.y) + (p0.z + p0.w) + (p1.x + p1.y) + (p1.z + p1.w));
        const float rs = 1.0f / sqrtf(var + 64e-5f);
        const f32x4 o0 = (d0 * rs * lg0 + lb0 + rk * cvlo(uv)) * cvlo(ug), o1 = (d1 * rs * lg1 + lb1 + rk * cvhi(uv)) * cvhi(ug);
        *(u32x4*)(YMIX + (size_t)t * D + c8) = pk8(o0, o1);
    }
}

namespace att {
constexpr int SLOT = 32768, OFF_V = 16384;
constexpr int TBL_OFF = MISC_OFF + 1024;
constexpr int LW_OFF = MISC_OFF + 2048;
constexpr int CST_OFF = MISC_OFF + 3072;
__device__ __forceinline__ int crow(int r, int hi) { return (r & 3) + 8 * (r >> 2) + 4 * hi; }
__device__ __forceinline__ void glds16(const void* gsrc, unsigned lds_dst) { unsigned keep;
    asm volatile("s_mov_b32 %0, m0\n\ts_mov_b32 m0, %2\n\ts_nop 0\n\tglobal_load_lds_dwordx4 %1, off\n\ts_mov_b32 m0, %0" : "=&s"(keep) : "v"(gsrc), "s"(lds_dst) : "memory"); }
__device__ __forceinline__ s16x4 vtr(const LAS unsigned char* p) { return __builtin_bit_cast(s16x4, __builtin_amdgcn_ds_read_tr16_b64_v4i16((LAS s16x4*)p)); }

__device__ __forceinline__ void attn_unit(LAS unsigned char* lds, const Args& a, int b, int h, int qb, float negM, float lam) {
    const int tid = threadIdx.x, lane = tid & 63, r32 = lane & 31, hi = lane >> 5; const int wid = __builtin_amdgcn_readfirstlane(tid >> 6);
    const int c = wid >> 2, rg = wid & 3;
    unsigned char* ws = a.ws;
    const bf16_t* QN = (const bf16_t*)(ws + WS_QN); const bf16_t* KN = (const bf16_t*)(ws + WS_KN); const bf16_t* P = (const bf16_t*)(ws + WS_P); bf16_t* YMIX = (bf16_t*)(ws + WS_YMIX);
    const int q0 = qb * 128; const size_t rowbase = (size_t)b * SEQ;
    const int NT = 2 * qb + 2;
    LAS float* tbl = (LAS float*)(lds + TBL_OFF); LAS float* lw = (LAS float*)(lds + LW_OFF) + wid * 32;
    if (tid < 128) {
        const int n = tid; int bkt;
        if (n < 16) bkt = n; else { bkt = 16 + (int)(logf((float)n * (1.0f / 16.0f)) / 2.0794415416798357f * 16.0f); bkt = bkt > 31 ? 31 : bkt; }
        tbl[n] = (a.in[21][bkt * 4 + h] - a.in[21][31 * 4 + h]) * LOG2E;
    }
    const bf16_t* Qw = QN + (rowbase + q0 + rg * 32 + r32) * CW + h * 128 + c * 64;
    bf16x8 qr[4];
#pragma unroll
    for (int d0 = 0; d0 < 4; ++d0) qr[d0] = *(const bf16x8*)(Qw + d0 * 16 + hi * 8);
    const bf16_t* k0src = KN + ((((size_t)(b * 8 + h * 2) * 64) * 8 + wid) * 64 + lane) * 8;
    const bf16_t* k1src = k0src + (size_t)64 * 8 * 64 * 8;
    const int pv0 = 2 * wid, pv1 = 2 * wid + 1;
    const bf16_t* VTb = (const bf16_t*)(ws + WS_VT) + (size_t)(b * 4 + h) * 64 * 8192;
    const bf16_t* v0src = VTb + pv0 * 512 + lane * 8;
    const bf16_t* v1src = VTb + pv1 * 512 + lane * 8;
#define ATT_DMA(t, slot) do { const unsigned s_ = lds0 + (unsigned)(slot) * SLOT; \
        glds16(k0src + (size_t)(t) * 4096, (unsigned)__builtin_amdgcn_readfirstlane(s_ + wid * 1024)); \
        glds16(k1src + (size_t)(t) * 4096, (unsigned)__builtin_amdgcn_readfirstlane(s_ + 8192 + wid * 1024)); \
        glds16(v0src + (size_t)(t) * 8192, (unsigned)__builtin_amdgcn_readfirstlane(s_ + OFF_V + pv0 * 1024)); \
        glds16(v1src + (size_t)(t) * 8192, (unsigned)__builtin_amdgcn_readfirstlane(s_ + OFF_V + pv1 * 1024)); } while (0)
#define ATT_SBAR() __builtin_amdgcn_sched_barrier(0)
    const unsigned lds0 = (unsigned)(uintptr_t)lds;
    f32x16 o[4];
#pragma unroll
    for (int d0 = 0; d0 < 4; ++d0) o[d0] = f32x16{};
    float lsum = 0.f;
    const bool shift = negM < -60.0f;
    const int qmin = q0 + 32 * rg, qpos = qmin + r32;
    ATT_DMA(0, 0);
    asm volatile("s_waitcnt vmcnt(0)" ::: "memory");
    __syncthreads();
    for (int t = 0; t < NT; ++t) {
        if (t + 1 < NT) ATT_DMA(t + 1, (t + 1) & 1);
        const int kmin = 64 * t;
        if (kmin <= qmin + 31) {
            const LAS unsigned char* slot = lds + (t & 1) * SLOT;
            const LAS unsigned char* kb = slot + c * 8192 + hi * 1024 + r32 * 16;
            const LAS unsigned char* vb = slot + OFF_V + ((lane >> 4) & 1) * 32 + (lane & 3) * 8 + (4 * hi + ((lane & 15) >> 2)) * 64;
            bf16x8 kf[8];
#pragma unroll
            for (int d0 = 0; d0 < 4; ++d0) { kf[2 * d0] = *(const LAS bf16x8*)(kb + d0 * 2048); kf[2 * d0 + 1] = *(const LAS bf16x8*)(kb + d0 * 2048 + 512); }
            s16x4 va[16], vc[16];
#pragma unroll
            for (int i = 0; i < 8; ++i) { va[2 * i] = vtr(vb + (i >> 2) * 4096 + (i & 3) * 1024); va[2 * i + 1] = vtr(vb + (i >> 2) * 4096 + (i & 3) * 1024 + 512); }
            ATT_SBAR();
            f32x16 p0, p1;
            p0 = __builtin_amdgcn_mfma_f32_32x32x16_bf16(kf[0], qr[0], f32x16{}, 0, 0, 0); p1 = __builtin_amdgcn_mfma_f32_32x32x16_bf16(kf[1], qr[0], f32x16{}, 0, 0, 0);
#pragma unroll
            for (int d0 = 1; d0 < 4; ++d0) { p0 = __builtin_amdgcn_mfma_f32_32x32x16_bf16(kf[2 * d0], qr[d0], p0, 0, 0, 0); p1 = __builtin_amdgcn_mfma_f32_32x32x16_bf16(kf[2 * d0 + 1], qr[d0], p1, 0, 0, 0); }
            ATT_SBAR();
            if (qmin - (kmin + 63) < 113) {
#pragma unroll
                for (int r = 0; r < 16; ++r) {
                    const int d0_ = qpos - (kmin + crow(r, hi)); const int d1_ = d0_ - 32;
                    const float t0 = tbl[d0_ < 0 ? 0 : (d0_ > 127 ? 127 : d0_)], t1 = tbl[d1_ < 0 ? 0 : (d1_ > 127 ? 127 : d1_)];
                    p0[r] = d0_ < 0 ? -INFINITY : p0[r] + t0; p1[r] = d1_ < 0 ? -INFINITY : p1[r] + t1;
                }
            }
            if (shift) {
#pragma unroll
                for (int r = 0; r < 16; ++r) { p0[r] += negM; p1[r] += negM; }
            }
            float sacc = 0.f;
#pragma unroll
            for (int r = 0; r < 16; ++r) { p0[r] = __builtin_amdgcn_exp2f(p0[r]); p1[r] = __builtin_amdgcn_exp2f(p1[r]); sacc += p0[r] + p1[r]; }
            lsum += sacc;
            u32x4 pw[4];
#pragma unroll
            for (int i = 0; i < 4; ++i) { pw[0][i] = pk2(p0[2 * i], p0[2 * i + 1]); pw[1][i] = pk2(p0[8 + 2 * i], p0[8 + 2 * i + 1]); pw[2][i] = pk2(p1[2 * i], p1[2 * i + 1]); pw[3][i] = pk2(p1[8 + 2 * i], p1[8 + 2 * i + 1]); }
            ATT_SBAR();
#pragma unroll
            for (int i = 0; i < 8; ++i) { vc[2 * i] = vtr(vb + (2 + (i >> 2)) * 4096 + (i & 3) * 1024); vc[2 * i + 1] = vtr(vb + (2 + (i >> 2)) * 4096 + (i & 3) * 1024 + 512); }
#pragma unroll
            for (int i = 0; i < 8; ++i) {
                const bf16x8 vf = (bf16x8){va[2 * i][0], va[2 * i][1], va[2 * i][2], va[2 * i][3], va[2 * i + 1][0], va[2 * i + 1][1], va[2 * i + 1][2], va[2 * i + 1][3]};
                o[i >> 2] = __builtin_amdgcn_mfma_f32_32x32x16_bf16(__builtin_bit_cast(bf16x8, pw[i & 3]), vf, o[i >> 2], 0, 0, 0);
            }
#pragma unroll
            for (int i = 0; i < 8; ++i) {
                const bf16x8 vf = (bf16x8){vc[2 * i][0], vc[2 * i][1], vc[2 * i][2], vc[2 * i][3], vc[2 * i + 1][0], vc[2 * i + 1][1], vc[2 * i + 1][2], vc[2 * i + 1][3]};
                o[2 + (i >> 2)] = __builtin_amdgcn_mfma_f32_32x32x16_bf16(__builtin_bit_cast(bf16x8, pw[i & 3]), vf, o[2 + (i >> 2)], 0, 0, 0);
            }
        }
        asm volatile("s_waitcnt vmcnt(0)" ::: "memory");
        __syncthreads();
    }
#undef ATT_DMA
#undef ATT_SBAR
    lsum += __shfl_xor(lsum, 32);
    if (hi == 0) lw[r32] = 1.0f / lsum;
    asm volatile("s_waitcnt lgkmcnt(0)" ::: "memory");
    LAS float* stg = (LAS float*)(lds + wid * 16384);
#pragma unroll
    for (int r = 0; r < 16; ++r) { const int orow = crow(r, hi); const float il = lw[orow];
#pragma unroll
        for (int d0 = 0; d0 < 4; ++d0) stg[orow * 128 + d0 * 32 + r32] = o[d0][r] * il; }
    __syncthreads();
    {
        const int row = tid >> 2, part = tid & 3, rgp = row >> 5, rr = row & 31;
        const LAS float* s1 = (const LAS float*)(lds + rgp * 16384) + rr * 128 + part * 32;
        const LAS float* s2 = (const LAS float*)(lds + (4 + rgp) * 16384) + rr * 128 + part * 32;
        float dv[32]; float ss = 0.f;
#pragma unroll
        for (int i = 0; i < 8; ++i) { const f32x4 x1 = *(const LAS f32x4*)(s1 + 4 * i), x2 = *(const LAS f32x4*)(s2 + 4 * i);
#pragma unroll
            for (int j = 0; j < 4; ++j) { const float dd = x1[j] - lam * x2[j]; dv[4 * i + j] = dd; ss += dd * dd; } }
        ss = red4(ss);
        const float sc = (1.0f / sqrtf(ss * (1.0f / 128.0f) + 1e-5f)) * 0.8f;
        const float* sg = a.in[20] + part * 32;
        bf16_t* op = YMIX + (rowbase + q0 + row) * D + CW + h * 128 + part * 32;
#pragma unroll
        for (int i = 0; i < 4; ++i) { u32x4 w;
            w.x = pk2(dv[8 * i] * sc * sg[8 * i], dv[8 * i + 1] * sc * sg[8 * i + 1]); w.y = pk2(dv[8 * i + 2] * sc * sg[8 * i + 2], dv[8 * i + 3] * sc * sg[8 * i + 3]);
            w.z = pk2(dv[8 * i + 4] * sc * sg[8 * i + 4], dv[8 * i + 5] * sc * sg[8 * i + 5]); w.w = pk2(dv[8 * i + 6] * sc * sg[8 * i + 6], dv[8 * i + 7] * sc * sg[8 * i + 7]);
            *(u32x4*)(op + 8 * i) = w; }
    }
    __syncthreads();
}

__device__ __forceinline__ void attn_phase(LAS unsigned char* lds, const Args& a, unsigned* ctl) {
    const int tid = threadIdx.x;
    LAS float* cst = (LAS float*)(lds + CST_OFF);
    if (tid < 64) {
        const float gq = fabsf(a.in[14][tid]), gk = fabsf(a.in[15][tid]);
        float mq = gq, mk = gk;
#pragma unroll
        for (int o = 1; o < 64; o <<= 1) { mq = fmaxf(mq, __shfl_xor(mq, o)); mk = fmaxf(mk, __shfl_xor(mk, o)); }
        const float d1 = wave_sum(a.in[16][tid] * a.in[17][tid]), d2 = wave_sum(a.in[18][tid] * a.in[19][tid]);
        float mb = 0.f;
        if (tid < 32) { for (int hh = 0; hh < 4; ++hh) mb = fmaxf(mb, (a.in[21][tid * 4 + hh] - a.in[21][31 * 4 + hh]) * LOG2E); }
#pragma unroll
        for (int o = 1; o < 64; o <<= 1) mb = fmaxf(mb, __shfl_xor(mb, o));
        if (tid == 0) { cst[0] = -(8.0f * LOG2E * mq * mk * 1.02f + mb); cst[1] = __expf(d1) - __expf(d2) + 0.2f; }
    }
    __syncthreads();
    const float negM = cst[0], lam = cst[1];
    LAS int* ubox = (LAS int*)(lds + CST_OFF + 16);
    for (;;) {
        if (tid == 0) ubox[0] = (int)atomicAdd(ctl + CW_ATTQ, 1u);
        __syncthreads();
        const int u = ubox[0];
        __syncthreads();
        if (u >= 1024) break;
        const int qb = 31 - (u >> 5), bhh = u & 31;
        attn_unit(lds, a, bhh >> 2, bhh & 3, qb, negM, lam);
    }
}
}

__device__ __forceinline__ void p5_router(LAS unsigned char* lds, const Args& a, unsigned* ctl) {
    const int tid = threadIdx.x, lane = tid & 63, r32 = lane & 31, hi = lane >> 5; const int wave = __builtin_amdgcn_readfirstlane(tid >> 6);
    unsigned char* ws = a.ws;
    const bf16_t* x1 = (const bf16_t*)(ws + WS_X1B); const float* g2 = a.in[23]; const float* rw = a.in[24]; const float* rb = a.in[25];
    unsigned char* H2 = ws + WS_H2; int* EIDX = (int*)(ws + WS_EIDX); float* GATE = (float*)(ws + WS_GATE); int* POS = (int*)(ws + WS_POS);
    LAS unsigned char* WH = lds; LAS unsigned char* WL = lds + 65536;
    LAS int* cnt = (LAS int*)(lds + MISC_OFF + 1024);
    LAS int* basel = (LAS int*)(lds + MISC_OFF + 1024 + 128);
    LAS int* el = (LAS int*)(lds + MISC_OFF + 2048);
    LAS int* pl = (LAS int*)(lds + MISC_OFF + 4096);
    {
        const int e = tid & 31;
        for (int k = tid >> 5; k < 1024; k += 16) {
            const float v = rw[k * 32 + e] * g2[k]; const unsigned h = f2bf(v); const float vh = __builtin_bit_cast(float, h << 16); const unsigned l = f2bf(v - vh);
            const int off = e * 2048 + (((k >> 3) ^ (e & 15)) << 4) + (k & 7) * 2;
            *(LAS unsigned short*)(WH + off) = (unsigned short)h; *(LAS unsigned short*)(WL + off) = (unsigned short)l;
        }
    }
    if (tid < 32) cnt[tid] = 0;
    __syncthreads();
    const int TPB = T / (int)gridDim.x, tb0 = blockIdx.x * TPB;
    if (wave < 4) {
        const int tl = wave * 32 + r32, t = tb0 + tl;
        const bf16_t* xrow = x1 + (size_t)t * D + 8 * hi;
        const LAS unsigned char* wh = WH + r32 * 2048; const LAS unsigned char* wl = WL + r32 * 2048; const int sw = r32 & 15;
        f32x16 d = f32x16{}; float ssq = 0.f;
#pragma unroll 8
        for (int s = 0; s < 64; ++s) {
            const u32x4 xb = *(const u32x4*)(xrow + 16 * s);
            const int co = ((2 * s + hi) ^ sw) << 4;
            const bf16x8 ah = *(const LAS bf16x8*)(wh + co), al = *(const LAS bf16x8*)(wl + co);
            const bf16x8 bx = __builtin_bit_cast(bf16x8, xb);
            d = __builtin_amdgcn_mfma_f32_32x32x16_bf16(ah, bx, d, 0, 0, 0);
            d = __builtin_amdgcn_mfma_f32_32x32x16_bf16(al, bx, d, 0, 0, 0);
            const f32x4 x0 = cvlo(xb), x1v = cvhi(xb);
            ssq += (x0.x * x0.x + x0.y * x0.y) + (x0.z * x0.z + x0.w * x0.w) + (x1v.x * x1v.x + x1v.y * x1v.y) + (x1v.z * x1v.z + x1v.w * x1v.w);
        }
        ssq += __shfl_xor(ssq, 32);
        const float rstd = 1.0f / sqrtf(ssq * (1.0f / D) + 1e-5f);
        float lg[16];
#pragma unroll
        for (int r = 0; r < 16; ++r) lg[r] = d[r] * rstd + rb[8 * (r >> 2) + 4 * hi + (r & 3)];
        float tv[4]; int ti[4];
#pragma unroll
        for (int k = 0; k < 4; ++k) {
            float bv = -INFINITY; int bi = 0;
#pragma unroll
            for (int r = 0; r < 16; ++r) { const int e = 8 * (r >> 2) + 4 * hi + (r & 3); if (lg[r] > bv) { bv = lg[r]; bi = e; } }
            tv[k] = bv; ti[k] = bi;
#pragma unroll
            for (int r = 0; r < 16; ++r) { const int e = 8 * (r >> 2) + 4 * hi + (r & 3); if (e == bi) lg[r] = -INFINITY; }
        }
        float ov[4]; int oi[4];
#pragma unroll
        for (int k = 0; k < 4; ++k) { ov[k] = __shfl_xor(tv[k], 32); oi[k] = __shfl_xor(ti[k], 32); }
        float mv[4]; int mi[4];
        {
            int pa = 0, pb = 0;
#pragma unroll
            for (int k = 0; k < 4; ++k) {
                float ca = -INFINITY, cb = -INFINITY; int ia = 0, ib = 0;
#pragma unroll
                for (int q = 0; q < 4; ++q) { if (q == pa) { ca = tv[q]; ia = ti[q]; } if (q == pb) { cb = ov[q]; ib = oi[q]; } }
                const bool takeA = (ca > cb) || (ca == cb && ia < ib);
                mv[k] = takeA ? ca : cb; mi[k] = takeA ? ia : ib; pa += takeA ? 1 : 0; pb += takeA ? 0 : 1;
            }
        }
        const float e1 = __expf(mv[1] - mv[0]), e2 = __expf(mv[2] - mv[0]), e3 = __expf(mv[3] - mv[0]);
        const float inv = 1.0f / (1.0f + e1 + e2 + e3);
        if (hi == 0) {
            *(int4*)(EIDX + (size_t)t * 4) = make_int4(mi[0], mi[1], mi[2], mi[3]);
            *(float4*)(GATE + (size_t)t * 4) = make_float4(inv, e1 * inv, e2 * inv, e3 * inv);
#pragma unroll
            for (int k = 0; k < 4; ++k) { el[tl * 4 + k] = mi[k]; pl[tl * 4 + k] = atomicAdd((int*)(cnt + mi[k]), 1); }
        }
    } else {
        f32x4 gv[4];
#pragma unroll
        for (int j = 0; j < 4; ++j) gv[j] = *((const f32x4*)g2 + lane + 64 * j);
        for (int i = 0; i < 32; ++i) {
            const int t = tb0 + (wave - 4) * 32 + i;
            const u32x2* xr = (const u32x2*)(x1 + (size_t)t * D) + lane;
            f32x4 v[4]; float s = 0.f;
#pragma unroll
            for (int j = 0; j < 4; ++j) { const u32x2 xw = xr[64 * j]; v[j] = (f32x4){bflo(xw.x), bfhi(xw.x), bflo(xw.y), bfhi(xw.y)}; s += (v[j].x * v[j].x + v[j].y * v[j].y) + (v[j].z * v[j].z + v[j].w * v[j].w); }
            const float rstd = (1.0f / sqrtf(wave_sum(s) * (1.0f / D) + 1e-5f)) * F8_X_MUL;
            unsigned* o4 = (unsigned*)(H2 + (size_t)t * D) + lane;
#pragma unroll
            for (int j = 0; j < 4; ++j) { v[j] = v[j] * rstd * gv[j]; o4[64 * j] = pk4_fp8(v[j].x, v[j].y, v[j].z, v[j].w); }
        }
    }
    __syncthreads();
    if (tid < 32) basel[tid] = (int)atomicAdd(ctl + CW_CNT + tid, (unsigned)cnt[tid]);
    __syncthreads();
    for (int i = tid; i < TPB * 4; i += 512) POS[(size_t)tb0 * 4 + i] = pl[i] + basel[el[i]];
}

__device__ __forceinline__ void p6_dispatch(LAS unsigned char* lds, const Args& a, unsigned* ctl) {
    const int tid = threadIdx.x, lane = tid & 63, wave = __builtin_amdgcn_readfirstlane(tid >> 6);
    unsigned char* ws = a.ws;
    const int* EIDX = (const int*)(ws + WS_EIDX); const float* GATE = (const float*)(ws + WS_GATE); const int* POS = (const int*)(ws + WS_POS);
    int* DEST = (int*)(ws + WS_DEST); float* ROWGATE = (float*)(ws + WS_ROWGATE); int* TILEE = (int*)(ws + WS_TILEE); int* ROWTOK = (int*)(ws + WS_ROWTOK);
    LAS int* pstart = (LAS int*)(lds + MISC_OFF + 1024); LAS int* pcnt = pstart + 32;
    if (tid == 0) {
        int acc = 0;
        for (int e = 0; e < NE; ++e) { const int cn = (int)__hip_atomic_load(ctl + CW_CNT + e, __ATOMIC_RELAXED, __HIP_MEMORY_SCOPE_AGENT); pstart[e] = acc; pcnt[e] = cn;
            const int nt = (cn + 255) >> 8;
            if (blockIdx.x == 0) for (int i = 0; i < nt; ++i) TILEE[(acc >> 8) + i] = e;
            acc += nt * 256; }
        if (blockIdx.x == 0) TILEE[1023] = acc >> 8;
    }
    __syncthreads();
    if (blockIdx.x < NE) {
        const int e = blockIdx.x, cn = pcnt[e], pe = ((cn + 255) >> 8) * 256;
        for (int i = cn + tid; i < pe; i += 512) ROWTOK[pstart[e] + i] = 0;
    }
    const int TPB = T / (int)gridDim.x, tb0 = blockIdx.x * TPB;
    for (int pi = tb0 * 4 + tid; pi < (tb0 + TPB) * 4; pi += 512) {
        const int e = EIDX[pi], dest = pstart[e] + POS[pi];
        DEST[pi] = dest; ROWGATE[dest] = GATE[pi]; ROWTOK[dest] = pi >> 2;
    }
}

__device__ __forceinline__ void p9_combine(const Args& a, int G) {
    const int tid = threadIdx.x, lane = tid & 63, wave = __builtin_amdgcn_readfirstlane(tid >> 6);
    unsigned char* ws = a.ws;
    const unsigned char* YS = ws + WS_YS; const int* DEST = (const int*)(ws + WS_DEST);
    float* out = a.out;
    const int gw = blockIdx.x * 8 + wave, NGW = G * 8;
    for (int t = gw; t < T; t += NGW) {
        f32x4* xr = (f32x4*)(out + (size_t)t * D) + lane; const u32x2* xi = (const u32x2*)((const bf16_t*)(ws + WS_X1B) + (size_t)t * D) + lane;
        f32x4 v[4];
#pragma unroll
        for (int j = 0; j < 4; ++j) { const u32x2 xw = xi[64 * j]; v[j] = (f32x4){bflo(xw.x), bfhi(xw.x), bflo(xw.y), bfhi(xw.y)}; }
#pragma unroll
        for (int k = 0; k < 4; ++k) {
            const int dest = DEST[t * 4 + k];
            const unsigned* yr = (const unsigned*)(YS + (size_t)dest * D) + lane;
#pragma unroll
            for (int j = 0; j < 4; ++j) { const unsigned w = yr[64 * j];
                const f32x2 lo = __builtin_amdgcn_cvt_pk_f32_fp8((int)w, false), hi2 = __builtin_amdgcn_cvt_pk_f32_fp8((int)w, true);
                v[j].x += lo.x * (1.0f / F8_Y_MUL); v[j].y += lo.y * (1.0f / F8_Y_MUL); v[j].z += hi2.x * (1.0f / F8_Y_MUL); v[j].w += hi2.y * (1.0f / F8_Y_MUL); }
        }
        if (TIME_REGION >= 0) { const float sc_ = 1.0f + 4e-6f * (float)((const unsigned*)(ws + WS_CTL))[301];
#pragma unroll
            for (int j = 0; j < 4; ++j) v[j] = v[j] * sc_; }
#pragma unroll
        for (int j = 0; j < 4; ++j) xr[64 * j] = v[j];
    }
}

constexpr int NPHASE = 10;
__global__ void __launch_bounds__(512, 2) hymba_fwd(Args args) {
    extern __shared__ __attribute__((aligned(16))) unsigned char lds_raw[];
    LAS unsigned char* lds = (LAS unsigned char*)lds_raw;
    cg::grid_group grid = cg::this_grid();
    const int G = gridDim.x;
    unsigned char* ws = args.ws;
    unsigned* ctl = (unsigned*)(ws + WS_CTL);
    const int lo = args.ph_lo, hi = args.ph_hi;
#define IN(k) (lo <= (k) && (k) < hi)
#define NREP(k) ((REP_PHASE) == (k) ? 2 : 1)
#define TSTART(k) do { if ((TIME_REGION) == (k) && blockIdx.x == 0 && threadIdx.x == 0) ctl[300] = (unsigned)__builtin_amdgcn_s_memrealtime(); } while (0)
#define TEND(k) do { if ((TIME_REGION) == (k) && blockIdx.x == 0 && threadIdx.x == 0) ctl[301] = (unsigned)__builtin_amdgcn_s_memrealtime() - ctl[300]; } while (0)
#define SEAM(k) do { if (IN(k) && IN((k) + 1)) { if (args.ph_lo < 0) grid.sync(); xcd_barrier(xbar); } } while (0)
    const int* TILEE = (const int*)(ws + WS_TILEE);
    { volatile LAS unsigned* st = (volatile LAS unsigned*)(lds + MISC_OFF); if (threadIdx.x < 2) st[threadIdx.x] = 0u; }
    __syncthreads();
    const XcdBarrier xbar = xcd_barrier_post(ctl + CW_BAR, (volatile LAS unsigned*)(lds + MISC_OFF));

    if (IN(0)) { for (int rep = 0; rep < NREP(0); ++rep) p0_prologue(lds, args, G); } SEAM(0);
    if (IN(1)) {
        pg8::Gemm g{ws + WS_XN, ws + WS_WINT, 1024, 0, 0, nullptr};
        pg8::TileOrder S; S.init(T / 256, NINP / 256, G, (int)blockIdx.x, nullptr, 0, WGM_P1);
        pg8::EpiBf16 E{(bf16_t*)(ws + WS_P), NINP, (bf16_t*)(ws + WS_VT)};
        for (int rep = 0; rep < NREP(1); ++rep) pg8::gemm_phase<false, false>(lds, g, S, E);
    } SEAM(1);
    TSTART(2);
    if (IN(2)) {
        p2_prep(lds, args);
        asm volatile("s_waitcnt vmcnt(0)" ::: "memory");
        __syncthreads();
        { const int bb = (int)blockIdx.x >> 5, cp = ((int)blockIdx.x & 31) * 2;
          _Pragma("clang loop unroll(disable)") for (int i = 0; i < 16; ++i) ck::chunk_item(lds, args, ((bb * 8 + (i & 7)) << 6) + cp + (i >> 3)); }
    } SEAM(2);
    TSTART(3);
    if (IN(3)) {
        TSTART(30); for (int rep = 0; rep < NREP(30); ++rep) { if (blockIdx.x < 64) ck::seq_head(lds, args, (int)blockIdx.x); __syncthreads(); } TEND(30);
        for (int rep = 0; rep < NREP(31); ++rep) att::attn_phase(lds, args, ctl + 64 * rep);
    } SEAM(3); TEND(3);
    if (IN(4)) {
        pg8::Gemm g{ws + WS_YMIX, ws + WS_WOUT, 1024, 0, 0, nullptr};
        pg8::TileOrder S; S.init(T / 256, D / 256, G, (int)blockIdx.x, nullptr, 0, WGM_P4);
        pg8::EpiResBf16 E{args.in[0], (bf16_t*)(ws + WS_X1B), D};
        for (int rep = 0; rep < NREP(4); ++rep) pg8::gemm_phase<false, false>(lds, g, S, E);
    } SEAM(4);
    if (IN(5)) { _Pragma("clang loop unroll(disable)") for (int rep = 0; rep < NREP(5); ++rep) { p5_router(lds, args, ctl + 256 * (NREP(5) - 1 - rep)); __syncthreads(); } } SEAM(5);
    if (IN(6)) { for (int rep = 0; rep < NREP(6); ++rep) { p6_dispatch(lds, args, ctl); __syncthreads(); } } SEAM(6);
    if (IN(7)) {
        const int ntile = TILEE[1023];
        pg8::Gemm g{ws + WS_H2, ws + WS_W1T, 1024, F8_W_SC, F8_X_SC, (const int*)(ws + WS_ROWTOK)};
        pg8::TileOrder S; S.init(ntile, 8, G, (int)blockIdx.x, TILEE, 8, WGM_P7);
        pg8::EpiSwiglu E{ws + WS_HID, args.in[27], TILEE};
        for (int rep = 0; rep < NREP(7); ++rep) pg8::gemm_phase<true, true>(lds, g, S, E);
    } SEAM(7);
    if (IN(8)) {
        const int ntile = TILEE[1023];
        pg8::Gemm g{ws + WS_HID, ws + WS_W2T, 1024, F8_W_SC, F8_H_SC, nullptr};
        pg8::TileOrder S; S.init(ntile, 4, G, (int)blockIdx.x, TILEE, 4, WGM_P8);
        pg8::EpiGateF8 E{ws + WS_YS, args.in[29], (const float*)(ws + WS_ROWGATE), TILEE};
        for (int rep = 0; rep < NREP(8); ++rep) pg8::gemm_phase<true, false>(lds, g, S, E);
    } SEAM(8);
    if (IN(9)) { p9_combine(args, G); }
#undef IN
#undef SEAM
}

extern "C" void kernel_launch(void* const* d_in, const int* in_sizes, int n_in, void* d_out, int out_size, void* d_ws, size_t ws_size, hipStream_t stream) {
    static int grid = 0;
    if (grid == 0) {
        if (n_in != 30 || in_sizes[0] != T * D || out_size != T * D || ws_size < WS_END) { fprintf(stderr, "kernel_launch: unexpected shapes (n_in %d, in0 %d, out %d, ws %zu); nothing launched\n", n_in, n_in > 0 ? in_sizes[0] : -1, out_size, ws_size); grid = -1; return; }
        int dev = 0, cus = 0, per_cu = 0;
        if (hipGetDevice(&dev) != hipSuccess || hipDeviceGetAttribute(&cus, hipDeviceAttributeMultiprocessorCount, dev) != hipSuccess) { grid = -1; return; }
        if (hipFuncSetAttribute((const void*)hymba_fwd, hipFuncAttributeMaxDynamicSharedMemorySize, LDS_BYTES) != hipSuccess) { fprintf(stderr, "kernel_launch: hipFuncSetAttribute failed\n"); grid = -1; return; }
        if (hipOccupancyMaxActiveBlocksPerMultiprocessor(&per_cu, (const void*)hymba_fwd, 512, LDS_BYTES) != hipSuccess || per_cu < 1) { fprintf(stderr, "kernel_launch: occupancy query says %d\n", per_cu); per_cu = 1; }
        (void)hipGetLastError();
        grid = cus;
        if (grid > 256) grid = 256;
        if (grid != 256 || T % grid != 0 || (T / grid) % 16 != 0) { fprintf(stderr, "kernel_launch: grid %d does not divide the token count evenly\n", grid); grid = -1; return; }
    }
    if (grid < 0) return;
    (void)hipMemsetAsync((char*)d_ws + WS_CTL, 0, CTL_ZERO_BYTES, stream);
    Args a{};
    for (int i = 0; i < 30; ++i) a.in[i] = (const float*)d_in[i];
    a.out = (float*)d_out; a.ws = (unsigned char*)d_ws;
    constexpr int NL = MK_N_LAUNCHES;
    for (int li = 0; li < NL; ++li) {
        a.ph_lo = (NL == 1) ? 0 : li; a.ph_hi = (NL == 1) ? NPHASE : li + 1;
        void* kargs[] = {&a};
        hipError_t e = hipLaunchCooperativeKernel((const void*)hymba_fwd, dim3(grid), dim3(512), kargs, LDS_BYTES, stream);
        if (e != hipSuccess) { fprintf(stderr, "kernel_launch: cooperative launch %d failed: %s (grid %d)\n", li, hipGetErrorString(e), grid); break; }
    }
}
```

```cpp
#include <hip/hip_runtime.h>
#include <hip/hip_cooperative_groups.h>
#include <cstdio>
#include <cstdint>
#include <type_traits>
namespace cg = cooperative_groups;

#ifndef REP_PHASE
#define REP_PHASE -1
#endif
#ifndef TIME_REGION
#define TIME_REGION -1
#endif
#ifndef WGM_P1
#define WGM_P1 2
#endif
#ifndef WGM_P4
#define WGM_P4 2
#endif
#ifndef WGM_P7
#define WGM_P7 2
#endif
#ifndef WGM_P8
#define WGM_P8 2
#endif
#ifndef MK_N_LAUNCHES
#define MK_N_LAUNCHES 1
#endif

#define LAS __attribute__((address_space(3)))
#define GAS __attribute__((address_space(1)))
typedef unsigned short bf16_t;
typedef short bf16x8 __attribute__((ext_vector_type(8)));
typedef short s16x4 __attribute__((ext_vector_type(4)));
typedef float f32x2 __attribute__((ext_vector_type(2)));
typedef float f32x4 __attribute__((ext_vector_type(4)));
typedef float f32x16 __attribute__((ext_vector_type(16)));
typedef unsigned u32x2 __attribute__((ext_vector_type(2)));
typedef unsigned u32x4 __attribute__((ext_vector_type(4)));
typedef int v8i32 __attribute__((ext_vector_type(8)));

constexpr int NB = 8, SEQ = 4096, T = NB * SEQ, D = 1024;
constexpr int CW = 512;
constexpr int NRW = 1696, NIN = 3232, NINP = 3328;
constexpr int DQ0 = 1696, DK0 = 2208, DV0 = 2720;
constexpr int NE = 32, TOPK = 4, DE = 1024;
constexpr int MAXROWS = T * TOPK + NE * 256;
constexpr int MAXTILES = MAXROWS / 256;
constexpr float LOG2E = 1.4426950408889634f;
constexpr float F8_W_MUL = 32.f, F8_X_MUL = 8.f, F8_H_MUL = 4.f, F8_Y_MUL = 16.f; constexpr int F8_W_SC = 0x7A7A7A7A, F8_X_SC = 0x7C7C7C7C, F8_H_SC = 0x7D7D7D7D;

constexpr size_t MiB = 1u << 20;
constexpr size_t WS_CTL = 0, CTL_ZERO_BYTES = 64 * 1024;
constexpr size_t WS_TILEE = 512 * 1024;
constexpr size_t WS_WINT = 1 * MiB;
constexpr size_t WS_WOUT = 8 * MiB;
constexpr size_t WS_W1T = 10 * MiB;
constexpr size_t WS_W2T = 138 * MiB;
constexpr size_t WS_EIDX = 202 * MiB;
constexpr size_t WS_GATE = WS_EIDX + 512 * 1024;
constexpr size_t WS_POS = WS_GATE + 512 * 1024;
constexpr size_t WS_DEST = WS_POS + 512 * 1024;
constexpr size_t WS_ROWGATE = 204 * MiB;
constexpr size_t WS_XN = 206 * MiB;
constexpr size_t WS_P = 270 * MiB;
constexpr size_t WS_SR = 478 * MiB, WS_SK = 510 * MiB, WS_SV = 542 * MiB, WS_SA = 574 * MiB, WS_SB = 606 * MiB;
constexpr size_t WS_SW = 638 * MiB;
constexpr size_t WS_SG = 702 * MiB;
constexpr size_t WS_QN = 734 * MiB, WS_KN = 766 * MiB;
constexpr size_t WS_YMIX = 798 * MiB;
constexpr size_t WS_H2 = 206 * MiB;
constexpr size_t WS_ROWTOK = 270 * MiB;
constexpr size_t WS_HID = 406 * MiB;
constexpr size_t WS_YS = 542 * MiB;
constexpr size_t WS_X1B = 862 * MiB;
constexpr size_t WS_CG = 862 * MiB;
constexpr size_t WS_CH = 894 * MiB;
constexpr size_t WS_CR2 = 926 * MiB;
constexpr size_t WS_CY0 = 958 * MiB;
constexpr size_t WS_RK = 990 * MiB;
constexpr size_t WS_VT = 992 * MiB;
constexpr size_t WS_END = 1024 * MiB;
constexpr int CW_CNT = 64;
constexpr int CW_ATTQ = 128;
constexpr int CW_BAR = 4096;

constexpr int RING_BYTES = 131072, MISC_OFF = RING_BYTES, LDS_BYTES = 147456;

__device__ __forceinline__ unsigned f2bf(float f) { unsigned u = __builtin_bit_cast(unsigned, f); return (u + 0x7fffu + ((u >> 16) & 1u)) >> 16; }
typedef __bf16 hwbf16x2 __attribute__((ext_vector_type(2)));
__device__ __forceinline__ unsigned pk2(float lo, float hi) { const f32x2 v = {lo, hi}; return __builtin_bit_cast(unsigned, __builtin_convertvector(v, hwbf16x2)); }
__device__ __forceinline__ unsigned pk4_fp8(float a, float b, float c, float d) {
    a = fminf(fmaxf(a, -448.f), 448.f); b = fminf(fmaxf(b, -448.f), 448.f); c = fminf(fmaxf(c, -448.f), 448.f); d = fminf(fmaxf(d, -448.f), 448.f);
    int r = __builtin_amdgcn_cvt_pk_fp8_f32(a, b, 0, false); r = __builtin_amdgcn_cvt_pk_fp8_f32(c, d, r, true); return (unsigned)r; }
__device__ __forceinline__ float bf2f(unsigned short b) { return __builtin_bit_cast(float, (unsigned)b << 16); }
__device__ __forceinline__ float bflo(unsigned w) { return __builtin_bit_cast(float, w << 16); }
__device__ __forceinline__ float bfhi(unsigned w) { return __builtin_bit_cast(float, w & 0xffff0000u); }
__device__ __forceinline__ float wave_sum(float v) {
#pragma unroll
    for (int o = 1; o < 64; o <<= 1) v += __shfl_xor(v, o);
    return v;
}
__device__ __forceinline__ float sigmoidf_(float x) { return 1.0f / (1.0f + __expf(-x)); }
template <int CTRL> __device__ __forceinline__ float dpp_f(float v) { return __builtin_bit_cast(float, __builtin_amdgcn_update_dpp(0, __builtin_bit_cast(int, v), CTRL, 0xF, 0xF, true)); }
__device__ __forceinline__ float red8(float v) {
    v += dpp_f<0xB1>(v);
    v += dpp_f<0x4E>(v);
    v += dpp_f<0x141>(v);
    return v;
}
__device__ __forceinline__ float red4(float v) { v += dpp_f<0xB1>(v); v += dpp_f<0x4E>(v); return v; }


#define XB_TMO      128
#define XB_XCNT(j)  (256  + 64 * (j))
#define XB_XSUB(j)  (1280 + 64 * (j))
#define XB_XGEN(j)  (2304 + 64 * (j))
#define XB_TOP      3328
#define XB_TOPGEN   3392
#define XCD_BAR_WORDS 3456
#define XB_SPIN_CAP (1u << 18)
__device__ __forceinline__ unsigned xb_ld(unsigned* p)              { return __hip_atomic_load(p, __ATOMIC_RELAXED, __HIP_MEMORY_SCOPE_AGENT); }
__device__ __forceinline__ unsigned xb_add(unsigned* p, unsigned v) { return __hip_atomic_fetch_add(p, v, __ATOMIC_RELAXED, __HIP_MEMORY_SCOPE_AGENT); }
__device__ __forceinline__ unsigned xb_xcc_id() { return (unsigned)__builtin_amdgcn_s_getreg((3 << 11) | 20) & 0xFu; }
#define XB_SPIN(cond, bar) do { unsigned _sp = 0; while (cond) { __builtin_amdgcn_s_sleep(1); \
    if ((++_sp & 255u) == 0u) { if (xb_ld(&(bar)[XB_TMO])) break; if (_sp > XB_SPIN_CAP) { atomicAdd(&(bar)[XB_TMO], 1u); break; } } } } while (0)
struct XcdBarrier { unsigned* bar; unsigned x; volatile LAS unsigned* st; };
__device__ __forceinline__ XcdBarrier xcd_barrier_post(unsigned* bar, volatile LAS unsigned* st) {
    XcdBarrier b; b.bar = bar; b.x = xb_xcc_id(); b.st = st;
    if (threadIdx.x == 0) (void)xb_add(&bar[XB_XCNT(b.x)], 1u);
    return b;
}
__device__ __forceinline__ void xcd_barrier_complete(unsigned* bar, unsigned x, unsigned& nloc, unsigned& nx) {
    const unsigned G = gridDim.x * gridDim.y * gridDim.z;
    unsigned sum, cnt, mine, sp = 0u;
    for (;;) {
        sum = 0u; cnt = 0u; mine = 0u;
#pragma unroll
        for (unsigned j = 0; j < 16; ++j) { const unsigned c = xb_ld(&bar[XB_XCNT(j)]); sum += c; cnt += (c > 0u) ? 1u : 0u; mine = (j == x) ? c : mine; }
        if (sum == G) break;
        __builtin_amdgcn_s_sleep(1);
        if ((++sp & 255u) == 0u) { if (xb_ld(&bar[XB_TMO])) break; if (sp > XB_SPIN_CAP) { atomicAdd(&bar[XB_TMO], 1u); break; } }
    }
    nloc = mine > 0u ? mine : 1u; nx = cnt > 0u ? cnt : 1u;
}
__device__ __forceinline__ void xcd_barrier(const XcdBarrier& b) {
    asm volatile("s_waitcnt vmcnt(0)" ::: "memory");
    __syncthreads();
    if (threadIdx.x == 0) {
        unsigned* bar = b.bar;
        __builtin_amdgcn_s_waitcnt(0);
        unsigned nloc = b.st[0], nx = b.st[1];
        if (nloc == 0u) { xcd_barrier_complete(bar, b.x, nloc, nx); b.st[0] = nloc; b.st[1] = nx; }
        const unsigned old = xb_add(&bar[XB_XSUB(b.x)], 1u);
        const unsigned gen = old / nloc;
        if (old + 1u == (gen + 1u) * nloc) {
            __builtin_amdgcn_fence(__ATOMIC_RELEASE, "agent");
            asm volatile("s_waitcnt vmcnt(0)" ::: "memory");
            const unsigned og = xb_add(&bar[XB_TOP], 1u);
            const unsigned tg = og / nx;
            if (og + 1u == (tg + 1u) * nx) xb_add(&bar[XB_TOPGEN], 1u);
            else XB_SPIN(xb_ld(&bar[XB_TOPGEN]) == tg, bar);
            __builtin_amdgcn_fence(__ATOMIC_ACQUIRE, "agent");
            xb_add(&bar[XB_XGEN(b.x)], 1u);
            asm volatile("s_waitcnt vmcnt(0)" ::: "memory");
        } else {
            XB_SPIN(xb_ld(&bar[XB_XGEN(b.x)]) == gen, bar);
            __builtin_amdgcn_fence(__ATOMIC_ACQUIRE, "agent");
            asm volatile("s_waitcnt vmcnt(0)" ::: "memory");
        }
    }
    __syncthreads();
}

namespace pg8 {
constexpr int BM = 256, BK = 64, HALF = 128, HTB = HALF * BK * 2, STAGE_BYTES = 8 * HTB, NXCD = 8;
__host__ __device__ __forceinline__ int lds_byte(int r, int c) { const int st = (r >> 4) * 2 + (c >> 5), rr = r & 15, cc = c & 31, ob = rr * 64 + cc * 2; return st * 1024 + (ob ^ (((ob >> 9) & 1) << 5)); }
__host__ __device__ __forceinline__ void stage_rc(int b, int& R, int& C) { const int st = b / 1024, sb = b % 1024, swz = sb ^ (((sb >> 9) & 1) << 5); R = (st >> 1) * 16 + swz / 64; C = (st & 1) * 32 + (swz % 64) / 2; }
__host__ __device__ __forceinline__ int perm32(int rho) { const int n = rho >> 4, i = rho & 15; return 8 * (i >> 2) + 4 * n + (i & 3); }

struct Unit { int pm, pn, pb; };
struct Gemm { const void* A; const void* Bt; int K; int scW, scA; const int* rowtok; };

struct TileOrder {
    int nM, nN, nwg, G, c, WGM; const int* tile_e; int nb_per_e;
    __device__ void init(int nM_, int nN_, int G_, int c_, const int* te, int nbe, int wgm) { nM = nM_; nN = nN_; nwg = nM * nN; G = G_; c = c_; tile_e = te; nb_per_e = nbe; WGM = wgm; }
    __device__ bool next(int i, Unit& u) const {
        const long L = (long)i * G + c; if (L >= nwg) return false;
        int wgid = (int)L; { const int q = nwg / NXCD, r = nwg % NXCD, xcd = wgid % NXCD, off = wgid / NXCD; wgid = (xcd < r ? xcd * (q + 1) : r * (q + 1) + (xcd - r) * q) + off; }
        const int nig = WGM * nN, gid = wgid / nig, fm = gid * WGM, gsz = (nM - fm) < WGM ? (nM - fm) : WGM;
        u.pm = fm + ((wgid % nig) % gsz); u.pn = (wgid % nig) / gsz;
        u.pb = tile_e ? tile_e[u.pm] * nb_per_e + u.pn : u.pn;
        return true;
    }
};

struct EpiBf16 {
    static constexpr bool PERM = true;
    bf16_t* O; int ldc; bf16_t* VT;
    __device__ __forceinline__ void operator()(const f32x4 (&acc)[2][2][4][2], const Unit& u, int wr, int wc, int fr, int fq) const {
        const int row0 = u.pm * BM + wr * 64 + fr; const int col0 = u.pn * BM + wc * 32 + 8 * fq;
#pragma unroll
        for (int ai = 0; ai < 2; ++ai)
#pragma unroll
            for (int m = 0; m < 4; ++m) { const int t = row0 + ai * HALF + m * 16; bf16_t* rowp = O + (size_t)t * ldc + col0;
#pragma unroll
                for (int bj = 0; bj < 2; ++bj) { const f32x4 v0 = acc[ai][bj][m][0], v1 = acc[ai][bj][m][1];
                    u32x4 w; w.x = pk2(v0[0], v0[1]); w.y = pk2(v0[2], v0[3]); w.z = pk2(v1[0], v1[1]); w.w = pk2(v1[2], v1[3]);
                    const int col = col0 + bj * HALF;
                    if (col >= DV0) { const int dvf = col - DV0, hh = dvf >> 7, dv = dvf & 127, tp = t & (SEQ - 1), key = tp & 63;
                        bf16_t* vp = VT + (((((size_t)((t >> 12) * 4 + hh) * 64 + (tp >> 6)) * 4 + (dv >> 5)) * 4 + (key >> 4)) * 16 + (key & 15)) * 32 + (dv & 31);
                        if (col < NIN) *(u32x4*)vp = w; }
                    else *(u32x4*)(rowp + bj * HALF) = w; } }
    }
};
struct EpiResBf16 {
    static constexpr bool PERM = true;
    const float* base; bf16_t* out; int ldc;
    __device__ __forceinline__ void operator()(const f32x4 (&acc)[2][2][4][2], const Unit& u, int wr, int wc, int fr, int fq) const {
        const int col0 = u.pn * BM + wc * 32 + 8 * fq;
#pragma unroll
        for (int ai = 0; ai < 2; ++ai)
#pragma unroll
            for (int m = 0; m < 4; ++m) { const size_t off = (size_t)(u.pm * BM + ai * HALF + wr * 64 + m * 16 + fr) * ldc + col0;
#pragma unroll
                for (int bj = 0; bj < 2; ++bj) { const f32x4 b0 = *(const f32x4*)(base + off + bj * HALF), b1 = *(const f32x4*)(base + off + bj * HALF + 4);
                    const f32x4 v0 = b0 + acc[ai][bj][m][0], v1 = b1 + acc[ai][bj][m][1];
                    u32x4 w; w.x = pk2(v0[0], v0[1]); w.y = pk2(v0[2], v0[3]); w.z = pk2(v1[0], v1[1]); w.w = pk2(v1[2], v1[3]);
                    *(u32x4*)(out + off + bj * HALF) = w; } }
    }
};
struct EpiSwiglu {
    static constexpr bool PERM = true;
    unsigned char* O; const float* b1; const int* tile_e;
    __device__ __forceinline__ void operator()(const f32x4 (&acc)[2][2][4][2], const Unit& u, int wr, int wc, int fr, int fq) const {
        const int e = tile_e[u.pm]; const int row0 = u.pm * BM + wr * 64 + fr; const int hc0 = u.pn * 128 + wc * 32 + 8 * fq;
        const float* bg = b1 + (size_t)e * 2048 + hc0; const float* bl = bg + 1024;
        const f32x4 g0 = *(const f32x4*)bg, g1 = *(const f32x4*)(bg + 4), l0 = *(const f32x4*)bl, l1 = *(const f32x4*)(bl + 4);
#pragma unroll
        for (int ai = 0; ai < 2; ++ai)
#pragma unroll
            for (int m = 0; m < 4; ++m) { unsigned char* rowp = O + (size_t)(row0 + ai * HALF + m * 16) * 1024 + hc0;
                float o[8];
#pragma unroll
                for (int n = 0; n < 2; ++n) { const f32x4 gv = acc[ai][0][m][n] + (n ? g1 : g0), lv = acc[ai][1][m][n] + (n ? l1 : l0);
#pragma unroll
                    for (int i = 0; i < 4; ++i) { const float g = fminf(gv[i], 7.0f), l = fminf(fmaxf(lv[i], -7.0f), 7.0f);
                        const float sg = __builtin_amdgcn_rcpf(1.0f + __builtin_amdgcn_exp2f(-1.702f * LOG2E * g)); o[n * 4 + i] = g * sg * (l + 1.0f); } }
                u32x2 w; w.x = pk4_fp8(o[0] * F8_H_MUL, o[1] * F8_H_MUL, o[2] * F8_H_MUL, o[3] * F8_H_MUL); w.y = pk4_fp8(o[4] * F8_H_MUL, o[5] * F8_H_MUL, o[6] * F8_H_MUL, o[7] * F8_H_MUL);
                *(u32x2*)rowp = w; }
    }
};
struct EpiGateF8 {
    static constexpr bool PERM = true;
    unsigned char* O; const float* b2; const float* rowgate; const int* tile_e;
    __device__ __forceinline__ void operator()(const f32x4 (&acc)[2][2][4][2], const Unit& u, int wr, int wc, int fr, int fq) const {
        const int e = tile_e[u.pm]; const int row0 = u.pm * BM + wr * 64 + fr; const int col0 = u.pn * BM + wc * 32 + 8 * fq;
        f32x4 bv[2][2];
#pragma unroll
        for (int bj = 0; bj < 2; ++bj)
#pragma unroll
            for (int n = 0; n < 2; ++n) bv[bj][n] = *(const f32x4*)(b2 + (size_t)e * 1024 + col0 + bj * HALF + 4 * n);
#pragma unroll
        for (int ai = 0; ai < 2; ++ai)
#pragma unroll
            for (int m = 0; m < 4; ++m) { const int row = row0 + ai * HALF + m * 16; const float gt = rowgate[row] * F8_Y_MUL; unsigned char* rowp = O + (size_t)row * 1024 + col0;
#pragma unroll
                for (int bj = 0; bj < 2; ++bj) { const f32x4 v0 = (acc[ai][bj][m][0] + bv[bj][0]) * gt, v1 = (acc[ai][bj][m][1] + bv[bj][1]) * gt;
                    u32x2 w; w.x = pk4_fp8(v0[0], v0[1], v0[2], v0[3]); w.y = pk4_fp8(v1[0], v1[1], v1[2], v1[3]);
                    *(u32x2*)(rowp + bj * HALF) = w; } }
    }
};

template <bool F8, bool GATHER, class Epi, class Sched>
__device__ __forceinline__ void gemm_phase(LAS unsigned char* lds, const Gemm g, const Sched& S, const Epi& E) {
    const int tid = threadIdx.x, wid = __builtin_amdgcn_readfirstlane(tid >> 6), lane = tid & 63, wr = wid >> 2, wc = wid & 3, fr = lane & 15, fq = lane >> 4;
    const int RB = F8 ? g.K : g.K * 2, nt = RB / 128;
    unsigned voffB[2];
#pragma unroll
    for (int i = 0; i < 2; ++i) { int R, C; stage_rc(tid * 16 + i * 8192, R, C); const int Rb = Epi::PERM ? ((R & ~31) + perm32(R & 31)) : R;
        voffB[i] = (unsigned)(Rb * RB + C * 2); }
#define PG8_AOFFS(dst, pm_) do { _Pragma("unroll") for (int h_ = 0; h_ < 2; ++h_) _Pragma("unroll") for (int i_ = 0; i_ < 2; ++i_) { int R_, C_; stage_rc(tid * 16 + i_ * 8192, R_, C_); \
        const int row_ = (pm_) * BM + h_ * HALF + R_; const unsigned grow_ = GATHER ? (unsigned)g.rowtok[row_] : (unsigned)row_; dst[h_][i_] = grow_ * (unsigned)RB + (unsigned)(C_ * 2); } } while (0)
    unsigned cvA[2][2], nvA[2][2];
    const size_t kstep = (size_t)(BK * 2);
    const size_t hstep = (size_t)HALF * RB;
    const size_t tstep = 2 * hstep;
    const unsigned ldsw = (unsigned)wid * 1024u;
    const int aoff = F8 ? lds_byte(wr * 64 + fr, (fq & 1) * 16) + (fq >> 1) * 1024 : lds_byte(wr * 64 + fr, fq * 8);
    const int boff = F8 ? lds_byte(wc * 32 + fr, (fq & 1) * 16) + (fq >> 1) * 1024 : lds_byte(wc * 32 + fr, fq * 8);
    const int scW = g.scW, scA = g.scA;
#define PG8_SA(b, h) (((b) * 2 + (h)) * HTB)
#define PG8_SB(b, h) ((4 + (b) * 2 + (h)) * HTB)
#define PG8_STAGE(bufoff, gbase, voff) do { _Pragma("unroll") for (int _i = 0; _i < 2; ++_i) \
        __builtin_amdgcn_global_load_lds((const unsigned*)((const char*)(gbase) + (voff)[_i]), (LAS unsigned*)(lds + (bufoff) + ldsw + _i * 8192), 16, 0, 0); } while (0)
typedef int v8i32a __attribute__((ext_vector_type(8), aligned(16)));
#define PG8_LD32(p) (*(const LAS v8i32a*)(p))
#define PG8_STAGE_A(bufoff, kptr, offs) do { _Pragma("unroll") for (int _i = 0; _i < 2; ++_i) \
        __builtin_amdgcn_global_load_lds((const unsigned*)((const char*)(kptr) + (offs)[_i]), (LAS unsigned*)(lds + (bufoff) + ldsw + _i * 8192), 16, 0, 0); } while (0)
#define PG8_LDA(dst, b, h) do { _Pragma("unroll") for (int m = 0; m < 4; ++m) { if constexpr (F8) { dst[m].f8 = __builtin_bit_cast(v8i32, PG8_LD32(lds + PG8_SA(b, h) + aoff + m * 2048)); } \
        else { _Pragma("unroll") for (int k = 0; k < 2; ++k) dst[m].hv[k] = *(const LAS bf16x8*)(lds + PG8_SA(b, h) + aoff + m * 2048 + k * 1024); } } } while (0)
#define PG8_LDB(dst, b, h) do { _Pragma("unroll") for (int n = 0; n < 2; ++n) { if constexpr (F8) { dst[n].f8 = __builtin_bit_cast(v8i32, PG8_LD32(lds + PG8_SB(b, h) + boff + n * 2048)); } \
        else { _Pragma("unroll") for (int k = 0; k < 2; ++k) dst[n].hv[k] = *(const LAS bf16x8*)(lds + PG8_SB(b, h) + boff + n * 2048 + k * 1024); } } } while (0)
#define PG8_MMA(ai, bj, At, Bt) do { __builtin_amdgcn_s_setprio(1); _Pragma("unroll") for (int m = 0; m < 4; ++m) _Pragma("unroll") for (int n = 0; n < 2; ++n) { \
        if constexpr (F8) { asm volatile("v_mfma_scale_f32_16x16x128_f8f6f4 %0, %1, %2, %0, %3, %4 op_sel_hi:[0,0,0]" : "+v"(acc[ai][bj][m][n]) : "v"(Bt[n].f8), "v"(At[m].f8), "v"(scW), "v"(scA)); } \
        else { _Pragma("unroll") for (int k = 0; k < 2; ++k) acc[ai][bj][m][n] = __builtin_amdgcn_mfma_f32_16x16x32_bf16(Bt[n].hv[k], At[m].hv[k], acc[ai][bj][m][n], 0, 0, 0); } } \
        __builtin_amdgcn_s_setprio(0); } while (0)
#define PG8_WAIT_V(n) asm volatile("s_waitcnt vmcnt(" #n ")" ::: "memory")
#define PG8_WAIT_L(n) asm volatile("s_waitcnt lgkmcnt(" #n ")" ::: "memory")
#define PG8_BAR __builtin_amdgcn_s_barrier()
#define PG8_SCHED __builtin_amdgcn_sched_barrier(0)
    Unit cur, nxt; int ui = 0;
    if (!S.next(0, cur)) return;
    f32x4 acc[2][2][4][2];
#pragma unroll
    for (int a = 0; a < 2; ++a)
#pragma unroll
        for (int b = 0; b < 2; ++b)
#pragma unroll
            for (int m = 0; m < 4; ++m)
#pragma unroll
                for (int n = 0; n < 2; ++n) acc[a][b][m][n] = (f32x4){0.f, 0.f, 0.f, 0.f};
    struct FragH { bf16x8 hv[2]; }; struct Frag8 { v8i32 f8; };
    typename std::conditional<F8, Frag8, FragH>::type At[4], B0[2], B1[2];
    const char* const kA = (const char*)g.A; const char* cB = (const char*)g.Bt + (size_t)cur.pb * tstep;
    PG8_AOFFS(cvA, cur.pm);
    PG8_STAGE(PG8_SB(0, 0), cB, voffB); PG8_STAGE(PG8_SB(0, 1), cB + hstep, voffB); PG8_STAGE_A(PG8_SA(0, 0), kA, cvA[0]); PG8_STAGE_A(PG8_SA(0, 1), kA, cvA[1]);
    if (wr == 1) PG8_BAR;
    PG8_WAIT_V(2); PG8_BAR;
    PG8_STAGE(PG8_SB(1, 0), cB + kstep, voffB); PG8_STAGE_A(PG8_SA(1, 0), kA + kstep, cvA[0]); PG8_STAGE(PG8_SB(1, 1), cB + hstep + kstep, voffB);
    PG8_WAIT_V(6); PG8_BAR;
    for (;;) {
        const bool has_next = S.next(ui + 1, nxt);
        const char* nB = has_next ? (const char*)g.Bt + (size_t)nxt.pb * tstep : cB;
        if (has_next) { PG8_AOFFS(nvA, nxt.pm); } else { _Pragma("unroll") for (int h_ = 0; h_ < 2; ++h_) _Pragma("unroll") for (int i_ = 0; i_ < 2; ++i_) nvA[h_][i_] = cvA[h_][i_]; }
#pragma clang loop unroll(disable)
        for (int t = 0; t < nt; t += 2) {
            const bool last = (t == nt - 2);
            const char* a1 = kA + (size_t)(t + 1) * kstep;
            const char* a2 = last ? kA : kA + (size_t)(t + 2) * kstep; const char* b2 = last ? nB : cB + (size_t)(t + 2) * kstep;
            const char* a3 = a2 + kstep; const char* b3 = b2 + kstep;
            unsigned v2A[2][2];
#pragma unroll
            for (int h_ = 0; h_ < 2; ++h_)
#pragma unroll
                for (int i_ = 0; i_ < 2; ++i_) v2A[h_][i_] = last ? nvA[h_][i_] : cvA[h_][i_];
            PG8_LDB(B0, 0, 0); PG8_LDB(B1, 0, 1); PG8_SCHED; PG8_LDA(At, 0, 0); PG8_STAGE_A(PG8_SA(1, 1), a1, cvA[1]);
            PG8_WAIT_V(8); PG8_WAIT_L(0); PG8_BAR; PG8_MMA(0, 0, At, B0); PG8_MMA(0, 1, At, B1); PG8_BAR; PG8_SCHED;
            PG8_LDA(At, 0, 1); PG8_STAGE(PG8_SB(0, 0), b2, voffB); PG8_STAGE(PG8_SB(0, 1), b2 + hstep, voffB); PG8_STAGE_A(PG8_SA(0, 0), a2, v2A[0]);
            PG8_WAIT_V(8); PG8_WAIT_L(0); PG8_BAR; PG8_MMA(1, 0, At, B0); PG8_MMA(1, 1, At, B1); PG8_BAR; PG8_SCHED;
            PG8_LDB(B0, 1, 0); PG8_LDB(B1, 1, 1); PG8_SCHED; PG8_LDA(At, 1, 0); PG8_STAGE_A(PG8_SA(0, 1), a2, v2A[1]);
            PG8_WAIT_V(8); PG8_WAIT_L(0); PG8_BAR; PG8_MMA(0, 0, At, B0); PG8_MMA(0, 1, At, B1); PG8_BAR; PG8_SCHED;
            PG8_LDA(At, 1, 1); PG8_STAGE(PG8_SB(1, 0), b3, voffB); PG8_STAGE(PG8_SB(1, 1), b3 + hstep, voffB); PG8_STAGE_A(PG8_SA(1, 0), a3, v2A[0]);
            PG8_WAIT_V(8); PG8_WAIT_L(0); PG8_BAR; PG8_MMA(1, 0, At, B0); PG8_MMA(1, 1, At, B1); PG8_BAR; PG8_SCHED;
        }
        if (wr == 0) PG8_BAR;
        if constexpr (F8) asm volatile("s_nop 15\n\ts_nop 15" ::: "memory");
        E(acc, cur, wr, wc, fr, fq);
        if (!has_next) break;
#pragma unroll
        for (int a = 0; a < 2; ++a)
#pragma unroll
            for (int b = 0; b < 2; ++b)
#pragma unroll
                for (int m = 0; m < 4; ++m)
#pragma unroll
                    for (int n = 0; n < 2; ++n) acc[a][b][m][n] = (f32x4){0.f, 0.f, 0.f, 0.f};
        cur = nxt; cB = nB; ++ui;
#pragma unroll
        for (int h_ = 0; h_ < 2; ++h_)
#pragma unroll
            for (int i_ = 0; i_ < 2; ++i_) cvA[h_][i_] = nvA[h_][i_];
        if (wr == 1) PG8_BAR;
    }
    PG8_WAIT_V(0);
    PG8_BAR;
#undef PG8_SA
#undef PG8_SB
#undef PG8_STAGE
#undef PG8_STAGE_A
#undef PG8_AOFFS
#undef PG8_LDA
#undef PG8_LDB
#undef PG8_MMA
#undef PG8_LD32
#undef PG8_WAIT_V
#undef PG8_WAIT_L
#undef PG8_BAR
#undef PG8_SCHED
}
}

struct Args { const float* in[30]; float* out; unsigned char* ws; int ph_lo, ph_hi; };

__device__ __forceinline__ void p0_transpose_item(const float* W, int K, int N, bf16_t* WT, int k0, int n0, int drow0, LAS float* scr, int lane) {
#pragma unroll 8
    for (int i = 0; i < 32; ++i) { const int kk = 2 * i + (lane >> 5); scr[kk * 33 + (lane & 31)] = W[(size_t)(k0 + kk) * N + n0 + (lane & 31)]; }
    asm volatile("s_waitcnt lgkmcnt(0)" ::: "memory");
    const int c = lane & 7;
#pragma unroll
    for (int j = 0; j < 4; ++j) { const int n = (lane >> 3) + 8 * j; const LAS float* s = scr + (8 * c) * 33 + n;
        u32x4 o; o.x = pk2(s[0 * 33], s[1 * 33]); o.y = pk2(s[2 * 33], s[3 * 33]); o.z = pk2(s[4 * 33], s[5 * 33]); o.w = pk2(s[6 * 33], s[7 * 33]);
        *(u32x4*)(WT + (size_t)(drow0 + n) * K + k0 + 8 * c) = o; }
    asm volatile("s_waitcnt lgkmcnt(0)" ::: "memory");
}
__device__ __forceinline__ void p0_transpose_item_f8(const float* W, int K, int N, unsigned char* WT, int k0, int n0, int drow0, LAS float* scr, int lane) {
#pragma unroll 8
    for (int i = 0; i < 32; ++i) { const int kk = 2 * i + (lane >> 5); scr[kk * 33 + (lane & 31)] = W[(size_t)(k0 + kk) * N + n0 + (lane & 31)]; }
    asm volatile("s_waitcnt lgkmcnt(0)" ::: "memory");
    const int c = lane & 3;
#pragma unroll
    for (int j = 0; j < 2; ++j) { const int n = (lane >> 2) + 16 * j; const LAS float* s = scr + (16 * c) * 33 + n;
        u32x4 o;
        o.x = pk4_fp8(s[0 * 33] * F8_W_MUL, s[1 * 33] * F8_W_MUL, s[2 * 33] * F8_W_MUL, s[3 * 33] * F8_W_MUL);
        o.y = pk4_fp8(s[4 * 33] * F8_W_MUL, s[5 * 33] * F8_W_MUL, s[6 * 33] * F8_W_MUL, s[7 * 33] * F8_W_MUL);
        o.z = pk4_fp8(s[8 * 33] * F8_W_MUL, s[9 * 33] * F8_W_MUL, s[10 * 33] * F8_W_MUL, s[11 * 33] * F8_W_MUL);
        o.w = pk4_fp8(s[12 * 33] * F8_W_MUL, s[13 * 33] * F8_W_MUL, s[14 * 33] * F8_W_MUL, s[15 * 33] * F8_W_MUL);
        *(u32x4*)(WT + (size_t)(drow0 + n) * K + k0 + 16 * c) = o; }
    asm volatile("s_waitcnt lgkmcnt(0)" ::: "memory");
}
__device__ __forceinline__ void p0_prologue(LAS unsigned char* lds, const Args& a, int G) {
    const int tid = threadIdx.x, lane = tid & 63, wave = __builtin_amdgcn_readfirstlane(tid >> 6);
    LAS float* scr = (LAS float*)(lds + wave * 16384);
    const int gw = blockIdx.x * 8 + wave, NGW = G * 8;
    unsigned char* ws = a.ws;
    bf16_t* Wint = (bf16_t*)(ws + WS_WINT); bf16_t* Woutt = (bf16_t*)(ws + WS_WOUT); unsigned char* W1t = ws + WS_W1T; unsigned char* W2t = ws + WS_W2T;
    constexpr int I_IN = 16 * (NIN / 32);
    constexpr int I_OUT = 16 * 32;
    constexpr int I_W1 = 16 * 64;
    constexpr int I_W2 = 16 * 32;
    constexpr int NITEMS = I_IN + I_OUT + NE * I_W1 + NE * I_W2;
    for (int it = gw; it < NITEMS; it += NGW) {
        int r = it;
        if (r < I_IN) { const int nblk = NIN / 32, kb = r / nblk, nb = r % nblk; p0_transpose_item(a.in[2], 1024, NIN, Wint, 64 * kb, 32 * nb, 32 * nb, scr, lane); continue; } r -= I_IN;
        if (r < I_OUT) { const int kb = r / 32, nb = r % 32; p0_transpose_item(a.in[22], 1024, 1024, Woutt, 64 * kb, 32 * nb, 32 * nb, scr, lane); continue; } r -= I_OUT;
        if (r < NE * I_W1) { const int e = r / I_W1, q = r % I_W1, kb = q / 64, nb = q % 64; const int n0 = 32 * nb;
            const int drow = (n0 < 1024) ? ((n0 >> 7) * 256 + (n0 & 127)) : (((n0 - 1024) >> 7) * 256 + 128 + ((n0 - 1024) & 127));
            p0_transpose_item_f8(a.in[26] + (size_t)e * 1024 * 2048, 1024, 2048, W1t + (size_t)e * 2048 * 1024, 64 * kb, n0, drow, scr, lane); continue; } r -= NE * I_W1;
        { const int e = r / I_W2, q = r % I_W2, kb = q / 32, nb = q % 32;
            p0_transpose_item_f8(a.in[28] + (size_t)e * 1024 * 1024, 1024, 1024, W2t + (size_t)e * 1024 * 1024, 64 * kb, 32 * nb, 32 * nb, scr, lane); }
    }
    const float* x = a.in[0]; const float* g1 = a.in[1]; bf16_t* XN = (bf16_t*)(ws + WS_XN);
    f32x4 gv[4];
#pragma unroll
    for (int j = 0; j < 4; ++j) gv[j] = *((const f32x4*)g1 + lane + 64 * j);
    for (int m = gw; m < T; m += NGW) {
        const f32x4* xr = (const f32x4*)(x + (size_t)m * D) + lane;
        f32x4 v[4]; float s = 0.f;
#pragma unroll
        for (int j = 0; j < 4; ++j) { v[j] = xr[64 * j]; s += (v[j].x * v[j].x + v[j].y * v[j].y) + (v[j].z * v[j].z + v[j].w * v[j].w); }
        const float rstd = 1.0f / sqrtf(wave_sum(s) * (1.0f / D) + 1e-5f);
        u32x2* o8 = (u32x2*)(XN + (size_t)m * D) + lane;
#pragma unroll
        for (int j = 0; j < 4; ++j) { u32x2 w; w.x = pk2(v[j].x * rstd * gv[j].x, v[j].y * rstd * gv[j].y); w.y = pk2(v[j].z * rstd * gv[j].z, v[j].w * rstd * gv[j].w); o8[64 * j] = w; }
    }
}

__device__ __forceinline__ f32x4 cvlo(const u32x4 u) { return (f32x4){bflo(u.x), bfhi(u.x), bflo(u.y), bfhi(u.y)}; }
__device__ __forceinline__ f32x4 cvhi(const u32x4 u) { return (f32x4){bflo(u.z), bfhi(u.z), bflo(u.w), bfhi(u.w)}; }
__device__ __forceinline__ u32x4 pk8(const f32x4 lo, const f32x4 hi) { u32x4 w; w.x = pk2(lo.x, lo.y); w.y = pk2(lo.z, lo.w); w.z = pk2(hi.x, hi.y); w.w = pk2(hi.z, hi.w); return w; }
__device__ __forceinline__ void p2_prep(LAS unsigned char* lds, const Args& a) {
    const int tid = threadIdx.x, lane = tid & 63, wave = __builtin_amdgcn_readfirstlane(tid >> 6);
    unsigned char* ws = a.ws;
    const bf16_t* P = (const bf16_t*)(ws + WS_P);
    bf16_t* SR = (bf16_t*)(ws + WS_SR); bf16_t* SK = (bf16_t*)(ws + WS_SK); bf16_t* SV = (bf16_t*)(ws + WS_SV); bf16_t* SA = (bf16_t*)(ws + WS_SA); bf16_t* SB = (bf16_t*)(ws + WS_SB);
    float* SW = (float*)(ws + WS_SW); bf16_t* SG = (bf16_t*)(ws + WS_SG); bf16_t* QN = (bf16_t*)(ws + WS_QN); bf16_t* KN = (bf16_t*)(ws + WS_KN);
    const float* mu = a.in[3]; const float* w0 = a.in[4]; const float* w2 = a.in[5]; const float* a0 = a.in[6]; const float* a2 = a.in[7]; const float* g2 = a.in[8];
    const float* k_k = a.in[9]; const float* k_a = a.in[10]; const float* qn_g = a.in[14]; const float* kn_g = a.in[15];
    LAS unsigned char* ACT = lds;
    LAS float* DEC = (LAS float*)(lds + 8192); LAS float* ALR = (LAS float*)(lds + 40960); LAS float* GG = (LAS float*)(lds + 73728);
    bf16x8 bw[4][5];
    const int fcol = lane & 15, fk = (lane >> 4) * 8;
#pragma unroll
    for (int cb = 0; cb < 4; ++cb) {
        const int col = wave * 64 + cb * 16 + fcol;
#pragma unroll
        for (int kb = 0; kb < 5; ++kb) {
            const float* src = (kb == 0) ? (w2 + (size_t)fk * CW + col) : (kb == 1) ? (a2 + (size_t)fk * CW + col) : (g2 + (size_t)((kb - 2) * 32 + fk) * CW + col);
            u32x4 w; w.x = pk2(src[0], src[CW]); w.y = pk2(src[2 * CW], src[3 * CW]); w.z = pk2(src[4 * CW], src[5 * CW]); w.w = pk2(src[6 * CW], src[7 * CW]);
            bw[cb][kb] = __builtin_bit_cast(bf16x8, w);
        }
    }
    float w0c[4], a0c[4];
#pragma unroll
    for (int cb = 0; cb < 4; ++cb) { w0c[cb] = w0[wave * 64 + cb * 16 + fcol]; a0c[cb] = a0[wave * 64 + cb * 16 + fcol]; }
    const int c8 = lane * 8;
    const int TPB = T / (int)gridDim.x;
    const int tb0 = blockIdx.x * TPB;
    for (int t0 = tb0; t0 < tb0 + TPB; t0 += 16) {
        if (tid < 320) {
            const int tok = tid / 20, ch = tid - tok * 20, t = t0 + tok, col = 1536 + ch * 8;
            const u32x4 cu = *(const u32x4*)(P + (size_t)t * NINP + col);
            u32x4 pu = (u32x4){0u, 0u, 0u, 0u};
            if (t & (SEQ - 1)) pu = *(const u32x4*)(P + (size_t)(t - 1) * NINP + col);
            const f32x4 m0 = *(const f32x4*)(mu + col), m1 = *(const f32x4*)(mu + col + 4);
            const f32x4 c0 = cvlo(cu), c1 = cvhi(cu), p0 = cvlo(pu), p1 = cvhi(pu);
            f32x4 s0 = c0 + (p0 - c0) * m0, s1 = c1 + (p1 - c1) * m1;
            if (ch < 4) {
#pragma unroll
                for (int i = 0; i < 4; ++i) { const float e0 = __expf(-2.0f * fabsf(s0[i])), e1 = __expf(-2.0f * fabsf(s1[i])); const float th0 = (1.0f - e0) / (1.0f + e0), th1 = (1.0f - e1) / (1.0f + e1);
                    s0[i] = s0[i] < 0.f ? -th0 : th0; s1[i] = s1[i] < 0.f ? -th1 : th1; }
            } else if (ch >= 8) {
#pragma unroll
                for (int i = 0; i < 4; ++i) { s0[i] = sigmoidf_(s0[i]); s1[i] = sigmoidf_(s1[i]); }
            }
            *(LAS u32x4*)(ACT + tok * 320 + ch * 16) = pk8(s0, s1);
        }
        __syncthreads();
        {
            bf16x8 af[5];
#pragma unroll
            for (int kb = 0; kb < 5; ++kb) af[kb] = *(const LAS bf16x8*)(ACT + fcol * 320 + kb * 64 + (lane >> 4) * 16);
#pragma unroll
            for (int cb = 0; cb < 4; ++cb) {
                const f32x4 z = {0.f, 0.f, 0.f, 0.f};
                const f32x4 aw = __builtin_amdgcn_mfma_f32_16x16x32_bf16(af[0], bw[cb][0], z, 0, 0, 0);
                const f32x4 aa = __builtin_amdgcn_mfma_f32_16x16x32_bf16(af[1], bw[cb][1], z, 0, 0, 0);
                f32x4 ag = __builtin_amdgcn_mfma_f32_16x16x32_bf16(af[2], bw[cb][2], z, 0, 0, 0);
                ag = __builtin_amdgcn_mfma_f32_16x16x32_bf16(af[3], bw[cb][3], ag, 0, 0, 0);
                ag = __builtin_amdgcn_mfma_f32_16x16x32_bf16(af[4], bw[cb][4], ag, 0, 0, 0);
                const int col = wave * 64 + cb * 16 + fcol;
#pragma unroll
                for (int i = 0; i < 4; ++i) { const int row = (lane >> 4) * 4 + i;
                    DEC[row * 512 + col] = __expf(-0.6065306597126334f * sigmoidf_(aw[i] + w0c[cb]));
                    ALR[row * 512 + col] = sigmoidf_(aa[i] + a0c[cb]);
                    GG[row * 512 + col] = ag[i]; }
            }
        }
        __syncthreads();
#pragma unroll 1
        for (int q = 0; q < 2; ++q) {
            const int tok = 2 * wave + q, t = t0 + tok; const size_t o = (size_t)t * CW + c8;
            const bf16_t* pr = P + (size_t)t * NINP + c8;
            const bool first = (t & (SEQ - 1)) == 0;
            const u32x4 zz = (u32x4){0u, 0u, 0u, 0u};
            f32x4 rr0, rr1;
            { const u32x4 cu = *(const u32x4*)(pr), pu = first ? zz : *(const u32x4*)(pr - NINP);
              const f32x4 m0 = *(const f32x4*)(mu + c8), m1 = *(const f32x4*)(mu + c8 + 4);
              const f32x4 c0 = cvlo(cu), c1 = cvhi(cu), p0 = cvlo(pu), p1 = cvhi(pu);
              rr0 = c0 + (p0 - c0) * m0; rr1 = c1 + (p1 - c1) * m1; *(u32x4*)(SR + o) = pk8(rr0, rr1); }
            { const u32x4 cu = *(const u32x4*)(pr + 1024), pu = first ? zz : *(const u32x4*)(pr - NINP + 1024);
              const f32x4 m0 = *(const f32x4*)(mu + 1024 + c8), m1 = *(const f32x4*)(mu + 1024 + c8 + 4);
              const f32x4 c0 = cvlo(cu), c1 = cvhi(cu), p0 = cvlo(pu), p1 = cvhi(pu);
              *(u32x4*)(SV + o) = pk8(c0 + (p0 - c0) * m0, c1 + (p1 - c1) * m1); }
            { const u32x4 cu = *(const u32x4*)(pr + 512), pu = first ? zz : *(const u32x4*)(pr - NINP + 512);
              const f32x4 m0 = *(const f32x4*)(mu + 512 + c8), m1 = *(const f32x4*)(mu + 512 + c8 + 4);
              const f32x4 c0 = cvlo(cu), c1 = cvhi(cu), p0 = cvlo(pu), p1 = cvhi(pu);
              const f32x4 k0 = c0 + (p0 - c0) * m0, k1 = c1 + (p1 - c1) * m1;
              const f32x4 kk0 = k0 * *(const f32x4*)(k_k + c8), kk1 = k1 * *(const f32x4*)(k_k + c8 + 4);
              float ss = (kk0.x * kk0.x + kk0.y * kk0.y) + (kk0.z * kk0.z + kk0.w * kk0.w) + (kk1.x * kk1.x + kk1.y * kk1.y) + (kk1.z * kk1.z + kk1.w * kk1.w);
              ss = red8(ss);
              const float inv = 1.0f / sqrtf(fmaxf(ss, 1e-24f));
              const f32x4 kn0 = kk0 * inv, kn1 = kk1 * inv;
              const f32x4 al0 = *(const LAS f32x4*)(ALR + tok * 512 + c8), al1 = *(const LAS f32x4*)(ALR + tok * 512 + c8 + 4);
              const f32x4 k20 = k0 * (1.0f + (al0 - 1.0f) * *(const f32x4*)(k_a + c8)), k21 = k1 * (1.0f + (al1 - 1.0f) * *(const f32x4*)(k_a + c8 + 4));
              *(u32x4*)(SK + o) = pk8(k20, k21); *(u32x4*)(SA + o) = pk8(-kn0, -kn1); *(u32x4*)(SB + o) = pk8(kn0 * al0, kn1 * al1);
              const f32x4 q0 = rr0 * k20 * *(const f32x4*)(a.in[11] + c8), q1 = rr1 * k21 * *(const f32x4*)(a.in[11] + c8 + 4);
              const float rk = red8((q0.x + q0.y) + (q0.z + q0.w) + (q1.x + q1.y) + (q1.z + q1.w));
              if ((lane & 7) == 0) ((float*)(ws + WS_RK))[(size_t)t * 8 + (lane >> 3)] = rk; }
            { const f32x4 de0 = *(const LAS f32x4*)(DEC + tok * 512 + c8), de1 = *(const LAS f32x4*)(DEC + tok * 512 + c8 + 4);
              const f32x4 gg0 = *(const LAS f32x4*)(GG + tok * 512 + c8), gg1 = *(const LAS f32x4*)(GG + tok * 512 + c8 + 4);
              *(u32x4*)(SG + o) = pk8(gg0, gg1); *(f32x4*)(SW + o) = de0; *(f32x4*)(SW + o + 4) = de1; }
            { const u32x4 uq = *(const u32x4*)(pr + DQ0), ukd = *(const u32x4*)(pr + DK0);
              const f32x4 q0 = cvlo(uq), q1 = cvhi(uq), d0 = cvlo(ukd), d1 = cvhi(ukd);
              float qs = (q0.x * q0.x + q0.y * q0.y) + (q0.z * q0.z + q0.w * q0.w) + (q1.x * q1.x + q1.y * q1.y) + (q1.z * q1.z + q1.w * q1.w);
              float ks = (d0.x * d0.x + d0.y * d0.y) + (d0.z * d0.z + d0.w * d0.w) + (d1.x * d1.x + d1.y * d1.y) + (d1.z * d1.z + d1.w * d1.w);
              qs = red8(qs); ks = red8(ks);
              const float qi = (1.0f / sqrtf(qs * (1.0f / 64.0f) + 1e-5f)) * (0.125f * LOG2E), ki = 1.0f / sqrtf(ks * (1.0f / 64.0f) + 1e-5f);
              const f32x4 g0 = *(const f32x4*)(qn_g + (c8 & 63)), g1 = *(const f32x4*)(qn_g + (c8 & 63) + 4), h0 = *(const f32x4*)(kn_g + (c8 & 63)), h1 = *(const f32x4*)(kn_g + (c8 & 63) + 4);
              *(u32x4*)(QN + o) = pk8(q0 * qi * g0, q1 * qi * g1);
              const size_t ko = ((((size_t)((t >> 12) * 8 + (c8 >> 6)) * 64 + ((t & (SEQ - 1)) >> 6)) * 8 + ((c8 & 63) >> 3)) * 64 + (t & 63)) * 8;
              *(u32x4*)(KN + ko) = pk8(d0 * ki * h0, d1 * ki * h1); }
        }
        __syncthreads();
    }
}

namespace ck {
constexpr int PS = 136;
constexpr int O_BT = 0, O_KT = 8704, O_AP = 17408, O_RT = 26112;
constexpr int O_AT = 34816, O_BH = 43008, O_KH = 51200, O_VV = 59392, O_TN = 67584, O_A2 = 75776, O_V2 = 83968;
constexpr int O_L = 92160, LSTR = 68;
constexpr int O_TOT = 109568, O_GC = 111616;
__device__ __forceinline__ int crow(int r, int hi) { return (r & 3) + 8 * (r >> 2) + 4 * hi; }
__device__ __forceinline__ int voff(int row, int col) { return ((col >> 5) * 4 + (row >> 4)) * 1024 + (row & 15) * 64 + (col & 31) * 2; }
__device__ __forceinline__ s16x4 vtr(const LAS unsigned char* p) { return __builtin_bit_cast(s16x4, __builtin_amdgcn_ds_read_tr16_b64_v4i16((LAS s16x4*)p)); }
__device__ __forceinline__ bf16x8 fragP(const LAS unsigned char* M, int row, int k0, int hi) {
    const LAS unsigned char* p = M + row * PS + (k0 + 4 * hi) * 2; const s16x4 lo = *(const LAS s16x4*)p, h = *(const LAS s16x4*)(p + 16);
    return (bf16x8){lo[0], lo[1], lo[2], lo[3], h[0], h[1], h[2], h[3]}; }
__device__ __forceinline__ bf16x8 fragT(const LAS unsigned char* M, int k0, int colblk, int lane, int hi) {
    const LAS unsigned char* p = M + (colblk * 4 + (k0 >> 4)) * 1024 + ((lane >> 4) & 1) * 32 + (lane & 3) * 8 + (4 * hi + ((lane & 15) >> 2)) * 64;
    const s16x4 lo = vtr(p), h = vtr(p + 512); return (bf16x8){lo[0], lo[1], lo[2], lo[3], h[0], h[1], h[2], h[3]}; }
__device__ __forceinline__ bf16x8 packR(const f32x16& x, int s) {
    u32x4 w; w.x = pk2(x[8 * s], x[8 * s + 1]); w.y = pk2(x[8 * s + 2], x[8 * s + 3]); w.z = pk2(x[8 * s + 4], x[8 * s + 5]); w.w = pk2(x[8 * s + 6], x[8 * s + 7]); return __builtin_bit_cast(bf16x8, w); }
#define CK_MFMA(a, b, c) __builtin_amdgcn_mfma_f32_32x32x16_bf16(a, b, c, 0, 0, 0)
__device__ __forceinline__ f32x16 score(const LAS unsigned char* Am, const LAS unsigned char* Bm, int sblk, int tblk, int mode, int r32, int hi) {
    f32x16 x = f32x16{};
#pragma unroll
    for (int ks = 0; ks < 4; ++ks) x = CK_MFMA(fragP(Am, sblk * 32 + r32, 16 * ks, hi), fragP(Bm, tblk * 32 + r32, 16 * ks, hi), x);
    if (mode) {
        const int t = tblk * 32 + r32;
#pragma unroll
        for (int r = 0; r < 16; ++r) { const int s = sblk * 32 + crow(r, hi); if (mode == 1 ? !(s < t) : !(s <= t)) x[r] = 0.f; }
    }
    return x;
}
__device__ __forceinline__ void storeT_V(LAS unsigned char* M, const f32x16& x, int rb, int c, int hi) {
#pragma unroll
    for (int q = 0; q < 4; ++q) { u32x2 w; w.x = pk2(x[4 * q], x[4 * q + 1]); w.y = pk2(x[4 * q + 2], x[4 * q + 3]); *(LAS u32x2*)(M + voff(c, rb * 32 + 8 * q + 4 * hi)) = w; }
}
__device__ __forceinline__ void storeT_S(LAS unsigned char* M, const f32x16& x, int rb, int c, int hi) {
#pragma unroll
    for (int q = 0; q < 4; ++q) { u32x2 w; w.x = pk2(x[4 * q], x[4 * q + 1]); w.y = pk2(x[4 * q + 2], x[4 * q + 3]); *(LAS u32x2*)(M + c * PS + (rb * 32 + 8 * q + 4 * hi) * 2) = w; }
}

__device__ __forceinline__ void chunk_item(LAS unsigned char* lds, const Args& a, int item) {
    const int tid = threadIdx.x; int lane = tid & 63; const int wave = __builtin_amdgcn_readfirstlane(tid >> 6);
#define CK_FRESH() asm volatile("" : "+v"(lane)); r32 = lane & 31; hi = lane >> 5
    int r32, hi; CK_FRESH();
    unsigned char* ws = a.ws;
    const bf16_t* SR = (const bf16_t*)(ws + WS_SR); const bf16_t* SK = (const bf16_t*)(ws + WS_SK); const bf16_t* SV = (const bf16_t*)(ws + WS_SV);
    const bf16_t* SA = (const bf16_t*)(ws + WS_SA); const bf16_t* SB = (const bf16_t*)(ws + WS_SB); const float* SW = (const float*)(ws + WS_SW);
    bf16_t* CG = (bf16_t*)(ws + WS_CG) + (size_t)item * 4096; bf16_t* CH = (bf16_t*)(ws + WS_CH) + (size_t)item * 4096;
    bf16_t* CR2 = (bf16_t*)(ws + WS_CR2) + (size_t)item * 4096; bf16_t* CY0 = (bf16_t*)(ws + WS_CY0) + (size_t)item * 4096;
    const int bh = item >> 6, c = item & 63, b = bh >> 3, h = bh & 7, tokc = b * SEQ + c * 64, col0 = h * 64;
    LAS unsigned char* BT = lds + O_BT; LAS unsigned char* KT = lds + O_KT; LAS unsigned char* AP = lds + O_AP; LAS unsigned char* RT = lds + O_RT;
    LAS unsigned char* AT = lds + O_AT; LAS unsigned char* BH = lds + O_BH; LAS unsigned char* KH = lds + O_KH; LAS unsigned char* VV = lds + O_VV;
    LAS unsigned char* TN = lds + O_TN; LAS unsigned char* A2M = lds + O_A2; LAS unsigned char* V2M = lds + O_V2;
    LAS float* L = (LAS float*)(lds + O_L); LAS float* TOT = (LAS float*)(lds + O_TOT); LAS float* GC = (LAS float*)(lds + O_GC);
    {
        const int tl = tid >> 3, c8 = (tid & 7) * 8; const size_t o = (size_t)(tokc + tl) * CW + col0 + c8;
        const f32x4 w0 = *(const f32x4*)(SW + o), w1 = *(const f32x4*)(SW + o + 4);
        const u32x4 ua = *(const u32x4*)(SA + o), ub = *(const u32x4*)(SB + o), uk = *(const u32x4*)(SK + o), ur = *(const u32x4*)(SR + o), uv = *(const u32x4*)(SV + o);
        float p[8] = {w0.x, w0.y, w0.z, w0.w, w1.x, w1.y, w1.z, w1.w}, wv[8];
#pragma unroll
        for (int j = 0; j < 8; ++j) wv[j] = p[j];
#pragma unroll
        for (int d = 8; d < 64; d <<= 1) {
#pragma unroll
            for (int j = 0; j < 8; ++j) { const float q = __shfl_up(p[j], d); if (lane >= d) p[j] *= q; }
        }
        if ((lane >> 3) == 7) { *(LAS f32x4*)(TOT + wave * 64 + c8) = (f32x4){p[0], p[1], p[2], p[3]}; *(LAS f32x4*)(TOT + wave * 64 + c8 + 4) = (f32x4){p[4], p[5], p[6], p[7]}; }
        __syncthreads();
        float pre[8], gC[8];
#pragma unroll
        for (int j = 0; j < 8; ++j) { pre[j] = 1.f; gC[j] = 1.f; }
#pragma unroll
        for (int w2 = 0; w2 < 8; ++w2) { const f32x4 t0 = *(const LAS f32x4*)(TOT + w2 * 64 + c8), t1 = *(const LAS f32x4*)(TOT + w2 * 64 + c8 + 4);
            const float tv[8] = {t0.x, t0.y, t0.z, t0.w, t1.x, t1.y, t1.z, t1.w};
#pragma unroll
            for (int j = 0; j < 8; ++j) { if (w2 < wave) pre[j] *= tv[j]; gC[j] *= tv[j]; } }
        if (tid < 8) { *(LAS f32x4*)(GC + c8) = (f32x4){gC[0], gC[1], gC[2], gC[3]}; *(LAS f32x4*)(GC + c8 + 4) = (f32x4){gC[4], gC[5], gC[6], gC[7]}; }
        const f32x4 a0 = cvlo(ua), a1 = cvhi(ua), b0 = cvlo(ub), b1 = cvhi(ub), k0 = cvlo(uk), k1 = cvhi(uk), r0 = cvlo(ur), r1 = cvhi(ur);
        const float av[8] = {a0.x, a0.y, a0.z, a0.w, a1.x, a1.y, a1.z, a1.w}, bv[8] = {b0.x, b0.y, b0.z, b0.w, b1.x, b1.y, b1.z, b1.w};
        const float kv[8] = {k0.x, k0.y, k0.z, k0.w, k1.x, k1.y, k1.z, k1.w}, rv[8] = {r0.x, r0.y, r0.z, r0.w, r1.x, r1.y, r1.z, r1.w};
        float at[8], rt[8], bt[8], kt[8], bh[8], kh[8];
#pragma unroll
        for (int j = 0; j < 8; ++j) { const float g = pre[j] * p[j], ig = __builtin_amdgcn_rcpf(g), gp = g * __builtin_amdgcn_rcpf(wv[j]);
            at[j] = av[j] * gp; rt[j] = rv[j] * g; bt[j] = bv[j] * ig; kt[j] = kv[j] * ig; bh[j] = bt[j] * gC[j]; kh[j] = kt[j] * gC[j]; }
#define CK_PK8(v) ((u32x4){pk2(v[0], v[1]), pk2(v[2], v[3]), pk2(v[4], v[5]), pk2(v[6], v[7])})
#define CK_ST_P(M, val_) do { LAS unsigned char* d_ = (M) + tl * PS + c8 * 2; const u32x4 q_ = (val_); *(LAS u32x2*)d_ = (u32x2){q_[0], q_[1]}; *(LAS u32x2*)(d_ + 8) = (u32x2){q_[2], q_[3]}; } while (0)
        const u32x4 wa = CK_PK8(at), wr = CK_PK8(rt), wb = CK_PK8(bt), wk = CK_PK8(kt), wbh = CK_PK8(bh), wkh = CK_PK8(kh);
        CK_ST_P(AP, wa); CK_ST_P(RT, wr); CK_ST_P(BT, wb); CK_ST_P(KT, wk);
        *(LAS u32x4*)(AT + voff(tl, c8)) = wa; *(LAS u32x4*)(BH + voff(tl, c8)) = wbh; *(LAS u32x4*)(KH + voff(tl, c8)) = wkh; *(LAS u32x4*)(VV + voff(tl, c8)) = uv;
#undef CK_PK8
#undef CK_ST_P
    }
    __syncthreads();
    CK_FRESH();
    f32x16 pa = f32x16{}, pb = f32x16{}, pc = f32x16{}, pd = f32x16{};
#define w1a pa
#define w1b pb
#define xb0 pa
#define xb1 pb
#define y0a pc
#define y0b pd
    if (wave < 2) {
        for (int k = 0; k < (wave == 0 ? 2 : 1); ++k) {
            const int sblk = wave == 0 ? k : 0, tblk = wave == 0 ? k : 1;
            const f32x16 x = score(BT, AP, sblk, tblk, wave == 0 ? 1 : 0, r32, hi);
            const int t = tblk * 32 + r32;
#pragma unroll
            for (int r = 0; r < 16; ++r) L[(sblk * 32 + crow(r, hi)) * LSTR + t] = x[r];
        }
    }
    __syncthreads();
    CK_FRESH();
    if (wave == 6) {
        float x[32];
#pragma unroll
        for (int t = 0; t < 32; ++t) x[t] = (r32 == t) ? 1.f : 0.f;
        const LAS float* Nr = L + (32 * hi) * LSTR + 32 * hi;
#pragma unroll
        for (int sidx = 0; sidx < 31; ++sidx) {
#pragma unroll
            for (int g4 = (sidx + 1) / 4; g4 < 8; ++g4) {
                const f32x4 nv = *(const LAS f32x4*)(Nr + sidx * LSTR + 4 * g4);
                if (4 * g4 + 0 > sidx) x[4 * g4 + 0] += nv.x * x[sidx];
                if (4 * g4 + 1 > sidx) x[4 * g4 + 1] += nv.y * x[sidx];
                if (4 * g4 + 2 > sidx) x[4 * g4 + 2] += nv.z * x[sidx];
                if (4 * g4 + 3 > sidx) x[4 * g4 + 3] += nv.w * x[sidx];
            }
            if ((sidx & 3) == 3) __builtin_amdgcn_sched_barrier(0);
        }
        const int cc = 32 * hi + r32;
#pragma unroll
        for (int t0 = 0; t0 < 32; t0 += 8) { u32x4 w; w.x = pk2(x[t0], x[t0 + 1]); w.y = pk2(x[t0 + 2], x[t0 + 3]); w.z = pk2(x[t0 + 4], x[t0 + 5]); w.w = pk2(x[t0 + 6], x[t0 + 7]);
            *(LAS u32x4*)(TN + voff(cc, 32 * hi + t0)) = w; }
        f32x16 m = f32x16{};
#pragma unroll
        for (int s = 0; s < 2; ++s) {
            const LAS float* lp = L + (16 * s + 4 * hi) * LSTR + 32 + r32;
            u32x4 aw; aw.x = pk2(lp[0], lp[LSTR]); aw.y = pk2(lp[2 * LSTR], lp[3 * LSTR]); aw.z = pk2(lp[8 * LSTR], lp[9 * LSTR]); aw.w = pk2(lp[10 * LSTR], lp[11 * LSTR]);
            const s16x4 b0 = *(const LAS s16x4*)(TN + voff(r32, 16 * s + 4 * hi)), b1 = *(const LAS s16x4*)(TN + voff(r32, 16 * s + 8 + 4 * hi));
            m = CK_MFMA(__builtin_bit_cast(bf16x8, aw), ((bf16x8){b0[0], b0[1], b0[2], b0[3], b1[0], b1[1], b1[2], b1[3]}), m);
        }
        f32x16 t21 = f32x16{};
#pragma unroll
        for (int s = 0; s < 2; ++s) t21 = CK_MFMA(fragT(TN, 32 + 16 * s, 1, lane, hi), packR(m, s), t21);
        storeT_V(TN, t21, 1, r32, hi);
    } else if (wave < 4) {
        const int dvb = wave - 2;
        const f32x16 x00 = score(KT, AP, 0, 0, 1, r32, hi), x01 = score(KT, AP, 0, 1, 0, r32, hi), x11 = score(KT, AP, 1, 1, 1, r32, hi);
#pragma unroll
        for (int s = 0; s < 2; ++s) {
            const bf16x8 v0 = fragT(VV, 16 * s, dvb, lane, hi), v1 = fragT(VV, 32 + 16 * s, dvb, lane, hi);
            w1a = CK_MFMA(packR(x00, s), v0, w1a);
            w1b = CK_MFMA(packR(x01, s), v0, w1b);
            w1b = CK_MFMA(packR(x11, s), v1, w1b);
        }
    } else if (wave < 6) {
        const int tb = wave - 4;
        f32x16 xk0, xk1 = f32x16{};
        if (tb == 0) { xk0 = score(KT, RT, 0, 0, 2, r32, hi); xb0 = score(BT, RT, 0, 0, 2, r32, hi); }
        else { xk0 = score(KT, RT, 0, 1, 0, r32, hi); xk1 = score(KT, RT, 1, 1, 2, r32, hi); xb0 = score(BT, RT, 0, 1, 0, r32, hi); xb1 = score(BT, RT, 1, 1, 2, r32, hi); }
#pragma unroll
        for (int s = 0; s < 2; ++s) {
            y0a = CK_MFMA(fragT(VV, 16 * s, 0, lane, hi), packR(xk0, s), y0a);
            y0b = CK_MFMA(fragT(VV, 16 * s, 1, lane, hi), packR(xk0, s), y0b);
            if (tb == 1) { y0a = CK_MFMA(fragT(VV, 32 + 16 * s, 0, lane, hi), packR(xk1, s), y0a); y0b = CK_MFMA(fragT(VV, 32 + 16 * s, 1, lane, hi), packR(xk1, s), y0b); }
        }
    }
    __syncthreads();
    CK_FRESH();
    if (wave < 2) {
        const int cb = wave; f32x16 a0 = f32x16{}, a1 = f32x16{};
#pragma unroll
        for (int ks = 0; ks < 4; ++ks) {
            const bf16x8 af = fragT(AT, 16 * ks, cb, lane, hi);
            if (ks < 2) a0 = CK_MFMA(af, fragT(TN, 16 * ks, 0, lane, hi), a0);
            a1 = CK_MFMA(af, fragT(TN, 16 * ks, 1, lane, hi), a1);
        }
        storeT_V(A2M, a0, cb, r32, hi); storeT_V(A2M, a1, cb, 32 + r32, hi);
    } else if (wave < 4) {
        const int dvb = wave - 2; f32x16 v0 = f32x16{}, v1 = f32x16{};
#pragma unroll
        for (int s = 0; s < 2; ++s) {
            v0 = CK_MFMA(packR(w1a, s), fragT(TN, 16 * s, 0, lane, hi), v0);
            v1 = CK_MFMA(packR(w1a, s), fragT(TN, 16 * s, 1, lane, hi), v1);
            v1 = CK_MFMA(packR(w1b, s), fragT(TN, 32 + 16 * s, 1, lane, hi), v1);
        }
        storeT_V(V2M, v0, dvb, r32, hi); storeT_V(V2M, v1, dvb, 32 + r32, hi);
    }
    __syncthreads();
    CK_FRESH();
    if (wave >= 4 && wave < 6) {
        const int tb = wave - 4, t = tb * 32 + r32;
        f32x16 r0 = f32x16{}, r1 = f32x16{};
#pragma unroll
        for (int s = 0; s < 2; ++s) {
            const bf16x8 p0 = packR(xb0, s);
            r0 = CK_MFMA(fragT(A2M, 16 * s, 0, lane, hi), p0, r0); r1 = CK_MFMA(fragT(A2M, 16 * s, 1, lane, hi), p0, r1);
            y0a = CK_MFMA(fragT(V2M, 16 * s, 0, lane, hi), p0, y0a); y0b = CK_MFMA(fragT(V2M, 16 * s, 1, lane, hi), p0, y0b);
            if (tb == 1) { const bf16x8 p1 = packR(xb1, s);
                r0 = CK_MFMA(fragT(A2M, 32 + 16 * s, 0, lane, hi), p1, r0); r1 = CK_MFMA(fragT(A2M, 32 + 16 * s, 1, lane, hi), p1, r1);
                y0a = CK_MFMA(fragT(V2M, 32 + 16 * s, 0, lane, hi), p1, y0a); y0b = CK_MFMA(fragT(V2M, 32 + 16 * s, 1, lane, hi), p1, y0b); }
        }
#pragma unroll
        for (int q = 0; q < 4; ++q) {
            const u32x2 u0 = *(const LAS u32x2*)(RT + t * PS + (8 * q + 4 * hi) * 2), u1 = *(const LAS u32x2*)(RT + t * PS + (32 + 8 * q + 4 * hi) * 2);
            r0[4 * q] += bflo(u0.x); r0[4 * q + 1] += bfhi(u0.x); r0[4 * q + 2] += bflo(u0.y); r0[4 * q + 3] += bfhi(u0.y);
            r1[4 * q] += bflo(u1.x); r1[4 * q + 1] += bfhi(u1.x); r1[4 * q + 2] += bflo(u1.y); r1[4 * q + 3] += bfhi(u1.y);
        }
        storeT_S(BT, r0, 0, t, hi); storeT_S(BT, r1, 1, t, hi);
        storeT_S(KT, y0a, 0, t, hi); storeT_S(KT, y0b, 1, t, hi);
    } else if (wave < 2) {
        const int ib = wave, i = ib * 32 + r32; const float gci = GC[i];
        f32x16 g0 = f32x16{}, g1 = f32x16{};
#pragma unroll
        for (int ks = 0; ks < 4; ++ks) { const bf16x8 bf_ = fragT(BH, 16 * ks, ib, lane, hi);
            g0 = CK_MFMA(fragT(A2M, 16 * ks, 0, lane, hi), bf_, g0); g1 = CK_MFMA(fragT(A2M, 16 * ks, 1, lane, hi), bf_, g1); }
#pragma unroll
        for (int r = 0; r < 16; ++r) { if (crow(r, hi) == i) g0[r] += gci; if (32 + crow(r, hi) == i) g1[r] += gci; }
        storeT_S(AP, g0, 0, i, hi); storeT_S(AP, g1, 1, i, hi);
    } else {
        const int id = wave < 4 ? wave - 2 : wave - 4, ib = id >> 1, dvb = id & 1;
        f32x16 hh = f32x16{};
#pragma unroll
        for (int ks = 0; ks < 4; ++ks) {
            hh = CK_MFMA(fragT(BH, 16 * ks, ib, lane, hi), fragT(V2M, 16 * ks, dvb, lane, hi), hh);
            hh = CK_MFMA(fragT(KH, 16 * ks, ib, lane, hi), fragT(VV, 16 * ks, dvb, lane, hi), hh);
        }
        storeT_S((LAS unsigned char*)L, hh, ib, dvb * 32 + r32, hi);
    }
    __syncthreads();
    {
        const int row = tid >> 3, ch = tid & 7;
        const LAS unsigned char* s0 = BT + row * PS + ch * 16; const LAS unsigned char* s1 = KT + row * PS + ch * 16; const LAS unsigned char* s2 = AP + row * PS + ch * 16; const LAS unsigned char* s3 = (const LAS unsigned char*)L + row * PS + ch * 16;
        const u32x2 a0 = *(const LAS u32x2*)s0, a1 = *(const LAS u32x2*)(s0 + 8), b0 = *(const LAS u32x2*)s1, b1 = *(const LAS u32x2*)(s1 + 8);
        const u32x2 c0 = *(const LAS u32x2*)s2, c1 = *(const LAS u32x2*)(s2 + 8), d0 = *(const LAS u32x2*)s3, d1 = *(const LAS u32x2*)(s3 + 8);
        *(u32x4*)(CR2 + row * 64 + ch * 8) = (u32x4){a0.x, a0.y, a1.x, a1.y}; *(u32x4*)(CY0 + row * 64 + ch * 8) = (u32x4){b0.x, b0.y, b1.x, b1.y};
        *(u32x4*)(CG + row * 64 + ch * 8) = (u32x4){c0.x, c0.y, c1.x, c1.y}; *(u32x4*)(CH + row * 64 + ch * 8) = (u32x4){d0.x, d0.y, d1.x, d1.y};
    }
    asm volatile("s_waitcnt lgkmcnt(0)" ::: "memory"); __builtin_amdgcn_s_barrier();
#undef CK_FRESH
#undef w1a
#undef w1b
#undef xb0
#undef xb1
#undef y0a
#undef y0b
}
}

namespace ck {
constexpr int SQ_MAT = 8704, SQ_BUF = 6 * SQ_MAT;
constexpr int SQ_OUT = 2 * SQ_BUF;
__device__ __forceinline__ bf16x8 lfrag(const LAS unsigned char* M, int row, int k0, int hi) { return fragP(M, row, k0, hi); }
__device__ __forceinline__ void linit(f32x16& x, const LAS unsigned char* M, int row, int cblk, int hi) {
#pragma unroll
    for (int q = 0; q < 4; ++q) { const u32x2 u = *(const LAS u32x2*)(M + row * PS + (cblk * 32 + 8 * q + 4 * hi) * 2); x[4 * q] = bflo(u.x); x[4 * q + 1] = bfhi(u.x); x[4 * q + 2] = bflo(u.y); x[4 * q + 3] = bfhi(u.y); }
}
__device__ __forceinline__ void seq_head(LAS unsigned char* lds, const Args& a, int bh) {
    const int tid = threadIdx.x, lane = tid & 63, r32 = lane & 31, hi = lane >> 5; const int wave = __builtin_amdgcn_readfirstlane(tid >> 6);
    unsigned char* ws = a.ws;
    const bf16_t* SV = (const bf16_t*)(ws + WS_SV); const bf16_t* SG = (const bf16_t*)(ws + WS_SG); const float* RK = (const float*)(ws + WS_RK); bf16_t* YMIX = (bf16_t*)(ws + WS_YMIX);
    const int b = bh >> 3, h = bh & 7, col0 = h * 64;
    const float* lng = a.in[12] + col0; const float* lnb = a.in[13] + col0;
#define SQ_LOAD(ch) do { const size_t item_ = (size_t)bh * 64 + (ch); LAS unsigned char* bb_ = lds + ((ch) & 1) * SQ_BUF; const size_t t0_ = (size_t)b * SEQ + (ch) * 64; \
        for (int p_ = tid - 128; p_ < 3072; p_ += 384) { const int m_ = p_ >> 9, q_ = p_ & 511, row_ = q_ >> 3, c8_ = (q_ & 7) * 8; u32x4 v_; \
            if (m_ == 0) v_ = *(const u32x4*)((const bf16_t*)(ws + WS_CG) + item_ * 4096 + row_ * 64 + c8_); \
            else if (m_ == 1) v_ = *(const u32x4*)((const bf16_t*)(ws + WS_CH) + item_ * 4096 + row_ * 64 + c8_); \
            else if (m_ == 2) v_ = *(const u32x4*)((const bf16_t*)(ws + WS_CR2) + item_ * 4096 + row_ * 64 + c8_); \
            else if (m_ == 3) v_ = *(const u32x4*)((const bf16_t*)(ws + WS_CY0) + item_ * 4096 + row_ * 64 + c8_); \
            else if (m_ == 4) v_ = *(const u32x4*)(SV + (t0_ + row_) * CW + col0 + c8_); \
            else v_ = *(const u32x4*)(SG + (t0_ + row_) * CW + col0 + c8_); \
            LAS unsigned char* d_ = bb_ + m_ * SQ_MAT + row_ * PS + c8_ * 2; *(LAS u32x2*)d_ = (u32x2){v_.x, v_.y}; *(LAS u32x2*)(d_ + 8) = (u32x2){v_.z, v_.w}; } } while (0)
#define SQ_STORE(ch) do { const LAS unsigned char* ob_ = lds + SQ_OUT + ((ch) & 1) * SQ_MAT; const size_t t0_ = (size_t)b * SEQ + (ch) * 64; \
        for (int p_ = tid - 128; p_ < 512; p_ += 384) { const int row_ = p_ >> 3, c8_ = (p_ & 7) * 8; const LAS unsigned char* s_ = ob_ + row_ * PS + c8_ * 2; \
            const u32x2 lo_ = *(const LAS u32x2*)s_, hi_ = *(const LAS u32x2*)(s_ + 8); *(u32x4*)(YMIX + (t0_ + row_) * D + col0 + c8_) = (u32x4){lo_.x, lo_.y, hi_.x, hi_.y}; } } while (0)
    if (wave >= 2) SQ_LOAD(0);
    __syncthreads();
    f32x16 X00 = f32x16{}, X01 = f32x16{}, X10 = f32x16{}, X11 = f32x16{};
#pragma unroll 1
    for (int c = 0; c < 64; ++c) {
        if (wave >= 2) {
            if (c + 1 < 64) SQ_LOAD(c + 1);
            if (c > 0) SQ_STORE(c - 1);
        } else {
            const int tb = wave;
            const LAS unsigned char* bb = lds + (c & 1) * SQ_BUF;
            const LAS unsigned char* MG = bb; const LAS unsigned char* MH = bb + SQ_MAT; const LAS unsigned char* MR = bb + 2 * SQ_MAT; const LAS unsigned char* MY = bb + 3 * SQ_MAT;
            const LAS unsigned char* MV = bb + 4 * SQ_MAT; const LAS unsigned char* MGT = bb + 5 * SQ_MAT;
            LAS unsigned char* OB = lds + SQ_OUT + (c & 1) * SQ_MAT;
            const int tl = tb * 32 + r32; const size_t t = (size_t)b * SEQ + c * 64 + tl;
            const float rk = RK[t * 8 + h];
            f32x16 y0, y1; linit(y0, MY, tl, 0, hi); linit(y1, MY, tl, 1, hi);
#pragma unroll
            for (int s = 0; s < 2; ++s) {
                const bf16x8 rf0 = lfrag(MR, tl, 16 * s, hi), rf1 = lfrag(MR, tl, 32 + 16 * s, hi);
                y0 = CK_MFMA(packR(X00, s), rf0, y0); y0 = CK_MFMA(packR(X10, s), rf1, y0);
                y1 = CK_MFMA(packR(X01, s), rf0, y1); y1 = CK_MFMA(packR(X11, s), rf1, y1);
            }
#pragma unroll
            for (int db = 0; db < 2; ++db) {
                f32x16 Na, Nb; linit(Na, MH, db * 32 + r32, 0, hi); linit(Nb, MH, db * 32 + r32, 1, hi);
#pragma unroll
                for (int s = 0; s < 2; ++s) {
                    const bf16x8 g00 = lfrag(MG, r32, 16 * s, hi), g01 = lfrag(MG, r32, 32 + 16 * s, hi), g10 = lfrag(MG, 32 + r32, 16 * s, hi), g11 = lfrag(MG, 32 + r32, 32 + 16 * s, hi);
                    const bf16x8 p0 = packR(db ? X01 : X00, s), p1 = packR(db ? X11 : X10, s);
                    Na = CK_MFMA(g00, p0, Na); Na = CK_MFMA(g01, p1, Na);
                    Nb = CK_MFMA(g10, p0, Nb); Nb = CK_MFMA(g11, p1, Nb);
                }
                if (db == 0) { X00 = Na; X10 = Nb; } else { X01 = Na; X11 = Nb; }
            }
            float sm = 0.f;
#pragma unroll
            for (int r = 0; r < 16; ++r) sm += y0[r] + y1[r];
            sm += __shfl_xor(sm, 32);
            const float mean = sm * (1.0f / 64.0f);
            float sq = 0.f;
#pragma unroll
            for (int r = 0; r < 16; ++r) { const float d0 = y0[r] - mean, d1 = y1[r] - mean; sq += d0 * d0 + d1 * d1; }
            sq += __shfl_xor(sq, 32);
            const float rs = 1.0f / sqrtf(sq * (1.0f / 64.0f) + 64e-5f);
#pragma unroll
            for (int db = 0; db < 2; ++db)
#pragma unroll
                for (int q = 0; q < 4; ++q) {
                    const int dv = db * 32 + 8 * q + 4 * hi;
                    const f32x4 lg = *(const f32x4*)(lng + dv), lb = *(const f32x4*)(lnb + dv);
                    const u32x2 uv = *(const LAS u32x2*)(MV + tl * PS + dv * 2), ug = *(const LAS u32x2*)(MGT + tl * PS + dv * 2);
                    const f32x4 vv = {bflo(uv.x), bfhi(uv.x), bflo(uv.y), bfhi(uv.y)}, gg = {bflo(ug.x), bfhi(ug.x), bflo(ug.y), bfhi(ug.y)};
                    f32x4 yy; if (db == 0) yy = (f32x4){y0[4 * q], y0[4 * q + 1], y0[4 * q + 2], y0[4 * q + 3]}; else yy = (f32x4){y1[4 * q], y1[4 * q + 1], y1[4 * q + 2], y1[4 * q + 3]};
                    const f32x4 o = ((yy - mean) * rs * lg + lb + rk * vv) * gg;
                    u32x2 w; w.x = pk2(o.x, o.y); w.y = pk2(o.z, o.w);
                    *(LAS u32x2*)(OB + tl * PS + dv * 2) = w;
                }
        }
        __syncthreads();
    }
    if (wave >= 2) SQ_STORE(63);
#undef SQ_LOAD
#undef SQ_STORE
}
}

namespace att {
constexpr int SLOT = 32768, OFF_V = 16384;
constexpr int TBL_OFF = MISC_OFF + 1024;
constexpr int LW_OFF = MISC_OFF + 2048;
constexpr int CST_OFF = MISC_OFF + 3072;
__device__ __forceinline__ int crow(int r, int hi) { return (r & 3) + 8 * (r >> 2) + 4 * hi; }
__device__ __forceinline__ void glds16(const void* gsrc, unsigned lds_dst) { unsigned keep;
    asm volatile("s_mov_b32 %0, m0\n\ts_mov_b32 m0, %2\n\ts_nop 0\n\tglobal_load_lds_dwordx4 %1, off\n\ts_mov_b32 m0, %0" : "=&s"(keep) : "v"(gsrc), "s"(lds_dst) : "memory"); }
__device__ __forceinline__ s16x4 vtr(const LAS unsigned char* p) { return __builtin_bit_cast(s16x4, __builtin_amdgcn_ds_read_tr16_b64_v4i16((LAS s16x4*)p)); }

__device__ __forceinline__ void attn_unit(LAS unsigned char* lds, const Args& a, int b, int h, int qb, float negM, float lam) {
    const int tid = threadIdx.x, lane = tid & 63, r32 = lane & 31, hi = lane >> 5; const int wid = __builtin_amdgcn_readfirstlane(tid >> 6);
    const int c = wid >> 2, rg = wid & 3;
    unsigned char* ws = a.ws;
    const bf16_t* QN = (const bf16_t*)(ws + WS_QN); const bf16_t* KN = (const bf16_t*)(ws + WS_KN); const bf16_t* P = (const bf16_t*)(ws + WS_P); bf16_t* YMIX = (bf16_t*)(ws + WS_YMIX);
    const int q0 = qb * 128; const size_t rowbase = (size_t)b * SEQ;
    const int NT = 2 * qb + 2;
    LAS float* tbl = (LAS float*)(lds + TBL_OFF); LAS float* lw = (LAS float*)(lds + LW_OFF) + wid * 32;
    if (tid < 128) {
        const int n = tid; int bkt;
        if (n < 16) bkt = n; else { bkt = 16 + (int)(logf((float)n * (1.0f / 16.0f)) / 2.0794415416798357f * 16.0f); bkt = bkt > 31 ? 31 : bkt; }
        tbl[n] = (a.in[21][bkt * 4 + h] - a.in[21][31 * 4 + h]) * LOG2E;
    }
    const bf16_t* Qw = QN + (rowbase + q0 + rg * 32 + r32) * CW + h * 128 + c * 64;
    bf16x8 qr[4];
#pragma unroll
    for (int d0 = 0; d0 < 4; ++d0) qr[d0] = *(const bf16x8*)(Qw + d0 * 16 + hi * 8);
    const bf16_t* k0src = KN + ((((size_t)(b * 8 + h * 2) * 64) * 8 + wid) * 64 + lane) * 8;
    const bf16_t* k1src = k0src + (size_t)64 * 8 * 64 * 8;
    const int pv0 = 2 * wid, pv1 = 2 * wid + 1;
    const bf16_t* VTb = (const bf16_t*)(ws + WS_VT) + (size_t)(b * 4 + h) * 64 * 8192;
    const bf16_t* v0src = VTb + pv0 * 512 + lane * 8;
    const bf16_t* v1src = VTb + pv1 * 512 + lane * 8;
#define ATT_DMA(t, slot) do { const unsigned s_ = lds0 + (unsigned)(slot) * SLOT; \
        glds16(k0src + (size_t)(t) * 4096, (unsigned)__builtin_amdgcn_readfirstlane(s_ + wid * 1024)); \
        glds16(k1src + (size_t)(t) * 4096, (unsigned)__builtin_amdgcn_readfirstlane(s_ + 8192 + wid * 1024)); \
        glds16(v0src + (size_t)(t) * 8192, (unsigned)__builtin_amdgcn_readfirstlane(s_ + OFF_V + pv0 * 1024)); \
        glds16(v1src + (size_t)(t) * 8192, (unsigned)__builtin_amdgcn_readfirstlane(s_ + OFF_V + pv1 * 1024)); } while (0)
#define ATT_SBAR() __builtin_amdgcn_sched_barrier(0)
    const unsigned lds0 = (unsigned)(uintptr_t)lds;
    f32x16 o[4];
#pragma unroll
    for (int d0 = 0; d0 < 4; ++d0) o[d0] = f32x16{};
    float lsum = 0.f;
    const bool shift = negM < -60.0f;
    const int qmin = q0 + 32 * rg, qpos = qmin + r32;
    ATT_DMA(0, 0);
    asm volatile("s_waitcnt vmcnt(0)" ::: "memory");
    __syncthreads();
    for (int t = 0; t < NT; ++t) {
        if (t + 1 < NT) ATT_DMA(t + 1, (t + 1) & 1);
        const int kmin = 64 * t;
        if (kmin <= qmin + 31) {
            const LAS unsigned char* slot = lds + (t & 1) * SLOT;
            const LAS unsigned char* kb = slot + c * 8192 + hi * 1024 + r32 * 16;
            const LAS unsigned char* vb = slot + OFF_V + ((lane >> 4) & 1) * 32 + (lane & 3) * 8 + (4 * hi + ((lane & 15) >> 2)) * 64;
            bf16x8 kf[8];
#pragma unroll
            for (int d0 = 0; d0 < 4; ++d0) { kf[2 * d0] = *(const LAS bf16x8*)(kb + d0 * 2048); kf[2 * d0 + 1] = *(const LAS bf16x8*)(kb + d0 * 2048 + 512); }
            s16x4 va[16], vc[16];
#pragma unroll
            for (int i = 0; i < 8; ++i) { va[2 * i] = vtr(vb + (i >> 2) * 4096 + (i & 3) * 1024); va[2 * i + 1] = vtr(vb + (i >> 2) * 4096 + (i & 3) * 1024 + 512); }
            ATT_SBAR();
            f32x16 p0, p1;
            p0 = __builtin_amdgcn_mfma_f32_32x32x16_bf16(kf[0], qr[0], f32x16{}, 0, 0, 0); p1 = __builtin_amdgcn_mfma_f32_32x32x16_bf16(kf[1], qr[0], f32x16{}, 0, 0, 0);
#pragma unroll
            for (int d0 = 1; d0 < 4; ++d0) { p0 = __builtin_amdgcn_mfma_f32_32x32x16_bf16(kf[2 * d0], qr[d0], p0, 0, 0, 0); p1 = __builtin_amdgcn_mfma_f32_32x32x16_bf16(kf[2 * d0 + 1], qr[d0], p1, 0, 0, 0); }
            ATT_SBAR();
            if (qmin - (kmin + 63) < 113) {
#pragma unroll
                for (int r = 0; r < 16; ++r) {
                    const int d0_ = qpos - (kmin + crow(r, hi)); const int d1_ = d0_ - 32;
                    const float t0 = tbl[d0_ < 0 ? 0 : (d0_ > 127 ? 127 : d0_)], t1 = tbl[d1_ < 0 ? 0 : (d1_ > 127 ? 127 : d1_)];
                    p0[r] = d0_ < 0 ? -INFINITY : p0[r] + t0; p1[r] = d1_ < 0 ? -INFINITY : p1[r] + t1;
                }
            }
            if (shift) {
#pragma unroll
                for (int r = 0; r < 16; ++r) { p0[r] += negM; p1[r] += negM; }
            }
            float sacc = 0.f;
#pragma unroll
            for (int r = 0; r < 16; ++r) { p0[r] = __builtin_amdgcn_exp2f(p0[r]); p1[r] = __builtin_amdgcn_exp2f(p1[r]); sacc += p0[r] + p1[r]; }
            lsum += sacc;
            u32x4 pw[4];
#pragma unroll
            for (int i = 0; i < 4; ++i) { pw[0][i] = pk2(p0[2 * i], p0[2 * i + 1]); pw[1][i] = pk2(p0[8 + 2 * i], p0[8 + 2 * i + 1]); pw[2][i] = pk2(p1[2 * i], p1[2 * i + 1]); pw[3][i] = pk2(p1[8 + 2 * i], p1[8 + 2 * i + 1]); }
            ATT_SBAR();
#pragma unroll
            for (int i = 0; i < 8; ++i) { vc[2 * i] = vtr(vb + (2 + (i >> 2)) * 4096 + (i & 3) * 1024); vc[2 * i + 1] = vtr(vb + (2 + (i >> 2)) * 4096 + (i & 3) * 1024 + 512); }
#pragma unroll
            for (int i = 0; i < 8; ++i) {
                const bf16x8 vf = (bf16x8){va[2 * i][0], va[2 * i][1], va[2 * i][2], va[2 * i][3], va[2 * i + 1][0], va[2 * i + 1][1], va[2 * i + 1][2], va[2 * i + 1][3]};
                o[i >> 2] = __builtin_amdgcn_mfma_f32_32x32x16_bf16(__builtin_bit_cast(bf16x8, pw[i & 3]), vf, o[i >> 2], 0, 0, 0);
            }
#pragma unroll
            for (int i = 0; i < 8; ++i) {
                const bf16x8 vf = (bf16x8){vc[2 * i][0], vc[2 * i][1], vc[2 * i][2], vc[2 * i][3], vc[2 * i + 1][0], vc[2 * i + 1][1], vc[2 * i + 1][2], vc[2 * i + 1][3]};
                o[2 + (i >> 2)] = __builtin_amdgcn_mfma_f32_32x32x16_bf16(__builtin_bit_cast(bf16x8, pw[i & 3]), vf, o[2 + (i >> 2)], 0, 0, 0);
            }
        }
        asm volatile("s_waitcnt vmcnt(0)" ::: "memory");
        __syncthreads();
    }
#undef ATT_DMA
#undef ATT_SBAR
    lsum += __shfl_xor(lsum, 32);
    if (hi == 0) lw[r32] = 1.0f / lsum;
    asm volatile("s_waitcnt lgkmcnt(0)" ::: "memory");
    LAS float* stg = (LAS float*)(lds + wid * 16384);
#pragma unroll
    for (int r = 0; r < 16; ++r) { const int orow = crow(r, hi); const float il = lw[orow];
#pragma unroll
        for (int d0 = 0; d0 < 4; ++d0) stg[orow * 128 + d0 * 32 + r32] = o[d0][r] * il; }
    __syncthreads();
    {
        const int row = tid >> 2, part = tid & 3, rgp = row >> 5, rr = row & 31;
        const LAS float* s1 = (const LAS float*)(lds + rgp * 16384) + rr * 128 + part * 32;
        const LAS float* s2 = (const LAS float*)(lds + (4 + rgp) * 16384) + rr * 128 + part * 32;
        float dv[32]; float ss = 0.f;
#pragma unroll
        for (int i = 0; i < 8; ++i) { const f32x4 x1 = *(const LAS f32x4*)(s1 + 4 * i), x2 = *(const LAS f32x4*)(s2 + 4 * i);
#pragma unroll
            for (int j = 0; j < 4; ++j) { const float dd = x1[j] - lam * x2[j]; dv[4 * i + j] = dd; ss += dd * dd; } }
        ss = red4(ss);
        const float sc = (1.0f / sqrtf(ss * (1.0f / 128.0f) + 1e-5f)) * 0.8f;
        const float* sg = a.in[20] + part * 32;
        bf16_t* op = YMIX + (rowbase + q0 + row) * D + CW + h * 128 + part * 32;
#pragma unroll
        for (int i = 0; i < 4; ++i) { u32x4 w;
            w.x = pk2(dv[8 * i] * sc * sg[8 * i], dv[8 * i + 1] * sc * sg[8 * i + 1]); w.y = pk2(dv[8 * i + 2] * sc * sg[8 * i + 2], dv[8 * i + 3] * sc * sg[8 * i + 3]);
            w.z = pk2(dv[8 * i + 4] * sc * sg[8 * i + 4], dv[8 * i + 5] * sc * sg[8 * i + 5]); w.w = pk2(dv[8 * i + 6] * sc * sg[8 * i + 6], dv[8 * i + 7] * sc * sg[8 * i + 7]);
            *(u32x4*)(op + 8 * i) = w; }
    }
    __syncthreads();
}

__device__ __forceinline__ void attn_phase(LAS unsigned char* lds, const Args& a, unsigned* ctl) {
    const int tid = threadIdx.x;
    LAS float* cst = (LAS float*)(lds + CST_OFF);
    if (tid < 64) {
        const float gq = fabsf(a.in[14][tid]), gk = fabsf(a.in[15][tid]);
        float mq = gq, mk = gk;
#pragma unroll
        for (int o = 1; o < 64; o <<= 1) { mq = fmaxf(mq, __shfl_xor(mq, o)); mk = fmaxf(mk, __shfl_xor(mk, o)); }
        const float d1 = wave_sum(a.in[16][tid] * a.in[17][tid]), d2 = wave_sum(a.in[18][tid] * a.in[19][tid]);
        float mb = 0.f;
        if (tid < 32) { for (int hh = 0; hh < 4; ++hh) mb = fmaxf(mb, (a.in[21][tid * 4 + hh] - a.in[21][31 * 4 + hh]) * LOG2E); }
#pragma unroll
        for (int o = 1; o < 64; o <<= 1) mb = fmaxf(mb, __shfl_xor(mb, o));
        if (tid == 0) { cst[0] = -(8.0f * LOG2E * mq * mk * 1.02f + mb); cst[1] = __expf(d1) - __expf(d2) + 0.2f; }
    }
    __syncthreads();
    const float negM = cst[0], lam = cst[1];
    LAS int* ubox = (LAS int*)(lds + CST_OFF + 16);
    for (;;) {
        if (tid == 0) ubox[0] = (int)atomicAdd(ctl + CW_ATTQ, 1u);
        __syncthreads();
        const int u = ubox[0];
        __syncthreads();
        if (u >= 1024) break;
        const int qb = 31 - (u >> 5), bhh = u & 31;
        attn_unit(lds, a, bhh >> 2, bhh & 3, qb, negM, lam);
    }
}
}

__device__ __forceinline__ void p5_router(LAS unsigned char* lds, const Args& a, unsigned* ctl) {
    const int tid = threadIdx.x, lane = tid & 63, r32 = lane & 31, hi = lane >> 5; const int wave = __builtin_amdgcn_readfirstlane(tid >> 6);
    unsigned char* ws = a.ws;
    const bf16_t* x1 = (const bf16_t*)(ws + WS_X1B); const float* g2 = a.in[23]; const float* rw = a.in[24]; const float* rb = a.in[25];
    unsigned char* H2 = ws + WS_H2; int* EIDX = (int*)(ws + WS_EIDX); float* GATE = (float*)(ws + WS_GATE); int* POS = (int*)(ws + WS_POS);
    LAS unsigned char* WH = lds; LAS unsigned char* WL = lds + 65536;
    LAS int* cnt = (LAS int*)(lds + MISC_OFF + 1024);
    LAS int* basel = (LAS int*)(lds + MISC_OFF + 1024 + 128);
    LAS int* el = (LAS int*)(lds + MISC_OFF + 2048);
    LAS int* pl = (LAS int*)(lds + MISC_OFF + 4096);
    {
        const int e = tid & 31;
        for (int k = tid >> 5; k < 1024; k += 16) {
            const float v = rw[k * 32 + e] * g2[k]; const unsigned h = f2bf(v); const float vh = __builtin_bit_cast(float, h << 16); const unsigned l = f2bf(v - vh);
            const int off = e * 2048 + (((k >> 3) ^ (e & 15)) << 4) + (k & 7) * 2;
            *(LAS unsigned short*)(WH + off) = (unsigned short)h; *(LAS unsigned short*)(WL + off) = (unsigned short)l;
        }
    }
    if (tid < 32) cnt[tid] = 0;
    __syncthreads();
    const int TPB = T / (int)gridDim.x, tb0 = blockIdx.x * TPB;
    if (wave < 4) {
        const int tl = wave * 32 + r32, t = tb0 + tl;
        const bf16_t* xrow = x1 + (size_t)t * D + 8 * hi;
        const LAS unsigned char* wh = WH + r32 * 2048; const LAS unsigned char* wl = WL + r32 * 2048; const int sw = r32 & 15;
        f32x16 d = f32x16{}; float ssq = 0.f;
#pragma unroll 8
        for (int s = 0; s < 64; ++s) {
            const u32x4 xb = *(const u32x4*)(xrow + 16 * s);
            const int co = ((2 * s + hi) ^ sw) << 4;
            const bf16x8 ah = *(const LAS bf16x8*)(wh + co), al = *(const LAS bf16x8*)(wl + co);
            const bf16x8 bx = __builtin_bit_cast(bf16x8, xb);
            d = __builtin_amdgcn_mfma_f32_32x32x16_bf16(ah, bx, d, 0, 0, 0);
            d = __builtin_amdgcn_mfma_f32_32x32x16_bf16(al, bx, d, 0, 0, 0);
            const f32x4 x0 = cvlo(xb), x1v = cvhi(xb);
            ssq += (x0.x * x0.x + x0.y * x0.y) + (x0.z * x0.z + x0.w * x0.w) + (x1v.x * x1v.x + x1v.y * x1v.y) + (x1v.z * x1v.z + x1v.w * x1v.w);
        }
        ssq += __shfl_xor(ssq, 32);
        const float rstd = 1.0f / sqrtf(ssq * (1.0f / D) + 1e-5f);
        float lg[16];
#pragma unroll
        for (int r = 0; r < 16; ++r) lg[r] = d[r] * rstd + rb[8 * (r >> 2) + 4 * hi + (r & 3)];
        float tv[4]; int ti[4];
#pragma unroll
        for (int k = 0; k < 4; ++k) {
            float bv = -INFINITY; int bi = 0;
#pragma unroll
            for (int r = 0; r < 16; ++r) { const int e = 8 * (r >> 2) + 4 * hi + (r & 3); if (lg[r] > bv) { bv = lg[r]; bi = e; } }
            tv[k] = bv; ti[k] = bi;
#pragma unroll
            for (int r = 0; r < 16; ++r) { const int e = 8 * (r >> 2) + 4 * hi + (r & 3); if (e == bi) lg[r] = -INFINITY; }
        }
        float ov[4]; int oi[4];
#pragma unroll
        for (int k = 0; k < 4; ++k) { ov[k] = __shfl_xor(tv[k], 32); oi[k] = __shfl_xor(ti[k], 32); }
        float mv[4]; int mi[4];
        {
            int pa = 0, pb = 0;
#pragma unroll
            for (int k = 0; k < 4; ++k) {
                float ca = -INFINITY, cb = -INFINITY; int ia = 0, ib = 0;
#pragma unroll
                for (int q = 0; q < 4; ++q) { if (q == pa) { ca = tv[q]; ia = ti[q]; } if (q == pb) { cb = ov[q]; ib = oi[q]; } }
                const bool takeA = (ca > cb) || (ca == cb && ia < ib);
                mv[k] = takeA ? ca : cb; mi[k] = takeA ? ia : ib; pa += takeA ? 1 : 0; pb += takeA ? 0 : 1;
            }
        }
        const float e1 = __expf(mv[1] - mv[0]), e2 = __expf(mv[2] - mv[0]), e3 = __expf(mv[3] - mv[0]);
        const float inv = 1.0f / (1.0f + e1 + e2 + e3);
        if (hi == 0) {
            *(int4*)(EIDX + (size_t)t * 4) = make_int4(mi[0], mi[1], mi[2], mi[3]);
            *(float4*)(GATE + (size_t)t * 4) = make_float4(inv, e1 * inv, e2 * inv, e3 * inv);
#pragma unroll
            for (int k = 0; k < 4; ++k) { el[tl * 4 + k] = mi[k]; pl[tl * 4 + k] = atomicAdd((int*)(cnt + mi[k]), 1); }
        }
    } else {
        f32x4 gv[4];
#pragma unroll
        for (int j = 0; j < 4; ++j) gv[j] = *((const f32x4*)g2 + lane + 64 * j);
        for (int i = 0; i < 32; ++i) {
            const int t = tb0 + (wave - 4) * 32 + i;
            const u32x2* xr = (const u32x2*)(x1 + (size_t)t * D) + lane;
            f32x4 v[4]; float s = 0.f;
#pragma unroll
            for (int j = 0; j < 4; ++j) { const u32x2 xw = xr[64 * j]; v[j] = (f32x4){bflo(xw.x), bfhi(xw.x), bflo(xw.y), bfhi(xw.y)}; s += (v[j].x * v[j].x + v[j].y * v[j].y) + (v[j].z * v[j].z + v[j].w * v[j].w); }
            const float rstd = (1.0f / sqrtf(wave_sum(s) * (1.0f / D) + 1e-5f)) * F8_X_MUL;
            unsigned* o4 = (unsigned*)(H2 + (size_t)t * D) + lane;
#pragma unroll
            for (int j = 0; j < 4; ++j) { v[j] = v[j] * rstd * gv[j]; o4[64 * j] = pk4_fp8(v[j].x, v[j].y, v[j].z, v[j].w); }
        }
    }
    __syncthreads();
    if (tid < 32) basel[tid] = (int)atomicAdd(ctl + CW_CNT + tid, (unsigned)cnt[tid]);
    __syncthreads();
    for (int i = tid; i < TPB * 4; i += 512) POS[(size_t)tb0 * 4 + i] = pl[i] + basel[el[i]];
}

__device__ __forceinline__ void p6_dispatch(LAS unsigned char* lds, const Args& a, unsigned* ctl) {
    const int tid = threadIdx.x, lane = tid & 63, wave = __builtin_amdgcn_readfirstlane(tid >> 6);
    unsigned char* ws = a.ws;
    const int* EIDX = (const int*)(ws + WS_EIDX); const float* GATE = (const float*)(ws + WS_GATE); const int* POS = (const int*)(ws + WS_POS);
    int* DEST = (int*)(ws + WS_DEST); float* ROWGATE = (float*)(ws + WS_ROWGATE); int* TILEE = (int*)(ws + WS_TILEE); int* ROWTOK = (int*)(ws + WS_ROWTOK);
    LAS int* pstart = (LAS int*)(lds + MISC_OFF + 1024); LAS int* pcnt = pstart + 32;
    if (tid < NE) pcnt[tid] = (int)__hip_atomic_load(ctl + CW_CNT + tid, __ATOMIC_RELAXED, __HIP_MEMORY_SCOPE_AGENT);
    __syncthreads();
    if (tid == 0) {
        int acc = 0;
        for (int e = 0; e < NE; ++e) { pstart[e] = acc; acc += ((pcnt[e] + 255) >> 8) * 256; }
        if (blockIdx.x == 0) TILEE[1023] = acc >> 8;
    }
    __syncthreads();
    if (blockIdx.x == 0 && tid < NE) { const int nt = (pcnt[tid] + 255) >> 8, t0_ = pstart[tid] >> 8; for (int i = 0; i < nt; ++i) TILEE[t0_ + i] = tid; }
    if (blockIdx.x < NE) {
        const int e = blockIdx.x, cn = pcnt[e], pe = ((cn + 255) >> 8) * 256;
        for (int i = cn + tid; i < pe; i += 512) ROWTOK[pstart[e] + i] = 0;
    }
    const int TPB = T / (int)gridDim.x, tb0 = blockIdx.x * TPB;
    for (int pi = tb0 * 4 + tid; pi < (tb0 + TPB) * 4; pi += 512) {
        const int e = EIDX[pi], dest = pstart[e] + POS[pi];
        DEST[pi] = dest; ROWGATE[dest] = GATE[pi]; ROWTOK[dest] = pi >> 2;
    }
}

__device__ __forceinline__ void p9_combine(const Args& a, int G) {
    const int tid = threadIdx.x, lane = tid & 63, wave = __builtin_amdgcn_readfirstlane(tid >> 6);
    unsigned char* ws = a.ws;
    const unsigned char* YS = ws + WS_YS; const int* DEST = (const int*)(ws + WS_DEST);
    float* out = a.out;
    const int gw = blockIdx.x * 8 + wave, NGW = G * 8;
    for (int t = gw; t < T; t += NGW) {
        f32x4* xr = (f32x4*)(out + (size_t)t * D) + lane; const u32x2* xi = (const u32x2*)((const bf16_t*)(ws + WS_X1B) + (size_t)t * D) + lane;
        f32x4 v[4];
#pragma unroll
        for (int j = 0; j < 4; ++j) { const u32x2 xw = xi[64 * j]; v[j] = (f32x4){bflo(xw.x), bfhi(xw.x), bflo(xw.y), bfhi(xw.y)}; }
#pragma unroll
        for (int k = 0; k < 4; ++k) {
            const int dest = DEST[t * 4 + k];
            const unsigned* yr = (const unsigned*)(YS + (size_t)dest * D) + lane;
#pragma unroll
            for (int j = 0; j < 4; ++j) { const unsigned w = yr[64 * j];
                const f32x2 lo = __builtin_amdgcn_cvt_pk_f32_fp8((int)w, false), hi2 = __builtin_amdgcn_cvt_pk_f32_fp8((int)w, true);
                v[j].x += lo.x * (1.0f / F8_Y_MUL); v[j].y += lo.y * (1.0f / F8_Y_MUL); v[j].z += hi2.x * (1.0f / F8_Y_MUL); v[j].w += hi2.y * (1.0f / F8_Y_MUL); }
        }
        if (TIME_REGION >= 0) { const float sc_ = 1.0f + 4e-6f * (float)((const unsigned*)(ws + WS_CTL))[301];
#pragma unroll
            for (int j = 0; j < 4; ++j) v[j] = v[j] * sc_; }
#pragma unroll
        for (int j = 0; j < 4; ++j) xr[64 * j] = v[j];
    }
}

constexpr int NPHASE = 10;
__global__ void __launch_bounds__(512, 2) hymba_fwd(Args args) {
    extern __shared__ __attribute__((aligned(16))) unsigned char lds_raw[];
    LAS unsigned char* lds = (LAS unsigned char*)lds_raw;
    cg::grid_group grid = cg::this_grid();
    const int G = gridDim.x;
    unsigned char* ws = args.ws;
    unsigned* ctl = (unsigned*)(ws + WS_CTL);
    const int lo = args.ph_lo, hi = args.ph_hi;
#define IN(k) (lo <= (k) && (k) < hi)
#define NREP(k) ((REP_PHASE) == (k) ? 2 : 1)
#define TSTART(k) do { if ((TIME_REGION) == (k) && blockIdx.x == 0 && threadIdx.x == 0) ctl[300] = (unsigned)__builtin_amdgcn_s_memrealtime(); } while (0)
#define TEND(k) do { if ((TIME_REGION) == (k) && blockIdx.x == 0 && threadIdx.x == 0) ctl[301] = (unsigned)__builtin_amdgcn_s_memrealtime() - ctl[300]; } while (0)
#define SEAM(k) do { if (IN(k) && IN((k) + 1)) { if (args.ph_lo < 0) grid.sync(); xcd_barrier(xbar); } } while (0)
    const int* TILEE = (const int*)(ws + WS_TILEE);
    { volatile LAS unsigned* st = (volatile LAS unsigned*)(lds + MISC_OFF); if (threadIdx.x < 2) st[threadIdx.x] = 0u; }
    __syncthreads();
    const XcdBarrier xbar = xcd_barrier_post(ctl + CW_BAR, (volatile LAS unsigned*)(lds + MISC_OFF));

    if (IN(0)) { for (int rep = 0; rep < NREP(0); ++rep) p0_prologue(lds, args, G); } SEAM(0);
    if (IN(1)) {
        pg8::Gemm g{ws + WS_XN, ws + WS_WINT, 1024, 0, 0, nullptr};
        pg8::TileOrder S; S.init(T / 256, NINP / 256, G, (int)blockIdx.x, nullptr, 0, WGM_P1);
        pg8::EpiBf16 E{(bf16_t*)(ws + WS_P), NINP, (bf16_t*)(ws + WS_VT)};
        for (int rep = 0; rep < NREP(1); ++rep) pg8::gemm_phase<false, false>(lds, g, S, E);
    } SEAM(1);
    TSTART(2);
    if (IN(2)) {
        p2_prep(lds, args);
        asm volatile("s_waitcnt vmcnt(0)" ::: "memory");
        __syncthreads();
        { const int bb = (int)blockIdx.x >> 5, cp = ((int)blockIdx.x & 31) * 2;
          _Pragma("clang loop unroll(disable)") for (int i = 0; i < 16; ++i) ck::chunk_item(lds, args, ((bb * 8 + (i & 7)) << 6) + cp + (i >> 3)); }
    } SEAM(2);
    TSTART(3);
    if (IN(3)) {
        TSTART(30); for (int rep = 0; rep < NREP(30); ++rep) { if (blockIdx.x < 64) ck::seq_head(lds, args, (int)blockIdx.x); __syncthreads(); } TEND(30);
        for (int rep = 0; rep < NREP(31); ++rep) att::attn_phase(lds, args, ctl + 64 * rep);
    } SEAM(3); TEND(3);
    if (IN(4)) {
        pg8::Gemm g{ws + WS_YMIX, ws + WS_WOUT, 1024, 0, 0, nullptr};
        pg8::TileOrder S; S.init(T / 256, D / 256, G, (int)blockIdx.x, nullptr, 0, WGM_P4);
        pg8::EpiResBf16 E{args.in[0], (bf16_t*)(ws + WS_X1B), D};
        for (int rep = 0; rep < NREP(4); ++rep) pg8::gemm_phase<false, false>(lds, g, S, E);
    } SEAM(4);
    if (IN(5)) { _Pragma("clang loop unroll(disable)") for (int rep = 0; rep < NREP(5); ++rep) { p5_router(lds, args, ctl + 256 * (NREP(5) - 1 - rep)); __syncthreads(); } } SEAM(5);
    if (IN(6)) { for (int rep = 0; rep < NREP(6); ++rep) { p6_dispatch(lds, args, ctl); __syncthreads(); } } SEAM(6);
    if (IN(7)) {
        const int ntile = TILEE[1023];
        pg8::Gemm g{ws + WS_H2, ws + WS_W1T, 1024, F8_W_SC, F8_X_SC, (const int*)(ws + WS_ROWTOK)};
        pg8::TileOrder S; S.init(ntile, 8, G, (int)blockIdx.x, TILEE, 8, WGM_P7);
        pg8::EpiSwiglu E{ws + WS_HID, args.in[27], TILEE};
        for (int rep = 0; rep < NREP(7); ++rep) pg8::gemm_phase<true, true>(lds, g, S, E);
    } SEAM(7);
    if (IN(8)) {
        const int ntile = TILEE[1023];
        pg8::Gemm g{ws + WS_HID, ws + WS_W2T, 1024, F8_W_SC, F8_H_SC, nullptr};
        pg8::TileOrder S; S.init(ntile, 4, G, (int)blockIdx.x, TILEE, 4, WGM_P8);
        pg8::EpiGateF8 E{ws + WS_YS, args.in[29], (const float*)(ws + WS_ROWGATE), TILEE};
        for (int rep = 0; rep < NREP(8); ++rep) pg8::gemm_phase<true, false>(lds, g, S, E);
    } SEAM(8);
    if (IN(9)) { p9_combine(args, G); }
#undef IN
#undef SEAM
}

extern "C" void kernel_launch(void* const* d_in, const int* in_sizes, int n_in, void* d_out, int out_size, void* d_ws, size_t ws_size, hipStream_t stream) {
    static int grid = 0;
    if (grid == 0) {
        if (n_in != 30 || in_sizes[0] != T * D || out_size != T * D || ws_size < WS_END) { fprintf(stderr, "kernel_launch: unexpected shapes (n_in %d, in0 %d, out %d, ws %zu); nothing launched\n", n_in, n_in > 0 ? in_sizes[0] : -1, out_size, ws_size); grid = -1; return; }
        int dev = 0, cus = 0, per_cu = 0;
        if (hipGetDevice(&dev) != hipSuccess || hipDeviceGetAttribute(&cus, hipDeviceAttributeMultiprocessorCount, dev) != hipSuccess) { grid = -1; return; }
        if (hipFuncSetAttribute((const void*)hymba_fwd, hipFuncAttributeMaxDynamicSharedMemorySize, LDS_BYTES) != hipSuccess) { fprintf(stderr, "kernel_launch: hipFuncSetAttribute failed\n"); grid = -1; return; }
        if (hipOccupancyMaxActiveBlocksPerMultiprocessor(&per_cu, (const void*)hymba_fwd, 512, LDS_BYTES) != hipSuccess || per_cu < 1) { fprintf(stderr, "kernel_launch: occupancy query says %d\n", per_cu); per_cu = 1; }
        (void)hipGetLastError();
        grid = cus;
        if (grid > 256) grid = 256;
        if (grid != 256 || T % grid != 0 || (T / grid) % 16 != 0) { fprintf(stderr, "kernel_launch: grid %d does not divide the token count evenly\n", grid); grid = -1; return; }
    }
    if (grid < 0) return;
    (void)hipMemsetAsync((char*)d_ws + WS_CTL, 0, CTL_ZERO_BYTES, stream);
    Args a{};
    for (int i = 0; i < 30; ++i) a.in[i] = (const float*)d_in[i];
    a.out = (float*)d_out; a.ws = (unsigned char*)d_ws;
    constexpr int NL = MK_N_LAUNCHES;
    for (int li = 0; li < NL; ++li) {
        a.ph_lo = (NL == 1) ? 0 : li; a.ph_hi = (NL == 1) ? NPHASE : li + 1;
        void* kargs[] = {&a};
        hipError_t e = hipLaunchCooperativeKernel((const void*)hymba_fwd, dim3(grid), dim3(512), kargs, LDS_BYTES, stream);
        if (e != hipSuccess) { fprintf(stderr, "kernel_launch: cooperative launch %d failed: %s (grid %d)\n", li, hipGetErrorString(e), grid); break; }
    }
}
```

```cpp
#include <hip/hip_runtime.h>
#include <hip/hip_cooperative_groups.h>
#include <cstdio>
#include <cstdint>
#include <type_traits>
namespace cg = cooperative_groups;

#ifndef REP_PHASE
#define REP_PHASE -1
#endif
#ifndef TIME_REGION
#define TIME_REGION -1
#endif
#ifndef WGM_P1
#define WGM_P1 2
#endif
#ifndef WGM_P4
#define WGM_P4 2
#endif
#ifndef WGM_P7
#define WGM_P7 2
#endif
#ifndef WGM_P8
#define WGM_P8 2
#endif
#ifndef MK_N_LAUNCHES
#define MK_N_LAUNCHES 1
#endif

#define LAS __attribute__((address_space(3)))
#define GAS __attribute__((address_space(1)))
typedef unsigned short bf16_t;
typedef short bf16x8 __attribute__((ext_vector_type(8)));
typedef short s16x4 __attribute__((ext_vector_type(4)));
typedef float f32x2 __attribute__((ext_vector_type(2)));
typedef float f32x4 __attribute__((ext_vector_type(4)));
typedef float f32x16 __attribute__((ext_vector_type(16)));
typedef unsigned u32x2 __attribute__((ext_vector_type(2)));
typedef unsigned u32x4 __attribute__((ext_vector_type(4)));
typedef int v8i32 __attribute__((ext_vector_type(8)));

constexpr int NB = 8, SEQ = 4096, T = NB * SEQ, D = 1024;
constexpr int CW = 512;
constexpr int NRW = 1696, NIN = 3232, NINP = 3328;
constexpr int DQ0 = 1696, DK0 = 2208, DV0 = 2720;
constexpr int NE = 32, TOPK = 4, DE = 1024;
constexpr int MAXROWS = T * TOPK + NE * 256;
constexpr int MAXTILES = MAXROWS / 256;
constexpr float LOG2E = 1.4426950408889634f;
constexpr float F8_W_MUL = 32.f, F8_X_MUL = 8.f, F8_H_MUL = 4.f, F8_Y_MUL = 16.f; constexpr int F8_W_SC = 0x7A7A7A7A, F8_X_SC = 0x7C7C7C7C, F8_H_SC = 0x7D7D7D7D;

constexpr size_t MiB = 1u << 20;
constexpr size_t WS_CTL = 0, CTL_ZERO_BYTES = 64 * 1024;
constexpr size_t WS_TILEE = 512 * 1024;
constexpr size_t WS_LW = 576 * 1024;
constexpr size_t WS_WINT = 1 * MiB;
constexpr size_t WS_WOUT = 8 * MiB;
constexpr size_t WS_W1T = 10 * MiB;
constexpr size_t WS_W2T = 138 * MiB;
constexpr size_t WS_EIDX = 202 * MiB;
constexpr size_t WS_GATE = WS_EIDX + 512 * 1024;
constexpr size_t WS_POS = WS_GATE + 512 * 1024;
constexpr size_t WS_DEST = WS_POS + 512 * 1024;
constexpr size_t WS_ROWGATE = 204 * MiB;
constexpr size_t WS_XN = 206 * MiB;
constexpr size_t WS_P = 270 * MiB;
constexpr size_t WS_SR = 478 * MiB, WS_SK = 510 * MiB, WS_SV = 542 * MiB, WS_SA = 574 * MiB, WS_SB = 606 * MiB;
constexpr size_t WS_SW = 638 * MiB;
constexpr size_t WS_SG = 702 * MiB;
constexpr size_t WS_QN = 734 * MiB, WS_KN = 766 * MiB;
constexpr size_t WS_YMIX = 798 * MiB;
constexpr size_t WS_H2 = 206 * MiB;
constexpr size_t WS_ROWTOK = 270 * MiB;
constexpr size_t WS_HID = 406 * MiB;
constexpr size_t WS_YS = 542 * MiB;
constexpr size_t WS_X1B = 862 * MiB;
constexpr size_t WS_CG = 862 * MiB;
constexpr size_t WS_CH = 894 * MiB;
constexpr size_t WS_CR2 = 926 * MiB;
constexpr size_t WS_CY0 = 958 * MiB;
constexpr size_t WS_RK = 990 * MiB;
constexpr size_t WS_VT = 992 * MiB;
constexpr size_t WS_END = 1024 * MiB;
constexpr int CW_CNT = 64;
constexpr int CW_ATTQ = 128;
constexpr int CW_BAR = 4096;

constexpr int RING_BYTES = 131072, MISC_OFF = RING_BYTES, LDS_BYTES = 147456;

__device__ __forceinline__ unsigned f2bf(float f) { unsigned u = __builtin_bit_cast(unsigned, f); return (u + 0x7fffu + ((u >> 16) & 1u)) >> 16; }
typedef __bf16 hwbf16x2 __attribute__((ext_vector_type(2)));
__device__ __forceinline__ unsigned pk2(float lo, float hi) { const f32x2 v = {lo, hi}; return __builtin_bit_cast(unsigned, __builtin_convertvector(v, hwbf16x2)); }
__device__ __forceinline__ unsigned pk4_fp8(float a, float b, float c, float d) {
    a = fminf(fmaxf(a, -448.f), 448.f); b = fminf(fmaxf(b, -448.f), 448.f); c = fminf(fmaxf(c, -448.f), 448.f); d = fminf(fmaxf(d, -448.f), 448.f);
    int r = __builtin_amdgcn_cvt_pk_fp8_f32(a, b, 0, false); r = __builtin_amdgcn_cvt_pk_fp8_f32(c, d, r, true); return (unsigned)r; }
__device__ __forceinline__ float bf2f(unsigned short b) { return __builtin_bit_cast(float, (unsigned)b << 16); }
__device__ __forceinline__ float bflo(unsigned w) { return __builtin_bit_cast(float, w << 16); }
__device__ __forceinline__ float bfhi(unsigned w) { return __builtin_bit_cast(float, w & 0xffff0000u); }
__device__ __forceinline__ float wave_sum(float v) {
#pragma unroll
    for (int o = 1; o < 64; o <<= 1) v += __shfl_xor(v, o);
    return v;
}
__device__ __forceinline__ float sigmoidf_(float x) { return 1.0f / (1.0f + __expf(-x)); }
template <int CTRL> __device__ __forceinline__ float dpp_f(float v) { return __builtin_bit_cast(float, __builtin_amdgcn_update_dpp(0, __builtin_bit_cast(int, v), CTRL, 0xF, 0xF, true)); }
__device__ __forceinline__ float red8(float v) {
    v += dpp_f<0xB1>(v);
    v += dpp_f<0x4E>(v);
    v += dpp_f<0x141>(v);
    return v;
}
__device__ __forceinline__ float red4(float v) { v += dpp_f<0xB1>(v); v += dpp_f<0x4E>(v); return v; }


#define XB_TMO      128
#define XB_XCNT(j)  (256  + 64 * (j))
#define XB_XSUB(j)  (1280 + 64 * (j))
#define XB_XGEN(j)  (2304 + 64 * (j))
#define XB_TOP      3328
#define XB_TOPGEN   3392
#define XCD_BAR_WORDS 3456
#define XB_SPIN_CAP (1u << 18)
__device__ __forceinline__ unsigned xb_ld(unsigned* p)              { return __hip_atomic_load(p, __ATOMIC_RELAXED, __HIP_MEMORY_SCOPE_AGENT); }
__device__ __forceinline__ unsigned xb_add(unsigned* p, unsigned v) { return __hip_atomic_fetch_add(p, v, __ATOMIC_RELAXED, __HIP_MEMORY_SCOPE_AGENT); }
__device__ __forceinline__ unsigned xb_xcc_id() { return (unsigned)__builtin_amdgcn_s_getreg((3 << 11) | 20) & 0xFu; }
#define XB_SPIN(cond, bar) do { unsigned _sp = 0; while (cond) { __builtin_amdgcn_s_sleep(1); \
    if ((++_sp & 255u) == 0u) { if (xb_ld(&(bar)[XB_TMO])) break; if (_sp > XB_SPIN_CAP) { atomicAdd(&(bar)[XB_TMO], 1u); break; } } } } while (0)
struct XcdBarrier { unsigned* bar; unsigned x; volatile LAS unsigned* st; };
__device__ __forceinline__ XcdBarrier xcd_barrier_post(unsigned* bar, volatile LAS unsigned* st) {
    XcdBarrier b; b.bar = bar; b.x = xb_xcc_id(); b.st = st;
    if (threadIdx.x == 0) (void)xb_add(&bar[XB_XCNT(b.x)], 1u);
    return b;
}
__device__ __forceinline__ void xcd_barrier_complete(unsigned* bar, unsigned x, unsigned& nloc, unsigned& nx) {
    const unsigned G = gridDim.x * gridDim.y * gridDim.z;
    unsigned sum, cnt, mine, sp = 0u;
    for (;;) {
        sum = 0u; cnt = 0u; mine = 0u;
#pragma unroll
        for (unsigned j = 0; j < 16; ++j) { const unsigned c = xb_ld(&bar[XB_XCNT(j)]); sum += c; cnt += (c > 0u) ? 1u : 0u; mine = (j == x) ? c : mine; }
        if (sum == G) break;
        __builtin_amdgcn_s_sleep(1);
        if ((++sp & 255u) == 0u) { if (xb_ld(&bar[XB_TMO])) break; if (sp > XB_SPIN_CAP) { atomicAdd(&bar[XB_TMO], 1u); break; } }
    }
    nloc = mine > 0u ? mine : 1u; nx = cnt > 0u ? cnt : 1u;
}
__device__ __forceinline__ void xcd_barrier(const XcdBarrier& b) {
    asm volatile("s_waitcnt vmcnt(0)" ::: "memory");
    __syncthreads();
    if (threadIdx.x == 0) {
        unsigned* bar = b.bar;
        __builtin_amdgcn_s_waitcnt(0);
        unsigned nloc = b.st[0], nx = b.st[1];
        if (nloc == 0u) { xcd_barrier_complete(bar, b.x, nloc, nx); b.st[0] = nloc; b.st[1] = nx; }
        const unsigned old = xb_add(&bar[XB_XSUB(b.x)], 1u);
        const unsigned gen = old / nloc;
        if (old + 1u == (gen + 1u) * nloc) {
            __builtin_amdgcn_fence(__ATOMIC_RELEASE, "agent");
            asm volatile("s_waitcnt vmcnt(0)" ::: "memory");
            const unsigned og = xb_add(&bar[XB_TOP], 1u);
            const unsigned tg = og / nx;
            if (og + 1u == (tg + 1u) * nx) xb_add(&bar[XB_TOPGEN], 1u);
            else XB_SPIN(xb_ld(&bar[XB_TOPGEN]) == tg, bar);
            __builtin_amdgcn_fence(__ATOMIC_ACQUIRE, "agent");
            xb_add(&bar[XB_XGEN(b.x)], 1u);
            asm volatile("s_waitcnt vmcnt(0)" ::: "memory");
        } else {
            XB_SPIN(xb_ld(&bar[XB_XGEN(b.x)]) == gen, bar);
            __builtin_amdgcn_fence(__ATOMIC_ACQUIRE, "agent");
            asm volatile("s_waitcnt vmcnt(0)" ::: "memory");
        }
    }
    __syncthreads();
}

namespace pg8 {
constexpr int BM = 256, BK = 64, HALF = 128, HTB = HALF * BK * 2, STAGE_BYTES = 8 * HTB, NXCD = 8;
__host__ __device__ __forceinline__ int lds_byte(int r, int c) { const int st = (r >> 4) * 2 + (c >> 5), rr = r & 15, cc = c & 31, ob = rr * 64 + cc * 2; return st * 1024 + (ob ^ (((ob >> 9) & 1) << 5)); }
__host__ __device__ __forceinline__ void stage_rc(int b, int& R, int& C) { const int st = b / 1024, sb = b % 1024, swz = sb ^ (((sb >> 9) & 1) << 5); R = (st >> 1) * 16 + swz / 64; C = (st & 1) * 32 + (swz % 64) / 2; }
__host__ __device__ __forceinline__ int perm32(int rho) { const int n = rho >> 4, i = rho & 15; return 8 * (i >> 2) + 4 * n + (i & 3); }

struct Unit { int pm, pn, pb; };
struct Gemm { const void* A; const void* Bt; int K; int scW, scA; const int* rowtok; };

struct TileOrder {
    int nM, nN, nwg, G, c, WGM; const int* tile_e; int nb_per_e;
    __device__ void init(int nM_, int nN_, int G_, int c_, const int* te, int nbe, int wgm) { nM = nM_; nN = nN_; nwg = nM * nN; G = G_; c = c_; tile_e = te; nb_per_e = nbe; WGM = wgm; }
    __device__ bool next(int i, Unit& u) const {
        const long L = (long)i * G + c; if (L >= nwg) return false;
        int wgid = (int)L; { const int q = nwg / NXCD, r = nwg % NXCD, xcd = wgid % NXCD, off = wgid / NXCD; wgid = (xcd < r ? xcd * (q + 1) : r * (q + 1) + (xcd - r) * q) + off; }
        const int nig = WGM * nN, gid = wgid / nig, fm = gid * WGM, gsz = (nM - fm) < WGM ? (nM - fm) : WGM;
        u.pm = fm + ((wgid % nig) % gsz); u.pn = (wgid % nig) / gsz;
        u.pb = tile_e ? tile_e[u.pm] * nb_per_e + u.pn : u.pn;
        return true;
    }
};

struct EpiBf16 {
    static constexpr bool PERM = true;
    bf16_t* O; int ldc; bf16_t* VT;
    __device__ __forceinline__ void operator()(const f32x4 (&acc)[2][2][4][2], const Unit& u, int wr, int wc, int fr, int fq) const {
        const int row0 = u.pm * BM + wr * 64 + fr; const int col0 = u.pn * BM + wc * 32 + 8 * fq;
#pragma unroll
        for (int ai = 0; ai < 2; ++ai)
#pragma unroll
            for (int m = 0; m < 4; ++m) { const int t = row0 + ai * HALF + m * 16; bf16_t* rowp = O + (size_t)t * ldc + col0;
#pragma unroll
                for (int bj = 0; bj < 2; ++bj) { const f32x4 v0 = acc[ai][bj][m][0], v1 = acc[ai][bj][m][1];
                    u32x4 w; w.x = pk2(v0[0], v0[1]); w.y = pk2(v0[2], v0[3]); w.z = pk2(v1[0], v1[1]); w.w = pk2(v1[2], v1[3]);
                    const int col = col0 + bj * HALF;
                    if (col >= DV0) { const int dvf = col - DV0, hh = dvf >> 7, dv = dvf & 127, tp = t & (SEQ - 1), key = tp & 63;
                        bf16_t* vp = VT + (((((size_t)((t >> 12) * 4 + hh) * 64 + (tp >> 6)) * 4 + (dv >> 5)) * 4 + (key >> 4)) * 16 + (key & 15)) * 32 + (dv & 31);
                        if (col < NIN) *(u32x4*)vp = w; }
                    else *(u32x4*)(rowp + bj * HALF) = w; } }
    }
};
struct EpiResBf16 {
    static constexpr bool PERM = true;
    const float* base; bf16_t* out; int ldc;
    __device__ __forceinline__ void operator()(const f32x4 (&acc)[2][2][4][2], const Unit& u, int wr, int wc, int fr, int fq) const {
        const int col0 = u.pn * BM + wc * 32 + 8 * fq;
#pragma unroll
        for (int ai = 0; ai < 2; ++ai)
#pragma unroll
            for (int m = 0; m < 4; ++m) { const size_t off = (size_t)(u.pm * BM + ai * HALF + wr * 64 + m * 16 + fr) * ldc + col0;
#pragma unroll
                for (int bj = 0; bj < 2; ++bj) { const f32x4 b0 = *(const f32x4*)(base + off + bj * HALF), b1 = *(const f32x4*)(base + off + bj * HALF + 4);
                    const f32x4 v0 = b0 + acc[ai][bj][m][0], v1 = b1 + acc[ai][bj][m][1];
                    u32x4 w; w.x = pk2(v0[0], v0[1]); w.y = pk2(v0[2], v0[3]); w.z = pk2(v1[0], v1[1]); w.w = pk2(v1[2], v1[3]);
                    *(u32x4*)(out + off + bj * HALF) = w; } }
    }
};
struct EpiSwiglu {
    static constexpr bool PERM = true;
    unsigned char* O; const float* b1; const int* tile_e;
    __device__ __forceinline__ void operator()(const f32x4 (&acc)[2][2][4][2], const Unit& u, int wr, int wc, int fr, int fq) const {
        const int e = tile_e[u.pm]; const int row0 = u.pm * BM + wr * 64 + fr; const int hc0 = u.pn * 128 + wc * 32 + 8 * fq;
        const float* bg = b1 + (size_t)e * 2048 + hc0; const float* bl = bg + 1024;
        const f32x4 g0 = *(const f32x4*)bg, g1 = *(const f32x4*)(bg + 4), l0 = *(const f32x4*)bl, l1 = *(const f32x4*)(bl + 4);
#pragma unroll
        for (int ai = 0; ai < 2; ++ai)
#pragma unroll
            for (int m = 0; m < 4; ++m) { unsigned char* rowp = O + (size_t)(row0 + ai * HALF + m * 16) * 1024 + hc0;
                float o[8];
#pragma unroll
                for (int n = 0; n < 2; ++n) { const f32x4 gv = acc[ai][0][m][n] + (n ? g1 : g0), lv = acc[ai][1][m][n] + (n ? l1 : l0);
#pragma unroll
                    for (int i = 0; i < 4; ++i) { const float g = fminf(gv[i], 7.0f), l = fminf(fmaxf(lv[i], -7.0f), 7.0f);
                        const float sg = __builtin_amdgcn_rcpf(1.0f + __builtin_amdgcn_exp2f(-1.702f * LOG2E * g)); o[n * 4 + i] = g * sg * (l + 1.0f); } }
                u32x2 w; w.x = pk4_fp8(o[0] * F8_H_MUL, o[1] * F8_H_MUL, o[2] * F8_H_MUL, o[3] * F8_H_MUL); w.y = pk4_fp8(o[4] * F8_H_MUL, o[5] * F8_H_MUL, o[6] * F8_H_MUL, o[7] * F8_H_MUL);
                *(u32x2*)rowp = w; }
    }
};
struct EpiGateF8 {
    static constexpr bool PERM = true;
    unsigned char* O; const float* b2; const float* rowgate; const int* tile_e;
    __device__ __forceinline__ void operator()(const f32x4 (&acc)[2][2][4][2], const Unit& u, int wr, int wc, int fr, int fq) const {
        const int e = tile_e[u.pm]; const int row0 = u.pm * BM + wr * 64 + fr; const int col0 = u.pn * BM + wc * 32 + 8 * fq;
        f32x4 bv[2][2];
#pragma unroll
        for (int bj = 0; bj < 2; ++bj)
#pragma unroll
            for (int n = 0; n < 2; ++n) bv[bj][n] = *(const f32x4*)(b2 + (size_t)e * 1024 + col0 + bj * HALF + 4 * n);
#pragma unroll
        for (int ai = 0; ai < 2; ++ai)
#pragma unroll
            for (int m = 0; m < 4; ++m) { const int row = row0 + ai * HALF + m * 16; const float gt = rowgate[row] * F8_Y_MUL; unsigned char* rowp = O + (size_t)row * 1024 + col0;
#pragma unroll
                for (int bj = 0; bj < 2; ++bj) { const f32x4 v0 = (acc[ai][bj][m][0] + bv[bj][0]) * gt, v1 = (acc[ai][bj][m][1] + bv[bj][1]) * gt;
                    u32x2 w; w.x = pk4_fp8(v0[0], v0[1], v0[2], v0[3]); w.y = pk4_fp8(v1[0], v1[1], v1[2], v1[3]);
                    *(u32x2*)(rowp + bj * HALF) = w; } }
    }
};

template <bool F8, bool GATHER, class Epi, class Sched>
__device__ __forceinline__ void gemm_phase(LAS unsigned char* lds, const Gemm g, const Sched& S, const Epi& E) {
    const int tid = threadIdx.x, wid = __builtin_amdgcn_readfirstlane(tid >> 6), lane = tid & 63, wr = wid >> 2, wc = wid & 3, fr = lane & 15, fq = lane >> 4;
    const int RB = F8 ? g.K : g.K * 2, nt = RB / 128;
    unsigned voffB[2];
#pragma unroll
    for (int i = 0; i < 2; ++i) { int R, C; stage_rc(tid * 16 + i * 8192, R, C); const int Rb = Epi::PERM ? ((R & ~31) + perm32(R & 31)) : R;
        voffB[i] = (unsigned)(Rb * RB + C * 2); }
#define PG8_AOFFS(dst, pm_) do { _Pragma("unroll") for (int h_ = 0; h_ < 2; ++h_) _Pragma("unroll") for (int i_ = 0; i_ < 2; ++i_) { int R_, C_; stage_rc(tid * 16 + i_ * 8192, R_, C_); \
        const int row_ = (pm_) * BM + h_ * HALF + R_; const unsigned grow_ = GATHER ? (unsigned)g.rowtok[row_] : (unsigned)row_; dst[h_][i_] = grow_ * (unsigned)RB + (unsigned)(C_ * 2); } } while (0)
    unsigned cvA[2][2], nvA[2][2];
    const size_t kstep = (size_t)(BK * 2);
    const size_t hstep = (size_t)HALF * RB;
    const size_t tstep = 2 * hstep;
    const unsigned ldsw = (unsigned)wid * 1024u;
    const int aoff = F8 ? lds_byte(wr * 64 + fr, (fq & 1) * 16) + (fq >> 1) * 1024 : lds_byte(wr * 64 + fr, fq * 8);
    const int boff = F8 ? lds_byte(wc * 32 + fr, (fq & 1) * 16) + (fq >> 1) * 1024 : lds_byte(wc * 32 + fr, fq * 8);
    const int scW = g.scW, scA = g.scA;
#define PG8_SA(b, h) (((b) * 2 + (h)) * HTB)
#define PG8_SB(b, h) ((4 + (b) * 2 + (h)) * HTB)
#define PG8_STAGE(bufoff, gbase, voff) do { _Pragma("unroll") for (int _i = 0; _i < 2; ++_i) \
        __builtin_amdgcn_global_load_lds((const unsigned*)((const char*)(gbase) + (voff)[_i]), (LAS unsigned*)(lds + (bufoff) + ldsw + _i * 8192), 16, 0, 0); } while (0)
typedef int v8i32a __attribute__((ext_vector_type(8), aligned(16)));
#define PG8_LD32(p) (*(const LAS v8i32a*)(p))
#define PG8_STAGE_A(bufoff, kptr, offs) do { _Pragma("unroll") for (int _i = 0; _i < 2; ++_i) \
        __builtin_amdgcn_global_load_lds((const unsigned*)((const char*)(kptr) + (offs)[_i]), (LAS unsigned*)(lds + (bufoff) + ldsw + _i * 8192), 16, 0, 0); } while (0)
#define PG8_LDA(dst, b, h) do { _Pragma("unroll") for (int m = 0; m < 4; ++m) { if constexpr (F8) { dst[m].f8 = __builtin_bit_cast(v8i32, PG8_LD32(lds + PG8_SA(b, h) + aoff + m * 2048)); } \
        else { _Pragma("unroll") for (int k = 0; k < 2; ++k) dst[m].hv[k] = *(const LAS bf16x8*)(lds + PG8_SA(b, h) + aoff + m * 2048 + k * 1024); } } } while (0)
#define PG8_LDB(dst, b, h) do { _Pragma("unroll") for (int n = 0; n < 2; ++n) { if constexpr (F8) { dst[n].f8 = __builtin_bit_cast(v8i32, PG8_LD32(lds + PG8_SB(b, h) + boff + n * 2048)); } \
        else { _Pragma("unroll") for (int k = 0; k < 2; ++k) dst[n].hv[k] = *(const LAS bf16x8*)(lds + PG8_SB(b, h) + boff + n * 2048 + k * 1024); } } } while (0)
#define PG8_MMA(ai, bj, At, Bt) do { __builtin_amdgcn_s_setprio(1); _Pragma("unroll") for (int m = 0; m < 4; ++m) _Pragma("unroll") for (int n = 0; n < 2; ++n) { \
        if constexpr (F8) { asm volatile("v_mfma_scale_f32_16x16x128_f8f6f4 %0, %1, %2, %0, %3, %4 op_sel_hi:[0,0,0]" : "+v"(acc[ai][bj][m][n]) : "v"(Bt[n].f8), "v"(At[m].f8), "v"(scW), "v"(scA)); } \
        else { _Pragma("unroll") for (int k = 0; k < 2; ++k) acc[ai][bj][m][n] = __builtin_amdgcn_mfma_f32_16x16x32_bf16(Bt[n].hv[k], At[m].hv[k], acc[ai][bj][m][n], 0, 0, 0); } } \
        __builtin_amdgcn_s_setprio(0); } while (0)
#define PG8_WAIT_V(n) asm volatile("s_waitcnt vmcnt(" #n ")" ::: "memory")
#define PG8_WAIT_L(n) asm volatile("s_waitcnt lgkmcnt(" #n ")" ::: "memory")
#define PG8_BAR __builtin_amdgcn_s_barrier()
#define PG8_SCHED __builtin_amdgcn_sched_barrier(0)
    Unit cur, nxt; int ui = 0;
    if (!S.next(0, cur)) return;
    f32x4 acc[2][2][4][2];
#pragma unroll
    for (int a = 0; a < 2; ++a)
#pragma unroll
        for (int b = 0; b < 2; ++b)
#pragma unroll
            for (int m = 0; m < 4; ++m)
#pragma unroll
                for (int n = 0; n < 2; ++n) acc[a][b][m][n] = (f32x4){0.f, 0.f, 0.f, 0.f};
    struct FragH { bf16x8 hv[2]; }; struct Frag8 { v8i32 f8; };
    typename std::conditional<F8, Frag8, FragH>::type At[4], B0[2], B1[2];
    const char* const kA = (const char*)g.A; const char* cB = (const char*)g.Bt + (size_t)cur.pb * tstep;
    PG8_AOFFS(cvA, cur.pm);
    PG8_STAGE(PG8_SB(0, 0), cB, voffB); PG8_STAGE(PG8_SB(0, 1), cB + hstep, voffB); PG8_STAGE_A(PG8_SA(0, 0), kA, cvA[0]); PG8_STAGE_A(PG8_SA(0, 1), kA, cvA[1]);
    if (wr == 1) PG8_BAR;
    PG8_WAIT_V(2); PG8_BAR;
    PG8_STAGE(PG8_SB(1, 0), cB + kstep, voffB); PG8_STAGE_A(PG8_SA(1, 0), kA + kstep, cvA[0]); PG8_STAGE(PG8_SB(1, 1), cB + hstep + kstep, voffB);
    PG8_WAIT_V(6); PG8_BAR;
    for (;;) {
        const bool has_next = S.next(ui + 1, nxt);
        const char* nB = has_next ? (const char*)g.Bt + (size_t)nxt.pb * tstep : cB;
        if (has_next) { PG8_AOFFS(nvA, nxt.pm); } else { _Pragma("unroll") for (int h_ = 0; h_ < 2; ++h_) _Pragma("unroll") for (int i_ = 0; i_ < 2; ++i_) nvA[h_][i_] = cvA[h_][i_]; }
#pragma clang loop unroll(disable)
        for (int t = 0; t < nt; t += 2) {
            const bool last = (t == nt - 2);
            const char* a1 = kA + (size_t)(t + 1) * kstep;
            const char* a2 = last ? kA : kA + (size_t)(t + 2) * kstep; const char* b2 = last ? nB : cB + (size_t)(t + 2) * kstep;
            const char* a3 = a2 + kstep; const char* b3 = b2 + kstep;
            unsigned v2A[2][2];
#pragma unroll
            for (int h_ = 0; h_ < 2; ++h_)
#pragma unroll
                for (int i_ = 0; i_ < 2; ++i_) v2A[h_][i_] = last ? nvA[h_][i_] : cvA[h_][i_];
            PG8_LDB(B0, 0, 0); PG8_LDB(B1, 0, 1); PG8_SCHED; PG8_LDA(At, 0, 0); PG8_STAGE_A(PG8_SA(1, 1), a1, cvA[1]);
            PG8_WAIT_V(8); PG8_WAIT_L(0); PG8_BAR; PG8_MMA(0, 0, At, B0); PG8_MMA(0, 1, At, B1); PG8_BAR; PG8_SCHED;
            PG8_LDA(At, 0, 1); PG8_STAGE(PG8_SB(0, 0), b2, voffB); PG8_STAGE(PG8_SB(0, 1), b2 + hstep, voffB); PG8_STAGE_A(PG8_SA(0, 0), a2, v2A[0]);
            PG8_WAIT_V(8); PG8_WAIT_L(0); PG8_BAR; PG8_MMA(1, 0, At, B0); PG8_MMA(1, 1, At, B1); PG8_BAR; PG8_SCHED;
            PG8_LDB(B0, 1, 0); PG8_LDB(B1, 1, 1); PG8_SCHED; PG8_LDA(At, 1, 0); PG8_STAGE_A(PG8_SA(0, 1), a2, v2A[1]);
            PG8_WAIT_V(8); PG8_WAIT_L(0); PG8_BAR; PG8_MMA(0, 0, At, B0); PG8_MMA(0, 1, At, B1); PG8_BAR; PG8_SCHED;
            PG8_LDA(At, 1, 1); PG8_STAGE(PG8_SB(1, 0), b3, voffB); PG8_STAGE(PG8_SB(1, 1), b3 + hstep, voffB); PG8_STAGE_A(PG8_SA(1, 0), a3, v2A[0]);
            PG8_WAIT_V(8); PG8_WAIT_L(0); PG8_BAR; PG8_MMA(1, 0, At, B0); PG8_MMA(1, 1, At, B1); PG8_BAR; PG8_SCHED;
        }
        if (wr == 0) PG8_BAR;
        if constexpr (F8) asm volatile("s_nop 15\n\ts_nop 15" ::: "memory");
        E(acc, cur, wr, wc, fr, fq);
        if (!has_next) break;
#pragma unroll
        for (int a = 0; a < 2; ++a)
#pragma unroll
            for (int b = 0; b < 2; ++b)
#pragma unroll
                for (int m = 0; m < 4; ++m)
#pragma unroll
                    for (int n = 0; n < 2; ++n) acc[a][b][m][n] = (f32x4){0.f, 0.f, 0.f, 0.f};
        cur = nxt; cB = nB; ++ui;
#pragma unroll
        for (int h_ = 0; h_ < 2; ++h_)
#pragma unroll
            for (int i_ = 0; i_ < 2; ++i_) cvA[h_][i_] = nvA[h_][i_];
        if (wr == 1) PG8_BAR;
    }
    PG8_WAIT_V(0);
    PG8_BAR;
#undef PG8_SA
#undef PG8_SB
#undef PG8_STAGE
#undef PG8_STAGE_A
#undef PG8_AOFFS
#undef PG8_LDA
#undef PG8_LDB
#undef PG8_MMA
#undef PG8_LD32
#undef PG8_WAIT_V
#undef PG8_WAIT_L
#undef PG8_BAR
#undef PG8_SCHED
}
}

struct Args { const float* in[30]; float* out; unsigned char* ws; int ph_lo, ph_hi; };

__device__ __forceinline__ void p0_transpose_item(const float* W, int K, int N, bf16_t* WT, int k0, int n0, int drow0, LAS float* scr, int lane) {
#pragma unroll 8
    for (int i = 0; i < 32; ++i) { const int kk = 2 * i + (lane >> 5); scr[kk * 33 + (lane & 31)] = W[(size_t)(k0 + kk) * N + n0 + (lane & 31)]; }
    asm volatile("s_waitcnt lgkmcnt(0)" ::: "memory");
    const int c = lane & 7;
#pragma unroll
    for (int j = 0; j < 4; ++j) { const int n = (lane >> 3) + 8 * j; const LAS float* s = scr + (8 * c) * 33 + n;
        u32x4 o; o.x = pk2(s[0 * 33], s[1 * 33]); o.y = pk2(s[2 * 33], s[3 * 33]); o.z = pk2(s[4 * 33], s[5 * 33]); o.w = pk2(s[6 * 33], s[7 * 33]);
        *(u32x4*)(WT + (size_t)(drow0 + n) * K + k0 + 8 * c) = o; }
    asm volatile("s_waitcnt lgkmcnt(0)" ::: "memory");
}
__device__ __forceinline__ void p0_transpose_item_f8(const float* W, int K, int N, unsigned char* WT, int k0, int n0, int drow0, LAS float* scr, int lane) {
    LAS unsigned* tile = (LAS unsigned*)scr;
    const float* src = W + (size_t)k0 * N + n0 + lane;
#pragma unroll 8
    for (int kq = 0; kq < 32; ++kq) {
        const float* p = src + (size_t)(4 * kq) * N;
        tile[lane * 33 + kq] = pk4_fp8(p[0] * F8_W_MUL, p[N] * F8_W_MUL, p[2 * (size_t)N] * F8_W_MUL, p[3 * (size_t)N] * F8_W_MUL);
    }
    asm volatile("s_waitcnt lgkmcnt(0)" ::: "memory");
    const int c = lane & 7;
#pragma unroll
    for (int j = 0; j < 8; ++j) { const int n = (lane >> 3) + 8 * j; const LAS unsigned* t = tile + n * 33 + 4 * c;
        *(u32x4*)(WT + (size_t)(drow0 + n) * K + k0 + 16 * c) = (u32x4){t[0], t[1], t[2], t[3]}; }
    asm volatile("s_waitcnt lgkmcnt(0)" ::: "memory");
}
__device__ __forceinline__ void p0_prologue(LAS unsigned char* lds, const Args& a, int G) {
    const int tid = threadIdx.x, lane = tid & 63, wave = __builtin_amdgcn_readfirstlane(tid >> 6);
    LAS float* scr = (LAS float*)(lds + wave * 16384);
    const int gw = blockIdx.x * 8 + wave, NGW = G * 8;
    unsigned char* ws = a.ws;
    bf16_t* Wint = (bf16_t*)(ws + WS_WINT); bf16_t* Woutt = (bf16_t*)(ws + WS_WOUT); unsigned char* W1t = ws + WS_W1T; unsigned char* W2t = ws + WS_W2T;
    constexpr int I_IN = 16 * (NIN / 32);
    constexpr int I_OUT = 16 * 32;
    constexpr int I_W1 = 8 * 32;
    constexpr int I_W2 = 8 * 16;
    constexpr int NITEMS = I_IN + I_OUT + NE * I_W1 + NE * I_W2;
    for (int it = gw; it < NITEMS; it += NGW) {
        int r = it;
        if (r < I_IN) { const int nblk = NIN / 32, kb = r / nblk, nb = r % nblk; p0_transpose_item(a.in[2], 1024, NIN, Wint, 64 * kb, 32 * nb, 32 * nb, scr, lane); continue; } r -= I_IN;
        if (r < I_OUT) { const int kb = r / 32, nb = r % 32; p0_transpose_item(a.in[22], 1024, 1024, Woutt, 64 * kb, 32 * nb, 32 * nb, scr, lane); continue; } r -= I_OUT;
        if (r < NE * I_W1) { const int e = r / I_W1, q = r % I_W1, kb = q / 32, nb = q % 32; const int n0 = 64 * nb;
            const int drow = (n0 < 1024) ? ((n0 >> 7) * 256 + (n0 & 127)) : (((n0 - 1024) >> 7) * 256 + 128 + ((n0 - 1024) & 127));
            p0_transpose_item_f8(a.in[26] + (size_t)e * 1024 * 2048, 1024, 2048, W1t + (size_t)e * 2048 * 1024, 128 * kb, n0, drow, scr, lane); continue; } r -= NE * I_W1;
        { const int e = r / I_W2, q = r % I_W2, kb = q / 16, nb = q % 16;
            p0_transpose_item_f8(a.in[28] + (size_t)e * 1024 * 1024, 1024, 1024, W2t + (size_t)e * 1024 * 1024, 128 * kb, 64 * nb, 64 * nb, scr, lane); }
    }
    { bf16_t* LW = (bf16_t*)(ws + WS_LW);
      for (int i = gw * 64 + lane; i < CW * 160; i += NGW * 64) { const int col = i / 160, k = i - col * 160;
          const float v = k < 32 ? a.in[5][k * CW + col] : (k < 64 ? a.in[7][(k - 32) * CW + col] : a.in[8][(k - 64) * CW + col]); LW[i] = (bf16_t)f2bf(v); } }
    const float* x = a.in[0]; const float* g1 = a.in[1]; bf16_t* XN = (bf16_t*)(ws + WS_XN);
    f32x4 gv[4];
#pragma unroll
    for (int j = 0; j < 4; ++j) gv[j] = *((const f32x4*)g1 + lane + 64 * j);
    for (int m = gw; m < T; m += NGW) {
        const f32x4* xr = (const f32x4*)(x + (size_t)m * D) + lane;
        f32x4 v[4]; float s = 0.f;
#pragma unroll
        for (int j = 0; j < 4; ++j) { v[j] = xr[64 * j]; s += (v[j].x * v[j].x + v[j].y * v[j].y) + (v[j].z * v[j].z + v[j].w * v[j].w); }
        const float rstd = 1.0f / sqrtf(wave_sum(s) * (1.0f / D) + 1e-5f);
        u32x2* o8 = (u32x2*)(XN + (size_t)m * D) + lane;
#pragma unroll
        for (int j = 0; j < 4; ++j) { u32x2 w; w.x = pk2(v[j].x * rstd * gv[j].x, v[j].y * rstd * gv[j].y); w.y = pk2(v[j].z * rstd * gv[j].z, v[j].w * rstd * gv[j].w); o8[64 * j] = w; }
    }
}

__device__ __forceinline__ f32x4 cvlo(const u32x4 u) { return (f32x4){bflo(u.x), bfhi(u.x), bflo(u.y), bfhi(u.y)}; }
__device__ __forceinline__ f32x4 cvhi(const u32x4 u) { return (f32x4){bflo(u.z), bfhi(u.z), bflo(u.w), bfhi(u.w)}; }
__device__ __forceinline__ u32x4 pk8(const f32x4 lo, const f32x4 hi) { u32x4 w; w.x = pk2(lo.x, lo.y); w.y = pk2(lo.z, lo.w); w.z = pk2(hi.x, hi.y); w.w = pk2(hi.z, hi.w); return w; }

namespace ck {
constexpr int PS = 136;
constexpr int O_BT = 0, O_KT = 8704, O_AP = 17408, O_RT = 26112;
constexpr int O_AT = 34816, O_BH = 43008, O_KH = 51200, O_VV = 59392, O_TN = 67584, O_A2 = 75776, O_V2 = 83968;
constexpr int O_L = 92160, LSTR = 68;
constexpr int O_TOT = 109568, O_GC = 111616;
constexpr int O_ACT = 112128;
__device__ __forceinline__ int crow(int r, int hi) { return (r & 3) + 8 * (r >> 2) + 4 * hi; }
__device__ __forceinline__ int voff(int row, int col) { return ((col >> 5) * 4 + (row >> 4)) * 1024 + (row & 15) * 64 + (col & 31) * 2; }
__device__ __forceinline__ s16x4 vtr(const LAS unsigned char* p) { return __builtin_bit_cast(s16x4, __builtin_amdgcn_ds_read_tr16_b64_v4i16((LAS s16x4*)p)); }
__device__ __forceinline__ bf16x8 fragP(const LAS unsigned char* M, int row, int k0, int hi) {
    const LAS unsigned char* p = M + row * PS + (k0 + 4 * hi) * 2; const s16x4 lo = *(const LAS s16x4*)p, h = *(const LAS s16x4*)(p + 16);
    return (bf16x8){lo[0], lo[1], lo[2], lo[3], h[0], h[1], h[2], h[3]}; }
__device__ __forceinline__ bf16x8 fragT(const LAS unsigned char* M, int k0, int colblk, int lane, int hi) {
    const LAS unsigned char* p = M + (colblk * 4 + (k0 >> 4)) * 1024 + ((lane >> 4) & 1) * 32 + (lane & 3) * 8 + (4 * hi + ((lane & 15) >> 2)) * 64;
    const s16x4 lo = vtr(p), h = vtr(p + 512); return (bf16x8){lo[0], lo[1], lo[2], lo[3], h[0], h[1], h[2], h[3]}; }
__device__ __forceinline__ bf16x8 packR(const f32x16& x, int s) {
    u32x4 w; w.x = pk2(x[8 * s], x[8 * s + 1]); w.y = pk2(x[8 * s + 2], x[8 * s + 3]); w.z = pk2(x[8 * s + 4], x[8 * s + 5]); w.w = pk2(x[8 * s + 6], x[8 * s + 7]); return __builtin_bit_cast(bf16x8, w); }
#define CK_MFMA(a, b, c) __builtin_amdgcn_mfma_f32_32x32x16_bf16(a, b, c, 0, 0, 0)
__device__ __forceinline__ f32x16 score(const LAS unsigned char* Am, const LAS unsigned char* Bm, int sblk, int tblk, int mode, int r32, int hi) {
    f32x16 x = f32x16{};
#pragma unroll
    for (int ks = 0; ks < 4; ++ks) x = CK_MFMA(fragP(Am, sblk * 32 + r32, 16 * ks, hi), fragP(Bm, tblk * 32 + r32, 16 * ks, hi), x);
    if (mode) {
        const int t = tblk * 32 + r32;
#pragma unroll
        for (int r = 0; r < 16; ++r) { const int s = sblk * 32 + crow(r, hi); if (mode == 1 ? !(s < t) : !(s <= t)) x[r] = 0.f; }
    }
    return x;
}
__device__ __forceinline__ void storeT_V(LAS unsigned char* M, const f32x16& x, int rb, int c, int hi) {
#pragma unroll
    for (int q = 0; q < 4; ++q) { u32x2 w; w.x = pk2(x[4 * q], x[4 * q + 1]); w.y = pk2(x[4 * q + 2], x[4 * q + 3]); *(LAS u32x2*)(M + voff(c, rb * 32 + 8 * q + 4 * hi)) = w; }
}
__device__ __forceinline__ void storeT_S(LAS unsigned char* M, const f32x16& x, int rb, int c, int hi) {
#pragma unroll
    for (int q = 0; q < 4; ++q) { u32x2 w; w.x = pk2(x[4 * q], x[4 * q + 1]); w.y = pk2(x[4 * q + 2], x[4 * q + 3]); *(LAS u32x2*)(M + c * PS + (rb * 32 + 8 * q + 4 * hi) * 2) = w; }
}

__device__ __forceinline__ void chunk_item(LAS unsigned char* lds, const Args& a, int item) {
    int tid = threadIdx.x; asm volatile("" : "+v"(tid)); int lane = tid & 63; const int wave = __builtin_amdgcn_readfirstlane(tid >> 6);
#define CK_FRESH() asm volatile("" : "+v"(lane)); r32 = lane & 31; hi = lane >> 5
    int r32, hi; CK_FRESH();
    unsigned char* ws = a.ws;
    const bf16_t* SR = (const bf16_t*)(ws + WS_SR); const bf16_t* SK = (const bf16_t*)(ws + WS_SK); const bf16_t* SV = (const bf16_t*)(ws + WS_SV);
    const bf16_t* SA = (const bf16_t*)(ws + WS_SA); const bf16_t* SB = (const bf16_t*)(ws + WS_SB); const float* SW = (const float*)(ws + WS_SW);
    bf16_t* CG = (bf16_t*)(ws + WS_CG) + (size_t)item * 4096; bf16_t* CH = (bf16_t*)(ws + WS_CH) + (size_t)item * 4096;
    bf16_t* CR2 = (bf16_t*)(ws + WS_CR2) + (size_t)item * 4096; bf16_t* CY0 = (bf16_t*)(ws + WS_CY0) + (size_t)item * 4096;
    const int bh = item >> 6, c = item & 63, b = bh >> 3, h = bh & 7, tokc = b * SEQ + c * 64, col0 = h * 64;
    LAS unsigned char* BT = lds + O_BT; LAS unsigned char* KT = lds + O_KT; LAS unsigned char* AP = lds + O_AP; LAS unsigned char* RT = lds + O_RT;
    LAS unsigned char* AT = lds + O_AT; LAS unsigned char* BH = lds + O_BH; LAS unsigned char* KH = lds + O_KH; LAS unsigned char* VV = lds + O_VV;
    LAS unsigned char* TN = lds + O_TN; LAS unsigned char* A2M = lds + O_A2; LAS unsigned char* V2M = lds + O_V2;
    LAS float* L = (LAS float*)(lds + O_L); LAS float* TOT = (LAS float*)(lds + O_TOT); LAS float* GC = (LAS float*)(lds + O_GC);
    {
        const int tl = tid >> 3, c8 = (tid & 7) * 8, cr = col0 + c8, t = tokc + tl;
        const bf16_t* P = (const bf16_t*)(ws + WS_P); const bf16_t* pr = P + (size_t)t * NINP + cr;
        bf16_t* SVo = (bf16_t*)(ws + WS_SV); bf16_t* SGo = (bf16_t*)(ws + WS_SG); bf16_t* QN = (bf16_t*)(ws + WS_QN); bf16_t* KN = (bf16_t*)(ws + WS_KN);
        const float* mu = a.in[3];
        const bool first = (t & (SEQ - 1)) == 0; const u32x4 zz = (u32x4){0u, 0u, 0u, 0u};
#define CK_PK8(v) ((u32x4){pk2(v[0], v[1]), pk2(v[2], v[3]), pk2(v[4], v[5]), pk2(v[6], v[7])})
#define CK_ST_P(M, val_) do { LAS unsigned char* d_ = (M) + tl * PS + c8 * 2; const u32x4 q_ = (val_); *(LAS u32x2*)d_ = (u32x2){q_[0], q_[1]}; *(LAS u32x2*)(d_ + 8) = (u32x2){q_[2], q_[3]}; } while (0)
        float g[8], gp[8], ig[8], gC[8];
        {
            const u32x4 deu = *(const LAS u32x4*)(TN + tl * 128 + c8 * 2); const f32x4 de0 = cvlo(deu), de1 = cvhi(deu);
            float wv[8] = {__builtin_amdgcn_exp2f(de0.x), __builtin_amdgcn_exp2f(de0.y), __builtin_amdgcn_exp2f(de0.z), __builtin_amdgcn_exp2f(de0.w), __builtin_amdgcn_exp2f(de1.x), __builtin_amdgcn_exp2f(de1.y), __builtin_amdgcn_exp2f(de1.z), __builtin_amdgcn_exp2f(de1.w)};
            float p[8];
#pragma unroll
            for (int j = 0; j < 8; ++j) p[j] = wv[j];
#pragma unroll
            for (int d = 8; d < 64; d <<= 1) {
#pragma unroll
                for (int j = 0; j < 8; ++j) { const float q = __shfl_up(p[j], d); if (lane >= d) p[j] *= q; }
            }
            if ((lane >> 3) == 7) { *(LAS f32x4*)(TOT + wave * 64 + c8) = (f32x4){p[0], p[1], p[2], p[3]}; *(LAS f32x4*)(TOT + wave * 64 + c8 + 4) = (f32x4){p[4], p[5], p[6], p[7]}; }
            __syncthreads();
            float pre[8];
#pragma unroll
            for (int j = 0; j < 8; ++j) { pre[j] = 1.f; gC[j] = 1.f; }
#pragma unroll
            for (int w2 = 0; w2 < 8; ++w2) { const f32x4 t0 = *(const LAS f32x4*)(TOT + w2 * 64 + c8), t1 = *(const LAS f32x4*)(TOT + w2 * 64 + c8 + 4);
                const float tv[8] = {t0.x, t0.y, t0.z, t0.w, t1.x, t1.y, t1.z, t1.w};
#pragma unroll
                for (int j = 0; j < 8; ++j) { if (w2 < wave) pre[j] *= tv[j]; gC[j] *= tv[j]; } }
            if (tid < 8) { *(LAS f32x4*)(GC + c8) = (f32x4){gC[0], gC[1], gC[2], gC[3]}; *(LAS f32x4*)(GC + c8 + 4) = (f32x4){gC[4], gC[5], gC[6], gC[7]}; }
#pragma unroll
            for (int j = 0; j < 8; ++j) { g[j] = pre[j] * p[j]; ig[j] = __builtin_amdgcn_rcpf(g[j]); gp[j] = g[j] * __builtin_amdgcn_rcpf(wv[j]); }
        }
        f32x4 r0, r1;
        { const u32x4 cu = *(const u32x4*)(pr), pu = first ? zz : *(const u32x4*)(pr - NINP);
          const f32x4 m0 = *(const f32x4*)(mu + cr), m1 = *(const f32x4*)(mu + cr + 4); const f32x4 c0 = cvlo(cu), c1 = cvhi(cu), p0 = cvlo(pu), p1 = cvhi(pu);
          r0 = c0 + (p0 - c0) * m0; r1 = c1 + (p1 - c1) * m1;
          const float rt[8] = {r0.x * g[0], r0.y * g[1], r0.z * g[2], r0.w * g[3], r1.x * g[4], r1.y * g[5], r1.z * g[6], r1.w * g[7]};
          CK_ST_P(RT, CK_PK8(rt)); }
        { const u32x4 cu = *(const u32x4*)(pr + 1024), pu = first ? zz : *(const u32x4*)(pr - NINP + 1024);
          const f32x4 m0 = *(const f32x4*)(mu + 1024 + cr), m1 = *(const f32x4*)(mu + 1024 + cr + 4); const f32x4 c0 = cvlo(cu), c1 = cvhi(cu), p0 = cvlo(pu), p1 = cvhi(pu);
          const u32x4 uv = pk8(c0 + (p0 - c0) * m0, c1 + (p1 - c1) * m1); *(u32x4*)(SVo + (size_t)t * CW + cr) = uv; *(LAS u32x4*)(VV + voff(tl, c8)) = uv; }
        *(u32x4*)(SGo + (size_t)t * CW + cr) = *(const LAS u32x4*)(V2M + tl * 128 + c8 * 2);
        { const u32x4 cu = *(const u32x4*)(pr + 512), pu = first ? zz : *(const u32x4*)(pr - NINP + 512);
          const f32x4 m0 = *(const f32x4*)(mu + 512 + cr), m1 = *(const f32x4*)(mu + 512 + cr + 4); const f32x4 c0 = cvlo(cu), c1 = cvhi(cu), p0 = cvlo(pu), p1 = cvhi(pu);
          const f32x4 k0 = c0 + (p0 - c0) * m0, k1 = c1 + (p1 - c1) * m1;
          const u32x4 alu = *(const LAS u32x4*)(A2M + tl * 128 + c8 * 2); const f32x4 al0 = cvlo(alu), al1 = cvhi(alu);
          const f32x4 kk0 = k0 * *(const f32x4*)(a.in[9] + cr), kk1 = k1 * *(const f32x4*)(a.in[9] + cr + 4);
          const float ss = red8((kk0.x * kk0.x + kk0.y * kk0.y) + (kk0.z * kk0.z + kk0.w * kk0.w) + (kk1.x * kk1.x + kk1.y * kk1.y) + (kk1.z * kk1.z + kk1.w * kk1.w));
          const float inv = 1.0f / sqrtf(fmaxf(ss, 1e-24f));
          const f32x4 kn0 = kk0 * inv, kn1 = kk1 * inv;
          const f32x4 k20 = k0 * (1.0f + (al0 - 1.0f) * *(const f32x4*)(a.in[10] + cr)), k21 = k1 * (1.0f + (al1 - 1.0f) * *(const f32x4*)(a.in[10] + cr + 4));
          { const f32x4 q0 = r0 * k20 * *(const f32x4*)(a.in[11] + cr), q1 = r1 * k21 * *(const f32x4*)(a.in[11] + cr + 4);
            const float rk = red8((q0.x + q0.y) + (q0.z + q0.w) + (q1.x + q1.y) + (q1.z + q1.w));
            if ((lane & 7) == 0) ((float*)(ws + WS_RK))[(size_t)t * 8 + h] = rk; }
          const float kv[8] = {k20.x, k20.y, k20.z, k20.w, k21.x, k21.y, k21.z, k21.w}, nv[8] = {kn0.x, kn0.y, kn0.z, kn0.w, kn1.x, kn1.y, kn1.z, kn1.w}, av_[8] = {al0.x, al0.y, al0.z, al0.w, al1.x, al1.y, al1.z, al1.w};
          float at[8], bt[8], kt[8], bh[8], kh[8];
#pragma unroll
          for (int j = 0; j < 8; ++j) { at[j] = -nv[j] * gp[j]; bt[j] = nv[j] * av_[j] * ig[j]; kt[j] = kv[j] * ig[j]; bh[j] = bt[j] * gC[j]; kh[j] = kt[j] * gC[j]; }
          const u32x4 wa = CK_PK8(at);
          CK_ST_P(AP, wa); *(LAS u32x4*)(AT + voff(tl, c8)) = wa;
          CK_ST_P(BT, CK_PK8(bt)); CK_ST_P(KT, CK_PK8(kt));
          *(LAS u32x4*)(BH + voff(tl, c8)) = CK_PK8(bh); *(LAS u32x4*)(KH + voff(tl, c8)) = CK_PK8(kh); }
        { const u32x4 uq = *(const u32x4*)(pr + DQ0), ukd = *(const u32x4*)(pr + DK0);
          const f32x4 q0 = cvlo(uq), q1 = cvhi(uq), d0 = cvlo(ukd), d1 = cvhi(ukd);
          const float qs = red8((q0.x * q0.x + q0.y * q0.y) + (q0.z * q0.z + q0.w * q0.w) + (q1.x * q1.x + q1.y * q1.y) + (q1.z * q1.z + q1.w * q1.w));
          const float ks = red8((d0.x * d0.x + d0.y * d0.y) + (d0.z * d0.z + d0.w * d0.w) + (d1.x * d1.x + d1.y * d1.y) + (d1.z * d1.z + d1.w * d1.w));
          const float qi = (1.0f / sqrtf(qs * (1.0f / 64.0f) + 1e-5f)) * (0.125f * LOG2E), ki = 1.0f / sqrtf(ks * (1.0f / 64.0f) + 1e-5f);
          const f32x4 g0 = *(const f32x4*)(a.in[14] + c8), g1 = *(const f32x4*)(a.in[14] + c8 + 4), h0 = *(const f32x4*)(a.in[15] + c8), h1 = *(const f32x4*)(a.in[15] + c8 + 4);
          *(u32x4*)(QN + (size_t)t * CW + cr) = pk8(q0 * qi * g0, q1 * qi * g1);
          const size_t ko = ((((size_t)(b * 8 + h) * 64 + c) * 8 + (c8 >> 3)) * 64 + tl) * 8;
          *(u32x4*)(KN + ko) = pk8(d0 * ki * h0, d1 * ki * h1); }
#undef CK_PK8
#undef CK_ST_P
    }
    __syncthreads();
    CK_FRESH();
    f32x16 pa = f32x16{}, pb = f32x16{}, pc = f32x16{}, pd = f32x16{};
#define w1a pa
#define w1b pb
#define xb0 pa
#define xb1 pb
#define y0a pc
#define y0b pd
    if (wave < 2) {
        for (int k = 0; k < (wave == 0 ? 2 : 1); ++k) {
            const int sblk = wave == 0 ? k : 0, tblk = wave == 0 ? k : 1;
            const f32x16 x = score(BT, AP, sblk, tblk, wave == 0 ? 1 : 0, r32, hi);
            const int t = tblk * 32 + r32;
#pragma unroll
            for (int r = 0; r < 16; ++r) L[(sblk * 32 + crow(r, hi)) * LSTR + t] = x[r];
        }
    }
    __syncthreads();
    CK_FRESH();
    if (wave == 6) {
        float x[32];
#pragma unroll
        for (int t = 0; t < 32; ++t) x[t] = (r32 == t) ? 1.f : 0.f;
        const LAS float* Nr = L + (32 * hi) * LSTR + 32 * hi;
#pragma unroll
        for (int sidx = 0; sidx < 31; ++sidx) {
#pragma unroll
            for (int g4 = (sidx + 1) / 4; g4 < 8; ++g4) {
                const f32x4 nv = *(const LAS f32x4*)(Nr + sidx * LSTR + 4 * g4);
                if (4 * g4 + 0 > sidx) x[4 * g4 + 0] += nv.x * x[sidx];
                if (4 * g4 + 1 > sidx) x[4 * g4 + 1] += nv.y * x[sidx];
                if (4 * g4 + 2 > sidx) x[4 * g4 + 2] += nv.z * x[sidx];
                if (4 * g4 + 3 > sidx) x[4 * g4 + 3] += nv.w * x[sidx];
            }
            if ((sidx & 3) == 3) __builtin_amdgcn_sched_barrier(0);
        }
        const int cc = 32 * hi + r32;
#pragma unroll
        for (int t0 = 0; t0 < 32; t0 += 8) { u32x4 w; w.x = pk2(x[t0], x[t0 + 1]); w.y = pk2(x[t0 + 2], x[t0 + 3]); w.z = pk2(x[t0 + 4], x[t0 + 5]); w.w = pk2(x[t0 + 6], x[t0 + 7]);
            *(LAS u32x4*)(TN + voff(cc, 32 * hi + t0)) = w; }
        f32x16 m = f32x16{};
#pragma unroll
        for (int s = 0; s < 2; ++s) {
            const LAS float* lp = L + (16 * s + 4 * hi) * LSTR + 32 + r32;
            u32x4 aw; aw.x = pk2(lp[0], lp[LSTR]); aw.y = pk2(lp[2 * LSTR], lp[3 * LSTR]); aw.z = pk2(lp[8 * LSTR], lp[9 * LSTR]); aw.w = pk2(lp[10 * LSTR], lp[11 * LSTR]);
            const s16x4 b0 = *(const LAS s16x4*)(TN + voff(r32, 16 * s + 4 * hi)), b1 = *(const LAS s16x4*)(TN + voff(r32, 16 * s + 8 + 4 * hi));
            m = CK_MFMA(__builtin_bit_cast(bf16x8, aw), ((bf16x8){b0[0], b0[1], b0[2], b0[3], b1[0], b1[1], b1[2], b1[3]}), m);
        }
        f32x16 t21 = f32x16{};
#pragma unroll
        for (int s = 0; s < 2; ++s) t21 = CK_MFMA(fragT(TN, 32 + 16 * s, 1, lane, hi), packR(m, s), t21);
        storeT_V(TN, t21, 1, r32, hi);
    } else if (wave < 4) {
        const int dvb = wave - 2;
        const f32x16 x00 = score(KT, AP, 0, 0, 1, r32, hi), x01 = score(KT, AP, 0, 1, 0, r32, hi), x11 = score(KT, AP, 1, 1, 1, r32, hi);
#pragma unroll
        for (int s = 0; s < 2; ++s) {
            const bf16x8 v0 = fragT(VV, 16 * s, dvb, lane, hi), v1 = fragT(VV, 32 + 16 * s, dvb, lane, hi);
            w1a = CK_MFMA(packR(x00, s), v0, w1a);
            w1b = CK_MFMA(packR(x01, s), v0, w1b);
            w1b = CK_MFMA(packR(x11, s), v1, w1b);
        }
    } else if (wave < 6) {
        const int tb = wave - 4;
        f32x16 xk0, xk1 = f32x16{};
        if (tb == 0) { xk0 = score(KT, RT, 0, 0, 2, r32, hi); xb0 = score(BT, RT, 0, 0, 2, r32, hi); }
        else { xk0 = score(KT, RT, 0, 1, 0, r32, hi); xk1 = score(KT, RT, 1, 1, 2, r32, hi); xb0 = score(BT, RT, 0, 1, 0, r32, hi); xb1 = score(BT, RT, 1, 1, 2, r32, hi); }
#pragma unroll
        for (int s = 0; s < 2; ++s) {
            y0a = CK_MFMA(fragT(VV, 16 * s, 0, lane, hi), packR(xk0, s), y0a);
            y0b = CK_MFMA(fragT(VV, 16 * s, 1, lane, hi), packR(xk0, s), y0b);
            if (tb == 1) { y0a = CK_MFMA(fragT(VV, 32 + 16 * s, 0, lane, hi), packR(xk1, s), y0a); y0b = CK_MFMA(fragT(VV, 32 + 16 * s, 1, lane, hi), packR(xk1, s), y0b); }
        }
    }
    __syncthreads();
    CK_FRESH();
    if (wave < 2) {
        const int cb = wave; f32x16 a0 = f32x16{}, a1 = f32x16{};
#pragma unroll
        for (int ks = 0; ks < 4; ++ks) {
            const bf16x8 af = fragT(AT, 16 * ks, cb, lane, hi);
            if (ks < 2) a0 = CK_MFMA(af, fragT(TN, 16 * ks, 0, lane, hi), a0);
            a1 = CK_MFMA(af, fragT(TN, 16 * ks, 1, lane, hi), a1);
        }
        storeT_V(A2M, a0, cb, r32, hi); storeT_V(A2M, a1, cb, 32 + r32, hi);
    } else if (wave < 4) {
        const int dvb = wave - 2; f32x16 v0 = f32x16{}, v1 = f32x16{};
#pragma unroll
        for (int s = 0; s < 2; ++s) {
            v0 = CK_MFMA(packR(w1a, s), fragT(TN, 16 * s, 0, lane, hi), v0);
            v1 = CK_MFMA(packR(w1a, s), fragT(TN, 16 * s, 1, lane, hi), v1);
            v1 = CK_MFMA(packR(w1b, s), fragT(TN, 32 + 16 * s, 1, lane, hi), v1);
        }
        storeT_V(V2M, v0, dvb, r32, hi); storeT_V(V2M, v1, dvb, 32 + r32, hi);
    }
    __syncthreads();
    CK_FRESH();
    if (wave >= 4 && wave < 6) {
        const int tb = wave - 4, t = tb * 32 + r32;
        f32x16 r0 = f32x16{}, r1 = f32x16{};
#pragma unroll
        for (int s = 0; s < 2; ++s) {
            const bf16x8 p0 = packR(xb0, s);
            r0 = CK_MFMA(fragT(A2M, 16 * s, 0, lane, hi), p0, r0); r1 = CK_MFMA(fragT(A2M, 16 * s, 1, lane, hi), p0, r1);
            y0a = CK_MFMA(fragT(V2M, 16 * s, 0, lane, hi), p0, y0a); y0b = CK_MFMA(fragT(V2M, 16 * s, 1, lane, hi), p0, y0b);
            if (tb == 1) { const bf16x8 p1 = packR(xb1, s);
                r0 = CK_MFMA(fragT(A2M, 32 + 16 * s, 0, lane, hi), p1, r0); r1 = CK_MFMA(fragT(A2M, 32 + 16 * s, 1, lane, hi), p1, r1);
                y0a = CK_MFMA(fragT(V2M, 32 + 16 * s, 0, lane, hi), p1, y0a); y0b = CK_MFMA(fragT(V2M, 32 + 16 * s, 1, lane, hi), p1, y0b); }
        }
#pragma unroll
        for (int q = 0; q < 4; ++q) {
            const u32x2 u0 = *(const LAS u32x2*)(RT + t * PS + (8 * q + 4 * hi) * 2), u1 = *(const LAS u32x2*)(RT + t * PS + (32 + 8 * q + 4 * hi) * 2);
            r0[4 * q] += bflo(u0.x); r0[4 * q + 1] += bfhi(u0.x); r0[4 * q + 2] += bflo(u0.y); r0[4 * q + 3] += bfhi(u0.y);
            r1[4 * q] += bflo(u1.x); r1[4 * q + 1] += bfhi(u1.x); r1[4 * q + 2] += bflo(u1.y); r1[4 * q + 3] += bfhi(u1.y);
        }
        storeT_S(BT, r0, 0, t, hi); storeT_S(BT, r1, 1, t, hi);
        storeT_S(KT, y0a, 0, t, hi); storeT_S(KT, y0b, 1, t, hi);
    } else if (wave < 2) {
        const int ib = wave, i = ib * 32 + r32; const float gci = GC[i];
        f32x16 g0 = f32x16{}, g1 = f32x16{};
#pragma unroll
        for (int ks = 0; ks < 4; ++ks) { const bf16x8 bf_ = fragT(BH, 16 * ks, ib, lane, hi);
            g0 = CK_MFMA(fragT(A2M, 16 * ks, 0, lane, hi), bf_, g0); g1 = CK_MFMA(fragT(A2M, 16 * ks, 1, lane, hi), bf_, g1); }
#pragma unroll
        for (int r = 0; r < 16; ++r) { if (crow(r, hi) == i) g0[r] += gci; if (32 + crow(r, hi) == i) g1[r] += gci; }
        storeT_S(AP, g0, 0, i, hi); storeT_S(AP, g1, 1, i, hi);
    } else {
        const int id = wave < 4 ? wave - 2 : wave - 4, ib = id >> 1, dvb = id & 1;
        f32x16 hh = f32x16{};
#pragma unroll
        for (int ks = 0; ks < 4; ++ks) {
            hh = CK_MFMA(fragT(BH, 16 * ks, ib, lane, hi), fragT(V2M, 16 * ks, dvb, lane, hi), hh);
            hh = CK_MFMA(fragT(KH, 16 * ks, ib, lane, hi), fragT(VV, 16 * ks, dvb, lane, hi), hh);
        }
        storeT_S((LAS unsigned char*)L, hh, ib, dvb * 32 + r32, hi);
    }
    __syncthreads();
    {
        asm volatile("" : "+v"(tid));
        const int row = tid >> 3, ch = tid & 7;
        const LAS unsigned char* s0 = BT + row * PS + ch * 16; const LAS unsigned char* s1 = KT + row * PS + ch * 16; const LAS unsigned char* s2 = AP + row * PS + ch * 16; const LAS unsigned char* s3 = (const LAS unsigned char*)L + row * PS + ch * 16;
        const u32x2 a0 = *(const LAS u32x2*)s0, a1 = *(const LAS u32x2*)(s0 + 8), b0 = *(const LAS u32x2*)s1, b1 = *(const LAS u32x2*)(s1 + 8);
        const u32x2 c0 = *(const LAS u32x2*)s2, c1 = *(const LAS u32x2*)(s2 + 8), d0 = *(const LAS u32x2*)s3, d1 = *(const LAS u32x2*)(s3 + 8);
        *(u32x4*)(CR2 + row * 64 + ch * 8) = (u32x4){a0.x, a0.y, a1.x, a1.y}; *(u32x4*)(CY0 + row * 64 + ch * 8) = (u32x4){b0.x, b0.y, b1.x, b1.y};
        *(u32x4*)(CG + row * 64 + ch * 8) = (u32x4){c0.x, c0.y, c1.x, c1.y}; *(u32x4*)(CH + row * 64 + ch * 8) = (u32x4){d0.x, d0.y, d1.x, d1.y};
    }
    asm volatile("s_waitcnt lgkmcnt(0)" ::: "memory"); __builtin_amdgcn_s_barrier();
#undef CK_FRESH
#undef w1a
#undef w1b
#undef xb0
#undef xb1
#undef y0a
#undef y0b
}

__device__ __forceinline__ void fused_item(LAS unsigned char* lds, const Args& a, int bc) {
    const int tid = threadIdx.x, lane = tid & 63; const int wave = __builtin_amdgcn_readfirstlane(tid >> 6);
    unsigned char* ws = a.ws;
    const bf16_t* P = (const bf16_t*)(ws + WS_P); const bf16_t* LW = (const bf16_t*)(ws + WS_LW); const float* mu = a.in[3];
    const int b = bc >> 6, c = bc & 63, tokc = b * SEQ + c * 64;
    LAS unsigned char* ACT = lds + O_ACT; LAS unsigned char* DECb = lds + O_TN; LAS unsigned char* ALRb = lds + O_A2; LAS unsigned char* GGb = lds + O_V2;
    for (int it = tid; it < 1280; it += 512) {
        const int tok = it / 20, ch = it - tok * 20, t = tokc + tok, col = 1536 + ch * 8;
        const u32x4 cu = *(const u32x4*)(P + (size_t)t * NINP + col);
        u32x4 pu = (u32x4){0u, 0u, 0u, 0u};
        if (t & (SEQ - 1)) pu = *(const u32x4*)(P + (size_t)(t - 1) * NINP + col);
        const f32x4 m0 = *(const f32x4*)(mu + col), m1 = *(const f32x4*)(mu + col + 4);
        const f32x4 c0 = cvlo(cu), c1 = cvhi(cu), p0 = cvlo(pu), p1 = cvhi(pu);
        f32x4 s0 = c0 + (p0 - c0) * m0, s1 = c1 + (p1 - c1) * m1;
        if (ch < 4) {
#pragma unroll
            for (int i = 0; i < 4; ++i) { const float e0 = __expf(-2.0f * fabsf(s0[i])), e1 = __expf(-2.0f * fabsf(s1[i])); const float th0 = (1.0f - e0) / (1.0f + e0), th1 = (1.0f - e1) / (1.0f + e1);
                s0[i] = s0[i] < 0.f ? -th0 : th0; s1[i] = s1[i] < 0.f ? -th1 : th1; }
        } else if (ch >= 8) {
#pragma unroll
            for (int i = 0; i < 4; ++i) { s0[i] = sigmoidf_(s0[i]); s1[i] = sigmoidf_(s1[i]); }
        }
        *(LAS u32x4*)(ACT + tok * 320 + ch * 16) = pk8(s0, s1);
    }
    __syncthreads();
#pragma clang loop unroll(disable)
    for (int h = 0; h < 8; ++h) {
        {
            int ln = lane; asm volatile("" : "+v"(ln));
            const int mt = wave >> 1, fcol = ln & 15, fq = ln >> 4;
            bf16x8 af[5];
#pragma unroll
            for (int kb = 0; kb < 5; ++kb) af[kb] = *(const LAS bf16x8*)(ACT + (mt * 16 + fcol) * 320 + kb * 64 + fq * 16);
#pragma unroll
            for (int cbi = 0; cbi < 2; ++cbi) {
                const int cb = (wave & 1) * 2 + cbi, col = h * 64 + cb * 16 + fcol;
                const bf16_t* lw = LW + (size_t)col * 160 + fq * 8;
                const f32x4 z = {0.f, 0.f, 0.f, 0.f};
                const f32x4 aw = __builtin_amdgcn_mfma_f32_16x16x32_bf16(af[0], *(const bf16x8*)(lw), z, 0, 0, 0);
                const f32x4 aa = __builtin_amdgcn_mfma_f32_16x16x32_bf16(af[1], *(const bf16x8*)(lw + 32), z, 0, 0, 0);
                f32x4 ag = __builtin_amdgcn_mfma_f32_16x16x32_bf16(af[2], *(const bf16x8*)(lw + 64), z, 0, 0, 0);
                ag = __builtin_amdgcn_mfma_f32_16x16x32_bf16(af[3], *(const bf16x8*)(lw + 96), ag, 0, 0, 0);
                ag = __builtin_amdgcn_mfma_f32_16x16x32_bf16(af[4], *(const bf16x8*)(lw + 128), ag, 0, 0, 0);
                const float w0c = a.in[4][col], a0c = a.in[6][col];
#pragma unroll
                for (int i = 0; i < 4; ++i) { const int off = (mt * 16 + fq * 4 + i) * 128 + (cb * 16 + fcol) * 2;
                    *(LAS unsigned short*)(DECb + off) = (unsigned short)f2bf(-0.8750325887f * sigmoidf_(aw[i] + w0c));
                    *(LAS unsigned short*)(ALRb + off) = (unsigned short)f2bf(sigmoidf_(aa[i] + a0c));
                    *(LAS unsigned short*)(GGb + off) = (unsigned short)f2bf(ag[i]); }
            }
        }
        __syncthreads();
        chunk_item(lds, a, ((b * 8 + h) << 6) + c);
    }
}
}

namespace ck {
constexpr int SQ_MAT = 8704, SQ_BUF = 6 * SQ_MAT;
constexpr int SQ_OUT = 2 * SQ_BUF;
__device__ __forceinline__ bf16x8 lfrag(const LAS unsigned char* M, int row, int k0, int hi) { return fragP(M, row, k0, hi); }
__device__ __forceinline__ void linit(f32x16& x, const LAS unsigned char* M, int row, int cblk, int hi) {
#pragma unroll
    for (int q = 0; q < 4; ++q) { const u32x2 u = *(const LAS u32x2*)(M + row * PS + (cblk * 32 + 8 * q + 4 * hi) * 2); x[4 * q] = bflo(u.x); x[4 * q + 1] = bfhi(u.x); x[4 * q + 2] = bflo(u.y); x[4 * q + 3] = bfhi(u.y); }
}
__device__ __forceinline__ void seq_head(LAS unsigned char* lds, const Args& a, int bh) {
    const int tid = threadIdx.x, lane = tid & 63, r32 = lane & 31, hi = lane >> 5; const int wave = __builtin_amdgcn_readfirstlane(tid >> 6);
    unsigned char* ws = a.ws;
    const bf16_t* SV = (const bf16_t*)(ws + WS_SV); const bf16_t* SG = (const bf16_t*)(ws + WS_SG); const float* RK = (const float*)(ws + WS_RK); bf16_t* YMIX = (bf16_t*)(ws + WS_YMIX);
    const int b = bh >> 3, h = bh & 7, col0 = h * 64;
    const float* lng = a.in[12] + col0; const float* lnb = a.in[13] + col0;
#define SQ_LOAD(ch) do { const size_t item_ = (size_t)bh * 64 + (ch); LAS unsigned char* bb_ = lds + ((ch) & 1) * SQ_BUF; const size_t t0_ = (size_t)b * SEQ + (ch) * 64; \
        for (int p_ = tid - 128; p_ < 3072; p_ += 384) { const int m_ = p_ >> 9, q_ = p_ & 511, row_ = q_ >> 3, c8_ = (q_ & 7) * 8; u32x4 v_; \
            if (m_ == 0) v_ = *(const u32x4*)((const bf16_t*)(ws + WS_CG) + item_ * 4096 + row_ * 64 + c8_); \
            else if (m_ == 1) v_ = *(const u32x4*)((const bf16_t*)(ws + WS_CH) + item_ * 4096 + row_ * 64 + c8_); \
            else if (m_ == 2) v_ = *(const u32x4*)((const bf16_t*)(ws + WS_CR2) + item_ * 4096 + row_ * 64 + c8_); \
            else if (m_ == 3) v_ = *(const u32x4*)((const bf16_t*)(ws + WS_CY0) + item_ * 4096 + row_ * 64 + c8_); \
            else if (m_ == 4) v_ = *(const u32x4*)(SV + (t0_ + row_) * CW + col0 + c8_); \
            else v_ = *(const u32x4*)(SG + (t0_ + row_) * CW + col0 + c8_); \
            LAS unsigned char* d_ = bb_ + m_ * SQ_MAT + row_ * PS + c8_ * 2; *(LAS u32x2*)d_ = (u32x2){v_.x, v_.y}; *(LAS u32x2*)(d_ + 8) = (u32x2){v_.z, v_.w}; } } while (0)
#define SQ_STORE(ch) do { const LAS unsigned char* ob_ = lds + SQ_OUT + ((ch) & 1) * SQ_MAT; const size_t t0_ = (size_t)b * SEQ + (ch) * 64; \
        for (int p_ = tid - 128; p_ < 512; p_ += 384) { const int row_ = p_ >> 3, c8_ = (p_ & 7) * 8; const LAS unsigned char* s_ = ob_ + row_ * PS + c8_ * 2; \
            const u32x2 lo_ = *(const LAS u32x2*)s_, hi_ = *(const LAS u32x2*)(s_ + 8); *(u32x4*)(YMIX + (t0_ + row_) * D + col0 + c8_) = (u32x4){lo_.x, lo_.y, hi_.x, hi_.y}; } } while (0)
    if (wave >= 2) SQ_LOAD(0);
    __syncthreads();
    f32x16 X00 = f32x16{}, X01 = f32x16{}, X10 = f32x16{}, X11 = f32x16{};
#pragma unroll 1
    for (int c = 0; c < 64; ++c) {
        if (wave >= 2) {
            if (c + 1 < 64) SQ_LOAD(c + 1);
            if (c > 0) SQ_STORE(c - 1);
        } else {
            const int tb = wave;
            const LAS unsigned char* bb = lds + (c & 1) * SQ_BUF;
            const LAS unsigned char* MG = bb; const LAS unsigned char* MH = bb + SQ_MAT; const LAS unsigned char* MR = bb + 2 * SQ_MAT; const LAS unsigned char* MY = bb + 3 * SQ_MAT;
            const LAS unsigned char* MV = bb + 4 * SQ_MAT; const LAS unsigned char* MGT = bb + 5 * SQ_MAT;
            LAS unsigned char* OB = lds + SQ_OUT + (c & 1) * SQ_MAT;
            const int tl = tb * 32 + r32; const size_t t = (size_t)b * SEQ + c * 64 + tl;
            const float rk = RK[t * 8 + h];
            f32x16 y0, y1; linit(y0, MY, tl, 0, hi); linit(y1, MY, tl, 1, hi);
#pragma unroll
            for (int s = 0; s < 2; ++s) {
                const bf16x8 rf0 = lfrag(MR, tl, 16 * s, hi), rf1 = lfrag(MR, tl, 32 + 16 * s, hi);
                y0 = CK_MFMA(packR(X00, s), rf0, y0); y0 = CK_MFMA(packR(X10, s), rf1, y0);
                y1 = CK_MFMA(packR(X01, s), rf0, y1); y1 = CK_MFMA(packR(X11, s), rf1, y1);
            }
#pragma unroll
            for (int db = 0; db < 2; ++db) {
                f32x16 Na, Nb; linit(Na, MH, db * 32 + r32, 0, hi); linit(Nb, MH, db * 32 + r32, 1, hi);
#pragma unroll
                for (int s = 0; s < 2; ++s) {
                    const bf16x8 g00 = lfrag(MG, r32, 16 * s, hi), g01 = lfrag(MG, r32, 32 + 16 * s, hi), g10 = lfrag(MG, 32 + r32, 16 * s, hi), g11 = lfrag(MG, 32 + r32, 32 + 16 * s, hi);
                    const bf16x8 p0 = packR(db ? X01 : X00, s), p1 = packR(db ? X11 : X10, s);
                    Na = CK_MFMA(g00, p0, Na); Na = CK_MFMA(g01, p1, Na);
                    Nb = CK_MFMA(g10, p0, Nb); Nb = CK_MFMA(g11, p1, Nb);
                }
                if (db == 0) { X00 = Na; X10 = Nb; } else { X01 = Na; X11 = Nb; }
            }
            float sm = 0.f;
#pragma unroll
            for (int r = 0; r < 16; ++r) sm += y0[r] + y1[r];
            sm += __shfl_xor(sm, 32);
            const float mean = sm * (1.0f / 64.0f);
            float sq = 0.f;
#pragma unroll
            for (int r = 0; r < 16; ++r) { const float d0 = y0[r] - mean, d1 = y1[r] - mean; sq += d0 * d0 + d1 * d1; }
            sq += __shfl_xor(sq, 32);
            const float rs = 1.0f / sqrtf(sq * (1.0f / 64.0f) + 64e-5f);
#pragma unroll
            for (int db = 0; db < 2; ++db)
#pragma unroll
                for (int q = 0; q < 4; ++q) {
                    const int dv = db * 32 + 8 * q + 4 * hi;
                    const f32x4 lg = *(const f32x4*)(lng + dv), lb = *(const f32x4*)(lnb + dv);
                    const u32x2 uv = *(const LAS u32x2*)(MV + tl * PS + dv * 2), ug = *(const LAS u32x2*)(MGT + tl * PS + dv * 2);
                    const f32x4 vv = {bflo(uv.x), bfhi(uv.x), bflo(uv.y), bfhi(uv.y)}, gg = {bflo(ug.x), bfhi(ug.x), bflo(ug.y), bfhi(ug.y)};
                    f32x4 yy; if (db == 0) yy = (f32x4){y0[4 * q], y0[4 * q + 1], y0[4 * q + 2], y0[4 * q + 3]}; else yy = (f32x4){y1[4 * q], y1[4 * q + 1], y1[4 * q + 2], y1[4 * q + 3]};
                    const f32x4 o = ((yy - mean) * rs * lg + lb + rk * vv) * gg;
                    u32x2 w; w.x = pk2(o.x, o.y); w.y = pk2(o.z, o.w);
                    *(LAS u32x2*)(OB + tl * PS + dv * 2) = w;
                }
        }
        __syncthreads();
    }
    if (wave >= 2) SQ_STORE(63);
#undef SQ_LOAD
#undef SQ_STORE
}
}

namespace att {
constexpr int SLOT = 32768, OFF_V = 16384;
constexpr int TBL_OFF = MISC_OFF + 1024;
constexpr int LW_OFF = MISC_OFF + 2048;
constexpr int CST_OFF = MISC_OFF + 3072;
__device__ __forceinline__ int crow(int r, int hi) { return (r & 3) + 8 * (r >> 2) + 4 * hi; }
__device__ __forceinline__ void glds16(const void* gsrc, unsigned lds_dst) { unsigned keep;
    asm volatile("s_mov_b32 %0, m0\n\ts_mov_b32 m0, %2\n\ts_nop 0\n\tglobal_load_lds_dwordx4 %1, off\n\ts_mov_b32 m0, %0" : "=&s"(keep) : "v"(gsrc), "s"(lds_dst) : "memory"); }
__device__ __forceinline__ s16x4 vtr(const LAS unsigned char* p) { return __builtin_bit_cast(s16x4, __builtin_amdgcn_ds_read_tr16_b64_v4i16((LAS s16x4*)p)); }

__device__ __forceinline__ void attn_unit(LAS unsigned char* lds, const Args& a, int b, int h, int qb, float negM, float lam) {
    const int tid = threadIdx.x, lane = tid & 63, r32 = lane & 31, hi = lane >> 5; const int wid = __builtin_amdgcn_readfirstlane(tid >> 6);
    const int c = wid >> 2, rg = wid & 3;
    unsigned char* ws = a.ws;
    const bf16_t* QN = (const bf16_t*)(ws + WS_QN); const bf16_t* KN = (const bf16_t*)(ws + WS_KN); const bf16_t* P = (const bf16_t*)(ws + WS_P); bf16_t* YMIX = (bf16_t*)(ws + WS_YMIX);
    const int q0 = qb * 128; const size_t rowbase = (size_t)b * SEQ;
    const int NT = 2 * qb + 2;
    LAS float* tbl = (LAS float*)(lds + TBL_OFF); LAS float* lw = (LAS float*)(lds + LW_OFF) + wid * 32;
    if (tid < 128) {
        const int n = tid; int bkt;
        if (n < 16) bkt = n; else { bkt = 16 + (int)(logf((float)n * (1.0f / 16.0f)) / 2.0794415416798357f * 16.0f); bkt = bkt > 31 ? 31 : bkt; }
        tbl[n] = (a.in[21][bkt * 4 + h] - a.in[21][31 * 4 + h]) * LOG2E;
    }
    const bf16_t* Qw = QN + (rowbase + q0 + rg * 32 + r32) * CW + h * 128 + c * 64;
    bf16x8 qr[4];
#pragma unroll
    for (int d0 = 0; d0 < 4; ++d0) qr[d0] = *(const bf16x8*)(Qw + d0 * 16 + hi * 8);
    const bf16_t* k0src = KN + ((((size_t)(b * 8 + h * 2) * 64) * 8 + wid) * 64 + lane) * 8;
    const bf16_t* k1src = k0src + (size_t)64 * 8 * 64 * 8;
    const int pv0 = 2 * wid, pv1 = 2 * wid + 1;
    const bf16_t* VTb = (const bf16_t*)(ws + WS_VT) + (size_t)(b * 4 + h) * 64 * 8192;
    const bf16_t* v0src = VTb + pv0 * 512 + lane * 8;
    const bf16_t* v1src = VTb + pv1 * 512 + lane * 8;
#define ATT_DMA(t, slot) do { const unsigned s_ = lds0 + (unsigned)(slot) * SLOT; \
        glds16(k0src + (size_t)(t) * 4096, (unsigned)__builtin_amdgcn_readfirstlane(s_ + wid * 1024)); \
        glds16(k1src + (size_t)(t) * 4096, (unsigned)__builtin_amdgcn_readfirstlane(s_ + 8192 + wid * 1024)); \
        glds16(v0src + (size_t)(t) * 8192, (unsigned)__builtin_amdgcn_readfirstlane(s_ + OFF_V + pv0 * 1024)); \
        glds16(v1src + (size_t)(t) * 8192, (unsigned)__builtin_amdgcn_readfirstlane(s_ + OFF_V + pv1 * 1024)); } while (0)
#define ATT_SBAR() __builtin_amdgcn_sched_barrier(0)
    const unsigned lds0 = (unsigned)(uintptr_t)lds;
    f32x16 o[4];
#pragma unroll
    for (int d0 = 0; d0 < 4; ++d0) o[d0] = f32x16{};
    float lsum = 0.f;
    const bool shift = negM < -60.0f;
    const int qmin = q0 + 32 * rg, qpos = qmin + r32;
    ATT_DMA(0, 0);
    asm volatile("s_waitcnt vmcnt(0)" ::: "memory");
    __syncthreads();
    for (int t = 0; t < NT; ++t) {
        if (t + 1 < NT) ATT_DMA(t + 1, (t + 1) & 1);
        const int kmin = 64 * t;
        if (kmin <= qmin + 31) {
            const LAS unsigned char* slot = lds + (t & 1) * SLOT;
            const LAS unsigned char* kb = slot + c * 8192 + hi * 1024 + r32 * 16;
            const LAS unsigned char* vb = slot + OFF_V + ((lane >> 4) & 1) * 32 + (lane & 3) * 8 + (4 * hi + ((lane & 15) >> 2)) * 64;
            bf16x8 kf[8];
#pragma unroll
            for (int d0 = 0; d0 < 4; ++d0) { kf[2 * d0] = *(const LAS bf16x8*)(kb + d0 * 2048); kf[2 * d0 + 1] = *(const LAS bf16x8*)(kb + d0 * 2048 + 512); }
            s16x4 va[16], vc[16];
#pragma unroll
            for (int i = 0; i < 8; ++i) { va[2 * i] = vtr(vb + (i >> 2) * 4096 + (i & 3) * 1024); va[2 * i + 1] = vtr(vb + (i >> 2) * 4096 + (i & 3) * 1024 + 512); }
            ATT_SBAR();
            f32x16 p0, p1;
            p0 = __builtin_amdgcn_mfma_f32_32x32x16_bf16(kf[0], qr[0], f32x16{}, 0, 0, 0); p1 = __builtin_amdgcn_mfma_f32_32x32x16_bf16(kf[1], qr[0], f32x16{}, 0, 0, 0);
#pragma unroll
            for (int d0 = 1; d0 < 4; ++d0) { p0 = __builtin_amdgcn_mfma_f32_32x32x16_bf16(kf[2 * d0], qr[d0], p0, 0, 0, 0); p1 = __builtin_amdgcn_mfma_f32_32x32x16_bf16(kf[2 * d0 + 1], qr[d0], p1, 0, 0, 0); }
            ATT_SBAR();
            if (qmin - (kmin + 63) < 113) {
#pragma unroll
                for (int r = 0; r < 16; ++r) {
                    const int d0_ = qpos - (kmin + crow(r, hi)); const int d1_ = d0_ - 32;
                    const float t0 = tbl[d0_ < 0 ? 0 : (d0_ > 127 ? 127 : d0_)], t1 = tbl[d1_ < 0 ? 0 : (d1_ > 127 ? 127 : d1_)];
                    p0[r] = d0_ < 0 ? -INFINITY : p0[r] + t0; p1[r] = d1_ < 0 ? -INFINITY : p1[r] + t1;
                }
            }
            if (shift) {
#pragma unroll
                for (int r = 0; r < 16; ++r) { p0[r] += negM; p1[r] += negM; }
            }
            float sacc = 0.f;
#pragma unroll
            for (int r = 0; r < 16; ++r) { p0[r] = __builtin_amdgcn_exp2f(p0[r]); p1[r] = __builtin_amdgcn_exp2f(p1[r]); sacc += p0[r] + p1[r]; }
            lsum += sacc;
            u32x4 pw[4];
#pragma unroll
            for (int i = 0; i < 4; ++i) { pw[0][i] = pk2(p0[2 * i], p0[2 * i + 1]); pw[1][i] = pk2(p0[8 + 2 * i], p0[8 + 2 * i + 1]); pw[2][i] = pk2(p1[2 * i], p1[2 * i + 1]); pw[3][i] = pk2(p1[8 + 2 * i], p1[8 + 2 * i + 1]); }
            ATT_SBAR();
#pragma unroll
            for (int i = 0; i < 8; ++i) { vc[2 * i] = vtr(vb + (2 + (i >> 2)) * 4096 + (i & 3) * 1024); vc[2 * i + 1] = vtr(vb + (2 + (i >> 2)) * 4096 + (i & 3) * 1024 + 512); }
#pragma unroll
            for (int i = 0; i < 8; ++i) {
                const bf16x8 vf = (bf16x8){va[2 * i][0], va[2 * i][1], va[2 * i][2], va[2 * i][3], va[2 * i + 1][0], va[2 * i + 1][1], va[2 * i + 1][2], va[2 * i + 1][3]};
                o[i >> 2] = __builtin_amdgcn_mfma_f32_32x32x16_bf16(__builtin_bit_cast(bf16x8, pw[i & 3]), vf, o[i >> 2], 0, 0, 0);
            }
#pragma unroll
            for (int i = 0; i < 8; ++i) {
                const bf16x8 vf = (bf16x8){vc[2 * i][0], vc[2 * i][1], vc[2 * i][2], vc[2 * i][3], vc[2 * i + 1][0], vc[2 * i + 1][1], vc[2 * i + 1][2], vc[2 * i + 1][3]};
                o[2 + (i >> 2)] = __builtin_amdgcn_mfma_f32_32x32x16_bf16(__builtin_bit_cast(bf16x8, pw[i & 3]), vf, o[2 + (i >> 2)], 0, 0, 0);
            }
        }
        asm volatile("s_waitcnt vmcnt(0)" ::: "memory");
        __syncthreads();
    }
#undef ATT_DMA
#undef ATT_SBAR
    lsum += __shfl_xor(lsum, 32);
    if (hi == 0) lw[r32] = 1.0f / lsum;
    asm volatile("s_waitcnt lgkmcnt(0)" ::: "memory");
    LAS float* stg = (LAS float*)(lds + wid * 16384);
#pragma unroll
    for (int r = 0; r < 16; ++r) { const int orow = crow(r, hi); const float il = lw[orow];
#pragma unroll
        for (int d0 = 0; d0 < 4; ++d0) stg[orow * 128 + d0 * 32 + r32] = o[d0][r] * il; }
    __syncthreads();
    {
        const int row = tid >> 2, part = tid & 3, rgp = row >> 5, rr = row & 31;
        const LAS float* s1 = (const LAS float*)(lds + rgp * 16384) + rr * 128 + part * 32;
        const LAS float* s2 = (const LAS float*)(lds + (4 + rgp) * 16384) + rr * 128 + part * 32;
        float dv[32]; float ss = 0.f;
#pragma unroll
        for (int i = 0; i < 8; ++i) { const f32x4 x1 = *(const LAS f32x4*)(s1 + 4 * i), x2 = *(const LAS f32x4*)(s2 + 4 * i);
#pragma unroll
            for (int j = 0; j < 4; ++j) { const float dd = x1[j] - lam * x2[j]; dv[4 * i + j] = dd; ss += dd * dd; } }
        ss = red4(ss);
        const float sc = (1.0f / sqrtf(ss * (1.0f / 128.0f) + 1e-5f)) * 0.8f;
        const float* sg = a.in[20] + part * 32;
        bf16_t* op = YMIX + (rowbase + q0 + row) * D + CW + h * 128 + part * 32;
#pragma unroll
        for (int i = 0; i < 4; ++i) { u32x4 w;
            w.x = pk2(dv[8 * i] * sc * sg[8 * i], dv[8 * i + 1] * sc * sg[8 * i + 1]); w.y = pk2(dv[8 * i + 2] * sc * sg[8 * i + 2], dv[8 * i + 3] * sc * sg[8 * i + 3]);
            w.z = pk2(dv[8 * i + 4] * sc * sg[8 * i + 4], dv[8 * i + 5] * sc * sg[8 * i + 5]); w.w = pk2(dv[8 * i + 6] * sc * sg[8 * i + 6], dv[8 * i + 7] * sc * sg[8 * i + 7]);
            *(u32x4*)(op + 8 * i) = w; }
    }
    __syncthreads();
}

__device__ __forceinline__ void attn_phase(LAS unsigned char* lds, const Args& a, unsigned* ctl) {
    const int tid = threadIdx.x;
    LAS float* cst = (LAS float*)(lds + CST_OFF);
    if (tid < 64) {
        const float gq = fabsf(a.in[14][tid]), gk = fabsf(a.in[15][tid]);
        float mq = gq, mk = gk;
#pragma unroll
        for (int o = 1; o < 64; o <<= 1) { mq = fmaxf(mq, __shfl_xor(mq, o)); mk = fmaxf(mk, __shfl_xor(mk, o)); }
        const float d1 = wave_sum(a.in[16][tid] * a.in[17][tid]), d2 = wave_sum(a.in[18][tid] * a.in[19][tid]);
        float mb = 0.f;
        if (tid < 32) { for (int hh = 0; hh < 4; ++hh) mb = fmaxf(mb, (a.in[21][tid * 4 + hh] - a.in[21][31 * 4 + hh]) * LOG2E); }
#pragma unroll
        for (int o = 1; o < 64; o <<= 1) mb = fmaxf(mb, __shfl_xor(mb, o));
        if (tid == 0) { cst[0] = -(8.0f * LOG2E * mq * mk * 1.02f + mb); cst[1] = __expf(d1) - __expf(d2) + 0.2f; }
    }
    __syncthreads();
    const float negM = cst[0], lam = cst[1];
    LAS int* ubox = (LAS int*)(lds + CST_OFF + 16);
    for (;;) {
        if (tid == 0) ubox[0] = (int)atomicAdd(ctl + CW_ATTQ, 1u);
        __syncthreads();
        const int u = ubox[0];
        __syncthreads();
        if (u >= 1024) break;
        const int qb = 31 - (u >> 5), bhh = u & 31;
        attn_unit(lds, a, bhh >> 2, bhh & 3, qb, negM, lam);
    }
}
}

__device__ __forceinline__ void p5_router(LAS unsigned char* lds, const Args& a, unsigned* ctl) {
    const int tid = threadIdx.x, lane = tid & 63, r32 = lane & 31, hi = lane >> 5; const int wave = __builtin_amdgcn_readfirstlane(tid >> 6);
    unsigned char* ws = a.ws;
    const bf16_t* x1 = (const bf16_t*)(ws + WS_X1B); const float* g2 = a.in[23]; const float* rw = a.in[24]; const float* rb = a.in[25];
    unsigned char* H2 = ws + WS_H2; int* EIDX = (int*)(ws + WS_EIDX); float* GATE = (float*)(ws + WS_GATE); int* POS = (int*)(ws + WS_POS);
    LAS unsigned char* WH = lds; LAS unsigned char* WL = lds + 65536;
    LAS int* cnt = (LAS int*)(lds + MISC_OFF + 1024);
    LAS int* basel = (LAS int*)(lds + MISC_OFF + 1024 + 128);
    LAS int* el = (LAS int*)(lds + MISC_OFF + 2048);
    LAS int* pl = (LAS int*)(lds + MISC_OFF + 4096);
    {
        const int e = tid & 31;
        for (int k = tid >> 5; k < 1024; k += 16) {
            const float v = rw[k * 32 + e] * g2[k]; const unsigned h = f2bf(v); const float vh = __builtin_bit_cast(float, h << 16); const unsigned l = f2bf(v - vh);
            const int off = e * 2048 + (((k >> 3) ^ (e & 15)) << 4) + (k & 7) * 2;
            *(LAS unsigned short*)(WH + off) = (unsigned short)h; *(LAS unsigned short*)(WL + off) = (unsigned short)l;
        }
    }
    if (tid < 32) cnt[tid] = 0;
    __syncthreads();
    const int TPB = T / (int)gridDim.x, tb0 = blockIdx.x * TPB;
    if (wave < 4) {
        const int tl = wave * 32 + r32, t = tb0 + tl;
        const bf16_t* xrow = x1 + (size_t)t * D + 8 * hi;
        const LAS unsigned char* wh = WH + r32 * 2048; const LAS unsigned char* wl = WL + r32 * 2048; const int sw = r32 & 15;
        f32x16 d = f32x16{}; float ssq = 0.f;
#pragma unroll 8
        for (int s = 0; s < 64; ++s) {
            const u32x4 xb = *(const u32x4*)(xrow + 16 * s);
            const int co = ((2 * s + hi) ^ sw) << 4;
            const bf16x8 ah = *(const LAS bf16x8*)(wh + co), al = *(const LAS bf16x8*)(wl + co);
            const bf16x8 bx = __builtin_bit_cast(bf16x8, xb);
            d = __builtin_amdgcn_mfma_f32_32x32x16_bf16(ah, bx, d, 0, 0, 0);
            d = __builtin_amdgcn_mfma_f32_32x32x16_bf16(al, bx, d, 0, 0, 0);
            const f32x4 x0 = cvlo(xb), x1v = cvhi(xb);
            ssq += (x0.x * x0.x + x0.y * x0.y) + (x0.z * x0.z + x0.w * x0.w) + (x1v.x * x1v.x + x1v.y * x1v.y) + (x1v.z * x1v.z + x1v.w * x1v.w);
        }
        ssq += __shfl_xor(ssq, 32);
        const float rstd = 1.0f / sqrtf(ssq * (1.0f / D) + 1e-5f);
        float lg[16];
#pragma unroll
        for (int r = 0; r < 16; ++r) lg[r] = d[r] * rstd + rb[8 * (r >> 2) + 4 * hi + (r & 3)];
        float tv[4]; int ti[4];
#pragma unroll
        for (int k = 0; k < 4; ++k) {
            float bv = -INFINITY; int bi = 0;
#pragma unroll
            for (int r = 0; r < 16; ++r) { const int e = 8 * (r >> 2) + 4 * hi + (r & 3); if (lg[r] > bv) { bv = lg[r]; bi = e; } }
            tv[k] = bv; ti[k] = bi;
#pragma unroll
            for (int r = 0; r < 16; ++r) { const int e = 8 * (r >> 2) + 4 * hi + (r & 3); if (e == bi) lg[r] = -INFINITY; }
        }
        float ov[4]; int oi[4];
#pragma unroll
        for (int k = 0; k < 4; ++k) { ov[k] = __shfl_xor(tv[k], 32); oi[k] = __shfl_xor(ti[k], 32); }
        float mv[4]; int mi[4];
        {
            int pa = 0, pb = 0;
#pragma unroll
            for (int k = 0; k < 4; ++k) {
                float ca = -INFINITY, cb = -INFINITY; int ia = 0, ib = 0;
#pragma unroll
                for (int q = 0; q < 4; ++q) { if (q == pa) { ca = tv[q]; ia = ti[q]; } if (q == pb) { cb = ov[q]; ib = oi[q]; } }
                const bool takeA = (ca > cb) || (ca == cb && ia < ib);
                mv[k] = takeA ? ca : cb; mi[k] = takeA ? ia : ib; pa += takeA ? 1 : 0; pb += takeA ? 0 : 1;
            }
        }
        const float e1 = __expf(mv[1] - mv[0]), e2 = __expf(mv[2] - mv[0]), e3 = __expf(mv[3] - mv[0]);
        const float inv = 1.0f / (1.0f + e1 + e2 + e3);
        if (hi == 0) {
            *(int4*)(EIDX + (size_t)t * 4) = make_int4(mi[0], mi[1], mi[2], mi[3]);
            *(float4*)(GATE + (size_t)t * 4) = make_float4(inv, e1 * inv, e2 * inv, e3 * inv);
#pragma unroll
            for (int k = 0; k < 4; ++k) { el[tl * 4 + k] = mi[k]; pl[tl * 4 + k] = atomicAdd((int*)(cnt + mi[k]), 1); }
        }
    } else {
        f32x4 gv[4];
#pragma unroll
        for (int j = 0; j < 4; ++j) gv[j] = *((const f32x4*)g2 + lane + 64 * j);
        for (int i = 0; i < 32; ++i) {
            const int t = tb0 + (wave - 4) * 32 + i;
            const u32x2* xr = (const u32x2*)(x1 + (size_t)t * D) + lane;
            f32x4 v[4]; float s = 0.f;
#pragma unroll
            for (int j = 0; j < 4; ++j) { const u32x2 xw = xr[64 * j]; v[j] = (f32x4){bflo(xw.x), bfhi(xw.x), bflo(xw.y), bfhi(xw.y)}; s += (v[j].x * v[j].x + v[j].y * v[j].y) + (v[j].z * v[j].z + v[j].w * v[j].w); }
            const float rstd = (1.0f / sqrtf(wave_sum(s) * (1.0f / D) + 1e-5f)) * F8_X_MUL;
            unsigned* o4 = (unsigned*)(H2 + (size_t)t * D) + lane;
#pragma unroll
            for (int j = 0; j < 4; ++j) { v[j] = v[j] * rstd * gv[j]; o4[64 * j] = pk4_fp8(v[j].x, v[j].y, v[j].z, v[j].w); }
        }
    }
    __syncthreads();
    if (tid < 32) basel[tid] = (int)atomicAdd(ctl + CW_CNT + tid, (unsigned)cnt[tid]);
    __syncthreads();
    for (int i = tid; i < TPB * 4; i += 512) POS[(size_t)tb0 * 4 + i] = pl[i] + basel[el[i]];
}

__device__ __forceinline__ void p6_dispatch(LAS unsigned char* lds, const Args& a, unsigned* ctl) {
    const int tid = threadIdx.x, lane = tid & 63, wave = __builtin_amdgcn_readfirstlane(tid >> 6);
    unsigned char* ws = a.ws;
    const int* EIDX = (const int*)(ws + WS_EIDX); const float* GATE = (const float*)(ws + WS_GATE); const int* POS = (const int*)(ws + WS_POS);
    int* DEST = (int*)(ws + WS_DEST); float* ROWGATE = (float*)(ws + WS_ROWGATE); int* TILEE = (int*)(ws + WS_TILEE); int* ROWTOK = (int*)(ws + WS_ROWTOK);
    LAS int* pstart = (LAS int*)(lds + MISC_OFF + 1024); LAS int* pcnt = pstart + 32;
    if (tid < NE) pcnt[tid] = (int)__hip_atomic_load(ctl + CW_CNT + tid, __ATOMIC_RELAXED, __HIP_MEMORY_SCOPE_AGENT);
    __syncthreads();
    if (tid == 0) {
        int acc = 0;
        for (int e = 0; e < NE; ++e) { pstart[e] = acc; acc += ((pcnt[e] + 255) >> 8) * 256; }
        if (blockIdx.x == 0) TILEE[1023] = acc >> 8;
    }
    __syncthreads();
    if (blockIdx.x == 0 && tid < NE) { const int nt = (pcnt[tid] + 255) >> 8, t0_ = pstart[tid] >> 8; for (int i = 0; i < nt; ++i) TILEE[t0_ + i] = tid; }
    if (blockIdx.x < NE) {
        const int e = blockIdx.x, cn = pcnt[e], pe = ((cn + 255) >> 8) * 256;
        for (int i = cn + tid; i < pe; i += 512) ROWTOK[pstart[e] + i] = 0;
    }
    const int TPB = T / (int)gridDim.x, tb0 = blockIdx.x * TPB;
    for (int pi = tb0 * 4 + tid; pi < (tb0 + TPB) * 4; pi += 512) {
        const int e = EIDX[pi], dest = pstart[e] + POS[pi];
        DEST[pi] = dest; ROWGATE[dest] = GATE[pi]; ROWTOK[dest] = pi >> 2;
    }
}

__device__ __forceinline__ void p9_combine(const Args& a, int G) {
    const int tid = threadIdx.x, lane = tid & 63, wave = __builtin_amdgcn_readfirstlane(tid >> 6);
    unsigned char* ws = a.ws;
    const unsigned char* YS = ws + WS_YS; const int* DEST = (const int*)(ws + WS_DEST);
    float* out = a.out;
    const int gw = blockIdx.x * 8 + wave, NGW = G * 8;
    for (int t = gw; t < T; t += NGW) {
        f32x4* xr = (f32x4*)(out + (size_t)t * D) + lane; const u32x2* xi = (const u32x2*)((const bf16_t*)(ws + WS_X1B) + (size_t)t * D) + lane;
        f32x4 v[4];
#pragma unroll
        for (int j = 0; j < 4; ++j) { const u32x2 xw = xi[64 * j]; v[j] = (f32x4){bflo(xw.x), bfhi(xw.x), bflo(xw.y), bfhi(xw.y)}; }
#pragma unroll
        for (int k = 0; k < 4; ++k) {
            const int dest = DEST[t * 4 + k];
            const unsigned* yr = (const unsigned*)(YS + (size_t)dest * D) + lane;
#pragma unroll
            for (int j = 0; j < 4; ++j) { const unsigned w = yr[64 * j];
                const f32x2 lo = __builtin_amdgcn_cvt_pk_f32_fp8((int)w, false), hi2 = __builtin_amdgcn_cvt_pk_f32_fp8((int)w, true);
                v[j].x += lo.x * (1.0f / F8_Y_MUL); v[j].y += lo.y * (1.0f / F8_Y_MUL); v[j].z += hi2.x * (1.0f / F8_Y_MUL); v[j].w += hi2.y * (1.0f / F8_Y_MUL); }
        }
        if (TIME_REGION >= 0) { const float sc_ = 1.0f + 4e-6f * (float)((const unsigned*)(ws + WS_CTL))[301];
#pragma unroll
            for (int j = 0; j < 4; ++j) v[j] = v[j] * sc_; }
#pragma unroll
        for (int j = 0; j < 4; ++j) xr[64 * j] = v[j];
    }
}

constexpr int NPHASE = 10;
__global__ void __launch_bounds__(512, 2) hymba_fwd(Args args) {
    extern __shared__ __attribute__((aligned(16))) unsigned char lds_raw[];
    LAS unsigned char* lds = (LAS unsigned char*)lds_raw;
    cg::grid_group grid = cg::this_grid();
    const int G = gridDim.x;
    unsigned char* ws = args.ws;
    unsigned* ctl = (unsigned*)(ws + WS_CTL);
    const int lo = args.ph_lo, hi = args.ph_hi;
#define IN(k) (lo <= (k) && (k) < hi)
#define NREP(k) ((REP_PHASE) == (k) ? 2 : 1)
#define TSTART(k) do { if ((TIME_REGION) == (k) && blockIdx.x == 0 && threadIdx.x == 0) ctl[300] = (unsigned)__builtin_amdgcn_s_memrealtime(); } while (0)
#define TEND(k) do { if ((TIME_REGION) == (k) && blockIdx.x == 0 && threadIdx.x == 0) ctl[301] = (unsigned)__builtin_amdgcn_s_memrealtime() - ctl[300]; } while (0)
#define SEAM(k) do { if (IN(k) && IN((k) + 1)) { if (args.ph_lo < 0) grid.sync(); xcd_barrier(xbar); } } while (0)
    const int* TILEE = (const int*)(ws + WS_TILEE);
    { volatile LAS unsigned* st = (volatile LAS unsigned*)(lds + LDS_BYTES - 64); if (threadIdx.x < 2) st[threadIdx.x] = 0u; }
    __syncthreads();
    const XcdBarrier xbar = xcd_barrier_post(ctl + CW_BAR, (volatile LAS unsigned*)(lds + LDS_BYTES - 64));

    if (IN(0)) { for (int rep = 0; rep < NREP(0); ++rep) p0_prologue(lds, args, G); } SEAM(0);
    if (IN(1)) {
        pg8::Gemm g{ws + WS_XN, ws + WS_WINT, 1024, 0, 0, nullptr};
        pg8::TileOrder S; S.init(T / 256, NINP / 256, G, (int)blockIdx.x, nullptr, 0, WGM_P1);
        pg8::EpiBf16 E{(bf16_t*)(ws + WS_P), NINP, (bf16_t*)(ws + WS_VT)};
        for (int rep = 0; rep < NREP(1); ++rep) pg8::gemm_phase<false, false>(lds, g, S, E);
    } SEAM(1);
    TSTART(2);
    if (IN(2)) {
        ck::fused_item(lds, args, (int)blockIdx.x * 2); ck::fused_item(lds, args, (int)blockIdx.x * 2 + 1);
    } SEAM(2);
    TSTART(3);
    if (IN(3)) {
        TSTART(30); for (int rep = 0; rep < NREP(30); ++rep) { if (blockIdx.x < 64) ck::seq_head(lds, args, (int)blockIdx.x); __syncthreads(); } TEND(30);
        for (int rep = 0; rep < NREP(31); ++rep) att::attn_phase(lds, args, ctl + 64 * rep);
    } SEAM(3); TEND(3);
    if (IN(4)) {
        pg8::Gemm g{ws + WS_YMIX, ws + WS_WOUT, 1024, 0, 0, nullptr};
        pg8::TileOrder S; S.init(T / 256, D / 256, G, (int)blockIdx.x, nullptr, 0, WGM_P4);
        pg8::EpiResBf16 E{args.in[0], (bf16_t*)(ws + WS_X1B), D};
        for (int rep = 0; rep < NREP(4); ++rep) pg8::gemm_phase<false, false>(lds, g, S, E);
    } SEAM(4);
    if (IN(5)) { _Pragma("clang loop unroll(disable)") for (int rep = 0; rep < NREP(5); ++rep) { p5_router(lds, args, ctl + 256 * (NREP(5) - 1 - rep)); __syncthreads(); } } SEAM(5);
    if (IN(6)) { for (int rep = 0; rep < NREP(6); ++rep) { p6_dispatch(lds, args, ctl); __syncthreads(); } } SEAM(6);
    if (IN(7)) {
        const int ntile = TILEE[1023];
        pg8::Gemm g{ws + WS_H2, ws + WS_W1T, 1024, F8_W_SC, F8_X_SC, (const int*)(ws + WS_ROWTOK)};
        pg8::TileOrder S; S.init(ntile, 8, G, (int)blockIdx.x, TILEE, 8, WGM_P7);
        pg8::EpiSwiglu E{ws + WS_HID, args.in[27], TILEE};
        for (int rep = 0; rep < NREP(7); ++rep) pg8::gemm_phase<true, true>(lds, g, S, E);
    } SEAM(7);
    if (IN(8)) {
        const int ntile = TILEE[1023];
        pg8::Gemm g{ws + WS_HID, ws + WS_W2T, 1024, F8_W_SC, F8_H_SC, nullptr};
        pg8::TileOrder S; S.init(ntile, 4, G, (int)blockIdx.x, TILEE, 4, WGM_P8);
        pg8::EpiGateF8 E{ws + WS_YS, args.in[29], (const float*)(ws + WS_ROWGATE), TILEE};
        for (int rep = 0; rep < NREP(8); ++rep) pg8::gemm_phase<true, false>(lds, g, S, E);
    } SEAM(8);
    if (IN(9)) { p9_combine(args, G); }
#undef IN
#undef SEAM
}

extern "C" void kernel_launch(void* const* d_in, const int* in_sizes, int n_in, void* d_out, int out_size, void* d_ws, size_t ws_size, hipStream_t stream) {
    static int grid = 0;
    if (grid == 0) {
        if (n_in != 30 || in_sizes[0] != T * D || out_size != T * D || ws_size < WS_END) { fprintf(stderr, "kernel_launch: unexpected shapes (n_in %d, in0 %d, out %d, ws %zu); nothing launched\n", n_in, n_in > 0 ? in_sizes[0] : -1, out_size, ws_size); grid = -1; return; }
        int dev = 0, cus = 0, per_cu = 0;
        if (hipGetDevice(&dev) != hipSuccess || hipDeviceGetAttribute(&cus, hipDeviceAttributeMultiprocessorCount, dev) != hipSuccess) { grid = -1; return; }
        if (hipFuncSetAttribute((const void*)hymba_fwd, hipFuncAttributeMaxDynamicSharedMemorySize, LDS_BYTES) != hipSuccess) { fprintf(stderr, "kernel_launch: hipFuncSetAttribute failed\n"); grid = -1; return; }
        if (hipOccupancyMaxActiveBlocksPerMultiprocessor(&per_cu, (const void*)hymba_fwd, 512, LDS_BYTES) != hipSuccess || per_cu < 1) { fprintf(stderr, "kernel_launch: occupancy query says %d\n", per_cu); per_cu = 1; }
        (void)hipGetLastError();
        grid = cus;
        if (grid > 256) grid = 256;
        if (grid != 256 || T % grid != 0 || (T / grid) % 16 != 0) { fprintf(stderr, "kernel_launch: grid %d does not divide the token count evenly\n", grid); grid = -1; return; }
    }
    if (grid < 0) return;
    (void)hipMemsetAsync((char*)d_ws + WS_CTL, 0, CTL_ZERO_BYTES, stream);
    Args a{};
    for (int i = 0; i < 30; ++i) a.in[i] = (const float*)d_in[i];
    a.out = (float*)d_out; a.ws = (unsigned char*)d_ws;
    constexpr int NL = MK_N_LAUNCHES;
    for (int li = 0; li < NL; ++li) {
        a.ph_lo = (NL == 1) ? 0 : li; a.ph_hi = (NL == 1) ? NPHASE : li + 1;
        void* kargs[] = {&a};
        hipError_t e = hipLaunchCooperativeKernel((const void*)hymba_fwd, dim3(grid), dim3(512), kargs, LDS_BYTES, stream);
        if (e != hipSuccess) { fprintf(stderr, "kernel_launch: cooperative launch %d failed: %s (grid %d)\n", li, hipGetErrorString(e), grid); break; }
    }
}
```

```cpp
#include <hip/hip_runtime.h>
#include <hip/hip_cooperative_groups.h>
#include <cstdio>
#include <cstdint>
#include <type_traits>
namespace cg = cooperative_groups;

#ifndef REP_PHASE
#define REP_PHASE -1
#endif
#ifndef TIME_REGION
#define TIME_REGION -1
#endif
#ifndef WGM_P1
#define WGM_P1 2
#endif
#ifndef WGM_P4
#define WGM_P4 2
#endif
#ifndef WGM_P7
#define WGM_P7 2
#endif
#ifndef WGM_P8
#define WGM_P8 2
#endif
#ifndef MK_N_LAUNCHES
#define MK_N_LAUNCHES 1
#endif

#define LAS __attribute__((address_space(3)))
#define GAS __attribute__((address_space(1)))
typedef unsigned short bf16_t;
typedef short bf16x8 __attribute__((ext_vector_type(8)));
typedef short s16x4 __attribute__((ext_vector_type(4)));
typedef float f32x2 __attribute__((ext_vector_type(2)));
typedef float f32x4 __attribute__((ext_vector_type(4)));
typedef float f32x16 __attribute__((ext_vector_type(16)));
typedef unsigned u32x2 __attribute__((ext_vector_type(2)));
typedef unsigned u32x4 __attribute__((ext_vector_type(4)));
typedef int v8i32 __attribute__((ext_vector_type(8)));

constexpr int NB = 8, SEQ = 4096, T = NB * SEQ, D = 1024;
constexpr int CW = 512;
constexpr int NRW = 1696, NIN = 3232, NINP = 3328;
constexpr int DQ0 = 1696, DK0 = 2208, DV0 = 2720;
constexpr int NE = 32, TOPK = 4, DE = 1024;
constexpr int MAXROWS = T * TOPK + NE * 256;
constexpr int MAXTILES = MAXROWS / 256;
constexpr float LOG2E = 1.4426950408889634f;
constexpr float F8_W_MUL = 32.f, F8_X_MUL = 8.f, F8_H_MUL = 4.f, F8_Y_MUL = 16.f; constexpr int F8_W_SC = 0x7A7A7A7A, F8_X_SC = 0x7C7C7C7C, F8_H_SC = 0x7D7D7D7D;

constexpr size_t MiB = 1u << 20;
constexpr size_t WS_CTL = 0, CTL_ZERO_BYTES = 64 * 1024;
constexpr size_t WS_TILEE = 512 * 1024;
constexpr size_t WS_LW = 576 * 1024;
constexpr size_t WS_WINT = 1 * MiB;
constexpr size_t WS_WOUT = 8 * MiB;
constexpr size_t WS_W1T = 10 * MiB;
constexpr size_t WS_W2T = 138 * MiB;
constexpr size_t WS_EIDX = 202 * MiB;
constexpr size_t WS_GATE = WS_EIDX + 512 * 1024;
constexpr size_t WS_POS = WS_GATE + 512 * 1024;
constexpr size_t WS_DEST = WS_POS + 512 * 1024;
constexpr size_t WS_ROWGATE = 204 * MiB;
constexpr size_t WS_XN = 206 * MiB;
constexpr size_t WS_P = 270 * MiB;
constexpr size_t WS_SR = 478 * MiB, WS_SK = 510 * MiB, WS_SV = 542 * MiB, WS_SA = 574 * MiB, WS_SB = 606 * MiB;
constexpr size_t WS_SW = 638 * MiB;
constexpr size_t WS_SG = 702 * MiB;
constexpr size_t WS_QN = 734 * MiB, WS_KN = 766 * MiB;
constexpr size_t WS_YMIX = 798 * MiB;
constexpr size_t WS_H2 = 206 * MiB;
constexpr size_t WS_ROWTOK = 270 * MiB;
constexpr size_t WS_HID = 406 * MiB;
constexpr size_t WS_YS = 542 * MiB;
constexpr size_t WS_X1B = 862 * MiB;
constexpr size_t WS_CG = 862 * MiB;
constexpr size_t WS_CH = 894 * MiB;
constexpr size_t WS_CR2 = 926 * MiB;
constexpr size_t WS_CY0 = 958 * MiB;
constexpr size_t WS_RK = 990 * MiB;
constexpr size_t WS_VT = 992 * MiB;
constexpr size_t WS_END = 1024 * MiB;
constexpr int CW_CNT = 64;
constexpr int CW_ATTQ = 128;
constexpr int CW_BAR = 4096;

constexpr int RING_BYTES = 131072, MISC_OFF = RING_BYTES, LDS_BYTES = 147456;

__device__ __forceinline__ unsigned f2bf(float f) { unsigned u = __builtin_bit_cast(unsigned, f); return (u + 0x7fffu + ((u >> 16) & 1u)) >> 16; }
typedef __bf16 hwbf16x2 __attribute__((ext_vector_type(2)));
__device__ __forceinline__ unsigned pk2(float lo, float hi) { const f32x2 v = {lo, hi}; return __builtin_bit_cast(unsigned, __builtin_convertvector(v, hwbf16x2)); }
__device__ __forceinline__ unsigned pk4_fp8(float a, float b, float c, float d) {
    a = fminf(fmaxf(a, -448.f), 448.f); b = fminf(fmaxf(b, -448.f), 448.f); c = fminf(fmaxf(c, -448.f), 448.f); d = fminf(fmaxf(d, -448.f), 448.f);
    int r = __builtin_amdgcn_cvt_pk_fp8_f32(a, b, 0, false); r = __builtin_amdgcn_cvt_pk_fp8_f32(c, d, r, true); return (unsigned)r; }
__device__ __forceinline__ float bf2f(unsigned short b) { return __builtin_bit_cast(float, (unsigned)b << 16); }
__device__ __forceinline__ float bflo(unsigned w) { return __builtin_bit_cast(float, w << 16); }
__device__ __forceinline__ float bfhi(unsigned w) { return __builtin_bit_cast(float, w & 0xffff0000u); }
__device__ __forceinline__ float wave_sum(float v) {
#pragma unroll
    for (int o = 1; o < 64; o <<= 1) v += __shfl_xor(v, o);
    return v;
}
__device__ __forceinline__ float sigmoidf_(float x) { return 1.0f / (1.0f + __expf(-x)); }
template <int CTRL> __device__ __forceinline__ float dpp_f(float v) { return __builtin_bit_cast(float, __builtin_amdgcn_update_dpp(0, __builtin_bit_cast(int, v), CTRL, 0xF, 0xF, true)); }
__device__ __forceinline__ float red8(float v) {
    v += dpp_f<0xB1>(v);
    v += dpp_f<0x4E>(v);
    v += dpp_f<0x141>(v);
    return v;
}
__device__ __forceinline__ float red4(float v) { v += dpp_f<0xB1>(v); v += dpp_f<0x4E>(v); return v; }


#define XB_TMO      128
#define XB_XCNT(j)  (256  + 64 * (j))
#define XB_XSUB(j)  (1280 + 64 * (j))
#define XB_XGEN(j)  (2304 + 64 * (j))
#define XB_TOP      3328
#define XB_TOPGEN   3392
#define XCD_BAR_WORDS 3456
#define XB_SPIN_CAP (1u << 18)
__device__ __forceinline__ unsigned xb_ld(unsigned* p)              { return __hip_atomic_load(p, __ATOMIC_RELAXED, __HIP_MEMORY_SCOPE_AGENT); }
__device__ __forceinline__ unsigned xb_add(unsigned* p, unsigned v) { return __hip_atomic_fetch_add(p, v, __ATOMIC_RELAXED, __HIP_MEMORY_SCOPE_AGENT); }
__device__ __forceinline__ unsigned xb_xcc_id() { return (unsigned)__builtin_amdgcn_s_getreg((3 << 11) | 20) & 0xFu; }
#define XB_SPIN(cond, bar) do { unsigned _sp = 0; while (cond) { __builtin_amdgcn_s_sleep(1); \
    if ((++_sp & 255u) == 0u) { if (xb_ld(&(bar)[XB_TMO])) break; if (_sp > XB_SPIN_CAP) { atomicAdd(&(bar)[XB_TMO], 1u); break; } } } } while (0)
struct XcdBarrier { unsigned* bar; unsigned x; volatile LAS unsigned* st; };
__device__ __forceinline__ XcdBarrier xcd_barrier_post(unsigned* bar, volatile LAS unsigned* st) {
    XcdBarrier b; b.bar = bar; b.x = xb_xcc_id(); b.st = st;
    if (threadIdx.x == 0) (void)xb_add(&bar[XB_XCNT(b.x)], 1u);
    return b;
}
__device__ __forceinline__ void xcd_barrier_complete(unsigned* bar, unsigned x, unsigned& nloc, unsigned& nx) {
    const unsigned G = gridDim.x * gridDim.y * gridDim.z;
    unsigned sum, cnt, mine, sp = 0u;
    for (;;) {
        sum = 0u; cnt = 0u; mine = 0u;
#pragma unroll
        for (unsigned j = 0; j < 16; ++j) { const unsigned c = xb_ld(&bar[XB_XCNT(j)]); sum += c; cnt += (c > 0u) ? 1u : 0u; mine = (j == x) ? c : mine; }
        if (sum == G) break;
        __builtin_amdgcn_s_sleep(1);
        if ((++sp & 255u) == 0u) { if (xb_ld(&bar[XB_TMO])) break; if (sp > XB_SPIN_CAP) { atomicAdd(&bar[XB_TMO], 1u); break; } }
    }
    nloc = mine > 0u ? mine : 1u; nx = cnt > 0u ? cnt : 1u;
}
__device__ __forceinline__ void xcd_barrier(const XcdBarrier& b) {
    asm volatile("s_waitcnt vmcnt(0)" ::: "memory");
    __syncthreads();
    if (threadIdx.x == 0) {
        unsigned* bar = b.bar;
        __builtin_amdgcn_s_waitcnt(0);
        unsigned nloc = b.st[0], nx = b.st[1];
        if (nloc == 0u) { xcd_barrier_complete(bar, b.x, nloc, nx); b.st[0] = nloc; b.st[1] = nx; }
        const unsigned old = xb_add(&bar[XB_XSUB(b.x)], 1u);
        const unsigned gen = old / nloc;
        if (old + 1u == (gen + 1u) * nloc) {
            __builtin_amdgcn_fence(__ATOMIC_RELEASE, "agent");
            asm volatile("s_waitcnt vmcnt(0)" ::: "memory");
            const unsigned og = xb_add(&bar[XB_TOP], 1u);
            const unsigned tg = og / nx;
            if (og + 1u == (tg + 1u) * nx) xb_add(&bar[XB_TOPGEN], 1u);
            else XB_SPIN(xb_ld(&bar[XB_TOPGEN]) == tg, bar);
            __builtin_amdgcn_fence(__ATOMIC_ACQUIRE, "agent");
            xb_add(&bar[XB_XGEN(b.x)], 1u);
            asm volatile("s_waitcnt vmcnt(0)" ::: "memory");
        } else {
            XB_SPIN(xb_ld(&bar[XB_XGEN(b.x)]) == gen, bar);
            __builtin_amdgcn_fence(__ATOMIC_ACQUIRE, "agent");
            asm volatile("s_waitcnt vmcnt(0)" ::: "memory");
        }
    }
    __syncthreads();
}

namespace pg8 {
constexpr int BM = 256, BK = 64, HALF = 128, HTB = HALF * BK * 2, STAGE_BYTES = 8 * HTB, NXCD = 8;
__host__ __device__ __forceinline__ int lds_byte(int r, int c) { const int st = (r >> 4) * 2 + (c >> 5), rr = r & 15, cc = c & 31, ob = rr * 64 + cc * 2; return st * 1024 + (ob ^ (((ob >> 9) & 1) << 5)); }
__host__ __device__ __forceinline__ void stage_rc(int b, int& R, int& C) { const int st = b / 1024, sb = b % 1024, swz = sb ^ (((sb >> 9) & 1) << 5); R = (st >> 1) * 16 + swz / 64; C = (st & 1) * 32 + (swz % 64) / 2; }
__host__ __device__ __forceinline__ int perm32(int rho) { const int n = rho >> 4, i = rho & 15; return 8 * (i >> 2) + 4 * n + (i & 3); }

struct Unit { int pm, pn, pb; };
struct Gemm { const void* A; const void* Bt; int K; int scW, scA; const int* rowtok; };

struct TileOrder {
    int nM, nN, nwg, G, c, WGM; const int* tile_e; int nb_per_e;
    __device__ void init(int nM_, int nN_, int G_, int c_, const int* te, int nbe, int wgm) { nM = nM_; nN = nN_; nwg = nM * nN; G = G_; c = c_; tile_e = te; nb_per_e = nbe; WGM = wgm; }
    __device__ bool next(int i, Unit& u) const {
        const long L = (long)i * G + c; if (L >= nwg) return false;
        int wgid = (int)L; { const int q = nwg / NXCD, r = nwg % NXCD, xcd = wgid % NXCD, off = wgid / NXCD; wgid = (xcd < r ? xcd * (q + 1) : r * (q + 1) + (xcd - r) * q) + off; }
        const int nig = WGM * nN, gid = wgid / nig, fm = gid * WGM, gsz = (nM - fm) < WGM ? (nM - fm) : WGM;
        u.pm = fm + ((wgid % nig) % gsz); u.pn = (wgid % nig) / gsz;
        u.pb = tile_e ? tile_e[u.pm] * nb_per_e + u.pn : u.pn;
        return true;
    }
};

struct EpiBf16 {
    static constexpr bool PERM = true;
    bf16_t* O; int ldc; bf16_t* VT;
    __device__ __forceinline__ void operator()(const f32x4 (&acc)[2][2][4][2], const Unit& u, int wr, int wc, int fr, int fq) const {
        const int row0 = u.pm * BM + wr * 64 + fr; const int col0 = u.pn * BM + wc * 32 + 8 * fq;
#pragma unroll
        for (int ai = 0; ai < 2; ++ai)
#pragma unroll
            for (int m = 0; m < 4; ++m) { const int t = row0 + ai * HALF + m * 16; bf16_t* rowp = O + (size_t)t * ldc + col0;
#pragma unroll
                for (int bj = 0; bj < 2; ++bj) { const f32x4 v0 = acc[ai][bj][m][0], v1 = acc[ai][bj][m][1];
                    u32x4 w; w.x = pk2(v0[0], v0[1]); w.y = pk2(v0[2], v0[3]); w.z = pk2(v1[0], v1[1]); w.w = pk2(v1[2], v1[3]);
                    const int col = col0 + bj * HALF;
                    if (col >= DV0) { const int dvf = col - DV0, hh = dvf >> 7, dv = dvf & 127, tp = t & (SEQ - 1), key = tp & 63;
                        bf16_t* vp = VT + (((((size_t)((t >> 12) * 4 + hh) * 64 + (tp >> 6)) * 4 + (dv >> 5)) * 4 + (key >> 4)) * 16 + (key & 15)) * 32 + (dv & 31);
                        if (col < NIN) *(u32x4*)vp = w; }
                    else *(u32x4*)(rowp + bj * HALF) = w; } }
    }
};
struct EpiResBf16 {
    static constexpr bool PERM = true;
    const float* base; bf16_t* out; int ldc;
    __device__ __forceinline__ void operator()(const f32x4 (&acc)[2][2][4][2], const Unit& u, int wr, int wc, int fr, int fq) const {
        const int col0 = u.pn * BM + wc * 32 + 8 * fq;
#pragma unroll
        for (int ai = 0; ai < 2; ++ai)
#pragma unroll
            for (int m = 0; m < 4; ++m) { const size_t off = (size_t)(u.pm * BM + ai * HALF + wr * 64 + m * 16 + fr) * ldc + col0;
#pragma unroll
                for (int bj = 0; bj < 2; ++bj) { const f32x4 b0 = *(const f32x4*)(base + off + bj * HALF), b1 = *(const f32x4*)(base + off + bj * HALF + 4);
                    const f32x4 v0 = b0 + acc[ai][bj][m][0], v1 = b1 + acc[ai][bj][m][1];
                    u32x4 w; w.x = pk2(v0[0], v0[1]); w.y = pk2(v0[2], v0[3]); w.z = pk2(v1[0], v1[1]); w.w = pk2(v1[2], v1[3]);
                    *(u32x4*)(out + off + bj * HALF) = w; } }
    }
};
struct EpiSwiglu {
    static constexpr bool PERM = true;
    unsigned char* O; const float* b1; const int* tile_e;
    __device__ __forceinline__ void operator()(const f32x4 (&acc)[2][2][4][2], const Unit& u, int wr, int wc, int fr, int fq) const {
        const int e = tile_e[u.pm]; const int row0 = u.pm * BM + wr * 64 + fr; const int hc0 = u.pn * 128 + wc * 32 + 8 * fq;
        const float* bg = b1 + (size_t)e * 2048 + hc0; const float* bl = bg + 1024;
        const f32x4 g0 = *(const f32x4*)bg, g1 = *(const f32x4*)(bg + 4), l0 = *(const f32x4*)bl, l1 = *(const f32x4*)(bl + 4);
#pragma unroll
        for (int ai = 0; ai < 2; ++ai)
#pragma unroll
            for (int m = 0; m < 4; ++m) { unsigned char* rowp = O + (size_t)(row0 + ai * HALF + m * 16) * 1024 + hc0;
                float o[8];
#pragma unroll
                for (int n = 0; n < 2; ++n) { const f32x4 gv = acc[ai][0][m][n] + (n ? g1 : g0), lv = acc[ai][1][m][n] + (n ? l1 : l0);
#pragma unroll
                    for (int i = 0; i < 4; ++i) { const float g = fminf(gv[i], 7.0f), l = fminf(fmaxf(lv[i], -7.0f), 7.0f);
                        const float sg = __builtin_amdgcn_rcpf(1.0f + __builtin_amdgcn_exp2f(-1.702f * LOG2E * g)); o[n * 4 + i] = g * sg * (l + 1.0f); } }
                u32x2 w; w.x = pk4_fp8(o[0] * F8_H_MUL, o[1] * F8_H_MUL, o[2] * F8_H_MUL, o[3] * F8_H_MUL); w.y = pk4_fp8(o[4] * F8_H_MUL, o[5] * F8_H_MUL, o[6] * F8_H_MUL, o[7] * F8_H_MUL);
                *(u32x2*)rowp = w; }
    }
};
struct EpiGateF8 {
    static constexpr bool PERM = true;
    unsigned char* O; const float* b2; const float* rowgate; const int* tile_e;
    __device__ __forceinline__ void operator()(const f32x4 (&acc)[2][2][4][2], const Unit& u, int wr, int wc, int fr, int fq) const {
        const int e = tile_e[u.pm]; const int row0 = u.pm * BM + wr * 64 + fr; const int col0 = u.pn * BM + wc * 32 + 8 * fq;
        f32x4 bv[2][2];
#pragma unroll
        for (int bj = 0; bj < 2; ++bj)
#pragma unroll
            for (int n = 0; n < 2; ++n) bv[bj][n] = *(const f32x4*)(b2 + (size_t)e * 1024 + col0 + bj * HALF + 4 * n);
#pragma unroll
        for (int ai = 0; ai < 2; ++ai)
#pragma unroll
            for (int m = 0; m < 4; ++m) { const int row = row0 + ai * HALF + m * 16; const float gt = rowgate[row] * F8_Y_MUL; unsigned char* rowp = O + (size_t)row * 1024 + col0;
#pragma unroll
                for (int bj = 0; bj < 2; ++bj) { const f32x4 v0 = (acc[ai][bj][m][0] + bv[bj][0]) * gt, v1 = (acc[ai][bj][m][1] + bv[bj][1]) * gt;
                    u32x2 w; w.x = pk4_fp8(v0[0], v0[1], v0[2], v0[3]); w.y = pk4_fp8(v1[0], v1[1], v1[2], v1[3]);
                    *(u32x2*)(rowp + bj * HALF) = w; } }
    }
};

template <bool F8, bool GATHER, class Epi, class Sched>
__device__ __forceinline__ void gemm_phase(LAS unsigned char* lds, const Gemm g, const Sched& S, const Epi& E) {
    const int tid = threadIdx.x, wid = __builtin_amdgcn_readfirstlane(tid >> 6), lane = tid & 63, wr = wid >> 2, wc = wid & 3, fr = lane & 15, fq = lane >> 4;
    const int RB = F8 ? g.K : g.K * 2, nt = RB / 128;
    unsigned voffB[2];
#pragma unroll
    for (int i = 0; i < 2; ++i) { int R, C; stage_rc(tid * 16 + i * 8192, R, C); const int Rb = Epi::PERM ? ((R & ~31) + perm32(R & 31)) : R;
        voffB[i] = (unsigned)(Rb * RB + C * 2); }
#define PG8_AOFFS(dst, pm_) do { _Pragma("unroll") for (int h_ = 0; h_ < 2; ++h_) _Pragma("unroll") for (int i_ = 0; i_ < 2; ++i_) { int R_, C_; stage_rc(tid * 16 + i_ * 8192, R_, C_); \
        const int row_ = (pm_) * BM + h_ * HALF + R_; const unsigned grow_ = GATHER ? (unsigned)g.rowtok[row_] : (unsigned)row_; dst[h_][i_] = grow_ * (unsigned)RB + (unsigned)(C_ * 2); } } while (0)
    unsigned cvA[2][2], nvA[2][2];
    const size_t kstep = (size_t)(BK * 2);
    const size_t hstep = (size_t)HALF * RB;
    const size_t tstep = 2 * hstep;
    const unsigned ldsw = (unsigned)wid * 1024u;
    const int aoff = F8 ? lds_byte(wr * 64 + fr, (fq & 1) * 16) + (fq >> 1) * 1024 : lds_byte(wr * 64 + fr, fq * 8);
    const int boff = F8 ? lds_byte(wc * 32 + fr, (fq & 1) * 16) + (fq >> 1) * 1024 : lds_byte(wc * 32 + fr, fq * 8);
    const int scW = g.scW, scA = g.scA;
#define PG8_SA(b, h) (((b) * 2 + (h)) * HTB)
#define PG8_SB(b, h) ((4 + (b) * 2 + (h)) * HTB)
#define PG8_STAGE(bufoff, gbase, voff) do { _Pragma("unroll") for (int _i = 0; _i < 2; ++_i) \
        __builtin_amdgcn_global_load_lds((const unsigned*)((const char*)(gbase) + (voff)[_i]), (LAS unsigned*)(lds + (bufoff) + ldsw + _i * 8192), 16, 0, 0); } while (0)
typedef int v8i32a __attribute__((ext_vector_type(8), aligned(16)));
#define PG8_LD32(p) (*(const LAS v8i32a*)(p))
#define PG8_STAGE_A(bufoff, kptr, offs) do { _Pragma("unroll") for (int _i = 0; _i < 2; ++_i) \
        __builtin_amdgcn_global_load_lds((const unsigned*)((const char*)(kptr) + (offs)[_i]), (LAS unsigned*)(lds + (bufoff) + ldsw + _i * 8192), 16, 0, 0); } while (0)
#define PG8_LDA(dst, b, h) do { _Pragma("unroll") for (int m = 0; m < 4; ++m) { if constexpr (F8) { dst[m].f8 = __builtin_bit_cast(v8i32, PG8_LD32(lds + PG8_SA(b, h) + aoff + m * 2048)); } \
        else { _Pragma("unroll") for (int k = 0; k < 2; ++k) dst[m].hv[k] = *(const LAS bf16x8*)(lds + PG8_SA(b, h) + aoff + m * 2048 + k * 1024); } } } while (0)
#define PG8_LDB(dst, b, h) do { _Pragma("unroll") for (int n = 0; n < 2; ++n) { if constexpr (F8) { dst[n].f8 = __builtin_bit_cast(v8i32, PG8_LD32(lds + PG8_SB(b, h) + boff + n * 2048)); } \
        else { _Pragma("unroll") for (int k = 0; k < 2; ++k) dst[n].hv[k] = *(const LAS bf16x8*)(lds + PG8_SB(b, h) + boff + n * 2048 + k * 1024); } } } while (0)
#define PG8_MMA(ai, bj, At, Bt) do { __builtin_amdgcn_s_setprio(1); _Pragma("unroll") for (int m = 0; m < 4; ++m) _Pragma("unroll") for (int n = 0; n < 2; ++n) { \
        if constexpr (F8) { asm volatile("v_mfma_scale_f32_16x16x128_f8f6f4 %0, %1, %2, %0, %3, %4 op_sel_hi:[0,0,0]" : "+v"(acc[ai][bj][m][n]) : "v"(Bt[n].f8), "v"(At[m].f8), "v"(scW), "v"(scA)); } \
        else { _Pragma("unroll") for (int k = 0; k < 2; ++k) acc[ai][bj][m][n] = __builtin_amdgcn_mfma_f32_16x16x32_bf16(Bt[n].hv[k], At[m].hv[k], acc[ai][bj][m][n], 0, 0, 0); } } \
        __builtin_amdgcn_s_setprio(0); } while (0)
#define PG8_WAIT_V(n) asm volatile("s_waitcnt vmcnt(" #n ")" ::: "memory")
#define PG8_WAIT_L(n) asm volatile("s_waitcnt lgkmcnt(" #n ")" ::: "memory")
#define PG8_BAR __builtin_amdgcn_s_barrier()
#define PG8_SCHED __builtin_amdgcn_sched_barrier(0)
    Unit cur, nxt; int ui = 0;
    if (!S.next(0, cur)) return;
    f32x4 acc[2][2][4][2];
#pragma unroll
    for (int a = 0; a < 2; ++a)
#pragma unroll
        for (int b = 0; b < 2; ++b)
#pragma unroll
            for (int m = 0; m < 4; ++m)
#pragma unroll
                for (int n = 0; n < 2; ++n) acc[a][b][m][n] = (f32x4){0.f, 0.f, 0.f, 0.f};
    struct FragH { bf16x8 hv[2]; }; struct Frag8 { v8i32 f8; };
    typename std::conditional<F8, Frag8, FragH>::type At[4], B0[2], B1[2];
    const char* const kA = (const char*)g.A; const char* cB = (const char*)g.Bt + (size_t)cur.pb * tstep;
    PG8_AOFFS(cvA, cur.pm);
    PG8_STAGE(PG8_SB(0, 0), cB, voffB); PG8_STAGE(PG8_SB(0, 1), cB + hstep, voffB); PG8_STAGE_A(PG8_SA(0, 0), kA, cvA[0]); PG8_STAGE_A(PG8_SA(0, 1), kA, cvA[1]);
    if (wr == 1) PG8_BAR;
    PG8_WAIT_V(2); PG8_BAR;
    PG8_STAGE(PG8_SB(1, 0), cB + kstep, voffB); PG8_STAGE_A(PG8_SA(1, 0), kA + kstep, cvA[0]); PG8_STAGE(PG8_SB(1, 1), cB + hstep + kstep, voffB);
    PG8_WAIT_V(6); PG8_BAR;
    for (;;) {
        const bool has_next = S.next(ui + 1, nxt);
        const char* nB = has_next ? (const char*)g.Bt + (size_t)nxt.pb * tstep : cB;
        if (has_next) { PG8_AOFFS(nvA, nxt.pm); } else { _Pragma("unroll") for (int h_ = 0; h_ < 2; ++h_) _Pragma("unroll") for (int i_ = 0; i_ < 2; ++i_) nvA[h_][i_] = cvA[h_][i_]; }
#pragma clang loop unroll(disable)
        for (int t = 0; t < nt; t += 2) {
            const bool last = (t == nt - 2);
            const char* a1 = kA + (size_t)(t + 1) * kstep;
            const char* a2 = last ? kA : kA + (size_t)(t + 2) * kstep; const char* b2 = last ? nB : cB + (size_t)(t + 2) * kstep;
            const char* a3 = a2 + kstep; const char* b3 = b2 + kstep;
            unsigned v2A[2][2];
#pragma unroll
            for (int h_ = 0; h_ < 2; ++h_)
#pragma unroll
                for (int i_ = 0; i_ < 2; ++i_) v2A[h_][i_] = last ? nvA[h_][i_] : cvA[h_][i_];
            PG8_LDB(B0, 0, 0); PG8_LDB(B1, 0, 1); PG8_SCHED; PG8_LDA(At, 0, 0); PG8_STAGE_A(PG8_SA(1, 1), a1, cvA[1]);
            PG8_WAIT_V(8); PG8_WAIT_L(0); PG8_BAR; PG8_MMA(0, 0, At, B0); PG8_MMA(0, 1, At, B1); PG8_BAR; PG8_SCHED;
            PG8_LDA(At, 0, 1); PG8_STAGE(PG8_SB(0, 0), b2, voffB); PG8_STAGE(PG8_SB(0, 1), b2 + hstep, voffB); PG8_STAGE_A(PG8_SA(0, 0), a2, v2A[0]);
            PG8_WAIT_V(8); PG8_WAIT_L(0); PG8_BAR; PG8_MMA(1, 0, At, B0); PG8_MMA(1, 1, At, B1); PG8_BAR; PG8_SCHED;
            PG8_LDB(B0, 1, 0); PG8_LDB(B1, 1, 1); PG8_SCHED; PG8_LDA(At, 1, 0); PG8_STAGE_A(PG8_SA(0, 1), a2, v2A[1]);
            PG8_WAIT_V(8); PG8_WAIT_L(0); PG8_BAR; PG8_MMA(0, 0, At, B0); PG8_MMA(0, 1, At, B1); PG8_BAR; PG8_SCHED;
            PG8_LDA(At, 1, 1); PG8_STAGE(PG8_SB(1, 0), b3, voffB); PG8_STAGE(PG8_SB(1, 1), b3 + hstep, voffB); PG8_STAGE_A(PG8_SA(1, 0), a3, v2A[0]);
            PG8_WAIT_V(8); PG8_WAIT_L(0); PG8_BAR; PG8_MMA(1, 0, At, B0); PG8_MMA(1, 1, At, B1); PG8_BAR; PG8_SCHED;
        }
        if (wr == 0) PG8_BAR;
        if constexpr (F8) asm volatile("s_nop 15\n\ts_nop 15" ::: "memory");
        E(acc, cur, wr, wc, fr, fq);
        if (!has_next) break;
#pragma unroll
        for (int a = 0; a < 2; ++a)
#pragma unroll
            for (int b = 0; b < 2; ++b)
#pragma unroll
                for (int m = 0; m < 4; ++m)
#pragma unroll
                    for (int n = 0; n < 2; ++n) acc[a][b][m][n] = (f32x4){0.f, 0.f, 0.f, 0.f};
        cur = nxt; cB = nB; ++ui;
#pragma unroll
        for (int h_ = 0; h_ < 2; ++h_)
#pragma unroll
            for (int i_ = 0; i_ < 2; ++i_) cvA[h_][i_] = nvA[h_][i_];
        if (wr == 1) PG8_BAR;
    }
    PG8_WAIT_V(0);
    PG8_BAR;
#undef PG8_SA
#undef PG8_SB
#undef PG8_STAGE
#undef PG8_STAGE_A
#undef PG8_AOFFS
#undef PG8_LDA
#undef PG8_LDB
#undef PG8_MMA
#undef PG8_LD32
#undef PG8_WAIT_V
#undef PG8_WAIT_L
#undef PG8_BAR
#undef PG8_SCHED
}
}

struct Args { const float* in[30]; float* out; unsigned char* ws; int ph_lo, ph_hi; };

__device__ __forceinline__ void p0_transpose_item(const float* W, int K, int N, bf16_t* WT, int k0, int n0, int drow0, LAS float* scr, int lane) {
#pragma unroll 8
    for (int i = 0; i < 32; ++i) { const int kk = 2 * i + (lane >> 5); scr[kk * 33 + (lane & 31)] = W[(size_t)(k0 + kk) * N + n0 + (lane & 31)]; }
    asm volatile("s_waitcnt lgkmcnt(0)" ::: "memory");
    const int c = lane & 7;
#pragma unroll
    for (int j = 0; j < 4; ++j) { const int n = (lane >> 3) + 8 * j; const LAS float* s = scr + (8 * c) * 33 + n;
        u32x4 o; o.x = pk2(s[0 * 33], s[1 * 33]); o.y = pk2(s[2 * 33], s[3 * 33]); o.z = pk2(s[4 * 33], s[5 * 33]); o.w = pk2(s[6 * 33], s[7 * 33]);
        *(u32x4*)(WT + (size_t)(drow0 + n) * K + k0 + 8 * c) = o; }
    asm volatile("s_waitcnt lgkmcnt(0)" ::: "memory");
}
__device__ __forceinline__ void p0_transpose_item_f8(const float* W, int K, int N, unsigned char* WT, int k0, int n0, int drow0, LAS float* scr, int lane) {
    LAS unsigned* tile = (LAS unsigned*)scr;
    const float* src = W + (size_t)k0 * N + n0 + lane;
#pragma unroll 8
    for (int kq = 0; kq < 32; ++kq) {
        const float* p = src + (size_t)(4 * kq) * N;
        tile[lane * 33 + kq] = pk4_fp8(p[0] * F8_W_MUL, p[N] * F8_W_MUL, p[2 * (size_t)N] * F8_W_MUL, p[3 * (size_t)N] * F8_W_MUL);
    }
    asm volatile("s_waitcnt lgkmcnt(0)" ::: "memory");
    const int c = lane & 7;
#pragma unroll
    for (int j = 0; j < 8; ++j) { const int n = (lane >> 3) + 8 * j; const LAS unsigned* t = tile + n * 33 + 4 * c;
        *(u32x4*)(WT + (size_t)(drow0 + n) * K + k0 + 16 * c) = (u32x4){t[0], t[1], t[2], t[3]}; }
    asm volatile("s_waitcnt lgkmcnt(0)" ::: "memory");
}
__device__ __forceinline__ void p0_prologue(LAS unsigned char* lds, const Args& a, int G) {
    const int tid = threadIdx.x, lane = tid & 63, wave = __builtin_amdgcn_readfirstlane(tid >> 6);
    LAS float* scr = (LAS float*)(lds + wave * 16384);
    const int gw = blockIdx.x * 8 + wave, NGW = G * 8;
    unsigned char* ws = a.ws;
    bf16_t* Wint = (bf16_t*)(ws + WS_WINT); bf16_t* Woutt = (bf16_t*)(ws + WS_WOUT); unsigned char* W1t = ws + WS_W1T; unsigned char* W2t = ws + WS_W2T;
    constexpr int I_IN = 16 * (NIN / 32);
    constexpr int I_OUT = 16 * 32;
    constexpr int I_W1 = 8 * 32;
    constexpr int I_W2 = 8 * 16;
    constexpr int NITEMS = I_IN + I_OUT + NE * I_W1 + NE * I_W2;
    for (int it = gw; it < NITEMS; it += NGW) {
        int r = it;
        if (r < I_IN) { const int nblk = NIN / 32, kb = r / nblk, nb = r % nblk; p0_transpose_item(a.in[2], 1024, NIN, Wint, 64 * kb, 32 * nb, 32 * nb, scr, lane); continue; } r -= I_IN;
        if (r < I_OUT) { const int kb = r / 32, nb = r % 32; p0_transpose_item(a.in[22], 1024, 1024, Woutt, 64 * kb, 32 * nb, 32 * nb, scr, lane); continue; } r -= I_OUT;
        if (r < NE * I_W1) { const int e = r / I_W1, q = r % I_W1, kb = q / 32, nb = q % 32; const int n0 = 64 * nb;
            const int drow = (n0 < 1024) ? ((n0 >> 7) * 256 + (n0 & 127)) : (((n0 - 1024) >> 7) * 256 + 128 + ((n0 - 1024) & 127));
            p0_transpose_item_f8(a.in[26] + (size_t)e * 1024 * 2048, 1024, 2048, W1t + (size_t)e * 2048 * 1024, 128 * kb, n0, drow, scr, lane); continue; } r -= NE * I_W1;
        { const int e = r / I_W2, q = r % I_W2, kb = q / 16, nb = q % 16;
            p0_transpose_item_f8(a.in[28] + (size_t)e * 1024 * 1024, 1024, 1024, W2t + (size_t)e * 1024 * 1024, 128 * kb, 64 * nb, 64 * nb, scr, lane); }
    }
    { bf16_t* LW = (bf16_t*)(ws + WS_LW);
      for (int i = gw * 64 + lane; i < CW * 160; i += NGW * 64) { const int col = i / 160, k = i - col * 160;
          const float v = k < 32 ? a.in[5][k * CW + col] : (k < 64 ? a.in[7][(k - 32) * CW + col] : a.in[8][(k - 64) * CW + col]); LW[i] = (bf16_t)f2bf(v); } }
    const float* x = a.in[0]; const float* g1 = a.in[1]; bf16_t* XN = (bf16_t*)(ws + WS_XN);
    f32x4 gv[4];
#pragma unroll
    for (int j = 0; j < 4; ++j) gv[j] = *((const f32x4*)g1 + lane + 64 * j);
#pragma unroll 4
    for (int m = gw; m < T; m += NGW) {
        const f32x4* xr = (const f32x4*)(x + (size_t)m * D) + lane;
        f32x4 v[4]; float s = 0.f;
#pragma unroll
        for (int j = 0; j < 4; ++j) { v[j] = xr[64 * j]; s += (v[j].x * v[j].x + v[j].y * v[j].y) + (v[j].z * v[j].z + v[j].w * v[j].w); }
        const float rstd = 1.0f / sqrtf(wave_sum(s) * (1.0f / D) + 1e-5f);
        u32x2* o8 = (u32x2*)(XN + (size_t)m * D) + lane;
#pragma unroll
        for (int j = 0; j < 4; ++j) { u32x2 w; w.x = pk2(v[j].x * rstd * gv[j].x, v[j].y * rstd * gv[j].y); w.y = pk2(v[j].z * rstd * gv[j].z, v[j].w * rstd * gv[j].w); o8[64 * j] = w; }
    }
}

__device__ __forceinline__ f32x4 cvlo(const u32x4 u) { return (f32x4){bflo(u.x), bfhi(u.x), bflo(u.y), bfhi(u.y)}; }
__device__ __forceinline__ f32x4 cvhi(const u32x4 u) { return (f32x4){bflo(u.z), bfhi(u.z), bflo(u.w), bfhi(u.w)}; }
__device__ __forceinline__ u32x4 pk8(const f32x4 lo, const f32x4 hi) { u32x4 w; w.x = pk2(lo.x, lo.y); w.y = pk2(lo.z, lo.w); w.z = pk2(hi.x, hi.y); w.w = pk2(hi.z, hi.w); return w; }

namespace ck {
constexpr int PS = 136;
constexpr int O_BT = 0, O_KT = 8704, O_AP = 17408, O_RT = 26112;
constexpr int O_AT = 34816, O_BH = 43008, O_KH = 51200, O_VV = 59392, O_TN = 67584, O_A2 = 75776, O_V2 = 83968;
constexpr int O_L = 92160, LSTR = 68;
constexpr int O_TOT = 109568, O_GC = 111616;
constexpr int O_ACT = 112128;
__device__ __forceinline__ int crow(int r, int hi) { return (r & 3) + 8 * (r >> 2) + 4 * hi; }
__device__ __forceinline__ int voff(int row, int col) { return ((col >> 5) * 4 + (row >> 4)) * 1024 + (row & 15) * 64 + (col & 31) * 2; }
__device__ __forceinline__ s16x4 vtr(const LAS unsigned char* p) { return __builtin_bit_cast(s16x4, __builtin_amdgcn_ds_read_tr16_b64_v4i16((LAS s16x4*)p)); }
__device__ __forceinline__ bf16x8 fragP(const LAS unsigned char* M, int row, int k0, int hi) {
    const LAS unsigned char* p = M + row * PS + (k0 + 4 * hi) * 2; const s16x4 lo = *(const LAS s16x4*)p, h = *(const LAS s16x4*)(p + 16);
    return (bf16x8){lo[0], lo[1], lo[2], lo[3], h[0], h[1], h[2], h[3]}; }
__device__ __forceinline__ bf16x8 fragT(const LAS unsigned char* M, int k0, int colblk, int lane, int hi) {
    const LAS unsigned char* p = M + (colblk * 4 + (k0 >> 4)) * 1024 + ((lane >> 4) & 1) * 32 + (lane & 3) * 8 + (4 * hi + ((lane & 15) >> 2)) * 64;
    const s16x4 lo = vtr(p), h = vtr(p + 512); return (bf16x8){lo[0], lo[1], lo[2], lo[3], h[0], h[1], h[2], h[3]}; }
__device__ __forceinline__ bf16x8 packR(const f32x16& x, int s) {
    u32x4 w; w.x = pk2(x[8 * s], x[8 * s + 1]); w.y = pk2(x[8 * s + 2], x[8 * s + 3]); w.z = pk2(x[8 * s + 4], x[8 * s + 5]); w.w = pk2(x[8 * s + 6], x[8 * s + 7]); return __builtin_bit_cast(bf16x8, w); }
#define CK_MFMA(a, b, c) __builtin_amdgcn_mfma_f32_32x32x16_bf16(a, b, c, 0, 0, 0)
__device__ __forceinline__ f32x16 score(const LAS unsigned char* Am, const LAS unsigned char* Bm, int sblk, int tblk, int mode, int r32, int hi) {
    f32x16 x = f32x16{};
#pragma unroll
    for (int ks = 0; ks < 4; ++ks) x = CK_MFMA(fragP(Am, sblk * 32 + r32, 16 * ks, hi), fragP(Bm, tblk * 32 + r32, 16 * ks, hi), x);
    if (mode) {
        const int t = tblk * 32 + r32;
#pragma unroll
        for (int r = 0; r < 16; ++r) { const int s = sblk * 32 + crow(r, hi); if (mode == 1 ? !(s < t) : !(s <= t)) x[r] = 0.f; }
    }
    return x;
}
__device__ __forceinline__ void storeT_V(LAS unsigned char* M, const f32x16& x, int rb, int c, int hi) {
#pragma unroll
    for (int q = 0; q < 4; ++q) { u32x2 w; w.x = pk2(x[4 * q], x[4 * q + 1]); w.y = pk2(x[4 * q + 2], x[4 * q + 3]); *(LAS u32x2*)(M + voff(c, rb * 32 + 8 * q + 4 * hi)) = w; }
}
__device__ __forceinline__ void storeT_S(LAS unsigned char* M, const f32x16& x, int rb, int c, int hi) {
#pragma unroll
    for (int q = 0; q < 4; ++q) { u32x2 w; w.x = pk2(x[4 * q], x[4 * q + 1]); w.y = pk2(x[4 * q + 2], x[4 * q + 3]); *(LAS u32x2*)(M + c * PS + (rb * 32 + 8 * q + 4 * hi) * 2) = w; }
}

__device__ __forceinline__ void chunk_item(LAS unsigned char* lds, const Args& a, int item) {
    int tid = threadIdx.x; asm volatile("" : "+v"(tid)); int lane = tid & 63; const int wave = __builtin_amdgcn_readfirstlane(tid >> 6);
#define CK_FRESH() asm volatile("" : "+v"(lane)); r32 = lane & 31; hi = lane >> 5
    int r32, hi; CK_FRESH();
    unsigned char* ws = a.ws;
    const bf16_t* SR = (const bf16_t*)(ws + WS_SR); const bf16_t* SK = (const bf16_t*)(ws + WS_SK); const bf16_t* SV = (const bf16_t*)(ws + WS_SV);
    const bf16_t* SA = (const bf16_t*)(ws + WS_SA); const bf16_t* SB = (const bf16_t*)(ws + WS_SB); const float* SW = (const float*)(ws + WS_SW);
    bf16_t* CG = (bf16_t*)(ws + WS_CG) + (size_t)item * 4096; bf16_t* CH = (bf16_t*)(ws + WS_CH) + (size_t)item * 4096;
    bf16_t* CR2 = (bf16_t*)(ws + WS_CR2) + (size_t)item * 4096; bf16_t* CY0 = (bf16_t*)(ws + WS_CY0) + (size_t)item * 4096;
    const int bh = item >> 6, c = item & 63, b = bh >> 3, h = bh & 7, tokc = b * SEQ + c * 64, col0 = h * 64;
    LAS unsigned char* BT = lds + O_BT; LAS unsigned char* KT = lds + O_KT; LAS unsigned char* AP = lds + O_AP; LAS unsigned char* RT = lds + O_RT;
    LAS unsigned char* AT = lds + O_AT; LAS unsigned char* BH = lds + O_BH; LAS unsigned char* KH = lds + O_KH; LAS unsigned char* VV = lds + O_VV;
    LAS unsigned char* TN = lds + O_TN; LAS unsigned char* A2M = lds + O_A2; LAS unsigned char* V2M = lds + O_V2;
    LAS float* L = (LAS float*)(lds + O_L); LAS float* TOT = (LAS float*)(lds + O_TOT); LAS float* GC = (LAS float*)(lds + O_GC);
    {
        const int tl = tid >> 3, c8 = (tid & 7) * 8, cr = col0 + c8, t = tokc + tl;
        const bf16_t* P = (const bf16_t*)(ws + WS_P); const bf16_t* pr = P + (size_t)t * NINP + cr;
        bf16_t* SVo = (bf16_t*)(ws + WS_SV); bf16_t* SGo = (bf16_t*)(ws + WS_SG); bf16_t* QN = (bf16_t*)(ws + WS_QN); bf16_t* KN = (bf16_t*)(ws + WS_KN);
        const float* mu = a.in[3];
        const bool first = (t & (SEQ - 1)) == 0; const u32x4 zz = (u32x4){0u, 0u, 0u, 0u};
#define CK_PK8(v) ((u32x4){pk2(v[0], v[1]), pk2(v[2], v[3]), pk2(v[4], v[5]), pk2(v[6], v[7])})
#define CK_ST_P(M, val_) do { LAS unsigned char* d_ = (M) + tl * PS + c8 * 2; const u32x4 q_ = (val_); *(LAS u32x2*)d_ = (u32x2){q_[0], q_[1]}; *(LAS u32x2*)(d_ + 8) = (u32x2){q_[2], q_[3]}; } while (0)
        float g[8], gp[8], ig[8], gC[8];
        {
            const u32x4 deu = *(const LAS u32x4*)(TN + tl * 128 + c8 * 2); const f32x4 de0 = cvlo(deu), de1 = cvhi(deu);
            float wv[8] = {__builtin_amdgcn_exp2f(de0.x), __builtin_amdgcn_exp2f(de0.y), __builtin_amdgcn_exp2f(de0.z), __builtin_amdgcn_exp2f(de0.w), __builtin_amdgcn_exp2f(de1.x), __builtin_amdgcn_exp2f(de1.y), __builtin_amdgcn_exp2f(de1.z), __builtin_amdgcn_exp2f(de1.w)};
            float p[8];
#pragma unroll
            for (int j = 0; j < 8; ++j) p[j] = wv[j];
#pragma unroll
            for (int d = 8; d < 64; d <<= 1) {
#pragma unroll
                for (int j = 0; j < 8; ++j) { const float q = __shfl_up(p[j], d); if (lane >= d) p[j] *= q; }
            }
            if ((lane >> 3) == 7) { *(LAS f32x4*)(TOT + wave * 64 + c8) = (f32x4){p[0], p[1], p[2], p[3]}; *(LAS f32x4*)(TOT + wave * 64 + c8 + 4) = (f32x4){p[4], p[5], p[6], p[7]}; }
            __syncthreads();
            float pre[8];
#pragma unroll
            for (int j = 0; j < 8; ++j) { pre[j] = 1.f; gC[j] = 1.f; }
#pragma unroll
            for (int w2 = 0; w2 < 8; ++w2) { const f32x4 t0 = *(const LAS f32x4*)(TOT + w2 * 64 + c8), t1 = *(const LAS f32x4*)(TOT + w2 * 64 + c8 + 4);
                const float tv[8] = {t0.x, t0.y, t0.z, t0.w, t1.x, t1.y, t1.z, t1.w};
#pragma unroll
                for (int j = 0; j < 8; ++j) { if (w2 < wave) pre[j] *= tv[j]; gC[j] *= tv[j]; } }
            if (tid < 8) { *(LAS f32x4*)(GC + c8) = (f32x4){gC[0], gC[1], gC[2], gC[3]}; *(LAS f32x4*)(GC + c8 + 4) = (f32x4){gC[4], gC[5], gC[6], gC[7]}; }
#pragma unroll
            for (int j = 0; j < 8; ++j) { g[j] = pre[j] * p[j]; ig[j] = __builtin_amdgcn_rcpf(g[j]); gp[j] = g[j] * __builtin_amdgcn_rcpf(wv[j]); }
        }
        f32x4 r0, r1;
        { const u32x4 cu = *(const u32x4*)(pr), pu = first ? zz : *(const u32x4*)(pr - NINP);
          const f32x4 m0 = *(const f32x4*)(mu + cr), m1 = *(const f32x4*)(mu + cr + 4); const f32x4 c0 = cvlo(cu), c1 = cvhi(cu), p0 = cvlo(pu), p1 = cvhi(pu);
          r0 = c0 + (p0 - c0) * m0; r1 = c1 + (p1 - c1) * m1;
          const float rt[8] = {r0.x * g[0], r0.y * g[1], r0.z * g[2], r0.w * g[3], r1.x * g[4], r1.y * g[5], r1.z * g[6], r1.w * g[7]};
          CK_ST_P(RT, CK_PK8(rt)); }
        { const u32x4 cu = *(const u32x4*)(pr + 1024), pu = first ? zz : *(const u32x4*)(pr - NINP + 1024);
          const f32x4 m0 = *(const f32x4*)(mu + 1024 + cr), m1 = *(const f32x4*)(mu + 1024 + cr + 4); const f32x4 c0 = cvlo(cu), c1 = cvhi(cu), p0 = cvlo(pu), p1 = cvhi(pu);
          const u32x4 uv = pk8(c0 + (p0 - c0) * m0, c1 + (p1 - c1) * m1); *(u32x4*)(SVo + (size_t)t * CW + cr) = uv; *(LAS u32x4*)(VV + voff(tl, c8)) = uv; }
        *(u32x4*)(SGo + (size_t)t * CW + cr) = *(const LAS u32x4*)(V2M + tl * 128 + c8 * 2);
        { const u32x4 cu = *(const u32x4*)(pr + 512), pu = first ? zz : *(const u32x4*)(pr - NINP + 512);
          const f32x4 m0 = *(const f32x4*)(mu + 512 + cr), m1 = *(const f32x4*)(mu + 512 + cr + 4); const f32x4 c0 = cvlo(cu), c1 = cvhi(cu), p0 = cvlo(pu), p1 = cvhi(pu);
          const f32x4 k0 = c0 + (p0 - c0) * m0, k1 = c1 + (p1 - c1) * m1;
          const u32x4 alu = *(const LAS u32x4*)(A2M + tl * 128 + c8 * 2); const f32x4 al0 = cvlo(alu), al1 = cvhi(alu);
          const f32x4 kk0 = k0 * *(const f32x4*)(a.in[9] + cr), kk1 = k1 * *(const f32x4*)(a.in[9] + cr + 4);
          const float ss = red8((kk0.x * kk0.x + kk0.y * kk0.y) + (kk0.z * kk0.z + kk0.w * kk0.w) + (kk1.x * kk1.x + kk1.y * kk1.y) + (kk1.z * kk1.z + kk1.w * kk1.w));
          const float inv = 1.0f / sqrtf(fmaxf(ss, 1e-24f));
          const f32x4 kn0 = kk0 * inv, kn1 = kk1 * inv;
          const f32x4 k20 = k0 * (1.0f + (al0 - 1.0f) * *(const f32x4*)(a.in[10] + cr)), k21 = k1 * (1.0f + (al1 - 1.0f) * *(const f32x4*)(a.in[10] + cr + 4));
          { const f32x4 q0 = r0 * k20 * *(const f32x4*)(a.in[11] + cr), q1 = r1 * k21 * *(const f32x4*)(a.in[11] + cr + 4);
            const float rk = red8((q0.x + q0.y) + (q0.z + q0.w) + (q1.x + q1.y) + (q1.z + q1.w));
            if ((lane & 7) == 0) ((float*)(ws + WS_RK))[(size_t)t * 8 + h] = rk; }
          const float kv[8] = {k20.x, k20.y, k20.z, k20.w, k21.x, k21.y, k21.z, k21.w}, nv[8] = {kn0.x, kn0.y, kn0.z, kn0.w, kn1.x, kn1.y, kn1.z, kn1.w}, av_[8] = {al0.x, al0.y, al0.z, al0.w, al1.x, al1.y, al1.z, al1.w};
          float at[8], bt[8], kt[8], bh[8], kh[8];
#pragma unroll
          for (int j = 0; j < 8; ++j) { at[j] = -nv[j] * gp[j]; bt[j] = nv[j] * av_[j] * ig[j]; kt[j] = kv[j] * ig[j]; bh[j] = bt[j] * gC[j]; kh[j] = kt[j] * gC[j]; }
          const u32x4 wa = CK_PK8(at);
          CK_ST_P(AP, wa); *(LAS u32x4*)(AT + voff(tl, c8)) = wa;
          CK_ST_P(BT, CK_PK8(bt)); CK_ST_P(KT, CK_PK8(kt));
          *(LAS u32x4*)(BH + voff(tl, c8)) = CK_PK8(bh); *(LAS u32x4*)(KH + voff(tl, c8)) = CK_PK8(kh); }
        { const u32x4 uq = *(const u32x4*)(pr + DQ0), ukd = *(const u32x4*)(pr + DK0);
          const f32x4 q0 = cvlo(uq), q1 = cvhi(uq), d0 = cvlo(ukd), d1 = cvhi(ukd);
          const float qs = red8((q0.x * q0.x + q0.y * q0.y) + (q0.z * q0.z + q0.w * q0.w) + (q1.x * q1.x + q1.y * q1.y) + (q1.z * q1.z + q1.w * q1.w));
          const float ks = red8((d0.x * d0.x + d0.y * d0.y) + (d0.z * d0.z + d0.w * d0.w) + (d1.x * d1.x + d1.y * d1.y) + (d1.z * d1.z + d1.w * d1.w));
          const float qi = (1.0f / sqrtf(qs * (1.0f / 64.0f) + 1e-5f)) * (0.125f * LOG2E), ki = 1.0f / sqrtf(ks * (1.0f / 64.0f) + 1e-5f);
          const f32x4 g0 = *(const f32x4*)(a.in[14] + c8), g1 = *(const f32x4*)(a.in[14] + c8 + 4), h0 = *(const f32x4*)(a.in[15] + c8), h1 = *(const f32x4*)(a.in[15] + c8 + 4);
          *(u32x4*)(QN + (size_t)t * CW + cr) = pk8(q0 * qi * g0, q1 * qi * g1);
          const size_t ko = ((((size_t)(b * 8 + h) * 64 + c) * 8 + (c8 >> 3)) * 64 + tl) * 8;
          *(u32x4*)(KN + ko) = pk8(d0 * ki * h0, d1 * ki * h1); }
#undef CK_PK8
#undef CK_ST_P
    }
    __syncthreads();
    CK_FRESH();
    f32x16 pa = f32x16{}, pb = f32x16{}, pc = f32x16{}, pd = f32x16{};
#define w1a pa
#define w1b pb
#define xb0 pa
#define xb1 pb
#define y0a pc
#define y0b pd
    if (wave < 2) {
        for (int k = 0; k < (wave == 0 ? 2 : 1); ++k) {
            const int sblk = wave == 0 ? k : 0, tblk = wave == 0 ? k : 1;
            const f32x16 x = score(BT, AP, sblk, tblk, wave == 0 ? 1 : 0, r32, hi);
            const int t = tblk * 32 + r32;
#pragma unroll
            for (int r = 0; r < 16; ++r) L[(sblk * 32 + crow(r, hi)) * LSTR + t] = x[r];
        }
    }
    __syncthreads();
    CK_FRESH();
    if (wave == 6) {
        float x[32];
#pragma unroll
        for (int t = 0; t < 32; ++t) x[t] = (r32 == t) ? 1.f : 0.f;
        const LAS float* Nr = L + (32 * hi) * LSTR + 32 * hi;
#pragma unroll
        for (int sidx = 0; sidx < 31; ++sidx) {
#pragma unroll
            for (int g4 = (sidx + 1) / 4; g4 < 8; ++g4) {
                const f32x4 nv = *(const LAS f32x4*)(Nr + sidx * LSTR + 4 * g4);
                if (4 * g4 + 0 > sidx) x[4 * g4 + 0] += nv.x * x[sidx];
                if (4 * g4 + 1 > sidx) x[4 * g4 + 1] += nv.y * x[sidx];
                if (4 * g4 + 2 > sidx) x[4 * g4 + 2] += nv.z * x[sidx];
                if (4 * g4 + 3 > sidx) x[4 * g4 + 3] += nv.w * x[sidx];
            }
            if ((sidx & 3) == 3) __builtin_amdgcn_sched_barrier(0);
        }
        const int cc = 32 * hi + r32;
#pragma unroll
        for (int t0 = 0; t0 < 32; t0 += 8) { u32x4 w; w.x = pk2(x[t0], x[t0 + 1]); w.y = pk2(x[t0 + 2], x[t0 + 3]); w.z = pk2(x[t0 + 4], x[t0 + 5]); w.w = pk2(x[t0 + 6], x[t0 + 7]);
            *(LAS u32x4*)(TN + voff(cc, 32 * hi + t0)) = w; }
        f32x16 m = f32x16{};
#pragma unroll
        for (int s = 0; s < 2; ++s) {
            const LAS float* lp = L + (16 * s + 4 * hi) * LSTR + 32 + r32;
            u32x4 aw; aw.x = pk2(lp[0], lp[LSTR]); aw.y = pk2(lp[2 * LSTR], lp[3 * LSTR]); aw.z = pk2(lp[8 * LSTR], lp[9 * LSTR]); aw.w = pk2(lp[10 * LSTR], lp[11 * LSTR]);
            const s16x4 b0 = *(const LAS s16x4*)(TN + voff(r32, 16 * s + 4 * hi)), b1 = *(const LAS s16x4*)(TN + voff(r32, 16 * s + 8 + 4 * hi));
            m = CK_MFMA(__builtin_bit_cast(bf16x8, aw), ((bf16x8){b0[0], b0[1], b0[2], b0[3], b1[0], b1[1], b1[2], b1[3]}), m);
        }
        f32x16 t21 = f32x16{};
#pragma unroll
        for (int s = 0; s < 2; ++s) t21 = CK_MFMA(fragT(TN, 32 + 16 * s, 1, lane, hi), packR(m, s), t21);
        storeT_V(TN, t21, 1, r32, hi);
    } else if (wave < 4) {
        const int dvb = wave - 2;
        const f32x16 x00 = score(KT, AP, 0, 0, 1, r32, hi), x01 = score(KT, AP, 0, 1, 0, r32, hi), x11 = score(KT, AP, 1, 1, 1, r32, hi);
#pragma unroll
        for (int s = 0; s < 2; ++s) {
            const bf16x8 v0 = fragT(VV, 16 * s, dvb, lane, hi), v1 = fragT(VV, 32 + 16 * s, dvb, lane, hi);
            w1a = CK_MFMA(packR(x00, s), v0, w1a);
            w1b = CK_MFMA(packR(x01, s), v0, w1b);
            w1b = CK_MFMA(packR(x11, s), v1, w1b);
        }
    } else if (wave < 6) {
        const int tb = wave - 4;
        f32x16 xk0, xk1 = f32x16{};
        if (tb == 0) { xk0 = score(KT, RT, 0, 0, 2, r32, hi); xb0 = score(BT, RT, 0, 0, 2, r32, hi); }
        else { xk0 = score(KT, RT, 0, 1, 0, r32, hi); xk1 = score(KT, RT, 1, 1, 2, r32, hi); xb0 = score(BT, RT, 0, 1, 0, r32, hi); xb1 = score(BT, RT, 1, 1, 2, r32, hi); }
#pragma unroll
        for (int s = 0; s < 2; ++s) {
            y0a = CK_MFMA(fragT(VV, 16 * s, 0, lane, hi), packR(xk0, s), y0a);
            y0b = CK_MFMA(fragT(VV, 16 * s, 1, lane, hi), packR(xk0, s), y0b);
            if (tb == 1) { y0a = CK_MFMA(fragT(VV, 32 + 16 * s, 0, lane, hi), packR(xk1, s), y0a); y0b = CK_MFMA(fragT(VV, 32 + 16 * s, 1, lane, hi), packR(xk1, s), y0b); }
        }
    }
    __syncthreads();
    CK_FRESH();
    if (wave < 2) {
        const int cb = wave; f32x16 a0 = f32x16{}, a1 = f32x16{};
#pragma unroll
        for (int ks = 0; ks < 4; ++ks) {
            const bf16x8 af = fragT(AT, 16 * ks, cb, lane, hi);
            if (ks < 2) a0 = CK_MFMA(af, fragT(TN, 16 * ks, 0, lane, hi), a0);
            a1 = CK_MFMA(af, fragT(TN, 16 * ks, 1, lane, hi), a1);
        }
        storeT_V(A2M, a0, cb, r32, hi); storeT_V(A2M, a1, cb, 32 + r32, hi);
    } else if (wave < 4) {
        const int dvb = wave - 2; f32x16 v0 = f32x16{}, v1 = f32x16{};
#pragma unroll
        for (int s = 0; s < 2; ++s) {
            v0 = CK_MFMA(packR(w1a, s), fragT(TN, 16 * s, 0, lane, hi), v0);
            v1 = CK_MFMA(packR(w1a, s), fragT(TN, 16 * s, 1, lane, hi), v1);
            v1 = CK_MFMA(packR(w1b, s), fragT(TN, 32 + 16 * s, 1, lane, hi), v1);
        }
        storeT_V(V2M, v0, dvb, r32, hi); storeT_V(V2M, v1, dvb, 32 + r32, hi);
    }
    __syncthreads();
    CK_FRESH();
    if (wave >= 4 && wave < 6) {
        const int tb = wave - 4, t = tb * 32 + r32;
        f32x16 r0 = f32x16{}, r1 = f32x16{};
#pragma unroll
        for (int s = 0; s < 2; ++s) {
            const bf16x8 p0 = packR(xb0, s);
            r0 = CK_MFMA(fragT(A2M, 16 * s, 0, lane, hi), p0, r0); r1 = CK_MFMA(fragT(A2M, 16 * s, 1, lane, hi), p0, r1);
            y0a = CK_MFMA(fragT(V2M, 16 * s, 0, lane, hi), p0, y0a); y0b = CK_MFMA(fragT(V2M, 16 * s, 1, lane, hi), p0, y0b);
            if (tb == 1) { const bf16x8 p1 = packR(xb1, s);
                r0 = CK_MFMA(fragT(A2M, 32 + 16 * s, 0, lane, hi), p1, r0); r1 = CK_MFMA(fragT(A2M, 32 + 16 * s, 1, lane, hi), p1, r1);
                y0a = CK_MFMA(fragT(V2M, 32 + 16 * s, 0, lane, hi), p1, y0a); y0b = CK_MFMA(fragT(V2M, 32 + 16 * s, 1, lane, hi), p1, y0b); }
        }
#pragma unroll
        for (int q = 0; q < 4; ++q) {
            const u32x2 u0 = *(const LAS u32x2*)(RT + t * PS + (8 * q + 4 * hi) * 2), u1 = *(const LAS u32x2*)(RT + t * PS + (32 + 8 * q + 4 * hi) * 2);
            r0[4 * q] += bflo(u0.x); r0[4 * q + 1] += bfhi(u0.x); r0[4 * q + 2] += bflo(u0.y); r0[4 * q + 3] += bfhi(u0.y);
            r1[4 * q] += bflo(u1.x); r1[4 * q + 1] += bfhi(u1.x); r1[4 * q + 2] += bflo(u1.y); r1[4 * q + 3] += bfhi(u1.y);
        }
        storeT_S(BT, r0, 0, t, hi); storeT_S(BT, r1, 1, t, hi);
        storeT_S(KT, y0a, 0, t, hi); storeT_S(KT, y0b, 1, t, hi);
    } else if (wave < 2) {
        const int ib = wave, i = ib * 32 + r32; const float gci = GC[i];
        f32x16 g0 = f32x16{}, g1 = f32x16{};
#pragma unroll
        for (int ks = 0; ks < 4; ++ks) { const bf16x8 bf_ = fragT(BH, 16 * ks, ib, lane, hi);
            g0 = CK_MFMA(fragT(A2M, 16 * ks, 0, lane, hi), bf_, g0); g1 = CK_MFMA(fragT(A2M, 16 * ks, 1, lane, hi), bf_, g1); }
#pragma unroll
        for (int r = 0; r < 16; ++r) { if (crow(r, hi) == i) g0[r] += gci; if (32 + crow(r, hi) == i) g1[r] += gci; }
        storeT_S(AP, g0, 0, i, hi); storeT_S(AP, g1, 1, i, hi);
    } else {
        const int id = wave < 4 ? wave - 2 : wave - 4, ib = id >> 1, dvb = id & 1;
        f32x16 hh = f32x16{};
#pragma unroll
        for (int ks = 0; ks < 4; ++ks) {
            hh = CK_MFMA(fragT(BH, 16 * ks, ib, lane, hi), fragT(V2M, 16 * ks, dvb, lane, hi), hh);
            hh = CK_MFMA(fragT(KH, 16 * ks, ib, lane, hi), fragT(VV, 16 * ks, dvb, lane, hi), hh);
        }
        storeT_S((LAS unsigned char*)L, hh, ib, dvb * 32 + r32, hi);
    }
    __syncthreads();
    {
        asm volatile("" : "+v"(tid));
        const int row = tid >> 3, ch = tid & 7;
        const LAS unsigned char* s0 = BT + row * PS + ch * 16; const LAS unsigned char* s1 = KT + row * PS + ch * 16; const LAS unsigned char* s2 = AP + row * PS + ch * 16; const LAS unsigned char* s3 = (const LAS unsigned char*)L + row * PS + ch * 16;
        const u32x2 a0 = *(const LAS u32x2*)s0, a1 = *(const LAS u32x2*)(s0 + 8), b0 = *(const LAS u32x2*)s1, b1 = *(const LAS u32x2*)(s1 + 8);
        const u32x2 c0 = *(const LAS u32x2*)s2, c1 = *(const LAS u32x2*)(s2 + 8), d0 = *(const LAS u32x2*)s3, d1 = *(const LAS u32x2*)(s3 + 8);
        *(u32x4*)(CR2 + row * 64 + ch * 8) = (u32x4){a0.x, a0.y, a1.x, a1.y}; *(u32x4*)(CY0 + row * 64 + ch * 8) = (u32x4){b0.x, b0.y, b1.x, b1.y};
        *(u32x4*)(CG + row * 64 + ch * 8) = (u32x4){c0.x, c0.y, c1.x, c1.y}; *(u32x4*)(CH + row * 64 + ch * 8) = (u32x4){d0.x, d0.y, d1.x, d1.y};
    }
    asm volatile("s_waitcnt lgkmcnt(0)" ::: "memory"); __builtin_amdgcn_s_barrier();
#undef CK_FRESH
#undef w1a
#undef w1b
#undef xb0
#undef xb1
#undef y0a
#undef y0b
}

__device__ __forceinline__ void fused_item(LAS unsigned char* lds, const Args& a, int bc) {
    const int tid = threadIdx.x, lane = tid & 63; const int wave = __builtin_amdgcn_readfirstlane(tid >> 6);
    unsigned char* ws = a.ws;
    const bf16_t* P = (const bf16_t*)(ws + WS_P); const bf16_t* LW = (const bf16_t*)(ws + WS_LW); const float* mu = a.in[3];
    const int b = bc >> 6, c = bc & 63, tokc = b * SEQ + c * 64;
    LAS unsigned char* ACT = lds + O_ACT; LAS unsigned char* DECb = lds + O_TN; LAS unsigned char* ALRb = lds + O_A2; LAS unsigned char* GGb = lds + O_V2;
    for (int it = tid; it < 1280; it += 512) {
        const int tok = it / 20, ch = it - tok * 20, t = tokc + tok, col = 1536 + ch * 8;
        const u32x4 cu = *(const u32x4*)(P + (size_t)t * NINP + col);
        u32x4 pu = (u32x4){0u, 0u, 0u, 0u};
        if (t & (SEQ - 1)) pu = *(const u32x4*)(P + (size_t)(t - 1) * NINP + col);
        const f32x4 m0 = *(const f32x4*)(mu + col), m1 = *(const f32x4*)(mu + col + 4);
        const f32x4 c0 = cvlo(cu), c1 = cvhi(cu), p0 = cvlo(pu), p1 = cvhi(pu);
        f32x4 s0 = c0 + (p0 - c0) * m0, s1 = c1 + (p1 - c1) * m1;
        if (ch < 4) {
#pragma unroll
            for (int i = 0; i < 4; ++i) { const float e0 = __expf(-2.0f * fabsf(s0[i])), e1 = __expf(-2.0f * fabsf(s1[i])); const float th0 = (1.0f - e0) / (1.0f + e0), th1 = (1.0f - e1) / (1.0f + e1);
                s0[i] = s0[i] < 0.f ? -th0 : th0; s1[i] = s1[i] < 0.f ? -th1 : th1; }
        } else if (ch >= 8) {
#pragma unroll
            for (int i = 0; i < 4; ++i) { s0[i] = sigmoidf_(s0[i]); s1[i] = sigmoidf_(s1[i]); }
        }
        *(LAS u32x4*)(ACT + tok * 320 + ch * 16) = pk8(s0, s1);
    }
    __syncthreads();
#pragma clang loop unroll(disable)
    for (int h = 0; h < 8; ++h) {
        {
            int ln = lane; asm volatile("" : "+v"(ln));
            const int mt = wave >> 1, fcol = ln & 15, fq = ln >> 4;
            bf16x8 af[5];
#pragma unroll
            for (int kb = 0; kb < 5; ++kb) af[kb] = *(const LAS bf16x8*)(ACT + (mt * 16 + fcol) * 320 + kb * 64 + fq * 16);
#pragma unroll
            for (int cbi = 0; cbi < 2; ++cbi) {
                const int cb = (wave & 1) * 2 + cbi, col = h * 64 + cb * 16 + fcol;
                const bf16_t* lw = LW + (size_t)col * 160 + fq * 8;
                const f32x4 z = {0.f, 0.f, 0.f, 0.f};
                const f32x4 aw = __builtin_amdgcn_mfma_f32_16x16x32_bf16(af[0], *(const bf16x8*)(lw), z, 0, 0, 0);
                const f32x4 aa = __builtin_amdgcn_mfma_f32_16x16x32_bf16(af[1], *(const bf16x8*)(lw + 32), z, 0, 0, 0);
                f32x4 ag = __builtin_amdgcn_mfma_f32_16x16x32_bf16(af[2], *(const bf16x8*)(lw + 64), z, 0, 0, 0);
                ag = __builtin_amdgcn_mfma_f32_16x16x32_bf16(af[3], *(const bf16x8*)(lw + 96), ag, 0, 0, 0);
                ag = __builtin_amdgcn_mfma_f32_16x16x32_bf16(af[4], *(const bf16x8*)(lw + 128), ag, 0, 0, 0);
                const float w0c = a.in[4][col], a0c = a.in[6][col];
#pragma unroll
                for (int i = 0; i < 4; ++i) { const int off = (mt * 16 + fq * 4 + i) * 128 + (cb * 16 + fcol) * 2;
                    *(LAS unsigned short*)(DECb + off) = (unsigned short)f2bf(-0.8750325887f * sigmoidf_(aw[i] + w0c));
                    *(LAS unsigned short*)(ALRb + off) = (unsigned short)f2bf(sigmoidf_(aa[i] + a0c));
                    *(LAS unsigned short*)(GGb + off) = (unsigned short)f2bf(ag[i]); }
            }
        }
        __syncthreads();
        chunk_item(lds, a, ((b * 8 + h) << 6) + c);
    }
}
}

namespace ck {
constexpr int SQ_MAT = 8704, SQ_BUF = 6 * SQ_MAT;
constexpr int SQ_OUT = 2 * SQ_BUF;
__device__ __forceinline__ bf16x8 lfrag(const LAS unsigned char* M, int row, int k0, int hi) { return fragP(M, row, k0, hi); }
__device__ __forceinline__ void linit(f32x16& x, const LAS unsigned char* M, int row, int cblk, int hi) {
#pragma unroll
    for (int q = 0; q < 4; ++q) { const u32x2 u = *(const LAS u32x2*)(M + row * PS + (cblk * 32 + 8 * q + 4 * hi) * 2); x[4 * q] = bflo(u.x); x[4 * q + 1] = bfhi(u.x); x[4 * q + 2] = bflo(u.y); x[4 * q + 3] = bfhi(u.y); }
}
__device__ __forceinline__ void seq_head(LAS unsigned char* lds, const Args& a, int bh) {
    const int tid = threadIdx.x, lane = tid & 63, r32 = lane & 31, hi = lane >> 5; const int wave = __builtin_amdgcn_readfirstlane(tid >> 6);
    unsigned char* ws = a.ws;
    const bf16_t* SV = (const bf16_t*)(ws + WS_SV); const bf16_t* SG = (const bf16_t*)(ws + WS_SG); const float* RK = (const float*)(ws + WS_RK); bf16_t* YMIX = (bf16_t*)(ws + WS_YMIX);
    const int b = bh >> 3, h = bh & 7, col0 = h * 64;
    const float* lng = a.in[12] + col0; const float* lnb = a.in[13] + col0;
    const int lw = wave - 2;
    const bf16_t* lsrc; int lpitch;
    { const size_t it0 = (size_t)bh * 64 * 4096; const size_t tk0 = (size_t)b * SEQ * CW + col0;
      lsrc = lw == 0 ? (const bf16_t*)(ws + WS_CG) + it0 : lw == 1 ? (const bf16_t*)(ws + WS_CH) + it0 : lw == 2 ? (const bf16_t*)(ws + WS_CR2) + it0 : lw == 3 ? (const bf16_t*)(ws + WS_CY0) + it0 : lw == 4 ? SV + tk0 : SG + tk0;
      lpitch = lw < 4 ? 64 : CW; }
#define SQ_LOAD(ch) do { const bf16_t* s_ = lsrc + (size_t)(ch) * 64 * lpitch; LAS unsigned char* bb_ = lds + ((ch) & 1) * SQ_BUF + lw * SQ_MAT; u32x4 v_[8]; \
        _Pragma("unroll") for (int i_ = 0; i_ < 8; ++i_) { const int q_ = lane + 64 * i_; v_[i_] = *(const u32x4*)(s_ + (size_t)(q_ >> 3) * lpitch + (q_ & 7) * 8); } \
        _Pragma("unroll") for (int i_ = 0; i_ < 8; ++i_) { const int q_ = lane + 64 * i_; LAS unsigned char* d_ = bb_ + (q_ >> 3) * PS + (q_ & 7) * 16; *(LAS u32x2*)d_ = (u32x2){v_[i_].x, v_[i_].y}; *(LAS u32x2*)(d_ + 8) = (u32x2){v_[i_].z, v_[i_].w}; } } while (0)
#define SQ_STORE(ch) do { const LAS unsigned char* ob_ = lds + SQ_OUT + ((ch) & 1) * SQ_MAT; const size_t t0_ = (size_t)b * SEQ + (ch) * 64; \
        for (int p_ = tid - 128; p_ < 512; p_ += 384) { const int row_ = p_ >> 3, c8_ = (p_ & 7) * 8; const LAS unsigned char* s_ = ob_ + row_ * PS + c8_ * 2; \
            const u32x2 lo_ = *(const LAS u32x2*)s_, hi_ = *(const LAS u32x2*)(s_ + 8); *(u32x4*)(YMIX + (t0_ + row_) * D + col0 + c8_) = (u32x4){lo_.x, lo_.y, hi_.x, hi_.y}; } } while (0)
    if (wave >= 2) SQ_LOAD(0);
    __syncthreads();
    f32x16 X00 = f32x16{}, X01 = f32x16{}, X10 = f32x16{}, X11 = f32x16{};
#pragma unroll 1
    for (int c = 0; c < 64; ++c) {
        if (wave >= 2) {
            if (c + 1 < 64) SQ_LOAD(c + 1);
            if (c > 0) SQ_STORE(c - 1);
        } else {
            const int tb = wave;
            const LAS unsigned char* bb = lds + (c & 1) * SQ_BUF;
            const LAS unsigned char* MG = bb; const LAS unsigned char* MH = bb + SQ_MAT; const LAS unsigned char* MR = bb + 2 * SQ_MAT; const LAS unsigned char* MY = bb + 3 * SQ_MAT;
            const LAS unsigned char* MV = bb + 4 * SQ_MAT; const LAS unsigned char* MGT = bb + 5 * SQ_MAT;
            LAS unsigned char* OB = lds + SQ_OUT + (c & 1) * SQ_MAT;
            const int tl = tb * 32 + r32; const size_t t = (size_t)b * SEQ + c * 64 + tl;
            const float rk = RK[t * 8 + h];
            f32x16 y0, y1; linit(y0, MY, tl, 0, hi); linit(y1, MY, tl, 1, hi);
#pragma unroll
            for (int s = 0; s < 2; ++s) {
                const bf16x8 rf0 = lfrag(MR, tl, 16 * s, hi), rf1 = lfrag(MR, tl, 32 + 16 * s, hi);
                y0 = CK_MFMA(packR(X00, s), rf0, y0); y0 = CK_MFMA(packR(X10, s), rf1, y0);
                y1 = CK_MFMA(packR(X01, s), rf0, y1); y1 = CK_MFMA(packR(X11, s), rf1, y1);
            }
#pragma unroll
            for (int db = 0; db < 2; ++db) {
                f32x16 Na, Nb; linit(Na, MH, db * 32 + r32, 0, hi); linit(Nb, MH, db * 32 + r32, 1, hi);
#pragma unroll
                for (int s = 0; s < 2; ++s) {
                    const bf16x8 g00 = lfrag(MG, r32, 16 * s, hi), g01 = lfrag(MG, r32, 32 + 16 * s, hi), g10 = lfrag(MG, 32 + r32, 16 * s, hi), g11 = lfrag(MG, 32 + r32, 32 + 16 * s, hi);
                    const bf16x8 p0 = packR(db ? X01 : X00, s), p1 = packR(db ? X11 : X10, s);
                    Na = CK_MFMA(g00, p0, Na); Na = CK_MFMA(g01, p1, Na);
                    Nb = CK_MFMA(g10, p0, Nb); Nb = CK_MFMA(g11, p1, Nb);
                }
                if (db == 0) { X00 = Na; X10 = Nb; } else { X01 = Na; X11 = Nb; }
            }
            float sm = 0.f;
#pragma unroll
            for (int r = 0; r < 16; ++r) sm += y0[r] + y1[r];
            sm += __shfl_xor(sm, 32);
            const float mean = sm * (1.0f / 64.0f);
            float sq = 0.f;
#pragma unroll
            for (int r = 0; r < 16; ++r) { const float d0 = y0[r] - mean, d1 = y1[r] - mean; sq += d0 * d0 + d1 * d1; }
            sq += __shfl_xor(sq, 32);
            const float rs = 1.0f / sqrtf(sq * (1.0f / 64.0f) + 64e-5f);
#pragma unroll
            for (int db = 0; db < 2; ++db)
#pragma unroll
                for (int q = 0; q < 4; ++q) {
                    const int dv = db * 32 + 8 * q + 4 * hi;
                    const f32x4 lg = *(const f32x4*)(lng + dv), lb = *(const f32x4*)(lnb + dv);
                    const u32x2 uv = *(const LAS u32x2*)(MV + tl * PS + dv * 2), ug = *(const LAS u32x2*)(MGT + tl * PS + dv * 2);
                    const f32x4 vv = {bflo(uv.x), bfhi(uv.x), bflo(uv.y), bfhi(uv.y)}, gg = {bflo(ug.x), bfhi(ug.x), bflo(ug.y), bfhi(ug.y)};
                    f32x4 yy; if (db == 0) yy = (f32x4){y0[4 * q], y0[4 * q + 1], y0[4 * q + 2], y0[4 * q + 3]}; else yy = (f32x4){y1[4 * q], y1[4 * q + 1], y1[4 * q + 2], y1[4 * q + 3]};
                    const f32x4 o = ((yy - mean) * rs * lg + lb + rk * vv) * gg;
                    u32x2 w; w.x = pk2(o.x, o.y); w.y = pk2(o.z, o.w);
                    *(LAS u32x2*)(OB + tl * PS + dv * 2) = w;
                }
        }
        __syncthreads();
    }
    if (wave >= 2) SQ_STORE(63);
#undef SQ_LOAD
#undef SQ_STORE
}
}

namespace att {
constexpr int SLOT = 32768, OFF_V = 16384;
constexpr int TBL_OFF = MISC_OFF + 1024;
constexpr int LW_OFF = MISC_OFF + 2048;
constexpr int CST_OFF = MISC_OFF + 3072;
__device__ __forceinline__ int crow(int r, int hi) { return (r & 3) + 8 * (r >> 2) + 4 * hi; }
__device__ __forceinline__ void glds16(const void* gsrc, unsigned lds_dst) { unsigned keep;
    asm volatile("s_mov_b32 %0, m0\n\ts_mov_b32 m0, %2\n\ts_nop 0\n\tglobal_load_lds_dwordx4 %1, off\n\ts_mov_b32 m0, %0" : "=&s"(keep) : "v"(gsrc), "s"(lds_dst) : "memory"); }
__device__ __forceinline__ s16x4 vtr(const LAS unsigned char* p) { return __builtin_bit_cast(s16x4, __builtin_amdgcn_ds_read_tr16_b64_v4i16((LAS s16x4*)p)); }

__device__ __forceinline__ void attn_unit(LAS unsigned char* lds, const Args& a, int b, int h, int qb, float negM, float lam) {
    const int tid = threadIdx.x, lane = tid & 63, r32 = lane & 31, hi = lane >> 5; const int wid = __builtin_amdgcn_readfirstlane(tid >> 6);
    const int c = wid >> 2, rg = wid & 3;
    unsigned char* ws = a.ws;
    const bf16_t* QN = (const bf16_t*)(ws + WS_QN); const bf16_t* KN = (const bf16_t*)(ws + WS_KN); const bf16_t* P = (const bf16_t*)(ws + WS_P); bf16_t* YMIX = (bf16_t*)(ws + WS_YMIX);
    const int q0 = qb * 128; const size_t rowbase = (size_t)b * SEQ;
    const int NT = 2 * qb + 2;
    LAS float* tbl = (LAS float*)(lds + TBL_OFF); LAS float* lw = (LAS float*)(lds + LW_OFF) + wid * 32;
    if (tid < 128) {
        const int n = tid; int bkt;
        if (n < 16) bkt = n; else { bkt = 16 + (int)(logf((float)n * (1.0f / 16.0f)) / 2.0794415416798357f * 16.0f); bkt = bkt > 31 ? 31 : bkt; }
        tbl[n] = (a.in[21][bkt * 4 + h] - a.in[21][31 * 4 + h]) * LOG2E;
    }
    const bf16_t* Qw = QN + (rowbase + q0 + rg * 32 + r32) * CW + h * 128 + c * 64;
    bf16x8 qr[4];
#pragma unroll
    for (int d0 = 0; d0 < 4; ++d0) qr[d0] = *(const bf16x8*)(Qw + d0 * 16 + hi * 8);
    const bf16_t* k0src = KN + ((((size_t)(b * 8 + h * 2) * 64) * 8 + wid) * 64 + lane) * 8;
    const bf16_t* k1src = k0src + (size_t)64 * 8 * 64 * 8;
    const int pv0 = 2 * wid, pv1 = 2 * wid + 1;
    const bf16_t* VTb = (const bf16_t*)(ws + WS_VT) + (size_t)(b * 4 + h) * 64 * 8192;
    const bf16_t* v0src = VTb + pv0 * 512 + lane * 8;
    const bf16_t* v1src = VTb + pv1 * 512 + lane * 8;
#define ATT_DMA(t, slot) do { const unsigned s_ = lds0 + (unsigned)(slot) * SLOT; \
        glds16(k0src + (size_t)(t) * 4096, (unsigned)__builtin_amdgcn_readfirstlane(s_ + wid * 1024)); \
        glds16(k1src + (size_t)(t) * 4096, (unsigned)__builtin_amdgcn_readfirstlane(s_ + 8192 + wid * 1024)); \
        glds16(v0src + (size_t)(t) * 8192, (unsigned)__builtin_amdgcn_readfirstlane(s_ + OFF_V + pv0 * 1024)); \
        glds16(v1src + (size_t)(t) * 8192, (unsigned)__builtin_amdgcn_readfirstlane(s_ + OFF_V + pv1 * 1024)); } while (0)
#define ATT_SBAR() __builtin_amdgcn_sched_barrier(0)
    const unsigned lds0 = (unsigned)(uintptr_t)lds;
    f32x16 o[4];
#pragma unroll
    for (int d0 = 0; d0 < 4; ++d0) o[d0] = f32x16{};
    float lsum = 0.f;
    const bool shift = negM < -60.0f;
    const int qmin = q0 + 32 * rg, qpos = qmin + r32;
    ATT_DMA(0, 0);
    asm volatile("s_waitcnt vmcnt(0)" ::: "memory");
    __syncthreads();
    for (int t = 0; t < NT; ++t) {
        if (t + 1 < NT) ATT_DMA(t + 1, (t + 1) & 1);
        const int kmin = 64 * t;
        if (kmin <= qmin + 31) {
            const LAS unsigned char* slot = lds + (t & 1) * SLOT;
            const LAS unsigned char* kb = slot + c * 8192 + hi * 1024 + r32 * 16;
            const LAS unsigned char* vb = slot + OFF_V + ((lane >> 4) & 1) * 32 + (lane & 3) * 8 + (4 * hi + ((lane & 15) >> 2)) * 64;
            bf16x8 kf[8];
#pragma unroll
            for (int d0 = 0; d0 < 4; ++d0) { kf[2 * d0] = *(const LAS bf16x8*)(kb + d0 * 2048); kf[2 * d0 + 1] = *(const LAS bf16x8*)(kb + d0 * 2048 + 512); }
            s16x4 va[16], vc[16];
#pragma unroll
            for (int i = 0; i < 8; ++i) { va[2 * i] = vtr(vb + (i >> 2) * 4096 + (i & 3) * 1024); va[2 * i + 1] = vtr(vb + (i >> 2) * 4096 + (i & 3) * 1024 + 512); }
            ATT_SBAR();
            f32x16 p0, p1;
            p0 = __builtin_amdgcn_mfma_f32_32x32x16_bf16(kf[0], qr[0], f32x16{}, 0, 0, 0); p1 = __builtin_amdgcn_mfma_f32_32x32x16_bf16(kf[1], qr[0], f32x16{}, 0, 0, 0);
#pragma unroll
            for (int d0 = 1; d0 < 4; ++d0) { p0 = __builtin_amdgcn_mfma_f32_32x32x16_bf16(kf[2 * d0], qr[d0], p0, 0, 0, 0); p1 = __builtin_amdgcn_mfma_f32_32x32x16_bf16(kf[2 * d0 + 1], qr[d0], p1, 0, 0, 0); }
            ATT_SBAR();
            if (qmin - (kmin + 63) < 113) {
#pragma unroll
                for (int r = 0; r < 16; ++r) {
                    const int d0_ = qpos - (kmin + crow(r, hi)); const int d1_ = d0_ - 32;
                    const float t0 = tbl[d0_ < 0 ? 0 : (d0_ > 127 ? 127 : d0_)], t1 = tbl[d1_ < 0 ? 0 : (d1_ > 127 ? 127 : d1_)];
                    p0[r] = d0_ < 0 ? -INFINITY : p0[r] + t0; p1[r] = d1_ < 0 ? -INFINITY : p1[r] + t1;
                }
            }
            if (shift) {
#pragma unroll
                for (int r = 0; r < 16; ++r) { p0[r] += negM; p1[r] += negM; }
            }
            float sacc = 0.f;
#pragma unroll
            for (int r = 0; r < 16; ++r) { p0[r] = __builtin_amdgcn_exp2f(p0[r]); p1[r] = __builtin_amdgcn_exp2f(p1[r]); sacc += p0[r] + p1[r]; }
            lsum += sacc;
            u32x4 pw[4];
#pragma unroll
            for (int i = 0; i < 4; ++i) { pw[0][i] = pk2(p0[2 * i], p0[2 * i + 1]); pw[1][i] = pk2(p0[8 + 2 * i], p0[8 + 2 * i + 1]); pw[2][i] = pk2(p1[2 * i], p1[2 * i + 1]); pw[3][i] = pk2(p1[8 + 2 * i], p1[8 + 2 * i + 1]); }
            ATT_SBAR();
#pragma unroll
            for (int i = 0; i < 8; ++i) { vc[2 * i] = vtr(vb + (2 + (i >> 2)) * 4096 + (i & 3) * 1024); vc[2 * i + 1] = vtr(vb + (2 + (i >> 2)) * 4096 + (i & 3) * 1024 + 512); }
#pragma unroll
            for (int i = 0; i < 8; ++i) {
                const bf16x8 vf = (bf16x8){va[2 * i][0], va[2 * i][1], va[2 * i][2], va[2 * i][3], va[2 * i + 1][0], va[2 * i + 1][1], va[2 * i + 1][2], va[2 * i + 1][3]};
                o[i >> 2] = __builtin_amdgcn_mfma_f32_32x32x16_bf16(__builtin_bit_cast(bf16x8, pw[i & 3]), vf, o[i >> 2], 0, 0, 0);
            }
#pragma unroll
            for (int i = 0; i < 8; ++i) {
                const bf16x8 vf = (bf16x8){vc[2 * i][0], vc[2 * i][1], vc[2 * i][2], vc[2 * i][3], vc[2 * i + 1][0], vc[2 * i + 1][1], vc[2 * i + 1][2], vc[2 * i + 1][3]};
                o[2 + (i >> 2)] = __builtin_amdgcn_mfma_f32_32x32x16_bf16(__builtin_bit_cast(bf16x8, pw[i & 3]), vf, o[2 + (i >> 2)], 0, 0, 0);
            }
        }
        asm volatile("s_waitcnt vmcnt(0)" ::: "memory");
        __syncthreads();
    }
#undef ATT_DMA
#undef ATT_SBAR
    lsum += __shfl_xor(lsum, 32);
    if (hi == 0) lw[r32] = 1.0f / lsum;
    asm volatile("s_waitcnt lgkmcnt(0)" ::: "memory");
    LAS float* stg = (LAS float*)(lds + wid * 16384);
#pragma unroll
    for (int r = 0; r < 16; ++r) { const int orow = crow(r, hi); const float il = lw[orow];
#pragma unroll
        for (int d0 = 0; d0 < 4; ++d0) stg[orow * 128 + d0 * 32 + r32] = o[d0][r] * il; }
    __syncthreads();
    {
        const int row = tid >> 2, part = tid & 3, rgp = row >> 5, rr = row & 31;
        const LAS float* s1 = (const LAS float*)(lds + rgp * 16384) + rr * 128 + part * 32;
        const LAS float* s2 = (const LAS float*)(lds + (4 + rgp) * 16384) + rr * 128 + part * 32;
        float dv[32]; float ss = 0.f;
#pragma unroll
        for (int i = 0; i < 8; ++i) { const f32x4 x1 = *(const LAS f32x4*)(s1 + 4 * i), x2 = *(const LAS f32x4*)(s2 + 4 * i);
#pragma unroll
            for (int j = 0; j < 4; ++j) { const float dd = x1[j] - lam * x2[j]; dv[4 * i + j] = dd; ss += dd * dd; } }
        ss = red4(ss);
        const float sc = (1.0f / sqrtf(ss * (1.0f / 128.0f) + 1e-5f)) * 0.8f;
        const float* sg = a.in[20] + part * 32;
        bf16_t* op = YMIX + (rowbase + q0 + row) * D + CW + h * 128 + part * 32;
#pragma unroll
        for (int i = 0; i < 4; ++i) { u32x4 w;
            w.x = pk2(dv[8 * i] * sc * sg[8 * i], dv[8 * i + 1] * sc * sg[8 * i + 1]); w.y = pk2(dv[8 * i + 2] * sc * sg[8 * i + 2], dv[8 * i + 3] * sc * sg[8 * i + 3]);
            w.z = pk2(dv[8 * i + 4] * sc * sg[8 * i + 4], dv[8 * i + 5] * sc * sg[8 * i + 5]); w.w = pk2(dv[8 * i + 6] * sc * sg[8 * i + 6], dv[8 * i + 7] * sc * sg[8 * i + 7]);
            *(u32x4*)(op + 8 * i) = w; }
    }
    __syncthreads();
}

__device__ __forceinline__ void attn_phase(LAS unsigned char* lds, const Args& a, unsigned* ctl) {
    const int tid = threadIdx.x;
    LAS float* cst = (LAS float*)(lds + CST_OFF);
    if (tid < 64) {
        const float gq = fabsf(a.in[14][tid]), gk = fabsf(a.in[15][tid]);
        float mq = gq, mk = gk;
#pragma unroll
        for (int o = 1; o < 64; o <<= 1) { mq = fmaxf(mq, __shfl_xor(mq, o)); mk = fmaxf(mk, __shfl_xor(mk, o)); }
        const float d1 = wave_sum(a.in[16][tid] * a.in[17][tid]), d2 = wave_sum(a.in[18][tid] * a.in[19][tid]);
        float mb = 0.f;
        if (tid < 32) { for (int hh = 0; hh < 4; ++hh) mb = fmaxf(mb, (a.in[21][tid * 4 + hh] - a.in[21][31 * 4 + hh]) * LOG2E); }
#pragma unroll
        for (int o = 1; o < 64; o <<= 1) mb = fmaxf(mb, __shfl_xor(mb, o));
        if (tid == 0) { cst[0] = -(8.0f * LOG2E * mq * mk * 1.02f + mb); cst[1] = __expf(d1) - __expf(d2) + 0.2f; }
    }
    __syncthreads();
    const float negM = cst[0], lam = cst[1];
    LAS int* ubox = (LAS int*)(lds + CST_OFF + 16);
    for (;;) {
        if (tid == 0) ubox[0] = (int)atomicAdd(ctl + CW_ATTQ, 1u);
        __syncthreads();
        const int u = ubox[0];
        __syncthreads();
        if (u >= 1024) break;
        const int qb = 31 - (u >> 5), bhh = u & 31;
        attn_unit(lds, a, bhh >> 2, bhh & 3, qb, negM, lam);
    }
}
}

__device__ __forceinline__ void p5_router(LAS unsigned char* lds, const Args& a, unsigned* ctl) {
    const int tid = threadIdx.x, lane = tid & 63, r32 = lane & 31, hi = lane >> 5; const int wave = __builtin_amdgcn_readfirstlane(tid >> 6);
    unsigned char* ws = a.ws;
    const bf16_t* x1 = (const bf16_t*)(ws + WS_X1B); const float* g2 = a.in[23]; const float* rw = a.in[24]; const float* rb = a.in[25];
    unsigned char* H2 = ws + WS_H2; int* EIDX = (int*)(ws + WS_EIDX); float* GATE = (float*)(ws + WS_GATE); int* POS = (int*)(ws + WS_POS);
    LAS unsigned char* WH = lds; LAS unsigned char* WL = lds + 65536;
    LAS int* cnt = (LAS int*)(lds + MISC_OFF + 1024);
    LAS int* basel = (LAS int*)(lds + MISC_OFF + 1024 + 128);
    LAS int* el = (LAS int*)(lds + MISC_OFF + 2048);
    LAS int* pl = (LAS int*)(lds + MISC_OFF + 4096);
    {
        const int e = tid & 31;
        for (int k = tid >> 5; k < 1024; k += 16) {
            const float v = rw[k * 32 + e] * g2[k]; const unsigned h = f2bf(v); const float vh = __builtin_bit_cast(float, h << 16); const unsigned l = f2bf(v - vh);
            const int off = e * 2048 + (((k >> 3) ^ (e & 15)) << 4) + (k & 7) * 2;
            *(LAS unsigned short*)(WH + off) = (unsigned short)h; *(LAS unsigned short*)(WL + off) = (unsigned short)l;
        }
    }
    if (tid < 32) cnt[tid] = 0;
    __syncthreads();
    const int TPB = T / (int)gridDim.x, tb0 = blockIdx.x * TPB;
    if (wave < 4) {
        const int tl = wave * 32 + r32, t = tb0 + tl;
        const bf16_t* xrow = x1 + (size_t)t * D + 8 * hi;
        const LAS unsigned char* wh = WH + r32 * 2048; const LAS unsigned char* wl = WL + r32 * 2048; const int sw = r32 & 15;
        f32x16 d = f32x16{}; float ssq = 0.f;
#pragma unroll 8
        for (int s = 0; s < 64; ++s) {
            const u32x4 xb = *(const u32x4*)(xrow + 16 * s);
            const int co = ((2 * s + hi) ^ sw) << 4;
            const bf16x8 ah = *(const LAS bf16x8*)(wh + co), al = *(const LAS bf16x8*)(wl + co);
            const bf16x8 bx = __builtin_bit_cast(bf16x8, xb);
            d = __builtin_amdgcn_mfma_f32_32x32x16_bf16(ah, bx, d, 0, 0, 0);
            d = __builtin_amdgcn_mfma_f32_32x32x16_bf16(al, bx, d, 0, 0, 0);
            const f32x4 x0 = cvlo(xb), x1v = cvhi(xb);
            ssq += (x0.x * x0.x + x0.y * x0.y) + (x0.z * x0.z + x0.w * x0.w) + (x1v.x * x1v.x + x1v.y * x1v.y) + (x1v.z * x1v.z + x1v.w * x1v.w);
        }
        ssq += __shfl_xor(ssq, 32);
        const float rstd = 1.0f / sqrtf(ssq * (1.0f / D) + 1e-5f);
        float lg[16];
#pragma unroll
        for (int r = 0; r < 16; ++r) lg[r] = d[r] * rstd + rb[8 * (r >> 2) + 4 * hi + (r & 3)];
        float tv[4]; int ti[4];
#pragma unroll
        for (int k = 0; k < 4; ++k) {
            float bv = -INFINITY; int bi = 0;
#pragma unroll
            for (int r = 0; r < 16; ++r) { const int e = 8 * (r >> 2) + 4 * hi + (r & 3); if (lg[r] > bv) { bv = lg[r]; bi = e; } }
            tv[k] = bv; ti[k] = bi;
#pragma unroll
            for (int r = 0; r < 16; ++r) { const int e = 8 * (r >> 2) + 4 * hi + (r & 3); if (e == bi) lg[r] = -INFINITY; }
        }
        float ov[4]; int oi[4];
#pragma unroll
        for (int k = 0; k < 4; ++k) { ov[k] = __shfl_xor(tv[k], 32); oi[k] = __shfl_xor(ti[k], 32); }
        float mv[4]; int mi[4];
        {
            int pa = 0, pb = 0;
#pragma unroll
            for (int k = 0; k < 4; ++k) {
                float ca = -INFINITY, cb = -INFINITY; int ia = 0, ib = 0;
#pragma unroll
                for (int q = 0; q < 4; ++q) { if (q == pa) { ca = tv[q]; ia = ti[q]; } if (q == pb) { cb = ov[q]; ib = oi[q]; } }
                const bool takeA = (ca > cb) || (ca == cb && ia < ib);
                mv[k] = takeA ? ca : cb; mi[k] = takeA ? ia : ib; pa += takeA ? 1 : 0; pb += takeA ? 0 : 1;
            }
        }
        const float e1 = __expf(mv[1] - mv[0]), e2 = __expf(mv[2] - mv[0]), e3 = __expf(mv[3] - mv[0]);
        const float inv = 1.0f / (1.0f + e1 + e2 + e3);
        if (hi == 0) {
            *(int4*)(EIDX + (size_t)t * 4) = make_int4(mi[0], mi[1], mi[2], mi[3]);
            *(float4*)(GATE + (size_t)t * 4) = make_float4(inv, e1 * inv, e2 * inv, e3 * inv);
#pragma unroll
            for (int k = 0; k < 4; ++k) { el[tl * 4 + k] = mi[k]; pl[tl * 4 + k] = atomicAdd((int*)(cnt + mi[k]), 1); }
        }
    } else {
        f32x4 gv[4];
#pragma unroll
        for (int j = 0; j < 4; ++j) gv[j] = *((const f32x4*)g2 + lane + 64 * j);
        for (int i = 0; i < 32; ++i) {
            const int t = tb0 + (wave - 4) * 32 + i;
            const u32x2* xr = (const u32x2*)(x1 + (size_t)t * D) + lane;
            f32x4 v[4]; float s = 0.f;
#pragma unroll
            for (int j = 0; j < 4; ++j) { const u32x2 xw = xr[64 * j]; v[j] = (f32x4){bflo(xw.x), bfhi(xw.x), bflo(xw.y), bfhi(xw.y)}; s += (v[j].x * v[j].x + v[j].y * v[j].y) + (v[j].z * v[j].z + v[j].w * v[j].w); }
            const float rstd = (1.0f / sqrtf(wave_sum(s) * (1.0f / D) + 1e-5f)) * F8_X_MUL;
            unsigned* o4 = (unsigned*)(H2 + (size_t)t * D) + lane;
#pragma unroll
            for (int j = 0; j < 4; ++j) { v[j] = v[j] * rstd * gv[j]; o4[64 * j] = pk4_fp8(v[j].x, v[j].y, v[j].z, v[j].w); }
        }
    }
    __syncthreads();
    if (tid < 32) basel[tid] = (int)atomicAdd(ctl + CW_CNT + tid, (unsigned)cnt[tid]);
    __syncthreads();
    for (int i = tid; i < TPB * 4; i += 512) POS[(size_t)tb0 * 4 + i] = pl[i] + basel[el[i]];
}

__device__ __forceinline__ void p6_dispatch(LAS unsigned char* lds, const Args& a, unsigned* ctl) {
    const int tid = threadIdx.x, lane = tid & 63, wave = __builtin_amdgcn_readfirstlane(tid >> 6);
    unsigned char* ws = a.ws;
    const int* EIDX = (const int*)(ws + WS_EIDX); const float* GATE = (const float*)(ws + WS_GATE); const int* POS = (const int*)(ws + WS_POS);
    int* DEST = (int*)(ws + WS_DEST); float* ROWGATE = (float*)(ws + WS_ROWGATE); int* TILEE = (int*)(ws + WS_TILEE); int* ROWTOK = (int*)(ws + WS_ROWTOK);
    LAS int* pstart = (LAS int*)(lds + MISC_OFF + 1024); LAS int* pcnt = pstart + 32;
    if (tid < NE) pcnt[tid] = (int)__hip_atomic_load(ctl + CW_CNT + tid, __ATOMIC_RELAXED, __HIP_MEMORY_SCOPE_AGENT);
    __syncthreads();
    if (tid == 0) {
        int acc = 0;
        for (int e = 0; e < NE; ++e) { pstart[e] = acc; acc += ((pcnt[e] + 255) >> 8) * 256; }
        if (blockIdx.x == 0) TILEE[1023] = acc >> 8;
    }
    __syncthreads();
    if (blockIdx.x == 0 && tid < NE) { const int nt = (pcnt[tid] + 255) >> 8, t0_ = pstart[tid] >> 8; for (int i = 0; i < nt; ++i) TILEE[t0_ + i] = tid; }
    if (blockIdx.x < NE) {
        const int e = blockIdx.x, cn = pcnt[e], pe = ((cn + 255) >> 8) * 256;
        for (int i = cn + tid; i < pe; i += 512) ROWTOK[pstart[e] + i] = 0;
    }
    const int TPB = T / (int)gridDim.x, tb0 = blockIdx.x * TPB;
    for (int pi = tb0 * 4 + tid; pi < (tb0 + TPB) * 4; pi += 512) {
        const int e = EIDX[pi], dest = pstart[e] + POS[pi];
        DEST[pi] = dest; ROWGATE[dest] = GATE[pi]; ROWTOK[dest] = pi >> 2;
    }
}

__device__ __forceinline__ void p9_combine(const Args& a, int G) {
    const int tid = threadIdx.x, lane = tid & 63, wave = __builtin_amdgcn_readfirstlane(tid >> 6);
    unsigned char* ws = a.ws;
    const unsigned char* YS = ws + WS_YS; const int* DEST = (const int*)(ws + WS_DEST);
    float* out = a.out;
    const int gw = blockIdx.x * 8 + wave, NGW = G * 8;
    for (int t = gw; t < T; t += NGW) {
        f32x4* xr = (f32x4*)(out + (size_t)t * D) + lane; const u32x2* xi = (const u32x2*)((const bf16_t*)(ws + WS_X1B) + (size_t)t * D) + lane;
        f32x4 v[4];
#pragma unroll
        for (int j = 0; j < 4; ++j) { const u32x2 xw = xi[64 * j]; v[j] = (f32x4){bflo(xw.x), bfhi(xw.x), bflo(xw.y), bfhi(xw.y)}; }
#pragma unroll
        for (int k = 0; k < 4; ++k) {
            const int dest = DEST[t * 4 + k];
            const unsigned* yr = (const unsigned*)(YS + (size_t)dest * D) + lane;
#pragma unroll
            for (int j = 0; j < 4; ++j) { const unsigned w = yr[64 * j];
                const f32x2 lo = __builtin_amdgcn_cvt_pk_f32_fp8((int)w, false), hi2 = __builtin_amdgcn_cvt_pk_f32_fp8((int)w, true);
                v[j].x += lo.x * (1.0f / F8_Y_MUL); v[j].y += lo.y * (1.0f / F8_Y_MUL); v[j].z += hi2.x * (1.0f / F8_Y_MUL); v[j].w += hi2.y * (1.0f / F8_Y_MUL); }
        }
        if (TIME_REGION >= 0) { const float sc_ = 1.0f + 4e-6f * (float)((const unsigned*)(ws + WS_CTL))[301];
#pragma unroll
            for (int j = 0; j < 4; ++j) v[j] = v[j] * sc_; }
#pragma unroll
        for (int j = 0; j < 4; ++j) xr[64 * j] = v[j];
    }
}

constexpr int NPHASE = 10;
__global__ void __launch_bounds__(512, 2) hymba_fwd(Args args) {
    extern __shared__ __attribute__((aligned(16))) unsigned char lds_raw[];
    LAS unsigned char* lds = (LAS unsigned char*)lds_raw;
    cg::grid_group grid = cg::this_grid();
    const int G = gridDim.x;
    unsigned char* ws = args.ws;
    unsigned* ctl = (unsigned*)(ws + WS_CTL);
    const int lo = args.ph_lo, hi = args.ph_hi;
#define IN(k) (lo <= (k) && (k) < hi)
#define NREP(k) ((REP_PHASE) == (k) ? 2 : 1)
#define TSTART(k) do { if ((TIME_REGION) == (k) && blockIdx.x == 0 && threadIdx.x == 0) ctl[300] = (unsigned)__builtin_amdgcn_s_memrealtime(); } while (0)
#define TEND(k) do { if ((TIME_REGION) == (k) && blockIdx.x == 0 && threadIdx.x == 0) ctl[301] = (unsigned)__builtin_amdgcn_s_memrealtime() - ctl[300]; } while (0)
#define SEAM(k) do { if (IN(k) && IN((k) + 1)) { if (args.ph_lo < 0) grid.sync(); xcd_barrier(xbar); } } while (0)
    const int* TILEE = (const int*)(ws + WS_TILEE);
    { volatile LAS unsigned* st = (volatile LAS unsigned*)(lds + LDS_BYTES - 64); if (threadIdx.x < 2) st[threadIdx.x] = 0u; }
    __syncthreads();
    const XcdBarrier xbar = xcd_barrier_post(ctl + CW_BAR, (volatile LAS unsigned*)(lds + LDS_BYTES - 64));

    if (IN(0)) { for (int rep = 0; rep < NREP(0); ++rep) p0_prologue(lds, args, G); } SEAM(0);
    if (IN(1)) {
        pg8::Gemm g{ws + WS_XN, ws + WS_WINT, 1024, 0, 0, nullptr};
        pg8::TileOrder S; S.init(T / 256, NINP / 256, G, (int)blockIdx.x, nullptr, 0, WGM_P1);
        pg8::EpiBf16 E{(bf16_t*)(ws + WS_P), NINP, (bf16_t*)(ws + WS_VT)};
        for (int rep = 0; rep < NREP(1); ++rep) pg8::gemm_phase<false, false>(lds, g, S, E);
    } SEAM(1);
    TSTART(2);
    if (IN(2)) {
        ck::fused_item(lds, args, (int)blockIdx.x * 2); ck::fused_item(lds, args, (int)blockIdx.x * 2 + 1);
    } SEAM(2);
    TSTART(3);
    if (IN(3)) {
        TSTART(30); for (int rep = 0; rep < NREP(30); ++rep) { if (blockIdx.x < 64) ck::seq_head(lds, args, (int)blockIdx.x); __syncthreads(); } TEND(30);
        for (int rep = 0; rep < NREP(31); ++rep) att::attn_phase(lds, args, ctl + 64 * rep);
    } SEAM(3); TEND(3);
    if (IN(4)) {
        pg8::Gemm g{ws + WS_YMIX, ws + WS_WOUT, 1024, 0, 0, nullptr};
        pg8::TileOrder S; S.init(T / 256, D / 256, G, (int)blockIdx.x, nullptr, 0, WGM_P4);
        pg8::EpiResBf16 E{args.in[0], (bf16_t*)(ws + WS_X1B), D};
        for (int rep = 0; rep < NREP(4); ++rep) pg8::gemm_phase<false, false>(lds, g, S, E);
    } SEAM(4);
    if (IN(5)) { _Pragma("clang loop unroll(disable)") for (int rep = 0; rep < NREP(5); ++rep) { p5_router(lds, args, ctl + 256 * (NREP(5) - 1 - rep)); __syncthreads(); } } SEAM(5);
    if (IN(6)) { for (int rep = 0; rep < NREP(6); ++rep) { p6_dispatch(lds, args, ctl); __syncthreads(); } } SEAM(6);
    if (IN(7)) {
        const int ntile = TILEE[1023];
        pg8::Gemm g{ws + WS_H2, ws + WS_W1T, 1024, F8_W_SC, F8_X_SC, (const int*)(ws + WS_ROWTOK)};
        pg8::TileOrder S; S.init(ntile, 8, G, (int)blockIdx.x, TILEE, 8, WGM_P7);
        pg8::EpiSwiglu E{ws + WS_HID, args.in[27], TILEE};
        for (int rep = 0; rep < NREP(7); ++rep) pg8::gemm_phase<true, true>(lds, g, S, E);
    } SEAM(7);
    if (IN(8)) {
        const int ntile = TILEE[1023];
        pg8::Gemm g{ws + WS_HID, ws + WS_W2T, 1024, F8_W_SC, F8_H_SC, nullptr};
        pg8::TileOrder S; S.init(ntile, 4, G, (int)blockIdx.x, TILEE, 4, WGM_P8);
        pg8::EpiGateF8 E{ws + WS_YS, args.in[29], (const float*)(ws + WS_ROWGATE), TILEE};
        for (int rep = 0; rep < NREP(8); ++rep) pg8::gemm_phase<true, false>(lds, g, S, E);
    } SEAM(8);
    if (IN(9)) { p9_combine(args, G); }
#undef IN
#undef SEAM
}

extern "C" void kernel_launch(void* const* d_in, const int* in_sizes, int n_in, void* d_out, int out_size, void* d_ws, size_t ws_size, hipStream_t stream) {
    static int grid = 0;
    if (grid == 0) {
        if (n_in != 30 || in_sizes[0] != T * D || out_size != T * D || ws_size < WS_END) { fprintf(stderr, "kernel_launch: unexpected shapes (n_in %d, in0 %d, out %d, ws %zu); nothing launched\n", n_in, n_in > 0 ? in_sizes[0] : -1, out_size, ws_size); grid = -1; return; }
        int dev = 0, cus = 0, per_cu = 0;
        if (hipGetDevice(&dev) != hipSuccess || hipDeviceGetAttribute(&cus, hipDeviceAttributeMultiprocessorCount, dev) != hipSuccess) { grid = -1; return; }
        if (hipFuncSetAttribute((const void*)hymba_fwd, hipFuncAttributeMaxDynamicSharedMemorySize, LDS_BYTES) != hipSuccess) { fprintf(stderr, "kernel_launch: hipFuncSetAttribute failed\n"); grid = -1; return; }
        if (hipOccupancyMaxActiveBlocksPerMultiprocessor(&per_cu, (const void*)hymba_fwd, 512, LDS_BYTES) != hipSuccess || per_cu < 1) { fprintf(stderr, "kernel_launch: occupancy query says %d\n", per_cu); per_cu = 1; }
        (void)hipGetLastError();
        grid = cus;
        if (grid > 256) grid = 256;
        if (grid != 256 || T % grid != 0 || (T / grid) % 16 != 0) { fprintf(stderr, "kernel_launch: grid %d does not divide the token count evenly\n", grid); grid = -1; return; }
    }
    if (grid < 0) return;
    (void)hipMemsetAsync((char*)d_ws + WS_CTL, 0, CTL_ZERO_BYTES, stream);
    Args a{};
    for (int i = 0; i < 30; ++i) a.in[i] = (const float*)d_in[i];
    a.out = (float*)d_out; a.ws = (unsigned char*)d_ws;
    constexpr int NL = MK_N_LAUNCHES;
    for (int li = 0; li < NL; ++li) {
        a.ph_lo = (NL == 1) ? 0 : li; a.ph_hi = (NL == 1) ? NPHASE : li + 1;
        void* kargs[] = {&a};
        hipError_t e = hipLaunchCooperativeKernel((const void*)hymba_fwd, dim3(grid), dim3(512), kargs, LDS_BYTES, stream);
        if (e != hipSuccess) { fprintf(stderr, "kernel_launch: cooperative launch %d failed: %s (grid %d)\n", li, hipGetErrorString(e), grid); break; }
    }
}
```

```cpp
#include <hip/hip_runtime.h>
#include <hip/hip_cooperative_groups.h>
#include <cstdio>
#include <cstdint>
#include <type_traits>
namespace cg = cooperative_groups;

#ifndef REP_PHASE
#define REP_PHASE -1
#endif
#ifndef TIME_REGION
#define TIME_REGION -1
#endif
#ifndef WGM_P1
#define WGM_P1 2
#endif
#ifndef WGM_P4
#define WGM_P4 2
#endif
#ifndef WGM_P7
#define WGM_P7 2
#endif
#ifndef WGM_P8
#define WGM_P8 2
#endif
#ifndef MK_N_LAUNCHES
#define MK_N_LAUNCHES 1
#endif

#define LAS __attribute__((address_space(3)))
#define GAS __attribute__((address_space(1)))
typedef unsigned short bf16_t;
typedef short bf16x8 __attribute__((ext_vector_type(8)));
typedef short s16x4 __attribute__((ext_vector_type(4)));
typedef float f32x2 __attribute__((ext_vector_type(2)));
typedef float f32x4 __attribute__((ext_vector_type(4)));
typedef float f32x16 __attribute__((ext_vector_type(16)));
typedef unsigned u32x2 __attribute__((ext_vector_type(2)));
typedef unsigned u32x4 __attribute__((ext_vector_type(4)));
typedef int v8i32 __attribute__((ext_vector_type(8)));

constexpr int NB = 8, SEQ = 4096, T = NB * SEQ, D = 1024;
constexpr int CW = 512;
constexpr int NRW = 1696, NIN = 3232, NINP = 3328;
constexpr int DQ0 = 1696, DK0 = 2208, DV0 = 2720;
constexpr int NE = 32, TOPK = 4, DE = 1024;
constexpr int MAXROWS = T * TOPK + NE * 256;
constexpr int MAXTILES = MAXROWS / 256;
constexpr float LOG2E = 1.4426950408889634f;
constexpr float F8_W_MUL = 32.f, F8_X_MUL = 8.f, F8_H_MUL = 4.f, F8_Y_MUL = 16.f; constexpr int F8_W_SC = 0x7A7A7A7A, F8_X_SC = 0x7C7C7C7C, F8_H_SC = 0x7D7D7D7D;

constexpr size_t MiB = 1u << 20;
constexpr size_t WS_CTL = 0, CTL_ZERO_BYTES = 64 * 1024;
constexpr size_t WS_TILEE = 512 * 1024;
constexpr size_t WS_LW = 576 * 1024;
constexpr size_t WS_WINT = 1 * MiB;
constexpr size_t WS_WOUT = 8 * MiB;
constexpr size_t WS_W1T = 10 * MiB;
constexpr size_t WS_W2T = 138 * MiB;
constexpr size_t WS_EIDX = 202 * MiB;
constexpr size_t WS_GATE = WS_EIDX + 512 * 1024;
constexpr size_t WS_POS = WS_GATE + 512 * 1024;
constexpr size_t WS_DEST = WS_POS + 512 * 1024;
constexpr size_t WS_ROWGATE = 204 * MiB;
constexpr size_t WS_XN = 206 * MiB;
constexpr size_t WS_P = 270 * MiB;
constexpr size_t WS_SR = 478 * MiB, WS_SK = 510 * MiB, WS_SV = 542 * MiB, WS_SA = 574 * MiB, WS_SB = 606 * MiB;
constexpr size_t WS_SW = 638 * MiB;
constexpr size_t WS_SG = 702 * MiB;
constexpr size_t WS_QN = 734 * MiB, WS_KN = 766 * MiB;
constexpr size_t WS_YMIX = 798 * MiB;
constexpr size_t WS_H2 = 206 * MiB;
constexpr size_t WS_ROWTOK = 270 * MiB;
constexpr size_t WS_HID = 406 * MiB;
constexpr size_t WS_YS = 542 * MiB;
constexpr size_t WS_X1B = 862 * MiB;
constexpr size_t WS_CG = 862 * MiB;
constexpr size_t WS_CH = 894 * MiB;
constexpr size_t WS_CR2 = 926 * MiB;
constexpr size_t WS_CY0 = 958 * MiB;
constexpr size_t WS_RK = 990 * MiB;
constexpr size_t WS_VT = 992 * MiB;
constexpr size_t WS_END = 1024 * MiB;
constexpr int CW_CNT = 64;
constexpr int CW_ATTQ = 128;
constexpr int CW_BAR = 4096;

constexpr int RING_BYTES = 131072, MISC_OFF = RING_BYTES, LDS_BYTES = 147456;

__device__ __forceinline__ unsigned f2bf(float f) { unsigned u = __builtin_bit_cast(unsigned, f); return (u + 0x7fffu + ((u >> 16) & 1u)) >> 16; }
typedef __bf16 hwbf16x2 __attribute__((ext_vector_type(2)));
__device__ __forceinline__ unsigned pk2(float lo, float hi) { const f32x2 v = {lo, hi}; return __builtin_bit_cast(unsigned, __builtin_convertvector(v, hwbf16x2)); }
__device__ __forceinline__ unsigned pk4_fp8(float a, float b, float c, float d) {
    a = fminf(fmaxf(a, -448.f), 448.f); b = fminf(fmaxf(b, -448.f), 448.f); c = fminf(fmaxf(c, -448.f), 448.f); d = fminf(fmaxf(d, -448.f), 448.f);
    int r = __builtin_amdgcn_cvt_pk_fp8_f32(a, b, 0, false); r = __builtin_amdgcn_cvt_pk_fp8_f32(c, d, r, true); return (unsigned)r; }
__device__ __forceinline__ float bf2f(unsigned short b) { return __builtin_bit_cast(float, (unsigned)b << 16); }
__device__ __forceinline__ float bflo(unsigned w) { return __builtin_bit_cast(float, w << 16); }
__device__ __forceinline__ float bfhi(unsigned w) { return __builtin_bit_cast(float, w & 0xffff0000u); }
__device__ __forceinline__ float wave_sum(float v) {
#pragma unroll
    for (int o = 1; o < 64; o <<= 1) v += __shfl_xor(v, o);
    return v;
}
__device__ __forceinline__ float sigmoidf_(float x) { return 1.0f / (1.0f + __expf(-x)); }
template <int CTRL> __device__ __forceinline__ float dpp_f(float v) { return __builtin_bit_cast(float, __builtin_amdgcn_update_dpp(0, __builtin_bit_cast(int, v), CTRL, 0xF, 0xF, true)); }
__device__ __forceinline__ float red8(float v) {
    v += dpp_f<0xB1>(v);
    v += dpp_f<0x4E>(v);
    v += dpp_f<0x141>(v);
    return v;
}
__device__ __forceinline__ float red4(float v) { v += dpp_f<0xB1>(v); v += dpp_f<0x4E>(v); return v; }


#define XB_TMO      128
#define XB_XCNT(j)  (256  + 64 * (j))
#define XB_XSUB(j)  (1280 + 64 * (j))
#define XB_XGEN(j)  (2304 + 64 * (j))
#define XB_TOP      3328
#define XB_TOPGEN   3392
#define XCD_BAR_WORDS 3456
#define XB_SPIN_CAP (1u << 18)
__device__ __forceinline__ unsigned xb_ld(unsigned* p)              { return __hip_atomic_load(p, __ATOMIC_RELAXED, __HIP_MEMORY_SCOPE_AGENT); }
__device__ __forceinline__ unsigned xb_add(unsigned* p, unsigned v) { return __hip_atomic_fetch_add(p, v, __ATOMIC_RELAXED, __HIP_MEMORY_SCOPE_AGENT); }
__device__ __forceinline__ unsigned xb_xcc_id() { return (unsigned)__builtin_amdgcn_s_getreg((3 << 11) | 20) & 0xFu; }
#define XB_SPIN(cond, bar) do { unsigned _sp = 0; while (cond) { __builtin_amdgcn_s_sleep(1); \
    if ((++_sp & 255u) == 0u) { if (xb_ld(&(bar)[XB_TMO])) break; if (_sp > XB_SPIN_CAP) { atomicAdd(&(bar)[XB_TMO], 1u); break; } } } } while (0)
struct XcdBarrier { unsigned* bar; unsigned x; volatile LAS unsigned* st; };
__device__ __forceinline__ XcdBarrier xcd_barrier_post(unsigned* bar, volatile LAS unsigned* st) {
    XcdBarrier b; b.bar = bar; b.x = xb_xcc_id(); b.st = st;
    if (threadIdx.x == 0) (void)xb_add(&bar[XB_XCNT(b.x)], 1u);
    return b;
}
__device__ __forceinline__ void xcd_barrier_complete(unsigned* bar, unsigned x, unsigned& nloc, unsigned& nx) {
    const unsigned G = gridDim.x * gridDim.y * gridDim.z;
    unsigned sum, cnt, mine, sp = 0u;
    for (;;) {
        sum = 0u; cnt = 0u; mine = 0u;
#pragma unroll
        for (unsigned j = 0; j < 16; ++j) { const unsigned c = xb_ld(&bar[XB_XCNT(j)]); sum += c; cnt += (c > 0u) ? 1u : 0u; mine = (j == x) ? c : mine; }
        if (sum == G) break;
        __builtin_amdgcn_s_sleep(1);
        if ((++sp & 255u) == 0u) { if (xb_ld(&bar[XB_TMO])) break; if (sp > XB_SPIN_CAP) { atomicAdd(&bar[XB_TMO], 1u); break; } }
    }
    nloc = mine > 0u ? mine : 1u; nx = cnt > 0u ? cnt : 1u;
}
__device__ __forceinline__ void xcd_barrier(const XcdBarrier& b) {
    asm volatile("s_waitcnt vmcnt(0)" ::: "memory");
    __syncthreads();
    if (threadIdx.x == 0) {
        unsigned* bar = b.bar;
        __builtin_amdgcn_s_waitcnt(0);
        unsigned nloc = b.st[0], nx = b.st[1];
        if (nloc == 0u) { xcd_barrier_complete(bar, b.x, nloc, nx); b.st[0] = nloc; b.st[1] = nx; }
        const unsigned old = xb_add(&bar[XB_XSUB(b.x)], 1u);
        const unsigned gen = old / nloc;
        if (old + 1u == (gen + 1u) * nloc) {
            __builtin_amdgcn_fence(__ATOMIC_RELEASE, "agent");
            asm volatile("s_waitcnt vmcnt(0)" ::: "memory");
            const unsigned og = xb_add(&bar[XB_TOP], 1u);
            const unsigned tg = og / nx;
            if (og + 1u == (tg + 1u) * nx) xb_add(&bar[XB_TOPGEN], 1u);
            else XB_SPIN(xb_ld(&bar[XB_TOPGEN]) == tg, bar);
            __builtin_amdgcn_fence(__ATOMIC_ACQUIRE, "agent");
            xb_add(&bar[XB_XGEN(b.x)], 1u);
            asm volatile("s_waitcnt vmcnt(0)" ::: "memory");
        } else {
            XB_SPIN(xb_ld(&bar[XB_XGEN(b.x)]) == gen, bar);
            __builtin_amdgcn_fence(__ATOMIC_ACQUIRE, "agent");
            asm volatile("s_waitcnt vmcnt(0)" ::: "memory");
        }
    }
    __syncthreads();
}

namespace pg8 {
constexpr int BM = 256, BK = 64, HALF = 128, HTB = HALF * BK * 2, STAGE_BYTES = 8 * HTB, NXCD = 8;
__host__ __device__ __forceinline__ int lds_byte(int r, int c) { const int st = (r >> 4) * 2 + (c >> 5), rr = r & 15, cc = c & 31, ob = rr * 64 + cc * 2; return st * 1024 + (ob ^ (((ob >> 9) & 1) << 5)); }
__host__ __device__ __forceinline__ void stage_rc(int b, int& R, int& C) { const int st = b / 1024, sb = b % 1024, swz = sb ^ (((sb >> 9) & 1) << 5); R = (st >> 1) * 16 + swz / 64; C = (st & 1) * 32 + (swz % 64) / 2; }
__host__ __device__ __forceinline__ void stage_rc_f8(int b, int& R, int& C) { const int p = b >> 10, l = (b >> 4) & 63, fr = l >> 2, fq = (l & 3) ^ ((-(fr >> 2)) & 3); R = (p >> 1) * 16 + fr; C = (2 * fq + (p & 1)) * 8; }
__host__ __device__ __forceinline__ int frag_f8(int row0, int fr, int fq) { return (row0 >> 4) * 2048 + fr * 64 + ((fq ^ ((-(fr >> 2)) & 3)) * 16); }
__host__ __device__ __forceinline__ int perm32(int rho) { const int n = rho >> 4, i = rho & 15; return 8 * (i >> 2) + 4 * n + (i & 3); }

struct Unit { int pm, pn, pb; };
struct Gemm { const void* A; const void* Bt; int K; int scW, scA; const int* rowtok; };

struct TileOrder {
    int nM, nN, nwg, G, c, WGM; const int* tile_e; int nb_per_e;
    __device__ void init(int nM_, int nN_, int G_, int c_, const int* te, int nbe, int wgm) { nM = nM_; nN = nN_; nwg = nM * nN; G = G_; c = c_; tile_e = te; nb_per_e = nbe; WGM = wgm; }
    __device__ bool next(int i, Unit& u) const {
        const long L = (long)i * G + c; if (L >= nwg) return false;
        int wgid = (int)L; { const int q = nwg / NXCD, r = nwg % NXCD, xcd = wgid % NXCD, off = wgid / NXCD; wgid = (xcd < r ? xcd * (q + 1) : r * (q + 1) + (xcd - r) * q) + off; }
        const int nig = WGM * nN, gid = wgid / nig, fm = gid * WGM, gsz = (nM - fm) < WGM ? (nM - fm) : WGM;
        u.pm = fm + ((wgid % nig) % gsz); u.pn = (wgid % nig) / gsz;
        u.pb = tile_e ? tile_e[u.pm] * nb_per_e + u.pn : u.pn;
        return true;
    }
};

struct EpiBf16 {
    static constexpr bool PERM = true;
    bf16_t* O; int ldc; bf16_t* VT;
    __device__ __forceinline__ void operator()(const f32x4 (&acc)[2][2][4][2], const Unit& u, int wr, int wc, int fr, int fq) const {
        const int row0 = u.pm * BM + wr * 64 + fr; const int col0 = u.pn * BM + wc * 32 + 8 * fq;
#pragma unroll
        for (int ai = 0; ai < 2; ++ai)
#pragma unroll
            for (int m = 0; m < 4; ++m) { const int t = row0 + ai * HALF + m * 16; bf16_t* rowp = O + (size_t)t * ldc + col0;
#pragma unroll
                for (int bj = 0; bj < 2; ++bj) { const f32x4 v0 = acc[ai][bj][m][0], v1 = acc[ai][bj][m][1];
                    u32x4 w; w.x = pk2(v0[0], v0[1]); w.y = pk2(v0[2], v0[3]); w.z = pk2(v1[0], v1[1]); w.w = pk2(v1[2], v1[3]);
                    const int col = col0 + bj * HALF;
                    if (col >= DV0) { const int dvf = col - DV0, hh = dvf >> 7, dv = dvf & 127, tp = t & (SEQ - 1), key = tp & 63;
                        bf16_t* vp = VT + (((((size_t)((t >> 12) * 4 + hh) * 64 + (tp >> 6)) * 4 + (dv >> 5)) * 4 + (key >> 4)) * 16 + (key & 15)) * 32 + (dv & 31);
                        if (col < NIN) *(u32x4*)vp = w; }
                    else *(u32x4*)(rowp + bj * HALF) = w; } }
    }
};
struct EpiResBf16 {
    static constexpr bool PERM = true;
    const float* base; bf16_t* out; int ldc;
    __device__ __forceinline__ void operator()(const f32x4 (&acc)[2][2][4][2], const Unit& u, int wr, int wc, int fr, int fq) const {
        const int col0 = u.pn * BM + wc * 32 + 8 * fq;
#pragma unroll
        for (int ai = 0; ai < 2; ++ai)
#pragma unroll
            for (int m = 0; m < 4; ++m) { const size_t off = (size_t)(u.pm * BM + ai * HALF + wr * 64 + m * 16 + fr) * ldc + col0;
#pragma unroll
                for (int bj = 0; bj < 2; ++bj) { const f32x4 b0 = *(const f32x4*)(base + off + bj * HALF), b1 = *(const f32x4*)(base + off + bj * HALF + 4);
                    const f32x4 v0 = b0 + acc[ai][bj][m][0], v1 = b1 + acc[ai][bj][m][1];
                    u32x4 w; w.x = pk2(v0[0], v0[1]); w.y = pk2(v0[2], v0[3]); w.z = pk2(v1[0], v1[1]); w.w = pk2(v1[2], v1[3]);
                    *(u32x4*)(out + off + bj * HALF) = w; } }
    }
};
struct EpiSwiglu {
    static constexpr bool PERM = true;
    unsigned char* O; const float* b1; const int* tile_e;
    __device__ __forceinline__ void operator()(const f32x4 (&acc)[2][2][4][2], const Unit& u, int wr, int wc, int fr, int fq) const {
        const int e = tile_e[u.pm]; const int row0 = u.pm * BM + wr * 64 + fr; const int hc0 = u.pn * 128 + wc * 32 + 8 * fq;
        const float* bg = b1 + (size_t)e * 2048 + hc0; const float* bl = bg + 1024;
        const f32x4 g0 = *(const f32x4*)bg, g1 = *(const f32x4*)(bg + 4), l0 = *(const f32x4*)bl, l1 = *(const f32x4*)(bl + 4);
#pragma unroll
        for (int ai = 0; ai < 2; ++ai)
#pragma unroll
            for (int m = 0; m < 4; ++m) { unsigned char* rowp = O + (size_t)(row0 + ai * HALF + m * 16) * 1024 + hc0;
                float o[8];
#pragma unroll
                for (int n = 0; n < 2; ++n) { const f32x4 gv = acc[ai][0][m][n] + (n ? g1 : g0), lv = acc[ai][1][m][n] + (n ? l1 : l0);
#pragma unroll
                    for (int i = 0; i < 4; ++i) { const float g = fminf(gv[i], 7.0f), l = fminf(fmaxf(lv[i], -7.0f), 7.0f);
                        const float sg = __builtin_amdgcn_rcpf(1.0f + __builtin_amdgcn_exp2f(-1.702f * LOG2E * g)); o[n * 4 + i] = g * sg * (l + 1.0f); } }
                u32x2 w; w.x = pk4_fp8(o[0] * F8_H_MUL, o[1] * F8_H_MUL, o[2] * F8_H_MUL, o[3] * F8_H_MUL); w.y = pk4_fp8(o[4] * F8_H_MUL, o[5] * F8_H_MUL, o[6] * F8_H_MUL, o[7] * F8_H_MUL);
                *(u32x2*)rowp = w; }
    }
};
struct EpiGateF8 {
    static constexpr bool PERM = true;
    unsigned char* O; const float* b2; const float* rowgate; const int* tile_e;
    __device__ __forceinline__ void operator()(const f32x4 (&acc)[2][2][4][2], const Unit& u, int wr, int wc, int fr, int fq) const {
        const int e = tile_e[u.pm]; const int row0 = u.pm * BM + wr * 64 + fr; const int col0 = u.pn * BM + wc * 32 + 8 * fq;
        f32x4 bv[2][2];
#pragma unroll
        for (int bj = 0; bj < 2; ++bj)
#pragma unroll
            for (int n = 0; n < 2; ++n) bv[bj][n] = *(const f32x4*)(b2 + (size_t)e * 1024 + col0 + bj * HALF + 4 * n);
#pragma unroll
        for (int ai = 0; ai < 2; ++ai)
#pragma unroll
            for (int m = 0; m < 4; ++m) { const int row = row0 + ai * HALF + m * 16; const float gt = rowgate[row] * F8_Y_MUL; unsigned char* rowp = O + (size_t)row * 1024 + col0;
#pragma unroll
                for (int bj = 0; bj < 2; ++bj) { const f32x4 v0 = (acc[ai][bj][m][0] + bv[bj][0]) * gt, v1 = (acc[ai][bj][m][1] + bv[bj][1]) * gt;
                    u32x2 w; w.x = pk4_fp8(v0[0], v0[1], v0[2], v0[3]); w.y = pk4_fp8(v1[0], v1[1], v1[2], v1[3]);
                    *(u32x2*)(rowp + bj * HALF) = w; } }
    }
};

__device__ __forceinline__ v8i32 pg8_ld32(const LAS unsigned char* p) { const u32x4 a = *(const LAS u32x4*)p, b = *(const LAS u32x4*)(p + 1024);
    return (v8i32){(int)a.x, (int)a.y, (int)a.z, (int)a.w, (int)b.x, (int)b.y, (int)b.z, (int)b.w}; }
template <bool F8, bool GATHER, class Epi, class Sched>
__device__ __forceinline__ void gemm_phase(LAS unsigned char* lds, const Gemm g, const Sched& S, const Epi& E) {
    const int tid = threadIdx.x, wid = __builtin_amdgcn_readfirstlane(tid >> 6), lane = tid & 63, wr = wid >> 2, wc = wid & 3, fr = lane & 15, fq = lane >> 4;
    const int RB = F8 ? g.K : g.K * 2, nt = RB / 128;
    unsigned voffB[2];
#pragma unroll
    for (int i = 0; i < 2; ++i) { int R, C; if constexpr (F8) stage_rc_f8(tid * 16 + i * 8192, R, C); else stage_rc(tid * 16 + i * 8192, R, C); const int Rb = Epi::PERM ? ((R & ~31) + perm32(R & 31)) : R;
        voffB[i] = (unsigned)(Rb * RB + C * 2); }
#define PG8_AOFFS(dst, pm_) do { _Pragma("unroll") for (int h_ = 0; h_ < 2; ++h_) _Pragma("unroll") for (int i_ = 0; i_ < 2; ++i_) { int R_, C_; if constexpr (F8) stage_rc_f8(tid * 16 + i_ * 8192, R_, C_); else stage_rc(tid * 16 + i_ * 8192, R_, C_); \
        const int row_ = (pm_) * BM + h_ * HALF + R_; const unsigned grow_ = GATHER ? (unsigned)g.rowtok[row_] : (unsigned)row_; dst[h_][i_] = grow_ * (unsigned)RB + (unsigned)(C_ * 2); } } while (0)
    unsigned cvA[2][2], nvA[2][2];
    const size_t kstep = (size_t)(BK * 2);
    const size_t hstep = (size_t)HALF * RB;
    const size_t tstep = 2 * hstep;
    const unsigned ldsw = (unsigned)wid * 1024u;
    const int aoff = F8 ? frag_f8(wr * 64, fr, fq) : lds_byte(wr * 64 + fr, fq * 8);
    const int boff = F8 ? frag_f8(wc * 32, fr, fq) : lds_byte(wc * 32 + fr, fq * 8);
    const int scW = g.scW, scA = g.scA;
#define PG8_SA(b, h) (((b) * 2 + (h)) * HTB)
#define PG8_SB(b, h) ((4 + (b) * 2 + (h)) * HTB)
#define PG8_STAGE(bufoff, gbase, voff) do { _Pragma("unroll") for (int _i = 0; _i < 2; ++_i) \
        __builtin_amdgcn_global_load_lds((const unsigned*)((const char*)(gbase) + (voff)[_i]), (LAS unsigned*)(lds + (bufoff) + ldsw + _i * 8192), 16, 0, 0); } while (0)
typedef int v8i32a __attribute__((ext_vector_type(8), aligned(16)));
#define PG8_LD32(p) pg8_ld32(p)
#define PG8_STAGE_A(bufoff, kptr, offs) do { _Pragma("unroll") for (int _i = 0; _i < 2; ++_i) \
        __builtin_amdgcn_global_load_lds((const unsigned*)((const char*)(kptr) + (offs)[_i]), (LAS unsigned*)(lds + (bufoff) + ldsw + _i * 8192), 16, 0, 0); } while (0)
#define PG8_LDA(dst, b, h) do { _Pragma("unroll") for (int m = 0; m < 4; ++m) { if constexpr (F8) { dst[m].f8 = PG8_LD32(lds + PG8_SA(b, h) + aoff + m * 2048); } \
        else { _Pragma("unroll") for (int k = 0; k < 2; ++k) dst[m].hv[k] = *(const LAS bf16x8*)(lds + PG8_SA(b, h) + aoff + m * 2048 + k * 1024); } } } while (0)
#define PG8_LDB(dst, b, h) do { _Pragma("unroll") for (int n = 0; n < 2; ++n) { if constexpr (F8) { dst[n].f8 = PG8_LD32(lds + PG8_SB(b, h) + boff + n * 2048); } \
        else { _Pragma("unroll") for (int k = 0; k < 2; ++k) dst[n].hv[k] = *(const LAS bf16x8*)(lds + PG8_SB(b, h) + boff + n * 2048 + k * 1024); } } } while (0)
#define PG8_MMA(ai, bj, At, Bt) do { __builtin_amdgcn_s_setprio(1); _Pragma("unroll") for (int m = 0; m < 4; ++m) _Pragma("unroll") for (int n = 0; n < 2; ++n) { \
        if constexpr (F8) { asm volatile("v_mfma_scale_f32_16x16x128_f8f6f4 %0, %1, %2, %0, %3, %4 op_sel_hi:[0,0,0]" : "+v"(acc[ai][bj][m][n]) : "v"(Bt[n].f8), "v"(At[m].f8), "v"(scW), "v"(scA)); } \
        else { _Pragma("unroll") for (int k = 0; k < 2; ++k) acc[ai][bj][m][n] = __builtin_amdgcn_mfma_f32_16x16x32_bf16(Bt[n].hv[k], At[m].hv[k], acc[ai][bj][m][n], 0, 0, 0); } } \
        __builtin_amdgcn_s_setprio(0); } while (0)
#define PG8_WAIT_V(n) asm volatile("s_waitcnt vmcnt(" #n ")" ::: "memory")
#define PG8_WAIT_L(n) asm volatile("s_waitcnt lgkmcnt(" #n ")" ::: "memory")
#define PG8_BAR __builtin_amdgcn_s_barrier()
#define PG8_SCHED __builtin_amdgcn_sched_barrier(0)
    Unit cur, nxt; int ui = 0;
    if (!S.next(0, cur)) return;
    f32x4 acc[2][2][4][2];
#pragma unroll
    for (int a = 0; a < 2; ++a)
#pragma unroll
        for (int b = 0; b < 2; ++b)
#pragma unroll
            for (int m = 0; m < 4; ++m)
#pragma unroll
                for (int n = 0; n < 2; ++n) acc[a][b][m][n] = (f32x4){0.f, 0.f, 0.f, 0.f};
    struct FragH { bf16x8 hv[2]; }; struct Frag8 { v8i32 f8; };
    typename std::conditional<F8, Frag8, FragH>::type At[4], B0[2], B1[2];
    const char* const kA = (const char*)g.A; const char* cB = (const char*)g.Bt + (size_t)cur.pb * tstep;
    PG8_AOFFS(cvA, cur.pm);
    PG8_STAGE(PG8_SB(0, 0), cB, voffB); PG8_STAGE(PG8_SB(0, 1), cB + hstep, voffB); PG8_STAGE_A(PG8_SA(0, 0), kA, cvA[0]); PG8_STAGE_A(PG8_SA(0, 1), kA, cvA[1]);
    if (wr == 1) PG8_BAR;
    PG8_WAIT_V(2); PG8_BAR;
    PG8_STAGE(PG8_SB(1, 0), cB + kstep, voffB); PG8_STAGE_A(PG8_SA(1, 0), kA + kstep, cvA[0]); PG8_STAGE(PG8_SB(1, 1), cB + hstep + kstep, voffB);
    PG8_WAIT_V(6); PG8_BAR;
    for (;;) {
        const bool has_next = S.next(ui + 1, nxt);
        const char* nB = has_next ? (const char*)g.Bt + (size_t)nxt.pb * tstep : cB;
        if (has_next) { PG8_AOFFS(nvA, nxt.pm); } else { _Pragma("unroll") for (int h_ = 0; h_ < 2; ++h_) _Pragma("unroll") for (int i_ = 0; i_ < 2; ++i_) nvA[h_][i_] = cvA[h_][i_]; }
#pragma clang loop unroll(disable)
        for (int t = 0; t < nt; t += 2) {
            const bool last = (t == nt - 2);
            const char* a1 = kA + (size_t)(t + 1) * kstep;
            const char* a2 = last ? kA : kA + (size_t)(t + 2) * kstep; const char* b2 = last ? nB : cB + (size_t)(t + 2) * kstep;
            const char* a3 = a2 + kstep; const char* b3 = b2 + kstep;
            unsigned v2A[2][2];
#pragma unroll
            for (int h_ = 0; h_ < 2; ++h_)
#pragma unroll
                for (int i_ = 0; i_ < 2; ++i_) v2A[h_][i_] = last ? nvA[h_][i_] : cvA[h_][i_];
            PG8_LDB(B0, 0, 0); PG8_LDB(B1, 0, 1); PG8_SCHED; PG8_LDA(At, 0, 0); PG8_STAGE_A(PG8_SA(1, 1), a1, cvA[1]);
            PG8_WAIT_V(8); PG8_WAIT_L(0); PG8_BAR; PG8_MMA(0, 0, At, B0); PG8_MMA(0, 1, At, B1); PG8_BAR; PG8_SCHED;
            PG8_LDA(At, 0, 1); PG8_STAGE(PG8_SB(0, 0), b2, voffB); PG8_STAGE(PG8_SB(0, 1), b2 + hstep, voffB); PG8_STAGE_A(PG8_SA(0, 0), a2, v2A[0]);
            PG8_WAIT_V(8); PG8_WAIT_L(0); PG8_BAR; PG8_MMA(1, 0, At, B0); PG8_MMA(1, 1, At, B1); PG8_BAR; PG8_SCHED;
            PG8_LDB(B0, 1, 0); PG8_LDB(B1, 1, 1); PG8_SCHED; PG8_LDA(At, 1, 0); PG8_STAGE_A(PG8_SA(0, 1), a2, v2A[1]);
            PG8_WAIT_V(8); PG8_WAIT_L(0); PG8_BAR; PG8_MMA(0, 0, At, B0); PG8_MMA(0, 1, At, B1); PG8_BAR; PG8_SCHED;
            PG8_LDA(At, 1, 1); PG8_STAGE(PG8_SB(1, 0), b3, voffB); PG8_STAGE(PG8_SB(1, 1), b3 + hstep, voffB); PG8_STAGE_A(PG8_SA(1, 0), a3, v2A[0]);
            PG8_WAIT_V(8); PG8_WAIT_L(0); PG8_BAR; PG8_MMA(1, 0, At, B0); PG8_MMA(1, 1, At, B1); PG8_BAR; PG8_SCHED;
        }
        if (wr == 0) PG8_BAR;
        if constexpr (F8) asm volatile("s_nop 15\n\ts_nop 15" ::: "memory");
        E(acc, cur, wr, wc, fr, fq);
        if (!has_next) break;
#pragma unroll
        for (int a = 0; a < 2; ++a)
#pragma unroll
            for (int b = 0; b < 2; ++b)
#pragma unroll
                for (int m = 0; m < 4; ++m)
#pragma unroll
                    for (int n = 0; n < 2; ++n) acc[a][b][m][n] = (f32x4){0.f, 0.f, 0.f, 0.f};
        cur = nxt; cB = nB; ++ui;
#pragma unroll
        for (int h_ = 0; h_ < 2; ++h_)
#pragma unroll
            for (int i_ = 0; i_ < 2; ++i_) cvA[h_][i_] = nvA[h_][i_];
        if (wr == 1) PG8_BAR;
    }
    PG8_WAIT_V(0);
    PG8_BAR;
#undef PG8_SA
#undef PG8_SB
#undef PG8_STAGE
#undef PG8_STAGE_A
#undef PG8_AOFFS
#undef PG8_LDA
#undef PG8_LDB
#undef PG8_MMA
#undef PG8_LD32
#undef PG8_WAIT_V
#undef PG8_WAIT_L
#undef PG8_BAR
#undef PG8_SCHED
}
}

struct Args { const float* in[30]; float* out; unsigned char* ws; int ph_lo, ph_hi; };

__device__ __forceinline__ void p0_transpose_item(const float* W, int K, int N, bf16_t* WT, int k0, int n0, int drow0, LAS float* scr, int lane) {
#pragma unroll 8
    for (int i = 0; i < 32; ++i) { const int kk = 2 * i + (lane >> 5); scr[kk * 33 + (lane & 31)] = W[(size_t)(k0 + kk) * N + n0 + (lane & 31)]; }
    asm volatile("s_waitcnt lgkmcnt(0)" ::: "memory");
    const int c = lane & 7;
#pragma unroll
    for (int j = 0; j < 4; ++j) { const int n = (lane >> 3) + 8 * j; const LAS float* s = scr + (8 * c) * 33 + n;
        u32x4 o; o.x = pk2(s[0 * 33], s[1 * 33]); o.y = pk2(s[2 * 33], s[3 * 33]); o.z = pk2(s[4 * 33], s[5 * 33]); o.w = pk2(s[6 * 33], s[7 * 33]);
        *(u32x4*)(WT + (size_t)(drow0 + n) * K + k0 + 8 * c) = o; }
    asm volatile("s_waitcnt lgkmcnt(0)" ::: "memory");
}
__device__ __forceinline__ void p0_transpose_item_f8(const float* W, int K, int N, unsigned char* WT, int k0, int n0, int drow0, LAS float* scr, int lane) {
    LAS unsigned* tile = (LAS unsigned*)scr;
    const float* src = W + (size_t)k0 * N + n0 + lane;
#pragma unroll 8
    for (int kq = 0; kq < 32; ++kq) {
        const float* p = src + (size_t)(4 * kq) * N;
        tile[lane * 33 + kq] = pk4_fp8(p[0] * F8_W_MUL, p[N] * F8_W_MUL, p[2 * (size_t)N] * F8_W_MUL, p[3 * (size_t)N] * F8_W_MUL);
    }
    asm volatile("s_waitcnt lgkmcnt(0)" ::: "memory");
    const int c = lane & 7;
#pragma unroll
    for (int j = 0; j < 8; ++j) { const int n = (lane >> 3) + 8 * j; const LAS unsigned* t = tile + n * 33 + 4 * c;
        *(u32x4*)(WT + (size_t)(drow0 + n) * K + k0 + 16 * c) = (u32x4){t[0], t[1], t[2], t[3]}; }
    asm volatile("s_waitcnt lgkmcnt(0)" ::: "memory");
}
__device__ __forceinline__ void p0_prologue(LAS unsigned char* lds, const Args& a, int G) {
    const int tid = threadIdx.x, lane = tid & 63, wave = __builtin_amdgcn_readfirstlane(tid >> 6);
    LAS float* scr = (LAS float*)(lds + wave * 16384);
    const int gw = blockIdx.x * 8 + wave, NGW = G * 8;
    unsigned char* ws = a.ws;
    bf16_t* Wint = (bf16_t*)(ws + WS_WINT); bf16_t* Woutt = (bf16_t*)(ws + WS_WOUT); unsigned char* W1t = ws + WS_W1T; unsigned char* W2t = ws + WS_W2T;
    constexpr int I_IN = 16 * (NIN / 32);
    constexpr int I_OUT = 16 * 32;
    constexpr int I_W1 = 8 * 32;
    constexpr int I_W2 = 8 * 16;
    constexpr int NITEMS = I_IN + I_OUT + NE * I_W1 + NE * I_W2;
    for (int it = gw; it < NITEMS; it += NGW) {
        int r = it;
        if (r < I_IN) { const int nblk = NIN / 32, kb = r / nblk, nb = r % nblk; p0_transpose_item(a.in[2], 1024, NIN, Wint, 64 * kb, 32 * nb, 32 * nb, scr, lane); continue; } r -= I_IN;
        if (r < I_OUT) { const int kb = r / 32, nb = r % 32; p0_transpose_item(a.in[22], 1024, 1024, Woutt, 64 * kb, 32 * nb, 32 * nb, scr, lane); continue; } r -= I_OUT;
        if (r < NE * I_W1) { const int e = r / I_W1, q = r % I_W1, kb = q / 32, nb = q % 32; const int n0 = 64 * nb;
            const int drow = (n0 < 1024) ? ((n0 >> 7) * 256 + (n0 & 127)) : (((n0 - 1024) >> 7) * 256 + 128 + ((n0 - 1024) & 127));
            p0_transpose_item_f8(a.in[26] + (size_t)e * 1024 * 2048, 1024, 2048, W1t + (size_t)e * 2048 * 1024, 128 * kb, n0, drow, scr, lane); continue; } r -= NE * I_W1;
        { const int e = r / I_W2, q = r % I_W2, kb = q / 16, nb = q % 16;
            p0_transpose_item_f8(a.in[28] + (size_t)e * 1024 * 1024, 1024, 1024, W2t + (size_t)e * 1024 * 1024, 128 * kb, 64 * nb, 64 * nb, scr, lane); }
    }
    { bf16_t* LW = (bf16_t*)(ws + WS_LW);
      for (int i = gw * 64 + lane; i < CW * 160; i += NGW * 64) { const int col = i / 160, k = i - col * 160;
          const float v = k < 32 ? a.in[5][k * CW + col] : (k < 64 ? a.in[7][(k - 32) * CW + col] : a.in[8][(k - 64) * CW + col]); LW[i] = (bf16_t)f2bf(v); } }
    const float* x = a.in[0]; const float* g1 = a.in[1]; bf16_t* XN = (bf16_t*)(ws + WS_XN);
    f32x4 gv[4];
#pragma unroll
    for (int j = 0; j < 4; ++j) gv[j] = *((const f32x4*)g1 + lane + 64 * j);
#pragma unroll 4
    for (int m = gw; m < T; m += NGW) {
        const f32x4* xr = (const f32x4*)(x + (size_t)m * D) + lane;
        f32x4 v[4]; float s = 0.f;
#pragma unroll
        for (int j = 0; j < 4; ++j) { v[j] = xr[64 * j]; s += (v[j].x * v[j].x + v[j].y * v[j].y) + (v[j].z * v[j].z + v[j].w * v[j].w); }
        const float rstd = 1.0f / sqrtf(wave_sum(s) * (1.0f / D) + 1e-5f);
        u32x2* o8 = (u32x2*)(XN + (size_t)m * D) + lane;
#pragma unroll
        for (int j = 0; j < 4; ++j) { u32x2 w; w.x = pk2(v[j].x * rstd * gv[j].x, v[j].y * rstd * gv[j].y); w.y = pk2(v[j].z * rstd * gv[j].z, v[j].w * rstd * gv[j].w); o8[64 * j] = w; }
    }
}

__device__ __forceinline__ f32x4 cvlo(const u32x4 u) { return (f32x4){bflo(u.x), bfhi(u.x), bflo(u.y), bfhi(u.y)}; }
__device__ __forceinline__ f32x4 cvhi(const u32x4 u) { return (f32x4){bflo(u.z), bfhi(u.z), bflo(u.w), bfhi(u.w)}; }
__device__ __forceinline__ u32x4 pk8(const f32x4 lo, const f32x4 hi) { u32x4 w; w.x = pk2(lo.x, lo.y); w.y = pk2(lo.z, lo.w); w.z = pk2(hi.x, hi.y); w.w = pk2(hi.z, hi.w); return w; }

namespace ck {
constexpr int PS = 136;
constexpr int O_BT = 0, O_KT = 8704, O_AP = 17408, O_RT = 26112;
constexpr int O_AT = 34816, O_BH = 43008, O_KH = 51200, O_VV = 59392, O_TN = 67584, O_A2 = 75776, O_V2 = 83968;
constexpr int O_L = 92160, LSTR = 68;
constexpr int O_TOT = 109568, O_GC = 111616;
constexpr int O_ACT = 112128;
__device__ __forceinline__ int crow(int r, int hi) { return (r & 3) + 8 * (r >> 2) + 4 * hi; }
__device__ __forceinline__ int voff(int row, int col) { return ((col >> 5) * 4 + (row >> 4)) * 1024 + (row & 15) * 64 + (col & 31) * 2; }
__device__ __forceinline__ s16x4 vtr(const LAS unsigned char* p) { return __builtin_bit_cast(s16x4, __builtin_amdgcn_ds_read_tr16_b64_v4i16((LAS s16x4*)p)); }
__device__ __forceinline__ bf16x8 fragP(const LAS unsigned char* M, int row, int k0, int hi) {
    const LAS unsigned char* p = M + row * PS + (k0 + 4 * hi) * 2; const s16x4 lo = *(const LAS s16x4*)p, h = *(const LAS s16x4*)(p + 16);
    return (bf16x8){lo[0], lo[1], lo[2], lo[3], h[0], h[1], h[2], h[3]}; }
__device__ __forceinline__ bf16x8 fragT(const LAS unsigned char* M, int k0, int colblk, int lane, int hi) {
    const LAS unsigned char* p = M + (colblk * 4 + (k0 >> 4)) * 1024 + ((lane >> 4) & 1) * 32 + (lane & 3) * 8 + (4 * hi + ((lane & 15) >> 2)) * 64;
    const s16x4 lo = vtr(p), h = vtr(p + 512); return (bf16x8){lo[0], lo[1], lo[2], lo[3], h[0], h[1], h[2], h[3]}; }
__device__ __forceinline__ bf16x8 packR(const f32x16& x, int s) {
    u32x4 w; w.x = pk2(x[8 * s], x[8 * s + 1]); w.y = pk2(x[8 * s + 2], x[8 * s + 3]); w.z = pk2(x[8 * s + 4], x[8 * s + 5]); w.w = pk2(x[8 * s + 6], x[8 * s + 7]); return __builtin_bit_cast(bf16x8, w); }
#define CK_MFMA(a, b, c) __builtin_amdgcn_mfma_f32_32x32x16_bf16(a, b, c, 0, 0, 0)
__device__ __forceinline__ f32x16 score(const LAS unsigned char* Am, const LAS unsigned char* Bm, int sblk, int tblk, int mode, int r32, int hi) {
    f32x16 x = f32x16{};
#pragma unroll
    for (int ks = 0; ks < 4; ++ks) x = CK_MFMA(fragP(Am, sblk * 32 + r32, 16 * ks, hi), fragP(Bm, tblk * 32 + r32, 16 * ks, hi), x);
    if (mode) {
        const int t = tblk * 32 + r32;
#pragma unroll
        for (int r = 0; r < 16; ++r) { const int s = sblk * 32 + crow(r, hi); if (mode == 1 ? !(s < t) : !(s <= t)) x[r] = 0.f; }
    }
    return x;
}
__device__ __forceinline__ void storeT_V(LAS unsigned char* M, const f32x16& x, int rb, int c, int hi) {
#pragma unroll
    for (int q = 0; q < 4; ++q) { u32x2 w; w.x = pk2(x[4 * q], x[4 * q + 1]); w.y = pk2(x[4 * q + 2], x[4 * q + 3]); *(LAS u32x2*)(M + voff(c, rb * 32 + 8 * q + 4 * hi)) = w; }
}
__device__ __forceinline__ void storeT_S(LAS unsigned char* M, const f32x16& x, int rb, int c, int hi) {
#pragma unroll
    for (int q = 0; q < 4; ++q) { u32x2 w; w.x = pk2(x[4 * q], x[4 * q + 1]); w.y = pk2(x[4 * q + 2], x[4 * q + 3]); *(LAS u32x2*)(M + c * PS + (rb * 32 + 8 * q + 4 * hi) * 2) = w; }
}

__device__ __forceinline__ void chunk_item(LAS unsigned char* lds, const Args& a, int item) {
    int tid = threadIdx.x; asm volatile("" : "+v"(tid)); int lane = tid & 63; const int wave = __builtin_amdgcn_readfirstlane(tid >> 6);
#define CK_FRESH() asm volatile("" : "+v"(lane)); r32 = lane & 31; hi = lane >> 5
    int r32, hi; CK_FRESH();
    unsigned char* ws = a.ws;
    const bf16_t* SR = (const bf16_t*)(ws + WS_SR); const bf16_t* SK = (const bf16_t*)(ws + WS_SK); const bf16_t* SV = (const bf16_t*)(ws + WS_SV);
    const bf16_t* SA = (const bf16_t*)(ws + WS_SA); const bf16_t* SB = (const bf16_t*)(ws + WS_SB); const float* SW = (const float*)(ws + WS_SW);
    bf16_t* CG = (bf16_t*)(ws + WS_CG) + (size_t)item * 4096; bf16_t* CH = (bf16_t*)(ws + WS_CH) + (size_t)item * 4096;
    bf16_t* CR2 = (bf16_t*)(ws + WS_CR2) + (size_t)item * 4096; bf16_t* CY0 = (bf16_t*)(ws + WS_CY0) + (size_t)item * 4096;
    const int bh = item >> 6, c = item & 63, b = bh >> 3, h = bh & 7, tokc = b * SEQ + c * 64, col0 = h * 64;
    LAS unsigned char* BT = lds + O_BT; LAS unsigned char* KT = lds + O_KT; LAS unsigned char* AP = lds + O_AP; LAS unsigned char* RT = lds + O_RT;
    LAS unsigned char* AT = lds + O_AT; LAS unsigned char* BH = lds + O_BH; LAS unsigned char* KH = lds + O_KH; LAS unsigned char* VV = lds + O_VV;
    LAS unsigned char* TN = lds + O_TN; LAS unsigned char* A2M = lds + O_A2; LAS unsigned char* V2M = lds + O_V2;
    LAS float* L = (LAS float*)(lds + O_L); LAS float* TOT = (LAS float*)(lds + O_TOT); LAS float* GC = (LAS float*)(lds + O_GC);
    {
        const int tl = tid >> 3, c8 = (tid & 7) * 8, cr = col0 + c8, t = tokc + tl;
        const bf16_t* P = (const bf16_t*)(ws + WS_P); const bf16_t* pr = P + (size_t)t * NINP + cr;
        bf16_t* SVo = (bf16_t*)(ws + WS_SV); bf16_t* SGo = (bf16_t*)(ws + WS_SG); bf16_t* QN = (bf16_t*)(ws + WS_QN); bf16_t* KN = (bf16_t*)(ws + WS_KN);
        const float* mu = a.in[3];
        const bool first = (t & (SEQ - 1)) == 0; const u32x4 zz = (u32x4){0u, 0u, 0u, 0u};
#define CK_PK8(v) ((u32x4){pk2(v[0], v[1]), pk2(v[2], v[3]), pk2(v[4], v[5]), pk2(v[6], v[7])})
#define CK_ST_P(M, val_) do { LAS unsigned char* d_ = (M) + tl * PS + c8 * 2; const u32x4 q_ = (val_); *(LAS u32x2*)d_ = (u32x2){q_[0], q_[1]}; *(LAS u32x2*)(d_ + 8) = (u32x2){q_[2], q_[3]}; } while (0)
        float g[8], gp[8], ig[8], gC[8];
        {
            const u32x4 deu = *(const LAS u32x4*)(TN + tl * 128 + c8 * 2); const f32x4 de0 = cvlo(deu), de1 = cvhi(deu);
            float wv[8] = {__builtin_amdgcn_exp2f(de0.x), __builtin_amdgcn_exp2f(de0.y), __builtin_amdgcn_exp2f(de0.z), __builtin_amdgcn_exp2f(de0.w), __builtin_amdgcn_exp2f(de1.x), __builtin_amdgcn_exp2f(de1.y), __builtin_amdgcn_exp2f(de1.z), __builtin_amdgcn_exp2f(de1.w)};
            float p[8];
#pragma unroll
            for (int j = 0; j < 8; ++j) p[j] = wv[j];
#pragma unroll
            for (int d = 8; d < 64; d <<= 1) {
#pragma unroll
                for (int j = 0; j < 8; ++j) { const float q = __shfl_up(p[j], d); if (lane >= d) p[j] *= q; }
            }
            if ((lane >> 3) == 7) { *(LAS f32x4*)(TOT + wave * 64 + c8) = (f32x4){p[0], p[1], p[2], p[3]}; *(LAS f32x4*)(TOT + wave * 64 + c8 + 4) = (f32x4){p[4], p[5], p[6], p[7]}; }
            __syncthreads();
            float pre[8];
#pragma unroll
            for (int j = 0; j < 8; ++j) { pre[j] = 1.f; gC[j] = 1.f; }
#pragma unroll
            for (int w2 = 0; w2 < 8; ++w2) { const f32x4 t0 = *(const LAS f32x4*)(TOT + w2 * 64 + c8), t1 = *(const LAS f32x4*)(TOT + w2 * 64 + c8 + 4);
                const float tv[8] = {t0.x, t0.y, t0.z, t0.w, t1.x, t1.y, t1.z, t1.w};
#pragma unroll
                for (int j = 0; j < 8; ++j) { if (w2 < wave) pre[j] *= tv[j]; gC[j] *= tv[j]; } }
            if (tid < 8) { *(LAS f32x4*)(GC + c8) = (f32x4){gC[0], gC[1], gC[2], gC[3]}; *(LAS f32x4*)(GC + c8 + 4) = (f32x4){gC[4], gC[5], gC[6], gC[7]}; }
#pragma unroll
            for (int j = 0; j < 8; ++j) { g[j] = pre[j] * p[j]; ig[j] = __builtin_amdgcn_rcpf(g[j]); gp[j] = g[j] * __builtin_amdgcn_rcpf(wv[j]); }
        }
        f32x4 r0, r1;
        { const u32x4 cu = *(const u32x4*)(pr), pu = first ? zz : *(const u32x4*)(pr - NINP);
          const f32x4 m0 = *(const f32x4*)(mu + cr), m1 = *(const f32x4*)(mu + cr + 4); const f32x4 c0 = cvlo(cu), c1 = cvhi(cu), p0 = cvlo(pu), p1 = cvhi(pu);
          r0 = c0 + (p0 - c0) * m0; r1 = c1 + (p1 - c1) * m1;
          const float rt[8] = {r0.x * g[0], r0.y * g[1], r0.z * g[2], r0.w * g[3], r1.x * g[4], r1.y * g[5], r1.z * g[6], r1.w * g[7]};
          CK_ST_P(RT, CK_PK8(rt)); }
        { const u32x4 cu = *(const u32x4*)(pr + 1024), pu = first ? zz : *(const u32x4*)(pr - NINP + 1024);
          const f32x4 m0 = *(const f32x4*)(mu + 1024 + cr), m1 = *(const f32x4*)(mu + 1024 + cr + 4); const f32x4 c0 = cvlo(cu), c1 = cvhi(cu), p0 = cvlo(pu), p1 = cvhi(pu);
          const u32x4 uv = pk8(c0 + (p0 - c0) * m0, c1 + (p1 - c1) * m1); *(u32x4*)(SVo + (size_t)t * CW + cr) = uv; *(LAS u32x4*)(VV + voff(tl, c8)) = uv; }
        *(u32x4*)(SGo + (size_t)t * CW + cr) = *(const LAS u32x4*)(V2M + tl * 128 + c8 * 2);
        { const u32x4 cu = *(const u32x4*)(pr + 512), pu = first ? zz : *(const u32x4*)(pr - NINP + 512);
          const f32x4 m0 = *(const f32x4*)(mu + 512 + cr), m1 = *(const f32x4*)(mu + 512 + cr + 4); const f32x4 c0 = cvlo(cu), c1 = cvhi(cu), p0 = cvlo(pu), p1 = cvhi(pu);
          const f32x4 k0 = c0 + (p0 - c0) * m0, k1 = c1 + (p1 - c1) * m1;
          const u32x4 alu = *(const LAS u32x4*)(A2M + tl * 128 + c8 * 2); const f32x4 al0 = cvlo(alu), al1 = cvhi(alu);
          const f32x4 kk0 = k0 * *(const f32x4*)(a.in[9] + cr), kk1 = k1 * *(const f32x4*)(a.in[9] + cr + 4);
          const float ss = red8((kk0.x * kk0.x + kk0.y * kk0.y) + (kk0.z * kk0.z + kk0.w * kk0.w) + (kk1.x * kk1.x + kk1.y * kk1.y) + (kk1.z * kk1.z + kk1.w * kk1.w));
          const float inv = 1.0f / sqrtf(fmaxf(ss, 1e-24f));
          const f32x4 kn0 = kk0 * inv, kn1 = kk1 * inv;
          const f32x4 k20 = k0 * (1.0f + (al0 - 1.0f) * *(const f32x4*)(a.in[10] + cr)), k21 = k1 * (1.0f + (al1 - 1.0f) * *(const f32x4*)(a.in[10] + cr + 4));
          { const f32x4 q0 = r0 * k20 * *(const f32x4*)(a.in[11] + cr), q1 = r1 * k21 * *(const f32x4*)(a.in[11] + cr + 4);
            const float rk = red8((q0.x + q0.y) + (q0.z + q0.w) + (q1.x + q1.y) + (q1.z + q1.w));
            if ((lane & 7) == 0) ((float*)(ws + WS_RK))[(size_t)t * 8 + h] = rk; }
          const float kv[8] = {k20.x, k20.y, k20.z, k20.w, k21.x, k21.y, k21.z, k21.w}, nv[8] = {kn0.x, kn0.y, kn0.z, kn0.w, kn1.x, kn1.y, kn1.z, kn1.w}, av_[8] = {al0.x, al0.y, al0.z, al0.w, al1.x, al1.y, al1.z, al1.w};
          float at[8], bt[8], kt[8], bh[8], kh[8];
#pragma unroll
          for (int j = 0; j < 8; ++j) { at[j] = -nv[j] * gp[j]; bt[j] = nv[j] * av_[j] * ig[j]; kt[j] = kv[j] * ig[j]; bh[j] = bt[j] * gC[j]; kh[j] = kt[j] * gC[j]; }
          const u32x4 wa = CK_PK8(at);
          CK_ST_P(AP, wa); *(LAS u32x4*)(AT + voff(tl, c8)) = wa;
          CK_ST_P(BT, CK_PK8(bt)); CK_ST_P(KT, CK_PK8(kt));
          *(LAS u32x4*)(BH + voff(tl, c8)) = CK_PK8(bh); *(LAS u32x4*)(KH + voff(tl, c8)) = CK_PK8(kh); }
        { const u32x4 uq = *(const u32x4*)(pr + DQ0), ukd = *(const u32x4*)(pr + DK0);
          const f32x4 q0 = cvlo(uq), q1 = cvhi(uq), d0 = cvlo(ukd), d1 = cvhi(ukd);
          const float qs = red8((q0.x * q0.x + q0.y * q0.y) + (q0.z * q0.z + q0.w * q0.w) + (q1.x * q1.x + q1.y * q1.y) + (q1.z * q1.z + q1.w * q1.w));
          const float ks = red8((d0.x * d0.x + d0.y * d0.y) + (d0.z * d0.z + d0.w * d0.w) + (d1.x * d1.x + d1.y * d1.y) + (d1.z * d1.z + d1.w * d1.w));
          const float qi = (1.0f / sqrtf(qs * (1.0f / 64.0f) + 1e-5f)) * (0.125f * LOG2E), ki = 1.0f / sqrtf(ks * (1.0f / 64.0f) + 1e-5f);
          const f32x4 g0 = *(const f32x4*)(a.in[14] + c8), g1 = *(const f32x4*)(a.in[14] + c8 + 4), h0 = *(const f32x4*)(a.in[15] + c8), h1 = *(const f32x4*)(a.in[15] + c8 + 4);
          *(u32x4*)(QN + (size_t)t * CW + cr) = pk8(q0 * qi * g0, q1 * qi * g1);
          const size_t ko = ((((size_t)(b * 8 + h) * 64 + c) * 8 + (c8 >> 3)) * 64 + tl) * 8;
          *(u32x4*)(KN + ko) = pk8(d0 * ki * h0, d1 * ki * h1); }
#undef CK_PK8
#undef CK_ST_P
    }
    __syncthreads();
    CK_FRESH();
    f32x16 pa = f32x16{}, pb = f32x16{}, pc = f32x16{}, pd = f32x16{};
#define w1a pa
#define w1b pb
#define xb0 pa
#define xb1 pb
#define y0a pc
#define y0b pd
    if (wave < 2) {
        for (int k = 0; k < (wave == 0 ? 2 : 1); ++k) {
            const int sblk = wave == 0 ? k : 0, tblk = wave == 0 ? k : 1;
            const f32x16 x = score(BT, AP, sblk, tblk, wave == 0 ? 1 : 0, r32, hi);
            const int t = tblk * 32 + r32;
#pragma unroll
            for (int r = 0; r < 16; ++r) L[(sblk * 32 + crow(r, hi)) * LSTR + t] = x[r];
        }
    }
    __syncthreads();
    CK_FRESH();
    if (wave == 6) {
        float x[32];
#pragma unroll
        for (int t = 0; t < 32; ++t) x[t] = (r32 == t) ? 1.f : 0.f;
        const LAS float* Nr = L + (32 * hi) * LSTR + 32 * hi;
#pragma unroll
        for (int sidx = 0; sidx < 31; ++sidx) {
#pragma unroll
            for (int g4 = (sidx + 1) / 4; g4 < 8; ++g4) {
                const f32x4 nv = *(const LAS f32x4*)(Nr + sidx * LSTR + 4 * g4);
                if (4 * g4 + 0 > sidx) x[4 * g4 + 0] += nv.x * x[sidx];
                if (4 * g4 + 1 > sidx) x[4 * g4 + 1] += nv.y * x[sidx];
                if (4 * g4 + 2 > sidx) x[4 * g4 + 2] += nv.z * x[sidx];
                if (4 * g4 + 3 > sidx) x[4 * g4 + 3] += nv.w * x[sidx];
            }
            if ((sidx & 3) == 3) __builtin_amdgcn_sched_barrier(0);
        }
        const int cc = 32 * hi + r32;
#pragma unroll
        for (int t0 = 0; t0 < 32; t0 += 8) { u32x4 w; w.x = pk2(x[t0], x[t0 + 1]); w.y = pk2(x[t0 + 2], x[t0 + 3]); w.z = pk2(x[t0 + 4], x[t0 + 5]); w.w = pk2(x[t0 + 6], x[t0 + 7]);
            *(LAS u32x4*)(TN + voff(cc, 32 * hi + t0)) = w; }
        f32x16 m = f32x16{};
#pragma unroll
        for (int s = 0; s < 2; ++s) {
            const LAS float* lp = L + (16 * s + 4 * hi) * LSTR + 32 + r32;
            u32x4 aw; aw.x = pk2(lp[0], lp[LSTR]); aw.y = pk2(lp[2 * LSTR], lp[3 * LSTR]); aw.z = pk2(lp[8 * LSTR], lp[9 * LSTR]); aw.w = pk2(lp[10 * LSTR], lp[11 * LSTR]);
            const s16x4 b0 = *(const LAS s16x4*)(TN + voff(r32, 16 * s + 4 * hi)), b1 = *(const LAS s16x4*)(TN + voff(r32, 16 * s + 8 + 4 * hi));
            m = CK_MFMA(__builtin_bit_cast(bf16x8, aw), ((bf16x8){b0[0], b0[1], b0[2], b0[3], b1[0], b1[1], b1[2], b1[3]}), m);
        }
        f32x16 t21 = f32x16{};
#pragma unroll
        for (int s = 0; s < 2; ++s) t21 = CK_MFMA(fragT(TN, 32 + 16 * s, 1, lane, hi), packR(m, s), t21);
        storeT_V(TN, t21, 1, r32, hi);
    } else if (wave < 4) {
        const int dvb = wave - 2;
        const f32x16 x00 = score(KT, AP, 0, 0, 1, r32, hi), x01 = score(KT, AP, 0, 1, 0, r32, hi), x11 = score(KT, AP, 1, 1, 1, r32, hi);
#pragma unroll
        for (int s = 0; s < 2; ++s) {
            const bf16x8 v0 = fragT(VV, 16 * s, dvb, lane, hi), v1 = fragT(VV, 32 + 16 * s, dvb, lane, hi);
            w1a = CK_MFMA(packR(x00, s), v0, w1a);
            w1b = CK_MFMA(packR(x01, s), v0, w1b);
            w1b = CK_MFMA(packR(x11, s), v1, w1b);
        }
    } else if (wave < 6) {
        const int tb = wave - 4;
        f32x16 xk0, xk1 = f32x16{};
        if (tb == 0) { xk0 = score(KT, RT, 0, 0, 2, r32, hi); xb0 = score(BT, RT, 0, 0, 2, r32, hi); }
        else { xk0 = score(KT, RT, 0, 1, 0, r32, hi); xk1 = score(KT, RT, 1, 1, 2, r32, hi); xb0 = score(BT, RT, 0, 1, 0, r32, hi); xb1 = score(BT, RT, 1, 1, 2, r32, hi); }
#pragma unroll
        for (int s = 0; s < 2; ++s) {
            y0a = CK_MFMA(fragT(VV, 16 * s, 0, lane, hi), packR(xk0, s), y0a);
            y0b = CK_MFMA(fragT(VV, 16 * s, 1, lane, hi), packR(xk0, s), y0b);
            if (tb == 1) { y0a = CK_MFMA(fragT(VV, 32 + 16 * s, 0, lane, hi), packR(xk1, s), y0a); y0b = CK_MFMA(fragT(VV, 32 + 16 * s, 1, lane, hi), packR(xk1, s), y0b); }
        }
    }
    __syncthreads();
    CK_FRESH();
    if (wave < 2) {
        const int cb = wave; f32x16 a0 = f32x16{}, a1 = f32x16{};
#pragma unroll
        for (int ks = 0; ks < 4; ++ks) {
            const bf16x8 af = fragT(AT, 16 * ks, cb, lane, hi);
            if (ks < 2) a0 = CK_MFMA(af, fragT(TN, 16 * ks, 0, lane, hi), a0);
            a1 = CK_MFMA(af, fragT(TN, 16 * ks, 1, lane, hi), a1);
        }
        storeT_V(A2M, a0, cb, r32, hi); storeT_V(A2M, a1, cb, 32 + r32, hi);
    } else if (wave < 4) {
        const int dvb = wave - 2; f32x16 v0 = f32x16{}, v1 = f32x16{};
#pragma unroll
        for (int s = 0; s < 2; ++s) {
            v0 = CK_MFMA(packR(w1a, s), fragT(TN, 16 * s, 0, lane, hi), v0);
            v1 = CK_MFMA(packR(w1a, s), fragT(TN, 16 * s, 1, lane, hi), v1);
            v1 = CK_MFMA(packR(w1b, s), fragT(TN, 32 + 16 * s, 1, lane, hi), v1);
        }
        storeT_V(V2M, v0, dvb, r32, hi); storeT_V(V2M, v1, dvb, 32 + r32, hi);
    }
    __syncthreads();
    CK_FRESH();
    if (wave >= 4 && wave < 6) {
        const int tb = wave - 4, t = tb * 32 + r32;
        f32x16 r0 = f32x16{}, r1 = f32x16{};
#pragma unroll
        for (int s = 0; s < 2; ++s) {
            const bf16x8 p0 = packR(xb0, s);
            r0 = CK_MFMA(fragT(A2M, 16 * s, 0, lane, hi), p0, r0); r1 = CK_MFMA(fragT(A2M, 16 * s, 1, lane, hi), p0, r1);
            y0a = CK_MFMA(fragT(V2M, 16 * s, 0, lane, hi), p0, y0a); y0b = CK_MFMA(fragT(V2M, 16 * s, 1, lane, hi), p0, y0b);
            if (tb == 1) { const bf16x8 p1 = packR(xb1, s);
                r0 = CK_MFMA(fragT(A2M, 32 + 16 * s, 0, lane, hi), p1, r0); r1 = CK_MFMA(fragT(A2M, 32 + 16 * s, 1, lane, hi), p1, r1);
                y0a = CK_MFMA(fragT(V2M, 32 + 16 * s, 0, lane, hi), p1, y0a); y0b = CK_MFMA(fragT(V2M, 32 + 16 * s, 1, lane, hi), p1, y0b); }
        }
#pragma unroll
        for (int q = 0; q < 4; ++q) {
            const u32x2 u0 = *(const LAS u32x2*)(RT + t * PS + (8 * q + 4 * hi) * 2), u1 = *(const LAS u32x2*)(RT + t * PS + (32 + 8 * q + 4 * hi) * 2);
            r0[4 * q] += bflo(u0.x); r0[4 * q + 1] += bfhi(u0.x); r0[4 * q + 2] += bflo(u0.y); r0[4 * q + 3] += bfhi(u0.y);
            r1[4 * q] += bflo(u1.x); r1[4 * q + 1] += bfhi(u1.x); r1[4 * q + 2] += bflo(u1.y); r1[4 * q + 3] += bfhi(u1.y);
        }
        storeT_S(BT, r0, 0, t, hi); storeT_S(BT, r1, 1, t, hi);
        storeT_S(KT, y0a, 0, t, hi); storeT_S(KT, y0b, 1, t, hi);
    } else if (wave < 2) {
        const int ib = wave, i = ib * 32 + r32; const float gci = GC[i];
        f32x16 g0 = f32x16{}, g1 = f32x16{};
#pragma unroll
        for (int ks = 0; ks < 4; ++ks) { const bf16x8 bf_ = fragT(BH, 16 * ks, ib, lane, hi);
            g0 = CK_MFMA(fragT(A2M, 16 * ks, 0, lane, hi), bf_, g0); g1 = CK_MFMA(fragT(A2M, 16 * ks, 1, lane, hi), bf_, g1); }
#pragma unroll
        for (int r = 0; r < 16; ++r) { if (crow(r, hi) == i) g0[r] += gci; if (32 + crow(r, hi) == i) g1[r] += gci; }
        storeT_S(AP, g0, 0, i, hi); storeT_S(AP, g1, 1, i, hi);
    } else {
        const int id = wave < 4 ? wave - 2 : wave - 4, ib = id >> 1, dvb = id & 1;
        f32x16 hh = f32x16{};
#pragma unroll
        for (int ks = 0; ks < 4; ++ks) {
            hh = CK_MFMA(fragT(BH, 16 * ks, ib, lane, hi), fragT(V2M, 16 * ks, dvb, lane, hi), hh);
            hh = CK_MFMA(fragT(KH, 16 * ks, ib, lane, hi), fragT(VV, 16 * ks, dvb, lane, hi), hh);
        }
        storeT_S((LAS unsigned char*)L, hh, ib, dvb * 32 + r32, hi);
    }
    __syncthreads();
    {
        asm volatile("" : "+v"(tid));
        const int row = tid >> 3, ch = tid & 7;
        const LAS unsigned char* s0 = BT + row * PS + ch * 16; const LAS unsigned char* s1 = KT + row * PS + ch * 16; const LAS unsigned char* s2 = AP + row * PS + ch * 16; const LAS unsigned char* s3 = (const LAS unsigned char*)L + row * PS + ch * 16;
        const u32x2 a0 = *(const LAS u32x2*)s0, a1 = *(const LAS u32x2*)(s0 + 8), b0 = *(const LAS u32x2*)s1, b1 = *(const LAS u32x2*)(s1 + 8);
        const u32x2 c0 = *(const LAS u32x2*)s2, c1 = *(const LAS u32x2*)(s2 + 8), d0 = *(const LAS u32x2*)s3, d1 = *(const LAS u32x2*)(s3 + 8);
        *(u32x4*)(CR2 + row * 64 + ch * 8) = (u32x4){a0.x, a0.y, a1.x, a1.y}; *(u32x4*)(CY0 + row * 64 + ch * 8) = (u32x4){b0.x, b0.y, b1.x, b1.y};
        *(u32x4*)(CG + row * 64 + ch * 8) = (u32x4){c0.x, c0.y, c1.x, c1.y}; *(u32x4*)(CH + row * 64 + ch * 8) = (u32x4){d0.x, d0.y, d1.x, d1.y};
    }
    asm volatile("s_waitcnt lgkmcnt(0)" ::: "memory"); __builtin_amdgcn_s_barrier();
#undef CK_FRESH
#undef w1a
#undef w1b
#undef xb0
#undef xb1
#undef y0a
#undef y0b
}

__device__ __forceinline__ void fused_item(LAS unsigned char* lds, const Args& a, int bc) {
    const int tid = threadIdx.x, lane = tid & 63; const int wave = __builtin_amdgcn_readfirstlane(tid >> 6);
    unsigned char* ws = a.ws;
    const bf16_t* P = (const bf16_t*)(ws + WS_P); const bf16_t* LW = (const bf16_t*)(ws + WS_LW); const float* mu = a.in[3];
    const int b = bc >> 6, c = bc & 63, tokc = b * SEQ + c * 64;
    LAS unsigned char* ACT = lds + O_ACT; LAS unsigned char* DECb = lds + O_TN; LAS unsigned char* ALRb = lds + O_A2; LAS unsigned char* GGb = lds + O_V2;
    for (int it = tid; it < 1280; it += 512) {
        const int tok = it / 20, ch = it - tok * 20, t = tokc + tok, col = 1536 + ch * 8;
        const u32x4 cu = *(const u32x4*)(P + (size_t)t * NINP + col);
        u32x4 pu = (u32x4){0u, 0u, 0u, 0u};
        if (t & (SEQ - 1)) pu = *(const u32x4*)(P + (size_t)(t - 1) * NINP + col);
        const f32x4 m0 = *(const f32x4*)(mu + col), m1 = *(const f32x4*)(mu + col + 4);
        const f32x4 c0 = cvlo(cu), c1 = cvhi(cu), p0 = cvlo(pu), p1 = cvhi(pu);
        f32x4 s0 = c0 + (p0 - c0) * m0, s1 = c1 + (p1 - c1) * m1;
        if (ch < 4) {
#pragma unroll
            for (int i = 0; i < 4; ++i) { const float e0 = __expf(-2.0f * fabsf(s0[i])), e1 = __expf(-2.0f * fabsf(s1[i])); const float th0 = (1.0f - e0) / (1.0f + e0), th1 = (1.0f - e1) / (1.0f + e1);
                s0[i] = s0[i] < 0.f ? -th0 : th0; s1[i] = s1[i] < 0.f ? -th1 : th1; }
        } else if (ch >= 8) {
#pragma unroll
            for (int i = 0; i < 4; ++i) { s0[i] = sigmoidf_(s0[i]); s1[i] = sigmoidf_(s1[i]); }
        }
        *(LAS u32x4*)(ACT + tok * 320 + ch * 16) = pk8(s0, s1);
    }
    __syncthreads();
#pragma clang loop unroll(disable)
    for (int h = 0; h < 8; ++h) {
        {
            int ln = lane; asm volatile("" : "+v"(ln));
            const int mt = wave >> 1, fcol = ln & 15, fq = ln >> 4;
            bf16x8 af[5];
#pragma unroll
            for (int kb = 0; kb < 5; ++kb) af[kb] = *(const LAS bf16x8*)(ACT + (mt * 16 + fcol) * 320 + kb * 64 + fq * 16);
#pragma unroll
            for (int cbi = 0; cbi < 2; ++cbi) {
                const int cb = (wave & 1) * 2 + cbi, col = h * 64 + cb * 16 + fcol;
                const bf16_t* lw = LW + (size_t)col * 160 + fq * 8;
                const f32x4 z = {0.f, 0.f, 0.f, 0.f};
                const f32x4 aw = __builtin_amdgcn_mfma_f32_16x16x32_bf16(af[0], *(const bf16x8*)(lw), z, 0, 0, 0);
                const f32x4 aa = __builtin_amdgcn_mfma_f32_16x16x32_bf16(af[1], *(const bf16x8*)(lw + 32), z, 0, 0, 0);
                f32x4 ag = __builtin_amdgcn_mfma_f32_16x16x32_bf16(af[2], *(const bf16x8*)(lw + 64), z, 0, 0, 0);
                ag = __builtin_amdgcn_mfma_f32_16x16x32_bf16(af[3], *(const bf16x8*)(lw + 96), ag, 0, 0, 0);
                ag = __builtin_amdgcn_mfma_f32_16x16x32_bf16(af[4], *(const bf16x8*)(lw + 128), ag, 0, 0, 0);
                const float w0c = a.in[4][col], a0c = a.in[6][col];
#pragma unroll
                for (int i = 0; i < 4; ++i) { const int off = (mt * 16 + fq * 4 + i) * 128 + (cb * 16 + fcol) * 2;
                    *(LAS unsigned short*)(DECb + off) = (unsigned short)f2bf(-0.8750325887f * sigmoidf_(aw[i] + w0c));
                    *(LAS unsigned short*)(ALRb + off) = (unsigned short)f2bf(sigmoidf_(aa[i] + a0c));
                    *(LAS unsigned short*)(GGb + off) = (unsigned short)f2bf(ag[i]); }
            }
        }
        __syncthreads();
        chunk_item(lds, a, ((b * 8 + h) << 6) + c);
    }
}
}

namespace ck {
constexpr int SQ_MAT = 8704, SQ_BUF = 6 * SQ_MAT;
constexpr int SQ_OUT = 2 * SQ_BUF;
__device__ __forceinline__ bf16x8 lfrag(const LAS unsigned char* M, int row, int k0, int hi) { return fragP(M, row, k0, hi); }
__device__ __forceinline__ void linit(f32x16& x, const LAS unsigned char* M, int row, int cblk, int hi) {
#pragma unroll
    for (int q = 0; q < 4; ++q) { const u32x2 u = *(const LAS u32x2*)(M + row * PS + (cblk * 32 + 8 * q + 4 * hi) * 2); x[4 * q] = bflo(u.x); x[4 * q + 1] = bfhi(u.x); x[4 * q + 2] = bflo(u.y); x[4 * q + 3] = bfhi(u.y); }
}
__device__ __forceinline__ void seq_head(LAS unsigned char* lds, const Args& a, int bh) {
    const int tid = threadIdx.x, lane = tid & 63, r32 = lane & 31, hi = lane >> 5; const int wave = __builtin_amdgcn_readfirstlane(tid >> 6);
    unsigned char* ws = a.ws;
    const bf16_t* SV = (const bf16_t*)(ws + WS_SV); const bf16_t* SG = (const bf16_t*)(ws + WS_SG); const float* RK = (const float*)(ws + WS_RK); bf16_t* YMIX = (bf16_t*)(ws + WS_YMIX);
    const int b = bh >> 3, h = bh & 7, col0 = h * 64;
    const float* lng = a.in[12] + col0; const float* lnb = a.in[13] + col0;
    const int lw = wave - 2;
    const bf16_t* lsrc; int lpitch;
    { const size_t it0 = (size_t)bh * 64 * 4096; const size_t tk0 = (size_t)b * SEQ * CW + col0;
      lsrc = lw == 0 ? (const bf16_t*)(ws + WS_CG) + it0 : lw == 1 ? (const bf16_t*)(ws + WS_CH) + it0 : lw == 2 ? (const bf16_t*)(ws + WS_CR2) + it0 : lw == 3 ? (const bf16_t*)(ws + WS_CY0) + it0 : lw == 4 ? SV + tk0 : SG + tk0;
      lpitch = lw < 4 ? 64 : CW; }
#define SQ_LOAD(ch) do { const bf16_t* s_ = lsrc + (size_t)(ch) * 64 * lpitch; LAS unsigned char* bb_ = lds + ((ch) & 1) * SQ_BUF + lw * SQ_MAT; u32x4 v_[8]; \
        _Pragma("unroll") for (int i_ = 0; i_ < 8; ++i_) { const int q_ = lane + 64 * i_; v_[i_] = *(const u32x4*)(s_ + (size_t)(q_ >> 3) * lpitch + (q_ & 7) * 8); } \
        _Pragma("unroll") for (int i_ = 0; i_ < 8; ++i_) { const int q_ = lane + 64 * i_; LAS unsigned char* d_ = bb_ + (q_ >> 3) * PS + (q_ & 7) * 16; *(LAS u32x2*)d_ = (u32x2){v_[i_].x, v_[i_].y}; *(LAS u32x2*)(d_ + 8) = (u32x2){v_[i_].z, v_[i_].w}; } } while (0)
#define SQ_STORE(ch) do { const LAS unsigned char* ob_ = lds + SQ_OUT + ((ch) & 1) * SQ_MAT; const size_t t0_ = (size_t)b * SEQ + (ch) * 64; \
        for (int p_ = tid - 128; p_ < 512; p_ += 384) { const int row_ = p_ >> 3, c8_ = (p_ & 7) * 8; const LAS unsigned char* s_ = ob_ + row_ * PS + c8_ * 2; \
            const u32x2 lo_ = *(const LAS u32x2*)s_, hi_ = *(const LAS u32x2*)(s_ + 8); *(u32x4*)(YMIX + (t0_ + row_) * D + col0 + c8_) = (u32x4){lo_.x, lo_.y, hi_.x, hi_.y}; } } while (0)
    if (wave >= 2) SQ_LOAD(0);
    __syncthreads();
    f32x16 X00 = f32x16{}, X01 = f32x16{}, X10 = f32x16{}, X11 = f32x16{};
#pragma unroll 1
    for (int c = 0; c < 64; ++c) {
        if (wave >= 2) {
            if (c + 1 < 64) SQ_LOAD(c + 1);
            if (c > 0) SQ_STORE(c - 1);
        } else {
            const int tb = wave;
            const LAS unsigned char* bb = lds + (c & 1) * SQ_BUF;
            const LAS unsigned char* MG = bb; const LAS unsigned char* MH = bb + SQ_MAT; const LAS unsigned char* MR = bb + 2 * SQ_MAT; const LAS unsigned char* MY = bb + 3 * SQ_MAT;
            const LAS unsigned char* MV = bb + 4 * SQ_MAT; const LAS unsigned char* MGT = bb + 5 * SQ_MAT;
            LAS unsigned char* OB = lds + SQ_OUT + (c & 1) * SQ_MAT;
            const int tl = tb * 32 + r32; const size_t t = (size_t)b * SEQ + c * 64 + tl;
            const float rk = RK[t * 8 + h];
            f32x16 y0, y1; linit(y0, MY, tl, 0, hi); linit(y1, MY, tl, 1, hi);
#pragma unroll
            for (int s = 0; s < 2; ++s) {
                const bf16x8 rf0 = lfrag(MR, tl, 16 * s, hi), rf1 = lfrag(MR, tl, 32 + 16 * s, hi);
                y0 = CK_MFMA(packR(X00, s), rf0, y0); y0 = CK_MFMA(packR(X10, s), rf1, y0);
                y1 = CK_MFMA(packR(X01, s), rf0, y1); y1 = CK_MFMA(packR(X11, s), rf1, y1);
            }
#pragma unroll
            for (int db = 0; db < 2; ++db) {
                f32x16 Na, Nb; linit(Na, MH, db * 32 + r32, 0, hi); linit(Nb, MH, db * 32 + r32, 1, hi);
#pragma unroll
                for (int s = 0; s < 2; ++s) {
                    const bf16x8 g00 = lfrag(MG, r32, 16 * s, hi), g01 = lfrag(MG, r32, 32 + 16 * s, hi), g10 = lfrag(MG, 32 + r32, 16 * s, hi), g11 = lfrag(MG, 32 + r32, 32 + 16 * s, hi);
                    const bf16x8 p0 = packR(db ? X01 : X00, s), p1 = packR(db ? X11 : X10, s);
                    Na = CK_MFMA(g00, p0, Na); Na = CK_MFMA(g01, p1, Na);
                    Nb = CK_MFMA(g10, p0, Nb); Nb = CK_MFMA(g11, p1, Nb);
                }
                if (db == 0) { X00 = Na; X10 = Nb; } else { X01 = Na; X11 = Nb; }
            }
            float sm = 0.f;
#pragma unroll
            for (int r = 0; r < 16; ++r) sm += y0[r] + y1[r];
            sm += __shfl_xor(sm, 32);
            const float mean = sm * (1.0f / 64.0f);
            float sq = 0.f;
#pragma unroll
            for (int r = 0; r < 16; ++r) { const float d0 = y0[r] - mean, d1 = y1[r] - mean; sq += d0 * d0 + d1 * d1; }
            sq += __shfl_xor(sq, 32);
            const float rs = 1.0f / sqrtf(sq * (1.0f / 64.0f) + 64e-5f);
#pragma unroll
            for (int db = 0; db < 2; ++db)
#pragma unroll
                for (int q = 0; q < 4; ++q) {
                    const int dv = db * 32 + 8 * q + 4 * hi;
                    const f32x4 lg = *(const f32x4*)(lng + dv), lb = *(const f32x4*)(lnb + dv);
                    const u32x2 uv = *(const LAS u32x2*)(MV + tl * PS + dv * 2), ug = *(const LAS u32x2*)(MGT + tl * PS + dv * 2);
                    const f32x4 vv = {bflo(uv.x), bfhi(uv.x), bflo(uv.y), bfhi(uv.y)}, gg = {bflo(ug.x), bfhi(ug.x), bflo(ug.y), bfhi(ug.y)};
                    f32x4 yy; if (db == 0) yy = (f32x4){y0[4 * q], y0[4 * q + 1], y0[4 * q + 2], y0[4 * q + 3]}; else yy = (f32x4){y1[4 * q], y1[4 * q + 1], y1[4 * q + 2], y1[4 * q + 3]};
                    const f32x4 o = ((yy - mean) * rs * lg + lb + rk * vv) * gg;
                    u32x2 w; w.x = pk2(o.x, o.y); w.y = pk2(o.z, o.w);
                    *(LAS u32x2*)(OB + tl * PS + dv * 2) = w;
                }
        }
        __syncthreads();
    }
    if (wave >= 2) SQ_STORE(63);
#undef SQ_LOAD
#undef SQ_STORE
}
}

namespace att {
constexpr int SLOT = 32768, OFF_V = 16384;
constexpr int TBL_OFF = MISC_OFF + 1024;
constexpr int LW_OFF = MISC_OFF + 2048;
constexpr int CST_OFF = MISC_OFF + 3072;
__device__ __forceinline__ int crow(int r, int hi) { return (r & 3) + 8 * (r >> 2) + 4 * hi; }
__device__ __forceinline__ void glds16(const void* gsrc, unsigned lds_dst) { unsigned keep;
    asm volatile("s_mov_b32 %0, m0\n\ts_mov_b32 m0, %2\n\ts_nop 0\n\tglobal_load_lds_dwordx4 %1, off\n\ts_mov_b32 m0, %0" : "=&s"(keep) : "v"(gsrc), "s"(lds_dst) : "memory"); }
__device__ __forceinline__ s16x4 vtr(const LAS unsigned char* p) { return __builtin_bit_cast(s16x4, __builtin_amdgcn_ds_read_tr16_b64_v4i16((LAS s16x4*)p)); }

__device__ __forceinline__ void attn_unit(LAS unsigned char* lds, const Args& a, int b, int h, int qb, float negM, float lam) {
    const int tid = threadIdx.x, lane = tid & 63, r32 = lane & 31, hi = lane >> 5; const int wid = __builtin_amdgcn_readfirstlane(tid >> 6);
    const int c = wid >> 2, rg = wid & 3;
    unsigned char* ws = a.ws;
    const bf16_t* QN = (const bf16_t*)(ws + WS_QN); const bf16_t* KN = (const bf16_t*)(ws + WS_KN); const bf16_t* P = (const bf16_t*)(ws + WS_P); bf16_t* YMIX = (bf16_t*)(ws + WS_YMIX);
    const int q0 = qb * 128; const size_t rowbase = (size_t)b * SEQ;
    const int NT = 2 * qb + 2;
    LAS float* tbl = (LAS float*)(lds + TBL_OFF); LAS float* lw = (LAS float*)(lds + LW_OFF) + wid * 32;
    if (tid < 128) {
        const int n = tid; int bkt;
        if (n < 16) bkt = n; else { bkt = 16 + (int)(logf((float)n * (1.0f / 16.0f)) / 2.0794415416798357f * 16.0f); bkt = bkt > 31 ? 31 : bkt; }
        tbl[n] = (a.in[21][bkt * 4 + h] - a.in[21][31 * 4 + h]) * LOG2E;
    }
    const bf16_t* Qw = QN + (rowbase + q0 + rg * 32 + r32) * CW + h * 128 + c * 64;
    bf16x8 qr[4];
#pragma unroll
    for (int d0 = 0; d0 < 4; ++d0) qr[d0] = *(const bf16x8*)(Qw + d0 * 16 + hi * 8);
    const bf16_t* k0src = KN + ((((size_t)(b * 8 + h * 2) * 64) * 8 + wid) * 64 + lane) * 8;
    const bf16_t* k1src = k0src + (size_t)64 * 8 * 64 * 8;
    const int pv0 = 2 * wid, pv1 = 2 * wid + 1;
    const bf16_t* VTb = (const bf16_t*)(ws + WS_VT) + (size_t)(b * 4 + h) * 64 * 8192;
    const bf16_t* v0src = VTb + pv0 * 512 + lane * 8;
    const bf16_t* v1src = VTb + pv1 * 512 + lane * 8;
#define ATT_DMA(t, slot) do { const unsigned s_ = lds0 + (unsigned)(slot) * SLOT; \
        glds16(k0src + (size_t)(t) * 4096, (unsigned)__builtin_amdgcn_readfirstlane(s_ + wid * 1024)); \
        glds16(k1src + (size_t)(t) * 4096, (unsigned)__builtin_amdgcn_readfirstlane(s_ + 8192 + wid * 1024)); \
        glds16(v0src + (size_t)(t) * 8192, (unsigned)__builtin_amdgcn_readfirstlane(s_ + OFF_V + pv0 * 1024)); \
        glds16(v1src + (size_t)(t) * 8192, (unsigned)__builtin_amdgcn_readfirstlane(s_ + OFF_V + pv1 * 1024)); } while (0)
#define ATT_SBAR() __builtin_amdgcn_sched_barrier(0)
    const unsigned lds0 = (unsigned)(uintptr_t)lds;
    f32x16 o[4];
#pragma unroll
    for (int d0 = 0; d0 < 4; ++d0) o[d0] = f32x16{};
    float lsum = 0.f;
    const bool shift = negM < -60.0f;
    const int qmin = q0 + 32 * rg, qpos = qmin + r32;
    ATT_DMA(0, 0);
    asm volatile("s_waitcnt vmcnt(0)" ::: "memory");
    __syncthreads();
    for (int t = 0; t < NT; ++t) {
        if (t + 1 < NT) ATT_DMA(t + 1, (t + 1) & 1);
        const int kmin = 64 * t;
        if (kmin <= qmin + 31) {
            const LAS unsigned char* slot = lds + (t & 1) * SLOT;
            const LAS unsigned char* kb = slot + c * 8192 + hi * 1024 + r32 * 16;
            const LAS unsigned char* vb = slot + OFF_V + ((lane >> 4) & 1) * 32 + (lane & 3) * 8 + (4 * hi + ((lane & 15) >> 2)) * 64;
            bf16x8 kf[8];
#pragma unroll
            for (int d0 = 0; d0 < 4; ++d0) { kf[2 * d0] = *(const LAS bf16x8*)(kb + d0 * 2048); kf[2 * d0 + 1] = *(const LAS bf16x8*)(kb + d0 * 2048 + 512); }
            s16x4 va[16], vc[16];
#pragma unroll
            for (int i = 0; i < 8; ++i) { va[2 * i] = vtr(vb + (i >> 2) * 4096 + (i & 3) * 1024); va[2 * i + 1] = vtr(vb + (i >> 2) * 4096 + (i & 3) * 1024 + 512); }
            ATT_SBAR();
            f32x16 p0, p1;
            p0 = __builtin_amdgcn_mfma_f32_32x32x16_bf16(kf[0], qr[0], f32x16{}, 0, 0, 0); p1 = __builtin_amdgcn_mfma_f32_32x32x16_bf16(kf[1], qr[0], f32x16{}, 0, 0, 0);
#pragma unroll
            for (int d0 = 1; d0 < 4; ++d0) { p0 = __builtin_amdgcn_mfma_f32_32x32x16_bf16(kf[2 * d0], qr[d0], p0, 0, 0, 0); p1 = __builtin_amdgcn_mfma_f32_32x32x16_bf16(kf[2 * d0 + 1], qr[d0], p1, 0, 0, 0); }
            ATT_SBAR();
            if (qmin - (kmin + 63) < 113) {
#pragma unroll
                for (int r = 0; r < 16; ++r) {
                    const int d0_ = qpos - (kmin + crow(r, hi)); const int d1_ = d0_ - 32;
                    const float t0 = tbl[d0_ < 0 ? 0 : (d0_ > 127 ? 127 : d0_)], t1 = tbl[d1_ < 0 ? 0 : (d1_ > 127 ? 127 : d1_)];
                    p0[r] = d0_ < 0 ? -INFINITY : p0[r] + t0; p1[r] = d1_ < 0 ? -INFINITY : p1[r] + t1;
                }
            }
            if (shift) {
#pragma unroll
                for (int r = 0; r < 16; ++r) { p0[r] += negM; p1[r] += negM; }
            }
            float sacc = 0.f;
#pragma unroll
            for (int r = 0; r < 16; ++r) { p0[r] = __builtin_amdgcn_exp2f(p0[r]); p1[r] = __builtin_amdgcn_exp2f(p1[r]); sacc += p0[r] + p1[r]; }
            lsum += sacc;
            u32x4 pw[4];
#pragma unroll
            for (int i = 0; i < 4; ++i) { pw[0][i] = pk2(p0[2 * i], p0[2 * i + 1]); pw[1][i] = pk2(p0[8 + 2 * i], p0[8 + 2 * i + 1]); pw[2][i] = pk2(p1[2 * i], p1[2 * i + 1]); pw[3][i] = pk2(p1[8 + 2 * i], p1[8 + 2 * i + 1]); }
            ATT_SBAR();
#pragma unroll
            for (int i = 0; i < 8; ++i) { vc[2 * i] = vtr(vb + (2 + (i >> 2)) * 4096 + (i & 3) * 1024); vc[2 * i + 1] = vtr(vb + (2 + (i >> 2)) * 4096 + (i & 3) * 1024 + 512); }
#pragma unroll
            for (int i = 0; i < 8; ++i) {
                const bf16x8 vf = (bf16x8){va[2 * i][0], va[2 * i][1], va[2 * i][2], va[2 * i][3], va[2 * i + 1][0], va[2 * i + 1][1], va[2 * i + 1][2], va[2 * i + 1][3]};
                o[i >> 2] = __builtin_amdgcn_mfma_f32_32x32x16_bf16(__builtin_bit_cast(bf16x8, pw[i & 3]), vf, o[i >> 2], 0, 0, 0);
            }
#pragma unroll
            for (int i = 0; i < 8; ++i) {
                const bf16x8 vf = (bf16x8){vc[2 * i][0], vc[2 * i][1], vc[2 * i][2], vc[2 * i][3], vc[2 * i + 1][0], vc[2 * i + 1][1], vc[2 * i + 1][2], vc[2 * i + 1][3]};
                o[2 + (i >> 2)] = __builtin_amdgcn_mfma_f32_32x32x16_bf16(__builtin_bit_cast(bf16x8, pw[i & 3]), vf, o[2 + (i >> 2)], 0, 0, 0);
            }
        }
        asm volatile("s_waitcnt vmcnt(0)" ::: "memory");
        __syncthreads();
    }
#undef ATT_DMA
#undef ATT_SBAR
    lsum += __shfl_xor(lsum, 32);
    if (hi == 0) lw[r32] = 1.0f / lsum;
    asm volatile("s_waitcnt lgkmcnt(0)" ::: "memory");
    LAS float* stg = (LAS float*)(lds + wid * 16384);
#pragma unroll
    for (int r = 0; r < 16; ++r) { const int orow = crow(r, hi); const float il = lw[orow];
#pragma unroll
        for (int d0 = 0; d0 < 4; ++d0) stg[orow * 128 + d0 * 32 + r32] = o[d0][r] * il; }
    __syncthreads();
    {
        const int row = tid >> 2, part = tid & 3, rgp = row >> 5, rr = row & 31;
        const LAS float* s1 = (const LAS float*)(lds + rgp * 16384) + rr * 128 + part * 32;
        const LAS float* s2 = (const LAS float*)(lds + (4 + rgp) * 16384) + rr * 128 + part * 32;
        float dv[32]; float ss = 0.f;
#pragma unroll
        for (int i = 0; i < 8; ++i) { const f32x4 x1 = *(const LAS f32x4*)(s1 + 4 * i), x2 = *(const LAS f32x4*)(s2 + 4 * i);
#pragma unroll
            for (int j = 0; j < 4; ++j) { const float dd = x1[j] - lam * x2[j]; dv[4 * i + j] = dd; ss += dd * dd; } }
        ss = red4(ss);
        const float sc = (1.0f / sqrtf(ss * (1.0f / 128.0f) + 1e-5f)) * 0.8f;
        const float* sg = a.in[20] + part * 32;
        bf16_t* op = YMIX + (rowbase + q0 + row) * D + CW + h * 128 + part * 32;
#pragma unroll
        for (int i = 0; i < 4; ++i) { u32x4 w;
            w.x = pk2(dv[8 * i] * sc * sg[8 * i], dv[8 * i + 1] * sc * sg[8 * i + 1]); w.y = pk2(dv[8 * i + 2] * sc * sg[8 * i + 2], dv[8 * i + 3] * sc * sg[8 * i + 3]);
            w.z = pk2(dv[8 * i + 4] * sc * sg[8 * i + 4], dv[8 * i + 5] * sc * sg[8 * i + 5]); w.w = pk2(dv[8 * i + 6] * sc * sg[8 * i + 6], dv[8 * i + 7] * sc * sg[8 * i + 7]);
            *(u32x4*)(op + 8 * i) = w; }
    }
    __syncthreads();
}

__device__ __forceinline__ void attn_phase(LAS unsigned char* lds, const Args& a, unsigned* ctl) {
    const int tid = threadIdx.x;
    LAS float* cst = (LAS float*)(lds + CST_OFF);
    if (tid < 64) {
        const float gq = fabsf(a.in[14][tid]), gk = fabsf(a.in[15][tid]);
        float mq = gq, mk = gk;
#pragma unroll
        for (int o = 1; o < 64; o <<= 1) { mq = fmaxf(mq, __shfl_xor(mq, o)); mk = fmaxf(mk, __shfl_xor(mk, o)); }
        const float d1 = wave_sum(a.in[16][tid] * a.in[17][tid]), d2 = wave_sum(a.in[18][tid] * a.in[19][tid]);
        float mb = 0.f;
        if (tid < 32) { for (int hh = 0; hh < 4; ++hh) mb = fmaxf(mb, (a.in[21][tid * 4 + hh] - a.in[21][31 * 4 + hh]) * LOG2E); }
#pragma unroll
        for (int o = 1; o < 64; o <<= 1) mb = fmaxf(mb, __shfl_xor(mb, o));
        if (tid == 0) { cst[0] = -(8.0f * LOG2E * mq * mk * 1.02f + mb); cst[1] = __expf(d1) - __expf(d2) + 0.2f; }
    }
    __syncthreads();
    const float negM = cst[0], lam = cst[1];
    LAS int* ubox = (LAS int*)(lds + CST_OFF + 16);
    for (;;) {
        if (tid == 0) ubox[0] = (int)atomicAdd(ctl + CW_ATTQ, 1u);
        __syncthreads();
        const int u = ubox[0];
        __syncthreads();
        if (u >= 1024) break;
        const int qb = 31 - (u >> 5), bhh = u & 31;
        attn_unit(lds, a, bhh >> 2, bhh & 3, qb, negM, lam);
    }
}
}

__device__ __forceinline__ void p5_router(LAS unsigned char* lds, const Args& a, unsigned* ctl) {
    const int tid = threadIdx.x, lane = tid & 63, r32 = lane & 31, hi = lane >> 5; const int wave = __builtin_amdgcn_readfirstlane(tid >> 6);
    unsigned char* ws = a.ws;
    const bf16_t* x1 = (const bf16_t*)(ws + WS_X1B); const float* g2 = a.in[23]; const float* rw = a.in[24]; const float* rb = a.in[25];
    unsigned char* H2 = ws + WS_H2; int* EIDX = (int*)(ws + WS_EIDX); float* GATE = (float*)(ws + WS_GATE); int* POS = (int*)(ws + WS_POS);
    LAS unsigned char* WH = lds; LAS unsigned char* WL = lds + 65536;
    LAS int* cnt = (LAS int*)(lds + MISC_OFF + 1024);
    LAS int* basel = (LAS int*)(lds + MISC_OFF + 1024 + 128);
    LAS int* el = (LAS int*)(lds + MISC_OFF + 2048);
    LAS int* pl = (LAS int*)(lds + MISC_OFF + 4096);
    {
        const int e = tid & 31;
        for (int k = tid >> 5; k < 1024; k += 16) {
            const float v = rw[k * 32 + e] * g2[k]; const unsigned h = f2bf(v); const float vh = __builtin_bit_cast(float, h << 16); const unsigned l = f2bf(v - vh);
            const int off = e * 2048 + (((k >> 3) ^ (e & 15)) << 4) + (k & 7) * 2;
            *(LAS unsigned short*)(WH + off) = (unsigned short)h; *(LAS unsigned short*)(WL + off) = (unsigned short)l;
        }
    }
    if (tid < 32) cnt[tid] = 0;
    __syncthreads();
    const int TPB = T / (int)gridDim.x, tb0 = blockIdx.x * TPB;
    if (wave < 4) {
        const int tl = wave * 32 + r32, t = tb0 + tl;
        const bf16_t* xrow = x1 + (size_t)t * D + 8 * hi;
        const LAS unsigned char* wh = WH + r32 * 2048; const LAS unsigned char* wl = WL + r32 * 2048; const int sw = r32 & 15;
        f32x16 d = f32x16{}; float ssq = 0.f;
#pragma unroll 8
        for (int s = 0; s < 64; ++s) {
            const u32x4 xb = *(const u32x4*)(xrow + 16 * s);
            const int co = ((2 * s + hi) ^ sw) << 4;
            const bf16x8 ah = *(const LAS bf16x8*)(wh + co), al = *(const LAS bf16x8*)(wl + co);
            const bf16x8 bx = __builtin_bit_cast(bf16x8, xb);
            d = __builtin_amdgcn_mfma_f32_32x32x16_bf16(ah, bx, d, 0, 0, 0);
            d = __builtin_amdgcn_mfma_f32_32x32x16_bf16(al, bx, d, 0, 0, 0);
            const f32x4 x0 = cvlo(xb), x1v = cvhi(xb);
            ssq += (x0.x * x0.x + x0.y * x0.y) + (x0.z * x0.z + x0.w * x0.w) + (x1v.x * x1v.x + x1v.y * x1v.y) + (x1v.z * x1v.z + x1v.w * x1v.w);
        }
        ssq += __shfl_xor(ssq, 32);
        const float rstd = 1.0f / sqrtf(ssq * (1.0f / D) + 1e-5f);
        float lg[16];
#pragma unroll
        for (int r = 0; r < 16; ++r) lg[r] = d[r] * rstd + rb[8 * (r >> 2) + 4 * hi + (r & 3)];
        float tv[4]; int ti[4];
#pragma unroll
        for (int k = 0; k < 4; ++k) {
            float bv = -INFINITY; int bi = 0;
#pragma unroll
            for (int r = 0; r < 16; ++r) { const int e = 8 * (r >> 2) + 4 * hi + (r & 3); if (lg[r] > bv) { bv = lg[r]; bi = e; } }
            tv[k] = bv; ti[k] = bi;
#pragma unroll
            for (int r = 0; r < 16; ++r) { const int e = 8 * (r >> 2) + 4 * hi + (r & 3); if (e == bi) lg[r] = -INFINITY; }
        }
        float ov[4]; int oi[4];
#pragma unroll
        for (int k = 0; k < 4; ++k) { ov[k] = __shfl_xor(tv[k], 32); oi[k] = __shfl_xor(ti[k], 32); }
        float mv[4]; int mi[4];
        {
            int pa = 0, pb = 0;
#pragma unroll
            for (int k = 0; k < 4; ++k) {
                float ca = -INFINITY, cb = -INFINITY; int ia = 0, ib = 0;
#pragma unroll
                for (int q = 0; q < 4; ++q) { if (q == pa) { ca = tv[q]; ia = ti[q]; } if (q == pb) { cb = ov[q]; ib = oi[q]; } }
                const bool takeA = (ca > cb) || (ca == cb && ia < ib);
                mv[k] = takeA ? ca : cb; mi[k] = takeA ? ia : ib; pa += takeA ? 1 : 0; pb += takeA ? 0 : 1;
            }
        }
        const float e1 = __expf(mv[1] - mv[0]), e2 = __expf(mv[2] - mv[0]), e3 = __expf(mv[3] - mv[0]);
        const float inv = 1.0f / (1.0f + e1 + e2 + e3);
        if (hi == 0) {
            *(int4*)(EIDX + (size_t)t * 4) = make_int4(mi[0], mi[1], mi[2], mi[3]);
            *(float4*)(GATE + (size_t)t * 4) = make_float4(inv, e1 * inv, e2 * inv, e3 * inv);
#pragma unroll
            for (int k = 0; k < 4; ++k) { el[tl * 4 + k] = mi[k]; pl[tl * 4 + k] = atomicAdd((int*)(cnt + mi[k]), 1); }
        }
    } else {
        f32x4 gv[4];
#pragma unroll
        for (int j = 0; j < 4; ++j) gv[j] = *((const f32x4*)g2 + lane + 64 * j);
        for (int i = 0; i < 32; ++i) {
            const int t = tb0 + (wave - 4) * 32 + i;
            const u32x2* xr = (const u32x2*)(x1 + (size_t)t * D) + lane;
            f32x4 v[4]; float s = 0.f;
#pragma unroll
            for (int j = 0; j < 4; ++j) { const u32x2 xw = xr[64 * j]; v[j] = (f32x4){bflo(xw.x), bfhi(xw.x), bflo(xw.y), bfhi(xw.y)}; s += (v[j].x * v[j].x + v[j].y * v[j].y) + (v[j].z * v[j].z + v[j].w * v[j].w); }
            const float rstd = (1.0f / sqrtf(wave_sum(s) * (1.0f / D) + 1e-5f)) * F8_X_MUL;
            unsigned* o4 = (unsigned*)(H2 + (size_t)t * D) + lane;
#pragma unroll
            for (int j = 0; j < 4; ++j) { v[j] = v[j] * rstd * gv[j]; o4[64 * j] = pk4_fp8(v[j].x, v[j].y, v[j].z, v[j].w); }
        }
    }
    __syncthreads();
    if (tid < 32) basel[tid] = (int)atomicAdd(ctl + CW_CNT + tid, (unsigned)cnt[tid]);
    __syncthreads();
    for (int i = tid; i < TPB * 4; i += 512) POS[(size_t)tb0 * 4 + i] = pl[i] + basel[el[i]];
}

__device__ __forceinline__ void p6_dispatch(LAS unsigned char* lds, const Args& a, unsigned* ctl) {
    const int tid = threadIdx.x, lane = tid & 63, wave = __builtin_amdgcn_readfirstlane(tid >> 6);
    unsigned char* ws = a.ws;
    const int* EIDX = (const int*)(ws + WS_EIDX); const float* GATE = (const float*)(ws + WS_GATE); const int* POS = (const int*)(ws + WS_POS);
    int* DEST = (int*)(ws + WS_DEST); float* ROWGATE = (float*)(ws + WS_ROWGATE); int* TILEE = (int*)(ws + WS_TILEE); int* ROWTOK = (int*)(ws + WS_ROWTOK);
    LAS int* pstart = (LAS int*)(lds + MISC_OFF + 1024); LAS int* pcnt = pstart + 32;
    if (tid < NE) pcnt[tid] = (int)__hip_atomic_load(ctl + CW_CNT + tid, __ATOMIC_RELAXED, __HIP_MEMORY_SCOPE_AGENT);
    __syncthreads();
    if (tid == 0) {
        int acc = 0;
        for (int e = 0; e < NE; ++e) { pstart[e] = acc; acc += ((pcnt[e] + 255) >> 8) * 256; }
        if (blockIdx.x == 0) TILEE[1023] = acc >> 8;
    }
    __syncthreads();
    if (blockIdx.x == 0 && tid < NE) { const int nt = (pcnt[tid] + 255) >> 8, t0_ = pstart[tid] >> 8; for (int i = 0; i < nt; ++i) TILEE[t0_ + i] = tid; }
    if (blockIdx.x < NE) {
        const int e = blockIdx.x, cn = pcnt[e], pe = ((cn + 255) >> 8) * 256;
        for (int i = cn + tid; i < pe; i += 512) ROWTOK[pstart[e] + i] = 0;
    }
    const int TPB = T / (int)gridDim.x, tb0 = blockIdx.x * TPB;
    for (int pi = tb0 * 4 + tid; pi < (tb0 + TPB) * 4; pi += 512) {
        const int e = EIDX[pi], dest = pstart[e] + POS[pi];
        DEST[pi] = dest; ROWGATE[dest] = GATE[pi]; ROWTOK[dest] = pi >> 2;
    }
}

__device__ __forceinline__ void p9_combine(const Args& a, int G) {
    const int tid = threadIdx.x, lane = tid & 63, wave = __builtin_amdgcn_readfirstlane(tid >> 6);
    unsigned char* ws = a.ws;
    const unsigned char* YS = ws + WS_YS; const int* DEST = (const int*)(ws + WS_DEST);
    float* out = a.out;
    const int gw = blockIdx.x * 8 + wave, NGW = G * 8;
    for (int t = gw; t < T; t += NGW) {
        f32x4* xr = (f32x4*)(out + (size_t)t * D) + lane; const u32x2* xi = (const u32x2*)((const bf16_t*)(ws + WS_X1B) + (size_t)t * D) + lane;
        f32x4 v[4];
#pragma unroll
        for (int j = 0; j < 4; ++j) { const u32x2 xw = xi[64 * j]; v[j] = (f32x4){bflo(xw.x), bfhi(xw.x), bflo(xw.y), bfhi(xw.y)}; }
#pragma unroll
        for (int k = 0; k < 4; ++k) {
            const int dest = DEST[t * 4 + k];
            const unsigned* yr = (const unsigned*)(YS + (size_t)dest * D) + lane;
#pragma unroll
            for (int j = 0; j < 4; ++j) { const unsigned w = yr[64 * j];
                const f32x2 lo = __builtin_amdgcn_cvt_pk_f32_fp8((int)w, false), hi2 = __builtin_amdgcn_cvt_pk_f32_fp8((int)w, true);
                v[j].x += lo.x * (1.0f / F8_Y_MUL); v[j].y += lo.y * (1.0f / F8_Y_MUL); v[j].z += hi2.x * (1.0f / F8_Y_MUL); v[j].w += hi2.y * (1.0f / F8_Y_MUL); }
        }
        if (TIME_REGION >= 0) { const float sc_ = 1.0f + 4e-6f * (float)((const unsigned*)(ws + WS_CTL))[301];
#pragma unroll
            for (int j = 0; j < 4; ++j) v[j] = v[j] * sc_; }
#pragma unroll
        for (int j = 0; j < 4; ++j) xr[64 * j] = v[j];
    }
}

constexpr int NPHASE = 10;
__global__ void __launch_bounds__(512, 2) hymba_fwd(Args args) {
    extern __shared__ __attribute__((aligned(16))) unsigned char lds_raw[];
    LAS unsigned char* lds = (LAS unsigned char*)lds_raw;
    cg::grid_group grid = cg::this_grid();
    const int G = gridDim.x;
    unsigned char* ws = args.ws;
    unsigned* ctl = (unsigned*)(ws + WS_CTL);
    const int lo = args.ph_lo, hi = args.ph_hi;
#define IN(k) (lo <= (k) && (k) < hi)
#define NREP(k) ((REP_PHASE) == (k) ? 2 : 1)
#define TSTART(k) do { if ((TIME_REGION) == (k) && blockIdx.x == 0 && threadIdx.x == 0) ctl[300] = (unsigned)__builtin_amdgcn_s_memrealtime(); } while (0)
#define TEND(k) do { if ((TIME_REGION) == (k) && blockIdx.x == 0 && threadIdx.x == 0) ctl[301] = (unsigned)__builtin_amdgcn_s_memrealtime() - ctl[300]; } while (0)
#define SEAM(k) do { if (IN(k) && IN((k) + 1)) { if (args.ph_lo < 0) grid.sync(); xcd_barrier(xbar); } } while (0)
    const int* TILEE = (const int*)(ws + WS_TILEE);
    { volatile LAS unsigned* st = (volatile LAS unsigned*)(lds + LDS_BYTES - 64); if (threadIdx.x < 2) st[threadIdx.x] = 0u; }
    __syncthreads();
    const XcdBarrier xbar = xcd_barrier_post(ctl + CW_BAR, (volatile LAS unsigned*)(lds + LDS_BYTES - 64));

    if (IN(0)) { for (int rep = 0; rep < NREP(0); ++rep) p0_prologue(lds, args, G); } SEAM(0);
    if (IN(1)) {
        pg8::Gemm g{ws + WS_XN, ws + WS_WINT, 1024, 0, 0, nullptr};
        pg8::TileOrder S; S.init(T / 256, NINP / 256, G, (int)blockIdx.x, nullptr, 0, WGM_P1);
        pg8::EpiBf16 E{(bf16_t*)(ws + WS_P), NINP, (bf16_t*)(ws + WS_VT)};
        for (int rep = 0; rep < NREP(1); ++rep) pg8::gemm_phase<false, false>(lds, g, S, E);
    } SEAM(1);
    TSTART(2);
    if (IN(2)) {
        ck::fused_item(lds, args, (int)blockIdx.x * 2); ck::fused_item(lds, args, (int)blockIdx.x * 2 + 1);
    } SEAM(2);
    TSTART(3);
    if (IN(3)) {
        TSTART(30); for (int rep = 0; rep < NREP(30); ++rep) { if (blockIdx.x < 64) ck::seq_head(lds, args, (int)blockIdx.x); __syncthreads(); } TEND(30);
        for (int rep = 0; rep < NREP(31); ++rep) att::attn_phase(lds, args, ctl + 64 * rep);
    } SEAM(3); TEND(3);
    if (IN(4)) {
        pg8::Gemm g{ws + WS_YMIX, ws + WS_WOUT, 1024, 0, 0, nullptr};
        pg8::TileOrder S; S.init(T / 256, D / 256, G, (int)blockIdx.x, nullptr, 0, WGM_P4);
        pg8::EpiResBf16 E{args.in[0], (bf16_t*)(ws + WS_X1B), D};
        for (int rep = 0; rep < NREP(4); ++rep) pg8::gemm_phase<false, false>(lds, g, S, E);
    } SEAM(4);
    if (IN(5)) { _Pragma("clang loop unroll(disable)") for (int rep = 0; rep < NREP(5); ++rep) { p5_router(lds, args, ctl + 256 * (NREP(5) - 1 - rep)); __syncthreads(); } } SEAM(5);
    if (IN(6)) { for (int rep = 0; rep < NREP(6); ++rep) { p6_dispatch(lds, args, ctl); __syncthreads(); } } SEAM(6);
    if (IN(7)) {
        const int ntile = TILEE[1023];
        pg8::Gemm g{ws + WS_H2, ws + WS_W1T, 1024, F8_W_SC, F8_X_SC, (const int*)(ws + WS_ROWTOK)};
        pg8::TileOrder S; S.init(ntile, 8, G, (int)blockIdx.x, TILEE, 8, WGM_P7);
        pg8::EpiSwiglu E{ws + WS_HID, args.in[27], TILEE};
        for (int rep = 0; rep < NREP(7); ++rep) pg8::gemm_phase<true, true>(lds, g, S, E);
    } SEAM(7);
    if (IN(8)) {
        const int ntile = TILEE[1023];
        pg8::Gemm g{ws + WS_HID, ws + WS_W2T, 1024, F8_W_SC, F8_H_SC, nullptr};
        pg8::TileOrder S; S.init(ntile, 4, G, (int)blockIdx.x, TILEE, 4, WGM_P8);
        pg8::EpiGateF8 E{ws + WS_YS, args.in[29], (const float*)(ws + WS_ROWGATE), TILEE};
        for (int rep = 0; rep < NREP(8); ++rep) pg8::gemm_phase<true, false>(lds, g, S, E);
    } SEAM(8);
    if (IN(9)) { p9_combine(args, G); }
#undef IN
#undef SEAM
}

extern "C" void kernel_launch(void* const* d_in, const int* in_sizes, int n_in, void* d_out, int out_size, void* d_ws, size_t ws_size, hipStream_t stream) {
    static int grid = 0;
    if (grid == 0) {
        if (n_in != 30 || in_sizes[0] != T * D || out_size != T * D || ws_size < WS_END) { fprintf(stderr, "kernel_launch: unexpected shapes (n_in %d, in0 %d, out %d, ws %zu); nothing launched\n", n_in, n_in > 0 ? in_sizes[0] : -1, out_size, ws_size); grid = -1; return; }
        int dev = 0, cus = 0, per_cu = 0;
        if (hipGetDevice(&dev) != hipSuccess || hipDeviceGetAttribute(&cus, hipDeviceAttributeMultiprocessorCount, dev) != hipSuccess) { grid = -1; return; }
        if (hipFuncSetAttribute((const void*)hymba_fwd, hipFuncAttributeMaxDynamicSharedMemorySize, LDS_BYTES) != hipSuccess) { fprintf(stderr, "kernel_launch: hipFuncSetAttribute failed\n"); grid = -1; return; }
        if (hipOccupancyMaxActiveBlocksPerMultiprocessor(&per_cu, (const void*)hymba_fwd, 512, LDS_BYTES) != hipSuccess || per_cu < 1) { fprintf(stderr, "kernel_launch: occupancy query says %d\n", per_cu); per_cu = 1; }
        (void)hipGetLastError();
        grid = cus;
        if (grid > 256) grid = 256;
        if (grid != 256 || T % grid != 0 || (T / grid) % 16 != 0) { fprintf(stderr, "kernel_launch: grid %d does not divide the token count evenly\n", grid); grid = -1; return; }
    }
    if (grid < 0) return;
    (void)hipMemsetAsync((char*)d_ws + WS_CTL, 0, CTL_ZERO_BYTES, stream);
    Args a{};
    for (int i = 0; i < 30; ++i) a.in[i] = (const float*)d_in[i];
    a.out = (float*)d_out; a.ws = (unsigned char*)d_ws;
    constexpr int NL = MK_N_LAUNCHES;
    for (int li = 0; li < NL; ++li) {
        a.ph_lo = (NL == 1) ? 0 : li; a.ph_hi = (NL == 1) ? NPHASE : li + 1;
        void* kargs[] = {&a};
        hipError_t e = hipLaunchCooperativeKernel((const void*)hymba_fwd, dim3(grid), dim3(512), kargs, LDS_BYTES, stream);
        if (e != hipSuccess) { fprintf(stderr, "kernel_launch: cooperative launch %d failed: %s (grid %d)\n", li, hipGetErrorString(e), grid); break; }
    }
}
```

```cpp
#include <hip/hip_runtime.h>
#include <hip/hip_cooperative_groups.h>
#include <cstdio>
#include <cstdint>
#include <type_traits>
namespace cg = cooperative_groups;

#ifndef REP_PHASE
#define REP_PHASE -1
#endif
#ifndef TIME_REGION
#define TIME_REGION -1
#endif
#ifndef WGM_P1
#define WGM_P1 2
#endif
#ifndef WGM_P4
#define WGM_P4 2
#endif
#ifndef WGM_P7
#define WGM_P7 2
#endif
#ifndef WGM_P8
#define WGM_P8 2
#endif
#ifndef MK_N_LAUNCHES
#define MK_N_LAUNCHES 1
#endif

#define LAS __attribute__((address_space(3)))
#define GAS __attribute__((address_space(1)))
typedef unsigned short bf16_t;
typedef short bf16x8 __attribute__((ext_vector_type(8)));
typedef short s16x4 __attribute__((ext_vector_type(4)));
typedef float f32x2 __attribute__((ext_vector_type(2)));
typedef float f32x4 __attribute__((ext_vector_type(4)));
typedef float f32x16 __attribute__((ext_vector_type(16)));
typedef unsigned u32x2 __attribute__((ext_vector_type(2)));
typedef unsigned u32x4 __attribute__((ext_vector_type(4)));
typedef int v8i32 __attribute__((ext_vector_type(8)));

constexpr int NB = 8, SEQ = 4096, T = NB * SEQ, D = 1024;
constexpr int CW = 512;
constexpr int NRW = 1696, NIN = 3232, NINP = 3328;
constexpr int DQ0 = 1696, DK0 = 2208, DV0 = 2720;
constexpr int NE = 32, TOPK = 4, DE = 1024;
constexpr int MAXROWS = T * TOPK + NE * 256;
constexpr int MAXTILES = MAXROWS / 256;
constexpr float LOG2E = 1.4426950408889634f;
constexpr float F8_W_MUL = 32.f, F8_X_MUL = 8.f, F8_H_MUL = 4.f, F8_Y_MUL = 16.f; constexpr int F8_W_SC = 0x7A7A7A7A, F8_X_SC = 0x7C7C7C7C, F8_H_SC = 0x7D7D7D7D;

constexpr size_t MiB = 1u << 20;
constexpr size_t WS_CTL = 0, CTL_ZERO_BYTES = 64 * 1024;
constexpr size_t WS_TILEE = 512 * 1024;
constexpr size_t WS_LW = 576 * 1024;
constexpr size_t WS_WINT = 1 * MiB;
constexpr size_t WS_WOUT = 8 * MiB;
constexpr size_t WS_W1T = 10 * MiB;
constexpr size_t WS_W2T = 138 * MiB;
constexpr size_t WS_EIDX = 202 * MiB;
constexpr size_t WS_GATE = WS_EIDX + 512 * 1024;
constexpr size_t WS_POS = WS_GATE + 512 * 1024;
constexpr size_t WS_DEST = WS_POS + 512 * 1024;
constexpr size_t WS_ROWGATE = 204 * MiB;
constexpr size_t WS_XN = 206 * MiB;
constexpr size_t WS_P = 270 * MiB;
constexpr size_t WS_SR = 478 * MiB, WS_SK = 510 * MiB, WS_SV = 542 * MiB, WS_SA = 574 * MiB, WS_SB = 606 * MiB;
constexpr size_t WS_SW = 638 * MiB;
constexpr size_t WS_SG = 702 * MiB;
constexpr size_t WS_QN = 734 * MiB, WS_KN = 766 * MiB;
constexpr size_t WS_YMIX = 798 * MiB;
constexpr size_t WS_H2 = 206 * MiB;
constexpr size_t WS_ROWTOK = 270 * MiB;
constexpr size_t WS_HID = 406 * MiB;
constexpr size_t WS_YS = 542 * MiB;
constexpr size_t WS_X1B = 862 * MiB;
constexpr size_t WS_CG = 862 * MiB;
constexpr size_t WS_CH = 894 * MiB;
constexpr size_t WS_CR2 = 926 * MiB;
constexpr size_t WS_CY0 = 958 * MiB;
constexpr size_t WS_RK = 990 * MiB;
constexpr size_t WS_VT = 992 * MiB;
constexpr size_t WS_END = 1024 * MiB;
constexpr int CW_CNT = 64;
constexpr int CW_ATTQ = 128;
constexpr int CW_BAR = 4096;

constexpr int RING_BYTES = 131072, MISC_OFF = RING_BYTES, LDS_BYTES = 147456;

__device__ __forceinline__ unsigned f2bf(float f) { unsigned u = __builtin_bit_cast(unsigned, f); return (u + 0x7fffu + ((u >> 16) & 1u)) >> 16; }
typedef __bf16 hwbf16x2 __attribute__((ext_vector_type(2)));
__device__ __forceinline__ unsigned pk2(float lo, float hi) { const f32x2 v = {lo, hi}; return __builtin_bit_cast(unsigned, __builtin_convertvector(v, hwbf16x2)); }
__device__ __forceinline__ unsigned pk4_fp8(float a, float b, float c, float d) {
    a = fminf(fmaxf(a, -448.f), 448.f); b = fminf(fmaxf(b, -448.f), 448.f); c = fminf(fmaxf(c, -448.f), 448.f); d = fminf(fmaxf(d, -448.f), 448.f);
    int r = __builtin_amdgcn_cvt_pk_fp8_f32(a, b, 0, false); r = __builtin_amdgcn_cvt_pk_fp8_f32(c, d, r, true); return (unsigned)r; }
__device__ __forceinline__ float bf2f(unsigned short b) { return __builtin_bit_cast(float, (unsigned)b << 16); }
__device__ __forceinline__ float bflo(unsigned w) { return __builtin_bit_cast(float, w << 16); }
__device__ __forceinline__ float bfhi(unsigned w) { return __builtin_bit_cast(float, w & 0xffff0000u); }
__device__ __forceinline__ float wave_sum(float v) {
#pragma unroll
    for (int o = 1; o < 64; o <<= 1) v += __shfl_xor(v, o);
    return v;
}
__device__ __forceinline__ float sigmoidf_(float x) { return 1.0f / (1.0f + __expf(-x)); }
template <int CTRL> __device__ __forceinline__ float dpp_f(float v) { return __builtin_bit_cast(float, __builtin_amdgcn_update_dpp(0, __builtin_bit_cast(int, v), CTRL, 0xF, 0xF, true)); }
__device__ __forceinline__ float red8(float v) {
    v += dpp_f<0xB1>(v);
    v += dpp_f<0x4E>(v);
    v += dpp_f<0x141>(v);
    return v;
}
__device__ __forceinline__ float red4(float v) { v += dpp_f<0xB1>(v); v += dpp_f<0x4E>(v); return v; }


#define XB_TMO      128
#define XB_XCNT(j)  (256  + 64 * (j))
#define XB_XSUB(j)  (1280 + 64 * (j))
#define XB_XGEN(j)  (2304 + 64 * (j))
#define XB_TOP      3328
#define XB_TOPGEN   3392
#define XCD_BAR_WORDS 3456
#define XB_SPIN_CAP (1u << 18)
__device__ __forceinline__ unsigned xb_ld(unsigned* p)              { return __hip_atomic_load(p, __ATOMIC_RELAXED, __HIP_MEMORY_SCOPE_AGENT); }
__device__ __forceinline__ unsigned xb_add(unsigned* p, unsigned v) { return __hip_atomic_fetch_add(p, v, __ATOMIC_RELAXED, __HIP_MEMORY_SCOPE_AGENT); }
__device__ __forceinline__ unsigned xb_xcc_id() { return (unsigned)__builtin_amdgcn_s_getreg((3 << 11) | 20) & 0xFu; }
#define XB_SPIN(cond, bar) do { unsigned _sp = 0; while (cond) { __builtin_amdgcn_s_sleep(1); \
    if ((++_sp & 255u) == 0u) { if (xb_ld(&(bar)[XB_TMO])) break; if (_sp > XB_SPIN_CAP) { atomicAdd(&(bar)[XB_TMO], 1u); break; } } } } while (0)
struct XcdBarrier { unsigned* bar; unsigned x; volatile LAS unsigned* st; };
__device__ __forceinline__ XcdBarrier xcd_barrier_post(unsigned* bar, volatile LAS unsigned* st) {
    XcdBarrier b; b.bar = bar; b.x = xb_xcc_id(); b.st = st;
    if (threadIdx.x == 0) (void)xb_add(&bar[XB_XCNT(b.x)], 1u);
    return b;
}
__device__ __forceinline__ void xcd_barrier_complete(unsigned* bar, unsigned x, unsigned& nloc, unsigned& nx) {
    const unsigned G = gridDim.x * gridDim.y * gridDim.z;
    unsigned sum, cnt, mine, sp = 0u;
    for (;;) {
        sum = 0u; cnt = 0u; mine = 0u;
#pragma unroll
        for (unsigned j = 0; j < 16; ++j) { const unsigned c = xb_ld(&bar[XB_XCNT(j)]); sum += c; cnt += (c > 0u) ? 1u : 0u; mine = (j == x) ? c : mine; }
        if (sum == G) break;
        __builtin_amdgcn_s_sleep(1);
        if ((++sp & 255u) == 0u) { if (xb_ld(&bar[XB_TMO])) break; if (sp > XB_SPIN_CAP) { atomicAdd(&bar[XB_TMO], 1u); break; } }
    }
    nloc = mine > 0u ? mine : 1u; nx = cnt > 0u ? cnt : 1u;
}
__device__ __forceinline__ void xcd_barrier(const XcdBarrier& b) {
    asm volatile("s_waitcnt vmcnt(0)" ::: "memory");
    __syncthreads();
    if (threadIdx.x == 0) {
        unsigned* bar = b.bar;
        __builtin_amdgcn_s_waitcnt(0);
        unsigned nloc = b.st[0], nx = b.st[1];
        if (nloc == 0u) { xcd_barrier_complete(bar, b.x, nloc, nx); b.st[0] = nloc; b.st[1] = nx; }
        const unsigned old = xb_add(&bar[XB_XSUB(b.x)], 1u);
        const unsigned gen = old / nloc;
        if (old + 1u == (gen + 1u) * nloc) {
            __builtin_amdgcn_fence(__ATOMIC_RELEASE, "agent");
            asm volatile("s_waitcnt vmcnt(0)" ::: "memory");
            const unsigned og = xb_add(&bar[XB_TOP], 1u);
            const unsigned tg = og / nx;
            if (og + 1u == (tg + 1u) * nx) xb_add(&bar[XB_TOPGEN], 1u);
            else XB_SPIN(xb_ld(&bar[XB_TOPGEN]) == tg, bar);
            __builtin_amdgcn_fence(__ATOMIC_ACQUIRE, "agent");
            xb_add(&bar[XB_XGEN(b.x)], 1u);
            asm volatile("s_waitcnt vmcnt(0)" ::: "memory");
        } else {
            XB_SPIN(xb_ld(&bar[XB_XGEN(b.x)]) == gen, bar);
            __builtin_amdgcn_fence(__ATOMIC_ACQUIRE, "agent");
            asm volatile("s_waitcnt vmcnt(0)" ::: "memory");
        }
    }
    __syncthreads();
}

namespace pg8 {
constexpr int BM = 256, BK = 64, HALF = 128, HTB = HALF * BK * 2, STAGE_BYTES = 8 * HTB, NXCD = 8;
__host__ __device__ __forceinline__ int lds_byte(int r, int c) { const int st = (r >> 4) * 2 + (c >> 5), rr = r & 15, cc = c & 31, ob = rr * 64 + cc * 2; return st * 1024 + (ob ^ (((ob >> 9) & 1) << 5)); }
__host__ __device__ __forceinline__ void stage_rc(int b, int& R, int& C) { const int st = b / 1024, sb = b % 1024, swz = sb ^ (((sb >> 9) & 1) << 5); R = (st >> 1) * 16 + swz / 64; C = (st & 1) * 32 + (swz % 64) / 2; }
__host__ __device__ __forceinline__ void stage_rc_f8(int b, int& R, int& C) { const int p = b >> 10, l = (b >> 4) & 63, fr = l >> 2, fq = (l & 3) ^ ((-(fr >> 2)) & 3); R = (p >> 1) * 16 + fr; C = (2 * fq + (p & 1)) * 8; }
__host__ __device__ __forceinline__ int frag_f8(int row0, int fr, int fq) { return (row0 >> 4) * 2048 + fr * 64 + ((fq ^ ((-(fr >> 2)) & 3)) * 16); }
__host__ __device__ __forceinline__ int perm32(int rho) { const int n = rho >> 4, i = rho & 15; return 8 * (i >> 2) + 4 * n + (i & 3); }

struct Unit { int pm, pn, pb; };
struct Gemm { const void* A; const void* Bt; int K; int scW, scA; const int* rowtok; };

struct TileOrder {
    int nM, nN, nwg, G, c, WGM; const int* tile_e; int nb_per_e;
    __device__ void init(int nM_, int nN_, int G_, int c_, const int* te, int nbe, int wgm) { nM = nM_; nN = nN_; nwg = nM * nN; G = G_; c = c_; tile_e = te; nb_per_e = nbe; WGM = wgm; }
    __device__ bool next(int i, Unit& u) const {
        const long L = (long)i * G + c; if (L >= nwg) return false;
        int wgid = (int)L; { const int q = nwg / NXCD, r = nwg % NXCD, xcd = wgid % NXCD, off = wgid / NXCD; wgid = (xcd < r ? xcd * (q + 1) : r * (q + 1) + (xcd - r) * q) + off; }
        const int nig = WGM * nN, gid = wgid / nig, fm = gid * WGM, gsz = (nM - fm) < WGM ? (nM - fm) : WGM;
        u.pm = fm + ((wgid % nig) % gsz); u.pn = (wgid % nig) / gsz;
        u.pb = tile_e ? tile_e[u.pm] * nb_per_e + u.pn : u.pn;
        return true;
    }
};

struct EpiBf16 {
    static constexpr bool PERM = true;
    bf16_t* O; int ldc; bf16_t* VT;
    __device__ __forceinline__ void operator()(const f32x4 (&acc)[2][2][4][2], const Unit& u, int wr, int wc, int fr, int fq) const {
        const int row0 = u.pm * BM + wr * 64 + fr; const int col0 = u.pn * BM + wc * 32 + 8 * fq;
#pragma unroll
        for (int ai = 0; ai < 2; ++ai)
#pragma unroll
            for (int m = 0; m < 4; ++m) { const int t = row0 + ai * HALF + m * 16; bf16_t* rowp = O + (size_t)t * ldc + col0;
#pragma unroll
                for (int bj = 0; bj < 2; ++bj) { const f32x4 v0 = acc[ai][bj][m][0], v1 = acc[ai][bj][m][1];
                    u32x4 w; w.x = pk2(v0[0], v0[1]); w.y = pk2(v0[2], v0[3]); w.z = pk2(v1[0], v1[1]); w.w = pk2(v1[2], v1[3]);
                    const int col = col0 + bj * HALF;
                    if (col >= DV0) { const int dvf = col - DV0, hh = dvf >> 7, dv = dvf & 127, tp = t & (SEQ - 1), key = tp & 63;
                        bf16_t* vp = VT + (((((size_t)((t >> 12) * 4 + hh) * 64 + (tp >> 6)) * 4 + (dv >> 5)) * 4 + (key >> 4)) * 16 + (key & 15)) * 32 + (dv & 31);
                        if (col < NIN) *(u32x4*)vp = w; }
                    else *(u32x4*)(rowp + bj * HALF) = w; } }
    }
};
struct EpiResBf16 {
    static constexpr bool PERM = true;
    const float* base; bf16_t* out; int ldc;
    __device__ __forceinline__ void operator()(const f32x4 (&acc)[2][2][4][2], const Unit& u, int wr, int wc, int fr, int fq) const {
        const int col0 = u.pn * BM + wc * 32 + 8 * fq;
#pragma unroll
        for (int ai = 0; ai < 2; ++ai)
#pragma unroll
            for (int m = 0; m < 4; ++m) { const size_t off = (size_t)(u.pm * BM + ai * HALF + wr * 64 + m * 16 + fr) * ldc + col0;
#pragma unroll
                for (int bj = 0; bj < 2; ++bj) { const f32x4 b0 = *(const f32x4*)(base + off + bj * HALF), b1 = *(const f32x4*)(base + off + bj * HALF + 4);
                    const f32x4 v0 = b0 + acc[ai][bj][m][0], v1 = b1 + acc[ai][bj][m][1];
                    u32x4 w; w.x = pk2(v0[0], v0[1]); w.y = pk2(v0[2], v0[3]); w.z = pk2(v1[0], v1[1]); w.w = pk2(v1[2], v1[3]);
                    *(u32x4*)(out + off + bj * HALF) = w; } }
    }
};
struct EpiSwiglu {
    static constexpr bool PERM = true;
    unsigned char* O; const float* b1; const int* tile_e;
    __device__ __forceinline__ void operator()(const f32x4 (&acc)[2][2][4][2], const Unit& u, int wr, int wc, int fr, int fq) const {
        const int e = tile_e[u.pm]; const int row0 = u.pm * BM + wr * 64 + fr; const int hc0 = u.pn * 128 + wc * 32 + 8 * fq;
        const float* bg = b1 + (size_t)e * 2048 + hc0; const float* bl = bg + 1024;
        const f32x4 g0 = *(const f32x4*)bg, g1 = *(const f32x4*)(bg + 4), l0 = *(const f32x4*)bl, l1 = *(const f32x4*)(bl + 4);
#pragma unroll
        for (int ai = 0; ai < 2; ++ai)
#pragma unroll
            for (int m = 0; m < 4; ++m) { unsigned char* rowp = O + (size_t)(row0 + ai * HALF + m * 16) * 1024 + hc0;
                float o[8];
#pragma unroll
                for (int n = 0; n < 2; ++n) { const f32x4 gv = acc[ai][0][m][n] + (n ? g1 : g0), lv = acc[ai][1][m][n] + (n ? l1 : l0);
#pragma unroll
                    for (int i = 0; i < 4; ++i) { const float g = fminf(gv[i], 7.0f), l = fminf(fmaxf(lv[i], -7.0f), 7.0f);
                        const float sg = __builtin_amdgcn_rcpf(1.0f + __builtin_amdgcn_exp2f(-1.702f * LOG2E * g)); o[n * 4 + i] = g * sg * (l + 1.0f); } }
                u32x2 w; w.x = pk4_fp8(o[0] * F8_H_MUL, o[1] * F8_H_MUL, o[2] * F8_H_MUL, o[3] * F8_H_MUL); w.y = pk4_fp8(o[4] * F8_H_MUL, o[5] * F8_H_MUL, o[6] * F8_H_MUL, o[7] * F8_H_MUL);
                *(u32x2*)rowp = w; }
    }
};
struct EpiGateF8 {
    static constexpr bool PERM = true;
    unsigned char* O; const float* b2; const float* rowgate; const int* tile_e;
    __device__ __forceinline__ void operator()(const f32x4 (&acc)[2][2][4][2], const Unit& u, int wr, int wc, int fr, int fq) const {
        const int e = tile_e[u.pm]; const int row0 = u.pm * BM + wr * 64 + fr; const int col0 = u.pn * BM + wc * 32 + 8 * fq;
        f32x4 bv[2][2];
#pragma unroll
        for (int bj = 0; bj < 2; ++bj)
#pragma unroll
            for (int n = 0; n < 2; ++n) bv[bj][n] = *(const f32x4*)(b2 + (size_t)e * 1024 + col0 + bj * HALF + 4 * n);
#pragma unroll
        for (int ai = 0; ai < 2; ++ai)
#pragma unroll
            for (int m = 0; m < 4; ++m) { const int row = row0 + ai * HALF + m * 16; const float gt = rowgate[row] * F8_Y_MUL; unsigned char* rowp = O + (size_t)row * 1024 + col0;
#pragma unroll
                for (int bj = 0; bj < 2; ++bj) { const f32x4 v0 = (acc[ai][bj][m][0] + bv[bj][0]) * gt, v1 = (acc[ai][bj][m][1] + bv[bj][1]) * gt;
                    u32x2 w; w.x = pk4_fp8(v0[0], v0[1], v0[2], v0[3]); w.y = pk4_fp8(v1[0], v1[1], v1[2], v1[3]);
                    *(u32x2*)(rowp + bj * HALF) = w; } }
    }
};

__device__ __forceinline__ v8i32 pg8_ld32(const LAS unsigned char* p) { const u32x4 a = *(const LAS u32x4*)p, b = *(const LAS u32x4*)(p + 1024);
    return (v8i32){(int)a.x, (int)a.y, (int)a.z, (int)a.w, (int)b.x, (int)b.y, (int)b.z, (int)b.w}; }
template <bool F8, bool GATHER, class Epi, class Sched>
__device__ __forceinline__ void gemm_phase(LAS unsigned char* lds, const Gemm g, const Sched& S, const Epi& E) {
    const int tid = threadIdx.x, wid = __builtin_amdgcn_readfirstlane(tid >> 6), lane = tid & 63, wr = wid >> 2, wc = wid & 3, fr = lane & 15, fq = lane >> 4;
    const int RB = F8 ? g.K : g.K * 2, nt = RB / 128;
    unsigned voffB[2];
#pragma unroll
    for (int i = 0; i < 2; ++i) { int R, C; if constexpr (F8) stage_rc_f8(tid * 16 + i * 8192, R, C); else stage_rc(tid * 16 + i * 8192, R, C); const int Rb = Epi::PERM ? ((R & ~31) + perm32(R & 31)) : R;
        voffB[i] = (unsigned)(Rb * RB + C * 2); }
#define PG8_AOFFS(dst, pm_) do { _Pragma("unroll") for (int h_ = 0; h_ < 2; ++h_) _Pragma("unroll") for (int i_ = 0; i_ < 2; ++i_) { int R_, C_; if constexpr (F8) stage_rc_f8(tid * 16 + i_ * 8192, R_, C_); else stage_rc(tid * 16 + i_ * 8192, R_, C_); \
        const int row_ = (pm_) * BM + h_ * HALF + R_; const unsigned grow_ = GATHER ? (unsigned)g.rowtok[row_] : (unsigned)row_; dst[h_][i_] = grow_ * (unsigned)RB + (unsigned)(C_ * 2); } } while (0)
    unsigned cvA[2][2], nvA[2][2];
    const size_t kstep = (size_t)(BK * 2);
    const size_t hstep = (size_t)HALF * RB;
    const size_t tstep = 2 * hstep;
    const unsigned ldsw = (unsigned)wid * 1024u;
    const int aoff = F8 ? frag_f8(wr * 64, fr, fq) : lds_byte(wr * 64 + fr, fq * 8);
    const int boff = F8 ? frag_f8(wc * 32, fr, fq) : lds_byte(wc * 32 + fr, fq * 8);
    const int scW = g.scW, scA = g.scA;
#define PG8_SA(b, h) (((b) * 2 + (h)) * HTB)
#define PG8_SB(b, h) ((4 + (b) * 2 + (h)) * HTB)
#define PG8_STAGE(bufoff, gbase, voff) do { _Pragma("unroll") for (int _i = 0; _i < 2; ++_i) \
        __builtin_amdgcn_global_load_lds((const unsigned*)((const char*)(gbase) + (voff)[_i]), (LAS unsigned*)(lds + (bufoff) + ldsw + _i * 8192), 16, 0, 0); } while (0)
typedef int v8i32a __attribute__((ext_vector_type(8), aligned(16)));
#define PG8_LD32(p) pg8_ld32(p)
#define PG8_STAGE_A(bufoff, kptr, offs) do { _Pragma("unroll") for (int _i = 0; _i < 2; ++_i) \
        __builtin_amdgcn_global_load_lds((const unsigned*)((const char*)(kptr) + (offs)[_i]), (LAS unsigned*)(lds + (bufoff) + ldsw + _i * 8192), 16, 0, 0); } while (0)
#define PG8_LDA(dst, b, h) do { _Pragma("unroll") for (int m = 0; m < 4; ++m) { if constexpr (F8) { dst[m].f8 = PG8_LD32(lds + PG8_SA(b, h) + aoff + m * 2048); } \
        else { _Pragma("unroll") for (int k = 0; k < 2; ++k) dst[m].hv[k] = *(const LAS bf16x8*)(lds + PG8_SA(b, h) + aoff + m * 2048 + k * 1024); } } } while (0)
#define PG8_LDB(dst, b, h) do { _Pragma("unroll") for (int n = 0; n < 2; ++n) { if constexpr (F8) { dst[n].f8 = PG8_LD32(lds + PG8_SB(b, h) + boff + n * 2048); } \
        else { _Pragma("unroll") for (int k = 0; k < 2; ++k) dst[n].hv[k] = *(const LAS bf16x8*)(lds + PG8_SB(b, h) + boff + n * 2048 + k * 1024); } } } while (0)
#define PG8_MMA(ai, bj, At, Bt) do { __builtin_amdgcn_s_setprio(1); _Pragma("unroll") for (int m = 0; m < 4; ++m) _Pragma("unroll") for (int n = 0; n < 2; ++n) { \
        if constexpr (F8) { asm volatile("v_mfma_scale_f32_16x16x128_f8f6f4 %0, %1, %2, %0, %3, %4 op_sel_hi:[0,0,0]" : "+v"(acc[ai][bj][m][n]) : "v"(Bt[n].f8), "v"(At[m].f8), "v"(scW), "v"(scA)); } \
        else { _Pragma("unroll") for (int k = 0; k < 2; ++k) acc[ai][bj][m][n] = __builtin_amdgcn_mfma_f32_16x16x32_bf16(Bt[n].hv[k], At[m].hv[k], acc[ai][bj][m][n], 0, 0, 0); } } \
        __builtin_amdgcn_s_setprio(0); } while (0)
#define PG8_WAIT_V(n) asm volatile("s_waitcnt vmcnt(" #n ")" ::: "memory")
#define PG8_WAIT_L(n) asm volatile("s_waitcnt lgkmcnt(" #n ")" ::: "memory")
#define PG8_BAR __builtin_amdgcn_s_barrier()
#define PG8_SCHED __builtin_amdgcn_sched_barrier(0)
    Unit cur, nxt; int ui = 0;
    if (!S.next(0, cur)) return;
    f32x4 acc[2][2][4][2];
#pragma unroll
    for (int a = 0; a < 2; ++a)
#pragma unroll
        for (int b = 0; b < 2; ++b)
#pragma unroll
            for (int m = 0; m < 4; ++m)
#pragma unroll
                for (int n = 0; n < 2; ++n) acc[a][b][m][n] = (f32x4){0.f, 0.f, 0.f, 0.f};
    struct FragH { bf16x8 hv[2]; }; struct Frag8 { v8i32 f8; };
    typename std::conditional<F8, Frag8, FragH>::type At[4], B0[2], B1[2];
    const char* const kA = (const char*)g.A; const char* cB = (const char*)g.Bt + (size_t)cur.pb * tstep;
    PG8_AOFFS(cvA, cur.pm);
    PG8_STAGE(PG8_SB(0, 0), cB, voffB); PG8_STAGE(PG8_SB(0, 1), cB + hstep, voffB); PG8_STAGE_A(PG8_SA(0, 0), kA, cvA[0]); PG8_STAGE_A(PG8_SA(0, 1), kA, cvA[1]);
    if (wr == 1) PG8_BAR;
    PG8_WAIT_V(2); PG8_BAR;
    PG8_STAGE(PG8_SB(1, 0), cB + kstep, voffB); PG8_STAGE_A(PG8_SA(1, 0), kA + kstep, cvA[0]); PG8_STAGE(PG8_SB(1, 1), cB + hstep + kstep, voffB);
    PG8_WAIT_V(6); PG8_BAR;
    for (;;) {
        const bool has_next = S.next(ui + 1, nxt);
        const char* nB = has_next ? (const char*)g.Bt + (size_t)nxt.pb * tstep : cB;
        if (has_next) { PG8_AOFFS(nvA, nxt.pm); } else { _Pragma("unroll") for (int h_ = 0; h_ < 2; ++h_) _Pragma("unroll") for (int i_ = 0; i_ < 2; ++i_) nvA[h_][i_] = cvA[h_][i_]; }
#pragma clang loop unroll(disable)
        for (int t = 0; t < nt; t += 2) {
            const bool last = (t == nt - 2);
            const char* a1 = kA + (size_t)(t + 1) * kstep;
            const char* a2 = last ? kA : kA + (size_t)(t + 2) * kstep; const char* b2 = last ? nB : cB + (size_t)(t + 2) * kstep;
            const char* a3 = a2 + kstep; const char* b3 = b2 + kstep;
            unsigned v2A[2][2];
#pragma unroll
            for (int h_ = 0; h_ < 2; ++h_)
#pragma unroll
                for (int i_ = 0; i_ < 2; ++i_) v2A[h_][i_] = last ? nvA[h_][i_] : cvA[h_][i_];
            PG8_LDB(B0, 0, 0); PG8_LDB(B1, 0, 1); PG8_SCHED; PG8_LDA(At, 0, 0); PG8_STAGE_A(PG8_SA(1, 1), a1, cvA[1]);
            PG8_WAIT_V(8); PG8_WAIT_L(0); PG8_BAR; PG8_MMA(0, 0, At, B0); PG8_MMA(0, 1, At, B1); PG8_BAR; PG8_SCHED;
            PG8_LDA(At, 0, 1); PG8_STAGE(PG8_SB(0, 0), b2, voffB); PG8_STAGE(PG8_SB(0, 1), b2 + hstep, voffB); PG8_STAGE_A(PG8_SA(0, 0), a2, v2A[0]);
            PG8_WAIT_V(8); PG8_WAIT_L(0); PG8_BAR; PG8_MMA(1, 0, At, B0); PG8_MMA(1, 1, At, B1); PG8_BAR; PG8_SCHED;
            PG8_LDB(B0, 1, 0); PG8_LDB(B1, 1, 1); PG8_SCHED; PG8_LDA(At, 1, 0); PG8_STAGE_A(PG8_SA(0, 1), a2, v2A[1]);
            PG8_WAIT_V(8); PG8_WAIT_L(0); PG8_BAR; PG8_MMA(0, 0, At, B0); PG8_MMA(0, 1, At, B1); PG8_BAR; PG8_SCHED;
            PG8_LDA(At, 1, 1); PG8_STAGE(PG8_SB(1, 0), b3, voffB); PG8_STAGE(PG8_SB(1, 1), b3 + hstep, voffB); PG8_STAGE_A(PG8_SA(1, 0), a3, v2A[0]);
            PG8_WAIT_V(8); PG8_WAIT_L(0); PG8_BAR; PG8_MMA(1, 0, At, B0); PG8_MMA(1, 1, At, B1); PG8_BAR; PG8_SCHED;
        }
        if (wr == 0) PG8_BAR;
        if constexpr (F8) asm volatile("s_nop 15\n\ts_nop 15" ::: "memory");
        E(acc, cur, wr, wc, fr, fq);
        if (!has_next) break;
#pragma unroll
        for (int a = 0; a < 2; ++a)
#pragma unroll
            for (int b = 0; b < 2; ++b)
#pragma unroll
                for (int m = 0; m < 4; ++m)
#pragma unroll
                    for (int n = 0; n < 2; ++n) acc[a][b][m][n] = (f32x4){0.f, 0.f, 0.f, 0.f};
        cur = nxt; cB = nB; ++ui;
#pragma unroll
        for (int h_ = 0; h_ < 2; ++h_)
#pragma unroll
            for (int i_ = 0; i_ < 2; ++i_) cvA[h_][i_] = nvA[h_][i_];
        if (wr == 1) PG8_BAR;
    }
    PG8_WAIT_V(0);
    PG8_BAR;
#undef PG8_SA
#undef PG8_SB
#undef PG8_STAGE
#undef PG8_STAGE_A
#undef PG8_AOFFS
#undef PG8_LDA
#undef PG8_LDB
#undef PG8_MMA
#undef PG8_LD32
#undef PG8_WAIT_V
#undef PG8_WAIT_L
#undef PG8_BAR
#undef PG8_SCHED
}
}

struct Args { const float* in[30]; float* out; unsigned char* ws; int ph_lo, ph_hi; };

__device__ __forceinline__ void p0_transpose_item(const float* W, int K, int N, bf16_t* WT, int k0, int n0, int drow0, LAS float* scr, int lane) {
#pragma unroll 8
    for (int i = 0; i < 32; ++i) { const int kk = 2 * i + (lane >> 5); scr[kk * 33 + (lane & 31)] = W[(size_t)(k0 + kk) * N + n0 + (lane & 31)]; }
    asm volatile("s_waitcnt lgkmcnt(0)" ::: "memory");
    const int c = lane & 7;
#pragma unroll
    for (int j = 0; j < 4; ++j) { const int n = (lane >> 3) + 8 * j; const LAS float* s = scr + (8 * c) * 33 + n;
        u32x4 o; o.x = pk2(s[0 * 33], s[1 * 33]); o.y = pk2(s[2 * 33], s[3 * 33]); o.z = pk2(s[4 * 33], s[5 * 33]); o.w = pk2(s[6 * 33], s[7 * 33]);
        *(u32x4*)(WT + (size_t)(drow0 + n) * K + k0 + 8 * c) = o; }
    asm volatile("s_waitcnt lgkmcnt(0)" ::: "memory");
}
__device__ __forceinline__ void p0_transpose_item_f8(const float* W, int K, int N, unsigned char* WT, int k0, int n0, int drow0, LAS float* scr, int lane) {
    LAS unsigned* tile = (LAS unsigned*)scr;
    const float* src = W + (size_t)k0 * N + n0 + lane;
#pragma unroll 1
    for (int kb = 0; kb < 32; kb += 16) {
        float v[16][4];
#pragma unroll
        for (int i = 0; i < 16; ++i) { const float* p = src + (size_t)(4 * (kb + i)) * N;
#pragma unroll
            for (int j = 0; j < 4; ++j) v[i][j] = __builtin_nontemporal_load(p + (size_t)j * N); }
        __builtin_amdgcn_sched_barrier(0);
#pragma unroll
        for (int i = 0; i < 16; ++i) tile[lane * 33 + kb + i] = pk4_fp8(v[i][0] * F8_W_MUL, v[i][1] * F8_W_MUL, v[i][2] * F8_W_MUL, v[i][3] * F8_W_MUL);
        __builtin_amdgcn_sched_barrier(0);
    }
    asm volatile("s_waitcnt lgkmcnt(0)" ::: "memory");
    const int c = lane & 7;
#pragma unroll
    for (int j = 0; j < 8; ++j) { const int n = (lane >> 3) + 8 * j; const LAS unsigned* t = tile + n * 33 + 4 * c;
        __builtin_nontemporal_store((u32x4){t[0], t[1], t[2], t[3]}, (u32x4*)(WT + (size_t)(drow0 + n) * K + k0 + 16 * c)); }
    asm volatile("s_waitcnt lgkmcnt(0)" ::: "memory");
}
constexpr int CONV_I_W1 = 8 * 32, CONV_I_W2 = 8 * 16;
constexpr int CONV_ITEMS = NE * (CONV_I_W1 + CONV_I_W2) / 8;
__device__ __forceinline__ void conv_item(LAS unsigned char* lds, const Args& a, int bi) {
    const int lane = threadIdx.x & 63, wave = __builtin_amdgcn_readfirstlane(threadIdx.x >> 6);
    LAS float* scr = (LAS float*)(lds + wave * 16384);
    unsigned char* W1t = a.ws + WS_W1T; unsigned char* W2t = a.ws + WS_W2T;
    int r = bi * 8 + wave;
    if (r < NE * CONV_I_W1) { const int e = r / CONV_I_W1, q = r % CONV_I_W1, kb = q / 32, nb = q % 32; const int n0 = 64 * nb;
        const int drow = (n0 < 1024) ? ((n0 >> 7) * 256 + (n0 & 127)) : (((n0 - 1024) >> 7) * 256 + 128 + ((n0 - 1024) & 127));
        p0_transpose_item_f8(a.in[26] + (size_t)e * 1024 * 2048, 1024, 2048, W1t + (size_t)e * 2048 * 1024, 128 * kb, n0, drow, scr, lane); }
    else { r -= NE * CONV_I_W1; const int e = r / CONV_I_W2, q = r % CONV_I_W2, kb = q / 16, nb = q % 16;
        p0_transpose_item_f8(a.in[28] + (size_t)e * 1024 * 1024, 1024, 1024, W2t + (size_t)e * 1024 * 1024, 128 * kb, 64 * nb, 64 * nb, scr, lane); }
}
__device__ __forceinline__ void p0_prologue(LAS unsigned char* lds, const Args& a, int G) {
    const int tid = threadIdx.x, lane = tid & 63, wave = __builtin_amdgcn_readfirstlane(tid >> 6);
    LAS float* scr = (LAS float*)(lds + wave * 16384);
    const int gw = blockIdx.x * 8 + wave, NGW = G * 8;
    unsigned char* ws = a.ws;
    bf16_t* Wint = (bf16_t*)(ws + WS_WINT); bf16_t* Woutt = (bf16_t*)(ws + WS_WOUT);
    constexpr int I_IN = 16 * (NIN / 32);
    constexpr int I_OUT = 16 * 32;
    constexpr int NITEMS = I_IN + I_OUT;
    for (int it = gw; it < NITEMS; it += NGW) {
        int r = it;
        if (r < I_IN) { const int nblk = NIN / 32, kb = r / nblk, nb = r % nblk; p0_transpose_item(a.in[2], 1024, NIN, Wint, 64 * kb, 32 * nb, 32 * nb, scr, lane); continue; } r -= I_IN;
        { const int kb = r / 32, nb = r % 32; p0_transpose_item(a.in[22], 1024, 1024, Woutt, 64 * kb, 32 * nb, 32 * nb, scr, lane); }
    }
    { bf16_t* LW = (bf16_t*)(ws + WS_LW);
      for (int i = gw * 64 + lane; i < CW * 160; i += NGW * 64) { const int col = i / 160, k = i - col * 160;
          const float v = k < 32 ? a.in[5][k * CW + col] : (k < 64 ? a.in[7][(k - 32) * CW + col] : a.in[8][(k - 64) * CW + col]); LW[i] = (bf16_t)f2bf(v); } }
    const float* x = a.in[0]; const float* g1 = a.in[1]; bf16_t* XN = (bf16_t*)(ws + WS_XN);
    f32x4 gv[4];
#pragma unroll
    for (int j = 0; j < 4; ++j) gv[j] = *((const f32x4*)g1 + lane + 64 * j);
#pragma unroll 4
    for (int m = gw; m < T; m += NGW) {
        const f32x4* xr = (const f32x4*)(x + (size_t)m * D) + lane;
        f32x4 v[4]; float s = 0.f;
#pragma unroll
        for (int j = 0; j < 4; ++j) { v[j] = xr[64 * j]; s += (v[j].x * v[j].x + v[j].y * v[j].y) + (v[j].z * v[j].z + v[j].w * v[j].w); }
        const float rstd = 1.0f / sqrtf(wave_sum(s) * (1.0f / D) + 1e-5f);
        u32x2* o8 = (u32x2*)(XN + (size_t)m * D) + lane;
#pragma unroll
        for (int j = 0; j < 4; ++j) { u32x2 w; w.x = pk2(v[j].x * rstd * gv[j].x, v[j].y * rstd * gv[j].y); w.y = pk2(v[j].z * rstd * gv[j].z, v[j].w * rstd * gv[j].w); o8[64 * j] = w; }
    }
}

__device__ __forceinline__ f32x4 cvlo(const u32x4 u) { return (f32x4){bflo(u.x), bfhi(u.x), bflo(u.y), bfhi(u.y)}; }
__device__ __forceinline__ f32x4 cvhi(const u32x4 u) { return (f32x4){bflo(u.z), bfhi(u.z), bflo(u.w), bfhi(u.w)}; }
__device__ __forceinline__ u32x4 pk8(const f32x4 lo, const f32x4 hi) { u32x4 w; w.x = pk2(lo.x, lo.y); w.y = pk2(lo.z, lo.w); w.z = pk2(hi.x, hi.y); w.w = pk2(hi.z, hi.w); return w; }

namespace ck {
constexpr int PS = 136;
constexpr int O_BT = 0, O_KT = 8704, O_AP = 17408, O_RT = 26112;
constexpr int O_AT = 34816, O_BH = 43008, O_KH = 51200, O_VV = 59392, O_TN = 67584, O_A2 = 75776, O_V2 = 83968;
constexpr int O_L = 92160, LSTR = 68;
constexpr int O_TOT = 109568, O_GC = 111616;
constexpr int O_ACT = 112128;
__device__ __forceinline__ int crow(int r, int hi) { return (r & 3) + 8 * (r >> 2) + 4 * hi; }
__device__ __forceinline__ int voff(int row, int col) { return ((col >> 5) * 4 + (row >> 4)) * 1024 + (row & 15) * 64 + (col & 31) * 2; }
__device__ __forceinline__ s16x4 vtr(const LAS unsigned char* p) { return __builtin_bit_cast(s16x4, __builtin_amdgcn_ds_read_tr16_b64_v4i16((LAS s16x4*)p)); }
__device__ __forceinline__ bf16x8 fragP(const LAS unsigned char* M, int row, int k0, int hi) {
    const LAS unsigned char* p = M + row * PS + (k0 + 4 * hi) * 2; const s16x4 lo = *(const LAS s16x4*)p, h = *(const LAS s16x4*)(p + 16);
    return (bf16x8){lo[0], lo[1], lo[2], lo[3], h[0], h[1], h[2], h[3]}; }
__device__ __forceinline__ bf16x8 fragT(const LAS unsigned char* M, int k0, int colblk, int lane, int hi) {
    const LAS unsigned char* p = M + (colblk * 4 + (k0 >> 4)) * 1024 + ((lane >> 4) & 1) * 32 + (lane & 3) * 8 + (4 * hi + ((lane & 15) >> 2)) * 64;
    const s16x4 lo = vtr(p), h = vtr(p + 512); return (bf16x8){lo[0], lo[1], lo[2], lo[3], h[0], h[1], h[2], h[3]}; }
__device__ __forceinline__ bf16x8 packR(const f32x16& x, int s) {
    u32x4 w; w.x = pk2(x[8 * s], x[8 * s + 1]); w.y = pk2(x[8 * s + 2], x[8 * s + 3]); w.z = pk2(x[8 * s + 4], x[8 * s + 5]); w.w = pk2(x[8 * s + 6], x[8 * s + 7]); return __builtin_bit_cast(bf16x8, w); }
#define CK_MFMA(a, b, c) __builtin_amdgcn_mfma_f32_32x32x16_bf16(a, b, c, 0, 0, 0)
__device__ __forceinline__ f32x16 score(const LAS unsigned char* Am, const LAS unsigned char* Bm, int sblk, int tblk, int mode, int r32, int hi) {
    f32x16 x = f32x16{};
#pragma unroll
    for (int ks = 0; ks < 4; ++ks) x = CK_MFMA(fragP(Am, sblk * 32 + r32, 16 * ks, hi), fragP(Bm, tblk * 32 + r32, 16 * ks, hi), x);
    if (mode) {
        const int t = tblk * 32 + r32;
#pragma unroll
        for (int r = 0; r < 16; ++r) { const int s = sblk * 32 + crow(r, hi); if (mode == 1 ? !(s < t) : !(s <= t)) x[r] = 0.f; }
    }
    return x;
}
__device__ __forceinline__ void storeT_V(LAS unsigned char* M, const f32x16& x, int rb, int c, int hi) {
#pragma unroll
    for (int q = 0; q < 4; ++q) { u32x2 w; w.x = pk2(x[4 * q], x[4 * q + 1]); w.y = pk2(x[4 * q + 2], x[4 * q + 3]); *(LAS u32x2*)(M + voff(c, rb * 32 + 8 * q + 4 * hi)) = w; }
}
__device__ __forceinline__ void storeT_S(LAS unsigned char* M, const f32x16& x, int rb, int c, int hi) {
#pragma unroll
    for (int q = 0; q < 4; ++q) { u32x2 w; w.x = pk2(x[4 * q], x[4 * q + 1]); w.y = pk2(x[4 * q + 2], x[4 * q + 3]); *(LAS u32x2*)(M + c * PS + (rb * 32 + 8 * q + 4 * hi) * 2) = w; }
}

__device__ __forceinline__ void chunk_item(LAS unsigned char* lds, const Args& a, int item) {
    int tid = threadIdx.x; asm volatile("" : "+v"(tid)); int lane = tid & 63; const int wave = __builtin_amdgcn_readfirstlane(tid >> 6);
#define CK_FRESH() asm volatile("" : "+v"(lane)); r32 = lane & 31; hi = lane >> 5
    int r32, hi; CK_FRESH();
    unsigned char* ws = a.ws;
    const bf16_t* SR = (const bf16_t*)(ws + WS_SR); const bf16_t* SK = (const bf16_t*)(ws + WS_SK); const bf16_t* SV = (const bf16_t*)(ws + WS_SV);
    const bf16_t* SA = (const bf16_t*)(ws + WS_SA); const bf16_t* SB = (const bf16_t*)(ws + WS_SB); const float* SW = (const float*)(ws + WS_SW);
    bf16_t* CG = (bf16_t*)(ws + WS_CG) + (size_t)item * 4096; bf16_t* CH = (bf16_t*)(ws + WS_CH) + (size_t)item * 4096;
    bf16_t* CR2 = (bf16_t*)(ws + WS_CR2) + (size_t)item * 4096; bf16_t* CY0 = (bf16_t*)(ws + WS_CY0) + (size_t)item * 4096;
    const int bh = item >> 6, c = item & 63, b = bh >> 3, h = bh & 7, tokc = b * SEQ + c * 64, col0 = h * 64;
    LAS unsigned char* BT = lds + O_BT; LAS unsigned char* KT = lds + O_KT; LAS unsigned char* AP = lds + O_AP; LAS unsigned char* RT = lds + O_RT;
    LAS unsigned char* AT = lds + O_AT; LAS unsigned char* BH = lds + O_BH; LAS unsigned char* KH = lds + O_KH; LAS unsigned char* VV = lds + O_VV;
    LAS unsigned char* TN = lds + O_TN; LAS unsigned char* A2M = lds + O_A2; LAS unsigned char* V2M = lds + O_V2;
    LAS float* L = (LAS float*)(lds + O_L); LAS float* TOT = (LAS float*)(lds + O_TOT); LAS float* GC = (LAS float*)(lds + O_GC);
    {
        const int tl = tid >> 3, c8 = (tid & 7) * 8, cr = col0 + c8, t = tokc + tl;
        const bf16_t* P = (const bf16_t*)(ws + WS_P); const bf16_t* pr = P + (size_t)t * NINP + cr;
        bf16_t* SVo = (bf16_t*)(ws + WS_SV); bf16_t* SGo = (bf16_t*)(ws + WS_SG); bf16_t* QN = (bf16_t*)(ws + WS_QN); bf16_t* KN = (bf16_t*)(ws + WS_KN);
        const float* mu = a.in[3];
        const bool first = (t & (SEQ - 1)) == 0; const u32x4 zz = (u32x4){0u, 0u, 0u, 0u};
#define CK_PK8(v) ((u32x4){pk2(v[0], v[1]), pk2(v[2], v[3]), pk2(v[4], v[5]), pk2(v[6], v[7])})
#define CK_ST_P(M, val_) do { LAS unsigned char* d_ = (M) + tl * PS + c8 * 2; const u32x4 q_ = (val_); *(LAS u32x2*)d_ = (u32x2){q_[0], q_[1]}; *(LAS u32x2*)(d_ + 8) = (u32x2){q_[2], q_[3]}; } while (0)
        float g[8], gp[8], ig[8], gC[8];
        {
            const u32x4 deu = *(const LAS u32x4*)(TN + tl * 128 + c8 * 2); const f32x4 de0 = cvlo(deu), de1 = cvhi(deu);
            float wv[8] = {__builtin_amdgcn_exp2f(de0.x), __builtin_amdgcn_exp2f(de0.y), __builtin_amdgcn_exp2f(de0.z), __builtin_amdgcn_exp2f(de0.w), __builtin_amdgcn_exp2f(de1.x), __builtin_amdgcn_exp2f(de1.y), __builtin_amdgcn_exp2f(de1.z), __builtin_amdgcn_exp2f(de1.w)};
            float p[8];
#pragma unroll
            for (int j = 0; j < 8; ++j) p[j] = wv[j];
#pragma unroll
            for (int d = 8; d < 64; d <<= 1) {
#pragma unroll
                for (int j = 0; j < 8; ++j) { const float q = __shfl_up(p[j], d); if (lane >= d) p[j] *= q; }
            }
            if ((lane >> 3) == 7) { *(LAS f32x4*)(TOT + wave * 64 + c8) = (f32x4){p[0], p[1], p[2], p[3]}; *(LAS f32x4*)(TOT + wave * 64 + c8 + 4) = (f32x4){p[4], p[5], p[6], p[7]}; }
            __syncthreads();
            float pre[8];
#pragma unroll
            for (int j = 0; j < 8; ++j) { pre[j] = 1.f; gC[j] = 1.f; }
#pragma unroll
            for (int w2 = 0; w2 < 8; ++w2) { const f32x4 t0 = *(const LAS f32x4*)(TOT + w2 * 64 + c8), t1 = *(const LAS f32x4*)(TOT + w2 * 64 + c8 + 4);
                const float tv[8] = {t0.x, t0.y, t0.z, t0.w, t1.x, t1.y, t1.z, t1.w};
#pragma unroll
                for (int j = 0; j < 8; ++j) { if (w2 < wave) pre[j] *= tv[j]; gC[j] *= tv[j]; } }
            if (tid < 8) { *(LAS f32x4*)(GC + c8) = (f32x4){gC[0], gC[1], gC[2], gC[3]}; *(LAS f32x4*)(GC + c8 + 4) = (f32x4){gC[4], gC[5], gC[6], gC[7]}; }
#pragma unroll
            for (int j = 0; j < 8; ++j) { g[j] = pre[j] * p[j]; ig[j] = __builtin_amdgcn_rcpf(g[j]); gp[j] = g[j] * __builtin_amdgcn_rcpf(wv[j]); }
        }
        f32x4 r0, r1;
        { const u32x4 cu = *(const u32x4*)(pr), pu = first ? zz : *(const u32x4*)(pr - NINP);
          const f32x4 m0 = *(const f32x4*)(mu + cr), m1 = *(const f32x4*)(mu + cr + 4); const f32x4 c0 = cvlo(cu), c1 = cvhi(cu), p0 = cvlo(pu), p1 = cvhi(pu);
          r0 = c0 + (p0 - c0) * m0; r1 = c1 + (p1 - c1) * m1;
          const float rt[8] = {r0.x * g[0], r0.y * g[1], r0.z * g[2], r0.w * g[3], r1.x * g[4], r1.y * g[5], r1.z * g[6], r1.w * g[7]};
          CK_ST_P(RT, CK_PK8(rt)); }
        { const u32x4 cu = *(const u32x4*)(pr + 1024), pu = first ? zz : *(const u32x4*)(pr - NINP + 1024);
          const f32x4 m0 = *(const f32x4*)(mu + 1024 + cr), m1 = *(const f32x4*)(mu + 1024 + cr + 4); const f32x4 c0 = cvlo(cu), c1 = cvhi(cu), p0 = cvlo(pu), p1 = cvhi(pu);
          const u32x4 uv = pk8(c0 + (p0 - c0) * m0, c1 + (p1 - c1) * m1); *(u32x4*)(SVo + (size_t)t * CW + cr) = uv; *(LAS u32x4*)(VV + voff(tl, c8)) = uv; }
        *(u32x4*)(SGo + (size_t)t * CW + cr) = *(const LAS u32x4*)(V2M + tl * 128 + c8 * 2);
        { const u32x4 cu = *(const u32x4*)(pr + 512), pu = first ? zz : *(const u32x4*)(pr - NINP + 512);
          const f32x4 m0 = *(const f32x4*)(mu + 512 + cr), m1 = *(const f32x4*)(mu + 512 + cr + 4); const f32x4 c0 = cvlo(cu), c1 = cvhi(cu), p0 = cvlo(pu), p1 = cvhi(pu);
          const f32x4 k0 = c0 + (p0 - c0) * m0, k1 = c1 + (p1 - c1) * m1;
          const u32x4 alu = *(const LAS u32x4*)(A2M + tl * 128 + c8 * 2); const f32x4 al0 = cvlo(alu), al1 = cvhi(alu);
          const f32x4 kk0 = k0 * *(const f32x4*)(a.in[9] + cr), kk1 = k1 * *(const f32x4*)(a.in[9] + cr + 4);
          const float ss = red8((kk0.x * kk0.x + kk0.y * kk0.y) + (kk0.z * kk0.z + kk0.w * kk0.w) + (kk1.x * kk1.x + kk1.y * kk1.y) + (kk1.z * kk1.z + kk1.w * kk1.w));
          const float inv = 1.0f / sqrtf(fmaxf(ss, 1e-24f));
          const f32x4 kn0 = kk0 * inv, kn1 = kk1 * inv;
          const f32x4 k20 = k0 * (1.0f + (al0 - 1.0f) * *(const f32x4*)(a.in[10] + cr)), k21 = k1 * (1.0f + (al1 - 1.0f) * *(const f32x4*)(a.in[10] + cr + 4));
          { const f32x4 q0 = r0 * k20 * *(const f32x4*)(a.in[11] + cr), q1 = r1 * k21 * *(const f32x4*)(a.in[11] + cr + 4);
            const float rk = red8((q0.x + q0.y) + (q0.z + q0.w) + (q1.x + q1.y) + (q1.z + q1.w));
            if ((lane & 7) == 0) ((float*)(ws + WS_RK))[(size_t)t * 8 + h] = rk; }
          const float kv[8] = {k20.x, k20.y, k20.z, k20.w, k21.x, k21.y, k21.z, k21.w}, nv[8] = {kn0.x, kn0.y, kn0.z, kn0.w, kn1.x, kn1.y, kn1.z, kn1.w}, av_[8] = {al0.x, al0.y, al0.z, al0.w, al1.x, al1.y, al1.z, al1.w};
          float at[8], bt[8], kt[8], bh[8], kh[8];
#pragma unroll
          for (int j = 0; j < 8; ++j) { at[j] = -nv[j] * gp[j]; bt[j] = nv[j] * av_[j] * ig[j]; kt[j] = kv[j] * ig[j]; bh[j] = bt[j] * gC[j]; kh[j] = kt[j] * gC[j]; }
          const u32x4 wa = CK_PK8(at);
          CK_ST_P(AP, wa); *(LAS u32x4*)(AT + voff(tl, c8)) = wa;
          CK_ST_P(BT, CK_PK8(bt)); CK_ST_P(KT, CK_PK8(kt));
          *(LAS u32x4*)(BH + voff(tl, c8)) = CK_PK8(bh); *(LAS u32x4*)(KH + voff(tl, c8)) = CK_PK8(kh); }
        { const u32x4 uq = *(const u32x4*)(pr + DQ0), ukd = *(const u32x4*)(pr + DK0);
          const f32x4 q0 = cvlo(uq), q1 = cvhi(uq), d0 = cvlo(ukd), d1 = cvhi(ukd);
          const float qs = red8((q0.x * q0.x + q0.y * q0.y) + (q0.z * q0.z + q0.w * q0.w) + (q1.x * q1.x + q1.y * q1.y) + (q1.z * q1.z + q1.w * q1.w));
          const float ks = red8((d0.x * d0.x + d0.y * d0.y) + (d0.z * d0.z + d0.w * d0.w) + (d1.x * d1.x + d1.y * d1.y) + (d1.z * d1.z + d1.w * d1.w));
          const float qi = (1.0f / sqrtf(qs * (1.0f / 64.0f) + 1e-5f)) * (0.125f * LOG2E), ki = 1.0f / sqrtf(ks * (1.0f / 64.0f) + 1e-5f);
          const f32x4 g0 = *(const f32x4*)(a.in[14] + c8), g1 = *(const f32x4*)(a.in[14] + c8 + 4), h0 = *(const f32x4*)(a.in[15] + c8), h1 = *(const f32x4*)(a.in[15] + c8 + 4);
          *(u32x4*)(QN + (size_t)t * CW + cr) = pk8(q0 * qi * g0, q1 * qi * g1);
          const size_t ko = ((((size_t)(b * 8 + h) * 64 + c) * 8 + (c8 >> 3)) * 64 + tl) * 8;
          *(u32x4*)(KN + ko) = pk8(d0 * ki * h0, d1 * ki * h1); }
#undef CK_PK8
#undef CK_ST_P
    }
    __syncthreads();
    CK_FRESH();
    f32x16 pa = f32x16{}, pb = f32x16{}, pc = f32x16{}, pd = f32x16{};
#define w1a pa
#define w1b pb
#define xb0 pa
#define xb1 pb
#define y0a pc
#define y0b pd
    if (wave < 2) {
        for (int k = 0; k < (wave == 0 ? 2 : 1); ++k) {
            const int sblk = wave == 0 ? k : 0, tblk = wave == 0 ? k : 1;
            const f32x16 x = score(BT, AP, sblk, tblk, wave == 0 ? 1 : 0, r32, hi);
            const int t = tblk * 32 + r32;
#pragma unroll
            for (int r = 0; r < 16; ++r) L[(sblk * 32 + crow(r, hi)) * LSTR + t] = x[r];
        }
    }
    __syncthreads();
    CK_FRESH();
    if (wave == 6) {
        float x[32];
#pragma unroll
        for (int t = 0; t < 32; ++t) x[t] = (r32 == t) ? 1.f : 0.f;
        const LAS float* Nr = L + (32 * hi) * LSTR + 32 * hi;
#pragma unroll
        for (int sidx = 0; sidx < 31; ++sidx) {
#pragma unroll
            for (int g4 = (sidx + 1) / 4; g4 < 8; ++g4) {
                const f32x4 nv = *(const LAS f32x4*)(Nr + sidx * LSTR + 4 * g4);
                if (4 * g4 + 0 > sidx) x[4 * g4 + 0] += nv.x * x[sidx];
                if (4 * g4 + 1 > sidx) x[4 * g4 + 1] += nv.y * x[sidx];
                if (4 * g4 + 2 > sidx) x[4 * g4 + 2] += nv.z * x[sidx];
                if (4 * g4 + 3 > sidx) x[4 * g4 + 3] += nv.w * x[sidx];
            }
            if ((sidx & 3) == 3) __builtin_amdgcn_sched_barrier(0);
        }
        const int cc = 32 * hi + r32;
#pragma unroll
        for (int t0 = 0; t0 < 32; t0 += 8) { u32x4 w; w.x = pk2(x[t0], x[t0 + 1]); w.y = pk2(x[t0 + 2], x[t0 + 3]); w.z = pk2(x[t0 + 4], x[t0 + 5]); w.w = pk2(x[t0 + 6], x[t0 + 7]);
            *(LAS u32x4*)(TN + voff(cc, 32 * hi + t0)) = w; }
        f32x16 m = f32x16{};
#pragma unroll
        for (int s = 0; s < 2; ++s) {
            const LAS float* lp = L + (16 * s + 4 * hi) * LSTR + 32 + r32;
            u32x4 aw; aw.x = pk2(lp[0], lp[LSTR]); aw.y = pk2(lp[2 * LSTR], lp[3 * LSTR]); aw.z = pk2(lp[8 * LSTR], lp[9 * LSTR]); aw.w = pk2(lp[10 * LSTR], lp[11 * LSTR]);
            const s16x4 b0 = *(const LAS s16x4*)(TN + voff(r32, 16 * s + 4 * hi)), b1 = *(const LAS s16x4*)(TN + voff(r32, 16 * s + 8 + 4 * hi));
            m = CK_MFMA(__builtin_bit_cast(bf16x8, aw), ((bf16x8){b0[0], b0[1], b0[2], b0[3], b1[0], b1[1], b1[2], b1[3]}), m);
        }
        f32x16 t21 = f32x16{};
#pragma unroll
        for (int s = 0; s < 2; ++s) t21 = CK_MFMA(fragT(TN, 32 + 16 * s, 1, lane, hi), packR(m, s), t21);
        storeT_V(TN, t21, 1, r32, hi);
    } else if (wave < 4) {
        const int dvb = wave - 2;
        const f32x16 x00 = score(KT, AP, 0, 0, 1, r32, hi), x01 = score(KT, AP, 0, 1, 0, r32, hi), x11 = score(KT, AP, 1, 1, 1, r32, hi);
#pragma unroll
        for (int s = 0; s < 2; ++s) {
            const bf16x8 v0 = fragT(VV, 16 * s, dvb, lane, hi), v1 = fragT(VV, 32 + 16 * s, dvb, lane, hi);
            w1a = CK_MFMA(packR(x00, s), v0, w1a);
            w1b = CK_MFMA(packR(x01, s), v0, w1b);
            w1b = CK_MFMA(packR(x11, s), v1, w1b);
        }
    } else if (wave < 6) {
        const int tb = wave - 4;
        f32x16 xk0, xk1 = f32x16{};
        if (tb == 0) { xk0 = score(KT, RT, 0, 0, 2, r32, hi); xb0 = score(BT, RT, 0, 0, 2, r32, hi); }
        else { xk0 = score(KT, RT, 0, 1, 0, r32, hi); xk1 = score(KT, RT, 1, 1, 2, r32, hi); xb0 = score(BT, RT, 0, 1, 0, r32, hi); xb1 = score(BT, RT, 1, 1, 2, r32, hi); }
#pragma unroll
        for (int s = 0; s < 2; ++s) {
            y0a = CK_MFMA(fragT(VV, 16 * s, 0, lane, hi), packR(xk0, s), y0a);
            y0b = CK_MFMA(fragT(VV, 16 * s, 1, lane, hi), packR(xk0, s), y0b);
            if (tb == 1) { y0a = CK_MFMA(fragT(VV, 32 + 16 * s, 0, lane, hi), packR(xk1, s), y0a); y0b = CK_MFMA(fragT(VV, 32 + 16 * s, 1, lane, hi), packR(xk1, s), y0b); }
        }
    }
    __syncthreads();
    CK_FRESH();
    if (wave < 2) {
        const int cb = wave; f32x16 a0 = f32x16{}, a1 = f32x16{};
#pragma unroll
        for (int ks = 0; ks < 4; ++ks) {
            const bf16x8 af = fragT(AT, 16 * ks, cb, lane, hi);
            if (ks < 2) a0 = CK_MFMA(af, fragT(TN, 16 * ks, 0, lane, hi), a0);
            a1 = CK_MFMA(af, fragT(TN, 16 * ks, 1, lane, hi), a1);
        }
        storeT_V(A2M, a0, cb, r32, hi); storeT_V(A2M, a1, cb, 32 + r32, hi);
    } else if (wave < 4) {
        const int dvb = wave - 2; f32x16 v0 = f32x16{}, v1 = f32x16{};
#pragma unroll
        for (int s = 0; s < 2; ++s) {
            v0 = CK_MFMA(packR(w1a, s), fragT(TN, 16 * s, 0, lane, hi), v0);
            v1 = CK_MFMA(packR(w1a, s), fragT(TN, 16 * s, 1, lane, hi), v1);
            v1 = CK_MFMA(packR(w1b, s), fragT(TN, 32 + 16 * s, 1, lane, hi), v1);
        }
        storeT_V(V2M, v0, dvb, r32, hi); storeT_V(V2M, v1, dvb, 32 + r32, hi);
    }
    __syncthreads();
    CK_FRESH();
    if (wave >= 4 && wave < 6) {
        const int tb = wave - 4, t = tb * 32 + r32;
        f32x16 r0 = f32x16{}, r1 = f32x16{};
#pragma unroll
        for (int s = 0; s < 2; ++s) {
            const bf16x8 p0 = packR(xb0, s);
            r0 = CK_MFMA(fragT(A2M, 16 * s, 0, lane, hi), p0, r0); r1 = CK_MFMA(fragT(A2M, 16 * s, 1, lane, hi), p0, r1);
            y0a = CK_MFMA(fragT(V2M, 16 * s, 0, lane, hi), p0, y0a); y0b = CK_MFMA(fragT(V2M, 16 * s, 1, lane, hi), p0, y0b);
            if (tb == 1) { const bf16x8 p1 = packR(xb1, s);
                r0 = CK_MFMA(fragT(A2M, 32 + 16 * s, 0, lane, hi), p1, r0); r1 = CK_MFMA(fragT(A2M, 32 + 16 * s, 1, lane, hi), p1, r1);
                y0a = CK_MFMA(fragT(V2M, 32 + 16 * s, 0, lane, hi), p1, y0a); y0b = CK_MFMA(fragT(V2M, 32 + 16 * s, 1, lane, hi), p1, y0b); }
        }
#pragma unroll
        for (int q = 0; q < 4; ++q) {
            const u32x2 u0 = *(const LAS u32x2*)(RT + t * PS + (8 * q + 4 * hi) * 2), u1 = *(const LAS u32x2*)(RT + t * PS + (32 + 8 * q + 4 * hi) * 2);
            r0[4 * q] += bflo(u0.x); r0[4 * q + 1] += bfhi(u0.x); r0[4 * q + 2] += bflo(u0.y); r0[4 * q + 3] += bfhi(u0.y);
            r1[4 * q] += bflo(u1.x); r1[4 * q + 1] += bfhi(u1.x); r1[4 * q + 2] += bflo(u1.y); r1[4 * q + 3] += bfhi(u1.y);
        }
        storeT_S(BT, r0, 0, t, hi); storeT_S(BT, r1, 1, t, hi);
        storeT_S(KT, y0a, 0, t, hi); storeT_S(KT, y0b, 1, t, hi);
    } else if (wave < 2) {
        const int ib = wave, i = ib * 32 + r32; const float gci = GC[i];
        f32x16 g0 = f32x16{}, g1 = f32x16{};
#pragma unroll
        for (int ks = 0; ks < 4; ++ks) { const bf16x8 bf_ = fragT(BH, 16 * ks, ib, lane, hi);
            g0 = CK_MFMA(fragT(A2M, 16 * ks, 0, lane, hi), bf_, g0); g1 = CK_MFMA(fragT(A2M, 16 * ks, 1, lane, hi), bf_, g1); }
#pragma unroll
        for (int r = 0; r < 16; ++r) { if (crow(r, hi) == i) g0[r] += gci; if (32 + crow(r, hi) == i) g1[r] += gci; }
        storeT_S(AP, g0, 0, i, hi); storeT_S(AP, g1, 1, i, hi);
    } else {
        const int id = wave < 4 ? wave - 2 : wave - 4, ib = id >> 1, dvb = id & 1;
        f32x16 hh = f32x16{};
#pragma unroll
        for (int ks = 0; ks < 4; ++ks) {
            hh = CK_MFMA(fragT(BH, 16 * ks, ib, lane, hi), fragT(V2M, 16 * ks, dvb, lane, hi), hh);
            hh = CK_MFMA(fragT(KH, 16 * ks, ib, lane, hi), fragT(VV, 16 * ks, dvb, lane, hi), hh);
        }
        storeT_S((LAS unsigned char*)L, hh, ib, dvb * 32 + r32, hi);
    }
    __syncthreads();
    {
        asm volatile("" : "+v"(tid));
        const int row = tid >> 3, ch = tid & 7;
        const LAS unsigned char* s0 = BT + row * PS + ch * 16; const LAS unsigned char* s1 = KT + row * PS + ch * 16; const LAS unsigned char* s2 = AP + row * PS + ch * 16; const LAS unsigned char* s3 = (const LAS unsigned char*)L + row * PS + ch * 16;
        const u32x2 a0 = *(const LAS u32x2*)s0, a1 = *(const LAS u32x2*)(s0 + 8), b0 = *(const LAS u32x2*)s1, b1 = *(const LAS u32x2*)(s1 + 8);
        const u32x2 c0 = *(const LAS u32x2*)s2, c1 = *(const LAS u32x2*)(s2 + 8), d0 = *(const LAS u32x2*)s3, d1 = *(const LAS u32x2*)(s3 + 8);
        *(u32x4*)(CR2 + row * 64 + ch * 8) = (u32x4){a0.x, a0.y, a1.x, a1.y}; *(u32x4*)(CY0 + row * 64 + ch * 8) = (u32x4){b0.x, b0.y, b1.x, b1.y};
        *(u32x4*)(CG + row * 64 + ch * 8) = (u32x4){c0.x, c0.y, c1.x, c1.y}; *(u32x4*)(CH + row * 64 + ch * 8) = (u32x4){d0.x, d0.y, d1.x, d1.y};
    }
    asm volatile("s_waitcnt lgkmcnt(0)" ::: "memory"); __builtin_amdgcn_s_barrier();
#undef CK_FRESH
#undef w1a
#undef w1b
#undef xb0
#undef xb1
#undef y0a
#undef y0b
}

__device__ __forceinline__ void fused_item(LAS unsigned char* lds, const Args& a, int bc) {
    const int tid = threadIdx.x, lane = tid & 63; const int wave = __builtin_amdgcn_readfirstlane(tid >> 6);
    unsigned char* ws = a.ws;
    const bf16_t* P = (const bf16_t*)(ws + WS_P); const bf16_t* LW = (const bf16_t*)(ws + WS_LW); const float* mu = a.in[3];
    const int b = bc >> 6, c = bc & 63, tokc = b * SEQ + c * 64;
    LAS unsigned char* ACT = lds + O_ACT; LAS unsigned char* DECb = lds + O_TN; LAS unsigned char* ALRb = lds + O_A2; LAS unsigned char* GGb = lds + O_V2;
    for (int it = tid; it < 1280; it += 512) {
        const int tok = it / 20, ch = it - tok * 20, t = tokc + tok, col = 1536 + ch * 8;
        const u32x4 cu = *(const u32x4*)(P + (size_t)t * NINP + col);
        u32x4 pu = (u32x4){0u, 0u, 0u, 0u};
        if (t & (SEQ - 1)) pu = *(const u32x4*)(P + (size_t)(t - 1) * NINP + col);
        const f32x4 m0 = *(const f32x4*)(mu + col), m1 = *(const f32x4*)(mu + col + 4);
        const f32x4 c0 = cvlo(cu), c1 = cvhi(cu), p0 = cvlo(pu), p1 = cvhi(pu);
        f32x4 s0 = c0 + (p0 - c0) * m0, s1 = c1 + (p1 - c1) * m1;
        if (ch < 4) {
#pragma unroll
            for (int i = 0; i < 4; ++i) { const float e0 = __expf(-2.0f * fabsf(s0[i])), e1 = __expf(-2.0f * fabsf(s1[i])); const float th0 = (1.0f - e0) / (1.0f + e0), th1 = (1.0f - e1) / (1.0f + e1);
                s0[i] = s0[i] < 0.f ? -th0 : th0; s1[i] = s1[i] < 0.f ? -th1 : th1; }
        } else if (ch >= 8) {
#pragma unroll
            for (int i = 0; i < 4; ++i) { s0[i] = sigmoidf_(s0[i]); s1[i] = sigmoidf_(s1[i]); }
        }
        *(LAS u32x4*)(ACT + tok * 320 + ch * 16) = pk8(s0, s1);
    }
    __syncthreads();
#pragma clang loop unroll(disable)
    for (int h = 0; h < 8; ++h) {
        {
            int ln = lane; asm volatile("" : "+v"(ln));
            const int mt = wave >> 1, fcol = ln & 15, fq = ln >> 4;
            bf16x8 af[5];
#pragma unroll
            for (int kb = 0; kb < 5; ++kb) af[kb] = *(const LAS bf16x8*)(ACT + (mt * 16 + fcol) * 320 + kb * 64 + fq * 16);
#pragma unroll
            for (int cbi = 0; cbi < 2; ++cbi) {
                const int cb = (wave & 1) * 2 + cbi, col = h * 64 + cb * 16 + fcol;
                const bf16_t* lw = LW + (size_t)col * 160 + fq * 8;
                const f32x4 z = {0.f, 0.f, 0.f, 0.f};
                const f32x4 aw = __builtin_amdgcn_mfma_f32_16x16x32_bf16(af[0], *(const bf16x8*)(lw), z, 0, 0, 0);
                const f32x4 aa = __builtin_amdgcn_mfma_f32_16x16x32_bf16(af[1], *(const bf16x8*)(lw + 32), z, 0, 0, 0);
                f32x4 ag = __builtin_amdgcn_mfma_f32_16x16x32_bf16(af[2], *(const bf16x8*)(lw + 64), z, 0, 0, 0);
                ag = __builtin_amdgcn_mfma_f32_16x16x32_bf16(af[3], *(const bf16x8*)(lw + 96), ag, 0, 0, 0);
                ag = __builtin_amdgcn_mfma_f32_16x16x32_bf16(af[4], *(const bf16x8*)(lw + 128), ag, 0, 0, 0);
                const float w0c = a.in[4][col], a0c = a.in[6][col];
#pragma unroll
                for (int i = 0; i < 4; ++i) { const int off = (mt * 16 + fq * 4 + i) * 128 + (cb * 16 + fcol) * 2;
                    *(LAS unsigned short*)(DECb + off) = (unsigned short)f2bf(-0.8750325887f * sigmoidf_(aw[i] + w0c));
                    *(LAS unsigned short*)(ALRb + off) = (unsigned short)f2bf(sigmoidf_(aa[i] + a0c));
                    *(LAS unsigned short*)(GGb + off) = (unsigned short)f2bf(ag[i]); }
            }
        }
        __syncthreads();
        chunk_item(lds, a, ((b * 8 + h) << 6) + c);
    }
}
}

namespace ck {
constexpr int SQ_MAT = 8704, SQ_BUF = 6 * SQ_MAT;
constexpr int SQ_OUT = 2 * SQ_BUF;
__device__ __forceinline__ bf16x8 lfrag(const LAS unsigned char* M, int row, int k0, int hi) { return fragP(M, row, k0, hi); }
__device__ __forceinline__ void linit(f32x16& x, const LAS unsigned char* M, int row, int cblk, int hi) {
#pragma unroll
    for (int q = 0; q < 4; ++q) { const u32x2 u = *(const LAS u32x2*)(M + row * PS + (cblk * 32 + 8 * q + 4 * hi) * 2); x[4 * q] = bflo(u.x); x[4 * q + 1] = bfhi(u.x); x[4 * q + 2] = bflo(u.y); x[4 * q + 3] = bfhi(u.y); }
}
__device__ __forceinline__ void seq_head(LAS unsigned char* lds, const Args& a, int bh) {
    const int tid = threadIdx.x, lane = tid & 63, r32 = lane & 31, hi = lane >> 5; const int wave = __builtin_amdgcn_readfirstlane(tid >> 6);
    unsigned char* ws = a.ws;
    const bf16_t* SV = (const bf16_t*)(ws + WS_SV); const bf16_t* SG = (const bf16_t*)(ws + WS_SG); const float* RK = (const float*)(ws + WS_RK); bf16_t* YMIX = (bf16_t*)(ws + WS_YMIX);
    const int b = bh >> 3, h = bh & 7, col0 = h * 64;
    const float* lng = a.in[12] + col0; const float* lnb = a.in[13] + col0;
    const int lw = wave - 2;
    const bf16_t* lsrc; int lpitch;
    { const size_t it0 = (size_t)bh * 64 * 4096; const size_t tk0 = (size_t)b * SEQ * CW + col0;
      lsrc = lw == 0 ? (const bf16_t*)(ws + WS_CG) + it0 : lw == 1 ? (const bf16_t*)(ws + WS_CH) + it0 : lw == 2 ? (const bf16_t*)(ws + WS_CR2) + it0 : lw == 3 ? (const bf16_t*)(ws + WS_CY0) + it0 : lw == 4 ? SV + tk0 : SG + tk0;
      lpitch = lw < 4 ? 64 : CW; }
#define SQ_LOAD(ch) do { const bf16_t* s_ = lsrc + (size_t)(ch) * 64 * lpitch; LAS unsigned char* bb_ = lds + ((ch) & 1) * SQ_BUF + lw * SQ_MAT; u32x4 v_[8]; \
        _Pragma("unroll") for (int i_ = 0; i_ < 8; ++i_) { const int q_ = lane + 64 * i_; v_[i_] = *(const u32x4*)(s_ + (size_t)(q_ >> 3) * lpitch + (q_ & 7) * 8); } \
        _Pragma("unroll") for (int i_ = 0; i_ < 8; ++i_) { const int q_ = lane + 64 * i_; LAS unsigned char* d_ = bb_ + (q_ >> 3) * PS + (q_ & 7) * 16; *(LAS u32x2*)d_ = (u32x2){v_[i_].x, v_[i_].y}; *(LAS u32x2*)(d_ + 8) = (u32x2){v_[i_].z, v_[i_].w}; } } while (0)
#define SQ_STORE(ch) do { const LAS unsigned char* ob_ = lds + SQ_OUT + ((ch) & 1) * SQ_MAT; const size_t t0_ = (size_t)b * SEQ + (ch) * 64; \
        for (int p_ = tid - 128; p_ < 512; p_ += 384) { const int row_ = p_ >> 3, c8_ = (p_ & 7) * 8; const LAS unsigned char* s_ = ob_ + row_ * PS + c8_ * 2; \
            const u32x2 lo_ = *(const LAS u32x2*)s_, hi_ = *(const LAS u32x2*)(s_ + 8); *(u32x4*)(YMIX + (t0_ + row_) * D + col0 + c8_) = (u32x4){lo_.x, lo_.y, hi_.x, hi_.y}; } } while (0)
    if (wave >= 2) SQ_LOAD(0);
    __syncthreads();
    f32x16 X00 = f32x16{}, X01 = f32x16{}, X10 = f32x16{}, X11 = f32x16{};
#pragma unroll 1
    for (int c = 0; c < 64; ++c) {
        if (wave >= 2) {
            if (c + 1 < 64) SQ_LOAD(c + 1);
            if (c > 0) SQ_STORE(c - 1);
        } else {
            const int tb = wave;
            const LAS unsigned char* bb = lds + (c & 1) * SQ_BUF;
            const LAS unsigned char* MG = bb; const LAS unsigned char* MH = bb + SQ_MAT; const LAS unsigned char* MR = bb + 2 * SQ_MAT; const LAS unsigned char* MY = bb + 3 * SQ_MAT;
            const LAS unsigned char* MV = bb + 4 * SQ_MAT; const LAS unsigned char* MGT = bb + 5 * SQ_MAT;
            LAS unsigned char* OB = lds + SQ_OUT + (c & 1) * SQ_MAT;
            const int tl = tb * 32 + r32; const size_t t = (size_t)b * SEQ + c * 64 + tl;
            const float rk = RK[t * 8 + h];
            f32x16 y0, y1; linit(y0, MY, tl, 0, hi); linit(y1, MY, tl, 1, hi);
#pragma unroll
            for (int s = 0; s < 2; ++s) {
                const bf16x8 rf0 = lfrag(MR, tl, 16 * s, hi), rf1 = lfrag(MR, tl, 32 + 16 * s, hi);
                y0 = CK_MFMA(packR(X00, s), rf0, y0); y0 = CK_MFMA(packR(X10, s), rf1, y0);
                y1 = CK_MFMA(packR(X01, s), rf0, y1); y1 = CK_MFMA(packR(X11, s), rf1, y1);
            }
#pragma unroll
            for (int db = 0; db < 2; ++db) {
                f32x16 Na, Nb; linit(Na, MH, db * 32 + r32, 0, hi); linit(Nb, MH, db * 32 + r32, 1, hi);
#pragma unroll
                for (int s = 0; s < 2; ++s) {
                    const bf16x8 g00 = lfrag(MG, r32, 16 * s, hi), g01 = lfrag(MG, r32, 32 + 16 * s, hi), g10 = lfrag(MG, 32 + r32, 16 * s, hi), g11 = lfrag(MG, 32 + r32, 32 + 16 * s, hi);
                    const bf16x8 p0 = packR(db ? X01 : X00, s), p1 = packR(db ? X11 : X10, s);
                    Na = CK_MFMA(g00, p0, Na); Na = CK_MFMA(g01, p1, Na);
                    Nb = CK_MFMA(g10, p0, Nb); Nb = CK_MFMA(g11, p1, Nb);
                }
                if (db == 0) { X00 = Na; X10 = Nb; } else { X01 = Na; X11 = Nb; }
            }
            float sm = 0.f;
#pragma unroll
            for (int r = 0; r < 16; ++r) sm += y0[r] + y1[r];
            sm += __shfl_xor(sm, 32);
            const float mean = sm * (1.0f / 64.0f);
            float sq = 0.f;
#pragma unroll
            for (int r = 0; r < 16; ++r) { const float d0 = y0[r] - mean, d1 = y1[r] - mean; sq += d0 * d0 + d1 * d1; }
            sq += __shfl_xor(sq, 32);
            const float rs = 1.0f / sqrtf(sq * (1.0f / 64.0f) + 64e-5f);
#pragma unroll
            for (int db = 0; db < 2; ++db)
#pragma unroll
                for (int q = 0; q < 4; ++q) {
                    const int dv = db * 32 + 8 * q + 4 * hi;
                    const f32x4 lg = *(const f32x4*)(lng + dv), lb = *(const f32x4*)(lnb + dv);
                    const u32x2 uv = *(const LAS u32x2*)(MV + tl * PS + dv * 2), ug = *(const LAS u32x2*)(MGT + tl * PS + dv * 2);
                    const f32x4 vv = {bflo(uv.x), bfhi(uv.x), bflo(uv.y), bfhi(uv.y)}, gg = {bflo(ug.x), bfhi(ug.x), bflo(ug.y), bfhi(ug.y)};
                    f32x4 yy; if (db == 0) yy = (f32x4){y0[4 * q], y0[4 * q + 1], y0[4 * q + 2], y0[4 * q + 3]}; else yy = (f32x4){y1[4 * q], y1[4 * q + 1], y1[4 * q + 2], y1[4 * q + 3]};
                    const f32x4 o = ((yy - mean) * rs * lg + lb + rk * vv) * gg;
                    u32x2 w; w.x = pk2(o.x, o.y); w.y = pk2(o.z, o.w);
                    *(LAS u32x2*)(OB + tl * PS + dv * 2) = w;
                }
        }
        __syncthreads();
    }
    if (wave >= 2) SQ_STORE(63);
#undef SQ_LOAD
#undef SQ_STORE
}
}

namespace att {
constexpr int SLOT = 32768, OFF_V = 16384;
constexpr int TBL_OFF = MISC_OFF + 1024;
constexpr int LW_OFF = MISC_OFF + 2048;
constexpr int CST_OFF = MISC_OFF + 3072;
__device__ __forceinline__ int crow(int r, int hi) { return (r & 3) + 8 * (r >> 2) + 4 * hi; }
__device__ __forceinline__ void glds16(const void* gsrc, unsigned lds_dst) { unsigned keep;
    asm volatile("s_mov_b32 %0, m0\n\ts_mov_b32 m0, %2\n\ts_nop 0\n\tglobal_load_lds_dwordx4 %1, off\n\ts_mov_b32 m0, %0" : "=&s"(keep) : "v"(gsrc), "s"(lds_dst) : "memory"); }
__device__ __forceinline__ s16x4 vtr(const LAS unsigned char* p) { return __builtin_bit_cast(s16x4, __builtin_amdgcn_ds_read_tr16_b64_v4i16((LAS s16x4*)p)); }

__device__ __forceinline__ void attn_unit(LAS unsigned char* lds, const Args& a, int b, int h, int qb, float negM, float lam) {
    const int tid = threadIdx.x, lane = tid & 63, r32 = lane & 31, hi = lane >> 5; const int wid = __builtin_amdgcn_readfirstlane(tid >> 6);
    const int c = wid >> 2, rg = wid & 3;
    unsigned char* ws = a.ws;
    const bf16_t* QN = (const bf16_t*)(ws + WS_QN); const bf16_t* KN = (const bf16_t*)(ws + WS_KN); const bf16_t* P = (const bf16_t*)(ws + WS_P); bf16_t* YMIX = (bf16_t*)(ws + WS_YMIX);
    const int q0 = qb * 128; const size_t rowbase = (size_t)b * SEQ;
    const int NT = 2 * qb + 2;
    LAS float* tbl = (LAS float*)(lds + TBL_OFF); LAS float* lw = (LAS float*)(lds + LW_OFF) + wid * 32;
    if (tid < 128) {
        const int n = tid; int bkt;
        if (n < 16) bkt = n; else { bkt = 16 + (int)(logf((float)n * (1.0f / 16.0f)) / 2.0794415416798357f * 16.0f); bkt = bkt > 31 ? 31 : bkt; }
        tbl[n] = (a.in[21][bkt * 4 + h] - a.in[21][31 * 4 + h]) * LOG2E;
    }
    const bf16_t* Qw = QN + (rowbase + q0 + rg * 32 + r32) * CW + h * 128 + c * 64;
    bf16x8 qr[4];
#pragma unroll
    for (int d0 = 0; d0 < 4; ++d0) qr[d0] = *(const bf16x8*)(Qw + d0 * 16 + hi * 8);
    const bf16_t* k0src = KN + ((((size_t)(b * 8 + h * 2) * 64) * 8 + wid) * 64 + lane) * 8;
    const bf16_t* k1src = k0src + (size_t)64 * 8 * 64 * 8;
    const int pv0 = 2 * wid, pv1 = 2 * wid + 1;
    const bf16_t* VTb = (const bf16_t*)(ws + WS_VT) + (size_t)(b * 4 + h) * 64 * 8192;
    const bf16_t* v0src = VTb + pv0 * 512 + lane * 8;
    const bf16_t* v1src = VTb + pv1 * 512 + lane * 8;
#define ATT_DMA(t, slot) do { const unsigned s_ = lds0 + (unsigned)(slot) * SLOT; \
        glds16(k0src + (size_t)(t) * 4096, (unsigned)__builtin_amdgcn_readfirstlane(s_ + wid * 1024)); \
        glds16(k1src + (size_t)(t) * 4096, (unsigned)__builtin_amdgcn_readfirstlane(s_ + 8192 + wid * 1024)); \
        glds16(v0src + (size_t)(t) * 8192, (unsigned)__builtin_amdgcn_readfirstlane(s_ + OFF_V + pv0 * 1024)); \
        glds16(v1src + (size_t)(t) * 8192, (unsigned)__builtin_amdgcn_readfirstlane(s_ + OFF_V + pv1 * 1024)); } while (0)
#define ATT_SBAR() __builtin_amdgcn_sched_barrier(0)
    const unsigned lds0 = (unsigned)(uintptr_t)lds;
    f32x16 o[4];
#pragma unroll
    for (int d0 = 0; d0 < 4; ++d0) o[d0] = f32x16{};
    float lsum = 0.f;
    const bool shift = negM < -60.0f;
    const int qmin = q0 + 32 * rg, qpos = qmin + r32;
    ATT_DMA(0, 0);
    asm volatile("s_waitcnt vmcnt(0)" ::: "memory");
    __syncthreads();
    for (int t = 0; t < NT; ++t) {
        if (t + 1 < NT) ATT_DMA(t + 1, (t + 1) & 1);
        const int kmin = 64 * t;
        if (kmin <= qmin + 31) {
            const LAS unsigned char* slot = lds + (t & 1) * SLOT;
            const LAS unsigned char* kb = slot + c * 8192 + hi * 1024 + r32 * 16;
            const LAS unsigned char* vb = slot + OFF_V + ((lane >> 4) & 1) * 32 + (lane & 3) * 8 + (4 * hi + ((lane & 15) >> 2)) * 64;
            bf16x8 kf[8];
#pragma unroll
            for (int d0 = 0; d0 < 4; ++d0) { kf[2 * d0] = *(const LAS bf16x8*)(kb + d0 * 2048); kf[2 * d0 + 1] = *(const LAS bf16x8*)(kb + d0 * 2048 + 512); }
            s16x4 va[16], vc[16];
#pragma unroll
            for (int i = 0; i < 8; ++i) { va[2 * i] = vtr(vb + (i >> 2) * 4096 + (i & 3) * 1024); va[2 * i + 1] = vtr(vb + (i >> 2) * 4096 + (i & 3) * 1024 + 512); }
            ATT_SBAR();
            f32x16 p0, p1;
            p0 = __builtin_amdgcn_mfma_f32_32x32x16_bf16(kf[0], qr[0], f32x16{}, 0, 0, 0); p1 = __builtin_amdgcn_mfma_f32_32x32x16_bf16(kf[1], qr[0], f32x16{}, 0, 0, 0);
#pragma unroll
            for (int d0 = 1; d0 < 4; ++d0) { p0 = __builtin_amdgcn_mfma_f32_32x32x16_bf16(kf[2 * d0], qr[d0], p0, 0, 0, 0); p1 = __builtin_amdgcn_mfma_f32_32x32x16_bf16(kf[2 * d0 + 1], qr[d0], p1, 0, 0, 0); }
            ATT_SBAR();
            if (qmin - (kmin + 63) < 113) {
#pragma unroll
                for (int r = 0; r < 16; ++r) {
                    const int d0_ = qpos - (kmin + crow(r, hi)); const int d1_ = d0_ - 32;
                    const float t0 = tbl[d0_ < 0 ? 0 : (d0_ > 127 ? 127 : d0_)], t1 = tbl[d1_ < 0 ? 0 : (d1_ > 127 ? 127 : d1_)];
                    p0[r] = d0_ < 0 ? -INFINITY : p0[r] + t0; p1[r] = d1_ < 0 ? -INFINITY : p1[r] + t1;
                }
            }
            if (shift) {
#pragma unroll
                for (int r = 0; r < 16; ++r) { p0[r] += negM; p1[r] += negM; }
            }
            float sacc = 0.f;
#pragma unroll
            for (int r = 0; r < 16; ++r) { p0[r] = __builtin_amdgcn_exp2f(p0[r]); p1[r] = __builtin_amdgcn_exp2f(p1[r]); sacc += p0[r] + p1[r]; }
            lsum += sacc;
            u32x4 pw[4];
#pragma unroll
            for (int i = 0; i < 4; ++i) { pw[0][i] = pk2(p0[2 * i], p0[2 * i + 1]); pw[1][i] = pk2(p0[8 + 2 * i], p0[8 + 2 * i + 1]); pw[2][i] = pk2(p1[2 * i], p1[2 * i + 1]); pw[3][i] = pk2(p1[8 + 2 * i], p1[8 + 2 * i + 1]); }
            ATT_SBAR();
#pragma unroll
            for (int i = 0; i < 8; ++i) { vc[2 * i] = vtr(vb + (2 + (i >> 2)) * 4096 + (i & 3) * 1024); vc[2 * i + 1] = vtr(vb + (2 + (i >> 2)) * 4096 + (i & 3) * 1024 + 512); }
#pragma unroll
            for (int i = 0; i < 8; ++i) {
                const bf16x8 vf = (bf16x8){va[2 * i][0], va[2 * i][1], va[2 * i][2], va[2 * i][3], va[2 * i + 1][0], va[2 * i + 1][1], va[2 * i + 1][2], va[2 * i + 1][3]};
                o[i >> 2] = __builtin_amdgcn_mfma_f32_32x32x16_bf16(__builtin_bit_cast(bf16x8, pw[i & 3]), vf, o[i >> 2], 0, 0, 0);
            }
#pragma unroll
            for (int i = 0; i < 8; ++i) {
                const bf16x8 vf = (bf16x8){vc[2 * i][0], vc[2 * i][1], vc[2 * i][2], vc[2 * i][3], vc[2 * i + 1][0], vc[2 * i + 1][1], vc[2 * i + 1][2], vc[2 * i + 1][3]};
                o[2 + (i >> 2)] = __builtin_amdgcn_mfma_f32_32x32x16_bf16(__builtin_bit_cast(bf16x8, pw[i & 3]), vf, o[2 + (i >> 2)], 0, 0, 0);
            }
        }
        asm volatile("s_waitcnt vmcnt(0)" ::: "memory");
        __syncthreads();
    }
#undef ATT_DMA
#undef ATT_SBAR
    lsum += __shfl_xor(lsum, 32);
    if (hi == 0) lw[r32] = 1.0f / lsum;
    asm volatile("s_waitcnt lgkmcnt(0)" ::: "memory");
    LAS float* stg = (LAS float*)(lds + wid * 16384);
#pragma unroll
    for (int r = 0; r < 16; ++r) { const int orow = crow(r, hi); const float il = lw[orow];
#pragma unroll
        for (int d0 = 0; d0 < 4; ++d0) stg[orow * 128 + d0 * 32 + r32] = o[d0][r] * il; }
    __syncthreads();
    {
        const int row = tid >> 2, part = tid & 3, rgp = row >> 5, rr = row & 31;
        const LAS float* s1 = (const LAS float*)(lds + rgp * 16384) + rr * 128 + part * 32;
        const LAS float* s2 = (const LAS float*)(lds + (4 + rgp) * 16384) + rr * 128 + part * 32;
        float dv[32]; float ss = 0.f;
#pragma unroll
        for (int i = 0; i < 8; ++i) { const f32x4 x1 = *(const LAS f32x4*)(s1 + 4 * i), x2 = *(const LAS f32x4*)(s2 + 4 * i);
#pragma unroll
            for (int j = 0; j < 4; ++j) { const float dd = x1[j] - lam * x2[j]; dv[4 * i + j] = dd; ss += dd * dd; } }
        ss = red4(ss);
        const float sc = (1.0f / sqrtf(ss * (1.0f / 128.0f) + 1e-5f)) * 0.8f;
        const float* sg = a.in[20] + part * 32;
        bf16_t* op = YMIX + (rowbase + q0 + row) * D + CW + h * 128 + part * 32;
#pragma unroll
        for (int i = 0; i < 4; ++i) { u32x4 w;
            w.x = pk2(dv[8 * i] * sc * sg[8 * i], dv[8 * i + 1] * sc * sg[8 * i + 1]); w.y = pk2(dv[8 * i + 2] * sc * sg[8 * i + 2], dv[8 * i + 3] * sc * sg[8 * i + 3]);
            w.z = pk2(dv[8 * i + 4] * sc * sg[8 * i + 4], dv[8 * i + 5] * sc * sg[8 * i + 5]); w.w = pk2(dv[8 * i + 6] * sc * sg[8 * i + 6], dv[8 * i + 7] * sc * sg[8 * i + 7]);
            *(u32x4*)(op + 8 * i) = w; }
    }
    __syncthreads();
}

__device__ __forceinline__ void attn_phase(LAS unsigned char* lds, const Args& a, unsigned* ctl) {
    const int tid = threadIdx.x;
    LAS float* cst = (LAS float*)(lds + CST_OFF);
    if (tid < 64) {
        const float gq = fabsf(a.in[14][tid]), gk = fabsf(a.in[15][tid]);
        float mq = gq, mk = gk;
#pragma unroll
        for (int o = 1; o < 64; o <<= 1) { mq = fmaxf(mq, __shfl_xor(mq, o)); mk = fmaxf(mk, __shfl_xor(mk, o)); }
        const float d1 = wave_sum(a.in[16][tid] * a.in[17][tid]), d2 = wave_sum(a.in[18][tid] * a.in[19][tid]);
        float mb = 0.f;
        if (tid < 32) { for (int hh = 0; hh < 4; ++hh) mb = fmaxf(mb, (a.in[21][tid * 4 + hh] - a.in[21][31 * 4 + hh]) * LOG2E); }
#pragma unroll
        for (int o = 1; o < 64; o <<= 1) mb = fmaxf(mb, __shfl_xor(mb, o));
        if (tid == 0) { cst[0] = -(8.0f * LOG2E * mq * mk * 1.02f + mb); cst[1] = __expf(d1) - __expf(d2) + 0.2f; }
    }
    __syncthreads();
    const float negM = cst[0], lam = cst[1];
    LAS int* ubox = (LAS int*)(lds + CST_OFF + 16);
    for (;;) {
        if (tid == 0) ubox[0] = (int)atomicAdd(ctl + CW_ATTQ, 1u);
        __syncthreads();
        const int u = __builtin_amdgcn_readfirstlane(ubox[0]);
        __syncthreads();
        if (u >= 1024 + CONV_ITEMS) break;
        const int qd = u / 5, rm = u - qd * 5;
        if (rm < 3) { conv_item(lds, a, qd * 3 + rm); continue; }
        const int au = qd * 2 + (rm - 3);
        const int qb = 31 - (au >> 5), bhh = au & 31;
        attn_unit(lds, a, bhh >> 2, bhh & 3, qb, negM, lam);
    }
}
}

__device__ __forceinline__ void p5_router(LAS unsigned char* lds, const Args& a, unsigned* ctl) {
    const int tid = threadIdx.x, lane = tid & 63, r32 = lane & 31, hi = lane >> 5; const int wave = __builtin_amdgcn_readfirstlane(tid >> 6);
    unsigned char* ws = a.ws;
    const bf16_t* x1 = (const bf16_t*)(ws + WS_X1B); const float* g2 = a.in[23]; const float* rw = a.in[24]; const float* rb = a.in[25];
    unsigned char* H2 = ws + WS_H2; int* EIDX = (int*)(ws + WS_EIDX); float* GATE = (float*)(ws + WS_GATE); int* POS = (int*)(ws + WS_POS);
    LAS unsigned char* WH = lds; LAS unsigned char* WL = lds + 65536;
    LAS int* cnt = (LAS int*)(lds + MISC_OFF + 1024);
    LAS int* basel = (LAS int*)(lds + MISC_OFF + 1024 + 128);
    LAS int* el = (LAS int*)(lds + MISC_OFF + 2048);
    LAS int* pl = (LAS int*)(lds + MISC_OFF + 4096);
    {
        const int e = tid & 31;
        for (int k = tid >> 5; k < 1024; k += 16) {
            const float v = rw[k * 32 + e] * g2[k]; const unsigned h = f2bf(v); const float vh = __builtin_bit_cast(float, h << 16); const unsigned l = f2bf(v - vh);
            const int off = e * 2048 + (((k >> 3) ^ (e & 15)) << 4) + (k & 7) * 2;
            *(LAS unsigned short*)(WH + off) = (unsigned short)h; *(LAS unsigned short*)(WL + off) = (unsigned short)l;
        }
    }
    if (tid < 32) cnt[tid] = 0;
    __syncthreads();
    const int TPB = T / (int)gridDim.x, tb0 = blockIdx.x * TPB;
    if (wave < 4) {
        const int tl = wave * 32 + r32, t = tb0 + tl;
        const bf16_t* xrow = x1 + (size_t)t * D + 8 * hi;
        const LAS unsigned char* wh = WH + r32 * 2048; const LAS unsigned char* wl = WL + r32 * 2048; const int sw = r32 & 15;
        f32x16 d = f32x16{}; float ssq = 0.f;
#pragma unroll 8
        for (int s = 0; s < 64; ++s) {
            const u32x4 xb = *(const u32x4*)(xrow + 16 * s);
            const int co = ((2 * s + hi) ^ sw) << 4;
            const bf16x8 ah = *(const LAS bf16x8*)(wh + co), al = *(const LAS bf16x8*)(wl + co);
            const bf16x8 bx = __builtin_bit_cast(bf16x8, xb);
            d = __builtin_amdgcn_mfma_f32_32x32x16_bf16(ah, bx, d, 0, 0, 0);
            d = __builtin_amdgcn_mfma_f32_32x32x16_bf16(al, bx, d, 0, 0, 0);
            const f32x4 x0 = cvlo(xb), x1v = cvhi(xb);
            ssq += (x0.x * x0.x + x0.y * x0.y) + (x0.z * x0.z + x0.w * x0.w) + (x1v.x * x1v.x + x1v.y * x1v.y) + (x1v.z * x1v.z + x1v.w * x1v.w);
        }
        ssq += __shfl_xor(ssq, 32);
        const float rstd = 1.0f / sqrtf(ssq * (1.0f / D) + 1e-5f);
        float lg[16];
#pragma unroll
        for (int r = 0; r < 16; ++r) lg[r] = d[r] * rstd + rb[8 * (r >> 2) + 4 * hi + (r & 3)];
        float tv[4]; int ti[4];
#pragma unroll
        for (int k = 0; k < 4; ++k) {
            float bv = -INFINITY; int bi = 0;
#pragma unroll
            for (int r = 0; r < 16; ++r) { const int e = 8 * (r >> 2) + 4 * hi + (r & 3); if (lg[r] > bv) { bv = lg[r]; bi = e; } }
            tv[k] = bv; ti[k] = bi;
#pragma unroll
            for (int r = 0; r < 16; ++r) { const int e = 8 * (r >> 2) + 4 * hi + (r & 3); if (e == bi) lg[r] = -INFINITY; }
        }
        float ov[4]; int oi[4];
#pragma unroll
        for (int k = 0; k < 4; ++k) { ov[k] = __shfl_xor(tv[k], 32); oi[k] = __shfl_xor(ti[k], 32); }
        float mv[4]; int mi[4];
        {
            int pa = 0, pb = 0;
#pragma unroll
            for (int k = 0; k < 4; ++k) {
                float ca = -INFINITY, cb = -INFINITY; int ia = 0, ib = 0;
#pragma unroll
                for (int q = 0; q < 4; ++q) { if (q == pa) { ca = tv[q]; ia = ti[q]; } if (q == pb) { cb = ov[q]; ib = oi[q]; } }
                const bool takeA = (ca > cb) || (ca == cb && ia < ib);
                mv[k] = takeA ? ca : cb; mi[k] = takeA ? ia : ib; pa += takeA ? 1 : 0; pb += takeA ? 0 : 1;
            }
        }
        const float e1 = __expf(mv[1] - mv[0]), e2 = __expf(mv[2] - mv[0]), e3 = __expf(mv[3] - mv[0]);
        const float inv = 1.0f / (1.0f + e1 + e2 + e3);
        if (hi == 0) {
            *(int4*)(EIDX + (size_t)t * 4) = make_int4(mi[0], mi[1], mi[2], mi[3]);
            *(float4*)(GATE + (size_t)t * 4) = make_float4(inv, e1 * inv, e2 * inv, e3 * inv);
#pragma unroll
            for (int k = 0; k < 4; ++k) { el[tl * 4 + k] = mi[k]; pl[tl * 4 + k] = atomicAdd((int*)(cnt + mi[k]), 1); }
        }
    } else {
        f32x4 gv[4];
#pragma unroll
        for (int j = 0; j < 4; ++j) gv[j] = *((const f32x4*)g2 + lane + 64 * j);
        for (int i = 0; i < 32; ++i) {
            const int t = tb0 + (wave - 4) * 32 + i;
            const u32x2* xr = (const u32x2*)(x1 + (size_t)t * D) + lane;
            f32x4 v[4]; float s = 0.f;
#pragma unroll
            for (int j = 0; j < 4; ++j) { const u32x2 xw = xr[64 * j]; v[j] = (f32x4){bflo(xw.x), bfhi(xw.x), bflo(xw.y), bfhi(xw.y)}; s += (v[j].x * v[j].x + v[j].y * v[j].y) + (v[j].z * v[j].z + v[j].w * v[j].w); }
            const float rstd = (1.0f / sqrtf(wave_sum(s) * (1.0f / D) + 1e-5f)) * F8_X_MUL;
            unsigned* o4 = (unsigned*)(H2 + (size_t)t * D) + lane;
#pragma unroll
            for (int j = 0; j < 4; ++j) { v[j] = v[j] * rstd * gv[j]; o4[64 * j] = pk4_fp8(v[j].x, v[j].y, v[j].z, v[j].w); }
        }
    }
    __syncthreads();
    if (tid < 32) basel[tid] = (int)atomicAdd(ctl + CW_CNT + tid, (unsigned)cnt[tid]);
    __syncthreads();
    for (int i = tid; i < TPB * 4; i += 512) POS[(size_t)tb0 * 4 + i] = pl[i] + basel[el[i]];
}

__device__ __forceinline__ void p6_dispatch(LAS unsigned char* lds, const Args& a, unsigned* ctl) {
    const int tid = threadIdx.x, lane = tid & 63, wave = __builtin_amdgcn_readfirstlane(tid >> 6);
    unsigned char* ws = a.ws;
    const int* EIDX = (const int*)(ws + WS_EIDX); const float* GATE = (const float*)(ws + WS_GATE); const int* POS = (const int*)(ws + WS_POS);
    int* DEST = (int*)(ws + WS_DEST); float* ROWGATE = (float*)(ws + WS_ROWGATE); int* TILEE = (int*)(ws + WS_TILEE); int* ROWTOK = (int*)(ws + WS_ROWTOK);
    LAS int* pstart = (LAS int*)(lds + MISC_OFF + 1024); LAS int* pcnt = pstart + 32;
    if (tid < NE) pcnt[tid] = (int)__hip_atomic_load(ctl + CW_CNT + tid, __ATOMIC_RELAXED, __HIP_MEMORY_SCOPE_AGENT);
    __syncthreads();
    if (tid == 0) {
        int acc = 0;
        for (int e = 0; e < NE; ++e) { pstart[e] = acc; acc += ((pcnt[e] + 255) >> 8) * 256; }
        if (blockIdx.x == 0) TILEE[1023] = acc >> 8;
    }
    __syncthreads();
    if (blockIdx.x == 0 && tid < NE) { const int nt = (pcnt[tid] + 255) >> 8, t0_ = pstart[tid] >> 8; for (int i = 0; i < nt; ++i) TILEE[t0_ + i] = tid; }
    if (blockIdx.x < NE) {
        const int e = blockIdx.x, cn = pcnt[e], pe = ((cn + 255) >> 8) * 256;
        for (int i = cn + tid; i < pe; i += 512) ROWTOK[pstart[e] + i] = 0;
    }
    const int TPB = T / (int)gridDim.x, tb0 = blockIdx.x * TPB;
    for (int pi = tb0 * 4 + tid; pi < (tb0 + TPB) * 4; pi += 512) {
        const int e = EIDX[pi], dest = pstart[e] + POS[pi];
        DEST[pi] = dest; ROWGATE[dest] = GATE[pi]; ROWTOK[dest] = pi >> 2;
    }
}

__device__ __forceinline__ void p9_combine(const Args& a, int G) {
    const int tid = threadIdx.x, lane = tid & 63, wave = __builtin_amdgcn_readfirstlane(tid >> 6);
    unsigned char* ws = a.ws;
    const unsigned char* YS = ws + WS_YS; const int* DEST = (const int*)(ws + WS_DEST);
    float* out = a.out;
    const int gw = blockIdx.x * 8 + wave, NGW = G * 8;
    for (int t = gw; t < T; t += NGW) {
        f32x4* xr = (f32x4*)(out + (size_t)t * D) + lane; const u32x2* xi = (const u32x2*)((const bf16_t*)(ws + WS_X1B) + (size_t)t * D) + lane;
        f32x4 v[4];
#pragma unroll
        for (int j = 0; j < 4; ++j) { const u32x2 xw = xi[64 * j]; v[j] = (f32x4){bflo(xw.x), bfhi(xw.x), bflo(xw.y), bfhi(xw.y)}; }
#pragma unroll
        for (int k = 0; k < 4; ++k) {
            const int dest = DEST[t * 4 + k];
            const unsigned* yr = (const unsigned*)(YS + (size_t)dest * D) + lane;
#pragma unroll
            for (int j = 0; j < 4; ++j) { const unsigned w = yr[64 * j];
                const f32x2 lo = __builtin_amdgcn_cvt_pk_f32_fp8((int)w, false), hi2 = __builtin_amdgcn_cvt_pk_f32_fp8((int)w, true);
                v[j].x += lo.x * (1.0f / F8_Y_MUL); v[j].y += lo.y * (1.0f / F8_Y_MUL); v[j].z += hi2.x * (1.0f / F8_Y_MUL); v[j].w += hi2.y * (1.0f / F8_Y_MUL); }
        }
        if (TIME_REGION >= 0) { const float sc_ = 1.0f + 4e-6f * (float)((const unsigned*)(ws + WS_CTL))[301];
#pragma unroll
            for (int j = 0; j < 4; ++j) v[j] = v[j] * sc_; }
#pragma unroll
        for (int j = 0; j < 4; ++j) xr[64 * j] = v[j];
    }
}

constexpr int NPHASE = 10;
__global__ void __launch_bounds__(512, 2) hymba_fwd(Args args) {
    extern __shared__ __attribute__((aligned(16))) unsigned char lds_raw[];
    LAS unsigned char* lds = (LAS unsigned char*)lds_raw;
    cg::grid_group grid = cg::this_grid();
    const int G = gridDim.x;
    unsigned char* ws = args.ws;
    unsigned* ctl = (unsigned*)(ws + WS_CTL);
    const int lo = args.ph_lo, hi = args.ph_hi;
#define IN(k) (lo <= (k) && (k) < hi)
#define NREP(k) ((REP_PHASE) == (k) ? 2 : 1)
#define TSTART(k) do { if ((TIME_REGION) == (k) && blockIdx.x == 0 && threadIdx.x == 0) ctl[300] = (unsigned)__builtin_amdgcn_s_memrealtime(); } while (0)
#define TEND(k) do { if ((TIME_REGION) == (k) && blockIdx.x == 0 && threadIdx.x == 0) ctl[301] = (unsigned)__builtin_amdgcn_s_memrealtime() - ctl[300]; } while (0)
#define SEAM(k) do { if (IN(k) && IN((k) + 1)) { if (args.ph_lo < 0) grid.sync(); xcd_barrier(xbar); } } while (0)
    const int* TILEE = (const int*)(ws + WS_TILEE);
    { volatile LAS unsigned* st = (volatile LAS unsigned*)(lds + LDS_BYTES - 64); if (threadIdx.x < 2) st[threadIdx.x] = 0u; }
    __syncthreads();
    const XcdBarrier xbar = xcd_barrier_post(ctl + CW_BAR, (volatile LAS unsigned*)(lds + LDS_BYTES - 64));

    if (IN(0)) { for (int rep = 0; rep < NREP(0); ++rep) p0_prologue(lds, args, G); } SEAM(0);
    if (IN(1)) {
        pg8::Gemm g{ws + WS_XN, ws + WS_WINT, 1024, 0, 0, nullptr};
        pg8::TileOrder S; S.init(T / 256, NINP / 256, G, (int)blockIdx.x, nullptr, 0, WGM_P1);
        pg8::EpiBf16 E{(bf16_t*)(ws + WS_P), NINP, (bf16_t*)(ws + WS_VT)};
        for (int rep = 0; rep < NREP(1); ++rep) pg8::gemm_phase<false, false>(lds, g, S, E);
    } SEAM(1);
    TSTART(2);
    if (IN(2)) {
        ck::fused_item(lds, args, (int)blockIdx.x * 2); ck::fused_item(lds, args, (int)blockIdx.x * 2 + 1);
    } SEAM(2);
    TSTART(3);
    if (IN(3)) {
        TSTART(30); for (int rep = 0; rep < NREP(30); ++rep) { if (blockIdx.x < 64) ck::seq_head(lds, args, (int)blockIdx.x); __syncthreads(); } TEND(30);
        for (int rep = 0; rep < NREP(31); ++rep) att::attn_phase(lds, args, ctl + 64 * rep);
    } SEAM(3); TEND(3);
    if (IN(4)) {
        pg8::Gemm g{ws + WS_YMIX, ws + WS_WOUT, 1024, 0, 0, nullptr};
        pg8::TileOrder S; S.init(T / 256, D / 256, G, (int)blockIdx.x, nullptr, 0, WGM_P4);
        pg8::EpiResBf16 E{args.in[0], (bf16_t*)(ws + WS_X1B), D};
        for (int rep = 0; rep < NREP(4); ++rep) pg8::gemm_phase<false, false>(lds, g, S, E);
    } SEAM(4);
    if (IN(5)) { _Pragma("clang loop unroll(disable)") for (int rep = 0; rep < NREP(5); ++rep) { p5_router(lds, args, ctl + 256 * (NREP(5) - 1 - rep)); __syncthreads(); } } SEAM(5);
    if (IN(6)) { for (int rep = 0; rep < NREP(6); ++rep) { p6_dispatch(lds, args, ctl); __syncthreads(); } } SEAM(6);
    if (IN(7)) {
        const int ntile = TILEE[1023];
        pg8::Gemm g{ws + WS_H2, ws + WS_W1T, 1024, F8_W_SC, F8_X_SC, (const int*)(ws + WS_ROWTOK)};
        pg8::TileOrder S; S.init(ntile, 8, G, (int)blockIdx.x, TILEE, 8, WGM_P7);
        pg8::EpiSwiglu E{ws + WS_HID, args.in[27], TILEE};
        for (int rep = 0; rep < NREP(7); ++rep) pg8::gemm_phase<true, true>(lds, g, S, E);
    } SEAM(7);
    if (IN(8)) {
        const int ntile = TILEE[1023];
        pg8::Gemm g{ws + WS_HID, ws + WS_W2T, 1024, F8_W_SC, F8_H_SC, nullptr};
        pg8::TileOrder S; S.init(ntile, 4, G, (int)blockIdx.x, TILEE, 4, WGM_P8);
        pg8::EpiGateF8 E{ws + WS_YS, args.in[29], (const float*)(ws + WS_ROWGATE), TILEE};
        for (int rep = 0; rep < NREP(8); ++rep) pg8::gemm_phase<true, false>(lds, g, S, E);
    } SEAM(8);
    if (IN(9)) { p9_combine(args, G); }
#undef IN
#undef SEAM
}

extern "C" void kernel_launch(void* const* d_in, const int* in_sizes, int n_in, void* d_out, int out_size, void* d_ws, size_t ws_size, hipStream_t stream) {
    static int grid = 0;
    if (grid == 0) {
        if (n_in != 30 || in_sizes[0] != T * D || out_size != T * D || ws_size < WS_END) { fprintf(stderr, "kernel_launch: unexpected shapes (n_in %d, in0 %d, out %d, ws %zu); nothing launched\n", n_in, n_in > 0 ? in_sizes[0] : -1, out_size, ws_size); grid = -1; return; }
        int dev = 0, cus = 0, per_cu = 0;
        if (hipGetDevice(&dev) != hipSuccess || hipDeviceGetAttribute(&cus, hipDeviceAttributeMultiprocessorCount, dev) != hipSuccess) { grid = -1; return; }
        if (hipFuncSetAttribute((const void*)hymba_fwd, hipFuncAttributeMaxDynamicSharedMemorySize, LDS_BYTES) != hipSuccess) { fprintf(stderr, "kernel_launch: hipFuncSetAttribute failed\n"); grid = -1; return; }
        if (hipOccupancyMaxActiveBlocksPerMultiprocessor(&per_cu, (const void*)hymba_fwd, 512, LDS_BYTES) != hipSuccess || per_cu < 1) { fprintf(stderr, "kernel_launch: occupancy query says %d\n", per_cu); per_cu = 1; }
        (void)hipGetLastError();
        grid = cus;
        if (grid > 256) grid = 256;
        if (grid != 256 || T % grid != 0 || (T / grid) % 16 != 0) { fprintf(stderr, "kernel_launch: grid %d does not divide the token count evenly\n", grid); grid = -1; return; }
    }
    if (grid < 0) return;
    (void)hipMemsetAsync((char*)d_ws + WS_CTL, 0, CTL_ZERO_BYTES, stream);
    Args a{};
    for (int i = 0; i < 30; ++i) a.in[i] = (const float*)d_in[i];
    a.out = (float*)d_out; a.ws = (unsigned char*)d_ws;
    constexpr int NL = MK_N_LAUNCHES;
    for (int li = 0; li < NL; ++li) {
        a.ph_lo = (NL == 1) ? 0 : li; a.ph_hi = (NL == 1) ? NPHASE : li + 1;
        void* kargs[] = {&a};
        hipError_t e = hipLaunchCooperativeKernel((const void*)hymba_fwd, dim3(grid), dim3(512), kargs, LDS_BYTES, stream);
        if (e != hipSuccess) { fprintf(stderr, "kernel_launch: cooperative launch %d failed: %s (grid %d)\n", li, hipGetErrorString(e), grid); break; }
    }
}
```

```cpp
#include <hip/hip_runtime.h>
#include <hip/hip_cooperative_groups.h>
#include <cstdio>
#include <cstdint>
#include <type_traits>
namespace cg = cooperative_groups;

#ifndef REP_PHASE
#define REP_PHASE -1
#endif
#ifndef TIME_REGION
#define TIME_REGION -1
#endif
#ifndef WGM_P1
#define WGM_P1 2
#endif
#ifndef WGM_P4
#define WGM_P4 2
#endif
#ifndef WGM_P7
#define WGM_P7 2
#endif
#ifndef WGM_P8
#define WGM_P8 2
#endif
#ifndef MK_N_LAUNCHES
#define MK_N_LAUNCHES 1
#endif

#define LAS __attribute__((address_space(3)))
#define GAS __attribute__((address_space(1)))
typedef unsigned short bf16_t;
typedef short bf16x8 __attribute__((ext_vector_type(8)));
typedef short s16x4 __attribute__((ext_vector_type(4)));
typedef float f32x2 __attribute__((ext_vector_type(2)));
typedef float f32x4 __attribute__((ext_vector_type(4)));
typedef float f32x16 __attribute__((ext_vector_type(16)));
typedef unsigned u32x2 __attribute__((ext_vector_type(2)));
typedef unsigned u32x4 __attribute__((ext_vector_type(4)));
typedef int v8i32 __attribute__((ext_vector_type(8)));

constexpr int NB = 8, SEQ = 4096, T = NB * SEQ, D = 1024;
constexpr int CW = 512;
constexpr int NRW = 1696, NIN = 3232, NINP = 3328;
constexpr int DQ0 = 1696, DK0 = 2208, DV0 = 2720;
constexpr int NE = 32, TOPK = 4, DE = 1024;
constexpr int MAXROWS = T * TOPK + NE * 256;
constexpr int MAXTILES = MAXROWS / 256;
constexpr float LOG2E = 1.4426950408889634f;
constexpr float F8_W_MUL = 32.f, F8_X_MUL = 8.f, F8_H_MUL = 4.f, F8_Y_MUL = 16.f; constexpr int F8_W_SC = 0x7A7A7A7A, F8_X_SC = 0x7C7C7C7C, F8_H_SC = 0x7D7D7D7D;

constexpr size_t MiB = 1u << 20;
constexpr size_t WS_CTL = 0, CTL_ZERO_BYTES = 64 * 1024;
constexpr size_t WS_TILEE = 512 * 1024;
constexpr size_t WS_LW = 576 * 1024;
constexpr size_t WS_WINT = 1 * MiB;
constexpr size_t WS_WOUT = 8 * MiB;
constexpr size_t WS_W1T = 10 * MiB;
constexpr size_t WS_W2T = 138 * MiB;
constexpr size_t WS_EIDX = 202 * MiB;
constexpr size_t WS_GATE = WS_EIDX + 512 * 1024;
constexpr size_t WS_POS = WS_GATE + 512 * 1024;
constexpr size_t WS_DEST = WS_POS + 512 * 1024;
constexpr size_t WS_ROWGATE = 204 * MiB;
constexpr size_t WS_XN = 206 * MiB;
constexpr size_t WS_P = 270 * MiB;
constexpr size_t WS_SR = 478 * MiB, WS_SK = 510 * MiB, WS_SV = 542 * MiB, WS_SA = 574 * MiB, WS_SB = 606 * MiB;
constexpr size_t WS_SW = 638 * MiB;
constexpr size_t WS_SG = 702 * MiB;
constexpr size_t WS_QN = 734 * MiB, WS_KN = 766 * MiB;
constexpr size_t WS_YMIX = 798 * MiB;
constexpr size_t WS_H2 = 206 * MiB;
constexpr size_t WS_ROWTOK = 270 * MiB;
constexpr size_t WS_HID = 406 * MiB;
constexpr size_t WS_YS = 542 * MiB;
constexpr size_t WS_X1B = 862 * MiB;
constexpr size_t WS_CG = 862 * MiB;
constexpr size_t WS_CH = 894 * MiB;
constexpr size_t WS_CR2 = 926 * MiB;
constexpr size_t WS_CY0 = 958 * MiB;
constexpr size_t WS_RK = 990 * MiB;
constexpr size_t WS_VT = 992 * MiB;
constexpr size_t WS_END = 1024 * MiB;
constexpr int CW_CNT = 64;
constexpr int CW_ATTQ = 128;
constexpr int CW_BAR = 4096;

constexpr int RING_BYTES = 131072, MISC_OFF = RING_BYTES, LDS_BYTES = 147456;

__device__ __forceinline__ unsigned f2bf(float f) { unsigned u = __builtin_bit_cast(unsigned, f); return (u + 0x7fffu + ((u >> 16) & 1u)) >> 16; }
typedef __bf16 hwbf16x2 __attribute__((ext_vector_type(2)));
__device__ __forceinline__ unsigned pk2(float lo, float hi) { const f32x2 v = {lo, hi}; return __builtin_bit_cast(unsigned, __builtin_convertvector(v, hwbf16x2)); }
__device__ __forceinline__ unsigned pk4_fp8(float a, float b, float c, float d) {
    a = fminf(fmaxf(a, -448.f), 448.f); b = fminf(fmaxf(b, -448.f), 448.f); c = fminf(fmaxf(c, -448.f), 448.f); d = fminf(fmaxf(d, -448.f), 448.f);
    int r = __builtin_amdgcn_cvt_pk_fp8_f32(a, b, 0, false); r = __builtin_amdgcn_cvt_pk_fp8_f32(c, d, r, true); return (unsigned)r; }
__device__ __forceinline__ float bf2f(unsigned short b) { return __builtin_bit_cast(float, (unsigned)b << 16); }
__device__ __forceinline__ float bflo(unsigned w) { return __builtin_bit_cast(float, w << 16); }
__device__ __forceinline__ float bfhi(unsigned w) { return __builtin_bit_cast(float, w & 0xffff0000u); }
__device__ __forceinline__ float wave_sum(float v) {
#pragma unroll
    for (int o = 1; o < 64; o <<= 1) v += __shfl_xor(v, o);
    return v;
}
__device__ __forceinline__ float sigmoidf_(float x) { return 1.0f / (1.0f + __expf(-x)); }
template <int CTRL> __device__ __forceinline__ float dpp_f(float v) { return __builtin_bit_cast(float, __builtin_amdgcn_update_dpp(0, __builtin_bit_cast(int, v), CTRL, 0xF, 0xF, true)); }
__device__ __forceinline__ float red8(float v) {
    v += dpp_f<0xB1>(v);
    v += dpp_f<0x4E>(v);
    v += dpp_f<0x141>(v);
    return v;
}
__device__ __forceinline__ float red4(float v) { v += dpp_f<0xB1>(v); v += dpp_f<0x4E>(v); return v; }


#define XB_TMO      128
#define XB_XCNT(j)  (256  + 64 * (j))
#define XB_XSUB(j)  (1280 + 64 * (j))
#define XB_XGEN(j)  (2304 + 64 * (j))
#define XB_TOP      3328
#define XB_TOPGEN   3392
#define XCD_BAR_WORDS 3456
#define XB_SPIN_CAP (1u << 18)
__device__ __forceinline__ unsigned xb_ld(unsigned* p)              { return __hip_atomic_load(p, __ATOMIC_RELAXED, __HIP_MEMORY_SCOPE_AGENT); }
__device__ __forceinline__ unsigned xb_add(unsigned* p, unsigned v) { return __hip_atomic_fetch_add(p, v, __ATOMIC_RELAXED, __HIP_MEMORY_SCOPE_AGENT); }
__device__ __forceinline__ unsigned xb_xcc_id() { return (unsigned)__builtin_amdgcn_s_getreg((3 << 11) | 20) & 0xFu; }
#define XB_SPIN(cond, bar) do { unsigned _sp = 0; while (cond) { __builtin_amdgcn_s_sleep(1); \
    if ((++_sp & 255u) == 0u) { if (xb_ld(&(bar)[XB_TMO])) break; if (_sp > XB_SPIN_CAP) { atomicAdd(&(bar)[XB_TMO], 1u); break; } } } } while (0)
struct XcdBarrier { unsigned* bar; unsigned x; volatile LAS unsigned* st; };
__device__ __forceinline__ XcdBarrier xcd_barrier_post(unsigned* bar, volatile LAS unsigned* st) {
    XcdBarrier b; b.bar = bar; b.x = xb_xcc_id(); b.st = st;
    if (threadIdx.x == 0) (void)xb_add(&bar[XB_XCNT(b.x)], 1u);
    return b;
}
__device__ __forceinline__ void xcd_barrier_complete(unsigned* bar, unsigned x, unsigned& nloc, unsigned& nx) {
    const unsigned G = gridDim.x * gridDim.y * gridDim.z;
    unsigned sum, cnt, mine, sp = 0u;
    for (;;) {
        sum = 0u; cnt = 0u; mine = 0u;
#pragma unroll
        for (unsigned j = 0; j < 16; ++j) { const unsigned c = xb_ld(&bar[XB_XCNT(j)]); sum += c; cnt += (c > 0u) ? 1u : 0u; mine = (j == x) ? c : mine; }
        if (sum == G) break;
        __builtin_amdgcn_s_sleep(1);
        if ((++sp & 255u) == 0u) { if (xb_ld(&bar[XB_TMO])) break; if (sp > XB_SPIN_CAP) { atomicAdd(&bar[XB_TMO], 1u); break; } }
    }
    nloc = mine > 0u ? mine : 1u; nx = cnt > 0u ? cnt : 1u;
}
__device__ __forceinline__ void xcd_barrier(const XcdBarrier& b) {
    asm volatile("s_waitcnt vmcnt(0)" ::: "memory");
    __syncthreads();
    if (threadIdx.x == 0) {
        unsigned* bar = b.bar;
        __builtin_amdgcn_s_waitcnt(0);
        unsigned nloc = b.st[0], nx = b.st[1];
        if (nloc == 0u) { xcd_barrier_complete(bar, b.x, nloc, nx); b.st[0] = nloc; b.st[1] = nx; }
        const unsigned old = xb_add(&bar[XB_XSUB(b.x)], 1u);
        const unsigned gen = old / nloc;
        if (old + 1u == (gen + 1u) * nloc) {
            __builtin_amdgcn_fence(__ATOMIC_RELEASE, "agent");
            asm volatile("s_waitcnt vmcnt(0)" ::: "memory");
            const unsigned og = xb_add(&bar[XB_TOP], 1u);
            const unsigned tg = og / nx;
            if (og + 1u == (tg + 1u) * nx) xb_add(&bar[XB_TOPGEN], 1u);
            else XB_SPIN(xb_ld(&bar[XB_TOPGEN]) == tg, bar);
            __builtin_amdgcn_fence(__ATOMIC_ACQUIRE, "agent");
            xb_add(&bar[XB_XGEN(b.x)], 1u);
            asm volatile("s_waitcnt vmcnt(0)" ::: "memory");
        } else {
            XB_SPIN(xb_ld(&bar[XB_XGEN(b.x)]) == gen, bar);
            __builtin_amdgcn_fence(__ATOMIC_ACQUIRE, "agent");
            asm volatile("s_waitcnt vmcnt(0)" ::: "memory");
        }
    }
    __syncthreads();
}

namespace pg8 {
constexpr int BM = 256, BK = 64, HALF = 128, HTB = HALF * BK * 2, STAGE_BYTES = 8 * HTB, NXCD = 8;
__host__ __device__ __forceinline__ int lds_byte(int r, int c) { const int st = (r >> 4) * 2 + (c >> 5), rr = r & 15, cc = c & 31, ob = rr * 64 + cc * 2; return st * 1024 + (ob ^ (((ob >> 9) & 1) << 5)); }
__host__ __device__ __forceinline__ void stage_rc(int b, int& R, int& C) { const int st = b / 1024, sb = b % 1024, swz = sb ^ (((sb >> 9) & 1) << 5); R = (st >> 1) * 16 + swz / 64; C = (st & 1) * 32 + (swz % 64) / 2; }
__host__ __device__ __forceinline__ int f8_swz(int fr) { return ((fr >> 1) & 3) | ((((fr + 4) >> 3) & 1) << 2); }
__host__ __device__ __forceinline__ void stage_rc_f8(int b, int& R, int& C) { const int p = b >> 10, l = (b >> 4) & 63, fr = (p & 1) * 8 + (l >> 3); R = (p >> 1) * 16 + fr; C = ((l & 7) ^ f8_swz(fr)) * 8; }
__host__ __device__ __forceinline__ int frag_f8(int row0, int fr, int fq, int j) { return (row0 >> 4) * 2048 + (fr >> 3) * 1024 + (fr & 7) * 128 + (((2 * fq + j) ^ f8_swz(fr)) * 16); }
__host__ __device__ __forceinline__ int perm32(int rho) { const int n = rho >> 4, i = rho & 15; return 8 * (i >> 2) + 4 * n + (i & 3); }

struct Unit { int pm, pn, pb; };
struct Gemm { const void* A; const void* Bt; int K; int scW, scA; const int* rowtok; };

struct TileOrder {
    int nM, nN, nwg, G, c, WGM; const int* tile_e; int nb_per_e;
    __device__ void init(int nM_, int nN_, int G_, int c_, const int* te, int nbe, int wgm) { nM = nM_; nN = nN_; nwg = nM * nN; G = G_; c = c_; tile_e = te; nb_per_e = nbe; WGM = wgm; }
    __device__ bool next(int i, Unit& u) const {
        const long L = (long)i * G + c; if (L >= nwg) return false;
        int wgid = (int)L; { const int q = nwg / NXCD, r = nwg % NXCD, xcd = wgid % NXCD, off = wgid / NXCD; wgid = (xcd < r ? xcd * (q + 1) : r * (q + 1) + (xcd - r) * q) + off; }
        const int nig = WGM * nN, gid = wgid / nig, fm = gid * WGM, gsz = (nM - fm) < WGM ? (nM - fm) : WGM;
        u.pm = fm + ((wgid % nig) % gsz); u.pn = (wgid % nig) / gsz;
        u.pb = tile_e ? tile_e[u.pm] * nb_per_e + u.pn : u.pn;
        return true;
    }
};

struct EpiBf16 {
    static constexpr bool PERM = true;
    bf16_t* O; int ldc; bf16_t* VT;
    __device__ __forceinline__ void operator()(const f32x4 (&acc)[2][2][4][2], const Unit& u, int wr, int wc, int fr, int fq) const {
        const int row0 = u.pm * BM + wr * 64 + fr; const int col0 = u.pn * BM + wc * 32 + 8 * fq;
#pragma unroll
        for (int ai = 0; ai < 2; ++ai)
#pragma unroll
            for (int m = 0; m < 4; ++m) { const int t = row0 + ai * HALF + m * 16; bf16_t* rowp = O + (size_t)t * ldc + col0;
#pragma unroll
                for (int bj = 0; bj < 2; ++bj) { const f32x4 v0 = acc[ai][bj][m][0], v1 = acc[ai][bj][m][1];
                    u32x4 w; w.x = pk2(v0[0], v0[1]); w.y = pk2(v0[2], v0[3]); w.z = pk2(v1[0], v1[1]); w.w = pk2(v1[2], v1[3]);
                    const int col = col0 + bj * HALF;
                    if (col >= DV0) { const int dvf = col - DV0, hh = dvf >> 7, dv = dvf & 127, tp = t & (SEQ - 1), key = tp & 63;
                        bf16_t* vp = VT + (((((size_t)((t >> 12) * 4 + hh) * 64 + (tp >> 6)) * 4 + (dv >> 5)) * 4 + (key >> 4)) * 16 + (key & 15)) * 32 + (dv & 31);
                        if (col < NIN) *(u32x4*)vp = w; }
                    else *(u32x4*)(rowp + bj * HALF) = w; } }
    }
};
struct EpiResBf16 {
    static constexpr bool PERM = true;
    const float* base; bf16_t* out; int ldc;
    __device__ __forceinline__ void operator()(const f32x4 (&acc)[2][2][4][2], const Unit& u, int wr, int wc, int fr, int fq) const {
        const int col0 = u.pn * BM + wc * 32 + 8 * fq;
#pragma unroll
        for (int ai = 0; ai < 2; ++ai) {
            f32x4 bb[4][2][2];
#pragma unroll
            for (int m = 0; m < 4; ++m) { const size_t off = (size_t)(u.pm * BM + ai * HALF + wr * 64 + m * 16 + fr) * ldc + col0;
#pragma unroll
                for (int bj = 0; bj < 2; ++bj) { bb[m][bj][0] = *(const f32x4*)(base + off + bj * HALF); bb[m][bj][1] = *(const f32x4*)(base + off + bj * HALF + 4); } }
            __builtin_amdgcn_sched_barrier(0);
#pragma unroll
            for (int m = 0; m < 4; ++m) { const size_t off = (size_t)(u.pm * BM + ai * HALF + wr * 64 + m * 16 + fr) * ldc + col0;
#pragma unroll
                for (int bj = 0; bj < 2; ++bj) {
                    const f32x4 v0 = bb[m][bj][0] + acc[ai][bj][m][0], v1 = bb[m][bj][1] + acc[ai][bj][m][1];
                    u32x4 w; w.x = pk2(v0[0], v0[1]); w.y = pk2(v0[2], v0[3]); w.z = pk2(v1[0], v1[1]); w.w = pk2(v1[2], v1[3]);
                    *(u32x4*)(out + off + bj * HALF) = w; } }
            __builtin_amdgcn_sched_barrier(0);
        }
    }
};
struct EpiSwiglu {
    static constexpr bool PERM = true;
    unsigned char* O; const float* b1; const int* tile_e;
    __device__ __forceinline__ void operator()(const f32x4 (&acc)[2][2][4][2], const Unit& u, int wr, int wc, int fr, int fq) const {
        const int e = tile_e[u.pm]; const int row0 = u.pm * BM + wr * 64 + fr; const int hc0 = u.pn * 128 + wc * 32 + 8 * fq;
        const float* bg = b1 + (size_t)e * 2048 + hc0; const float* bl = bg + 1024;
        const f32x4 g0 = *(const f32x4*)bg, g1 = *(const f32x4*)(bg + 4), l0 = *(const f32x4*)bl, l1 = *(const f32x4*)(bl + 4);
#pragma unroll
        for (int ai = 0; ai < 2; ++ai)
#pragma unroll
            for (int m = 0; m < 4; ++m) { unsigned char* rowp = O + (size_t)(row0 + ai * HALF + m * 16) * 1024 + hc0;
                float o[8];
#pragma unroll
                for (int n = 0; n < 2; ++n) { const f32x4 gv = acc[ai][0][m][n] + (n ? g1 : g0), lv = acc[ai][1][m][n] + (n ? l1 : l0);
#pragma unroll
                    for (int i = 0; i < 4; ++i) { const float g = fminf(gv[i], 7.0f), l = fminf(fmaxf(lv[i], -7.0f), 7.0f);
                        const float sg = __builtin_amdgcn_rcpf(1.0f + __builtin_amdgcn_exp2f(-1.702f * LOG2E * g)); o[n * 4 + i] = g * sg * (l + 1.0f); } }
                u32x2 w; w.x = pk4_fp8(o[0] * F8_H_MUL, o[1] * F8_H_MUL, o[2] * F8_H_MUL, o[3] * F8_H_MUL); w.y = pk4_fp8(o[4] * F8_H_MUL, o[5] * F8_H_MUL, o[6] * F8_H_MUL, o[7] * F8_H_MUL);
                *(u32x2*)rowp = w; }
    }
};
struct EpiGateF8 {
    static constexpr bool PERM = true;
    unsigned char* O; const float* b2; const float* rowgate; const int* tile_e;
    __device__ __forceinline__ void operator()(const f32x4 (&acc)[2][2][4][2], const Unit& u, int wr, int wc, int fr, int fq) const {
        const int e = tile_e[u.pm]; const int row0 = u.pm * BM + wr * 64 + fr; const int col0 = u.pn * BM + wc * 32 + 8 * fq;
        f32x4 bv[2][2];
#pragma unroll
        for (int bj = 0; bj < 2; ++bj)
#pragma unroll
            for (int n = 0; n < 2; ++n) bv[bj][n] = *(const f32x4*)(b2 + (size_t)e * 1024 + col0 + bj * HALF + 4 * n);
#pragma unroll
        for (int ai = 0; ai < 2; ++ai)
#pragma unroll
            for (int m = 0; m < 4; ++m) { const int row = row0 + ai * HALF + m * 16; const float gt = rowgate[row] * F8_Y_MUL; unsigned char* rowp = O + (size_t)row * 1024 + col0;
#pragma unroll
                for (int bj = 0; bj < 2; ++bj) { const f32x4 v0 = (acc[ai][bj][m][0] + bv[bj][0]) * gt, v1 = (acc[ai][bj][m][1] + bv[bj][1]) * gt;
                    u32x2 w; w.x = pk4_fp8(v0[0], v0[1], v0[2], v0[3]); w.y = pk4_fp8(v1[0], v1[1], v1[2], v1[3]);
                    *(u32x2*)(rowp + bj * HALF) = w; } }
    }
};

__device__ __forceinline__ v8i32 pg8_ld32(const LAS unsigned char* p, const LAS unsigned char* q) { const u32x4 a = *(const LAS u32x4*)p, b = *(const LAS u32x4*)q;
    return (v8i32){(int)a.x, (int)a.y, (int)a.z, (int)a.w, (int)b.x, (int)b.y, (int)b.z, (int)b.w}; }
template <bool F8, bool GATHER, class Epi, class Sched>
__device__ __forceinline__ void gemm_phase(LAS unsigned char* lds, const Gemm g, const Sched& S, const Epi& E) {
    const int tid = threadIdx.x, wid = __builtin_amdgcn_readfirstlane(tid >> 6), lane = tid & 63, wr = wid >> 2, wc = wid & 3, fr = lane & 15, fq = lane >> 4;
    const int RB = F8 ? g.K : g.K * 2, nt = RB / 128;
    unsigned voffB[2];
#pragma unroll
    for (int i = 0; i < 2; ++i) { int R, C; if constexpr (F8) stage_rc_f8(tid * 16 + i * 8192, R, C); else stage_rc(tid * 16 + i * 8192, R, C); const int Rb = Epi::PERM ? ((R & ~31) + perm32(R & 31)) : R;
        voffB[i] = (unsigned)(Rb * RB + C * 2); }
#define PG8_AOFFS(dst, pm_) do { _Pragma("unroll") for (int h_ = 0; h_ < 2; ++h_) _Pragma("unroll") for (int i_ = 0; i_ < 2; ++i_) { int R_, C_; if constexpr (F8) stage_rc_f8(tid * 16 + i_ * 8192, R_, C_); else stage_rc(tid * 16 + i_ * 8192, R_, C_); \
        const int row_ = (pm_) * BM + h_ * HALF + R_; const unsigned grow_ = GATHER ? (unsigned)g.rowtok[row_] : (unsigned)row_; dst[h_][i_] = grow_ * (unsigned)RB + (unsigned)(C_ * 2); } } while (0)
    unsigned cvA[2][2], nvA[2][2];
    const size_t kstep = (size_t)(BK * 2);
    const size_t hstep = (size_t)HALF * RB;
    const size_t tstep = 2 * hstep;
    const unsigned ldsw = (unsigned)wid * 1024u;
    const int aoff = F8 ? frag_f8(wr * 64, fr, fq, 0) : lds_byte(wr * 64 + fr, fq * 8); const int aoff1 = F8 ? frag_f8(wr * 64, fr, fq, 1) : 0;
    const int boff = F8 ? frag_f8(wc * 32, fr, fq, 0) : lds_byte(wc * 32 + fr, fq * 8); const int boff1 = F8 ? frag_f8(wc * 32, fr, fq, 1) : 0;
    const int scW = g.scW, scA = g.scA;
#define PG8_SA(b, h) (((b) * 2 + (h)) * HTB)
#define PG8_SB(b, h) ((4 + (b) * 2 + (h)) * HTB)
#define PG8_STAGE(bufoff, gbase, voff) do { _Pragma("unroll") for (int _i = 0; _i < 2; ++_i) \
        __builtin_amdgcn_global_load_lds((const unsigned*)((const char*)(gbase) + (voff)[_i]), (LAS unsigned*)(lds + (bufoff) + ldsw + _i * 8192), 16, 0, 0); } while (0)
typedef int v8i32a __attribute__((ext_vector_type(8), aligned(16)));
#define PG8_LD32(p, q) pg8_ld32(p, q)
#define PG8_STAGE_A(bufoff, kptr, offs) do { _Pragma("unroll") for (int _i = 0; _i < 2; ++_i) \
        __builtin_amdgcn_global_load_lds((const unsigned*)((const char*)(kptr) + (offs)[_i]), (LAS unsigned*)(lds + (bufoff) + ldsw + _i * 8192), 16, 0, 0); } while (0)
#define PG8_LDA(dst, b, h) do { _Pragma("unroll") for (int m = 0; m < 4; ++m) { if constexpr (F8) { dst[m].f8 = PG8_LD32(lds + PG8_SA(b, h) + aoff + m * 2048, lds + PG8_SA(b, h) + aoff1 + m * 2048); } \
        else { _Pragma("unroll") for (int k = 0; k < 2; ++k) dst[m].hv[k] = *(const LAS bf16x8*)(lds + PG8_SA(b, h) + aoff + m * 2048 + k * 1024); } } } while (0)
#define PG8_LDB(dst, b, h) do { _Pragma("unroll") for (int n = 0; n < 2; ++n) { if constexpr (F8) { dst[n].f8 = PG8_LD32(lds + PG8_SB(b, h) + boff + n * 2048, lds + PG8_SB(b, h) + boff1 + n * 2048); } \
        else { _Pragma("unroll") for (int k = 0; k < 2; ++k) dst[n].hv[k] = *(const LAS bf16x8*)(lds + PG8_SB(b, h) + boff + n * 2048 + k * 1024); } } } while (0)
#define PG8_MMA(ai, bj, At, Bt) do { __builtin_amdgcn_s_setprio(1); _Pragma("unroll") for (int m = 0; m < 4; ++m) _Pragma("unroll") for (int n = 0; n < 2; ++n) { \
        if constexpr (F8) { asm volatile("v_mfma_scale_f32_16x16x128_f8f6f4 %0, %1, %2, %0, %3, %4 op_sel_hi:[0,0,0]" : "+v"(acc[ai][bj][m][n]) : "v"(Bt[n].f8), "v"(At[m].f8), "v"(scW), "v"(scA)); } \
        else { _Pragma("unroll") for (int k = 0; k < 2; ++k) acc[ai][bj][m][n] = __builtin_amdgcn_mfma_f32_16x16x32_bf16(Bt[n].hv[k], At[m].hv[k], acc[ai][bj][m][n], 0, 0, 0); } } \
        __builtin_amdgcn_s_setprio(0); } while (0)
#define PG8_WAIT_V(n) asm volatile("s_waitcnt vmcnt(" #n ")" ::: "memory")
#define PG8_WAIT_L(n) asm volatile("s_waitcnt lgkmcnt(" #n ")" ::: "memory")
#define PG8_BAR __builtin_amdgcn_s_barrier()
#define PG8_SCHED __builtin_amdgcn_sched_barrier(0)
    Unit cur, nxt; int ui = 0;
    if (!S.next(0, cur)) return;
    f32x4 acc[2][2][4][2];
#pragma unroll
    for (int a = 0; a < 2; ++a)
#pragma unroll
        for (int b = 0; b < 2; ++b)
#pragma unroll
            for (int m = 0; m < 4; ++m)
#pragma unroll
                for (int n = 0; n < 2; ++n) acc[a][b][m][n] = (f32x4){0.f, 0.f, 0.f, 0.f};
    struct FragH { bf16x8 hv[2]; }; struct Frag8 { v8i32 f8; };
    typename std::conditional<F8, Frag8, FragH>::type At[4], B0[2], B1[2];
    const char* const kA = (const char*)g.A; const char* cB = (const char*)g.Bt + (size_t)cur.pb * tstep;
    PG8_AOFFS(cvA, cur.pm);
    PG8_STAGE(PG8_SB(0, 0), cB, voffB); PG8_STAGE(PG8_SB(0, 1), cB + hstep, voffB); PG8_STAGE_A(PG8_SA(0, 0), kA, cvA[0]); PG8_STAGE_A(PG8_SA(0, 1), kA, cvA[1]);
    if (wr == 1) PG8_BAR;
    PG8_WAIT_V(2); PG8_BAR;
    PG8_STAGE(PG8_SB(1, 0), cB + kstep, voffB); PG8_STAGE_A(PG8_SA(1, 0), kA + kstep, cvA[0]); PG8_STAGE(PG8_SB(1, 1), cB + hstep + kstep, voffB);
    PG8_WAIT_V(6); PG8_BAR;
    for (;;) {
        const bool has_next = S.next(ui + 1, nxt);
        const char* nB = has_next ? (const char*)g.Bt + (size_t)nxt.pb * tstep : cB;
        if (has_next) { PG8_AOFFS(nvA, nxt.pm); } else { _Pragma("unroll") for (int h_ = 0; h_ < 2; ++h_) _Pragma("unroll") for (int i_ = 0; i_ < 2; ++i_) nvA[h_][i_] = cvA[h_][i_]; }
#pragma clang loop unroll(disable)
        for (int t = 0; t < nt; t += 2) {
            const bool last = (t == nt - 2);
            const char* a1 = kA + (size_t)(t + 1) * kstep;
            const char* a2 = last ? kA : kA + (size_t)(t + 2) * kstep; const char* b2 = last ? nB : cB + (size_t)(t + 2) * kstep;
            const char* a3 = a2 + kstep; const char* b3 = b2 + kstep;
            unsigned v2A[2][2];
#pragma unroll
            for (int h_ = 0; h_ < 2; ++h_)
#pragma unroll
                for (int i_ = 0; i_ < 2; ++i_) v2A[h_][i_] = last ? nvA[h_][i_] : cvA[h_][i_];
            PG8_LDB(B0, 0, 0); PG8_LDB(B1, 0, 1); PG8_SCHED; PG8_LDA(At, 0, 0); PG8_STAGE_A(PG8_SA(1, 1), a1, cvA[1]);
            PG8_WAIT_V(8); PG8_WAIT_L(0); PG8_BAR; PG8_MMA(0, 0, At, B0); PG8_MMA(0, 1, At, B1); PG8_BAR; PG8_SCHED;
            PG8_LDA(At, 0, 1); PG8_STAGE(PG8_SB(0, 0), b2, voffB); PG8_STAGE(PG8_SB(0, 1), b2 + hstep, voffB); PG8_STAGE_A(PG8_SA(0, 0), a2, v2A[0]);
            PG8_WAIT_V(8); PG8_WAIT_L(0); PG8_BAR; PG8_MMA(1, 0, At, B0); PG8_MMA(1, 1, At, B1); PG8_BAR; PG8_SCHED;
            PG8_LDB(B0, 1, 0); PG8_LDB(B1, 1, 1); PG8_SCHED; PG8_LDA(At, 1, 0); PG8_STAGE_A(PG8_SA(0, 1), a2, v2A[1]);
            PG8_WAIT_V(8); PG8_WAIT_L(0); PG8_BAR; PG8_MMA(0, 0, At, B0); PG8_MMA(0, 1, At, B1); PG8_BAR; PG8_SCHED;
            PG8_LDA(At, 1, 1); PG8_STAGE(PG8_SB(1, 0), b3, voffB); PG8_STAGE(PG8_SB(1, 1), b3 + hstep, voffB); PG8_STAGE_A(PG8_SA(1, 0), a3, v2A[0]);
            PG8_WAIT_V(8); PG8_WAIT_L(0); PG8_BAR; PG8_MMA(1, 0, At, B0); PG8_MMA(1, 1, At, B1); PG8_BAR; PG8_SCHED;
        }
        if (wr == 0) PG8_BAR;
        if constexpr (F8) asm volatile("s_nop 15\n\ts_nop 15" ::: "memory");
        E(acc, cur, wr, wc, fr, fq);
        if (!has_next) break;
#pragma unroll
        for (int a = 0; a < 2; ++a)
#pragma unroll
            for (int b = 0; b < 2; ++b)
#pragma unroll
                for (int m = 0; m < 4; ++m)
#pragma unroll
                    for (int n = 0; n < 2; ++n) acc[a][b][m][n] = (f32x4){0.f, 0.f, 0.f, 0.f};
        cur = nxt; cB = nB; ++ui;
#pragma unroll
        for (int h_ = 0; h_ < 2; ++h_)
#pragma unroll
            for (int i_ = 0; i_ < 2; ++i_) cvA[h_][i_] = nvA[h_][i_];
        if (wr == 1) PG8_BAR;
    }
    PG8_WAIT_V(0);
    PG8_BAR;
#undef PG8_SA
#undef PG8_SB
#undef PG8_STAGE
#undef PG8_STAGE_A
#undef PG8_AOFFS
#undef PG8_LDA
#undef PG8_LDB
#undef PG8_MMA
#undef PG8_LD32
#undef PG8_WAIT_V
#undef PG8_WAIT_L
#undef PG8_BAR
#undef PG8_SCHED
}
}

struct Args { const float* in[30]; float* out; unsigned char* ws; int ph_lo, ph_hi; };

__device__ __forceinline__ void p0_transpose_item(const float* W, int K, int N, bf16_t* WT, int k0, int n0, int drow0, LAS float* scr, int lane) {
#pragma unroll 8
    for (int i = 0; i < 32; ++i) { const int kk = 2 * i + (lane >> 5); scr[kk * 33 + (lane & 31)] = W[(size_t)(k0 + kk) * N + n0 + (lane & 31)]; }
    asm volatile("s_waitcnt lgkmcnt(0)" ::: "memory");
    const int c = lane & 7;
#pragma unroll
    for (int j = 0; j < 4; ++j) { const int n = (lane >> 3) + 8 * j; const LAS float* s = scr + (8 * c) * 33 + n;
        u32x4 o; o.x = pk2(s[0 * 33], s[1 * 33]); o.y = pk2(s[2 * 33], s[3 * 33]); o.z = pk2(s[4 * 33], s[5 * 33]); o.w = pk2(s[6 * 33], s[7 * 33]);
        *(u32x4*)(WT + (size_t)(drow0 + n) * K + k0 + 8 * c) = o; }
    asm volatile("s_waitcnt lgkmcnt(0)" ::: "memory");
}
__device__ __forceinline__ void p0_transpose_item_f8(const float* W, int K, int N, unsigned char* WT, int k0, int n0, int drow0, LAS float* scr, int lane) {
    LAS unsigned* tile = (LAS unsigned*)scr;
    const float* src = W + (size_t)k0 * N + n0 + lane;
#pragma unroll 1
    for (int kb = 0; kb < 32; kb += 16) {
        float v[16][4];
#pragma unroll
        for (int i = 0; i < 16; ++i) { const float* p = src + (size_t)(4 * (kb + i)) * N;
#pragma unroll
            for (int j = 0; j < 4; ++j) v[i][j] = __builtin_nontemporal_load(p + (size_t)j * N); }
        __builtin_amdgcn_sched_barrier(0);
#pragma unroll
        for (int i = 0; i < 16; ++i) tile[lane * 33 + kb + i] = pk4_fp8(v[i][0] * F8_W_MUL, v[i][1] * F8_W_MUL, v[i][2] * F8_W_MUL, v[i][3] * F8_W_MUL);
        __builtin_amdgcn_sched_barrier(0);
    }
    asm volatile("s_waitcnt lgkmcnt(0)" ::: "memory");
    const int c = lane & 7;
#pragma unroll
    for (int j = 0; j < 8; ++j) { const int n = (lane >> 3) + 8 * j; const LAS unsigned* t = tile + n * 33 + 4 * c;
        __builtin_nontemporal_store((u32x4){t[0], t[1], t[2], t[3]}, (u32x4*)(WT + (size_t)(drow0 + n) * K + k0 + 16 * c)); }
    asm volatile("s_waitcnt lgkmcnt(0)" ::: "memory");
}
constexpr int CONV_I_W1 = 8 * 32, CONV_I_W2 = 8 * 16;
constexpr int CONV_ITEMS = NE * (CONV_I_W1 + CONV_I_W2) / 8;
__device__ __forceinline__ void conv_item(LAS unsigned char* lds, const Args& a, int bi) {
    const int lane = threadIdx.x & 63, wave = __builtin_amdgcn_readfirstlane(threadIdx.x >> 6);
    LAS float* scr = (LAS float*)(lds + wave * 16384);
    unsigned char* W1t = a.ws + WS_W1T; unsigned char* W2t = a.ws + WS_W2T;
    int r = bi * 8 + wave;
    if (r < NE * CONV_I_W1) { const int e = r / CONV_I_W1, q = r % CONV_I_W1, kb = q / 32, nb = q % 32; const int n0 = 64 * nb;
        const int drow = (n0 < 1024) ? ((n0 >> 7) * 256 + (n0 & 127)) : (((n0 - 1024) >> 7) * 256 + 128 + ((n0 - 1024) & 127));
        p0_transpose_item_f8(a.in[26] + (size_t)e * 1024 * 2048, 1024, 2048, W1t + (size_t)e * 2048 * 1024, 128 * kb, n0, drow, scr, lane); }
    else { r -= NE * CONV_I_W1; const int e = r / CONV_I_W2, q = r % CONV_I_W2, kb = q / 16, nb = q % 16;
        p0_transpose_item_f8(a.in[28] + (size_t)e * 1024 * 1024, 1024, 1024, W2t + (size_t)e * 1024 * 1024, 128 * kb, 64 * nb, 64 * nb, scr, lane); }
}
__device__ __forceinline__ void p0_prologue(LAS unsigned char* lds, const Args& a, int G) {
    const int tid = threadIdx.x, lane = tid & 63, wave = __builtin_amdgcn_readfirstlane(tid >> 6);
    LAS float* scr = (LAS float*)(lds + wave * 16384);
    const int gw = blockIdx.x * 8 + wave, NGW = G * 8;
    unsigned char* ws = a.ws;
    bf16_t* Wint = (bf16_t*)(ws + WS_WINT); bf16_t* Woutt = (bf16_t*)(ws + WS_WOUT);
    constexpr int I_IN = 16 * (NIN / 32);
    constexpr int I_OUT = 16 * 32;
    constexpr int NITEMS = I_IN + I_OUT;
    for (int it = gw; it < NITEMS; it += NGW) {
        int r = it;
        if (r < I_IN) { const int nblk = NIN / 32, kb = r / nblk, nb = r % nblk; p0_transpose_item(a.in[2], 1024, NIN, Wint, 64 * kb, 32 * nb, 32 * nb, scr, lane); continue; } r -= I_IN;
        { const int kb = r / 32, nb = r % 32; p0_transpose_item(a.in[22], 1024, 1024, Woutt, 64 * kb, 32 * nb, 32 * nb, scr, lane); }
    }
    { bf16_t* LW = (bf16_t*)(ws + WS_LW);
      for (int i = gw * 64 + lane; i < CW * 160; i += NGW * 64) { const int col = i / 160, k = i - col * 160;
          const float v = k < 32 ? a.in[5][k * CW + col] : (k < 64 ? a.in[7][(k - 32) * CW + col] : a.in[8][(k - 64) * CW + col]); LW[i] = (bf16_t)f2bf(v); } }
    const float* x = a.in[0]; const float* g1 = a.in[1]; bf16_t* XN = (bf16_t*)(ws + WS_XN);
    f32x4 gv[4];
#pragma unroll
    for (int j = 0; j < 4; ++j) gv[j] = *((const f32x4*)g1 + lane + 64 * j);
#pragma unroll 4
    for (int m = gw; m < T; m += NGW) {
        const f32x4* xr = (const f32x4*)(x + (size_t)m * D) + lane;
        f32x4 v[4]; float s = 0.f;
#pragma unroll
        for (int j = 0; j < 4; ++j) { v[j] = xr[64 * j]; s += (v[j].x * v[j].x + v[j].y * v[j].y) + (v[j].z * v[j].z + v[j].w * v[j].w); }
        const float rstd = 1.0f / sqrtf(wave_sum(s) * (1.0f / D) + 1e-5f);
        u32x2* o8 = (u32x2*)(XN + (size_t)m * D) + lane;
#pragma unroll
        for (int j = 0; j < 4; ++j) { u32x2 w; w.x = pk2(v[j].x * rstd * gv[j].x, v[j].y * rstd * gv[j].y); w.y = pk2(v[j].z * rstd * gv[j].z, v[j].w * rstd * gv[j].w); o8[64 * j] = w; }
    }
}

__device__ __forceinline__ f32x4 cvlo(const u32x4 u) { return (f32x4){bflo(u.x), bfhi(u.x), bflo(u.y), bfhi(u.y)}; }
__device__ __forceinline__ f32x4 cvhi(const u32x4 u) { return (f32x4){bflo(u.z), bfhi(u.z), bflo(u.w), bfhi(u.w)}; }
__device__ __forceinline__ u32x4 pk8(const f32x4 lo, const f32x4 hi) { u32x4 w; w.x = pk2(lo.x, lo.y); w.y = pk2(lo.z, lo.w); w.z = pk2(hi.x, hi.y); w.w = pk2(hi.z, hi.w); return w; }

namespace ck {
constexpr int PS = 136;
constexpr int O_BT = 0, O_KT = 8704, O_AP = 17408, O_RT = 26112;
constexpr int O_AT = 34816, O_BH = 43008, O_KH = 51200, O_VV = 59392, O_TN = 67584, O_A2 = 75776, O_V2 = 83968;
constexpr int O_L = 92160, LSTR = 68;
constexpr int O_TOT = 109568, O_GC = 111616;
constexpr int O_ACT = 112128;
__device__ __forceinline__ int crow(int r, int hi) { return (r & 3) + 8 * (r >> 2) + 4 * hi; }
__device__ __forceinline__ int voff(int row, int col) { return ((col >> 5) * 4 + (row >> 4)) * 1024 + (row & 15) * 64 + (col & 31) * 2; }
__device__ __forceinline__ s16x4 vtr(const LAS unsigned char* p) { return __builtin_bit_cast(s16x4, __builtin_amdgcn_ds_read_tr16_b64_v4i16((LAS s16x4*)p)); }
__device__ __forceinline__ bf16x8 fragP(const LAS unsigned char* M, int row, int k0, int hi) {
    const LAS unsigned char* p = M + row * PS + (k0 + 4 * hi) * 2; const s16x4 lo = *(const LAS s16x4*)p, h = *(const LAS s16x4*)(p + 16);
    return (bf16x8){lo[0], lo[1], lo[2], lo[3], h[0], h[1], h[2], h[3]}; }
__device__ __forceinline__ bf16x8 fragT(const LAS unsigned char* M, int k0, int colblk, int lane, int hi) {
    const LAS unsigned char* p = M + (colblk * 4 + (k0 >> 4)) * 1024 + ((lane >> 4) & 1) * 32 + (lane & 3) * 8 + (4 * hi + ((lane & 15) >> 2)) * 64;
    const s16x4 lo = vtr(p), h = vtr(p + 512); return (bf16x8){lo[0], lo[1], lo[2], lo[3], h[0], h[1], h[2], h[3]}; }
__device__ __forceinline__ bf16x8 packR(const f32x16& x, int s) {
    u32x4 w; w.x = pk2(x[8 * s], x[8 * s + 1]); w.y = pk2(x[8 * s + 2], x[8 * s + 3]); w.z = pk2(x[8 * s + 4], x[8 * s + 5]); w.w = pk2(x[8 * s + 6], x[8 * s + 7]); return __builtin_bit_cast(bf16x8, w); }
#define CK_MFMA(a, b, c) __builtin_amdgcn_mfma_f32_32x32x16_bf16(a, b, c, 0, 0, 0)
__device__ __forceinline__ f32x16 score(const LAS unsigned char* Am, const LAS unsigned char* Bm, int sblk, int tblk, int mode, int r32, int hi) {
    f32x16 x = f32x16{};
#pragma unroll
    for (int ks = 0; ks < 4; ++ks) x = CK_MFMA(fragP(Am, sblk * 32 + r32, 16 * ks, hi), fragP(Bm, tblk * 32 + r32, 16 * ks, hi), x);
    if (mode) {
        const int t = tblk * 32 + r32;
#pragma unroll
        for (int r = 0; r < 16; ++r) { const int s = sblk * 32 + crow(r, hi); if (mode == 1 ? !(s < t) : !(s <= t)) x[r] = 0.f; }
    }
    return x;
}
__device__ __forceinline__ void storeT_V(LAS unsigned char* M, const f32x16& x, int rb, int c, int hi) {
#pragma unroll
    for (int q = 0; q < 4; ++q) { u32x2 w; w.x = pk2(x[4 * q], x[4 * q + 1]); w.y = pk2(x[4 * q + 2], x[4 * q + 3]); *(LAS u32x2*)(M + voff(c, rb * 32 + 8 * q + 4 * hi)) = w; }
}
__device__ __forceinline__ void storeT_S(LAS unsigned char* M, const f32x16& x, int rb, int c, int hi) {
#pragma unroll
    for (int q = 0; q < 4; ++q) { u32x2 w; w.x = pk2(x[4 * q], x[4 * q + 1]); w.y = pk2(x[4 * q + 2], x[4 * q + 3]); *(LAS u32x2*)(M + c * PS + (rb * 32 + 8 * q + 4 * hi) * 2) = w; }
}

__device__ __forceinline__ void chunk_item(LAS unsigned char* lds, const Args& a, int item) {
    int tid = threadIdx.x; asm volatile("" : "+v"(tid)); int lane = tid & 63; const int wave = __builtin_amdgcn_readfirstlane(tid >> 6);
#define CK_FRESH() asm volatile("" : "+v"(lane)); r32 = lane & 31; hi = lane >> 5
    int r32, hi; CK_FRESH();
    unsigned char* ws = a.ws;
    const bf16_t* SR = (const bf16_t*)(ws + WS_SR); const bf16_t* SK = (const bf16_t*)(ws + WS_SK); const bf16_t* SV = (const bf16_t*)(ws + WS_SV);
    const bf16_t* SA = (const bf16_t*)(ws + WS_SA); const bf16_t* SB = (const bf16_t*)(ws + WS_SB); const float* SW = (const float*)(ws + WS_SW);
    bf16_t* CG = (bf16_t*)(ws + WS_CG) + (size_t)item * 4096; bf16_t* CH = (bf16_t*)(ws + WS_CH) + (size_t)item * 4096;
    bf16_t* CR2 = (bf16_t*)(ws + WS_CR2) + (size_t)item * 4096; bf16_t* CY0 = (bf16_t*)(ws + WS_CY0) + (size_t)item * 4096;
    const int bh = item >> 6, c = item & 63, b = bh >> 3, h = bh & 7, tokc = b * SEQ + c * 64, col0 = h * 64;
    LAS unsigned char* BT = lds + O_BT; LAS unsigned char* KT = lds + O_KT; LAS unsigned char* AP = lds + O_AP; LAS unsigned char* RT = lds + O_RT;
    LAS unsigned char* AT = lds + O_AT; LAS unsigned char* BH = lds + O_BH; LAS unsigned char* KH = lds + O_KH; LAS unsigned char* VV = lds + O_VV;
    LAS unsigned char* TN = lds + O_TN; LAS unsigned char* A2M = lds + O_A2; LAS unsigned char* V2M = lds + O_V2;
    LAS float* L = (LAS float*)(lds + O_L); LAS float* TOT = (LAS float*)(lds + O_TOT); LAS float* GC = (LAS float*)(lds + O_GC);
    {
        const int tl = tid >> 3, c8 = (tid & 7) * 8, cr = col0 + c8, t = tokc + tl;
        const bf16_t* P = (const bf16_t*)(ws + WS_P); const bf16_t* pr = P + (size_t)t * NINP + cr;
        bf16_t* SVo = (bf16_t*)(ws + WS_SV); bf16_t* SGo = (bf16_t*)(ws + WS_SG); bf16_t* QN = (bf16_t*)(ws + WS_QN); bf16_t* KN = (bf16_t*)(ws + WS_KN);
        const float* mu = a.in[3];
        const bool first = (t & (SEQ - 1)) == 0; const u32x4 zz = (u32x4){0u, 0u, 0u, 0u};
#define CK_PK8(v) ((u32x4){pk2(v[0], v[1]), pk2(v[2], v[3]), pk2(v[4], v[5]), pk2(v[6], v[7])})
#define CK_ST_P(M, val_) do { LAS unsigned char* d_ = (M) + tl * PS + c8 * 2; const u32x4 q_ = (val_); *(LAS u32x2*)d_ = (u32x2){q_[0], q_[1]}; *(LAS u32x2*)(d_ + 8) = (u32x2){q_[2], q_[3]}; } while (0)
        float g[8], gp[8], ig[8], gC[8];
        {
            const u32x4 deu = *(const LAS u32x4*)(TN + tl * 128 + c8 * 2); const f32x4 de0 = cvlo(deu), de1 = cvhi(deu);
            float wv[8] = {__builtin_amdgcn_exp2f(de0.x), __builtin_amdgcn_exp2f(de0.y), __builtin_amdgcn_exp2f(de0.z), __builtin_amdgcn_exp2f(de0.w), __builtin_amdgcn_exp2f(de1.x), __builtin_amdgcn_exp2f(de1.y), __builtin_amdgcn_exp2f(de1.z), __builtin_amdgcn_exp2f(de1.w)};
            float p[8];
#pragma unroll
            for (int j = 0; j < 8; ++j) p[j] = wv[j];
#pragma unroll
            for (int d = 8; d < 64; d <<= 1) {
#pragma unroll
                for (int j = 0; j < 8; ++j) { const float q = __shfl_up(p[j], d); if (lane >= d) p[j] *= q; }
            }
            if ((lane >> 3) == 7) { *(LAS f32x4*)(TOT + wave * 64 + c8) = (f32x4){p[0], p[1], p[2], p[3]}; *(LAS f32x4*)(TOT + wave * 64 + c8 + 4) = (f32x4){p[4], p[5], p[6], p[7]}; }
            __syncthreads();
            float pre[8];
#pragma unroll
            for (int j = 0; j < 8; ++j) { pre[j] = 1.f; gC[j] = 1.f; }
#pragma unroll
            for (int w2 = 0; w2 < 8; ++w2) { const f32x4 t0 = *(const LAS f32x4*)(TOT + w2 * 64 + c8), t1 = *(const LAS f32x4*)(TOT + w2 * 64 + c8 + 4);
                const float tv[8] = {t0.x, t0.y, t0.z, t0.w, t1.x, t1.y, t1.z, t1.w};
#pragma unroll
                for (int j = 0; j < 8; ++j) { if (w2 < wave) pre[j] *= tv[j]; gC[j] *= tv[j]; } }
            if (tid < 8) { *(LAS f32x4*)(GC + c8) = (f32x4){gC[0], gC[1], gC[2], gC[3]}; *(LAS f32x4*)(GC + c8 + 4) = (f32x4){gC[4], gC[5], gC[6], gC[7]}; }
#pragma unroll
            for (int j = 0; j < 8; ++j) { g[j] = pre[j] * p[j]; ig[j] = __builtin_amdgcn_rcpf(g[j]); gp[j] = g[j] * __builtin_amdgcn_rcpf(wv[j]); }
        }
        f32x4 r0, r1;
        { const u32x4 cu = *(const u32x4*)(pr), pu = first ? zz : *(const u32x4*)(pr - NINP);
          const f32x4 m0 = *(const f32x4*)(mu + cr), m1 = *(const f32x4*)(mu + cr + 4); const f32x4 c0 = cvlo(cu), c1 = cvhi(cu), p0 = cvlo(pu), p1 = cvhi(pu);
          r0 = c0 + (p0 - c0) * m0; r1 = c1 + (p1 - c1) * m1;
          const float rt[8] = {r0.x * g[0], r0.y * g[1], r0.z * g[2], r0.w * g[3], r1.x * g[4], r1.y * g[5], r1.z * g[6], r1.w * g[7]};
          CK_ST_P(RT, CK_PK8(rt)); }
        { const u32x4 cu = *(const u32x4*)(pr + 1024), pu = first ? zz : *(const u32x4*)(pr - NINP + 1024);
          const f32x4 m0 = *(const f32x4*)(mu + 1024 + cr), m1 = *(const f32x4*)(mu + 1024 + cr + 4); const f32x4 c0 = cvlo(cu), c1 = cvhi(cu), p0 = cvlo(pu), p1 = cvhi(pu);
          const u32x4 uv = pk8(c0 + (p0 - c0) * m0, c1 + (p1 - c1) * m1); *(u32x4*)(SVo + (size_t)t * CW + cr) = uv; *(LAS u32x4*)(VV + voff(tl, c8)) = uv; }
        *(u32x4*)(SGo + (size_t)t * CW + cr) = *(const LAS u32x4*)(V2M + tl * 128 + c8 * 2);
        { const u32x4 cu = *(const u32x4*)(pr + 512), pu = first ? zz : *(const u32x4*)(pr - NINP + 512);
          const f32x4 m0 = *(const f32x4*)(mu + 512 + cr), m1 = *(const f32x4*)(mu + 512 + cr + 4); const f32x4 c0 = cvlo(cu), c1 = cvhi(cu), p0 = cvlo(pu), p1 = cvhi(pu);
          const f32x4 k0 = c0 + (p0 - c0) * m0, k1 = c1 + (p1 - c1) * m1;
          const u32x4 alu = *(const LAS u32x4*)(A2M + tl * 128 + c8 * 2); const f32x4 al0 = cvlo(alu), al1 = cvhi(alu);
          const f32x4 kk0 = k0 * *(const f32x4*)(a.in[9] + cr), kk1 = k1 * *(const f32x4*)(a.in[9] + cr + 4);
          const float ss = red8((kk0.x * kk0.x + kk0.y * kk0.y) + (kk0.z * kk0.z + kk0.w * kk0.w) + (kk1.x * kk1.x + kk1.y * kk1.y) + (kk1.z * kk1.z + kk1.w * kk1.w));
          const float inv = 1.0f / sqrtf(fmaxf(ss, 1e-24f));
          const f32x4 kn0 = kk0 * inv, kn1 = kk1 * inv;
          const f32x4 k20 = k0 * (1.0f + (al0 - 1.0f) * *(const f32x4*)(a.in[10] + cr)), k21 = k1 * (1.0f + (al1 - 1.0f) * *(const f32x4*)(a.in[10] + cr + 4));
          { const f32x4 q0 = r0 * k20 * *(const f32x4*)(a.in[11] + cr), q1 = r1 * k21 * *(const f32x4*)(a.in[11] + cr + 4);
            const float rk = red8((q0.x + q0.y) + (q0.z + q0.w) + (q1.x + q1.y) + (q1.z + q1.w));
            if ((lane & 7) == 0) ((float*)(ws + WS_RK))[(size_t)t * 8 + h] = rk; }
          const float kv[8] = {k20.x, k20.y, k20.z, k20.w, k21.x, k21.y, k21.z, k21.w}, nv[8] = {kn0.x, kn0.y, kn0.z, kn0.w, kn1.x, kn1.y, kn1.z, kn1.w}, av_[8] = {al0.x, al0.y, al0.z, al0.w, al1.x, al1.y, al1.z, al1.w};
          float at[8], bt[8], kt[8], bh[8], kh[8];
#pragma unroll
          for (int j = 0; j < 8; ++j) { at[j] = -nv[j] * gp[j]; bt[j] = nv[j] * av_[j] * ig[j]; kt[j] = kv[j] * ig[j]; bh[j] = bt[j] * gC[j]; kh[j] = kt[j] * gC[j]; }
          const u32x4 wa = CK_PK8(at);
          CK_ST_P(AP, wa); *(LAS u32x4*)(AT + voff(tl, c8)) = wa;
          CK_ST_P(BT, CK_PK8(bt)); CK_ST_P(KT, CK_PK8(kt));
          *(LAS u32x4*)(BH + voff(tl, c8)) = CK_PK8(bh); *(LAS u32x4*)(KH + voff(tl, c8)) = CK_PK8(kh); }
        { const u32x4 uq = *(const u32x4*)(pr + DQ0), ukd = *(const u32x4*)(pr + DK0);
          const f32x4 q0 = cvlo(uq), q1 = cvhi(uq), d0 = cvlo(ukd), d1 = cvhi(ukd);
          const float qs = red8((q0.x * q0.x + q0.y * q0.y) + (q0.z * q0.z + q0.w * q0.w) + (q1.x * q1.x + q1.y * q1.y) + (q1.z * q1.z + q1.w * q1.w));
          const float ks = red8((d0.x * d0.x + d0.y * d0.y) + (d0.z * d0.z + d0.w * d0.w) + (d1.x * d1.x + d1.y * d1.y) + (d1.z * d1.z + d1.w * d1.w));
          const float qi = (1.0f / sqrtf(qs * (1.0f / 64.0f) + 1e-5f)) * (0.125f * LOG2E), ki = 1.0f / sqrtf(ks * (1.0f / 64.0f) + 1e-5f);
          const f32x4 g0 = *(const f32x4*)(a.in[14] + c8), g1 = *(const f32x4*)(a.in[14] + c8 + 4), h0 = *(const f32x4*)(a.in[15] + c8), h1 = *(const f32x4*)(a.in[15] + c8 + 4);
          *(u32x4*)(QN + (size_t)t * CW + cr) = pk8(q0 * qi * g0, q1 * qi * g1);
          const size_t ko = ((((size_t)(b * 8 + h) * 64 + c) * 8 + (c8 >> 3)) * 64 + tl) * 8;
          *(u32x4*)(KN + ko) = pk8(d0 * ki * h0, d1 * ki * h1); }
#undef CK_PK8
#undef CK_ST_P
    }
    __syncthreads();
    CK_FRESH();
    f32x16 pa = f32x16{}, pb = f32x16{}, pc = f32x16{}, pd = f32x16{};
#define w1a pa
#define w1b pb
#define xb0 pa
#define xb1 pb
#define y0a pc
#define y0b pd
    if (wave < 2) {
        for (int k = 0; k < (wave == 0 ? 2 : 1); ++k) {
            const int sblk = wave == 0 ? k : 0, tblk = wave == 0 ? k : 1;
            const f32x16 x = score(BT, AP, sblk, tblk, wave == 0 ? 1 : 0, r32, hi);
            const int t = tblk * 32 + r32;
#pragma unroll
            for (int r = 0; r < 16; ++r) L[(sblk * 32 + crow(r, hi)) * LSTR + t] = x[r];
        }
    }
    __syncthreads();
    CK_FRESH();
    if (wave == 6) {
        float x[32];
#pragma unroll
        for (int t = 0; t < 32; ++t) x[t] = (r32 == t) ? 1.f : 0.f;
        const LAS float* Nr = L + (32 * hi) * LSTR + 32 * hi;
#pragma unroll
        for (int sidx = 0; sidx < 31; ++sidx) {
#pragma unroll
            for (int g4 = (sidx + 1) / 4; g4 < 8; ++g4) {
                const f32x4 nv = *(const LAS f32x4*)(Nr + sidx * LSTR + 4 * g4);
                if (4 * g4 + 0 > sidx) x[4 * g4 + 0] += nv.x * x[sidx];
                if (4 * g4 + 1 > sidx) x[4 * g4 + 1] += nv.y * x[sidx];
                if (4 * g4 + 2 > sidx) x[4 * g4 + 2] += nv.z * x[sidx];
                if (4 * g4 + 3 > sidx) x[4 * g4 + 3] += nv.w * x[sidx];
            }
            if ((sidx & 3) == 3) __builtin_amdgcn_sched_barrier(0);
        }
        const int cc = 32 * hi + r32;
#pragma unroll
        for (int t0 = 0; t0 < 32; t0 += 8) { u32x4 w; w.x = pk2(x[t0], x[t0 + 1]); w.y = pk2(x[t0 + 2], x[t0 + 3]); w.z = pk2(x[t0 + 4], x[t0 + 5]); w.w = pk2(x[t0 + 6], x[t0 + 7]);
            *(LAS u32x4*)(TN + voff(cc, 32 * hi + t0)) = w; }
        f32x16 m = f32x16{};
#pragma unroll
        for (int s = 0; s < 2; ++s) {
            const LAS float* lp = L + (16 * s + 4 * hi) * LSTR + 32 + r32;
            u32x4 aw; aw.x = pk2(lp[0], lp[LSTR]); aw.y = pk2(lp[2 * LSTR], lp[3 * LSTR]); aw.z = pk2(lp[8 * LSTR], lp[9 * LSTR]); aw.w = pk2(lp[10 * LSTR], lp[11 * LSTR]);
            const s16x4 b0 = *(const LAS s16x4*)(TN + voff(r32, 16 * s + 4 * hi)), b1 = *(const LAS s16x4*)(TN + voff(r32, 16 * s + 8 + 4 * hi));
            m = CK_MFMA(__builtin_bit_cast(bf16x8, aw), ((bf16x8){b0[0], b0[1], b0[2], b0[3], b1[0], b1[1], b1[2], b1[3]}), m);
        }
        f32x16 t21 = f32x16{};
#pragma unroll
        for (int s = 0; s < 2; ++s) t21 = CK_MFMA(fragT(TN, 32 + 16 * s, 1, lane, hi), packR(m, s), t21);
        storeT_V(TN, t21, 1, r32, hi);
    } else if (wave < 4) {
        const int dvb = wave - 2;
        const f32x16 x00 = score(KT, AP, 0, 0, 1, r32, hi), x01 = score(KT, AP, 0, 1, 0, r32, hi), x11 = score(KT, AP, 1, 1, 1, r32, hi);
#pragma unroll
        for (int s = 0; s < 2; ++s) {
            const bf16x8 v0 = fragT(VV, 16 * s, dvb, lane, hi), v1 = fragT(VV, 32 + 16 * s, dvb, lane, hi);
            w1a = CK_MFMA(packR(x00, s), v0, w1a);
            w1b = CK_MFMA(packR(x01, s), v0, w1b);
            w1b = CK_MFMA(packR(x11, s), v1, w1b);
        }
    } else if (wave < 6) {
        const int tb = wave - 4;
        f32x16 xk0, xk1 = f32x16{};
        if (tb == 0) { xk0 = score(KT, RT, 0, 0, 2, r32, hi); xb0 = score(BT, RT, 0, 0, 2, r32, hi); }
        else { xk0 = score(KT, RT, 0, 1, 0, r32, hi); xk1 = score(KT, RT, 1, 1, 2, r32, hi); xb0 = score(BT, RT, 0, 1, 0, r32, hi); xb1 = score(BT, RT, 1, 1, 2, r32, hi); }
#pragma unroll
        for (int s = 0; s < 2; ++s) {
            y0a = CK_MFMA(fragT(VV, 16 * s, 0, lane, hi), packR(xk0, s), y0a);
            y0b = CK_MFMA(fragT(VV, 16 * s, 1, lane, hi), packR(xk0, s), y0b);
            if (tb == 1) { y0a = CK_MFMA(fragT(VV, 32 + 16 * s, 0, lane, hi), packR(xk1, s), y0a); y0b = CK_MFMA(fragT(VV, 32 + 16 * s, 1, lane, hi), packR(xk1, s), y0b); }
        }
    }
    __syncthreads();
    CK_FRESH();
    if (wave < 2) {
        const int cb = wave; f32x16 a0 = f32x16{}, a1 = f32x16{};
#pragma unroll
        for (int ks = 0; ks < 4; ++ks) {
            const bf16x8 af = fragT(AT, 16 * ks, cb, lane, hi);
            if (ks < 2) a0 = CK_MFMA(af, fragT(TN, 16 * ks, 0, lane, hi), a0);
            a1 = CK_MFMA(af, fragT(TN, 16 * ks, 1, lane, hi), a1);
        }
        storeT_V(A2M, a0, cb, r32, hi); storeT_V(A2M, a1, cb, 32 + r32, hi);
    } else if (wave < 4) {
        const int dvb = wave - 2; f32x16 v0 = f32x16{}, v1 = f32x16{};
#pragma unroll
        for (int s = 0; s < 2; ++s) {
            v0 = CK_MFMA(packR(w1a, s), fragT(TN, 16 * s, 0, lane, hi), v0);
            v1 = CK_MFMA(packR(w1a, s), fragT(TN, 16 * s, 1, lane, hi), v1);
            v1 = CK_MFMA(packR(w1b, s), fragT(TN, 32 + 16 * s, 1, lane, hi), v1);
        }
        storeT_V(V2M, v0, dvb, r32, hi); storeT_V(V2M, v1, dvb, 32 + r32, hi);
    }
    __syncthreads();
    CK_FRESH();
    if (wave >= 4 && wave < 6) {
        const int tb = wave - 4, t = tb * 32 + r32;
        f32x16 r0 = f32x16{}, r1 = f32x16{};
#pragma unroll
        for (int s = 0; s < 2; ++s) {
            const bf16x8 p0 = packR(xb0, s);
            r0 = CK_MFMA(fragT(A2M, 16 * s, 0, lane, hi), p0, r0); r1 = CK_MFMA(fragT(A2M, 16 * s, 1, lane, hi), p0, r1);
            y0a = CK_MFMA(fragT(V2M, 16 * s, 0, lane, hi), p0, y0a); y0b = CK_MFMA(fragT(V2M, 16 * s, 1, lane, hi), p0, y0b);
            if (tb == 1) { const bf16x8 p1 = packR(xb1, s);
                r0 = CK_MFMA(fragT(A2M, 32 + 16 * s, 0, lane, hi), p1, r0); r1 = CK_MFMA(fragT(A2M, 32 + 16 * s, 1, lane, hi), p1, r1);
                y0a = CK_MFMA(fragT(V2M, 32 + 16 * s, 0, lane, hi), p1, y0a); y0b = CK_MFMA(fragT(V2M, 32 + 16 * s, 1, lane, hi), p1, y0b); }
        }
#pragma unroll
        for (int q = 0; q < 4; ++q) {
            const u32x2 u0 = *(const LAS u32x2*)(RT + t * PS + (8 * q + 4 * hi) * 2), u1 = *(const LAS u32x2*)(RT + t * PS + (32 + 8 * q + 4 * hi) * 2);
            r0[4 * q] += bflo(u0.x); r0[4 * q + 1] += bfhi(u0.x); r0[4 * q + 2] += bflo(u0.y); r0[4 * q + 3] += bfhi(u0.y);
            r1[4 * q] += bflo(u1.x); r1[4 * q + 1] += bfhi(u1.x); r1[4 * q + 2] += bflo(u1.y); r1[4 * q + 3] += bfhi(u1.y);
        }
        storeT_S(BT, r0, 0, t, hi); storeT_S(BT, r1, 1, t, hi);
        storeT_S(KT, y0a, 0, t, hi); storeT_S(KT, y0b, 1, t, hi);
    } else if (wave < 2) {
        const int ib = wave, i = ib * 32 + r32; const float gci = GC[i];
        f32x16 g0 = f32x16{}, g1 = f32x16{};
#pragma unroll
        for (int ks = 0; ks < 4; ++ks) { const bf16x8 bf_ = fragT(BH, 16 * ks, ib, lane, hi);
            g0 = CK_MFMA(fragT(A2M, 16 * ks, 0, lane, hi), bf_, g0); g1 = CK_MFMA(fragT(A2M, 16 * ks, 1, lane, hi), bf_, g1); }
#pragma unroll
        for (int r = 0; r < 16; ++r) { if (crow(r, hi) == i) g0[r] += gci; if (32 + crow(r, hi) == i) g1[r] += gci; }
        storeT_S(AP, g0, 0, i, hi); storeT_S(AP, g1, 1, i, hi);
    } else {
        const int id = wave < 4 ? wave - 2 : wave - 4, ib = id >> 1, dvb = id & 1;
        f32x16 hh = f32x16{};
#pragma unroll
        for (int ks = 0; ks < 4; ++ks) {
            hh = CK_MFMA(fragT(BH, 16 * ks, ib, lane, hi), fragT(V2M, 16 * ks, dvb, lane, hi), hh);
            hh = CK_MFMA(fragT(KH, 16 * ks, ib, lane, hi), fragT(VV, 16 * ks, dvb, lane, hi), hh);
        }
        storeT_S((LAS unsigned char*)L, hh, ib, dvb * 32 + r32, hi);
    }
    __syncthreads();
    {
        asm volatile("" : "+v"(tid));
        const int row = tid >> 3, ch = tid & 7;
        const LAS unsigned char* s0 = BT + row * PS + ch * 16; const LAS unsigned char* s1 = KT + row * PS + ch * 16; const LAS unsigned char* s2 = AP + row * PS + ch * 16; const LAS unsigned char* s3 = (const LAS unsigned char*)L + row * PS + ch * 16;
        const u32x2 a0 = *(const LAS u32x2*)s0, a1 = *(const LAS u32x2*)(s0 + 8), b0 = *(const LAS u32x2*)s1, b1 = *(const LAS u32x2*)(s1 + 8);
        const u32x2 c0 = *(const LAS u32x2*)s2, c1 = *(const LAS u32x2*)(s2 + 8), d0 = *(const LAS u32x2*)s3, d1 = *(const LAS u32x2*)(s3 + 8);
        *(u32x4*)(CR2 + row * 64 + ch * 8) = (u32x4){a0.x, a0.y, a1.x, a1.y}; *(u32x4*)(CY0 + row * 64 + ch * 8) = (u32x4){b0.x, b0.y, b1.x, b1.y};
        *(u32x4*)(CG + row * 64 + ch * 8) = (u32x4){c0.x, c0.y, c1.x, c1.y}; *(u32x4*)(CH + row * 64 + ch * 8) = (u32x4){d0.x, d0.y, d1.x, d1.y};
    }
    asm volatile("s_waitcnt lgkmcnt(0)" ::: "memory"); __builtin_amdgcn_s_barrier();
#undef CK_FRESH
#undef w1a
#undef w1b
#undef xb0
#undef xb1
#undef y0a
#undef y0b
}

__device__ __forceinline__ void fused_item(LAS unsigned char* lds, const Args& a, int bc) {
    const int tid = threadIdx.x, lane = tid & 63; const int wave = __builtin_amdgcn_readfirstlane(tid >> 6);
    unsigned char* ws = a.ws;
    const bf16_t* P = (const bf16_t*)(ws + WS_P); const bf16_t* LW = (const bf16_t*)(ws + WS_LW); const float* mu = a.in[3];
    const int b = bc >> 6, c = bc & 63, tokc = b * SEQ + c * 64;
    LAS unsigned char* ACT = lds + O_ACT; LAS unsigned char* DECb = lds + O_TN; LAS unsigned char* ALRb = lds + O_A2; LAS unsigned char* GGb = lds + O_V2;
    for (int it = tid; it < 1280; it += 512) {
        const int tok = it / 20, ch = it - tok * 20, t = tokc + tok, col = 1536 + ch * 8;
        const u32x4 cu = *(const u32x4*)(P + (size_t)t * NINP + col);
        u32x4 pu = (u32x4){0u, 0u, 0u, 0u};
        if (t & (SEQ - 1)) pu = *(const u32x4*)(P + (size_t)(t - 1) * NINP + col);
        const f32x4 m0 = *(const f32x4*)(mu + col), m1 = *(const f32x4*)(mu + col + 4);
        const f32x4 c0 = cvlo(cu), c1 = cvhi(cu), p0 = cvlo(pu), p1 = cvhi(pu);
        f32x4 s0 = c0 + (p0 - c0) * m0, s1 = c1 + (p1 - c1) * m1;
        if (ch < 4) {
#pragma unroll
            for (int i = 0; i < 4; ++i) { const float e0 = __expf(-2.0f * fabsf(s0[i])), e1 = __expf(-2.0f * fabsf(s1[i])); const float th0 = (1.0f - e0) / (1.0f + e0), th1 = (1.0f - e1) / (1.0f + e1);
                s0[i] = s0[i] < 0.f ? -th0 : th0; s1[i] = s1[i] < 0.f ? -th1 : th1; }
        } else if (ch >= 8) {
#pragma unroll
            for (int i = 0; i < 4; ++i) { s0[i] = sigmoidf_(s0[i]); s1[i] = sigmoidf_(s1[i]); }
        }
        *(LAS u32x4*)(ACT + tok * 320 + ch * 16) = pk8(s0, s1);
    }
    __syncthreads();
#pragma clang loop unroll(disable)
    for (int h = 0; h < 8; ++h) {
        {
            int ln = lane; asm volatile("" : "+v"(ln));
            const int mt = wave >> 1, fcol = ln & 15, fq = ln >> 4;
            bf16x8 wf[2][5]; float w0c[2], a0c[2];
#pragma unroll
            for (int cbi = 0; cbi < 2; ++cbi) { const int col = h * 64 + ((wave & 1) * 2 + cbi) * 16 + fcol; const bf16_t* lw = LW + (size_t)col * 160 + fq * 8;
#pragma unroll
                for (int kb = 0; kb < 5; ++kb) wf[cbi][kb] = *(const bf16x8*)(lw + 32 * kb);
                w0c[cbi] = a.in[4][col]; a0c[cbi] = a.in[6][col]; }
            bf16x8 af[5];
#pragma unroll
            for (int kb = 0; kb < 5; ++kb) af[kb] = *(const LAS bf16x8*)(ACT + (mt * 16 + fcol) * 320 + kb * 64 + fq * 16);
            __builtin_amdgcn_sched_barrier(0);
#pragma unroll
            for (int cbi = 0; cbi < 2; ++cbi) {
                const int cb = (wave & 1) * 2 + cbi;
                const f32x4 z = {0.f, 0.f, 0.f, 0.f};
                const f32x4 aw = __builtin_amdgcn_mfma_f32_16x16x32_bf16(af[0], wf[cbi][0], z, 0, 0, 0);
                const f32x4 aa = __builtin_amdgcn_mfma_f32_16x16x32_bf16(af[1], wf[cbi][1], z, 0, 0, 0);
                f32x4 ag = __builtin_amdgcn_mfma_f32_16x16x32_bf16(af[2], wf[cbi][2], z, 0, 0, 0);
                ag = __builtin_amdgcn_mfma_f32_16x16x32_bf16(af[3], wf[cbi][3], ag, 0, 0, 0);
                ag = __builtin_amdgcn_mfma_f32_16x16x32_bf16(af[4], wf[cbi][4], ag, 0, 0, 0);
#pragma unroll
                for (int i = 0; i < 4; ++i) { const int off = (mt * 16 + fq * 4 + i) * 128 + (cb * 16 + fcol) * 2;
                    *(LAS unsigned short*)(DECb + off) = (unsigned short)f2bf(-0.8750325887f * sigmoidf_(aw[i] + w0c[cbi]));
                    *(LAS unsigned short*)(ALRb + off) = (unsigned short)f2bf(sigmoidf_(aa[i] + a0c[cbi]));
                    *(LAS unsigned short*)(GGb + off) = (unsigned short)f2bf(ag[i]); }
            }
        }
        __syncthreads();
        chunk_item(lds, a, ((b * 8 + h) << 6) + c);
    }
}
}

namespace ck {
constexpr int SQ_MAT = 8704, SQ_BUF = 6 * SQ_MAT;
constexpr int SQ_OUT = 2 * SQ_BUF;
__device__ __forceinline__ bf16x8 lfrag(const LAS unsigned char* M, int row, int k0, int hi) { return fragP(M, row, k0, hi); }
__device__ __forceinline__ void linit(f32x16& x, const LAS unsigned char* M, int row, int cblk, int hi) {
#pragma unroll
    for (int q = 0; q < 4; ++q) { const u32x2 u = *(const LAS u32x2*)(M + row * PS + (cblk * 32 + 8 * q + 4 * hi) * 2); x[4 * q] = bflo(u.x); x[4 * q + 1] = bfhi(u.x); x[4 * q + 2] = bflo(u.y); x[4 * q + 3] = bfhi(u.y); }
}
__device__ __forceinline__ void seq_head(LAS unsigned char* lds, const Args& a, int bh) {
    const int tid = threadIdx.x, lane = tid & 63, r32 = lane & 31, hi = lane >> 5; const int wave = __builtin_amdgcn_readfirstlane(tid >> 6);
    unsigned char* ws = a.ws;
    const bf16_t* SV = (const bf16_t*)(ws + WS_SV); const bf16_t* SG = (const bf16_t*)(ws + WS_SG); const float* RK = (const float*)(ws + WS_RK); bf16_t* YMIX = (bf16_t*)(ws + WS_YMIX);
    const int b = bh >> 3, h = bh & 7, col0 = h * 64;
    const float* lng = a.in[12] + col0; const float* lnb = a.in[13] + col0;
    const int lw = wave - 2;
    const bf16_t* lsrc; int lpitch;
    { const size_t it0 = (size_t)bh * 64 * 4096; const size_t tk0 = (size_t)b * SEQ * CW + col0;
      lsrc = lw == 0 ? (const bf16_t*)(ws + WS_CG) + it0 : lw == 1 ? (const bf16_t*)(ws + WS_CH) + it0 : lw == 2 ? (const bf16_t*)(ws + WS_CR2) + it0 : lw == 3 ? (const bf16_t*)(ws + WS_CY0) + it0 : lw == 4 ? SV + tk0 : SG + tk0;
      lpitch = lw < 4 ? 64 : CW; }
#define SQ_LOAD(ch) do { const bf16_t* s_ = lsrc + (size_t)(ch) * 64 * lpitch; LAS unsigned char* bb_ = lds + ((ch) & 1) * SQ_BUF + lw * SQ_MAT; u32x4 v_[8]; \
        _Pragma("unroll") for (int i_ = 0; i_ < 8; ++i_) { const int q_ = lane + 64 * i_; v_[i_] = *(const u32x4*)(s_ + (size_t)(q_ >> 3) * lpitch + (q_ & 7) * 8); } \
        _Pragma("unroll") for (int i_ = 0; i_ < 8; ++i_) { const int q_ = lane + 64 * i_; LAS unsigned char* d_ = bb_ + (q_ >> 3) * PS + (q_ & 7) * 16; *(LAS u32x2*)d_ = (u32x2){v_[i_].x, v_[i_].y}; *(LAS u32x2*)(d_ + 8) = (u32x2){v_[i_].z, v_[i_].w}; } } while (0)
#define SQ_STORE(ch) do { const LAS unsigned char* ob_ = lds + SQ_OUT + ((ch) & 1) * SQ_MAT; const size_t t0_ = (size_t)b * SEQ + (ch) * 64; \
        for (int p_ = tid - 128; p_ < 512; p_ += 384) { const int row_ = p_ >> 3, c8_ = (p_ & 7) * 8; const LAS unsigned char* s_ = ob_ + row_ * PS + c8_ * 2; \
            const u32x2 lo_ = *(const LAS u32x2*)s_, hi_ = *(const LAS u32x2*)(s_ + 8); *(u32x4*)(YMIX + (t0_ + row_) * D + col0 + c8_) = (u32x4){lo_.x, lo_.y, hi_.x, hi_.y}; } } while (0)
    if (wave >= 2) SQ_LOAD(0);
    __syncthreads();
    f32x16 X00 = f32x16{}, X01 = f32x16{}, X10 = f32x16{}, X11 = f32x16{};
#pragma unroll 1
    for (int c = 0; c < 64; ++c) {
        if (wave >= 2) {
            if (c + 1 < 64) SQ_LOAD(c + 1);
            if (c > 0) SQ_STORE(c - 1);
        } else {
            const int tb = wave;
            const LAS unsigned char* bb = lds + (c & 1) * SQ_BUF;
            const LAS unsigned char* MG = bb; const LAS unsigned char* MH = bb + SQ_MAT; const LAS unsigned char* MR = bb + 2 * SQ_MAT; const LAS unsigned char* MY = bb + 3 * SQ_MAT;
            const LAS unsigned char* MV = bb + 4 * SQ_MAT; const LAS unsigned char* MGT = bb + 5 * SQ_MAT;
            LAS unsigned char* OB = lds + SQ_OUT + (c & 1) * SQ_MAT;
            const int tl = tb * 32 + r32; const size_t t = (size_t)b * SEQ + c * 64 + tl;
            const float rk = RK[t * 8 + h];
            f32x16 y0, y1; linit(y0, MY, tl, 0, hi); linit(y1, MY, tl, 1, hi);
#pragma unroll
            for (int s = 0; s < 2; ++s) {
                const bf16x8 rf0 = lfrag(MR, tl, 16 * s, hi), rf1 = lfrag(MR, tl, 32 + 16 * s, hi);
                y0 = CK_MFMA(packR(X00, s), rf0, y0); y0 = CK_MFMA(packR(X10, s), rf1, y0);
                y1 = CK_MFMA(packR(X01, s), rf0, y1); y1 = CK_MFMA(packR(X11, s), rf1, y1);
            }
#pragma unroll
            for (int db = 0; db < 2; ++db) {
                f32x16 Na, Nb; linit(Na, MH, db * 32 + r32, 0, hi); linit(Nb, MH, db * 32 + r32, 1, hi);
#pragma unroll
                for (int s = 0; s < 2; ++s) {
                    const bf16x8 g00 = lfrag(MG, r32, 16 * s, hi), g01 = lfrag(MG, r32, 32 + 16 * s, hi), g10 = lfrag(MG, 32 + r32, 16 * s, hi), g11 = lfrag(MG, 32 + r32, 32 + 16 * s, hi);
                    const bf16x8 p0 = packR(db ? X01 : X00, s), p1 = packR(db ? X11 : X10, s);
                    Na = CK_MFMA(g00, p0, Na); Na = CK_MFMA(g01, p1, Na);
                    Nb = CK_MFMA(g10, p0, Nb); Nb = CK_MFMA(g11, p1, Nb);
                }
                if (db == 0) { X00 = Na; X10 = Nb; } else { X01 = Na; X11 = Nb; }
            }
            float sm = 0.f;
#pragma unroll
            for (int r = 0; r < 16; ++r) sm += y0[r] + y1[r];
            sm += __shfl_xor(sm, 32);
            const float mean = sm * (1.0f / 64.0f);
            float sq = 0.f;
#pragma unroll
            for (int r = 0; r < 16; ++r) { const float d0 = y0[r] - mean, d1 = y1[r] - mean; sq += d0 * d0 + d1 * d1; }
            sq += __shfl_xor(sq, 32);
            const float rs = 1.0f / sqrtf(sq * (1.0f / 64.0f) + 64e-5f);
#pragma unroll
            for (int db = 0; db < 2; ++db)
#pragma unroll
                for (int q = 0; q < 4; ++q) {
                    const int dv = db * 32 + 8 * q + 4 * hi;
                    const f32x4 lg = *(const f32x4*)(lng + dv), lb = *(const f32x4*)(lnb + dv);
                    const u32x2 uv = *(const LAS u32x2*)(MV + tl * PS + dv * 2), ug = *(const LAS u32x2*)(MGT + tl * PS + dv * 2);
                    const f32x4 vv = {bflo(uv.x), bfhi(uv.x), bflo(uv.y), bfhi(uv.y)}, gg = {bflo(ug.x), bfhi(ug.x), bflo(ug.y), bfhi(ug.y)};
                    f32x4 yy; if (db == 0) yy = (f32x4){y0[4 * q], y0[4 * q + 1], y0[4 * q + 2], y0[4 * q + 3]}; else yy = (f32x4){y1[4 * q], y1[4 * q + 1], y1[4 * q + 2], y1[4 * q + 3]};
                    const f32x4 o = ((yy - mean) * rs * lg + lb + rk * vv) * gg;
                    u32x2 w; w.x = pk2(o.x, o.y); w.y = pk2(o.z, o.w);
                    *(LAS u32x2*)(OB + tl * PS + dv * 2) = w;
                }
        }
        __syncthreads();
    }
    if (wave >= 2) SQ_STORE(63);
#undef SQ_LOAD
#undef SQ_STORE
}
}

namespace att {
constexpr int SLOT = 32768, OFF_V = 16384;
constexpr int TBL_OFF = MISC_OFF + 1024;
constexpr int LW_OFF = MISC_OFF + 2048;
constexpr int CST_OFF = MISC_OFF + 3072;
__device__ __forceinline__ int crow(int r, int hi) { return (r & 3) + 8 * (r >> 2) + 4 * hi; }
__device__ __forceinline__ void glds16(const void* gsrc, unsigned lds_dst) { unsigned keep;
    asm volatile("s_mov_b32 %0, m0\n\ts_mov_b32 m0, %2\n\ts_nop 0\n\tglobal_load_lds_dwordx4 %1, off\n\ts_mov_b32 m0, %0" : "=&s"(keep) : "v"(gsrc), "s"(lds_dst) : "memory"); }
__device__ __forceinline__ s16x4 vtr(const LAS unsigned char* p) { return __builtin_bit_cast(s16x4, __builtin_amdgcn_ds_read_tr16_b64_v4i16((LAS s16x4*)p)); }

__device__ __forceinline__ void attn_unit(LAS unsigned char* lds, const Args& a, int b, int h, int qb, float negM, float lam) {
    const int tid = threadIdx.x, lane = tid & 63, r32 = lane & 31, hi = lane >> 5; const int wid = __builtin_amdgcn_readfirstlane(tid >> 6);
    const int c = wid >> 2, rg = wid & 3;
    unsigned char* ws = a.ws;
    const bf16_t* QN = (const bf16_t*)(ws + WS_QN); const bf16_t* KN = (const bf16_t*)(ws + WS_KN); const bf16_t* P = (const bf16_t*)(ws + WS_P); bf16_t* YMIX = (bf16_t*)(ws + WS_YMIX);
    const int q0 = qb * 128; const size_t rowbase = (size_t)b * SEQ;
    const int NT = 2 * qb + 2;
    LAS float* tbl = (LAS float*)(lds + TBL_OFF); LAS float* lw = (LAS float*)(lds + LW_OFF) + wid * 32;
    if (tid < 128) {
        const int n = tid; int bkt;
        if (n < 16) bkt = n; else { bkt = 16 + (int)(logf((float)n * (1.0f / 16.0f)) / 2.0794415416798357f * 16.0f); bkt = bkt > 31 ? 31 : bkt; }
        tbl[n] = (a.in[21][bkt * 4 + h] - a.in[21][31 * 4 + h]) * LOG2E;
    }
    const bf16_t* Qw = QN + (rowbase + q0 + rg * 32 + r32) * CW + h * 128 + c * 64;
    bf16x8 qr[4];
#pragma unroll
    for (int d0 = 0; d0 < 4; ++d0) qr[d0] = *(const bf16x8*)(Qw + d0 * 16 + hi * 8);
    const bf16_t* k0src = KN + ((((size_t)(b * 8 + h * 2) * 64) * 8 + wid) * 64 + lane) * 8;
    const bf16_t* k1src = k0src + (size_t)64 * 8 * 64 * 8;
    const int pv0 = 2 * wid, pv1 = 2 * wid + 1;
    const bf16_t* VTb = (const bf16_t*)(ws + WS_VT) + (size_t)(b * 4 + h) * 64 * 8192;
    const bf16_t* v0src = VTb + pv0 * 512 + lane * 8;
    const bf16_t* v1src = VTb + pv1 * 512 + lane * 8;
#define ATT_DMA(t, slot) do { const unsigned s_ = lds0 + (unsigned)(slot) * SLOT; \
        glds16(k0src + (size_t)(t) * 4096, (unsigned)__builtin_amdgcn_readfirstlane(s_ + wid * 1024)); \
        glds16(k1src + (size_t)(t) * 4096, (unsigned)__builtin_amdgcn_readfirstlane(s_ + 8192 + wid * 1024)); \
        glds16(v0src + (size_t)(t) * 8192, (unsigned)__builtin_amdgcn_readfirstlane(s_ + OFF_V + pv0 * 1024)); \
        glds16(v1src + (size_t)(t) * 8192, (unsigned)__builtin_amdgcn_readfirstlane(s_ + OFF_V + pv1 * 1024)); } while (0)
#define ATT_SBAR() __builtin_amdgcn_sched_barrier(0)
    const unsigned lds0 = (unsigned)(uintptr_t)lds;
    f32x16 o[4];
#pragma unroll
    for (int d0 = 0; d0 < 4; ++d0) o[d0] = f32x16{};
    float lsum = 0.f;
    const bool shift = negM < -60.0f;
    const int qmin = q0 + 32 * rg, qpos = qmin + r32;
    ATT_DMA(0, 0);
    asm volatile("s_waitcnt vmcnt(0)" ::: "memory");
    __syncthreads();
    for (int t = 0; t < NT; ++t) {
        if (t + 1 < NT) ATT_DMA(t + 1, (t + 1) & 1);
        const int kmin = 64 * t;
        if (kmin <= qmin + 31) {
            const LAS unsigned char* slot = lds + (t & 1) * SLOT;
            const LAS unsigned char* kb = slot + c * 8192 + hi * 1024 + r32 * 16;
            const LAS unsigned char* vb = slot + OFF_V + ((lane >> 4) & 1) * 32 + (lane & 3) * 8 + (4 * hi + ((lane & 15) >> 2)) * 64;
            bf16x8 kf[8];
#pragma unroll
            for (int d0 = 0; d0 < 4; ++d0) { kf[2 * d0] = *(const LAS bf16x8*)(kb + d0 * 2048); kf[2 * d0 + 1] = *(const LAS bf16x8*)(kb + d0 * 2048 + 512); }
            s16x4 va[16], vc[16];
#pragma unroll
            for (int i = 0; i < 8; ++i) { va[2 * i] = vtr(vb + (i >> 2) * 4096 + (i & 3) * 1024); va[2 * i + 1] = vtr(vb + (i >> 2) * 4096 + (i & 3) * 1024 + 512); }
            ATT_SBAR();
            f32x16 p0, p1;
            p0 = __builtin_amdgcn_mfma_f32_32x32x16_bf16(kf[0], qr[0], f32x16{}, 0, 0, 0); p1 = __builtin_amdgcn_mfma_f32_32x32x16_bf16(kf[1], qr[0], f32x16{}, 0, 0, 0);
#pragma unroll
            for (int d0 = 1; d0 < 4; ++d0) { p0 = __builtin_amdgcn_mfma_f32_32x32x16_bf16(kf[2 * d0], qr[d0], p0, 0, 0, 0); p1 = __builtin_amdgcn_mfma_f32_32x32x16_bf16(kf[2 * d0 + 1], qr[d0], p1, 0, 0, 0); }
            ATT_SBAR();
            if (qmin - (kmin + 63) < 113) {
#pragma unroll
                for (int r = 0; r < 16; ++r) {
                    const int d0_ = qpos - (kmin + crow(r, hi)); const int d1_ = d0_ - 32;
                    const float t0 = tbl[d0_ < 0 ? 0 : (d0_ > 127 ? 127 : d0_)], t1 = tbl[d1_ < 0 ? 0 : (d1_ > 127 ? 127 : d1_)];
                    p0[r] = d0_ < 0 ? -INFINITY : p0[r] + t0; p1[r] = d1_ < 0 ? -INFINITY : p1[r] + t1;
                }
            }
            if (shift) {
#pragma unroll
                for (int r = 0; r < 16; ++r) { p0[r] += negM; p1[r] += negM; }
            }
            float sacc = 0.f;
#pragma unroll
            for (int r = 0; r < 16; ++r) { p0[r] = __builtin_amdgcn_exp2f(p0[r]); p1[r] = __builtin_amdgcn_exp2f(p1[r]); sacc += p0[r] + p1[r]; }
            lsum += sacc;
            u32x4 pw[4];
#pragma unroll
            for (int i = 0; i < 4; ++i) { pw[0][i] = pk2(p0[2 * i], p0[2 * i + 1]); pw[1][i] = pk2(p0[8 + 2 * i], p0[8 + 2 * i + 1]); pw[2][i] = pk2(p1[2 * i], p1[2 * i + 1]); pw[3][i] = pk2(p1[8 + 2 * i], p1[8 + 2 * i + 1]); }
            ATT_SBAR();
#pragma unroll
            for (int i = 0; i < 8; ++i) { vc[2 * i] = vtr(vb + (2 + (i >> 2)) * 4096 + (i & 3) * 1024); vc[2 * i + 1] = vtr(vb + (2 + (i >> 2)) * 4096 + (i & 3) * 1024 + 512); }
#pragma unroll
            for (int i = 0; i < 8; ++i) {
                const bf16x8 vf = (bf16x8){va[2 * i][0], va[2 * i][1], va[2 * i][2], va[2 * i][3], va[2 * i + 1][0], va[2 * i + 1][1], va[2 * i + 1][2], va[2 * i + 1][3]};
                o[i >> 2] = __builtin_amdgcn_mfma_f32_32x32x16_bf16(__builtin_bit_cast(bf16x8, pw[i & 3]), vf, o[i >> 2], 0, 0, 0);
            }
#pragma unroll
            for (int i = 0; i < 8; ++i) {
                const bf16x8 vf = (bf16x8){vc[2 * i][0], vc[2 * i][1], vc[2 * i][2], vc[2 * i][3], vc[2 * i + 1][0], vc[2 * i + 1][1], vc[2 * i + 1][2], vc[2 * i + 1][3]};
                o[2 + (i >> 2)] = __builtin_amdgcn_mfma_f32_32x32x16_bf16(__builtin_bit_cast(bf16x8, pw[i & 3]), vf, o[2 + (i >> 2)], 0, 0, 0);
            }
        }
        asm volatile("s_waitcnt vmcnt(0)" ::: "memory");
        __syncthreads();
    }
#undef ATT_DMA
#undef ATT_SBAR
    lsum += __shfl_xor(lsum, 32);
    if (hi == 0) lw[r32] = 1.0f / lsum;
    asm volatile("s_waitcnt lgkmcnt(0)" ::: "memory");
    LAS float* stg = (LAS float*)(lds + wid * 16384);
#pragma unroll
    for (int r = 0; r < 16; ++r) { const int orow = crow(r, hi); const float il = lw[orow];
#pragma unroll
        for (int d0 = 0; d0 < 4; ++d0) stg[orow * 128 + d0 * 32 + r32] = o[d0][r] * il; }
    __syncthreads();
    {
        const int row = tid >> 2, part = tid & 3, rgp = row >> 5, rr = row & 31;
        const LAS float* s1 = (const LAS float*)(lds + rgp * 16384) + rr * 128 + part * 32;
        const LAS float* s2 = (const LAS float*)(lds + (4 + rgp) * 16384) + rr * 128 + part * 32;
        float dv[32]; float ss = 0.f;
#pragma unroll
        for (int i = 0; i < 8; ++i) { const f32x4 x1 = *(const LAS f32x4*)(s1 + 4 * i), x2 = *(const LAS f32x4*)(s2 + 4 * i);
#pragma unroll
            for (int j = 0; j < 4; ++j) { const float dd = x1[j] - lam * x2[j]; dv[4 * i + j] = dd; ss += dd * dd; } }
        ss = red4(ss);
        const float sc = (1.0f / sqrtf(ss * (1.0f / 128.0f) + 1e-5f)) * 0.8f;
        const float* sg = a.in[20] + part * 32;
        bf16_t* op = YMIX + (rowbase + q0 + row) * D + CW + h * 128 + part * 32;
#pragma unroll
        for (int i = 0; i < 4; ++i) { u32x4 w;
            w.x = pk2(dv[8 * i] * sc * sg[8 * i], dv[8 * i + 1] * sc * sg[8 * i + 1]); w.y = pk2(dv[8 * i + 2] * sc * sg[8 * i + 2], dv[8 * i + 3] * sc * sg[8 * i + 3]);
            w.z = pk2(dv[8 * i + 4] * sc * sg[8 * i + 4], dv[8 * i + 5] * sc * sg[8 * i + 5]); w.w = pk2(dv[8 * i + 6] * sc * sg[8 * i + 6], dv[8 * i + 7] * sc * sg[8 * i + 7]);
            *(u32x4*)(op + 8 * i) = w; }
    }
    __syncthreads();
}

__device__ __forceinline__ void attn_phase(LAS unsigned char* lds, const Args& a, unsigned* ctl) {
    const int tid = threadIdx.x;
    LAS float* cst = (LAS float*)(lds + CST_OFF);
    if (tid < 64) {
        const float gq = fabsf(a.in[14][tid]), gk = fabsf(a.in[15][tid]);
        float mq = gq, mk = gk;
#pragma unroll
        for (int o = 1; o < 64; o <<= 1) { mq = fmaxf(mq, __shfl_xor(mq, o)); mk = fmaxf(mk, __shfl_xor(mk, o)); }
        const float d1 = wave_sum(a.in[16][tid] * a.in[17][tid]), d2 = wave_sum(a.in[18][tid] * a.in[19][tid]);
        float mb = 0.f;
        if (tid < 32) { for (int hh = 0; hh < 4; ++hh) mb = fmaxf(mb, (a.in[21][tid * 4 + hh] - a.in[21][31 * 4 + hh]) * LOG2E); }
#pragma unroll
        for (int o = 1; o < 64; o <<= 1) mb = fmaxf(mb, __shfl_xor(mb, o));
        if (tid == 0) { cst[0] = -(8.0f * LOG2E * mq * mk * 1.02f + mb); cst[1] = __expf(d1) - __expf(d2) + 0.2f; }
    }
    __syncthreads();
    const float negM = cst[0], lam = cst[1];
    LAS int* ubox = (LAS int*)(lds + CST_OFF + 16);
    for (;;) {
        if (tid == 0) ubox[0] = (int)atomicAdd(ctl + CW_ATTQ, 1u);
        __syncthreads();
        const int u = __builtin_amdgcn_readfirstlane(ubox[0]);
        __syncthreads();
        if (u >= 1024 + CONV_ITEMS) break;
        const int qd = u / 5, rm = u - qd * 5;
        if (rm < 3) { conv_item(lds, a, qd * 3 + rm); continue; }
        const int au = qd * 2 + (rm - 3);
        const int qb = 31 - (au >> 5), bhh = au & 31;
        attn_unit(lds, a, bhh >> 2, bhh & 3, qb, negM, lam);
    }
}
}

__device__ __forceinline__ void p5_router(LAS unsigned char* lds, const Args& a, unsigned* ctl) {
    const int tid = threadIdx.x, lane = tid & 63, r32 = lane & 31, hi = lane >> 5; const int wave = __builtin_amdgcn_readfirstlane(tid >> 6);
    unsigned char* ws = a.ws;
    const bf16_t* x1 = (const bf16_t*)(ws + WS_X1B); const float* g2 = a.in[23]; const float* rw = a.in[24]; const float* rb = a.in[25];
    unsigned char* H2 = ws + WS_H2; int* EIDX = (int*)(ws + WS_EIDX); float* GATE = (float*)(ws + WS_GATE); int* POS = (int*)(ws + WS_POS);
    LAS unsigned char* WH = lds; LAS unsigned char* WL = lds + 65536;
    LAS int* cnt = (LAS int*)(lds + MISC_OFF + 1024);
    LAS int* basel = (LAS int*)(lds + MISC_OFF + 1024 + 128);
    LAS int* el = (LAS int*)(lds + MISC_OFF + 2048);
    LAS int* pl = (LAS int*)(lds + MISC_OFF + 4096);
    {
        const int e = tid & 31;
        for (int k = tid >> 5; k < 1024; k += 16) {
            const float v = rw[k * 32 + e] * g2[k]; const unsigned h = f2bf(v); const float vh = __builtin_bit_cast(float, h << 16); const unsigned l = f2bf(v - vh);
            const int off = e * 2048 + (((k >> 3) ^ (e & 15)) << 4) + (k & 7) * 2;
            *(LAS unsigned short*)(WH + off) = (unsigned short)h; *(LAS unsigned short*)(WL + off) = (unsigned short)l;
        }
    }
    if (tid < 32) cnt[tid] = 0;
    __syncthreads();
    const int TPB = T / (int)gridDim.x, tb0 = blockIdx.x * TPB;
    if (wave < 4) {
        const int tl = wave * 32 + r32, t = tb0 + tl;
        const bf16_t* xrow = x1 + (size_t)t * D + 8 * hi;
        const LAS unsigned char* wh = WH + r32 * 2048; const LAS unsigned char* wl = WL + r32 * 2048; const int sw = r32 & 15;
        f32x16 d = f32x16{}; float ssq = 0.f;
#pragma unroll 8
        for (int s = 0; s < 64; ++s) {
            const u32x4 xb = *(const u32x4*)(xrow + 16 * s);
            const int co = ((2 * s + hi) ^ sw) << 4;
            const bf16x8 ah = *(const LAS bf16x8*)(wh + co), al = *(const LAS bf16x8*)(wl + co);
            const bf16x8 bx = __builtin_bit_cast(bf16x8, xb);
            d = __builtin_amdgcn_mfma_f32_32x32x16_bf16(ah, bx, d, 0, 0, 0);
            d = __builtin_amdgcn_mfma_f32_32x32x16_bf16(al, bx, d, 0, 0, 0);
            const f32x4 x0 = cvlo(xb), x1v = cvhi(xb);
            ssq += (x0.x * x0.x + x0.y * x0.y) + (x0.z * x0.z + x0.w * x0.w) + (x1v.x * x1v.x + x1v.y * x1v.y) + (x1v.z * x1v.z + x1v.w * x1v.w);
        }
        ssq += __shfl_xor(ssq, 32);
        const float rstd = 1.0f / sqrtf(ssq * (1.0f / D) + 1e-5f);
        float lg[16];
#pragma unroll
        for (int r = 0; r < 16; ++r) lg[r] = d[r] * rstd + rb[8 * (r >> 2) + 4 * hi + (r & 3)];
        float tv[4]; int ti[4];
#pragma unroll
        for (int k = 0; k < 4; ++k) {
            float bv = -INFINITY; int bi = 0;
#pragma unroll
            for (int r = 0; r < 16; ++r) { const int e = 8 * (r >> 2) + 4 * hi + (r & 3); if (lg[r] > bv) { bv = lg[r]; bi = e; } }
            tv[k] = bv; ti[k] = bi;
#pragma unroll
            for (int r = 0; r < 16; ++r) { const int e = 8 * (r >> 2) + 4 * hi + (r & 3); if (e == bi) lg[r] = -INFINITY; }
        }
        float ov[4]; int oi[4];
#pragma unroll
        for (int k = 0; k < 4; ++k) { ov[k] = __shfl_xor(tv[k], 32); oi[k] = __shfl_xor(ti[k], 32); }
        float mv[4]; int mi[4];
        {
            int pa = 0, pb = 0;
#pragma unroll
            for (int k = 0; k < 4; ++k) {
                float ca = -INFINITY, cb = -INFINITY; int ia = 0, ib = 0;
#pragma unroll
                for (int q = 0; q < 4; ++q) { if (q == pa) { ca = tv[q]; ia = ti[q]; } if (q == pb) { cb = ov[q]; ib = oi[q]; } }
                const bool takeA = (ca > cb) || (ca == cb && ia < ib);
                mv[k] = takeA ? ca : cb; mi[k] = takeA ? ia : ib; pa += takeA ? 1 : 0; pb += takeA ? 0 : 1;
            }
        }
        const float e1 = __expf(mv[1] - mv[0]), e2 = __expf(mv[2] - mv[0]), e3 = __expf(mv[3] - mv[0]);
        const float inv = 1.0f / (1.0f + e1 + e2 + e3);
        if (hi == 0) {
            *(int4*)(EIDX + (size_t)t * 4) = make_int4(mi[0], mi[1], mi[2], mi[3]);
            *(float4*)(GATE + (size_t)t * 4) = make_float4(inv, e1 * inv, e2 * inv, e3 * inv);
#pragma unroll
            for (int k = 0; k < 4; ++k) { el[tl * 4 + k] = mi[k]; pl[tl * 4 + k] = atomicAdd((int*)(cnt + mi[k]), 1); }
        }
    } else {
        f32x4 gv[4];
#pragma unroll
        for (int j = 0; j < 4; ++j) gv[j] = *((const f32x4*)g2 + lane + 64 * j);
        for (int i = 0; i < 32; ++i) {
            const int t = tb0 + (wave - 4) * 32 + i;
            const u32x2* xr = (const u32x2*)(x1 + (size_t)t * D) + lane;
            f32x4 v[4]; float s = 0.f;
#pragma unroll
            for (int j = 0; j < 4; ++j) { const u32x2 xw = xr[64 * j]; v[j] = (f32x4){bflo(xw.x), bfhi(xw.x), bflo(xw.y), bfhi(xw.y)}; s += (v[j].x * v[j].x + v[j].y * v[j].y) + (v[j].z * v[j].z + v[j].w * v[j].w); }
            const float rstd = (1.0f / sqrtf(wave_sum(s) * (1.0f / D) + 1e-5f)) * F8_X_MUL;
            unsigned* o4 = (unsigned*)(H2 + (size_t)t * D) + lane;
#pragma unroll
            for (int j = 0; j < 4; ++j) { v[j] = v[j] * rstd * gv[j]; o4[64 * j] = pk4_fp8(v[j].x, v[j].y, v[j].z, v[j].w); }
        }
    }
    __syncthreads();
    if (tid < 32) basel[tid] = (int)atomicAdd(ctl + CW_CNT + tid, (unsigned)cnt[tid]);
    __syncthreads();
    for (int i = tid; i < TPB * 4; i += 512) POS[(size_t)tb0 * 4 + i] = pl[i] + basel[el[i]];
}

__device__ __forceinline__ void p6_dispatch(LAS unsigned char* lds, const Args& a, unsigned* ctl) {
    const int tid = threadIdx.x, lane = tid & 63, wave = __builtin_amdgcn_readfirstlane(tid >> 6);
    unsigned char* ws = a.ws;
    const int* EIDX = (const int*)(ws + WS_EIDX); const float* GATE = (const float*)(ws + WS_GATE); const int* POS = (const int*)(ws + WS_POS);
    int* DEST = (int*)(ws + WS_DEST); float* ROWGATE = (float*)(ws + WS_ROWGATE); int* TILEE = (int*)(ws + WS_TILEE); int* ROWTOK = (int*)(ws + WS_ROWTOK);
    LAS int* pstart = (LAS int*)(lds + MISC_OFF + 1024); LAS int* pcnt = pstart + 32;
    if (tid < NE) pcnt[tid] = (int)__hip_atomic_load(ctl + CW_CNT + tid, __ATOMIC_RELAXED, __HIP_MEMORY_SCOPE_AGENT);
    __syncthreads();
    if (tid == 0) {
        int acc = 0;
        for (int e = 0; e < NE; ++e) { pstart[e] = acc; acc += ((pcnt[e] + 255) >> 8) * 256; }
        if (blockIdx.x == 0) TILEE[1023] = acc >> 8;
    }
    __syncthreads();
    if (blockIdx.x == 0 && tid < NE) { const int nt = (pcnt[tid] + 255) >> 8, t0_ = pstart[tid] >> 8; for (int i = 0; i < nt; ++i) TILEE[t0_ + i] = tid; }
    if (blockIdx.x < NE) {
        const int e = blockIdx.x, cn = pcnt[e], pe = ((cn + 255) >> 8) * 256;
        for (int i = cn + tid; i < pe; i += 512) ROWTOK[pstart[e] + i] = 0;
    }
    const int TPB = T / (int)gridDim.x, tb0 = blockIdx.x * TPB;
    for (int pi = tb0 * 4 + tid; pi < (tb0 + TPB) * 4; pi += 512) {
        const int e = EIDX[pi], dest = pstart[e] + POS[pi];
        DEST[pi] = dest; ROWGATE[dest] = GATE[pi]; ROWTOK[dest] = pi >> 2;
    }
}

__device__ __forceinline__ void p9_combine(const Args& a, int G) {
    const int tid = threadIdx.x, lane = tid & 63, wave = __builtin_amdgcn_readfirstlane(tid >> 6);
    unsigned char* ws = a.ws;
    const unsigned char* YS = ws + WS_YS; const int* DEST = (const int*)(ws + WS_DEST);
    float* out = a.out;
    const int gw = blockIdx.x * 8 + wave, NGW = G * 8;
    for (int t = gw; t < T; t += NGW) {
        f32x4* xr = (f32x4*)(out + (size_t)t * D) + lane; const u32x2* xi = (const u32x2*)((const bf16_t*)(ws + WS_X1B) + (size_t)t * D) + lane;
        f32x4 v[4];
#pragma unroll
        for (int j = 0; j < 4; ++j) { const u32x2 xw = xi[64 * j]; v[j] = (f32x4){bflo(xw.x), bfhi(xw.x), bflo(xw.y), bfhi(xw.y)}; }
#pragma unroll
        for (int k = 0; k < 4; ++k) {
            const int dest = DEST[t * 4 + k];
            const unsigned* yr = (const unsigned*)(YS + (size_t)dest * D) + lane;
#pragma unroll
            for (int j = 0; j < 4; ++j) { const unsigned w = yr[64 * j];
                const f32x2 lo = __builtin_amdgcn_cvt_pk_f32_fp8((int)w, false), hi2 = __builtin_amdgcn_cvt_pk_f32_fp8((int)w, true);
                v[j].x += lo.x * (1.0f / F8_Y_MUL); v[j].y += lo.y * (1.0f / F8_Y_MUL); v[j].z += hi2.x * (1.0f / F8_Y_MUL); v[j].w += hi2.y * (1.0f / F8_Y_MUL); }
        }
        if (TIME_REGION >= 0) { const float sc_ = 1.0f + 4e-6f * (float)((const unsigned*)(ws + WS_CTL))[301];
#pragma unroll
            for (int j = 0; j < 4; ++j) v[j] = v[j] * sc_; }
#pragma unroll
        for (int j = 0; j < 4; ++j) xr[64 * j] = v[j];
    }
}

constexpr int NPHASE = 10;
__global__ void __launch_bounds__(512, 2) hymba_fwd(Args args) {
    extern __shared__ __attribute__((aligned(16))) unsigned char lds_raw[];
    LAS unsigned char* lds = (LAS unsigned char*)lds_raw;
    cg::grid_group grid = cg::this_grid();
    const int G = gridDim.x;
    unsigned char* ws = args.ws;
    unsigned* ctl = (unsigned*)(ws + WS_CTL);
    const int lo = args.ph_lo, hi = args.ph_hi;
#define IN(k) (lo <= (k) && (k) < hi)
#define NREP(k) ((REP_PHASE) == (k) ? 2 : 1)
#define TSTART(k) do { if ((TIME_REGION) == (k) && blockIdx.x == 0 && threadIdx.x == 0) ctl[300] = (unsigned)__builtin_amdgcn_s_memrealtime(); } while (0)
#define TEND(k) do { if ((TIME_REGION) == (k) && blockIdx.x == 0 && threadIdx.x == 0) ctl[301] = (unsigned)__builtin_amdgcn_s_memrealtime() - ctl[300]; } while (0)
#define SEAM(k) do { if (IN(k) && IN((k) + 1)) { if (args.ph_lo < 0) grid.sync(); xcd_barrier(xbar); } } while (0)
    const int* TILEE = (const int*)(ws + WS_TILEE);
    { volatile LAS unsigned* st = (volatile LAS unsigned*)(lds + LDS_BYTES - 64); if (threadIdx.x < 2) st[threadIdx.x] = 0u; }
    __syncthreads();
    const XcdBarrier xbar = xcd_barrier_post(ctl + CW_BAR, (volatile LAS unsigned*)(lds + LDS_BYTES - 64));

    if (IN(0)) { for (int rep = 0; rep < NREP(0); ++rep) p0_prologue(lds, args, G); } SEAM(0);
    if (IN(1)) {
        pg8::Gemm g{ws + WS_XN, ws + WS_WINT, 1024, 0, 0, nullptr};
        pg8::TileOrder S; S.init(T / 256, NINP / 256, G, (int)blockIdx.x, nullptr, 0, WGM_P1);
        pg8::EpiBf16 E{(bf16_t*)(ws + WS_P), NINP, (bf16_t*)(ws + WS_VT)};
        for (int rep = 0; rep < NREP(1); ++rep) pg8::gemm_phase<false, false>(lds, g, S, E);
    } SEAM(1);
    TSTART(2);
    if (IN(2)) {
        ck::fused_item(lds, args, (int)blockIdx.x * 2); ck::fused_item(lds, args, (int)blockIdx.x * 2 + 1);
    } SEAM(2);
    TSTART(3);
    if (IN(3)) {
        TSTART(30); for (int rep = 0; rep < NREP(30); ++rep) { if (blockIdx.x < 64) ck::seq_head(lds, args, (int)blockIdx.x); __syncthreads(); } TEND(30);
        for (int rep = 0; rep < NREP(31); ++rep) att::attn_phase(lds, args, ctl + 64 * rep);
    } SEAM(3); TEND(3);
    if (IN(4)) {
        pg8::Gemm g{ws + WS_YMIX, ws + WS_WOUT, 1024, 0, 0, nullptr};
        pg8::TileOrder S; S.init(T / 256, D / 256, G, (int)blockIdx.x, nullptr, 0, WGM_P4);
        pg8::EpiResBf16 E{args.in[0], (bf16_t*)(ws + WS_X1B), D};
        for (int rep = 0; rep < NREP(4); ++rep) pg8::gemm_phase<false, false>(lds, g, S, E);
    } SEAM(4);
    if (IN(5)) { _Pragma("clang loop unroll(disable)") for (int rep = 0; rep < NREP(5); ++rep) { p5_router(lds, args, ctl + 256 * (NREP(5) - 1 - rep)); __syncthreads(); } } SEAM(5);
    if (IN(6)) { for (int rep = 0; rep < NREP(6); ++rep) { p6_dispatch(lds, args, ctl); __syncthreads(); } } SEAM(6);
    if (IN(7)) {
        const int ntile = TILEE[1023];
        pg8::Gemm g{ws + WS_H2, ws + WS_W1T, 1024, F8_W_SC, F8_X_SC, (const int*)(ws + WS_ROWTOK)};
        pg8::TileOrder S; S.init(ntile, 8, G, (int)blockIdx.x, TILEE, 8, WGM_P7);
        pg8::EpiSwiglu E{ws + WS_HID, args.in[27], TILEE};
        for (int rep = 0; rep < NREP(7); ++rep) pg8::gemm_phase<true, true>(lds, g, S, E);
    } SEAM(7);
    if (IN(8)) {
        const int ntile = TILEE[1023];
        pg8::Gemm g{ws + WS_HID, ws + WS_W2T, 1024, F8_W_SC, F8_H_SC, nullptr};
        pg8::TileOrder S; S.init(ntile, 4, G, (int)blockIdx.x, TILEE, 4, WGM_P8);
        pg8::EpiGateF8 E{ws + WS_YS, args.in[29], (const float*)(ws + WS_ROWGATE), TILEE};
        for (int rep = 0; rep < NREP(8); ++rep) pg8::gemm_phase<true, false>(lds, g, S, E);
    } SEAM(8);
    if (IN(9)) { p9_combine(args, G); }
#undef IN
#undef SEAM
}

extern "C" void kernel_launch(void* const* d_in, const int* in_sizes, int n_in, void* d_out, int out_size, void* d_ws, size_t ws_size, hipStream_t stream) {
    static int grid = 0;
    if (grid == 0) {
        if (n_in != 30 || in_sizes[0] != T * D || out_size != T * D || ws_size < WS_END) { fprintf(stderr, "kernel_launch: unexpected shapes (n_in %d, in0 %d, out %d, ws %zu); nothing launched\n", n_in, n_in > 0 ? in_sizes[0] : -1, out_size, ws_size); grid = -1; return; }
        int dev = 0, cus = 0, per_cu = 0;
        if (hipGetDevice(&dev) != hipSuccess || hipDeviceGetAttribute(&cus, hipDeviceAttributeMultiprocessorCount, dev) != hipSuccess) { grid = -1; return; }
        if (hipFuncSetAttribute((const void*)hymba_fwd, hipFuncAttributeMaxDynamicSharedMemorySize, LDS_BYTES) != hipSuccess) { fprintf(stderr, "kernel_launch: hipFuncSetAttribute failed\n"); grid = -1; return; }
        if (hipOccupancyMaxActiveBlocksPerMultiprocessor(&per_cu, (const void*)hymba_fwd, 512, LDS_BYTES) != hipSuccess || per_cu < 1) { fprintf(stderr, "kernel_launch: occupancy query says %d\n", per_cu); per_cu = 1; }
        (void)hipGetLastError();
        grid = cus;
        if (grid > 256) grid = 256;
        if (grid != 256 || T % grid != 0 || (T / grid) % 16 != 0) { fprintf(stderr, "kernel_launch: grid %d does not divide the token count evenly\n", grid); grid = -1; return; }
    }
    if (grid < 0) return;
    (void)hipMemsetAsync((char*)d_ws + WS_CTL, 0, CTL_ZERO_BYTES, stream);
    Args a{};
    for (int i = 0; i < 30; ++i) a.in[i] = (const float*)d_in[i];
    a.out = (float*)d_out; a.ws = (unsigned char*)d_ws;
    constexpr int NL = MK_N_LAUNCHES;
    for (int li = 0; li < NL; ++li) {
        a.ph_lo = (NL == 1) ? 0 : li; a.ph_hi = (NL == 1) ? NPHASE : li + 1;
        void* kargs[] = {&a};
        hipError_t e = hipLaunchCooperativeKernel((const void*)hymba_fwd, dim3(grid), dim3(512), kargs, LDS_BYTES, stream);
        if (e != hipSuccess) { fprintf(stderr, "kernel_launch: cooperative launch %d failed: %s (grid %d)\n", li, hipGetErrorString(e), grid); break; }
    }
}
```

```cpp
#include <hip/hip_runtime.h>
#include <hip/hip_cooperative_groups.h>
#include <cstdio>
#include <cstdint>
#include <type_traits>
namespace cg = cooperative_groups;

#ifndef REP_PHASE
#define REP_PHASE -1
#endif
#ifndef TIME_REGION
#define TIME_REGION -1
#endif
#ifndef WGM_P1
#define WGM_P1 2
#endif
#ifndef WGM_P4
#define WGM_P4 2
#endif
#ifndef WGM_P7
#define WGM_P7 2
#endif
#ifndef WGM_P8
#define WGM_P8 2
#endif
#ifndef MK_N_LAUNCHES
#define MK_N_LAUNCHES 1
#endif

#define LAS __attribute__((address_space(3)))
#define GAS __attribute__((address_space(1)))
typedef unsigned short bf16_t;
typedef short bf16x8 __attribute__((ext_vector_type(8)));
typedef short s16x4 __attribute__((ext_vector_type(4)));
typedef float f32x2 __attribute__((ext_vector_type(2)));
typedef float f32x4 __attribute__((ext_vector_type(4)));
typedef float f32x16 __attribute__((ext_vector_type(16)));
typedef unsigned u32x2 __attribute__((ext_vector_type(2)));
typedef unsigned u32x4 __attribute__((ext_vector_type(4)));
typedef int v8i32 __attribute__((ext_vector_type(8)));

constexpr int NB = 8, SEQ = 4096, T = NB * SEQ, D = 1024;
constexpr int CW = 512;
constexpr int NRW = 1696, NIN = 3232, NINP = 3328;
constexpr int DQ0 = 1696, DK0 = 2208, DV0 = 2720;
constexpr int NE = 32, TOPK = 4, DE = 1024;
constexpr int MAXROWS = T * TOPK + NE * 256;
constexpr int MAXTILES = MAXROWS / 256;
constexpr float LOG2E = 1.4426950408889634f;
constexpr float F8_W_MUL = 32.f, F8_X_MUL = 8.f, F8_H_MUL = 4.f, F8_Y_MUL = 16.f; constexpr int F8_W_SC = 0x7A7A7A7A, F8_X_SC = 0x7C7C7C7C, F8_H_SC = 0x7D7D7D7D;

constexpr size_t MiB = 1u << 20;
constexpr size_t WS_CTL = 0, CTL_ZERO_BYTES = 64 * 1024;
constexpr size_t WS_TILEE = 512 * 1024;
constexpr size_t WS_LW = 576 * 1024;
constexpr size_t WS_WINT = 1 * MiB;
constexpr size_t WS_WOUT = 8 * MiB;
constexpr size_t WS_W1T = 10 * MiB;
constexpr size_t WS_W2T = 138 * MiB;
constexpr size_t WS_EIDX = 202 * MiB;
constexpr size_t WS_GATE = WS_EIDX + 512 * 1024;
constexpr size_t WS_POS = WS_GATE + 512 * 1024;
constexpr size_t WS_DEST = WS_POS + 512 * 1024;
constexpr size_t WS_ROWGATE = 204 * MiB;
constexpr size_t WS_XN = 206 * MiB;
constexpr size_t WS_P = 270 * MiB;
constexpr size_t WS_SR = 478 * MiB, WS_SK = 510 * MiB, WS_SV = 542 * MiB, WS_SA = 574 * MiB, WS_SB = 606 * MiB;
constexpr size_t WS_SW = 638 * MiB;
constexpr size_t WS_SG = 702 * MiB;
constexpr size_t WS_QN = 734 * MiB, WS_KN = 766 * MiB;
constexpr size_t WS_YMIX = 798 * MiB;
constexpr size_t WS_H2 = 206 * MiB;
constexpr size_t WS_ROWTOK = 270 * MiB;
constexpr size_t WS_HID = 406 * MiB;
constexpr size_t WS_YS = 542 * MiB;
constexpr size_t WS_X1B = 862 * MiB;
constexpr size_t WS_CG = 862 * MiB;
constexpr size_t WS_CH = 894 * MiB;
constexpr size_t WS_CR2 = 926 * MiB;
constexpr size_t WS_CY0 = 958 * MiB;
constexpr size_t WS_RK = 990 * MiB;
constexpr size_t WS_VT = 992 * MiB;
constexpr size_t WS_END = 1024 * MiB;
constexpr int CW_CNT = 64;
constexpr int CW_ATTQ = 128;
constexpr int CW_BAR = 4096;

constexpr int RING_BYTES = 131072, MISC_OFF = RING_BYTES, LDS_BYTES = 147456;

__device__ __forceinline__ unsigned f2bf(float f) { unsigned u = __builtin_bit_cast(unsigned, f); return (u + 0x7fffu + ((u >> 16) & 1u)) >> 16; }
typedef __bf16 hwbf16x2 __attribute__((ext_vector_type(2)));
__device__ __forceinline__ unsigned pk2(float lo, float hi) { const f32x2 v = {lo, hi}; return __builtin_bit_cast(unsigned, __builtin_convertvector(v, hwbf16x2)); }
__device__ __forceinline__ unsigned pk4_fp8(float a, float b, float c, float d) {
    a = fminf(fmaxf(a, -448.f), 448.f); b = fminf(fmaxf(b, -448.f), 448.f); c = fminf(fmaxf(c, -448.f), 448.f); d = fminf(fmaxf(d, -448.f), 448.f);
    int r = __builtin_amdgcn_cvt_pk_fp8_f32(a, b, 0, false); r = __builtin_amdgcn_cvt_pk_fp8_f32(c, d, r, true); return (unsigned)r; }
__device__ __forceinline__ float bf2f(unsigned short b) { return __builtin_bit_cast(float, (unsigned)b << 16); }
__device__ __forceinline__ float bflo(unsigned w) { return __builtin_bit_cast(float, w << 16); }
__device__ __forceinline__ float bfhi(unsigned w) { return __builtin_bit_cast(float, w & 0xffff0000u); }
__device__ __forceinline__ float wave_sum(float v) {
#pragma unroll
    for (int o = 1; o < 64; o <<= 1) v += __shfl_xor(v, o);
    return v;
}
__device__ __forceinline__ float sigmoidf_(float x) { return 1.0f / (1.0f + __expf(-x)); }
template <int CTRL> __device__ __forceinline__ float dpp_f(float v) { return __builtin_bit_cast(float, __builtin_amdgcn_update_dpp(0, __builtin_bit_cast(int, v), CTRL, 0xF, 0xF, true)); }
__device__ __forceinline__ float red8(float v) {
    v += dpp_f<0xB1>(v);
    v += dpp_f<0x4E>(v);
    v += dpp_f<0x141>(v);
    return v;
}
__device__ __forceinline__ float red4(float v) { v += dpp_f<0xB1>(v); v += dpp_f<0x4E>(v); return v; }


#define XB_TMO      128
#define XB_XCNT(j)  (256  + 64 * (j))
#define XB_XSUB(j)  (1280 + 64 * (j))
#define XB_XGEN(j)  (2304 + 64 * (j))
#define XB_TOP      3328
#define XB_TOPGEN   3392
#define XCD_BAR_WORDS 3456
#define XB_SPIN_CAP (1u << 18)
__device__ __forceinline__ unsigned xb_ld(unsigned* p)              { return __hip_atomic_load(p, __ATOMIC_RELAXED, __HIP_MEMORY_SCOPE_AGENT); }
__device__ __forceinline__ unsigned xb_add(unsigned* p, unsigned v) { return __hip_atomic_fetch_add(p, v, __ATOMIC_RELAXED, __HIP_MEMORY_SCOPE_AGENT); }
__device__ __forceinline__ unsigned xb_xcc_id() { return (unsigned)__builtin_amdgcn_s_getreg((3 << 11) | 20) & 0xFu; }
#define XB_SPIN(cond, bar) do { unsigned _sp = 0; while (cond) { __builtin_amdgcn_s_sleep(1); \
    if ((++_sp & 255u) == 0u) { if (xb_ld(&(bar)[XB_TMO])) break; if (_sp > XB_SPIN_CAP) { atomicAdd(&(bar)[XB_TMO], 1u); break; } } } } while (0)
struct XcdBarrier { unsigned* bar; unsigned x; volatile LAS unsigned* st; };
__device__ __forceinline__ XcdBarrier xcd_barrier_post(unsigned* bar, volatile LAS unsigned* st) {
    XcdBarrier b; b.bar = bar; b.x = xb_xcc_id(); b.st = st;
    if (threadIdx.x == 0) (void)xb_add(&bar[XB_XCNT(b.x)], 1u);
    return b;
}
__device__ __forceinline__ void xcd_barrier_complete(unsigned* bar, unsigned x, unsigned& nloc, unsigned& nx) {
    const unsigned G = gridDim.x * gridDim.y * gridDim.z;
    unsigned sum, cnt, mine, sp = 0u;
    for (;;) {
        sum = 0u; cnt = 0u; mine = 0u;
#pragma unroll
        for (unsigned j = 0; j < 16; ++j) { const unsigned c = xb_ld(&bar[XB_XCNT(j)]); sum += c; cnt += (c > 0u) ? 1u : 0u; mine = (j == x) ? c : mine; }
        if (sum == G) break;
        __builtin_amdgcn_s_sleep(1);
        if ((++sp & 255u) == 0u) { if (xb_ld(&bar[XB_TMO])) break; if (sp > XB_SPIN_CAP) { atomicAdd(&bar[XB_TMO], 1u); break; } }
    }
    nloc = mine > 0u ? mine : 1u; nx = cnt > 0u ? cnt : 1u;
}
__device__ __forceinline__ void xcd_barrier(const XcdBarrier& b) {
    asm volatile("s_waitcnt vmcnt(0)" ::: "memory");
    __syncthreads();
    if (threadIdx.x == 0) {
        unsigned* bar = b.bar;
        __builtin_amdgcn_s_waitcnt(0);
        unsigned nloc = b.st[0], nx = b.st[1];
        if (nloc == 0u) { xcd_barrier_complete(bar, b.x, nloc, nx); b.st[0] = nloc; b.st[1] = nx; }
        const unsigned old = xb_add(&bar[XB_XSUB(b.x)], 1u);
        const unsigned gen = old / nloc;
        if (old + 1u == (gen + 1u) * nloc) {
            __builtin_amdgcn_fence(__ATOMIC_RELEASE, "agent");
            asm volatile("s_waitcnt vmcnt(0)" ::: "memory");
            const unsigned og = xb_add(&bar[XB_TOP], 1u);
            const unsigned tg = og / nx;
            if (og + 1u == (tg + 1u) * nx) xb_add(&bar[XB_TOPGEN], 1u);
            else XB_SPIN(xb_ld(&bar[XB_TOPGEN]) == tg, bar);
            __builtin_amdgcn_fence(__ATOMIC_ACQUIRE, "agent");
            xb_add(&bar[XB_XGEN(b.x)], 1u);
            asm volatile("s_waitcnt vmcnt(0)" ::: "memory");
        } else {
            XB_SPIN(xb_ld(&bar[XB_XGEN(b.x)]) == gen, bar);
            __builtin_amdgcn_fence(__ATOMIC_ACQUIRE, "agent");
            asm volatile("s_waitcnt vmcnt(0)" ::: "memory");
        }
    }
    __syncthreads();
}

namespace pg8 {
constexpr int BM = 256, BK = 64, HALF = 128, HTB = HALF * BK * 2, STAGE_BYTES = 8 * HTB, NXCD = 8;
__host__ __device__ __forceinline__ int lds_byte(int r, int c) { const int st = (r >> 4) * 2 + (c >> 5), rr = r & 15, cc = c & 31, ob = rr * 64 + cc * 2; return st * 1024 + (ob ^ (((ob >> 9) & 1) << 5)); }
__host__ __device__ __forceinline__ void stage_rc(int b, int& R, int& C) { const int st = b / 1024, sb = b % 1024, swz = sb ^ (((sb >> 9) & 1) << 5); R = (st >> 1) * 16 + swz / 64; C = (st & 1) * 32 + (swz % 64) / 2; }
__host__ __device__ __forceinline__ int f8_swz(int fr) { return ((fr >> 1) & 3) | ((((fr + 4) >> 3) & 1) << 2); }
__host__ __device__ __forceinline__ void stage_rc_f8(int b, int& R, int& C) { const int p = b >> 10, l = (b >> 4) & 63, fr = (p & 1) * 8 + (l >> 3); R = (p >> 1) * 16 + fr; C = ((l & 7) ^ f8_swz(fr)) * 8; }
__host__ __device__ __forceinline__ int frag_f8(int row0, int fr, int fq, int j) { return (row0 >> 4) * 2048 + (fr >> 3) * 1024 + (fr & 7) * 128 + (((2 * fq + j) ^ f8_swz(fr)) * 16); }
__host__ __device__ __forceinline__ int perm32(int rho) { const int n = rho >> 4, i = rho & 15; return 8 * (i >> 2) + 4 * n + (i & 3); }

struct Unit { int pm, pn, pb; };
struct Gemm { const void* A; const void* Bt; int K; int scW, scA; const int* rowtok; };

struct TileOrder {
    int nM, nN, nwg, G, c, WGM; const int* tile_e; int nb_per_e;
    __device__ void init(int nM_, int nN_, int G_, int c_, const int* te, int nbe, int wgm) { nM = nM_; nN = nN_; nwg = nM * nN; G = G_; c = c_; tile_e = te; nb_per_e = nbe; WGM = wgm; }
    __device__ bool next(int i, Unit& u) const {
        const long L = (long)i * G + c; if (L >= nwg) return false;
        int wgid = (int)L; { const int q = nwg / NXCD, r = nwg % NXCD, xcd = wgid % NXCD, off = wgid / NXCD; wgid = (xcd < r ? xcd * (q + 1) : r * (q + 1) + (xcd - r) * q) + off; }
        const int nig = WGM * nN, gid = wgid / nig, fm = gid * WGM, gsz = (nM - fm) < WGM ? (nM - fm) : WGM;
        u.pm = fm + ((wgid % nig) % gsz); u.pn = (wgid % nig) / gsz;
        u.pb = tile_e ? tile_e[u.pm] * nb_per_e + u.pn : u.pn;
        return true;
    }
};

struct EpiBf16 {
    static constexpr bool PERM = true;
    bf16_t* O; int ldc; bf16_t* VT;
    __device__ __forceinline__ void operator()(const f32x4 (&acc)[2][2][4][2], const Unit& u, int wr, int wc, int fr, int fq) const {
        const int row0 = u.pm * BM + wr * 64 + fr; const int col0 = u.pn * BM + wc * 32 + 8 * fq;
#pragma unroll
        for (int ai = 0; ai < 2; ++ai)
#pragma unroll
            for (int m = 0; m < 4; ++m) { const int t = row0 + ai * HALF + m * 16; bf16_t* rowp = O + (size_t)t * ldc + col0;
#pragma unroll
                for (int bj = 0; bj < 2; ++bj) { const f32x4 v0 = acc[ai][bj][m][0], v1 = acc[ai][bj][m][1];
                    u32x4 w; w.x = pk2(v0[0], v0[1]); w.y = pk2(v0[2], v0[3]); w.z = pk2(v1[0], v1[1]); w.w = pk2(v1[2], v1[3]);
                    const int col = col0 + bj * HALF;
                    if (col >= DV0) { const int dvf = col - DV0, hh = dvf >> 7, dv = dvf & 127, tp = t & (SEQ - 1), key = tp & 63;
                        bf16_t* vp = VT + (((((size_t)((t >> 12) * 4 + hh) * 64 + (tp >> 6)) * 4 + (dv >> 5)) * 4 + (key >> 4)) * 16 + (key & 15)) * 32 + (dv & 31);
                        if (col < NIN) *(u32x4*)vp = w; }
                    else *(u32x4*)(rowp + bj * HALF) = w; } }
    }
};
struct EpiResBf16 {
    static constexpr bool PERM = true;
    const float* base; bf16_t* out; int ldc;
    __device__ __forceinline__ void operator()(const f32x4 (&acc)[2][2][4][2], const Unit& u, int wr, int wc, int fr, int fq) const {
        const int col0 = u.pn * BM + wc * 32 + 8 * fq;
#pragma unroll
        for (int ai = 0; ai < 2; ++ai) {
            f32x4 bb[4][2][2];
#pragma unroll
            for (int m = 0; m < 4; ++m) { const size_t off = (size_t)(u.pm * BM + ai * HALF + wr * 64 + m * 16 + fr) * ldc + col0;
#pragma unroll
                for (int bj = 0; bj < 2; ++bj) { bb[m][bj][0] = *(const f32x4*)(base + off + bj * HALF); bb[m][bj][1] = *(const f32x4*)(base + off + bj * HALF + 4); } }
            __builtin_amdgcn_sched_barrier(0);
#pragma unroll
            for (int m = 0; m < 4; ++m) { const size_t off = (size_t)(u.pm * BM + ai * HALF + wr * 64 + m * 16 + fr) * ldc + col0;
#pragma unroll
                for (int bj = 0; bj < 2; ++bj) {
                    const f32x4 v0 = bb[m][bj][0] + acc[ai][bj][m][0], v1 = bb[m][bj][1] + acc[ai][bj][m][1];
                    u32x4 w; w.x = pk2(v0[0], v0[1]); w.y = pk2(v0[2], v0[3]); w.z = pk2(v1[0], v1[1]); w.w = pk2(v1[2], v1[3]);
                    *(u32x4*)(out + off + bj * HALF) = w; } }
            __builtin_amdgcn_sched_barrier(0);
        }
    }
};
struct EpiSwiglu {
    static constexpr bool PERM = true;
    unsigned char* O; const float* b1; const int* tile_e;
    __device__ __forceinline__ void operator()(const f32x4 (&acc)[2][2][4][2], const Unit& u, int wr, int wc, int fr, int fq) const {
        const int e = tile_e[u.pm]; const int row0 = u.pm * BM + wr * 64 + fr; const int hc0 = u.pn * 128 + wc * 32 + 8 * fq;
        const float* bg = b1 + (size_t)e * 2048 + hc0; const float* bl = bg + 1024;
        const f32x4 g0 = *(const f32x4*)bg, g1 = *(const f32x4*)(bg + 4), l0 = *(const f32x4*)bl, l1 = *(const f32x4*)(bl + 4);
#pragma unroll
        for (int ai = 0; ai < 2; ++ai)
#pragma unroll
            for (int m = 0; m < 4; ++m) { unsigned char* rowp = O + (size_t)(row0 + ai * HALF + m * 16) * 1024 + hc0;
                float o[8];
#pragma unroll
                for (int n = 0; n < 2; ++n) { const f32x4 gv = acc[ai][0][m][n] + (n ? g1 : g0), lv = acc[ai][1][m][n] + (n ? l1 : l0);
#pragma unroll
                    for (int i = 0; i < 4; ++i) { const float g = fminf(gv[i], 7.0f), l = fminf(fmaxf(lv[i], -7.0f), 7.0f);
                        const float sg = __builtin_amdgcn_rcpf(1.0f + __builtin_amdgcn_exp2f(-1.702f * LOG2E * g)); o[n * 4 + i] = g * sg * (l + 1.0f); } }
                u32x2 w; w.x = pk4_fp8(o[0] * F8_H_MUL, o[1] * F8_H_MUL, o[2] * F8_H_MUL, o[3] * F8_H_MUL); w.y = pk4_fp8(o[4] * F8_H_MUL, o[5] * F8_H_MUL, o[6] * F8_H_MUL, o[7] * F8_H_MUL);
                *(u32x2*)rowp = w; }
    }
};
struct EpiGateF8 {
    static constexpr bool PERM = true;
    unsigned char* O; const float* b2; const float* rowgate; const int* tile_e;
    __device__ __forceinline__ void operator()(const f32x4 (&acc)[2][2][4][2], const Unit& u, int wr, int wc, int fr, int fq) const {
        const int e = tile_e[u.pm]; const int row0 = u.pm * BM + wr * 64 + fr; const int col0 = u.pn * BM + wc * 32 + 8 * fq;
        f32x4 bv[2][2];
#pragma unroll
        for (int bj = 0; bj < 2; ++bj)
#pragma unroll
            for (int n = 0; n < 2; ++n) bv[bj][n] = *(const f32x4*)(b2 + (size_t)e * 1024 + col0 + bj * HALF + 4 * n);
#pragma unroll
        for (int ai = 0; ai < 2; ++ai)
#pragma unroll
            for (int m = 0; m < 4; ++m) { const int row = row0 + ai * HALF + m * 16; const float gt = rowgate[row] * F8_Y_MUL; unsigned char* rowp = O + (size_t)row * 1024 + col0;
#pragma unroll
                for (int bj = 0; bj < 2; ++bj) { const f32x4 v0 = (acc[ai][bj][m][0] + bv[bj][0]) * gt, v1 = (acc[ai][bj][m][1] + bv[bj][1]) * gt;
                    u32x2 w; w.x = pk4_fp8(v0[0], v0[1], v0[2], v0[3]); w.y = pk4_fp8(v1[0], v1[1], v1[2], v1[3]);
                    *(u32x2*)(rowp + bj * HALF) = w; } }
    }
};

__device__ __forceinline__ v8i32 pg8_ld32(const LAS unsigned char* p, const LAS unsigned char* q) { const u32x4 a = *(const LAS u32x4*)p, b = *(const LAS u32x4*)q;
    return (v8i32){(int)a.x, (int)a.y, (int)a.z, (int)a.w, (int)b.x, (int)b.y, (int)b.z, (int)b.w}; }
template <bool F8, bool GATHER, class Epi, class Sched>
__device__ __forceinline__ void gemm_phase(LAS unsigned char* lds, const Gemm g, const Sched& S, const Epi& E) {
    const int tid = threadIdx.x, wid = __builtin_amdgcn_readfirstlane(tid >> 6), lane = tid & 63, wr = wid >> 2, wc = wid & 3, fr = lane & 15, fq = lane >> 4;
    const int RB = F8 ? g.K : g.K * 2, nt = RB / 128;
    unsigned voffB[2];
#pragma unroll
    for (int i = 0; i < 2; ++i) { int R, C; if constexpr (F8) stage_rc_f8(tid * 16 + i * 8192, R, C); else stage_rc(tid * 16 + i * 8192, R, C); const int Rb = Epi::PERM ? ((R & ~31) + perm32(R & 31)) : R;
        voffB[i] = (unsigned)(Rb * RB + C * 2); }
#define PG8_AOFFS(dst, pm_) do { _Pragma("unroll") for (int h_ = 0; h_ < 2; ++h_) _Pragma("unroll") for (int i_ = 0; i_ < 2; ++i_) { int R_, C_; if constexpr (F8) stage_rc_f8(tid * 16 + i_ * 8192, R_, C_); else stage_rc(tid * 16 + i_ * 8192, R_, C_); \
        const int row_ = (pm_) * BM + h_ * HALF + R_; const unsigned grow_ = GATHER ? (unsigned)g.rowtok[row_] : (unsigned)row_; dst[h_][i_] = grow_ * (unsigned)RB + (unsigned)(C_ * 2); } } while (0)
    unsigned cvA[2][2], nvA[2][2];
    const size_t kstep = (size_t)(BK * 2);
    const size_t hstep = (size_t)HALF * RB;
    const size_t tstep = 2 * hstep;
    const unsigned ldsw = (unsigned)wid * 1024u;
    const int aoff = F8 ? frag_f8(wr * 64, fr, fq, 0) : lds_byte(wr * 64 + fr, fq * 8); const int aoff1 = F8 ? frag_f8(wr * 64, fr, fq, 1) : 0;
    const int boff = F8 ? frag_f8(wc * 32, fr, fq, 0) : lds_byte(wc * 32 + fr, fq * 8); const int boff1 = F8 ? frag_f8(wc * 32, fr, fq, 1) : 0;
    const int scW = g.scW, scA = g.scA;
#define PG8_SA(b, h) (((b) * 2 + (h)) * HTB)
#define PG8_SB(b, h) ((4 + (b) * 2 + (h)) * HTB)
#define PG8_STAGE(bufoff, gbase, voff) do { _Pragma("unroll") for (int _i = 0; _i < 2; ++_i) \
        __builtin_amdgcn_global_load_lds((const unsigned*)((const char*)(gbase) + (voff)[_i]), (LAS unsigned*)(lds + (bufoff) + ldsw + _i * 8192), 16, 0, 0); } while (0)
typedef int v8i32a __attribute__((ext_vector_type(8), aligned(16)));
#define PG8_LD32(p, q) pg8_ld32(p, q)
#define PG8_STAGE_A(bufoff, kptr, offs) do { _Pragma("unroll") for (int _i = 0; _i < 2; ++_i) \
        __builtin_amdgcn_global_load_lds((const unsigned*)((const char*)(kptr) + (offs)[_i]), (LAS unsigned*)(lds + (bufoff) + ldsw + _i * 8192), 16, 0, 0); } while (0)
#define PG8_LDA(dst, b, h) do { _Pragma("unroll") for (int m = 0; m < 4; ++m) { if constexpr (F8) { dst[m].f8 = PG8_LD32(lds + PG8_SA(b, h) + aoff + m * 2048, lds + PG8_SA(b, h) + aoff1 + m * 2048); } \
        else { _Pragma("unroll") for (int k = 0; k < 2; ++k) dst[m].hv[k] = *(const LAS bf16x8*)(lds + PG8_SA(b, h) + aoff + m * 2048 + k * 1024); } } } while (0)
#define PG8_LDB(dst, b, h) do { _Pragma("unroll") for (int n = 0; n < 2; ++n) { if constexpr (F8) { dst[n].f8 = PG8_LD32(lds + PG8_SB(b, h) + boff + n * 2048, lds + PG8_SB(b, h) + boff1 + n * 2048); } \
        else { _Pragma("unroll") for (int k = 0; k < 2; ++k) dst[n].hv[k] = *(const LAS bf16x8*)(lds + PG8_SB(b, h) + boff + n * 2048 + k * 1024); } } } while (0)
#define PG8_MMA(ai, bj, At, Bt) do { __builtin_amdgcn_s_setprio(1); _Pragma("unroll") for (int m = 0; m < 4; ++m) _Pragma("unroll") for (int n = 0; n < 2; ++n) { \
        if constexpr (F8) { asm volatile("v_mfma_scale_f32_16x16x128_f8f6f4 %0, %1, %2, %0, %3, %4 op_sel_hi:[0,0,0]" : "+v"(acc[ai][bj][m][n]) : "v"(Bt[n].f8), "v"(At[m].f8), "v"(scW), "v"(scA)); } \
        else { _Pragma("unroll") for (int k = 0; k < 2; ++k) acc[ai][bj][m][n] = __builtin_amdgcn_mfma_f32_16x16x32_bf16(Bt[n].hv[k], At[m].hv[k], acc[ai][bj][m][n], 0, 0, 0); } } \
        __builtin_amdgcn_s_setprio(0); } while (0)
#define PG8_WAIT_V(n) asm volatile("s_waitcnt vmcnt(" #n ")" ::: "memory")
#define PG8_WAIT_L(n) asm volatile("s_waitcnt lgkmcnt(" #n ")" ::: "memory")
#define PG8_BAR __builtin_amdgcn_s_barrier()
#define PG8_SCHED __builtin_amdgcn_sched_barrier(0)
    Unit cur, nxt; int ui = 0;
    if (!S.next(0, cur)) return;
    f32x4 acc[2][2][4][2];
#pragma unroll
    for (int a = 0; a < 2; ++a)
#pragma unroll
        for (int b = 0; b < 2; ++b)
#pragma unroll
            for (int m = 0; m < 4; ++m)
#pragma unroll
                for (int n = 0; n < 2; ++n) acc[a][b][m][n] = (f32x4){0.f, 0.f, 0.f, 0.f};
    struct FragH { bf16x8 hv[2]; }; struct Frag8 { v8i32 f8; };
    typename std::conditional<F8, Frag8, FragH>::type At[4], B0[2], B1[2];
    const char* const kA = (const char*)g.A; const char* cB = (const char*)g.Bt + (size_t)cur.pb * tstep;
    PG8_AOFFS(cvA, cur.pm);
    PG8_STAGE(PG8_SB(0, 0), cB, voffB); PG8_STAGE(PG8_SB(0, 1), cB + hstep, voffB); PG8_STAGE_A(PG8_SA(0, 0), kA, cvA[0]); PG8_STAGE_A(PG8_SA(0, 1), kA, cvA[1]);
    if (wr == 1) PG8_BAR;
    PG8_WAIT_V(2); PG8_BAR;
    PG8_STAGE(PG8_SB(1, 0), cB + kstep, voffB); PG8_STAGE_A(PG8_SA(1, 0), kA + kstep, cvA[0]); PG8_STAGE(PG8_SB(1, 1), cB + hstep + kstep, voffB);
    PG8_WAIT_V(6); PG8_BAR;
    for (;;) {
        const bool has_next = S.next(ui + 1, nxt);
        const char* nB = has_next ? (const char*)g.Bt + (size_t)nxt.pb * tstep : cB;
        if (has_next) { PG8_AOFFS(nvA, nxt.pm); } else { _Pragma("unroll") for (int h_ = 0; h_ < 2; ++h_) _Pragma("unroll") for (int i_ = 0; i_ < 2; ++i_) nvA[h_][i_] = cvA[h_][i_]; }
#pragma clang loop unroll(disable)
        for (int t = 0; t < nt; t += 2) {
            const bool last = (t == nt - 2);
            const char* a1 = kA + (size_t)(t + 1) * kstep;
            const char* a2 = last ? kA : kA + (size_t)(t + 2) * kstep; const char* b2 = last ? nB : cB + (size_t)(t + 2) * kstep;
            const char* a3 = a2 + kstep; const char* b3 = b2 + kstep;
            unsigned v2A[2][2];
#pragma unroll
            for (int h_ = 0; h_ < 2; ++h_)
#pragma unroll
                for (int i_ = 0; i_ < 2; ++i_) v2A[h_][i_] = last ? nvA[h_][i_] : cvA[h_][i_];
            PG8_LDB(B0, 0, 0); PG8_LDB(B1, 0, 1); PG8_SCHED; PG8_LDA(At, 0, 0); PG8_STAGE_A(PG8_SA(1, 1), a1, cvA[1]);
            PG8_WAIT_V(8); PG8_WAIT_L(0); PG8_BAR; PG8_MMA(0, 0, At, B0); PG8_MMA(0, 1, At, B1); PG8_BAR; PG8_SCHED;
            PG8_LDA(At, 0, 1); PG8_STAGE(PG8_SB(0, 0), b2, voffB); PG8_STAGE(PG8_SB(0, 1), b2 + hstep, voffB); PG8_STAGE_A(PG8_SA(0, 0), a2, v2A[0]);
            PG8_WAIT_V(8); PG8_WAIT_L(0); PG8_BAR; PG8_MMA(1, 0, At, B0); PG8_MMA(1, 1, At, B1); PG8_BAR; PG8_SCHED;
            PG8_LDB(B0, 1, 0); PG8_LDB(B1, 1, 1); PG8_SCHED; PG8_LDA(At, 1, 0); PG8_STAGE_A(PG8_SA(0, 1), a2, v2A[1]);
            PG8_WAIT_V(8); PG8_WAIT_L(0); PG8_BAR; PG8_MMA(0, 0, At, B0); PG8_MMA(0, 1, At, B1); PG8_BAR; PG8_SCHED;
            PG8_LDA(At, 1, 1); PG8_STAGE(PG8_SB(1, 0), b3, voffB); PG8_STAGE(PG8_SB(1, 1), b3 + hstep, voffB); PG8_STAGE_A(PG8_SA(1, 0), a3, v2A[0]);
            PG8_WAIT_V(8); PG8_WAIT_L(0); PG8_BAR; PG8_MMA(1, 0, At, B0); PG8_MMA(1, 1, At, B1); PG8_BAR; PG8_SCHED;
        }
        if (wr == 0) PG8_BAR;
        if constexpr (F8) asm volatile("s_nop 15\n\ts_nop 15" ::: "memory");
        E(acc, cur, wr, wc, fr, fq);
        if (!has_next) break;
#pragma unroll
        for (int a = 0; a < 2; ++a)
#pragma unroll
            for (int b = 0; b < 2; ++b)
#pragma unroll
                for (int m = 0; m < 4; ++m)
#pragma unroll
                    for (int n = 0; n < 2; ++n) acc[a][b][m][n] = (f32x4){0.f, 0.f, 0.f, 0.f};
        cur = nxt; cB = nB; ++ui;
#pragma unroll
        for (int h_ = 0; h_ < 2; ++h_)
#pragma unroll
            for (int i_ = 0; i_ < 2; ++i_) cvA[h_][i_] = nvA[h_][i_];
        if (wr == 1) PG8_BAR;
    }
    PG8_WAIT_V(0);
    PG8_BAR;
#undef PG8_SA
#undef PG8_SB
#undef PG8_STAGE
#undef PG8_STAGE_A
#undef PG8_AOFFS
#undef PG8_LDA
#undef PG8_LDB
#undef PG8_MMA
#undef PG8_LD32
#undef PG8_WAIT_V
#undef PG8_WAIT_L
#undef PG8_BAR
#undef PG8_SCHED
}
}

struct Args { const float* in[30]; float* out; unsigned char* ws; int ph_lo, ph_hi; };

__device__ __forceinline__ void p0_transpose_item(const float* W, int K, int N, bf16_t* WT, int k0, int n0, int drow0, LAS float* scr, int lane) {
#pragma unroll 8
    for (int i = 0; i < 32; ++i) { const int kk = 2 * i + (lane >> 5); scr[kk * 33 + (lane & 31)] = W[(size_t)(k0 + kk) * N + n0 + (lane & 31)]; }
    asm volatile("s_waitcnt lgkmcnt(0)" ::: "memory");
    const int c = lane & 7;
#pragma unroll
    for (int j = 0; j < 4; ++j) { const int n = (lane >> 3) + 8 * j; const LAS float* s = scr + (8 * c) * 33 + n;
        u32x4 o; o.x = pk2(s[0 * 33], s[1 * 33]); o.y = pk2(s[2 * 33], s[3 * 33]); o.z = pk2(s[4 * 33], s[5 * 33]); o.w = pk2(s[6 * 33], s[7 * 33]);
        *(u32x4*)(WT + (size_t)(drow0 + n) * K + k0 + 8 * c) = o; }
    asm volatile("s_waitcnt lgkmcnt(0)" ::: "memory");
}
__device__ __forceinline__ void p0_transpose_item_f8(const float* W, int K, int N, unsigned char* WT, int k0, int n0, int drow0, LAS float* scr, int lane) {
    LAS unsigned* tile = (LAS unsigned*)scr;
    const float* src = W + (size_t)k0 * N + n0 + lane;
#pragma unroll 1
    for (int kb = 0; kb < 32; kb += 16) {
        float v[16][4];
#pragma unroll
        for (int i = 0; i < 16; ++i) { const float* p = src + (size_t)(4 * (kb + i)) * N;
#pragma unroll
            for (int j = 0; j < 4; ++j) v[i][j] = __builtin_nontemporal_load(p + (size_t)j * N); }
        __builtin_amdgcn_sched_barrier(0);
#pragma unroll
        for (int i = 0; i < 16; ++i) tile[lane * 33 + kb + i] = pk4_fp8(v[i][0] * F8_W_MUL, v[i][1] * F8_W_MUL, v[i][2] * F8_W_MUL, v[i][3] * F8_W_MUL);
        __builtin_amdgcn_sched_barrier(0);
    }
    asm volatile("s_waitcnt lgkmcnt(0)" ::: "memory");
    const int c = lane & 7;
#pragma unroll
    for (int j = 0; j < 8; ++j) { const int n = (lane >> 3) + 8 * j; const LAS unsigned* t = tile + n * 33 + 4 * c;
        __builtin_nontemporal_store((u32x4){t[0], t[1], t[2], t[3]}, (u32x4*)(WT + (size_t)(drow0 + n) * K + k0 + 16 * c)); }
    asm volatile("s_waitcnt lgkmcnt(0)" ::: "memory");
}
constexpr int CONV_I_W1 = 8 * 32, CONV_I_W2 = 8 * 16;
constexpr int CONV_ITEMS = NE * (CONV_I_W1 + CONV_I_W2) / 8;
__device__ __forceinline__ void conv_item(LAS unsigned char* lds, const Args& a, int bi) {
    const int lane = threadIdx.x & 63, wave = __builtin_amdgcn_readfirstlane(threadIdx.x >> 6);
    LAS float* scr = (LAS float*)(lds + wave * 16384);
    unsigned char* W1t = a.ws + WS_W1T; unsigned char* W2t = a.ws + WS_W2T;
    int r = bi * 8 + wave;
    if (r < NE * CONV_I_W1) { const int e = r / CONV_I_W1, q = r % CONV_I_W1, kb = q / 32, nb = q % 32; const int n0 = 64 * nb;
        const int drow = (n0 < 1024) ? ((n0 >> 7) * 256 + (n0 & 127)) : (((n0 - 1024) >> 7) * 256 + 128 + ((n0 - 1024) & 127));
        p0_transpose_item_f8(a.in[26] + (size_t)e * 1024 * 2048, 1024, 2048, W1t + (size_t)e * 2048 * 1024, 128 * kb, n0, drow, scr, lane); }
    else { r -= NE * CONV_I_W1; const int e = r / CONV_I_W2, q = r % CONV_I_W2, kb = q / 16, nb = q % 16;
        p0_transpose_item_f8(a.in[28] + (size_t)e * 1024 * 1024, 1024, 1024, W2t + (size_t)e * 1024 * 1024, 128 * kb, 64 * nb, 64 * nb, scr, lane); }
}
__device__ __forceinline__ void p0_prologue(LAS unsigned char* lds, const Args& a, int G) {
    const int tid = threadIdx.x, lane = tid & 63, wave = __builtin_amdgcn_readfirstlane(tid >> 6);
    LAS float* scr = (LAS float*)(lds + wave * 16384);
    const int gw = blockIdx.x * 8 + wave, NGW = G * 8;
    unsigned char* ws = a.ws;
    bf16_t* Wint = (bf16_t*)(ws + WS_WINT); bf16_t* Woutt = (bf16_t*)(ws + WS_WOUT);
    constexpr int I_IN = 16 * (NIN / 32);
    constexpr int I_OUT = 16 * 32;
    constexpr int NITEMS = I_IN + I_OUT;
    for (int it = gw; it < NITEMS; it += NGW) {
        int r = it;
        if (r < I_IN) { const int nblk = NIN / 32, kb = r / nblk, nb = r % nblk; p0_transpose_item(a.in[2], 1024, NIN, Wint, 64 * kb, 32 * nb, 32 * nb, scr, lane); continue; } r -= I_IN;
        { const int kb = r / 32, nb = r % 32; p0_transpose_item(a.in[22], 1024, 1024, Woutt, 64 * kb, 32 * nb, 32 * nb, scr, lane); }
    }
    { bf16_t* LW = (bf16_t*)(ws + WS_LW);
      for (int i = gw * 64 + lane; i < CW * 160; i += NGW * 64) { const int col = i / 160, k = i - col * 160;
          const float v = k < 32 ? a.in[5][k * CW + col] : (k < 64 ? a.in[7][(k - 32) * CW + col] : a.in[8][(k - 64) * CW + col]); LW[i] = (bf16_t)f2bf(v); } }
    const float* x = a.in[0]; const float* g1 = a.in[1]; bf16_t* XN = (bf16_t*)(ws + WS_XN);
    f32x4 gv[4];
#pragma unroll
    for (int j = 0; j < 4; ++j) gv[j] = *((const f32x4*)g1 + lane + 64 * j);
#pragma unroll 4
    for (int m = gw; m < T; m += NGW) {
        const f32x4* xr = (const f32x4*)(x + (size_t)m * D) + lane;
        f32x4 v[4]; float s = 0.f;
#pragma unroll
        for (int j = 0; j < 4; ++j) { v[j] = xr[64 * j]; s += (v[j].x * v[j].x + v[j].y * v[j].y) + (v[j].z * v[j].z + v[j].w * v[j].w); }
        const float rstd = 1.0f / sqrtf(wave_sum(s) * (1.0f / D) + 1e-5f);
        u32x2* o8 = (u32x2*)(XN + (size_t)m * D) + lane;
#pragma unroll
        for (int j = 0; j < 4; ++j) { u32x2 w; w.x = pk2(v[j].x * rstd * gv[j].x, v[j].y * rstd * gv[j].y); w.y = pk2(v[j].z * rstd * gv[j].z, v[j].w * rstd * gv[j].w); o8[64 * j] = w; }
    }
}

__device__ __forceinline__ f32x4 cvlo(const u32x4 u) { return (f32x4){bflo(u.x), bfhi(u.x), bflo(u.y), bfhi(u.y)}; }
__device__ __forceinline__ f32x4 cvhi(const u32x4 u) { return (f32x4){bflo(u.z), bfhi(u.z), bflo(u.w), bfhi(u.w)}; }
__device__ __forceinline__ u32x4 pk8(const f32x4 lo, const f32x4 hi) { u32x4 w; w.x = pk2(lo.x, lo.y); w.y = pk2(lo.z, lo.w); w.z = pk2(hi.x, hi.y); w.w = pk2(hi.z, hi.w); return w; }

namespace ck {
constexpr int PS = 136;
constexpr int O_BT = 0, O_KT = 8704, O_AP = 17408, O_RT = 26112;
constexpr int O_AT = 34816, O_BH = 43008, O_KH = 51200, O_VV = 59392, O_TN = 67584, O_A2 = 75776, O_V2 = 83968;
constexpr int O_L = 92160, LSTR = 68;
constexpr int O_TOT = 109568, O_GC = 111616;
constexpr int O_ACT = 112128;
__device__ __forceinline__ int crow(int r, int hi) { return (r & 3) + 8 * (r >> 2) + 4 * hi; }
__device__ __forceinline__ int voff(int row, int col) { return ((col >> 5) * 4 + (row >> 4)) * 1024 + (row & 15) * 64 + (col & 31) * 2; }
__device__ __forceinline__ s16x4 vtr(const LAS unsigned char* p) { return __builtin_bit_cast(s16x4, __builtin_amdgcn_ds_read_tr16_b64_v4i16((LAS s16x4*)p)); }
__device__ __forceinline__ bf16x8 fragP(const LAS unsigned char* M, int row, int k0, int hi) {
    const LAS unsigned char* p = M + row * PS + (k0 + 4 * hi) * 2; const s16x4 lo = *(const LAS s16x4*)p, h = *(const LAS s16x4*)(p + 16);
    return (bf16x8){lo[0], lo[1], lo[2], lo[3], h[0], h[1], h[2], h[3]}; }
__device__ __forceinline__ bf16x8 fragT(const LAS unsigned char* M, int k0, int colblk, int lane, int hi) {
    const LAS unsigned char* p = M + (colblk * 4 + (k0 >> 4)) * 1024 + ((lane >> 4) & 1) * 32 + (lane & 3) * 8 + (4 * hi + ((lane & 15) >> 2)) * 64;
    const s16x4 lo = vtr(p), h = vtr(p + 512); return (bf16x8){lo[0], lo[1], lo[2], lo[3], h[0], h[1], h[2], h[3]}; }
__device__ __forceinline__ bf16x8 packR(const f32x16& x, int s) {
    u32x4 w; w.x = pk2(x[8 * s], x[8 * s + 1]); w.y = pk2(x[8 * s + 2], x[8 * s + 3]); w.z = pk2(x[8 * s + 4], x[8 * s + 5]); w.w = pk2(x[8 * s + 6], x[8 * s + 7]); return __builtin_bit_cast(bf16x8, w); }
#define CK_MFMA(a, b, c) __builtin_amdgcn_mfma_f32_32x32x16_bf16(a, b, c, 0, 0, 0)
__device__ __forceinline__ f32x16 score(const LAS unsigned char* Am, const LAS unsigned char* Bm, int sblk, int tblk, int mode, int r32, int hi) {
    f32x16 x = f32x16{};
#pragma unroll
    for (int ks = 0; ks < 4; ++ks) x = CK_MFMA(fragP(Am, sblk * 32 + r32, 16 * ks, hi), fragP(Bm, tblk * 32 + r32, 16 * ks, hi), x);
    if (mode) {
        const int t = tblk * 32 + r32;
#pragma unroll
        for (int r = 0; r < 16; ++r) { const int s = sblk * 32 + crow(r, hi); if (mode == 1 ? !(s < t) : !(s <= t)) x[r] = 0.f; }
    }
    return x;
}
__device__ __forceinline__ void storeT_V(LAS unsigned char* M, const f32x16& x, int rb, int c, int hi) {
#pragma unroll
    for (int q = 0; q < 4; ++q) { u32x2 w; w.x = pk2(x[4 * q], x[4 * q + 1]); w.y = pk2(x[4 * q + 2], x[4 * q + 3]); *(LAS u32x2*)(M + voff(c, rb * 32 + 8 * q + 4 * hi)) = w; }
}
__device__ __forceinline__ void storeT_S(LAS unsigned char* M, const f32x16& x, int rb, int c, int hi) {
#pragma unroll
    for (int q = 0; q < 4; ++q) { u32x2 w; w.x = pk2(x[4 * q], x[4 * q + 1]); w.y = pk2(x[4 * q + 2], x[4 * q + 3]); *(LAS u32x2*)(M + c * PS + (rb * 32 + 8 * q + 4 * hi) * 2) = w; }
}

__device__ __forceinline__ void chunk_item(LAS unsigned char* lds, const Args& a, int item) {
    int tid = threadIdx.x; asm volatile("" : "+v"(tid)); int lane = tid & 63; const int wave = __builtin_amdgcn_readfirstlane(tid >> 6);
#define CK_FRESH() asm volatile("" : "+v"(lane)); r32 = lane & 31; hi = lane >> 5
    int r32, hi; CK_FRESH();
    unsigned char* ws = a.ws;
    const bf16_t* SR = (const bf16_t*)(ws + WS_SR); const bf16_t* SK = (const bf16_t*)(ws + WS_SK); const bf16_t* SV = (const bf16_t*)(ws + WS_SV);
    const bf16_t* SA = (const bf16_t*)(ws + WS_SA); const bf16_t* SB = (const bf16_t*)(ws + WS_SB); const float* SW = (const float*)(ws + WS_SW);
    bf16_t* CG = (bf16_t*)(ws + WS_CG) + (size_t)item * 4096; bf16_t* CH = (bf16_t*)(ws + WS_CH) + (size_t)item * 4096;
    bf16_t* CR2 = (bf16_t*)(ws + WS_CR2) + (size_t)item * 4096; bf16_t* CY0 = (bf16_t*)(ws + WS_CY0) + (size_t)item * 4096;
    const int bh = item >> 6, c = item & 63, b = bh >> 3, h = bh & 7, tokc = b * SEQ + c * 64, col0 = h * 64;
    LAS unsigned char* BT = lds + O_BT; LAS unsigned char* KT = lds + O_KT; LAS unsigned char* AP = lds + O_AP; LAS unsigned char* RT = lds + O_RT;
    LAS unsigned char* AT = lds + O_AT; LAS unsigned char* BH = lds + O_BH; LAS unsigned char* KH = lds + O_KH; LAS unsigned char* VV = lds + O_VV;
    LAS unsigned char* TN = lds + O_TN; LAS unsigned char* A2M = lds + O_A2; LAS unsigned char* V2M = lds + O_V2;
    LAS float* L = (LAS float*)(lds + O_L); LAS float* TOT = (LAS float*)(lds + O_TOT); LAS float* GC = (LAS float*)(lds + O_GC);
    {
        const int tl = tid >> 3, c8 = (tid & 7) * 8, cr = col0 + c8, t = tokc + tl;
        const bf16_t* P = (const bf16_t*)(ws + WS_P); const bf16_t* pr = P + (size_t)t * NINP + cr;
        bf16_t* SVo = (bf16_t*)(ws + WS_SV); bf16_t* SGo = (bf16_t*)(ws + WS_SG); bf16_t* QN = (bf16_t*)(ws + WS_QN); bf16_t* KN = (bf16_t*)(ws + WS_KN);
        const float* mu = a.in[3];
        const bool first = (t & (SEQ - 1)) == 0; const u32x4 zz = (u32x4){0u, 0u, 0u, 0u};
#define CK_PK8(v) ((u32x4){pk2(v[0], v[1]), pk2(v[2], v[3]), pk2(v[4], v[5]), pk2(v[6], v[7])})
#define CK_ST_P(M, val_) do { LAS unsigned char* d_ = (M) + tl * PS + c8 * 2; const u32x4 q_ = (val_); *(LAS u32x2*)d_ = (u32x2){q_[0], q_[1]}; *(LAS u32x2*)(d_ + 8) = (u32x2){q_[2], q_[3]}; } while (0)
        float g[8], gp[8], ig[8], gC[8];
        {
            const u32x4 deu = *(const LAS u32x4*)(TN + tl * 128 + c8 * 2); const f32x4 de0 = cvlo(deu), de1 = cvhi(deu);
            float wv[8] = {__builtin_amdgcn_exp2f(de0.x), __builtin_amdgcn_exp2f(de0.y), __builtin_amdgcn_exp2f(de0.z), __builtin_amdgcn_exp2f(de0.w), __builtin_amdgcn_exp2f(de1.x), __builtin_amdgcn_exp2f(de1.y), __builtin_amdgcn_exp2f(de1.z), __builtin_amdgcn_exp2f(de1.w)};
            float p[8];
#pragma unroll
            for (int j = 0; j < 8; ++j) p[j] = wv[j];
#pragma unroll
            for (int d = 8; d < 64; d <<= 1) {
#pragma unroll
                for (int j = 0; j < 8; ++j) { const float q = __shfl_up(p[j], d); if (lane >= d) p[j] *= q; }
            }
            if ((lane >> 3) == 7) { *(LAS f32x4*)(TOT + wave * 64 + c8) = (f32x4){p[0], p[1], p[2], p[3]}; *(LAS f32x4*)(TOT + wave * 64 + c8 + 4) = (f32x4){p[4], p[5], p[6], p[7]}; }
            __syncthreads();
            float pre[8];
#pragma unroll
            for (int j = 0; j < 8; ++j) { pre[j] = 1.f; gC[j] = 1.f; }
#pragma unroll
            for (int w2 = 0; w2 < 8; ++w2) { const f32x4 t0 = *(const LAS f32x4*)(TOT + w2 * 64 + c8), t1 = *(const LAS f32x4*)(TOT + w2 * 64 + c8 + 4);
                const float tv[8] = {t0.x, t0.y, t0.z, t0.w, t1.x, t1.y, t1.z, t1.w};
#pragma unroll
                for (int j = 0; j < 8; ++j) { if (w2 < wave) pre[j] *= tv[j]; gC[j] *= tv[j]; } }
            if (tid < 8) { *(LAS f32x4*)(GC + c8) = (f32x4){gC[0], gC[1], gC[2], gC[3]}; *(LAS f32x4*)(GC + c8 + 4) = (f32x4){gC[4], gC[5], gC[6], gC[7]}; }
#pragma unroll
            for (int j = 0; j < 8; ++j) { g[j] = pre[j] * p[j]; ig[j] = __builtin_amdgcn_rcpf(g[j]); gp[j] = g[j] * __builtin_amdgcn_rcpf(wv[j]); }
        }
        f32x4 r0, r1;
        { const u32x4 cu = *(const u32x4*)(pr), pu = first ? zz : *(const u32x4*)(pr - NINP);
          const f32x4 m0 = *(const f32x4*)(mu + cr), m1 = *(const f32x4*)(mu + cr + 4); const f32x4 c0 = cvlo(cu), c1 = cvhi(cu), p0 = cvlo(pu), p1 = cvhi(pu);
          r0 = c0 + (p0 - c0) * m0; r1 = c1 + (p1 - c1) * m1;
          const float rt[8] = {r0.x * g[0], r0.y * g[1], r0.z * g[2], r0.w * g[3], r1.x * g[4], r1.y * g[5], r1.z * g[6], r1.w * g[7]};
          CK_ST_P(RT, CK_PK8(rt)); }
        { const u32x4 cu = *(const u32x4*)(pr + 1024), pu = first ? zz : *(const u32x4*)(pr - NINP + 1024);
          const f32x4 m0 = *(const f32x4*)(mu + 1024 + cr), m1 = *(const f32x4*)(mu + 1024 + cr + 4); const f32x4 c0 = cvlo(cu), c1 = cvhi(cu), p0 = cvlo(pu), p1 = cvhi(pu);
          const u32x4 uv = pk8(c0 + (p0 - c0) * m0, c1 + (p1 - c1) * m1); *(u32x4*)(SVo + (size_t)t * CW + cr) = uv; *(LAS u32x4*)(VV + voff(tl, c8)) = uv; }
        *(u32x4*)(SGo + (size_t)t * CW + cr) = *(const LAS u32x4*)(V2M + tl * 128 + c8 * 2);
        { const u32x4 cu = *(const u32x4*)(pr + 512), pu = first ? zz : *(const u32x4*)(pr - NINP + 512);
          const f32x4 m0 = *(const f32x4*)(mu + 512 + cr), m1 = *(const f32x4*)(mu + 512 + cr + 4); const f32x4 c0 = cvlo(cu), c1 = cvhi(cu), p0 = cvlo(pu), p1 = cvhi(pu);
          const f32x4 k0 = c0 + (p0 - c0) * m0, k1 = c1 + (p1 - c1) * m1;
          const u32x4 alu = *(const LAS u32x4*)(A2M + tl * 128 + c8 * 2); const f32x4 al0 = cvlo(alu), al1 = cvhi(alu);
          const f32x4 kk0 = k0 * *(const f32x4*)(a.in[9] + cr), kk1 = k1 * *(const f32x4*)(a.in[9] + cr + 4);
          const float ss = red8((kk0.x * kk0.x + kk0.y * kk0.y) + (kk0.z * kk0.z + kk0.w * kk0.w) + (kk1.x * kk1.x + kk1.y * kk1.y) + (kk1.z * kk1.z + kk1.w * kk1.w));
          const float inv = 1.0f / sqrtf(fmaxf(ss, 1e-24f));
          const f32x4 kn0 = kk0 * inv, kn1 = kk1 * inv;
          const f32x4 k20 = k0 * (1.0f + (al0 - 1.0f) * *(const f32x4*)(a.in[10] + cr)), k21 = k1 * (1.0f + (al1 - 1.0f) * *(const f32x4*)(a.in[10] + cr + 4));
          { const f32x4 q0 = r0 * k20 * *(const f32x4*)(a.in[11] + cr), q1 = r1 * k21 * *(const f32x4*)(a.in[11] + cr + 4);
            const float rk = red8((q0.x + q0.y) + (q0.z + q0.w) + (q1.x + q1.y) + (q1.z + q1.w));
            if ((lane & 7) == 0) ((float*)(ws + WS_RK))[(size_t)t * 8 + h] = rk; }
          const float kv[8] = {k20.x, k20.y, k20.z, k20.w, k21.x, k21.y, k21.z, k21.w}, nv[8] = {kn0.x, kn0.y, kn0.z, kn0.w, kn1.x, kn1.y, kn1.z, kn1.w}, av_[8] = {al0.x, al0.y, al0.z, al0.w, al1.x, al1.y, al1.z, al1.w};
          float at[8], bt[8], kt[8], bh[8], kh[8];
#pragma unroll
          for (int j = 0; j < 8; ++j) { at[j] = -nv[j] * gp[j]; bt[j] = nv[j] * av_[j] * ig[j]; kt[j] = kv[j] * ig[j]; bh[j] = bt[j] * gC[j]; kh[j] = kt[j] * gC[j]; }
          const u32x4 wa = CK_PK8(at);
          CK_ST_P(AP, wa); *(LAS u32x4*)(AT + voff(tl, c8)) = wa;
          CK_ST_P(BT, CK_PK8(bt)); CK_ST_P(KT, CK_PK8(kt));
          *(LAS u32x4*)(BH + voff(tl, c8)) = CK_PK8(bh); *(LAS u32x4*)(KH + voff(tl, c8)) = CK_PK8(kh); }
        { const u32x4 uq = *(const u32x4*)(pr + DQ0), ukd = *(const u32x4*)(pr + DK0);
          const f32x4 q0 = cvlo(uq), q1 = cvhi(uq), d0 = cvlo(ukd), d1 = cvhi(ukd);
          const float qs = red8((q0.x * q0.x + q0.y * q0.y) + (q0.z * q0.z + q0.w * q0.w) + (q1.x * q1.x + q1.y * q1.y) + (q1.z * q1.z + q1.w * q1.w));
          const float ks = red8((d0.x * d0.x + d0.y * d0.y) + (d0.z * d0.z + d0.w * d0.w) + (d1.x * d1.x + d1.y * d1.y) + (d1.z * d1.z + d1.w * d1.w));
          const float qi = (1.0f / sqrtf(qs * (1.0f / 64.0f) + 1e-5f)) * (0.125f * LOG2E), ki = 1.0f / sqrtf(ks * (1.0f / 64.0f) + 1e-5f);
          const f32x4 g0 = *(const f32x4*)(a.in[14] + c8), g1 = *(const f32x4*)(a.in[14] + c8 + 4), h0 = *(const f32x4*)(a.in[15] + c8), h1 = *(const f32x4*)(a.in[15] + c8 + 4);
          *(u32x4*)(QN + (size_t)t * CW + cr) = pk8(q0 * qi * g0, q1 * qi * g1);
          const size_t ko = ((((size_t)(b * 8 + h) * 64 + c) * 8 + (c8 >> 3)) * 64 + tl) * 8;
          *(u32x4*)(KN + ko) = pk8(d0 * ki * h0, d1 * ki * h1); }
#undef CK_PK8
#undef CK_ST_P
    }
    __syncthreads();
    CK_FRESH();
    f32x16 pa = f32x16{}, pb = f32x16{}, pc = f32x16{}, pd = f32x16{};
#define w1a pa
#define w1b pb
#define xb0 pa
#define xb1 pb
#define y0a pc
#define y0b pd
    if (wave < 2) {
        for (int k = 0; k < (wave == 0 ? 2 : 1); ++k) {
            const int sblk = wave == 0 ? k : 0, tblk = wave == 0 ? k : 1;
            const f32x16 x = score(BT, AP, sblk, tblk, wave == 0 ? 1 : 0, r32, hi);
            const int t = tblk * 32 + r32;
#pragma unroll
            for (int r = 0; r < 16; ++r) L[(sblk * 32 + crow(r, hi)) * LSTR + t] = x[r];
        }
    }
    __syncthreads();
    CK_FRESH();
    if (wave == 6) {
        float x[32];
#pragma unroll
        for (int t = 0; t < 32; ++t) x[t] = (r32 == t) ? 1.f : 0.f;
        const LAS float* Nr = L + (32 * hi) * LSTR + 32 * hi;
#pragma unroll
        for (int sidx = 0; sidx < 31; ++sidx) {
#pragma unroll
            for (int g4 = (sidx + 1) / 4; g4 < 8; ++g4) {
                const f32x4 nv = *(const LAS f32x4*)(Nr + sidx * LSTR + 4 * g4);
                if (4 * g4 + 0 > sidx) x[4 * g4 + 0] += nv.x * x[sidx];
                if (4 * g4 + 1 > sidx) x[4 * g4 + 1] += nv.y * x[sidx];
                if (4 * g4 + 2 > sidx) x[4 * g4 + 2] += nv.z * x[sidx];
                if (4 * g4 + 3 > sidx) x[4 * g4 + 3] += nv.w * x[sidx];
            }
            if ((sidx & 3) == 3) __builtin_amdgcn_sched_barrier(0);
        }
        const int cc = 32 * hi + r32;
#pragma unroll
        for (int t0 = 0; t0 < 32; t0 += 8) { u32x4 w; w.x = pk2(x[t0], x[t0 + 1]); w.y = pk2(x[t0 + 2], x[t0 + 3]); w.z = pk2(x[t0 + 4], x[t0 + 5]); w.w = pk2(x[t0 + 6], x[t0 + 7]);
            *(LAS u32x4*)(TN + voff(cc, 32 * hi + t0)) = w; }
        f32x16 m = f32x16{};
#pragma unroll
        for (int s = 0; s < 2; ++s) {
            const LAS float* lp = L + (16 * s + 4 * hi) * LSTR + 32 + r32;
            u32x4 aw; aw.x = pk2(lp[0], lp[LSTR]); aw.y = pk2(lp[2 * LSTR], lp[3 * LSTR]); aw.z = pk2(lp[8 * LSTR], lp[9 * LSTR]); aw.w = pk2(lp[10 * LSTR], lp[11 * LSTR]);
            const s16x4 b0 = *(const LAS s16x4*)(TN + voff(r32, 16 * s + 4 * hi)), b1 = *(const LAS s16x4*)(TN + voff(r32, 16 * s + 8 + 4 * hi));
            m = CK_MFMA(__builtin_bit_cast(bf16x8, aw), ((bf16x8){b0[0], b0[1], b0[2], b0[3], b1[0], b1[1], b1[2], b1[3]}), m);
        }
        f32x16 t21 = f32x16{};
#pragma unroll
        for (int s = 0; s < 2; ++s) t21 = CK_MFMA(fragT(TN, 32 + 16 * s, 1, lane, hi), packR(m, s), t21);
        storeT_V(TN, t21, 1, r32, hi);
    } else if (wave < 4) {
        const int dvb = wave - 2;
        const f32x16 x00 = score(KT, AP, 0, 0, 1, r32, hi), x01 = score(KT, AP, 0, 1, 0, r32, hi), x11 = score(KT, AP, 1, 1, 1, r32, hi);
#pragma unroll
        for (int s = 0; s < 2; ++s) {
            const bf16x8 v0 = fragT(VV, 16 * s, dvb, lane, hi), v1 = fragT(VV, 32 + 16 * s, dvb, lane, hi);
            w1a = CK_MFMA(packR(x00, s), v0, w1a);
            w1b = CK_MFMA(packR(x01, s), v0, w1b);
            w1b = CK_MFMA(packR(x11, s), v1, w1b);
        }
    } else if (wave < 6) {
        const int tb = wave - 4;
        f32x16 xk0, xk1 = f32x16{};
        if (tb == 0) { xk0 = score(KT, RT, 0, 0, 2, r32, hi); xb0 = score(BT, RT, 0, 0, 2, r32, hi); }
        else { xk0 = score(KT, RT, 0, 1, 0, r32, hi); xk1 = score(KT, RT, 1, 1, 2, r32, hi); xb0 = score(BT, RT, 0, 1, 0, r32, hi); xb1 = score(BT, RT, 1, 1, 2, r32, hi); }
#pragma unroll
        for (int s = 0; s < 2; ++s) {
            y0a = CK_MFMA(fragT(VV, 16 * s, 0, lane, hi), packR(xk0, s), y0a);
            y0b = CK_MFMA(fragT(VV, 16 * s, 1, lane, hi), packR(xk0, s), y0b);
            if (tb == 1) { y0a = CK_MFMA(fragT(VV, 32 + 16 * s, 0, lane, hi), packR(xk1, s), y0a); y0b = CK_MFMA(fragT(VV, 32 + 16 * s, 1, lane, hi), packR(xk1, s), y0b); }
        }
    }
    __syncthreads();
    CK_FRESH();
    if (wave < 2) {
        const int cb = wave; f32x16 a0 = f32x16{}, a1 = f32x16{};
#pragma unroll
        for (int ks = 0; ks < 4; ++ks) {
            const bf16x8 af = fragT(AT, 16 * ks, cb, lane, hi);
            if (ks < 2) a0 = CK_MFMA(af, fragT(TN, 16 * ks, 0, lane, hi), a0);
            a1 = CK_MFMA(af, fragT(TN, 16 * ks, 1, lane, hi), a1);
        }
        storeT_V(A2M, a0, cb, r32, hi); storeT_V(A2M, a1, cb, 32 + r32, hi);
    } else if (wave < 4) {
        const int dvb = wave - 2; f32x16 v0 = f32x16{}, v1 = f32x16{};
#pragma unroll
        for (int s = 0; s < 2; ++s) {
            v0 = CK_MFMA(packR(w1a, s), fragT(TN, 16 * s, 0, lane, hi), v0);
            v1 = CK_MFMA(packR(w1a, s), fragT(TN, 16 * s, 1, lane, hi), v1);
            v1 = CK_MFMA(packR(w1b, s), fragT(TN, 32 + 16 * s, 1, lane, hi), v1);
        }
        storeT_V(V2M, v0, dvb, r32, hi); storeT_V(V2M, v1, dvb, 32 + r32, hi);
    }
    __syncthreads();
    CK_FRESH();
    if (wave >= 4 && wave < 6) {
        const int tb = wave - 4, t = tb * 32 + r32;
        f32x16 r0 = f32x16{}, r1 = f32x16{};
#pragma unroll
        for (int s = 0; s < 2; ++s) {
            const bf16x8 p0 = packR(xb0, s);
            r0 = CK_MFMA(fragT(A2M, 16 * s, 0, lane, hi), p0, r0); r1 = CK_MFMA(fragT(A2M, 16 * s, 1, lane, hi), p0, r1);
            y0a = CK_MFMA(fragT(V2M, 16 * s, 0, lane, hi), p0, y0a); y0b = CK_MFMA(fragT(V2M, 16 * s, 1, lane, hi), p0, y0b);
            if (tb == 1) { const bf16x8 p1 = packR(xb1, s);
                r0 = CK_MFMA(fragT(A2M, 32 + 16 * s, 0, lane, hi), p1, r0); r1 = CK_MFMA(fragT(A2M, 32 + 16 * s, 1, lane, hi), p1, r1);
                y0a = CK_MFMA(fragT(V2M, 32 + 16 * s, 0, lane, hi), p1, y0a); y0b = CK_MFMA(fragT(V2M, 32 + 16 * s, 1, lane, hi), p1, y0b); }
        }
#pragma unroll
        for (int q = 0; q < 4; ++q) {
            const u32x2 u0 = *(const LAS u32x2*)(RT + t * PS + (8 * q + 4 * hi) * 2), u1 = *(const LAS u32x2*)(RT + t * PS + (32 + 8 * q + 4 * hi) * 2);
            r0[4 * q] += bflo(u0.x); r0[4 * q + 1] += bfhi(u0.x); r0[4 * q + 2] += bflo(u0.y); r0[4 * q + 3] += bfhi(u0.y);
            r1[4 * q] += bflo(u1.x); r1[4 * q + 1] += bfhi(u1.x); r1[4 * q + 2] += bflo(u1.y); r1[4 * q + 3] += bfhi(u1.y);
        }
        storeT_S(BT, r0, 0, t, hi); storeT_S(BT, r1, 1, t, hi);
        storeT_S(KT, y0a, 0, t, hi); storeT_S(KT, y0b, 1, t, hi);
    } else if (wave < 2) {
        const int ib = wave, i = ib * 32 + r32; const float gci = GC[i];
        f32x16 g0 = f32x16{}, g1 = f32x16{};
#pragma unroll
        for (int ks = 0; ks < 4; ++ks) { const bf16x8 bf_ = fragT(BH, 16 * ks, ib, lane, hi);
            g0 = CK_MFMA(fragT(A2M, 16 * ks, 0, lane, hi), bf_, g0); g1 = CK_MFMA(fragT(A2M, 16 * ks, 1, lane, hi), bf_, g1); }
#pragma unroll
        for (int r = 0; r < 16; ++r) { if (crow(r, hi) == i) g0[r] += gci; if (32 + crow(r, hi) == i) g1[r] += gci; }
        storeT_S(AP, g0, 0, i, hi); storeT_S(AP, g1, 1, i, hi);
    } else {
        const int id = wave < 4 ? wave - 2 : wave - 4, ib = id >> 1, dvb = id & 1;
        f32x16 hh = f32x16{};
#pragma unroll
        for (int ks = 0; ks < 4; ++ks) {
            hh = CK_MFMA(fragT(BH, 16 * ks, ib, lane, hi), fragT(V2M, 16 * ks, dvb, lane, hi), hh);
            hh = CK_MFMA(fragT(KH, 16 * ks, ib, lane, hi), fragT(VV, 16 * ks, dvb, lane, hi), hh);
        }
        storeT_S((LAS unsigned char*)L, hh, ib, dvb * 32 + r32, hi);
    }
    __syncthreads();
    {
        asm volatile("" : "+v"(tid));
        const int row = tid >> 3, ch = tid & 7;
        const LAS unsigned char* s0 = BT + row * PS + ch * 16; const LAS unsigned char* s1 = KT + row * PS + ch * 16; const LAS unsigned char* s2 = AP + row * PS + ch * 16; const LAS unsigned char* s3 = (const LAS unsigned char*)L + row * PS + ch * 16;
        const u32x2 a0 = *(const LAS u32x2*)s0, a1 = *(const LAS u32x2*)(s0 + 8), b0 = *(const LAS u32x2*)s1, b1 = *(const LAS u32x2*)(s1 + 8);
        const u32x2 c0 = *(const LAS u32x2*)s2, c1 = *(const LAS u32x2*)(s2 + 8), d0 = *(const LAS u32x2*)s3, d1 = *(const LAS u32x2*)(s3 + 8);
        *(u32x4*)(CR2 + row * 64 + ch * 8) = (u32x4){a0.x, a0.y, a1.x, a1.y}; *(u32x4*)(CY0 + row * 64 + ch * 8) = (u32x4){b0.x, b0.y, b1.x, b1.y};
        *(u32x4*)(CG + row * 64 + ch * 8) = (u32x4){c0.x, c0.y, c1.x, c1.y}; *(u32x4*)(CH + row * 64 + ch * 8) = (u32x4){d0.x, d0.y, d1.x, d1.y};
    }
    asm volatile("s_waitcnt lgkmcnt(0)" ::: "memory"); __builtin_amdgcn_s_barrier();
#undef CK_FRESH
#undef w1a
#undef w1b
#undef xb0
#undef xb1
#undef y0a
#undef y0b
}

__device__ __forceinline__ void fused_item(LAS unsigned char* lds, const Args& a, int bc) {
    const int tid = threadIdx.x, lane = tid & 63; const int wave = __builtin_amdgcn_readfirstlane(tid >> 6);
    unsigned char* ws = a.ws;
    const bf16_t* P = (const bf16_t*)(ws + WS_P); const bf16_t* LW = (const bf16_t*)(ws + WS_LW); const float* mu = a.in[3];
    const int b = bc >> 6, c = bc & 63, tokc = b * SEQ + c * 64;
    LAS unsigned char* ACT = lds + O_ACT; LAS unsigned char* DECb = lds + O_TN; LAS unsigned char* ALRb = lds + O_A2; LAS unsigned char* GGb = lds + O_V2;
    for (int it = tid; it < 1280; it += 512) {
        const int tok = it / 20, ch = it - tok * 20, t = tokc + tok, col = 1536 + ch * 8;
        const u32x4 cu = *(const u32x4*)(P + (size_t)t * NINP + col);
        u32x4 pu = (u32x4){0u, 0u, 0u, 0u};
        if (t & (SEQ - 1)) pu = *(const u32x4*)(P + (size_t)(t - 1) * NINP + col);
        const f32x4 m0 = *(const f32x4*)(mu + col), m1 = *(const f32x4*)(mu + col + 4);
        const f32x4 c0 = cvlo(cu), c1 = cvhi(cu), p0 = cvlo(pu), p1 = cvhi(pu);
        f32x4 s0 = c0 + (p0 - c0) * m0, s1 = c1 + (p1 - c1) * m1;
        if (ch < 4) {
#pragma unroll
            for (int i = 0; i < 4; ++i) { const float e0 = __expf(-2.0f * fabsf(s0[i])), e1 = __expf(-2.0f * fabsf(s1[i])); const float th0 = (1.0f - e0) / (1.0f + e0), th1 = (1.0f - e1) / (1.0f + e1);
                s0[i] = s0[i] < 0.f ? -th0 : th0; s1[i] = s1[i] < 0.f ? -th1 : th1; }
        } else if (ch >= 8) {
#pragma unroll
            for (int i = 0; i < 4; ++i) { s0[i] = sigmoidf_(s0[i]); s1[i] = sigmoidf_(s1[i]); }
        }
        *(LAS u32x4*)(ACT + tok * 320 + ch * 16) = pk8(s0, s1);
    }
    __syncthreads();
#pragma clang loop unroll(disable)
    for (int h = 0; h < 8; ++h) {
        {
            int ln = lane; asm volatile("" : "+v"(ln));
            const int mt = wave >> 1, fcol = ln & 15, fq = ln >> 4;
            bf16x8 wf[2][5]; float w0c[2], a0c[2];
#pragma unroll
            for (int cbi = 0; cbi < 2; ++cbi) { const int col = h * 64 + ((wave & 1) * 2 + cbi) * 16 + fcol; const bf16_t* lw = LW + (size_t)col * 160 + fq * 8;
#pragma unroll
                for (int kb = 0; kb < 5; ++kb) wf[cbi][kb] = *(const bf16x8*)(lw + 32 * kb);
                w0c[cbi] = a.in[4][col]; a0c[cbi] = a.in[6][col]; }
            bf16x8 af[5];
#pragma unroll
            for (int kb = 0; kb < 5; ++kb) af[kb] = *(const LAS bf16x8*)(ACT + (mt * 16 + fcol) * 320 + kb * 64 + fq * 16);
            __builtin_amdgcn_sched_barrier(0);
#pragma unroll
            for (int cbi = 0; cbi < 2; ++cbi) {
                const int cb = (wave & 1) * 2 + cbi;
                const f32x4 z = {0.f, 0.f, 0.f, 0.f};
                const f32x4 aw = __builtin_amdgcn_mfma_f32_16x16x32_bf16(af[0], wf[cbi][0], z, 0, 0, 0);
                const f32x4 aa = __builtin_amdgcn_mfma_f32_16x16x32_bf16(af[1], wf[cbi][1], z, 0, 0, 0);
                f32x4 ag = __builtin_amdgcn_mfma_f32_16x16x32_bf16(af[2], wf[cbi][2], z, 0, 0, 0);
                ag = __builtin_amdgcn_mfma_f32_16x16x32_bf16(af[3], wf[cbi][3], ag, 0, 0, 0);
                ag = __builtin_amdgcn_mfma_f32_16x16x32_bf16(af[4], wf[cbi][4], ag, 0, 0, 0);
#pragma unroll
                for (int i = 0; i < 4; ++i) { const int off = (mt * 16 + fq * 4 + i) * 128 + (cb * 16 + fcol) * 2;
                    *(LAS unsigned short*)(DECb + off) = (unsigned short)f2bf(-0.8750325887f * sigmoidf_(aw[i] + w0c[cbi]));
                    *(LAS unsigned short*)(ALRb + off) = (unsigned short)f2bf(sigmoidf_(aa[i] + a0c[cbi]));
                    *(LAS unsigned short*)(GGb + off) = (unsigned short)f2bf(ag[i]); }
            }
        }
        __syncthreads();
        chunk_item(lds, a, ((b * 8 + h) << 6) + c);
    }
}
}

namespace ck {
constexpr int SQ_MAT = 8704, SQ_BUF = 6 * SQ_MAT;
constexpr int SQ_OUT = 2 * SQ_BUF;
__device__ __forceinline__ bf16x8 lfrag(const LAS unsigned char* M, int row, int k0, int hi) { return fragP(M, row, k0, hi); }
__device__ __forceinline__ void linit(f32x16& x, const LAS unsigned char* M, int row, int cblk, int hi) {
#pragma unroll
    for (int q = 0; q < 4; ++q) { const u32x2 u = *(const LAS u32x2*)(M + row * PS + (cblk * 32 + 8 * q + 4 * hi) * 2); x[4 * q] = bflo(u.x); x[4 * q + 1] = bfhi(u.x); x[4 * q + 2] = bflo(u.y); x[4 * q + 3] = bfhi(u.y); }
}
__device__ __forceinline__ void seq_head(LAS unsigned char* lds, const Args& a, int bh) {
    const int tid = threadIdx.x, lane = tid & 63, r32 = lane & 31, hi = lane >> 5; const int wave = __builtin_amdgcn_readfirstlane(tid >> 6);
    unsigned char* ws = a.ws;
    const bf16_t* SV = (const bf16_t*)(ws + WS_SV); const bf16_t* SG = (const bf16_t*)(ws + WS_SG); const float* RK = (const float*)(ws + WS_RK); bf16_t* YMIX = (bf16_t*)(ws + WS_YMIX);
    const int b = bh >> 3, h = bh & 7, col0 = h * 64;
    const float* lng = a.in[12] + col0; const float* lnb = a.in[13] + col0;
    const int lw = wave - 2;
    const bf16_t* lsrc; int lpitch;
    { const size_t it0 = (size_t)bh * 64 * 4096; const size_t tk0 = (size_t)b * SEQ * CW + col0;
      lsrc = lw == 0 ? (const bf16_t*)(ws + WS_CG) + it0 : lw == 1 ? (const bf16_t*)(ws + WS_CH) + it0 : lw == 2 ? (const bf16_t*)(ws + WS_CR2) + it0 : lw == 3 ? (const bf16_t*)(ws + WS_CY0) + it0 : lw == 4 ? SV + tk0 : SG + tk0;
      lpitch = lw < 4 ? 64 : CW; }
#define SQ_LOAD(ch) do { const bf16_t* s_ = lsrc + (size_t)(ch) * 64 * lpitch; LAS unsigned char* bb_ = lds + ((ch) & 1) * SQ_BUF + lw * SQ_MAT; u32x4 v_[8]; \
        _Pragma("unroll") for (int i_ = 0; i_ < 8; ++i_) { const int q_ = lane + 64 * i_; v_[i_] = *(const u32x4*)(s_ + (size_t)(q_ >> 3) * lpitch + (q_ & 7) * 8); } \
        _Pragma("unroll") for (int i_ = 0; i_ < 8; ++i_) { const int q_ = lane + 64 * i_; LAS unsigned char* d_ = bb_ + (q_ >> 3) * PS + (q_ & 7) * 16; *(LAS u32x2*)d_ = (u32x2){v_[i_].x, v_[i_].y}; *(LAS u32x2*)(d_ + 8) = (u32x2){v_[i_].z, v_[i_].w}; } } while (0)
#define SQ_STORE(ch) do { const LAS unsigned char* ob_ = lds + SQ_OUT + ((ch) & 1) * SQ_MAT; const size_t t0_ = (size_t)b * SEQ + (ch) * 64; \
        for (int p_ = tid - 128; p_ < 512; p_ += 384) { const int row_ = p_ >> 3, c8_ = (p_ & 7) * 8; const LAS unsigned char* s_ = ob_ + row_ * PS + c8_ * 2; \
            const u32x2 lo_ = *(const LAS u32x2*)s_, hi_ = *(const LAS u32x2*)(s_ + 8); *(u32x4*)(YMIX + (t0_ + row_) * D + col0 + c8_) = (u32x4){lo_.x, lo_.y, hi_.x, hi_.y}; } } while (0)
    if (wave >= 2) SQ_LOAD(0);
    __syncthreads();
    f32x16 X00 = f32x16{}, X01 = f32x16{}, X10 = f32x16{}, X11 = f32x16{};
#pragma unroll 1
    for (int c = 0; c < 64; ++c) {
        if (wave >= 2) {
            if (c + 1 < 64) SQ_LOAD(c + 1);
            if (c > 0) SQ_STORE(c - 1);
        } else {
            const int tb = wave;
            const LAS unsigned char* bb = lds + (c & 1) * SQ_BUF;
            const LAS unsigned char* MG = bb; const LAS unsigned char* MH = bb + SQ_MAT; const LAS unsigned char* MR = bb + 2 * SQ_MAT; const LAS unsigned char* MY = bb + 3 * SQ_MAT;
            const LAS unsigned char* MV = bb + 4 * SQ_MAT; const LAS unsigned char* MGT = bb + 5 * SQ_MAT;
            LAS unsigned char* OB = lds + SQ_OUT + (c & 1) * SQ_MAT;
            const int tl = tb * 32 + r32; const size_t t = (size_t)b * SEQ + c * 64 + tl;
            const float rk = RK[t * 8 + h];
            f32x16 y0, y1; linit(y0, MY, tl, 0, hi); linit(y1, MY, tl, 1, hi);
#pragma unroll
            for (int s = 0; s < 2; ++s) {
                const bf16x8 rf0 = lfrag(MR, tl, 16 * s, hi), rf1 = lfrag(MR, tl, 32 + 16 * s, hi);
                y0 = CK_MFMA(packR(X00, s), rf0, y0); y0 = CK_MFMA(packR(X10, s), rf1, y0);
                y1 = CK_MFMA(packR(X01, s), rf0, y1); y1 = CK_MFMA(packR(X11, s), rf1, y1);
            }
#pragma unroll
            for (int db = 0; db < 2; ++db) {
                f32x16 Na, Nb; linit(Na, MH, db * 32 + r32, 0, hi); linit(Nb, MH, db * 32 + r32, 1, hi);
#pragma unroll
                for (int s = 0; s < 2; ++s) {
                    const bf16x8 g00 = lfrag(MG, r32, 16 * s, hi), g01 = lfrag(MG, r32, 32 + 16 * s, hi), g10 = lfrag(MG, 32 + r32, 16 * s, hi), g11 = lfrag(MG, 32 + r32, 32 + 16 * s, hi);
                    const bf16x8 p0 = packR(db ? X01 : X00, s), p1 = packR(db ? X11 : X10, s);
                    Na = CK_MFMA(g00, p0, Na); Na = CK_MFMA(g01, p1, Na);
                    Nb = CK_MFMA(g10, p0, Nb); Nb = CK_MFMA(g11, p1, Nb);
                }
                if (db == 0) { X00 = Na; X10 = Nb; } else { X01 = Na; X11 = Nb; }
            }
            float sm = 0.f;
#pragma unroll
            for (int r = 0; r < 16; ++r) sm += y0[r] + y1[r];
            sm += __shfl_xor(sm, 32);
            const float mean = sm * (1.0f / 64.0f);
            float sq = 0.f;
#pragma unroll
            for (int r = 0; r < 16; ++r) { const float d0 = y0[r] - mean, d1 = y1[r] - mean; sq += d0 * d0 + d1 * d1; }
            sq += __shfl_xor(sq, 32);
            const float rs = 1.0f / sqrtf(sq * (1.0f / 64.0f) + 64e-5f);
#pragma unroll
            for (int db = 0; db < 2; ++db)
#pragma unroll
                for (int q = 0; q < 4; ++q) {
                    const int dv = db * 32 + 8 * q + 4 * hi;
                    const f32x4 lg = *(const f32x4*)(lng + dv), lb = *(const f32x4*)(lnb + dv);
                    const u32x2 uv = *(const LAS u32x2*)(MV + tl * PS + dv * 2), ug = *(const LAS u32x2*)(MGT + tl * PS + dv * 2);
                    const f32x4 vv = {bflo(uv.x), bfhi(uv.x), bflo(uv.y), bfhi(uv.y)}, gg = {bflo(ug.x), bfhi(ug.x), bflo(ug.y), bfhi(ug.y)};
                    f32x4 yy; if (db == 0) yy = (f32x4){y0[4 * q], y0[4 * q + 1], y0[4 * q + 2], y0[4 * q + 3]}; else yy = (f32x4){y1[4 * q], y1[4 * q + 1], y1[4 * q + 2], y1[4 * q + 3]};
                    const f32x4 o = ((yy - mean) * rs * lg + lb + rk * vv) * gg;
                    u32x2 w; w.x = pk2(o.x, o.y); w.y = pk2(o.z, o.w);
                    *(LAS u32x2*)(OB + tl * PS + dv * 2) = w;
                }
        }
        __syncthreads();
    }
    if (wave >= 2) SQ_STORE(63);
#undef SQ_LOAD
#undef SQ_STORE
}
}

namespace att {
constexpr int SLOT = 32768, OFF_V = 16384;
constexpr int TBL_OFF = MISC_OFF + 1024;
constexpr int LW_OFF = MISC_OFF + 2048;
constexpr int CST_OFF = MISC_OFF + 3072;
__device__ __forceinline__ int crow(int r, int hi) { return (r & 3) + 8 * (r >> 2) + 4 * hi; }
__device__ __forceinline__ void glds16(const void* gsrc, unsigned lds_dst) { unsigned keep;
    asm volatile("s_mov_b32 %0, m0\n\ts_mov_b32 m0, %2\n\ts_nop 0\n\tglobal_load_lds_dwordx4 %1, off\n\ts_mov_b32 m0, %0" : "=&s"(keep) : "v"(gsrc), "s"(lds_dst) : "memory"); }
__device__ __forceinline__ s16x4 vtr(const LAS unsigned char* p) { return __builtin_bit_cast(s16x4, __builtin_amdgcn_ds_read_tr16_b64_v4i16((LAS s16x4*)p)); }

__device__ __forceinline__ void attn_unit(LAS unsigned char* lds, const Args& a, int b, int h, int qb, float negM, float lam) {
    const int tid = threadIdx.x, lane = tid & 63, r32 = lane & 31, hi = lane >> 5; const int wid = __builtin_amdgcn_readfirstlane(tid >> 6);
    const int c = wid >> 2, rg = wid & 3;
    unsigned char* ws = a.ws;
    const bf16_t* QN = (const bf16_t*)(ws + WS_QN); const bf16_t* KN = (const bf16_t*)(ws + WS_KN); const bf16_t* P = (const bf16_t*)(ws + WS_P); bf16_t* YMIX = (bf16_t*)(ws + WS_YMIX);
    const int q0 = qb * 128; const size_t rowbase = (size_t)b * SEQ;
    const int NT = 2 * qb + 2;
    LAS float* tbl = (LAS float*)(lds + TBL_OFF); LAS float* lw = (LAS float*)(lds + LW_OFF) + wid * 32;
    if (tid < 128) {
        const int n = tid; int bkt;
        if (n < 16) bkt = n; else { bkt = 16 + (int)(logf((float)n * (1.0f / 16.0f)) / 2.0794415416798357f * 16.0f); bkt = bkt > 31 ? 31 : bkt; }
        tbl[n] = (a.in[21][bkt * 4 + h] - a.in[21][31 * 4 + h]) * LOG2E;
    }
    const bf16_t* Qw = QN + (rowbase + q0 + rg * 32 + r32) * CW + h * 128 + c * 64;
    bf16x8 qr[4];
#pragma unroll
    for (int d0 = 0; d0 < 4; ++d0) qr[d0] = *(const bf16x8*)(Qw + d0 * 16 + hi * 8);
    const bf16_t* k0src = KN + ((((size_t)(b * 8 + h * 2) * 64) * 8 + wid) * 64 + lane) * 8;
    const bf16_t* k1src = k0src + (size_t)64 * 8 * 64 * 8;
    const int pv0 = 2 * wid, pv1 = 2 * wid + 1;
    const bf16_t* VTb = (const bf16_t*)(ws + WS_VT) + (size_t)(b * 4 + h) * 64 * 8192;
    const bf16_t* v0src = VTb + pv0 * 512 + lane * 8;
    const bf16_t* v1src = VTb + pv1 * 512 + lane * 8;
#define ATT_DMA(t, slot) do { const unsigned s_ = lds0 + (unsigned)(slot) * SLOT; \
        glds16(k0src + (size_t)(t) * 4096, (unsigned)__builtin_amdgcn_readfirstlane(s_ + wid * 1024)); \
        glds16(k1src + (size_t)(t) * 4096, (unsigned)__builtin_amdgcn_readfirstlane(s_ + 8192 + wid * 1024)); \
        glds16(v0src + (size_t)(t) * 8192, (unsigned)__builtin_amdgcn_readfirstlane(s_ + OFF_V + pv0 * 1024)); \
        glds16(v1src + (size_t)(t) * 8192, (unsigned)__builtin_amdgcn_readfirstlane(s_ + OFF_V + pv1 * 1024)); } while (0)
#define ATT_SBAR() __builtin_amdgcn_sched_barrier(0)
    const unsigned lds0 = (unsigned)(uintptr_t)lds;
    f32x16 o[4];
#pragma unroll
    for (int d0 = 0; d0 < 4; ++d0) o[d0] = f32x16{};
    float lsum = 0.f;
    const bool shift = negM < -60.0f;
    const int qmin = q0 + 32 * rg, qpos = qmin + r32;
    ATT_DMA(0, 0);
    asm volatile("s_waitcnt vmcnt(0)" ::: "memory");
    __syncthreads();
    for (int t = 0; t < NT; ++t) {
        if (t + 1 < NT) ATT_DMA(t + 1, (t + 1) & 1);
        const int kmin = 64 * t;
        if (kmin <= qmin + 31) {
            const LAS unsigned char* slot = lds + (t & 1) * SLOT;
            const LAS unsigned char* kb = slot + c * 8192 + hi * 1024 + r32 * 16;
            const LAS unsigned char* vb = slot + OFF_V + ((lane >> 4) & 1) * 32 + (lane & 3) * 8 + (4 * hi + ((lane & 15) >> 2)) * 64;
            bf16x8 kf[8];
#pragma unroll
            for (int d0 = 0; d0 < 4; ++d0) { kf[2 * d0] = *(const LAS bf16x8*)(kb + d0 * 2048); kf[2 * d0 + 1] = *(const LAS bf16x8*)(kb + d0 * 2048 + 512); }
            ATT_SBAR();
            f32x16 p0, p1;
            p0 = __builtin_amdgcn_mfma_f32_32x32x16_bf16(kf[0], qr[0], f32x16{}, 0, 0, 0); p1 = __builtin_amdgcn_mfma_f32_32x32x16_bf16(kf[1], qr[0], f32x16{}, 0, 0, 0);
#pragma unroll
            for (int d0 = 1; d0 < 4; ++d0) { p0 = __builtin_amdgcn_mfma_f32_32x32x16_bf16(kf[2 * d0], qr[d0], p0, 0, 0, 0); p1 = __builtin_amdgcn_mfma_f32_32x32x16_bf16(kf[2 * d0 + 1], qr[d0], p1, 0, 0, 0); }
            ATT_SBAR();
            s16x4 vv[2][8];
#define ATT_LDV(ks) do { _Pragma("unroll") for (int dvb_ = 0; dvb_ < 4; ++dvb_) { vv[(ks) & 1][2 * dvb_] = vtr(vb + dvb_ * 4096 + (ks) * 1024); vv[(ks) & 1][2 * dvb_ + 1] = vtr(vb + dvb_ * 4096 + (ks) * 1024 + 512); } } while (0)
            ATT_LDV(0); ATT_LDV(1);
            ATT_SBAR();
            if (qmin - (kmin + 63) < 113) {
#pragma unroll
                for (int r = 0; r < 16; ++r) {
                    const int d0_ = qpos - (kmin + crow(r, hi)); const int d1_ = d0_ - 32;
                    const float t0 = tbl[d0_ < 0 ? 0 : (d0_ > 127 ? 127 : d0_)], t1 = tbl[d1_ < 0 ? 0 : (d1_ > 127 ? 127 : d1_)];
                    p0[r] = d0_ < 0 ? -INFINITY : p0[r] + t0; p1[r] = d1_ < 0 ? -INFINITY : p1[r] + t1;
                }
            }
            if (shift) {
#pragma unroll
                for (int r = 0; r < 16; ++r) { p0[r] += negM; p1[r] += negM; }
            }
            float sacc = 0.f;
#pragma unroll
            for (int j = 0; j < 8; ++j) { p0[j] = __builtin_amdgcn_exp2f(p0[j]); sacc += p0[j]; }
#pragma unroll
            for (int ks = 0; ks < 4; ++ks) {
                u32x4 pwk;
                if (ks == 0) { pwk.x = pk2(p0[0], p0[1]); pwk.y = pk2(p0[2], p0[3]); pwk.z = pk2(p0[4], p0[5]); pwk.w = pk2(p0[6], p0[7]); }
                else if (ks == 1) { pwk.x = pk2(p0[8], p0[9]); pwk.y = pk2(p0[10], p0[11]); pwk.z = pk2(p0[12], p0[13]); pwk.w = pk2(p0[14], p0[15]); }
                else if (ks == 2) { pwk.x = pk2(p1[0], p1[1]); pwk.y = pk2(p1[2], p1[3]); pwk.z = pk2(p1[4], p1[5]); pwk.w = pk2(p1[6], p1[7]); }
                else { pwk.x = pk2(p1[8], p1[9]); pwk.y = pk2(p1[10], p1[11]); pwk.z = pk2(p1[12], p1[13]); pwk.w = pk2(p1[14], p1[15]); }
#pragma unroll
                for (int dvb = 0; dvb < 4; ++dvb) {
                    const bf16x8 vf = (bf16x8){vv[ks & 1][2 * dvb][0], vv[ks & 1][2 * dvb][1], vv[ks & 1][2 * dvb][2], vv[ks & 1][2 * dvb][3], vv[ks & 1][2 * dvb + 1][0], vv[ks & 1][2 * dvb + 1][1], vv[ks & 1][2 * dvb + 1][2], vv[ks & 1][2 * dvb + 1][3]};
                    ATT_SBAR();
                    o[dvb] = __builtin_amdgcn_mfma_f32_32x32x16_bf16(__builtin_bit_cast(bf16x8, pwk), vf, o[dvb], 0, 0, 0);
                    if (ks == 0) { p0[8 + 2 * dvb] = __builtin_amdgcn_exp2f(p0[8 + 2 * dvb]); p0[9 + 2 * dvb] = __builtin_amdgcn_exp2f(p0[9 + 2 * dvb]); sacc += p0[8 + 2 * dvb] + p0[9 + 2 * dvb]; }
                    else if (ks == 1) { p1[2 * dvb] = __builtin_amdgcn_exp2f(p1[2 * dvb]); p1[2 * dvb + 1] = __builtin_amdgcn_exp2f(p1[2 * dvb + 1]); sacc += p1[2 * dvb] + p1[2 * dvb + 1]; }
                    else if (ks == 2) { p1[8 + 2 * dvb] = __builtin_amdgcn_exp2f(p1[8 + 2 * dvb]); p1[9 + 2 * dvb] = __builtin_amdgcn_exp2f(p1[9 + 2 * dvb]); sacc += p1[8 + 2 * dvb] + p1[9 + 2 * dvb]; }
                }
                ATT_SBAR();
                if (ks < 2) ATT_LDV(ks + 2);
            }
#undef ATT_LDV
            lsum += sacc;
        }
        asm volatile("s_waitcnt vmcnt(0)" ::: "memory");
        __syncthreads();
    }
#undef ATT_DMA
#undef ATT_SBAR
    lsum += __shfl_xor(lsum, 32);
    if (hi == 0) lw[r32] = 1.0f / lsum;
    asm volatile("s_waitcnt lgkmcnt(0)" ::: "memory");
    LAS float* stg = (LAS float*)(lds + wid * 16384);
#pragma unroll
    for (int r = 0; r < 16; ++r) { const int orow = crow(r, hi); const float il = lw[orow];
#pragma unroll
        for (int d0 = 0; d0 < 4; ++d0) stg[orow * 128 + d0 * 32 + r32] = o[d0][r] * il; }
    __syncthreads();
    {
        const int row = tid >> 2, part = tid & 3, rgp = row >> 5, rr = row & 31;
        const LAS float* s1 = (const LAS float*)(lds + rgp * 16384) + rr * 128 + part * 32;
        const LAS float* s2 = (const LAS float*)(lds + (4 + rgp) * 16384) + rr * 128 + part * 32;
        float dv[32]; float ss = 0.f;
#pragma unroll
        for (int i = 0; i < 8; ++i) { const f32x4 x1 = *(const LAS f32x4*)(s1 + 4 * i), x2 = *(const LAS f32x4*)(s2 + 4 * i);
#pragma unroll
            for (int j = 0; j < 4; ++j) { const float dd = x1[j] - lam * x2[j]; dv[4 * i + j] = dd; ss += dd * dd; } }
        ss = red4(ss);
        const float sc = (1.0f / sqrtf(ss * (1.0f / 128.0f) + 1e-5f)) * 0.8f;
        const float* sg = a.in[20] + part * 32;
        bf16_t* op = YMIX + (rowbase + q0 + row) * D + CW + h * 128 + part * 32;
#pragma unroll
        for (int i = 0; i < 4; ++i) { u32x4 w;
            w.x = pk2(dv[8 * i] * sc * sg[8 * i], dv[8 * i + 1] * sc * sg[8 * i + 1]); w.y = pk2(dv[8 * i + 2] * sc * sg[8 * i + 2], dv[8 * i + 3] * sc * sg[8 * i + 3]);
            w.z = pk2(dv[8 * i + 4] * sc * sg[8 * i + 4], dv[8 * i + 5] * sc * sg[8 * i + 5]); w.w = pk2(dv[8 * i + 6] * sc * sg[8 * i + 6], dv[8 * i + 7] * sc * sg[8 * i + 7]);
            *(u32x4*)(op + 8 * i) = w; }
    }
    __syncthreads();
}

__device__ __forceinline__ void attn_phase(LAS unsigned char* lds, const Args& a, unsigned* ctl) {
    const int tid = threadIdx.x;
    LAS float* cst = (LAS float*)(lds + CST_OFF);
    if (tid < 64) {
        const float gq = fabsf(a.in[14][tid]), gk = fabsf(a.in[15][tid]);
        float mq = gq, mk = gk;
#pragma unroll
        for (int o = 1; o < 64; o <<= 1) { mq = fmaxf(mq, __shfl_xor(mq, o)); mk = fmaxf(mk, __shfl_xor(mk, o)); }
        const float d1 = wave_sum(a.in[16][tid] * a.in[17][tid]), d2 = wave_sum(a.in[18][tid] * a.in[19][tid]);
        float mb = 0.f;
        if (tid < 32) { for (int hh = 0; hh < 4; ++hh) mb = fmaxf(mb, (a.in[21][tid * 4 + hh] - a.in[21][31 * 4 + hh]) * LOG2E); }
#pragma unroll
        for (int o = 1; o < 64; o <<= 1) mb = fmaxf(mb, __shfl_xor(mb, o));
        if (tid == 0) { cst[0] = -(8.0f * LOG2E * mq * mk * 1.02f + mb); cst[1] = __expf(d1) - __expf(d2) + 0.2f; }
    }
    __syncthreads();
    const float negM = cst[0], lam = cst[1];
    LAS int* ubox = (LAS int*)(lds + CST_OFF + 16);
    for (;;) {
        if (tid == 0) ubox[0] = (int)atomicAdd(ctl + CW_ATTQ, 1u);
        __syncthreads();
        const int u = __builtin_amdgcn_readfirstlane(ubox[0]);
        __syncthreads();
        if (u >= 1024 + CONV_ITEMS) break;
        const int qd = u / 5, rm = u - qd * 5;
        if (rm < 3) { conv_item(lds, a, qd * 3 + rm); continue; }
        const int au = qd * 2 + (rm - 3);
        const int qb = 31 - (au >> 5), bhh = au & 31;
        attn_unit(lds, a, bhh >> 2, bhh & 3, qb, negM, lam);
    }
}
}

__device__ __forceinline__ void p5_router(LAS unsigned char* lds, const Args& a, unsigned* ctl) {
    const int tid = threadIdx.x, lane = tid & 63, r32 = lane & 31, hi = lane >> 5; const int wave = __builtin_amdgcn_readfirstlane(tid >> 6);
    unsigned char* ws = a.ws;
    const bf16_t* x1 = (const bf16_t*)(ws + WS_X1B); const float* g2 = a.in[23]; const float* rw = a.in[24]; const float* rb = a.in[25];
    unsigned char* H2 = ws + WS_H2; int* EIDX = (int*)(ws + WS_EIDX); float* GATE = (float*)(ws + WS_GATE); int* POS = (int*)(ws + WS_POS);
    LAS unsigned char* WH = lds; LAS unsigned char* WL = lds + 65536;
    LAS int* cnt = (LAS int*)(lds + MISC_OFF + 1024);
    LAS int* basel = (LAS int*)(lds + MISC_OFF + 1024 + 128);
    LAS int* el = (LAS int*)(lds + MISC_OFF + 2048);
    LAS int* pl = (LAS int*)(lds + MISC_OFF + 4096);
    {
        const int e = tid & 31;
        for (int k = tid >> 5; k < 1024; k += 16) {
            const float v = rw[k * 32 + e] * g2[k]; const unsigned h = f2bf(v); const float vh = __builtin_bit_cast(float, h << 16); const unsigned l = f2bf(v - vh);
            const int off = e * 2048 + (((k >> 3) ^ (e & 15)) << 4) + (k & 7) * 2;
            *(LAS unsigned short*)(WH + off) = (unsigned short)h; *(LAS unsigned short*)(WL + off) = (unsigned short)l;
        }
    }
    if (tid < 32) cnt[tid] = 0;
    __syncthreads();
    const int TPB = T / (int)gridDim.x, tb0 = blockIdx.x * TPB;
    if (wave < 4) {
        const int tl = wave * 32 + r32, t = tb0 + tl;
        const bf16_t* xrow = x1 + (size_t)t * D + 8 * hi;
        const LAS unsigned char* wh = WH + r32 * 2048; const LAS unsigned char* wl = WL + r32 * 2048; const int sw = r32 & 15;
        f32x16 d = f32x16{}; float ssq = 0.f;
#pragma unroll 8
        for (int s = 0; s < 64; ++s) {
            const u32x4 xb = *(const u32x4*)(xrow + 16 * s);
            const int co = ((2 * s + hi) ^ sw) << 4;
            const bf16x8 ah = *(const LAS bf16x8*)(wh + co), al = *(const LAS bf16x8*)(wl + co);
            const bf16x8 bx = __builtin_bit_cast(bf16x8, xb);
            d = __builtin_amdgcn_mfma_f32_32x32x16_bf16(ah, bx, d, 0, 0, 0);
            d = __builtin_amdgcn_mfma_f32_32x32x16_bf16(al, bx, d, 0, 0, 0);
            const f32x4 x0 = cvlo(xb), x1v = cvhi(xb);
            ssq += (x0.x * x0.x + x0.y * x0.y) + (x0.z * x0.z + x0.w * x0.w) + (x1v.x * x1v.x + x1v.y * x1v.y) + (x1v.z * x1v.z + x1v.w * x1v.w);
        }
        ssq += __shfl_xor(ssq, 32);
        const float rstd = 1.0f / sqrtf(ssq * (1.0f / D) + 1e-5f);
        float lg[16];
#pragma unroll
        for (int r = 0; r < 16; ++r) lg[r] = d[r] * rstd + rb[8 * (r >> 2) + 4 * hi + (r & 3)];
        float tv[4]; int ti[4];
#pragma unroll
        for (int k = 0; k < 4; ++k) {
            float bv = -INFINITY; int bi = 0;
#pragma unroll
            for (int r = 0; r < 16; ++r) { const int e = 8 * (r >> 2) + 4 * hi + (r & 3); if (lg[r] > bv) { bv = lg[r]; bi = e; } }
            tv[k] = bv; ti[k] = bi;
#pragma unroll
            for (int r = 0; r < 16; ++r) { const int e = 8 * (r >> 2) + 4 * hi + (r & 3); if (e == bi) lg[r] = -INFINITY; }
        }
        float ov[4]; int oi[4];
#pragma unroll
        for (int k = 0; k < 4; ++k) { ov[k] = __shfl_xor(tv[k], 32); oi[k] = __shfl_xor(ti[k], 32); }
        float mv[4]; int mi[4];
        {
            int pa = 0, pb = 0;
#pragma unroll
            for (int k = 0; k < 4; ++k) {
                float ca = -INFINITY, cb = -INFINITY; int ia = 0, ib = 0;
#pragma unroll
                for (int q = 0; q < 4; ++q) { if (q == pa) { ca = tv[q]; ia = ti[q]; } if (q == pb) { cb = ov[q]; ib = oi[q]; } }
                const bool takeA = (ca > cb) || (ca == cb && ia < ib);
                mv[k] = takeA ? ca : cb; mi[k] = takeA ? ia : ib; pa += takeA ? 1 : 0; pb += takeA ? 0 : 1;
            }
        }
        const float e1 = __expf(mv[1] - mv[0]), e2 = __expf(mv[2] - mv[0]), e3 = __expf(mv[3] - mv[0]);
        const float inv = 1.0f / (1.0f + e1 + e2 + e3);
        if (hi == 0) {
            *(int4*)(EIDX + (size_t)t * 4) = make_int4(mi[0], mi[1], mi[2], mi[3]);
            *(float4*)(GATE + (size_t)t * 4) = make_float4(inv, e1 * inv, e2 * inv, e3 * inv);
#pragma unroll
            for (int k = 0; k < 4; ++k) { el[tl * 4 + k] = mi[k]; pl[tl * 4 + k] = atomicAdd((int*)(cnt + mi[k]), 1); }
        }
    } else {
        f32x4 gv[4];
#pragma unroll
        for (int j = 0; j < 4; ++j) gv[j] = *((const f32x4*)g2 + lane + 64 * j);
        for (int i = 0; i < 32; ++i) {
            const int t = tb0 + (wave - 4) * 32 + i;
            const u32x2* xr = (const u32x2*)(x1 + (size_t)t * D) + lane;
            f32x4 v[4]; float s = 0.f;
#pragma unroll
            for (int j = 0; j < 4; ++j) { const u32x2 xw = xr[64 * j]; v[j] = (f32x4){bflo(xw.x), bfhi(xw.x), bflo(xw.y), bfhi(xw.y)}; s += (v[j].x * v[j].x + v[j].y * v[j].y) + (v[j].z * v[j].z + v[j].w * v[j].w); }
            const float rstd = (1.0f / sqrtf(wave_sum(s) * (1.0f / D) + 1e-5f)) * F8_X_MUL;
            unsigned* o4 = (unsigned*)(H2 + (size_t)t * D) + lane;
#pragma unroll
            for (int j = 0; j < 4; ++j) { v[j] = v[j] * rstd * gv[j]; o4[64 * j] = pk4_fp8(v[j].x, v[j].y, v[j].z, v[j].w); }
        }
    }
    __syncthreads();
    if (tid < 32) basel[tid] = (int)atomicAdd(ctl + CW_CNT + tid, (unsigned)cnt[tid]);
    __syncthreads();
    for (int i = tid; i < TPB * 4; i += 512) POS[(size_t)tb0 * 4 + i] = pl[i] + basel[el[i]];
}

__device__ __forceinline__ void p6_dispatch(LAS unsigned char* lds, const Args& a, unsigned* ctl) {
    const int tid = threadIdx.x, lane = tid & 63, wave = __builtin_amdgcn_readfirstlane(tid >> 6);
    unsigned char* ws = a.ws;
    const int* EIDX = (const int*)(ws + WS_EIDX); const float* GATE = (const float*)(ws + WS_GATE); const int* POS = (const int*)(ws + WS_POS);
    int* DEST = (int*)(ws + WS_DEST); float* ROWGATE = (float*)(ws + WS_ROWGATE); int* TILEE = (int*)(ws + WS_TILEE); int* ROWTOK = (int*)(ws + WS_ROWTOK);
    LAS int* pstart = (LAS int*)(lds + MISC_OFF + 1024); LAS int* pcnt = pstart + 32;
    if (tid < NE) pcnt[tid] = (int)__hip_atomic_load(ctl + CW_CNT + tid, __ATOMIC_RELAXED, __HIP_MEMORY_SCOPE_AGENT);
    __syncthreads();
    if (tid == 0) {
        int acc = 0;
        for (int e = 0; e < NE; ++e) { pstart[e] = acc; acc += ((pcnt[e] + 255) >> 8) * 256; }
        if (blockIdx.x == 0) TILEE[1023] = acc >> 8;
    }
    __syncthreads();
    if (blockIdx.x == 0 && tid < NE) { const int nt = (pcnt[tid] + 255) >> 8, t0_ = pstart[tid] >> 8; for (int i = 0; i < nt; ++i) TILEE[t0_ + i] = tid; }
    if (blockIdx.x < NE) {
        const int e = blockIdx.x, cn = pcnt[e], pe = ((cn + 255) >> 8) * 256;
        for (int i = cn + tid; i < pe; i += 512) ROWTOK[pstart[e] + i] = 0;
    }
    const int TPB = T / (int)gridDim.x, tb0 = blockIdx.x * TPB;
    for (int pi = tb0 * 4 + tid; pi < (tb0 + TPB) * 4; pi += 512) {
        const int e = EIDX[pi], dest = pstart[e] + POS[pi];
        DEST[pi] = dest; ROWGATE[dest] = GATE[pi]; ROWTOK[dest] = pi >> 2;
    }
}

__device__ __forceinline__ void p9_combine(const Args& a, int G) {
    const int tid = threadIdx.x, lane = tid & 63, wave = __builtin_amdgcn_readfirstlane(tid >> 6);
    unsigned char* ws = a.ws;
    const unsigned char* YS = ws + WS_YS; const int* DEST = (const int*)(ws + WS_DEST);
    float* out = a.out;
    const int gw = blockIdx.x * 8 + wave, NGW = G * 8;
    for (int t = gw; t < T; t += NGW) {
        f32x4* xr = (f32x4*)(out + (size_t)t * D) + lane; const u32x2* xi = (const u32x2*)((const bf16_t*)(ws + WS_X1B) + (size_t)t * D) + lane;
        f32x4 v[4];
#pragma unroll
        for (int j = 0; j < 4; ++j) { const u32x2 xw = xi[64 * j]; v[j] = (f32x4){bflo(xw.x), bfhi(xw.x), bflo(xw.y), bfhi(xw.y)}; }
#pragma unroll
        for (int k = 0; k < 4; ++k) {
            const int dest = DEST[t * 4 + k];
            const unsigned* yr = (const unsigned*)(YS + (size_t)dest * D) + lane;
#pragma unroll
            for (int j = 0; j < 4; ++j) { const unsigned w = yr[64 * j];
                const f32x2 lo = __builtin_amdgcn_cvt_pk_f32_fp8((int)w, false), hi2 = __builtin_amdgcn_cvt_pk_f32_fp8((int)w, true);
                v[j].x += lo.x * (1.0f / F8_Y_MUL); v[j].y += lo.y * (1.0f / F8_Y_MUL); v[j].z += hi2.x * (1.0f / F8_Y_MUL); v[j].w += hi2.y * (1.0f / F8_Y_MUL); }
        }
        if (TIME_REGION >= 0) { const float sc_ = 1.0f + 4e-6f * (float)((const unsigned*)(ws + WS_CTL))[301];
#pragma unroll
            for (int j = 0; j < 4; ++j) v[j] = v[j] * sc_; }
#pragma unroll
        for (int j = 0; j < 4; ++j) xr[64 * j] = v[j];
    }
}

constexpr int NPHASE = 10;
__global__ void __launch_bounds__(512, 2) hymba_fwd(Args args) {
    extern __shared__ __attribute__((aligned(16))) unsigned char lds_raw[];
    LAS unsigned char* lds = (LAS unsigned char*)lds_raw;
    cg::grid_group grid = cg::this_grid();
    const int G = gridDim.x;
    unsigned char* ws = args.ws;
    unsigned* ctl = (unsigned*)(ws + WS_CTL);
    const int lo = args.ph_lo, hi = args.ph_hi;
#define IN(k) (lo <= (k) && (k) < hi)
#define NREP(k) ((REP_PHASE) == (k) ? 2 : 1)
#define TSTART(k) do { if ((TIME_REGION) == (k) && blockIdx.x == 0 && threadIdx.x == 0) ctl[300] = (unsigned)__builtin_amdgcn_s_memrealtime(); } while (0)
#define TEND(k) do { if ((TIME_REGION) == (k) && blockIdx.x == 0 && threadIdx.x == 0) ctl[301] = (unsigned)__builtin_amdgcn_s_memrealtime() - ctl[300]; } while (0)
#define SEAM(k) do { if (IN(k) && IN((k) + 1)) { if (args.ph_lo < 0) grid.sync(); xcd_barrier(xbar); } } while (0)
    const int* TILEE = (const int*)(ws + WS_TILEE);
    { volatile LAS unsigned* st = (volatile LAS unsigned*)(lds + LDS_BYTES - 64); if (threadIdx.x < 2) st[threadIdx.x] = 0u; }
    __syncthreads();
    const XcdBarrier xbar = xcd_barrier_post(ctl + CW_BAR, (volatile LAS unsigned*)(lds + LDS_BYTES - 64));

    if (IN(0)) { for (int rep = 0; rep < NREP(0); ++rep) p0_prologue(lds, args, G); } SEAM(0);
    if (IN(1)) {
        pg8::Gemm g{ws + WS_XN, ws + WS_WINT, 1024, 0, 0, nullptr};
        pg8::TileOrder S; S.init(T / 256, NINP / 256, G, (int)blockIdx.x, nullptr, 0, WGM_P1);
        pg8::EpiBf16 E{(bf16_t*)(ws + WS_P), NINP, (bf16_t*)(ws + WS_VT)};
        for (int rep = 0; rep < NREP(1); ++rep) pg8::gemm_phase<false, false>(lds, g, S, E);
    } SEAM(1);
    TSTART(2);
    if (IN(2)) {
        ck::fused_item(lds, args, (int)blockIdx.x * 2); ck::fused_item(lds, args, (int)blockIdx.x * 2 + 1);
    } SEAM(2);
    TSTART(3);
    if (IN(3)) {
        TSTART(30); for (int rep = 0; rep < NREP(30); ++rep) { if (blockIdx.x < 64) ck::seq_head(lds, args, (int)blockIdx.x); __syncthreads(); } TEND(30);
        for (int rep = 0; rep < NREP(31); ++rep) att::attn_phase(lds, args, ctl + 64 * rep);
    } SEAM(3); TEND(3);
    if (IN(4)) {
        pg8::Gemm g{ws + WS_YMIX, ws + WS_WOUT, 1024, 0, 0, nullptr};
        pg8::TileOrder S; S.init(T / 256, D / 256, G, (int)blockIdx.x, nullptr, 0, WGM_P4);
        pg8::EpiResBf16 E{args.in[0], (bf16_t*)(ws + WS_X1B), D};
        for (int rep = 0; rep < NREP(4); ++rep) pg8::gemm_phase<false, false>(lds, g, S, E);
    } SEAM(4);
    if (IN(5)) { _Pragma("clang loop unroll(disable)") for (int rep = 0; rep < NREP(5); ++rep) { p5_router(lds, args, ctl + 256 * (NREP(5) - 1 - rep)); __syncthreads(); } } SEAM(5);
    if (IN(6)) { for (int rep = 0; rep < NREP(6); ++rep) { p6_dispatch(lds, args, ctl); __syncthreads(); } } SEAM(6);
    if (IN(7)) {
        const int ntile = TILEE[1023];
        pg8::Gemm g{ws + WS_H2, ws + WS_W1T, 1024, F8_W_SC, F8_X_SC, (const int*)(ws + WS_ROWTOK)};
        pg8::TileOrder S; S.init(ntile, 8, G, (int)blockIdx.x, TILEE, 8, WGM_P7);
        pg8::EpiSwiglu E{ws + WS_HID, args.in[27], TILEE};
        for (int rep = 0; rep < NREP(7); ++rep) pg8::gemm_phase<true, true>(lds, g, S, E);
    } SEAM(7);
    if (IN(8)) {
        const int ntile = TILEE[1023];
        pg8::Gemm g{ws + WS_HID, ws + WS_W2T, 1024, F8_W_SC, F8_H_SC, nullptr};
        pg8::TileOrder S; S.init(ntile, 4, G, (int)blockIdx.x, TILEE, 4, WGM_P8);
        pg8::EpiGateF8 E{ws + WS_YS, args.in[29], (const float*)(ws + WS_ROWGATE), TILEE};
        for (int rep = 0; rep < NREP(8); ++rep) pg8::gemm_phase<true, false>(lds, g, S, E);
    } SEAM(8);
    if (IN(9)) { p9_combine(args, G); }
#undef IN
#undef SEAM
}

extern "C" void kernel_launch(void* const* d_in, const int* in_sizes, int n_in, void* d_out, int out_size, void* d_ws, size_t ws_size, hipStream_t stream) {
    static int grid = 0;
    if (grid == 0) {
        if (n_in != 30 || in_sizes[0] != T * D || out_size != T * D || ws_size < WS_END) { fprintf(stderr, "kernel_launch: unexpected shapes (n_in %d, in0 %d, out %d, ws %zu); nothing launched\n", n_in, n_in > 0 ? in_sizes[0] : -1, out_size, ws_size); grid = -1; return; }
        int dev = 0, cus = 0, per_cu = 0;
        if (hipGetDevice(&dev) != hipSuccess || hipDeviceGetAttribute(&cus, hipDeviceAttributeMultiprocessorCount, dev) != hipSuccess) { grid = -1; return; }
        if (hipFuncSetAttribute((const void*)hymba_fwd, hipFuncAttributeMaxDynamicSharedMemorySize, LDS_BYTES) != hipSuccess) { fprintf(stderr, "kernel_launch: hipFuncSetAttribute failed\n"); grid = -1; return; }
        if (hipOccupancyMaxActiveBlocksPerMultiprocessor(&per_cu, (const void*)hymba_fwd, 512, LDS_BYTES) != hipSuccess || per_cu < 1) { fprintf(stderr, "kernel_launch: occupancy query says %d\n", per_cu); per_cu = 1; }
        (void)hipGetLastError();
        grid = cus;
        if (grid > 256) grid = 256;
        if (grid != 256 || T % grid != 0 || (T / grid) % 16 != 0) { fprintf(stderr, "kernel_launch: grid %d does not divide the token count evenly\n", grid); grid = -1; return; }
    }
    if (grid < 0) return;
    (void)hipMemsetAsync((char*)d_ws + WS_CTL, 0, CTL_ZERO_BYTES, stream);
    Args a{};
    for (int i = 0; i < 30; ++i) a.in[i] = (const float*)d_in[i];
    a.out = (float*)d_out; a.ws = (unsigned char*)d_ws;
    constexpr int NL = MK_N_LAUNCHES;
    for (int li = 0; li < NL; ++li) {
        a.ph_lo = (NL == 1) ? 0 : li; a.ph_hi = (NL == 1) ? NPHASE : li + 1;
        void* kargs[] = {&a};
        hipError_t e = hipLaunchCooperativeKernel((const void*)hymba_fwd, dim3(grid), dim3(512), kargs, LDS_BYTES, stream);
        if (e != hipSuccess) { fprintf(stderr, "kernel_launch: cooperative launch %d failed: %s (grid %d)\n", li, hipGetErrorString(e), grid); break; }
    }
}
```

```cpp
#include <hip/hip_runtime.h>
#include <hip/hip_cooperative_groups.h>
#include <cstdio>
#include <cstdint>
#include <type_traits>
namespace cg = cooperative_groups;

#ifndef REP_PHASE
#define REP_PHASE -1
#endif
#ifndef TIME_REGION
#define TIME_REGION -1
#endif
#ifndef WGM_P1
#define WGM_P1 2
#endif
#ifndef WGM_P4
#define WGM_P4 2
#endif
#ifndef WGM_P7
#define WGM_P7 2
#endif
#ifndef WGM_P8
#define WGM_P8 2
#endif
#ifndef MK_N_LAUNCHES
#define MK_N_LAUNCHES 1
#endif

#define LAS __attribute__((address_space(3)))
#define GAS __attribute__((address_space(1)))
typedef unsigned short bf16_t;
typedef short bf16x8 __attribute__((ext_vector_type(8)));
typedef short s16x4 __attribute__((ext_vector_type(4)));
typedef float f32x2 __attribute__((ext_vector_type(2)));
typedef float f32x4 __attribute__((ext_vector_type(4)));
typedef float f32x16 __attribute__((ext_vector_type(16)));
typedef unsigned u32x2 __attribute__((ext_vector_type(2)));
typedef unsigned u32x4 __attribute__((ext_vector_type(4)));
typedef int v8i32 __attribute__((ext_vector_type(8)));

constexpr int NB = 8, SEQ = 4096, T = NB * SEQ, D = 1024;
constexpr int CW = 512;
constexpr int NRW = 1696, NIN = 3232, NINP = 3328;
constexpr int DQ0 = 1696, DK0 = 2208, DV0 = 2720;
constexpr int NE = 32, TOPK = 4, DE = 1024;
constexpr int MAXROWS = T * TOPK + NE * 256;
constexpr int MAXTILES = MAXROWS / 256;
constexpr float LOG2E = 1.4426950408889634f;
constexpr float F8_W_MUL = 32.f, F8_X_MUL = 8.f, F8_H_MUL = 4.f, F8_Y_MUL = 16.f; constexpr int F8_W_SC = 0x7A7A7A7A, F8_X_SC = 0x7C7C7C7C, F8_H_SC = 0x7D7D7D7D;

constexpr size_t MiB = 1u << 20;
constexpr size_t WS_CTL = 0, CTL_ZERO_BYTES = 64 * 1024;
constexpr size_t WS_TILEE = 512 * 1024;
constexpr size_t WS_LW = 576 * 1024;
constexpr size_t WS_WINT = 1 * MiB;
constexpr size_t WS_WOUT = 8 * MiB;
constexpr size_t WS_W1T = 10 * MiB;
constexpr size_t WS_W2T = 138 * MiB;
constexpr size_t WS_EIDX = 202 * MiB;
constexpr size_t WS_GATE = WS_EIDX + 512 * 1024;
constexpr size_t WS_POS = WS_GATE + 512 * 1024;
constexpr size_t WS_DEST = WS_POS + 512 * 1024;
constexpr size_t WS_ROWGATE = 204 * MiB;
constexpr size_t WS_XN = 206 * MiB;
constexpr size_t WS_P = 270 * MiB;
constexpr size_t WS_SR = 478 * MiB, WS_SK = 510 * MiB, WS_SV = 542 * MiB, WS_SA = 574 * MiB, WS_SB = 606 * MiB;
constexpr size_t WS_SW = 638 * MiB;
constexpr size_t WS_SG = 702 * MiB;
constexpr size_t WS_QN = 734 * MiB, WS_KN = 766 * MiB;
constexpr size_t WS_YMIX = 798 * MiB;
constexpr size_t WS_H2 = 206 * MiB;
constexpr size_t WS_ROWTOK = 270 * MiB;
constexpr size_t WS_HID = 406 * MiB;
constexpr size_t WS_YS = 542 * MiB;
constexpr size_t WS_X1B = 862 * MiB;
constexpr size_t WS_CG = 862 * MiB;
constexpr size_t WS_CH = 894 * MiB;
constexpr size_t WS_CR2 = 926 * MiB;
constexpr size_t WS_CY0 = 958 * MiB;
constexpr size_t WS_RK = 990 * MiB;
constexpr size_t WS_VT = 992 * MiB;
constexpr size_t WS_END = 1024 * MiB;
constexpr int CW_CNT = 64;
constexpr int CW_ATTQ = 128;
constexpr int CW_BAR = 4096;

constexpr int RING_BYTES = 131072, MISC_OFF = RING_BYTES, LDS_BYTES = 147456;

__device__ __forceinline__ unsigned f2bf(float f) { unsigned u = __builtin_bit_cast(unsigned, f); return (u + 0x7fffu + ((u >> 16) & 1u)) >> 16; }
typedef __bf16 hwbf16x2 __attribute__((ext_vector_type(2)));
__device__ __forceinline__ unsigned pk2(float lo, float hi) { const f32x2 v = {lo, hi}; return __builtin_bit_cast(unsigned, __builtin_convertvector(v, hwbf16x2)); }
__device__ __forceinline__ unsigned pk4_fp8(float a, float b, float c, float d) {
    a = fminf(fmaxf(a, -448.f), 448.f); b = fminf(fmaxf(b, -448.f), 448.f); c = fminf(fmaxf(c, -448.f), 448.f); d = fminf(fmaxf(d, -448.f), 448.f);
    int r = __builtin_amdgcn_cvt_pk_fp8_f32(a, b, 0, false); r = __builtin_amdgcn_cvt_pk_fp8_f32(c, d, r, true); return (unsigned)r; }
__device__ __forceinline__ float bf2f(unsigned short b) { return __builtin_bit_cast(float, (unsigned)b << 16); }
__device__ __forceinline__ float bflo(unsigned w) { return __builtin_bit_cast(float, w << 16); }
__device__ __forceinline__ float bfhi(unsigned w) { return __builtin_bit_cast(float, w & 0xffff0000u); }
__device__ __forceinline__ float wave_sum(float v) {
#pragma unroll
    for (int o = 1; o < 64; o <<= 1) v += __shfl_xor(v, o);
    return v;
}
__device__ __forceinline__ float sigmoidf_(float x) { return 1.0f / (1.0f + __expf(-x)); }
template <int CTRL> __device__ __forceinline__ float dpp_f(float v) { return __builtin_bit_cast(float, __builtin_amdgcn_update_dpp(0, __builtin_bit_cast(int, v), CTRL, 0xF, 0xF, true)); }
__device__ __forceinline__ float red8(float v) {
    v += dpp_f<0xB1>(v);
    v += dpp_f<0x4E>(v);
    v += dpp_f<0x141>(v);
    return v;
}
__device__ __forceinline__ float red4(float v) { v += dpp_f<0xB1>(v); v += dpp_f<0x4E>(v); return v; }


#define XB_TMO      128
#define XB_XCNT(j)  (256  + 64 * (j))
#define XB_XSUB(j)  (1280 + 64 * (j))
#define XB_XGEN(j)  (2304 + 64 * (j))
#define XB_TOP      3328
#define XB_TOPGEN   3392
#define XCD_BAR_WORDS 3456
#define XB_SPIN_CAP (1u << 18)
__device__ __forceinline__ unsigned xb_ld(unsigned* p)              { return __hip_atomic_load(p, __ATOMIC_RELAXED, __HIP_MEMORY_SCOPE_AGENT); }
__device__ __forceinline__ unsigned xb_add(unsigned* p, unsigned v) { return __hip_atomic_fetch_add(p, v, __ATOMIC_RELAXED, __HIP_MEMORY_SCOPE_AGENT); }
__device__ __forceinline__ unsigned xb_xcc_id() { return (unsigned)__builtin_amdgcn_s_getreg((3 << 11) | 20) & 0xFu; }
#define XB_SPIN(cond, bar) do { unsigned _sp = 0; while (cond) { __builtin_amdgcn_s_sleep(1); \
    if ((++_sp & 255u) == 0u) { if (xb_ld(&(bar)[XB_TMO])) break; if (_sp > XB_SPIN_CAP) { atomicAdd(&(bar)[XB_TMO], 1u); break; } } } } while (0)
struct XcdBarrier { unsigned* bar; unsigned x; volatile LAS unsigned* st; };
__device__ __forceinline__ XcdBarrier xcd_barrier_post(unsigned* bar, volatile LAS unsigned* st) {
    XcdBarrier b; b.bar = bar; b.x = xb_xcc_id(); b.st = st;
    if (threadIdx.x == 0) (void)xb_add(&bar[XB_XCNT(b.x)], 1u);
    return b;
}
__device__ __forceinline__ void xcd_barrier_complete(unsigned* bar, unsigned x, unsigned& nloc, unsigned& nx) {
    const unsigned G = gridDim.x * gridDim.y * gridDim.z;
    unsigned sum, cnt, mine, sp = 0u;
    for (;;) {
        sum = 0u; cnt = 0u; mine = 0u;
#pragma unroll
        for (unsigned j = 0; j < 16; ++j) { const unsigned c = xb_ld(&bar[XB_XCNT(j)]); sum += c; cnt += (c > 0u) ? 1u : 0u; mine = (j == x) ? c : mine; }
        if (sum == G) break;
        __builtin_amdgcn_s_sleep(1);
        if ((++sp & 255u) == 0u) { if (xb_ld(&bar[XB_TMO])) break; if (sp > XB_SPIN_CAP) { atomicAdd(&bar[XB_TMO], 1u); break; } }
    }
    nloc = mine > 0u ? mine : 1u; nx = cnt > 0u ? cnt : 1u;
}
__device__ __forceinline__ void xcd_barrier(const XcdBarrier& b) {
    asm volatile("s_waitcnt vmcnt(0)" ::: "memory");
    __syncthreads();
    if (threadIdx.x == 0) {
        unsigned* bar = b.bar;
        __builtin_amdgcn_s_waitcnt(0);
        unsigned nloc = b.st[0], nx = b.st[1];
        if (nloc == 0u) { xcd_barrier_complete(bar, b.x, nloc, nx); b.st[0] = nloc; b.st[1] = nx; }
        const unsigned old = xb_add(&bar[XB_XSUB(b.x)], 1u);
        const unsigned gen = old / nloc;
        if (old + 1u == (gen + 1u) * nloc) {
            __builtin_amdgcn_fence(__ATOMIC_RELEASE, "agent");
            asm volatile("s_waitcnt vmcnt(0)" ::: "memory");
            const unsigned og = xb_add(&bar[XB_TOP], 1u);
            const unsigned tg = og / nx;
            if (og + 1u == (tg + 1u) * nx) xb_add(&bar[XB_TOPGEN], 1u);
            else XB_SPIN(xb_ld(&bar[XB_TOPGEN]) == tg, bar);
            __builtin_amdgcn_fence(__ATOMIC_ACQUIRE, "agent");
            xb_add(&bar[XB_XGEN(b.x)], 1u);
            asm volatile("s_waitcnt vmcnt(0)" ::: "memory");
        } else {
            XB_SPIN(xb_ld(&bar[XB_XGEN(b.x)]) == gen, bar);
            __builtin_amdgcn_fence(__ATOMIC_ACQUIRE, "agent");
            asm volatile("s_waitcnt vmcnt(0)" ::: "memory");
        }
    }
    __syncthreads();
}

namespace pg8 {
constexpr int BM = 256, BK = 64, HALF = 128, HTB = HALF * BK * 2, STAGE_BYTES = 8 * HTB, NXCD = 8;
__host__ __device__ __forceinline__ int lds_byte(int r, int c) { const int st = (r >> 4) * 2 + (c >> 5), rr = r & 15, cc = c & 31, ob = rr * 64 + cc * 2; return st * 1024 + (ob ^ (((ob >> 9) & 1) << 5)); }
__host__ __device__ __forceinline__ void stage_rc(int b, int& R, int& C) { const int st = b / 1024, sb = b % 1024, swz = sb ^ (((sb >> 9) & 1) << 5); R = (st >> 1) * 16 + swz / 64; C = (st & 1) * 32 + (swz % 64) / 2; }
__host__ __device__ __forceinline__ int f8_swz(int fr) { return ((fr >> 1) & 3) | ((((fr + 4) >> 3) & 1) << 2); }
__host__ __device__ __forceinline__ void stage_rc_f8(int b, int& R, int& C) { const int p = b >> 10, l = (b >> 4) & 63, fr = (p & 1) * 8 + (l >> 3); R = (p >> 1) * 16 + fr; C = ((l & 7) ^ f8_swz(fr)) * 8; }
__host__ __device__ __forceinline__ int frag_f8(int row0, int fr, int fq, int j) { return (row0 >> 4) * 2048 + (fr >> 3) * 1024 + (fr & 7) * 128 + (((2 * fq + j) ^ f8_swz(fr)) * 16); }
__host__ __device__ __forceinline__ int perm32(int rho) { const int n = rho >> 4, i = rho & 15; return 8 * (i >> 2) + 4 * n + (i & 3); }

struct Unit { int pm, pn, pb; };
struct Gemm { const void* A; const void* Bt; int K; int scW, scA; const int* rowtok; };

struct TileOrder {
    int nM, nN, nwg, G, c, WGM; const int* tile_e; int nb_per_e;
    __device__ void init(int nM_, int nN_, int G_, int c_, const int* te, int nbe, int wgm) { nM = nM_; nN = nN_; nwg = nM * nN; G = G_; c = c_; tile_e = te; nb_per_e = nbe; WGM = wgm; }
    __device__ bool next(int i, Unit& u) const {
        const long L = (long)i * G + c; if (L >= nwg) return false;
        int wgid = (int)L; { const int q = nwg / NXCD, r = nwg % NXCD, xcd = wgid % NXCD, off = wgid / NXCD; wgid = (xcd < r ? xcd * (q + 1) : r * (q + 1) + (xcd - r) * q) + off; }
        const int nig = WGM * nN, gid = wgid / nig, fm = gid * WGM, gsz = (nM - fm) < WGM ? (nM - fm) : WGM;
        u.pm = fm + ((wgid % nig) % gsz); u.pn = (wgid % nig) / gsz;
        u.pb = tile_e ? tile_e[u.pm] * nb_per_e + u.pn : u.pn;
        return true;
    }
};

struct EpiBf16 {
    static constexpr bool PERM = true;
    bf16_t* O; int ldc; bf16_t* VT;
    __device__ __forceinline__ void operator()(const f32x4 (&acc)[2][2][4][2], const Unit& u, int wr, int wc, int fr, int fq) const {
        const int row0 = u.pm * BM + wr * 64 + fr; const int col0 = u.pn * BM + wc * 32 + 8 * fq;
#pragma unroll
        for (int ai = 0; ai < 2; ++ai)
#pragma unroll
            for (int m = 0; m < 4; ++m) { const int t = row0 + ai * HALF + m * 16; bf16_t* rowp = O + (size_t)t * ldc + col0;
#pragma unroll
                for (int bj = 0; bj < 2; ++bj) { const f32x4 v0 = acc[ai][bj][m][0], v1 = acc[ai][bj][m][1];
                    u32x4 w; w.x = pk2(v0[0], v0[1]); w.y = pk2(v0[2], v0[3]); w.z = pk2(v1[0], v1[1]); w.w = pk2(v1[2], v1[3]);
                    const int col = col0 + bj * HALF;
                    if (col >= DV0) { const int dvf = col - DV0, hh = dvf >> 7, dv = dvf & 127, tp = t & (SEQ - 1), key = tp & 63;
                        bf16_t* vp = VT + (((((size_t)((t >> 12) * 4 + hh) * 64 + (tp >> 6)) * 4 + (dv >> 5)) * 4 + (key >> 4)) * 16 + (key & 15)) * 32 + (dv & 31);
                        if (col < NIN) *(u32x4*)vp = w; }
                    else *(u32x4*)(rowp + bj * HALF) = w; } }
    }
};
struct EpiResBf16 {
    static constexpr bool PERM = true;
    const float* base; bf16_t* out; int ldc;
    __device__ __forceinline__ void operator()(const f32x4 (&acc)[2][2][4][2], const Unit& u, int wr, int wc, int fr, int fq) const {
        const int col0 = u.pn * BM + wc * 32 + 8 * fq;
#pragma unroll
        for (int ai = 0; ai < 2; ++ai) {
            f32x4 bb[4][2][2];
#pragma unroll
            for (int m = 0; m < 4; ++m) { const size_t off = (size_t)(u.pm * BM + ai * HALF + wr * 64 + m * 16 + fr) * ldc + col0;
#pragma unroll
                for (int bj = 0; bj < 2; ++bj) { bb[m][bj][0] = *(const f32x4*)(base + off + bj * HALF); bb[m][bj][1] = *(const f32x4*)(base + off + bj * HALF + 4); } }
            __builtin_amdgcn_sched_barrier(0);
#pragma unroll
            for (int m = 0; m < 4; ++m) { const size_t off = (size_t)(u.pm * BM + ai * HALF + wr * 64 + m * 16 + fr) * ldc + col0;
#pragma unroll
                for (int bj = 0; bj < 2; ++bj) {
                    const f32x4 v0 = bb[m][bj][0] + acc[ai][bj][m][0], v1 = bb[m][bj][1] + acc[ai][bj][m][1];
                    u32x4 w; w.x = pk2(v0[0], v0[1]); w.y = pk2(v0[2], v0[3]); w.z = pk2(v1[0], v1[1]); w.w = pk2(v1[2], v1[3]);
                    *(u32x4*)(out + off + bj * HALF) = w; } }
            __builtin_amdgcn_sched_barrier(0);
        }
    }
};
struct EpiSwiglu {
    static constexpr bool PERM = true;
    unsigned char* O; const float* b1; const int* tile_e;
    __device__ __forceinline__ void operator()(const f32x4 (&acc)[2][2][4][2], const Unit& u, int wr, int wc, int fr, int fq) const {
        const int e = tile_e[u.pm]; const int row0 = u.pm * BM + wr * 64 + fr; const int hc0 = u.pn * 128 + wc * 32 + 8 * fq;
        const float* bg = b1 + (size_t)e * 2048 + hc0; const float* bl = bg + 1024;
        const f32x4 g0 = *(const f32x4*)bg, g1 = *(const f32x4*)(bg + 4), l0 = *(const f32x4*)bl, l1 = *(const f32x4*)(bl + 4);
#pragma unroll
        for (int ai = 0; ai < 2; ++ai)
#pragma unroll
            for (int m = 0; m < 4; ++m) { unsigned char* rowp = O + (size_t)(row0 + ai * HALF + m * 16) * 1024 + hc0;
                float o[8];
#pragma unroll
                for (int n = 0; n < 2; ++n) { const f32x4 gv = acc[ai][0][m][n] + (n ? g1 : g0), lv = acc[ai][1][m][n] + (n ? l1 : l0);
#pragma unroll
                    for (int i = 0; i < 4; ++i) { const float g = fminf(gv[i], 7.0f), l = fminf(fmaxf(lv[i], -7.0f), 7.0f);
                        const float sg = __builtin_amdgcn_rcpf(1.0f + __builtin_amdgcn_exp2f(-1.702f * LOG2E * g)); o[n * 4 + i] = g * sg * (l + 1.0f); } }
                u32x2 w; w.x = pk4_fp8(o[0] * F8_H_MUL, o[1] * F8_H_MUL, o[2] * F8_H_MUL, o[3] * F8_H_MUL); w.y = pk4_fp8(o[4] * F8_H_MUL, o[5] * F8_H_MUL, o[6] * F8_H_MUL, o[7] * F8_H_MUL);
                *(u32x2*)rowp = w; }
    }
};
struct EpiGateF8 {
    static constexpr bool PERM = true;
    unsigned char* O; const float* b2; const float* rowgate; const int* tile_e;
    __device__ __forceinline__ void operator()(const f32x4 (&acc)[2][2][4][2], const Unit& u, int wr, int wc, int fr, int fq) const {
        const int e = tile_e[u.pm]; const int row0 = u.pm * BM + wr * 64 + fr; const int col0 = u.pn * BM + wc * 32 + 8 * fq;
        f32x4 bv[2][2];
#pragma unroll
        for (int bj = 0; bj < 2; ++bj)
#pragma unroll
            for (int n = 0; n < 2; ++n) bv[bj][n] = *(const f32x4*)(b2 + (size_t)e * 1024 + col0 + bj * HALF + 4 * n);
#pragma unroll
        for (int ai = 0; ai < 2; ++ai)
#pragma unroll
            for (int m = 0; m < 4; ++m) { const int row = row0 + ai * HALF + m * 16; const float gt = rowgate[row] * F8_Y_MUL; unsigned char* rowp = O + (size_t)row * 1024 + col0;
#pragma unroll
                for (int bj = 0; bj < 2; ++bj) { const f32x4 v0 = (acc[ai][bj][m][0] + bv[bj][0]) * gt, v1 = (acc[ai][bj][m][1] + bv[bj][1]) * gt;
                    u32x2 w; w.x = pk4_fp8(v0[0], v0[1], v0[2], v0[3]); w.y = pk4_fp8(v1[0], v1[1], v1[2], v1[3]);
                    *(u32x2*)(rowp + bj * HALF) = w; } }
    }
};

__device__ __forceinline__ v8i32 pg8_ld32(const LAS unsigned char* p, const LAS unsigned char* q) { const u32x4 a = *(const LAS u32x4*)p, b = *(const LAS u32x4*)q;
    return (v8i32){(int)a.x, (int)a.y, (int)a.z, (int)a.w, (int)b.x, (int)b.y, (int)b.z, (int)b.w}; }
template <bool F8, bool GATHER, class Epi, class Sched>
__device__ __forceinline__ void gemm_phase(LAS unsigned char* lds, const Gemm g, const Sched& S, const Epi& E) {
    const int tid = threadIdx.x, wid = __builtin_amdgcn_readfirstlane(tid >> 6), lane = tid & 63, wr = wid >> 2, wc = wid & 3, fr = lane & 15, fq = lane >> 4;
    const int RB = F8 ? g.K : g.K * 2, nt = RB / 128;
    unsigned voffB[2];
#pragma unroll
    for (int i = 0; i < 2; ++i) { int R, C; if constexpr (F8) stage_rc_f8(tid * 16 + i * 8192, R, C); else stage_rc(tid * 16 + i * 8192, R, C); const int Rb = Epi::PERM ? ((R & ~31) + perm32(R & 31)) : R;
        voffB[i] = (unsigned)(Rb * RB + C * 2); }
#define PG8_AOFFS(dst, pm_) do { _Pragma("unroll") for (int h_ = 0; h_ < 2; ++h_) _Pragma("unroll") for (int i_ = 0; i_ < 2; ++i_) { int R_, C_; if constexpr (F8) stage_rc_f8(tid * 16 + i_ * 8192, R_, C_); else stage_rc(tid * 16 + i_ * 8192, R_, C_); \
        const int row_ = (pm_) * BM + h_ * HALF + R_; const unsigned grow_ = GATHER ? (unsigned)g.rowtok[row_] : (unsigned)row_; dst[h_][i_] = grow_ * (unsigned)RB + (unsigned)(C_ * 2); } } while (0)
    unsigned cvA[2][2], nvA[2][2];
    const size_t kstep = (size_t)(BK * 2);
    const size_t hstep = (size_t)HALF * RB;
    const size_t tstep = 2 * hstep;
    const unsigned ldsw = (unsigned)wid * 1024u;
    const int aoff = F8 ? frag_f8(wr * 64, fr, fq, 0) : lds_byte(wr * 64 + fr, fq * 8); const int aoff1 = F8 ? frag_f8(wr * 64, fr, fq, 1) : 0;
    const int boff = F8 ? frag_f8(wc * 32, fr, fq, 0) : lds_byte(wc * 32 + fr, fq * 8); const int boff1 = F8 ? frag_f8(wc * 32, fr, fq, 1) : 0;
    const int scW = g.scW, scA = g.scA;
#define PG8_SA(b, h) (((b) * 2 + (h)) * HTB)
#define PG8_SB(b, h) ((4 + (b) * 2 + (h)) * HTB)
#define PG8_STAGE(bufoff, gbase, voff) do { _Pragma("unroll") for (int _i = 0; _i < 2; ++_i) \
        __builtin_amdgcn_global_load_lds((const unsigned*)((const char*)(gbase) + (voff)[_i]), (LAS unsigned*)(lds + (bufoff) + ldsw + _i * 8192), 16, 0, 0); } while (0)
typedef int v8i32a __attribute__((ext_vector_type(8), aligned(16)));
#define PG8_LD32(p, q) pg8_ld32(p, q)
#define PG8_STAGE_A(bufoff, kptr, offs) do { _Pragma("unroll") for (int _i = 0; _i < 2; ++_i) \
        __builtin_amdgcn_global_load_lds((const unsigned*)((const char*)(kptr) + (offs)[_i]), (LAS unsigned*)(lds + (bufoff) + ldsw + _i * 8192), 16, 0, 0); } while (0)
#define PG8_LDA(dst, b, h) do { _Pragma("unroll") for (int m = 0; m < 4; ++m) { if constexpr (F8) { dst[m].f8 = PG8_LD32(lds + PG8_SA(b, h) + aoff + m * 2048, lds + PG8_SA(b, h) + aoff1 + m * 2048); } \
        else { _Pragma("unroll") for (int k = 0; k < 2; ++k) dst[m].hv[k] = *(const LAS bf16x8*)(lds + PG8_SA(b, h) + aoff + m * 2048 + k * 1024); } } } while (0)
#define PG8_LDB(dst, b, h) do { _Pragma("unroll") for (int n = 0; n < 2; ++n) { if constexpr (F8) { dst[n].f8 = PG8_LD32(lds + PG8_SB(b, h) + boff + n * 2048, lds + PG8_SB(b, h) + boff1 + n * 2048); } \
        else { _Pragma("unroll") for (int k = 0; k < 2; ++k) dst[n].hv[k] = *(const LAS bf16x8*)(lds + PG8_SB(b, h) + boff + n * 2048 + k * 1024); } } } while (0)
#define PG8_MMA(ai, bj, At, Bt) do { __builtin_amdgcn_s_setprio(1); _Pragma("unroll") for (int m = 0; m < 4; ++m) _Pragma("unroll") for (int n = 0; n < 2; ++n) { \
        if constexpr (F8) { asm volatile("v_mfma_scale_f32_16x16x128_f8f6f4 %0, %1, %2, %0, %3, %4 op_sel_hi:[0,0,0]" : "+v"(acc[ai][bj][m][n]) : "v"(Bt[n].f8), "v"(At[m].f8), "v"(scW), "v"(scA)); } \
        else { _Pragma("unroll") for (int k = 0; k < 2; ++k) acc[ai][bj][m][n] = __builtin_amdgcn_mfma_f32_16x16x32_bf16(Bt[n].hv[k], At[m].hv[k], acc[ai][bj][m][n], 0, 0, 0); } } \
        __builtin_amdgcn_s_setprio(0); } while (0)
#define PG8_WAIT_V(n) asm volatile("s_waitcnt vmcnt(" #n ")" ::: "memory")
#define PG8_WAIT_L(n) asm volatile("s_waitcnt lgkmcnt(" #n ")" ::: "memory")
#define PG8_BAR __builtin_amdgcn_s_barrier()
#define PG8_SCHED __builtin_amdgcn_sched_barrier(0)
    Unit cur, nxt; int ui = 0;
    if (!S.next(0, cur)) return;
    f32x4 acc[2][2][4][2];
#pragma unroll
    for (int a = 0; a < 2; ++a)
#pragma unroll
        for (int b = 0; b < 2; ++b)
#pragma unroll
            for (int m = 0; m < 4; ++m)
#pragma unroll
                for (int n = 0; n < 2; ++n) acc[a][b][m][n] = (f32x4){0.f, 0.f, 0.f, 0.f};
    struct FragH { bf16x8 hv[2]; }; struct Frag8 { v8i32 f8; };
    typename std::conditional<F8, Frag8, FragH>::type At[4], B0[2], B1[2];
    const char* const kA = (const char*)g.A; const char* cB = (const char*)g.Bt + (size_t)cur.pb * tstep;
    PG8_AOFFS(cvA, cur.pm);
    PG8_STAGE(PG8_SB(0, 0), cB, voffB); PG8_STAGE(PG8_SB(0, 1), cB + hstep, voffB); PG8_STAGE_A(PG8_SA(0, 0), kA, cvA[0]); PG8_STAGE_A(PG8_SA(0, 1), kA, cvA[1]);
    if (wr == 1) PG8_BAR;
    PG8_WAIT_V(2); PG8_BAR;
    PG8_STAGE(PG8_SB(1, 0), cB + kstep, voffB); PG8_STAGE_A(PG8_SA(1, 0), kA + kstep, cvA[0]); PG8_STAGE(PG8_SB(1, 1), cB + hstep + kstep, voffB);
    PG8_WAIT_V(6); PG8_BAR;
    for (;;) {
        const bool has_next = S.next(ui + 1, nxt);
        const char* nB = has_next ? (const char*)g.Bt + (size_t)nxt.pb * tstep : cB;
        if (has_next) { PG8_AOFFS(nvA, nxt.pm); } else { _Pragma("unroll") for (int h_ = 0; h_ < 2; ++h_) _Pragma("unroll") for (int i_ = 0; i_ < 2; ++i_) nvA[h_][i_] = cvA[h_][i_]; }
#pragma clang loop unroll(disable)
        for (int t = 0; t < nt; t += 2) {
            const bool last = (t == nt - 2);
            const char* a1 = kA + (size_t)(t + 1) * kstep;
            const char* a2 = last ? kA : kA + (size_t)(t + 2) * kstep; const char* b2 = last ? nB : cB + (size_t)(t + 2) * kstep;
            const char* a3 = a2 + kstep; const char* b3 = b2 + kstep;
            unsigned v2A[2][2];
#pragma unroll
            for (int h_ = 0; h_ < 2; ++h_)
#pragma unroll
                for (int i_ = 0; i_ < 2; ++i_) v2A[h_][i_] = last ? nvA[h_][i_] : cvA[h_][i_];
            PG8_LDB(B0, 0, 0); PG8_LDB(B1, 0, 1); PG8_SCHED; PG8_LDA(At, 0, 0); PG8_STAGE_A(PG8_SA(1, 1), a1, cvA[1]);
            PG8_WAIT_V(8); PG8_WAIT_L(0); PG8_BAR; PG8_MMA(0, 0, At, B0); PG8_MMA(0, 1, At, B1); PG8_BAR; PG8_SCHED;
            PG8_LDA(At, 0, 1); PG8_STAGE(PG8_SB(0, 0), b2, voffB); PG8_STAGE(PG8_SB(0, 1), b2 + hstep, voffB); PG8_STAGE_A(PG8_SA(0, 0), a2, v2A[0]);
            PG8_WAIT_V(8); PG8_WAIT_L(0); PG8_BAR; PG8_MMA(1, 0, At, B0); PG8_MMA(1, 1, At, B1); PG8_BAR; PG8_SCHED;
            PG8_LDB(B0, 1, 0); PG8_LDB(B1, 1, 1); PG8_SCHED; PG8_LDA(At, 1, 0); PG8_STAGE_A(PG8_SA(0, 1), a2, v2A[1]);
            PG8_WAIT_V(8); PG8_WAIT_L(0); PG8_BAR; PG8_MMA(0, 0, At, B0); PG8_MMA(0, 1, At, B1); PG8_BAR; PG8_SCHED;
            PG8_LDA(At, 1, 1); PG8_STAGE(PG8_SB(1, 0), b3, voffB); PG8_STAGE(PG8_SB(1, 1), b3 + hstep, voffB); PG8_STAGE_A(PG8_SA(1, 0), a3, v2A[0]);
            PG8_WAIT_V(8); PG8_WAIT_L(0); PG8_BAR; PG8_MMA(1, 0, At, B0); PG8_MMA(1, 1, At, B1); PG8_BAR; PG8_SCHED;
        }
        if (wr == 0) PG8_BAR;
        if constexpr (F8) asm volatile("s_nop 15\n\ts_nop 15" ::: "memory");
        E(acc, cur, wr, wc, fr, fq);
        if (!has_next) break;
#pragma unroll
        for (int a = 0; a < 2; ++a)
#pragma unroll
            for (int b = 0; b < 2; ++b)
#pragma unroll
                for (int m = 0; m < 4; ++m)
#pragma unroll
                    for (int n = 0; n < 2; ++n) acc[a][b][m][n] = (f32x4){0.f, 0.f, 0.f, 0.f};
        cur = nxt; cB = nB; ++ui;
#pragma unroll
        for (int h_ = 0; h_ < 2; ++h_)
#pragma unroll
            for (int i_ = 0; i_ < 2; ++i_) cvA[h_][i_] = nvA[h_][i_];
        if (wr == 1) PG8_BAR;
    }
    PG8_WAIT_V(0);
    PG8_BAR;
#undef PG8_SA
#undef PG8_SB
#undef PG8_STAGE
#undef PG8_STAGE_A
#undef PG8_AOFFS
#undef PG8_LDA
#undef PG8_LDB
#undef PG8_MMA
#undef PG8_LD32
#undef PG8_WAIT_V
#undef PG8_WAIT_L
#undef PG8_BAR
#undef PG8_SCHED
}
}

struct Args { const float* in[30]; float* out; unsigned char* ws; int ph_lo, ph_hi; };

__device__ __forceinline__ void p0_transpose_item(const float* W, int K, int N, bf16_t* WT, int k0, int n0, int drow0, LAS float* scr, int lane) {
#pragma unroll 8
    for (int i = 0; i < 32; ++i) { const int kk = 2 * i + (lane >> 5); scr[kk * 33 + (lane & 31)] = W[(size_t)(k0 + kk) * N + n0 + (lane & 31)]; }
    asm volatile("s_waitcnt lgkmcnt(0)" ::: "memory");
    const int c = lane & 7;
#pragma unroll
    for (int j = 0; j < 4; ++j) { const int n = (lane >> 3) + 8 * j; const LAS float* s = scr + (8 * c) * 33 + n;
        u32x4 o; o.x = pk2(s[0 * 33], s[1 * 33]); o.y = pk2(s[2 * 33], s[3 * 33]); o.z = pk2(s[4 * 33], s[5 * 33]); o.w = pk2(s[6 * 33], s[7 * 33]);
        *(u32x4*)(WT + (size_t)(drow0 + n) * K + k0 + 8 * c) = o; }
    asm volatile("s_waitcnt lgkmcnt(0)" ::: "memory");
}
__device__ __forceinline__ void p0_transpose_item_f8(const float* W, int K, int N, unsigned char* WT, int k0, int n0, int drow0, LAS float* scr, int lane) {
    LAS unsigned* tile = (LAS unsigned*)scr;
    const float* src = W + (size_t)k0 * N + n0 + lane;
#pragma unroll 1
    for (int kb = 0; kb < 32; kb += 16) {
        float v[16][4];
#pragma unroll
        for (int i = 0; i < 16; ++i) { const float* p = src + (size_t)(4 * (kb + i)) * N;
#pragma unroll
            for (int j = 0; j < 4; ++j) v[i][j] = __builtin_nontemporal_load(p + (size_t)j * N); }
        __builtin_amdgcn_sched_barrier(0);
#pragma unroll
        for (int i = 0; i < 16; ++i) tile[lane * 33 + kb + i] = pk4_fp8(v[i][0] * F8_W_MUL, v[i][1] * F8_W_MUL, v[i][2] * F8_W_MUL, v[i][3] * F8_W_MUL);
        __builtin_amdgcn_sched_barrier(0);
    }
    asm volatile("s_waitcnt lgkmcnt(0)" ::: "memory");
    const int c = lane & 7;
#pragma unroll
    for (int j = 0; j < 8; ++j) { const int n = (lane >> 3) + 8 * j; const LAS unsigned* t = tile + n * 33 + 4 * c;
        __builtin_nontemporal_store((u32x4){t[0], t[1], t[2], t[3]}, (u32x4*)(WT + (size_t)(drow0 + n) * K + k0 + 16 * c)); }
    asm volatile("s_waitcnt lgkmcnt(0)" ::: "memory");
}
constexpr int CONV_I_W1 = 8 * 32, CONV_I_W2 = 8 * 16;
constexpr int CONV_ITEMS = NE * (CONV_I_W1 + CONV_I_W2) / 8;
__device__ __forceinline__ void conv_item(LAS unsigned char* lds, const Args& a, int bi) {
    const int lane = threadIdx.x & 63, wave = __builtin_amdgcn_readfirstlane(threadIdx.x >> 6);
    LAS float* scr = (LAS float*)(lds + wave * 16384);
    unsigned char* W1t = a.ws + WS_W1T; unsigned char* W2t = a.ws + WS_W2T;
    int r = bi * 8 + wave;
    if (r < NE * CONV_I_W1) { const int e = r / CONV_I_W1, q = r % CONV_I_W1, kb = q / 32, nb = q % 32; const int n0 = 64 * nb;
        const int drow = (n0 < 1024) ? ((n0 >> 7) * 256 + (n0 & 127)) : (((n0 - 1024) >> 7) * 256 + 128 + ((n0 - 1024) & 127));
        p0_transpose_item_f8(a.in[26] + (size_t)e * 1024 * 2048, 1024, 2048, W1t + (size_t)e * 2048 * 1024, 128 * kb, n0, drow, scr, lane); }
    else { r -= NE * CONV_I_W1; const int e = r / CONV_I_W2, q = r % CONV_I_W2, kb = q / 16, nb = q % 16;
        p0_transpose_item_f8(a.in[28] + (size_t)e * 1024 * 1024, 1024, 1024, W2t + (size_t)e * 1024 * 1024, 128 * kb, 64 * nb, 64 * nb, scr, lane); }
}
__device__ __forceinline__ void p0_prologue(LAS unsigned char* lds, const Args& a, int G) {
    const int tid = threadIdx.x, lane = tid & 63, wave = __builtin_amdgcn_readfirstlane(tid >> 6);
    LAS float* scr = (LAS float*)(lds + wave * 16384);
    const int gw = blockIdx.x * 8 + wave, NGW = G * 8;
    unsigned char* ws = a.ws;
    bf16_t* Wint = (bf16_t*)(ws + WS_WINT); bf16_t* Woutt = (bf16_t*)(ws + WS_WOUT);
    constexpr int I_IN = 16 * (NIN / 32);
    constexpr int I_OUT = 16 * 32;
    constexpr int NITEMS = I_IN + I_OUT;
    for (int it = gw; it < NITEMS; it += NGW) {
        int r = it;
        if (r < I_IN) { const int nblk = NIN / 32, kb = r / nblk, nb = r % nblk; p0_transpose_item(a.in[2], 1024, NIN, Wint, 64 * kb, 32 * nb, 32 * nb, scr, lane); continue; } r -= I_IN;
        { const int kb = r / 32, nb = r % 32; p0_transpose_item(a.in[22], 1024, 1024, Woutt, 64 * kb, 32 * nb, 32 * nb, scr, lane); }
    }
    { bf16_t* LW = (bf16_t*)(ws + WS_LW);
      for (int i = gw * 64 + lane; i < CW * 160; i += NGW * 64) { const int col = i / 160, k = i - col * 160;
          const float v = k < 32 ? a.in[5][k * CW + col] : (k < 64 ? a.in[7][(k - 32) * CW + col] : a.in[8][(k - 64) * CW + col]); LW[i] = (bf16_t)f2bf(v); } }
    const float* x = a.in[0]; const float* g1 = a.in[1]; bf16_t* XN = (bf16_t*)(ws + WS_XN);
    f32x4 gv[4];
#pragma unroll
    for (int j = 0; j < 4; ++j) gv[j] = *((const f32x4*)g1 + lane + 64 * j);
#pragma unroll 4
    for (int m = gw; m < T; m += NGW) {
        const f32x4* xr = (const f32x4*)(x + (size_t)m * D) + lane;
        f32x4 v[4]; float s = 0.f;
#pragma unroll
        for (int j = 0; j < 4; ++j) { v[j] = xr[64 * j]; s += (v[j].x * v[j].x + v[j].y * v[j].y) + (v[j].z * v[j].z + v[j].w * v[j].w); }
        const float rstd = 1.0f / sqrtf(wave_sum(s) * (1.0f / D) + 1e-5f);
        u32x2* o8 = (u32x2*)(XN + (size_t)m * D) + lane;
#pragma unroll
        for (int j = 0; j < 4; ++j) { u32x2 w; w.x = pk2(v[j].x * rstd * gv[j].x, v[j].y * rstd * gv[j].y); w.y = pk2(v[j].z * rstd * gv[j].z, v[j].w * rstd * gv[j].w); o8[64 * j] = w; }
    }
}

__device__ __forceinline__ f32x4 cvlo(const u32x4 u) { return (f32x4){bflo(u.x), bfhi(u.x), bflo(u.y), bfhi(u.y)}; }
__device__ __forceinline__ f32x4 cvhi(const u32x4 u) { return (f32x4){bflo(u.z), bfhi(u.z), bflo(u.w), bfhi(u.w)}; }
__device__ __forceinline__ u32x4 pk8(const f32x4 lo, const f32x4 hi) { u32x4 w; w.x = pk2(lo.x, lo.y); w.y = pk2(lo.z, lo.w); w.z = pk2(hi.x, hi.y); w.w = pk2(hi.z, hi.w); return w; }

namespace ck {
constexpr int PS = 136;
constexpr int O_BT = 0, O_KT = 8704, O_AP = 17408, O_RT = 26112;
constexpr int O_AT = 34816, O_BH = 43008, O_KH = 51200, O_VV = 59392, O_TN = 67584, O_A2 = 75776, O_V2 = 83968;
constexpr int O_L = 92160, LSTR = 68;
constexpr int O_TOT = 109568, O_GC = 111616;
constexpr int O_PT = 132608;
constexpr int O_ACT = 112128;
__device__ __forceinline__ int crow(int r, int hi) { return (r & 3) + 8 * (r >> 2) + 4 * hi; }
__device__ __forceinline__ int voff(int row, int col) { return ((col >> 5) * 4 + (row >> 4)) * 1024 + (row & 15) * 64 + (col & 31) * 2; }
__device__ __forceinline__ s16x4 vtr(const LAS unsigned char* p) { return __builtin_bit_cast(s16x4, __builtin_amdgcn_ds_read_tr16_b64_v4i16((LAS s16x4*)p)); }
__device__ __forceinline__ bf16x8 fragP(const LAS unsigned char* M, int row, int k0, int hi) {
    const LAS unsigned char* p = M + row * PS + (k0 + 4 * hi) * 2; const s16x4 lo = *(const LAS s16x4*)p, h = *(const LAS s16x4*)(p + 16);
    return (bf16x8){lo[0], lo[1], lo[2], lo[3], h[0], h[1], h[2], h[3]}; }
__device__ __forceinline__ bf16x8 fragT(const LAS unsigned char* M, int k0, int colblk, int lane, int hi) {
    const LAS unsigned char* p = M + (colblk * 4 + (k0 >> 4)) * 1024 + ((lane >> 4) & 1) * 32 + (lane & 3) * 8 + (4 * hi + ((lane & 15) >> 2)) * 64;
    const s16x4 lo = vtr(p), h = vtr(p + 512); return (bf16x8){lo[0], lo[1], lo[2], lo[3], h[0], h[1], h[2], h[3]}; }
__device__ __forceinline__ bf16x8 packR(const f32x16& x, int s) {
    u32x4 w; w.x = pk2(x[8 * s], x[8 * s + 1]); w.y = pk2(x[8 * s + 2], x[8 * s + 3]); w.z = pk2(x[8 * s + 4], x[8 * s + 5]); w.w = pk2(x[8 * s + 6], x[8 * s + 7]); return __builtin_bit_cast(bf16x8, w); }
#define CK_MFMA(a, b, c) __builtin_amdgcn_mfma_f32_32x32x16_bf16(a, b, c, 0, 0, 0)
__device__ __forceinline__ f32x16 score(const LAS unsigned char* Am, const LAS unsigned char* Bm, int sblk, int tblk, int mode, int r32, int hi) {
    f32x16 x = f32x16{};
#pragma unroll
    for (int ks = 0; ks < 4; ++ks) x = CK_MFMA(fragP(Am, sblk * 32 + r32, 16 * ks, hi), fragP(Bm, tblk * 32 + r32, 16 * ks, hi), x);
    if (mode) {
        const int t = tblk * 32 + r32;
#pragma unroll
        for (int r = 0; r < 16; ++r) { const int s = sblk * 32 + crow(r, hi); if (mode == 1 ? !(s < t) : !(s <= t)) x[r] = 0.f; }
    }
    return x;
}
__device__ __forceinline__ void storeT_V(LAS unsigned char* M, const f32x16& x, int rb, int c, int hi) {
#pragma unroll
    for (int q = 0; q < 4; ++q) { u32x2 w; w.x = pk2(x[4 * q], x[4 * q + 1]); w.y = pk2(x[4 * q + 2], x[4 * q + 3]); *(LAS u32x2*)(M + voff(c, rb * 32 + 8 * q + 4 * hi)) = w; }
}
__device__ __forceinline__ void storeT_S(LAS unsigned char* M, const f32x16& x, int rb, int c, int hi) {
#pragma unroll
    for (int q = 0; q < 4; ++q) { u32x2 w; w.x = pk2(x[4 * q], x[4 * q + 1]); w.y = pk2(x[4 * q + 2], x[4 * q + 3]); *(LAS u32x2*)(M + c * PS + (rb * 32 + 8 * q + 4 * hi) * 2) = w; }
}

__device__ __forceinline__ void chunk_item(LAS unsigned char* lds, const Args& a, int item) {
    int tid = threadIdx.x; asm volatile("" : "+v"(tid)); int lane = tid & 63; const int wave = __builtin_amdgcn_readfirstlane(tid >> 6);
#define CK_FRESH() asm volatile("" : "+v"(lane)); r32 = lane & 31; hi = lane >> 5
    int r32, hi; CK_FRESH();
    unsigned char* ws = a.ws;
    const bf16_t* SR = (const bf16_t*)(ws + WS_SR); const bf16_t* SK = (const bf16_t*)(ws + WS_SK); const bf16_t* SV = (const bf16_t*)(ws + WS_SV);
    const bf16_t* SA = (const bf16_t*)(ws + WS_SA); const bf16_t* SB = (const bf16_t*)(ws + WS_SB); const float* SW = (const float*)(ws + WS_SW);
    bf16_t* CG = (bf16_t*)(ws + WS_CG) + (size_t)item * 4096; bf16_t* CH = (bf16_t*)(ws + WS_CH) + (size_t)item * 4096;
    bf16_t* CR2 = (bf16_t*)(ws + WS_CR2) + (size_t)item * 4096; bf16_t* CY0 = (bf16_t*)(ws + WS_CY0) + (size_t)item * 4096;
    const int bh = item >> 6, c = item & 63, b = bh >> 3, h = bh & 7, tokc = b * SEQ + c * 64, col0 = h * 64;
    LAS unsigned char* BT = lds + O_BT; LAS unsigned char* KT = lds + O_KT; LAS unsigned char* AP = lds + O_AP; LAS unsigned char* RT = lds + O_RT;
    LAS unsigned char* AT = lds + O_AT; LAS unsigned char* BH = lds + O_BH; LAS unsigned char* KH = lds + O_KH; LAS unsigned char* VV = lds + O_VV;
    LAS unsigned char* TN = lds + O_TN; LAS unsigned char* A2M = lds + O_A2; LAS unsigned char* V2M = lds + O_V2;
    LAS float* L = (LAS float*)(lds + O_L); LAS float* TOT = (LAS float*)(lds + O_TOT); LAS float* GC = (LAS float*)(lds + O_GC);
    {
        const int tl = tid >> 3, c8 = (tid & 7) * 8, cr = col0 + c8, t = tokc + tl;
        const bf16_t* P = (const bf16_t*)(ws + WS_P); const bf16_t* pr = P + (size_t)t * NINP + cr;
        bf16_t* SVo = (bf16_t*)(ws + WS_SV); bf16_t* SGo = (bf16_t*)(ws + WS_SG); bf16_t* QN = (bf16_t*)(ws + WS_QN); bf16_t* KN = (bf16_t*)(ws + WS_KN);
        const LAS float* PT = (const LAS float*)(lds + O_PT);
        const bool first = (t & (SEQ - 1)) == 0; const u32x4 zz = (u32x4){0u, 0u, 0u, 0u};
#define CK_PK8(v) ((u32x4){pk2(v[0], v[1]), pk2(v[2], v[3]), pk2(v[4], v[5]), pk2(v[6], v[7])})
#define CK_ST_P(M, val_) do { LAS unsigned char* d_ = (M) + tl * PS + c8 * 2; const u32x4 q_ = (val_); *(LAS u32x2*)d_ = (u32x2){q_[0], q_[1]}; *(LAS u32x2*)(d_ + 8) = (u32x2){q_[2], q_[3]}; } while (0)
        const u32x4 cu_r = *(const u32x4*)(pr), pu_r = first ? zz : *(const u32x4*)(pr - NINP);
        const u32x4 cu_v = *(const u32x4*)(pr + 1024), pu_v = first ? zz : *(const u32x4*)(pr - NINP + 1024);
        const u32x4 cu_k = *(const u32x4*)(pr + 512), pu_k = first ? zz : *(const u32x4*)(pr - NINP + 512);
        const u32x4 uq = *(const u32x4*)(pr + DQ0), ukd = *(const u32x4*)(pr + DK0);
        __builtin_amdgcn_sched_barrier(0);
        float g[8], gp[8], ig[8], gC[8];
        {
            const u32x4 deu = *(const LAS u32x4*)(TN + tl * 128 + c8 * 2); const f32x4 de0 = cvlo(deu), de1 = cvhi(deu);
            float wv[8] = {__builtin_amdgcn_exp2f(de0.x), __builtin_amdgcn_exp2f(de0.y), __builtin_amdgcn_exp2f(de0.z), __builtin_amdgcn_exp2f(de0.w), __builtin_amdgcn_exp2f(de1.x), __builtin_amdgcn_exp2f(de1.y), __builtin_amdgcn_exp2f(de1.z), __builtin_amdgcn_exp2f(de1.w)};
            float p[8];
#pragma unroll
            for (int j = 0; j < 8; ++j) p[j] = wv[j];
#pragma unroll
            for (int d = 8; d < 64; d <<= 1) {
#pragma unroll
                for (int j = 0; j < 8; ++j) { const float q = __shfl_up(p[j], d); if (lane >= d) p[j] *= q; }
            }
            if ((lane >> 3) == 7) { *(LAS f32x4*)(TOT + wave * 64 + c8) = (f32x4){p[0], p[1], p[2], p[3]}; *(LAS f32x4*)(TOT + wave * 64 + c8 + 4) = (f32x4){p[4], p[5], p[6], p[7]}; }
            __syncthreads();
            float pre[8];
#pragma unroll
            for (int j = 0; j < 8; ++j) { pre[j] = 1.f; gC[j] = 1.f; }
#pragma unroll
            for (int w2 = 0; w2 < 8; ++w2) { const f32x4 t0 = *(const LAS f32x4*)(TOT + w2 * 64 + c8), t1 = *(const LAS f32x4*)(TOT + w2 * 64 + c8 + 4);
                const float tv[8] = {t0.x, t0.y, t0.z, t0.w, t1.x, t1.y, t1.z, t1.w};
#pragma unroll
                for (int j = 0; j < 8; ++j) { if (w2 < wave) pre[j] *= tv[j]; gC[j] *= tv[j]; } }
            if (tid < 8) { *(LAS f32x4*)(GC + c8) = (f32x4){gC[0], gC[1], gC[2], gC[3]}; *(LAS f32x4*)(GC + c8 + 4) = (f32x4){gC[4], gC[5], gC[6], gC[7]}; }
#pragma unroll
            for (int j = 0; j < 8; ++j) { g[j] = pre[j] * p[j]; ig[j] = __builtin_amdgcn_rcpf(g[j]); gp[j] = g[j] * __builtin_amdgcn_rcpf(wv[j]); }
        }
        f32x4 r0, r1;
        { const u32x4 cu = cu_r, pu = pu_r;
          const f32x4 m0 = *(const LAS f32x4*)(PT + cr), m1 = *(const LAS f32x4*)(PT + cr + 4); const f32x4 c0 = cvlo(cu), c1 = cvhi(cu), p0 = cvlo(pu), p1 = cvhi(pu);
          r0 = c0 + (p0 - c0) * m0; r1 = c1 + (p1 - c1) * m1;
          const float rt[8] = {r0.x * g[0], r0.y * g[1], r0.z * g[2], r0.w * g[3], r1.x * g[4], r1.y * g[5], r1.z * g[6], r1.w * g[7]};
          CK_ST_P(RT, CK_PK8(rt)); }
        { const u32x4 cu = cu_v, pu = pu_v;
          const f32x4 m0 = *(const LAS f32x4*)(PT + 1024 + cr), m1 = *(const LAS f32x4*)(PT + 1024 + cr + 4); const f32x4 c0 = cvlo(cu), c1 = cvhi(cu), p0 = cvlo(pu), p1 = cvhi(pu);
          const u32x4 uv = pk8(c0 + (p0 - c0) * m0, c1 + (p1 - c1) * m1); *(u32x4*)(SVo + (size_t)t * CW + cr) = uv; *(LAS u32x4*)(VV + voff(tl, c8)) = uv; }
        *(u32x4*)(SGo + (size_t)t * CW + cr) = *(const LAS u32x4*)(V2M + tl * 128 + c8 * 2);
        { const u32x4 cu = cu_k, pu = pu_k;
          const f32x4 m0 = *(const LAS f32x4*)(PT + 512 + cr), m1 = *(const LAS f32x4*)(PT + 512 + cr + 4); const f32x4 c0 = cvlo(cu), c1 = cvhi(cu), p0 = cvlo(pu), p1 = cvhi(pu);
          const f32x4 k0 = c0 + (p0 - c0) * m0, k1 = c1 + (p1 - c1) * m1;
          const u32x4 alu = *(const LAS u32x4*)(A2M + tl * 128 + c8 * 2); const f32x4 al0 = cvlo(alu), al1 = cvhi(alu);
          const f32x4 kk0 = k0 * *(const LAS f32x4*)(PT + 1536 + cr), kk1 = k1 * *(const LAS f32x4*)(PT + 1536 + cr + 4);
          const float ss = red8((kk0.x * kk0.x + kk0.y * kk0.y) + (kk0.z * kk0.z + kk0.w * kk0.w) + (kk1.x * kk1.x + kk1.y * kk1.y) + (kk1.z * kk1.z + kk1.w * kk1.w));
          const float inv = 1.0f / sqrtf(fmaxf(ss, 1e-24f));
          const f32x4 kn0 = kk0 * inv, kn1 = kk1 * inv;
          const f32x4 k20 = k0 * (1.0f + (al0 - 1.0f) * *(const LAS f32x4*)(PT + 2048 + cr)), k21 = k1 * (1.0f + (al1 - 1.0f) * *(const LAS f32x4*)(PT + 2048 + cr + 4));
          { const f32x4 q0 = r0 * k20 * *(const LAS f32x4*)(PT + 2560 + cr), q1 = r1 * k21 * *(const LAS f32x4*)(PT + 2560 + cr + 4);
            const float rk = red8((q0.x + q0.y) + (q0.z + q0.w) + (q1.x + q1.y) + (q1.z + q1.w));
            if ((lane & 7) == 0) ((float*)(ws + WS_RK))[(size_t)t * 8 + h] = rk; }
          const float kv[8] = {k20.x, k20.y, k20.z, k20.w, k21.x, k21.y, k21.z, k21.w}, nv[8] = {kn0.x, kn0.y, kn0.z, kn0.w, kn1.x, kn1.y, kn1.z, kn1.w}, av_[8] = {al0.x, al0.y, al0.z, al0.w, al1.x, al1.y, al1.z, al1.w};
          float at[8], bt[8], kt[8], bh[8], kh[8];
#pragma unroll
          for (int j = 0; j < 8; ++j) { at[j] = -nv[j] * gp[j]; bt[j] = nv[j] * av_[j] * ig[j]; kt[j] = kv[j] * ig[j]; bh[j] = bt[j] * gC[j]; kh[j] = kt[j] * gC[j]; }
          const u32x4 wa = CK_PK8(at);
          CK_ST_P(AP, wa); *(LAS u32x4*)(AT + voff(tl, c8)) = wa;
          CK_ST_P(BT, CK_PK8(bt)); CK_ST_P(KT, CK_PK8(kt));
          *(LAS u32x4*)(BH + voff(tl, c8)) = CK_PK8(bh); *(LAS u32x4*)(KH + voff(tl, c8)) = CK_PK8(kh); }
        {
          const f32x4 q0 = cvlo(uq), q1 = cvhi(uq), d0 = cvlo(ukd), d1 = cvhi(ukd);
          const float qs = red8((q0.x * q0.x + q0.y * q0.y) + (q0.z * q0.z + q0.w * q0.w) + (q1.x * q1.x + q1.y * q1.y) + (q1.z * q1.z + q1.w * q1.w));
          const float ks = red8((d0.x * d0.x + d0.y * d0.y) + (d0.z * d0.z + d0.w * d0.w) + (d1.x * d1.x + d1.y * d1.y) + (d1.z * d1.z + d1.w * d1.w));
          const float qi = (1.0f / sqrtf(qs * (1.0f / 64.0f) + 1e-5f)) * (0.125f * LOG2E), ki = 1.0f / sqrtf(ks * (1.0f / 64.0f) + 1e-5f);
          const f32x4 g0 = *(const LAS f32x4*)(PT + 3072 + c8), g1 = *(const LAS f32x4*)(PT + 3072 + c8 + 4), h0 = *(const LAS f32x4*)(PT + 3136 + c8), h1 = *(const LAS f32x4*)(PT + 3136 + c8 + 4);
          *(u32x4*)(QN + (size_t)t * CW + cr) = pk8(q0 * qi * g0, q1 * qi * g1);
          const size_t ko = ((((size_t)(b * 8 + h) * 64 + c) * 8 + (c8 >> 3)) * 64 + tl) * 8;
          *(u32x4*)(KN + ko) = pk8(d0 * ki * h0, d1 * ki * h1); }
#undef CK_PK8
#undef CK_ST_P
    }
    __syncthreads();
    CK_FRESH();
    f32x16 pa = f32x16{}, pb = f32x16{}, pc = f32x16{}, pd = f32x16{};
#define w1a pa
#define w1b pb
#define xb0 pa
#define xb1 pb
#define y0a pc
#define y0b pd
    if (wave < 2) {
        for (int k = 0; k < (wave == 0 ? 2 : 1); ++k) {
            const int sblk = wave == 0 ? k : 0, tblk = wave == 0 ? k : 1;
            const f32x16 x = score(BT, AP, sblk, tblk, wave == 0 ? 1 : 0, r32, hi);
            const int t = tblk * 32 + r32;
#pragma unroll
            for (int r = 0; r < 16; ++r) L[(sblk * 32 + crow(r, hi)) * LSTR + t] = x[r];
        }
    }
    __syncthreads();
    CK_FRESH();
    if (wave == 6) {
        float x[32];
#pragma unroll
        for (int t = 0; t < 32; ++t) x[t] = (r32 == t) ? 1.f : 0.f;
        const LAS float* Nr = L + (32 * hi) * LSTR + 32 * hi;
#pragma unroll
        for (int sidx = 0; sidx < 31; ++sidx) {
#pragma unroll
            for (int g4 = (sidx + 1) / 4; g4 < 8; ++g4) {
                const f32x4 nv = *(const LAS f32x4*)(Nr + sidx * LSTR + 4 * g4);
                if (4 * g4 + 0 > sidx) x[4 * g4 + 0] += nv.x * x[sidx];
                if (4 * g4 + 1 > sidx) x[4 * g4 + 1] += nv.y * x[sidx];
                if (4 * g4 + 2 > sidx) x[4 * g4 + 2] += nv.z * x[sidx];
                if (4 * g4 + 3 > sidx) x[4 * g4 + 3] += nv.w * x[sidx];
            }
            if ((sidx & 3) == 3) __builtin_amdgcn_sched_barrier(0);
        }
        const int cc = 32 * hi + r32;
#pragma unroll
        for (int t0 = 0; t0 < 32; t0 += 8) { u32x4 w; w.x = pk2(x[t0], x[t0 + 1]); w.y = pk2(x[t0 + 2], x[t0 + 3]); w.z = pk2(x[t0 + 4], x[t0 + 5]); w.w = pk2(x[t0 + 6], x[t0 + 7]);
            *(LAS u32x4*)(TN + voff(cc, 32 * hi + t0)) = w; }
        f32x16 m = f32x16{};
#pragma unroll
        for (int s = 0; s < 2; ++s) {
            const LAS float* lp = L + (16 * s + 4 * hi) * LSTR + 32 + r32;
            u32x4 aw; aw.x = pk2(lp[0], lp[LSTR]); aw.y = pk2(lp[2 * LSTR], lp[3 * LSTR]); aw.z = pk2(lp[8 * LSTR], lp[9 * LSTR]); aw.w = pk2(lp[10 * LSTR], lp[11 * LSTR]);
            const s16x4 b0 = *(const LAS s16x4*)(TN + voff(r32, 16 * s + 4 * hi)), b1 = *(const LAS s16x4*)(TN + voff(r32, 16 * s + 8 + 4 * hi));
            m = CK_MFMA(__builtin_bit_cast(bf16x8, aw), ((bf16x8){b0[0], b0[1], b0[2], b0[3], b1[0], b1[1], b1[2], b1[3]}), m);
        }
        f32x16 t21 = f32x16{};
#pragma unroll
        for (int s = 0; s < 2; ++s) t21 = CK_MFMA(fragT(TN, 32 + 16 * s, 1, lane, hi), packR(m, s), t21);
        storeT_V(TN, t21, 1, r32, hi);
    } else if (wave < 4) {
        const int dvb = wave - 2;
        const f32x16 x00 = score(KT, AP, 0, 0, 1, r32, hi), x01 = score(KT, AP, 0, 1, 0, r32, hi), x11 = score(KT, AP, 1, 1, 1, r32, hi);
#pragma unroll
        for (int s = 0; s < 2; ++s) {
            const bf16x8 v0 = fragT(VV, 16 * s, dvb, lane, hi), v1 = fragT(VV, 32 + 16 * s, dvb, lane, hi);
            w1a = CK_MFMA(packR(x00, s), v0, w1a);
            w1b = CK_MFMA(packR(x01, s), v0, w1b);
            w1b = CK_MFMA(packR(x11, s), v1, w1b);
        }
    } else if (wave < 6) {
        const int tb = wave - 4;
        f32x16 xk0, xk1 = f32x16{};
        if (tb == 0) { xk0 = score(KT, RT, 0, 0, 2, r32, hi); xb0 = score(BT, RT, 0, 0, 2, r32, hi); }
        else { xk0 = score(KT, RT, 0, 1, 0, r32, hi); xk1 = score(KT, RT, 1, 1, 2, r32, hi); xb0 = score(BT, RT, 0, 1, 0, r32, hi); xb1 = score(BT, RT, 1, 1, 2, r32, hi); }
#pragma unroll
        for (int s = 0; s < 2; ++s) {
            y0a = CK_MFMA(fragT(VV, 16 * s, 0, lane, hi), packR(xk0, s), y0a);
            y0b = CK_MFMA(fragT(VV, 16 * s, 1, lane, hi), packR(xk0, s), y0b);
            if (tb == 1) { y0a = CK_MFMA(fragT(VV, 32 + 16 * s, 0, lane, hi), packR(xk1, s), y0a); y0b = CK_MFMA(fragT(VV, 32 + 16 * s, 1, lane, hi), packR(xk1, s), y0b); }
        }
    }
    __syncthreads();
    CK_FRESH();
    if (wave < 2) {
        const int cb = wave; f32x16 a0 = f32x16{}, a1 = f32x16{};
#pragma unroll
        for (int ks = 0; ks < 4; ++ks) {
            const bf16x8 af = fragT(AT, 16 * ks, cb, lane, hi);
            if (ks < 2) a0 = CK_MFMA(af, fragT(TN, 16 * ks, 0, lane, hi), a0);
            a1 = CK_MFMA(af, fragT(TN, 16 * ks, 1, lane, hi), a1);
        }
        storeT_V(A2M, a0, cb, r32, hi); storeT_V(A2M, a1, cb, 32 + r32, hi);
    } else if (wave < 4) {
        const int dvb = wave - 2; f32x16 v0 = f32x16{}, v1 = f32x16{};
#pragma unroll
        for (int s = 0; s < 2; ++s) {
            v0 = CK_MFMA(packR(w1a, s), fragT(TN, 16 * s, 0, lane, hi), v0);
            v1 = CK_MFMA(packR(w1a, s), fragT(TN, 16 * s, 1, lane, hi), v1);
            v1 = CK_MFMA(packR(w1b, s), fragT(TN, 32 + 16 * s, 1, lane, hi), v1);
        }
        storeT_V(V2M, v0, dvb, r32, hi); storeT_V(V2M, v1, dvb, 32 + r32, hi);
    }
    __syncthreads();
    CK_FRESH();
    if (wave >= 4 && wave < 6) {
        const int tb = wave - 4, t = tb * 32 + r32;
        f32x16 r0 = f32x16{}, r1 = f32x16{};
#pragma unroll
        for (int s = 0; s < 2; ++s) {
            const bf16x8 p0 = packR(xb0, s);
            r0 = CK_MFMA(fragT(A2M, 16 * s, 0, lane, hi), p0, r0); r1 = CK_MFMA(fragT(A2M, 16 * s, 1, lane, hi), p0, r1);
            y0a = CK_MFMA(fragT(V2M, 16 * s, 0, lane, hi), p0, y0a); y0b = CK_MFMA(fragT(V2M, 16 * s, 1, lane, hi), p0, y0b);
            if (tb == 1) { const bf16x8 p1 = packR(xb1, s);
                r0 = CK_MFMA(fragT(A2M, 32 + 16 * s, 0, lane, hi), p1, r0); r1 = CK_MFMA(fragT(A2M, 32 + 16 * s, 1, lane, hi), p1, r1);
                y0a = CK_MFMA(fragT(V2M, 32 + 16 * s, 0, lane, hi), p1, y0a); y0b = CK_MFMA(fragT(V2M, 32 + 16 * s, 1, lane, hi), p1, y0b); }
        }
#pragma unroll
        for (int q = 0; q < 4; ++q) {
            const u32x2 u0 = *(const LAS u32x2*)(RT + t * PS + (8 * q + 4 * hi) * 2), u1 = *(const LAS u32x2*)(RT + t * PS + (32 + 8 * q + 4 * hi) * 2);
            r0[4 * q] += bflo(u0.x); r0[4 * q + 1] += bfhi(u0.x); r0[4 * q + 2] += bflo(u0.y); r0[4 * q + 3] += bfhi(u0.y);
            r1[4 * q] += bflo(u1.x); r1[4 * q + 1] += bfhi(u1.x); r1[4 * q + 2] += bflo(u1.y); r1[4 * q + 3] += bfhi(u1.y);
        }
        storeT_S(BT, r0, 0, t, hi); storeT_S(BT, r1, 1, t, hi);
        storeT_S(KT, y0a, 0, t, hi); storeT_S(KT, y0b, 1, t, hi);
    } else if (wave < 2) {
        const int ib = wave, i = ib * 32 + r32; const float gci = GC[i];
        f32x16 g0 = f32x16{}, g1 = f32x16{};
#pragma unroll
        for (int ks = 0; ks < 4; ++ks) { const bf16x8 bf_ = fragT(BH, 16 * ks, ib, lane, hi);
            g0 = CK_MFMA(fragT(A2M, 16 * ks, 0, lane, hi), bf_, g0); g1 = CK_MFMA(fragT(A2M, 16 * ks, 1, lane, hi), bf_, g1); }
#pragma unroll
        for (int r = 0; r < 16; ++r) { if (crow(r, hi) == i) g0[r] += gci; if (32 + crow(r, hi) == i) g1[r] += gci; }
        storeT_S(AP, g0, 0, i, hi); storeT_S(AP, g1, 1, i, hi);
    } else {
        const int id = wave < 4 ? wave - 2 : wave - 4, ib = id >> 1, dvb = id & 1;
        f32x16 hh = f32x16{};
#pragma unroll
        for (int ks = 0; ks < 4; ++ks) {
            hh = CK_MFMA(fragT(BH, 16 * ks, ib, lane, hi), fragT(V2M, 16 * ks, dvb, lane, hi), hh);
            hh = CK_MFMA(fragT(KH, 16 * ks, ib, lane, hi), fragT(VV, 16 * ks, dvb, lane, hi), hh);
        }
        storeT_S((LAS unsigned char*)L, hh, ib, dvb * 32 + r32, hi);
    }
    __syncthreads();
    {
        asm volatile("" : "+v"(tid));
        const int row = tid >> 3, ch = tid & 7;
        const LAS unsigned char* s0 = BT + row * PS + ch * 16; const LAS unsigned char* s1 = KT + row * PS + ch * 16; const LAS unsigned char* s2 = AP + row * PS + ch * 16; const LAS unsigned char* s3 = (const LAS unsigned char*)L + row * PS + ch * 16;
        const u32x2 a0 = *(const LAS u32x2*)s0, a1 = *(const LAS u32x2*)(s0 + 8), b0 = *(const LAS u32x2*)s1, b1 = *(const LAS u32x2*)(s1 + 8);
        const u32x2 c0 = *(const LAS u32x2*)s2, c1 = *(const LAS u32x2*)(s2 + 8), d0 = *(const LAS u32x2*)s3, d1 = *(const LAS u32x2*)(s3 + 8);
        *(u32x4*)(CR2 + row * 64 + ch * 8) = (u32x4){a0.x, a0.y, a1.x, a1.y}; *(u32x4*)(CY0 + row * 64 + ch * 8) = (u32x4){b0.x, b0.y, b1.x, b1.y};
        *(u32x4*)(CG + row * 64 + ch * 8) = (u32x4){c0.x, c0.y, c1.x, c1.y}; *(u32x4*)(CH + row * 64 + ch * 8) = (u32x4){d0.x, d0.y, d1.x, d1.y};
    }
    asm volatile("s_waitcnt lgkmcnt(0)" ::: "memory"); __builtin_amdgcn_s_barrier();
#undef CK_FRESH
#undef w1a
#undef w1b
#undef xb0
#undef xb1
#undef y0a
#undef y0b
}

__device__ __forceinline__ void fused_item(LAS unsigned char* lds, const Args& a, int bc) {
    const int tid = threadIdx.x, lane = tid & 63; const int wave = __builtin_amdgcn_readfirstlane(tid >> 6);
    unsigned char* ws = a.ws;
    const bf16_t* P = (const bf16_t*)(ws + WS_P); const bf16_t* LW = (const bf16_t*)(ws + WS_LW); const float* mu = a.in[3];
    const int b = bc >> 6, c = bc & 63, tokc = b * SEQ + c * 64;
    LAS unsigned char* ACT = lds + O_ACT; LAS unsigned char* DECb = lds + O_TN; LAS unsigned char* ALRb = lds + O_A2; LAS unsigned char* GGb = lds + O_V2;
    {
        LAS float* PT = (LAS float*)(lds + O_PT);
        for (int i = tid; i < 3200; i += 512) {
            const float v = i < 1536 ? mu[i] : (i < 2048 ? a.in[9][i - 1536] : (i < 2560 ? a.in[10][i - 2048] : (i < 3072 ? a.in[11][i - 2560] : (i < 3136 ? a.in[14][i - 3072] : a.in[15][i - 3136]))));
            PT[i] = v; }
    }
    {
        u32x4 cu_[3], pu_[3]; f32x4 m0_[3], m1_[3];
#pragma unroll
        for (int j = 0; j < 3; ++j) {
            const int it = tid + 512 * j; cu_[j] = (u32x4){0u, 0u, 0u, 0u}; pu_[j] = (u32x4){0u, 0u, 0u, 0u}; m0_[j] = (f32x4){0.f, 0.f, 0.f, 0.f}; m1_[j] = m0_[j];
            if (it < 1280) {
                const int tok = it / 20, ch = it - tok * 20, t = tokc + tok, col = 1536 + ch * 8;
                cu_[j] = *(const u32x4*)(P + (size_t)t * NINP + col);
                if (t & (SEQ - 1)) pu_[j] = *(const u32x4*)(P + (size_t)(t - 1) * NINP + col);
                m0_[j] = *(const f32x4*)(mu + col); m1_[j] = *(const f32x4*)(mu + col + 4); }
        }
        __builtin_amdgcn_sched_barrier(0);
#pragma unroll
        for (int j = 0; j < 3; ++j) {
            const int it = tid + 512 * j;
            if (it < 1280) {
                const int tok = it / 20, ch = it - tok * 20;
                const f32x4 c0 = cvlo(cu_[j]), c1 = cvhi(cu_[j]), p0 = cvlo(pu_[j]), p1 = cvhi(pu_[j]);
                f32x4 s0 = c0 + (p0 - c0) * m0_[j], s1 = c1 + (p1 - c1) * m1_[j];
                if (ch < 4) {
#pragma unroll
                    for (int i = 0; i < 4; ++i) { const float e0 = __expf(-2.0f * fabsf(s0[i])), e1 = __expf(-2.0f * fabsf(s1[i])); const float th0 = (1.0f - e0) / (1.0f + e0), th1 = (1.0f - e1) / (1.0f + e1);
                        s0[i] = s0[i] < 0.f ? -th0 : th0; s1[i] = s1[i] < 0.f ? -th1 : th1; }
                } else if (ch >= 8) {
#pragma unroll
                    for (int i = 0; i < 4; ++i) { s0[i] = sigmoidf_(s0[i]); s1[i] = sigmoidf_(s1[i]); }
                }
                *(LAS u32x4*)(ACT + tok * 320 + ch * 16) = pk8(s0, s1);
            }
        }
    }
    __syncthreads();
#pragma clang loop unroll(disable)
    for (int h = 0; h < 8; ++h) {
        {
            int ln = lane; asm volatile("" : "+v"(ln));
            const int mt = wave >> 1, fcol = ln & 15, fq = ln >> 4;
            bf16x8 wf[2][5]; float w0c[2], a0c[2];
#pragma unroll
            for (int cbi = 0; cbi < 2; ++cbi) { const int col = h * 64 + ((wave & 1) * 2 + cbi) * 16 + fcol; const bf16_t* lw = LW + (size_t)col * 160 + fq * 8;
#pragma unroll
                for (int kb = 0; kb < 5; ++kb) wf[cbi][kb] = *(const bf16x8*)(lw + 32 * kb);
                w0c[cbi] = a.in[4][col]; a0c[cbi] = a.in[6][col]; }
            bf16x8 af[5];
#pragma unroll
            for (int kb = 0; kb < 5; ++kb) af[kb] = *(const LAS bf16x8*)(ACT + (mt * 16 + fcol) * 320 + kb * 64 + fq * 16);
            __builtin_amdgcn_sched_barrier(0);
#pragma unroll
            for (int cbi = 0; cbi < 2; ++cbi) {
                const int cb = (wave & 1) * 2 + cbi;
                const f32x4 z = {0.f, 0.f, 0.f, 0.f};
                const f32x4 aw = __builtin_amdgcn_mfma_f32_16x16x32_bf16(af[0], wf[cbi][0], z, 0, 0, 0);
                const f32x4 aa = __builtin_amdgcn_mfma_f32_16x16x32_bf16(af[1], wf[cbi][1], z, 0, 0, 0);
                f32x4 ag = __builtin_amdgcn_mfma_f32_16x16x32_bf16(af[2], wf[cbi][2], z, 0, 0, 0);
                ag = __builtin_amdgcn_mfma_f32_16x16x32_bf16(af[3], wf[cbi][3], ag, 0, 0, 0);
                ag = __builtin_amdgcn_mfma_f32_16x16x32_bf16(af[4], wf[cbi][4], ag, 0, 0, 0);
#pragma unroll
                for (int i = 0; i < 4; ++i) { const int off = (mt * 16 + fq * 4 + i) * 128 + (cb * 16 + fcol) * 2;
                    *(LAS unsigned short*)(DECb + off) = (unsigned short)f2bf(-0.8750325887f * sigmoidf_(aw[i] + w0c[cbi]));
                    *(LAS unsigned short*)(ALRb + off) = (unsigned short)f2bf(sigmoidf_(aa[i] + a0c[cbi]));
                    *(LAS unsigned short*)(GGb + off) = (unsigned short)f2bf(ag[i]); }
            }
        }
        __syncthreads();
        chunk_item(lds, a, ((b * 8 + h) << 6) + c);
    }
}
}

namespace ck {
constexpr int SQ_MAT = 8704, SQ_BUF = 6 * SQ_MAT;
constexpr int SQ_OUT = 2 * SQ_BUF;
__device__ __forceinline__ bf16x8 lfrag(const LAS unsigned char* M, int row, int k0, int hi) { return fragP(M, row, k0, hi); }
__device__ __forceinline__ void linit(f32x16& x, const LAS unsigned char* M, int row, int cblk, int hi) {
#pragma unroll
    for (int q = 0; q < 4; ++q) { const u32x2 u = *(const LAS u32x2*)(M + row * PS + (cblk * 32 + 8 * q + 4 * hi) * 2); x[4 * q] = bflo(u.x); x[4 * q + 1] = bfhi(u.x); x[4 * q + 2] = bflo(u.y); x[4 * q + 3] = bfhi(u.y); }
}
__device__ __forceinline__ void seq_head(LAS unsigned char* lds, const Args& a, int bh) {
    const int tid = threadIdx.x, lane = tid & 63, r32 = lane & 31, hi = lane >> 5; const int wave = __builtin_amdgcn_readfirstlane(tid >> 6);
    unsigned char* ws = a.ws;
    const bf16_t* SV = (const bf16_t*)(ws + WS_SV); const bf16_t* SG = (const bf16_t*)(ws + WS_SG); const float* RK = (const float*)(ws + WS_RK); bf16_t* YMIX = (bf16_t*)(ws + WS_YMIX);
    const int b = bh >> 3, h = bh & 7, col0 = h * 64;
    const float* lng = a.in[12] + col0; const float* lnb = a.in[13] + col0;
    const int lw = wave - 2;
    const bf16_t* lsrc; int lpitch;
    { const size_t it0 = (size_t)bh * 64 * 4096; const size_t tk0 = (size_t)b * SEQ * CW + col0;
      lsrc = lw == 0 ? (const bf16_t*)(ws + WS_CG) + it0 : lw == 1 ? (const bf16_t*)(ws + WS_CH) + it0 : lw == 2 ? (const bf16_t*)(ws + WS_CR2) + it0 : lw == 3 ? (const bf16_t*)(ws + WS_CY0) + it0 : lw == 4 ? SV + tk0 : SG + tk0;
      lpitch = lw < 4 ? 64 : CW; }
#define SQ_LOAD(ch) do { const bf16_t* s_ = lsrc + (size_t)(ch) * 64 * lpitch; LAS unsigned char* bb_ = lds + ((ch) & 1) * SQ_BUF + lw * SQ_MAT; u32x4 v_[8]; \
        _Pragma("unroll") for (int i_ = 0; i_ < 8; ++i_) { const int q_ = lane + 64 * i_; v_[i_] = *(const u32x4*)(s_ + (size_t)(q_ >> 3) * lpitch + (q_ & 7) * 8); } \
        _Pragma("unroll") for (int i_ = 0; i_ < 8; ++i_) { const int q_ = lane + 64 * i_; LAS unsigned char* d_ = bb_ + (q_ >> 3) * PS + (q_ & 7) * 16; *(LAS u32x2*)d_ = (u32x2){v_[i_].x, v_[i_].y}; *(LAS u32x2*)(d_ + 8) = (u32x2){v_[i_].z, v_[i_].w}; } } while (0)
#define SQ_STORE(ch) do { const LAS unsigned char* ob_ = lds + SQ_OUT + ((ch) & 1) * SQ_MAT; const size_t t0_ = (size_t)b * SEQ + (ch) * 64; \
        for (int p_ = tid - 128; p_ < 512; p_ += 384) { const int row_ = p_ >> 3, c8_ = (p_ & 7) * 8; const LAS unsigned char* s_ = ob_ + row_ * PS + c8_ * 2; \
            const u32x2 lo_ = *(const LAS u32x2*)s_, hi_ = *(const LAS u32x2*)(s_ + 8); *(u32x4*)(YMIX + (t0_ + row_) * D + col0 + c8_) = (u32x4){lo_.x, lo_.y, hi_.x, hi_.y}; } } while (0)
    if (wave >= 2) SQ_LOAD(0);
    __syncthreads();
    f32x16 X00 = f32x16{}, X01 = f32x16{}, X10 = f32x16{}, X11 = f32x16{};
#pragma unroll 1
    for (int c = 0; c < 64; ++c) {
        if (wave >= 2) {
            if (c + 1 < 64) SQ_LOAD(c + 1);
            if (c > 0) SQ_STORE(c - 1);
        } else {
            const int tb = wave;
            const LAS unsigned char* bb = lds + (c & 1) * SQ_BUF;
            const LAS unsigned char* MG = bb; const LAS unsigned char* MH = bb + SQ_MAT; const LAS unsigned char* MR = bb + 2 * SQ_MAT; const LAS unsigned char* MY = bb + 3 * SQ_MAT;
            const LAS unsigned char* MV = bb + 4 * SQ_MAT; const LAS unsigned char* MGT = bb + 5 * SQ_MAT;
            LAS unsigned char* OB = lds + SQ_OUT + (c & 1) * SQ_MAT;
            const int tl = tb * 32 + r32; const size_t t = (size_t)b * SEQ + c * 64 + tl;
            const float rk = RK[t * 8 + h];
            f32x16 y0, y1; linit(y0, MY, tl, 0, hi); linit(y1, MY, tl, 1, hi);
#pragma unroll
            for (int s = 0; s < 2; ++s) {
                const bf16x8 rf0 = lfrag(MR, tl, 16 * s, hi), rf1 = lfrag(MR, tl, 32 + 16 * s, hi);
                y0 = CK_MFMA(packR(X00, s), rf0, y0); y0 = CK_MFMA(packR(X10, s), rf1, y0);
                y1 = CK_MFMA(packR(X01, s), rf0, y1); y1 = CK_MFMA(packR(X11, s), rf1, y1);
            }
#pragma unroll
            for (int db = 0; db < 2; ++db) {
                f32x16 Na, Nb; linit(Na, MH, db * 32 + r32, 0, hi); linit(Nb, MH, db * 32 + r32, 1, hi);
#pragma unroll
                for (int s = 0; s < 2; ++s) {
                    const bf16x8 g00 = lfrag(MG, r32, 16 * s, hi), g01 = lfrag(MG, r32, 32 + 16 * s, hi), g10 = lfrag(MG, 32 + r32, 16 * s, hi), g11 = lfrag(MG, 32 + r32, 32 + 16 * s, hi);
                    const bf16x8 p0 = packR(db ? X01 : X00, s), p1 = packR(db ? X11 : X10, s);
                    Na = CK_MFMA(g00, p0, Na); Na = CK_MFMA(g01, p1, Na);
                    Nb = CK_MFMA(g10, p0, Nb); Nb = CK_MFMA(g11, p1, Nb);
                }
                if (db == 0) { X00 = Na; X10 = Nb; } else { X01 = Na; X11 = Nb; }
            }
            float sm = 0.f;
#pragma unroll
            for (int r = 0; r < 16; ++r) sm += y0[r] + y1[r];
            sm += __shfl_xor(sm, 32);
            const float mean = sm * (1.0f / 64.0f);
            float sq = 0.f;
#pragma unroll
            for (int r = 0; r < 16; ++r) { const float d0 = y0[r] - mean, d1 = y1[r] - mean; sq += d0 * d0 + d1 * d1; }
            sq += __shfl_xor(sq, 32);
            const float rs = 1.0f / sqrtf(sq * (1.0f / 64.0f) + 64e-5f);
#pragma unroll
            for (int db = 0; db < 2; ++db)
#pragma unroll
                for (int q = 0; q < 4; ++q) {
                    const int dv = db * 32 + 8 * q + 4 * hi;
                    const f32x4 lg = *(const f32x4*)(lng + dv), lb = *(const f32x4*)(lnb + dv);
                    const u32x2 uv = *(const LAS u32x2*)(MV + tl * PS + dv * 2), ug = *(const LAS u32x2*)(MGT + tl * PS + dv * 2);
                    const f32x4 vv = {bflo(uv.x), bfhi(uv.x), bflo(uv.y), bfhi(uv.y)}, gg = {bflo(ug.x), bfhi(ug.x), bflo(ug.y), bfhi(ug.y)};
                    f32x4 yy; if (db == 0) yy = (f32x4){y0[4 * q], y0[4 * q + 1], y0[4 * q + 2], y0[4 * q + 3]}; else yy = (f32x4){y1[4 * q], y1[4 * q + 1], y1[4 * q + 2], y1[4 * q + 3]};
                    const f32x4 o = ((yy - mean) * rs * lg + lb + rk * vv) * gg;
                    u32x2 w; w.x = pk2(o.x, o.y); w.y = pk2(o.z, o.w);
                    *(LAS u32x2*)(OB + tl * PS + dv * 2) = w;
                }
        }
        __syncthreads();
    }
    if (wave >= 2) SQ_STORE(63);
#undef SQ_LOAD
#undef SQ_STORE
}
}

namespace att {
constexpr int SLOT = 32768, OFF_V = 16384;
constexpr int TBL_OFF = MISC_OFF + 1024;
constexpr int LW_OFF = MISC_OFF + 2048;
constexpr int CST_OFF = MISC_OFF + 3072;
__device__ __forceinline__ int crow(int r, int hi) { return (r & 3) + 8 * (r >> 2) + 4 * hi; }
__device__ __forceinline__ void glds16(const void* gsrc, unsigned lds_dst) { unsigned keep;
    asm volatile("s_mov_b32 %0, m0\n\ts_mov_b32 m0, %2\n\ts_nop 0\n\tglobal_load_lds_dwordx4 %1, off\n\ts_mov_b32 m0, %0" : "=&s"(keep) : "v"(gsrc), "s"(lds_dst) : "memory"); }
__device__ __forceinline__ s16x4 vtr(const LAS unsigned char* p) { return __builtin_bit_cast(s16x4, __builtin_amdgcn_ds_read_tr16_b64_v4i16((LAS s16x4*)p)); }

__device__ __forceinline__ void attn_unit(LAS unsigned char* lds, const Args& a, int b, int h, int qb, float negM, float lam) {
    const int tid = threadIdx.x, lane = tid & 63, r32 = lane & 31, hi = lane >> 5; const int wid = __builtin_amdgcn_readfirstlane(tid >> 6);
    const int c = wid >> 2, rg = wid & 3;
    unsigned char* ws = a.ws;
    const bf16_t* QN = (const bf16_t*)(ws + WS_QN); const bf16_t* KN = (const bf16_t*)(ws + WS_KN); const bf16_t* P = (const bf16_t*)(ws + WS_P); bf16_t* YMIX = (bf16_t*)(ws + WS_YMIX);
    const int q0 = qb * 128; const size_t rowbase = (size_t)b * SEQ;
    const int NT = 2 * qb + 2;
    LAS float* tbl = (LAS float*)(lds + TBL_OFF); LAS float* lw = (LAS float*)(lds + LW_OFF) + wid * 32;
    if (tid < 128) {
        const int n = tid; int bkt;
        if (n < 16) bkt = n; else { bkt = 16 + (int)(logf((float)n * (1.0f / 16.0f)) / 2.0794415416798357f * 16.0f); bkt = bkt > 31 ? 31 : bkt; }
        tbl[n] = (a.in[21][bkt * 4 + h] - a.in[21][31 * 4 + h]) * LOG2E;
    }
    const bf16_t* Qw = QN + (rowbase + q0 + rg * 32 + r32) * CW + h * 128 + c * 64;
    bf16x8 qr[4];
#pragma unroll
    for (int d0 = 0; d0 < 4; ++d0) qr[d0] = *(const bf16x8*)(Qw + d0 * 16 + hi * 8);
    const bf16_t* k0src = KN + ((((size_t)(b * 8 + h * 2) * 64) * 8 + wid) * 64 + lane) * 8;
    const bf16_t* k1src = k0src + (size_t)64 * 8 * 64 * 8;
    const int pv0 = 2 * wid, pv1 = 2 * wid + 1;
    const bf16_t* VTb = (const bf16_t*)(ws + WS_VT) + (size_t)(b * 4 + h) * 64 * 8192;
    const bf16_t* v0src = VTb + pv0 * 512 + lane * 8;
    const bf16_t* v1src = VTb + pv1 * 512 + lane * 8;
#define ATT_DMA(t, slot) do { const unsigned s_ = lds0 + (unsigned)(slot) * SLOT; \
        glds16(k0src + (size_t)(t) * 4096, (unsigned)__builtin_amdgcn_readfirstlane(s_ + wid * 1024)); \
        glds16(k1src + (size_t)(t) * 4096, (unsigned)__builtin_amdgcn_readfirstlane(s_ + 8192 + wid * 1024)); \
        glds16(v0src + (size_t)(t) * 8192, (unsigned)__builtin_amdgcn_readfirstlane(s_ + OFF_V + pv0 * 1024)); \
        glds16(v1src + (size_t)(t) * 8192, (unsigned)__builtin_amdgcn_readfirstlane(s_ + OFF_V + pv1 * 1024)); } while (0)
#define ATT_SBAR() __builtin_amdgcn_sched_barrier(0)
    const unsigned lds0 = (unsigned)(uintptr_t)lds;
    f32x16 o[4];
#pragma unroll
    for (int d0 = 0; d0 < 4; ++d0) o[d0] = f32x16{};
    float lsum = 0.f;
    const bool shift = negM < -60.0f;
    const int qmin = q0 + 32 * rg, qpos = qmin + r32;
    ATT_DMA(0, 0);
    asm volatile("s_waitcnt vmcnt(0)" ::: "memory");
    __syncthreads();
    for (int t = 0; t < NT; ++t) {
        if (t + 1 < NT) ATT_DMA(t + 1, (t + 1) & 1);
        const int kmin = 64 * t;
        if (kmin <= qmin + 31) {
            const LAS unsigned char* slot = lds + (t & 1) * SLOT;
            const LAS unsigned char* kb = slot + c * 8192 + hi * 1024 + r32 * 16;
            const LAS unsigned char* vb = slot + OFF_V + ((lane >> 4) & 1) * 32 + (lane & 3) * 8 + (4 * hi + ((lane & 15) >> 2)) * 64;
            bf16x8 kf[8];
#pragma unroll
            for (int d0 = 0; d0 < 4; ++d0) { kf[2 * d0] = *(const LAS bf16x8*)(kb + d0 * 2048); kf[2 * d0 + 1] = *(const LAS bf16x8*)(kb + d0 * 2048 + 512); }
            ATT_SBAR();
            f32x16 p0, p1;
            p0 = __builtin_amdgcn_mfma_f32_32x32x16_bf16(kf[0], qr[0], f32x16{}, 0, 0, 0); p1 = __builtin_amdgcn_mfma_f32_32x32x16_bf16(kf[1], qr[0], f32x16{}, 0, 0, 0);
#pragma unroll
            for (int d0 = 1; d0 < 4; ++d0) { p0 = __builtin_amdgcn_mfma_f32_32x32x16_bf16(kf[2 * d0], qr[d0], p0, 0, 0, 0); p1 = __builtin_amdgcn_mfma_f32_32x32x16_bf16(kf[2 * d0 + 1], qr[d0], p1, 0, 0, 0); }
            ATT_SBAR();
            s16x4 vv[2][8];
#define ATT_LDV(ks) do { _Pragma("unroll") for (int dvb_ = 0; dvb_ < 4; ++dvb_) { vv[(ks) & 1][2 * dvb_] = vtr(vb + dvb_ * 4096 + (ks) * 1024); vv[(ks) & 1][2 * dvb_ + 1] = vtr(vb + dvb_ * 4096 + (ks) * 1024 + 512); } } while (0)
            ATT_LDV(0); ATT_LDV(1);
            ATT_SBAR();
            if (qmin - (kmin + 63) < 113) {
#pragma unroll
                for (int r = 0; r < 16; ++r) {
                    const int d0_ = qpos - (kmin + crow(r, hi)); const int d1_ = d0_ - 32;
                    const float t0 = tbl[d0_ < 0 ? 0 : (d0_ > 127 ? 127 : d0_)], t1 = tbl[d1_ < 0 ? 0 : (d1_ > 127 ? 127 : d1_)];
                    p0[r] = d0_ < 0 ? -INFINITY : p0[r] + t0; p1[r] = d1_ < 0 ? -INFINITY : p1[r] + t1;
                }
            }
            if (shift) {
#pragma unroll
                for (int r = 0; r < 16; ++r) { p0[r] += negM; p1[r] += negM; }
            }
            float sacc = 0.f;
#pragma unroll
            for (int j = 0; j < 8; ++j) { p0[j] = __builtin_amdgcn_exp2f(p0[j]); sacc += p0[j]; }
#pragma unroll
            for (int ks = 0; ks < 4; ++ks) {
                u32x4 pwk;
                if (ks == 0) { pwk.x = pk2(p0[0], p0[1]); pwk.y = pk2(p0[2], p0[3]); pwk.z = pk2(p0[4], p0[5]); pwk.w = pk2(p0[6], p0[7]); }
                else if (ks == 1) { pwk.x = pk2(p0[8], p0[9]); pwk.y = pk2(p0[10], p0[11]); pwk.z = pk2(p0[12], p0[13]); pwk.w = pk2(p0[14], p0[15]); }
                else if (ks == 2) { pwk.x = pk2(p1[0], p1[1]); pwk.y = pk2(p1[2], p1[3]); pwk.z = pk2(p1[4], p1[5]); pwk.w = pk2(p1[6], p1[7]); }
                else { pwk.x = pk2(p1[8], p1[9]); pwk.y = pk2(p1[10], p1[11]); pwk.z = pk2(p1[12], p1[13]); pwk.w = pk2(p1[14], p1[15]); }
#pragma unroll
                for (int dvb = 0; dvb < 4; ++dvb) {
                    const bf16x8 vf = (bf16x8){vv[ks & 1][2 * dvb][0], vv[ks & 1][2 * dvb][1], vv[ks & 1][2 * dvb][2], vv[ks & 1][2 * dvb][3], vv[ks & 1][2 * dvb + 1][0], vv[ks & 1][2 * dvb + 1][1], vv[ks & 1][2 * dvb + 1][2], vv[ks & 1][2 * dvb + 1][3]};
                    ATT_SBAR();
                    o[dvb] = __builtin_amdgcn_mfma_f32_32x32x16_bf16(__builtin_bit_cast(bf16x8, pwk), vf, o[dvb], 0, 0, 0);
                    if (ks == 0) { p0[8 + 2 * dvb] = __builtin_amdgcn_exp2f(p0[8 + 2 * dvb]); p0[9 + 2 * dvb] = __builtin_amdgcn_exp2f(p0[9 + 2 * dvb]); sacc += p0[8 + 2 * dvb] + p0[9 + 2 * dvb]; }
                    else if (ks == 1) { p1[2 * dvb] = __builtin_amdgcn_exp2f(p1[2 * dvb]); p1[2 * dvb + 1] = __builtin_amdgcn_exp2f(p1[2 * dvb + 1]); sacc += p1[2 * dvb] + p1[2 * dvb + 1]; }
                    else if (ks == 2) { p1[8 + 2 * dvb] = __builtin_amdgcn_exp2f(p1[8 + 2 * dvb]); p1[9 + 2 * dvb] = __builtin_amdgcn_exp2f(p1[9 + 2 * dvb]); sacc += p1[8 + 2 * dvb] + p1[9 + 2 * dvb]; }
                }
                ATT_SBAR();
                if (ks < 2) ATT_LDV(ks + 2);
            }
#undef ATT_LDV
            lsum += sacc;
        }
        asm volatile("s_waitcnt vmcnt(0)" ::: "memory");
        __syncthreads();
    }
#undef ATT_DMA
#undef ATT_SBAR
    lsum += __shfl_xor(lsum, 32);
    if (hi == 0) lw[r32] = 1.0f / lsum;
    asm volatile("s_waitcnt lgkmcnt(0)" ::: "memory");
    LAS float* stg = (LAS float*)(lds + wid * 16384);
#pragma unroll
    for (int r = 0; r < 16; ++r) { const int orow = crow(r, hi); const float il = lw[orow];
#pragma unroll
        for (int d0 = 0; d0 < 4; ++d0) stg[orow * 128 + d0 * 32 + r32] = o[d0][r] * il; }
    __syncthreads();
    {
        const int row = tid >> 2, part = tid & 3, rgp = row >> 5, rr = row & 31;
        const LAS float* s1 = (const LAS float*)(lds + rgp * 16384) + rr * 128 + part * 32;
        const LAS float* s2 = (const LAS float*)(lds + (4 + rgp) * 16384) + rr * 128 + part * 32;
        float dv[32]; float ss = 0.f;
#pragma unroll
        for (int i = 0; i < 8; ++i) { const f32x4 x1 = *(const LAS f32x4*)(s1 + 4 * i), x2 = *(const LAS f32x4*)(s2 + 4 * i);
#pragma unroll
            for (int j = 0; j < 4; ++j) { const float dd = x1[j] - lam * x2[j]; dv[4 * i + j] = dd; ss += dd * dd; } }
        ss = red4(ss);
        const float sc = (1.0f / sqrtf(ss * (1.0f / 128.0f) + 1e-5f)) * 0.8f;
        const float* sg = a.in[20] + part * 32;
        bf16_t* op = YMIX + (rowbase + q0 + row) * D + CW + h * 128 + part * 32;
#pragma unroll
        for (int i = 0; i < 4; ++i) { u32x4 w;
            w.x = pk2(dv[8 * i] * sc * sg[8 * i], dv[8 * i + 1] * sc * sg[8 * i + 1]); w.y = pk2(dv[8 * i + 2] * sc * sg[8 * i + 2], dv[8 * i + 3] * sc * sg[8 * i + 3]);
            w.z = pk2(dv[8 * i + 4] * sc * sg[8 * i + 4], dv[8 * i + 5] * sc * sg[8 * i + 5]); w.w = pk2(dv[8 * i + 6] * sc * sg[8 * i + 6], dv[8 * i + 7] * sc * sg[8 * i + 7]);
            *(u32x4*)(op + 8 * i) = w; }
    }
    __syncthreads();
}

__device__ __forceinline__ void attn_phase(LAS unsigned char* lds, const Args& a, unsigned* ctl) {
    const int tid = threadIdx.x;
    LAS float* cst = (LAS float*)(lds + CST_OFF);
    if (tid < 64) {
        const float gq = fabsf(a.in[14][tid]), gk = fabsf(a.in[15][tid]);
        float mq = gq, mk = gk;
#pragma unroll
        for (int o = 1; o < 64; o <<= 1) { mq = fmaxf(mq, __shfl_xor(mq, o)); mk = fmaxf(mk, __shfl_xor(mk, o)); }
        const float d1 = wave_sum(a.in[16][tid] * a.in[17][tid]), d2 = wave_sum(a.in[18][tid] * a.in[19][tid]);
        float mb = 0.f;
        if (tid < 32) { for (int hh = 0; hh < 4; ++hh) mb = fmaxf(mb, (a.in[21][tid * 4 + hh] - a.in[21][31 * 4 + hh]) * LOG2E); }
#pragma unroll
        for (int o = 1; o < 64; o <<= 1) mb = fmaxf(mb, __shfl_xor(mb, o));
        if (tid == 0) { cst[0] = -(8.0f * LOG2E * mq * mk * 1.02f + mb); cst[1] = __expf(d1) - __expf(d2) + 0.2f; }
    }
    __syncthreads();
    const float negM = cst[0], lam = cst[1];
    LAS int* ubox = (LAS int*)(lds + CST_OFF + 16);
    for (;;) {
        if (tid == 0) ubox[0] = (int)atomicAdd(ctl + CW_ATTQ, 1u);
        __syncthreads();
        const int u = __builtin_amdgcn_readfirstlane(ubox[0]);
        __syncthreads();
        if (u >= 1024 + CONV_ITEMS) break;
        const int qd = u / 5, rm = u - qd * 5;
        if (rm < 3) { conv_item(lds, a, qd * 3 + rm); continue; }
        const int au = qd * 2 + (rm - 3);
        const int qb = 31 - (au >> 5), bhh = au & 31;
        attn_unit(lds, a, bhh >> 2, bhh & 3, qb, negM, lam);
    }
}
}

__device__ __forceinline__ void p5_router(LAS unsigned char* lds, const Args& a, unsigned* ctl) {
    const int tid = threadIdx.x, lane = tid & 63, r32 = lane & 31, hi = lane >> 5; const int wave = __builtin_amdgcn_readfirstlane(tid >> 6);
    unsigned char* ws = a.ws;
    const bf16_t* x1 = (const bf16_t*)(ws + WS_X1B); const float* g2 = a.in[23]; const float* rw = a.in[24]; const float* rb = a.in[25];
    unsigned char* H2 = ws + WS_H2; int* EIDX = (int*)(ws + WS_EIDX); float* GATE = (float*)(ws + WS_GATE); int* POS = (int*)(ws + WS_POS);
    LAS unsigned char* WH = lds; LAS unsigned char* WL = lds + 65536;
    LAS int* cnt = (LAS int*)(lds + MISC_OFF + 1024);
    LAS int* basel = (LAS int*)(lds + MISC_OFF + 1024 + 128);
    LAS int* el = (LAS int*)(lds + MISC_OFF + 2048);
    LAS int* pl = (LAS int*)(lds + MISC_OFF + 4096);
    {
        const int e = tid & 31;
        for (int k = tid >> 5; k < 1024; k += 16) {
            const float v = rw[k * 32 + e] * g2[k]; const unsigned h = f2bf(v); const float vh = __builtin_bit_cast(float, h << 16); const unsigned l = f2bf(v - vh);
            const int off = e * 2048 + (((k >> 3) ^ (e & 15)) << 4) + (k & 7) * 2;
            *(LAS unsigned short*)(WH + off) = (unsigned short)h; *(LAS unsigned short*)(WL + off) = (unsigned short)l;
        }
    }
    if (tid < 32) cnt[tid] = 0;
    __syncthreads();
    const int TPB = T / (int)gridDim.x, tb0 = blockIdx.x * TPB;
    if (wave < 4) {
        const int tl = wave * 32 + r32, t = tb0 + tl;
        const bf16_t* xrow = x1 + (size_t)t * D + 8 * hi;
        const LAS unsigned char* wh = WH + r32 * 2048; const LAS unsigned char* wl = WL + r32 * 2048; const int sw = r32 & 15;
        f32x16 d = f32x16{}; float ssq = 0.f;
#pragma unroll 8
        for (int s = 0; s < 64; ++s) {
            const u32x4 xb = *(const u32x4*)(xrow + 16 * s);
            const int co = ((2 * s + hi) ^ sw) << 4;
            const bf16x8 ah = *(const LAS bf16x8*)(wh + co), al = *(const LAS bf16x8*)(wl + co);
            const bf16x8 bx = __builtin_bit_cast(bf16x8, xb);
            d = __builtin_amdgcn_mfma_f32_32x32x16_bf16(ah, bx, d, 0, 0, 0);
            d = __builtin_amdgcn_mfma_f32_32x32x16_bf16(al, bx, d, 0, 0, 0);
            const f32x4 x0 = cvlo(xb), x1v = cvhi(xb);
            ssq += (x0.x * x0.x + x0.y * x0.y) + (x0.z * x0.z + x0.w * x0.w) + (x1v.x * x1v.x + x1v.y * x1v.y) + (x1v.z * x1v.z + x1v.w * x1v.w);
        }
        ssq += __shfl_xor(ssq, 32);
        const float rstd = 1.0f / sqrtf(ssq * (1.0f / D) + 1e-5f);
        float lg[16];
#pragma unroll
        for (int r = 0; r < 16; ++r) lg[r] = d[r] * rstd + rb[8 * (r >> 2) + 4 * hi + (r & 3)];
        float tv[4]; int ti[4];
#pragma unroll
        for (int k = 0; k < 4; ++k) {
            float bv = -INFINITY; int bi = 0;
#pragma unroll
            for (int r = 0; r < 16; ++r) { const int e = 8 * (r >> 2) + 4 * hi + (r & 3); if (lg[r] > bv) { bv = lg[r]; bi = e; } }
            tv[k] = bv; ti[k] = bi;
#pragma unroll
            for (int r = 0; r < 16; ++r) { const int e = 8 * (r >> 2) + 4 * hi + (r & 3); if (e == bi) lg[r] = -INFINITY; }
        }
        float ov[4]; int oi[4];
#pragma unroll
        for (int k = 0; k < 4; ++k) { ov[k] = __shfl_xor(tv[k], 32); oi[k] = __shfl_xor(ti[k], 32); }
        float mv[4]; int mi[4];
        {
            int pa = 0, pb = 0;
#pragma unroll
            for (int k = 0; k < 4; ++k) {
                float ca = -INFINITY, cb = -INFINITY; int ia = 0, ib = 0;
#pragma unroll
                for (int q = 0; q < 4; ++q) { if (q == pa) { ca = tv[q]; ia = ti[q]; } if (q == pb) { cb = ov[q]; ib = oi[q]; } }
                const bool takeA = (ca > cb) || (ca == cb && ia < ib);
                mv[k] = takeA ? ca : cb; mi[k] = takeA ? ia : ib; pa += takeA ? 1 : 0; pb += takeA ? 0 : 1;
            }
        }
        const float e1 = __expf(mv[1] - mv[0]), e2 = __expf(mv[2] - mv[0]), e3 = __expf(mv[3] - mv[0]);
        const float inv = 1.0f / (1.0f + e1 + e2 + e3);
        if (hi == 0) {
            *(int4*)(EIDX + (size_t)t * 4) = make_int4(mi[0], mi[1], mi[2], mi[3]);
            *(float4*)(GATE + (size_t)t * 4) = make_float4(inv, e1 * inv, e2 * inv, e3 * inv);
#pragma unroll
            for (int k = 0; k < 4; ++k) { el[tl * 4 + k] = mi[k]; pl[tl * 4 + k] = atomicAdd((int*)(cnt + mi[k]), 1); }
        }
    } else {
        f32x4 gv[4];
#pragma unroll
        for (int j = 0; j < 4; ++j) gv[j] = *((const f32x4*)g2 + lane + 64 * j);
        for (int i = 0; i < 32; ++i) {
            const int t = tb0 + (wave - 4) * 32 + i;
            const u32x2* xr = (const u32x2*)(x1 + (size_t)t * D) + lane;
            f32x4 v[4]; float s = 0.f;
#pragma unroll
            for (int j = 0; j < 4; ++j) { const u32x2 xw = xr[64 * j]; v[j] = (f32x4){bflo(xw.x), bfhi(xw.x), bflo(xw.y), bfhi(xw.y)}; s += (v[j].x * v[j].x + v[j].y * v[j].y) + (v[j].z * v[j].z + v[j].w * v[j].w); }
            const float rstd = (1.0f / sqrtf(wave_sum(s) * (1.0f / D) + 1e-5f)) * F8_X_MUL;
            unsigned* o4 = (unsigned*)(H2 + (size_t)t * D) + lane;
#pragma unroll
            for (int j = 0; j < 4; ++j) { v[j] = v[j] * rstd * gv[j]; o4[64 * j] = pk4_fp8(v[j].x, v[j].y, v[j].z, v[j].w); }
        }
    }
    __syncthreads();
    if (tid < 32) basel[tid] = (int)atomicAdd(ctl + CW_CNT + tid, (unsigned)cnt[tid]);
    __syncthreads();
    for (int i = tid; i < TPB * 4; i += 512) POS[(size_t)tb0 * 4 + i] = pl[i] + basel[el[i]];
}

__device__ __forceinline__ void p6_dispatch(LAS unsigned char* lds, const Args& a, unsigned* ctl) {
    const int tid = threadIdx.x, lane = tid & 63, wave = __builtin_amdgcn_readfirstlane(tid >> 6);
    unsigned char* ws = a.ws;
    const int* EIDX = (const int*)(ws + WS_EIDX); const float* GATE = (const float*)(ws + WS_GATE); const int* POS = (const int*)(ws + WS_POS);
    int* DEST = (int*)(ws + WS_DEST); float* ROWGATE = (float*)(ws + WS_ROWGATE); int* TILEE = (int*)(ws + WS_TILEE); int* ROWTOK = (int*)(ws + WS_ROWTOK);
    LAS int* pstart = (LAS int*)(lds + MISC_OFF + 1024); LAS int* pcnt = pstart + 32;
    if (tid < NE) pcnt[tid] = (int)__hip_atomic_load(ctl + CW_CNT + tid, __ATOMIC_RELAXED, __HIP_MEMORY_SCOPE_AGENT);
    __syncthreads();
    if (tid == 0) {
        int acc = 0;
        for (int e = 0; e < NE; ++e) { pstart[e] = acc; acc += ((pcnt[e] + 255) >> 8) * 256; }
        if (blockIdx.x == 0) TILEE[1023] = acc >> 8;
    }
    __syncthreads();
    if (blockIdx.x == 0 && tid < NE) { const int nt = (pcnt[tid] + 255) >> 8, t0_ = pstart[tid] >> 8; for (int i = 0; i < nt; ++i) TILEE[t0_ + i] = tid; }
    if (blockIdx.x < NE) {
        const int e = blockIdx.x, cn = pcnt[e], pe = ((cn + 255) >> 8) * 256;
        for (int i = cn + tid; i < pe; i += 512) ROWTOK[pstart[e] + i] = 0;
    }
    const int TPB = T / (int)gridDim.x, tb0 = blockIdx.x * TPB;
    for (int pi = tb0 * 4 + tid; pi < (tb0 + TPB) * 4; pi += 512) {
        const int e = EIDX[pi], dest = pstart[e] + POS[pi];
        DEST[pi] = dest; ROWGATE[dest] = GATE[pi]; ROWTOK[dest] = pi >> 2;
    }
}

__device__ __forceinline__ void p9_combine(const Args& a, int G) {
    const int tid = threadIdx.x, lane = tid & 63, wave = __builtin_amdgcn_readfirstlane(tid >> 6);
    unsigned char* ws = a.ws;
    const unsigned char* YS = ws + WS_YS; const int* DEST = (const int*)(ws + WS_DEST);
    float* out = a.out;
    const int gw = blockIdx.x * 8 + wave, NGW = G * 8;
    for (int t = gw; t < T; t += NGW) {
        f32x4* xr = (f32x4*)(out + (size_t)t * D) + lane; const u32x2* xi = (const u32x2*)((const bf16_t*)(ws + WS_X1B) + (size_t)t * D) + lane;
        f32x4 v[4];
#pragma unroll
        for (int j = 0; j < 4; ++j) { const u32x2 xw = xi[64 * j]; v[j] = (f32x4){bflo(xw.x), bfhi(xw.x), bflo(xw.y), bfhi(xw.y)}; }
#pragma unroll
        for (int k = 0; k < 4; ++k) {
            const int dest = DEST[t * 4 + k];
            const unsigned* yr = (const unsigned*)(YS + (size_t)dest * D) + lane;
#pragma unroll
            for (int j = 0; j < 4; ++j) { const unsigned w = yr[64 * j];
                const f32x2 lo = __builtin_amdgcn_cvt_pk_f32_fp8((int)w, false), hi2 = __builtin_amdgcn_cvt_pk_f32_fp8((int)w, true);
                v[j].x += lo.x * (1.0f / F8_Y_MUL); v[j].y += lo.y * (1.0f / F8_Y_MUL); v[j].z += hi2.x * (1.0f / F8_Y_MUL); v[j].w += hi2.y * (1.0f / F8_Y_MUL); }
        }
        if (TIME_REGION >= 0) { const float sc_ = 1.0f + 4e-6f * (float)((const unsigned*)(ws + WS_CTL))[301];
#pragma unroll
            for (int j = 0; j < 4; ++j) v[j] = v[j] * sc_; }
#pragma unroll
        for (int j = 0; j < 4; ++j) xr[64 * j] = v[j];
    }
}

constexpr int NPHASE = 10;
__global__ void __launch_bounds__(512, 2) hymba_fwd(Args args) {
    extern __shared__ __attribute__((aligned(16))) unsigned char lds_raw[];
    LAS unsigned char* lds = (LAS unsigned char*)lds_raw;
    cg::grid_group grid = cg::this_grid();
    const int G = gridDim.x;
    unsigned char* ws = args.ws;
    unsigned* ctl = (unsigned*)(ws + WS_CTL);
    const int lo = args.ph_lo, hi = args.ph_hi;
#define IN(k) (lo <= (k) && (k) < hi)
#define NREP(k) ((REP_PHASE) == (k) ? 2 : 1)
#define TSTART(k) do { if ((TIME_REGION) == (k) && blockIdx.x == 0 && threadIdx.x == 0) ctl[300] = (unsigned)__builtin_amdgcn_s_memrealtime(); } while (0)
#define TEND(k) do { if ((TIME_REGION) == (k) && blockIdx.x == 0 && threadIdx.x == 0) ctl[301] = (unsigned)__builtin_amdgcn_s_memrealtime() - ctl[300]; } while (0)
#define SEAM(k) do { if (IN(k) && IN((k) + 1)) { if (args.ph_lo < 0) grid.sync(); xcd_barrier(xbar); } } while (0)
    const int* TILEE = (const int*)(ws + WS_TILEE);
    { volatile LAS unsigned* st = (volatile LAS unsigned*)(lds + LDS_BYTES - 64); if (threadIdx.x < 2) st[threadIdx.x] = 0u; }
    __syncthreads();
    const XcdBarrier xbar = xcd_barrier_post(ctl + CW_BAR, (volatile LAS unsigned*)(lds + LDS_BYTES - 64));

    if (IN(0)) { for (int rep = 0; rep < NREP(0); ++rep) p0_prologue(lds, args, G); } SEAM(0);
    if (IN(1)) {
        pg8::Gemm g{ws + WS_XN, ws + WS_WINT, 1024, 0, 0, nullptr};
        pg8::TileOrder S; S.init(T / 256, NINP / 256, G, (int)blockIdx.x, nullptr, 0, WGM_P1);
        pg8::EpiBf16 E{(bf16_t*)(ws + WS_P), NINP, (bf16_t*)(ws + WS_VT)};
        for (int rep = 0; rep < NREP(1); ++rep) pg8::gemm_phase<false, false>(lds, g, S, E);
    } SEAM(1);
    TSTART(2);
    if (IN(2)) {
        ck::fused_item(lds, args, (int)blockIdx.x * 2); ck::fused_item(lds, args, (int)blockIdx.x * 2 + 1);
    } SEAM(2);
    TSTART(3);
    if (IN(3)) {
        TSTART(30); for (int rep = 0; rep < NREP(30); ++rep) { if (blockIdx.x < 64) ck::seq_head(lds, args, (int)blockIdx.x); __syncthreads(); } TEND(30);
        for (int rep = 0; rep < NREP(31); ++rep) att::attn_phase(lds, args, ctl + 64 * rep);
    } SEAM(3); TEND(3);
    if (IN(4)) {
        pg8::Gemm g{ws + WS_YMIX, ws + WS_WOUT, 1024, 0, 0, nullptr};
        pg8::TileOrder S; S.init(T / 256, D / 256, G, (int)blockIdx.x, nullptr, 0, WGM_P4);
        pg8::EpiResBf16 E{args.in[0], (bf16_t*)(ws + WS_X1B), D};
        for (int rep = 0; rep < NREP(4); ++rep) pg8::gemm_phase<false, false>(lds, g, S, E);
    } SEAM(4);
    if (IN(5)) { _Pragma("clang loop unroll(disable)") for (int rep = 0; rep < NREP(5); ++rep) { p5_router(lds, args, ctl + 256 * (NREP(5) - 1 - rep)); __syncthreads(); } } SEAM(5);
    if (IN(6)) { for (int rep = 0; rep < NREP(6); ++rep) { p6_dispatch(lds, args, ctl); __syncthreads(); } } SEAM(6);
    if (IN(7)) {
        const int ntile = TILEE[1023];
        pg8::Gemm g{ws + WS_H2, ws + WS_W1T, 1024, F8_W_SC, F8_X_SC, (const int*)(ws + WS_ROWTOK)};
        pg8::TileOrder S; S.init(ntile, 8, G, (int)blockIdx.x, TILEE, 8, WGM_P7);
        pg8::EpiSwiglu E{ws + WS_HID, args.in[27], TILEE};
        for (int rep = 0; rep < NREP(7); ++rep) pg8::gemm_phase<true, true>(lds, g, S, E);
    } SEAM(7);
    if (IN(8)) {
        const int ntile = TILEE[1023];
        pg8::Gemm g{ws + WS_HID, ws + WS_W2T, 1024, F8_W_SC, F8_H_SC, nullptr};
        pg8::TileOrder S; S.init(ntile, 4, G, (int)blockIdx.x, TILEE, 4, WGM_P8);
        pg8::EpiGateF8 E{ws + WS_YS, args.in[29], (const float*)(ws + WS_ROWGATE), TILEE};
        for (int rep = 0; rep < NREP(8); ++rep) pg8::gemm_phase<true, false>(lds, g, S, E);
    } SEAM(8);
    if (IN(9)) { p9_combine(args, G); }
#undef IN
#undef SEAM
}

extern "C" void kernel_launch(void* const* d_in, const int* in_sizes, int n_in, void* d_out, int out_size, void* d_ws, size_t ws_size, hipStream_t stream) {
    static int grid = 0;
    if (grid == 0) {
        if (n_in != 30 || in_sizes[0] != T * D || out_size != T * D || ws_size < WS_END) { fprintf(stderr, "kernel_launch: unexpected shapes (n_in %d, in0 %d, out %d, ws %zu); nothing launched\n", n_in, n_in > 0 ? in_sizes[0] : -1, out_size, ws_size); grid = -1; return; }
        int dev = 0, cus = 0, per_cu = 0;
        if (hipGetDevice(&dev) != hipSuccess || hipDeviceGetAttribute(&cus, hipDeviceAttributeMultiprocessorCount, dev) != hipSuccess) { grid = -1; return; }
        if (hipFuncSetAttribute((const void*)hymba_fwd, hipFuncAttributeMaxDynamicSharedMemorySize, LDS_BYTES) != hipSuccess) { fprintf(stderr, "kernel_launch: hipFuncSetAttribute failed\n"); grid = -1; return; }
        if (hipOccupancyMaxActiveBlocksPerMultiprocessor(&per_cu, (const void*)hymba_fwd, 512, LDS_BYTES) != hipSuccess || per_cu < 1) { fprintf(stderr, "kernel_launch: occupancy query says %d\n", per_cu); per_cu = 1; }
        (void)hipGetLastError();
        grid = cus;
        if (grid > 256) grid = 256;
        if (grid != 256 || T % grid != 0 || (T / grid) % 16 != 0) { fprintf(stderr, "kernel_launch: grid %d does not divide the token count evenly\n", grid); grid = -1; return; }
    }
    if (grid < 0) return;
    (void)hipMemsetAsync((char*)d_ws + WS_CTL, 0, CTL_ZERO_BYTES, stream);
    Args a{};
    for (int i = 0; i < 30; ++i) a.in[i] = (const float*)d_in[i];
    a.out = (float*)d_out; a.ws = (unsigned char*)d_ws;
    constexpr int NL = MK_N_LAUNCHES;
    for (int li = 0; li < NL; ++li) {
        a.ph_lo = (NL == 1) ? 0 : li; a.ph_hi = (NL == 1) ? NPHASE : li + 1;
        void* kargs[] = {&a};
        hipError_t e = hipLaunchCooperativeKernel((const void*)hymba_fwd, dim3(grid), dim3(512), kargs, LDS_BYTES, stream);
        if (e != hipSuccess) { fprintf(stderr, "kernel_launch: cooperative launch %d failed: %s (grid %d)\n", li, hipGetErrorString(e), grid); break; }
    }
}
```

```cpp
#include <hip/hip_runtime.h>
#include <hip/hip_cooperative_groups.h>
#include <cstdio>
#include <cstdint>
#include <type_traits>
namespace cg = cooperative_groups;

#ifndef REP_PHASE
#define REP_PHASE -1
#endif
#ifndef TIME_REGION
#define TIME_REGION -1
#endif
#ifndef WGM_P1
#define WGM_P1 2
#endif
#ifndef WGM_P4
#define WGM_P4 2
#endif
#ifndef WGM_P7
#define WGM_P7 2
#endif
#ifndef WGM_P8
#define WGM_P8 2
#endif
#ifndef MK_N_LAUNCHES
#define MK_N_LAUNCHES 1
#endif

#define LAS __attribute__((address_space(3)))
#define GAS __attribute__((address_space(1)))
typedef unsigned short bf16_t;
typedef short bf16x8 __attribute__((ext_vector_type(8)));
typedef short s16x4 __attribute__((ext_vector_type(4)));
typedef float f32x2 __attribute__((ext_vector_type(2)));
typedef float f32x4 __attribute__((ext_vector_type(4)));
typedef float f32x16 __attribute__((ext_vector_type(16)));
typedef unsigned u32x2 __attribute__((ext_vector_type(2)));
typedef unsigned u32x4 __attribute__((ext_vector_type(4)));
typedef int v8i32 __attribute__((ext_vector_type(8)));

constexpr int NB = 8, SEQ = 4096, T = NB * SEQ, D = 1024;
constexpr int CW = 512;
constexpr int NRW = 1696, NIN = 3232, NINP = 3328;
constexpr int DQ0 = 1696, DK0 = 2208, DV0 = 2720;
constexpr int NE = 32, TOPK = 4, DE = 1024;
constexpr int MAXROWS = T * TOPK + NE * 256;
constexpr int MAXTILES = MAXROWS / 256;
constexpr float LOG2E = 1.4426950408889634f;
constexpr float F8_W_MUL = 32.f, F8_X_MUL = 8.f, F8_H_MUL = 4.f, F8_Y_MUL = 16.f; constexpr int F8_W_SC = 0x7A7A7A7A, F8_X_SC = 0x7C7C7C7C, F8_H_SC = 0x7D7D7D7D;

constexpr size_t MiB = 1u << 20;
constexpr size_t WS_CTL = 0, CTL_ZERO_BYTES = 64 * 1024;
constexpr size_t WS_TILEE = 512 * 1024;
constexpr size_t WS_LW = 576 * 1024;
constexpr size_t WS_WINT = 1 * MiB;
constexpr size_t WS_WOUT = 8 * MiB;
constexpr size_t WS_W1T = 10 * MiB;
constexpr size_t WS_W2T = 138 * MiB;
constexpr size_t WS_EIDX = 202 * MiB;
constexpr size_t WS_GATE = WS_EIDX + 512 * 1024;
constexpr size_t WS_POS = WS_GATE + 512 * 1024;
constexpr size_t WS_DEST = WS_POS + 512 * 1024;
constexpr size_t WS_ROWGATE = 204 * MiB;
constexpr size_t WS_XN = 206 * MiB;
constexpr size_t WS_P = 270 * MiB;
constexpr size_t WS_SR = 478 * MiB, WS_SK = 510 * MiB, WS_SV = 542 * MiB, WS_SA = 574 * MiB, WS_SB = 606 * MiB;
constexpr size_t WS_SW = 638 * MiB;
constexpr size_t WS_SG = 702 * MiB;
constexpr size_t WS_QN = 734 * MiB, WS_KN = 766 * MiB;
constexpr size_t WS_YMIX = 798 * MiB;
constexpr size_t WS_H2 = 206 * MiB;
constexpr size_t WS_ROWTOK = 270 * MiB;
constexpr size_t WS_HID = 406 * MiB;
constexpr size_t WS_YS = 542 * MiB;
constexpr size_t WS_X1B = 862 * MiB;
constexpr size_t WS_CG = 862 * MiB;
constexpr size_t WS_CH = 894 * MiB;
constexpr size_t WS_CR2 = 926 * MiB;
constexpr size_t WS_CY0 = 958 * MiB;
constexpr size_t WS_RK = 990 * MiB;
constexpr size_t WS_VT = 992 * MiB;
constexpr size_t WS_END = 1024 * MiB;
constexpr int CW_CNT = 64;
constexpr int CW_ATTQ = 128;
constexpr int CW_BAR = 4096;

constexpr int RING_BYTES = 131072, MISC_OFF = RING_BYTES, LDS_BYTES = 147456;

__device__ __forceinline__ unsigned f2bf(float f) { unsigned u = __builtin_bit_cast(unsigned, f); return (u + 0x7fffu + ((u >> 16) & 1u)) >> 16; }
typedef __bf16 hwbf16x2 __attribute__((ext_vector_type(2)));
__device__ __forceinline__ unsigned pk2(float lo, float hi) { const f32x2 v = {lo, hi}; return __builtin_bit_cast(unsigned, __builtin_convertvector(v, hwbf16x2)); }
__device__ __forceinline__ unsigned pk4_fp8(float a, float b, float c, float d) {
    a = fminf(fmaxf(a, -448.f), 448.f); b = fminf(fmaxf(b, -448.f), 448.f); c = fminf(fmaxf(c, -448.f), 448.f); d = fminf(fmaxf(d, -448.f), 448.f);
    int r = __builtin_amdgcn_cvt_pk_fp8_f32(a, b, 0, false); r = __builtin_amdgcn_cvt_pk_fp8_f32(c, d, r, true); return (unsigned)r; }
__device__ __forceinline__ float bf2f(unsigned short b) { return __builtin_bit_cast(float, (unsigned)b << 16); }
__device__ __forceinline__ float bflo(unsigned w) { return __builtin_bit_cast(float, w << 16); }
__device__ __forceinline__ float bfhi(unsigned w) { return __builtin_bit_cast(float, w & 0xffff0000u); }
__device__ __forceinline__ float wave_sum(float v) {
#pragma unroll
    for (int o = 1; o < 64; o <<= 1) v += __shfl_xor(v, o);
    return v;
}
__device__ __forceinline__ float sigmoidf_(float x) { return 1.0f / (1.0f + __expf(-x)); }
template <int CTRL> __device__ __forceinline__ float dpp_f(float v) { return __builtin_bit_cast(float, __builtin_amdgcn_update_dpp(0, __builtin_bit_cast(int, v), CTRL, 0xF, 0xF, true)); }
__device__ __forceinline__ float red8(float v) {
    v += dpp_f<0xB1>(v);
    v += dpp_f<0x4E>(v);
    v += dpp_f<0x141>(v);
    return v;
}
__device__ __forceinline__ float red4(float v) { v += dpp_f<0xB1>(v); v += dpp_f<0x4E>(v); return v; }


#define XB_TMO      128
#define XB_XCNT(j)  (256  + 64 * (j))
#define XB_XSUB(j)  (1280 + 64 * (j))
#define XB_XGEN(j)  (2304 + 64 * (j))
#define XB_TOP      3328
#define XB_TOPGEN   3392
#define XCD_BAR_WORDS 3456
#define XB_SPIN_CAP (1u << 18)
__device__ __forceinline__ unsigned xb_ld(unsigned* p)              { return __hip_atomic_load(p, __ATOMIC_RELAXED, __HIP_MEMORY_SCOPE_AGENT); }
__device__ __forceinline__ unsigned xb_add(unsigned* p, unsigned v) { return __hip_atomic_fetch_add(p, v, __ATOMIC_RELAXED, __HIP_MEMORY_SCOPE_AGENT); }
__device__ __forceinline__ unsigned xb_xcc_id() { return (unsigned)__builtin_amdgcn_s_getreg((3 << 11) | 20) & 0xFu; }
#define XB_SPIN(cond, bar) do { unsigned _sp = 0; while (cond) { __builtin_amdgcn_s_sleep(1); \
    if ((++_sp & 255u) == 0u) { if (xb_ld(&(bar)[XB_TMO])) break; if (_sp > XB_SPIN_CAP) { atomicAdd(&(bar)[XB_TMO], 1u); break; } } } } while (0)
struct XcdBarrier { unsigned* bar; unsigned x; volatile LAS unsigned* st; };
__device__ __forceinline__ XcdBarrier xcd_barrier_post(unsigned* bar, volatile LAS unsigned* st) {
    XcdBarrier b; b.bar = bar; b.x = xb_xcc_id(); b.st = st;
    if (threadIdx.x == 0) (void)xb_add(&bar[XB_XCNT(b.x)], 1u);
    return b;
}
__device__ __forceinline__ void xcd_barrier_complete(unsigned* bar, unsigned x, unsigned& nloc, unsigned& nx) {
    const unsigned G = gridDim.x * gridDim.y * gridDim.z;
    unsigned sum, cnt, mine, sp = 0u;
    for (;;) {
        sum = 0u; cnt = 0u; mine = 0u;
#pragma unroll
        for (unsigned j = 0; j < 16; ++j) { const unsigned c = xb_ld(&bar[XB_XCNT(j)]); sum += c; cnt += (c > 0u) ? 1u : 0u; mine = (j == x) ? c : mine; }
        if (sum == G) break;
        __builtin_amdgcn_s_sleep(1);
        if ((++sp & 255u) == 0u) { if (xb_ld(&bar[XB_TMO])) break; if (sp > XB_SPIN_CAP) { atomicAdd(&bar[XB_TMO], 1u); break; } }
    }
    nloc = mine > 0u ? mine : 1u; nx = cnt > 0u ? cnt : 1u;
}
__device__ __forceinline__ void xcd_barrier(const XcdBarrier& b) {
    asm volatile("s_waitcnt vmcnt(0)" ::: "memory");
    __syncthreads();
    if (threadIdx.x == 0) {
        unsigned* bar = b.bar;
        __builtin_amdgcn_s_waitcnt(0);
        unsigned nloc = b.st[0], nx = b.st[1];
        if (nloc == 0u) { xcd_barrier_complete(bar, b.x, nloc, nx); b.st[0] = nloc; b.st[1] = nx; }
        const unsigned old = xb_add(&bar[XB_XSUB(b.x)], 1u);
        const unsigned gen = old / nloc;
        if (old + 1u == (gen + 1u) * nloc) {
            __builtin_amdgcn_fence(__ATOMIC_RELEASE, "agent");
            asm volatile("s_waitcnt vmcnt(0)" ::: "memory");
            const unsigned og = xb_add(&bar[XB_TOP], 1u);
            const unsigned tg = og / nx;
            if (og + 1u == (tg + 1u) * nx) xb_add(&bar[XB_TOPGEN], 1u);
            else XB_SPIN(xb_ld(&bar[XB_TOPGEN]) == tg, bar);
            __builtin_amdgcn_fence(__ATOMIC_ACQUIRE, "agent");
            xb_add(&bar[XB_XGEN(b.x)], 1u);
            asm volatile("s_waitcnt vmcnt(0)" ::: "memory");
        } else {
            XB_SPIN(xb_ld(&bar[XB_XGEN(b.x)]) == gen, bar);
            __builtin_amdgcn_fence(__ATOMIC_ACQUIRE, "agent");
            asm volatile("s_waitcnt vmcnt(0)" ::: "memory");
        }
    }
    __syncthreads();
}

namespace pg8 {
constexpr int BM = 256, BK = 64, HALF = 128, HTB = HALF * BK * 2, STAGE_BYTES = 8 * HTB, NXCD = 8;
__host__ __device__ __forceinline__ int lds_byte(int r, int c) { const int st = (r >> 4) * 2 + (c >> 5), rr = r & 15, cc = c & 31, ob = rr * 64 + cc * 2; return st * 1024 + (ob ^ (((ob >> 9) & 1) << 5)); }
__host__ __device__ __forceinline__ void stage_rc(int b, int& R, int& C) { const int st = b / 1024, sb = b % 1024, swz = sb ^ (((sb >> 9) & 1) << 5); R = (st >> 1) * 16 + swz / 64; C = (st & 1) * 32 + (swz % 64) / 2; }
__host__ __device__ __forceinline__ int f8_swz(int fr) { return ((fr >> 1) & 3) | ((((fr + 4) >> 3) & 1) << 2); }
__host__ __device__ __forceinline__ void stage_rc_f8(int b, int& R, int& C) { const int p = b >> 10, l = (b >> 4) & 63, fr = (p & 1) * 8 + (l >> 3); R = (p >> 1) * 16 + fr; C = ((l & 7) ^ f8_swz(fr)) * 8; }
__host__ __device__ __forceinline__ int frag_f8(int row0, int fr, int fq, int j) { return (row0 >> 4) * 2048 + (fr >> 3) * 1024 + (fr & 7) * 128 + (((2 * fq + j) ^ f8_swz(fr)) * 16); }
__host__ __device__ __forceinline__ int perm32(int rho) { const int n = rho >> 4, i = rho & 15; return 8 * (i >> 2) + 4 * n + (i & 3); }

struct Unit { int pm, pn, pb; };
struct Gemm { const void* A; const void* Bt; int K; int scW, scA; const int* rowtok; };

struct TileOrder {
    int nM, nN, nwg, G, c, WGM; const int* tile_e; int nb_per_e;
    __device__ void init(int nM_, int nN_, int G_, int c_, const int* te, int nbe, int wgm) { nM = nM_; nN = nN_; nwg = nM * nN; G = G_; c = c_; tile_e = te; nb_per_e = nbe; WGM = wgm; }
    __device__ bool next(int i, Unit& u) const {
        const long L = (long)i * G + c; if (L >= nwg) return false;
        int wgid = (int)L; { const int q = nwg / NXCD, r = nwg % NXCD, xcd = wgid % NXCD, off = wgid / NXCD; wgid = (xcd < r ? xcd * (q + 1) : r * (q + 1) + (xcd - r) * q) + off; }
        const int nig = WGM * nN, gid = wgid / nig, fm = gid * WGM, gsz = (nM - fm) < WGM ? (nM - fm) : WGM;
        u.pm = fm + ((wgid % nig) % gsz); u.pn = (wgid % nig) / gsz;
        u.pb = tile_e ? tile_e[u.pm] * nb_per_e + u.pn : u.pn;
        return true;
    }
};

struct EpiBf16 {
    static constexpr bool PERM = true;
    bf16_t* O; int ldc; bf16_t* VT;
    __device__ __forceinline__ void operator()(const f32x4 (&acc)[2][2][4][2], const Unit& u, int wr, int wc, int fr, int fq) const {
        const int row0 = u.pm * BM + wr * 64 + fr; const int col0 = u.pn * BM + wc * 32 + 8 * fq;
#pragma unroll
        for (int ai = 0; ai < 2; ++ai)
#pragma unroll
            for (int m = 0; m < 4; ++m) { const int t = row0 + ai * HALF + m * 16; bf16_t* rowp = O + (size_t)t * ldc + col0;
#pragma unroll
                for (int bj = 0; bj < 2; ++bj) { const f32x4 v0 = acc[ai][bj][m][0], v1 = acc[ai][bj][m][1];
                    u32x4 w; w.x = pk2(v0[0], v0[1]); w.y = pk2(v0[2], v0[3]); w.z = pk2(v1[0], v1[1]); w.w = pk2(v1[2], v1[3]);
                    const int col = col0 + bj * HALF;
                    if (col >= DV0) { const int dvf = col - DV0, hh = dvf >> 7, dv = dvf & 127, tp = t & (SEQ - 1), key = tp & 63;
                        bf16_t* vp = VT + (((((size_t)((t >> 12) * 4 + hh) * 64 + (tp >> 6)) * 4 + (dv >> 5)) * 4 + (key >> 4)) * 16 + (key & 15)) * 32 + (dv & 31);
                        if (col < NIN) *(u32x4*)vp = w; }
                    else *(u32x4*)(rowp + bj * HALF) = w; } }
    }
};
struct EpiResBf16 {
    static constexpr bool PERM = true;
    const float* base; bf16_t* out; int ldc;
    __device__ __forceinline__ void operator()(const f32x4 (&acc)[2][2][4][2], const Unit& u, int wr, int wc, int fr, int fq) const {
        const int col0 = u.pn * BM + wc * 32 + 8 * fq;
#pragma unroll
        for (int ai = 0; ai < 2; ++ai) {
            f32x4 bb[4][2][2];
#pragma unroll
            for (int m = 0; m < 4; ++m) { const size_t off = (size_t)(u.pm * BM + ai * HALF + wr * 64 + m * 16 + fr) * ldc + col0;
#pragma unroll
                for (int bj = 0; bj < 2; ++bj) { bb[m][bj][0] = *(const f32x4*)(base + off + bj * HALF); bb[m][bj][1] = *(const f32x4*)(base + off + bj * HALF + 4); } }
            __builtin_amdgcn_sched_barrier(0);
#pragma unroll
            for (int m = 0; m < 4; ++m) { const size_t off = (size_t)(u.pm * BM + ai * HALF + wr * 64 + m * 16 + fr) * ldc + col0;
#pragma unroll
                for (int bj = 0; bj < 2; ++bj) {
                    const f32x4 v0 = bb[m][bj][0] + acc[ai][bj][m][0], v1 = bb[m][bj][1] + acc[ai][bj][m][1];
                    u32x4 w; w.x = pk2(v0[0], v0[1]); w.y = pk2(v0[2], v0[3]); w.z = pk2(v1[0], v1[1]); w.w = pk2(v1[2], v1[3]);
                    *(u32x4*)(out + off + bj * HALF) = w; } }
            __builtin_amdgcn_sched_barrier(0);
        }
    }
};
struct EpiSwiglu {
    static constexpr bool PERM = true;
    unsigned char* O; const float* b1; const int* tile_e;
    __device__ __forceinline__ void operator()(const f32x4 (&acc)[2][2][4][2], const Unit& u, int wr, int wc, int fr, int fq) const {
        const int e = tile_e[u.pm]; const int row0 = u.pm * BM + wr * 64 + fr; const int hc0 = u.pn * 128 + wc * 32 + 8 * fq;
        const float* bg = b1 + (size_t)e * 2048 + hc0; const float* bl = bg + 1024;
        const f32x4 g0 = *(const f32x4*)bg, g1 = *(const f32x4*)(bg + 4), l0 = *(const f32x4*)bl, l1 = *(const f32x4*)(bl + 4);
#pragma unroll
        for (int ai = 0; ai < 2; ++ai)
#pragma unroll
            for (int m = 0; m < 4; ++m) { unsigned char* rowp = O + (size_t)(row0 + ai * HALF + m * 16) * 1024 + hc0;
                float o[8];
#pragma unroll
                for (int n = 0; n < 2; ++n) { const f32x4 gv = acc[ai][0][m][n] + (n ? g1 : g0), lv = acc[ai][1][m][n] + (n ? l1 : l0);
#pragma unroll
                    for (int i = 0; i < 4; ++i) { const float g = fminf(gv[i], 7.0f), l = fminf(fmaxf(lv[i], -7.0f), 7.0f);
                        const float sg = __builtin_amdgcn_rcpf(1.0f + __builtin_amdgcn_exp2f(-1.702f * LOG2E * g)); o[n * 4 + i] = g * sg * (l + 1.0f); } }
                u32x2 w; w.x = pk4_fp8(o[0] * F8_H_MUL, o[1] * F8_H_MUL, o[2] * F8_H_MUL, o[3] * F8_H_MUL); w.y = pk4_fp8(o[4] * F8_H_MUL, o[5] * F8_H_MUL, o[6] * F8_H_MUL, o[7] * F8_H_MUL);
                *(u32x2*)rowp = w; }
    }
};
struct EpiGateF8 {
    static constexpr bool PERM = true;
    unsigned char* O; const float* b2; const float* rowgate; const int* tile_e;
    __device__ __forceinline__ void operator()(const f32x4 (&acc)[2][2][4][2], const Unit& u, int wr, int wc, int fr, int fq) const {
        const int e = tile_e[u.pm]; const int row0 = u.pm * BM + wr * 64 + fr; const int col0 = u.pn * BM + wc * 32 + 8 * fq;
        f32x4 bv[2][2];
#pragma unroll
        for (int bj = 0; bj < 2; ++bj)
#pragma unroll
            for (int n = 0; n < 2; ++n) bv[bj][n] = *(const f32x4*)(b2 + (size_t)e * 1024 + col0 + bj * HALF + 4 * n);
#pragma unroll
        for (int ai = 0; ai < 2; ++ai)
#pragma unroll
            for (int m = 0; m < 4; ++m) { const int row = row0 + ai * HALF + m * 16; const float gt = rowgate[row] * F8_Y_MUL; unsigned char* rowp = O + (size_t)row * 1024 + col0;
#pragma unroll
                for (int bj = 0; bj < 2; ++bj) { const f32x4 v0 = (acc[ai][bj][m][0] + bv[bj][0]) * gt, v1 = (acc[ai][bj][m][1] + bv[bj][1]) * gt;
                    u32x2 w; w.x = pk4_fp8(v0[0], v0[1], v0[2], v0[3]); w.y = pk4_fp8(v1[0], v1[1], v1[2], v1[3]);
                    *(u32x2*)(rowp + bj * HALF) = w; } }
    }
};

__device__ __forceinline__ v8i32 pg8_ld32(const LAS unsigned char* p, const LAS unsigned char* q) { const u32x4 a = *(const LAS u32x4*)p, b = *(const LAS u32x4*)q;
    return (v8i32){(int)a.x, (int)a.y, (int)a.z, (int)a.w, (int)b.x, (int)b.y, (int)b.z, (int)b.w}; }
template <bool F8, bool GATHER, class Epi, class Sched>
__device__ __forceinline__ void gemm_phase(LAS unsigned char* lds, const Gemm g, const Sched& S, const Epi& E) {
    const int tid = threadIdx.x, wid = __builtin_amdgcn_readfirstlane(tid >> 6), lane = tid & 63, wr = wid >> 2, wc = wid & 3, fr = lane & 15, fq = lane >> 4;
    const int RB = F8 ? g.K : g.K * 2, nt = RB / 128;
    unsigned voffB[2];
#pragma unroll
    for (int i = 0; i < 2; ++i) { int R, C; if constexpr (F8) stage_rc_f8(tid * 16 + i * 8192, R, C); else stage_rc(tid * 16 + i * 8192, R, C); const int Rb = Epi::PERM ? ((R & ~31) + perm32(R & 31)) : R;
        voffB[i] = (unsigned)(Rb * RB + C * 2); }
#define PG8_AOFFS(dst, pm_) do { _Pragma("unroll") for (int h_ = 0; h_ < 2; ++h_) _Pragma("unroll") for (int i_ = 0; i_ < 2; ++i_) { int R_, C_; if constexpr (F8) stage_rc_f8(tid * 16 + i_ * 8192, R_, C_); else stage_rc(tid * 16 + i_ * 8192, R_, C_); \
        const int row_ = (pm_) * BM + h_ * HALF + R_; const unsigned grow_ = GATHER ? (unsigned)g.rowtok[row_] : (unsigned)row_; dst[h_][i_] = grow_ * (unsigned)RB + (unsigned)(C_ * 2); } } while (0)
    unsigned cvA[2][2], nvA[2][2];
    const size_t kstep = (size_t)(BK * 2);
    const size_t hstep = (size_t)HALF * RB;
    const size_t tstep = 2 * hstep;
    const unsigned ldsw = (unsigned)wid * 1024u;
    const int aoff = F8 ? frag_f8(wr * 64, fr, fq, 0) : lds_byte(wr * 64 + fr, fq * 8); const int aoff1 = F8 ? frag_f8(wr * 64, fr, fq, 1) : 0;
    const int boff = F8 ? frag_f8(wc * 32, fr, fq, 0) : lds_byte(wc * 32 + fr, fq * 8); const int boff1 = F8 ? frag_f8(wc * 32, fr, fq, 1) : 0;
    const int scW = g.scW, scA = g.scA;
#define PG8_SA(b, h) (((b) * 2 + (h)) * HTB)
#define PG8_SB(b, h) ((4 + (b) * 2 + (h)) * HTB)
#define PG8_STAGE(bufoff, gbase, voff) do { _Pragma("unroll") for (int _i = 0; _i < 2; ++_i) \
        __builtin_amdgcn_global_load_lds((const unsigned*)((const char*)(gbase) + (voff)[_i]), (LAS unsigned*)(lds + (bufoff) + ldsw + _i * 8192), 16, 0, 0); } while (0)
typedef int v8i32a __attribute__((ext_vector_type(8), aligned(16)));
#define PG8_LD32(p, q) pg8_ld32(p, q)
#define PG8_STAGE_A(bufoff, kptr, offs) do { _Pragma("unroll") for (int _i = 0; _i < 2; ++_i) \
        __builtin_amdgcn_global_load_lds((const unsigned*)((const char*)(kptr) + (offs)[_i]), (LAS unsigned*)(lds + (bufoff) + ldsw + _i * 8192), 16, 0, 0); } while (0)
#define PG8_LDA(dst, b, h) do { _Pragma("unroll") for (int m = 0; m < 4; ++m) { if constexpr (F8) { dst[m].f8 = PG8_LD32(lds + PG8_SA(b, h) + aoff + m * 2048, lds + PG8_SA(b, h) + aoff1 + m * 2048); } \
        else { _Pragma("unroll") for (int k = 0; k < 2; ++k) dst[m].hv[k] = *(const LAS bf16x8*)(lds + PG8_SA(b, h) + aoff + m * 2048 + k * 1024); } } } while (0)
#define PG8_LDB(dst, b, h) do { _Pragma("unroll") for (int n = 0; n < 2; ++n) { if constexpr (F8) { dst[n].f8 = PG8_LD32(lds + PG8_SB(b, h) + boff + n * 2048, lds + PG8_SB(b, h) + boff1 + n * 2048); } \
        else { _Pragma("unroll") for (int k = 0; k < 2; ++k) dst[n].hv[k] = *(const LAS bf16x8*)(lds + PG8_SB(b, h) + boff + n * 2048 + k * 1024); } } } while (0)
#define PG8_MMA(ai, bj, At, Bt) do { __builtin_amdgcn_s_setprio(1); _Pragma("unroll") for (int m = 0; m < 4; ++m) _Pragma("unroll") for (int n = 0; n < 2; ++n) { \
        if constexpr (F8) { asm volatile("v_mfma_scale_f32_16x16x128_f8f6f4 %0, %1, %2, %0, %3, %4 op_sel_hi:[0,0,0]" : "+v"(acc[ai][bj][m][n]) : "v"(Bt[n].f8), "v"(At[m].f8), "v"(scW), "v"(scA)); } \
        else { _Pragma("unroll") for (int k = 0; k < 2; ++k) acc[ai][bj][m][n] = __builtin_amdgcn_mfma_f32_16x16x32_bf16(Bt[n].hv[k], At[m].hv[k], acc[ai][bj][m][n], 0, 0, 0); } } \
        __builtin_amdgcn_s_setprio(0); } while (0)
#define PG8_WAIT_V(n) asm volatile("s_waitcnt vmcnt(" #n ")" ::: "memory")
#define PG8_WAIT_L(n) asm volatile("s_waitcnt lgkmcnt(" #n ")" ::: "memory")
#define PG8_BAR __builtin_amdgcn_s_barrier()
#define PG8_SCHED __builtin_amdgcn_sched_barrier(0)
    Unit cur, nxt; int ui = 0;
    if (!S.next(0, cur)) return;
    f32x4 acc[2][2][4][2];
#pragma unroll
    for (int a = 0; a < 2; ++a)
#pragma unroll
        for (int b = 0; b < 2; ++b)
#pragma unroll
            for (int m = 0; m < 4; ++m)
#pragma unroll
                for (int n = 0; n < 2; ++n) acc[a][b][m][n] = (f32x4){0.f, 0.f, 0.f, 0.f};
    struct FragH { bf16x8 hv[2]; }; struct Frag8 { v8i32 f8; };
    typename std::conditional<F8, Frag8, FragH>::type At[4], B0[2], B1[2];
    const char* const kA = (const char*)g.A; const char* cB = (const char*)g.Bt + (size_t)cur.pb * tstep;
    PG8_AOFFS(cvA, cur.pm);
    PG8_STAGE(PG8_SB(0, 0), cB, voffB); PG8_STAGE(PG8_SB(0, 1), cB + hstep, voffB); PG8_STAGE_A(PG8_SA(0, 0), kA, cvA[0]); PG8_STAGE_A(PG8_SA(0, 1), kA, cvA[1]);
    if (wr == 1) PG8_BAR;
    PG8_WAIT_V(2); PG8_BAR;
    PG8_STAGE(PG8_SB(1, 0), cB + kstep, voffB); PG8_STAGE_A(PG8_SA(1, 0), kA + kstep, cvA[0]); PG8_STAGE(PG8_SB(1, 1), cB + hstep + kstep, voffB);
    PG8_WAIT_V(6); PG8_BAR;
    for (;;) {
        const bool has_next = S.next(ui + 1, nxt);
        const char* nB = has_next ? (const char*)g.Bt + (size_t)nxt.pb * tstep : cB;
        if (has_next) { PG8_AOFFS(nvA, nxt.pm); } else { _Pragma("unroll") for (int h_ = 0; h_ < 2; ++h_) _Pragma("unroll") for (int i_ = 0; i_ < 2; ++i_) nvA[h_][i_] = cvA[h_][i_]; }
#pragma clang loop unroll(disable)
        for (int t = 0; t < nt; t += 2) {
            const bool last = (t == nt - 2);
            const char* a1 = kA + (size_t)(t + 1) * kstep;
            const char* a2 = last ? kA : kA + (size_t)(t + 2) * kstep; const char* b2 = last ? nB : cB + (size_t)(t + 2) * kstep;
            const char* a3 = a2 + kstep; const char* b3 = b2 + kstep;
            unsigned v2A[2][2];
#pragma unroll
            for (int h_ = 0; h_ < 2; ++h_)
#pragma unroll
                for (int i_ = 0; i_ < 2; ++i_) v2A[h_][i_] = last ? nvA[h_][i_] : cvA[h_][i_];
            PG8_LDB(B0, 0, 0); PG8_LDB(B1, 0, 1); PG8_SCHED; PG8_LDA(At, 0, 0); PG8_STAGE_A(PG8_SA(1, 1), a1, cvA[1]);
            PG8_WAIT_V(8); PG8_WAIT_L(0); PG8_BAR; PG8_MMA(0, 0, At, B0); PG8_MMA(0, 1, At, B1); PG8_BAR; PG8_SCHED;
            PG8_LDA(At, 0, 1); PG8_STAGE(PG8_SB(0, 0), b2, voffB); PG8_STAGE(PG8_SB(0, 1), b2 + hstep, voffB); PG8_STAGE_A(PG8_SA(0, 0), a2, v2A[0]);
            PG8_WAIT_V(8); PG8_WAIT_L(0); PG8_BAR; PG8_MMA(1, 0, At, B0); PG8_MMA(1, 1, At, B1); PG8_BAR; PG8_SCHED;
            PG8_LDB(B0, 1, 0); PG8_LDB(B1, 1, 1); PG8_SCHED; PG8_LDA(At, 1, 0); PG8_STAGE_A(PG8_SA(0, 1), a2, v2A[1]);
            PG8_WAIT_V(8); PG8_WAIT_L(0); PG8_BAR; PG8_MMA(0, 0, At, B0); PG8_MMA(0, 1, At, B1); PG8_BAR; PG8_SCHED;
            PG8_LDA(At, 1, 1); PG8_STAGE(PG8_SB(1, 0), b3, voffB); PG8_STAGE(PG8_SB(1, 1), b3 + hstep, voffB); PG8_STAGE_A(PG8_SA(1, 0), a3, v2A[0]);
            PG8_WAIT_V(8); PG8_WAIT_L(0); PG8_BAR; PG8_MMA(1, 0, At, B0); PG8_MMA(1, 1, At, B1); PG8_BAR; PG8_SCHED;
        }
        if (wr == 0) PG8_BAR;
        if constexpr (F8) asm volatile("s_nop 15\n\ts_nop 15" ::: "memory");
        E(acc, cur, wr, wc, fr, fq);
        if (!has_next) break;
#pragma unroll
        for (int a = 0; a < 2; ++a)
#pragma unroll
            for (int b = 0; b < 2; ++b)
#pragma unroll
                for (int m = 0; m < 4; ++m)
#pragma unroll
                    for (int n = 0; n < 2; ++n) acc[a][b][m][n] = (f32x4){0.f, 0.f, 0.f, 0.f};
        cur = nxt; cB = nB; ++ui;
#pragma unroll
        for (int h_ = 0; h_ < 2; ++h_)
#pragma unroll
            for (int i_ = 0; i_ < 2; ++i_) cvA[h_][i_] = nvA[h_][i_];
        if (wr == 1) PG8_BAR;
    }
    PG8_WAIT_V(0);
    PG8_BAR;
#undef PG8_SA
#undef PG8_SB
#undef PG8_STAGE
#undef PG8_STAGE_A
#undef PG8_AOFFS
#undef PG8_LDA
#undef PG8_LDB
#undef PG8_MMA
#undef PG8_LD32
#undef PG8_WAIT_V
#undef PG8_WAIT_L
#undef PG8_BAR
#undef PG8_SCHED
}
}

struct Args { const float* in[30]; float* out; unsigned char* ws; int ph_lo, ph_hi; };

__device__ __forceinline__ void p0_transpose_item(const float* W, int K, int N, bf16_t* WT, int k0, int n0, int drow0, LAS float* scr, int lane) {
#pragma unroll 8
    for (int i = 0; i < 32; ++i) { const int kk = 2 * i + (lane >> 5); scr[kk * 33 + (lane & 31)] = W[(size_t)(k0 + kk) * N + n0 + (lane & 31)]; }
    asm volatile("s_waitcnt lgkmcnt(0)" ::: "memory");
    const int c = lane & 7;
#pragma unroll
    for (int j = 0; j < 4; ++j) { const int n = (lane >> 3) + 8 * j; const LAS float* s = scr + (8 * c) * 33 + n;
        u32x4 o; o.x = pk2(s[0 * 33], s[1 * 33]); o.y = pk2(s[2 * 33], s[3 * 33]); o.z = pk2(s[4 * 33], s[5 * 33]); o.w = pk2(s[6 * 33], s[7 * 33]);
        *(u32x4*)(WT + (size_t)(drow0 + n) * K + k0 + 8 * c) = o; }
    asm volatile("s_waitcnt lgkmcnt(0)" ::: "memory");
}
__device__ __forceinline__ void p0_transpose_item_f8(const float* W, int K, int N, unsigned char* WT, int k0, int n0, int drow0, LAS float* scr, int lane) {
    LAS unsigned* tile = (LAS unsigned*)scr;
    const float* src = W + (size_t)k0 * N + n0 + lane;
#pragma unroll 1
    for (int kb = 0; kb < 32; kb += 16) {
        float v[16][4];
#pragma unroll
        for (int i = 0; i < 16; ++i) { const float* p = src + (size_t)(4 * (kb + i)) * N;
#pragma unroll
            for (int j = 0; j < 4; ++j) v[i][j] = __builtin_nontemporal_load(p + (size_t)j * N); }
        __builtin_amdgcn_sched_barrier(0);
#pragma unroll
        for (int i = 0; i < 16; ++i) tile[lane * 33 + kb + i] = pk4_fp8(v[i][0] * F8_W_MUL, v[i][1] * F8_W_MUL, v[i][2] * F8_W_MUL, v[i][3] * F8_W_MUL);
        __builtin_amdgcn_sched_barrier(0);
    }
    asm volatile("s_waitcnt lgkmcnt(0)" ::: "memory");
    const int c = lane & 7;
#pragma unroll
    for (int j = 0; j < 8; ++j) { const int n = (lane >> 3) + 8 * j; const LAS unsigned* t = tile + n * 33 + 4 * c;
        __builtin_nontemporal_store((u32x4){t[0], t[1], t[2], t[3]}, (u32x4*)(WT + (size_t)(drow0 + n) * K + k0 + 16 * c)); }
    asm volatile("s_waitcnt lgkmcnt(0)" ::: "memory");
}
constexpr int CONV_I_W1 = 8 * 32, CONV_I_W2 = 8 * 16;
constexpr int CONV_ITEMS = NE * (CONV_I_W1 + CONV_I_W2) / 8;
__device__ __forceinline__ void conv_item(LAS unsigned char* lds, const Args& a, int bi) {
    const int lane = threadIdx.x & 63, wave = __builtin_amdgcn_readfirstlane(threadIdx.x >> 6);
    LAS float* scr = (LAS float*)(lds + wave * 16384);
    unsigned char* W1t = a.ws + WS_W1T; unsigned char* W2t = a.ws + WS_W2T;
    int r = bi * 8 + wave;
    if (r < NE * CONV_I_W1) { const int e = r / CONV_I_W1, q = r % CONV_I_W1, kb = q / 32, nb = q % 32; const int n0 = 64 * nb;
        const int drow = (n0 < 1024) ? ((n0 >> 7) * 256 + (n0 & 127)) : (((n0 - 1024) >> 7) * 256 + 128 + ((n0 - 1024) & 127));
        p0_transpose_item_f8(a.in[26] + (size_t)e * 1024 * 2048, 1024, 2048, W1t + (size_t)e * 2048 * 1024, 128 * kb, n0, drow, scr, lane); }
    else { r -= NE * CONV_I_W1; const int e = r / CONV_I_W2, q = r % CONV_I_W2, kb = q / 16, nb = q % 16;
        p0_transpose_item_f8(a.in[28] + (size_t)e * 1024 * 1024, 1024, 1024, W2t + (size_t)e * 1024 * 1024, 128 * kb, 64 * nb, 64 * nb, scr, lane); }
}
__device__ __forceinline__ void p0_prologue(LAS unsigned char* lds, const Args& a, int G) {
    const int tid = threadIdx.x, lane = tid & 63, wave = __builtin_amdgcn_readfirstlane(tid >> 6);
    LAS float* scr = (LAS float*)(lds + wave * 16384);
    const int gw = blockIdx.x * 8 + wave, NGW = G * 8;
    unsigned char* ws = a.ws;
    bf16_t* Wint = (bf16_t*)(ws + WS_WINT); bf16_t* Woutt = (bf16_t*)(ws + WS_WOUT);
    constexpr int I_IN = 16 * (NIN / 32);
    constexpr int I_OUT = 16 * 32;
    constexpr int NITEMS = I_IN + I_OUT;
    for (int it = gw; it < NITEMS; it += NGW) {
        int r = it;
        if (r < I_IN) { const int nblk = NIN / 32, kb = r / nblk, nb = r % nblk; p0_transpose_item(a.in[2], 1024, NIN, Wint, 64 * kb, 32 * nb, 32 * nb, scr, lane); continue; } r -= I_IN;
        { const int kb = r / 32, nb = r % 32; p0_transpose_item(a.in[22], 1024, 1024, Woutt, 64 * kb, 32 * nb, 32 * nb, scr, lane); }
    }
    { bf16_t* LW = (bf16_t*)(ws + WS_LW);
      for (int i = gw * 64 + lane; i < CW * 160; i += NGW * 64) { const int col = i / 160, k = i - col * 160;
          const float v = k < 32 ? a.in[5][k * CW + col] : (k < 64 ? a.in[7][(k - 32) * CW + col] : a.in[8][(k - 64) * CW + col]); LW[i] = (bf16_t)f2bf(v); } }
    const float* x = a.in[0]; const float* g1 = a.in[1]; bf16_t* XN = (bf16_t*)(ws + WS_XN);
    f32x4 gv[4];
#pragma unroll
    for (int j = 0; j < 4; ++j) gv[j] = *((const f32x4*)g1 + lane + 64 * j);
#pragma unroll 4
    for (int m = gw; m < T; m += NGW) {
        const f32x4* xr = (const f32x4*)(x + (size_t)m * D) + lane;
        f32x4 v[4]; float s = 0.f;
#pragma unroll
        for (int j = 0; j < 4; ++j) { v[j] = xr[64 * j]; s += (v[j].x * v[j].x + v[j].y * v[j].y) + (v[j].z * v[j].z + v[j].w * v[j].w); }
        const float rstd = 1.0f / sqrtf(wave_sum(s) * (1.0f / D) + 1e-5f);
        u32x2* o8 = (u32x2*)(XN + (size_t)m * D) + lane;
#pragma unroll
        for (int j = 0; j < 4; ++j) { u32x2 w; w.x = pk2(v[j].x * rstd * gv[j].x, v[j].y * rstd * gv[j].y); w.y = pk2(v[j].z * rstd * gv[j].z, v[j].w * rstd * gv[j].w); o8[64 * j] = w; }
    }
}

__device__ __forceinline__ f32x4 cvlo(const u32x4 u) { return (f32x4){bflo(u.x), bfhi(u.x), bflo(u.y), bfhi(u.y)}; }
__device__ __forceinline__ f32x4 cvhi(const u32x4 u) { return (f32x4){bflo(u.z), bfhi(u.z), bflo(u.w), bfhi(u.w)}; }
__device__ __forceinline__ u32x4 pk8(const f32x4 lo, const f32x4 hi) { u32x4 w; w.x = pk2(lo.x, lo.y); w.y = pk2(lo.z, lo.w); w.z = pk2(hi.x, hi.y); w.w = pk2(hi.z, hi.w); return w; }

namespace ck {
constexpr int PS = 136;
constexpr int O_BT = 0, O_KT = 8704, O_AP = 17408, O_RT = 26112;
constexpr int O_AT = 34816, O_BH = 43008, O_KH = 51200, O_VV = 59392, O_TN = 67584, O_A2 = 75776, O_V2 = 83968;
constexpr int O_L = 92160, LSTR = 68;
constexpr int O_TOT = 109568, O_GC = 111616;
constexpr int O_PT = 132608;
constexpr int O_ACT = 112128;
__device__ __forceinline__ int crow(int r, int hi) { return (r & 3) + 8 * (r >> 2) + 4 * hi; }
__device__ __forceinline__ int voff(int row, int col) { return ((col >> 5) * 4 + (row >> 4)) * 1024 + (row & 15) * 64 + (col & 31) * 2; }
__device__ __forceinline__ s16x4 vtr(const LAS unsigned char* p) { return __builtin_bit_cast(s16x4, __builtin_amdgcn_ds_read_tr16_b64_v4i16((LAS s16x4*)p)); }
__device__ __forceinline__ bf16x8 fragP(const LAS unsigned char* M, int row, int k0, int hi) {
    const LAS unsigned char* p = M + row * PS + (k0 + 4 * hi) * 2; const s16x4 lo = *(const LAS s16x4*)p, h = *(const LAS s16x4*)(p + 16);
    return (bf16x8){lo[0], lo[1], lo[2], lo[3], h[0], h[1], h[2], h[3]}; }
__device__ __forceinline__ bf16x8 fragT(const LAS unsigned char* M, int k0, int colblk, int lane, int hi) {
    const LAS unsigned char* p = M + (colblk * 4 + (k0 >> 4)) * 1024 + ((lane >> 4) & 1) * 32 + (lane & 3) * 8 + (4 * hi + ((lane & 15) >> 2)) * 64;
    const s16x4 lo = vtr(p), h = vtr(p + 512); return (bf16x8){lo[0], lo[1], lo[2], lo[3], h[0], h[1], h[2], h[3]}; }
__device__ __forceinline__ bf16x8 packR(const f32x16& x, int s) {
    u32x4 w; w.x = pk2(x[8 * s], x[8 * s + 1]); w.y = pk2(x[8 * s + 2], x[8 * s + 3]); w.z = pk2(x[8 * s + 4], x[8 * s + 5]); w.w = pk2(x[8 * s + 6], x[8 * s + 7]); return __builtin_bit_cast(bf16x8, w); }
#define CK_MFMA(a, b, c) __builtin_amdgcn_mfma_f32_32x32x16_bf16(a, b, c, 0, 0, 0)
__device__ __forceinline__ f32x16 score(const LAS unsigned char* Am, const LAS unsigned char* Bm, int sblk, int tblk, int mode, int r32, int hi) {
    f32x16 x = f32x16{};
#pragma unroll
    for (int ks = 0; ks < 4; ++ks) x = CK_MFMA(fragP(Am, sblk * 32 + r32, 16 * ks, hi), fragP(Bm, tblk * 32 + r32, 16 * ks, hi), x);
    if (mode) {
        const int t = tblk * 32 + r32;
#pragma unroll
        for (int r = 0; r < 16; ++r) { const int s = sblk * 32 + crow(r, hi); if (mode == 1 ? !(s < t) : !(s <= t)) x[r] = 0.f; }
    }
    return x;
}
__device__ __forceinline__ void storeT_V(LAS unsigned char* M, const f32x16& x, int rb, int c, int hi) {
#pragma unroll
    for (int q = 0; q < 4; ++q) { u32x2 w; w.x = pk2(x[4 * q], x[4 * q + 1]); w.y = pk2(x[4 * q + 2], x[4 * q + 3]); *(LAS u32x2*)(M + voff(c, rb * 32 + 8 * q + 4 * hi)) = w; }
}
__device__ __forceinline__ void storeT_S(LAS unsigned char* M, const f32x16& x, int rb, int c, int hi) {
#pragma unroll
    for (int q = 0; q < 4; ++q) { u32x2 w; w.x = pk2(x[4 * q], x[4 * q + 1]); w.y = pk2(x[4 * q + 2], x[4 * q + 3]); *(LAS u32x2*)(M + c * PS + (rb * 32 + 8 * q + 4 * hi) * 2) = w; }
}

__device__ __forceinline__ void chunk_item(LAS unsigned char* lds, const Args& a, int item) {
    int tid = threadIdx.x; asm volatile("" : "+v"(tid)); int lane = tid & 63; const int wave = __builtin_amdgcn_readfirstlane(tid >> 6);
#define CK_FRESH() asm volatile("" : "+v"(lane)); r32 = lane & 31; hi = lane >> 5
    int r32, hi; CK_FRESH();
    unsigned char* ws = a.ws;
    const bf16_t* SR = (const bf16_t*)(ws + WS_SR); const bf16_t* SK = (const bf16_t*)(ws + WS_SK); const bf16_t* SV = (const bf16_t*)(ws + WS_SV);
    const bf16_t* SA = (const bf16_t*)(ws + WS_SA); const bf16_t* SB = (const bf16_t*)(ws + WS_SB); const float* SW = (const float*)(ws + WS_SW);
    bf16_t* CG = (bf16_t*)(ws + WS_CG) + (size_t)item * 4096; bf16_t* CH = (bf16_t*)(ws + WS_CH) + (size_t)item * 4096;
    bf16_t* CR2 = (bf16_t*)(ws + WS_CR2) + (size_t)item * 4096; bf16_t* CY0 = (bf16_t*)(ws + WS_CY0) + (size_t)item * 4096;
    const int bh = item >> 6, c = item & 63, b = bh >> 3, h = bh & 7, tokc = b * SEQ + c * 64, col0 = h * 64;
    LAS unsigned char* BT = lds + O_BT; LAS unsigned char* KT = lds + O_KT; LAS unsigned char* AP = lds + O_AP; LAS unsigned char* RT = lds + O_RT;
    LAS unsigned char* AT = lds + O_AT; LAS unsigned char* BH = lds + O_BH; LAS unsigned char* KH = lds + O_KH; LAS unsigned char* VV = lds + O_VV;
    LAS unsigned char* TN = lds + O_TN; LAS unsigned char* A2M = lds + O_A2; LAS unsigned char* V2M = lds + O_V2;
    LAS float* L = (LAS float*)(lds + O_L); LAS float* TOT = (LAS float*)(lds + O_TOT); LAS float* GC = (LAS float*)(lds + O_GC);
    {
        const int tl = tid >> 3, c8 = (tid & 7) * 8, cr = col0 + c8, t = tokc + tl;
        const bf16_t* P = (const bf16_t*)(ws + WS_P); const bf16_t* pr = P + (size_t)t * NINP + cr;
        bf16_t* SVo = (bf16_t*)(ws + WS_SV); bf16_t* SGo = (bf16_t*)(ws + WS_SG); bf16_t* QN = (bf16_t*)(ws + WS_QN); bf16_t* KN = (bf16_t*)(ws + WS_KN);
        const LAS float* PT = (const LAS float*)(lds + O_PT);
        const bool first = (t & (SEQ - 1)) == 0; const u32x4 zz = (u32x4){0u, 0u, 0u, 0u};
#define CK_PK8(v) ((u32x4){pk2(v[0], v[1]), pk2(v[2], v[3]), pk2(v[4], v[5]), pk2(v[6], v[7])})
#define CK_ST_P(M, val_) do { LAS unsigned char* d_ = (M) + tl * PS + c8 * 2; const u32x4 q_ = (val_); *(LAS u32x2*)d_ = (u32x2){q_[0], q_[1]}; *(LAS u32x2*)(d_ + 8) = (u32x2){q_[2], q_[3]}; } while (0)
        const u32x4 cu_r = *(const u32x4*)(pr), pu_r = first ? zz : *(const u32x4*)(pr - NINP);
        const u32x4 cu_v = *(const u32x4*)(pr + 1024), pu_v = first ? zz : *(const u32x4*)(pr - NINP + 1024);
        const u32x4 cu_k = *(const u32x4*)(pr + 512), pu_k = first ? zz : *(const u32x4*)(pr - NINP + 512);
        const u32x4 uq = *(const u32x4*)(pr + DQ0), ukd = *(const u32x4*)(pr + DK0);
        __builtin_amdgcn_sched_barrier(0);
        float g[8], gp[8], ig[8], gC[8];
        {
            const u32x4 deu = *(const LAS u32x4*)(TN + tl * 128 + c8 * 2); const f32x4 de0 = cvlo(deu), de1 = cvhi(deu);
            float wv[8] = {__builtin_amdgcn_exp2f(de0.x), __builtin_amdgcn_exp2f(de0.y), __builtin_amdgcn_exp2f(de0.z), __builtin_amdgcn_exp2f(de0.w), __builtin_amdgcn_exp2f(de1.x), __builtin_amdgcn_exp2f(de1.y), __builtin_amdgcn_exp2f(de1.z), __builtin_amdgcn_exp2f(de1.w)};
            float p[8];
#pragma unroll
            for (int j = 0; j < 8; ++j) p[j] = wv[j];
#pragma unroll
            for (int d = 8; d < 64; d <<= 1) {
#pragma unroll
                for (int j = 0; j < 8; ++j) { const float q = __shfl_up(p[j], d); if (lane >= d) p[j] *= q; }
            }
            if ((lane >> 3) == 7) { *(LAS f32x4*)(TOT + wave * 64 + c8) = (f32x4){p[0], p[1], p[2], p[3]}; *(LAS f32x4*)(TOT + wave * 64 + c8 + 4) = (f32x4){p[4], p[5], p[6], p[7]}; }
            __syncthreads();
            float pre[8];
#pragma unroll
            for (int j = 0; j < 8; ++j) { pre[j] = 1.f; gC[j] = 1.f; }
#pragma unroll
            for (int w2 = 0; w2 < 8; ++w2) { const f32x4 t0 = *(const LAS f32x4*)(TOT + w2 * 64 + c8), t1 = *(const LAS f32x4*)(TOT + w2 * 64 + c8 + 4);
                const float tv[8] = {t0.x, t0.y, t0.z, t0.w, t1.x, t1.y, t1.z, t1.w};
#pragma unroll
                for (int j = 0; j < 8; ++j) { if (w2 < wave) pre[j] *= tv[j]; gC[j] *= tv[j]; } }
            if (tid < 8) { *(LAS f32x4*)(GC + c8) = (f32x4){gC[0], gC[1], gC[2], gC[3]}; *(LAS f32x4*)(GC + c8 + 4) = (f32x4){gC[4], gC[5], gC[6], gC[7]}; }
#pragma unroll
            for (int j = 0; j < 8; ++j) { g[j] = pre[j] * p[j]; ig[j] = __builtin_amdgcn_rcpf(g[j]); gp[j] = g[j] * __builtin_amdgcn_rcpf(wv[j]); }
        }
        f32x4 r0, r1;
        { const u32x4 cu = cu_r, pu = pu_r;
          const f32x4 m0 = *(const LAS f32x4*)(PT + cr), m1 = *(const LAS f32x4*)(PT + cr + 4); const f32x4 c0 = cvlo(cu), c1 = cvhi(cu), p0 = cvlo(pu), p1 = cvhi(pu);
          r0 = c0 + (p0 - c0) * m0; r1 = c1 + (p1 - c1) * m1;
          const float rt[8] = {r0.x * g[0], r0.y * g[1], r0.z * g[2], r0.w * g[3], r1.x * g[4], r1.y * g[5], r1.z * g[6], r1.w * g[7]};
          CK_ST_P(RT, CK_PK8(rt)); }
        { const u32x4 cu = cu_v, pu = pu_v;
          const f32x4 m0 = *(const LAS f32x4*)(PT + 1024 + cr), m1 = *(const LAS f32x4*)(PT + 1024 + cr + 4); const f32x4 c0 = cvlo(cu), c1 = cvhi(cu), p0 = cvlo(pu), p1 = cvhi(pu);
          const u32x4 uv = pk8(c0 + (p0 - c0) * m0, c1 + (p1 - c1) * m1); *(u32x4*)(SVo + (size_t)t * CW + cr) = uv; *(LAS u32x4*)(VV + voff(tl, c8)) = uv; }
        *(u32x4*)(SGo + (size_t)t * CW + cr) = *(const LAS u32x4*)(V2M + tl * 128 + c8 * 2);
        { const u32x4 cu = cu_k, pu = pu_k;
          const f32x4 m0 = *(const LAS f32x4*)(PT + 512 + cr), m1 = *(const LAS f32x4*)(PT + 512 + cr + 4); const f32x4 c0 = cvlo(cu), c1 = cvhi(cu), p0 = cvlo(pu), p1 = cvhi(pu);
          const f32x4 k0 = c0 + (p0 - c0) * m0, k1 = c1 + (p1 - c1) * m1;
          const u32x4 alu = *(const LAS u32x4*)(A2M + tl * 128 + c8 * 2); const f32x4 al0 = cvlo(alu), al1 = cvhi(alu);
          const f32x4 kk0 = k0 * *(const LAS f32x4*)(PT + 1536 + cr), kk1 = k1 * *(const LAS f32x4*)(PT + 1536 + cr + 4);
          const float ss = red8((kk0.x * kk0.x + kk0.y * kk0.y) + (kk0.z * kk0.z + kk0.w * kk0.w) + (kk1.x * kk1.x + kk1.y * kk1.y) + (kk1.z * kk1.z + kk1.w * kk1.w));
          const float inv = 1.0f / sqrtf(fmaxf(ss, 1e-24f));
          const f32x4 kn0 = kk0 * inv, kn1 = kk1 * inv;
          const f32x4 k20 = k0 * (1.0f + (al0 - 1.0f) * *(const LAS f32x4*)(PT + 2048 + cr)), k21 = k1 * (1.0f + (al1 - 1.0f) * *(const LAS f32x4*)(PT + 2048 + cr + 4));
          { const f32x4 q0 = r0 * k20 * *(const LAS f32x4*)(PT + 2560 + cr), q1 = r1 * k21 * *(const LAS f32x4*)(PT + 2560 + cr + 4);
            const float rk = red8((q0.x + q0.y) + (q0.z + q0.w) + (q1.x + q1.y) + (q1.z + q1.w));
            if ((lane & 7) == 0) ((float*)(ws + WS_RK))[(size_t)t * 8 + h] = rk; }
          const float kv[8] = {k20.x, k20.y, k20.z, k20.w, k21.x, k21.y, k21.z, k21.w}, nv[8] = {kn0.x, kn0.y, kn0.z, kn0.w, kn1.x, kn1.y, kn1.z, kn1.w}, av_[8] = {al0.x, al0.y, al0.z, al0.w, al1.x, al1.y, al1.z, al1.w};
          float at[8], bt[8], kt[8], bh[8], kh[8];
#pragma unroll
          for (int j = 0; j < 8; ++j) { at[j] = -nv[j] * gp[j]; bt[j] = nv[j] * av_[j] * ig[j]; kt[j] = kv[j] * ig[j]; bh[j] = bt[j] * gC[j]; kh[j] = kt[j] * gC[j]; }
          const u32x4 wa = CK_PK8(at);
          CK_ST_P(AP, wa); *(LAS u32x4*)(AT + voff(tl, c8)) = wa;
          CK_ST_P(BT, CK_PK8(bt)); CK_ST_P(KT, CK_PK8(kt));
          *(LAS u32x4*)(BH + voff(tl, c8)) = CK_PK8(bh); *(LAS u32x4*)(KH + voff(tl, c8)) = CK_PK8(kh); }
        {
          const f32x4 q0 = cvlo(uq), q1 = cvhi(uq), d0 = cvlo(ukd), d1 = cvhi(ukd);
          const float qs = red8((q0.x * q0.x + q0.y * q0.y) + (q0.z * q0.z + q0.w * q0.w) + (q1.x * q1.x + q1.y * q1.y) + (q1.z * q1.z + q1.w * q1.w));
          const float ks = red8((d0.x * d0.x + d0.y * d0.y) + (d0.z * d0.z + d0.w * d0.w) + (d1.x * d1.x + d1.y * d1.y) + (d1.z * d1.z + d1.w * d1.w));
          const float qi = (1.0f / sqrtf(qs * (1.0f / 64.0f) + 1e-5f)) * (0.125f * LOG2E), ki = 1.0f / sqrtf(ks * (1.0f / 64.0f) + 1e-5f);
          const f32x4 g0 = *(const LAS f32x4*)(PT + 3072 + c8), g1 = *(const LAS f32x4*)(PT + 3072 + c8 + 4), h0 = *(const LAS f32x4*)(PT + 3136 + c8), h1 = *(const LAS f32x4*)(PT + 3136 + c8 + 4);
          *(u32x4*)(QN + (size_t)t * CW + cr) = pk8(q0 * qi * g0, q1 * qi * g1);
          const size_t ko = ((((size_t)(b * 8 + h) * 64 + c) * 8 + (c8 >> 3)) * 64 + tl) * 8;
          *(u32x4*)(KN + ko) = pk8(d0 * ki * h0, d1 * ki * h1); }
#undef CK_PK8
#undef CK_ST_P
    }
    __syncthreads();
    CK_FRESH();
    f32x16 pa = f32x16{}, pb = f32x16{}, pc = f32x16{}, pd = f32x16{};
#define w1a pa
#define w1b pb
#define xb0 pa
#define xb1 pb
#define y0a pc
#define y0b pd
    if (wave < 2) {
        for (int k = 0; k < (wave == 0 ? 2 : 1); ++k) {
            const int sblk = wave == 0 ? k : 0, tblk = wave == 0 ? k : 1;
            const f32x16 x = score(BT, AP, sblk, tblk, wave == 0 ? 1 : 0, r32, hi);
            const int t = tblk * 32 + r32;
#pragma unroll
            for (int r = 0; r < 16; ++r) L[(sblk * 32 + crow(r, hi)) * LSTR + t] = x[r];
        }
    }
    __syncthreads();
    CK_FRESH();
    if (wave == 6) {
        float x[32];
#pragma unroll
        for (int t = 0; t < 32; ++t) x[t] = (r32 == t) ? 1.f : 0.f;
        const LAS float* Nr = L + (32 * hi) * LSTR + 32 * hi;
#pragma unroll
        for (int sidx = 0; sidx < 31; ++sidx) {
#pragma unroll
            for (int g4 = (sidx + 1) / 4; g4 < 8; ++g4) {
                const f32x4 nv = *(const LAS f32x4*)(Nr + sidx * LSTR + 4 * g4);
                if (4 * g4 + 0 > sidx) x[4 * g4 + 0] += nv.x * x[sidx];
                if (4 * g4 + 1 > sidx) x[4 * g4 + 1] += nv.y * x[sidx];
                if (4 * g4 + 2 > sidx) x[4 * g4 + 2] += nv.z * x[sidx];
                if (4 * g4 + 3 > sidx) x[4 * g4 + 3] += nv.w * x[sidx];
            }
            if ((sidx & 3) == 3) __builtin_amdgcn_sched_barrier(0);
        }
        const int cc = 32 * hi + r32;
#pragma unroll
        for (int t0 = 0; t0 < 32; t0 += 8) { u32x4 w; w.x = pk2(x[t0], x[t0 + 1]); w.y = pk2(x[t0 + 2], x[t0 + 3]); w.z = pk2(x[t0 + 4], x[t0 + 5]); w.w = pk2(x[t0 + 6], x[t0 + 7]);
            *(LAS u32x4*)(TN + voff(cc, 32 * hi + t0)) = w; }
        f32x16 m = f32x16{};
#pragma unroll
        for (int s = 0; s < 2; ++s) {
            const LAS float* lp = L + (16 * s + 4 * hi) * LSTR + 32 + r32;
            u32x4 aw; aw.x = pk2(lp[0], lp[LSTR]); aw.y = pk2(lp[2 * LSTR], lp[3 * LSTR]); aw.z = pk2(lp[8 * LSTR], lp[9 * LSTR]); aw.w = pk2(lp[10 * LSTR], lp[11 * LSTR]);
            const s16x4 b0 = *(const LAS s16x4*)(TN + voff(r32, 16 * s + 4 * hi)), b1 = *(const LAS s16x4*)(TN + voff(r32, 16 * s + 8 + 4 * hi));
            m = CK_MFMA(__builtin_bit_cast(bf16x8, aw), ((bf16x8){b0[0], b0[1], b0[2], b0[3], b1[0], b1[1], b1[2], b1[3]}), m);
        }
        f32x16 t21 = f32x16{};
#pragma unroll
        for (int s = 0; s < 2; ++s) t21 = CK_MFMA(fragT(TN, 32 + 16 * s, 1, lane, hi), packR(m, s), t21);
        storeT_V(TN, t21, 1, r32, hi);
    } else if (wave < 4) {
        const int dvb = wave - 2;
        const f32x16 x00 = score(KT, AP, 0, 0, 1, r32, hi), x01 = score(KT, AP, 0, 1, 0, r32, hi), x11 = score(KT, AP, 1, 1, 1, r32, hi);
#pragma unroll
        for (int s = 0; s < 2; ++s) {
            const bf16x8 v0 = fragT(VV, 16 * s, dvb, lane, hi), v1 = fragT(VV, 32 + 16 * s, dvb, lane, hi);
            w1a = CK_MFMA(packR(x00, s), v0, w1a);
            w1b = CK_MFMA(packR(x01, s), v0, w1b);
            w1b = CK_MFMA(packR(x11, s), v1, w1b);
        }
    } else if (wave < 6) {
        const int tb = wave - 4;
        f32x16 xk0, xk1 = f32x16{};
        if (tb == 0) { xk0 = score(KT, RT, 0, 0, 2, r32, hi); xb0 = score(BT, RT, 0, 0, 2, r32, hi); }
        else { xk0 = score(KT, RT, 0, 1, 0, r32, hi); xk1 = score(KT, RT, 1, 1, 2, r32, hi); xb0 = score(BT, RT, 0, 1, 0, r32, hi); xb1 = score(BT, RT, 1, 1, 2, r32, hi); }
#pragma unroll
        for (int s = 0; s < 2; ++s) {
            y0a = CK_MFMA(fragT(VV, 16 * s, 0, lane, hi), packR(xk0, s), y0a);
            y0b = CK_MFMA(fragT(VV, 16 * s, 1, lane, hi), packR(xk0, s), y0b);
            if (tb == 1) { y0a = CK_MFMA(fragT(VV, 32 + 16 * s, 0, lane, hi), packR(xk1, s), y0a); y0b = CK_MFMA(fragT(VV, 32 + 16 * s, 1, lane, hi), packR(xk1, s), y0b); }
        }
    }
    __syncthreads();
    CK_FRESH();
    if (wave < 2) {
        const int cb = wave; f32x16 a0 = f32x16{}, a1 = f32x16{};
#pragma unroll
        for (int ks = 0; ks < 4; ++ks) {
            const bf16x8 af = fragT(AT, 16 * ks, cb, lane, hi);
            if (ks < 2) a0 = CK_MFMA(af, fragT(TN, 16 * ks, 0, lane, hi), a0);
            a1 = CK_MFMA(af, fragT(TN, 16 * ks, 1, lane, hi), a1);
        }
        storeT_V(A2M, a0, cb, r32, hi); storeT_V(A2M, a1, cb, 32 + r32, hi);
    } else if (wave < 4) {
        const int dvb = wave - 2; f32x16 v0 = f32x16{}, v1 = f32x16{};
#pragma unroll
        for (int s = 0; s < 2; ++s) {
            v0 = CK_MFMA(packR(w1a, s), fragT(TN, 16 * s, 0, lane, hi), v0);
            v1 = CK_MFMA(packR(w1a, s), fragT(TN, 16 * s, 1, lane, hi), v1);
            v1 = CK_MFMA(packR(w1b, s), fragT(TN, 32 + 16 * s, 1, lane, hi), v1);
        }
        storeT_V(V2M, v0, dvb, r32, hi); storeT_V(V2M, v1, dvb, 32 + r32, hi);
    }
    __syncthreads();
    CK_FRESH();
    if (wave >= 4 && wave < 6) {
        const int tb = wave - 4, t = tb * 32 + r32;
        f32x16 r0 = f32x16{}, r1 = f32x16{};
#pragma unroll
        for (int s = 0; s < 2; ++s) {
            const bf16x8 p0 = packR(xb0, s);
            r0 = CK_MFMA(fragT(A2M, 16 * s, 0, lane, hi), p0, r0); r1 = CK_MFMA(fragT(A2M, 16 * s, 1, lane, hi), p0, r1);
            y0a = CK_MFMA(fragT(V2M, 16 * s, 0, lane, hi), p0, y0a); y0b = CK_MFMA(fragT(V2M, 16 * s, 1, lane, hi), p0, y0b);
            if (tb == 1) { const bf16x8 p1 = packR(xb1, s);
                r0 = CK_MFMA(fragT(A2M, 32 + 16 * s, 0, lane, hi), p1, r0); r1 = CK_MFMA(fragT(A2M, 32 + 16 * s, 1, lane, hi), p1, r1);
                y0a = CK_MFMA(fragT(V2M, 32 + 16 * s, 0, lane, hi), p1, y0a); y0b = CK_MFMA(fragT(V2M, 32 + 16 * s, 1, lane, hi), p1, y0b); }
        }
#pragma unroll
        for (int q = 0; q < 4; ++q) {
            const u32x2 u0 = *(const LAS u32x2*)(RT + t * PS + (8 * q + 4 * hi) * 2), u1 = *(const LAS u32x2*)(RT + t * PS + (32 + 8 * q + 4 * hi) * 2);
            r0[4 * q] += bflo(u0.x); r0[4 * q + 1] += bfhi(u0.x); r0[4 * q + 2] += bflo(u0.y); r0[4 * q + 3] += bfhi(u0.y);
            r1[4 * q] += bflo(u1.x); r1[4 * q + 1] += bfhi(u1.x); r1[4 * q + 2] += bflo(u1.y); r1[4 * q + 3] += bfhi(u1.y);
        }
        storeT_S(BT, r0, 0, t, hi); storeT_S(BT, r1, 1, t, hi);
        storeT_S(KT, y0a, 0, t, hi); storeT_S(KT, y0b, 1, t, hi);
    } else if (wave < 2) {
        const int ib = wave, i = ib * 32 + r32; const float gci = GC[i];
        f32x16 g0 = f32x16{}, g1 = f32x16{};
#pragma unroll
        for (int ks = 0; ks < 4; ++ks) { const bf16x8 bf_ = fragT(BH, 16 * ks, ib, lane, hi);
            g0 = CK_MFMA(fragT(A2M, 16 * ks, 0, lane, hi), bf_, g0); g1 = CK_MFMA(fragT(A2M, 16 * ks, 1, lane, hi), bf_, g1); }
#pragma unroll
        for (int r = 0; r < 16; ++r) { if (crow(r, hi) == i) g0[r] += gci; if (32 + crow(r, hi) == i) g1[r] += gci; }
        storeT_S(AP, g0, 0, i, hi); storeT_S(AP, g1, 1, i, hi);
    } else {
        const int id = wave < 4 ? wave - 2 : wave - 4, ib = id >> 1, dvb = id & 1;
        f32x16 hh = f32x16{};
#pragma unroll
        for (int ks = 0; ks < 4; ++ks) {
            hh = CK_MFMA(fragT(BH, 16 * ks, ib, lane, hi), fragT(V2M, 16 * ks, dvb, lane, hi), hh);
            hh = CK_MFMA(fragT(KH, 16 * ks, ib, lane, hi), fragT(VV, 16 * ks, dvb, lane, hi), hh);
        }
        storeT_S((LAS unsigned char*)L, hh, ib, dvb * 32 + r32, hi);
    }
    __syncthreads();
    {
        asm volatile("" : "+v"(tid));
        const int row = tid >> 3, ch = tid & 7;
        const LAS unsigned char* s0 = BT + row * PS + ch * 16; const LAS unsigned char* s1 = KT + row * PS + ch * 16; const LAS unsigned char* s2 = AP + row * PS + ch * 16; const LAS unsigned char* s3 = (const LAS unsigned char*)L + row * PS + ch * 16;
        const u32x2 a0 = *(const LAS u32x2*)s0, a1 = *(const LAS u32x2*)(s0 + 8), b0 = *(const LAS u32x2*)s1, b1 = *(const LAS u32x2*)(s1 + 8);
        const u32x2 c0 = *(const LAS u32x2*)s2, c1 = *(const LAS u32x2*)(s2 + 8), d0 = *(const LAS u32x2*)s3, d1 = *(const LAS u32x2*)(s3 + 8);
        *(u32x4*)(CR2 + row * 64 + ch * 8) = (u32x4){a0.x, a0.y, a1.x, a1.y}; *(u32x4*)(CY0 + row * 64 + ch * 8) = (u32x4){b0.x, b0.y, b1.x, b1.y};
        *(u32x4*)(CG + row * 64 + ch * 8) = (u32x4){c0.x, c0.y, c1.x, c1.y}; *(u32x4*)(CH + row * 64 + ch * 8) = (u32x4){d0.x, d0.y, d1.x, d1.y};
    }
    asm volatile("s_waitcnt lgkmcnt(0)" ::: "memory"); __builtin_amdgcn_s_barrier();
#undef CK_FRESH
#undef w1a
#undef w1b
#undef xb0
#undef xb1
#undef y0a
#undef y0b
}

__device__ __forceinline__ void fused_item(LAS unsigned char* lds, const Args& a, int bc) {
    const int tid = threadIdx.x, lane = tid & 63; const int wave = __builtin_amdgcn_readfirstlane(tid >> 6);
    unsigned char* ws = a.ws;
    const bf16_t* P = (const bf16_t*)(ws + WS_P); const bf16_t* LW = (const bf16_t*)(ws + WS_LW); const float* mu = a.in[3];
    const int b = bc >> 6, c = bc & 63, tokc = b * SEQ + c * 64;
    LAS unsigned char* ACT = lds + O_ACT; LAS unsigned char* DECb = lds + O_TN; LAS unsigned char* ALRb = lds + O_A2; LAS unsigned char* GGb = lds + O_V2;
    {
        LAS float* PT = (LAS float*)(lds + O_PT);
        for (int i = tid; i < 3200; i += 512) {
            const float v = i < 1536 ? mu[i] : (i < 2048 ? a.in[9][i - 1536] : (i < 2560 ? a.in[10][i - 2048] : (i < 3072 ? a.in[11][i - 2560] : (i < 3136 ? a.in[14][i - 3072] : a.in[15][i - 3136]))));
            PT[i] = v; }
    }
    {
        u32x4 cu_[3], pu_[3]; f32x4 m0_[3], m1_[3];
#pragma unroll
        for (int j = 0; j < 3; ++j) {
            const int it = tid + 512 * j; cu_[j] = (u32x4){0u, 0u, 0u, 0u}; pu_[j] = (u32x4){0u, 0u, 0u, 0u}; m0_[j] = (f32x4){0.f, 0.f, 0.f, 0.f}; m1_[j] = m0_[j];
            if (it < 1280) {
                const int tok = it / 20, ch = it - tok * 20, t = tokc + tok, col = 1536 + ch * 8;
                cu_[j] = *(const u32x4*)(P + (size_t)t * NINP + col);
                if (t & (SEQ - 1)) pu_[j] = *(const u32x4*)(P + (size_t)(t - 1) * NINP + col);
                m0_[j] = *(const f32x4*)(mu + col); m1_[j] = *(const f32x4*)(mu + col + 4); }
        }
        __builtin_amdgcn_sched_barrier(0);
#pragma unroll
        for (int j = 0; j < 3; ++j) {
            const int it = tid + 512 * j;
            if (it < 1280) {
                const int tok = it / 20, ch = it - tok * 20;
                const f32x4 c0 = cvlo(cu_[j]), c1 = cvhi(cu_[j]), p0 = cvlo(pu_[j]), p1 = cvhi(pu_[j]);
                f32x4 s0 = c0 + (p0 - c0) * m0_[j], s1 = c1 + (p1 - c1) * m1_[j];
                if (ch < 4) {
#pragma unroll
                    for (int i = 0; i < 4; ++i) { const float e0 = __expf(-2.0f * fabsf(s0[i])), e1 = __expf(-2.0f * fabsf(s1[i])); const float th0 = (1.0f - e0) / (1.0f + e0), th1 = (1.0f - e1) / (1.0f + e1);
                        s0[i] = s0[i] < 0.f ? -th0 : th0; s1[i] = s1[i] < 0.f ? -th1 : th1; }
                } else if (ch >= 8) {
#pragma unroll
                    for (int i = 0; i < 4; ++i) { s0[i] = sigmoidf_(s0[i]); s1[i] = sigmoidf_(s1[i]); }
                }
                *(LAS u32x4*)(ACT + tok * 320 + ch * 16) = pk8(s0, s1);
            }
        }
    }
    __syncthreads();
#pragma clang loop unroll(disable)
    for (int h = 0; h < 8; ++h) {
        {
            int ln = lane; asm volatile("" : "+v"(ln));
            const int mt = wave >> 1, fcol = ln & 15, fq = ln >> 4;
            bf16x8 wf[2][5]; float w0c[2], a0c[2];
#pragma unroll
            for (int cbi = 0; cbi < 2; ++cbi) { const int col = h * 64 + ((wave & 1) * 2 + cbi) * 16 + fcol; const bf16_t* lw = LW + (size_t)col * 160 + fq * 8;
#pragma unroll
                for (int kb = 0; kb < 5; ++kb) wf[cbi][kb] = *(const bf16x8*)(lw + 32 * kb);
                w0c[cbi] = a.in[4][col]; a0c[cbi] = a.in[6][col]; }
            bf16x8 af[5];
#pragma unroll
            for (int kb = 0; kb < 5; ++kb) af[kb] = *(const LAS bf16x8*)(ACT + (mt * 16 + fcol) * 320 + kb * 64 + fq * 16);
            __builtin_amdgcn_sched_barrier(0);
#pragma unroll
            for (int cbi = 0; cbi < 2; ++cbi) {
                const int cb = (wave & 1) * 2 + cbi;
                const f32x4 z = {0.f, 0.f, 0.f, 0.f};
                const f32x4 aw = __builtin_amdgcn_mfma_f32_16x16x32_bf16(af[0], wf[cbi][0], z, 0, 0, 0);
                const f32x4 aa = __builtin_amdgcn_mfma_f32_16x16x32_bf16(af[1], wf[cbi][1], z, 0, 0, 0);
                f32x4 ag = __builtin_amdgcn_mfma_f32_16x16x32_bf16(af[2], wf[cbi][2], z, 0, 0, 0);
                ag = __builtin_amdgcn_mfma_f32_16x16x32_bf16(af[3], wf[cbi][3], ag, 0, 0, 0);
                ag = __builtin_amdgcn_mfma_f32_16x16x32_bf16(af[4], wf[cbi][4], ag, 0, 0, 0);
#pragma unroll
                for (int i = 0; i < 4; ++i) { const int off = (mt * 16 + fq * 4 + i) * 128 + (cb * 16 + fcol) * 2;
                    *(LAS unsigned short*)(DECb + off) = (unsigned short)f2bf(-0.8750325887f * sigmoidf_(aw[i] + w0c[cbi]));
                    *(LAS unsigned short*)(ALRb + off) = (unsigned short)f2bf(sigmoidf_(aa[i] + a0c[cbi]));
                    *(LAS unsigned short*)(GGb + off) = (unsigned short)f2bf(ag[i]); }
            }
        }
        __syncthreads();
        chunk_item(lds, a, ((b * 8 + h) << 6) + c);
    }
}
}

namespace ck {
constexpr int SQ_MAT = 8704, SQ_BUF = 6 * SQ_MAT;
constexpr int SQ_OUT = 2 * SQ_BUF;
__device__ __forceinline__ bf16x8 lfrag(const LAS unsigned char* M, int row, int k0, int hi) { return fragP(M, row, k0, hi); }
__device__ __forceinline__ void linit(f32x16& x, const LAS unsigned char* M, int row, int cblk, int hi) {
#pragma unroll
    for (int q = 0; q < 4; ++q) { const u32x2 u = *(const LAS u32x2*)(M + row * PS + (cblk * 32 + 8 * q + 4 * hi) * 2); x[4 * q] = bflo(u.x); x[4 * q + 1] = bfhi(u.x); x[4 * q + 2] = bflo(u.y); x[4 * q + 3] = bfhi(u.y); }
}
__device__ __forceinline__ void seq_head(LAS unsigned char* lds, const Args& a, int bh) {
    const int tid = threadIdx.x, lane = tid & 63, r32 = lane & 31, hi = lane >> 5; const int wave = __builtin_amdgcn_readfirstlane(tid >> 6);
    unsigned char* ws = a.ws;
    const bf16_t* SV = (const bf16_t*)(ws + WS_SV); const bf16_t* SG = (const bf16_t*)(ws + WS_SG); const float* RK = (const float*)(ws + WS_RK); bf16_t* YMIX = (bf16_t*)(ws + WS_YMIX);
    const int b = bh >> 3, h = bh & 7, col0 = h * 64;
    const float* lng = a.in[12] + col0; const float* lnb = a.in[13] + col0;
    const int lw = wave - 2;
    const bf16_t* lsrc; int lpitch;
    { const size_t it0 = (size_t)bh * 64 * 4096; const size_t tk0 = (size_t)b * SEQ * CW + col0;
      lsrc = lw == 0 ? (const bf16_t*)(ws + WS_CG) + it0 : lw == 1 ? (const bf16_t*)(ws + WS_CH) + it0 : lw == 2 ? (const bf16_t*)(ws + WS_CR2) + it0 : lw == 3 ? (const bf16_t*)(ws + WS_CY0) + it0 : lw == 4 ? SV + tk0 : SG + tk0;
      lpitch = lw < 4 ? 64 : CW; }
#define SQ_LOAD(ch) do { const bf16_t* s_ = lsrc + (size_t)(ch) * 64 * lpitch; LAS unsigned char* bb_ = lds + ((ch) & 1) * SQ_BUF + lw * SQ_MAT; u32x4 v_[8]; \
        _Pragma("unroll") for (int i_ = 0; i_ < 8; ++i_) { const int q_ = lane + 64 * i_; v_[i_] = *(const u32x4*)(s_ + (size_t)(q_ >> 3) * lpitch + (q_ & 7) * 8); } \
        _Pragma("unroll") for (int i_ = 0; i_ < 8; ++i_) { const int q_ = lane + 64 * i_; LAS unsigned char* d_ = bb_ + (q_ >> 3) * PS + (q_ & 7) * 16; *(LAS u32x2*)d_ = (u32x2){v_[i_].x, v_[i_].y}; *(LAS u32x2*)(d_ + 8) = (u32x2){v_[i_].z, v_[i_].w}; } } while (0)
#define SQ_STORE(ch) do { const LAS unsigned char* ob_ = lds + SQ_OUT + ((ch) & 1) * SQ_MAT; const size_t t0_ = (size_t)b * SEQ + (ch) * 64; \
        for (int p_ = tid - 128; p_ < 512; p_ += 384) { const int row_ = p_ >> 3, c8_ = (p_ & 7) * 8; const LAS unsigned char* s_ = ob_ + row_ * PS + c8_ * 2; \
            const u32x2 lo_ = *(const LAS u32x2*)s_, hi_ = *(const LAS u32x2*)(s_ + 8); *(u32x4*)(YMIX + (t0_ + row_) * D + col0 + c8_) = (u32x4){lo_.x, lo_.y, hi_.x, hi_.y}; } } while (0)
    if (wave >= 2) SQ_LOAD(0);
    __syncthreads();
    f32x16 X00 = f32x16{}, X01 = f32x16{}, X10 = f32x16{}, X11 = f32x16{};
#pragma unroll 1
    for (int c = 0; c < 64; ++c) {
        if (wave >= 2) {
            if (c + 1 < 64) SQ_LOAD(c + 1);
            if (c > 0) SQ_STORE(c - 1);
        } else {
            const int tb = wave;
            const LAS unsigned char* bb = lds + (c & 1) * SQ_BUF;
            const LAS unsigned char* MG = bb; const LAS unsigned char* MH = bb + SQ_MAT; const LAS unsigned char* MR = bb + 2 * SQ_MAT; const LAS unsigned char* MY = bb + 3 * SQ_MAT;
            const LAS unsigned char* MV = bb + 4 * SQ_MAT; const LAS unsigned char* MGT = bb + 5 * SQ_MAT;
            LAS unsigned char* OB = lds + SQ_OUT + (c & 1) * SQ_MAT;
            const int tl = tb * 32 + r32; const size_t t = (size_t)b * SEQ + c * 64 + tl;
            const float rk = RK[t * 8 + h];
            f32x16 y0, y1; linit(y0, MY, tl, 0, hi); linit(y1, MY, tl, 1, hi);
#pragma unroll
            for (int s = 0; s < 2; ++s) {
                const bf16x8 rf0 = lfrag(MR, tl, 16 * s, hi), rf1 = lfrag(MR, tl, 32 + 16 * s, hi);
                y0 = CK_MFMA(packR(X00, s), rf0, y0); y0 = CK_MFMA(packR(X10, s), rf1, y0);
                y1 = CK_MFMA(packR(X01, s), rf0, y1); y1 = CK_MFMA(packR(X11, s), rf1, y1);
            }
#pragma unroll
            for (int db = 0; db < 2; ++db) {
                f32x16 Na, Nb; linit(Na, MH, db * 32 + r32, 0, hi); linit(Nb, MH, db * 32 + r32, 1, hi);
#pragma unroll
                for (int s = 0; s < 2; ++s) {
                    const bf16x8 g00 = lfrag(MG, r32, 16 * s, hi), g01 = lfrag(MG, r32, 32 + 16 * s, hi), g10 = lfrag(MG, 32 + r32, 16 * s, hi), g11 = lfrag(MG, 32 + r32, 32 + 16 * s, hi);
                    const bf16x8 p0 = packR(db ? X01 : X00, s), p1 = packR(db ? X11 : X10, s);
                    Na = CK_MFMA(g00, p0, Na); Na = CK_MFMA(g01, p1, Na);
                    Nb = CK_MFMA(g10, p0, Nb); Nb = CK_MFMA(g11, p1, Nb);
                }
                if (db == 0) { X00 = Na; X10 = Nb; } else { X01 = Na; X11 = Nb; }
            }
            float sm = 0.f;
#pragma unroll
            for (int r = 0; r < 16; ++r) sm += y0[r] + y1[r];
            sm += __shfl_xor(sm, 32);
            const float mean = sm * (1.0f / 64.0f);
            float sq = 0.f;
#pragma unroll
            for (int r = 0; r < 16; ++r) { const float d0 = y0[r] - mean, d1 = y1[r] - mean; sq += d0 * d0 + d1 * d1; }
            sq += __shfl_xor(sq, 32);
            const float rs = 1.0f / sqrtf(sq * (1.0f / 64.0f) + 64e-5f);
#pragma unroll
            for (int db = 0; db < 2; ++db)
#pragma unroll
                for (int q = 0; q < 4; ++q) {
                    const int dv = db * 32 + 8 * q + 4 * hi;
                    const f32x4 lg = *(const f32x4*)(lng + dv), lb = *(const f32x4*)(lnb + dv);
                    const u32x2 uv = *(const LAS u32x2*)(MV + tl * PS + dv * 2), ug = *(const LAS u32x2*)(MGT + tl * PS + dv * 2);
                    const f32x4 vv = {bflo(uv.x), bfhi(uv.x), bflo(uv.y), bfhi(uv.y)}, gg = {bflo(ug.x), bfhi(ug.x), bflo(ug.y), bfhi(ug.y)};
                    f32x4 yy; if (db == 0) yy = (f32x4){y0[4 * q], y0[4 * q + 1], y0[4 * q + 2], y0[4 * q + 3]}; else yy = (f32x4){y1[4 * q], y1[4 * q + 1], y1[4 * q + 2], y1[4 * q + 3]};
                    const f32x4 o = ((yy - mean) * rs * lg + lb + rk * vv) * gg;
                    u32x2 w; w.x = pk2(o.x, o.y); w.y = pk2(o.z, o.w);
                    *(LAS u32x2*)(OB + tl * PS + dv * 2) = w;
                }
        }
        __syncthreads();
    }
    if (wave >= 2) SQ_STORE(63);
#undef SQ_LOAD
#undef SQ_STORE
}
}

namespace att {
constexpr int SLOT = 32768, OFF_V = 16384;
constexpr int TBL_OFF = MISC_OFF + 1024;
constexpr int LW_OFF = MISC_OFF + 2048;
constexpr int CST_OFF = MISC_OFF + 3072;
__device__ __forceinline__ int crow(int r, int hi) { return (r & 3) + 8 * (r >> 2) + 4 * hi; }
__device__ __forceinline__ void glds16(const void* gsrc, unsigned lds_dst) { unsigned keep;
    asm volatile("s_mov_b32 %0, m0\n\ts_mov_b32 m0, %2\n\ts_nop 0\n\tglobal_load_lds_dwordx4 %1, off\n\ts_mov_b32 m0, %0" : "=&s"(keep) : "v"(gsrc), "s"(lds_dst) : "memory"); }
__device__ __forceinline__ s16x4 vtr(const LAS unsigned char* p) { return __builtin_bit_cast(s16x4, __builtin_amdgcn_ds_read_tr16_b64_v4i16((LAS s16x4*)p)); }

__device__ __forceinline__ void attn_unit(LAS unsigned char* lds, const Args& a, int b, int h, int qb, float negM, float lam) {
    const int tid = threadIdx.x, lane = tid & 63, r32 = lane & 31, hi = lane >> 5; const int wid = __builtin_amdgcn_readfirstlane(tid >> 6);
    const int c = wid >> 2, rg = wid & 3;
    unsigned char* ws = a.ws;
    const bf16_t* QN = (const bf16_t*)(ws + WS_QN); const bf16_t* KN = (const bf16_t*)(ws + WS_KN); const bf16_t* P = (const bf16_t*)(ws + WS_P); bf16_t* YMIX = (bf16_t*)(ws + WS_YMIX);
    const int q0 = qb * 128; const size_t rowbase = (size_t)b * SEQ;
    const int NT = 2 * qb + 2;
    LAS float* tbl = (LAS float*)(lds + TBL_OFF); LAS float* lw = (LAS float*)(lds + LW_OFF) + wid * 32;
    if (tid < 128) {
        const int n = tid; int bkt;
        if (n < 16) bkt = n; else { bkt = 16 + (int)(logf((float)n * (1.0f / 16.0f)) / 2.0794415416798357f * 16.0f); bkt = bkt > 31 ? 31 : bkt; }
        tbl[n] = (a.in[21][bkt * 4 + h] - a.in[21][31 * 4 + h]) * LOG2E;
    }
    const bf16_t* Qw = QN + (rowbase + q0 + rg * 32 + r32) * CW + h * 128 + c * 64;
    bf16x8 qr[4];
#pragma unroll
    for (int d0 = 0; d0 < 4; ++d0) qr[d0] = *(const bf16x8*)(Qw + d0 * 16 + hi * 8);
    const bf16_t* k0src = KN + ((((size_t)(b * 8 + h * 2) * 64) * 8 + wid) * 64 + lane) * 8;
    const bf16_t* k1src = k0src + (size_t)64 * 8 * 64 * 8;
    const int pv0 = 2 * wid, pv1 = 2 * wid + 1;
    const bf16_t* VTb = (const bf16_t*)(ws + WS_VT) + (size_t)(b * 4 + h) * 64 * 8192;
    const bf16_t* v0src = VTb + pv0 * 512 + lane * 8;
    const bf16_t* v1src = VTb + pv1 * 512 + lane * 8;
#define ATT_DMA(t, slot) do { const unsigned s_ = lds0 + (unsigned)(slot) * SLOT; \
        glds16(k0src + (size_t)(t) * 4096, (unsigned)__builtin_amdgcn_readfirstlane(s_ + wid * 1024)); \
        glds16(k1src + (size_t)(t) * 4096, (unsigned)__builtin_amdgcn_readfirstlane(s_ + 8192 + wid * 1024)); \
        glds16(v0src + (size_t)(t) * 8192, (unsigned)__builtin_amdgcn_readfirstlane(s_ + OFF_V + pv0 * 1024)); \
        glds16(v1src + (size_t)(t) * 8192, (unsigned)__builtin_amdgcn_readfirstlane(s_ + OFF_V + pv1 * 1024)); } while (0)
#define ATT_SBAR() __builtin_amdgcn_sched_barrier(0)
    const unsigned lds0 = (unsigned)(uintptr_t)lds;
    f32x16 o[4];
#pragma unroll
    for (int d0 = 0; d0 < 4; ++d0) o[d0] = f32x16{};
    float lsum = 0.f;
    const bool shift = negM < -60.0f;
    const int qmin = q0 + 32 * rg, qpos = qmin + r32;
    ATT_DMA(0, 0);
    asm volatile("s_waitcnt vmcnt(0)" ::: "memory");
    __syncthreads();
    for (int t = 0; t < NT; ++t) {
        if (t + 1 < NT) ATT_DMA(t + 1, (t + 1) & 1);
        const int kmin = 64 * t;
        if (kmin <= qmin + 31) {
            const LAS unsigned char* slot = lds + (t & 1) * SLOT;
            const LAS unsigned char* kb = slot + c * 8192 + hi * 1024 + r32 * 16;
            const LAS unsigned char* vb = slot + OFF_V + ((lane >> 4) & 1) * 32 + (lane & 3) * 8 + (4 * hi + ((lane & 15) >> 2)) * 64;
            bf16x8 kf[8];
#pragma unroll
            for (int d0 = 0; d0 < 4; ++d0) { kf[2 * d0] = *(const LAS bf16x8*)(kb + d0 * 2048); kf[2 * d0 + 1] = *(const LAS bf16x8*)(kb + d0 * 2048 + 512); }
            ATT_SBAR();
            f32x16 p0, p1;
            p0 = __builtin_amdgcn_mfma_f32_32x32x16_bf16(kf[0], qr[0], f32x16{}, 0, 0, 0); p1 = __builtin_amdgcn_mfma_f32_32x32x16_bf16(kf[1], qr[0], f32x16{}, 0, 0, 0);
#pragma unroll
            for (int d0 = 1; d0 < 4; ++d0) { p0 = __builtin_amdgcn_mfma_f32_32x32x16_bf16(kf[2 * d0], qr[d0], p0, 0, 0, 0); p1 = __builtin_amdgcn_mfma_f32_32x32x16_bf16(kf[2 * d0 + 1], qr[d0], p1, 0, 0, 0); }
            ATT_SBAR();
            s16x4 vv[2][8];
#define ATT_LDV(ks) do { _Pragma("unroll") for (int dvb_ = 0; dvb_ < 4; ++dvb_) { vv[(ks) & 1][2 * dvb_] = vtr(vb + dvb_ * 4096 + (ks) * 1024); vv[(ks) & 1][2 * dvb_ + 1] = vtr(vb + dvb_ * 4096 + (ks) * 1024 + 512); } } while (0)
            ATT_LDV(0); ATT_LDV(1);
            ATT_SBAR();
            if (qmin - (kmin + 63) < 113) {
#pragma unroll
                for (int r = 0; r < 16; ++r) {
                    const int d0_ = qpos - (kmin + crow(r, hi)); const int d1_ = d0_ - 32;
                    const float t0 = tbl[d0_ < 0 ? 0 : (d0_ > 127 ? 127 : d0_)], t1 = tbl[d1_ < 0 ? 0 : (d1_ > 127 ? 127 : d1_)];
                    p0[r] = d0_ < 0 ? -INFINITY : p0[r] + t0; p1[r] = d1_ < 0 ? -INFINITY : p1[r] + t1;
                }
            }
            if (shift) {
#pragma unroll
                for (int r = 0; r < 16; ++r) { p0[r] += negM; p1[r] += negM; }
            }
            float sacc = 0.f;
#pragma unroll
            for (int j = 0; j < 8; ++j) { p0[j] = __builtin_amdgcn_exp2f(p0[j]); sacc += p0[j]; }
#pragma unroll
            for (int ks = 0; ks < 4; ++ks) {
                u32x4 pwk;
                if (ks == 0) { pwk.x = pk2(p0[0], p0[1]); pwk.y = pk2(p0[2], p0[3]); pwk.z = pk2(p0[4], p0[5]); pwk.w = pk2(p0[6], p0[7]); }
                else if (ks == 1) { pwk.x = pk2(p0[8], p0[9]); pwk.y = pk2(p0[10], p0[11]); pwk.z = pk2(p0[12], p0[13]); pwk.w = pk2(p0[14], p0[15]); }
                else if (ks == 2) { pwk.x = pk2(p1[0], p1[1]); pwk.y = pk2(p1[2], p1[3]); pwk.z = pk2(p1[4], p1[5]); pwk.w = pk2(p1[6], p1[7]); }
                else { pwk.x = pk2(p1[8], p1[9]); pwk.y = pk2(p1[10], p1[11]); pwk.z = pk2(p1[12], p1[13]); pwk.w = pk2(p1[14], p1[15]); }
#pragma unroll
                for (int dvb = 0; dvb < 4; ++dvb) {
                    const bf16x8 vf = (bf16x8){vv[ks & 1][2 * dvb][0], vv[ks & 1][2 * dvb][1], vv[ks & 1][2 * dvb][2], vv[ks & 1][2 * dvb][3], vv[ks & 1][2 * dvb + 1][0], vv[ks & 1][2 * dvb + 1][1], vv[ks & 1][2 * dvb + 1][2], vv[ks & 1][2 * dvb + 1][3]};
                    ATT_SBAR();
                    o[dvb] = __builtin_amdgcn_mfma_f32_32x32x16_bf16(__builtin_bit_cast(bf16x8, pwk), vf, o[dvb], 0, 0, 0);
                    if (ks == 0) { p0[8 + 2 * dvb] = __builtin_amdgcn_exp2f(p0[8 + 2 * dvb]); p0[9 + 2 * dvb] = __builtin_amdgcn_exp2f(p0[9 + 2 * dvb]); sacc += p0[8 + 2 * dvb] + p0[9 + 2 * dvb]; }
                    else if (ks == 1) { p1[2 * dvb] = __builtin_amdgcn_exp2f(p1[2 * dvb]); p1[2 * dvb + 1] = __builtin_amdgcn_exp2f(p1[2 * dvb + 1]); sacc += p1[2 * dvb] + p1[2 * dvb + 1]; }
                    else if (ks == 2) { p1[8 + 2 * dvb] = __builtin_amdgcn_exp2f(p1[8 + 2 * dvb]); p1[9 + 2 * dvb] = __builtin_amdgcn_exp2f(p1[9 + 2 * dvb]); sacc += p1[8 + 2 * dvb] + p1[9 + 2 * dvb]; }
                }
                ATT_SBAR();
                if (ks < 2) ATT_LDV(ks + 2);
            }
#undef ATT_LDV
            lsum += sacc;
        }
        asm volatile("s_waitcnt vmcnt(0)" ::: "memory");
        __syncthreads();
    }
#undef ATT_DMA
#undef ATT_SBAR
    lsum += __shfl_xor(lsum, 32);
    if (hi == 0) lw[r32] = 1.0f / lsum;
    asm volatile("s_waitcnt lgkmcnt(0)" ::: "memory");
    LAS float* stg = (LAS float*)(lds + wid * 16384);
#pragma unroll
    for (int r = 0; r < 16; ++r) { const int orow = crow(r, hi); const float il = lw[orow];
#pragma unroll
        for (int d0 = 0; d0 < 4; ++d0) stg[orow * 128 + d0 * 32 + r32] = o[d0][r] * il; }
    __syncthreads();
    {
        const int row = tid >> 2, part = tid & 3, rgp = row >> 5, rr = row & 31;
        const LAS float* s1 = (const LAS float*)(lds + rgp * 16384) + rr * 128 + part * 32;
        const LAS float* s2 = (const LAS float*)(lds + (4 + rgp) * 16384) + rr * 128 + part * 32;
        float dv[32]; float ss = 0.f;
#pragma unroll
        for (int i = 0; i < 8; ++i) { const f32x4 x1 = *(const LAS f32x4*)(s1 + 4 * i), x2 = *(const LAS f32x4*)(s2 + 4 * i);
#pragma unroll
            for (int j = 0; j < 4; ++j) { const float dd = x1[j] - lam * x2[j]; dv[4 * i + j] = dd; ss += dd * dd; } }
        ss = red4(ss);
        const float sc = (1.0f / sqrtf(ss * (1.0f / 128.0f) + 1e-5f)) * 0.8f;
        const float* sg = a.in[20] + part * 32;
        bf16_t* op = YMIX + (rowbase + q0 + row) * D + CW + h * 128 + part * 32;
#pragma unroll
        for (int i = 0; i < 4; ++i) { u32x4 w;
            w.x = pk2(dv[8 * i] * sc * sg[8 * i], dv[8 * i + 1] * sc * sg[8 * i + 1]); w.y = pk2(dv[8 * i + 2] * sc * sg[8 * i + 2], dv[8 * i + 3] * sc * sg[8 * i + 3]);
            w.z = pk2(dv[8 * i + 4] * sc * sg[8 * i + 4], dv[8 * i + 5] * sc * sg[8 * i + 5]); w.w = pk2(dv[8 * i + 6] * sc * sg[8 * i + 6], dv[8 * i + 7] * sc * sg[8 * i + 7]);
            *(u32x4*)(op + 8 * i) = w; }
    }
    __syncthreads();
}

__device__ __forceinline__ void attn_phase(LAS unsigned char* lds, const Args& a, unsigned* ctl) {
    const int tid = threadIdx.x;
    LAS float* cst = (LAS float*)(lds + CST_OFF);
    if (tid < 64) {
        const float gq = fabsf(a.in[14][tid]), gk = fabsf(a.in[15][tid]);
        float mq = gq, mk = gk;
#pragma unroll
        for (int o = 1; o < 64; o <<= 1) { mq = fmaxf(mq, __shfl_xor(mq, o)); mk = fmaxf(mk, __shfl_xor(mk, o)); }
        const float d1 = wave_sum(a.in[16][tid] * a.in[17][tid]), d2 = wave_sum(a.in[18][tid] * a.in[19][tid]);
        float mb = 0.f;
        if (tid < 32) { for (int hh = 0; hh < 4; ++hh) mb = fmaxf(mb, (a.in[21][tid * 4 + hh] - a.in[21][31 * 4 + hh]) * LOG2E); }
#pragma unroll
        for (int o = 1; o < 64; o <<= 1) mb = fmaxf(mb, __shfl_xor(mb, o));
        if (tid == 0) { cst[0] = -(8.0f * LOG2E * mq * mk * 1.02f + mb); cst[1] = __expf(d1) - __expf(d2) + 0.2f; }
    }
    __syncthreads();
    const float negM = cst[0], lam = cst[1];
    LAS int* ubox = (LAS int*)(lds + CST_OFF + 16);
    for (;;) {
        if (tid == 0) ubox[0] = (int)atomicAdd(ctl + CW_ATTQ, 1u);
        __syncthreads();
        const int u = __builtin_amdgcn_readfirstlane(ubox[0]);
        __syncthreads();
        if (u >= 1024 + CONV_ITEMS) break;
        const int qd = u / 5, rm = u - qd * 5;
        if (rm < 3) { conv_item(lds, a, qd * 3 + rm); continue; }
        const int au = qd * 2 + (rm - 3);
        const int qb = 31 - (au >> 5), bhh = au & 31;
        attn_unit(lds, a, bhh >> 2, bhh & 3, qb, negM, lam);
    }
}
}

__device__ __forceinline__ void p5_router(LAS unsigned char* lds, const Args& a, unsigned* ctl) {
    const int tid = threadIdx.x, lane = tid & 63, r32 = lane & 31, hi = lane >> 5; const int wave = __builtin_amdgcn_readfirstlane(tid >> 6);
    unsigned char* ws = a.ws;
    const bf16_t* x1 = (const bf16_t*)(ws + WS_X1B); const float* g2 = a.in[23]; const float* rw = a.in[24]; const float* rb = a.in[25];
    unsigned char* H2 = ws + WS_H2; int* EIDX = (int*)(ws + WS_EIDX); float* GATE = (float*)(ws + WS_GATE); int* POS = (int*)(ws + WS_POS);
    LAS unsigned char* WH = lds; LAS unsigned char* WL = lds + 65536;
    LAS int* cnt = (LAS int*)(lds + MISC_OFF + 1024);
    LAS int* basel = (LAS int*)(lds + MISC_OFF + 1024 + 128);
    LAS int* el = (LAS int*)(lds + MISC_OFF + 2048);
    LAS int* pl = (LAS int*)(lds + MISC_OFF + 4096);
    {
        const int e = tid & 31;
#pragma unroll 1
        for (int kb = tid >> 5; kb < 1024; kb += 256) {
            float wv[16], gv[16];
#pragma unroll
            for (int j = 0; j < 16; ++j) { const int k = kb + 16 * j; wv[j] = rw[k * 32 + e]; gv[j] = g2[k]; }
            __builtin_amdgcn_sched_barrier(0);
#pragma unroll
            for (int j = 0; j < 16; ++j) { const int k = kb + 16 * j;
                const float v = wv[j] * gv[j]; const unsigned h = f2bf(v); const float vh = __builtin_bit_cast(float, h << 16); const unsigned l = f2bf(v - vh);
                const int off = e * 2048 + (((k >> 3) ^ (e & 15)) << 4) + (k & 7) * 2;
                *(LAS unsigned short*)(WH + off) = (unsigned short)h; *(LAS unsigned short*)(WL + off) = (unsigned short)l; }
            __builtin_amdgcn_sched_barrier(0);
        }
    }
    if (tid < 32) cnt[tid] = 0;
    __syncthreads();
    const int TPB = T / (int)gridDim.x, tb0 = blockIdx.x * TPB;
    if (wave < 4) {
        const int tl = wave * 32 + r32, t = tb0 + tl;
        const bf16_t* xrow = x1 + (size_t)t * D + 8 * hi;
        const LAS unsigned char* wh = WH + r32 * 2048; const LAS unsigned char* wl = WL + r32 * 2048; const int sw = r32 & 15;
        f32x16 d = f32x16{}; float ssq = 0.f;
#pragma unroll 1
        for (int s0 = 0; s0 < 64; s0 += 16) {
          u32x4 xbv[16];
#pragma unroll
          for (int i = 0; i < 16; ++i) xbv[i] = *(const u32x4*)(xrow + 16 * (s0 + i));
          __builtin_amdgcn_sched_barrier(0);
#pragma unroll
          for (int i = 0; i < 16; ++i) { const int s = s0 + i;
            const u32x4 xb = xbv[i];
            const int co = ((2 * s + hi) ^ sw) << 4;
            const bf16x8 ah = *(const LAS bf16x8*)(wh + co), al = *(const LAS bf16x8*)(wl + co);
            const bf16x8 bx = __builtin_bit_cast(bf16x8, xb);
            d = __builtin_amdgcn_mfma_f32_32x32x16_bf16(ah, bx, d, 0, 0, 0);
            d = __builtin_amdgcn_mfma_f32_32x32x16_bf16(al, bx, d, 0, 0, 0);
            const f32x4 x0 = cvlo(xb), x1v = cvhi(xb);
            ssq += (x0.x * x0.x + x0.y * x0.y) + (x0.z * x0.z + x0.w * x0.w) + (x1v.x * x1v.x + x1v.y * x1v.y) + (x1v.z * x1v.z + x1v.w * x1v.w);
          }
          __builtin_amdgcn_sched_barrier(0);
        }
        ssq += __shfl_xor(ssq, 32);
        const float rstd = 1.0f / sqrtf(ssq * (1.0f / D) + 1e-5f);
        float lg[16];
#pragma unroll
        for (int r = 0; r < 16; ++r) lg[r] = d[r] * rstd + rb[8 * (r >> 2) + 4 * hi + (r & 3)];
        float tv[4]; int ti[4];
#pragma unroll
        for (int k = 0; k < 4; ++k) {
            float bv = -INFINITY; int bi = 0;
#pragma unroll
            for (int r = 0; r < 16; ++r) { const int e = 8 * (r >> 2) + 4 * hi + (r & 3); if (lg[r] > bv) { bv = lg[r]; bi = e; } }
            tv[k] = bv; ti[k] = bi;
#pragma unroll
            for (int r = 0; r < 16; ++r) { const int e = 8 * (r >> 2) + 4 * hi + (r & 3); if (e == bi) lg[r] = -INFINITY; }
        }
        float ov[4]; int oi[4];
#pragma unroll
        for (int k = 0; k < 4; ++k) { ov[k] = __shfl_xor(tv[k], 32); oi[k] = __shfl_xor(ti[k], 32); }
        float mv[4]; int mi[4];
        {
            int pa = 0, pb = 0;
#pragma unroll
            for (int k = 0; k < 4; ++k) {
                float ca = -INFINITY, cb = -INFINITY; int ia = 0, ib = 0;
#pragma unroll
                for (int q = 0; q < 4; ++q) { if (q == pa) { ca = tv[q]; ia = ti[q]; } if (q == pb) { cb = ov[q]; ib = oi[q]; } }
                const bool takeA = (ca > cb) || (ca == cb && ia < ib);
                mv[k] = takeA ? ca : cb; mi[k] = takeA ? ia : ib; pa += takeA ? 1 : 0; pb += takeA ? 0 : 1;
            }
        }
        const float e1 = __expf(mv[1] - mv[0]), e2 = __expf(mv[2] - mv[0]), e3 = __expf(mv[3] - mv[0]);
        const float inv = 1.0f / (1.0f + e1 + e2 + e3);
        if (hi == 0) {
            *(int4*)(EIDX + (size_t)t * 4) = make_int4(mi[0], mi[1], mi[2], mi[3]);
            *(float4*)(GATE + (size_t)t * 4) = make_float4(inv, e1 * inv, e2 * inv, e3 * inv);
#pragma unroll
            for (int k = 0; k < 4; ++k) { el[tl * 4 + k] = mi[k]; pl[tl * 4 + k] = atomicAdd((int*)(cnt + mi[k]), 1); }
        }
    } else {
        f32x4 gv[4];
#pragma unroll
        for (int j = 0; j < 4; ++j) gv[j] = *((const f32x4*)g2 + lane + 64 * j);
#pragma unroll 1
        for (int i0 = 0; i0 < 32; i0 += 8) {
            u32x2 xw[8][4];
#pragma unroll
            for (int i = 0; i < 8; ++i) { const u32x2* xr = (const u32x2*)(x1 + (size_t)(tb0 + (wave - 4) * 32 + i0 + i) * D) + lane;
#pragma unroll
                for (int j = 0; j < 4; ++j) xw[i][j] = xr[64 * j]; }
            __builtin_amdgcn_sched_barrier(0);
#pragma unroll
            for (int i = 0; i < 8; ++i) {
                const int t = tb0 + (wave - 4) * 32 + i0 + i;
                f32x4 v[4]; float s = 0.f;
#pragma unroll
                for (int j = 0; j < 4; ++j) { v[j] = (f32x4){bflo(xw[i][j].x), bfhi(xw[i][j].x), bflo(xw[i][j].y), bfhi(xw[i][j].y)}; s += (v[j].x * v[j].x + v[j].y * v[j].y) + (v[j].z * v[j].z + v[j].w * v[j].w); }
                const float rstd = (1.0f / sqrtf(wave_sum(s) * (1.0f / D) + 1e-5f)) * F8_X_MUL;
                unsigned* o4 = (unsigned*)(H2 + (size_t)t * D) + lane;
#pragma unroll
                for (int j = 0; j < 4; ++j) { v[j] = v[j] * rstd * gv[j]; o4[64 * j] = pk4_fp8(v[j].x, v[j].y, v[j].z, v[j].w); }
            }
            __builtin_amdgcn_sched_barrier(0);
        }
    }
    __syncthreads();
    if (tid < 32) basel[tid] = (int)atomicAdd(ctl + CW_CNT + tid, (unsigned)cnt[tid]);
    __syncthreads();
    for (int i = tid; i < TPB * 4; i += 512) POS[(size_t)tb0 * 4 + i] = pl[i] + basel[el[i]];
}

__device__ __forceinline__ void p6_dispatch(LAS unsigned char* lds, const Args& a, unsigned* ctl) {
    const int tid = threadIdx.x, lane = tid & 63, wave = __builtin_amdgcn_readfirstlane(tid >> 6);
    unsigned char* ws = a.ws;
    const int* EIDX = (const int*)(ws + WS_EIDX); const float* GATE = (const float*)(ws + WS_GATE); const int* POS = (const int*)(ws + WS_POS);
    int* DEST = (int*)(ws + WS_DEST); float* ROWGATE = (float*)(ws + WS_ROWGATE); int* TILEE = (int*)(ws + WS_TILEE); int* ROWTOK = (int*)(ws + WS_ROWTOK);
    LAS int* pstart = (LAS int*)(lds + MISC_OFF + 1024); LAS int* pcnt = pstart + 32;
    if (tid < NE) pcnt[tid] = (int)__hip_atomic_load(ctl + CW_CNT + tid, __ATOMIC_RELAXED, __HIP_MEMORY_SCOPE_AGENT);
    __syncthreads();
    if (tid == 0) {
        int acc = 0;
        for (int e = 0; e < NE; ++e) { pstart[e] = acc; acc += ((pcnt[e] + 255) >> 8) * 256; }
        if (blockIdx.x == 0) TILEE[1023] = acc >> 8;
    }
    __syncthreads();
    if (blockIdx.x == 0 && tid < NE) { const int nt = (pcnt[tid] + 255) >> 8, t0_ = pstart[tid] >> 8; for (int i = 0; i < nt; ++i) TILEE[t0_ + i] = tid; }
    if (blockIdx.x < NE) {
        const int e = blockIdx.x, cn = pcnt[e], pe = ((cn + 255) >> 8) * 256;
        for (int i = cn + tid; i < pe; i += 512) ROWTOK[pstart[e] + i] = 0;
    }
    const int TPB = T / (int)gridDim.x, tb0 = blockIdx.x * TPB;
    for (int pi = tb0 * 4 + tid; pi < (tb0 + TPB) * 4; pi += 512) {
        const int e = EIDX[pi], dest = pstart[e] + POS[pi];
        DEST[pi] = dest; ROWGATE[dest] = GATE[pi]; ROWTOK[dest] = pi >> 2;
    }
}

__device__ __forceinline__ void p9_combine(const Args& a, int G) {
    const int tid = threadIdx.x, lane = tid & 63, wave = __builtin_amdgcn_readfirstlane(tid >> 6);
    unsigned char* ws = a.ws;
    const unsigned char* YS = ws + WS_YS; const int* DEST = (const int*)(ws + WS_DEST);
    float* out = a.out;
    const int gw = blockIdx.x * 8 + wave, NGW = G * 8;
    for (int t = gw; t < T; t += NGW) {
        f32x4* xr = (f32x4*)(out + (size_t)t * D) + lane; const u32x2* xi = (const u32x2*)((const bf16_t*)(ws + WS_X1B) + (size_t)t * D) + lane;
        f32x4 v[4];
#pragma unroll
        for (int j = 0; j < 4; ++j) { const u32x2 xw = xi[64 * j]; v[j] = (f32x4){bflo(xw.x), bfhi(xw.x), bflo(xw.y), bfhi(xw.y)}; }
#pragma unroll
        for (int k = 0; k < 4; ++k) {
            const int dest = DEST[t * 4 + k];
            const unsigned* yr = (const unsigned*)(YS + (size_t)dest * D) + lane;
#pragma unroll
            for (int j = 0; j < 4; ++j) { const unsigned w = yr[64 * j];
                const f32x2 lo = __builtin_amdgcn_cvt_pk_f32_fp8((int)w, false), hi2 = __builtin_amdgcn_cvt_pk_f32_fp8((int)w, true);
                v[j].x += lo.x * (1.0f / F8_Y_MUL); v[j].y += lo.y * (1.0f / F8_Y_MUL); v[j].z += hi2.x * (1.0f / F8_Y_MUL); v[j].w += hi2.y * (1.0f / F8_Y_MUL); }
        }
        if (TIME_REGION >= 0) { const float sc_ = 1.0f + 4e-6f * (float)((const unsigned*)(ws + WS_CTL))[301];
#pragma unroll
            for (int j = 0; j < 4; ++j) v[j] = v[j] * sc_; }
#pragma unroll
        for (int j = 0; j < 4; ++j) xr[64 * j] = v[j];
    }
}

constexpr int NPHASE = 10;
__global__ void __launch_bounds__(512, 2) hymba_fwd(Args args) {
    extern __shared__ __attribute__((aligned(16))) unsigned char lds_raw[];
    LAS unsigned char* lds = (LAS unsigned char*)lds_raw;
    cg::grid_group grid = cg::this_grid();
    const int G = gridDim.x;
    unsigned char* ws = args.ws;
    unsigned* ctl = (unsigned*)(ws + WS_CTL);
    const int lo = args.ph_lo, hi = args.ph_hi;
#define IN(k) (lo <= (k) && (k) < hi)
#define NREP(k) ((REP_PHASE) == (k) ? 2 : 1)
#define TSTART(k) do { if ((TIME_REGION) == (k) && blockIdx.x == 0 && threadIdx.x == 0) ctl[300] = (unsigned)__builtin_amdgcn_s_memrealtime(); } while (0)
#define TEND(k) do { if ((TIME_REGION) == (k) && blockIdx.x == 0 && threadIdx.x == 0) ctl[301] = (unsigned)__builtin_amdgcn_s_memrealtime() - ctl[300]; } while (0)
#define SEAM(k) do { if (IN(k) && IN((k) + 1)) { if (args.ph_lo < 0) grid.sync(); xcd_barrier(xbar); } } while (0)
    const int* TILEE = (const int*)(ws + WS_TILEE);
    { volatile LAS unsigned* st = (volatile LAS unsigned*)(lds + LDS_BYTES - 64); if (threadIdx.x < 2) st[threadIdx.x] = 0u; }
    __syncthreads();
    const XcdBarrier xbar = xcd_barrier_post(ctl + CW_BAR, (volatile LAS unsigned*)(lds + LDS_BYTES - 64));

    if (IN(0)) { for (int rep = 0; rep < NREP(0); ++rep) p0_prologue(lds, args, G); } SEAM(0);
    if (IN(1)) {
        pg8::Gemm g{ws + WS_XN, ws + WS_WINT, 1024, 0, 0, nullptr};
        pg8::TileOrder S; S.init(T / 256, NINP / 256, G, (int)blockIdx.x, nullptr, 0, WGM_P1);
        pg8::EpiBf16 E{(bf16_t*)(ws + WS_P), NINP, (bf16_t*)(ws + WS_VT)};
        for (int rep = 0; rep < NREP(1); ++rep) pg8::gemm_phase<false, false>(lds, g, S, E);
    } SEAM(1);
    TSTART(2);
    if (IN(2)) {
        ck::fused_item(lds, args, (int)blockIdx.x * 2); ck::fused_item(lds, args, (int)blockIdx.x * 2 + 1);
    } SEAM(2);
    TSTART(3);
    if (IN(3)) {
        TSTART(30); for (int rep = 0; rep < NREP(30); ++rep) { if (blockIdx.x < 64) ck::seq_head(lds, args, (int)blockIdx.x); __syncthreads(); } TEND(30);
        for (int rep = 0; rep < NREP(31); ++rep) att::attn_phase(lds, args, ctl + 64 * rep);
    } SEAM(3); TEND(3);
    if (IN(4)) {
        pg8::Gemm g{ws + WS_YMIX, ws + WS_WOUT, 1024, 0, 0, nullptr};
        pg8::TileOrder S; S.init(T / 256, D / 256, G, (int)blockIdx.x, nullptr, 0, WGM_P4);
        pg8::EpiResBf16 E{args.in[0], (bf16_t*)(ws + WS_X1B), D};
        for (int rep = 0; rep < NREP(4); ++rep) pg8::gemm_phase<false, false>(lds, g, S, E);
    } SEAM(4);
    if (IN(5)) { _Pragma("clang loop unroll(disable)") for (int rep = 0; rep < NREP(5); ++rep) { p5_router(lds, args, ctl + 256 * (NREP(5) - 1 - rep)); __syncthreads(); } } SEAM(5);
    if (IN(6)) { for (int rep = 0; rep < NREP(6); ++rep) { p6_dispatch(lds, args, ctl); __syncthreads(); } } SEAM(6);
    if (IN(7)) {
        const int ntile = TILEE[1023];
        pg8::Gemm g{ws + WS_H2, ws + WS_W1T, 1024, F8_W_SC, F8_X_SC, (const int*)(ws + WS_ROWTOK)};
        pg8::TileOrder S; S.init(ntile, 8, G, (int)blockIdx.x, TILEE, 8, WGM_P7);
        pg8::EpiSwiglu E{ws + WS_HID, args.in[27], TILEE};
        for (int rep = 0; rep < NREP(7); ++rep) pg8::gemm_phase<true, true>(lds, g, S, E);
    } SEAM(7);
    if (IN(8)) {
        const int ntile = TILEE[1023];
        pg8::Gemm g{ws + WS_HID, ws + WS_W2T, 1024, F8_W_SC, F8_H_SC, nullptr};
        pg8::TileOrder S; S.init(ntile, 4, G, (int)blockIdx.x, TILEE, 4, WGM_P8);
        pg8::EpiGateF8 E{ws + WS_YS, args.in[29], (const float*)(ws + WS_ROWGATE), TILEE};
        for (int rep = 0; rep < NREP(8); ++rep) pg8::gemm_phase<true, false>(lds, g, S, E);
    } SEAM(8);
    if (IN(9)) { p9_combine(args, G); }
#undef IN
#undef SEAM
}

extern "C" void kernel_launch(void* const* d_in, const int* in_sizes, int n_in, void* d_out, int out_size, void* d_ws, size_t ws_size, hipStream_t stream) {
    static int grid = 0;
    if (grid == 0) {
        if (n_in != 30 || in_sizes[0] != T * D || out_size != T * D || ws_size < WS_END) { fprintf(stderr, "kernel_launch: unexpected shapes (n_in %d, in0 %d, out %d, ws %zu); nothing launched\n", n_in, n_in > 0 ? in_sizes[0] : -1, out_size, ws_size); grid = -1; return; }
        int dev = 0, cus = 0, per_cu = 0;
        if (hipGetDevice(&dev) != hipSuccess || hipDeviceGetAttribute(&cus, hipDeviceAttributeMultiprocessorCount, dev) != hipSuccess) { grid = -1; return; }
        if (hipFuncSetAttribute((const void*)hymba_fwd, hipFuncAttributeMaxDynamicSharedMemorySize, LDS_BYTES) != hipSuccess) { fprintf(stderr, "kernel_launch: hipFuncSetAttribute failed\n"); grid = -1; return; }
        if (hipOccupancyMaxActiveBlocksPerMultiprocessor(&per_cu, (const void*)hymba_fwd, 512, LDS_BYTES) != hipSuccess || per_cu < 1) { fprintf(stderr, "kernel_launch: occupancy query says %d\n", per_cu); per_cu = 1; }
        (void)hipGetLastError();
        grid = cus;
        if (grid > 256) grid = 256;
        if (grid != 256 || T % grid != 0 || (T / grid) % 16 != 0) { fprintf(stderr, "kernel_launch: grid %d does not divide the token count evenly\n", grid); grid = -1; return; }
    }
    if (grid < 0) return;
    (void)hipMemsetAsync((char*)d_ws + WS_CTL, 0, CTL_ZERO_BYTES, stream);
    Args a{};
    for (int i = 0; i < 30; ++i) a.in[i] = (const float*)d_in[i];
    a.out = (float*)d_out; a.ws = (unsigned char*)d_ws;
    constexpr int NL = MK_N_LAUNCHES;
    for (int li = 0; li < NL; ++li) {
        a.ph_lo = (NL == 1) ? 0 : li; a.ph_hi = (NL == 1) ? NPHASE : li + 1;
        void* kargs[] = {&a};
        hipError_t e = hipLaunchCooperativeKernel((const void*)hymba_fwd, dim3(grid), dim3(512), kargs, LDS_BYTES, stream);
        if (e != hipSuccess) { fprintf(stderr, "kernel_launch: cooperative launch %d failed: %s (grid %d)\n", li, hipGetErrorString(e), grid); break; }
    }
}
```

```cpp
#include <hip/hip_runtime.h>
#include <hip/hip_cooperative_groups.h>
#include <cstdio>
#include <cstdint>
#include <type_traits>
namespace cg = cooperative_groups;

#ifndef REP_PHASE
#define REP_PHASE -1
#endif
#ifndef TIME_REGION
#define TIME_REGION -1
#endif
#ifndef WGM_P1
#define WGM_P1 2
#endif
#ifndef WGM_P4
#define WGM_P4 2
#endif
#ifndef WGM_P7
#define WGM_P7 2
#endif
#ifndef WGM_P8
#define WGM_P8 2
#endif
#ifndef MK_N_LAUNCHES
#define MK_N_LAUNCHES 1
#endif

#define LAS __attribute__((address_space(3)))
#define GAS __attribute__((address_space(1)))
typedef unsigned short bf16_t;
typedef short bf16x8 __attribute__((ext_vector_type(8)));
typedef short s16x4 __attribute__((ext_vector_type(4)));
typedef float f32x2 __attribute__((ext_vector_type(2)));
typedef float f32x4 __attribute__((ext_vector_type(4)));
typedef float f32x16 __attribute__((ext_vector_type(16)));
typedef unsigned u32x2 __attribute__((ext_vector_type(2)));
typedef unsigned u32x4 __attribute__((ext_vector_type(4)));
typedef int v8i32 __attribute__((ext_vector_type(8)));

constexpr int NB = 8, SEQ = 4096, T = NB * SEQ, D = 1024;
constexpr int CW = 512;
constexpr int NRW = 1696, NIN = 3232, NINP = 3328;
constexpr int DQ0 = 1696, DK0 = 2208, DV0 = 2720;
constexpr int NE = 32, TOPK = 4, DE = 1024;
constexpr int MAXROWS = T * TOPK + NE * 256;
constexpr int MAXTILES = MAXROWS / 256;
constexpr float LOG2E = 1.4426950408889634f;
constexpr float F8_W_MUL = 32.f, F8_X_MUL = 8.f, F8_H_MUL = 4.f, F8_Y_MUL = 16.f; constexpr int F8_W_SC = 0x7A7A7A7A, F8_X_SC = 0x7C7C7C7C, F8_H_SC = 0x7D7D7D7D;

constexpr size_t MiB = 1u << 20;
constexpr size_t WS_CTL = 0, CTL_ZERO_BYTES = 64 * 1024;
constexpr size_t WS_TILEE = 512 * 1024;
constexpr size_t WS_LW = 576 * 1024;
constexpr size_t WS_WINT = 1 * MiB;
constexpr size_t WS_WOUT = 8 * MiB;
constexpr size_t WS_W1T = 10 * MiB;
constexpr size_t WS_W2T = 138 * MiB;
constexpr size_t WS_EIDX = 202 * MiB;
constexpr size_t WS_GATE = WS_EIDX + 512 * 1024;
constexpr size_t WS_POS = WS_GATE + 512 * 1024;
constexpr size_t WS_DEST = WS_POS + 512 * 1024;
constexpr size_t WS_ROWGATE = 204 * MiB;
constexpr size_t WS_XN = 206 * MiB;
constexpr size_t WS_P = 270 * MiB;
constexpr size_t WS_SR = 478 * MiB, WS_SK = 510 * MiB, WS_SV = 542 * MiB, WS_SA = 574 * MiB, WS_SB = 606 * MiB;
constexpr size_t WS_SW = 638 * MiB;
constexpr size_t WS_SG = 702 * MiB;
constexpr size_t WS_QN = 734 * MiB, WS_KN = 766 * MiB;
constexpr size_t WS_YMIX = 798 * MiB;
constexpr size_t WS_H2 = 206 * MiB;
constexpr size_t WS_ROWTOK = 270 * MiB;
constexpr size_t WS_HID = 406 * MiB;
constexpr size_t WS_YS = 542 * MiB;
constexpr size_t WS_X1B = 862 * MiB;
constexpr size_t WS_CG = 862 * MiB;
constexpr size_t WS_CH = 894 * MiB;
constexpr size_t WS_CR2 = 926 * MiB;
constexpr size_t WS_CY0 = 958 * MiB;
constexpr size_t WS_RK = 990 * MiB;
constexpr size_t WS_VT = 992 * MiB;
constexpr size_t WS_END = 1024 * MiB;
constexpr int CW_CNT = 64;
constexpr int CW_ATTQ = 128;
constexpr int CW_BAR = 4096;

constexpr int RING_BYTES = 131072, MISC_OFF = RING_BYTES, LDS_BYTES = 147456;

__device__ __forceinline__ unsigned f2bf(float f) { unsigned u = __builtin_bit_cast(unsigned, f); return (u + 0x7fffu + ((u >> 16) & 1u)) >> 16; }
typedef __bf16 hwbf16x2 __attribute__((ext_vector_type(2)));
__device__ __forceinline__ unsigned pk2(float lo, float hi) { const f32x2 v = {lo, hi}; return __builtin_bit_cast(unsigned, __builtin_convertvector(v, hwbf16x2)); }
__device__ __forceinline__ unsigned pk4_fp8(float a, float b, float c, float d) {
    a = fminf(fmaxf(a, -448.f), 448.f); b = fminf(fmaxf(b, -448.f), 448.f); c = fminf(fmaxf(c, -448.f), 448.f); d = fminf(fmaxf(d, -448.f), 448.f);
    int r = __builtin_amdgcn_cvt_pk_fp8_f32(a, b, 0, false); r = __builtin_amdgcn_cvt_pk_fp8_f32(c, d, r, true); return (unsigned)r; }
__device__ __forceinline__ unsigned pk4_fp8_nc(float a, float b, float c, float d) {
    int r = __builtin_amdgcn_cvt_pk_fp8_f32(a, b, 0, false); r = __builtin_amdgcn_cvt_pk_fp8_f32(c, d, r, true); return (unsigned)r; }
__device__ __forceinline__ float bf2f(unsigned short b) { return __builtin_bit_cast(float, (unsigned)b << 16); }
__device__ __forceinline__ float bflo(unsigned w) { return __builtin_bit_cast(float, w << 16); }
__device__ __forceinline__ float bfhi(unsigned w) { return __builtin_bit_cast(float, w & 0xffff0000u); }
__device__ __forceinline__ float sigmoidf_(float x) { return __builtin_amdgcn_rcpf(1.0f + __builtin_amdgcn_exp2f(-1.4426950408889634f * x)); }
template <int CTRL> __device__ __forceinline__ float dpp_f(float v) { return __builtin_bit_cast(float, __builtin_amdgcn_update_dpp(0, __builtin_bit_cast(int, v), CTRL, 0xF, 0xF, true)); }
__device__ __forceinline__ float wave_sum(float v) {
    v += dpp_f<0xB1>(v); v += dpp_f<0x4E>(v); v += dpp_f<0x141>(v); v += dpp_f<0x140>(v);
    const int vi = __builtin_bit_cast(int, v);
    return (__builtin_bit_cast(float, __builtin_amdgcn_readlane(vi, 0)) + __builtin_bit_cast(float, __builtin_amdgcn_readlane(vi, 16)))
         + (__builtin_bit_cast(float, __builtin_amdgcn_readlane(vi, 32)) + __builtin_bit_cast(float, __builtin_amdgcn_readlane(vi, 48)));
}
__device__ __forceinline__ float red8(float v) {
    v += dpp_f<0xB1>(v);
    v += dpp_f<0x4E>(v);
    v += dpp_f<0x141>(v);
    return v;
}
__device__ __forceinline__ float red4(float v) { v += dpp_f<0xB1>(v); v += dpp_f<0x4E>(v); return v; }


#define XB_TMO      128
#define XB_XCNT(j)  (256  + 64 * (j))
#define XB_XSUB(j)  (1280 + 64 * (j))
#define XB_XGEN(j)  (2304 + 64 * (j))
#define XB_TOP      3328
#define XB_TOPGEN   3392
#define XCD_BAR_WORDS 3456
#define XB_SPIN_CAP (1u << 18)
__device__ __forceinline__ unsigned xb_ld(unsigned* p)              { return __hip_atomic_load(p, __ATOMIC_RELAXED, __HIP_MEMORY_SCOPE_AGENT); }
__device__ __forceinline__ unsigned xb_add(unsigned* p, unsigned v) { return __hip_atomic_fetch_add(p, v, __ATOMIC_RELAXED, __HIP_MEMORY_SCOPE_AGENT); }
__device__ __forceinline__ unsigned xb_xcc_id() { return (unsigned)__builtin_amdgcn_s_getreg((3 << 11) | 20) & 0xFu; }
#define XB_SPIN(cond, bar) do { unsigned _sp = 0; while (cond) { __builtin_amdgcn_s_sleep(1); \
    if ((++_sp & 255u) == 0u) { if (xb_ld(&(bar)[XB_TMO])) break; if (_sp > XB_SPIN_CAP) { atomicAdd(&(bar)[XB_TMO], 1u); break; } } } } while (0)
struct XcdBarrier { unsigned* bar; unsigned x; volatile LAS unsigned* st; };
__device__ __forceinline__ XcdBarrier xcd_barrier_post(unsigned* bar, volatile LAS unsigned* st) {
    XcdBarrier b; b.bar = bar; b.x = xb_xcc_id(); b.st = st;
    if (threadIdx.x == 0) (void)xb_add(&bar[XB_XCNT(b.x)], 1u);
    return b;
}
__device__ __forceinline__ void xcd_barrier_complete(unsigned* bar, unsigned x, unsigned& nloc, unsigned& nx) {
    const unsigned G = gridDim.x * gridDim.y * gridDim.z;
    unsigned sum, cnt, mine, sp = 0u;
    for (;;) {
        sum = 0u; cnt = 0u; mine = 0u;
#pragma unroll
        for (unsigned j = 0; j < 16; ++j) { const unsigned c = xb_ld(&bar[XB_XCNT(j)]); sum += c; cnt += (c > 0u) ? 1u : 0u; mine = (j == x) ? c : mine; }
        if (sum == G) break;
        __builtin_amdgcn_s_sleep(1);
        if ((++sp & 255u) == 0u) { if (xb_ld(&bar[XB_TMO])) break; if (sp > XB_SPIN_CAP) { atomicAdd(&bar[XB_TMO], 1u); break; } }
    }
    nloc = mine > 0u ? mine : 1u; nx = cnt > 0u ? cnt : 1u;
}
__device__ __forceinline__ void xcd_barrier(const XcdBarrier& b) {
    asm volatile("s_waitcnt vmcnt(0)" ::: "memory");
    __syncthreads();
    if (threadIdx.x == 0) {
        unsigned* bar = b.bar;
        __builtin_amdgcn_s_waitcnt(0);
        unsigned nloc = b.st[0], nx = b.st[1];
        if (nloc == 0u) { xcd_barrier_complete(bar, b.x, nloc, nx); b.st[0] = nloc; b.st[1] = nx; }
        const unsigned old = xb_add(&bar[XB_XSUB(b.x)], 1u);
        const unsigned gen = old / nloc;
        if (old + 1u == (gen + 1u) * nloc) {
            __builtin_amdgcn_fence(__ATOMIC_RELEASE, "agent");
            asm volatile("s_waitcnt vmcnt(0)" ::: "memory");
            const unsigned og = xb_add(&bar[XB_TOP], 1u);
            const unsigned tg = og / nx;
            if (og + 1u == (tg + 1u) * nx) xb_add(&bar[XB_TOPGEN], 1u);
            else XB_SPIN(xb_ld(&bar[XB_TOPGEN]) == tg, bar);
            __builtin_amdgcn_fence(__ATOMIC_ACQUIRE, "agent");
            xb_add(&bar[XB_XGEN(b.x)], 1u);
            asm volatile("s_waitcnt vmcnt(0)" ::: "memory");
        } else {
            XB_SPIN(xb_ld(&bar[XB_XGEN(b.x)]) == gen, bar);
            __builtin_amdgcn_fence(__ATOMIC_ACQUIRE, "agent");
            asm volatile("s_waitcnt vmcnt(0)" ::: "memory");
        }
    }
    __syncthreads();
}

namespace pg8 {
constexpr int BM = 256, BK = 64, HALF = 128, HTB = HALF * BK * 2, STAGE_BYTES = 8 * HTB, NXCD = 8;
__host__ __device__ __forceinline__ int lds_byte(int r, int c) { const int st = (r >> 4) * 2 + (c >> 5), rr = r & 15, cc = c & 31, ob = rr * 64 + cc * 2; return st * 1024 + (ob ^ (((ob >> 9) & 1) << 5)); }
__host__ __device__ __forceinline__ void stage_rc(int b, int& R, int& C) { const int st = b / 1024, sb = b % 1024, swz = sb ^ (((sb >> 9) & 1) << 5); R = (st >> 1) * 16 + swz / 64; C = (st & 1) * 32 + (swz % 64) / 2; }
__host__ __device__ __forceinline__ int f8_swz(int fr) { return ((fr >> 1) & 3) | ((((fr + 4) >> 3) & 1) << 2); }
__host__ __device__ __forceinline__ void stage_rc_f8(int b, int& R, int& C) { const int p = b >> 10, l = (b >> 4) & 63, fr = (p & 1) * 8 + (l >> 3); R = (p >> 1) * 16 + fr; C = ((l & 7) ^ f8_swz(fr)) * 8; }
__host__ __device__ __forceinline__ int frag_f8(int row0, int fr, int fq, int j) { return (row0 >> 4) * 2048 + (fr >> 3) * 1024 + (fr & 7) * 128 + (((2 * fq + j) ^ f8_swz(fr)) * 16); }
__host__ __device__ __forceinline__ int perm32(int rho) { const int n = rho >> 4, i = rho & 15; return 8 * (i >> 2) + 4 * n + (i & 3); }

struct Unit { int pm, pn, pb; };
struct Gemm { const void* A; const void* Bt; int K; int scW, scA; const int* rowtok; };

struct TileOrder {
    int nM, nN, nwg, G, c, WGM; const int* tile_e; int nb_per_e;
    __device__ void init(int nM_, int nN_, int G_, int c_, const int* te, int nbe, int wgm) { nM = nM_; nN = nN_; nwg = nM * nN; G = G_; c = c_; tile_e = te; nb_per_e = nbe; WGM = wgm; }
    __device__ bool next(int i, Unit& u) const {
        const long L = (long)i * G + c; if (L >= nwg) return false;
        int wgid = (int)L; { const int q = nwg / NXCD, r = nwg % NXCD, xcd = wgid % NXCD, off = wgid / NXCD; wgid = (xcd < r ? xcd * (q + 1) : r * (q + 1) + (xcd - r) * q) + off; }
        const int nig = WGM * nN, gid = wgid / nig, fm = gid * WGM, gsz = (nM - fm) < WGM ? (nM - fm) : WGM;
        u.pm = fm + ((wgid % nig) % gsz); u.pn = (wgid % nig) / gsz;
        u.pb = tile_e ? tile_e[u.pm] * nb_per_e + u.pn : u.pn;
        return true;
    }
};

struct EpiBf16 {
    static constexpr bool PERM = true;
    bf16_t* O; int ldc; bf16_t* VT;
    __device__ __forceinline__ void operator()(const f32x4 (&acc)[2][2][4][2], const Unit& u, int wr, int wc, int fr, int fq) const {
        const int row0 = u.pm * BM + wr * 64 + fr; const int col0 = u.pn * BM + wc * 32 + 8 * fq;
#pragma unroll
        for (int ai = 0; ai < 2; ++ai)
#pragma unroll
            for (int m = 0; m < 4; ++m) { const int t = row0 + ai * HALF + m * 16; bf16_t* rowp = O + (size_t)t * ldc + col0;
#pragma unroll
                for (int bj = 0; bj < 2; ++bj) { const f32x4 v0 = acc[ai][bj][m][0], v1 = acc[ai][bj][m][1];
                    u32x4 w; w.x = pk2(v0[0], v0[1]); w.y = pk2(v0[2], v0[3]); w.z = pk2(v1[0], v1[1]); w.w = pk2(v1[2], v1[3]);
                    const int col = col0 + bj * HALF;
                    if (col >= DV0) { const int dvf = col - DV0, hh = dvf >> 7, dv = dvf & 127, tp = t & (SEQ - 1), key = tp & 63;
                        bf16_t* vp = VT + (((((size_t)((t >> 12) * 4 + hh) * 64 + (tp >> 6)) * 4 + (dv >> 5)) * 4 + (key >> 4)) * 16 + (key & 15)) * 32 + (dv & 31);
                        if (col < NIN) *(u32x4*)vp = w; }
                    else *(u32x4*)(rowp + bj * HALF) = w; } }
    }
};
struct EpiResBf16 {
    static constexpr bool PERM = true;
    const float* base; bf16_t* out; int ldc;
    __device__ __forceinline__ void operator()(const f32x4 (&acc)[2][2][4][2], const Unit& u, int wr, int wc, int fr, int fq) const {
        const int col0 = u.pn * BM + wc * 32 + 8 * fq;
#pragma unroll
        for (int ai = 0; ai < 2; ++ai) {
            f32x4 bb[4][2][2];
#pragma unroll
            for (int m = 0; m < 4; ++m) { const size_t off = (size_t)(u.pm * BM + ai * HALF + wr * 64 + m * 16 + fr) * ldc + col0;
#pragma unroll
                for (int bj = 0; bj < 2; ++bj) { bb[m][bj][0] = *(const f32x4*)(base + off + bj * HALF); bb[m][bj][1] = *(const f32x4*)(base + off + bj * HALF + 4); } }
            __builtin_amdgcn_sched_barrier(0);
#pragma unroll
            for (int m = 0; m < 4; ++m) { const size_t off = (size_t)(u.pm * BM + ai * HALF + wr * 64 + m * 16 + fr) * ldc + col0;
#pragma unroll
                for (int bj = 0; bj < 2; ++bj) {
                    const f32x4 v0 = bb[m][bj][0] + acc[ai][bj][m][0], v1 = bb[m][bj][1] + acc[ai][bj][m][1];
                    u32x4 w; w.x = pk2(v0[0], v0[1]); w.y = pk2(v0[2], v0[3]); w.z = pk2(v1[0], v1[1]); w.w = pk2(v1[2], v1[3]);
                    *(u32x4*)(out + off + bj * HALF) = w; } }
            __builtin_amdgcn_sched_barrier(0);
        }
    }
};
struct EpiSwiglu {
    static constexpr bool PERM = true;
    unsigned char* O; const float* b1; const int* tile_e;
    __device__ __forceinline__ void operator()(const f32x4 (&acc)[2][2][4][2], const Unit& u, int wr, int wc, int fr, int fq) const {
        const int e = tile_e[u.pm]; const int row0 = u.pm * BM + wr * 64 + fr; const int hc0 = u.pn * 128 + wc * 32 + 8 * fq;
        const float* bg = b1 + (size_t)e * 2048 + hc0; const float* bl = bg + 1024;
        const f32x4 g0 = *(const f32x4*)bg, g1 = *(const f32x4*)(bg + 4), l0 = *(const f32x4*)bl, l1 = *(const f32x4*)(bl + 4);
#pragma unroll
        for (int ai = 0; ai < 2; ++ai)
#pragma unroll
            for (int m = 0; m < 4; ++m) { unsigned char* rowp = O + (size_t)(row0 + ai * HALF + m * 16) * 1024 + hc0;
                u32x2 w;
#pragma unroll
                for (int n = 0; n < 2; ++n) { const f32x4 gv = acc[ai][0][m][n] + (n ? g1 : g0), lv = acc[ai][1][m][n] + (n ? l1 : l0);
                    f32x4 g, l;
#pragma unroll
                    for (int i = 0; i < 4; ++i) { g[i] = fminf(gv[i], 7.0f); l[i] = __builtin_amdgcn_fmed3f(lv[i], -7.0f, 7.0f); }
                    const f32x4 ea = g * (-1.702f * LOG2E);
                    f32x4 den;
#pragma unroll
                    for (int i = 0; i < 4; ++i) den[i] = __builtin_amdgcn_exp2f(ea[i]);
                    den = den + 1.0f;
                    f32x4 r;
#pragma unroll
                    for (int i = 0; i < 4; ++i) r[i] = __builtin_amdgcn_rcpf(den[i]);
                    const f32x4 o = (g * r) * (l * F8_H_MUL + F8_H_MUL);
                    const unsigned pw_ = pk4_fp8_nc(o[0], o[1], o[2], o[3]);
                    if (n == 0) w.x = pw_; else w.y = pw_; }
                *(u32x2*)rowp = w; }
    }
};
struct EpiGateF8 {
    static constexpr bool PERM = true;
    unsigned char* O; const float* b2; const float* rowgate; const int* tile_e;
    __device__ __forceinline__ void operator()(const f32x4 (&acc)[2][2][4][2], const Unit& u, int wr, int wc, int fr, int fq) const {
        const int e = tile_e[u.pm]; const int row0 = u.pm * BM + wr * 64 + fr; const int col0 = u.pn * BM + wc * 32 + 8 * fq;
        f32x4 bv[2][2];
#pragma unroll
        for (int bj = 0; bj < 2; ++bj)
#pragma unroll
            for (int n = 0; n < 2; ++n) bv[bj][n] = *(const f32x4*)(b2 + (size_t)e * 1024 + col0 + bj * HALF + 4 * n);
#pragma unroll
        for (int ai = 0; ai < 2; ++ai)
#pragma unroll
            for (int m = 0; m < 4; ++m) { const int row = row0 + ai * HALF + m * 16; const float gt = rowgate[row] * F8_Y_MUL; unsigned char* rowp = O + (size_t)row * 1024 + col0;
#pragma unroll
                for (int bj = 0; bj < 2; ++bj) { const f32x4 v0 = (acc[ai][bj][m][0] + bv[bj][0]) * gt, v1 = (acc[ai][bj][m][1] + bv[bj][1]) * gt;
                    u32x2 w; w.x = pk4_fp8(v0[0], v0[1], v0[2], v0[3]); w.y = pk4_fp8(v1[0], v1[1], v1[2], v1[3]);
                    *(u32x2*)(rowp + bj * HALF) = w; } }
    }
};

__device__ __forceinline__ v8i32 pg8_ld32(const LAS unsigned char* p, const LAS unsigned char* q) { const u32x4 a = *(const LAS u32x4*)p, b = *(const LAS u32x4*)q;
    return (v8i32){(int)a.x, (int)a.y, (int)a.z, (int)a.w, (int)b.x, (int)b.y, (int)b.z, (int)b.w}; }
template <bool F8, bool GATHER, class Epi, class Sched>
__device__ __forceinline__ void gemm_phase(LAS unsigned char* lds, const Gemm g, const Sched& S, const Epi& E) {
    const int tid = threadIdx.x, wid = __builtin_amdgcn_readfirstlane(tid >> 6), lane = tid & 63, wr = wid >> 2, wc = wid & 3, fr = lane & 15, fq = lane >> 4;
    const int RB = F8 ? g.K : g.K * 2, nt = RB / 128;
    unsigned voffB[2];
#pragma unroll
    for (int i = 0; i < 2; ++i) { int R, C; if constexpr (F8) stage_rc_f8(tid * 16 + i * 8192, R, C); else stage_rc(tid * 16 + i * 8192, R, C); const int Rb = Epi::PERM ? ((R & ~31) + perm32(R & 31)) : R;
        voffB[i] = (unsigned)(Rb * RB + C * 2); }
#define PG8_AOFFS(dst, pm_) do { _Pragma("unroll") for (int h_ = 0; h_ < 2; ++h_) _Pragma("unroll") for (int i_ = 0; i_ < 2; ++i_) { int R_, C_; if constexpr (F8) stage_rc_f8(tid * 16 + i_ * 8192, R_, C_); else stage_rc(tid * 16 + i_ * 8192, R_, C_); \
        const int row_ = (pm_) * BM + h_ * HALF + R_; const unsigned grow_ = GATHER ? (unsigned)g.rowtok[row_] : (unsigned)row_; dst[h_][i_] = grow_ * (unsigned)RB + (unsigned)(C_ * 2); } } while (0)
    unsigned cvA[2][2], nvA[2][2];
    const size_t kstep = (size_t)(BK * 2);
    const size_t hstep = (size_t)HALF * RB;
    const size_t tstep = 2 * hstep;
    const unsigned ldsw = (unsigned)wid * 1024u;
    const int aoff = F8 ? frag_f8(wr * 64, fr, fq, 0) : lds_byte(wr * 64 + fr, fq * 8); const int aoff1 = F8 ? frag_f8(wr * 64, fr, fq, 1) : 0;
    const int boff = F8 ? frag_f8(wc * 32, fr, fq, 0) : lds_byte(wc * 32 + fr, fq * 8); const int boff1 = F8 ? frag_f8(wc * 32, fr, fq, 1) : 0;
    const int scW = g.scW, scA = g.scA;
#define PG8_SA(b, h) (((b) * 2 + (h)) * HTB)
#define PG8_SB(b, h) ((4 + (b) * 2 + (h)) * HTB)
#define PG8_STAGE(bufoff, gbase, voff) do { _Pragma("unroll") for (int _i = 0; _i < 2; ++_i) \
        __builtin_amdgcn_global_load_lds((const unsigned*)((const char*)(gbase) + (voff)[_i]), (LAS unsigned*)(lds + (bufoff) + ldsw + _i * 8192), 16, 0, 0); } while (0)
typedef int v8i32a __attribute__((ext_vector_type(8), aligned(16)));
#define PG8_LD32(p, q) pg8_ld32(p, q)
#define PG8_STAGE_A(bufoff, kptr, offs) do { _Pragma("unroll") for (int _i = 0; _i < 2; ++_i) \
        __builtin_amdgcn_global_load_lds((const unsigned*)((const char*)(kptr) + (offs)[_i]), (LAS unsigned*)(lds + (bufoff) + ldsw + _i * 8192), 16, 0, 0); } while (0)
#define PG8_LDA(dst, b, h) do { _Pragma("unroll") for (int m = 0; m < 4; ++m) { if constexpr (F8) { dst[m].f8 = PG8_LD32(lds + PG8_SA(b, h) + aoff + m * 2048, lds + PG8_SA(b, h) + aoff1 + m * 2048); } \
        else { _Pragma("unroll") for (int k = 0; k < 2; ++k) dst[m].hv[k] = *(const LAS bf16x8*)(lds + PG8_SA(b, h) + aoff + m * 2048 + k * 1024); } } } while (0)
#define PG8_LDB(dst, b, h) do { _Pragma("unroll") for (int n = 0; n < 2; ++n) { if constexpr (F8) { dst[n].f8 = PG8_LD32(lds + PG8_SB(b, h) + boff + n * 2048, lds + PG8_SB(b, h) + boff1 + n * 2048); } \
        else { _Pragma("unroll") for (int k = 0; k < 2; ++k) dst[n].hv[k] = *(const LAS bf16x8*)(lds + PG8_SB(b, h) + boff + n * 2048 + k * 1024); } } } while (0)
#define PG8_MMA(ai, bj, At, Bt) do { __builtin_amdgcn_s_setprio(1); _Pragma("unroll") for (int m = 0; m < 4; ++m) _Pragma("unroll") for (int n = 0; n < 2; ++n) { \
        if constexpr (F8) { asm volatile("v_mfma_scale_f32_16x16x128_f8f6f4 %0, %1, %2, %0, %3, %4 op_sel_hi:[0,0,0]" : "+v"(acc[ai][bj][m][n]) : "v"(Bt[n].f8), "v"(At[m].f8), "v"(scW), "v"(scA)); } \
        else { _Pragma("unroll") for (int k = 0; k < 2; ++k) acc[ai][bj][m][n] = __builtin_amdgcn_mfma_f32_16x16x32_bf16(Bt[n].hv[k], At[m].hv[k], acc[ai][bj][m][n], 0, 0, 0); } } \
        __builtin_amdgcn_s_setprio(0); } while (0)
#define PG8_WAIT_V(n) asm volatile("s_waitcnt vmcnt(" #n ")" ::: "memory")
#define PG8_WAIT_L(n) asm volatile("s_waitcnt lgkmcnt(" #n ")" ::: "memory")
#define PG8_BAR __builtin_amdgcn_s_barrier()
#define PG8_SCHED __builtin_amdgcn_sched_barrier(0)
    Unit cur, nxt; int ui = 0;
    if (!S.next(0, cur)) return;
    f32x4 acc[2][2][4][2];
#pragma unroll
    for (int a = 0; a < 2; ++a)
#pragma unroll
        for (int b = 0; b < 2; ++b)
#pragma unroll
            for (int m = 0; m < 4; ++m)
#pragma unroll
                for (int n = 0; n < 2; ++n) acc[a][b][m][n] = (f32x4){0.f, 0.f, 0.f, 0.f};
    struct FragH { bf16x8 hv[2]; }; struct Frag8 { v8i32 f8; };
    typename std::conditional<F8, Frag8, FragH>::type At[4], B0[2], B1[2];
    const char* const kA = (const char*)g.A; const char* cB = (const char*)g.Bt + (size_t)cur.pb * tstep;
    PG8_AOFFS(cvA, cur.pm);
    PG8_STAGE(PG8_SB(0, 0), cB, voffB); PG8_STAGE(PG8_SB(0, 1), cB + hstep, voffB); PG8_STAGE_A(PG8_SA(0, 0), kA, cvA[0]); PG8_STAGE_A(PG8_SA(0, 1), kA, cvA[1]);
    if (wr == 1) PG8_BAR;
    PG8_WAIT_V(2); PG8_BAR;
    PG8_STAGE(PG8_SB(1, 0), cB + kstep, voffB); PG8_STAGE_A(PG8_SA(1, 0), kA + kstep, cvA[0]); PG8_STAGE(PG8_SB(1, 1), cB + hstep + kstep, voffB);
    PG8_WAIT_V(6); PG8_BAR;
    for (;;) {
        const bool has_next = S.next(ui + 1, nxt);
        const char* nB = has_next ? (const char*)g.Bt + (size_t)nxt.pb * tstep : cB;
        if (has_next) { PG8_AOFFS(nvA, nxt.pm); } else { _Pragma("unroll") for (int h_ = 0; h_ < 2; ++h_) _Pragma("unroll") for (int i_ = 0; i_ < 2; ++i_) nvA[h_][i_] = cvA[h_][i_]; }
#pragma clang loop unroll(disable)
        for (int t = 0; t < nt; t += 2) {
            const bool last = (t == nt - 2);
            const char* a1 = kA + (size_t)(t + 1) * kstep;
            const char* a2 = last ? kA : kA + (size_t)(t + 2) * kstep; const char* b2 = last ? nB : cB + (size_t)(t + 2) * kstep;
            const char* a3 = a2 + kstep; const char* b3 = b2 + kstep;
            unsigned v2A[2][2];
#pragma unroll
            for (int h_ = 0; h_ < 2; ++h_)
#pragma unroll
                for (int i_ = 0; i_ < 2; ++i_) v2A[h_][i_] = last ? nvA[h_][i_] : cvA[h_][i_];
            PG8_LDB(B0, 0, 0); PG8_LDB(B1, 0, 1); PG8_SCHED; PG8_LDA(At, 0, 0); PG8_STAGE_A(PG8_SA(1, 1), a1, cvA[1]);
            PG8_WAIT_V(8); PG8_WAIT_L(0); PG8_BAR; PG8_MMA(0, 0, At, B0); PG8_MMA(0, 1, At, B1); PG8_BAR; PG8_SCHED;
            PG8_LDA(At, 0, 1); PG8_STAGE(PG8_SB(0, 0), b2, voffB); PG8_STAGE(PG8_SB(0, 1), b2 + hstep, voffB); PG8_STAGE_A(PG8_SA(0, 0), a2, v2A[0]);
            PG8_WAIT_V(8); PG8_WAIT_L(0); PG8_BAR; PG8_MMA(1, 0, At, B0); PG8_MMA(1, 1, At, B1); PG8_BAR; PG8_SCHED;
            PG8_LDB(B0, 1, 0); PG8_LDB(B1, 1, 1); PG8_SCHED; PG8_LDA(At, 1, 0); PG8_STAGE_A(PG8_SA(0, 1), a2, v2A[1]);
            PG8_WAIT_V(8); PG8_WAIT_L(0); PG8_BAR; PG8_MMA(0, 0, At, B0); PG8_MMA(0, 1, At, B1); PG8_BAR; PG8_SCHED;
            PG8_LDA(At, 1, 1); PG8_STAGE(PG8_SB(1, 0), b3, voffB); PG8_STAGE(PG8_SB(1, 1), b3 + hstep, voffB); PG8_STAGE_A(PG8_SA(1, 0), a3, v2A[0]);
            PG8_WAIT_V(8); PG8_WAIT_L(0); PG8_BAR; PG8_MMA(1, 0, At, B0); PG8_MMA(1, 1, At, B1); PG8_BAR; PG8_SCHED;
        }
        if (wr == 0) PG8_BAR;
        if constexpr (F8) asm volatile("s_nop 15\n\ts_nop 15" ::: "memory");
        E(acc, cur, wr, wc, fr, fq);
        if (!has_next) break;
#pragma unroll
        for (int a = 0; a < 2; ++a)
#pragma unroll
            for (int b = 0; b < 2; ++b)
#pragma unroll
                for (int m = 0; m < 4; ++m)
#pragma unroll
                    for (int n = 0; n < 2; ++n) acc[a][b][m][n] = (f32x4){0.f, 0.f, 0.f, 0.f};
        cur = nxt; cB = nB; ++ui;
#pragma unroll
        for (int h_ = 0; h_ < 2; ++h_)
#pragma unroll
            for (int i_ = 0; i_ < 2; ++i_) cvA[h_][i_] = nvA[h_][i_];
        if (wr == 1) PG8_BAR;
    }
    PG8_WAIT_V(0);
    PG8_BAR;
#undef PG8_SA
#undef PG8_SB
#undef PG8_STAGE
#undef PG8_STAGE_A
#undef PG8_AOFFS
#undef PG8_LDA
#undef PG8_LDB
#undef PG8_MMA
#undef PG8_LD32
#undef PG8_WAIT_V
#undef PG8_WAIT_L
#undef PG8_BAR
#undef PG8_SCHED
}
}

struct Args { const float* in[30]; float* out; unsigned char* ws; int ph_lo, ph_hi; };

__device__ __forceinline__ void p0_transpose_item(const float* W, int K, int N, bf16_t* WT, int k0, int n0, int drow0, LAS float* scr, int lane) {
#pragma unroll 8
    for (int i = 0; i < 32; ++i) { const int kk = 2 * i + (lane >> 5); scr[kk * 33 + (lane & 31)] = __builtin_nontemporal_load(W + (size_t)(k0 + kk) * N + n0 + (lane & 31)); }
    asm volatile("s_waitcnt lgkmcnt(0)" ::: "memory");
    const int c = lane & 7;
#pragma unroll
    for (int j = 0; j < 4; ++j) { const int n = (lane >> 3) + 8 * j; const LAS float* s = scr + (8 * c) * 33 + n;
        u32x4 o; o.x = pk2(s[0 * 33], s[1 * 33]); o.y = pk2(s[2 * 33], s[3 * 33]); o.z = pk2(s[4 * 33], s[5 * 33]); o.w = pk2(s[6 * 33], s[7 * 33]);
        *(u32x4*)(WT + (size_t)(drow0 + n) * K + k0 + 8 * c) = o; }
    asm volatile("s_waitcnt lgkmcnt(0)" ::: "memory");
}
__device__ __forceinline__ void p0_transpose_item_f8(const float* W, int K, int N, unsigned char* WT, int k0, int n0, int drow0, LAS float* scr, int lane) {
    LAS unsigned* tile = (LAS unsigned*)scr;
    const float* src = W + (size_t)k0 * N + n0 + lane;
#pragma unroll 1
    for (int kb = 0; kb < 32; kb += 16) {
        float v[16][4];
#pragma unroll
        for (int i = 0; i < 16; ++i) { const float* p = src + (size_t)(4 * (kb + i)) * N;
#pragma unroll
            for (int j = 0; j < 4; ++j) v[i][j] = __builtin_nontemporal_load(p + (size_t)j * N); }
        __builtin_amdgcn_sched_barrier(0);
#pragma unroll
        for (int i = 0; i < 16; ++i) tile[lane * 33 + kb + i] = pk4_fp8(v[i][0] * F8_W_MUL, v[i][1] * F8_W_MUL, v[i][2] * F8_W_MUL, v[i][3] * F8_W_MUL);
        __builtin_amdgcn_sched_barrier(0);
    }
    asm volatile("s_waitcnt lgkmcnt(0)" ::: "memory");
    const int c = lane & 7;
#pragma unroll
    for (int j = 0; j < 8; ++j) { const int n = (lane >> 3) + 8 * j; const LAS unsigned* t = tile + n * 33 + 4 * c;
        __builtin_nontemporal_store((u32x4){t[0], t[1], t[2], t[3]}, (u32x4*)(WT + (size_t)(drow0 + n) * K + k0 + 16 * c)); }
    asm volatile("s_waitcnt lgkmcnt(0)" ::: "memory");
}
constexpr int CONV_I_W1 = 8 * 32, CONV_I_W2 = 8 * 16;
constexpr int CONV_ITEMS_F8 = NE * (CONV_I_W1 + CONV_I_W2) / 8;
constexpr int CONV_ITEMS = CONV_ITEMS_F8 + 64;
__device__ __forceinline__ void conv_item(LAS unsigned char* lds, const Args& a, int bi) {
    int tid_ = threadIdx.x; asm volatile("" : "+v"(tid_));
    const int lane = tid_ & 63, wave = __builtin_amdgcn_readfirstlane(threadIdx.x >> 6);
    LAS float* scr = (LAS float*)(lds + wave * 16384);
    unsigned char* W1t = a.ws + WS_W1T; unsigned char* W2t = a.ws + WS_W2T;
    if (bi >= CONV_ITEMS_F8) { const int r = (bi - CONV_ITEMS_F8) * 8 + wave, kb = r / 32, nb = r % 32;
        p0_transpose_item(a.in[22], 1024, 1024, (bf16_t*)(a.ws + WS_WOUT), 64 * kb, 32 * nb, 32 * nb, scr, lane); return; }
    int r = bi * 8 + wave;
    if (r < NE * CONV_I_W1) { const int e = r / CONV_I_W1, q = r % CONV_I_W1, kb = q / 32, nb = q % 32; const int n0 = 64 * nb;
        const int drow = (n0 < 1024) ? ((n0 >> 7) * 256 + (n0 & 127)) : (((n0 - 1024) >> 7) * 256 + 128 + ((n0 - 1024) & 127));
        p0_transpose_item_f8(a.in[26] + (size_t)e * 1024 * 2048, 1024, 2048, W1t + (size_t)e * 2048 * 1024, 128 * kb, n0, drow, scr, lane); }
    else { r -= NE * CONV_I_W1; const int e = r / CONV_I_W2, q = r % CONV_I_W2, kb = q / 16, nb = q % 16;
        p0_transpose_item_f8(a.in[28] + (size_t)e * 1024 * 1024, 1024, 1024, W2t + (size_t)e * 1024 * 1024, 128 * kb, 64 * nb, 64 * nb, scr, lane); }
}
__device__ __forceinline__ void p0_prologue(LAS unsigned char* lds, const Args& a, int G) {
    const int tid = threadIdx.x, lane = tid & 63, wave = __builtin_amdgcn_readfirstlane(tid >> 6);
    LAS float* scr = (LAS float*)(lds + wave * 16384);
    const int gw = blockIdx.x * 8 + wave, NGW = G * 8;
    unsigned char* ws = a.ws;
    bf16_t* Wint = (bf16_t*)(ws + WS_WINT); bf16_t* Woutt = (bf16_t*)(ws + WS_WOUT);
    constexpr int I_IN = 16 * (NIN / 32);
    constexpr int I_OUT = 16 * 32;
    for (int r = gw; r < I_IN; r += NGW) { const int nblk = NIN / 32, kb = r / nblk, nb = r % nblk; p0_transpose_item(a.in[2], 1024, NIN, Wint, 64 * kb, 32 * nb, 32 * nb, scr, lane); }
    { bf16_t* LW = (bf16_t*)(ws + WS_LW);
      for (int i = gw * 64 + lane; i < CW * 160; i += NGW * 64) { const int col = i / 160, k = i - col * 160;
          const float v = k < 32 ? a.in[5][k * CW + col] : (k < 64 ? a.in[7][(k - 32) * CW + col] : a.in[8][(k - 64) * CW + col]); LW[i] = (bf16_t)f2bf(v); } }
    const float* x = a.in[0]; const float* g1 = a.in[1]; bf16_t* XN = (bf16_t*)(ws + WS_XN);
    f32x4 gv[4];
#pragma unroll
    for (int j = 0; j < 4; ++j) gv[j] = *((const f32x4*)g1 + lane + 64 * j);
#pragma unroll 4
    for (int m = gw; m < T; m += NGW) {
        const f32x4* xr = (const f32x4*)(x + (size_t)m * D) + lane;
        f32x4 v[4]; float s = 0.f;
#pragma unroll
        for (int j = 0; j < 4; ++j) { v[j] = __builtin_nontemporal_load(xr + 64 * j); s += (v[j].x * v[j].x + v[j].y * v[j].y) + (v[j].z * v[j].z + v[j].w * v[j].w); }
        const float rstd = 1.0f / sqrtf(wave_sum(s) * (1.0f / D) + 1e-5f);
        u32x2* o8 = (u32x2*)(XN + (size_t)m * D) + lane;
#pragma unroll
        for (int j = 0; j < 4; ++j) { u32x2 w; w.x = pk2(v[j].x * rstd * gv[j].x, v[j].y * rstd * gv[j].y); w.y = pk2(v[j].z * rstd * gv[j].z, v[j].w * rstd * gv[j].w); o8[64 * j] = w; }
    }
}

__device__ __forceinline__ f32x4 cvlo(const u32x4 u) { return (f32x4){bflo(u.x), bfhi(u.x), bflo(u.y), bfhi(u.y)}; }
__device__ __forceinline__ f32x4 cvhi(const u32x4 u) { return (f32x4){bflo(u.z), bfhi(u.z), bflo(u.w), bfhi(u.w)}; }
__device__ __forceinline__ u32x4 pk8(const f32x4 lo, const f32x4 hi) { u32x4 w; w.x = pk2(lo.x, lo.y); w.y = pk2(lo.z, lo.w); w.z = pk2(hi.x, hi.y); w.w = pk2(hi.z, hi.w); return w; }

namespace ck {
constexpr int PS = 136;
constexpr int O_BT = 0, O_KT = 8704, O_AP = 17408, O_RT = 26112;
constexpr int O_AT = 34816, O_BH = 43008, O_KH = 51200, O_VV = 59392, O_TN = 67584, O_A2 = 75776, O_V2 = 83968;
constexpr int O_L = 92160, LSTR = 68;
constexpr int O_TOT = 109568, O_GC = 111616;
constexpr int O_PT = 132608;
constexpr int O_ACT = 112128;
__device__ __forceinline__ int crow(int r, int hi) { return (r & 3) + 8 * (r >> 2) + 4 * hi; }
__device__ __forceinline__ int voff(int row, int col) { return ((col >> 5) * 4 + (row >> 4)) * 1024 + (row & 15) * 64 + (col & 31) * 2; }
__device__ __forceinline__ s16x4 vtr(const LAS unsigned char* p) { return __builtin_bit_cast(s16x4, __builtin_amdgcn_ds_read_tr16_b64_v4i16((LAS s16x4*)p)); }
__device__ __forceinline__ bf16x8 fragP(const LAS unsigned char* M, int row, int k0, int hi) {
    const LAS unsigned char* p = M + row * PS + (k0 + 4 * hi) * 2; const s16x4 lo = *(const LAS s16x4*)p, h = *(const LAS s16x4*)(p + 16);
    return (bf16x8){lo[0], lo[1], lo[2], lo[3], h[0], h[1], h[2], h[3]}; }
__device__ __forceinline__ bf16x8 fragT(const LAS unsigned char* M, int k0, int colblk, int lane, int hi) {
    const LAS unsigned char* p = M + (colblk * 4 + (k0 >> 4)) * 1024 + ((lane >> 4) & 1) * 32 + (lane & 3) * 8 + (4 * hi + ((lane & 15) >> 2)) * 64;
    const s16x4 lo = vtr(p), h = vtr(p + 512); return (bf16x8){lo[0], lo[1], lo[2], lo[3], h[0], h[1], h[2], h[3]}; }
__device__ __forceinline__ bf16x8 packR(const f32x16& x, int s) {
    u32x4 w; w.x = pk2(x[8 * s], x[8 * s + 1]); w.y = pk2(x[8 * s + 2], x[8 * s + 3]); w.z = pk2(x[8 * s + 4], x[8 * s + 5]); w.w = pk2(x[8 * s + 6], x[8 * s + 7]); return __builtin_bit_cast(bf16x8, w); }
#define CK_MFMA(a, b, c) __builtin_amdgcn_mfma_f32_32x32x16_bf16(a, b, c, 0, 0, 0)
__device__ __forceinline__ f32x16 score(const LAS unsigned char* Am, const LAS unsigned char* Bm, int sblk, int tblk, int mode, int r32, int hi) {
    f32x16 x = f32x16{};
#pragma unroll
    for (int ks = 0; ks < 4; ++ks) x = CK_MFMA(fragP(Am, sblk * 32 + r32, 16 * ks, hi), fragP(Bm, tblk * 32 + r32, 16 * ks, hi), x);
    if (mode) {
        const int t = tblk * 32 + r32;
#pragma unroll
        for (int r = 0; r < 16; ++r) { const int s = sblk * 32 + crow(r, hi); if (mode == 1 ? !(s < t) : !(s <= t)) x[r] = 0.f; }
    }
    return x;
}
__device__ __forceinline__ void storeT_V(LAS unsigned char* M, const f32x16& x, int rb, int c, int hi) {
#pragma unroll
    for (int q = 0; q < 4; ++q) { u32x2 w; w.x = pk2(x[4 * q], x[4 * q + 1]); w.y = pk2(x[4 * q + 2], x[4 * q + 3]); *(LAS u32x2*)(M + voff(c, rb * 32 + 8 * q + 4 * hi)) = w; }
}
__device__ __forceinline__ void storeT_S(LAS unsigned char* M, const f32x16& x, int rb, int c, int hi) {
#pragma unroll
    for (int q = 0; q < 4; ++q) { u32x2 w; w.x = pk2(x[4 * q], x[4 * q + 1]); w.y = pk2(x[4 * q + 2], x[4 * q + 3]); *(LAS u32x2*)(M + c * PS + (rb * 32 + 8 * q + 4 * hi) * 2) = w; }
}

struct RowPre { u32x4 cu_r, pu_r, cu_v, pu_v, cu_k, pu_k; };
__device__ __forceinline__ void row_prefetch(RowPre& rp, const Args& a, int item) {
    int tid = threadIdx.x; asm volatile("" : "+v"(tid));
    const int bh = item >> 6, c = item & 63, b = bh >> 3, h = bh & 7, tokc = b * SEQ + c * 64, col0 = h * 64;
    const int tl = tid >> 3, c8 = (tid & 7) * 8, cr = col0 + c8, t = tokc + tl;
    const bf16_t* pr = (const bf16_t*)(a.ws + WS_P) + (size_t)t * NINP + cr;
    const bool first = (t & (SEQ - 1)) == 0; const u32x4 zz = (u32x4){0u, 0u, 0u, 0u};
    rp.cu_r = __builtin_nontemporal_load((const u32x4*)(pr)); rp.pu_r = first ? zz : __builtin_nontemporal_load((const u32x4*)(pr - NINP));
    rp.cu_v = __builtin_nontemporal_load((const u32x4*)(pr + 1024)); rp.pu_v = first ? zz : __builtin_nontemporal_load((const u32x4*)(pr - NINP + 1024));
    rp.cu_k = __builtin_nontemporal_load((const u32x4*)(pr + 512)); rp.pu_k = first ? zz : __builtin_nontemporal_load((const u32x4*)(pr - NINP + 512));
}
__device__ __forceinline__ void chunk_item(LAS unsigned char* lds, const Args& a, int item, const RowPre& rp) {
    int tid = threadIdx.x; asm volatile("" : "+v"(tid)); int lane = tid & 63; const int wave = __builtin_amdgcn_readfirstlane(tid >> 6);
#define CK_FRESH() asm volatile("" : "+v"(lane)); r32 = lane & 31; hi = lane >> 5
    int r32, hi; CK_FRESH();
    unsigned char* ws = a.ws;
    const bf16_t* SR = (const bf16_t*)(ws + WS_SR); const bf16_t* SK = (const bf16_t*)(ws + WS_SK); const bf16_t* SV = (const bf16_t*)(ws + WS_SV);
    const bf16_t* SA = (const bf16_t*)(ws + WS_SA); const bf16_t* SB = (const bf16_t*)(ws + WS_SB); const float* SW = (const float*)(ws + WS_SW);
    bf16_t* CG = (bf16_t*)(ws + WS_CG) + (size_t)item * 4096; bf16_t* CH = (bf16_t*)(ws + WS_CH) + (size_t)item * 4096;
    bf16_t* CR2 = (bf16_t*)(ws + WS_CR2) + (size_t)item * 4096; bf16_t* CY0 = (bf16_t*)(ws + WS_CY0) + (size_t)item * 4096;
    const int bh = item >> 6, c = item & 63, b = bh >> 3, h = bh & 7, tokc = b * SEQ + c * 64, col0 = h * 64;
    LAS unsigned char* BT = lds + O_BT; LAS unsigned char* KT = lds + O_KT; LAS unsigned char* AP = lds + O_AP; LAS unsigned char* RT = lds + O_RT;
    LAS unsigned char* AT = lds + O_AT; LAS unsigned char* BH = lds + O_BH; LAS unsigned char* KH = lds + O_KH; LAS unsigned char* VV = lds + O_VV;
    LAS unsigned char* TN = lds + O_TN; LAS unsigned char* A2M = lds + O_A2; LAS unsigned char* V2M = lds + O_V2;
    LAS float* L = (LAS float*)(lds + O_L); LAS float* TOT = (LAS float*)(lds + O_TOT); LAS float* GC = (LAS float*)(lds + O_GC);
    {
        const int tl = tid >> 3, c8 = (tid & 7) * 8, cr = col0 + c8, t = tokc + tl;
        const bf16_t* P = (const bf16_t*)(ws + WS_P); const bf16_t* pr = P + (size_t)t * NINP + cr;
        bf16_t* SVo = (bf16_t*)(ws + WS_SV); bf16_t* SGo = (bf16_t*)(ws + WS_SG); bf16_t* QN = (bf16_t*)(ws + WS_QN); bf16_t* KN = (bf16_t*)(ws + WS_KN);
        const LAS float* PT = (const LAS float*)(lds + O_PT);
        const bool first = (t & (SEQ - 1)) == 0; const u32x4 zz = (u32x4){0u, 0u, 0u, 0u};
#define CK_PK8(v) ((u32x4){pk2(v[0], v[1]), pk2(v[2], v[3]), pk2(v[4], v[5]), pk2(v[6], v[7])})
#define CK_ST_P(M, val_) do { LAS unsigned char* d_ = (M) + tl * PS + c8 * 2; const u32x4 q_ = (val_); *(LAS u32x2*)d_ = (u32x2){q_[0], q_[1]}; *(LAS u32x2*)(d_ + 8) = (u32x2){q_[2], q_[3]}; } while (0)
        const u32x4 cu_r = rp.cu_r, pu_r = rp.pu_r, cu_v = rp.cu_v, pu_v = rp.pu_v, cu_k = rp.cu_k, pu_k = rp.pu_k;
        const u32x4 uq = __builtin_nontemporal_load((const u32x4*)(pr + DQ0)), ukd = __builtin_nontemporal_load((const u32x4*)(pr + DK0));
        __builtin_amdgcn_sched_barrier(0);
        float g[8], gp[8], ig[8], gC[8];
        {
            const u32x4 deu = *(const LAS u32x4*)(TN + tl * 128 + c8 * 2); const f32x4 de0 = cvlo(deu), de1 = cvhi(deu);
            float wv[8] = {__builtin_amdgcn_exp2f(de0.x), __builtin_amdgcn_exp2f(de0.y), __builtin_amdgcn_exp2f(de0.z), __builtin_amdgcn_exp2f(de0.w), __builtin_amdgcn_exp2f(de1.x), __builtin_amdgcn_exp2f(de1.y), __builtin_amdgcn_exp2f(de1.z), __builtin_amdgcn_exp2f(de1.w)};
            float p[8];
#pragma unroll
            for (int j = 0; j < 8; ++j) p[j] = wv[j];
#pragma unroll
            for (int d = 8; d < 64; d <<= 1) {
#pragma unroll
                for (int j = 0; j < 8; ++j) { const float q = __shfl_up(p[j], d); if (lane >= d) p[j] *= q; }
            }
            if ((lane >> 3) == 7) { *(LAS f32x4*)(TOT + wave * 64 + c8) = (f32x4){p[0], p[1], p[2], p[3]}; *(LAS f32x4*)(TOT + wave * 64 + c8 + 4) = (f32x4){p[4], p[5], p[6], p[7]}; }
            __syncthreads();
            float pre[8];
#pragma unroll
            for (int j = 0; j < 8; ++j) { pre[j] = 1.f; gC[j] = 1.f; }
#pragma unroll
            for (int w2 = 0; w2 < 8; ++w2) { const f32x4 t0 = *(const LAS f32x4*)(TOT + w2 * 64 + c8), t1 = *(const LAS f32x4*)(TOT + w2 * 64 + c8 + 4);
                const float tv[8] = {t0.x, t0.y, t0.z, t0.w, t1.x, t1.y, t1.z, t1.w};
                if (w2 < wave) { asm volatile("" ::: "memory");
#pragma unroll
                    for (int j = 0; j < 8; ++j) pre[j] *= tv[j]; }
#pragma unroll
                for (int j = 0; j < 8; ++j) gC[j] *= tv[j]; }
            if (tid < 8) { *(LAS f32x4*)(GC + c8) = (f32x4){gC[0], gC[1], gC[2], gC[3]}; *(LAS f32x4*)(GC + c8 + 4) = (f32x4){gC[4], gC[5], gC[6], gC[7]}; }
#pragma unroll
            for (int j = 0; j < 8; ++j) { g[j] = pre[j] * p[j]; ig[j] = __builtin_amdgcn_rcpf(g[j]); gp[j] = g[j] * __builtin_amdgcn_rcpf(wv[j]); }
        }
        f32x4 r0, r1;
        { const u32x4 cu = cu_r, pu = pu_r;
          const f32x4 m0 = *(const LAS f32x4*)(PT + cr), m1 = *(const LAS f32x4*)(PT + cr + 4); const f32x4 c0 = cvlo(cu), c1 = cvhi(cu), p0 = cvlo(pu), p1 = cvhi(pu);
          r0 = c0 + (p0 - c0) * m0; r1 = c1 + (p1 - c1) * m1;
          const float rt[8] = {r0.x * g[0], r0.y * g[1], r0.z * g[2], r0.w * g[3], r1.x * g[4], r1.y * g[5], r1.z * g[6], r1.w * g[7]};
          CK_ST_P(RT, CK_PK8(rt)); }
        { const u32x4 cu = cu_v, pu = pu_v;
          const f32x4 m0 = *(const LAS f32x4*)(PT + 1024 + cr), m1 = *(const LAS f32x4*)(PT + 1024 + cr + 4); const f32x4 c0 = cvlo(cu), c1 = cvhi(cu), p0 = cvlo(pu), p1 = cvhi(pu);
          const u32x4 uv = pk8(c0 + (p0 - c0) * m0, c1 + (p1 - c1) * m1); *(u32x4*)(SVo + (size_t)t * CW + cr) = uv; *(LAS u32x4*)(VV + voff(tl, c8)) = uv; }
        *(u32x4*)(SGo + (size_t)t * CW + cr) = *(const LAS u32x4*)(V2M + tl * 128 + c8 * 2);
        { const u32x4 cu = cu_k, pu = pu_k;
          const f32x4 m0 = *(const LAS f32x4*)(PT + 512 + cr), m1 = *(const LAS f32x4*)(PT + 512 + cr + 4); const f32x4 c0 = cvlo(cu), c1 = cvhi(cu), p0 = cvlo(pu), p1 = cvhi(pu);
          const f32x4 k0 = c0 + (p0 - c0) * m0, k1 = c1 + (p1 - c1) * m1;
          const u32x4 alu = *(const LAS u32x4*)(A2M + tl * 128 + c8 * 2); const f32x4 al0 = cvlo(alu), al1 = cvhi(alu);
          const f32x4 kk0 = k0 * *(const LAS f32x4*)(PT + 1536 + cr), kk1 = k1 * *(const LAS f32x4*)(PT + 1536 + cr + 4);
          const float ss = red8((kk0.x * kk0.x + kk0.y * kk0.y) + (kk0.z * kk0.z + kk0.w * kk0.w) + (kk1.x * kk1.x + kk1.y * kk1.y) + (kk1.z * kk1.z + kk1.w * kk1.w));
          const float inv = __builtin_amdgcn_rsqf(fmaxf(ss, 1e-24f));
          const f32x4 kn0 = kk0 * inv, kn1 = kk1 * inv;
          const f32x4 k20 = k0 * (1.0f + (al0 - 1.0f) * *(const LAS f32x4*)(PT + 2048 + cr)), k21 = k1 * (1.0f + (al1 - 1.0f) * *(const LAS f32x4*)(PT + 2048 + cr + 4));
          { const f32x4 q0 = r0 * k20 * *(const LAS f32x4*)(PT + 2560 + cr), q1 = r1 * k21 * *(const LAS f32x4*)(PT + 2560 + cr + 4);
            const float rk = red8((q0.x + q0.y) + (q0.z + q0.w) + (q1.x + q1.y) + (q1.z + q1.w));
            if ((lane & 7) == 0) ((float*)(ws + WS_RK))[(size_t)t * 8 + h] = rk; }
          const float kv[8] = {k20.x, k20.y, k20.z, k20.w, k21.x, k21.y, k21.z, k21.w}, nv[8] = {kn0.x, kn0.y, kn0.z, kn0.w, kn1.x, kn1.y, kn1.z, kn1.w}, av_[8] = {al0.x, al0.y, al0.z, al0.w, al1.x, al1.y, al1.z, al1.w};
          float at[8], bt[8], kt[8], bh[8], kh[8];
#pragma unroll
          for (int j = 0; j < 8; ++j) { at[j] = -nv[j] * gp[j]; bt[j] = nv[j] * av_[j] * ig[j]; kt[j] = kv[j] * ig[j]; bh[j] = bt[j] * gC[j]; kh[j] = kt[j] * gC[j]; }
          const u32x4 wa = CK_PK8(at);
          CK_ST_P(AP, wa); *(LAS u32x4*)(AT + voff(tl, c8)) = wa;
          CK_ST_P(BT, CK_PK8(bt)); CK_ST_P(KT, CK_PK8(kt));
          *(LAS u32x4*)(BH + voff(tl, c8)) = CK_PK8(bh); *(LAS u32x4*)(KH + voff(tl, c8)) = CK_PK8(kh); }
        {
          const f32x4 q0 = cvlo(uq), q1 = cvhi(uq), d0 = cvlo(ukd), d1 = cvhi(ukd);
          const float qs = red8((q0.x * q0.x + q0.y * q0.y) + (q0.z * q0.z + q0.w * q0.w) + (q1.x * q1.x + q1.y * q1.y) + (q1.z * q1.z + q1.w * q1.w));
          const float ks = red8((d0.x * d0.x + d0.y * d0.y) + (d0.z * d0.z + d0.w * d0.w) + (d1.x * d1.x + d1.y * d1.y) + (d1.z * d1.z + d1.w * d1.w));
          const float qi = __builtin_amdgcn_rsqf(qs * (1.0f / 64.0f) + 1e-5f) * (0.125f * LOG2E), ki = __builtin_amdgcn_rsqf(ks * (1.0f / 64.0f) + 1e-5f);
          const f32x4 g0 = *(const LAS f32x4*)(PT + 3072 + c8), g1 = *(const LAS f32x4*)(PT + 3072 + c8 + 4), h0 = *(const LAS f32x4*)(PT + 3136 + c8), h1 = *(const LAS f32x4*)(PT + 3136 + c8 + 4);
          *(u32x4*)(QN + (size_t)t * CW + cr) = pk8(q0 * qi * g0, q1 * qi * g1);
          const size_t ko = ((((size_t)(b * 8 + h) * 64 + c) * 8 + (c8 >> 3)) * 64 + tl) * 8;
          *(u32x4*)(KN + ko) = pk8(d0 * ki * h0, d1 * ki * h1); }
#undef CK_PK8
#undef CK_ST_P
    }
    __syncthreads();
    CK_FRESH();
    f32x16 pa = f32x16{}, pb = f32x16{}, pc = f32x16{}, pd = f32x16{};
#define w1a pa
#define w1b pb
#define xb0 pa
#define xb1 pb
#define y0a pc
#define y0b pd
    if (wave < 2) {
        for (int k = 0; k < (wave == 0 ? 2 : 1); ++k) {
            const int sblk = wave == 0 ? k : 0, tblk = wave == 0 ? k : 1;
            const f32x16 x = score(BT, AP, sblk, tblk, wave == 0 ? 1 : 0, r32, hi);
            const int t = tblk * 32 + r32;
#pragma unroll
            for (int r = 0; r < 16; ++r) L[(sblk * 32 + crow(r, hi)) * LSTR + t] = x[r];
        }
    }
    __syncthreads();
    CK_FRESH();
    if (wave == 6) {
        float x[32];
#pragma unroll
        for (int t = 0; t < 32; ++t) x[t] = (r32 == t) ? 1.f : 0.f;
        const LAS float* Nr = L + (32 * hi) * LSTR + 32 * hi;
#pragma unroll
        for (int sidx = 0; sidx < 31; ++sidx) {
#pragma unroll
            for (int g4 = (sidx + 1) / 4; g4 < 8; ++g4) {
                const f32x4 nv = *(const LAS f32x4*)(Nr + sidx * LSTR + 4 * g4);
                if (4 * g4 + 0 > sidx) x[4 * g4 + 0] += nv.x * x[sidx];
                if (4 * g4 + 1 > sidx) x[4 * g4 + 1] += nv.y * x[sidx];
                if (4 * g4 + 2 > sidx) x[4 * g4 + 2] += nv.z * x[sidx];
                if (4 * g4 + 3 > sidx) x[4 * g4 + 3] += nv.w * x[sidx];
            }
            if ((sidx & 3) == 3) __builtin_amdgcn_sched_barrier(0);
        }
        const int cc = 32 * hi + r32;
#pragma unroll
        for (int t0 = 0; t0 < 32; t0 += 8) { u32x4 w; w.x = pk2(x[t0], x[t0 + 1]); w.y = pk2(x[t0 + 2], x[t0 + 3]); w.z = pk2(x[t0 + 4], x[t0 + 5]); w.w = pk2(x[t0 + 6], x[t0 + 7]);
            *(LAS u32x4*)(TN + voff(cc, 32 * hi + t0)) = w; }
        f32x16 m = f32x16{};
#pragma unroll
        for (int s = 0; s < 2; ++s) {
            const LAS float* lp = L + (16 * s + 4 * hi) * LSTR + 32 + r32;
            u32x4 aw; aw.x = pk2(lp[0], lp[LSTR]); aw.y = pk2(lp[2 * LSTR], lp[3 * LSTR]); aw.z = pk2(lp[8 * LSTR], lp[9 * LSTR]); aw.w = pk2(lp[10 * LSTR], lp[11 * LSTR]);
            const s16x4 b0 = *(const LAS s16x4*)(TN + voff(r32, 16 * s + 4 * hi)), b1 = *(const LAS s16x4*)(TN + voff(r32, 16 * s + 8 + 4 * hi));
            m = CK_MFMA(__builtin_bit_cast(bf16x8, aw), ((bf16x8){b0[0], b0[1], b0[2], b0[3], b1[0], b1[1], b1[2], b1[3]}), m);
        }
        f32x16 t21 = f32x16{};
#pragma unroll
        for (int s = 0; s < 2; ++s) t21 = CK_MFMA(fragT(TN, 32 + 16 * s, 1, lane, hi), packR(m, s), t21);
        storeT_V(TN, t21, 1, r32, hi);
    } else if (wave < 4) {
        const int dvb = wave - 2;
        const f32x16 x00 = score(KT, AP, 0, 0, 1, r32, hi), x01 = score(KT, AP, 0, 1, 0, r32, hi), x11 = score(KT, AP, 1, 1, 1, r32, hi);
#pragma unroll
        for (int s = 0; s < 2; ++s) {
            const bf16x8 v0 = fragT(VV, 16 * s, dvb, lane, hi), v1 = fragT(VV, 32 + 16 * s, dvb, lane, hi);
            w1a = CK_MFMA(packR(x00, s), v0, w1a);
            w1b = CK_MFMA(packR(x01, s), v0, w1b);
            w1b = CK_MFMA(packR(x11, s), v1, w1b);
        }
    } else if (wave < 6) {
        const int tb = wave - 4;
        f32x16 xk0, xk1 = f32x16{};
        if (tb == 0) { xk0 = score(KT, RT, 0, 0, 2, r32, hi); xb0 = score(BT, RT, 0, 0, 2, r32, hi); }
        else { xk0 = score(KT, RT, 0, 1, 0, r32, hi); xk1 = score(KT, RT, 1, 1, 2, r32, hi); xb0 = score(BT, RT, 0, 1, 0, r32, hi); xb1 = score(BT, RT, 1, 1, 2, r32, hi); }
#pragma unroll
        for (int s = 0; s < 2; ++s) {
            y0a = CK_MFMA(fragT(VV, 16 * s, 0, lane, hi), packR(xk0, s), y0a);
            y0b = CK_MFMA(fragT(VV, 16 * s, 1, lane, hi), packR(xk0, s), y0b);
            if (tb == 1) { y0a = CK_MFMA(fragT(VV, 32 + 16 * s, 0, lane, hi), packR(xk1, s), y0a); y0b = CK_MFMA(fragT(VV, 32 + 16 * s, 1, lane, hi), packR(xk1, s), y0b); }
        }
    }
    __syncthreads();
    CK_FRESH();
    if (wave < 2) {
        const int cb = wave; f32x16 a0 = f32x16{}, a1 = f32x16{};
#pragma unroll
        for (int ks = 0; ks < 4; ++ks) {
            const bf16x8 af = fragT(AT, 16 * ks, cb, lane, hi);
            if (ks < 2) a0 = CK_MFMA(af, fragT(TN, 16 * ks, 0, lane, hi), a0);
            a1 = CK_MFMA(af, fragT(TN, 16 * ks, 1, lane, hi), a1);
        }
        storeT_V(A2M, a0, cb, r32, hi); storeT_V(A2M, a1, cb, 32 + r32, hi);
    } else if (wave < 4) {
        const int dvb = wave - 2; f32x16 v0 = f32x16{}, v1 = f32x16{};
#pragma unroll
        for (int s = 0; s < 2; ++s) {
            v0 = CK_MFMA(packR(w1a, s), fragT(TN, 16 * s, 0, lane, hi), v0);
            v1 = CK_MFMA(packR(w1a, s), fragT(TN, 16 * s, 1, lane, hi), v1);
            v1 = CK_MFMA(packR(w1b, s), fragT(TN, 32 + 16 * s, 1, lane, hi), v1);
        }
        storeT_V(V2M, v0, dvb, r32, hi); storeT_V(V2M, v1, dvb, 32 + r32, hi);
    }
    __syncthreads();
    CK_FRESH();
    if (wave >= 4 && wave < 6) {
        const int tb = wave - 4, t = tb * 32 + r32;
        f32x16 r0 = f32x16{}, r1 = f32x16{};
#pragma unroll
        for (int s = 0; s < 2; ++s) {
            const bf16x8 p0 = packR(xb0, s);
            r0 = CK_MFMA(fragT(A2M, 16 * s, 0, lane, hi), p0, r0); r1 = CK_MFMA(fragT(A2M, 16 * s, 1, lane, hi), p0, r1);
            y0a = CK_MFMA(fragT(V2M, 16 * s, 0, lane, hi), p0, y0a); y0b = CK_MFMA(fragT(V2M, 16 * s, 1, lane, hi), p0, y0b);
            if (tb == 1) { const bf16x8 p1 = packR(xb1, s);
                r0 = CK_MFMA(fragT(A2M, 32 + 16 * s, 0, lane, hi), p1, r0); r1 = CK_MFMA(fragT(A2M, 32 + 16 * s, 1, lane, hi), p1, r1);
                y0a = CK_MFMA(fragT(V2M, 32 + 16 * s, 0, lane, hi), p1, y0a); y0b = CK_MFMA(fragT(V2M, 32 + 16 * s, 1, lane, hi), p1, y0b); }
        }
#pragma unroll
        for (int q = 0; q < 4; ++q) {
            const u32x2 u0 = *(const LAS u32x2*)(RT + t * PS + (8 * q + 4 * hi) * 2), u1 = *(const LAS u32x2*)(RT + t * PS + (32 + 8 * q + 4 * hi) * 2);
            r0[4 * q] += bflo(u0.x); r0[4 * q + 1] += bfhi(u0.x); r0[4 * q + 2] += bflo(u0.y); r0[4 * q + 3] += bfhi(u0.y);
            r1[4 * q] += bflo(u1.x); r1[4 * q + 1] += bfhi(u1.x); r1[4 * q + 2] += bflo(u1.y); r1[4 * q + 3] += bfhi(u1.y);
        }
        storeT_S(BT, r0, 0, t, hi); storeT_S(BT, r1, 1, t, hi);
        storeT_S(KT, y0a, 0, t, hi); storeT_S(KT, y0b, 1, t, hi);
    } else if (wave < 2) {
        const int ib = wave, i = ib * 32 + r32; const float gci = GC[i];
        f32x16 g0 = f32x16{}, g1 = f32x16{};
#pragma unroll
        for (int ks = 0; ks < 4; ++ks) { const bf16x8 bf_ = fragT(BH, 16 * ks, ib, lane, hi);
            g0 = CK_MFMA(fragT(A2M, 16 * ks, 0, lane, hi), bf_, g0); g1 = CK_MFMA(fragT(A2M, 16 * ks, 1, lane, hi), bf_, g1); }
#pragma unroll
        for (int r = 0; r < 16; ++r) { if (crow(r, hi) == i) g0[r] += gci; if (32 + crow(r, hi) == i) g1[r] += gci; }
        storeT_S(AP, g0, 0, i, hi); storeT_S(AP, g1, 1, i, hi);
    } else {
        const int id = wave < 4 ? wave - 2 : wave - 4, ib = id >> 1, dvb = id & 1;
        f32x16 hh = f32x16{};
#pragma unroll
        for (int ks = 0; ks < 4; ++ks) {
            hh = CK_MFMA(fragT(BH, 16 * ks, ib, lane, hi), fragT(V2M, 16 * ks, dvb, lane, hi), hh);
            hh = CK_MFMA(fragT(KH, 16 * ks, ib, lane, hi), fragT(VV, 16 * ks, dvb, lane, hi), hh);
        }
        storeT_S((LAS unsigned char*)L, hh, ib, dvb * 32 + r32, hi);
    }
    __syncthreads();
    {
        asm volatile("" : "+v"(tid));
        const int row = tid >> 3, ch = tid & 7;
        const LAS unsigned char* s0 = BT + row * PS + ch * 16; const LAS unsigned char* s1 = KT + row * PS + ch * 16; const LAS unsigned char* s2 = AP + row * PS + ch * 16; const LAS unsigned char* s3 = (const LAS unsigned char*)L + row * PS + ch * 16;
        const u32x2 a0 = *(const LAS u32x2*)s0, a1 = *(const LAS u32x2*)(s0 + 8), b0 = *(const LAS u32x2*)s1, b1 = *(const LAS u32x2*)(s1 + 8);
        const u32x2 c0 = *(const LAS u32x2*)s2, c1 = *(const LAS u32x2*)(s2 + 8), d0 = *(const LAS u32x2*)s3, d1 = *(const LAS u32x2*)(s3 + 8);
        *(u32x4*)(CR2 + row * 64 + ch * 8) = (u32x4){a0.x, a0.y, a1.x, a1.y}; *(u32x4*)(CY0 + row * 64 + ch * 8) = (u32x4){b0.x, b0.y, b1.x, b1.y};
        *(u32x4*)(CG + row * 64 + ch * 8) = (u32x4){c0.x, c0.y, c1.x, c1.y}; *(u32x4*)(CH + row * 64 + ch * 8) = (u32x4){d0.x, d0.y, d1.x, d1.y};
    }
    asm volatile("s_waitcnt lgkmcnt(0)" ::: "memory"); __builtin_amdgcn_s_barrier();
#undef CK_FRESH
#undef w1a
#undef w1b
#undef xb0
#undef xb1
#undef y0a
#undef y0b
}

__device__ __forceinline__ void fused_item(LAS unsigned char* lds, const Args& a, int bc) {
    int tid_ = threadIdx.x; asm volatile("" : "+v"(tid_));
    const int tid = tid_, lane = tid & 63; const int wave = __builtin_amdgcn_readfirstlane(tid >> 6);
    unsigned char* ws = a.ws;
    const bf16_t* P = (const bf16_t*)(ws + WS_P); const bf16_t* LW = (const bf16_t*)(ws + WS_LW); const float* mu = a.in[3];
    const int b = bc >> 6, c = bc & 63, tokc = b * SEQ + c * 64;
    LAS unsigned char* ACT = lds + O_ACT; LAS unsigned char* DECb = lds + O_TN; LAS unsigned char* ALRb = lds + O_A2; LAS unsigned char* GGb = lds + O_V2;
    {
        LAS float* PT = (LAS float*)(lds + O_PT);
        for (int i = tid; i < 3200; i += 512) {
            const float v = i < 1536 ? mu[i] : (i < 2048 ? a.in[9][i - 1536] : (i < 2560 ? a.in[10][i - 2048] : (i < 3072 ? a.in[11][i - 2560] : (i < 3136 ? a.in[14][i - 3072] : a.in[15][i - 3136]))));
            PT[i] = v; }
    }
    {
        u32x4 cu_[3], pu_[3]; f32x4 m0_[3], m1_[3];
#pragma unroll
        for (int j = 0; j < 3; ++j) {
            const int it = tid + 512 * j; cu_[j] = (u32x4){0u, 0u, 0u, 0u}; pu_[j] = (u32x4){0u, 0u, 0u, 0u}; m0_[j] = (f32x4){0.f, 0.f, 0.f, 0.f}; m1_[j] = m0_[j];
            if (it < 1280) {
                const int tok = it / 20, ch = it - tok * 20, t = tokc + tok, col = 1536 + ch * 8;
                cu_[j] = __builtin_nontemporal_load((const u32x4*)(P + (size_t)t * NINP + col));
                if (t & (SEQ - 1)) pu_[j] = __builtin_nontemporal_load((const u32x4*)(P + (size_t)(t - 1) * NINP + col));
                m0_[j] = *(const f32x4*)(mu + col); m1_[j] = *(const f32x4*)(mu + col + 4); }
        }
        __builtin_amdgcn_sched_barrier(0);
#pragma unroll
        for (int j = 0; j < 3; ++j) {
            const int it = tid + 512 * j;
            if (it < 1280) {
                const int tok = it / 20, ch = it - tok * 20;
                const f32x4 c0 = cvlo(cu_[j]), c1 = cvhi(cu_[j]), p0 = cvlo(pu_[j]), p1 = cvhi(pu_[j]);
                f32x4 s0 = c0 + (p0 - c0) * m0_[j], s1 = c1 + (p1 - c1) * m1_[j];
                if (ch < 4) {
#pragma unroll
                    for (int i = 0; i < 4; ++i) { const float e0 = __builtin_amdgcn_exp2f(-2.8853900817779268f * fabsf(s0[i])), e1 = __builtin_amdgcn_exp2f(-2.8853900817779268f * fabsf(s1[i])); const float th0 = (1.0f - e0) * __builtin_amdgcn_rcpf(1.0f + e0), th1 = (1.0f - e1) * __builtin_amdgcn_rcpf(1.0f + e1);
                        s0[i] = s0[i] < 0.f ? -th0 : th0; s1[i] = s1[i] < 0.f ? -th1 : th1; }
                } else if (ch >= 8) {
#pragma unroll
                    for (int i = 0; i < 4; ++i) { s0[i] = sigmoidf_(s0[i]); s1[i] = sigmoidf_(s1[i]); }
                }
                *(LAS u32x4*)(ACT + tok * 320 + ch * 16) = pk8(s0, s1);
            }
        }
    }
    __syncthreads();
#pragma clang loop unroll(disable)
    for (int h = 0; h < 8; ++h) {
        RowPre rp; row_prefetch(rp, a, ((b * 8 + h) << 6) + c);
        {
            int ln = lane; asm volatile("" : "+v"(ln));
            const int mt = wave >> 1, fcol = ln & 15, fq = ln >> 4;
            bf16x8 wf[2][5]; float w0c[2], a0c[2];
#pragma unroll
            for (int cbi = 0; cbi < 2; ++cbi) { const int col = h * 64 + ((wave & 1) * 2 + cbi) * 16 + fcol; const bf16_t* lw = LW + (size_t)col * 160 + fq * 8;
#pragma unroll
                for (int kb = 0; kb < 5; ++kb) wf[cbi][kb] = *(const bf16x8*)(lw + 32 * kb);
                w0c[cbi] = a.in[4][col]; a0c[cbi] = a.in[6][col]; }
            bf16x8 af[5];
#pragma unroll
            for (int kb = 0; kb < 5; ++kb) af[kb] = *(const LAS bf16x8*)(ACT + (mt * 16 + fcol) * 320 + kb * 64 + fq * 16);
            __builtin_amdgcn_sched_barrier(0);
#pragma unroll
            for (int cbi = 0; cbi < 2; ++cbi) {
                const int cb = (wave & 1) * 2 + cbi;
                const f32x4 z = {0.f, 0.f, 0.f, 0.f};
                const f32x4 aw = __builtin_amdgcn_mfma_f32_16x16x32_bf16(af[0], wf[cbi][0], z, 0, 0, 0);
                const f32x4 aa = __builtin_amdgcn_mfma_f32_16x16x32_bf16(af[1], wf[cbi][1], z, 0, 0, 0);
                f32x4 ag = __builtin_amdgcn_mfma_f32_16x16x32_bf16(af[2], wf[cbi][2], z, 0, 0, 0);
                ag = __builtin_amdgcn_mfma_f32_16x16x32_bf16(af[3], wf[cbi][3], ag, 0, 0, 0);
                ag = __builtin_amdgcn_mfma_f32_16x16x32_bf16(af[4], wf[cbi][4], ag, 0, 0, 0);
#pragma unroll
                for (int i = 0; i < 4; ++i) { const int off = (mt * 16 + fq * 4 + i) * 128 + (cb * 16 + fcol) * 2;
                    *(LAS unsigned short*)(DECb + off) = (unsigned short)f2bf(-0.8750325887f * sigmoidf_(aw[i] + w0c[cbi]));
                    *(LAS unsigned short*)(ALRb + off) = (unsigned short)f2bf(sigmoidf_(aa[i] + a0c[cbi]));
                    *(LAS unsigned short*)(GGb + off) = (unsigned short)f2bf(ag[i]); }
            }
        }
        __syncthreads();
        chunk_item(lds, a, ((b * 8 + h) << 6) + c, rp);
    }
}
}

namespace ck {
constexpr int SQ_MAT = 8704, SQ_BUF = 6 * SQ_MAT;
constexpr int SQ_OUT = 2 * SQ_BUF;
__device__ __forceinline__ bf16x8 lfrag(const LAS unsigned char* M, int row, int k0, int hi) { return fragP(M, row, k0, hi); }
__device__ __forceinline__ void linit(f32x16& x, const LAS unsigned char* M, int row, int cblk, int hi) {
#pragma unroll
    for (int q = 0; q < 4; ++q) { const u32x2 u = *(const LAS u32x2*)(M + row * PS + (cblk * 32 + 8 * q + 4 * hi) * 2); x[4 * q] = bflo(u.x); x[4 * q + 1] = bfhi(u.x); x[4 * q + 2] = bflo(u.y); x[4 * q + 3] = bfhi(u.y); }
}
__device__ __forceinline__ void seq_head(LAS unsigned char* lds, const Args& a, int bh) {
    const int tid = threadIdx.x, lane = tid & 63, r32 = lane & 31, hi = lane >> 5; const int wave = __builtin_amdgcn_readfirstlane(tid >> 6);
    unsigned char* ws = a.ws;
    const bf16_t* SV = (const bf16_t*)(ws + WS_SV); const bf16_t* SG = (const bf16_t*)(ws + WS_SG); const float* RK = (const float*)(ws + WS_RK); bf16_t* YMIX = (bf16_t*)(ws + WS_YMIX);
    const int b = bh >> 3, h = bh & 7, col0 = h * 64;
    const float* lng = a.in[12] + col0; const float* lnb = a.in[13] + col0;
    const int lw = wave - 2;
    const bf16_t* lsrc; int lpitch;
    { const size_t it0 = (size_t)bh * 64 * 4096; const size_t tk0 = (size_t)b * SEQ * CW + col0;
      lsrc = lw == 0 ? (const bf16_t*)(ws + WS_CG) + it0 : lw == 1 ? (const bf16_t*)(ws + WS_CH) + it0 : lw == 2 ? (const bf16_t*)(ws + WS_CR2) + it0 : lw == 3 ? (const bf16_t*)(ws + WS_CY0) + it0 : lw == 4 ? SV + tk0 : SG + tk0;
      lpitch = lw < 4 ? 64 : CW; }
#define SQ_LOAD(ch) do { const bf16_t* s_ = lsrc + (size_t)(ch) * 64 * lpitch; LAS unsigned char* bb_ = lds + ((ch) & 1) * SQ_BUF + lw * SQ_MAT; u32x4 v_[8]; \
        _Pragma("unroll") for (int i_ = 0; i_ < 8; ++i_) { const int q_ = lane + 64 * i_; v_[i_] = __builtin_nontemporal_load((const u32x4*)(s_ + (size_t)(q_ >> 3) * lpitch + (q_ & 7) * 8)); } \
        _Pragma("unroll") for (int i_ = 0; i_ < 8; ++i_) { const int q_ = lane + 64 * i_; LAS unsigned char* d_ = bb_ + (q_ >> 3) * PS + (q_ & 7) * 16; *(LAS u32x2*)d_ = (u32x2){v_[i_].x, v_[i_].y}; *(LAS u32x2*)(d_ + 8) = (u32x2){v_[i_].z, v_[i_].w}; } } while (0)
#define SQ_STORE(ch) do { const LAS unsigned char* ob_ = lds + SQ_OUT + ((ch) & 1) * SQ_MAT; const size_t t0_ = (size_t)b * SEQ + (ch) * 64; \
        for (int p_ = tid - 128; p_ < 512; p_ += 384) { const int row_ = p_ >> 3, c8_ = (p_ & 7) * 8; const LAS unsigned char* s_ = ob_ + row_ * PS + c8_ * 2; \
            const u32x2 lo_ = *(const LAS u32x2*)s_, hi_ = *(const LAS u32x2*)(s_ + 8); *(u32x4*)(YMIX + (t0_ + row_) * D + col0 + c8_) = (u32x4){lo_.x, lo_.y, hi_.x, hi_.y}; } } while (0)
    if (wave >= 2) SQ_LOAD(0);
    __syncthreads();
    f32x16 X00 = f32x16{}, X01 = f32x16{}, X10 = f32x16{}, X11 = f32x16{};
#pragma unroll 1
    for (int c = 0; c < 64; ++c) {
        if (wave >= 2) {
            if (c + 1 < 64) SQ_LOAD(c + 1);
            if (c > 0) SQ_STORE(c - 1);
        } else {
            const int tb = wave;
            const LAS unsigned char* bb = lds + (c & 1) * SQ_BUF;
            const LAS unsigned char* MG = bb; const LAS unsigned char* MH = bb + SQ_MAT; const LAS unsigned char* MR = bb + 2 * SQ_MAT; const LAS unsigned char* MY = bb + 3 * SQ_MAT;
            const LAS unsigned char* MV = bb + 4 * SQ_MAT; const LAS unsigned char* MGT = bb + 5 * SQ_MAT;
            LAS unsigned char* OB = lds + SQ_OUT + (c & 1) * SQ_MAT;
            const int tl = tb * 32 + r32; const size_t t = (size_t)b * SEQ + c * 64 + tl;
            const float rk = RK[t * 8 + h];
            f32x16 y0, y1; linit(y0, MY, tl, 0, hi); linit(y1, MY, tl, 1, hi);
#pragma unroll
            for (int s = 0; s < 2; ++s) {
                const bf16x8 rf0 = lfrag(MR, tl, 16 * s, hi), rf1 = lfrag(MR, tl, 32 + 16 * s, hi);
                y0 = CK_MFMA(packR(X00, s), rf0, y0); y0 = CK_MFMA(packR(X10, s), rf1, y0);
                y1 = CK_MFMA(packR(X01, s), rf0, y1); y1 = CK_MFMA(packR(X11, s), rf1, y1);
            }
#pragma unroll
            for (int db = 0; db < 2; ++db) {
                f32x16 Na, Nb; linit(Na, MH, db * 32 + r32, 0, hi); linit(Nb, MH, db * 32 + r32, 1, hi);
#pragma unroll
                for (int s = 0; s < 2; ++s) {
                    const bf16x8 g00 = lfrag(MG, r32, 16 * s, hi), g01 = lfrag(MG, r32, 32 + 16 * s, hi), g10 = lfrag(MG, 32 + r32, 16 * s, hi), g11 = lfrag(MG, 32 + r32, 32 + 16 * s, hi);
                    const bf16x8 p0 = packR(db ? X01 : X00, s), p1 = packR(db ? X11 : X10, s);
                    Na = CK_MFMA(g00, p0, Na); Na = CK_MFMA(g01, p1, Na);
                    Nb = CK_MFMA(g10, p0, Nb); Nb = CK_MFMA(g11, p1, Nb);
                }
                if (db == 0) { X00 = Na; X10 = Nb; } else { X01 = Na; X11 = Nb; }
            }
            float sm = 0.f;
#pragma unroll
            for (int r = 0; r < 16; ++r) sm += y0[r] + y1[r];
            sm += __shfl_xor(sm, 32);
            const float mean = sm * (1.0f / 64.0f);
            float sq = 0.f;
#pragma unroll
            for (int r = 0; r < 16; ++r) { const float d0 = y0[r] - mean, d1 = y1[r] - mean; sq += d0 * d0 + d1 * d1; }
            sq += __shfl_xor(sq, 32);
            const float rs = __builtin_amdgcn_rsqf(sq * (1.0f / 64.0f) + 64e-5f);
#pragma unroll
            for (int db = 0; db < 2; ++db)
#pragma unroll
                for (int q = 0; q < 4; ++q) {
                    const int dv = db * 32 + 8 * q + 4 * hi;
                    const f32x4 lg = *(const f32x4*)(lng + dv), lb = *(const f32x4*)(lnb + dv);
                    const u32x2 uv = *(const LAS u32x2*)(MV + tl * PS + dv * 2), ug = *(const LAS u32x2*)(MGT + tl * PS + dv * 2);
                    const f32x4 vv = {bflo(uv.x), bfhi(uv.x), bflo(uv.y), bfhi(uv.y)}, gg = {bflo(ug.x), bfhi(ug.x), bflo(ug.y), bfhi(ug.y)};
                    f32x4 yy; if (db == 0) yy = (f32x4){y0[4 * q], y0[4 * q + 1], y0[4 * q + 2], y0[4 * q + 3]}; else yy = (f32x4){y1[4 * q], y1[4 * q + 1], y1[4 * q + 2], y1[4 * q + 3]};
                    const f32x4 o = ((yy - mean) * rs * lg + lb + rk * vv) * gg;
                    u32x2 w; w.x = pk2(o.x, o.y); w.y = pk2(o.z, o.w);
                    *(LAS u32x2*)(OB + tl * PS + dv * 2) = w;
                }
        }
        __syncthreads();
    }
    if (wave >= 2) SQ_STORE(63);
#undef SQ_LOAD
#undef SQ_STORE
}
}

namespace att {
constexpr int SLOT = 32768, OFF_V = 16384;
constexpr int TBL_OFF = MISC_OFF + 1024;
constexpr int LW_OFF = MISC_OFF + 2048;
constexpr int CST_OFF = MISC_OFF + 3072;
constexpr int TBL4_OFF = MISC_OFF + 4096;
constexpr int SG_OFF = MISC_OFF + 12288;
__device__ __forceinline__ int crow(int r, int hi) { return (r & 3) + 8 * (r >> 2) + 4 * hi; }
__device__ __forceinline__ void glds16(const void* gsrc, unsigned lds_dst) { unsigned keep;
    asm volatile("s_mov_b32 %0, m0\n\ts_mov_b32 m0, %2\n\ts_nop 0\n\tglobal_load_lds_dwordx4 %1, off\n\ts_mov_b32 m0, %0" : "=&s"(keep) : "v"(gsrc), "s"(lds_dst) : "memory"); }
__device__ __forceinline__ void glds16s(const void* sbase, unsigned voff, unsigned lds_dst) { unsigned keep;
    asm volatile("s_mov_b32 %0, m0\n\ts_mov_b32 m0, %3\n\ts_nop 0\n\tglobal_load_lds_dwordx4 %1, %2\n\ts_mov_b32 m0, %0" : "=&s"(keep) : "v"(voff), "s"(sbase), "s"(lds_dst) : "memory"); }
__device__ __forceinline__ s16x4 vtr(const LAS unsigned char* p) { return __builtin_bit_cast(s16x4, __builtin_amdgcn_ds_read_tr16_b64_v4i16((LAS s16x4*)p)); }
__device__ __forceinline__ float add1(float a, float b) { float r = a + b; asm("" : "+v"(r)); return r; }

__device__ __forceinline__ void attn_unit(LAS unsigned char* lds, const Args& a, int b, int h, int qb, float negM, float lam) {
    int tid_in = threadIdx.x; asm volatile("" : "+v"(tid_in));
    const int tid = tid_in, lane = tid & 63, r32 = lane & 31, hi = lane >> 5; const int wid = __builtin_amdgcn_readfirstlane(threadIdx.x >> 6);
    const int c = wid >> 2, rg = wid & 3;
    unsigned char* ws = a.ws;
    const bf16_t* QN = (const bf16_t*)(ws + WS_QN); const bf16_t* KN = (const bf16_t*)(ws + WS_KN); const bf16_t* P = (const bf16_t*)(ws + WS_P); bf16_t* YMIX = (bf16_t*)(ws + WS_YMIX);
    const int q0 = qb * 128; const size_t rowbase = (size_t)b * SEQ;
    const int NT = 2 * qb + 2;
    const LAS float* tbl = (const LAS float*)(lds + TBL4_OFF) + h * 512; LAS float* lw = (LAS float*)(lds + LW_OFF) + wid * 32;
    const bf16_t* Qw = QN + (rowbase + q0 + rg * 32 + r32) * CW + h * 128 + c * 64;
    bf16x8 qr[4];
#pragma unroll
    for (int d0 = 0; d0 < 4; ++d0) qr[d0] = *(const bf16x8*)(Qw + d0 * 16 + hi * 8);
    const bf16_t* k0src = KN + ((((size_t)(b * 8 + h * 2) * 64) * 8 + wid) * 64) * 8;
    const bf16_t* k1src = k0src + (size_t)64 * 8 * 64 * 8;
    const int pv0 = 2 * wid, pv1 = 2 * wid + 1;
    const bf16_t* VTb = (const bf16_t*)(ws + WS_VT) + (size_t)(b * 4 + h) * 64 * 8192;
    const bf16_t* v0src = VTb + pv0 * 512;
    const bf16_t* v1src = VTb + pv1 * 512;
#define ATT_DMA(t, slot) do { const unsigned s_ = lds0 + (unsigned)(slot) * SLOT; \
        const unsigned dvo_ = (unsigned)(threadIdx.x & 63) * 16u; \
        glds16s(k0src + (size_t)(t) * 4096, dvo_, (unsigned)__builtin_amdgcn_readfirstlane(s_ + wid * 1024)); \
        glds16s(k1src + (size_t)(t) * 4096, dvo_, (unsigned)__builtin_amdgcn_readfirstlane(s_ + 8192 + wid * 1024)); \
        glds16s(v0src + (size_t)(t) * 8192, dvo_, (unsigned)__builtin_amdgcn_readfirstlane(s_ + OFF_V + pv0 * 1024)); \
        glds16s(v1src + (size_t)(t) * 8192, dvo_, (unsigned)__builtin_amdgcn_readfirstlane(s_ + OFF_V + pv1 * 1024)); } while (0)
#define ATT_SBAR() __builtin_amdgcn_sched_barrier(0)
    const unsigned lds0 = (unsigned)(uintptr_t)lds;
    f32x16 o[4];
#pragma unroll
    for (int d0 = 0; d0 < 4; ++d0) o[d0] = f32x16{};
    float lsum = 0.f;
    const bool shift = negM < -60.0f;
    const int qmin = q0 + 32 * rg, qpos = qmin + r32;
    const int NTw = (64 * (NT - 1) <= qmin + 31) ? NT : NT - 1;
#define ATT_MF(a_, b_, c_) __builtin_amdgcn_mfma_f32_32x32x16_bf16(a_, b_, c_, 0, 0, 0)
#define ATT_EXP2(P, i_) do { P[i_] = __builtin_amdgcn_exp2f(P[i_]); P[(i_) + 1] = __builtin_amdgcn_exp2f(P[(i_) + 1]); sacc = add1(add1(sacc, P[i_]), P[(i_) + 1]); } while (0)
#define ATT_EXP1(P, i_) do { P[i_] = __builtin_amdgcn_exp2f(P[i_]); sacc = add1(sacc, P[i_]); } while (0)
#define ATT_PACK(P, o_) ((u32x4){pk2(P[o_], P[(o_) + 1]), pk2(P[(o_) + 2], P[(o_) + 3]), pk2(P[(o_) + 4], P[(o_) + 5]), pk2(P[(o_) + 6], P[(o_) + 7])})
#define ATT_LDV1(vb_, i_) do { vv[(i_) & 3][0] = vtr((vb_) + ((i_) & 3) * 4096 + ((i_) >> 2) * 1024); vv[(i_) & 3][1] = vtr((vb_) + ((i_) & 3) * 4096 + ((i_) >> 2) * 1024 + 512); } while (0)
#define ATT_VF1(i_) ((bf16x8){vv[(i_) & 3][0][0], vv[(i_) & 3][0][1], vv[(i_) & 3][0][2], vv[(i_) & 3][0][3], vv[(i_) & 3][1][0], vv[(i_) & 3][1][1], vv[(i_) & 3][1][2], vv[(i_) & 3][1][3]})
#define ATT_ITER(t, PC0, PC1, PN0, PN1, ACT, NXT) do { \
        if ((t) + 2 < NT) { ATT_DMA((t) + 2, sD); } \
        const int kmin = 64 * (t); \
        const bool act = (ACT), nxt = (NXT); \
        int ln_ = lane; asm volatile("" : "+v"(ln_)); const int r32_ = ln_ & 31, hi_ = ln_ >> 5;            \
        const LAS unsigned char* vb = lds + sV * SLOT + OFF_V + ((ln_ >> 4) & 1) * 32 + (ln_ & 3) * 8 + (4 * hi_ + ((ln_ & 15) >> 2)) * 64; \
        s16x4 vv[4][2]; float sacc = 0.f; \
        if (act) { \
            if (qmin - (kmin + 63) < 113) {         \
                const LAS float* rv = tbl + (383 - (qmin + r32_) + kmin + 4 * hi_); \
                _Pragma("unroll") for (int r = 0; r < 16; ++r) { PC0[r] += rv[(r & 3) + 8 * (r >> 2)]; PC1[r] += rv[32 + (r & 3) + 8 * (r >> 2)]; } \
            } \
            if (shift) { _Pragma("unroll") for (int r = 0; r < 16; ++r) { PC0[r] += negM; PC1[r] += negM; } } \
        } \
        if (nxt) { \
            const LAS unsigned char* kb = lds + sK * SLOT + c * 8192 + hi_ * 1024 + r32_ * 16; \
            bf16x8 ka0 = *(const LAS bf16x8*)(kb), ka1 = *(const LAS bf16x8*)(kb + 512), kb0 = *(const LAS bf16x8*)(kb + 2048), kb1 = *(const LAS bf16x8*)(kb + 2048 + 512); \
            ATT_SBAR(); \
            PN0 = ATT_MF(ka0, qr[0], f32x16{}); ATT_EXP1(PC0, 0); ATT_SBAR(); \
            PN1 = ATT_MF(ka1, qr[0], f32x16{}); ATT_EXP1(PC0, 1); ATT_SBAR(); \
            ka0 = *(const LAS bf16x8*)(kb + 4096); ka1 = *(const LAS bf16x8*)(kb + 4096 + 512); \
            PN0 = ATT_MF(kb0, qr[1], PN0); ATT_EXP1(PC0, 2); ATT_SBAR(); \
            PN1 = ATT_MF(kb1, qr[1], PN1); ATT_EXP1(PC0, 3); ATT_SBAR(); \
            kb0 = *(const LAS bf16x8*)(kb + 6144); kb1 = *(const LAS bf16x8*)(kb + 6144 + 512); \
            PN0 = ATT_MF(ka0, qr[2], PN0); ATT_EXP1(PC0, 4); ATT_SBAR(); \
            PN1 = ATT_MF(ka1, qr[2], PN1); ATT_EXP1(PC0, 5); ATT_SBAR(); \
            PN0 = ATT_MF(kb0, qr[3], PN0); ATT_EXP1(PC0, 6); ATT_SBAR(); \
            PN1 = ATT_MF(kb1, qr[3], PN1); ATT_EXP1(PC0, 7); ATT_SBAR(); \
        } else if (act) { \
            _Pragma("unroll") for (int j = 0; j < 8; j += 2) ATT_EXP2(PC0, j); \
            ATT_SBAR(); \
        } \
        if (act) { \
            ATT_LDV1(vb, 0); ATT_LDV1(vb, 1); ATT_LDV1(vb, 2); ATT_LDV1(vb, 3); \
            u32x4 pwk = ATT_PACK(PC0, 0); \
            _Pragma("unroll") for (int dvb = 0; dvb < 4; ++dvb) { ATT_SBAR(); o[dvb] = ATT_MF(__builtin_bit_cast(bf16x8, pwk), ATT_VF1(dvb), o[dvb]); ATT_LDV1(vb, 4 + dvb); ATT_EXP2(PC0, 8 + 2 * dvb); } \
            ATT_SBAR(); \
            pwk = ATT_PACK(PC0, 8); \
            _Pragma("unroll") for (int dvb = 0; dvb < 4; ++dvb) { ATT_SBAR(); o[dvb] = ATT_MF(__builtin_bit_cast(bf16x8, pwk), ATT_VF1(4 + dvb), o[dvb]); ATT_LDV1(vb, 8 + dvb); ATT_EXP2(PC1, 2 * dvb); } \
            ATT_SBAR(); \
            pwk = ATT_PACK(PC1, 0); \
            _Pragma("unroll") for (int dvb = 0; dvb < 4; ++dvb) { ATT_SBAR(); o[dvb] = ATT_MF(__builtin_bit_cast(bf16x8, pwk), ATT_VF1(8 + dvb), o[dvb]); ATT_LDV1(vb, 12 + dvb); ATT_EXP2(PC1, 8 + 2 * dvb); } \
            ATT_SBAR(); \
            pwk = ATT_PACK(PC1, 8); \
            _Pragma("unroll") for (int dvb = 0; dvb < 4; ++dvb) { ATT_SBAR(); o[dvb] = ATT_MF(__builtin_bit_cast(bf16x8, pwk), ATT_VF1(12 + dvb), o[dvb]); } \
            lsum += sacc; \
        } \
        sV = sV == 2 ? 0 : sV + 1; sK = sK == 2 ? 0 : sK + 1; sD = sD == 2 ? 0 : sD + 1; \
        asm volatile("s_waitcnt vmcnt(0)" ::: "memory"); \
        __syncthreads(); \
    } while (0)
    ATT_DMA(0, 0);
    if (1 < NT) ATT_DMA(1, 1);
    asm volatile("s_waitcnt vmcnt(0)" ::: "memory");
    __syncthreads();
    if (wid >= 4) __builtin_amdgcn_s_setprio(1);
    f32x16 pA0 = f32x16{}, pA1 = f32x16{}, pB0 = f32x16{}, pB1 = f32x16{};
    if (0 < NTw) {
        const LAS unsigned char* kb = lds + c * 8192 + hi * 1024 + r32 * 16;
        bf16x8 kf[8];
#pragma unroll
        for (int d0 = 0; d0 < 4; ++d0) { kf[2 * d0] = *(const LAS bf16x8*)(kb + d0 * 2048); kf[2 * d0 + 1] = *(const LAS bf16x8*)(kb + d0 * 2048 + 512); }
        pA0 = ATT_MF(kf[0], qr[0], f32x16{}); pA1 = ATT_MF(kf[1], qr[0], f32x16{});
#pragma unroll
        for (int d0 = 1; d0 < 4; ++d0) { pA0 = ATT_MF(kf[2 * d0], qr[d0], pA0); pA1 = ATT_MF(kf[2 * d0 + 1], qr[d0], pA1); }
    }
    int sV = 0, sK = 1, sD = 2;
    int t = 0;
    for (; t < NT - 2; t += 2) {
        ATT_ITER(t, pA0, pA1, pB0, pB1, true, true);
        ATT_ITER(t + 1, pB0, pB1, pA0, pA1, true, true);
    }
    ATT_ITER(t, pA0, pA1, pB0, pB1, true, NTw == NT);
    ATT_ITER(t + 1, pB0, pB1, pA0, pA1, NTw == NT, false);
#undef ATT_MF
#undef ATT_EXP2
#undef ATT_EXP1
#undef ATT_PACK
#undef ATT_LDV1
#undef ATT_VF1
#undef ATT_ITER
    __builtin_amdgcn_s_setprio(0);
#undef ATT_DMA
#undef ATT_SBAR
    lsum += __shfl_xor(lsum, 32);
    if (hi == 0) lw[r32] = 1.0f / lsum;
    asm volatile("s_waitcnt lgkmcnt(0)" ::: "memory");
    LAS float* stg = (LAS float*)(lds + wid * 16384);
#pragma unroll
    for (int r = 0; r < 16; ++r) { const int orow = crow(r, hi); const float il = lw[orow];
#pragma unroll
        for (int d0 = 0; d0 < 4; ++d0) stg[orow * 128 + d0 * 32 + r32] = o[d0][r] * il; }
    __syncthreads();
    {
        const int row = tid >> 2, part = tid & 3, rgp = row >> 5, rr = row & 31;
        const LAS float* s1 = (const LAS float*)(lds + rgp * 16384) + rr * 128 + part * 32;
        const LAS float* s2 = (const LAS float*)(lds + (4 + rgp) * 16384) + rr * 128 + part * 32;
        float dv[32]; float ss = 0.f;
#pragma unroll
        for (int i = 0; i < 8; ++i) { const f32x4 x1 = *(const LAS f32x4*)(s1 + 4 * i), x2 = *(const LAS f32x4*)(s2 + 4 * i);
#pragma unroll
            for (int j = 0; j < 4; ++j) { const float dd = x1[j] - lam * x2[j]; dv[4 * i + j] = dd; ss += dd * dd; } }
        ss = red4(ss);
        const float sc = __builtin_amdgcn_rsqf(ss * (1.0f / 128.0f) + 1e-5f) * 0.8f;
        const LAS float* sg = (const LAS float*)(lds + SG_OFF) + part * 32;
        bf16_t* op = YMIX + (rowbase + q0 + row) * D + CW + h * 128 + part * 32;
#pragma unroll
        for (int i = 0; i < 4; ++i) { u32x4 w;
            w.x = pk2(dv[8 * i] * sc * sg[8 * i], dv[8 * i + 1] * sc * sg[8 * i + 1]); w.y = pk2(dv[8 * i + 2] * sc * sg[8 * i + 2], dv[8 * i + 3] * sc * sg[8 * i + 3]);
            w.z = pk2(dv[8 * i + 4] * sc * sg[8 * i + 4], dv[8 * i + 5] * sc * sg[8 * i + 5]); w.w = pk2(dv[8 * i + 6] * sc * sg[8 * i + 6], dv[8 * i + 7] * sc * sg[8 * i + 7]);
            *(u32x4*)(op + 8 * i) = w; }
    }
    __syncthreads();
}

__device__ __forceinline__ void attn_phase(LAS unsigned char* lds, const Args& a, unsigned* ctl) {
    const int tid = threadIdx.x;
    LAS float* cst = (LAS float*)(lds + CST_OFF);
    if (tid < 64) {
        const float gq = fabsf(a.in[14][tid]), gk = fabsf(a.in[15][tid]);
        float mq = gq, mk = gk;
#pragma unroll
        for (int o = 1; o < 64; o <<= 1) { mq = fmaxf(mq, __shfl_xor(mq, o)); mk = fmaxf(mk, __shfl_xor(mk, o)); }
        const float d1 = wave_sum(a.in[16][tid] * a.in[17][tid]), d2 = wave_sum(a.in[18][tid] * a.in[19][tid]);
        float mb = 0.f;
        if (tid < 32) { for (int hh = 0; hh < 4; ++hh) mb = fmaxf(mb, (a.in[21][tid * 4 + hh] - a.in[21][31 * 4 + hh]) * LOG2E); }
#pragma unroll
        for (int o = 1; o < 64; o <<= 1) mb = fmaxf(mb, __shfl_xor(mb, o));
        if (tid == 0) { cst[0] = -(8.0f * LOG2E * mq * mk * 1.02f + mb); cst[1] = __expf(d1) - __expf(d2) + 0.2f; }
    }
    {
#pragma unroll
        for (int i = 0; i < 4; ++i) {
            const int idx = tid + 512 * i, hh = idx >> 9, n = 383 - (idx & 511); int bkt;
            if (n < 16) bkt = n < 0 ? 0 : n; else { bkt = 16 + (int)(logf((float)n * (1.0f / 16.0f)) / 2.0794415416798357f * 16.0f); bkt = bkt > 31 ? 31 : bkt; }
            const float v = (a.in[21][bkt * 4 + hh] - a.in[21][31 * 4 + hh]) * LOG2E;
            ((LAS float*)(lds + TBL4_OFF))[idx] = n < 0 ? -INFINITY : (n > 127 ? 0.f : v); }
        if (tid < 128) ((LAS float*)(lds + SG_OFF))[tid] = a.in[20][tid];
    }
    __syncthreads();
    const float negM = cst[0], lam = cst[1];
    LAS int* ubox = (LAS int*)(lds + CST_OFF + 16);
    for (;;) {
        if (tid == 0) ubox[0] = (int)atomicAdd(ctl + CW_ATTQ, 1u);
        __syncthreads();
        const int u = __builtin_amdgcn_readfirstlane(ubox[0]);
        __syncthreads();
        if (u >= 5 * ((CONV_ITEMS + 2) / 3)) break;
        const int qd = u / 5, rm = u - qd * 5;
        if (rm < 3) { if (qd * 3 + rm < CONV_ITEMS) conv_item(lds, a, qd * 3 + rm); continue; }
        const int au = qd * 2 + (rm - 3);
        if (au >= 1024) continue;
        const int qb = 31 - (au >> 5), bhh = au & 31;
        attn_unit(lds, a, bhh >> 2, bhh & 3, qb, negM, lam);
    }
}
}

__device__ __forceinline__ void p5_router(LAS unsigned char* lds, const Args& a, unsigned* ctl) {
    const int tid = threadIdx.x, lane = tid & 63, r32 = lane & 31, hi = lane >> 5; const int wave = __builtin_amdgcn_readfirstlane(tid >> 6);
    unsigned char* ws = a.ws;
    const bf16_t* x1 = (const bf16_t*)(ws + WS_X1B); const float* g2 = a.in[23]; const float* rw = a.in[24]; const float* rb = a.in[25];
    unsigned char* H2 = ws + WS_H2; int* EIDX = (int*)(ws + WS_EIDX); float* GATE = (float*)(ws + WS_GATE); int* POS = (int*)(ws + WS_POS);
    LAS unsigned char* WH = lds; LAS unsigned char* WL = lds + 65536;
    LAS int* cnt = (LAS int*)(lds + MISC_OFF + 1024);
    LAS int* basel = (LAS int*)(lds + MISC_OFF + 1024 + 128);
    LAS int* el = (LAS int*)(lds + MISC_OFF + 2048);
    LAS int* pl = (LAS int*)(lds + MISC_OFF + 4096);
    {
        const int e = tid & 31;
#pragma unroll 1
        for (int kb = tid >> 5; kb < 1024; kb += 256) {
            float wv[16], gv[16];
#pragma unroll
            for (int j = 0; j < 16; ++j) { const int k = kb + 16 * j; wv[j] = rw[k * 32 + e]; gv[j] = g2[k]; }
            __builtin_amdgcn_sched_barrier(0);
#pragma unroll
            for (int j = 0; j < 16; ++j) { const int k = kb + 16 * j;
                const float v = wv[j] * gv[j]; const unsigned h = f2bf(v); const float vh = __builtin_bit_cast(float, h << 16); const unsigned l = f2bf(v - vh);
                const int off = e * 2048 + (((k >> 3) ^ (e & 15)) << 4) + (k & 7) * 2;
                *(LAS unsigned short*)(WH + off) = (unsigned short)h; *(LAS unsigned short*)(WL + off) = (unsigned short)l; }
            __builtin_amdgcn_sched_barrier(0);
        }
    }
    if (tid < 32) cnt[tid] = 0;
    __syncthreads();
    const int TPB = T / (int)gridDim.x, tb0 = blockIdx.x * TPB;
    if (wave < 4) {
        const int tl = wave * 32 + r32, t = tb0 + tl;
        const bf16_t* xrow = x1 + (size_t)t * D + 8 * hi;
        const LAS unsigned char* wh = WH + r32 * 2048; const LAS unsigned char* wl = WL + r32 * 2048; const int sw = r32 & 15;
        f32x16 d = f32x16{}; float ssq = 0.f;
#pragma unroll 1
        for (int s0 = 0; s0 < 64; s0 += 16) {
          u32x4 xbv[16];
#pragma unroll
          for (int i = 0; i < 16; ++i) xbv[i] = *(const u32x4*)(xrow + 16 * (s0 + i));
          __builtin_amdgcn_sched_barrier(0);
#pragma unroll
          for (int i = 0; i < 16; ++i) { const int s = s0 + i;
            const u32x4 xb = xbv[i];
            const int co = ((2 * s + hi) ^ sw) << 4;
            const bf16x8 ah = *(const LAS bf16x8*)(wh + co), al = *(const LAS bf16x8*)(wl + co);
            const bf16x8 bx = __builtin_bit_cast(bf16x8, xb);
            d = __builtin_amdgcn_mfma_f32_32x32x16_bf16(ah, bx, d, 0, 0, 0);
            d = __builtin_amdgcn_mfma_f32_32x32x16_bf16(al, bx, d, 0, 0, 0);
            const f32x4 x0 = cvlo(xb), x1v = cvhi(xb);
            ssq += (x0.x * x0.x + x0.y * x0.y) + (x0.z * x0.z + x0.w * x0.w) + (x1v.x * x1v.x + x1v.y * x1v.y) + (x1v.z * x1v.z + x1v.w * x1v.w);
          }
          __builtin_amdgcn_sched_barrier(0);
        }
        ssq += __shfl_xor(ssq, 32);
        const float rstd = 1.0f / sqrtf(ssq * (1.0f / D) + 1e-5f);
        float lg[16];
#pragma unroll
        for (int r = 0; r < 16; ++r) lg[r] = d[r] * rstd + rb[8 * (r >> 2) + 4 * hi + (r & 3)];
        float tv[4]; int ti[4];
#pragma unroll
        for (int k = 0; k < 4; ++k) {
            float bv = -INFINITY; int bi = 0;
#pragma unroll
            for (int r = 0; r < 16; ++r) { const int e = 8 * (r >> 2) + 4 * hi + (r & 3); if (lg[r] > bv) { bv = lg[r]; bi = e; } }
            tv[k] = bv; ti[k] = bi;
#pragma unroll
            for (int r = 0; r < 16; ++r) { const int e = 8 * (r >> 2) + 4 * hi + (r & 3); if (e == bi) lg[r] = -INFINITY; }
        }
        float ov[4]; int oi[4];
#pragma unroll
        for (int k = 0; k < 4; ++k) { ov[k] = __shfl_xor(tv[k], 32); oi[k] = __shfl_xor(ti[k], 32); }
        float mv[4]; int mi[4];
        {
            int pa = 0, pb = 0;
#pragma unroll
            for (int k = 0; k < 4; ++k) {
                float ca = -INFINITY, cb = -INFINITY; int ia = 0, ib = 0;
#pragma unroll
                for (int q = 0; q < 4; ++q) { if (q == pa) { ca = tv[q]; ia = ti[q]; } if (q == pb) { cb = ov[q]; ib = oi[q]; } }
                const bool takeA = (ca > cb) || (ca == cb && ia < ib);
                mv[k] = takeA ? ca : cb; mi[k] = takeA ? ia : ib; pa += takeA ? 1 : 0; pb += takeA ? 0 : 1;
            }
        }
        const float e1 = __expf(mv[1] - mv[0]), e2 = __expf(mv[2] - mv[0]), e3 = __expf(mv[3] - mv[0]);
        const float inv = 1.0f / (1.0f + e1 + e2 + e3);
        if (hi == 0) {
            *(int4*)(EIDX + (size_t)t * 4) = make_int4(mi[0], mi[1], mi[2], mi[3]);
            *(float4*)(GATE + (size_t)t * 4) = make_float4(inv, e1 * inv, e2 * inv, e3 * inv);
#pragma unroll
            for (int k = 0; k < 4; ++k) { el[tl * 4 + k] = mi[k]; pl[tl * 4 + k] = atomicAdd((int*)(cnt + mi[k]), 1); }
        }
    } else {
        f32x4 gv[4];
#pragma unroll
        for (int j = 0; j < 4; ++j) gv[j] = *((const f32x4*)g2 + lane + 64 * j);
#pragma unroll 1
        for (int i0 = 0; i0 < 32; i0 += 8) {
            u32x2 xw[8][4];
#pragma unroll
            for (int i = 0; i < 8; ++i) { const u32x2* xr = (const u32x2*)(x1 + (size_t)(tb0 + (wave - 4) * 32 + i0 + i) * D) + lane;
#pragma unroll
                for (int j = 0; j < 4; ++j) xw[i][j] = xr[64 * j]; }
            __builtin_amdgcn_sched_barrier(0);
#pragma unroll
            for (int i = 0; i < 8; ++i) {
                const int t = tb0 + (wave - 4) * 32 + i0 + i;
                f32x4 v[4]; float s = 0.f;
#pragma unroll
                for (int j = 0; j < 4; ++j) { v[j] = (f32x4){bflo(xw[i][j].x), bfhi(xw[i][j].x), bflo(xw[i][j].y), bfhi(xw[i][j].y)}; s += (v[j].x * v[j].x + v[j].y * v[j].y) + (v[j].z * v[j].z + v[j].w * v[j].w); }
                const float rstd = __builtin_amdgcn_rsqf(wave_sum(s) * (1.0f / D) + 1e-5f) * F8_X_MUL;
                unsigned* o4 = (unsigned*)(H2 + (size_t)t * D) + lane;
#pragma unroll
                for (int j = 0; j < 4; ++j) { v[j] = v[j] * rstd * gv[j]; o4[64 * j] = pk4_fp8(v[j].x, v[j].y, v[j].z, v[j].w); }
            }
            __builtin_amdgcn_sched_barrier(0);
        }
    }
    __syncthreads();
    if (tid < 32) basel[tid] = (int)atomicAdd(ctl + CW_CNT + tid, (unsigned)cnt[tid]);
    __syncthreads();
    for (int i = tid; i < TPB * 4; i += 512) POS[(size_t)tb0 * 4 + i] = pl[i] + basel[el[i]];
}

__device__ __forceinline__ void p6_dispatch(LAS unsigned char* lds, const Args& a, unsigned* ctl) {
    const int tid = threadIdx.x, lane = tid & 63, wave = __builtin_amdgcn_readfirstlane(tid >> 6);
    unsigned char* ws = a.ws;
    const int* EIDX = (const int*)(ws + WS_EIDX); const float* GATE = (const float*)(ws + WS_GATE); const int* POS = (const int*)(ws + WS_POS);
    int* DEST = (int*)(ws + WS_DEST); float* ROWGATE = (float*)(ws + WS_ROWGATE); int* TILEE = (int*)(ws + WS_TILEE); int* ROWTOK = (int*)(ws + WS_ROWTOK);
    LAS int* pstart = (LAS int*)(lds + MISC_OFF + 1024); LAS int* pcnt = pstart + 32;
    if (tid < NE) pcnt[tid] = (int)__hip_atomic_load(ctl + CW_CNT + tid, __ATOMIC_RELAXED, __HIP_MEMORY_SCOPE_AGENT);
    __syncthreads();
    if (tid == 0) {
        int acc = 0;
        for (int e = 0; e < NE; ++e) { pstart[e] = acc; acc += ((pcnt[e] + 255) >> 8) * 256; }
        if (blockIdx.x == 0) TILEE[1023] = acc >> 8;
    }
    __syncthreads();
    if (blockIdx.x == 0 && tid < NE) { const int nt = (pcnt[tid] + 255) >> 8, t0_ = pstart[tid] >> 8; for (int i = 0; i < nt; ++i) TILEE[t0_ + i] = tid; }
    if (blockIdx.x < NE) {
        const int e = blockIdx.x, cn = pcnt[e], pe = ((cn + 255) >> 8) * 256;
        for (int i = cn + tid; i < pe; i += 512) ROWTOK[pstart[e] + i] = 0;
    }
    const int TPB = T / (int)gridDim.x, tb0 = blockIdx.x * TPB;
    for (int pi = tb0 * 4 + tid; pi < (tb0 + TPB) * 4; pi += 512) {
        const int e = EIDX[pi], dest = pstart[e] + POS[pi];
        DEST[pi] = dest; ROWGATE[dest] = GATE[pi]; ROWTOK[dest] = pi >> 2;
    }
}

__device__ __forceinline__ void p9_combine(const Args& a, int G) {
    const int tid = threadIdx.x, lane = tid & 63, wave = __builtin_amdgcn_readfirstlane(tid >> 6);
    unsigned char* ws = a.ws;
    const unsigned char* YS = ws + WS_YS; const int* DEST = (const int*)(ws + WS_DEST);
    float* out = a.out;
    const int gw = blockIdx.x * 8 + wave, NGW = G * 8;
    for (int t = gw; t < T; t += NGW) {
        f32x4* xr = (f32x4*)(out + (size_t)t * D) + lane; const u32x2* xi = (const u32x2*)((const bf16_t*)(ws + WS_X1B) + (size_t)t * D) + lane;
        f32x4 v[4];
#pragma unroll
        for (int j = 0; j < 4; ++j) { const u32x2 xw = xi[64 * j]; v[j] = (f32x4){bflo(xw.x), bfhi(xw.x), bflo(xw.y), bfhi(xw.y)}; }
#pragma unroll
        for (int k = 0; k < 4; ++k) {
            const int dest = DEST[t * 4 + k];
            const unsigned* yr = (const unsigned*)(YS + (size_t)dest * D) + lane;
#pragma unroll
            for (int j = 0; j < 4; ++j) { const unsigned w = yr[64 * j];
                const f32x2 lo = __builtin_amdgcn_cvt_pk_f32_fp8((int)w, false), hi2 = __builtin_amdgcn_cvt_pk_f32_fp8((int)w, true);
                v[j].x += lo.x * (1.0f / F8_Y_MUL); v[j].y += lo.y * (1.0f / F8_Y_MUL); v[j].z += hi2.x * (1.0f / F8_Y_MUL); v[j].w += hi2.y * (1.0f / F8_Y_MUL); }
        }
        if (TIME_REGION >= 0) { const float sc_ = 1.0f + 4e-6f * (float)((const unsigned*)(ws + WS_CTL))[301];
#pragma unroll
            for (int j = 0; j < 4; ++j) v[j] = v[j] * sc_; }
#pragma unroll
        for (int j = 0; j < 4; ++j) __builtin_nontemporal_store(v[j], xr + 64 * j);
    }
}

constexpr int NPHASE = 10;
__global__ void __launch_bounds__(512, 2) hymba_fwd(Args args) {
    extern __shared__ __attribute__((aligned(16))) unsigned char lds_raw[];
    LAS unsigned char* lds = (LAS unsigned char*)lds_raw;
    cg::grid_group grid = cg::this_grid();
    const int G = gridDim.x;
    unsigned char* ws = args.ws;
    unsigned* ctl = (unsigned*)(ws + WS_CTL);
    const int lo = args.ph_lo, hi = args.ph_hi;
#define IN(k) (lo <= (k) && (k) < hi)
#define NREP(k) ((REP_PHASE) == (k) ? 2 : 1)
#define TSTART(k) do { if ((TIME_REGION) == (k) && blockIdx.x == 0 && threadIdx.x == 0) ctl[300] = (unsigned)__builtin_amdgcn_s_memrealtime(); } while (0)
#define TEND(k) do { if ((TIME_REGION) == (k) && blockIdx.x == 0 && threadIdx.x == 0) ctl[301] = (unsigned)__builtin_amdgcn_s_memrealtime() - ctl[300]; } while (0)
#define SEAM(k) do { if (IN(k) && IN((k) + 1)) { if (args.ph_lo < 0) grid.sync(); xcd_barrier(xbar); } } while (0)
    const int* TILEE = (const int*)(ws + WS_TILEE);
    { volatile LAS unsigned* st = (volatile LAS unsigned*)(lds + LDS_BYTES - 64); if (threadIdx.x < 2) st[threadIdx.x] = 0u; }
    __syncthreads();
    const XcdBarrier xbar = xcd_barrier_post(ctl + CW_BAR, (volatile LAS unsigned*)(lds + LDS_BYTES - 64));

    if (IN(0)) { for (int rep = 0; rep < NREP(0); ++rep) p0_prologue(lds, args, G); } SEAM(0);
    if (IN(1)) {
        pg8::Gemm g{ws + WS_XN, ws + WS_WINT, 1024, 0, 0, nullptr};
        pg8::TileOrder S; S.init(T / 256, NINP / 256, G, (int)blockIdx.x, nullptr, 0, WGM_P1);
        pg8::EpiBf16 E{(bf16_t*)(ws + WS_P), NINP, (bf16_t*)(ws + WS_VT)};
        for (int rep = 0; rep < NREP(1); ++rep) pg8::gemm_phase<false, false>(lds, g, S, E);
    } SEAM(1);
    TSTART(2);
    if (IN(2)) {
        ck::fused_item(lds, args, (int)blockIdx.x * 2); ck::fused_item(lds, args, (int)blockIdx.x * 2 + 1);
    } SEAM(2);
    TSTART(3);
    if (IN(3)) {
        TSTART(30); for (int rep = 0; rep < NREP(30); ++rep) { if (blockIdx.x < 64) ck::seq_head(lds, args, (int)blockIdx.x); __syncthreads(); } TEND(30);
        for (int rep = 0; rep < NREP(31); ++rep) att::attn_phase(lds, args, ctl + 64 * rep);
    } SEAM(3); TEND(3);
    if (IN(4)) {
        pg8::Gemm g{ws + WS_YMIX, ws + WS_WOUT, 1024, 0, 0, nullptr};
        pg8::TileOrder S; S.init(T / 256, D / 256, G, (int)blockIdx.x, nullptr, 0, WGM_P4);
        pg8::EpiResBf16 E{args.in[0], (bf16_t*)(ws + WS_X1B), D};
        for (int rep = 0; rep < NREP(4); ++rep) pg8::gemm_phase<false, false>(lds, g, S, E);
    } SEAM(4);
    if (IN(5)) { _Pragma("clang loop unroll(disable)") for (int rep = 0; rep < NREP(5); ++rep) { p5_router(lds, args, ctl + 256 * (NREP(5) - 1 - rep)); __syncthreads(); } } SEAM(5);
    if (IN(6)) { for (int rep = 0; rep < NREP(6); ++rep) { p6_dispatch(lds, args, ctl); __syncthreads(); } } SEAM(6);
    if (IN(7)) {
        const int ntile = TILEE[1023];
        pg8::Gemm g{ws + WS_H2, ws + WS_W1T, 1024, F8_W_SC, F8_X_SC, (const int*)(ws + WS_ROWTOK)};
        pg8::TileOrder S; S.init(ntile, 8, G, (int)blockIdx.x, TILEE, 8, WGM_P7);
        pg8::EpiSwiglu E{ws + WS_HID, args.in[27], TILEE};
        for (int rep = 0; rep < NREP(7); ++rep) pg8::gemm_phase<true, true>(lds, g, S, E);
    } SEAM(7);
    if (IN(8)) {
        const int ntile = TILEE[1023];
        pg8::Gemm g{ws + WS_HID, ws + WS_W2T, 1024, F8_W_SC, F8_H_SC, nullptr};
        pg8::TileOrder S; S.init(ntile, 4, G, (int)blockIdx.x, TILEE, 4, WGM_P8);
        pg8::EpiGateF8 E{ws + WS_YS, args.in[29], (const float*)(ws + WS_ROWGATE), TILEE};
        for (int rep = 0; rep < NREP(8); ++rep) pg8::gemm_phase<true, false>(lds, g, S, E);
    } SEAM(8);
    if (IN(9)) { p9_combine(args, G); }
#undef IN
#undef SEAM
}

extern "C" void kernel_launch(void* const* d_in, const int* in_sizes, int n_in, void* d_out, int out_size, void* d_ws, size_t ws_size, hipStream_t stream) {
    static int grid = 0;
    if (grid == 0) {
        if (n_in != 30 || in_sizes[0] != T * D || out_size != T * D || ws_size < WS_END) { fprintf(stderr, "kernel_launch: unexpected shapes (n_in %d, in0 %d, out %d, ws %zu); nothing launched\n", n_in, n_in > 0 ? in_sizes[0] : -1, out_size, ws_size); grid = -1; return; }
        int dev = 0, cus = 0, per_cu = 0;
        if (hipGetDevice(&dev) != hipSuccess || hipDeviceGetAttribute(&cus, hipDeviceAttributeMultiprocessorCount, dev) != hipSuccess) { grid = -1; return; }
        if (hipFuncSetAttribute((const void*)hymba_fwd, hipFuncAttributeMaxDynamicSharedMemorySize, LDS_BYTES) != hipSuccess) { fprintf(stderr, "kernel_launch: hipFuncSetAttribute failed\n"); grid = -1; return; }
        if (hipOccupancyMaxActiveBlocksPerMultiprocessor(&per_cu, (const void*)hymba_fwd, 512, LDS_BYTES) != hipSuccess || per_cu < 1) { fprintf(stderr, "kernel_launch: occupancy query says %d\n", per_cu); per_cu = 1; }
        (void)hipGetLastError();
        grid = cus;
        if (grid > 256) grid = 256;
        if (grid != 256 || T % grid != 0 || (T / grid) % 16 != 0) { fprintf(stderr, "kernel_launch: grid %d does not divide the token count evenly\n", grid); grid = -1; return; }
    }
    if (grid < 0) return;
    (void)hipMemsetAsync((char*)d_ws + WS_CTL, 0, CTL_ZERO_BYTES, stream);
    Args a{};
    for (int i = 0; i < 30; ++i) a.in[i] = (const float*)d_in[i];
    a.out = (float*)d_out; a.ws = (unsigned char*)d_ws;
    constexpr int NL = MK_N_LAUNCHES;
    for (int li = 0; li < NL; ++li) {
        a.ph_lo = (NL == 1) ? 0 : li; a.ph_hi = (NL == 1) ? NPHASE : li + 1;
        void* kargs[] = {&a};
        hipError_t e = hipLaunchCooperativeKernel((const void*)hymba_fwd, dim3(grid), dim3(512), kargs, LDS_BYTES, stream);
        if (e != hipSuccess) { fprintf(stderr, "kernel_launch: cooperative launch %d failed: %s (grid %d)\n", li, hipGetErrorString(e), grid); break; }
    }
}
```
